# Optimizing an MI355X kernel written in HIP

```python
import jax, jax.numpy as jnp
from jax import lax
import numpy as np

D_MODEL = 1024
BATCH = 8
SEQ = 4096
DEPTH = 2

GRID_W = 64
CTX_LEN = 256
N_MIXERS = 2
NA_HEADS = 16
NA_HEAD_DIM = D_MODEL // NA_HEADS
WIN_R = 8
WIN_C = 16
FNO_GROUPS = 4
FNO_GROUP_DIM = D_MODEL // FNO_GROUPS
PEER_HEADS = 8
PEER_N_KEYS = 128
PEER_N_EXPERTS = PEER_N_KEYS * PEER_N_KEYS
PEER_TOPK = 16
PEER_KEY_DIM = 256
PEER_HALF = PEER_KEY_DIM // 2
PEER_BLOCK = 128
N_MOD = 6
EPS = 1e-6

kernel_name = "hybrid_na_fnet_peer_dit"


def rmsnorm(x, g):
    xf = x.astype(jnp.float32)
    y = xf * lax.rsqrt(jnp.mean(xf * xf, axis=-1, keepdims=True) + EPS)
    return y.astype(x.dtype) * g


def split_heads(t):
    return t.reshape(t.shape[0], t.shape[1], NA_HEADS, NA_HEAD_DIM)


def neighbourhood_attention(q, k, v, k_ctx, v_ctx, rpb):
    b, n, h, dh = q.shape
    rows = n // GRID_W
    kr = min(WIN_R, rows)
    kc = min(WIN_C, GRID_W)
    scale = dh ** -0.5
    qg = q.reshape(b, rows, GRID_W, h, dh)
    kg = k.reshape(b, rows, GRID_W, h, dh)
    vg = v.reshape(b, rows, GRID_W, h, dh)
    col = jnp.arange(GRID_W)
    c_start = jnp.clip(col - kc // 2, 0, GRID_W - kc)
    in_win = (col[None, :] >= c_start[:, None]) & (col[None, :] < c_start[:, None] + kc)
    dc_idx = jnp.clip(col[None, :] - col[:, None] + WIN_C - 1, 0, 2 * WIN_C - 2)
    rpb_f = rpb.astype(jnp.float32)
    neg = jnp.finfo(jnp.float32).min

    def row_block(r):
        r_start = jnp.clip(r - kr // 2, 0, rows - kr)
        q_r = lax.dynamic_index_in_dim(qg, r, axis=1, keepdims=False)
        k_r = lax.dynamic_slice_in_dim(kg, r_start, kr, axis=1)
        v_r = lax.dynamic_slice_in_dim(vg, r_start, kr, axis=1)
        dr_idx = r_start + jnp.arange(kr) - r + WIN_R - 1
        bias = rpb_f[:, dr_idx][:, :, dc_idx].transpose(0, 2, 1, 3)
        s_lat = jnp.einsum('bqhd,bikhd->bhqik', q_r, k_r).astype(jnp.float32) * scale + bias[None]
        s_lat = jnp.where(in_win[:, None, :], s_lat, neg)
        s_ctx = jnp.einsum('bqhd,bchd->bhqc', q_r, k_ctx).astype(jnp.float32) * scale
        s = jnp.concatenate([s_lat.reshape(b, h, GRID_W, kr * GRID_W), s_ctx], axis=-1)
        p = jax.nn.softmax(s, axis=-1).astype(v.dtype)
        p_lat = p[..., :kr * GRID_W].reshape(b, h, GRID_W, kr, GRID_W)
        p_ctx = p[..., kr * GRID_W:]
        return (jnp.einsum('bhqik,bikhd->bqhd', p_lat, v_r)
                + jnp.einsum('bhqc,bchd->bqhd', p_ctx, v_ctx))

    out = lax.map(row_block, jnp.arange(rows))
    return out.transpose(1, 0, 2, 3, 4).reshape(b, n, h * dh)


def context_attention(q, k, v):
    b, cl, h, dh = q.shape
    s = jnp.einsum('bqhd,bkhd->bhqk', q, k).astype(jnp.float32) * dh ** -0.5
    p = jax.nn.softmax(s, axis=-1).astype(v.dtype)
    return jnp.einsum('bhqk,bkhd->bqhd', p, v).reshape(b, cl, h * dh)


def fourier_mix(h, w_out):
    b, n, d = h.shape
    hg = h.astype(jnp.float32).reshape(b, n, FNO_GROUPS, FNO_GROUP_DIM)
    f = jnp.fft.fftn(hg, axes=(1, 3), norm="ortho").real
    return f.reshape(b, n, d).astype(h.dtype) @ w_out


def peer_ffn(h, w_query, sub_keys, u_tab, v_tab):
    b, n, d = h.shape
    xb = h.reshape(-1, PEER_BLOCK, d)

    def block(xt):
        t = xt.shape[0]
        q = (xt @ w_query).reshape(t, PEER_HEADS, 2, PEER_HALF)
        s = jnp.einsum('thpk,pek->thpe', q, sub_keys).astype(jnp.float32)
        s_a, i_a = lax.top_k(s[:, :, 0], PEER_TOPK)
        s_b, i_b = lax.top_k(s[:, :, 1], PEER_TOPK)
        cand_s = (s_a[..., :, None] + s_b[..., None, :]).reshape(t, PEER_HEADS, PEER_TOPK * PEER_TOPK)
        cand_i = (i_a[..., :, None] * PEER_N_KEYS + i_b[..., None, :]).reshape(t, PEER_HEADS, PEER_TOPK * PEER_TOPK)
        top_s, pos = lax.top_k(cand_s, PEER_TOPK)
        idx = jnp.take_along_axis(cand_i, pos, axis=-1)
        g = jax.nn.softmax(top_s, axis=-1).astype(xt.dtype)
        act = jax.nn.gelu(jnp.einsum('thkd,td->thk', u_tab[idx], xt), approximate=False)
        return jnp.einsum('thk,thkd->td', g * act, v_tab[idx])

    return lax.map(block, xb).reshape(b, n, d)


def setup_inputs(seed: int = 0) -> dict:
    key = jax.random.key(seed)
    ks = jax.random.split(key, 17)
    n_na = (DEPTH + N_MIXERS - 1) // N_MIXERS
    n_fno = DEPTH // N_MIXERS
    D = D_MODEL

    def nrm(k, shape, s):
        return jax.random.normal(k, shape, jnp.float32) * s

    return {
        "x": nrm(ks[0], (BATCH, SEQ, D), 1.0),
        "c": nrm(ks[1], (BATCH, D), 1.0),
        "ctx": nrm(ks[2], (BATCH, CTX_LEN, D), 1.0),
        "c_ctx": nrm(ks[3], (D,), 1.0),
        "norm_mix": 1.0 + nrm(ks[4], (DEPTH, D), 0.02),
        "norm_ffn": 1.0 + nrm(ks[5], (DEPTH, D), 0.02),
        "w_mod": nrm(ks[6], (DEPTH, D, N_MOD * D), 0.5 * D ** -0.5),
        "b_mod": nrm(ks[7], (DEPTH, N_MOD * D), 0.02),
        "na_w_qkv": nrm(ks[8], (n_na, D, 3 * D), D ** -0.5),
        "na_w_o": nrm(ks[9], (n_na, D, D), D ** -0.5),
        "na_rpb": nrm(ks[10], (n_na, NA_HEADS, 2 * WIN_R - 1, 2 * WIN_C - 1), 0.5),
        "fno_w_out": nrm(ks[11], (n_fno, D, D), D ** -0.5),
        "peer_w_query": nrm(ks[12], (DEPTH, D, PEER_HEADS * PEER_KEY_DIM), D ** -0.5),
        "peer_sub_keys": nrm(ks[13], (DEPTH, 2, PEER_N_KEYS, PEER_HALF), PEER_HALF ** -0.5),
        "peer_u": nrm(ks[14], (DEPTH, PEER_N_EXPERTS, D), D ** -0.5),
        "peer_v": nrm(ks[15], (DEPTH, PEER_N_EXPERTS, D), 1.0),
        "norm_final": 1.0 + nrm(ks[16], (D,), 0.02),
    }


def reference(x, c, ctx, c_ctx, norm_mix, norm_ffn, w_mod, b_mod, na_w_qkv, na_w_o, na_rpb,
              fno_w_out, peer_w_query, peer_sub_keys, peer_u, peer_v, norm_final):
    xc = ctx
    for i in range(DEPTH):
        mixer = i % N_MIXERS
        j = i // N_MIXERS
        ctx_read_later = any(l % N_MIXERS == 0 for l in range(i + 1, DEPTH))
        need_ctx_in = ctx_read_later or mixer == 0

        mod_x = jax.nn.silu(c) @ w_mod[i] + b_mod[i]
        sh_m, sc_m, g_m, sh_f, sc_f, g_f = jnp.split(mod_x[:, None, :], N_MOD, axis=-1)
        hx = rmsnorm(x, norm_mix[i]) * (1 + sc_m) + sh_m
        if need_ctx_in:
            mod_c = jax.nn.silu(c_ctx) @ w_mod[i] + b_mod[i]
            csh_m, csc_m, cg_m, csh_f, csc_f, cg_f = jnp.split(mod_c, N_MOD, axis=-1)
            hc = rmsnorm(xc, norm_mix[i]) * (1 + csc_m) + csh_m

        if mixer == 0:
            q, k, v = jnp.split(hx @ na_w_qkv[j], 3, axis=-1)
            k_c, v_c = jnp.split(hc @ na_w_qkv[j][:, D_MODEL:], 2, axis=-1)
            k_c, v_c = split_heads(k_c), split_heads(v_c)
            mix_x = neighbourhood_attention(split_heads(q), split_heads(k), split_heads(v),
                                            k_c, v_c, na_rpb[j]) @ na_w_o[j]
            if ctx_read_later:
                q_c = split_heads(hc @ na_w_qkv[j][:, :D_MODEL])
                mix_c = context_attention(q_c, k_c, v_c) @ na_w_o[j]
        else:
            mix_x = fourier_mix(hx, fno_w_out[j])
            if ctx_read_later:
                mix_c = fourier_mix(hc, fno_w_out[j])

        x = x + g_m * mix_x
        hx = rmsnorm(x, norm_ffn[i]) * (1 + sc_f) + sh_f
        x = x + g_f * peer_ffn(hx, peer_w_query[i], peer_sub_keys[i], peer_u[i], peer_v[i])
        if ctx_read_later:
            xc = xc + cg_m * mix_c
            hc = rmsnorm(xc, norm_ffn[i]) * (1 + csc_f) + csh_f
            xc = xc + cg_f * peer_ffn(hc, peer_w_query[i], peer_sub_keys[i], peer_u[i], peer_v[i])
    return rmsnorm(x, norm_final)
```

```cpp
#include <hip/hip_runtime.h>
#include <cstdio>
#include <cstdint>

#define LAS __attribute__((address_space(3)))
typedef unsigned short bf16_t;
typedef short bf16x8 __attribute__((ext_vector_type(8)));
typedef short s16x4 __attribute__((ext_vector_type(4)));
typedef float f32x2 __attribute__((ext_vector_type(2)));
typedef float f32x4 __attribute__((ext_vector_type(4)));
typedef float f32x16 __attribute__((ext_vector_type(16)));
typedef unsigned u32x2 __attribute__((ext_vector_type(2)));
typedef unsigned u32x4 __attribute__((ext_vector_type(4)));
typedef __bf16 bf16x2_t __attribute__((ext_vector_type(2)));

#ifndef DBG_SKIP
#define DBG_SKIP 0
#endif
constexpr int DM = 1024, NB = 8, SEQ = 4096, CTXL = 256, GW = 64;
constexpr int ML = NB * SEQ;
constexpr int MC = NB * CTXL;
constexpr int MT = ML + MC;
constexpr int NMOD = 6 * DM;
constexpr int NEXP = 16384;
constexpr float EPS = 1e-6f;
constexpr float LOG2E = 1.4426950408889634f;

constexpr size_t MiB = 1u << 20;
constexpr size_t WS_CTL = 0, CTL_ZERO_BYTES = 1 * MiB;
constexpr size_t WS_MOD = 1 * MiB;
constexpr size_t WS_WQKV = 2 * MiB;
constexpr size_t WS_WO = 8 * MiB;
constexpr size_t WS_WF = 10 * MiB;
constexpr size_t WS_WPQ = 12 * MiB;
constexpr size_t WS_SK = 20 * MiB;
constexpr size_t WS_WC = 20 * MiB + 256 * 1024;
constexpr size_t WS_CS = 22 * MiB;
constexpr size_t WS_TAB = 86 * MiB;
constexpr size_t WS_HX = 214 * MiB;
constexpr size_t WS_QK = 282 * MiB;
constexpr size_t WS_VT = 418 * MiB;
constexpr size_t WS_IDX = WS_VT;
constexpr size_t WS_GATE = WS_VT + 8 * MiB;
constexpr size_t WS_END = 486 * MiB;
constexpr int CW_BAR = 4096;

__device__ __forceinline__ unsigned f2bf(float f) { unsigned u = __builtin_bit_cast(unsigned, f); return (u + 0x7fffu + ((u >> 16) & 1u)) >> 16; }
__device__ __forceinline__ unsigned pk2(float lo, float hi) { return f2bf(lo) | (f2bf(hi) << 16); }
__device__ __forceinline__ unsigned cvtpk(float lo, float hi) { f32x2 v = {lo, hi}; bf16x2_t b = __builtin_convertvector(v, bf16x2_t); return __builtin_bit_cast(unsigned, b); }
__device__ __forceinline__ float bflo(unsigned u) { return __builtin_bit_cast(float, u << 16); }
__device__ __forceinline__ float bfhi(unsigned u) { return __builtin_bit_cast(float, u & 0xffff0000u); }
__device__ __forceinline__ float wave_sum(float v) {
#pragma unroll
    for (int o = 1; o < 64; o <<= 1) v += __shfl_xor(v, o);
    return v;
}
__device__ __forceinline__ int crow(int r, int hi) { return (r & 3) + 8 * (r >> 2) + 4 * hi; }
__device__ __forceinline__ float gelu_erf(float v) {
    const float av = __builtin_fabsf(v), d = av * 0.2316418882f + 1.0f;
    const float t = __builtin_amdgcn_rcpf(d);
    float q = t * 0.5307027145f + (-0.7265760135f); q = q * t + 0.7107068705f; q = q * t + (-0.142248368f); q = q * t + 0.127414796f; q = q * t;
    const float e = __builtin_amdgcn_exp2f((v * v) * (-0.72134752044f));
    const float m = v * (q * e), r = v - m;
    return v < 0.f ? m : r;
}

namespace pg8 {
constexpr int BM = 256, BK = 64, HALF = 128, HTB = HALF * BK * 2, STAGE_BYTES = 8 * HTB, NXCD = 8, WGM = 8;
__host__ __device__ __forceinline__ int lds_byte(int r, int c) { const int st = (r >> 4) * 2 + (c >> 5), rr = r & 15, cc = c & 31, ob = rr * 64 + cc * 2; return st * 1024 + (ob ^ (((ob >> 9) & 1) << 5)); }
__host__ __device__ __forceinline__ void stage_rc(int b, int& R, int& C) { const int st = b / 1024, sb = b % 1024, swz = sb ^ (((sb >> 9) & 1) << 5); R = (st >> 1) * 16 + swz / 64; C = (st & 1) * 32 + (swz % 64) / 2; }
__host__ __device__ __forceinline__ int perm32(int rho) { const int n = rho >> 4, i = rho & 15; return 8 * (i >> 2) + 4 * n + (i & 3); }

struct Unit { int pm, pn, pb; };
struct Gemm { const bf16_t* A; const bf16_t* Bt; };
template <int M_, int N_, int K_, int LDA_, int LDB_, int NBATCH_, long BSA_, long BSB_> struct Shape { static constexpr int M = M_, N = N_, K = K_, lda = LDA_, ldb = LDB_, nbatch = NBATCH_; static constexpr long bsA = BSA_, bsB = BSB_; };

template <class SH> struct StaticOrder {
    static constexpr int nM = SH::M / BM, nN = SH::N / BM, per = nM * nN, nwg = per * SH::nbatch;
    int G, c;
    __device__ __forceinline__ void init(int G_, int c_) { G = G_; c = c_; }
    __device__ __forceinline__ bool next(int i, Unit& u) const {
        const long L = (long)i * G + c; if (L >= nwg) return false;
        int wgid = (int)L; { const int q = nwg / NXCD, r = nwg % NXCD, xcd = wgid % NXCD, off = wgid / NXCD; wgid = (xcd < r ? xcd * (q + 1) : r * (q + 1) + (xcd - r) * q) + off; }
        u.pb = wgid / per; wgid -= u.pb * per;
        const int nig = WGM * nN, gid = wgid / nig, fm = gid * WGM, gsz = (nM - fm) < WGM ? (nM - fm) : WGM;
        u.pm = fm + ((wgid % nig) % gsz); u.pn = (wgid % nig) / gsz; return true;
    }
};

struct EpiStoreBf16 {
    static constexpr bool PERM = true;
    bf16_t* O; long ldc; long bstride;
    __device__ __forceinline__ void operator()(const f32x4 (&acc)[2][2][4][2], const Unit& u, int wr, int wc, int fr, int fq) const {
        const int row0 = u.pm * BM + wr * 64 + fr, col0 = u.pn * BM + wc * 32 + 8 * fq;
        bf16_t* base = O + (long)u.pb * bstride;
#pragma unroll
        for (int ai = 0; ai < 2; ++ai)
#pragma unroll
            for (int m = 0; m < 4; ++m) { bf16_t* rowp = base + (long)(row0 + ai * HALF + m * 16) * ldc + col0;
#pragma unroll
                for (int bj = 0; bj < 2; ++bj) { const f32x4 v0 = acc[ai][bj][m][0], v1 = acc[ai][bj][m][1];
                    u32x4 w; w.x = cvtpk(v0[0], v0[1]); w.y = cvtpk(v0[2], v0[3]); w.z = cvtpk(v1[0], v1[1]); w.w = cvtpk(v1[2], v1[3]);
                    *(u32x4*)(rowp + bj * HALF) = w; } }
    }
};
struct EpiYt {
    static constexpr bool PERM = true;
    bf16_t* Yt;
    __device__ __forceinline__ void operator()(const f32x4 (&acc)[2][2][4][2], const Unit& u, int wr, int wc, int fr, int fq) const {
        const int row0 = u.pm * BM + wr * 64 + fr, col0 = u.pn * BM + wc * 32 + 8 * fq;
#pragma unroll
        for (int ai = 0; ai < 2; ++ai)
#pragma unroll
            for (int m = 0; m < 4; ++m) { const int row = row0 + ai * HALF + m * 16; const int part = row >> 8, cp = row & 255;
#pragma unroll
                for (int bj = 0; bj < 2; ++bj) { const int col = col0 + bj * HALF; const int b = col >> 12, n = col & 4095;
                    const f32x4 v0 = acc[ai][bj][m][0], v1 = acc[ai][bj][m][1];
                    u32x4 w; w.x = cvtpk(v0[0], v0[1]); w.y = cvtpk(v0[2], v0[3]); w.z = cvtpk(v1[0], v1[1]); w.w = cvtpk(v1[2], v1[3]);
                    *(u32x4*)(Yt + ((((long)(b * 4 + u.pb) * 256 + cp) * 2 + part) << 12) + n) = w; }
                asm volatile("" ::: "memory"); }
    }
};
struct EpiResid {
    static constexpr bool PERM = false;
    const float* Xin; float* Xout; const float* gate; int gstride; float gs;
    __device__ __forceinline__ void operator()(const f32x4 (&acc)[2][2][4][2], const Unit& u, int wr, int wc, int fr, int fq) const {
        const int row0 = u.pm * BM + wr * 64 + fr, col0 = u.pn * BM + wc * 32 + 4 * fq;
        const float* gb = gate + (long)((u.pm * BM) >> 12) * gstride;
        f32x4 gv[2][2];
#pragma unroll
        for (int bj = 0; bj < 2; ++bj)
#pragma unroll
            for (int n = 0; n < 2; ++n) gv[bj][n] = *(const f32x4*)(gb + col0 + bj * HALF + n * 16);
#pragma unroll
        for (int ai = 0; ai < 2; ++ai)
#pragma unroll
            for (int m = 0; m < 4; ++m) { const long off = (long)(row0 + ai * HALF + m * 16) * DM + col0;
#pragma unroll
                for (int bj = 0; bj < 2; ++bj)
#pragma unroll
                    for (int n = 0; n < 2; ++n) { const f32x4 bs = *(const f32x4*)(Xin + off + bj * HALF + n * 16);
                        *(f32x4*)(Xout + off + bj * HALF + n * 16) = bs + gv[bj][n] * acc[ai][bj][m][n] * gs; }
                if (m & 1) asm volatile("" ::: "memory"); }
    }
};

template <class SH, class Epi>
__device__ __forceinline__ void gemm_phase(LAS unsigned char* lds, const Gemm g, int G_, int c_, const Epi& E) {
    StaticOrder<SH> S; S.init(G_, c_);
    int tid_ = threadIdx.x; asm volatile("" : "+v"(tid_));
    const int tid = tid_, wid = __builtin_amdgcn_readfirstlane(tid >> 6), lane = tid & 63, wr = wid >> 2, wc = wid & 3, fr = lane & 15, fq = lane >> 4;
    constexpr int K = SH::K, nt = K / BK;
    unsigned voffA[2], voffB[2];
#pragma unroll
    for (int i = 0; i < 2; ++i) { int R, C; stage_rc(tid * 16 + i * 8192, R, C); const int Rb = Epi::PERM ? ((R & ~31) + perm32(R & 31)) : R;
        voffA[i] = (unsigned)(R * SH::lda + C) * 2u; voffB[i] = (unsigned)(Rb * SH::ldb + C) * 2u; }
    constexpr size_t kstep = (size_t)(BK * 2);
    constexpr size_t hstepA = (size_t)HALF * SH::lda * 2, hstepB = (size_t)HALF * SH::ldb * 2;
    constexpr size_t tstepA = 2 * hstepA, tstepB = 2 * hstepB;
    const unsigned ldsw = (unsigned)wid * 1024u;
    const int aoff = lds_byte(wr * 64 + fr, fq * 8), boff = lds_byte(wc * 32 + fr, fq * 8);
#define PG8_SA(b, h) (((b) * 2 + (h)) * HTB)
#define PG8_SB(b, h) ((4 + (b) * 2 + (h)) * HTB)
#define PG8_STAGE(bufoff, gbase, voff) do { _Pragma("unroll") for (int _i = 0; _i < 2; ++_i) \
        __builtin_amdgcn_global_load_lds((const unsigned*)((const char*)(gbase) + (voff)[_i]), (LAS unsigned*)(lds + (bufoff) + ldsw + _i * 8192), 16, 0, 0); } while (0)
#define PG8_LDA(dst, b, h) do { _Pragma("unroll") for (int m = 0; m < 4; ++m) _Pragma("unroll") for (int k = 0; k < 2; ++k) dst[m][k] = *(const LAS bf16x8*)(lds + PG8_SA(b, h) + aoff + m * 2048 + k * 1024); } while (0)
#define PG8_LDB(dst, b, h) do { _Pragma("unroll") for (int n = 0; n < 2; ++n) _Pragma("unroll") for (int k = 0; k < 2; ++k) dst[n][k] = *(const LAS bf16x8*)(lds + PG8_SB(b, h) + boff + n * 2048 + k * 1024); } while (0)
#define PG8_MMA(ai, bj, At, Bt) do { __builtin_amdgcn_s_setprio(1); _Pragma("unroll") for (int m = 0; m < 4; ++m) _Pragma("unroll") for (int n = 0; n < 2; ++n) _Pragma("unroll") for (int k = 0; k < 2; ++k) \
        acc[ai][bj][m][n] = __builtin_amdgcn_mfma_f32_16x16x32_bf16(Bt[n][k], At[m][k], acc[ai][bj][m][n], 0, 0, 0); __builtin_amdgcn_s_setprio(0); } while (0)
#define PG8_WAIT_V(n) asm volatile("s_waitcnt vmcnt(" #n ")" ::: "memory")
#define PG8_WAIT_L(n) asm volatile("s_waitcnt lgkmcnt(" #n ")" ::: "memory")
#define PG8_BAR __builtin_amdgcn_s_barrier()
#define PG8_SCHED __builtin_amdgcn_sched_barrier(0)
    Unit cur, nxt; int ui = 0;
    if (!S.next(0, cur)) return;
    f32x4 acc[2][2][4][2];
#pragma unroll
    for (int a = 0; a < 2; ++a)
#pragma unroll
        for (int b = 0; b < 2; ++b)
#pragma unroll
            for (int m = 0; m < 4; ++m)
#pragma unroll
                for (int n = 0; n < 2; ++n) acc[a][b][m][n] = (f32x4){0.f, 0.f, 0.f, 0.f};
    bf16x8 At[4][2], B0[2][2], B1[2][2];
    const char* cA = (const char*)(g.A + (long)cur.pb * SH::bsA) + (size_t)cur.pm * tstepA; const char* cB = (const char*)(g.Bt + (long)cur.pb * SH::bsB) + (size_t)cur.pn * tstepB;
    PG8_STAGE(PG8_SB(0, 0), cB, voffB); PG8_STAGE(PG8_SB(0, 1), cB + hstepB, voffB); PG8_STAGE(PG8_SA(0, 0), cA, voffA); PG8_STAGE(PG8_SA(0, 1), cA + hstepA, voffA);
    if (wr == 1) PG8_BAR;
    PG8_WAIT_V(2); PG8_BAR;
    PG8_STAGE(PG8_SB(1, 0), cB + kstep, voffB); PG8_STAGE(PG8_SA(1, 0), cA + kstep, voffA); PG8_STAGE(PG8_SB(1, 1), cB + hstepB + kstep, voffB);
    PG8_WAIT_V(6); PG8_BAR;
    for (;;) {
        const bool has_next = S.next(ui + 1, nxt);
        const char* nA = has_next ? (const char*)(g.A + (long)nxt.pb * SH::bsA) + (size_t)nxt.pm * tstepA : cA; const char* nB = has_next ? (const char*)(g.Bt + (long)nxt.pb * SH::bsB) + (size_t)nxt.pn * tstepB : cB;
#pragma nounroll
        for (int t = 0; t < nt; t += 2) {
            const bool last = (t == nt - 2);
            const char* a1 = cA + (size_t)(t + 1) * kstep;
            const char* a2 = last ? nA : cA + (size_t)(t + 2) * kstep; const char* b2 = last ? nB : cB + (size_t)(t + 2) * kstep;
            const char* a3 = a2 + kstep; const char* b3 = b2 + kstep;
            PG8_LDB(B0, 0, 0); PG8_LDB(B1, 0, 1); PG8_SCHED; PG8_LDA(At, 0, 0); PG8_STAGE(PG8_SA(1, 1), a1 + hstepA, voffA);
            PG8_WAIT_V(8); PG8_WAIT_L(0); PG8_BAR; PG8_MMA(0, 0, At, B0); PG8_MMA(0, 1, At, B1); PG8_BAR; PG8_SCHED;
            PG8_LDA(At, 0, 1); PG8_STAGE(PG8_SB(0, 0), b2, voffB); PG8_STAGE(PG8_SB(0, 1), b2 + hstepB, voffB); PG8_STAGE(PG8_SA(0, 0), a2, voffA);
            PG8_WAIT_V(8); PG8_WAIT_L(0); PG8_BAR; PG8_MMA(1, 0, At, B0); PG8_MMA(1, 1, At, B1); PG8_BAR; PG8_SCHED;
            PG8_LDB(B0, 1, 0); PG8_LDB(B1, 1, 1); PG8_SCHED; PG8_LDA(At, 1, 0); PG8_STAGE(PG8_SA(0, 1), a2 + hstepA, voffA);
            PG8_WAIT_V(8); PG8_WAIT_L(0); PG8_BAR; PG8_MMA(0, 0, At, B0); PG8_MMA(0, 1, At, B1); PG8_BAR; PG8_SCHED;
            PG8_LDA(At, 1, 1); PG8_STAGE(PG8_SB(1, 0), b3, voffB); PG8_STAGE(PG8_SB(1, 1), b3 + hstepB, voffB); PG8_STAGE(PG8_SA(1, 0), a3, voffA);
            PG8_WAIT_V(8); PG8_WAIT_L(0); PG8_BAR; PG8_MMA(1, 0, At, B0); PG8_MMA(1, 1, At, B1); PG8_BAR; PG8_SCHED;
        }
        if (wr == 0) PG8_BAR;
        E(acc, cur, wr, wc, fr, fq);
        if (!has_next) break;
#pragma unroll
        for (int a = 0; a < 2; ++a)
#pragma unroll
            for (int b = 0; b < 2; ++b)
#pragma unroll
                for (int m = 0; m < 4; ++m)
#pragma unroll
                    for (int n = 0; n < 2; ++n) acc[a][b][m][n] = (f32x4){0.f, 0.f, 0.f, 0.f};
        cur = nxt; cA = nA; cB = nB; ++ui;
        if (wr == 1) PG8_BAR;
    }
    PG8_WAIT_V(0);
    PG8_BAR;
#undef PG8_SA
#undef PG8_SB
#undef PG8_STAGE
#undef PG8_LDA
#undef PG8_LDB
#undef PG8_MMA
#undef PG8_WAIT_V
#undef PG8_WAIT_L
#undef PG8_BAR
#undef PG8_SCHED
}
}

#define XB_TMO      128
#define XB_XCNT(j)  (256  + 64 * (j))
#define XB_XSUB(j)  (1280 + 64 * (j))
#define XB_XGEN(j)  (2304 + 64 * (j))
#define XB_TOP      3328
#define XB_TOPGEN   3392
#define XCD_BAR_WORDS 3456
#define XB_SPIN_CAP (1u << 18)
__device__ __forceinline__ unsigned xb_ld(unsigned* p)              { return __hip_atomic_load(p, __ATOMIC_RELAXED, __HIP_MEMORY_SCOPE_AGENT); }
__device__ __forceinline__ unsigned xb_add(unsigned* p, unsigned v) { return __hip_atomic_fetch_add(p, v, __ATOMIC_RELAXED, __HIP_MEMORY_SCOPE_AGENT); }
__device__ __forceinline__ unsigned xb_xcc_id() { return (unsigned)__builtin_amdgcn_s_getreg((3 << 11) | 20) & 0xFu; }
#define XB_SPIN(cond, bar) do { unsigned _sp = 0; while (cond) { __builtin_amdgcn_s_sleep(1); \
    if ((++_sp & 255u) == 0u) { if (xb_ld(&(bar)[XB_TMO])) break; if (_sp > XB_SPIN_CAP) { atomicAdd(&(bar)[XB_TMO], 1u); break; } } } } while (0)
struct XcdBarrier { unsigned* bar; unsigned x; volatile LAS unsigned* st; };
__device__ __forceinline__ XcdBarrier xcd_barrier_post(unsigned* bar, volatile LAS unsigned* st) {
    XcdBarrier b; b.bar = bar; b.x = xb_xcc_id(); b.st = st;
    if (threadIdx.x == 0) (void)xb_add(&bar[XB_XCNT(b.x)], 1u);
    return b;
}
__device__ __forceinline__ void xcd_barrier_complete(unsigned* bar, unsigned x, unsigned& nloc, unsigned& nx) {
    const unsigned G = gridDim.x * gridDim.y * gridDim.z;
    unsigned sum, cnt, mine, sp = 0u;
    for (;;) {
        sum = 0u; cnt = 0u; mine = 0u;
#pragma unroll
        for (unsigned j = 0; j < 16; ++j) { const unsigned c = xb_ld(&bar[XB_XCNT(j)]); sum += c; cnt += (c > 0u) ? 1u : 0u; mine = (j == x) ? c : mine; }
        if (sum == G) break;
        __builtin_amdgcn_s_sleep(1);
        if ((++sp & 255u) == 0u) { if (xb_ld(&bar[XB_TMO])) break; if (sp > XB_SPIN_CAP) { atomicAdd(&bar[XB_TMO], 1u); break; } }
    }
    nloc = mine > 0u ? mine : 1u; nx = cnt > 0u ? cnt : 1u;
}
__device__ __forceinline__ void xcd_barrier(const XcdBarrier& b) {
    asm volatile("s_waitcnt vmcnt(0)" ::: "memory");
    __syncthreads();
    if (threadIdx.x == 0) {
        unsigned* bar = b.bar;
        __builtin_amdgcn_s_waitcnt(0);
        unsigned nloc = b.st[0], nx = b.st[1];
        if (nloc == 0u) { xcd_barrier_complete(bar, b.x, nloc, nx); b.st[0] = nloc; b.st[1] = nx; }
        const unsigned old = xb_add(&bar[XB_XSUB(b.x)], 1u);
        const unsigned gen = old / nloc;
        if (old + 1u == (gen + 1u) * nloc) {
            __builtin_amdgcn_fence(__ATOMIC_RELEASE, "agent");
            asm volatile("s_waitcnt vmcnt(0)" ::: "memory");
            const unsigned og = xb_add(&bar[XB_TOP], 1u);
            const unsigned tg = og / nx;
            if (og + 1u == (tg + 1u) * nx) xb_add(&bar[XB_TOPGEN], 1u);
            else XB_SPIN(xb_ld(&bar[XB_TOPGEN]) == tg, bar);
            __builtin_amdgcn_fence(__ATOMIC_ACQUIRE, "agent");
            xb_add(&bar[XB_XGEN(b.x)], 1u);
            asm volatile("s_waitcnt vmcnt(0)" ::: "memory");
        } else {
            XB_SPIN(xb_ld(&bar[XB_XGEN(b.x)]) == gen, bar);
            __builtin_amdgcn_fence(__ATOMIC_ACQUIRE, "agent");
            asm volatile("s_waitcnt vmcnt(0)" ::: "memory");
        }
    }
    __syncthreads();
}

constexpr int RING_BYTES = 131072;
constexpr int LDSCTL_OFF = RING_BYTES, MISC_OFF = LDSCTL_OFF + 320;
constexpr int LDS_BYTES = 147456;
constexpr int NWAVES = 8;

struct Args { const float* in[17]; float* out; unsigned char* ws; };

struct Ctx {
    LAS unsigned char* lds;
    int tid, lane, wave, vcu, G;
};

__device__ __forceinline__ Ctx fresh(const Ctx& F) {
    Ctx C = F; int t = threadIdx.x; asm volatile("" : "+v"(t)); C.tid = t; C.lane = t & 63; return C;
}
__device__ __forceinline__ void p0_transpose_item(const float* W, int K, int N, bf16_t* WT, LAS float* scr, int item, int lane) {
    const int nblk = N / 32, kb = item / nblk, nb = item % nblk, k0 = 64 * kb, n0 = 32 * nb;
#pragma unroll 8
    for (int i = 0; i < 32; ++i) { const int kk = 2 * i + (lane >> 5); scr[kk * 33 + (lane & 31)] = W[(size_t)(k0 + kk) * N + n0 + (lane & 31)]; }
    asm volatile("s_waitcnt lgkmcnt(0)" ::: "memory");
    const int c = lane & 7;
#pragma unroll
    for (int j = 0; j < 4; ++j) { const int n = (lane >> 3) + 8 * j; const LAS float* s = scr + (8 * c) * 33 + n;
        u32x4 o; o.x = pk2(s[0 * 33], s[1 * 33]); o.y = pk2(s[2 * 33], s[3 * 33]); o.z = pk2(s[4 * 33], s[5 * 33]); o.w = pk2(s[6 * 33], s[7 * 33]);
        *(u32x4*)(WT + (size_t)(n0 + n) * K + k0 + 8 * c) = o; }
    asm volatile("s_waitcnt lgkmcnt(0)" ::: "memory");
}
__device__ __forceinline__ void cvt8(const float* src, bf16_t* dst) {
    const f32x4 a = *(const f32x4*)src, b = *(const f32x4*)(src + 4);
    u32x4 o; o.x = pk2(a[0], a[1]); o.y = pk2(a[2], a[3]); o.z = pk2(b[0], b[1]); o.w = pk2(b[2], b[3]);
    *(u32x4*)dst = o;
}

__device__ __forceinline__ void p0_prologue(const Ctx& F0, const Args& a) {
    const Ctx F = fresh(F0);
    unsigned char* ws = a.ws;
    const int gw = F.vcu * NWAVES + F.wave, NGW = F.G * NWAVES;
    const long gt = (long)F.vcu * 512 + F.tid, NGT = (long)F.G * 512;
    {
        LAS float* red = (LAS float*)(F.lds);
        const float* c = a.in[1]; const float* cctx = a.in[3]; const float* wmod = a.in[6]; const float* bmod = a.in[7];
        float* modb = (float*)(ws + WS_MOD);
        for (int item = F.vcu; item < 96; item += F.G) {
            const int l = item / 48, nc = item % 48, n0 = nc * 128 + 2 * F.lane, kb = F.wave * 128;
            float sv[9][2];
#pragma unroll
            for (int r = 0; r < 9; ++r)
#pragma unroll
                for (int j = 0; j < 2; ++j) { const int k = kb + 64 * j + F.lane; const float v = (r < 8) ? c[r * DM + k] : cctx[k]; sv[r][j] = v / (1.0f + __expf(-v)); }
            float acc[9][2];
#pragma unroll
            for (int r = 0; r < 9; ++r) { acc[r][0] = 0.f; acc[r][1] = 0.f; }
            const float* wp = wmod + (size_t)l * DM * NMOD + (size_t)kb * NMOD + n0;
#pragma unroll
            for (int j = 0; j < 2; ++j)
#pragma unroll 8
                for (int kl = 0; kl < 64; ++kl) {
                    const f32x2 w = *(const f32x2*)(wp + (size_t)(64 * j + kl) * NMOD);
#pragma unroll
                    for (int r = 0; r < 9; ++r) { const float s = __builtin_bit_cast(float, __builtin_amdgcn_readlane(__builtin_bit_cast(int, sv[r][j]), kl)); acc[r][0] += s * w[0]; acc[r][1] += s * w[1]; }
                }
            __syncthreads();
#pragma unroll
            for (int r = 0; r < 9; ++r) { red[(F.wave * 9 + r) * 128 + 2 * F.lane] = acc[r][0]; red[(F.wave * 9 + r) * 128 + 2 * F.lane + 1] = acc[r][1]; }
            __syncthreads();
            for (int o = F.tid; o < 9 * 128; o += 512) { const int r = o >> 7, nl = o & 127; float s = 0.f;
#pragma unroll
                for (int w = 0; w < 8; ++w) s += red[(w * 9 + r) * 128 + nl];
                modb[(size_t)(l * 9 + r) * NMOD + nc * 128 + nl] = s + bmod[l * NMOD + nc * 128 + nl]; }
        }
        __syncthreads();
    }
    {
        LAS float* scr = (LAS float*)(F.lds + F.wave * 16384);
        constexpr int I_QKV = (DM / 64) * (3 * DM / 32), I_O = (DM / 64) * (DM / 32), I_PQ = (DM / 64) * (2 * DM / 32);
        constexpr int NITEMS = I_QKV + 2 * I_O + 2 * I_PQ;
        for (int it = gw; it < NITEMS; it += NGW) {
            int r = it;
            if (r < I_QKV) { p0_transpose_item(a.in[8], DM, 3 * DM, (bf16_t*)(ws + WS_WQKV), scr, r, F.lane); continue; } r -= I_QKV;
            if (r < I_O) { p0_transpose_item(a.in[9], DM, DM, (bf16_t*)(ws + WS_WO), scr, r, F.lane); continue; } r -= I_O;
            if (r < I_O) { p0_transpose_item(a.in[11], DM, DM, (bf16_t*)(ws + WS_WF), scr, r, F.lane); continue; } r -= I_O;
            if (r < I_PQ) { p0_transpose_item(a.in[12], DM, 2 * DM, (bf16_t*)(ws + WS_WPQ), scr, r, F.lane); continue; } r -= I_PQ;
            p0_transpose_item(a.in[12] + (size_t)DM * 2 * DM, DM, 2 * DM, (bf16_t*)(ws + WS_WPQ) + (size_t)2 * DM * DM, scr, r, F.lane);
        }
    }
    for (long i = gt; i < 2 * 2 * 128 * 128 / 8; i += NGT) cvt8(a.in[13] + i * 8, (bf16_t*)(ws + WS_SK) + i * 8);
    {
        constexpr long PER = (long)NEXP * DM / 8;
        for (long i = gt; i < 4 * PER; i += NGT) {
            const int q = (int)(i / PER); const long r = i - (long)q * PER; const int l = q >> 1, tb = q & 1;
            const float* src = (tb ? a.in[15] : a.in[14]) + (size_t)l * NEXP * DM + r * 8;
            cvt8(src, (bf16_t*)(ws + WS_TAB) + (size_t)q * NEXP * DM + r * 8);
        }
    }
    {
        bf16_t* wc = (bf16_t*)(ws + WS_WC);
        for (long i = gt; i < 512 * 256 / 8; i += NGT) { const int nn = (int)(i >> 5), k0 = (int)(i & 31) * 8; float v[8];
#pragma unroll
            for (int j = 0; j < 8; ++j) { const int m = ((k0 + j) * (nn & 255)) & 255; const float fr = (float)m * (1.0f / 256.0f);
                v[j] = (nn < 256 ? __builtin_amdgcn_cosf(fr) : __builtin_amdgcn_sinf(fr)) * (1.0f / 16.0f); }
            u32x4 o; o.x = pk2(v[0], v[1]); o.y = pk2(v[2], v[3]); o.z = pk2(v[4], v[5]); o.w = pk2(v[6], v[7]);
            *(u32x4*)(wc + i * 8) = o; }
        bf16_t* cs = (bf16_t*)(ws + WS_CS);
        for (long i = gt; i < 4096L * 8192 / 8; i += NGT) { const int np = (int)(i >> 10), c0 = (int)(i & 1023) * 8; const int part = c0 >> 12; float v[8];
#pragma unroll
            for (int j = 0; j < 8; ++j) { const int n = (c0 + j) & 4095; const int m = (n * np) & 4095; const float fr = (float)m * (1.0f / 4096.0f);
                v[j] = (part == 0 ? __builtin_amdgcn_cosf(fr) : -__builtin_amdgcn_sinf(fr)) * (1.0f / 64.0f); }
            u32x4 o; o.x = pk2(v[0], v[1]); o.y = pk2(v[2], v[3]); o.z = pk2(v[4], v[5]); o.w = pk2(v[6], v[7]);
            *(u32x4*)(cs + i * 8) = o; }
    }
}

__device__ __forceinline__ void norm_mod_row(const float* xrow, const float* gw, const float* sh, const float* sc, bf16_t* orow, int lane) {
    const f32x4* xr = (const f32x4*)xrow + lane;
    f32x4 v[4]; float s = 0.f;
#pragma unroll
    for (int j = 0; j < 4; ++j) { v[j] = xr[64 * j]; s += (v[j].x * v[j].x + v[j].y * v[j].y) + (v[j].z * v[j].z + v[j].w * v[j].w); }
    const float rstd = 1.0f / sqrtf(wave_sum(s) * (1.0f / DM) + EPS);
    unsigned long long* o8 = (unsigned long long*)orow + lane;
#pragma unroll
    for (int j = 0; j < 4; ++j) {
        const f32x4 g = ((const f32x4*)gw)[lane + 64 * j], a = ((const f32x4*)sh)[lane + 64 * j], c = ((const f32x4*)sc)[lane + 64 * j];
        const f32x4 y = (v[j] * rstd * g) * (c + 1.0f) + a;
        o8[64 * j] = (unsigned long long)cvtpk(y.x, y.y) | ((unsigned long long)cvtpk(y.z, y.w) << 32);
    }
}
__device__ __forceinline__ void norm_phase(const Ctx& F0, const Args& a, int mode, int layer, int off, const float* gw) {
    const Ctx F = fresh(F0);
    const int gwv = F.vcu * NWAVES + F.wave, NGW = F.G * NWAVES;
    const float* modb = (const float*)(a.ws + WS_MOD) + (size_t)layer * 9 * NMOD;
    bf16_t* hx = (bf16_t*)(a.ws + WS_HX);
    const int nrows = (mode == 0) ? MT : ML;
    for (int m = gwv; m < nrows; m += NGW) {
        const float* src; const float* mr;
        if (m < ML) { src = (mode == 0 ? a.in[0] : a.out) + (size_t)m * DM; mr = modb + (size_t)(m >> 12) * NMOD; }
        else { src = a.in[2] + (size_t)(m - ML) * DM; mr = modb + (size_t)8 * NMOD; }
        norm_mod_row(src, gw, mr + off, mr + off + DM, hx + (size_t)m * DM, F.lane);
    }
}
__device__ __forceinline__ void final_norm_phase(const Ctx& F0, const Args& a) {
    const Ctx F = fresh(F0);
    const int gwv = F.vcu * NWAVES + F.wave, NGW = F.G * NWAVES;
    const float* gw = a.in[16];
    for (int m = gwv; m < ML; m += NGW) {
        f32x4* xr = (f32x4*)(a.out + (size_t)m * DM) + F.lane;
        f32x4 v[4]; float s = 0.f;
#pragma unroll
        for (int j = 0; j < 4; ++j) { v[j] = xr[64 * j]; s += (v[j].x * v[j].x + v[j].y * v[j].y) + (v[j].z * v[j].z + v[j].w * v[j].w); }
        const float rstd = 1.0f / sqrtf(wave_sum(s) * (1.0f / DM) + EPS);
#pragma unroll
        for (int j = 0; j < 4; ++j) xr[64 * j] = v[j] * rstd * ((const f32x4*)gw)[F.lane + 64 * j];
    }
}

__device__ __forceinline__ void attn_phase(const Ctx& F0, const Args& a) {
    const Ctx F = fresh(F0);
    const bf16_t* QK = (const bf16_t*)(a.ws + WS_QK);
    const bf16_t* VT = (const bf16_t*)(a.ws + WS_VT);
    bf16_t* AO = (bf16_t*)(a.ws + WS_HX);
    const float* rpb = a.in[10];
    LAS float* rl = (LAS float*)F.lds;
    const int lane = F.lane, hl = F.wave >> 1, qt = F.wave & 1, q32 = lane & 31, hi = lane >> 5;
    const float SC = 0.125f * LOG2E, NEG = -1e30f;
    for (int task = F.vcu; task < 2048; task += F.G) {
        const int hq = task & 3, r = (task >> 2) & 63, b = task >> 8;
        __syncthreads();
        for (int i = F.tid; i < 4 * 465; i += 512) rl[i] = rpb[hq * 4 * 465 + i] * LOG2E;
        __syncthreads();
        const int h = 4 * hq + hl;
        const int r_start = min(max(r - 4, 0), 56);
        const int qc = 32 * qt + q32;
        const int cs = min(max(qc - 8, 0), 48);
        const long mq = (long)b * SEQ + r * GW + qc;
        bf16x8 qr[4];
#pragma unroll
        for (int d0 = 0; d0 < 4; ++d0) qr[d0] = *(const bf16x8*)(QK + mq * 2048 + h * 64 + d0 * 16 + hi * 8);
        float m_run = NEG, l_run = 0.f;
        f32x16 o[2];
#pragma unroll
        for (int i = 0; i < 16; ++i) { o[0][i] = 0.f; o[1][i] = 0.f; }
        for (int it = 0; it < 12; ++it) {
            const bool latent = it < 8;
            const int kr = r_start + it;
            const long tok0 = latent ? ((long)b * SEQ + (long)kr * GW) : ((long)ML + b * CTXL + (it - 8) * 64);
            f32x16 p[2];
#pragma unroll
            for (int blk = 0; blk < 2; ++blk) {
                const bf16_t* kp = QK + (tok0 + 32 * blk + q32) * 2048 + 1024 + h * 64 + hi * 8;
                f32x16 acc;
#pragma unroll
                for (int i = 0; i < 16; ++i) acc[i] = 0.f;
#pragma unroll
                for (int d0 = 0; d0 < 4; ++d0) { const bf16x8 kf = *(const bf16x8*)(kp + d0 * 16); acc = __builtin_amdgcn_mfma_f32_32x32x16_bf16(kf, qr[d0], acc, 0, 0, 0); }
                p[blk] = acc;
            }
            float mx = NEG;
            if (latent) {
                const LAS float* rb = rl + hl * 465 + (kr - r + 7) * 31;
#pragma unroll
                for (int blk = 0; blk < 2; ++blk)
#pragma unroll
                    for (int i = 0; i < 16; ++i) { const int kc = 32 * blk + crow(i, hi); const bool valid = (kc >= cs) && (kc < cs + 16);
                        const int bi = valid ? (kc - qc + 15) : 0; const float bv = rb[bi];
                        const float v = valid ? (p[blk][i] * SC + bv) : NEG; p[blk][i] = v; mx = fmaxf(mx, v); }
            } else {
#pragma unroll
                for (int blk = 0; blk < 2; ++blk)
#pragma unroll
                    for (int i = 0; i < 16; ++i) { const float v = p[blk][i] * SC; p[blk][i] = v; mx = fmaxf(mx, v); }
            }
            mx = fmaxf(mx, __shfl_xor(mx, 32));
            const float m_new = fmaxf(m_run, mx);
            const float alpha = __builtin_amdgcn_exp2f(m_run - m_new);
            m_run = m_new;
            float rs = 0.f;
#pragma unroll
            for (int blk = 0; blk < 2; ++blk)
#pragma unroll
                for (int i = 0; i < 16; ++i) { const float e = __builtin_amdgcn_exp2f(p[blk][i] - m_new); p[blk][i] = e; rs += e; }
            l_run = l_run * alpha + rs;
#pragma unroll
            for (int i = 0; i < 16; ++i) { o[0][i] *= alpha; o[1][i] *= alpha; }
#pragma unroll
            for (int blk = 0; blk < 2; ++blk)
#pragma unroll
                for (int s = 0; s < 2; ++s) {
                    u32x4 pw; pw.x = cvtpk(p[blk][8 * s + 0], p[blk][8 * s + 1]); pw.y = cvtpk(p[blk][8 * s + 2], p[blk][8 * s + 3]);
                    pw.z = cvtpk(p[blk][8 * s + 4], p[blk][8 * s + 5]); pw.w = cvtpk(p[blk][8 * s + 6], p[blk][8 * s + 7]);
                    const bf16x8 pf = __builtin_bit_cast(bf16x8, pw);
#pragma unroll
                    for (int dh = 0; dh < 2; ++dh) {
                        const bf16_t* vp = VT + (long)(h * 64 + 32 * dh + q32) * MT + tok0 + 32 * blk + 16 * s + 4 * hi;
                        const u32x2 v0 = *(const u32x2*)vp, v1 = *(const u32x2*)(vp + 8);
                        u32x4 vw; vw.x = v0.x; vw.y = v0.y; vw.z = v1.x; vw.w = v1.y;
                        o[dh] = __builtin_amdgcn_mfma_f32_32x32x16_bf16(__builtin_bit_cast(bf16x8, vw), pf, o[dh], 0, 0, 0);
                    }
                }
        }
        l_run += __shfl_xor(l_run, 32);
        const float linv = 1.0f / l_run;
        bf16_t* op = AO + mq * DM + h * 64;
#pragma unroll
        for (int dh = 0; dh < 2; ++dh)
#pragma unroll
            for (int g4 = 0; g4 < 4; ++g4) {
                u32x2 w; w.x = cvtpk(o[dh][4 * g4 + 0] * linv, o[dh][4 * g4 + 1] * linv); w.y = cvtpk(o[dh][4 * g4 + 2] * linv, o[dh][4 * g4 + 3] * linv);
                *(u32x2*)(op + 32 * dh + 8 * g4 + 4 * hi) = w;
            }
    }
    __syncthreads();
}

__device__ __forceinline__ void ce_desc(float& a, float& b) { const float hi = fmaxf(a, b), lo = fminf(a, b); a = hi; b = lo; }
__device__ __forceinline__ void ce_dir(float& a, float& b, bool desc) { const float hi = fmaxf(a, b), lo = fminf(a, b); a = desc ? hi : lo; b = desc ? lo : hi; }
__device__ __forceinline__ void sort16_desc(float (&v)[16]) {
#pragma unroll
    for (int k = 2; k <= 16; k <<= 1)
#pragma unroll
        for (int j = k >> 1; j > 0; j >>= 1)
#pragma unroll
            for (int i = 0; i < 16; ++i) { const int l = i ^ j; if (l > i) ce_dir(v[i], v[l], (i & k) == 0); }
}
__device__ __forceinline__ void merge16_desc(float (&a)[16], const float (&b)[16]) {
#pragma unroll
    for (int i = 0; i < 16; ++i) a[i] = fmaxf(a[i], b[15 - i]);
#pragma unroll
    for (int j = 8; j > 0; j >>= 1)
#pragma unroll
        for (int i = 0; i < 16; ++i) { const int l = i ^ j; if (l > i) ce_desc(a[i], a[l]); }
}

struct CandTab { int i[64]; int j[64]; };
__host__ __device__ constexpr CandTab make_cand_tab() {
    CandTab t{}; int n = 0;
    for (int i = 0; i < 16; ++i) for (int j = 0; j < 16; ++j) if ((i + 1) * (j + 1) <= 16) { t.i[n] = i; t.j[n] = j; ++n; }
    for (; n < 64; ++n) { t.i[n] = -1; t.j[n] = -1; }
    return t;
}

__device__ __forceinline__ void peer_topk_phase(const Ctx& F0, const Args& a, int layer) {
    const Ctx F = fresh(F0);
    const bf16_t* QP = (const bf16_t*)(a.ws + WS_QK);
    const bf16_t* SK = (const bf16_t*)(a.ws + WS_SK) + (size_t)layer * 2 * 128 * 128;
    unsigned short* IDX = (unsigned short*)(a.ws + WS_IDX);
    float* GATE = (float*)(a.ws + WS_GATE);
    const int gwv = F.vcu * NWAVES + F.wave, NGW = F.G * NWAVES;
    const int lane = F.lane, t32 = lane & 31, hi = lane >> 5;
    __syncthreads();
    for (int c = F.tid; c < 4096; c += 512) *(LAS u32x4*)(F.lds + (c >> 4) * 272 + (c & 15) * 16) = *(const u32x4*)(SK + (size_t)c * 8);
    __syncthreads();
    for (int task = gwv; task < 1024 * 8; task += NGW) {
        const int tt = task >> 3, h = task & 7;
        const long tok = (long)tt * 32 + t32;
        float top[2][16];
#pragma unroll
        for (int p = 0; p < 2; ++p) {
            f32x16 acc[4];
#pragma unroll
            for (int eb = 0; eb < 4; ++eb)
#pragma unroll
                for (int i = 0; i < 16; ++i) acc[eb][i] = 0.f;
            const bf16_t* qp = QP + tok * 2048 + h * 256 + p * 128 + hi * 8;
            const LAS unsigned char* kp = F.lds + (p * 128 + t32) * 272 + hi * 16;
#pragma unroll
            for (int ks = 0; ks < 8; ++ks) {
                if ((ks & 1) == 0) asm volatile("" ::: "memory");
                const bf16x8 bq = *(const bf16x8*)(qp + ks * 16);
#pragma unroll
                for (int eb = 0; eb < 4; ++eb) { const bf16x8 ak = *(const LAS bf16x8*)(kp + eb * 32 * 272 + ks * 32); acc[eb] = __builtin_amdgcn_mfma_f32_32x32x16_bf16(ak, bq, acc[eb], 0, 0, 0); }
            }
            float cur[16];
#pragma unroll
            for (int eb = 0; eb < 4; ++eb) {
                float v[16];
#pragma unroll
                for (int i = 0; i < 16; ++i) { const unsigned e = 32 * eb + crow(i, hi); v[i] = __builtin_bit_cast(float, (__builtin_bit_cast(unsigned, acc[eb][i]) & ~0x7Fu) | e); }
                sort16_desc(v);
                if (eb == 0) {
#pragma unroll
                    for (int i = 0; i < 16; ++i) cur[i] = v[i];
                } else merge16_desc(cur, v);
            }
            float oth[16];
#pragma unroll
            for (int i = 0; i < 16; ++i) oth[i] = __shfl_xor(cur[i], 32);
            merge16_desc(cur, oth);
#pragma unroll
            for (int i = 0; i < 16; ++i) top[p][i] = cur[i];
            __builtin_amdgcn_sched_barrier(0);
        }
        float best[16];
#pragma unroll
        for (int gI = 0; gI < 4; ++gI) {
            float v[16];
#pragma unroll
            for (int q = 0; q < 16; ++q) {
                constexpr CandTab CT = make_cand_tab();
                const int ci = CT.i[16 * gI + q], cj = CT.j[16 * gI + q];
                if (ci >= 0) {
                    const unsigned ua = __builtin_bit_cast(unsigned, top[0][ci]), ub = __builtin_bit_cast(unsigned, top[1][cj]);
                    const float s = top[0][ci] + top[1][cj];
                    const unsigned code = ((ua & 0x7Fu) << 7) | (ub & 0x7Fu);
                    v[q] = __builtin_bit_cast(float, (__builtin_bit_cast(unsigned, s) & ~0x3FFFu) | code);
                } else v[q] = -3.0e38f;
            }
            sort16_desc(v);
            if (gI == 0) {
#pragma unroll
                for (int i = 0; i < 16; ++i) best[i] = v[i];
            } else merge16_desc(best, v);
            __builtin_amdgcn_sched_barrier(0);
        }
        float e[16], sum = 0.f;
#pragma unroll
        for (int i = 0; i < 16; ++i) { e[i] = __builtin_amdgcn_exp2f((best[i] - best[0]) * LOG2E); sum += e[i]; }
        const float inv = 1.0f / sum;
        if (hi == 0) {
            u32x4 w0, w1;
            w0.x = (__builtin_bit_cast(unsigned, best[0]) & 0x3FFFu) | ((__builtin_bit_cast(unsigned, best[1]) & 0x3FFFu) << 16);
            w0.y = (__builtin_bit_cast(unsigned, best[2]) & 0x3FFFu) | ((__builtin_bit_cast(unsigned, best[3]) & 0x3FFFu) << 16);
            w0.z = (__builtin_bit_cast(unsigned, best[4]) & 0x3FFFu) | ((__builtin_bit_cast(unsigned, best[5]) & 0x3FFFu) << 16);
            w0.w = (__builtin_bit_cast(unsigned, best[6]) & 0x3FFFu) | ((__builtin_bit_cast(unsigned, best[7]) & 0x3FFFu) << 16);
            w1.x = (__builtin_bit_cast(unsigned, best[8]) & 0x3FFFu) | ((__builtin_bit_cast(unsigned, best[9]) & 0x3FFFu) << 16);
            w1.y = (__builtin_bit_cast(unsigned, best[10]) & 0x3FFFu) | ((__builtin_bit_cast(unsigned, best[11]) & 0x3FFFu) << 16);
            w1.z = (__builtin_bit_cast(unsigned, best[12]) & 0x3FFFu) | ((__builtin_bit_cast(unsigned, best[13]) & 0x3FFFu) << 16);
            w1.w = (__builtin_bit_cast(unsigned, best[14]) & 0x3FFFu) | ((__builtin_bit_cast(unsigned, best[15]) & 0x3FFFu) << 16);
            u32x4* ip = (u32x4*)(IDX + tok * 128 + h * 16);
            ip[0] = w0; ip[1] = w1;
        } else {
            f32x4* gp = (f32x4*)(GATE + tok * 128 + h * 16);
#pragma unroll
            for (int q = 0; q < 4; ++q) gp[q] = (f32x4){e[4 * q] * inv, e[4 * q + 1] * inv, e[4 * q + 2] * inv, e[4 * q + 3] * inv};
        }
    }
    __syncthreads();
}

#ifndef DBG_BRUTE_TOPK
#define DBG_BRUTE_TOPK 1
#endif
__device__ __forceinline__ void peer_topk_brute(const Ctx& F0, const Args& a, int layer) {
    const Ctx F = fresh(F0);
    const bf16_t* QP = (const bf16_t*)(a.ws + WS_QK);
    const bf16_t* SK = (const bf16_t*)(a.ws + WS_SK) + (size_t)layer * 2 * 128 * 128;
    unsigned short* IDX = (unsigned short*)(a.ws + WS_IDX);
    float* GATE = (float*)(a.ws + WS_GATE);
    const long gt = (long)F.vcu * 512 + F.tid, NGT = (long)F.G * 512;
    for (long task = gt; task < (long)ML * 8; task += NGT) {
        const long t = task >> 3; const int h = (int)(task & 7);
        float ts[2][16]; int ti[2][16];
#pragma unroll
        for (int p = 0; p < 2; ++p) {
#pragma unroll
            for (int k = 0; k < 16; ++k) { ts[p][k] = -3.0e38f; ti[p][k] = 0; }
            const unsigned* qp = (const unsigned*)(QP + t * 2048 + h * 256 + p * 128);
            for (int e = 0; e < 128; ++e) {
                const unsigned* kp = (const unsigned*)(SK + (size_t)(p * 128 + e) * 128);
                float s = 0.f;
                for (int k2 = 0; k2 < 64; ++k2) { const unsigned qa = qp[k2], ka = kp[k2]; s += bflo(qa) * bflo(ka); s += bfhi(qa) * bfhi(ka); }
                int ei = e;
#pragma unroll
                for (int k = 0; k < 16; ++k) { const bool gt_ = s > ts[p][k]; const float tv = ts[p][k]; const int tiv = ti[p][k];
                    ts[p][k] = gt_ ? s : tv; ti[p][k] = gt_ ? ei : tiv; s = gt_ ? tv : s; ei = gt_ ? tiv : ei; }
            }
        }
        float bs[16]; int bi[16];
#pragma unroll
        for (int k = 0; k < 16; ++k) { bs[k] = -3.0e38f; bi[k] = 0; }
#pragma unroll
        for (int i = 0; i < 16; ++i)
#pragma unroll
            for (int j = 0; j < 16; ++j) {
                float s = ts[0][i] + ts[1][j]; int ei = ti[0][i] * 128 + ti[1][j];
#pragma unroll
                for (int k = 0; k < 16; ++k) { const bool gt_ = s > bs[k]; const float tv = bs[k]; const int tiv = bi[k];
                    bs[k] = gt_ ? s : tv; bi[k] = gt_ ? ei : tiv; s = gt_ ? tv : s; ei = gt_ ? tiv : ei; }
            }
        float e[16], sum = 0.f;
#pragma unroll
        for (int i = 0; i < 16; ++i) { e[i] = __expf(bs[i] - bs[0]); sum += e[i]; }
        const float inv = 1.0f / sum;
#pragma unroll
        for (int i = 0; i < 16; ++i) { IDX[t * 128 + h * 16 + i] = (unsigned short)bi[i]; GATE[t * 128 + h * 16 + i] = e[i] * inv; }
    }
}

__device__ __forceinline__ void peer_gather_phase(const Ctx& F0, const Args& a, int layer) {
    const Ctx F = fresh(F0);
    const bf16_t* HX = (const bf16_t*)(a.ws + WS_HX);
    const bf16_t* UT = (const bf16_t*)(a.ws + WS_TAB) + (size_t)(2 * layer) * NEXP * DM;
    const bf16_t* VTB = (const bf16_t*)(a.ws + WS_TAB) + (size_t)(2 * layer + 1) * NEXP * DM;
    const unsigned short* IDX = (const unsigned short*)(a.ws + WS_IDX);
    const float* GATE = (const float*)(a.ws + WS_GATE);
    const float* modb = (const float*)(a.ws + WS_MOD) + (size_t)layer * 9 * NMOD;
    float* X = a.out;
    const int gwv = F.vcu * NWAVES + F.wave, NGW = F.G * NWAVES;
    const int lane = F.lane, r16 = lane & 15, g4 = lane >> 4;
    for (int t = gwv; t < ML; t += NGW) {
        int eid[8];
#pragma unroll
        for (int rb = 0; rb < 8; ++rb) eid[rb] = IDX[(size_t)t * 128 + 16 * rb + r16];
        f32x4 acc[8];
#pragma unroll
        for (int rb = 0; rb < 8; ++rb) acc[rb] = (f32x4){0.f, 0.f, 0.f, 0.f};
        const bf16_t* xp = HX + (size_t)t * DM + 8 * g4;
#pragma unroll 2
        for (int s = 0; s < 32; ++s) {
            const bf16x8 xf = *(const bf16x8*)(xp + 32 * s);
#pragma unroll
            for (int rb = 0; rb < 8; ++rb) {
                const bf16x8 uf = *(const bf16x8*)(UT + (size_t)eid[rb] * DM + 32 * s + 8 * g4);
                acc[rb] = __builtin_amdgcn_mfma_f32_16x16x32_bf16(uf, xf, acc[rb], 0, 0, 0);
            }
        }
        float wgt[8][4];
#pragma unroll
        for (int rb = 0; rb < 8; ++rb) { const f32x4 gv = *(const f32x4*)(GATE + (size_t)t * 128 + 16 * rb + 4 * g4);
#pragma unroll
            for (int j = 0; j < 4; ++j) wgt[rb][j] = gelu_erf(acc[rb][j]) * gv[j]; }
        float y[16];
#pragma unroll
        for (int i = 0; i < 16; ++i) y[i] = 0.f;
#pragma unroll
        for (int rb = 0; rb < 8; ++rb)
#pragma unroll
            for (int gg = 0; gg < 4; ++gg)
#pragma unroll
                for (int j = 0; j < 4; ++j) {
                    const int slot = 4 * gg + j;
                    const float w = __builtin_bit_cast(float, __builtin_amdgcn_readlane(__builtin_bit_cast(int, wgt[rb][j]), 16 * gg));
                    const int e = __builtin_amdgcn_readlane(eid[rb], slot);
                    const u32x4* vp = (const u32x4*)(VTB + (size_t)e * DM) + 2 * lane;
                    const u32x4 v0 = vp[0], v1 = vp[1];
                    y[0] += w * bflo(v0.x); y[1] += w * bfhi(v0.x); y[2] += w * bflo(v0.y); y[3] += w * bfhi(v0.y);
                    y[4] += w * bflo(v0.z); y[5] += w * bfhi(v0.z); y[6] += w * bflo(v0.w); y[7] += w * bfhi(v0.w);
                    y[8] += w * bflo(v1.x); y[9] += w * bfhi(v1.x); y[10] += w * bflo(v1.y); y[11] += w * bfhi(v1.y);
                    y[12] += w * bflo(v1.z); y[13] += w * bfhi(v1.z); y[14] += w * bflo(v1.w); y[15] += w * bfhi(v1.w);
                }
        const float dbg_s = (DBG_SKIP & (layer == 0 ? 2 : 8)) ? 0.f : 1.f;
        const float* gf = modb + (size_t)(t >> 12) * NMOD + 5 * DM + 16 * lane;
        float* xo = X + (size_t)t * DM + 16 * lane;
#pragma unroll
        for (int q = 0; q < 4; ++q) { const f32x4 g = *(const f32x4*)(gf + 4 * q) * dbg_s; f32x4 xv = *(f32x4*)(xo + 4 * q);
            xv.x += g.x * y[4 * q]; xv.y += g.y * y[4 * q + 1]; xv.z += g.z * y[4 * q + 2]; xv.w += g.w * y[4 * q + 3]; *(f32x4*)(xo + 4 * q) = xv; }
    }
}

__global__ void __launch_bounds__(NWAVES * 64, 2) fwd_kernel(Args args) {
    extern __shared__ __attribute__((aligned(16))) unsigned char lds_raw[];
    Ctx F;
    F.lds = (LAS unsigned char*)lds_raw;
    F.tid = threadIdx.x; F.lane = F.tid & 63; F.wave = __builtin_amdgcn_readfirstlane(F.tid >> 6);
    F.G = gridDim.x; { const int bx = blockIdx.x; F.vcu = (F.G % 8 == 0) ? (bx % 8) * (F.G / 8) + bx / 8 : bx; }
    volatile LAS unsigned* MISC = (volatile LAS unsigned*)(F.lds + MISC_OFF);
    for (int u = F.tid; u < (LDS_BYTES - LDSCTL_OFF) / 4; u += NWAVES * 64) ((LAS unsigned*)(F.lds + LDSCTL_OFF))[u] = 0u;
    __syncthreads();
    unsigned char* ws = args.ws;
    XcdBarrier bar = xcd_barrier_post((unsigned*)(ws + WS_CTL) + CW_BAR, MISC + 8);
#define GRID_BAR() xcd_barrier(bar)
#define PEER_BLOCK(layer) do { \
        norm_phase(F, args, 1, layer, 3 * DM, args.in[5] + (layer) * DM); \
        GRID_BAR(); \
        { using SHq = pg8::Shape<ML, 2048, DM, DM, DM, 1, 0, 0>; \
          pg8::gemm_phase<SHq>(F.lds, pg8::Gemm{HX, (const bf16_t*)(ws + WS_WPQ) + (size_t)(layer) * 2048 * DM}, F.G, bx, pg8::EpiStoreBf16{QKb, 2048, 0}); } \
        GRID_BAR(); \
        if (DBG_BRUTE_TOPK) peer_topk_brute(F, args, layer); else peer_topk_phase(F, args, layer); \
        GRID_BAR(); \
        peer_gather_phase(F, args, layer); \
        GRID_BAR(); \
    } while (0)
    const float* modb = (const float*)(ws + WS_MOD);
    bf16_t* HX = (bf16_t*)(ws + WS_HX);
    bf16_t* QKb = (bf16_t*)(ws + WS_QK);
    bf16_t* VTb = (bf16_t*)(ws + WS_VT);
    const bf16_t* Wqkv = (const bf16_t*)(ws + WS_WQKV);
    const int bx = (int)blockIdx.x;

    p0_prologue(F, args);
    GRID_BAR();
    norm_phase(F, args, 0, 0, 0, args.in[4]);
    GRID_BAR();
    {
        using SH1 = pg8::Shape<MT, 2048, DM, DM, DM, 1, 0, 0>;
        pg8::gemm_phase<SH1>(F.lds, pg8::Gemm{HX, Wqkv}, F.G, bx, pg8::EpiStoreBf16{QKb, 2048, 0});
        using SH2 = pg8::Shape<DM, MT, DM, DM, DM, 1, 0, 0>;
        pg8::gemm_phase<SH2>(F.lds, pg8::Gemm{Wqkv + (size_t)2048 * DM, HX}, F.G, bx, pg8::EpiStoreBf16{VTb, MT, 0});
    }
    GRID_BAR();
    attn_phase(F, args);
    GRID_BAR();
    {
        using SH = pg8::Shape<ML, DM, DM, DM, DM, 1, 0, 0>;
        pg8::gemm_phase<SH>(F.lds, pg8::Gemm{HX, (const bf16_t*)(ws + WS_WO)}, F.G, bx, pg8::EpiResid{args.in[0], args.out, modb + 2 * DM, NMOD, (DBG_SKIP & 1) ? 0.f : 1.f});
    }
    GRID_BAR();
    PEER_BLOCK(0);
    norm_phase(F, args, 1, 1, 0, args.in[4] + DM);
    GRID_BAR();
    {
        using SH = pg8::Shape<512, ML, 256, 256, DM, 4, 0, 256>;
        pg8::gemm_phase<SH>(F.lds, pg8::Gemm{(const bf16_t*)(ws + WS_WC), HX}, F.G, bx, pg8::EpiYt{QKb});
    }
    GRID_BAR();
    {
        using SH = pg8::Shape<SEQ, DM, 8192, 8192, 8192, NB, 0, (long)DM * 8192>;
        pg8::gemm_phase<SH>(F.lds, pg8::Gemm{(const bf16_t*)(ws + WS_CS), QKb}, F.G, bx, pg8::EpiStoreBf16{VTb, DM, (long)SEQ * DM});
    }
    GRID_BAR();
    {
        using SH = pg8::Shape<ML, DM, DM, DM, DM, 1, 0, 0>;
        pg8::gemm_phase<SH>(F.lds, pg8::Gemm{VTb, (const bf16_t*)(ws + WS_WF)}, F.G, bx, pg8::EpiResid{args.out, args.out, modb + (size_t)9 * NMOD + 2 * DM, NMOD, (DBG_SKIP & 4) ? 0.f : 1.f});
    }
    GRID_BAR();
    PEER_BLOCK(1);
    final_norm_phase(F, args);
#undef PEER_BLOCK
}

extern "C" void kernel_launch(void* const* d_in, const int* in_sizes, int n_in, void* d_out, int out_size, void* d_ws, size_t ws_size, hipStream_t stream) {
    static int grid = 0;
    if (grid == 0) {
        if (n_in != 17 || in_sizes[0] != ML * DM || out_size != ML * DM || ws_size < WS_END) { fprintf(stderr, "kernel_launch: unexpected shapes (n_in %d, in0 %d, out %d, ws %zu)\n", n_in, n_in > 0 ? in_sizes[0] : -1, out_size, ws_size); grid = -1; return; }
        int dev = 0, cus = 0, per_cu = 0;
        if (hipGetDevice(&dev) != hipSuccess || hipDeviceGetAttribute(&cus, hipDeviceAttributeMultiprocessorCount, dev) != hipSuccess) { grid = -1; return; }
        if (hipFuncSetAttribute((const void*)fwd_kernel, hipFuncAttributeMaxDynamicSharedMemorySize, LDS_BYTES) != hipSuccess) { fprintf(stderr, "kernel_launch: hipFuncSetAttribute failed\n"); grid = -1; return; }
        if (hipOccupancyMaxActiveBlocksPerMultiprocessor(&per_cu, (const void*)fwd_kernel, NWAVES * 64, LDS_BYTES) != hipSuccess || per_cu < 1)
            fprintf(stderr, "kernel_launch: note: occupancy query reports %d workgroups per CU\n", per_cu);
        (void)hipGetLastError();
        grid = cus;
    }
    if (grid < 0) return;
    if (hipMemsetAsync((char*)d_ws + WS_CTL, 0, CTL_ZERO_BYTES, stream) != hipSuccess) { fprintf(stderr, "kernel_launch: memset failed\n"); return; }
    Args a{};
    for (int i = 0; i < 17; ++i) a.in[i] = (const float*)d_in[i];
    a.out = (float*)d_out; a.ws = (unsigned char*)d_ws;
    hipLaunchKernelGGL(fwd_kernel, dim3(grid), dim3(NWAVES * 64), LDS_BYTES, stream, a);
    const hipError_t le = hipPeekAtLastError();
    if (le != hipSuccess) fprintf(stderr, "kernel_launch: launch failed: %s\n", hipGetErrorName(le));
}
```

```cpp
#include <hip/hip_runtime.h>
#include <cstdio>
#include <cstdint>

#define LAS __attribute__((address_space(3)))
typedef unsigned short bf16_t;
typedef short bf16x8 __attribute__((ext_vector_type(8)));
typedef short s16x4 __attribute__((ext_vector_type(4)));
typedef float f32x2 __attribute__((ext_vector_type(2)));
typedef float f32x4 __attribute__((ext_vector_type(4)));
typedef float f32x16 __attribute__((ext_vector_type(16)));
typedef unsigned u32x2 __attribute__((ext_vector_type(2)));
typedef unsigned u32x4 __attribute__((ext_vector_type(4)));
typedef __bf16 bf16x2_t __attribute__((ext_vector_type(2)));

#ifndef DBG_SKIP
#define DBG_SKIP 0
#endif
constexpr int DM = 1024, NB = 8, SEQ = 4096, CTXL = 256, GW = 64;
constexpr int ML = NB * SEQ;
constexpr int MC = NB * CTXL;
constexpr int MT = ML + MC;
constexpr int NMOD = 6 * DM;
constexpr int NEXP = 16384;
constexpr float EPS = 1e-6f;
constexpr float LOG2E = 1.4426950408889634f;

constexpr size_t MiB = 1u << 20;
constexpr size_t WS_CTL = 0, CTL_ZERO_BYTES = 1 * MiB;
constexpr size_t WS_MOD = 1 * MiB;
constexpr size_t WS_WQKV = 2 * MiB;
constexpr size_t WS_WO = 8 * MiB;
constexpr size_t WS_WF = 10 * MiB;
constexpr size_t WS_WPQ = 12 * MiB;
constexpr size_t WS_SK = 20 * MiB;
constexpr size_t WS_WC = 20 * MiB + 256 * 1024;
constexpr size_t WS_CS = 22 * MiB;
constexpr size_t WS_TAB = 86 * MiB;
constexpr size_t WS_HX = 214 * MiB;
constexpr size_t WS_QK = 282 * MiB;
constexpr size_t WS_VT = 418 * MiB;
constexpr size_t WS_IDX = WS_VT;
constexpr size_t WS_GATE = WS_VT + 8 * MiB;
constexpr size_t WS_END = 486 * MiB;
constexpr int CW_BAR = 4096;
constexpr size_t WS_DBG = 486 * MiB;
#ifndef DBG_CHECK_TOPK
#define DBG_CHECK_TOPK 0
#endif

__device__ __forceinline__ unsigned f2bf(float f) { unsigned u = __builtin_bit_cast(unsigned, f); return (u + 0x7fffu + ((u >> 16) & 1u)) >> 16; }
__device__ __forceinline__ unsigned pk2(float lo, float hi) { return f2bf(lo) | (f2bf(hi) << 16); }
__device__ __forceinline__ unsigned cvtpk(float lo, float hi) { f32x2 v = {lo, hi}; bf16x2_t b = __builtin_convertvector(v, bf16x2_t); return __builtin_bit_cast(unsigned, b); }
__device__ __forceinline__ float bflo(unsigned u) { return __builtin_bit_cast(float, u << 16); }
__device__ __forceinline__ float bfhi(unsigned u) { return __builtin_bit_cast(float, u & 0xffff0000u); }
__device__ __forceinline__ float wave_sum(float v) {
#pragma unroll
    for (int o = 1; o < 64; o <<= 1) v += __shfl_xor(v, o);
    return v;
}
__device__ __forceinline__ int crow(int r, int hi) { return (r & 3) + 8 * (r >> 2) + 4 * hi; }
__device__ __forceinline__ float gelu_erf(float v) {
    const float av = __builtin_fabsf(v), d = av * 0.2316418882f + 1.0f;
    const float t = __builtin_amdgcn_rcpf(d);
    float q = t * 0.5307027145f + (-0.7265760135f); q = q * t + 0.7107068705f; q = q * t + (-0.142248368f); q = q * t + 0.127414796f; q = q * t;
    const float e = __builtin_amdgcn_exp2f((v * v) * (-0.72134752044f));
    const float m = v * (q * e), r = v - m;
    return v < 0.f ? m : r;
}

namespace pg8 {
constexpr int BM = 256, BK = 64, HALF = 128, HTB = HALF * BK * 2, STAGE_BYTES = 8 * HTB, NXCD = 8, WGM = 8;
__host__ __device__ __forceinline__ int lds_byte(int r, int c) { const int st = (r >> 4) * 2 + (c >> 5), rr = r & 15, cc = c & 31, ob = rr * 64 + cc * 2; return st * 1024 + (ob ^ (((ob >> 9) & 1) << 5)); }
__host__ __device__ __forceinline__ void stage_rc(int b, int& R, int& C) { const int st = b / 1024, sb = b % 1024, swz = sb ^ (((sb >> 9) & 1) << 5); R = (st >> 1) * 16 + swz / 64; C = (st & 1) * 32 + (swz % 64) / 2; }
__host__ __device__ __forceinline__ int perm32(int rho) { const int n = rho >> 4, i = rho & 15; return 8 * (i >> 2) + 4 * n + (i & 3); }

struct Unit { int pm, pn, pb; };
struct Gemm { const bf16_t* A; const bf16_t* Bt; };
template <int M_, int N_, int K_, int LDA_, int LDB_, int NBATCH_, long BSA_, long BSB_> struct Shape { static constexpr int M = M_, N = N_, K = K_, lda = LDA_, ldb = LDB_, nbatch = NBATCH_; static constexpr long bsA = BSA_, bsB = BSB_; };

template <class SH> struct StaticOrder {
    static constexpr int nM = SH::M / BM, nN = SH::N / BM, per = nM * nN, nwg = per * SH::nbatch;
    int G, c;
    __device__ __forceinline__ void init(int G_, int c_) { G = G_; c = c_; }
    __device__ __forceinline__ bool next(int i, Unit& u) const {
        const long L = (long)i * G + c; if (L >= nwg) return false;
        int wgid = (int)L; { const int q = nwg / NXCD, r = nwg % NXCD, xcd = wgid % NXCD, off = wgid / NXCD; wgid = (xcd < r ? xcd * (q + 1) : r * (q + 1) + (xcd - r) * q) + off; }
        u.pb = wgid / per; wgid -= u.pb * per;
        const int nig = WGM * nN, gid = wgid / nig, fm = gid * WGM, gsz = (nM - fm) < WGM ? (nM - fm) : WGM;
        u.pm = fm + ((wgid % nig) % gsz); u.pn = (wgid % nig) / gsz; return true;
    }
};

struct EpiStoreBf16 {
    static constexpr bool PERM = true;
    bf16_t* O; long ldc; long bstride;
    __device__ __forceinline__ void operator()(const f32x4 (&acc)[2][2][4][2], const Unit& u, int wr, int wc, int fr, int fq) const {
        const int row0 = u.pm * BM + wr * 64 + fr, col0 = u.pn * BM + wc * 32 + 8 * fq;
        bf16_t* base = O + (long)u.pb * bstride;
#pragma unroll
        for (int ai = 0; ai < 2; ++ai)
#pragma unroll
            for (int m = 0; m < 4; ++m) { bf16_t* rowp = base + (long)(row0 + ai * HALF + m * 16) * ldc + col0;
#pragma unroll
                for (int bj = 0; bj < 2; ++bj) { const f32x4 v0 = acc[ai][bj][m][0], v1 = acc[ai][bj][m][1];
                    u32x4 w; w.x = cvtpk(v0[0], v0[1]); w.y = cvtpk(v0[2], v0[3]); w.z = cvtpk(v1[0], v1[1]); w.w = cvtpk(v1[2], v1[3]);
                    *(u32x4*)(rowp + bj * HALF) = w; } }
    }
};
struct EpiYt {
    static constexpr bool PERM = true;
    bf16_t* Yt;
    __device__ __forceinline__ void operator()(const f32x4 (&acc)[2][2][4][2], const Unit& u, int wr, int wc, int fr, int fq) const {
        const int row0 = u.pm * BM + wr * 64 + fr, col0 = u.pn * BM + wc * 32 + 8 * fq;
#pragma unroll
        for (int ai = 0; ai < 2; ++ai)
#pragma unroll
            for (int m = 0; m < 4; ++m) { const int row = row0 + ai * HALF + m * 16; const int part = row >> 8, cp = row & 255;
#pragma unroll
                for (int bj = 0; bj < 2; ++bj) { const int col = col0 + bj * HALF; const int b = col >> 12, n = col & 4095;
                    const f32x4 v0 = acc[ai][bj][m][0], v1 = acc[ai][bj][m][1];
                    u32x4 w; w.x = cvtpk(v0[0], v0[1]); w.y = cvtpk(v0[2], v0[3]); w.z = cvtpk(v1[0], v1[1]); w.w = cvtpk(v1[2], v1[3]);
                    *(u32x4*)(Yt + ((((long)(b * 4 + u.pb) * 256 + cp) * 2 + part) << 12) + n) = w; }
                asm volatile("" ::: "memory"); }
    }
};
struct EpiResid {
    static constexpr bool PERM = false;
    const float* Xin; float* Xout; const float* gate; int gstride; float gs;
    __device__ __forceinline__ void operator()(const f32x4 (&acc)[2][2][4][2], const Unit& u, int wr, int wc, int fr, int fq) const {
        const int row0 = u.pm * BM + wr * 64 + fr, col0 = u.pn * BM + wc * 32 + 4 * fq;
        const float* gb = gate + (long)((u.pm * BM) >> 12) * gstride;
        f32x4 gv[2][2];
#pragma unroll
        for (int bj = 0; bj < 2; ++bj)
#pragma unroll
            for (int n = 0; n < 2; ++n) gv[bj][n] = *(const f32x4*)(gb + col0 + bj * HALF + n * 16);
#pragma unroll
        for (int ai = 0; ai < 2; ++ai)
#pragma unroll
            for (int m = 0; m < 4; ++m) { const long off = (long)(row0 + ai * HALF + m * 16) * DM + col0;
#pragma unroll
                for (int bj = 0; bj < 2; ++bj)
#pragma unroll
                    for (int n = 0; n < 2; ++n) { const f32x4 bs = *(const f32x4*)(Xin + off + bj * HALF + n * 16);
                        *(f32x4*)(Xout + off + bj * HALF + n * 16) = bs + gv[bj][n] * acc[ai][bj][m][n] * gs; }
                if (m & 1) asm volatile("" ::: "memory"); }
    }
};

template <class SH, class Epi>
__device__ __forceinline__ void gemm_phase(LAS unsigned char* lds, const Gemm g, int G_, int c_, const Epi& E) {
    StaticOrder<SH> S; S.init(G_, c_);
    int tid_ = threadIdx.x; asm volatile("" : "+v"(tid_));
    const int tid = tid_, wid = __builtin_amdgcn_readfirstlane(tid >> 6), lane = tid & 63, wr = wid >> 2, wc = wid & 3, fr = lane & 15, fq = lane >> 4;
    constexpr int K = SH::K, nt = K / BK;
    unsigned voffA[2], voffB[2];
#pragma unroll
    for (int i = 0; i < 2; ++i) { int R, C; stage_rc(tid * 16 + i * 8192, R, C); const int Rb = Epi::PERM ? ((R & ~31) + perm32(R & 31)) : R;
        voffA[i] = (unsigned)(R * SH::lda + C) * 2u; voffB[i] = (unsigned)(Rb * SH::ldb + C) * 2u; }
    constexpr size_t kstep = (size_t)(BK * 2);
    constexpr size_t hstepA = (size_t)HALF * SH::lda * 2, hstepB = (size_t)HALF * SH::ldb * 2;
    constexpr size_t tstepA = 2 * hstepA, tstepB = 2 * hstepB;
    const unsigned ldsw = (unsigned)wid * 1024u;
    const int aoff = lds_byte(wr * 64 + fr, fq * 8), boff = lds_byte(wc * 32 + fr, fq * 8);
#define PG8_SA(b, h) (((b) * 2 + (h)) * HTB)
#define PG8_SB(b, h) ((4 + (b) * 2 + (h)) * HTB)
#define PG8_STAGE(bufoff, gbase, voff) do { _Pragma("unroll") for (int _i = 0; _i < 2; ++_i) \
        __builtin_amdgcn_global_load_lds((const unsigned*)((const char*)(gbase) + (voff)[_i]), (LAS unsigned*)(lds + (bufoff) + ldsw + _i * 8192), 16, 0, 0); } while (0)
#define PG8_LDA(dst, b, h) do { _Pragma("unroll") for (int m = 0; m < 4; ++m) _Pragma("unroll") for (int k = 0; k < 2; ++k) dst[m][k] = *(const LAS bf16x8*)(lds + PG8_SA(b, h) + aoff + m * 2048 + k * 1024); } while (0)
#define PG8_LDB(dst, b, h) do { _Pragma("unroll") for (int n = 0; n < 2; ++n) _Pragma("unroll") for (int k = 0; k < 2; ++k) dst[n][k] = *(const LAS bf16x8*)(lds + PG8_SB(b, h) + boff + n * 2048 + k * 1024); } while (0)
#define PG8_MMA(ai, bj, At, Bt) do { __builtin_amdgcn_s_setprio(1); _Pragma("unroll") for (int m = 0; m < 4; ++m) _Pragma("unroll") for (int n = 0; n < 2; ++n) _Pragma("unroll") for (int k = 0; k < 2; ++k) \
        acc[ai][bj][m][n] = __builtin_amdgcn_mfma_f32_16x16x32_bf16(Bt[n][k], At[m][k], acc[ai][bj][m][n], 0, 0, 0); __builtin_amdgcn_s_setprio(0); } while (0)
#define PG8_WAIT_V(n) asm volatile("s_waitcnt vmcnt(" #n ")" ::: "memory")
#define PG8_WAIT_L(n) asm volatile("s_waitcnt lgkmcnt(" #n ")" ::: "memory")
#define PG8_BAR __builtin_amdgcn_s_barrier()
#define PG8_SCHED __builtin_amdgcn_sched_barrier(0)
    Unit cur, nxt; int ui = 0;
    if (!S.next(0, cur)) return;
    f32x4 acc[2][2][4][2];
#pragma unroll
    for (int a = 0; a < 2; ++a)
#pragma unroll
        for (int b = 0; b < 2; ++b)
#pragma unroll
            for (int m = 0; m < 4; ++m)
#pragma unroll
                for (int n = 0; n < 2; ++n) acc[a][b][m][n] = (f32x4){0.f, 0.f, 0.f, 0.f};
    bf16x8 At[4][2], B0[2][2], B1[2][2];
    const char* cA = (const char*)(g.A + (long)cur.pb * SH::bsA) + (size_t)cur.pm * tstepA; const char* cB = (const char*)(g.Bt + (long)cur.pb * SH::bsB) + (size_t)cur.pn * tstepB;
    PG8_STAGE(PG8_SB(0, 0), cB, voffB); PG8_STAGE(PG8_SB(0, 1), cB + hstepB, voffB); PG8_STAGE(PG8_SA(0, 0), cA, voffA); PG8_STAGE(PG8_SA(0, 1), cA + hstepA, voffA);
    if (wr == 1) PG8_BAR;
    PG8_WAIT_V(2); PG8_BAR;
    PG8_STAGE(PG8_SB(1, 0), cB + kstep, voffB); PG8_STAGE(PG8_SA(1, 0), cA + kstep, voffA); PG8_STAGE(PG8_SB(1, 1), cB + hstepB + kstep, voffB);
    PG8_WAIT_V(6); PG8_BAR;
    for (;;) {
        const bool has_next = S.next(ui + 1, nxt);
        const char* nA = has_next ? (const char*)(g.A + (long)nxt.pb * SH::bsA) + (size_t)nxt.pm * tstepA : cA; const char* nB = has_next ? (const char*)(g.Bt + (long)nxt.pb * SH::bsB) + (size_t)nxt.pn * tstepB : cB;
#pragma nounroll
        for (int t = 0; t < nt; t += 2) {
            const bool last = (t == nt - 2);
            const char* a1 = cA + (size_t)(t + 1) * kstep;
            const char* a2 = last ? nA : cA + (size_t)(t + 2) * kstep; const char* b2 = last ? nB : cB + (size_t)(t + 2) * kstep;
            const char* a3 = a2 + kstep; const char* b3 = b2 + kstep;
            PG8_LDB(B0, 0, 0); PG8_LDB(B1, 0, 1); PG8_SCHED; PG8_LDA(At, 0, 0); PG8_STAGE(PG8_SA(1, 1), a1 + hstepA, voffA);
            PG8_WAIT_V(8); PG8_WAIT_L(0); PG8_BAR; PG8_MMA(0, 0, At, B0); PG8_MMA(0, 1, At, B1); PG8_BAR; PG8_SCHED;
            PG8_LDA(At, 0, 1); PG8_STAGE(PG8_SB(0, 0), b2, voffB); PG8_STAGE(PG8_SB(0, 1), b2 + hstepB, voffB); PG8_STAGE(PG8_SA(0, 0), a2, voffA);
            PG8_WAIT_V(8); PG8_WAIT_L(0); PG8_BAR; PG8_MMA(1, 0, At, B0); PG8_MMA(1, 1, At, B1); PG8_BAR; PG8_SCHED;
            PG8_LDB(B0, 1, 0); PG8_LDB(B1, 1, 1); PG8_SCHED; PG8_LDA(At, 1, 0); PG8_STAGE(PG8_SA(0, 1), a2 + hstepA, voffA);
            PG8_WAIT_V(8); PG8_WAIT_L(0); PG8_BAR; PG8_MMA(0, 0, At, B0); PG8_MMA(0, 1, At, B1); PG8_BAR; PG8_SCHED;
            PG8_LDA(At, 1, 1); PG8_STAGE(PG8_SB(1, 0), b3, voffB); PG8_STAGE(PG8_SB(1, 1), b3 + hstepB, voffB); PG8_STAGE(PG8_SA(1, 0), a3, voffA);
            PG8_WAIT_V(8); PG8_WAIT_L(0); PG8_BAR; PG8_MMA(1, 0, At, B0); PG8_MMA(1, 1, At, B1); PG8_BAR; PG8_SCHED;
        }
        if (wr == 0) PG8_BAR;
        E(acc, cur, wr, wc, fr, fq);
        if (!has_next) break;
#pragma unroll
        for (int a = 0; a < 2; ++a)
#pragma unroll
            for (int b = 0; b < 2; ++b)
#pragma unroll
                for (int m = 0; m < 4; ++m)
#pragma unroll
                    for (int n = 0; n < 2; ++n) acc[a][b][m][n] = (f32x4){0.f, 0.f, 0.f, 0.f};
        cur = nxt; cA = nA; cB = nB; ++ui;
        if (wr == 1) PG8_BAR;
    }
    PG8_WAIT_V(0);
    PG8_BAR;
#undef PG8_SA
#undef PG8_SB
#undef PG8_STAGE
#undef PG8_LDA
#undef PG8_LDB
#undef PG8_MMA
#undef PG8_WAIT_V
#undef PG8_WAIT_L
#undef PG8_BAR
#undef PG8_SCHED
}
}

#define XB_TMO      128
#define XB_XCNT(j)  (256  + 64 * (j))
#define XB_XSUB(j)  (1280 + 64 * (j))
#define XB_XGEN(j)  (2304 + 64 * (j))
#define XB_TOP      3328
#define XB_TOPGEN   3392
#define XCD_BAR_WORDS 3456
#define XB_SPIN_CAP (1u << 18)
__device__ __forceinline__ unsigned xb_ld(unsigned* p)              { return __hip_atomic_load(p, __ATOMIC_RELAXED, __HIP_MEMORY_SCOPE_AGENT); }
__device__ __forceinline__ unsigned xb_add(unsigned* p, unsigned v) { return __hip_atomic_fetch_add(p, v, __ATOMIC_RELAXED, __HIP_MEMORY_SCOPE_AGENT); }
__device__ __forceinline__ unsigned xb_xcc_id() { return (unsigned)__builtin_amdgcn_s_getreg((3 << 11) | 20) & 0xFu; }
#define XB_SPIN(cond, bar) do { unsigned _sp = 0; while (cond) { __builtin_amdgcn_s_sleep(1); \
    if ((++_sp & 255u) == 0u) { if (xb_ld(&(bar)[XB_TMO])) break; if (_sp > XB_SPIN_CAP) { atomicAdd(&(bar)[XB_TMO], 1u); break; } } } } while (0)
struct XcdBarrier { unsigned* bar; unsigned x; volatile LAS unsigned* st; };
__device__ __forceinline__ XcdBarrier xcd_barrier_post(unsigned* bar, volatile LAS unsigned* st) {
    XcdBarrier b; b.bar = bar; b.x = xb_xcc_id(); b.st = st;
    if (threadIdx.x == 0) (void)xb_add(&bar[XB_XCNT(b.x)], 1u);
    return b;
}
__device__ __forceinline__ void xcd_barrier_complete(unsigned* bar, unsigned x, unsigned& nloc, unsigned& nx) {
    const unsigned G = gridDim.x * gridDim.y * gridDim.z;
    unsigned sum, cnt, mine, sp = 0u;
    for (;;) {
        sum = 0u; cnt = 0u; mine = 0u;
#pragma unroll
        for (unsigned j = 0; j < 16; ++j) { const unsigned c = xb_ld(&bar[XB_XCNT(j)]); sum += c; cnt += (c > 0u) ? 1u : 0u; mine = (j == x) ? c : mine; }
        if (sum == G) break;
        __builtin_amdgcn_s_sleep(1);
        if ((++sp & 255u) == 0u) { if (xb_ld(&bar[XB_TMO])) break; if (sp > XB_SPIN_CAP) { atomicAdd(&bar[XB_TMO], 1u); break; } }
    }
    nloc = mine > 0u ? mine : 1u; nx = cnt > 0u ? cnt : 1u;
}
__device__ __forceinline__ void xcd_barrier(const XcdBarrier& b) {
    asm volatile("s_waitcnt vmcnt(0)" ::: "memory");
    __syncthreads();
    if (threadIdx.x == 0) {
        unsigned* bar = b.bar;
        __builtin_amdgcn_s_waitcnt(0);
        unsigned nloc = b.st[0], nx = b.st[1];
        if (nloc == 0u) { xcd_barrier_complete(bar, b.x, nloc, nx); b.st[0] = nloc; b.st[1] = nx; }
        const unsigned old = xb_add(&bar[XB_XSUB(b.x)], 1u);
        const unsigned gen = old / nloc;
        if (old + 1u == (gen + 1u) * nloc) {
            __builtin_amdgcn_fence(__ATOMIC_RELEASE, "agent");
            asm volatile("s_waitcnt vmcnt(0)" ::: "memory");
            const unsigned og = xb_add(&bar[XB_TOP], 1u);
            const unsigned tg = og / nx;
            if (og + 1u == (tg + 1u) * nx) xb_add(&bar[XB_TOPGEN], 1u);
            else XB_SPIN(xb_ld(&bar[XB_TOPGEN]) == tg, bar);
            __builtin_amdgcn_fence(__ATOMIC_ACQUIRE, "agent");
            xb_add(&bar[XB_XGEN(b.x)], 1u);
            asm volatile("s_waitcnt vmcnt(0)" ::: "memory");
        } else {
            XB_SPIN(xb_ld(&bar[XB_XGEN(b.x)]) == gen, bar);
            __builtin_amdgcn_fence(__ATOMIC_ACQUIRE, "agent");
            asm volatile("s_waitcnt vmcnt(0)" ::: "memory");
        }
    }
    __syncthreads();
}

constexpr int RING_BYTES = 131072;
constexpr int LDSCTL_OFF = RING_BYTES, MISC_OFF = LDSCTL_OFF + 320;
constexpr int LDS_BYTES = 147456;
constexpr int NWAVES = 8;

struct Args { const float* in[17]; float* out; unsigned char* ws; };

struct Ctx {
    LAS unsigned char* lds;
    int tid, lane, wave, vcu, G;
};

__device__ __forceinline__ Ctx fresh(const Ctx& F) {
    Ctx C = F; int t = threadIdx.x; asm volatile("" : "+v"(t)); C.tid = t; C.lane = t & 63; return C;
}
__device__ __forceinline__ void p0_transpose_item(const float* W, int K, int N, bf16_t* WT, LAS float* scr, int item, int lane) {
    const int nblk = N / 32, kb = item / nblk, nb = item % nblk, k0 = 64 * kb, n0 = 32 * nb;
#pragma unroll 8
    for (int i = 0; i < 32; ++i) { const int kk = 2 * i + (lane >> 5); scr[kk * 33 + (lane & 31)] = W[(size_t)(k0 + kk) * N + n0 + (lane & 31)]; }
    asm volatile("s_waitcnt lgkmcnt(0)" ::: "memory");
    const int c = lane & 7;
#pragma unroll
    for (int j = 0; j < 4; ++j) { const int n = (lane >> 3) + 8 * j; const LAS float* s = scr + (8 * c) * 33 + n;
        u32x4 o; o.x = pk2(s[0 * 33], s[1 * 33]); o.y = pk2(s[2 * 33], s[3 * 33]); o.z = pk2(s[4 * 33], s[5 * 33]); o.w = pk2(s[6 * 33], s[7 * 33]);
        *(u32x4*)(WT + (size_t)(n0 + n) * K + k0 + 8 * c) = o; }
    asm volatile("s_waitcnt lgkmcnt(0)" ::: "memory");
}
__device__ __forceinline__ void cvt8(const float* src, bf16_t* dst) {
    const f32x4 a = *(const f32x4*)src, b = *(const f32x4*)(src + 4);
    u32x4 o; o.x = pk2(a[0], a[1]); o.y = pk2(a[2], a[3]); o.z = pk2(b[0], b[1]); o.w = pk2(b[2], b[3]);
    *(u32x4*)dst = o;
}

__device__ __forceinline__ void p0_prologue(const Ctx& F0, const Args& a) {
    const Ctx F = fresh(F0);
    unsigned char* ws = a.ws;
    const int gw = F.vcu * NWAVES + F.wave, NGW = F.G * NWAVES;
    const long gt = (long)F.vcu * 512 + F.tid, NGT = (long)F.G * 512;
    {
        LAS float* red = (LAS float*)(F.lds);
        const float* c = a.in[1]; const float* cctx = a.in[3]; const float* wmod = a.in[6]; const float* bmod = a.in[7];
        float* modb = (float*)(ws + WS_MOD);
        for (int item = F.vcu; item < 96; item += F.G) {
            const int l = item / 48, nc = item % 48, n0 = nc * 128 + 2 * F.lane, kb = F.wave * 128;
            float sv[9][2];
#pragma unroll
            for (int r = 0; r < 9; ++r)
#pragma unroll
                for (int j = 0; j < 2; ++j) { const int k = kb + 64 * j + F.lane; const float v = (r < 8) ? c[r * DM + k] : cctx[k]; sv[r][j] = v / (1.0f + __expf(-v)); }
            float acc[9][2];
#pragma unroll
            for (int r = 0; r < 9; ++r) { acc[r][0] = 0.f; acc[r][1] = 0.f; }
            const float* wp = wmod + (size_t)l * DM * NMOD + (size_t)kb * NMOD + n0;
#pragma unroll
            for (int j = 0; j < 2; ++j)
#pragma unroll 8
                for (int kl = 0; kl < 64; ++kl) {
                    const f32x2 w = *(const f32x2*)(wp + (size_t)(64 * j + kl) * NMOD);
#pragma unroll
                    for (int r = 0; r < 9; ++r) { const float s = __builtin_bit_cast(float, __builtin_amdgcn_readlane(__builtin_bit_cast(int, sv[r][j]), kl)); acc[r][0] += s * w[0]; acc[r][1] += s * w[1]; }
                }
            __syncthreads();
#pragma unroll
            for (int r = 0; r < 9; ++r) { red[(F.wave * 9 + r) * 128 + 2 * F.lane] = acc[r][0]; red[(F.wave * 9 + r) * 128 + 2 * F.lane + 1] = acc[r][1]; }
            __syncthreads();
            for (int o = F.tid; o < 9 * 128; o += 512) { const int r = o >> 7, nl = o & 127; float s = 0.f;
#pragma unroll
                for (int w = 0; w < 8; ++w) s += red[(w * 9 + r) * 128 + nl];
                modb[(size_t)(l * 9 + r) * NMOD + nc * 128 + nl] = s + bmod[l * NMOD + nc * 128 + nl]; }
        }
        __syncthreads();
    }
    {
        LAS float* scr = (LAS float*)(F.lds + F.wave * 16384);
        constexpr int I_QKV = (DM / 64) * (3 * DM / 32), I_O = (DM / 64) * (DM / 32), I_PQ = (DM / 64) * (2 * DM / 32);
        constexpr int NITEMS = I_QKV + 2 * I_O + 2 * I_PQ;
        for (int it = gw; it < NITEMS; it += NGW) {
            int r = it;
            if (r < I_QKV) { p0_transpose_item(a.in[8], DM, 3 * DM, (bf16_t*)(ws + WS_WQKV), scr, r, F.lane); continue; } r -= I_QKV;
            if (r < I_O) { p0_transpose_item(a.in[9], DM, DM, (bf16_t*)(ws + WS_WO), scr, r, F.lane); continue; } r -= I_O;
            if (r < I_O) { p0_transpose_item(a.in[11], DM, DM, (bf16_t*)(ws + WS_WF), scr, r, F.lane); continue; } r -= I_O;
            if (r < I_PQ) { p0_transpose_item(a.in[12], DM, 2 * DM, (bf16_t*)(ws + WS_WPQ), scr, r, F.lane); continue; } r -= I_PQ;
            p0_transpose_item(a.in[12] + (size_t)DM * 2 * DM, DM, 2 * DM, (bf16_t*)(ws + WS_WPQ) + (size_t)2 * DM * DM, scr, r, F.lane);
        }
    }
    for (long i = gt; i < 2 * 2 * 128 * 128 / 8; i += NGT) cvt8(a.in[13] + i * 8, (bf16_t*)(ws + WS_SK) + i * 8);
    {
        constexpr long PER = (long)NEXP * DM / 8;
        for (long i = gt; i < 4 * PER; i += NGT) {
            const int q = (int)(i / PER); const long r = i - (long)q * PER; const int l = q >> 1, tb = q & 1;
            const float* src = (tb ? a.in[15] : a.in[14]) + (size_t)l * NEXP * DM + r * 8;
            cvt8(src, (bf16_t*)(ws + WS_TAB) + (size_t)q * NEXP * DM + r * 8);
        }
    }
    {
        bf16_t* wc = (bf16_t*)(ws + WS_WC);
        for (long i = gt; i < 512 * 256 / 8; i += NGT) { const int nn = (int)(i >> 5), k0 = (int)(i & 31) * 8; float v[8];
#pragma unroll
            for (int j = 0; j < 8; ++j) { const int m = ((k0 + j) * (nn & 255)) & 255; const float fr = (float)m * (1.0f / 256.0f);
                v[j] = (nn < 256 ? __builtin_amdgcn_cosf(fr) : __builtin_amdgcn_sinf(fr)) * (1.0f / 16.0f); }
            u32x4 o; o.x = pk2(v[0], v[1]); o.y = pk2(v[2], v[3]); o.z = pk2(v[4], v[5]); o.w = pk2(v[6], v[7]);
            *(u32x4*)(wc + i * 8) = o; }
        bf16_t* cs = (bf16_t*)(ws + WS_CS);
        for (long i = gt; i < 4096L * 8192 / 8; i += NGT) { const int np = (int)(i >> 10), c0 = (int)(i & 1023) * 8; const int part = c0 >> 12; float v[8];
#pragma unroll
            for (int j = 0; j < 8; ++j) { const int n = (c0 + j) & 4095; const int m = (n * np) & 4095; const float fr = (float)m * (1.0f / 4096.0f);
                v[j] = (part == 0 ? __builtin_amdgcn_cosf(fr) : -__builtin_amdgcn_sinf(fr)) * (1.0f / 64.0f); }
            u32x4 o; o.x = pk2(v[0], v[1]); o.y = pk2(v[2], v[3]); o.z = pk2(v[4], v[5]); o.w = pk2(v[6], v[7]);
            *(u32x4*)(cs + i * 8) = o; }
    }
}

__device__ __forceinline__ void norm_mod_row(const float* xrow, const float* gw, const float* sh, const float* sc, bf16_t* orow, int lane) {
    const f32x4* xr = (const f32x4*)xrow + lane;
    f32x4 v[4]; float s = 0.f;
#pragma unroll
    for (int j = 0; j < 4; ++j) { v[j] = xr[64 * j]; s += (v[j].x * v[j].x + v[j].y * v[j].y) + (v[j].z * v[j].z + v[j].w * v[j].w); }
    const float rstd = 1.0f / sqrtf(wave_sum(s) * (1.0f / DM) + EPS);
    unsigned long long* o8 = (unsigned long long*)orow + lane;
#pragma unroll
    for (int j = 0; j < 4; ++j) {
        const f32x4 g = ((const f32x4*)gw)[lane + 64 * j], a = ((const f32x4*)sh)[lane + 64 * j], c = ((const f32x4*)sc)[lane + 64 * j];
        const f32x4 y = (v[j] * rstd * g) * (c + 1.0f) + a;
        o8[64 * j] = (unsigned long long)cvtpk(y.x, y.y) | ((unsigned long long)cvtpk(y.z, y.w) << 32);
    }
}
__device__ __forceinline__ void norm_phase(const Ctx& F0, const Args& a, int mode, int layer, int off, const float* gw) {
    const Ctx F = fresh(F0);
    const int gwv = F.vcu * NWAVES + F.wave, NGW = F.G * NWAVES;
    const float* modb = (const float*)(a.ws + WS_MOD) + (size_t)layer * 9 * NMOD;
    bf16_t* hx = (bf16_t*)(a.ws + WS_HX);
    const int nrows = (mode == 0) ? MT : ML;
    for (int m = gwv; m < nrows; m += NGW) {
        const float* src; const float* mr;
        if (m < ML) { src = (mode == 0 ? a.in[0] : a.out) + (size_t)m * DM; mr = modb + (size_t)(m >> 12) * NMOD; }
        else { src = a.in[2] + (size_t)(m - ML) * DM; mr = modb + (size_t)8 * NMOD; }
        norm_mod_row(src, gw, mr + off, mr + off + DM, hx + (size_t)m * DM, F.lane);
    }
}
__device__ __forceinline__ void final_norm_phase(const Ctx& F0, const Args& a) {
    const Ctx F = fresh(F0);
    const int gwv = F.vcu * NWAVES + F.wave, NGW = F.G * NWAVES;
    const float* gw = a.in[16];
    for (int m = gwv; m < ML; m += NGW) {
        f32x4* xr = (f32x4*)(a.out + (size_t)m * DM) + F.lane;
        f32x4 v[4]; float s = 0.f;
#pragma unroll
        for (int j = 0; j < 4; ++j) { v[j] = xr[64 * j]; s += (v[j].x * v[j].x + v[j].y * v[j].y) + (v[j].z * v[j].z + v[j].w * v[j].w); }
        const float rstd = 1.0f / sqrtf(wave_sum(s) * (1.0f / DM) + EPS);
#pragma unroll
        for (int j = 0; j < 4; ++j) xr[64 * j] = v[j] * rstd * ((const f32x4*)gw)[F.lane + 64 * j];
    }
}

__device__ __forceinline__ void attn_phase(const Ctx& F0, const Args& a) {
    const Ctx F = fresh(F0);
    const bf16_t* QK = (const bf16_t*)(a.ws + WS_QK);
    const bf16_t* VT = (const bf16_t*)(a.ws + WS_VT);
    bf16_t* AO = (bf16_t*)(a.ws + WS_HX);
    const float* rpb = a.in[10];
    LAS float* rl = (LAS float*)F.lds;
    const int lane = F.lane, hl = F.wave >> 1, qt = F.wave & 1, q32 = lane & 31, hi = lane >> 5;
    const float SC = 0.125f * LOG2E, NEG = -1e30f;
    for (int task = F.vcu; task < 2048; task += F.G) {
        const int hq = task & 3, r = (task >> 2) & 63, b = task >> 8;
        __syncthreads();
        for (int i = F.tid; i < 4 * 465; i += 512) rl[i] = rpb[hq * 4 * 465 + i] * LOG2E;
        __syncthreads();
        const int h = 4 * hq + hl;
        const int r_start = min(max(r - 4, 0), 56);
        const int qc = 32 * qt + q32;
        const int cs = min(max(qc - 8, 0), 48);
        const long mq = (long)b * SEQ + r * GW + qc;
        bf16x8 qr[4];
#pragma unroll
        for (int d0 = 0; d0 < 4; ++d0) qr[d0] = *(const bf16x8*)(QK + mq * 2048 + h * 64 + d0 * 16 + hi * 8);
        float m_run = NEG, l_run = 0.f;
        f32x16 o[2];
#pragma unroll
        for (int i = 0; i < 16; ++i) { o[0][i] = 0.f; o[1][i] = 0.f; }
        for (int it = 0; it < 12; ++it) {
            const bool latent = it < 8;
            const int kr = r_start + it;
            const long tok0 = latent ? ((long)b * SEQ + (long)kr * GW) : ((long)ML + b * CTXL + (it - 8) * 64);
            f32x16 p[2];
#pragma unroll
            for (int blk = 0; blk < 2; ++blk) {
                const bf16_t* kp = QK + (tok0 + 32 * blk + q32) * 2048 + 1024 + h * 64 + hi * 8;
                f32x16 acc;
#pragma unroll
                for (int i = 0; i < 16; ++i) acc[i] = 0.f;
                asm volatile("" : "+v"(acc));
#pragma unroll
                for (int d0 = 0; d0 < 4; ++d0) { const bf16x8 kf = *(const bf16x8*)(kp + d0 * 16); acc = __builtin_amdgcn_mfma_f32_32x32x16_bf16(kf, qr[d0], acc, 0, 0, 0); }
                p[blk] = acc;
            }
            float mx = NEG;
            if (latent) {
                const LAS float* rb = rl + hl * 465 + (kr - r + 7) * 31;
#pragma unroll
                for (int blk = 0; blk < 2; ++blk)
#pragma unroll
                    for (int i = 0; i < 16; ++i) { const int kc = 32 * blk + crow(i, hi); const bool valid = (kc >= cs) && (kc < cs + 16);
                        const int bi = valid ? (kc - qc + 15) : 0; const float bv = rb[bi];
                        const float v = valid ? (p[blk][i] * SC + bv) : NEG; p[blk][i] = v; mx = fmaxf(mx, v); }
            } else {
#pragma unroll
                for (int blk = 0; blk < 2; ++blk)
#pragma unroll
                    for (int i = 0; i < 16; ++i) { const float v = p[blk][i] * SC; p[blk][i] = v; mx = fmaxf(mx, v); }
            }
            mx = fmaxf(mx, __shfl_xor(mx, 32));
            const float m_new = fmaxf(m_run, mx);
            const float alpha = __builtin_amdgcn_exp2f(m_run - m_new);
            m_run = m_new;
            float rs = 0.f;
#pragma unroll
            for (int blk = 0; blk < 2; ++blk)
#pragma unroll
                for (int i = 0; i < 16; ++i) { const float e = __builtin_amdgcn_exp2f(p[blk][i] - m_new); p[blk][i] = e; rs += e; }
            l_run = l_run * alpha + rs;
#pragma unroll
            for (int i = 0; i < 16; ++i) { o[0][i] *= alpha; o[1][i] *= alpha; }
#pragma unroll
            for (int blk = 0; blk < 2; ++blk)
#pragma unroll
                for (int s = 0; s < 2; ++s) {
                    u32x4 pw; pw.x = cvtpk(p[blk][8 * s + 0], p[blk][8 * s + 1]); pw.y = cvtpk(p[blk][8 * s + 2], p[blk][8 * s + 3]);
                    pw.z = cvtpk(p[blk][8 * s + 4], p[blk][8 * s + 5]); pw.w = cvtpk(p[blk][8 * s + 6], p[blk][8 * s + 7]);
                    const bf16x8 pf = __builtin_bit_cast(bf16x8, pw);
#pragma unroll
                    for (int dh = 0; dh < 2; ++dh) {
                        const bf16_t* vp = VT + (long)(h * 64 + 32 * dh + q32) * MT + tok0 + 32 * blk + 16 * s + 4 * hi;
                        const u32x2 v0 = *(const u32x2*)vp, v1 = *(const u32x2*)(vp + 8);
                        u32x4 vw; vw.x = v0.x; vw.y = v0.y; vw.z = v1.x; vw.w = v1.y;
                        o[dh] = __builtin_amdgcn_mfma_f32_32x32x16_bf16(__builtin_bit_cast(bf16x8, vw), pf, o[dh], 0, 0, 0);
                    }
                }
        }
        l_run += __shfl_xor(l_run, 32);
        const float linv = 1.0f / l_run;
        bf16_t* op = AO + mq * DM + h * 64;
#pragma unroll
        for (int dh = 0; dh < 2; ++dh)
#pragma unroll
            for (int g4 = 0; g4 < 4; ++g4) {
                u32x2 w; w.x = cvtpk(o[dh][4 * g4 + 0] * linv, o[dh][4 * g4 + 1] * linv); w.y = cvtpk(o[dh][4 * g4 + 2] * linv, o[dh][4 * g4 + 3] * linv);
                *(u32x2*)(op + 32 * dh + 8 * g4 + 4 * hi) = w;
            }
    }
    __syncthreads();
}

__device__ __forceinline__ void ce_desc(float& a, float& b) { const float hi = fmaxf(a, b), lo = fminf(a, b); a = hi; b = lo; }
__device__ __forceinline__ void ce_dir(float& a, float& b, bool desc) { const float hi = fmaxf(a, b), lo = fminf(a, b); a = desc ? hi : lo; b = desc ? lo : hi; }
__device__ __forceinline__ void sort16_desc(float (&v)[16]) {
#pragma unroll
    for (int k = 2; k <= 16; k <<= 1)
#pragma unroll
        for (int j = k >> 1; j > 0; j >>= 1)
#pragma unroll
            for (int i = 0; i < 16; ++i) { const int l = i ^ j; if (l > i) ce_dir(v[i], v[l], (i & k) == 0); }
}
__device__ __forceinline__ void merge16_desc(float (&a)[16], const float (&b)[16]) {
#pragma unroll
    for (int i = 0; i < 16; ++i) a[i] = fmaxf(a[i], b[15 - i]);
#pragma unroll
    for (int j = 8; j > 0; j >>= 1)
#pragma unroll
        for (int i = 0; i < 16; ++i) { const int l = i ^ j; if (l > i) ce_desc(a[i], a[l]); }
}

struct CandTab { int i[64]; int j[64]; };
__host__ __device__ constexpr CandTab make_cand_tab() {
    CandTab t{}; int n = 0;
    for (int i = 0; i < 16; ++i) for (int j = 0; j < 16; ++j) if ((i + 1) * (j + 1) <= 16) { t.i[n] = i; t.j[n] = j; ++n; }
    for (; n < 64; ++n) { t.i[n] = -1; t.j[n] = -1; }
    return t;
}

__device__ __forceinline__ void peer_topk_phase(const Ctx& F0, const Args& a, int layer) {
    const Ctx F = fresh(F0);
    const bf16_t* QP = (const bf16_t*)(a.ws + WS_QK);
    const bf16_t* SK = (const bf16_t*)(a.ws + WS_SK) + (size_t)layer * 2 * 128 * 128;
    unsigned short* IDX = (unsigned short*)(a.ws + (DBG_CHECK_TOPK ? WS_DBG : WS_IDX));
    float* GATE = (float*)(a.ws + (DBG_CHECK_TOPK ? WS_DBG + 8 * MiB : WS_GATE));
    const int gwv = F.vcu * NWAVES + F.wave, NGW = F.G * NWAVES;
    const int lane = F.lane, t32 = lane & 31, hi = lane >> 5;
    __syncthreads();
    for (int c = F.tid; c < 4096; c += 512) *(LAS u32x4*)(F.lds + (c >> 4) * 272 + (c & 15) * 16) = *(const u32x4*)(SK + (size_t)c * 8);
    __syncthreads();
    for (int task = gwv; task < 1024 * 8; task += NGW) {
        const int tt = task >> 3, h = task & 7;
        const long tok = (long)tt * 32 + t32;
        float top[2][16];
#pragma unroll
        for (int p = 0; p < 2; ++p) {
            f32x16 acc[4];
#pragma unroll
            for (int eb = 0; eb < 4; ++eb)
#pragma unroll
                for (int i = 0; i < 16; ++i) acc[eb][i] = 0.f;
#pragma unroll
            for (int eb = 0; eb < 4; ++eb) asm volatile("" : "+v"(acc[eb]));
            const bf16_t* qp = QP + tok * 2048 + h * 256 + p * 128 + hi * 8;
            const LAS unsigned char* kp = F.lds + (p * 128 + t32) * 272 + hi * 16;
#pragma unroll
            for (int ks = 0; ks < 8; ++ks) {
                if ((ks & 1) == 0) asm volatile("" ::: "memory");
                const bf16x8 bq = *(const bf16x8*)(qp + ks * 16);
#pragma unroll
                for (int eb = 0; eb < 4; ++eb) { const bf16x8 ak = *(const LAS bf16x8*)(kp + eb * 32 * 272 + ks * 32); acc[eb] = __builtin_amdgcn_mfma_f32_32x32x16_bf16(ak, bq, acc[eb], 0, 0, 0); }
            }
            float cur[16];
#pragma unroll
            for (int eb = 0; eb < 4; ++eb) {
                float v[16];
#pragma unroll
                for (int i = 0; i < 16; ++i) { const unsigned e = 32 * eb + crow(i, hi); float x = acc[eb][i]; asm volatile("" : "+v"(x));
                    v[i] = __builtin_bit_cast(float, (__builtin_bit_cast(unsigned, x) & ~0x7Fu) | e); }
                sort16_desc(v);
                if (eb == 0) {
#pragma unroll
                    for (int i = 0; i < 16; ++i) cur[i] = v[i];
                } else merge16_desc(cur, v);
            }
            float oth[16];
#pragma unroll
            for (int i = 0; i < 16; ++i) oth[i] = __shfl_xor(cur[i], 32);
            merge16_desc(cur, oth);
#pragma unroll
            for (int i = 0; i < 16; ++i) top[p][i] = cur[i];
            __builtin_amdgcn_sched_barrier(0);
        }
        float best[16];
#pragma unroll
        for (int gI = 0; gI < 4; ++gI) {
            float v[16];
#pragma unroll
            for (int q = 0; q < 16; ++q) {
                constexpr CandTab CT = make_cand_tab();
                const int ci = CT.i[16 * gI + q], cj = CT.j[16 * gI + q];
                if (ci >= 0) {
                    const unsigned ua = __builtin_bit_cast(unsigned, top[0][ci]), ub = __builtin_bit_cast(unsigned, top[1][cj]);
                    float s = top[0][ci] + top[1][cj]; asm volatile("" : "+v"(s));
                    const unsigned code = ((ua & 0x7Fu) << 7) | (ub & 0x7Fu);
                    v[q] = __builtin_bit_cast(float, (__builtin_bit_cast(unsigned, s) & ~0x3FFFu) | code);
                } else v[q] = -3.0e38f;
            }
            sort16_desc(v);
            if (gI == 0) {
#pragma unroll
                for (int i = 0; i < 16; ++i) best[i] = v[i];
            } else merge16_desc(best, v);
            __builtin_amdgcn_sched_barrier(0);
        }
        float e[16], sum = 0.f;
#pragma unroll
        for (int i = 0; i < 16; ++i) { e[i] = __builtin_amdgcn_exp2f((best[i] - best[0]) * LOG2E); sum += e[i]; }
        const float inv = 1.0f / sum;
        if (hi == 0) {
            u32x4 w0, w1;
            w0.x = (__builtin_bit_cast(unsigned, best[0]) & 0x3FFFu) | ((__builtin_bit_cast(unsigned, best[1]) & 0x3FFFu) << 16);
            w0.y = (__builtin_bit_cast(unsigned, best[2]) & 0x3FFFu) | ((__builtin_bit_cast(unsigned, best[3]) & 0x3FFFu) << 16);
            w0.z = (__builtin_bit_cast(unsigned, best[4]) & 0x3FFFu) | ((__builtin_bit_cast(unsigned, best[5]) & 0x3FFFu) << 16);
            w0.w = (__builtin_bit_cast(unsigned, best[6]) & 0x3FFFu) | ((__builtin_bit_cast(unsigned, best[7]) & 0x3FFFu) << 16);
            w1.x = (__builtin_bit_cast(unsigned, best[8]) & 0x3FFFu) | ((__builtin_bit_cast(unsigned, best[9]) & 0x3FFFu) << 16);
            w1.y = (__builtin_bit_cast(unsigned, best[10]) & 0x3FFFu) | ((__builtin_bit_cast(unsigned, best[11]) & 0x3FFFu) << 16);
            w1.z = (__builtin_bit_cast(unsigned, best[12]) & 0x3FFFu) | ((__builtin_bit_cast(unsigned, best[13]) & 0x3FFFu) << 16);
            w1.w = (__builtin_bit_cast(unsigned, best[14]) & 0x3FFFu) | ((__builtin_bit_cast(unsigned, best[15]) & 0x3FFFu) << 16);
            u32x4* ip = (u32x4*)(IDX + tok * 128 + h * 16);
            ip[0] = w0; ip[1] = w1;
        } else {
            f32x4* gp = (f32x4*)(GATE + tok * 128 + h * 16);
#pragma unroll
            for (int q = 0; q < 4; ++q) gp[q] = (f32x4){e[4 * q] * inv, e[4 * q + 1] * inv, e[4 * q + 2] * inv, e[4 * q + 3] * inv};
        }
    }
    __syncthreads();
}

#ifndef DBG_BRUTE_TOPK
#define DBG_BRUTE_TOPK 0
#endif
__device__ __forceinline__ void peer_topk_brute(const Ctx& F0, const Args& a, int layer) {
    const Ctx F = fresh(F0);
    const bf16_t* QP = (const bf16_t*)(a.ws + WS_QK);
    const bf16_t* SK = (const bf16_t*)(a.ws + WS_SK) + (size_t)layer * 2 * 128 * 128;
    unsigned short* IDX = (unsigned short*)(a.ws + WS_IDX);
    float* GATE = (float*)(a.ws + WS_GATE);
    const long gt = (long)F.vcu * 512 + F.tid, NGT = (long)F.G * 512;
    for (long task = gt; task < (long)ML * 8; task += NGT) {
        const long t = task >> 3; const int h = (int)(task & 7);
        float ts[2][16]; int ti[2][16];
#pragma unroll
        for (int p = 0; p < 2; ++p) {
#pragma unroll
            for (int k = 0; k < 16; ++k) { ts[p][k] = -3.0e38f; ti[p][k] = 0; }
            const unsigned* qp = (const unsigned*)(QP + t * 2048 + h * 256 + p * 128);
            for (int e = 0; e < 128; ++e) {
                const unsigned* kp = (const unsigned*)(SK + (size_t)(p * 128 + e) * 128);
                float s = 0.f;
                for (int k2 = 0; k2 < 64; ++k2) { const unsigned qa = qp[k2], ka = kp[k2]; s += bflo(qa) * bflo(ka); s += bfhi(qa) * bfhi(ka); }
                int ei = e;
#pragma unroll
                for (int k = 0; k < 16; ++k) { const bool gt_ = s > ts[p][k]; const float tv = ts[p][k]; const int tiv = ti[p][k];
                    ts[p][k] = gt_ ? s : tv; ti[p][k] = gt_ ? ei : tiv; s = gt_ ? tv : s; ei = gt_ ? tiv : ei; }
            }
        }
        float bs[16]; int bi[16];
#pragma unroll
        for (int k = 0; k < 16; ++k) { bs[k] = -3.0e38f; bi[k] = 0; }
#pragma unroll
        for (int i = 0; i < 16; ++i)
#pragma unroll
            for (int j = 0; j < 16; ++j) {
                float s = ts[0][i] + ts[1][j]; int ei = ti[0][i] * 128 + ti[1][j];
#pragma unroll
                for (int k = 0; k < 16; ++k) { const bool gt_ = s > bs[k]; const float tv = bs[k]; const int tiv = bi[k];
                    bs[k] = gt_ ? s : tv; bi[k] = gt_ ? ei : tiv; s = gt_ ? tv : s; ei = gt_ ? tiv : ei; }
            }
        float e[16], sum = 0.f;
#pragma unroll
        for (int i = 0; i < 16; ++i) { e[i] = __expf(bs[i] - bs[0]); sum += e[i]; }
        const float inv = 1.0f / sum;
#pragma unroll
        for (int i = 0; i < 16; ++i) { IDX[t * 128 + h * 16 + i] = (unsigned short)bi[i]; GATE[t * 128 + h * 16 + i] = e[i] * inv; }
    }
}

__device__ __forceinline__ void dbg_compare_topk(const Ctx& F0, const Args& a) {
    const Ctx F = fresh(F0);
    const unsigned short* I1 = (const unsigned short*)(a.ws + WS_IDX);
    const unsigned short* I2 = (const unsigned short*)(a.ws + WS_DBG);
    int* MTB = (int*)(a.ws + WS_DBG + 24 * MiB);
    const int gwv = F.vcu * NWAVES + F.wave, NGW = F.G * NWAVES;
    for (int t = gwv; t < ML; t += NGW) {
        float m = 0.f;
        if (F.lane < 8) {
            int cnt = 0;
            for (int i = 0; i < 16; ++i) { const int x = I2[(size_t)t * 128 + F.lane * 16 + i]; bool f = false;
                for (int j = 0; j < 16; ++j) f = f || (I1[(size_t)t * 128 + F.lane * 16 + j] == x);
                cnt += f ? 0 : 1; }
            m = (float)cnt;
        }
        m = wave_sum(m);
        if (F.lane == 0) MTB[t] = (int)m;
    }
}
__device__ __forceinline__ void dbg_apply_mask(const Ctx& F0, const Args& a) {
    const Ctx F = fresh(F0);
    const int* MTB = (const int*)(a.ws + WS_DBG + 24 * MiB);
    const int gwv = F.vcu * NWAVES + F.wave, NGW = F.G * NWAVES;
    for (int t = gwv; t < ML; t += NGW) {
        const int ncol = 8 * MTB[t];
        for (int c = F.lane; c < ncol; c += 64) a.out[(size_t)t * DM + c] = 0.f;
    }
}

__device__ __forceinline__ void peer_gather_phase(const Ctx& F0, const Args& a, int layer) {
    const Ctx F = fresh(F0);
    const bf16_t* HX = (const bf16_t*)(a.ws + WS_HX);
    const bf16_t* UT = (const bf16_t*)(a.ws + WS_TAB) + (size_t)(2 * layer) * NEXP * DM;
    const bf16_t* VTB = (const bf16_t*)(a.ws + WS_TAB) + (size_t)(2 * layer + 1) * NEXP * DM;
    const unsigned short* IDX = (const unsigned short*)(a.ws + WS_IDX);
    const float* GATE = (const float*)(a.ws + WS_GATE);
    const float* modb = (const float*)(a.ws + WS_MOD) + (size_t)layer * 9 * NMOD;
    float* X = a.out;
    const int gwv = F.vcu * NWAVES + F.wave, NGW = F.G * NWAVES;
    const int lane = F.lane, r16 = lane & 15, g4 = lane >> 4;
    for (int t = gwv; t < ML; t += NGW) {
        int eid[8];
#pragma unroll
        for (int rb = 0; rb < 8; ++rb) eid[rb] = IDX[(size_t)t * 128 + 16 * rb + r16];
        f32x4 acc[8];
#pragma unroll
        for (int rb = 0; rb < 8; ++rb) acc[rb] = (f32x4){0.f, 0.f, 0.f, 0.f};
        const bf16_t* xp = HX + (size_t)t * DM + 8 * g4;
#pragma unroll 2
        for (int s = 0; s < 32; ++s) {
            const bf16x8 xf = *(const bf16x8*)(xp + 32 * s);
#pragma unroll
            for (int rb = 0; rb < 8; ++rb) {
                const bf16x8 uf = *(const bf16x8*)(UT + (size_t)eid[rb] * DM + 32 * s + 8 * g4);
                acc[rb] = __builtin_amdgcn_mfma_f32_16x16x32_bf16(uf, xf, acc[rb], 0, 0, 0);
            }
        }
        float wgt[8][4];
#pragma unroll
        for (int rb = 0; rb < 8; ++rb) { const f32x4 gv = *(const f32x4*)(GATE + (size_t)t * 128 + 16 * rb + 4 * g4);
#pragma unroll
            for (int j = 0; j < 4; ++j) wgt[rb][j] = gelu_erf(acc[rb][j]) * gv[j]; }
        float y[16];
#pragma unroll
        for (int i = 0; i < 16; ++i) y[i] = 0.f;
#pragma unroll
        for (int rb = 0; rb < 8; ++rb)
#pragma unroll
            for (int gg = 0; gg < 4; ++gg)
#pragma unroll
                for (int j = 0; j < 4; ++j) {
                    const int slot = 4 * gg + j;
                    const float w = __builtin_bit_cast(float, __builtin_amdgcn_readlane(__builtin_bit_cast(int, wgt[rb][j]), 16 * gg));
                    const int e = __builtin_amdgcn_readlane(eid[rb], slot);
                    const u32x4* vp = (const u32x4*)(VTB + (size_t)e * DM) + 2 * lane;
                    const u32x4 v0 = vp[0], v1 = vp[1];
                    y[0] += w * bflo(v0.x); y[1] += w * bfhi(v0.x); y[2] += w * bflo(v0.y); y[3] += w * bfhi(v0.y);
                    y[4] += w * bflo(v0.z); y[5] += w * bfhi(v0.z); y[6] += w * bflo(v0.w); y[7] += w * bfhi(v0.w);
                    y[8] += w * bflo(v1.x); y[9] += w * bfhi(v1.x); y[10] += w * bflo(v1.y); y[11] += w * bfhi(v1.y);
                    y[12] += w * bflo(v1.z); y[13] += w * bfhi(v1.z); y[14] += w * bflo(v1.w); y[15] += w * bfhi(v1.w);
                }
        const float dbg_s = (DBG_SKIP & (layer == 0 ? 2 : 8)) ? 0.f : 1.f;
        const float* gf = modb + (size_t)(t >> 12) * NMOD + 5 * DM + 16 * lane;
        float* xo = X + (size_t)t * DM + 16 * lane;
#pragma unroll
        for (int q = 0; q < 4; ++q) { const f32x4 g = *(const f32x4*)(gf + 4 * q) * dbg_s; f32x4 xv = *(f32x4*)(xo + 4 * q);
            xv.x += g.x * y[4 * q]; xv.y += g.y * y[4 * q + 1]; xv.z += g.z * y[4 * q + 2]; xv.w += g.w * y[4 * q + 3]; *(f32x4*)(xo + 4 * q) = xv; }
    }
}

__global__ void __launch_bounds__(NWAVES * 64, 2) fwd_kernel(Args args) {
    extern __shared__ __attribute__((aligned(16))) unsigned char lds_raw[];
    Ctx F;
    F.lds = (LAS unsigned char*)lds_raw;
    F.tid = threadIdx.x; F.lane = F.tid & 63; F.wave = __builtin_amdgcn_readfirstlane(F.tid >> 6);
    F.G = gridDim.x; { const int bx = blockIdx.x; F.vcu = (F.G % 8 == 0) ? (bx % 8) * (F.G / 8) + bx / 8 : bx; }
    volatile LAS unsigned* MISC = (volatile LAS unsigned*)(F.lds + MISC_OFF);
    for (int u = F.tid; u < (LDS_BYTES - LDSCTL_OFF) / 4; u += NWAVES * 64) ((LAS unsigned*)(F.lds + LDSCTL_OFF))[u] = 0u;
    __syncthreads();
    unsigned char* ws = args.ws;
    XcdBarrier bar = xcd_barrier_post((unsigned*)(ws + WS_CTL) + CW_BAR, MISC + 8);
#define GRID_BAR() xcd_barrier(bar)
#define PEER_BLOCK(layer) do { \
        norm_phase(F, args, 1, layer, 3 * DM, args.in[5] + (layer) * DM); \
        GRID_BAR(); \
        { using SHq = pg8::Shape<ML, 2048, DM, DM, DM, 1, 0, 0>; \
          pg8::gemm_phase<SHq>(F.lds, pg8::Gemm{HX, (const bf16_t*)(ws + WS_WPQ) + (size_t)(layer) * 2048 * DM}, F.G, bx, pg8::EpiStoreBf16{QKb, 2048, 0}); } \
        GRID_BAR(); \
        if (DBG_BRUTE_TOPK || DBG_CHECK_TOPK) peer_topk_brute(F, args, layer); else peer_topk_phase(F, args, layer); \
        if (DBG_CHECK_TOPK && (layer) == 0) { peer_topk_phase(F, args, layer); GRID_BAR(); dbg_compare_topk(F, args); } \
        GRID_BAR(); \
        peer_gather_phase(F, args, layer); \
        GRID_BAR(); \
    } while (0)
    const float* modb = (const float*)(ws + WS_MOD);
    bf16_t* HX = (bf16_t*)(ws + WS_HX);
    bf16_t* QKb = (bf16_t*)(ws + WS_QK);
    bf16_t* VTb = (bf16_t*)(ws + WS_VT);
    const bf16_t* Wqkv = (const bf16_t*)(ws + WS_WQKV);
    const int bx = (int)blockIdx.x;

    p0_prologue(F, args);
    GRID_BAR();
    norm_phase(F, args, 0, 0, 0, args.in[4]);
    GRID_BAR();
    {
        using SH1 = pg8::Shape<MT, 2048, DM, DM, DM, 1, 0, 0>;
        pg8::gemm_phase<SH1>(F.lds, pg8::Gemm{HX, Wqkv}, F.G, bx, pg8::EpiStoreBf16{QKb, 2048, 0});
        using SH2 = pg8::Shape<DM, MT, DM, DM, DM, 1, 0, 0>;
        pg8::gemm_phase<SH2>(F.lds, pg8::Gemm{Wqkv + (size_t)2048 * DM, HX}, F.G, bx, pg8::EpiStoreBf16{VTb, MT, 0});
    }
    GRID_BAR();
    attn_phase(F, args);
    GRID_BAR();
    {
        using SH = pg8::Shape<ML, DM, DM, DM, DM, 1, 0, 0>;
        pg8::gemm_phase<SH>(F.lds, pg8::Gemm{HX, (const bf16_t*)(ws + WS_WO)}, F.G, bx, pg8::EpiResid{args.in[0], args.out, modb + 2 * DM, NMOD, (DBG_SKIP & 1) ? 0.f : 1.f});
    }
    GRID_BAR();
    PEER_BLOCK(0);
    norm_phase(F, args, 1, 1, 0, args.in[4] + DM);
    GRID_BAR();
    {
        using SH = pg8::Shape<512, ML, 256, 256, DM, 4, 0, 256>;
        pg8::gemm_phase<SH>(F.lds, pg8::Gemm{(const bf16_t*)(ws + WS_WC), HX}, F.G, bx, pg8::EpiYt{QKb});
    }
    GRID_BAR();
    {
        using SH = pg8::Shape<SEQ, DM, 8192, 8192, 8192, NB, 0, (long)DM * 8192>;
        pg8::gemm_phase<SH>(F.lds, pg8::Gemm{(const bf16_t*)(ws + WS_CS), QKb}, F.G, bx, pg8::EpiStoreBf16{VTb, DM, (long)SEQ * DM});
    }
    GRID_BAR();
    {
        using SH = pg8::Shape<ML, DM, DM, DM, DM, 1, 0, 0>;
        pg8::gemm_phase<SH>(F.lds, pg8::Gemm{VTb, (const bf16_t*)(ws + WS_WF)}, F.G, bx, pg8::EpiResid{args.out, args.out, modb + (size_t)9 * NMOD + 2 * DM, NMOD, (DBG_SKIP & 4) ? 0.f : 1.f});
    }
    GRID_BAR();
    PEER_BLOCK(1);
    final_norm_phase(F, args);
    if (DBG_CHECK_TOPK) { GRID_BAR(); dbg_apply_mask(F, args); }
#undef PEER_BLOCK
}

extern "C" void kernel_launch(void* const* d_in, const int* in_sizes, int n_in, void* d_out, int out_size, void* d_ws, size_t ws_size, hipStream_t stream) {
    static int grid = 0;
    if (grid == 0) {
        if (n_in != 17 || in_sizes[0] != ML * DM || out_size != ML * DM || ws_size < WS_END + (DBG_CHECK_TOPK ? 26 * MiB : 0)) { fprintf(stderr, "kernel_launch: unexpected shapes (n_in %d, in0 %d, out %d, ws %zu)\n", n_in, n_in > 0 ? in_sizes[0] : -1, out_size, ws_size); grid = -1; return; }
        int dev = 0, cus = 0, per_cu = 0;
        if (hipGetDevice(&dev) != hipSuccess || hipDeviceGetAttribute(&cus, hipDeviceAttributeMultiprocessorCount, dev) != hipSuccess) { grid = -1; return; }
        if (hipFuncSetAttribute((const void*)fwd_kernel, hipFuncAttributeMaxDynamicSharedMemorySize, LDS_BYTES) != hipSuccess) { fprintf(stderr, "kernel_launch: hipFuncSetAttribute failed\n"); grid = -1; return; }
        if (hipOccupancyMaxActiveBlocksPerMultiprocessor(&per_cu, (const void*)fwd_kernel, NWAVES * 64, LDS_BYTES) != hipSuccess || per_cu < 1)
            fprintf(stderr, "kernel_launch: note: occupancy query reports %d workgroups per CU\n", per_cu);
        (void)hipGetLastError();
        grid = cus;
    }
    if (grid < 0) return;
    if (hipMemsetAsync((char*)d_ws + WS_CTL, 0, CTL_ZERO_BYTES, stream) != hipSuccess) { fprintf(stderr, "kernel_launch: memset failed\n"); return; }
    Args a{};
    for (int i = 0; i < 17; ++i) a.in[i] = (const float*)d_in[i];
    a.out = (float*)d_out; a.ws = (unsigned char*)d_ws;
    hipLaunchKernelGGL(fwd_kernel, dim3(grid), dim3(NWAVES * 64), LDS_BYTES, stream, a);
    const hipError_t le = hipPeekAtLastError();
    if (le != hipSuccess) fprintf(stderr, "kernel_launch: launch failed: %s\n", hipGetErrorName(le));
}
```

```cpp
#include <hip/hip_runtime.h>
#include <cstdio>
#include <cstdint>

#define LAS __attribute__((address_space(3)))
typedef unsigned short bf16_t;
typedef short bf16x8 __attribute__((ext_vector_type(8)));
typedef short s16x4 __attribute__((ext_vector_type(4)));
typedef float f32x2 __attribute__((ext_vector_type(2)));
typedef float f32x4 __attribute__((ext_vector_type(4)));
typedef float f32x16 __attribute__((ext_vector_type(16)));
typedef unsigned u32x2 __attribute__((ext_vector_type(2)));
typedef unsigned u32x4 __attribute__((ext_vector_type(4)));
typedef __bf16 bf16x2_t __attribute__((ext_vector_type(2)));

#ifndef DBG_SKIP
#define DBG_SKIP 0
#endif
constexpr int DM = 1024, NB = 8, SEQ = 4096, CTXL = 256, GW = 64;
constexpr int ML = NB * SEQ;
constexpr int MC = NB * CTXL;
constexpr int MT = ML + MC;
constexpr int NMOD = 6 * DM;
constexpr int NEXP = 16384;
constexpr float EPS = 1e-6f;
constexpr float LOG2E = 1.4426950408889634f;

constexpr size_t MiB = 1u << 20;
constexpr size_t WS_CTL = 0, CTL_ZERO_BYTES = 1 * MiB;
constexpr size_t WS_MOD = 1 * MiB;
constexpr size_t WS_WQKV = 2 * MiB;
constexpr size_t WS_WO = 8 * MiB;
constexpr size_t WS_WF = 10 * MiB;
constexpr size_t WS_WPQ = 12 * MiB;
constexpr size_t WS_SK = 20 * MiB;
constexpr size_t WS_WC = 20 * MiB + 256 * 1024;
constexpr size_t WS_CS = 22 * MiB;
constexpr size_t WS_TAB = 86 * MiB;
constexpr size_t WS_X8 = 150 * MiB;
constexpr size_t WS_WT = 182 * MiB;
constexpr size_t WS_PART = 282 * MiB;
constexpr float U_SCALE = 512.f, V_SCALE = 16.f, X_SCALE = 16.f;
constexpr size_t WS_HX = 214 * MiB;
constexpr size_t WS_QK = 282 * MiB;
constexpr size_t WS_VT = 418 * MiB;
constexpr size_t WS_IDX = WS_VT;
constexpr size_t WS_GATE = WS_VT + 8 * MiB;
constexpr size_t WS_END = 486 * MiB;
constexpr int CW_BAR = 4096;
constexpr size_t WS_DBG = 486 * MiB;
#ifndef DBG_CHECK_TOPK
#define DBG_CHECK_TOPK 0
#endif

__device__ __forceinline__ unsigned f2bf(float f) { unsigned u = __builtin_bit_cast(unsigned, f); return (u + 0x7fffu + ((u >> 16) & 1u)) >> 16; }
__device__ __forceinline__ unsigned pk2(float lo, float hi) { return f2bf(lo) | (f2bf(hi) << 16); }
__device__ __forceinline__ unsigned cvtpk(float lo, float hi) { f32x2 v = {lo, hi}; bf16x2_t b = __builtin_convertvector(v, bf16x2_t); return __builtin_bit_cast(unsigned, b); }
__device__ __forceinline__ float bflo(unsigned u) { return __builtin_bit_cast(float, u << 16); }
__device__ __forceinline__ float bfhi(unsigned u) { return __builtin_bit_cast(float, u & 0xffff0000u); }
__device__ __forceinline__ float wave_sum(float v) {
#pragma unroll
    for (int o = 1; o < 64; o <<= 1) v += __shfl_xor(v, o);
    return v;
}
__device__ __forceinline__ int crow(int r, int hi) { return (r & 3) + 8 * (r >> 2) + 4 * hi; }
__device__ __forceinline__ float gelu_erf(float v) {
    const float av = __builtin_fabsf(v), d = av * 0.2316418882f + 1.0f;
    const float t = __builtin_amdgcn_rcpf(d);
    float q = t * 0.5307027145f + (-0.7265760135f); q = q * t + 0.7107068705f; q = q * t + (-0.142248368f); q = q * t + 0.127414796f; q = q * t;
    const float e = __builtin_amdgcn_exp2f((v * v) * (-0.72134752044f));
    const float m = v * (q * e), r = v - m;
    return v < 0.f ? m : r;
}

namespace pg8 {
constexpr int BM = 256, BK = 64, HALF = 128, HTB = HALF * BK * 2, STAGE_BYTES = 8 * HTB, NXCD = 8, WGM = 8;
__host__ __device__ __forceinline__ int lds_byte(int r, int c) { const int st = (r >> 4) * 2 + (c >> 5), rr = r & 15, cc = c & 31, ob = rr * 64 + cc * 2; return st * 1024 + (ob ^ (((ob >> 9) & 1) << 5)); }
__host__ __device__ __forceinline__ void stage_rc(int b, int& R, int& C) { const int st = b / 1024, sb = b % 1024, swz = sb ^ (((sb >> 9) & 1) << 5); R = (st >> 1) * 16 + swz / 64; C = (st & 1) * 32 + (swz % 64) / 2; }
__host__ __device__ __forceinline__ int perm32(int rho) { const int n = rho >> 4, i = rho & 15; return 8 * (i >> 2) + 4 * n + (i & 3); }

struct Unit { int pm, pn, pb; };
struct Gemm { const bf16_t* A; const bf16_t* Bt; };
template <int M_, int N_, int K_, int LDA_, int LDB_, int NBATCH_, long BSA_, long BSB_> struct Shape { static constexpr int M = M_, N = N_, K = K_, lda = LDA_, ldb = LDB_, nbatch = NBATCH_; static constexpr long bsA = BSA_, bsB = BSB_; };

template <class SH> struct StaticOrder {
    static constexpr int nM = SH::M / BM, nN = SH::N / BM, per = nM * nN, nwg = per * SH::nbatch;
    int G, c;
    __device__ __forceinline__ void init(int G_, int c_) { G = G_; c = c_; }
    __device__ __forceinline__ bool next(int i, Unit& u) const {
        const long L = (long)i * G + c; if (L >= nwg) return false;
        int wgid = (int)L; { const int q = nwg / NXCD, r = nwg % NXCD, xcd = wgid % NXCD, off = wgid / NXCD; wgid = (xcd < r ? xcd * (q + 1) : r * (q + 1) + (xcd - r) * q) + off; }
        u.pb = wgid / per; wgid -= u.pb * per;
        const int nig = WGM * nN, gid = wgid / nig, fm = gid * WGM, gsz = (nM - fm) < WGM ? (nM - fm) : WGM;
        u.pm = fm + ((wgid % nig) % gsz); u.pn = (wgid % nig) / gsz; return true;
    }
};

struct EpiStoreBf16 {
    static constexpr bool PERM = true;
    bf16_t* O; long ldc; long bstride;
    __device__ __forceinline__ void operator()(const f32x4 (&acc)[2][2][4][2], const Unit& u, int wr, int wc, int fr, int fq) const {
        const int row0 = u.pm * BM + wr * 64 + fr, col0 = u.pn * BM + wc * 32 + 8 * fq;
        bf16_t* base = O + (long)u.pb * bstride;
#pragma unroll
        for (int ai = 0; ai < 2; ++ai)
#pragma unroll
            for (int m = 0; m < 4; ++m) { bf16_t* rowp = base + (long)(row0 + ai * HALF + m * 16) * ldc + col0;
#pragma unroll
                for (int bj = 0; bj < 2; ++bj) { const f32x4 v0 = acc[ai][bj][m][0], v1 = acc[ai][bj][m][1];
                    u32x4 w; w.x = cvtpk(v0[0], v0[1]); w.y = cvtpk(v0[2], v0[3]); w.z = cvtpk(v1[0], v1[1]); w.w = cvtpk(v1[2], v1[3]);
                    *(u32x4*)(rowp + bj * HALF) = w; } }
    }
};
struct EpiYt {
    static constexpr bool PERM = true;
    bf16_t* Yt;
    __device__ __forceinline__ void operator()(const f32x4 (&acc)[2][2][4][2], const Unit& u, int wr, int wc, int fr, int fq) const {
        const int row0 = u.pm * BM + wr * 64 + fr, col0 = u.pn * BM + wc * 32 + 8 * fq;
#pragma unroll
        for (int ai = 0; ai < 2; ++ai)
#pragma unroll
            for (int m = 0; m < 4; ++m) { const int row = row0 + ai * HALF + m * 16; const int part = row >> 8, cp = row & 255;
#pragma unroll
                for (int bj = 0; bj < 2; ++bj) { const int col = col0 + bj * HALF; const int b = col >> 12, n = col & 4095;
                    const f32x4 v0 = acc[ai][bj][m][0], v1 = acc[ai][bj][m][1];
                    u32x4 w; w.x = cvtpk(v0[0], v0[1]); w.y = cvtpk(v0[2], v0[3]); w.z = cvtpk(v1[0], v1[1]); w.w = cvtpk(v1[2], v1[3]);
                    *(u32x4*)(Yt + ((((long)(b * 4 + u.pb) * 256 + cp) * 2 + part) << 12) + n) = w; }
                asm volatile("" ::: "memory"); }
    }
};
struct EpiResid {
    static constexpr bool PERM = false;
    const float* Xin; float* Xout; const float* gate; int gstride; float gs;
    __device__ __forceinline__ void operator()(const f32x4 (&acc)[2][2][4][2], const Unit& u, int wr, int wc, int fr, int fq) const {
        const int row0 = u.pm * BM + wr * 64 + fr, col0 = u.pn * BM + wc * 32 + 4 * fq;
        const float* gb = gate + (long)((u.pm * BM) >> 12) * gstride;
        f32x4 gv[2][2];
#pragma unroll
        for (int bj = 0; bj < 2; ++bj)
#pragma unroll
            for (int n = 0; n < 2; ++n) gv[bj][n] = *(const f32x4*)(gb + col0 + bj * HALF + n * 16);
#pragma unroll
        for (int ai = 0; ai < 2; ++ai)
#pragma unroll
            for (int m = 0; m < 4; ++m) { const long off = (long)(row0 + ai * HALF + m * 16) * DM + col0;
#pragma unroll
                for (int bj = 0; bj < 2; ++bj)
#pragma unroll
                    for (int n = 0; n < 2; ++n) { const f32x4 bs = *(const f32x4*)(Xin + off + bj * HALF + n * 16);
                        *(f32x4*)(Xout + off + bj * HALF + n * 16) = bs + gv[bj][n] * acc[ai][bj][m][n] * gs; }
                if (m & 1) asm volatile("" ::: "memory"); }
    }
};

template <class SH, class Epi>
__device__ __forceinline__ void gemm_phase(LAS unsigned char* lds, const Gemm g, int G_, int c_, const Epi& E) {
    StaticOrder<SH> S; S.init(G_, c_);
    int tid_ = threadIdx.x; asm volatile("" : "+v"(tid_));
    const int tid = tid_, wid = __builtin_amdgcn_readfirstlane(tid >> 6), lane = tid & 63, wr = wid >> 2, wc = wid & 3, fr = lane & 15, fq = lane >> 4;
    constexpr int K = SH::K, nt = K / BK;
    unsigned voffA[2], voffB[2];
#pragma unroll
    for (int i = 0; i < 2; ++i) { int R, C; stage_rc(tid * 16 + i * 8192, R, C); const int Rb = Epi::PERM ? ((R & ~31) + perm32(R & 31)) : R;
        voffA[i] = (unsigned)(R * SH::lda + C) * 2u; voffB[i] = (unsigned)(Rb * SH::ldb + C) * 2u; }
    constexpr size_t kstep = (size_t)(BK * 2);
    constexpr size_t hstepA = (size_t)HALF * SH::lda * 2, hstepB = (size_t)HALF * SH::ldb * 2;
    constexpr size_t tstepA = 2 * hstepA, tstepB = 2 * hstepB;
    const unsigned ldsw = (unsigned)wid * 1024u;
    const int aoff = lds_byte(wr * 64 + fr, fq * 8), boff = lds_byte(wc * 32 + fr, fq * 8);
#define PG8_SA(b, h) (((b) * 2 + (h)) * HTB)
#define PG8_SB(b, h) ((4 + (b) * 2 + (h)) * HTB)
#define PG8_STAGE(bufoff, gbase, voff) do { _Pragma("unroll") for (int _i = 0; _i < 2; ++_i) \
        __builtin_amdgcn_global_load_lds((const unsigned*)((const char*)(gbase) + (voff)[_i]), (LAS unsigned*)(lds + (bufoff) + ldsw + _i * 8192), 16, 0, 0); } while (0)
#define PG8_LDA(dst, b, h) do { _Pragma("unroll") for (int m = 0; m < 4; ++m) _Pragma("unroll") for (int k = 0; k < 2; ++k) dst[m][k] = *(const LAS bf16x8*)(lds + PG8_SA(b, h) + aoff + m * 2048 + k * 1024); } while (0)
#define PG8_LDB(dst, b, h) do { _Pragma("unroll") for (int n = 0; n < 2; ++n) _Pragma("unroll") for (int k = 0; k < 2; ++k) dst[n][k] = *(const LAS bf16x8*)(lds + PG8_SB(b, h) + boff + n * 2048 + k * 1024); } while (0)
#define PG8_MMA(ai, bj, At, Bt) do { __builtin_amdgcn_s_setprio(1); _Pragma("unroll") for (int m = 0; m < 4; ++m) _Pragma("unroll") for (int n = 0; n < 2; ++n) _Pragma("unroll") for (int k = 0; k < 2; ++k) \
        acc[ai][bj][m][n] = __builtin_amdgcn_mfma_f32_16x16x32_bf16(Bt[n][k], At[m][k], acc[ai][bj][m][n], 0, 0, 0); __builtin_amdgcn_s_setprio(0); } while (0)
#define PG8_WAIT_V(n) asm volatile("s_waitcnt vmcnt(" #n ")" ::: "memory")
#define PG8_WAIT_L(n) asm volatile("s_waitcnt lgkmcnt(" #n ")" ::: "memory")
#define PG8_BAR __builtin_amdgcn_s_barrier()
#define PG8_SCHED __builtin_amdgcn_sched_barrier(0)
    Unit cur, nxt; int ui = 0;
    if (!S.next(0, cur)) return;
    f32x4 acc[2][2][4][2];
#pragma unroll
    for (int a = 0; a < 2; ++a)
#pragma unroll
        for (int b = 0; b < 2; ++b)
#pragma unroll
            for (int m = 0; m < 4; ++m)
#pragma unroll
                for (int n = 0; n < 2; ++n) acc[a][b][m][n] = (f32x4){0.f, 0.f, 0.f, 0.f};
    bf16x8 At[4][2], B0[2][2], B1[2][2];
    const char* cA = (const char*)(g.A + (long)cur.pb * SH::bsA) + (size_t)cur.pm * tstepA; const char* cB = (const char*)(g.Bt + (long)cur.pb * SH::bsB) + (size_t)cur.pn * tstepB;
    PG8_STAGE(PG8_SB(0, 0), cB, voffB); PG8_STAGE(PG8_SB(0, 1), cB + hstepB, voffB); PG8_STAGE(PG8_SA(0, 0), cA, voffA); PG8_STAGE(PG8_SA(0, 1), cA + hstepA, voffA);
    if (wr == 1) PG8_BAR;
    PG8_WAIT_V(2); PG8_BAR;
    PG8_STAGE(PG8_SB(1, 0), cB + kstep, voffB); PG8_STAGE(PG8_SA(1, 0), cA + kstep, voffA); PG8_STAGE(PG8_SB(1, 1), cB + hstepB + kstep, voffB);
    PG8_WAIT_V(6); PG8_BAR;
    for (;;) {
        const bool has_next = S.next(ui + 1, nxt);
        const char* nA = has_next ? (const char*)(g.A + (long)nxt.pb * SH::bsA) + (size_t)nxt.pm * tstepA : cA; const char* nB = has_next ? (const char*)(g.Bt + (long)nxt.pb * SH::bsB) + (size_t)nxt.pn * tstepB : cB;
#pragma nounroll
        for (int t = 0; t < nt; t += 2) {
            const bool last = (t == nt - 2);
            const char* a1 = cA + (size_t)(t + 1) * kstep;
            const char* a2 = last ? nA : cA + (size_t)(t + 2) * kstep; const char* b2 = last ? nB : cB + (size_t)(t + 2) * kstep;
            const char* a3 = a2 + kstep; const char* b3 = b2 + kstep;
            PG8_LDB(B0, 0, 0); PG8_LDB(B1, 0, 1); PG8_SCHED; PG8_LDA(At, 0, 0); PG8_STAGE(PG8_SA(1, 1), a1 + hstepA, voffA);
            PG8_WAIT_V(8); PG8_WAIT_L(0); PG8_BAR; PG8_MMA(0, 0, At, B0); PG8_MMA(0, 1, At, B1); PG8_BAR; PG8_SCHED;
            PG8_LDA(At, 0, 1); PG8_STAGE(PG8_SB(0, 0), b2, voffB); PG8_STAGE(PG8_SB(0, 1), b2 + hstepB, voffB); PG8_STAGE(PG8_SA(0, 0), a2, voffA);
            PG8_WAIT_V(8); PG8_WAIT_L(0); PG8_BAR; PG8_MMA(1, 0, At, B0); PG8_MMA(1, 1, At, B1); PG8_BAR; PG8_SCHED;
            PG8_LDB(B0, 1, 0); PG8_LDB(B1, 1, 1); PG8_SCHED; PG8_LDA(At, 1, 0); PG8_STAGE(PG8_SA(0, 1), a2 + hstepA, voffA);
            PG8_WAIT_V(8); PG8_WAIT_L(0); PG8_BAR; PG8_MMA(0, 0, At, B0); PG8_MMA(0, 1, At, B1); PG8_BAR; PG8_SCHED;
            PG8_LDA(At, 1, 1); PG8_STAGE(PG8_SB(1, 0), b3, voffB); PG8_STAGE(PG8_SB(1, 1), b3 + hstepB, voffB); PG8_STAGE(PG8_SA(1, 0), a3, voffA);
            PG8_WAIT_V(8); PG8_WAIT_L(0); PG8_BAR; PG8_MMA(1, 0, At, B0); PG8_MMA(1, 1, At, B1); PG8_BAR; PG8_SCHED;
        }
        if (wr == 0) PG8_BAR;
        E(acc, cur, wr, wc, fr, fq);
        if (!has_next) break;
#pragma unroll
        for (int a = 0; a < 2; ++a)
#pragma unroll
            for (int b = 0; b < 2; ++b)
#pragma unroll
                for (int m = 0; m < 4; ++m)
#pragma unroll
                    for (int n = 0; n < 2; ++n) acc[a][b][m][n] = (f32x4){0.f, 0.f, 0.f, 0.f};
        cur = nxt; cA = nA; cB = nB; ++ui;
        if (wr == 1) PG8_BAR;
    }
    PG8_WAIT_V(0);
    PG8_BAR;
#undef PG8_SA
#undef PG8_SB
#undef PG8_STAGE
#undef PG8_LDA
#undef PG8_LDB
#undef PG8_MMA
#undef PG8_WAIT_V
#undef PG8_WAIT_L
#undef PG8_BAR
#undef PG8_SCHED
}
}

#define XB_TMO      128
#define XB_XCNT(j)  (256  + 64 * (j))
#define XB_XSUB(j)  (1280 + 64 * (j))
#define XB_XGEN(j)  (2304 + 64 * (j))
#define XB_TOP      3328
#define XB_TOPGEN   3392
#define XCD_BAR_WORDS 3456
#define XB_SPIN_CAP (1u << 18)
__device__ __forceinline__ unsigned xb_ld(unsigned* p)              { return __hip_atomic_load(p, __ATOMIC_RELAXED, __HIP_MEMORY_SCOPE_AGENT); }
__device__ __forceinline__ unsigned xb_add(unsigned* p, unsigned v) { return __hip_atomic_fetch_add(p, v, __ATOMIC_RELAXED, __HIP_MEMORY_SCOPE_AGENT); }
__device__ __forceinline__ unsigned xb_xcc_id() { return (unsigned)__builtin_amdgcn_s_getreg((3 << 11) | 20) & 0xFu; }
#define XB_SPIN(cond, bar) do { unsigned _sp = 0; while (cond) { __builtin_amdgcn_s_sleep(1); \
    if ((++_sp & 255u) == 0u) { if (xb_ld(&(bar)[XB_TMO])) break; if (_sp > XB_SPIN_CAP) { atomicAdd(&(bar)[XB_TMO], 1u); break; } } } } while (0)
struct XcdBarrier { unsigned* bar; unsigned x; volatile LAS unsigned* st; };
__device__ __forceinline__ XcdBarrier xcd_barrier_post(unsigned* bar, volatile LAS unsigned* st) {
    XcdBarrier b; b.bar = bar; b.x = xb_xcc_id(); b.st = st;
    if (threadIdx.x == 0) (void)xb_add(&bar[XB_XCNT(b.x)], 1u);
    return b;
}
__device__ __forceinline__ void xcd_barrier_complete(unsigned* bar, unsigned x, unsigned& nloc, unsigned& nx) {
    const unsigned G = gridDim.x * gridDim.y * gridDim.z;
    unsigned sum, cnt, mine, sp = 0u;
    for (;;) {
        sum = 0u; cnt = 0u; mine = 0u;
#pragma unroll
        for (unsigned j = 0; j < 16; ++j) { const unsigned c = xb_ld(&bar[XB_XCNT(j)]); sum += c; cnt += (c > 0u) ? 1u : 0u; mine = (j == x) ? c : mine; }
        if (sum == G) break;
        __builtin_amdgcn_s_sleep(1);
        if ((++sp & 255u) == 0u) { if (xb_ld(&bar[XB_TMO])) break; if (sp > XB_SPIN_CAP) { atomicAdd(&bar[XB_TMO], 1u); break; } }
    }
    nloc = mine > 0u ? mine : 1u; nx = cnt > 0u ? cnt : 1u;
}
__device__ __forceinline__ void xcd_barrier(const XcdBarrier& b) {
    asm volatile("s_waitcnt vmcnt(0)" ::: "memory");
    __syncthreads();
    if (threadIdx.x == 0) {
        unsigned* bar = b.bar;
        __builtin_amdgcn_s_waitcnt(0);
        unsigned nloc = b.st[0], nx = b.st[1];
        if (nloc == 0u) { xcd_barrier_complete(bar, b.x, nloc, nx); b.st[0] = nloc; b.st[1] = nx; }
        const unsigned old = xb_add(&bar[XB_XSUB(b.x)], 1u);
        const unsigned gen = old / nloc;
        if (old + 1u == (gen + 1u) * nloc) {
            __builtin_amdgcn_fence(__ATOMIC_RELEASE, "agent");
            asm volatile("s_waitcnt vmcnt(0)" ::: "memory");
            const unsigned og = xb_add(&bar[XB_TOP], 1u);
            const unsigned tg = og / nx;
            if (og + 1u == (tg + 1u) * nx) xb_add(&bar[XB_TOPGEN], 1u);
            else XB_SPIN(xb_ld(&bar[XB_TOPGEN]) == tg, bar);
            __builtin_amdgcn_fence(__ATOMIC_ACQUIRE, "agent");
            xb_add(&bar[XB_XGEN(b.x)], 1u);
            asm volatile("s_waitcnt vmcnt(0)" ::: "memory");
        } else {
            XB_SPIN(xb_ld(&bar[XB_XGEN(b.x)]) == gen, bar);
            __builtin_amdgcn_fence(__ATOMIC_ACQUIRE, "agent");
            asm volatile("s_waitcnt vmcnt(0)" ::: "memory");
        }
    }
    __syncthreads();
}

constexpr int RING_BYTES = 131072;
constexpr int LDSCTL_OFF = RING_BYTES, MISC_OFF = LDSCTL_OFF + 320;
constexpr int LDS_BYTES = 147456;
constexpr int NWAVES = 8;

struct Args { const float* in[17]; float* out; unsigned char* ws; };

struct Ctx {
    LAS unsigned char* lds;
    int tid, lane, wave, vcu, G;
};

__device__ __forceinline__ Ctx fresh(const Ctx& F) {
    Ctx C = F; int t = threadIdx.x; asm volatile("" : "+v"(t)); C.tid = t; C.lane = t & 63; return C;
}
__device__ __forceinline__ void p0_transpose_item(const float* W, int K, int N, bf16_t* WT, LAS float* scr, int item, int lane) {
    const int nblk = N / 32, kb = item / nblk, nb = item % nblk, k0 = 64 * kb, n0 = 32 * nb;
#pragma unroll 8
    for (int i = 0; i < 32; ++i) { const int kk = 2 * i + (lane >> 5); scr[kk * 33 + (lane & 31)] = W[(size_t)(k0 + kk) * N + n0 + (lane & 31)]; }
    asm volatile("s_waitcnt lgkmcnt(0)" ::: "memory");
    const int c = lane & 7;
#pragma unroll
    for (int j = 0; j < 4; ++j) { const int n = (lane >> 3) + 8 * j; const LAS float* s = scr + (8 * c) * 33 + n;
        u32x4 o; o.x = pk2(s[0 * 33], s[1 * 33]); o.y = pk2(s[2 * 33], s[3 * 33]); o.z = pk2(s[4 * 33], s[5 * 33]); o.w = pk2(s[6 * 33], s[7 * 33]);
        *(u32x4*)(WT + (size_t)(n0 + n) * K + k0 + 8 * c) = o; }
    asm volatile("s_waitcnt lgkmcnt(0)" ::: "memory");
}
__device__ __forceinline__ void cvt8(const float* src, bf16_t* dst) {
    const f32x4 a = *(const f32x4*)src, b = *(const f32x4*)(src + 4);
    u32x4 o; o.x = pk2(a[0], a[1]); o.y = pk2(a[2], a[3]); o.z = pk2(b[0], b[1]); o.w = pk2(b[2], b[3]);
    *(u32x4*)dst = o;
}

__device__ __forceinline__ void p0_prologue(const Ctx& F0, const Args& a) {
    const Ctx F = fresh(F0);
    unsigned char* ws = a.ws;
    const int gw = F.vcu * NWAVES + F.wave, NGW = F.G * NWAVES;
    const long gt = (long)F.vcu * 512 + F.tid, NGT = (long)F.G * 512;
    {
        LAS float* red = (LAS float*)(F.lds);
        const float* c = a.in[1]; const float* cctx = a.in[3]; const float* wmod = a.in[6]; const float* bmod = a.in[7];
        float* modb = (float*)(ws + WS_MOD);
        for (int item = F.vcu; item < 96; item += F.G) {
            const int l = item / 48, nc = item % 48, n0 = nc * 128 + 2 * F.lane, kb = F.wave * 128;
            float sv[9][2];
#pragma unroll
            for (int r = 0; r < 9; ++r)
#pragma unroll
                for (int j = 0; j < 2; ++j) { const int k = kb + 64 * j + F.lane; const float v = (r < 8) ? c[r * DM + k] : cctx[k]; sv[r][j] = v / (1.0f + __expf(-v)); }
            float acc[9][2];
#pragma unroll
            for (int r = 0; r < 9; ++r) { acc[r][0] = 0.f; acc[r][1] = 0.f; }
            const float* wp = wmod + (size_t)l * DM * NMOD + (size_t)kb * NMOD + n0;
#pragma unroll
            for (int j = 0; j < 2; ++j)
#pragma unroll 8
                for (int kl = 0; kl < 64; ++kl) {
                    const f32x2 w = *(const f32x2*)(wp + (size_t)(64 * j + kl) * NMOD);
#pragma unroll
                    for (int r = 0; r < 9; ++r) { const float s = __builtin_bit_cast(float, __builtin_amdgcn_readlane(__builtin_bit_cast(int, sv[r][j]), kl)); acc[r][0] += s * w[0]; acc[r][1] += s * w[1]; }
                }
            __syncthreads();
#pragma unroll
            for (int r = 0; r < 9; ++r) { red[(F.wave * 9 + r) * 128 + 2 * F.lane] = acc[r][0]; red[(F.wave * 9 + r) * 128 + 2 * F.lane + 1] = acc[r][1]; }
            __syncthreads();
            for (int o = F.tid; o < 9 * 128; o += 512) { const int r = o >> 7, nl = o & 127; float s = 0.f;
#pragma unroll
                for (int w = 0; w < 8; ++w) s += red[(w * 9 + r) * 128 + nl];
                modb[(size_t)(l * 9 + r) * NMOD + nc * 128 + nl] = s + bmod[l * NMOD + nc * 128 + nl]; }
        }
        __syncthreads();
    }
    {
        LAS float* scr = (LAS float*)(F.lds + F.wave * 16384);
        constexpr int I_QKV = (DM / 64) * (3 * DM / 32), I_O = (DM / 64) * (DM / 32), I_PQ = (DM / 64) * (2 * DM / 32);
        constexpr int NITEMS = I_QKV + 2 * I_O + 2 * I_PQ;
        for (int it = gw; it < NITEMS; it += NGW) {
            int r = it;
            if (r < I_QKV) { p0_transpose_item(a.in[8], DM, 3 * DM, (bf16_t*)(ws + WS_WQKV), scr, r, F.lane); continue; } r -= I_QKV;
            if (r < I_O) { p0_transpose_item(a.in[9], DM, DM, (bf16_t*)(ws + WS_WO), scr, r, F.lane); continue; } r -= I_O;
            if (r < I_O) { p0_transpose_item(a.in[11], DM, DM, (bf16_t*)(ws + WS_WF), scr, r, F.lane); continue; } r -= I_O;
            if (r < I_PQ) { p0_transpose_item(a.in[12], DM, 2 * DM, (bf16_t*)(ws + WS_WPQ), scr, r, F.lane); continue; } r -= I_PQ;
            p0_transpose_item(a.in[12] + (size_t)DM * 2 * DM, DM, 2 * DM, (bf16_t*)(ws + WS_WPQ) + (size_t)2 * DM * DM, scr, r, F.lane);
        }
    }
    for (long i = gt; i < 2 * 2 * 128 * 128 / 8; i += NGT) cvt8(a.in[13] + i * 8, (bf16_t*)(ws + WS_SK) + i * 8);
    {
        constexpr long PER = (long)NEXP * DM / 16;
        unsigned char* t8 = ws + WS_TAB;
        for (long i = gt; i < 4 * PER; i += NGT) {
            const int q = (int)(i / PER); const long r = i - (long)q * PER; const int l = q >> 1, tb = q & 1;
            const int e = (int)(r >> 6), c16 = (int)(r & 63);
            const float* src = (tb ? a.in[15] : a.in[14]) + ((size_t)l * NEXP + e) * DM + c16 * 16;
            const float sc = tb ? V_SCALE : U_SCALE;
            u32x4 o;
#pragma unroll
            for (int d = 0; d < 4; ++d) { const f32x4 v = *(const f32x4*)(src + 4 * d); int w = 0;
                w = __builtin_amdgcn_cvt_pk_fp8_f32(fminf(fmaxf(v[0] * sc, -448.f), 448.f), fminf(fmaxf(v[1] * sc, -448.f), 448.f), w, false);
                w = __builtin_amdgcn_cvt_pk_fp8_f32(fminf(fmaxf(v[2] * sc, -448.f), 448.f), fminf(fmaxf(v[3] * sc, -448.f), 448.f), w, true);
                o[d] = (unsigned)w; }
            *(u32x4*)(t8 + (((size_t)q * 8 + (c16 >> 3)) * NEXP + e) * 128 + (c16 & 7) * 16) = o;
        }
    }
    {
        bf16_t* wc = (bf16_t*)(ws + WS_WC);
        for (long i = gt; i < 512 * 256 / 8; i += NGT) { const int nn = (int)(i >> 5), k0 = (int)(i & 31) * 8; float v[8];
#pragma unroll
            for (int j = 0; j < 8; ++j) { const int m = ((k0 + j) * (nn & 255)) & 255; const float fr = (float)m * (1.0f / 256.0f);
                v[j] = (nn < 256 ? __builtin_amdgcn_cosf(fr) : __builtin_amdgcn_sinf(fr)) * (1.0f / 16.0f); }
            u32x4 o; o.x = pk2(v[0], v[1]); o.y = pk2(v[2], v[3]); o.z = pk2(v[4], v[5]); o.w = pk2(v[6], v[7]);
            *(u32x4*)(wc + i * 8) = o; }
        bf16_t* cs = (bf16_t*)(ws + WS_CS);
        for (long i = gt; i < 4096L * 8192 / 8; i += NGT) { const int np = (int)(i >> 10), c0 = (int)(i & 1023) * 8; const int part = c0 >> 12; float v[8];
#pragma unroll
            for (int j = 0; j < 8; ++j) { const int n = (c0 + j) & 4095; const int m = (n * np) & 4095; const float fr = (float)m * (1.0f / 4096.0f);
                v[j] = (part == 0 ? __builtin_amdgcn_cosf(fr) : -__builtin_amdgcn_sinf(fr)) * (1.0f / 64.0f); }
            u32x4 o; o.x = pk2(v[0], v[1]); o.y = pk2(v[2], v[3]); o.z = pk2(v[4], v[5]); o.w = pk2(v[6], v[7]);
            *(u32x4*)(cs + i * 8) = o; }
    }
}

__device__ __forceinline__ void norm_mod_row(const float* xrow, const float* gw, const float* sh, const float* sc, bf16_t* orow, int lane, unsigned char* x8 = nullptr, long trow = 0) {
    const f32x4* xr = (const f32x4*)xrow + lane;
    f32x4 v[4]; float s = 0.f;
#pragma unroll
    for (int j = 0; j < 4; ++j) { v[j] = xr[64 * j]; s += (v[j].x * v[j].x + v[j].y * v[j].y) + (v[j].z * v[j].z + v[j].w * v[j].w); }
    const float rstd = 1.0f / sqrtf(wave_sum(s) * (1.0f / DM) + EPS);
    unsigned long long* o8 = (unsigned long long*)orow + lane;
#pragma unroll
    for (int j = 0; j < 4; ++j) {
        const f32x4 g = ((const f32x4*)gw)[lane + 64 * j], a = ((const f32x4*)sh)[lane + 64 * j], c = ((const f32x4*)sc)[lane + 64 * j];
        const f32x4 y = (v[j] * rstd * g) * (c + 1.0f) + a;
        o8[64 * j] = (unsigned long long)cvtpk(y.x, y.y) | ((unsigned long long)cvtpk(y.z, y.w) << 32);
        if (x8) { int w = 0;
            w = __builtin_amdgcn_cvt_pk_fp8_f32(fminf(fmaxf(y.x * X_SCALE, -448.f), 448.f), fminf(fmaxf(y.y * X_SCALE, -448.f), 448.f), w, false);
            w = __builtin_amdgcn_cvt_pk_fp8_f32(fminf(fmaxf(y.z * X_SCALE, -448.f), 448.f), fminf(fmaxf(y.w * X_SCALE, -448.f), 448.f), w, true);
            *(int*)(x8 + ((size_t)(2 * j + (lane >> 5)) * ML + trow) * 128 + (4 * lane & 127)) = w; }
    }
}
__device__ __forceinline__ void norm_phase(const Ctx& F0, const Args& a, int mode, int layer, int off, const float* gw) {
    const Ctx F = fresh(F0);
    const int gwv = F.vcu * NWAVES + F.wave, NGW = F.G * NWAVES;
    const float* modb = (const float*)(a.ws + WS_MOD) + (size_t)layer * 9 * NMOD;
    bf16_t* hx = (bf16_t*)(a.ws + WS_HX);
    const int nrows = (mode == 0) ? MT : ML;
    for (int m = gwv; m < nrows; m += NGW) {
        const float* src; const float* mr;
        if (m < ML) { src = (mode == 0 ? a.in[0] : a.out) + (size_t)m * DM; mr = modb + (size_t)(m >> 12) * NMOD; }
        else { src = a.in[2] + (size_t)(m - ML) * DM; mr = modb + (size_t)8 * NMOD; }
        norm_mod_row(src, gw, mr + off, mr + off + DM, hx + (size_t)m * DM, F.lane, (off == 3 * DM) ? (a.ws + WS_X8) : nullptr, m);
    }
}
__device__ __forceinline__ void final_norm_phase(const Ctx& F0, const Args& a) {
    const Ctx F = fresh(F0);
    const int gwv = F.vcu * NWAVES + F.wave, NGW = F.G * NWAVES;
    const float* gw = a.in[16];
    for (int m = gwv; m < ML; m += NGW) {
        f32x4* xr = (f32x4*)(a.out + (size_t)m * DM) + F.lane;
        f32x4 v[4]; float s = 0.f;
#pragma unroll
        for (int j = 0; j < 4; ++j) { v[j] = xr[64 * j]; s += (v[j].x * v[j].x + v[j].y * v[j].y) + (v[j].z * v[j].z + v[j].w * v[j].w); }
        const float rstd = 1.0f / sqrtf(wave_sum(s) * (1.0f / DM) + EPS);
#pragma unroll
        for (int j = 0; j < 4; ++j) xr[64 * j] = v[j] * rstd * ((const f32x4*)gw)[F.lane + 64 * j];
    }
}

__device__ __forceinline__ void attn_phase(const Ctx& F0, const Args& a) {
    const Ctx F = fresh(F0);
    const bf16_t* QK = (const bf16_t*)(a.ws + WS_QK);
    const bf16_t* VT = (const bf16_t*)(a.ws + WS_VT);
    bf16_t* AO = (bf16_t*)(a.ws + WS_HX);
    const float* rpb = a.in[10];
    LAS float* rl = (LAS float*)F.lds;
    const int lane = F.lane, hl = F.wave >> 1, qt = F.wave & 1, q32 = lane & 31, hi = lane >> 5;
    const float SC = 0.125f * LOG2E, NEG = -1e30f;
    for (int task = F.vcu; task < 2048; task += F.G) {
        const int hq = task & 3, r = (task >> 2) & 63, b = task >> 8;
        __syncthreads();
        for (int i = F.tid; i < 4 * 465; i += 512) rl[i] = rpb[hq * 4 * 465 + i] * LOG2E;
        __syncthreads();
        const int h = 4 * hq + hl;
        const int r_start = min(max(r - 4, 0), 56);
        const int qc = 32 * qt + q32;
        const int cs = min(max(qc - 8, 0), 48);
        const long mq = (long)b * SEQ + r * GW + qc;
        bf16x8 qr[4];
#pragma unroll
        for (int d0 = 0; d0 < 4; ++d0) qr[d0] = *(const bf16x8*)(QK + mq * 2048 + h * 64 + d0 * 16 + hi * 8);
        float m_run = NEG, l_run = 0.f;
        f32x16 o[2];
#pragma unroll
        for (int i = 0; i < 16; ++i) { o[0][i] = 0.f; o[1][i] = 0.f; }
        for (int it = 0; it < 12; ++it) {
            const bool latent = it < 8;
            const int kr = r_start + it;
            const long tok0 = latent ? ((long)b * SEQ + (long)kr * GW) : ((long)ML + b * CTXL + (it - 8) * 64);
            f32x16 p[2];
#pragma unroll
            for (int blk = 0; blk < 2; ++blk) {
                const bf16_t* kp = QK + (tok0 + 32 * blk + q32) * 2048 + 1024 + h * 64 + hi * 8;
                f32x16 acc;
#pragma unroll
                for (int i = 0; i < 16; ++i) acc[i] = 0.f;
                asm volatile("" : "+v"(acc));
#pragma unroll
                for (int d0 = 0; d0 < 4; ++d0) { const bf16x8 kf = *(const bf16x8*)(kp + d0 * 16); acc = __builtin_amdgcn_mfma_f32_32x32x16_bf16(kf, qr[d0], acc, 0, 0, 0); }
                p[blk] = acc;
            }
            float mx = NEG;
            if (latent) {
                const LAS float* rb = rl + hl * 465 + (kr - r + 7) * 31;
#pragma unroll
                for (int blk = 0; blk < 2; ++blk)
#pragma unroll
                    for (int i = 0; i < 16; ++i) { const int kc = 32 * blk + crow(i, hi); const bool valid = (kc >= cs) && (kc < cs + 16);
                        const int bi = valid ? (kc - qc + 15) : 0; const float bv = rb[bi];
                        const float v = valid ? (p[blk][i] * SC + bv) : NEG; p[blk][i] = v; mx = fmaxf(mx, v); }
            } else {
#pragma unroll
                for (int blk = 0; blk < 2; ++blk)
#pragma unroll
                    for (int i = 0; i < 16; ++i) { const float v = p[blk][i] * SC; p[blk][i] = v; mx = fmaxf(mx, v); }
            }
            mx = fmaxf(mx, __shfl_xor(mx, 32));
            const float m_new = fmaxf(m_run, mx);
            const float alpha = __builtin_amdgcn_exp2f(m_run - m_new);
            m_run = m_new;
            float rs = 0.f;
#pragma unroll
            for (int blk = 0; blk < 2; ++blk)
#pragma unroll
                for (int i = 0; i < 16; ++i) { const float e = __builtin_amdgcn_exp2f(p[blk][i] - m_new); p[blk][i] = e; rs += e; }
            l_run = l_run * alpha + rs;
#pragma unroll
            for (int i = 0; i < 16; ++i) { o[0][i] *= alpha; o[1][i] *= alpha; }
#pragma unroll
            for (int blk = 0; blk < 2; ++blk)
#pragma unroll
                for (int s = 0; s < 2; ++s) {
                    u32x4 pw; pw.x = cvtpk(p[blk][8 * s + 0], p[blk][8 * s + 1]); pw.y = cvtpk(p[blk][8 * s + 2], p[blk][8 * s + 3]);
                    pw.z = cvtpk(p[blk][8 * s + 4], p[blk][8 * s + 5]); pw.w = cvtpk(p[blk][8 * s + 6], p[blk][8 * s + 7]);
                    const bf16x8 pf = __builtin_bit_cast(bf16x8, pw);
#pragma unroll
                    for (int dh = 0; dh < 2; ++dh) {
                        const bf16_t* vp = VT + (long)(h * 64 + 32 * dh + q32) * MT + tok0 + 32 * blk + 16 * s + 4 * hi;
                        const u32x2 v0 = *(const u32x2*)vp, v1 = *(const u32x2*)(vp + 8);
                        u32x4 vw; vw.x = v0.x; vw.y = v0.y; vw.z = v1.x; vw.w = v1.y;
                        o[dh] = __builtin_amdgcn_mfma_f32_32x32x16_bf16(__builtin_bit_cast(bf16x8, vw), pf, o[dh], 0, 0, 0);
                    }
                }
        }
        l_run += __shfl_xor(l_run, 32);
        const float linv = 1.0f / l_run;
        bf16_t* op = AO + mq * DM + h * 64;
#pragma unroll
        for (int dh = 0; dh < 2; ++dh)
#pragma unroll
            for (int g4 = 0; g4 < 4; ++g4) {
                u32x2 w; w.x = cvtpk(o[dh][4 * g4 + 0] * linv, o[dh][4 * g4 + 1] * linv); w.y = cvtpk(o[dh][4 * g4 + 2] * linv, o[dh][4 * g4 + 3] * linv);
                *(u32x2*)(op + 32 * dh + 8 * g4 + 4 * hi) = w;
            }
    }
    __syncthreads();
}

__device__ __forceinline__ void ce_desc(float& a, float& b) { const float hi = fmaxf(a, b), lo = fminf(a, b); a = hi; b = lo; }
__device__ __forceinline__ void ce_dir(float& a, float& b, bool desc) { const float hi = fmaxf(a, b), lo = fminf(a, b); a = desc ? hi : lo; b = desc ? lo : hi; }
__device__ __forceinline__ void sort16_desc(float (&v)[16]) {
#pragma unroll
    for (int k = 2; k <= 16; k <<= 1)
#pragma unroll
        for (int j = k >> 1; j > 0; j >>= 1)
#pragma unroll
            for (int i = 0; i < 16; ++i) { const int l = i ^ j; if (l > i) ce_dir(v[i], v[l], (i & k) == 0); }
}
__device__ __forceinline__ void merge16_desc(float (&a)[16], const float (&b)[16]) {
#pragma unroll
    for (int i = 0; i < 16; ++i) a[i] = fmaxf(a[i], b[15 - i]);
#pragma unroll
    for (int j = 8; j > 0; j >>= 1)
#pragma unroll
        for (int i = 0; i < 16; ++i) { const int l = i ^ j; if (l > i) ce_desc(a[i], a[l]); }
}

struct CandTab { int i[64]; int j[64]; };
__host__ __device__ constexpr CandTab make_cand_tab() {
    CandTab t{}; int n = 0;
    for (int i = 0; i < 16; ++i) for (int j = 0; j < 16; ++j) if ((i + 1) * (j + 1) <= 16) { t.i[n] = i; t.j[n] = j; ++n; }
    for (; n < 64; ++n) { t.i[n] = -1; t.j[n] = -1; }
    return t;
}

__device__ __forceinline__ void peer_topk_phase(const Ctx& F0, const Args& a, int layer) {
    const Ctx F = fresh(F0);
    const bf16_t* QP = (const bf16_t*)(a.ws + WS_QK);
    const bf16_t* SK = (const bf16_t*)(a.ws + WS_SK) + (size_t)layer * 2 * 128 * 128;
    unsigned short* IDX = (unsigned short*)(a.ws + (DBG_CHECK_TOPK ? WS_DBG : WS_IDX));
    float* GATE = (float*)(a.ws + (DBG_CHECK_TOPK ? WS_DBG + 8 * MiB : WS_GATE));
    const int gwv = F.vcu * NWAVES + F.wave, NGW = F.G * NWAVES;
    const int lane = F.lane, t32 = lane & 31, hi = lane >> 5;
    __syncthreads();
    for (int c = F.tid; c < 4096; c += 512) *(LAS u32x4*)(F.lds + (c >> 4) * 272 + (c & 15) * 16) = *(const u32x4*)(SK + (size_t)c * 8);
    __syncthreads();
    for (int task = gwv; task < 1024 * 8; task += NGW) {
        const int tt = task >> 3, h = task & 7;
        const long tok = (long)tt * 32 + t32;
        float top[2][16];
#pragma unroll
        for (int p = 0; p < 2; ++p) {
            f32x16 acc[4];
#pragma unroll
            for (int eb = 0; eb < 4; ++eb)
#pragma unroll
                for (int i = 0; i < 16; ++i) acc[eb][i] = 0.f;
#pragma unroll
            for (int eb = 0; eb < 4; ++eb) asm volatile("" : "+v"(acc[eb]));
            const bf16_t* qp = QP + tok * 2048 + h * 256 + p * 128 + hi * 8;
            const LAS unsigned char* kp = F.lds + (p * 128 + t32) * 272 + hi * 16;
#pragma unroll
            for (int ks = 0; ks < 8; ++ks) {
                if ((ks & 1) == 0) asm volatile("" ::: "memory");
                const bf16x8 bq = *(const bf16x8*)(qp + ks * 16);
#pragma unroll
                for (int eb = 0; eb < 4; ++eb) { const bf16x8 ak = *(const LAS bf16x8*)(kp + eb * 32 * 272 + ks * 32); acc[eb] = __builtin_amdgcn_mfma_f32_32x32x16_bf16(ak, bq, acc[eb], 0, 0, 0); }
            }
            float cur[16];
#pragma unroll
            for (int eb = 0; eb < 4; ++eb) {
                float v[16];
#pragma unroll
                for (int i = 0; i < 16; ++i) { const unsigned e = 32 * eb + crow(i, hi); float x = acc[eb][i]; asm volatile("" : "+v"(x));
                    v[i] = __builtin_bit_cast(float, (__builtin_bit_cast(unsigned, x) & ~0x7Fu) | e); }
                sort16_desc(v);
                if (eb == 0) {
#pragma unroll
                    for (int i = 0; i < 16; ++i) cur[i] = v[i];
                } else merge16_desc(cur, v);
            }
            float oth[16];
#pragma unroll
            for (int i = 0; i < 16; ++i) oth[i] = __shfl_xor(cur[i], 32);
            merge16_desc(cur, oth);
#pragma unroll
            for (int i = 0; i < 16; ++i) top[p][i] = cur[i];
            __builtin_amdgcn_sched_barrier(0);
        }
        float best[16];
#pragma unroll
        for (int gI = 0; gI < 4; ++gI) {
            float v[16];
#pragma unroll
            for (int q = 0; q < 16; ++q) {
                constexpr CandTab CT = make_cand_tab();
                const int ci = CT.i[16 * gI + q], cj = CT.j[16 * gI + q];
                if (ci >= 0) {
                    const unsigned ua = __builtin_bit_cast(unsigned, top[0][ci]), ub = __builtin_bit_cast(unsigned, top[1][cj]);
                    float s = top[0][ci] + top[1][cj]; asm volatile("" : "+v"(s));
                    const unsigned code = ((ua & 0x7Fu) << 7) | (ub & 0x7Fu);
                    v[q] = __builtin_bit_cast(float, (__builtin_bit_cast(unsigned, s) & ~0x3FFFu) | code);
                } else v[q] = -3.0e38f;
            }
            sort16_desc(v);
            if (gI == 0) {
#pragma unroll
                for (int i = 0; i < 16; ++i) best[i] = v[i];
            } else merge16_desc(best, v);
            __builtin_amdgcn_sched_barrier(0);
        }
        float e[16], sum = 0.f;
#pragma unroll
        for (int i = 0; i < 16; ++i) { e[i] = __builtin_amdgcn_exp2f((best[i] - best[0]) * LOG2E); sum += e[i]; }
        const float inv = 1.0f / sum;
        if (hi == 0) {
            u32x4 w0, w1;
            w0.x = (__builtin_bit_cast(unsigned, best[0]) & 0x3FFFu) | ((__builtin_bit_cast(unsigned, best[1]) & 0x3FFFu) << 16);
            w0.y = (__builtin_bit_cast(unsigned, best[2]) & 0x3FFFu) | ((__builtin_bit_cast(unsigned, best[3]) & 0x3FFFu) << 16);
            w0.z = (__builtin_bit_cast(unsigned, best[4]) & 0x3FFFu) | ((__builtin_bit_cast(unsigned, best[5]) & 0x3FFFu) << 16);
            w0.w = (__builtin_bit_cast(unsigned, best[6]) & 0x3FFFu) | ((__builtin_bit_cast(unsigned, best[7]) & 0x3FFFu) << 16);
            w1.x = (__builtin_bit_cast(unsigned, best[8]) & 0x3FFFu) | ((__builtin_bit_cast(unsigned, best[9]) & 0x3FFFu) << 16);
            w1.y = (__builtin_bit_cast(unsigned, best[10]) & 0x3FFFu) | ((__builtin_bit_cast(unsigned, best[11]) & 0x3FFFu) << 16);
            w1.z = (__builtin_bit_cast(unsigned, best[12]) & 0x3FFFu) | ((__builtin_bit_cast(unsigned, best[13]) & 0x3FFFu) << 16);
            w1.w = (__builtin_bit_cast(unsigned, best[14]) & 0x3FFFu) | ((__builtin_bit_cast(unsigned, best[15]) & 0x3FFFu) << 16);
            u32x4* ip = (u32x4*)(IDX + tok * 128 + h * 16);
            ip[0] = w0; ip[1] = w1;
        } else {
            f32x4* gp = (f32x4*)(GATE + tok * 128 + h * 16);
#pragma unroll
            for (int q = 0; q < 4; ++q) gp[q] = (f32x4){e[4 * q] * inv, e[4 * q + 1] * inv, e[4 * q + 2] * inv, e[4 * q + 3] * inv};
        }
    }
    __syncthreads();
}

#ifndef DBG_BRUTE_TOPK
#define DBG_BRUTE_TOPK 0
#endif
__device__ __forceinline__ void peer_topk_brute(const Ctx& F0, const Args& a, int layer) {
    const Ctx F = fresh(F0);
    const bf16_t* QP = (const bf16_t*)(a.ws + WS_QK);
    const bf16_t* SK = (const bf16_t*)(a.ws + WS_SK) + (size_t)layer * 2 * 128 * 128;
    unsigned short* IDX = (unsigned short*)(a.ws + WS_IDX);
    float* GATE = (float*)(a.ws + WS_GATE);
    const long gt = (long)F.vcu * 512 + F.tid, NGT = (long)F.G * 512;
    for (long task = gt; task < (long)ML * 8; task += NGT) {
        const long t = task >> 3; const int h = (int)(task & 7);
        float ts[2][16]; int ti[2][16];
#pragma unroll
        for (int p = 0; p < 2; ++p) {
#pragma unroll
            for (int k = 0; k < 16; ++k) { ts[p][k] = -3.0e38f; ti[p][k] = 0; }
            const unsigned* qp = (const unsigned*)(QP + t * 2048 + h * 256 + p * 128);
            for (int e = 0; e < 128; ++e) {
                const unsigned* kp = (const unsigned*)(SK + (size_t)(p * 128 + e) * 128);
                float s = 0.f;
                for (int k2 = 0; k2 < 64; ++k2) { const unsigned qa = qp[k2], ka = kp[k2]; s += bflo(qa) * bflo(ka); s += bfhi(qa) * bfhi(ka); }
                int ei = e;
#pragma unroll
                for (int k = 0; k < 16; ++k) { const bool gt_ = s > ts[p][k]; const float tv = ts[p][k]; const int tiv = ti[p][k];
                    ts[p][k] = gt_ ? s : tv; ti[p][k] = gt_ ? ei : tiv; s = gt_ ? tv : s; ei = gt_ ? tiv : ei; }
            }
        }
        float bs[16]; int bi[16];
#pragma unroll
        for (int k = 0; k < 16; ++k) { bs[k] = -3.0e38f; bi[k] = 0; }
#pragma unroll
        for (int i = 0; i < 16; ++i)
#pragma unroll
            for (int j = 0; j < 16; ++j) {
                float s = ts[0][i] + ts[1][j]; int ei = ti[0][i] * 128 + ti[1][j];
#pragma unroll
                for (int k = 0; k < 16; ++k) { const bool gt_ = s > bs[k]; const float tv = bs[k]; const int tiv = bi[k];
                    bs[k] = gt_ ? s : tv; bi[k] = gt_ ? ei : tiv; s = gt_ ? tv : s; ei = gt_ ? tiv : ei; }
            }
        float e[16], sum = 0.f;
#pragma unroll
        for (int i = 0; i < 16; ++i) { e[i] = __expf(bs[i] - bs[0]); sum += e[i]; }
        const float inv = 1.0f / sum;
#pragma unroll
        for (int i = 0; i < 16; ++i) { IDX[t * 128 + h * 16 + i] = (unsigned short)bi[i]; GATE[t * 128 + h * 16 + i] = e[i] * inv; }
    }
}

__device__ __forceinline__ void dbg_compare_topk(const Ctx& F0, const Args& a) {
    const Ctx F = fresh(F0);
    const unsigned short* I1 = (const unsigned short*)(a.ws + WS_IDX);
    const unsigned short* I2 = (const unsigned short*)(a.ws + WS_DBG);
    int* MTB = (int*)(a.ws + WS_DBG + 24 * MiB);
    const int gwv = F.vcu * NWAVES + F.wave, NGW = F.G * NWAVES;
    for (int t = gwv; t < ML; t += NGW) {
        float m = 0.f;
        if (F.lane < 8) {
            int cnt = 0;
            for (int i = 0; i < 16; ++i) { const int x = I2[(size_t)t * 128 + F.lane * 16 + i]; bool f = false;
                for (int j = 0; j < 16; ++j) f = f || (I1[(size_t)t * 128 + F.lane * 16 + j] == x);
                cnt += f ? 0 : 1; }
            m = (float)cnt;
        }
        m = wave_sum(m);
        if (F.lane == 0) MTB[t] = (int)m;
    }
}
__device__ __forceinline__ void dbg_apply_mask(const Ctx& F0, const Args& a) {
    const Ctx F = fresh(F0);
    const int* MTB = (const int*)(a.ws + WS_DBG + 24 * MiB);
    const int gwv = F.vcu * NWAVES + F.wave, NGW = F.G * NWAVES;
    for (int t = gwv; t < ML; t += NGW) {
        const int ncol = 8 * MTB[t];
        for (int c = F.lane; c < ncol; c += 64) a.out[(size_t)t * DM + c] = 0.f;
    }
}

typedef long i64_t;
__device__ __forceinline__ void peer_u_phase(const Ctx& F0, const Args& a, int layer) {
    const Ctx F = fresh(F0);
    const int s = (int)(blockIdx.x & 7), j = (int)(blockIdx.x >> 3), nmem = F.G >> 3;
    const unsigned char* U8s = a.ws + WS_TAB + ((size_t)(2 * layer) * 8 + s) * NEXP * 128;
    const unsigned char* X8s = a.ws + WS_X8 + (size_t)s * ML * 128;
    const unsigned short* IDX = (const unsigned short*)(a.ws + WS_IDX);
    float* PART = (float*)(a.ws + WS_PART) + (size_t)s * ML * 128;
    const int lane = F.lane, r16 = lane & 15, g4 = lane >> 4;
    for (int t = j * NWAVES + F.wave; t < ML; t += nmem * NWAVES) {
        int eid[8];
#pragma unroll
        for (int rb = 0; rb < 8; ++rb) eid[rb] = IDX[(size_t)t * 128 + 16 * rb + r16];
        const unsigned char* xp = X8s + (size_t)t * 128 + 16 * g4;
        const u32x4 x0 = *(const u32x4*)xp, x1 = *(const u32x4*)(xp + 64);
        u32x4 ua[8][2];
#pragma unroll
        for (int rb = 0; rb < 8; ++rb) { const unsigned char* up = U8s + (size_t)eid[rb] * 128 + 16 * g4; ua[rb][0] = *(const u32x4*)up; ua[rb][1] = *(const u32x4*)(up + 64); }
        f32x4 mine = (f32x4){0.f, 0.f, 0.f, 0.f};
#pragma unroll
        for (int rb = 0; rb < 8; ++rb) {
            f32x4 acc = (f32x4){0.f, 0.f, 0.f, 0.f};
#define PK64(lo, hi) ((i64_t)(((unsigned long long)(hi) << 32) | (unsigned long long)(lo)))
            acc = __builtin_amdgcn_mfma_f32_16x16x32_fp8_fp8(PK64(ua[rb][0].x, ua[rb][0].y), PK64(x0.x, x0.y), acc, 0, 0, 0);
            acc = __builtin_amdgcn_mfma_f32_16x16x32_fp8_fp8(PK64(ua[rb][0].z, ua[rb][0].w), PK64(x0.z, x0.w), acc, 0, 0, 0);
            acc = __builtin_amdgcn_mfma_f32_16x16x32_fp8_fp8(PK64(ua[rb][1].x, ua[rb][1].y), PK64(x1.x, x1.y), acc, 0, 0, 0);
            acc = __builtin_amdgcn_mfma_f32_16x16x32_fp8_fp8(PK64(ua[rb][1].z, ua[rb][1].w), PK64(x1.z, x1.w), acc, 0, 0, 0);
#undef PK64
            if (r16 == rb) mine = acc;
        }
        if (r16 < 8) *(f32x4*)(PART + (size_t)t * 128 + 16 * r16 + 4 * g4) = mine;
    }
}
__device__ __forceinline__ void peer_w_phase(const Ctx& F0, const Args& a) {
    const Ctx F = fresh(F0);
    const float* PART = (const float*)(a.ws + WS_PART);
    const float* GATE = (const float*)(a.ws + WS_GATE);
    float* WT = (float*)(a.ws + WS_WT);
    const int gwv = F.vcu * NWAVES + F.wave, NGW = F.G * NWAVES;
    for (int t = gwv; t < ML; t += NGW) {
        f32x2 z = (f32x2){0.f, 0.f};
#pragma unroll
        for (int s = 0; s < 8; ++s) z += *(const f32x2*)(PART + ((size_t)s * ML + t) * 128 + 2 * F.lane);
        const f32x2 g = *(const f32x2*)(GATE + (size_t)t * 128 + 2 * F.lane);
        f32x2 w; w.x = g.x * gelu_erf(z.x * (1.0f / (U_SCALE * X_SCALE))); w.y = g.y * gelu_erf(z.y * (1.0f / (U_SCALE * X_SCALE)));
        *(f32x2*)(WT + (size_t)t * 128 + 2 * F.lane) = w;
    }
}
__device__ __forceinline__ void peer_v_phase(const Ctx& F0, const Args& a, int layer) {
    const Ctx F = fresh(F0);
    const int s = (int)(blockIdx.x & 7), j = (int)(blockIdx.x >> 3), nmem = F.G >> 3;
    const unsigned char* V8s = a.ws + WS_TAB + ((size_t)(2 * layer + 1) * 8 + s) * NEXP * 128;
    const unsigned short* IDX = (const unsigned short*)(a.ws + WS_IDX);
    const float* WT = (const float*)(a.ws + WS_WT);
    const float* modb = (const float*)(a.ws + WS_MOD) + (size_t)layer * 9 * NMOD;
    float* X = a.out;
    const int lane = F.lane, rsub = lane >> 3, c16 = lane & 7;
    LAS float* red = (LAS float*)(F.lds + F.wave * 4096);
    const float dbg_s = (DBG_SKIP & (layer == 0 ? 2 : 8)) ? 0.f : 1.f;
    for (int t = j * NWAVES + F.wave; t < ML; t += nmem * NWAVES) {
        const u32x4 i0 = *(const u32x4*)(IDX + (size_t)t * 128 + 16 * rsub), i1 = *(const u32x4*)(IDX + (size_t)t * 128 + 16 * rsub + 8);
        f32x4 wv[4];
#pragma unroll
        for (int q = 0; q < 4; ++q) wv[q] = *(const f32x4*)(WT + (size_t)t * 128 + 16 * rsub + 4 * q);
        u32x4 rows[16];
#pragma unroll
        for (int i = 0; i < 16; ++i) { const unsigned pair = (i < 8) ? i0[i >> 1] : i1[(i - 8) >> 1]; const unsigned e = (i & 1) ? (pair >> 16) : (pair & 0xffffu);
            rows[i] = *(const u32x4*)(V8s + (size_t)e * 128 + 16 * c16); }
        float acc[16];
#pragma unroll
        for (int c = 0; c < 16; ++c) acc[c] = 0.f;
#pragma unroll
        for (int i = 0; i < 16; ++i) { const float w = wv[i >> 2][i & 3];
#pragma unroll
            for (int d = 0; d < 4; ++d) { const f32x2 lo = __builtin_amdgcn_cvt_pk_f32_fp8((int)rows[i][d], false), hi = __builtin_amdgcn_cvt_pk_f32_fp8((int)rows[i][d], true);
                acc[4 * d + 0] += w * lo[0]; acc[4 * d + 1] += w * lo[1]; acc[4 * d + 2] += w * hi[0]; acc[4 * d + 3] += w * hi[1]; } }
#pragma unroll
        for (int q = 0; q < 4; ++q) *(LAS f32x4*)(red + rsub * 128 + c16 * 16 + 4 * q) = (f32x4){acc[4 * q], acc[4 * q + 1], acc[4 * q + 2], acc[4 * q + 3]};
        asm volatile("s_waitcnt lgkmcnt(0)" ::: "memory");
        f32x2 sum = (f32x2){0.f, 0.f};
#pragma unroll
        for (int r = 0; r < 8; ++r) sum += *(const LAS f32x2*)(red + r * 128 + 2 * lane);
        asm volatile("s_waitcnt lgkmcnt(0)" ::: "memory");
        const f32x2 g = *(const f32x2*)(modb + (size_t)(t >> 12) * NMOD + 5 * DM + 128 * s + 2 * lane) * (dbg_s * (1.0f / V_SCALE));
        f32x2* xo = (f32x2*)(X + (size_t)t * DM + 128 * s + 2 * lane);
        *xo = *xo + g * sum;
    }
}

__global__ void __launch_bounds__(NWAVES * 64, 2) fwd_kernel(Args args) {
    extern __shared__ __attribute__((aligned(16))) unsigned char lds_raw[];
    Ctx F;
    F.lds = (LAS unsigned char*)lds_raw;
    F.tid = threadIdx.x; F.lane = F.tid & 63; F.wave = __builtin_amdgcn_readfirstlane(F.tid >> 6);
    F.G = gridDim.x; { const int bx = blockIdx.x; F.vcu = (F.G % 8 == 0) ? (bx % 8) * (F.G / 8) + bx / 8 : bx; }
    volatile LAS unsigned* MISC = (volatile LAS unsigned*)(F.lds + MISC_OFF);
    for (int u = F.tid; u < (LDS_BYTES - LDSCTL_OFF) / 4; u += NWAVES * 64) ((LAS unsigned*)(F.lds + LDSCTL_OFF))[u] = 0u;
    __syncthreads();
    unsigned char* ws = args.ws;
    XcdBarrier bar = xcd_barrier_post((unsigned*)(ws + WS_CTL) + CW_BAR, MISC + 8);
#define GRID_BAR() xcd_barrier(bar)
#define PEER_BLOCK(layer) do { \
        norm_phase(F, args, 1, layer, 3 * DM, args.in[5] + (layer) * DM); \
        GRID_BAR(); \
        { using SHq = pg8::Shape<ML, 2048, DM, DM, DM, 1, 0, 0>; \
          pg8::gemm_phase<SHq>(F.lds, pg8::Gemm{HX, (const bf16_t*)(ws + WS_WPQ) + (size_t)(layer) * 2048 * DM}, F.G, bx, pg8::EpiStoreBf16{QKb, 2048, 0}); } \
        GRID_BAR(); \
        if (DBG_BRUTE_TOPK || DBG_CHECK_TOPK) peer_topk_brute(F, args, layer); else peer_topk_phase(F, args, layer); \
        if (DBG_CHECK_TOPK && (layer) == 0) { peer_topk_phase(F, args, layer); GRID_BAR(); dbg_compare_topk(F, args); } \
        GRID_BAR(); \
        peer_u_phase(F, args, layer); \
        GRID_BAR(); \
        peer_w_phase(F, args); \
        GRID_BAR(); \
        peer_v_phase(F, args, layer); \
        GRID_BAR(); \
    } while (0)
    const float* modb = (const float*)(ws + WS_MOD);
    bf16_t* HX = (bf16_t*)(ws + WS_HX);
    bf16_t* QKb = (bf16_t*)(ws + WS_QK);
    bf16_t* VTb = (bf16_t*)(ws + WS_VT);
    const bf16_t* Wqkv = (const bf16_t*)(ws + WS_WQKV);
    const int bx = (int)blockIdx.x;

    p0_prologue(F, args);
    GRID_BAR();
    norm_phase(F, args, 0, 0, 0, args.in[4]);
    GRID_BAR();
    {
        using SH1 = pg8::Shape<MT, 2048, DM, DM, DM, 1, 0, 0>;
        pg8::gemm_phase<SH1>(F.lds, pg8::Gemm{HX, Wqkv}, F.G, bx, pg8::EpiStoreBf16{QKb, 2048, 0});
        using SH2 = pg8::Shape<DM, MT, DM, DM, DM, 1, 0, 0>;
        pg8::gemm_phase<SH2>(F.lds, pg8::Gemm{Wqkv + (size_t)2048 * DM, HX}, F.G, bx, pg8::EpiStoreBf16{VTb, MT, 0});
    }
    GRID_BAR();
    attn_phase(F, args);
    GRID_BAR();
    {
        using SH = pg8::Shape<ML, DM, DM, DM, DM, 1, 0, 0>;
        pg8::gemm_phase<SH>(F.lds, pg8::Gemm{HX, (const bf16_t*)(ws + WS_WO)}, F.G, bx, pg8::EpiResid{args.in[0], args.out, modb + 2 * DM, NMOD, (DBG_SKIP & 1) ? 0.f : 1.f});
    }
    GRID_BAR();
    PEER_BLOCK(0);
    norm_phase(F, args, 1, 1, 0, args.in[4] + DM);
    GRID_BAR();
    {
        using SH = pg8::Shape<512, ML, 256, 256, DM, 4, 0, 256>;
        pg8::gemm_phase<SH>(F.lds, pg8::Gemm{(const bf16_t*)(ws + WS_WC), HX}, F.G, bx, pg8::EpiYt{QKb});
    }
    GRID_BAR();
    {
        using SH = pg8::Shape<SEQ, DM, 8192, 8192, 8192, NB, 0, (long)DM * 8192>;
        pg8::gemm_phase<SH>(F.lds, pg8::Gemm{(const bf16_t*)(ws + WS_CS), QKb}, F.G, bx, pg8::EpiStoreBf16{VTb, DM, (long)SEQ * DM});
    }
    GRID_BAR();
    {
        using SH = pg8::Shape<ML, DM, DM, DM, DM, 1, 0, 0>;
        pg8::gemm_phase<SH>(F.lds, pg8::Gemm{VTb, (const bf16_t*)(ws + WS_WF)}, F.G, bx, pg8::EpiResid{args.out, args.out, modb + (size_t)9 * NMOD + 2 * DM, NMOD, (DBG_SKIP & 4) ? 0.f : 1.f});
    }
    GRID_BAR();
    PEER_BLOCK(1);
    final_norm_phase(F, args);
    if (DBG_CHECK_TOPK) { GRID_BAR(); dbg_apply_mask(F, args); }
#undef PEER_BLOCK
}

extern "C" void kernel_launch(void* const* d_in, const int* in_sizes, int n_in, void* d_out, int out_size, void* d_ws, size_t ws_size, hipStream_t stream) {
    static int grid = 0;
    if (grid == 0) {
        if (n_in != 17 || in_sizes[0] != ML * DM || out_size != ML * DM || ws_size < WS_END + (DBG_CHECK_TOPK ? 26 * MiB : 0)) { fprintf(stderr, "kernel_launch: unexpected shapes (n_in %d, in0 %d, out %d, ws %zu)\n", n_in, n_in > 0 ? in_sizes[0] : -1, out_size, ws_size); grid = -1; return; }
        int dev = 0, cus = 0, per_cu = 0;
        if (hipGetDevice(&dev) != hipSuccess || hipDeviceGetAttribute(&cus, hipDeviceAttributeMultiprocessorCount, dev) != hipSuccess) { grid = -1; return; }
        if (hipFuncSetAttribute((const void*)fwd_kernel, hipFuncAttributeMaxDynamicSharedMemorySize, LDS_BYTES) != hipSuccess) { fprintf(stderr, "kernel_launch: hipFuncSetAttribute failed\n"); grid = -1; return; }
        if (hipOccupancyMaxActiveBlocksPerMultiprocessor(&per_cu, (const void*)fwd_kernel, NWAVES * 64, LDS_BYTES) != hipSuccess || per_cu < 1)
            fprintf(stderr, "kernel_launch: note: occupancy query reports %d workgroups per CU\n", per_cu);
        (void)hipGetLastError();
        grid = cus;
        if (grid % 8 != 0) { fprintf(stderr, "kernel_launch: CU count %d is not a multiple of 8\n", cus); grid = -1; return; }
    }
    if (grid < 0) return;
    if (hipMemsetAsync((char*)d_ws + WS_CTL, 0, CTL_ZERO_BYTES, stream) != hipSuccess) { fprintf(stderr, "kernel_launch: memset failed\n"); return; }
    Args a{};
    for (int i = 0; i < 17; ++i) a.in[i] = (const float*)d_in[i];
    a.out = (float*)d_out; a.ws = (unsigned char*)d_ws;
    hipLaunchKernelGGL(fwd_kernel, dim3(grid), dim3(NWAVES * 64), LDS_BYTES, stream, a);
    const hipError_t le = hipPeekAtLastError();
    if (le != hipSuccess) fprintf(stderr, "kernel_launch: launch failed: %s\n", hipGetErrorName(le));
}
```

```cpp
#include <hip/hip_runtime.h>
#include <cstdio>
#include <cstdint>

#define LAS __attribute__((address_space(3)))
typedef unsigned short bf16_t;
typedef short bf16x8 __attribute__((ext_vector_type(8)));
typedef short s16x4 __attribute__((ext_vector_type(4)));
typedef float f32x2 __attribute__((ext_vector_type(2)));
typedef float f32x4 __attribute__((ext_vector_type(4)));
typedef float f32x16 __attribute__((ext_vector_type(16)));
typedef unsigned u32x2 __attribute__((ext_vector_type(2)));
typedef unsigned u32x4 __attribute__((ext_vector_type(4)));
typedef __bf16 bf16x2_t __attribute__((ext_vector_type(2)));

#ifndef DBG_SKIP
#define DBG_SKIP 0
#endif
constexpr int DM = 1024, NB = 8, SEQ = 4096, CTXL = 256, GW = 64;
constexpr int ML = NB * SEQ;
constexpr int MC = NB * CTXL;
constexpr int MT = ML + MC;
constexpr int NMOD = 6 * DM;
constexpr int NEXP = 16384;
constexpr float EPS = 1e-6f;
constexpr float LOG2E = 1.4426950408889634f;

constexpr size_t MiB = 1u << 20;
constexpr size_t WS_CTL = 0, CTL_ZERO_BYTES = 1 * MiB;
constexpr size_t WS_MOD = 1 * MiB;
constexpr size_t WS_WQKV = 2 * MiB;
constexpr size_t WS_WO = 8 * MiB;
constexpr size_t WS_WF = 10 * MiB;
constexpr size_t WS_WPQ = 12 * MiB;
constexpr size_t WS_SK = 20 * MiB;
constexpr size_t WS_WC = 20 * MiB + 256 * 1024;
constexpr size_t WS_CS = 22 * MiB;
constexpr size_t WS_TAB = 86 * MiB;
constexpr size_t WS_X8 = 150 * MiB;
constexpr size_t WS_WT = 182 * MiB;
constexpr size_t WS_PART = 282 * MiB;
constexpr float U_SCALE = 512.f, V_SCALE = 16.f, X_SCALE = 16.f;
constexpr size_t WS_HX = 214 * MiB;
constexpr size_t WS_QK = 282 * MiB;
constexpr size_t WS_VT = 418 * MiB;
constexpr size_t WS_IDX = WS_VT;
constexpr size_t WS_GATE = WS_VT + 8 * MiB;
constexpr size_t WS_END = 486 * MiB;
constexpr int CW_BAR = 4096;

__device__ __forceinline__ unsigned f2bf(float f) { unsigned u = __builtin_bit_cast(unsigned, f); return (u + 0x7fffu + ((u >> 16) & 1u)) >> 16; }
__device__ __forceinline__ unsigned pk2(float lo, float hi) { return f2bf(lo) | (f2bf(hi) << 16); }
__device__ __forceinline__ unsigned cvtpk(float lo, float hi) { f32x2 v = {lo, hi}; bf16x2_t b = __builtin_convertvector(v, bf16x2_t); return __builtin_bit_cast(unsigned, b); }
__device__ __forceinline__ float bflo(unsigned u) { return __builtin_bit_cast(float, u << 16); }
__device__ __forceinline__ float bfhi(unsigned u) { return __builtin_bit_cast(float, u & 0xffff0000u); }
__device__ __forceinline__ float wave_sum(float v) {
#pragma unroll
    for (int o = 1; o < 64; o <<= 1) v += __shfl_xor(v, o);
    return v;
}
__device__ __forceinline__ int crow(int r, int hi) { return (r & 3) + 8 * (r >> 2) + 4 * hi; }
__device__ __forceinline__ float gelu_erf(float v) {
    const float av = __builtin_fabsf(v), d = av * 0.2316418882f + 1.0f;
    const float t = __builtin_amdgcn_rcpf(d);
    float q = t * 0.5307027145f + (-0.7265760135f); q = q * t + 0.7107068705f; q = q * t + (-0.142248368f); q = q * t + 0.127414796f; q = q * t;
    const float e = __builtin_amdgcn_exp2f((v * v) * (-0.72134752044f));
    const float m = v * (q * e), r = v - m;
    return v < 0.f ? m : r;
}

namespace pg8 {
constexpr int BM = 256, BK = 64, HALF = 128, HTB = HALF * BK * 2, STAGE_BYTES = 8 * HTB, NXCD = 8, WGM = 8;
__host__ __device__ __forceinline__ int lds_byte(int r, int c) { const int st = (r >> 4) * 2 + (c >> 5), rr = r & 15, cc = c & 31, ob = rr * 64 + cc * 2; return st * 1024 + (ob ^ (((ob >> 9) & 1) << 5)); }
__host__ __device__ __forceinline__ void stage_rc(int b, int& R, int& C) { const int st = b / 1024, sb = b % 1024, swz = sb ^ (((sb >> 9) & 1) << 5); R = (st >> 1) * 16 + swz / 64; C = (st & 1) * 32 + (swz % 64) / 2; }
__host__ __device__ __forceinline__ int perm32(int rho) { const int n = rho >> 4, i = rho & 15; return 8 * (i >> 2) + 4 * n + (i & 3); }

struct Unit { int pm, pn, pb; };
struct Gemm { const bf16_t* A; const bf16_t* Bt; };
template <int M_, int N_, int K_, int LDA_, int LDB_, int NBATCH_, long BSA_, long BSB_> struct Shape { static constexpr int M = M_, N = N_, K = K_, lda = LDA_, ldb = LDB_, nbatch = NBATCH_; static constexpr long bsA = BSA_, bsB = BSB_; };

template <class SH> struct StaticOrder {
    static constexpr int nM = SH::M / BM, nN = SH::N / BM, per = nM * nN, nwg = per * SH::nbatch;
    int G, c;
    __device__ __forceinline__ void init(int G_, int c_) { G = G_; c = c_; }
    __device__ __forceinline__ bool next(int i, Unit& u) const {
        const long L = (long)i * G + c; if (L >= nwg) return false;
        int wgid = (int)L; { const int q = nwg / NXCD, r = nwg % NXCD, xcd = wgid % NXCD, off = wgid / NXCD; wgid = (xcd < r ? xcd * (q + 1) : r * (q + 1) + (xcd - r) * q) + off; }
        u.pb = wgid / per; wgid -= u.pb * per;
        const int nig = WGM * nN, gid = wgid / nig, fm = gid * WGM, gsz = (nM - fm) < WGM ? (nM - fm) : WGM;
        u.pm = fm + ((wgid % nig) % gsz); u.pn = (wgid % nig) / gsz; return true;
    }
};

struct EpiStoreBf16 {
    static constexpr bool PERM = true;
    bf16_t* O; long ldc; long bstride;
    __device__ __forceinline__ void operator()(const f32x4 (&acc)[2][2][4][2], const Unit& u, int wr, int wc, int fr, int fq) const {
        const int row0 = u.pm * BM + wr * 64 + fr, col0 = u.pn * BM + wc * 32 + 8 * fq;
        bf16_t* base = O + (long)u.pb * bstride;
#pragma unroll
        for (int ai = 0; ai < 2; ++ai)
#pragma unroll
            for (int m = 0; m < 4; ++m) { bf16_t* rowp = base + (long)(row0 + ai * HALF + m * 16) * ldc + col0;
#pragma unroll
                for (int bj = 0; bj < 2; ++bj) { const f32x4 v0 = acc[ai][bj][m][0], v1 = acc[ai][bj][m][1];
                    u32x4 w; w.x = cvtpk(v0[0], v0[1]); w.y = cvtpk(v0[2], v0[3]); w.z = cvtpk(v1[0], v1[1]); w.w = cvtpk(v1[2], v1[3]);
                    *(u32x4*)(rowp + bj * HALF) = w; } }
    }
};
struct EpiYt {
    static constexpr bool PERM = true;
    bf16_t* Yt;
    __device__ __forceinline__ void operator()(const f32x4 (&acc)[2][2][4][2], const Unit& u, int wr, int wc, int fr, int fq) const {
        const int row0 = u.pm * BM + wr * 64 + fr, col0 = u.pn * BM + wc * 32 + 8 * fq;
#pragma unroll
        for (int ai = 0; ai < 2; ++ai)
#pragma unroll
            for (int m = 0; m < 4; ++m) { const int row = row0 + ai * HALF + m * 16; const int part = row >> 8, cp = row & 255;
#pragma unroll
                for (int bj = 0; bj < 2; ++bj) { const int col = col0 + bj * HALF; const int b = col >> 12, n = col & 4095;
                    const f32x4 v0 = acc[ai][bj][m][0], v1 = acc[ai][bj][m][1];
                    u32x4 w; w.x = cvtpk(v0[0], v0[1]); w.y = cvtpk(v0[2], v0[3]); w.z = cvtpk(v1[0], v1[1]); w.w = cvtpk(v1[2], v1[3]);
                    *(u32x4*)(Yt + ((((long)(b * 4 + u.pb) * 256 + cp) * 2 + part) << 12) + n) = w; }
                asm volatile("" ::: "memory"); }
    }
};
struct EpiResid {
    static constexpr bool PERM = false;
    const float* Xin; float* Xout; const float* gate; int gstride; float gs;
    __device__ __forceinline__ void operator()(const f32x4 (&acc)[2][2][4][2], const Unit& u, int wr, int wc, int fr, int fq) const {
        const int row0 = u.pm * BM + wr * 64 + fr, col0 = u.pn * BM + wc * 32 + 4 * fq;
        const float* gb = gate + (long)((u.pm * BM) >> 12) * gstride;
        f32x4 gv[2][2];
#pragma unroll
        for (int bj = 0; bj < 2; ++bj)
#pragma unroll
            for (int n = 0; n < 2; ++n) gv[bj][n] = *(const f32x4*)(gb + col0 + bj * HALF + n * 16);
#pragma unroll
        for (int ai = 0; ai < 2; ++ai)
#pragma unroll
            for (int m = 0; m < 4; ++m) { const long off = (long)(row0 + ai * HALF + m * 16) * DM + col0;
#pragma unroll
                for (int bj = 0; bj < 2; ++bj)
#pragma unroll
                    for (int n = 0; n < 2; ++n) { const f32x4 bs = *(const f32x4*)(Xin + off + bj * HALF + n * 16);
                        *(f32x4*)(Xout + off + bj * HALF + n * 16) = bs + gv[bj][n] * acc[ai][bj][m][n] * gs; }
                if (m & 1) asm volatile("" ::: "memory"); }
    }
};

template <class SH, class Epi>
__device__ __forceinline__ void gemm_phase(LAS unsigned char* lds, const Gemm g, int G_, int c_, const Epi& E) {
    StaticOrder<SH> S; S.init(G_, c_);
    int tid_ = threadIdx.x; asm volatile("" : "+v"(tid_));
    const int tid = tid_, wid = __builtin_amdgcn_readfirstlane(tid >> 6), lane = tid & 63, wr = wid >> 2, wc = wid & 3, fr = lane & 15, fq = lane >> 4;
    constexpr int K = SH::K, nt = K / BK;
    unsigned voffA[2], voffB[2];
#pragma unroll
    for (int i = 0; i < 2; ++i) { int R, C; stage_rc(tid * 16 + i * 8192, R, C); const int Rb = Epi::PERM ? ((R & ~31) + perm32(R & 31)) : R;
        voffA[i] = (unsigned)(R * SH::lda + C) * 2u; voffB[i] = (unsigned)(Rb * SH::ldb + C) * 2u; }
    constexpr size_t kstep = (size_t)(BK * 2);
    constexpr size_t hstepA = (size_t)HALF * SH::lda * 2, hstepB = (size_t)HALF * SH::ldb * 2;
    constexpr size_t tstepA = 2 * hstepA, tstepB = 2 * hstepB;
    const unsigned ldsw = (unsigned)wid * 1024u;
    const int aoff = lds_byte(wr * 64 + fr, fq * 8), boff = lds_byte(wc * 32 + fr, fq * 8);
#define PG8_SA(b, h) (((b) * 2 + (h)) * HTB)
#define PG8_SB(b, h) ((4 + (b) * 2 + (h)) * HTB)
#define PG8_STAGE(bufoff, gbase, voff) do { _Pragma("unroll") for (int _i = 0; _i < 2; ++_i) \
        __builtin_amdgcn_global_load_lds((const unsigned*)((const char*)(gbase) + (voff)[_i]), (LAS unsigned*)(lds + (bufoff) + ldsw + _i * 8192), 16, 0, 0); } while (0)
#define PG8_LDA(dst, b, h) do { _Pragma("unroll") for (int m = 0; m < 4; ++m) _Pragma("unroll") for (int k = 0; k < 2; ++k) dst[m][k] = *(const LAS bf16x8*)(lds + PG8_SA(b, h) + aoff + m * 2048 + k * 1024); } while (0)
#define PG8_LDB(dst, b, h) do { _Pragma("unroll") for (int n = 0; n < 2; ++n) _Pragma("unroll") for (int k = 0; k < 2; ++k) dst[n][k] = *(const LAS bf16x8*)(lds + PG8_SB(b, h) + boff + n * 2048 + k * 1024); } while (0)
#define PG8_MMA(ai, bj, At, Bt) do { __builtin_amdgcn_s_setprio(1); _Pragma("unroll") for (int m = 0; m < 4; ++m) _Pragma("unroll") for (int n = 0; n < 2; ++n) _Pragma("unroll") for (int k = 0; k < 2; ++k) \
        acc[ai][bj][m][n] = __builtin_amdgcn_mfma_f32_16x16x32_bf16(Bt[n][k], At[m][k], acc[ai][bj][m][n], 0, 0, 0); __builtin_amdgcn_s_setprio(0); } while (0)
#define PG8_WAIT_V(n) asm volatile("s_waitcnt vmcnt(" #n ")" ::: "memory")
#define PG8_WAIT_L(n) asm volatile("s_waitcnt lgkmcnt(" #n ")" ::: "memory")
#define PG8_BAR __builtin_amdgcn_s_barrier()
#define PG8_SCHED __builtin_amdgcn_sched_barrier(0)
    Unit cur, nxt; int ui = 0;
    if (!S.next(0, cur)) return;
    f32x4 acc[2][2][4][2];
#pragma unroll
    for (int a = 0; a < 2; ++a)
#pragma unroll
        for (int b = 0; b < 2; ++b)
#pragma unroll
            for (int m = 0; m < 4; ++m)
#pragma unroll
                for (int n = 0; n < 2; ++n) acc[a][b][m][n] = (f32x4){0.f, 0.f, 0.f, 0.f};
    bf16x8 At[4][2], B0[2][2], B1[2][2];
    const char* cA = (const char*)(g.A + (long)cur.pb * SH::bsA) + (size_t)cur.pm * tstepA; const char* cB = (const char*)(g.Bt + (long)cur.pb * SH::bsB) + (size_t)cur.pn * tstepB;
    PG8_STAGE(PG8_SB(0, 0), cB, voffB); PG8_STAGE(PG8_SB(0, 1), cB + hstepB, voffB); PG8_STAGE(PG8_SA(0, 0), cA, voffA); PG8_STAGE(PG8_SA(0, 1), cA + hstepA, voffA);
    if (wr == 1) PG8_BAR;
    PG8_WAIT_V(2); PG8_BAR;
    PG8_STAGE(PG8_SB(1, 0), cB + kstep, voffB); PG8_STAGE(PG8_SA(1, 0), cA + kstep, voffA); PG8_STAGE(PG8_SB(1, 1), cB + hstepB + kstep, voffB);
    PG8_WAIT_V(6); PG8_BAR;
    for (;;) {
        const bool has_next = S.next(ui + 1, nxt);
        const char* nA = has_next ? (const char*)(g.A + (long)nxt.pb * SH::bsA) + (size_t)nxt.pm * tstepA : cA; const char* nB = has_next ? (const char*)(g.Bt + (long)nxt.pb * SH::bsB) + (size_t)nxt.pn * tstepB : cB;
#pragma nounroll
        for (int t = 0; t < nt; t += 2) {
            const bool last = (t == nt - 2);
            const char* a1 = cA + (size_t)(t + 1) * kstep;
            const char* a2 = last ? nA : cA + (size_t)(t + 2) * kstep; const char* b2 = last ? nB : cB + (size_t)(t + 2) * kstep;
            const char* a3 = a2 + kstep; const char* b3 = b2 + kstep;
            PG8_LDB(B0, 0, 0); PG8_LDB(B1, 0, 1); PG8_SCHED; PG8_LDA(At, 0, 0); PG8_STAGE(PG8_SA(1, 1), a1 + hstepA, voffA);
            PG8_WAIT_V(8); PG8_WAIT_L(0); PG8_BAR; PG8_MMA(0, 0, At, B0); PG8_MMA(0, 1, At, B1); PG8_BAR; PG8_SCHED;
            PG8_LDA(At, 0, 1); PG8_STAGE(PG8_SB(0, 0), b2, voffB); PG8_STAGE(PG8_SB(0, 1), b2 + hstepB, voffB); PG8_STAGE(PG8_SA(0, 0), a2, voffA);
            PG8_WAIT_V(8); PG8_WAIT_L(0); PG8_BAR; PG8_MMA(1, 0, At, B0); PG8_MMA(1, 1, At, B1); PG8_BAR; PG8_SCHED;
            PG8_LDB(B0, 1, 0); PG8_LDB(B1, 1, 1); PG8_SCHED; PG8_LDA(At, 1, 0); PG8_STAGE(PG8_SA(0, 1), a2 + hstepA, voffA);
            PG8_WAIT_V(8); PG8_WAIT_L(0); PG8_BAR; PG8_MMA(0, 0, At, B0); PG8_MMA(0, 1, At, B1); PG8_BAR; PG8_SCHED;
            PG8_LDA(At, 1, 1); PG8_STAGE(PG8_SB(1, 0), b3, voffB); PG8_STAGE(PG8_SB(1, 1), b3 + hstepB, voffB); PG8_STAGE(PG8_SA(1, 0), a3, voffA);
            PG8_WAIT_V(8); PG8_WAIT_L(0); PG8_BAR; PG8_MMA(1, 0, At, B0); PG8_MMA(1, 1, At, B1); PG8_BAR; PG8_SCHED;
        }
        if (wr == 0) PG8_BAR;
        E(acc, cur, wr, wc, fr, fq);
        if (!has_next) break;
#pragma unroll
        for (int a = 0; a < 2; ++a)
#pragma unroll
            for (int b = 0; b < 2; ++b)
#pragma unroll
                for (int m = 0; m < 4; ++m)
#pragma unroll
                    for (int n = 0; n < 2; ++n) acc[a][b][m][n] = (f32x4){0.f, 0.f, 0.f, 0.f};
        cur = nxt; cA = nA; cB = nB; ++ui;
        if (wr == 1) PG8_BAR;
    }
    PG8_WAIT_V(0);
    PG8_BAR;
#undef PG8_SA
#undef PG8_SB
#undef PG8_STAGE
#undef PG8_LDA
#undef PG8_LDB
#undef PG8_MMA
#undef PG8_WAIT_V
#undef PG8_WAIT_L
#undef PG8_BAR
#undef PG8_SCHED
}
}

#define XB_TMO      128
#define XB_XCNT(j)  (256  + 64 * (j))
#define XB_XSUB(j)  (1280 + 64 * (j))
#define XB_XGEN(j)  (2304 + 64 * (j))
#define XB_TOP      3328
#define XB_TOPGEN   3392
#define XCD_BAR_WORDS 3456
#define XB_SPIN_CAP (1u << 18)
__device__ __forceinline__ unsigned xb_ld(unsigned* p)              { return __hip_atomic_load(p, __ATOMIC_RELAXED, __HIP_MEMORY_SCOPE_AGENT); }
__device__ __forceinline__ unsigned xb_add(unsigned* p, unsigned v) { return __hip_atomic_fetch_add(p, v, __ATOMIC_RELAXED, __HIP_MEMORY_SCOPE_AGENT); }
__device__ __forceinline__ unsigned xb_xcc_id() { return (unsigned)__builtin_amdgcn_s_getreg((3 << 11) | 20) & 0xFu; }
#define XB_SPIN(cond, bar) do { unsigned _sp = 0; while (cond) { __builtin_amdgcn_s_sleep(1); \
    if ((++_sp & 255u) == 0u) { if (xb_ld(&(bar)[XB_TMO])) break; if (_sp > XB_SPIN_CAP) { atomicAdd(&(bar)[XB_TMO], 1u); break; } } } } while (0)
struct XcdBarrier { unsigned* bar; unsigned x; volatile LAS unsigned* st; };
__device__ __forceinline__ XcdBarrier xcd_barrier_post(unsigned* bar, volatile LAS unsigned* st) {
    XcdBarrier b; b.bar = bar; b.x = xb_xcc_id(); b.st = st;
    if (threadIdx.x == 0) (void)xb_add(&bar[XB_XCNT(b.x)], 1u);
    return b;
}
__device__ __forceinline__ void xcd_barrier_complete(unsigned* bar, unsigned x, unsigned& nloc, unsigned& nx) {
    const unsigned G = gridDim.x * gridDim.y * gridDim.z;
    unsigned sum, cnt, mine, sp = 0u;
    for (;;) {
        sum = 0u; cnt = 0u; mine = 0u;
#pragma unroll
        for (unsigned j = 0; j < 16; ++j) { const unsigned c = xb_ld(&bar[XB_XCNT(j)]); sum += c; cnt += (c > 0u) ? 1u : 0u; mine = (j == x) ? c : mine; }
        if (sum == G) break;
        __builtin_amdgcn_s_sleep(1);
        if ((++sp & 255u) == 0u) { if (xb_ld(&bar[XB_TMO])) break; if (sp > XB_SPIN_CAP) { atomicAdd(&bar[XB_TMO], 1u); break; } }
    }
    nloc = mine > 0u ? mine : 1u; nx = cnt > 0u ? cnt : 1u;
}
__device__ __forceinline__ void xcd_barrier(const XcdBarrier& b) {
    asm volatile("s_waitcnt vmcnt(0)" ::: "memory");
    __syncthreads();
    if (threadIdx.x == 0) {
        unsigned* bar = b.bar;
        __builtin_amdgcn_s_waitcnt(0);
        unsigned nloc = b.st[0], nx = b.st[1];
        if (nloc == 0u) { xcd_barrier_complete(bar, b.x, nloc, nx); b.st[0] = nloc; b.st[1] = nx; }
        const unsigned old = xb_add(&bar[XB_XSUB(b.x)], 1u);
        const unsigned gen = old / nloc;
        if (old + 1u == (gen + 1u) * nloc) {
            __builtin_amdgcn_fence(__ATOMIC_RELEASE, "agent");
            asm volatile("s_waitcnt vmcnt(0)" ::: "memory");
            const unsigned og = xb_add(&bar[XB_TOP], 1u);
            const unsigned tg = og / nx;
            if (og + 1u == (tg + 1u) * nx) xb_add(&bar[XB_TOPGEN], 1u);
            else XB_SPIN(xb_ld(&bar[XB_TOPGEN]) == tg, bar);
            __builtin_amdgcn_fence(__ATOMIC_ACQUIRE, "agent");
            xb_add(&bar[XB_XGEN(b.x)], 1u);
            asm volatile("s_waitcnt vmcnt(0)" ::: "memory");
        } else {
            XB_SPIN(xb_ld(&bar[XB_XGEN(b.x)]) == gen, bar);
            __builtin_amdgcn_fence(__ATOMIC_ACQUIRE, "agent");
            asm volatile("s_waitcnt vmcnt(0)" ::: "memory");
        }
    }
    __syncthreads();
}

constexpr int RING_BYTES = 131072;
constexpr int LDSCTL_OFF = RING_BYTES, MISC_OFF = LDSCTL_OFF + 320;
constexpr int LDS_BYTES = 147456;
constexpr int NWAVES = 8;

struct Args { const float* in[17]; float* out; unsigned char* ws; };

struct Ctx {
    LAS unsigned char* lds;
    int tid, lane, wave, vcu, G;
};

__device__ __forceinline__ Ctx fresh(const Ctx& F) {
    Ctx C = F; int t = threadIdx.x; asm volatile("" : "+v"(t)); C.tid = t; C.lane = t & 63; return C;
}
__device__ __forceinline__ void p0_transpose_item(const float* W, int K, int N, bf16_t* WT, LAS float* scr, int item, int lane) {
    const int nblk = N / 32, kb = item / nblk, nb = item % nblk, k0 = 64 * kb, n0 = 32 * nb;
#pragma unroll 8
    for (int i = 0; i < 32; ++i) { const int kk = 2 * i + (lane >> 5); scr[kk * 33 + (lane & 31)] = W[(size_t)(k0 + kk) * N + n0 + (lane & 31)]; }
    asm volatile("s_waitcnt lgkmcnt(0)" ::: "memory");
    const int c = lane & 7;
#pragma unroll
    for (int j = 0; j < 4; ++j) { const int n = (lane >> 3) + 8 * j; const LAS float* s = scr + (8 * c) * 33 + n;
        u32x4 o; o.x = pk2(s[0 * 33], s[1 * 33]); o.y = pk2(s[2 * 33], s[3 * 33]); o.z = pk2(s[4 * 33], s[5 * 33]); o.w = pk2(s[6 * 33], s[7 * 33]);
        *(u32x4*)(WT + (size_t)(n0 + n) * K + k0 + 8 * c) = o; }
    asm volatile("s_waitcnt lgkmcnt(0)" ::: "memory");
}
__device__ __forceinline__ void cvt8(const float* src, bf16_t* dst) {
    const f32x4 a = *(const f32x4*)src, b = *(const f32x4*)(src + 4);
    u32x4 o; o.x = pk2(a[0], a[1]); o.y = pk2(a[2], a[3]); o.z = pk2(b[0], b[1]); o.w = pk2(b[2], b[3]);
    *(u32x4*)dst = o;
}

__device__ __forceinline__ void p0_prologue(const Ctx& F0, const Args& a) {
    const Ctx F = fresh(F0);
    unsigned char* ws = a.ws;
    const int gw = F.vcu * NWAVES + F.wave, NGW = F.G * NWAVES;
    const long gt = (long)F.vcu * 512 + F.tid, NGT = (long)F.G * 512;
    {
        LAS float* red = (LAS float*)(F.lds);
        const float* c = a.in[1]; const float* cctx = a.in[3]; const float* wmod = a.in[6]; const float* bmod = a.in[7];
        float* modb = (float*)(ws + WS_MOD);
        for (int item = F.vcu; item < 96; item += F.G) {
            const int l = item / 48, nc = item % 48, n0 = nc * 128 + 2 * F.lane, kb = F.wave * 128;
            float sv[9][2];
#pragma unroll
            for (int r = 0; r < 9; ++r)
#pragma unroll
                for (int j = 0; j < 2; ++j) { const int k = kb + 64 * j + F.lane; const float v = (r < 8) ? c[r * DM + k] : cctx[k]; sv[r][j] = v / (1.0f + __expf(-v)); }
            float acc[9][2];
#pragma unroll
            for (int r = 0; r < 9; ++r) { acc[r][0] = 0.f; acc[r][1] = 0.f; }
            const float* wp = wmod + (size_t)l * DM * NMOD + (size_t)kb * NMOD + n0;
#pragma unroll
            for (int j = 0; j < 2; ++j)
#pragma unroll 8
                for (int kl = 0; kl < 64; ++kl) {
                    const f32x2 w = *(const f32x2*)(wp + (size_t)(64 * j + kl) * NMOD);
#pragma unroll
                    for (int r = 0; r < 9; ++r) { const float s = __builtin_bit_cast(float, __builtin_amdgcn_readlane(__builtin_bit_cast(int, sv[r][j]), kl)); acc[r][0] += s * w[0]; acc[r][1] += s * w[1]; }
                }
            __syncthreads();
#pragma unroll
            for (int r = 0; r < 9; ++r) { red[(F.wave * 9 + r) * 128 + 2 * F.lane] = acc[r][0]; red[(F.wave * 9 + r) * 128 + 2 * F.lane + 1] = acc[r][1]; }
            __syncthreads();
            for (int o = F.tid; o < 9 * 128; o += 512) { const int r = o >> 7, nl = o & 127; float s = 0.f;
#pragma unroll
                for (int w = 0; w < 8; ++w) s += red[(w * 9 + r) * 128 + nl];
                modb[(size_t)(l * 9 + r) * NMOD + nc * 128 + nl] = s + bmod[l * NMOD + nc * 128 + nl]; }
        }
        __syncthreads();
    }
    {
        LAS float* scr = (LAS float*)(F.lds + F.wave * 16384);
        constexpr int I_QKV = (DM / 64) * (3 * DM / 32), I_O = (DM / 64) * (DM / 32), I_PQ = (DM / 64) * (2 * DM / 32);
        constexpr int NITEMS = I_QKV + 2 * I_O + 2 * I_PQ;
        for (int it = gw; it < NITEMS; it += NGW) {
            int r = it;
            if (r < I_QKV) { p0_transpose_item(a.in[8], DM, 3 * DM, (bf16_t*)(ws + WS_WQKV), scr, r, F.lane); continue; } r -= I_QKV;
            if (r < I_O) { p0_transpose_item(a.in[9], DM, DM, (bf16_t*)(ws + WS_WO), scr, r, F.lane); continue; } r -= I_O;
            if (r < I_O) { p0_transpose_item(a.in[11], DM, DM, (bf16_t*)(ws + WS_WF), scr, r, F.lane); continue; } r -= I_O;
            if (r < I_PQ) { p0_transpose_item(a.in[12], DM, 2 * DM, (bf16_t*)(ws + WS_WPQ), scr, r, F.lane); continue; } r -= I_PQ;
            p0_transpose_item(a.in[12] + (size_t)DM * 2 * DM, DM, 2 * DM, (bf16_t*)(ws + WS_WPQ) + (size_t)2 * DM * DM, scr, r, F.lane);
        }
    }
    for (long i = gt; i < 2 * 2 * 128 * 128 / 8; i += NGT) cvt8(a.in[13] + i * 8, (bf16_t*)(ws + WS_SK) + i * 8);
    {
        constexpr long PER = (long)NEXP * DM / 16;
        unsigned char* t8 = ws + WS_TAB;
        for (long i = gt; i < 4 * PER; i += NGT) {
            const int q = (int)(i / PER); const long r = i - (long)q * PER; const int l = q >> 1, tb = q & 1;
            const int e = (int)(r >> 6), c16 = (int)(r & 63);
            const float* src = (tb ? a.in[15] : a.in[14]) + ((size_t)l * NEXP + e) * DM + c16 * 16;
            const float sc = tb ? V_SCALE : U_SCALE;
            u32x4 o;
#pragma unroll
            for (int d = 0; d < 4; ++d) { const f32x4 v = *(const f32x4*)(src + 4 * d); int w = 0;
                w = __builtin_amdgcn_cvt_pk_fp8_f32(fminf(fmaxf(v[0] * sc, -448.f), 448.f), fminf(fmaxf(v[1] * sc, -448.f), 448.f), w, false);
                w = __builtin_amdgcn_cvt_pk_fp8_f32(fminf(fmaxf(v[2] * sc, -448.f), 448.f), fminf(fmaxf(v[3] * sc, -448.f), 448.f), w, true);
                o[d] = (unsigned)w; }
            *(u32x4*)(t8 + (((size_t)q * 8 + (c16 >> 3)) * NEXP + e) * 128 + (c16 & 7) * 16) = o;
        }
    }
    {
        bf16_t* wc = (bf16_t*)(ws + WS_WC);
        for (long i = gt; i < 512 * 256 / 8; i += NGT) { const int nn = (int)(i >> 5), k0 = (int)(i & 31) * 8; float v[8];
#pragma unroll
            for (int j = 0; j < 8; ++j) { const int m = ((k0 + j) * (nn & 255)) & 255; const float fr = (float)m * (1.0f / 256.0f);
                v[j] = (nn < 256 ? __builtin_amdgcn_cosf(fr) : __builtin_amdgcn_sinf(fr)) * (1.0f / 16.0f); }
            u32x4 o; o.x = pk2(v[0], v[1]); o.y = pk2(v[2], v[3]); o.z = pk2(v[4], v[5]); o.w = pk2(v[6], v[7]);
            *(u32x4*)(wc + i * 8) = o; }
        bf16_t* cs = (bf16_t*)(ws + WS_CS);
        for (long i = gt; i < 4096L * 8192 / 8; i += NGT) { const int np = (int)(i >> 10), c0 = (int)(i & 1023) * 8; const int part = c0 >> 12; float v[8];
#pragma unroll
            for (int j = 0; j < 8; ++j) { const int n = (c0 + j) & 4095; const int m = (n * np) & 4095; const float fr = (float)m * (1.0f / 4096.0f);
                v[j] = (part == 0 ? __builtin_amdgcn_cosf(fr) : -__builtin_amdgcn_sinf(fr)) * (1.0f / 64.0f); }
            u32x4 o; o.x = pk2(v[0], v[1]); o.y = pk2(v[2], v[3]); o.z = pk2(v[4], v[5]); o.w = pk2(v[6], v[7]);
            *(u32x4*)(cs + i * 8) = o; }
    }
}

__device__ __forceinline__ void norm_mod_row(const float* xrow, const float* gw, const float* sh, const float* sc, bf16_t* orow, int lane, unsigned char* x8 = nullptr, long trow = 0) {
    const f32x4* xr = (const f32x4*)xrow + lane;
    f32x4 v[4]; float s = 0.f;
#pragma unroll
    for (int j = 0; j < 4; ++j) { v[j] = xr[64 * j]; s += (v[j].x * v[j].x + v[j].y * v[j].y) + (v[j].z * v[j].z + v[j].w * v[j].w); }
    const float rstd = 1.0f / sqrtf(wave_sum(s) * (1.0f / DM) + EPS);
    unsigned long long* o8 = (unsigned long long*)orow + lane;
#pragma unroll
    for (int j = 0; j < 4; ++j) {
        const f32x4 g = ((const f32x4*)gw)[lane + 64 * j], a = ((const f32x4*)sh)[lane + 64 * j], c = ((const f32x4*)sc)[lane + 64 * j];
        const f32x4 y = (v[j] * rstd * g) * (c + 1.0f) + a;
        o8[64 * j] = (unsigned long long)cvtpk(y.x, y.y) | ((unsigned long long)cvtpk(y.z, y.w) << 32);
        if (x8) { int w = 0;
            w = __builtin_amdgcn_cvt_pk_fp8_f32(fminf(fmaxf(y.x * X_SCALE, -448.f), 448.f), fminf(fmaxf(y.y * X_SCALE, -448.f), 448.f), w, false);
            w = __builtin_amdgcn_cvt_pk_fp8_f32(fminf(fmaxf(y.z * X_SCALE, -448.f), 448.f), fminf(fmaxf(y.w * X_SCALE, -448.f), 448.f), w, true);
            *(int*)(x8 + ((size_t)(2 * j + (lane >> 5)) * ML + trow) * 128 + (4 * lane & 127)) = w; }
    }
}
__device__ __forceinline__ void norm_phase(const Ctx& F0, const Args& a, int mode, int layer, int off, const float* gw) {
    const Ctx F = fresh(F0);
    const int gwv = F.vcu * NWAVES + F.wave, NGW = F.G * NWAVES;
    const float* modb = (const float*)(a.ws + WS_MOD) + (size_t)layer * 9 * NMOD;
    bf16_t* hx = (bf16_t*)(a.ws + WS_HX);
    const int nrows = (mode == 0) ? MT : ML;
    for (int m = gwv; m < nrows; m += NGW) {
        const float* src; const float* mr;
        if (m < ML) { src = (mode == 0 ? a.in[0] : a.out) + (size_t)m * DM; mr = modb + (size_t)(m >> 12) * NMOD; }
        else { src = a.in[2] + (size_t)(m - ML) * DM; mr = modb + (size_t)8 * NMOD; }
        norm_mod_row(src, gw, mr + off, mr + off + DM, hx + (size_t)m * DM, F.lane);
    }
}
__device__ __forceinline__ void final_norm_phase(const Ctx& F0, const Args& a) {
    const Ctx F = fresh(F0);
    const int gwv = F.vcu * NWAVES + F.wave, NGW = F.G * NWAVES;
    const float* gw = a.in[16];
    for (int m = gwv; m < ML; m += NGW) {
        f32x4* xr = (f32x4*)(a.out + (size_t)m * DM) + F.lane;
        f32x4 v[4]; float s = 0.f;
#pragma unroll
        for (int j = 0; j < 4; ++j) { v[j] = xr[64 * j]; s += (v[j].x * v[j].x + v[j].y * v[j].y) + (v[j].z * v[j].z + v[j].w * v[j].w); }
        const float rstd = 1.0f / sqrtf(wave_sum(s) * (1.0f / DM) + EPS);
#pragma unroll
        for (int j = 0; j < 4; ++j) xr[64 * j] = v[j] * rstd * ((const f32x4*)gw)[F.lane + 64 * j];
    }
}

__device__ __forceinline__ void attn_phase(const Ctx& F0, const Args& a) {
    const Ctx F = fresh(F0);
    const bf16_t* QK = (const bf16_t*)(a.ws + WS_QK);
    const bf16_t* VT = (const bf16_t*)(a.ws + WS_VT);
    bf16_t* AO = (bf16_t*)(a.ws + WS_HX);
    const float* rpb = a.in[10];
    LAS float* rl = (LAS float*)F.lds;
    const int lane = F.lane, hl = F.wave >> 1, qt = F.wave & 1, q32 = lane & 31, hi = lane >> 5;
    const float SC = 0.125f * LOG2E, NEG = -1e30f;
    for (int task = F.vcu; task < 2048; task += F.G) {
        const int hq = task & 3, r = (task >> 2) & 63, b = task >> 8;
        __syncthreads();
        for (int i = F.tid; i < 4 * 465; i += 512) rl[i] = rpb[hq * 4 * 465 + i] * LOG2E;
        __syncthreads();
        const int h = 4 * hq + hl;
        const int r_start = min(max(r - 4, 0), 56);
        const int qc = 32 * qt + q32;
        const int cs = min(max(qc - 8, 0), 48);
        const long mq = (long)b * SEQ + r * GW + qc;
        bf16x8 qr[4];
#pragma unroll
        for (int d0 = 0; d0 < 4; ++d0) qr[d0] = *(const bf16x8*)(QK + mq * 2048 + h * 64 + d0 * 16 + hi * 8);
        float m_run = NEG, l_run = 0.f;
        f32x16 o[2];
#pragma unroll
        for (int i = 0; i < 16; ++i) { o[0][i] = 0.f; o[1][i] = 0.f; }
        for (int it = 0; it < 12; ++it) {
            const bool latent = it < 8;
            const int kr = r_start + it;
            const long tok0 = latent ? ((long)b * SEQ + (long)kr * GW) : ((long)ML + b * CTXL + (it - 8) * 64);
            f32x16 p[2];
#pragma unroll
            for (int blk = 0; blk < 2; ++blk) {
                const bf16_t* kp = QK + (tok0 + 32 * blk + q32) * 2048 + 1024 + h * 64 + hi * 8;
                f32x16 acc;
#pragma unroll
                for (int i = 0; i < 16; ++i) acc[i] = 0.f;
                asm volatile("" : "+v"(acc));
#pragma unroll
                for (int d0 = 0; d0 < 4; ++d0) { const bf16x8 kf = *(const bf16x8*)(kp + d0 * 16); acc = __builtin_amdgcn_mfma_f32_32x32x16_bf16(kf, qr[d0], acc, 0, 0, 0); }
                p[blk] = acc;
            }
            float mx = NEG;
            if (latent) {
                const LAS float* rb = rl + hl * 465 + (kr - r + 7) * 31;
#pragma unroll
                for (int blk = 0; blk < 2; ++blk)
#pragma unroll
                    for (int i = 0; i < 16; ++i) { const int kc = 32 * blk + crow(i, hi); const bool valid = (kc >= cs) && (kc < cs + 16);
                        const int bi = valid ? (kc - qc + 15) : 0; const float bv = rb[bi];
                        const float v = valid ? (p[blk][i] * SC + bv) : NEG; p[blk][i] = v; mx = fmaxf(mx, v); }
            } else {
#pragma unroll
                for (int blk = 0; blk < 2; ++blk)
#pragma unroll
                    for (int i = 0; i < 16; ++i) { const float v = p[blk][i] * SC; p[blk][i] = v; mx = fmaxf(mx, v); }
            }
            mx = fmaxf(mx, __shfl_xor(mx, 32));
            const float m_new = fmaxf(m_run, mx);
            const float alpha = __builtin_amdgcn_exp2f(m_run - m_new);
            m_run = m_new;
            float rs = 0.f;
#pragma unroll
            for (int blk = 0; blk < 2; ++blk)
#pragma unroll
                for (int i = 0; i < 16; ++i) { const float e = __builtin_amdgcn_exp2f(p[blk][i] - m_new); p[blk][i] = e; rs += e; }
            l_run = l_run * alpha + rs;
#pragma unroll
            for (int i = 0; i < 16; ++i) { o[0][i] *= alpha; o[1][i] *= alpha; }
#pragma unroll
            for (int blk = 0; blk < 2; ++blk)
#pragma unroll
                for (int s = 0; s < 2; ++s) {
                    u32x4 pw; pw.x = cvtpk(p[blk][8 * s + 0], p[blk][8 * s + 1]); pw.y = cvtpk(p[blk][8 * s + 2], p[blk][8 * s + 3]);
                    pw.z = cvtpk(p[blk][8 * s + 4], p[blk][8 * s + 5]); pw.w = cvtpk(p[blk][8 * s + 6], p[blk][8 * s + 7]);
                    const bf16x8 pf = __builtin_bit_cast(bf16x8, pw);
#pragma unroll
                    for (int dh = 0; dh < 2; ++dh) {
                        const bf16_t* vp = VT + (long)(h * 64 + 32 * dh + q32) * MT + tok0 + 32 * blk + 16 * s + 4 * hi;
                        const u32x2 v0 = *(const u32x2*)vp, v1 = *(const u32x2*)(vp + 8);
                        u32x4 vw; vw.x = v0.x; vw.y = v0.y; vw.z = v1.x; vw.w = v1.y;
                        o[dh] = __builtin_amdgcn_mfma_f32_32x32x16_bf16(__builtin_bit_cast(bf16x8, vw), pf, o[dh], 0, 0, 0);
                    }
                }
        }
        l_run += __shfl_xor(l_run, 32);
        const float linv = 1.0f / l_run;
        bf16_t* op = AO + mq * DM + h * 64;
#pragma unroll
        for (int dh = 0; dh < 2; ++dh)
#pragma unroll
            for (int g4 = 0; g4 < 4; ++g4) {
                u32x2 w; w.x = cvtpk(o[dh][4 * g4 + 0] * linv, o[dh][4 * g4 + 1] * linv); w.y = cvtpk(o[dh][4 * g4 + 2] * linv, o[dh][4 * g4 + 3] * linv);
                *(u32x2*)(op + 32 * dh + 8 * g4 + 4 * hi) = w;
            }
    }
    __syncthreads();
}

__device__ __forceinline__ void ce_desc(float& a, float& b) { const float hi = fmaxf(a, b), lo = fminf(a, b); a = hi; b = lo; }
__device__ __forceinline__ void ce_dir(float& a, float& b, bool desc) { const float hi = fmaxf(a, b), lo = fminf(a, b); a = desc ? hi : lo; b = desc ? lo : hi; }
__device__ __forceinline__ void sort16_desc(float (&v)[16]) {
#pragma unroll
    for (int k = 2; k <= 16; k <<= 1)
#pragma unroll
        for (int j = k >> 1; j > 0; j >>= 1)
#pragma unroll
            for (int i = 0; i < 16; ++i) { const int l = i ^ j; if (l > i) ce_dir(v[i], v[l], (i & k) == 0); }
}
__device__ __forceinline__ void merge16_desc(float (&a)[16], const float (&b)[16]) {
#pragma unroll
    for (int i = 0; i < 16; ++i) a[i] = fmaxf(a[i], b[15 - i]);
#pragma unroll
    for (int j = 8; j > 0; j >>= 1)
#pragma unroll
        for (int i = 0; i < 16; ++i) { const int l = i ^ j; if (l > i) ce_desc(a[i], a[l]); }
}

struct CandTab { int i[64]; int j[64]; };
__host__ __device__ constexpr CandTab make_cand_tab() {
    CandTab t{}; int n = 0;
    for (int i = 0; i < 16; ++i) for (int j = 0; j < 16; ++j) if ((i + 1) * (j + 1) <= 16) { t.i[n] = i; t.j[n] = j; ++n; }
    for (; n < 64; ++n) { t.i[n] = -1; t.j[n] = -1; }
    return t;
}

__device__ __forceinline__ void peer_topk_phase(const Ctx& F0, const Args& a, int layer) {
    const Ctx F = fresh(F0);
    const bf16_t* QP = (const bf16_t*)(a.ws + WS_QK);
    const bf16_t* SK = (const bf16_t*)(a.ws + WS_SK) + (size_t)layer * 2 * 128 * 128;
    unsigned short* IDX = (unsigned short*)(a.ws + WS_IDX);
    float* GATE = (float*)(a.ws + WS_GATE);
    const int gwv = F.vcu * NWAVES + F.wave, NGW = F.G * NWAVES;
    const int lane = F.lane, t32 = lane & 31, hi = lane >> 5;
    __syncthreads();
    for (int c = F.tid; c < 4096; c += 512) *(LAS u32x4*)(F.lds + (c >> 4) * 272 + (c & 15) * 16) = *(const u32x4*)(SK + (size_t)c * 8);
    __syncthreads();
    for (int task = gwv; task < 1024 * 8; task += NGW) {
        const int tt = task >> 3, h = task & 7;
        const long tok = (long)tt * 32 + t32;
        float top[2][16];
#pragma unroll
        for (int p = 0; p < 2; ++p) {
            f32x16 acc[4];
#pragma unroll
            for (int eb = 0; eb < 4; ++eb)
#pragma unroll
                for (int i = 0; i < 16; ++i) acc[eb][i] = 0.f;
#pragma unroll
            for (int eb = 0; eb < 4; ++eb) asm volatile("" : "+v"(acc[eb]));
            const bf16_t* qp = QP + tok * 2048 + h * 256 + p * 128 + hi * 8;
            const LAS unsigned char* kp = F.lds + (p * 128 + t32) * 272 + hi * 16;
#pragma unroll
            for (int ks = 0; ks < 8; ++ks) {
                if ((ks & 1) == 0) asm volatile("" ::: "memory");
                const bf16x8 bq = *(const bf16x8*)(qp + ks * 16);
#pragma unroll
                for (int eb = 0; eb < 4; ++eb) { const bf16x8 ak = *(const LAS bf16x8*)(kp + eb * 32 * 272 + ks * 32); acc[eb] = __builtin_amdgcn_mfma_f32_32x32x16_bf16(ak, bq, acc[eb], 0, 0, 0); }
            }
            float cur[16];
#pragma unroll
            for (int eb = 0; eb < 4; ++eb) {
                float v[16];
#pragma unroll
                for (int i = 0; i < 16; ++i) { const unsigned e = 32 * eb + crow(i, hi); float x = acc[eb][i]; asm volatile("" : "+v"(x));
                    v[i] = __builtin_bit_cast(float, (__builtin_bit_cast(unsigned, x) & ~0x7Fu) | e); }
                sort16_desc(v);
                if (eb == 0) {
#pragma unroll
                    for (int i = 0; i < 16; ++i) cur[i] = v[i];
                } else merge16_desc(cur, v);
            }
            float oth[16];
#pragma unroll
            for (int i = 0; i < 16; ++i) oth[i] = __shfl_xor(cur[i], 32);
            merge16_desc(cur, oth);
#pragma unroll
            for (int i = 0; i < 16; ++i) top[p][i] = cur[i];
            __builtin_amdgcn_sched_barrier(0);
        }
        float best[16];
#pragma unroll
        for (int gI = 0; gI < 4; ++gI) {
            float v[16];
#pragma unroll
            for (int q = 0; q < 16; ++q) {
                constexpr CandTab CT = make_cand_tab();
                const int ci = CT.i[16 * gI + q], cj = CT.j[16 * gI + q];
                if (ci >= 0) {
                    const unsigned ua = __builtin_bit_cast(unsigned, top[0][ci]), ub = __builtin_bit_cast(unsigned, top[1][cj]);
                    float s = top[0][ci] + top[1][cj]; asm volatile("" : "+v"(s));
                    const unsigned code = ((ua & 0x7Fu) << 7) | (ub & 0x7Fu);
                    v[q] = __builtin_bit_cast(float, (__builtin_bit_cast(unsigned, s) & ~0x3FFFu) | code);
                } else v[q] = -3.0e38f;
            }
            sort16_desc(v);
            if (gI == 0) {
#pragma unroll
                for (int i = 0; i < 16; ++i) best[i] = v[i];
            } else merge16_desc(best, v);
            __builtin_amdgcn_sched_barrier(0);
        }
        float e[16], sum = 0.f;
#pragma unroll
        for (int i = 0; i < 16; ++i) { e[i] = __builtin_amdgcn_exp2f((best[i] - best[0]) * LOG2E); sum += e[i]; }
        const float inv = 1.0f / sum;
        if (hi == 0) {
            u32x4 w0, w1;
            w0.x = (__builtin_bit_cast(unsigned, best[0]) & 0x3FFFu) | ((__builtin_bit_cast(unsigned, best[1]) & 0x3FFFu) << 16);
            w0.y = (__builtin_bit_cast(unsigned, best[2]) & 0x3FFFu) | ((__builtin_bit_cast(unsigned, best[3]) & 0x3FFFu) << 16);
            w0.z = (__builtin_bit_cast(unsigned, best[4]) & 0x3FFFu) | ((__builtin_bit_cast(unsigned, best[5]) & 0x3FFFu) << 16);
            w0.w = (__builtin_bit_cast(unsigned, best[6]) & 0x3FFFu) | ((__builtin_bit_cast(unsigned, best[7]) & 0x3FFFu) << 16);
            w1.x = (__builtin_bit_cast(unsigned, best[8]) & 0x3FFFu) | ((__builtin_bit_cast(unsigned, best[9]) & 0x3FFFu) << 16);
            w1.y = (__builtin_bit_cast(unsigned, best[10]) & 0x3FFFu) | ((__builtin_bit_cast(unsigned, best[11]) & 0x3FFFu) << 16);
            w1.z = (__builtin_bit_cast(unsigned, best[12]) & 0x3FFFu) | ((__builtin_bit_cast(unsigned, best[13]) & 0x3FFFu) << 16);
            w1.w = (__builtin_bit_cast(unsigned, best[14]) & 0x3FFFu) | ((__builtin_bit_cast(unsigned, best[15]) & 0x3FFFu) << 16);
            u32x4* ip = (u32x4*)(IDX + tok * 128 + h * 16);
            ip[0] = w0; ip[1] = w1;
        } else {
            f32x4* gp = (f32x4*)(GATE + tok * 128 + h * 16);
#pragma unroll
            for (int q = 0; q < 4; ++q) gp[q] = (f32x4){e[4 * q] * inv, e[4 * q + 1] * inv, e[4 * q + 2] * inv, e[4 * q + 3] * inv};
        }
    }
    __syncthreads();
}

typedef long i64_t;
template <int CTRL> __device__ __forceinline__ float dpp_f(float v) { return __builtin_bit_cast(float, __builtin_amdgcn_update_dpp(0, __builtin_bit_cast(int, v), CTRL, 0xF, 0xF, true)); }
__device__ __forceinline__ void peer_u_phase(const Ctx& F0, const Args& a, int layer) {
    const Ctx F = fresh(F0);
    const int s = (int)(blockIdx.x & 7), j = (int)(blockIdx.x >> 3), nmem = F.G >> 3;
    const unsigned char* U8s = a.ws + WS_TAB + ((size_t)(2 * layer) * 8 + s) * NEXP * 128;
    const bf16_t* HX = (const bf16_t*)(a.ws + WS_HX);
    const unsigned short* IDX = (const unsigned short*)(a.ws + WS_IDX);
    float* PART = (float*)(a.ws + WS_PART) + (size_t)s * ML * 128;
    const int lane = F.lane, rsub = lane >> 3, c16 = lane & 7;
    const bool c2 = (lane & 4) != 0, c1 = (lane & 2) != 0, c0 = (lane & 1) != 0;
    const int t0 = j * NWAVES + F.wave, stride = nmem * NWAVES, ntok = (ML - t0 + stride - 1) / stride;
#define U_TOK(i) ((size_t)(t0 + ((i) < ntok ? (i) : ntok - 1) * stride))
    u32x4 iN[2];
    { const size_t o_ = U_TOK(0) * 128 + 16 * rsub; iN[0] = *(const u32x4*)(IDX + o_); iN[1] = *(const u32x4*)(IDX + o_ + 8); }
    for (int i = 0; i < ntok; ++i) {
        u32x4 R[16];
#pragma unroll
        for (int i_ = 0; i_ < 16; ++i_) { const unsigned pair_ = iN[i_ >> 3][(i_ & 7) >> 1]; const unsigned e_ = (i_ & 1) ? (pair_ >> 16) : (pair_ & 0xffffu);
            R[i_] = *(const u32x4*)(U8s + (unsigned)(e_ * 128 + 16 * c16)); }
        const size_t t_ = U_TOK(i);
        const u32x4 xa = *(const u32x4*)(HX + t_ * DM + 128 * s + 16 * c16), xb = *(const u32x4*)(HX + t_ * DM + 128 * s + 16 * c16 + 8);
        { const size_t o_ = U_TOK(i + 1) * 128 + 16 * rsub; iN[0] = *(const u32x4*)(IDX + o_); iN[1] = *(const u32x4*)(IDX + o_ + 8); }
        f32x2 xf[8];
#pragma unroll
        for (int d = 0; d < 4; ++d) { xf[d] = (f32x2){bflo(xa[d]), bfhi(xa[d])}; xf[4 + d] = (f32x2){bflo(xb[d]), bfhi(xb[d])}; }
        float v[16];
#pragma unroll
        for (int i_ = 0; i_ < 16; ++i_) { f32x2 p2 = (f32x2){0.f, 0.f};
#pragma unroll
            for (int d = 0; d < 4; ++d) { const f32x2 lo_ = __builtin_amdgcn_cvt_pk_f32_fp8((int)R[i_][d], false), hi_ = __builtin_amdgcn_cvt_pk_f32_fp8((int)R[i_][d], true);
                p2 += lo_ * xf[2 * d] + hi_ * xf[2 * d + 1]; }
            v[i_] = p2[0] + p2[1]; }
        float a8[8], a4[4], a2[2];
#pragma unroll
        for (int k = 0; k < 8; ++k) { const float keep = c2 ? v[k + 8] : v[k], send = c2 ? v[k] : v[k + 8]; a8[k] = keep + dpp_f<0x141>(send); }
#pragma unroll
        for (int k = 0; k < 4; ++k) { const float keep = c1 ? a8[k + 4] : a8[k], send = c1 ? a8[k] : a8[k + 4]; a4[k] = keep + dpp_f<0x4E>(send); }
#pragma unroll
        for (int k = 0; k < 2; ++k) { const float keep = c0 ? a4[k + 2] : a4[k], send = c0 ? a4[k] : a4[k + 2]; a2[k] = keep + dpp_f<0xB1>(send); }
        *(f32x2*)(PART + t_ * 128 + 2 * lane) = (f32x2){a2[0], a2[1]};
    }
#undef U_TOK
}
__device__ __forceinline__ void peer_w_phase(const Ctx& F0, const Args& a) {
    const Ctx F = fresh(F0);
    const float* PART = (const float*)(a.ws + WS_PART);
    const float* GATE = (const float*)(a.ws + WS_GATE);
    float* WT = (float*)(a.ws + WS_WT);
    const int gwv = F.vcu * NWAVES + F.wave, NGW = F.G * NWAVES;
    for (int t = gwv; t < ML; t += NGW) {
        f32x2 z = (f32x2){0.f, 0.f};
#pragma unroll
        for (int s = 0; s < 8; ++s) z += *(const f32x2*)(PART + ((size_t)s * ML + t) * 128 + 2 * F.lane);
        const f32x2 g = *(const f32x2*)(GATE + (size_t)t * 128 + 2 * F.lane);
        f32x2 w; w.x = g.x * gelu_erf(z.x * (1.0f / U_SCALE)); w.y = g.y * gelu_erf(z.y * (1.0f / U_SCALE));
        *(f32x2*)(WT + (size_t)t * 128 + 2 * F.lane) = w;
    }
}
__device__ __forceinline__ void peer_v_phase(const Ctx& F0, const Args& a, int layer, float oscale = 1.0f) {
    const Ctx F = fresh(F0);
    const int s = (int)(blockIdx.x & 7), j = (int)(blockIdx.x >> 3), nmem = F.G >> 3;
    const unsigned char* V8s = a.ws + WS_TAB + ((size_t)(2 * layer + 1) * 8 + s) * NEXP * 128;
    const unsigned short* IDX = (const unsigned short*)(a.ws + WS_IDX);
    const float* WT = (const float*)(a.ws + WS_WT);
    const float* modb = (const float*)(a.ws + WS_MOD) + (size_t)layer * 9 * NMOD;
    float* X = a.out;
    const int lane = F.lane, rsub = lane >> 3, c16 = lane & 7;
    LAS float* red = (LAS float*)(F.lds + F.wave * 4096);
    const float dbg_s = ((DBG_SKIP & (layer == 0 ? 2 : 8)) ? 0.f : oscale) * (1.0f / V_SCALE);
    const int t0 = j * NWAVES + F.wave, stride = nmem * NWAVES, ntok = (ML - t0 + stride - 1) / stride;
#define V_TOK(i) ((size_t)(t0 + ((i) < ntok ? (i) : ntok - 1) * stride))
#define V_LOAD_IW(dI, dW, i) do { const size_t o_ = V_TOK(i) * 128 + 16 * rsub; dI[0] = *(const u32x4*)(IDX + o_); dI[1] = *(const u32x4*)(IDX + o_ + 8); \
        _Pragma("unroll") for (int q = 0; q < 4; ++q) dW[q] = *(const f32x4*)(WT + o_ + 4 * q); } while (0)
#define V_LOAD_ROWS(dR, iv) do { _Pragma("unroll") for (int i_ = 0; i_ < 16; ++i_) { const unsigned pair_ = iv[i_ >> 3][(i_ & 7) >> 1]; const unsigned e_ = (i_ & 1) ? (pair_ >> 16) : (pair_ & 0xffffu); \
        dR[i_] = *(const u32x4*)(V8s + (unsigned)(e_ * 128 + 16 * c16)); } } while (0)
#define V_COMPUTE(R, W, i) do { float acc_[16]; _Pragma("unroll") for (int c = 0; c < 16; ++c) acc_[c] = 0.f; \
        _Pragma("unroll") for (int i_ = 0; i_ < 16; ++i_) { const float w_ = W[i_ >> 2][i_ & 3]; \
            _Pragma("unroll") for (int d = 0; d < 4; ++d) { const f32x2 lo_ = __builtin_amdgcn_cvt_pk_f32_fp8((int)R[i_][d], false), hi_ = __builtin_amdgcn_cvt_pk_f32_fp8((int)R[i_][d], true); \
                acc_[4 * d + 0] += w_ * lo_[0]; acc_[4 * d + 1] += w_ * lo_[1]; acc_[4 * d + 2] += w_ * hi_[0]; acc_[4 * d + 3] += w_ * hi_[1]; } } \
        _Pragma("unroll") for (int q = 0; q < 4; ++q) *(LAS f32x4*)(red + rsub * 128 + c16 * 16 + 4 * q) = (f32x4){acc_[4 * q], acc_[4 * q + 1], acc_[4 * q + 2], acc_[4 * q + 3]}; \
        f32x2 sum_ = (f32x2){0.f, 0.f}; \
        _Pragma("unroll") for (int r = 0; r < 8; ++r) sum_ += *(const LAS f32x2*)(red + r * 128 + 2 * lane); \
        if ((i) < ntok) { const size_t t_ = V_TOK(i); \
            const f32x2 g_ = *(const f32x2*)(modb + (t_ >> 12) * NMOD + 5 * DM + 128 * s + 2 * lane) * dbg_s; \
            f32x2* xo_ = (f32x2*)(X + t_ * DM + 128 * s + 2 * lane); *xo_ = *xo_ + g_ * sum_; } } while (0)
    u32x4 iN[2]; f32x4 wN[4];
    V_LOAD_IW(iN, wN, 0);
    for (int i = 0; i < ntok; ++i) {
        u32x4 R[16]; f32x4 wC[4];
        V_LOAD_ROWS(R, iN);
#pragma unroll
        for (int q = 0; q < 4; ++q) wC[q] = wN[q];
        V_LOAD_IW(iN, wN, i + 1);
        float acc[16];
#pragma unroll
        for (int c = 0; c < 16; ++c) acc[c] = 0.f;
#pragma unroll
        for (int i_ = 0; i_ < 16; ++i_) { const float w_ = wC[i_ >> 2][i_ & 3];
#pragma unroll
            for (int d = 0; d < 4; ++d) { const f32x2 lo_ = __builtin_amdgcn_cvt_pk_f32_fp8((int)R[i_][d], false), hi_ = __builtin_amdgcn_cvt_pk_f32_fp8((int)R[i_][d], true);
                acc[4 * d + 0] += w_ * lo_[0]; acc[4 * d + 1] += w_ * lo_[1]; acc[4 * d + 2] += w_ * hi_[0]; acc[4 * d + 3] += w_ * hi_[1]; } }
#pragma unroll
        for (int q = 0; q < 4; ++q) *(LAS f32x4*)(red + rsub * 128 + c16 * 16 + 4 * q) = (f32x4){acc[4 * q], acc[4 * q + 1], acc[4 * q + 2], acc[4 * q + 3]};
        f32x2 sum = (f32x2){0.f, 0.f};
#pragma unroll
        for (int r = 0; r < 8; ++r) sum += *(const LAS f32x2*)(red + r * 128 + 2 * lane);
        { const size_t t_ = V_TOK(i);
          const f32x2 g_ = *(const f32x2*)(modb + (t_ >> 12) * NMOD + 5 * DM + 128 * s + 2 * lane) * dbg_s;
          f32x2* xo_ = (f32x2*)(X + t_ * DM + 128 * s + 2 * lane); *xo_ = *xo_ + g_ * sum; }
    }
#undef V_TOK
#undef V_LOAD_IW
#undef V_LOAD_ROWS
#undef V_COMPUTE
}

__global__ void __launch_bounds__(NWAVES * 64, 2) fwd_kernel(Args args) {
    extern __shared__ __attribute__((aligned(16))) unsigned char lds_raw[];
    Ctx F;
    F.lds = (LAS unsigned char*)lds_raw;
    F.tid = threadIdx.x; F.lane = F.tid & 63; F.wave = __builtin_amdgcn_readfirstlane(F.tid >> 6);
    F.G = gridDim.x; { const int bx = blockIdx.x; F.vcu = (F.G % 8 == 0) ? (bx % 8) * (F.G / 8) + bx / 8 : bx; }
    volatile LAS unsigned* MISC = (volatile LAS unsigned*)(F.lds + MISC_OFF);
    for (int u = F.tid; u < (LDS_BYTES - LDSCTL_OFF) / 4; u += NWAVES * 64) ((LAS unsigned*)(F.lds + LDSCTL_OFF))[u] = 0u;
    __syncthreads();
    unsigned char* ws = args.ws;
    XcdBarrier bar = xcd_barrier_post((unsigned*)(ws + WS_CTL) + CW_BAR, MISC + 8);
#define GRID_BAR() xcd_barrier(bar)
#ifndef DBG_REP
#define DBG_REP 0
#endif
#define REP(k, ...) do { __VA_ARGS__; if (DBG_REP == (k)) { GRID_BAR(); __VA_ARGS__; } } while (0)
#define PEER_BLOCK(layer) do { \
        norm_phase(F, args, 1, layer, 3 * DM, args.in[5] + (layer) * DM); \
        GRID_BAR(); \
        { using SHq = pg8::Shape<ML, 2048, DM, DM, DM, 1, 0, 0>; \
          REP(7, pg8::gemm_phase<SHq>(F.lds, pg8::Gemm{HX, (const bf16_t*)(ws + WS_WPQ) + (size_t)(layer) * 2048 * DM}, F.G, bx, pg8::EpiStoreBf16{QKb, 2048, 0})); } \
        GRID_BAR(); \
        REP(8, peer_topk_phase(F, args, layer)); \
        GRID_BAR(); \
        REP(9, peer_u_phase(F, args, layer)); \
        GRID_BAR(); \
        REP(10, peer_w_phase(F, args)); \
        GRID_BAR(); \
        peer_v_phase(F, args, layer); if (DBG_REP == 11) { GRID_BAR(); peer_v_phase(F, args, layer, 0.f); } \
        GRID_BAR(); \
    } while (0)
    const float* modb = (const float*)(ws + WS_MOD);
    bf16_t* HX = (bf16_t*)(ws + WS_HX);
    bf16_t* QKb = (bf16_t*)(ws + WS_QK);
    bf16_t* VTb = (bf16_t*)(ws + WS_VT);
    const bf16_t* Wqkv = (const bf16_t*)(ws + WS_WQKV);
    const int bx = (int)blockIdx.x;

    REP(1, p0_prologue(F, args));
    GRID_BAR();
    REP(2, norm_phase(F, args, 0, 0, 0, args.in[4]));
    GRID_BAR();
    {
        using SH1 = pg8::Shape<MT, 2048, DM, DM, DM, 1, 0, 0>;
        pg8::gemm_phase<SH1>(F.lds, pg8::Gemm{HX, Wqkv}, F.G, bx, pg8::EpiStoreBf16{QKb, 2048, 0});
        using SH2 = pg8::Shape<DM, MT, DM, DM, DM, 1, 0, 0>;
        pg8::gemm_phase<SH2>(F.lds, pg8::Gemm{Wqkv + (size_t)2048 * DM, HX}, F.G, bx, pg8::EpiStoreBf16{VTb, MT, 0});
        if (DBG_REP == 3) { pg8::gemm_phase<SH1>(F.lds, pg8::Gemm{HX, Wqkv}, F.G, bx, pg8::EpiStoreBf16{QKb, 2048, 0}); pg8::gemm_phase<SH2>(F.lds, pg8::Gemm{Wqkv + (size_t)2048 * DM, HX}, F.G, bx, pg8::EpiStoreBf16{VTb, MT, 0}); }
    }
    GRID_BAR();
    REP(4, attn_phase(F, args));
    GRID_BAR();
    {
        using SH = pg8::Shape<ML, DM, DM, DM, DM, 1, 0, 0>;
        pg8::gemm_phase<SH>(F.lds, pg8::Gemm{HX, (const bf16_t*)(ws + WS_WO)}, F.G, bx, pg8::EpiResid{args.in[0], args.out, modb + 2 * DM, NMOD, (DBG_SKIP & 1) ? 0.f : 1.f});
    }
    GRID_BAR();
    PEER_BLOCK(0);
    norm_phase(F, args, 1, 1, 0, args.in[4] + DM);
    GRID_BAR();
    {
        using SH = pg8::Shape<512, ML, 256, 256, DM, 4, 0, 256>;
        pg8::gemm_phase<SH>(F.lds, pg8::Gemm{(const bf16_t*)(ws + WS_WC), HX}, F.G, bx, pg8::EpiYt{QKb});
    }
    GRID_BAR();
    {
        using SH = pg8::Shape<SEQ, DM, 8192, 8192, 8192, NB, 0, (long)DM * 8192>;
        REP(14, pg8::gemm_phase<SH>(F.lds, pg8::Gemm{(const bf16_t*)(ws + WS_CS), QKb}, F.G, bx, pg8::EpiStoreBf16{VTb, DM, (long)SEQ * DM}));
    }
    GRID_BAR();
    {
        using SH = pg8::Shape<ML, DM, DM, DM, DM, 1, 0, 0>;
        pg8::gemm_phase<SH>(F.lds, pg8::Gemm{VTb, (const bf16_t*)(ws + WS_WF)}, F.G, bx, pg8::EpiResid{args.out, args.out, modb + (size_t)9 * NMOD + 2 * DM, NMOD, (DBG_SKIP & 4) ? 0.f : 1.f});
    }
    GRID_BAR();
    PEER_BLOCK(1);
    final_norm_phase(F, args);
#undef PEER_BLOCK
}

extern "C" void kernel_launch(void* const* d_in, const int* in_sizes, int n_in, void* d_out, int out_size, void* d_ws, size_t ws_size, hipStream_t stream) {
    static int grid = 0;
    if (grid == 0) {
        if (n_in != 17 || in_sizes[0] != ML * DM || out_size != ML * DM || ws_size < WS_END) { fprintf(stderr, "kernel_launch: unexpected shapes (n_in %d, in0 %d, out %d, ws %zu)\n", n_in, n_in > 0 ? in_sizes[0] : -1, out_size, ws_size); grid = -1; return; }
        int dev = 0, cus = 0, per_cu = 0;
        if (hipGetDevice(&dev) != hipSuccess || hipDeviceGetAttribute(&cus, hipDeviceAttributeMultiprocessorCount, dev) != hipSuccess) { grid = -1; return; }
        if (hipFuncSetAttribute((const void*)fwd_kernel, hipFuncAttributeMaxDynamicSharedMemorySize, LDS_BYTES) != hipSuccess) { fprintf(stderr, "kernel_launch: hipFuncSetAttribute failed\n"); grid = -1; return; }
        if (hipOccupancyMaxActiveBlocksPerMultiprocessor(&per_cu, (const void*)fwd_kernel, NWAVES * 64, LDS_BYTES) != hipSuccess || per_cu < 1)
            fprintf(stderr, "kernel_launch: note: occupancy query reports %d workgroups per CU\n", per_cu);
        (void)hipGetLastError();
        grid = cus;
        if (grid % 8 != 0) { fprintf(stderr, "kernel_launch: CU count %d is not a multiple of 8\n", cus); grid = -1; return; }
    }
    if (grid < 0) return;
    if (hipMemsetAsync((char*)d_ws + WS_CTL, 0, CTL_ZERO_BYTES, stream) != hipSuccess) { fprintf(stderr, "kernel_launch: memset failed\n"); return; }
    Args a{};
    for (int i = 0; i < 17; ++i) a.in[i] = (const float*)d_in[i];
    a.out = (float*)d_out; a.ws = (unsigned char*)d_ws;
    hipLaunchKernelGGL(fwd_kernel, dim3(grid), dim3(NWAVES * 64), LDS_BYTES, stream, a);
    const hipError_t le = hipPeekAtLastError();
    if (le != hipSuccess) fprintf(stderr, "kernel_launch: launch failed: %s\n", hipGetErrorName(le));
}
```

```cpp
#include <hip/hip_runtime.h>
#include <cstdio>
#include <cstdint>

#define LAS __attribute__((address_space(3)))
typedef unsigned short bf16_t;
typedef short bf16x8 __attribute__((ext_vector_type(8)));
typedef short s16x4 __attribute__((ext_vector_type(4)));
typedef float f32x2 __attribute__((ext_vector_type(2)));
typedef float f32x4 __attribute__((ext_vector_type(4)));
typedef float f32x16 __attribute__((ext_vector_type(16)));
typedef unsigned u32x2 __attribute__((ext_vector_type(2)));
typedef unsigned u32x4 __attribute__((ext_vector_type(4)));
typedef __bf16 bf16x2_t __attribute__((ext_vector_type(2)));

#ifndef DBG_SKIP
#define DBG_SKIP 0
#endif
constexpr int DM = 1024, NB = 8, SEQ = 4096, CTXL = 256, GW = 64;
constexpr int ML = NB * SEQ;
constexpr int MC = NB * CTXL;
constexpr int MT = ML + MC;
constexpr int NMOD = 6 * DM;
constexpr int NEXP = 16384;
constexpr float EPS = 1e-6f;
constexpr float LOG2E = 1.4426950408889634f;

constexpr size_t MiB = 1u << 20;
constexpr size_t WS_CTL = 0, CTL_ZERO_BYTES = 1 * MiB;
constexpr size_t WS_MOD = 1 * MiB;
constexpr size_t WS_WQKV = 2 * MiB;
constexpr size_t WS_WO = 8 * MiB;
constexpr size_t WS_WF = 10 * MiB;
constexpr size_t WS_WPQ = 12 * MiB;
constexpr size_t WS_SK = 20 * MiB;
constexpr size_t WS_WC = 20 * MiB + 256 * 1024;
constexpr size_t WS_CS = 22 * MiB;
constexpr size_t WS_TAB = 86 * MiB;
constexpr size_t WS_X8 = 150 * MiB;
constexpr size_t WS_WT = 182 * MiB;
constexpr size_t WS_PART = 282 * MiB;
constexpr float U_SCALE = 512.f, V_SCALE = 16.f, X_SCALE = 16.f;
constexpr size_t WS_HX = 214 * MiB;
constexpr size_t WS_QK = 282 * MiB;
constexpr size_t WS_VT = 418 * MiB;
constexpr size_t WS_IDX = WS_VT;
constexpr size_t WS_GATE = WS_VT + 8 * MiB;
constexpr size_t WS_END = 486 * MiB;
constexpr int CW_BAR = 4096;

__device__ __forceinline__ unsigned f2bf(float f) { unsigned u = __builtin_bit_cast(unsigned, f); return (u + 0x7fffu + ((u >> 16) & 1u)) >> 16; }
__device__ __forceinline__ unsigned pk2(float lo, float hi) { return f2bf(lo) | (f2bf(hi) << 16); }
__device__ __forceinline__ unsigned cvtpk(float lo, float hi) { f32x2 v = {lo, hi}; bf16x2_t b = __builtin_convertvector(v, bf16x2_t); return __builtin_bit_cast(unsigned, b); }
__device__ __forceinline__ float bflo(unsigned u) { return __builtin_bit_cast(float, u << 16); }
__device__ __forceinline__ float bfhi(unsigned u) { return __builtin_bit_cast(float, u & 0xffff0000u); }
__device__ __forceinline__ float wave_sum(float v) {
#pragma unroll
    for (int o = 1; o < 64; o <<= 1) v += __shfl_xor(v, o);
    return v;
}
__device__ __forceinline__ int crow(int r, int hi) { return (r & 3) + 8 * (r >> 2) + 4 * hi; }
__device__ __forceinline__ float gelu_erf(float v) {
    const float av = __builtin_fabsf(v), d = av * 0.2316418882f + 1.0f;
    const float t = __builtin_amdgcn_rcpf(d);
    float q = t * 0.5307027145f + (-0.7265760135f); q = q * t + 0.7107068705f; q = q * t + (-0.142248368f); q = q * t + 0.127414796f; q = q * t;
    const float e = __builtin_amdgcn_exp2f((v * v) * (-0.72134752044f));
    const float m = v * (q * e), r = v - m;
    return v < 0.f ? m : r;
}

namespace pg8 {
constexpr int BM = 256, BK = 64, HALF = 128, HTB = HALF * BK * 2, STAGE_BYTES = 8 * HTB, NXCD = 8, WGM = 8;
__host__ __device__ __forceinline__ int lds_byte(int r, int c) { const int st = (r >> 4) * 2 + (c >> 5), rr = r & 15, cc = c & 31, ob = rr * 64 + cc * 2; return st * 1024 + (ob ^ (((ob >> 9) & 1) << 5)); }
__host__ __device__ __forceinline__ void stage_rc(int b, int& R, int& C) { const int st = b / 1024, sb = b % 1024, swz = sb ^ (((sb >> 9) & 1) << 5); R = (st >> 1) * 16 + swz / 64; C = (st & 1) * 32 + (swz % 64) / 2; }
__host__ __device__ __forceinline__ int perm32(int rho) { const int n = rho >> 4, i = rho & 15; return 8 * (i >> 2) + 4 * n + (i & 3); }

struct Unit { int pm, pn, pb; };
struct Gemm { const bf16_t* A; const bf16_t* Bt; };
template <int M_, int N_, int K_, int LDA_, int LDB_, int NBATCH_, long BSA_, long BSB_> struct Shape { static constexpr int M = M_, N = N_, K = K_, lda = LDA_, ldb = LDB_, nbatch = NBATCH_; static constexpr long bsA = BSA_, bsB = BSB_; };

template <class SH> struct StaticOrder {
    static constexpr int nM = SH::M / BM, nN = SH::N / BM, per = nM * nN, nwg = per * SH::nbatch;
    int G, c;
    __device__ __forceinline__ void init(int G_, int c_) { G = G_; c = c_; }
    __device__ __forceinline__ bool next(int i, Unit& u) const {
        const long L = (long)i * G + c; if (L >= nwg) return false;
        int wgid = (int)L; { const int q = nwg / NXCD, r = nwg % NXCD, xcd = wgid % NXCD, off = wgid / NXCD; wgid = (xcd < r ? xcd * (q + 1) : r * (q + 1) + (xcd - r) * q) + off; }
        u.pb = wgid / per; wgid -= u.pb * per;
        const int nig = WGM * nN, gid = wgid / nig, fm = gid * WGM, gsz = (nM - fm) < WGM ? (nM - fm) : WGM;
        u.pm = fm + ((wgid % nig) % gsz); u.pn = (wgid % nig) / gsz; return true;
    }
};

struct EpiStoreBf16 {
    static constexpr bool PERM = true;
    bf16_t* O; long ldc; long bstride; int scols; float scale0;
    __device__ __forceinline__ void operator()(const f32x4 (&acc)[2][2][4][2], const Unit& u, int wr, int wc, int fr, int fq) const {
        const int row0 = u.pm * BM + wr * 64 + fr, col0 = u.pn * BM + wc * 32 + 8 * fq;
        bf16_t* base = O + (long)u.pb * bstride;
        const float sc = (u.pn * BM < scols) ? scale0 : 1.0f;
#pragma unroll
        for (int ai = 0; ai < 2; ++ai)
#pragma unroll
            for (int m = 0; m < 4; ++m) { bf16_t* rowp = base + (long)(row0 + ai * HALF + m * 16) * ldc + col0;
#pragma unroll
                for (int bj = 0; bj < 2; ++bj) { const f32x4 v0 = acc[ai][bj][m][0] * sc, v1 = acc[ai][bj][m][1] * sc;
                    u32x4 w; w.x = cvtpk(v0[0], v0[1]); w.y = cvtpk(v0[2], v0[3]); w.z = cvtpk(v1[0], v1[1]); w.w = cvtpk(v1[2], v1[3]);
                    *(u32x4*)(rowp + bj * HALF) = w; } }
    }
};
struct EpiDft2 {
    static constexpr bool PERM = true;
    bf16_t* O;
    __device__ __forceinline__ void operator()(const f32x4 (&acc)[2][2][4][2], const Unit& u, int wr, int wc, int fr, int fq) const {
        const int row0 = u.pm * BM + wr * 64 + fr, cl0 = wc * 32 + 8 * fq;
        bf16_t* base = O + (long)u.pb * SEQ * DM + u.pn * BM;
#pragma unroll
        for (int ai = 0; ai < 2; ++ai)
#pragma unroll
            for (int m = 0; m < 4; ++m) { const int np = row0 + ai * HALF + m * 16;
                bf16_t* rowp = base + (long)np * DM; bf16_t* mirp = base + (long)(SEQ - np) * DM;
#pragma unroll
                for (int bj = 0; bj < 2; ++bj) { const f32x4 v0 = acc[ai][bj][m][0], v1 = acc[ai][bj][m][1]; const int cl = cl0 + bj * HALF;
                    u32x4 w; w.x = cvtpk(v0[0], v0[1]); w.y = cvtpk(v0[2], v0[3]); w.z = cvtpk(v1[0], v1[1]); w.w = cvtpk(v1[2], v1[3]);
                    *(u32x4*)(rowp + cl) = w;
                    if (np != 0) {
#pragma unroll
                        for (int i = 0; i < 8; ++i) { const unsigned word = w[i >> 1]; mirp[(256 - cl - i) & 255] = (bf16_t)((i & 1) ? (word >> 16) : (word & 0xffffu)); } } }
                asm volatile("" ::: "memory"); }
    }
};
struct EpiYt {
    static constexpr bool PERM = true;
    bf16_t* Yt;
    __device__ __forceinline__ void operator()(const f32x4 (&acc)[2][2][4][2], const Unit& u, int wr, int wc, int fr, int fq) const {
        const int row0 = u.pm * BM + wr * 64 + fr, col0 = u.pn * BM + wc * 32 + 8 * fq;
#pragma unroll
        for (int ai = 0; ai < 2; ++ai)
#pragma unroll
            for (int m = 0; m < 4; ++m) { const int row = row0 + ai * HALF + m * 16; const int part = row >> 8, cp = row & 255;
#pragma unroll
                for (int bj = 0; bj < 2; ++bj) { const int col = col0 + bj * HALF; const int b = col >> 12, n = col & 4095;
                    const f32x4 v0 = acc[ai][bj][m][0], v1 = acc[ai][bj][m][1];
                    u32x4 w; w.x = cvtpk(v0[0], v0[1]); w.y = cvtpk(v0[2], v0[3]); w.z = cvtpk(v1[0], v1[1]); w.w = cvtpk(v1[2], v1[3]);
                    *(u32x4*)(Yt + ((((long)(b * 4 + u.pb) * 256 + cp) * 2 + part) << 12) + n) = w; }
                asm volatile("" ::: "memory"); }
    }
};
struct EpiResid {
    static constexpr bool PERM = false;
    const float* Xin; float* Xout; const float* gate; int gstride; float gs;
    __device__ __forceinline__ void operator()(const f32x4 (&acc)[2][2][4][2], const Unit& u, int wr, int wc, int fr, int fq) const {
        const int row0 = u.pm * BM + wr * 64 + fr, col0 = u.pn * BM + wc * 32 + 4 * fq;
        const float* gb = gate + (long)((u.pm * BM) >> 12) * gstride;
        f32x4 gv[2][2];
#pragma unroll
        for (int bj = 0; bj < 2; ++bj)
#pragma unroll
            for (int n = 0; n < 2; ++n) gv[bj][n] = *(const f32x4*)(gb + col0 + bj * HALF + n * 16);
#pragma unroll
        for (int ai = 0; ai < 2; ++ai)
#pragma unroll
            for (int m = 0; m < 4; ++m) { const long off = (long)(row0 + ai * HALF + m * 16) * DM + col0;
#pragma unroll
                for (int bj = 0; bj < 2; ++bj)
#pragma unroll
                    for (int n = 0; n < 2; ++n) { const f32x4 bs = *(const f32x4*)(Xin + off + bj * HALF + n * 16);
                        *(f32x4*)(Xout + off + bj * HALF + n * 16) = bs + gv[bj][n] * acc[ai][bj][m][n] * gs; }
                if (m & 1) asm volatile("" ::: "memory"); }
    }
};

template <class SH, class Epi>
__device__ __forceinline__ void gemm_phase(LAS unsigned char* lds, const Gemm g, int G_, int c_, const Epi& E) {
    StaticOrder<SH> S; S.init(G_, c_);
    int tid_ = threadIdx.x; asm volatile("" : "+v"(tid_));
    const int tid = tid_, wid = __builtin_amdgcn_readfirstlane(tid >> 6), lane = tid & 63, wr = wid >> 2, wc = wid & 3, fr = lane & 15, fq = lane >> 4;
    constexpr int K = SH::K, nt = K / BK;
    unsigned voffA[2], voffB[2];
#pragma unroll
    for (int i = 0; i < 2; ++i) { int R, C; stage_rc(tid * 16 + i * 8192, R, C); const int Rb = Epi::PERM ? ((R & ~31) + perm32(R & 31)) : R;
        voffA[i] = (unsigned)(R * SH::lda + C) * 2u; voffB[i] = (unsigned)(Rb * SH::ldb + C) * 2u; }
    constexpr size_t kstep = (size_t)(BK * 2);
    constexpr size_t hstepA = (size_t)HALF * SH::lda * 2, hstepB = (size_t)HALF * SH::ldb * 2;
    constexpr size_t tstepA = 2 * hstepA, tstepB = 2 * hstepB;
    const unsigned ldsw = (unsigned)wid * 1024u;
    const int aoff = lds_byte(wr * 64 + fr, fq * 8), boff = lds_byte(wc * 32 + fr, fq * 8);
#define PG8_SA(b, h) (((b) * 2 + (h)) * HTB)
#define PG8_SB(b, h) ((4 + (b) * 2 + (h)) * HTB)
#define PG8_STAGE(bufoff, gbase, voff) do { _Pragma("unroll") for (int _i = 0; _i < 2; ++_i) \
        __builtin_amdgcn_global_load_lds((const unsigned*)((const char*)(gbase) + (voff)[_i]), (LAS unsigned*)(lds + (bufoff) + ldsw + _i * 8192), 16, 0, 0); } while (0)
#define PG8_LDA(dst, b, h) do { _Pragma("unroll") for (int m = 0; m < 4; ++m) _Pragma("unroll") for (int k = 0; k < 2; ++k) dst[m][k] = *(const LAS bf16x8*)(lds + PG8_SA(b, h) + aoff + m * 2048 + k * 1024); } while (0)
#define PG8_LDB(dst, b, h) do { _Pragma("unroll") for (int n = 0; n < 2; ++n) _Pragma("unroll") for (int k = 0; k < 2; ++k) dst[n][k] = *(const LAS bf16x8*)(lds + PG8_SB(b, h) + boff + n * 2048 + k * 1024); } while (0)
#define PG8_MMA(ai, bj, At, Bt) do { __builtin_amdgcn_s_setprio(1); _Pragma("unroll") for (int m = 0; m < 4; ++m) _Pragma("unroll") for (int n = 0; n < 2; ++n) _Pragma("unroll") for (int k = 0; k < 2; ++k) \
        acc[ai][bj][m][n] = __builtin_amdgcn_mfma_f32_16x16x32_bf16(Bt[n][k], At[m][k], acc[ai][bj][m][n], 0, 0, 0); __builtin_amdgcn_s_setprio(0); } while (0)
#define PG8_WAIT_V(n) asm volatile("s_waitcnt vmcnt(" #n ")" ::: "memory")
#define PG8_WAIT_L(n) asm volatile("s_waitcnt lgkmcnt(" #n ")" ::: "memory")
#define PG8_BAR __builtin_amdgcn_s_barrier()
#define PG8_SCHED __builtin_amdgcn_sched_barrier(0)
    Unit cur, nxt; int ui = 0;
    if (!S.next(0, cur)) return;
    f32x4 acc[2][2][4][2];
#pragma unroll
    for (int a = 0; a < 2; ++a)
#pragma unroll
        for (int b = 0; b < 2; ++b)
#pragma unroll
            for (int m = 0; m < 4; ++m)
#pragma unroll
                for (int n = 0; n < 2; ++n) acc[a][b][m][n] = (f32x4){0.f, 0.f, 0.f, 0.f};
    bf16x8 At[4][2], B0[2][2], B1[2][2];
    const char* cA = (const char*)(g.A + (long)cur.pb * SH::bsA) + (size_t)cur.pm * tstepA; const char* cB = (const char*)(g.Bt + (long)cur.pb * SH::bsB) + (size_t)cur.pn * tstepB;
    PG8_STAGE(PG8_SB(0, 0), cB, voffB); PG8_STAGE(PG8_SB(0, 1), cB + hstepB, voffB); PG8_STAGE(PG8_SA(0, 0), cA, voffA); PG8_STAGE(PG8_SA(0, 1), cA + hstepA, voffA);
    if (wr == 1) PG8_BAR;
    PG8_WAIT_V(2); PG8_BAR;
    PG8_STAGE(PG8_SB(1, 0), cB + kstep, voffB); PG8_STAGE(PG8_SA(1, 0), cA + kstep, voffA); PG8_STAGE(PG8_SB(1, 1), cB + hstepB + kstep, voffB);
    PG8_WAIT_V(6); PG8_BAR;
    for (;;) {
        const bool has_next = S.next(ui + 1, nxt);
        const char* nA = has_next ? (const char*)(g.A + (long)nxt.pb * SH::bsA) + (size_t)nxt.pm * tstepA : cA; const char* nB = has_next ? (const char*)(g.Bt + (long)nxt.pb * SH::bsB) + (size_t)nxt.pn * tstepB : cB;
#pragma nounroll
        for (int t = 0; t < nt; t += 2) {
            const bool last = (t == nt - 2);
            const char* a1 = cA + (size_t)(t + 1) * kstep;
            const char* a2 = last ? nA : cA + (size_t)(t + 2) * kstep; const char* b2 = last ? nB : cB + (size_t)(t + 2) * kstep;
            const char* a3 = a2 + kstep; const char* b3 = b2 + kstep;
            PG8_LDB(B0, 0, 0); PG8_LDB(B1, 0, 1); PG8_SCHED; PG8_LDA(At, 0, 0); PG8_STAGE(PG8_SA(1, 1), a1 + hstepA, voffA);
            PG8_WAIT_V(8); PG8_WAIT_L(0); PG8_BAR; PG8_MMA(0, 0, At, B0); PG8_MMA(0, 1, At, B1); PG8_BAR; PG8_SCHED;
            PG8_LDA(At, 0, 1); PG8_STAGE(PG8_SB(0, 0), b2, voffB); PG8_STAGE(PG8_SB(0, 1), b2 + hstepB, voffB); PG8_STAGE(PG8_SA(0, 0), a2, voffA);
            PG8_WAIT_V(8); PG8_WAIT_L(0); PG8_BAR; PG8_MMA(1, 0, At, B0); PG8_MMA(1, 1, At, B1); PG8_BAR; PG8_SCHED;
            PG8_LDB(B0, 1, 0); PG8_LDB(B1, 1, 1); PG8_SCHED; PG8_LDA(At, 1, 0); PG8_STAGE(PG8_SA(0, 1), a2 + hstepA, voffA);
            PG8_WAIT_V(8); PG8_WAIT_L(0); PG8_BAR; PG8_MMA(0, 0, At, B0); PG8_MMA(0, 1, At, B1); PG8_BAR; PG8_SCHED;
            PG8_LDA(At, 1, 1); PG8_STAGE(PG8_SB(1, 0), b3, voffB); PG8_STAGE(PG8_SB(1, 1), b3 + hstepB, voffB); PG8_STAGE(PG8_SA(1, 0), a3, voffA);
            PG8_WAIT_V(8); PG8_WAIT_L(0); PG8_BAR; PG8_MMA(1, 0, At, B0); PG8_MMA(1, 1, At, B1); PG8_BAR; PG8_SCHED;
        }
        if (wr == 0) PG8_BAR;
        E(acc, cur, wr, wc, fr, fq);
        if (!has_next) break;
#pragma unroll
        for (int a = 0; a < 2; ++a)
#pragma unroll
            for (int b = 0; b < 2; ++b)
#pragma unroll
                for (int m = 0; m < 4; ++m)
#pragma unroll
                    for (int n = 0; n < 2; ++n) acc[a][b][m][n] = (f32x4){0.f, 0.f, 0.f, 0.f};
        cur = nxt; cA = nA; cB = nB; ++ui;
        if (wr == 1) PG8_BAR;
    }
    PG8_WAIT_V(0);
    PG8_BAR;
#undef PG8_SA
#undef PG8_SB
#undef PG8_STAGE
#undef PG8_LDA
#undef PG8_LDB
#undef PG8_MMA
#undef PG8_WAIT_V
#undef PG8_WAIT_L
#undef PG8_BAR
#undef PG8_SCHED
}
}

#define XB_TMO      128
#define XB_XCNT(j)  (256  + 64 * (j))
#define XB_XSUB(j)  (1280 + 64 * (j))
#define XB_XGEN(j)  (2304 + 64 * (j))
#define XB_TOP      3328
#define XB_TOPGEN   3392
#define XCD_BAR_WORDS 3456
#define XB_SPIN_CAP (1u << 18)
__device__ __forceinline__ unsigned xb_ld(unsigned* p)              { return __hip_atomic_load(p, __ATOMIC_RELAXED, __HIP_MEMORY_SCOPE_AGENT); }
__device__ __forceinline__ unsigned xb_add(unsigned* p, unsigned v) { return __hip_atomic_fetch_add(p, v, __ATOMIC_RELAXED, __HIP_MEMORY_SCOPE_AGENT); }
__device__ __forceinline__ unsigned xb_xcc_id() { return (unsigned)__builtin_amdgcn_s_getreg((3 << 11) | 20) & 0xFu; }
#define XB_SPIN(cond, bar) do { unsigned _sp = 0; while (cond) { __builtin_amdgcn_s_sleep(1); \
    if ((++_sp & 255u) == 0u) { if (xb_ld(&(bar)[XB_TMO])) break; if (_sp > XB_SPIN_CAP) { atomicAdd(&(bar)[XB_TMO], 1u); break; } } } } while (0)
struct XcdBarrier { unsigned* bar; unsigned x; volatile LAS unsigned* st; };
__device__ __forceinline__ XcdBarrier xcd_barrier_post(unsigned* bar, volatile LAS unsigned* st) {
    XcdBarrier b; b.bar = bar; b.x = xb_xcc_id(); b.st = st;
    if (threadIdx.x == 0) (void)xb_add(&bar[XB_XCNT(b.x)], 1u);
    return b;
}
__device__ __forceinline__ void xcd_barrier_complete(unsigned* bar, unsigned x, unsigned& nloc, unsigned& nx) {
    const unsigned G = gridDim.x * gridDim.y * gridDim.z;
    unsigned sum, cnt, mine, sp = 0u;
    for (;;) {
        sum = 0u; cnt = 0u; mine = 0u;
#pragma unroll
        for (unsigned j = 0; j < 16; ++j) { const unsigned c = xb_ld(&bar[XB_XCNT(j)]); sum += c; cnt += (c > 0u) ? 1u : 0u; mine = (j == x) ? c : mine; }
        if (sum == G) break;
        __builtin_amdgcn_s_sleep(1);
        if ((++sp & 255u) == 0u) { if (xb_ld(&bar[XB_TMO])) break; if (sp > XB_SPIN_CAP) { atomicAdd(&bar[XB_TMO], 1u); break; } }
    }
    nloc = mine > 0u ? mine : 1u; nx = cnt > 0u ? cnt : 1u;
}
__device__ __forceinline__ void xcd_barrier(const XcdBarrier& b) {
    asm volatile("s_waitcnt vmcnt(0)" ::: "memory");
    __syncthreads();
    if (threadIdx.x == 0) {
        unsigned* bar = b.bar;
        __builtin_amdgcn_s_waitcnt(0);
        unsigned nloc = b.st[0], nx = b.st[1];
        if (nloc == 0u) { xcd_barrier_complete(bar, b.x, nloc, nx); b.st[0] = nloc; b.st[1] = nx; }
        const unsigned old = xb_add(&bar[XB_XSUB(b.x)], 1u);
        const unsigned gen = old / nloc;
        if (old + 1u == (gen + 1u) * nloc) {
            __builtin_amdgcn_fence(__ATOMIC_RELEASE, "agent");
            asm volatile("s_waitcnt vmcnt(0)" ::: "memory");
            const unsigned og = xb_add(&bar[XB_TOP], 1u);
            const unsigned tg = og / nx;
            if (og + 1u == (tg + 1u) * nx) xb_add(&bar[XB_TOPGEN], 1u);
            else XB_SPIN(xb_ld(&bar[XB_TOPGEN]) == tg, bar);
            __builtin_amdgcn_fence(__ATOMIC_ACQUIRE, "agent");
            xb_add(&bar[XB_XGEN(b.x)], 1u);
            asm volatile("s_waitcnt vmcnt(0)" ::: "memory");
        } else {
            XB_SPIN(xb_ld(&bar[XB_XGEN(b.x)]) == gen, bar);
            __builtin_amdgcn_fence(__ATOMIC_ACQUIRE, "agent");
            asm volatile("s_waitcnt vmcnt(0)" ::: "memory");
        }
    }
    __syncthreads();
}

constexpr int RING_BYTES = 131072;
constexpr int LDSCTL_OFF = RING_BYTES, MISC_OFF = LDSCTL_OFF + 320;
constexpr int LDS_BYTES = 147456;
constexpr int NWAVES = 8;

struct Args { const float* in[17]; float* out; unsigned char* ws; };

struct Ctx {
    LAS unsigned char* lds;
    int tid, lane, wave, vcu, G;
};

__device__ __forceinline__ Ctx fresh(const Ctx& F) {
    Ctx C = F; int t = threadIdx.x; asm volatile("" : "+v"(t)); C.tid = t; C.lane = t & 63; return C;
}
__device__ __forceinline__ void p0_transpose_item(const float* W, int K, int N, bf16_t* WT, LAS float* scr, int item, int lane) {
    const int nblk = N / 32, kb = item / nblk, nb = item % nblk, k0 = 64 * kb, n0 = 32 * nb;
#pragma unroll 8
    for (int i = 0; i < 32; ++i) { const int kk = 2 * i + (lane >> 5); scr[kk * 33 + (lane & 31)] = W[(size_t)(k0 + kk) * N + n0 + (lane & 31)]; }
    asm volatile("s_waitcnt lgkmcnt(0)" ::: "memory");
    const int c = lane & 7;
#pragma unroll
    for (int j = 0; j < 4; ++j) { const int n = (lane >> 3) + 8 * j; const LAS float* s = scr + (8 * c) * 33 + n;
        u32x4 o; o.x = pk2(s[0 * 33], s[1 * 33]); o.y = pk2(s[2 * 33], s[3 * 33]); o.z = pk2(s[4 * 33], s[5 * 33]); o.w = pk2(s[6 * 33], s[7 * 33]);
        *(u32x4*)(WT + (size_t)(n0 + n) * K + k0 + 8 * c) = o; }
    asm volatile("s_waitcnt lgkmcnt(0)" ::: "memory");
}
__device__ __forceinline__ void cvt8(const float* src, bf16_t* dst) {
    const f32x4 a = *(const f32x4*)src, b = *(const f32x4*)(src + 4);
    u32x4 o; o.x = pk2(a[0], a[1]); o.y = pk2(a[2], a[3]); o.z = pk2(b[0], b[1]); o.w = pk2(b[2], b[3]);
    *(u32x4*)dst = o;
}

__device__ __forceinline__ void p0_prologue(const Ctx& F0, const Args& a) {
    const Ctx F = fresh(F0);
    unsigned char* ws = a.ws;
    const int gw = F.vcu * NWAVES + F.wave, NGW = F.G * NWAVES;
    const long gt = (long)F.vcu * 512 + F.tid, NGT = (long)F.G * 512;
    {
        LAS float* red = (LAS float*)(F.lds);
        const float* c = a.in[1]; const float* cctx = a.in[3]; const float* wmod = a.in[6]; const float* bmod = a.in[7];
        float* modb = (float*)(ws + WS_MOD);
        for (int item = F.vcu; item < 96; item += F.G) {
            const int l = item / 48, nc = item % 48, n0 = nc * 128 + 2 * F.lane, kb = F.wave * 128;
            float sv[9][2];
#pragma unroll
            for (int r = 0; r < 9; ++r)
#pragma unroll
                for (int j = 0; j < 2; ++j) { const int k = kb + 64 * j + F.lane; const float v = (r < 8) ? c[r * DM + k] : cctx[k]; sv[r][j] = v / (1.0f + __expf(-v)); }
            float acc[9][2];
#pragma unroll
            for (int r = 0; r < 9; ++r) { acc[r][0] = 0.f; acc[r][1] = 0.f; }
            const float* wp = wmod + (size_t)l * DM * NMOD + (size_t)kb * NMOD + n0;
#pragma unroll
            for (int j = 0; j < 2; ++j)
#pragma unroll 8
                for (int kl = 0; kl < 64; ++kl) {
                    const f32x2 w = *(const f32x2*)(wp + (size_t)(64 * j + kl) * NMOD);
#pragma unroll
                    for (int r = 0; r < 9; ++r) { const float s = __builtin_bit_cast(float, __builtin_amdgcn_readlane(__builtin_bit_cast(int, sv[r][j]), kl)); acc[r][0] += s * w[0]; acc[r][1] += s * w[1]; }
                }
            __syncthreads();
#pragma unroll
            for (int r = 0; r < 9; ++r) { red[(F.wave * 9 + r) * 128 + 2 * F.lane] = acc[r][0]; red[(F.wave * 9 + r) * 128 + 2 * F.lane + 1] = acc[r][1]; }
            __syncthreads();
            for (int o = F.tid; o < 9 * 128; o += 512) { const int r = o >> 7, nl = o & 127; float s = 0.f;
#pragma unroll
                for (int w = 0; w < 8; ++w) s += red[(w * 9 + r) * 128 + nl];
                modb[(size_t)(l * 9 + r) * NMOD + nc * 128 + nl] = s + bmod[l * NMOD + nc * 128 + nl]; }
        }
        __syncthreads();
    }
    {
        LAS float* scr = (LAS float*)(F.lds + F.wave * 16384);
        constexpr int I_QKV = (DM / 64) * (3 * DM / 32), I_O = (DM / 64) * (DM / 32), I_PQ = (DM / 64) * (2 * DM / 32);
        constexpr int NITEMS = I_QKV + 2 * I_O + 2 * I_PQ;
        for (int it = gw; it < NITEMS; it += NGW) {
            int r = it;
            if (r < I_QKV) { p0_transpose_item(a.in[8], DM, 3 * DM, (bf16_t*)(ws + WS_WQKV), scr, r, F.lane); continue; } r -= I_QKV;
            if (r < I_O) { p0_transpose_item(a.in[9], DM, DM, (bf16_t*)(ws + WS_WO), scr, r, F.lane); continue; } r -= I_O;
            if (r < I_O) { p0_transpose_item(a.in[11], DM, DM, (bf16_t*)(ws + WS_WF), scr, r, F.lane); continue; } r -= I_O;
            if (r < I_PQ) { p0_transpose_item(a.in[12], DM, 2 * DM, (bf16_t*)(ws + WS_WPQ), scr, r, F.lane); continue; } r -= I_PQ;
            p0_transpose_item(a.in[12] + (size_t)DM * 2 * DM, DM, 2 * DM, (bf16_t*)(ws + WS_WPQ) + (size_t)2 * DM * DM, scr, r, F.lane);
        }
    }
    for (long i = gt; i < 2 * 2 * 128 * 128 / 8; i += NGT) cvt8(a.in[13] + i * 8, (bf16_t*)(ws + WS_SK) + i * 8);
    {
        constexpr long PER = (long)NEXP * DM / 16;
        unsigned char* t8 = ws + WS_TAB;
        for (long i = gt; i < 4 * PER; i += NGT) {
            const int q = (int)(i / PER); const long r = i - (long)q * PER; const int l = q >> 1, tb = q & 1;
            const int e = (int)(r >> 6), c16 = (int)(r & 63);
            const float* src = (tb ? a.in[15] : a.in[14]) + ((size_t)l * NEXP + e) * DM + c16 * 16;
            const float sc = tb ? V_SCALE : U_SCALE;
            u32x4 o;
#pragma unroll
            for (int d = 0; d < 4; ++d) { const f32x4 v = *(const f32x4*)(src + 4 * d); int w = 0;
                w = __builtin_amdgcn_cvt_pk_fp8_f32(fminf(fmaxf(v[0] * sc, -448.f), 448.f), fminf(fmaxf(v[1] * sc, -448.f), 448.f), w, false);
                w = __builtin_amdgcn_cvt_pk_fp8_f32(fminf(fmaxf(v[2] * sc, -448.f), 448.f), fminf(fmaxf(v[3] * sc, -448.f), 448.f), w, true);
                o[d] = (unsigned)w; }
            *(u32x4*)(t8 + (((size_t)q * 8 + (c16 >> 3)) * NEXP + e) * 128 + (c16 & 7) * 16) = o;
        }
    }
    {
        bf16_t* wc = (bf16_t*)(ws + WS_WC);
        for (long i = gt; i < 512 * 256 / 8; i += NGT) { const int nn = (int)(i >> 5), k0 = (int)(i & 31) * 8; float v[8];
#pragma unroll
            for (int j = 0; j < 8; ++j) { const int m = ((k0 + j) * (nn & 255)) & 255; const float fr = (float)m * (1.0f / 256.0f);
                v[j] = (nn < 256 ? __builtin_amdgcn_cosf(fr) : __builtin_amdgcn_sinf(fr)) * (1.0f / 16.0f); }
            u32x4 o; o.x = pk2(v[0], v[1]); o.y = pk2(v[2], v[3]); o.z = pk2(v[4], v[5]); o.w = pk2(v[6], v[7]);
            *(u32x4*)(wc + i * 8) = o; }
        bf16_t* cs = (bf16_t*)(ws + WS_CS);
        for (long i = gt; i < 4096L * 8192 / 8; i += NGT) { const int np = (int)(i >> 10), c0 = (int)(i & 1023) * 8; const int part = c0 >> 12; float v[8];
#pragma unroll
            for (int j = 0; j < 8; ++j) { const int n = (c0 + j) & 4095; const int m = (n * np) & 4095; const float fr = (float)m * (1.0f / 4096.0f);
                v[j] = (part == 0 ? __builtin_amdgcn_cosf(fr) : -__builtin_amdgcn_sinf(fr)) * (1.0f / 64.0f); }
            u32x4 o; o.x = pk2(v[0], v[1]); o.y = pk2(v[2], v[3]); o.z = pk2(v[4], v[5]); o.w = pk2(v[6], v[7]);
            *(u32x4*)(cs + i * 8) = o; }
    }
}

__device__ __forceinline__ void norm_mod_row(const float* xrow, const float* gw, const float* sh, const float* sc, bf16_t* orow, int lane, unsigned char* x8 = nullptr, long trow = 0) {
    const f32x4* xr = (const f32x4*)xrow + lane;
    f32x4 v[4]; float s = 0.f;
#pragma unroll
    for (int j = 0; j < 4; ++j) { v[j] = xr[64 * j]; s += (v[j].x * v[j].x + v[j].y * v[j].y) + (v[j].z * v[j].z + v[j].w * v[j].w); }
    const float rstd = 1.0f / sqrtf(wave_sum(s) * (1.0f / DM) + EPS);
    unsigned long long* o8 = (unsigned long long*)orow + lane;
#pragma unroll
    for (int j = 0; j < 4; ++j) {
        const f32x4 g = ((const f32x4*)gw)[lane + 64 * j], a = ((const f32x4*)sh)[lane + 64 * j], c = ((const f32x4*)sc)[lane + 64 * j];
        const f32x4 y = (v[j] * rstd * g) * (c + 1.0f) + a;
        o8[64 * j] = (unsigned long long)cvtpk(y.x, y.y) | ((unsigned long long)cvtpk(y.z, y.w) << 32);
        if (x8) { int w = 0;
            w = __builtin_amdgcn_cvt_pk_fp8_f32(fminf(fmaxf(y.x * X_SCALE, -448.f), 448.f), fminf(fmaxf(y.y * X_SCALE, -448.f), 448.f), w, false);
            w = __builtin_amdgcn_cvt_pk_fp8_f32(fminf(fmaxf(y.z * X_SCALE, -448.f), 448.f), fminf(fmaxf(y.w * X_SCALE, -448.f), 448.f), w, true);
            *(int*)(x8 + ((size_t)(2 * j + (lane >> 5)) * ML + trow) * 128 + (4 * lane & 127)) = w; }
    }
}
__device__ __forceinline__ void norm_phase(const Ctx& F0, const Args& a, int mode, int layer, int off, const float* gw) {
    const Ctx F = fresh(F0);
    const int gwv = F.vcu * NWAVES + F.wave, NGW = F.G * NWAVES;
    const float* modb = (const float*)(a.ws + WS_MOD) + (size_t)layer * 9 * NMOD;
    bf16_t* hx = (bf16_t*)(a.ws + WS_HX);
    const int nrows = (mode == 0) ? MT : ML;
    for (int m = gwv; m < nrows; m += NGW) {
        const float* src; const float* mr;
        if (m < ML) { src = (mode == 0 ? a.in[0] : a.out) + (size_t)m * DM; mr = modb + (size_t)(m >> 12) * NMOD; }
        else { src = a.in[2] + (size_t)(m - ML) * DM; mr = modb + (size_t)8 * NMOD; }
        norm_mod_row(src, gw, mr + off, mr + off + DM, hx + (size_t)m * DM, F.lane);
    }
}
__device__ __forceinline__ void final_norm_phase(const Ctx& F0, const Args& a) {
    const Ctx F = fresh(F0);
    const int gwv = F.vcu * NWAVES + F.wave, NGW = F.G * NWAVES;
    const float* gw = a.in[16];
    for (int m = gwv; m < ML; m += NGW) {
        f32x4* xr = (f32x4*)(a.out + (size_t)m * DM) + F.lane;
        f32x4 v[4]; float s = 0.f;
#pragma unroll
        for (int j = 0; j < 4; ++j) { v[j] = xr[64 * j]; s += (v[j].x * v[j].x + v[j].y * v[j].y) + (v[j].z * v[j].z + v[j].w * v[j].w); }
        const float rstd = 1.0f / sqrtf(wave_sum(s) * (1.0f / DM) + EPS);
#pragma unroll
        for (int j = 0; j < 4; ++j) xr[64 * j] = v[j] * rstd * ((const f32x4*)gw)[F.lane + 64 * j];
    }
}

constexpr int ATT_ROWB = 144, ATT_TILEB = 64 * ATT_ROWB, ATT_BIAS_B = 2048, ATT_K0 = ATT_BIAS_B, ATT_V0 = ATT_K0 + 2 * ATT_TILEB;
constexpr float ATT_THR = 8.0f;
template <int NG, bool LATENT>
__device__ __forceinline__ void attn_sub(const LAS unsigned char* Kt, const LAS unsigned char* Vt_, int ko, const LAS float* brow, const int (&relidx)[8],
                                         const bf16x8 (&qf)[2], float& m_ref, float& l_run, f32x4 (&o)[4], int q16, int g4) {
    bf16x8 kf[2 * NG][2]; u32x2 vf[4][NG][2]; f32x4 sc[2 * NG];
#pragma unroll
    for (int blk = 0; blk < 2 * NG; ++blk)
#pragma unroll
        for (int ks = 0; ks < 2; ++ks) kf[blk][ks] = *(const LAS bf16x8*)(Kt + (ko + 16 * blk + q16) * ATT_ROWB + 64 * ks + 16 * g4);
#pragma unroll
    for (int d = 0; d < 4; ++d)
#pragma unroll
        for (int gk = 0; gk < NG; ++gk) { const LAS unsigned char* vp = Vt_ + (16 * d + q16) * ATT_ROWB + 2 * (ko + 32 * gk + 4 * g4);
            vf[d][gk][0] = *(const LAS u32x2*)vp; vf[d][gk][1] = *(const LAS u32x2*)(vp + 32); }
    if (LATENT) {
#pragma unroll
        for (int kk = 0; kk < 8; ++kk) sc[kk >> 2][kk & 3] = brow[relidx[kk]] - m_ref;
    } else {
#pragma unroll
        for (int blk = 0; blk < 2 * NG; ++blk) sc[blk] = (f32x4){-m_ref, -m_ref, -m_ref, -m_ref};
    }
#pragma unroll
    for (int blk = 0; blk < 2 * NG; ++blk)
#pragma unroll
        for (int ks = 0; ks < 2; ++ks) sc[blk] = __builtin_amdgcn_mfma_f32_16x16x32_bf16(kf[blk][ks], qf[ks], sc[blk], 0, 0, 0);
    float mx = fmaxf(fmaxf(sc[0][0], sc[0][1]), fmaxf(sc[0][2], sc[0][3]));
#pragma unroll
    for (int blk = 1; blk < 2 * NG; ++blk) mx = fmaxf(mx, fmaxf(fmaxf(sc[blk][0], sc[blk][1]), fmaxf(sc[blk][2], sc[blk][3])));
    if (__builtin_amdgcn_ballot_w64(mx > ATT_THR) != 0ull) {
        mx = fmaxf(mx, __shfl_xor(mx, 16)); mx = fmaxf(mx, __shfl_xor(mx, 32));
        const float dl = mx > ATT_THR ? mx : 0.f;
        m_ref += dl;
        const float al = __builtin_amdgcn_exp2f(-dl);
        l_run *= al;
#pragma unroll
        for (int d = 0; d < 4; ++d) o[d] *= al;
#pragma unroll
        for (int blk = 0; blk < 2 * NG; ++blk) sc[blk] -= dl;
    }
    float ls = 0.f;
#pragma unroll
    for (int blk = 0; blk < 2 * NG; ++blk)
#pragma unroll
        for (int i = 0; i < 4; ++i) { const float e = __builtin_amdgcn_exp2f(sc[blk][i]); sc[blk][i] = e; ls += e; }
    l_run += ls;
    bf16x8 pf[NG];
#pragma unroll
    for (int gk = 0; gk < NG; ++gk) { u32x4 pw; pw.x = cvtpk(sc[2 * gk][0], sc[2 * gk][1]); pw.y = cvtpk(sc[2 * gk][2], sc[2 * gk][3]); pw.z = cvtpk(sc[2 * gk + 1][0], sc[2 * gk + 1][1]); pw.w = cvtpk(sc[2 * gk + 1][2], sc[2 * gk + 1][3]);
        pf[gk] = __builtin_bit_cast(bf16x8, pw); }
#pragma unroll
    for (int gk = 0; gk < NG; ++gk)
#pragma unroll
        for (int d = 0; d < 4; ++d) { u32x4 vw; vw.x = vf[d][gk][0].x; vw.y = vf[d][gk][0].y; vw.z = vf[d][gk][1].x; vw.w = vf[d][gk][1].y;
            o[d] = __builtin_amdgcn_mfma_f32_16x16x32_bf16(__builtin_bit_cast(bf16x8, vw), pf[gk], o[d], 0, 0, 0); }
}
__device__ __forceinline__ void attn_phase(const Ctx& F0, const Args& a) {
    const Ctx F = fresh(F0);
    const bf16_t* QK = (const bf16_t*)(a.ws + WS_QK);
    const bf16_t* VT = (const bf16_t*)(a.ws + WS_VT);
    bf16_t* AO = (bf16_t*)(a.ws + WS_HX);
    const float* rpb = a.in[10];
    LAS float* bias = (LAS float*)F.lds;
    const int tid = F.tid, lane = F.lane, q16 = lane & 15, g4 = lane >> 4;
    const int rr = F.wave >> 2, jt = F.wave & 3;
    const int qc = 16 * jt + q16, cs = min(max(qc - 8, 0), 48), ksj = min(max(16 * jt - 8, 0), 32);
    int relidx[8];
#pragma unroll
    for (int k = 0; k < 8; ++k) { const int kc = ksj + 16 * (k >> 2) + 4 * g4 + (k & 3); relidx[k] = (kc >= cs && kc < cs + 16) ? (kc - qc + 15) : 31; }
    const int lrow = tid >> 3, lch = tid & 7;
    const unsigned lds_st = (unsigned)(lrow * ATT_ROWB + lch * 16);
    const int nunits = NB * 16 * 32, upb = (nunits + F.G - 1) / F.G;
    int cur_bh = -1;
    for (int k = 0; k < upb; ++k) {
        int p, bh;
        if (F.G == 256) { p = F.vcu & 31; bh = (F.vcu >> 5) + 8 * k; }
        else { const int id = F.vcu * upb + k; if (id >= nunits) break; p = id & 31; bh = id >> 5; }
        const int b = bh >> 4, h = bh & 15;
        if (bh != cur_bh) {
            __syncthreads();
            for (int i = tid; i < 15 * 32; i += 512) { const int dr = i >> 5, dc = i & 31; bias[i] = (dc < 31) ? rpb[(h * 15 + dr) * 31 + dc] * LOG2E : -1e30f; }
            cur_bh = bh;
        }
        const int r0 = 2 * p, rs0 = min(max(r0 - 4, 0), 56), rs1 = min(max(r0 + 1 - 4, 0), 56);
        const int nlat = rs1 + 8 - rs0, nsteps = nlat + 4;
        const int r = r0 + rr, rs = rr ? rs1 : rs0;
        const long tokq = (long)b * SEQ + r * GW + qc;
        const bf16_t* kbase = QK + 1024 + h * 64 + lch * 8;
        const bf16_t* vbase = VT + (long)(h * 64 + lrow) * MT + lch * 8;
#define ATT_TOK0(step) ((step) < nlat ? ((long)b * SEQ + (long)(rs0 + (step)) * GW) : ((long)ML + b * CTXL + ((step) - nlat) * 64))
        u32x4 kA, vA, kB, vB, kC, vC, kD, vD;
#define ATT_LOAD(step, kr_, vr_) do { const int st_ = (step) < nsteps ? (step) : nsteps - 1; const long t_ = ATT_TOK0(st_);     \
        kr_ = *(const u32x4*)(kbase + (t_ + lrow) * 2048); vr_ = *(const u32x4*)(vbase + t_); } while (0)
#define ATT_WRITE(buf, kr_, vr_) do { *(LAS u32x4*)(F.lds + ATT_K0 + (buf) * ATT_TILEB + lds_st) = kr_; *(LAS u32x4*)(F.lds + ATT_V0 + (buf) * ATT_TILEB + lds_st) = vr_; } while (0)
        ATT_LOAD(0, kA, vA); ATT_LOAD(1, kB, vB); ATT_LOAD(2, kC, vC); ATT_LOAD(3, kD, vD);
        bf16x8 qf[2];
#pragma unroll
        for (int ks = 0; ks < 2; ++ks) qf[ks] = *(const bf16x8*)(QK + tokq * 2048 + h * 64 + 32 * ks + 8 * g4);
        float m_ref = 0.f, l_run = 0.f;
        f32x4 o[4];
#pragma unroll
        for (int d = 0; d < 4; ++d) o[d] = (f32x4){0.f, 0.f, 0.f, 0.f};
        __syncthreads();
        ATT_WRITE(0, kA, vA);
        asm volatile("" :: "v"(qf[0]), "v"(qf[1]));
        __syncthreads();
#define ATT_COMPUTE(step, cur) do { \
            const LAS unsigned char* Kt = F.lds + ATT_K0 + (cur) * ATT_TILEB; \
            const LAS unsigned char* Vt_ = F.lds + ATT_V0 + (cur) * ATT_TILEB; \
            if ((step) < nlat) { const int kr = rs0 + (step); \
                if (kr >= rs && kr < rs + 8) attn_sub<1, true>(Kt, Vt_, ksj, bias + (kr - r + 7) * 32, relidx, qf, m_ref, l_run, o, q16, g4); \
            } else attn_sub<2, false>(Kt, Vt_, 0, bias, relidx, qf, m_ref, l_run, o, q16, g4); \
        } while (0)
        for (int step = 0; step < nsteps; step += 4) {
            ATT_COMPUTE(step, 0);
            if (step + 1 < nsteps) ATT_WRITE(1, kB, vB);
            ATT_LOAD(step + 4, kA, vA);
            __syncthreads();
            if (step + 1 < nsteps) { ATT_COMPUTE(step + 1, 1); }
            if (step + 2 < nsteps) ATT_WRITE(0, kC, vC);
            ATT_LOAD(step + 5, kB, vB);
            __syncthreads();
            if (step + 2 < nsteps) { ATT_COMPUTE(step + 2, 0); }
            if (step + 3 < nsteps) ATT_WRITE(1, kD, vD);
            ATT_LOAD(step + 6, kC, vC);
            __syncthreads();
            if (step + 3 < nsteps) { ATT_COMPUTE(step + 3, 1); }
            if (step + 4 < nsteps) ATT_WRITE(0, kA, vA);
            ATT_LOAD(step + 7, kD, vD);
            __syncthreads();
        }
#undef ATT_LOAD
#undef ATT_WRITE
#undef ATT_COMPUTE
#undef ATT_TOK0
        l_run += __shfl_xor(l_run, 16); l_run += __shfl_xor(l_run, 32);
        const float linv = 1.0f / l_run;
        bf16_t* op = AO + tokq * DM + h * 64 + 4 * g4;
#pragma unroll
        for (int d = 0; d < 4; ++d) { u32x2 w; w.x = cvtpk(o[d][0] * linv, o[d][1] * linv); w.y = cvtpk(o[d][2] * linv, o[d][3] * linv); *(u32x2*)(op + 16 * d) = w; }
    }
    __syncthreads();
}

__device__ __forceinline__ void ce_desc(float& a, float& b) { const float hi = fmaxf(a, b), lo = fminf(a, b); a = hi; b = lo; }
__device__ __forceinline__ void ce_dir(float& a, float& b, bool desc) { const float hi = fmaxf(a, b), lo = fminf(a, b); a = desc ? hi : lo; b = desc ? lo : hi; }
__device__ __forceinline__ void sort16_desc(float (&v)[16]) {
#pragma unroll
    for (int k = 2; k <= 16; k <<= 1)
#pragma unroll
        for (int j = k >> 1; j > 0; j >>= 1)
#pragma unroll
            for (int i = 0; i < 16; ++i) { const int l = i ^ j; if (l > i) ce_dir(v[i], v[l], (i & k) == 0); }
}
__device__ __forceinline__ void merge16_desc(float (&a)[16], const float (&b)[16]) {
#pragma unroll
    for (int i = 0; i < 16; ++i) a[i] = fmaxf(a[i], b[15 - i]);
#pragma unroll
    for (int j = 8; j > 0; j >>= 1)
#pragma unroll
        for (int i = 0; i < 16; ++i) { const int l = i ^ j; if (l > i) ce_desc(a[i], a[l]); }
}

struct CandTab { int i[64]; int j[64]; };
__host__ __device__ constexpr CandTab make_cand_tab() {
    CandTab t{}; int n = 0;
    for (int i = 0; i < 16; ++i) for (int j = 0; j < 16; ++j) if ((i + 1) * (j + 1) <= 16) { t.i[n] = i; t.j[n] = j; ++n; }
    for (; n < 64; ++n) { t.i[n] = -1; t.j[n] = -1; }
    return t;
}

__device__ __forceinline__ void peer_topk_phase(const Ctx& F0, const Args& a, int layer) {
    const Ctx F = fresh(F0);
    const bf16_t* QP = (const bf16_t*)(a.ws + WS_QK);
    const bf16_t* SK = (const bf16_t*)(a.ws + WS_SK) + (size_t)layer * 2 * 128 * 128;
    unsigned short* IDX = (unsigned short*)(a.ws + WS_IDX);
    float* GATE = (float*)(a.ws + WS_GATE);
    const int gwv = F.vcu * NWAVES + F.wave, NGW = F.G * NWAVES;
    const int lane = F.lane, t32 = lane & 31, hi = lane >> 5;
    __syncthreads();
    for (int c = F.tid; c < 4096; c += 512) *(LAS u32x4*)(F.lds + (c >> 4) * 272 + (c & 15) * 16) = *(const u32x4*)(SK + (size_t)c * 8);
    __syncthreads();
    for (int task = gwv; task < 1024 * 8; task += NGW) {
        const int tt = task >> 3, h = task & 7;
        const long tok = (long)tt * 32 + t32;
        float top[2][16];
#pragma unroll
        for (int p = 0; p < 2; ++p) {
            f32x16 acc[4];
#pragma unroll
            for (int eb = 0; eb < 4; ++eb)
#pragma unroll
                for (int i = 0; i < 16; ++i) acc[eb][i] = 0.f;
#pragma unroll
            for (int eb = 0; eb < 4; ++eb) asm volatile("" : "+v"(acc[eb]));
            const bf16_t* qp = QP + tok * 2048 + h * 256 + p * 128 + hi * 8;
            const LAS unsigned char* kp = F.lds + (p * 128 + t32) * 272 + hi * 16;
#pragma unroll
            for (int ks = 0; ks < 8; ++ks) {
                if ((ks & 1) == 0) asm volatile("" ::: "memory");
                const bf16x8 bq = *(const bf16x8*)(qp + ks * 16);
#pragma unroll
                for (int eb = 0; eb < 4; ++eb) { const bf16x8 ak = *(const LAS bf16x8*)(kp + eb * 32 * 272 + ks * 32); acc[eb] = __builtin_amdgcn_mfma_f32_32x32x16_bf16(ak, bq, acc[eb], 0, 0, 0); }
            }
            float cur[16];
#pragma unroll
            for (int eb = 0; eb < 4; ++eb) {
                float v[16];
#pragma unroll
                for (int i = 0; i < 16; ++i) { const unsigned e = 32 * eb + crow(i, hi); float x = acc[eb][i]; asm volatile("" : "+v"(x));
                    v[i] = __builtin_bit_cast(float, (__builtin_bit_cast(unsigned, x) & ~0x7Fu) | e); }
                sort16_desc(v);
                if (eb == 0) {
#pragma unroll
                    for (int i = 0; i < 16; ++i) cur[i] = v[i];
                } else merge16_desc(cur, v);
            }
            float oth[16];
#pragma unroll
            for (int i = 0; i < 16; ++i) oth[i] = __shfl_xor(cur[i], 32);
            merge16_desc(cur, oth);
#pragma unroll
            for (int i = 0; i < 16; ++i) top[p][i] = cur[i];
            __builtin_amdgcn_sched_barrier(0);
        }
        float best[16];
#pragma unroll
        for (int gI = 0; gI < 4; ++gI) {
            float v[16];
#pragma unroll
            for (int q = 0; q < 16; ++q) {
                constexpr CandTab CT = make_cand_tab();
                const int ci = CT.i[16 * gI + q], cj = CT.j[16 * gI + q];
                if (ci >= 0) {
                    const unsigned ua = __builtin_bit_cast(unsigned, top[0][ci]), ub = __builtin_bit_cast(unsigned, top[1][cj]);
                    float s = top[0][ci] + top[1][cj]; asm volatile("" : "+v"(s));
                    const unsigned code = ((ua & 0x7Fu) << 7) | (ub & 0x7Fu);
                    v[q] = __builtin_bit_cast(float, (__builtin_bit_cast(unsigned, s) & ~0x3FFFu) | code);
                } else v[q] = -3.0e38f;
            }
            sort16_desc(v);
            if (gI == 0) {
#pragma unroll
                for (int i = 0; i < 16; ++i) best[i] = v[i];
            } else merge16_desc(best, v);
            __builtin_amdgcn_sched_barrier(0);
        }
        float e[16], sum = 0.f;
#pragma unroll
        for (int i = 0; i < 16; ++i) { e[i] = __builtin_amdgcn_exp2f((best[i] - best[0]) * LOG2E); sum += e[i]; }
        const float inv = 1.0f / sum;
        if (hi == 0) {
            u32x4 w0, w1;
            w0.x = (__builtin_bit_cast(unsigned, best[0]) & 0x3FFFu) | ((__builtin_bit_cast(unsigned, best[1]) & 0x3FFFu) << 16);
            w0.y = (__builtin_bit_cast(unsigned, best[2]) & 0x3FFFu) | ((__builtin_bit_cast(unsigned, best[3]) & 0x3FFFu) << 16);
            w0.z = (__builtin_bit_cast(unsigned, best[4]) & 0x3FFFu) | ((__builtin_bit_cast(unsigned, best[5]) & 0x3FFFu) << 16);
            w0.w = (__builtin_bit_cast(unsigned, best[6]) & 0x3FFFu) | ((__builtin_bit_cast(unsigned, best[7]) & 0x3FFFu) << 16);
            w1.x = (__builtin_bit_cast(unsigned, best[8]) & 0x3FFFu) | ((__builtin_bit_cast(unsigned, best[9]) & 0x3FFFu) << 16);
            w1.y = (__builtin_bit_cast(unsigned, best[10]) & 0x3FFFu) | ((__builtin_bit_cast(unsigned, best[11]) & 0x3FFFu) << 16);
            w1.z = (__builtin_bit_cast(unsigned, best[12]) & 0x3FFFu) | ((__builtin_bit_cast(unsigned, best[13]) & 0x3FFFu) << 16);
            w1.w = (__builtin_bit_cast(unsigned, best[14]) & 0x3FFFu) | ((__builtin_bit_cast(unsigned, best[15]) & 0x3FFFu) << 16);
            u32x4* ip = (u32x4*)(IDX + tok * 128 + h * 16);
            ip[0] = w0; ip[1] = w1;
        } else {
            f32x4* gp = (f32x4*)(GATE + tok * 128 + h * 16);
#pragma unroll
            for (int q = 0; q < 4; ++q) gp[q] = (f32x4){e[4 * q] * inv, e[4 * q + 1] * inv, e[4 * q + 2] * inv, e[4 * q + 3] * inv};
        }
    }
    __syncthreads();
}

typedef long i64_t;
template <int CTRL> __device__ __forceinline__ float dpp_f(float v) { return __builtin_bit_cast(float, __builtin_amdgcn_update_dpp(0, __builtin_bit_cast(int, v), CTRL, 0xF, 0xF, true)); }
__device__ __forceinline__ void peer_u_phase(const Ctx& F0, const Args& a, int layer) {
    const Ctx F = fresh(F0);
    const int s = (int)(blockIdx.x & 7), j = (int)(blockIdx.x >> 3), nmem = F.G >> 3;
    const unsigned char* U8s = a.ws + WS_TAB + ((size_t)(2 * layer) * 8 + s) * NEXP * 128;
    const bf16_t* HX = (const bf16_t*)(a.ws + WS_HX);
    const unsigned short* IDX = (const unsigned short*)(a.ws + WS_IDX);
    float* PART = (float*)(a.ws + WS_PART) + (size_t)s * ML * 128;
    const int lane = F.lane, rsub = lane >> 3, c16 = lane & 7;
    const bool c2 = (lane & 4) != 0, c1 = (lane & 2) != 0, c0 = (lane & 1) != 0;
    const int t0 = j * NWAVES + F.wave, stride = nmem * NWAVES, ntok = (ML - t0 + stride - 1) / stride;
#define U_TOK(i) ((size_t)(t0 + ((i) < ntok ? (i) : ntok - 1) * stride))
    u32x4 iN[2];
    { const size_t o_ = U_TOK(0) * 128 + 16 * rsub; iN[0] = *(const u32x4*)(IDX + o_); iN[1] = *(const u32x4*)(IDX + o_ + 8); }
    for (int i = 0; i < ntok; ++i) {
        u32x4 R[16];
#pragma unroll
        for (int i_ = 0; i_ < 16; ++i_) { const unsigned pair_ = iN[i_ >> 3][(i_ & 7) >> 1]; const unsigned e_ = (i_ & 1) ? (pair_ >> 16) : (pair_ & 0xffffu);
            R[i_] = *(const u32x4*)(U8s + (unsigned)(e_ * 128 + 16 * c16)); }
        const size_t t_ = U_TOK(i);
        const u32x4 xa = *(const u32x4*)(HX + t_ * DM + 128 * s + 16 * c16), xb = *(const u32x4*)(HX + t_ * DM + 128 * s + 16 * c16 + 8);
        { const size_t o_ = U_TOK(i + 1) * 128 + 16 * rsub; iN[0] = *(const u32x4*)(IDX + o_); iN[1] = *(const u32x4*)(IDX + o_ + 8); }
        f32x2 xf[8];
#pragma unroll
        for (int d = 0; d < 4; ++d) { xf[d] = (f32x2){bflo(xa[d]), bfhi(xa[d])}; xf[4 + d] = (f32x2){bflo(xb[d]), bfhi(xb[d])}; }
        float v[16];
#pragma unroll
        for (int i_ = 0; i_ < 16; ++i_) { f32x2 p2 = (f32x2){0.f, 0.f};
#pragma unroll
            for (int d = 0; d < 4; ++d) { const f32x2 lo_ = __builtin_amdgcn_cvt_pk_f32_fp8((int)R[i_][d], false), hi_ = __builtin_amdgcn_cvt_pk_f32_fp8((int)R[i_][d], true);
                p2 += lo_ * xf[2 * d] + hi_ * xf[2 * d + 1]; }
            v[i_] = p2[0] + p2[1]; }
        float a8[8], a4[4], a2[2];
#pragma unroll
        for (int k = 0; k < 8; ++k) { const float keep = c2 ? v[k + 8] : v[k], send = c2 ? v[k] : v[k + 8]; a8[k] = keep + dpp_f<0x141>(send); }
#pragma unroll
        for (int k = 0; k < 4; ++k) { const float keep = c1 ? a8[k + 4] : a8[k], send = c1 ? a8[k] : a8[k + 4]; a4[k] = keep + dpp_f<0x4E>(send); }
#pragma unroll
        for (int k = 0; k < 2; ++k) { const float keep = c0 ? a4[k + 2] : a4[k], send = c0 ? a4[k] : a4[k + 2]; a2[k] = keep + dpp_f<0xB1>(send); }
        *(f32x2*)(PART + t_ * 128 + 2 * lane) = (f32x2){a2[0], a2[1]};
    }
#undef U_TOK
}
__device__ __forceinline__ void peer_w_phase(const Ctx& F0, const Args& a) {
    const Ctx F = fresh(F0);
    const float* PART = (const float*)(a.ws + WS_PART);
    const float* GATE = (const float*)(a.ws + WS_GATE);
    float* WT = (float*)(a.ws + WS_WT);
    const int gwv = F.vcu * NWAVES + F.wave, NGW = F.G * NWAVES;
    for (int t = gwv; t < ML; t += NGW) {
        f32x2 z = (f32x2){0.f, 0.f};
#pragma unroll
        for (int s = 0; s < 8; ++s) z += *(const f32x2*)(PART + ((size_t)s * ML + t) * 128 + 2 * F.lane);
        const f32x2 g = *(const f32x2*)(GATE + (size_t)t * 128 + 2 * F.lane);
        f32x2 w; w.x = g.x * gelu_erf(z.x * (1.0f / U_SCALE)); w.y = g.y * gelu_erf(z.y * (1.0f / U_SCALE));
        *(f32x2*)(WT + (size_t)t * 128 + 2 * F.lane) = w;
    }
}
__device__ __forceinline__ void peer_v_phase(const Ctx& F0, const Args& a, int layer, float oscale = 1.0f) {
    const Ctx F = fresh(F0);
    const int s = (int)(blockIdx.x & 7), j = (int)(blockIdx.x >> 3), nmem = F.G >> 3;
    const unsigned char* V8s = a.ws + WS_TAB + ((size_t)(2 * layer + 1) * 8 + s) * NEXP * 128;
    const unsigned short* IDX = (const unsigned short*)(a.ws + WS_IDX);
    const float* WT = (const float*)(a.ws + WS_WT);
    const float* modb = (const float*)(a.ws + WS_MOD) + (size_t)layer * 9 * NMOD;
    float* X = a.out;
    const int lane = F.lane, rsub = lane >> 3, c16 = lane & 7;
    LAS float* red = (LAS float*)(F.lds + F.wave * 4096);
    const float dbg_s = ((DBG_SKIP & (layer == 0 ? 2 : 8)) ? 0.f : oscale) * (1.0f / V_SCALE);
    const int t0 = j * NWAVES + F.wave, stride = nmem * NWAVES, ntok = (ML - t0 + stride - 1) / stride;
#define V_TOK(i) ((size_t)(t0 + ((i) < ntok ? (i) : ntok - 1) * stride))
#define V_LOAD_IW(dI, dW, i) do { const size_t o_ = V_TOK(i) * 128 + 16 * rsub; dI[0] = *(const u32x4*)(IDX + o_); dI[1] = *(const u32x4*)(IDX + o_ + 8); \
        _Pragma("unroll") for (int q = 0; q < 4; ++q) dW[q] = *(const f32x4*)(WT + o_ + 4 * q); } while (0)
#define V_LOAD_ROWS(dR, iv) do { _Pragma("unroll") for (int i_ = 0; i_ < 16; ++i_) { const unsigned pair_ = iv[i_ >> 3][(i_ & 7) >> 1]; const unsigned e_ = (i_ & 1) ? (pair_ >> 16) : (pair_ & 0xffffu); \
        dR[i_] = *(const u32x4*)(V8s + (unsigned)(e_ * 128 + 16 * c16)); } } while (0)
#define V_COMPUTE(R, W, i) do { float acc_[16]; _Pragma("unroll") for (int c = 0; c < 16; ++c) acc_[c] = 0.f; \
        _Pragma("unroll") for (int i_ = 0; i_ < 16; ++i_) { const float w_ = W[i_ >> 2][i_ & 3]; \
            _Pragma("unroll") for (int d = 0; d < 4; ++d) { const f32x2 lo_ = __builtin_amdgcn_cvt_pk_f32_fp8((int)R[i_][d], false), hi_ = __builtin_amdgcn_cvt_pk_f32_fp8((int)R[i_][d], true); \
                acc_[4 * d + 0] += w_ * lo_[0]; acc_[4 * d + 1] += w_ * lo_[1]; acc_[4 * d + 2] += w_ * hi_[0]; acc_[4 * d + 3] += w_ * hi_[1]; } } \
        _Pragma("unroll") for (int q = 0; q < 4; ++q) *(LAS f32x4*)(red + rsub * 128 + c16 * 16 + 4 * q) = (f32x4){acc_[4 * q], acc_[4 * q + 1], acc_[4 * q + 2], acc_[4 * q + 3]}; \
        f32x2 sum_ = (f32x2){0.f, 0.f}; \
        _Pragma("unroll") for (int r = 0; r < 8; ++r) sum_ += *(const LAS f32x2*)(red + r * 128 + 2 * lane); \
        if ((i) < ntok) { const size_t t_ = V_TOK(i); \
            const f32x2 g_ = *(const f32x2*)(modb + (t_ >> 12) * NMOD + 5 * DM + 128 * s + 2 * lane) * dbg_s; \
            f32x2* xo_ = (f32x2*)(X + t_ * DM + 128 * s + 2 * lane); *xo_ = *xo_ + g_ * sum_; } } while (0)
    u32x4 iN[2]; f32x4 wN[4];
    V_LOAD_IW(iN, wN, 0);
    for (int i = 0; i < ntok; ++i) {
        u32x4 R[16]; f32x4 wC[4];
        V_LOAD_ROWS(R, iN);
#pragma unroll
        for (int q = 0; q < 4; ++q) wC[q] = wN[q];
        V_LOAD_IW(iN, wN, i + 1);
        float acc[16];
#pragma unroll
        for (int c = 0; c < 16; ++c) acc[c] = 0.f;
#pragma unroll
        for (int i_ = 0; i_ < 16; ++i_) { const float w_ = wC[i_ >> 2][i_ & 3];
#pragma unroll
            for (int d = 0; d < 4; ++d) { const f32x2 lo_ = __builtin_amdgcn_cvt_pk_f32_fp8((int)R[i_][d], false), hi_ = __builtin_amdgcn_cvt_pk_f32_fp8((int)R[i_][d], true);
                acc[4 * d + 0] += w_ * lo_[0]; acc[4 * d + 1] += w_ * lo_[1]; acc[4 * d + 2] += w_ * hi_[0]; acc[4 * d + 3] += w_ * hi_[1]; } }
#pragma unroll
        for (int q = 0; q < 4; ++q) *(LAS f32x4*)(red + rsub * 128 + c16 * 16 + 4 * q) = (f32x4){acc[4 * q], acc[4 * q + 1], acc[4 * q + 2], acc[4 * q + 3]};
        f32x2 sum = (f32x2){0.f, 0.f};
#pragma unroll
        for (int r = 0; r < 8; ++r) sum += *(const LAS f32x2*)(red + r * 128 + 2 * lane);
        { const size_t t_ = V_TOK(i);
          const f32x2 g_ = *(const f32x2*)(modb + (t_ >> 12) * NMOD + 5 * DM + 128 * s + 2 * lane) * dbg_s;
          f32x2* xo_ = (f32x2*)(X + t_ * DM + 128 * s + 2 * lane); *xo_ = *xo_ + g_ * sum; }
    }
#undef V_TOK
#undef V_LOAD_IW
#undef V_LOAD_ROWS
#undef V_COMPUTE
}

__device__ __forceinline__ void dft_nyquist_rows(const Ctx& F0, const Args& a) {
    const Ctx F = fresh(F0);
    const bf16_t* Yt = (const bf16_t*)(a.ws + WS_QK);
    bf16_t* Fo = (bf16_t*)(a.ws + WS_VT);
    const int gwv = F.vcu * NWAVES + F.wave, NGW = F.G * NWAVES;
    for (int o = gwv; o < NB * DM; o += NGW) {
        const bf16_t* src = Yt + (size_t)o * 8192;
        float s = 0.f;
#pragma unroll
        for (int it = 0; it < 8; ++it) { const u32x4 v = *(const u32x4*)(src + it * 512 + F.lane * 8);
#pragma unroll
            for (int d = 0; d < 4; ++d) s += bflo(v[d]) - bfhi(v[d]); }
        s = wave_sum(s) * (1.0f / 64.0f);
        if (F.lane == 0) Fo[((size_t)(o >> 10) * SEQ + 2048) * DM + (o & 1023)] = (bf16_t)f2bf(s);
    }
}

__global__ void __launch_bounds__(NWAVES * 64, 2) fwd_kernel(Args args) {
    extern __shared__ __attribute__((aligned(16))) unsigned char lds_raw[];
    Ctx F;
    F.lds = (LAS unsigned char*)lds_raw;
    F.tid = threadIdx.x; F.lane = F.tid & 63; F.wave = __builtin_amdgcn_readfirstlane(F.tid >> 6);
    F.G = gridDim.x; { const int bx = blockIdx.x; F.vcu = (F.G % 8 == 0) ? (bx % 8) * (F.G / 8) + bx / 8 : bx; }
    volatile LAS unsigned* MISC = (volatile LAS unsigned*)(F.lds + MISC_OFF);
    for (int u = F.tid; u < (LDS_BYTES - LDSCTL_OFF) / 4; u += NWAVES * 64) ((LAS unsigned*)(F.lds + LDSCTL_OFF))[u] = 0u;
    __syncthreads();
    unsigned char* ws = args.ws;
    XcdBarrier bar = xcd_barrier_post((unsigned*)(ws + WS_CTL) + CW_BAR, MISC + 8);
#define GRID_BAR() xcd_barrier(bar)
#ifndef DBG_REP
#define DBG_REP 0
#endif
#define REP(k, ...) do { __VA_ARGS__; if (DBG_REP == (k)) { GRID_BAR(); __VA_ARGS__; } } while (0)
#define PEER_BLOCK(layer) do { \
        norm_phase(F, args, 1, layer, 3 * DM, args.in[5] + (layer) * DM); \
        GRID_BAR(); \
        { using SHq = pg8::Shape<ML, 2048, DM, DM, DM, 1, 0, 0>; \
          REP(7, pg8::gemm_phase<SHq>(F.lds, pg8::Gemm{HX, (const bf16_t*)(ws + WS_WPQ) + (size_t)(layer) * 2048 * DM}, F.G, bx, pg8::EpiStoreBf16{QKb, 2048, 0, 0, 1.0f})); } \
        GRID_BAR(); \
        REP(8, peer_topk_phase(F, args, layer)); \
        GRID_BAR(); \
        REP(9, peer_u_phase(F, args, layer)); \
        GRID_BAR(); \
        REP(10, peer_w_phase(F, args)); \
        GRID_BAR(); \
        peer_v_phase(F, args, layer); if (DBG_REP == 11) { GRID_BAR(); peer_v_phase(F, args, layer, 0.f); } \
        GRID_BAR(); \
    } while (0)
    const float* modb = (const float*)(ws + WS_MOD);
    bf16_t* HX = (bf16_t*)(ws + WS_HX);
    bf16_t* QKb = (bf16_t*)(ws + WS_QK);
    bf16_t* VTb = (bf16_t*)(ws + WS_VT);
    const bf16_t* Wqkv = (const bf16_t*)(ws + WS_WQKV);
    const int bx = (int)blockIdx.x;

    REP(1, p0_prologue(F, args));
    GRID_BAR();
    REP(2, norm_phase(F, args, 0, 0, 0, args.in[4]));
    GRID_BAR();
    {
        using SH1 = pg8::Shape<MT, 2048, DM, DM, DM, 1, 0, 0>;
        pg8::gemm_phase<SH1>(F.lds, pg8::Gemm{HX, Wqkv}, F.G, bx, pg8::EpiStoreBf16{QKb, 2048, 0, 1024, 0.125f * LOG2E});
        using SH2 = pg8::Shape<DM, MT, DM, DM, DM, 1, 0, 0>;
        pg8::gemm_phase<SH2>(F.lds, pg8::Gemm{Wqkv + (size_t)2048 * DM, HX}, F.G, bx, pg8::EpiStoreBf16{VTb, MT, 0, 0, 1.0f});
        if (DBG_REP == 3) { pg8::gemm_phase<SH1>(F.lds, pg8::Gemm{HX, Wqkv}, F.G, bx, pg8::EpiStoreBf16{QKb, 2048, 0, 1024, 0.125f * LOG2E}); pg8::gemm_phase<SH2>(F.lds, pg8::Gemm{Wqkv + (size_t)2048 * DM, HX}, F.G, bx, pg8::EpiStoreBf16{VTb, MT, 0, 0, 1.0f}); }
    }
    GRID_BAR();
    REP(4, attn_phase(F, args));
    GRID_BAR();
    {
        using SH = pg8::Shape<ML, DM, DM, DM, DM, 1, 0, 0>;
        pg8::gemm_phase<SH>(F.lds, pg8::Gemm{HX, (const bf16_t*)(ws + WS_WO)}, F.G, bx, pg8::EpiResid{args.in[0], args.out, modb + 2 * DM, NMOD, (DBG_SKIP & 1) ? 0.f : 1.f});
    }
    GRID_BAR();
    PEER_BLOCK(0);
    norm_phase(F, args, 1, 1, 0, args.in[4] + DM);
    GRID_BAR();
    {
        using SH = pg8::Shape<512, ML, 256, 256, DM, 4, 0, 256>;
        pg8::gemm_phase<SH>(F.lds, pg8::Gemm{(const bf16_t*)(ws + WS_WC), HX}, F.G, bx, pg8::EpiYt{QKb});
    }
    GRID_BAR();
    {
        using SH = pg8::Shape<SEQ / 2, DM, 8192, 8192, 8192, NB, 0, (long)DM * 8192>;
        REP(14, pg8::gemm_phase<SH>(F.lds, pg8::Gemm{(const bf16_t*)(ws + WS_CS), QKb}, F.G, bx, pg8::EpiDft2{VTb}));
        dft_nyquist_rows(F, args);
    }
    GRID_BAR();
    {
        using SH = pg8::Shape<ML, DM, DM, DM, DM, 1, 0, 0>;
        pg8::gemm_phase<SH>(F.lds, pg8::Gemm{VTb, (const bf16_t*)(ws + WS_WF)}, F.G, bx, pg8::EpiResid{args.out, args.out, modb + (size_t)9 * NMOD + 2 * DM, NMOD, (DBG_SKIP & 4) ? 0.f : 1.f});
    }
    GRID_BAR();
    PEER_BLOCK(1);
    final_norm_phase(F, args);
#undef PEER_BLOCK
}

extern "C" void kernel_launch(void* const* d_in, const int* in_sizes, int n_in, void* d_out, int out_size, void* d_ws, size_t ws_size, hipStream_t stream) {
    static int grid = 0;
    if (grid == 0) {
        if (n_in != 17 || in_sizes[0] != ML * DM || out_size != ML * DM || ws_size < WS_END) { fprintf(stderr, "kernel_launch: unexpected shapes (n_in %d, in0 %d, out %d, ws %zu)\n", n_in, n_in > 0 ? in_sizes[0] : -1, out_size, ws_size); grid = -1; return; }
        int dev = 0, cus = 0, per_cu = 0;
        if (hipGetDevice(&dev) != hipSuccess || hipDeviceGetAttribute(&cus, hipDeviceAttributeMultiprocessorCount, dev) != hipSuccess) { grid = -1; return; }
        if (hipFuncSetAttribute((const void*)fwd_kernel, hipFuncAttributeMaxDynamicSharedMemorySize, LDS_BYTES) != hipSuccess) { fprintf(stderr, "kernel_launch: hipFuncSetAttribute failed\n"); grid = -1; return; }
        if (hipOccupancyMaxActiveBlocksPerMultiprocessor(&per_cu, (const void*)fwd_kernel, NWAVES * 64, LDS_BYTES) != hipSuccess || per_cu < 1)
            fprintf(stderr, "kernel_launch: note: occupancy query reports %d workgroups per CU\n", per_cu);
        (void)hipGetLastError();
        grid = cus;
        if (grid % 8 != 0) { fprintf(stderr, "kernel_launch: CU count %d is not a multiple of 8\n", cus); grid = -1; return; }
    }
    if (grid < 0) return;
    if (hipMemsetAsync((char*)d_ws + WS_CTL, 0, CTL_ZERO_BYTES, stream) != hipSuccess) { fprintf(stderr, "kernel_launch: memset failed\n"); return; }
    Args a{};
    for (int i = 0; i < 17; ++i) a.in[i] = (const float*)d_in[i];
    a.out = (float*)d_out; a.ws = (unsigned char*)d_ws;
    hipLaunchKernelGGL(fwd_kernel, dim3(grid), dim3(NWAVES * 64), LDS_BYTES, stream, a);
    const hipError_t le = hipPeekAtLastError();
    if (le != hipSuccess) fprintf(stderr, "kernel_launch: launch failed: %s\n", hipGetErrorName(le));
}
```

```cpp
#include <hip/hip_runtime.h>
#include <cstdio>
#include <cstdint>

#define LAS __attribute__((address_space(3)))
typedef unsigned short bf16_t;
typedef short bf16x8 __attribute__((ext_vector_type(8)));
typedef short s16x4 __attribute__((ext_vector_type(4)));
typedef float f32x2 __attribute__((ext_vector_type(2)));
typedef float f32x4 __attribute__((ext_vector_type(4)));
typedef float f32x16 __attribute__((ext_vector_type(16)));
typedef unsigned u32x2 __attribute__((ext_vector_type(2)));
typedef unsigned u32x4 __attribute__((ext_vector_type(4)));
typedef __bf16 bf16x2_t __attribute__((ext_vector_type(2)));

#ifndef DBG_SKIP
#define DBG_SKIP 0
#endif
constexpr int DM = 1024, NB = 8, SEQ = 4096, CTXL = 256, GW = 64;
constexpr int ML = NB * SEQ;
constexpr int MC = NB * CTXL;
constexpr int MT = ML + MC;
constexpr int NMOD = 6 * DM;
constexpr int NEXP = 16384;
constexpr float EPS = 1e-6f;
constexpr float LOG2E = 1.4426950408889634f;

constexpr size_t MiB = 1u << 20;
constexpr size_t WS_CTL = 0, CTL_ZERO_BYTES = 1 * MiB;
constexpr size_t WS_MOD = 1 * MiB;
constexpr size_t WS_WQKV = 2 * MiB;
constexpr size_t WS_WO = 8 * MiB;
constexpr size_t WS_WF = 10 * MiB;
constexpr size_t WS_WPQ = 12 * MiB;
constexpr size_t WS_SK = 20 * MiB;
constexpr size_t WS_WC = 20 * MiB + 256 * 1024;
constexpr size_t WS_CS = 22 * MiB;
constexpr size_t WS_TAB = 86 * MiB;
constexpr size_t WS_X8 = 150 * MiB;
constexpr size_t WS_WT = 182 * MiB;
constexpr size_t WS_PART = 282 * MiB;
constexpr float U_SCALE = 903.f;
constexpr float XQ_SCALE = 15.875f;
constexpr float V_SCALE = 28.2f;
constexpr size_t TAB_LAYER = 32 * MiB, TAB_VOFF = 16 * MiB;
constexpr size_t WS_WSC = 198 * MiB;
constexpr size_t WS_HX = 214 * MiB;
constexpr size_t WS_QK = 282 * MiB;
constexpr size_t WS_VT = 418 * MiB;
constexpr size_t WS_IDX = WS_VT;
constexpr size_t WS_GATE = WS_VT + 8 * MiB;
constexpr size_t WS_END = 486 * MiB;
constexpr int CW_BAR = 4096;

__device__ __forceinline__ unsigned f2bf(float f) { unsigned u = __builtin_bit_cast(unsigned, f); return (u + 0x7fffu + ((u >> 16) & 1u)) >> 16; }
__device__ __forceinline__ unsigned pk2(float lo, float hi) { return f2bf(lo) | (f2bf(hi) << 16); }
__device__ __forceinline__ unsigned cvtpk(float lo, float hi) { f32x2 v = {lo, hi}; bf16x2_t b = __builtin_convertvector(v, bf16x2_t); return __builtin_bit_cast(unsigned, b); }
__device__ __forceinline__ float bflo(unsigned u) { return __builtin_bit_cast(float, u << 16); }
__device__ __forceinline__ float bfhi(unsigned u) { return __builtin_bit_cast(float, u & 0xffff0000u); }
__device__ __forceinline__ float wave_sum(float v) {
#pragma unroll
    for (int o = 1; o < 64; o <<= 1) v += __shfl_xor(v, o);
    return v;
}
__device__ __forceinline__ int crow(int r, int hi) { return (r & 3) + 8 * (r >> 2) + 4 * hi; }
__device__ __forceinline__ float gelu_erf(float v) {
    const float av = __builtin_fabsf(v), d = av * 0.2316418882f + 1.0f;
    const float t = __builtin_amdgcn_rcpf(d);
    float q = t * 0.5307027145f + (-0.7265760135f); q = q * t + 0.7107068705f; q = q * t + (-0.142248368f); q = q * t + 0.127414796f; q = q * t;
    const float e = __builtin_amdgcn_exp2f((v * v) * (-0.72134752044f));
    const float m = v * (q * e), r = v - m;
    return v < 0.f ? m : r;
}

namespace pg8 {
constexpr int BM = 256, BK = 64, HALF = 128, HTB = HALF * BK * 2, STAGE_BYTES = 8 * HTB, NXCD = 8, WGM = 8;
__host__ __device__ __forceinline__ int lds_byte(int r, int c) { const int st = (r >> 4) * 2 + (c >> 5), rr = r & 15, cc = c & 31, ob = rr * 64 + cc * 2; return st * 1024 + (ob ^ (((ob >> 9) & 1) << 5)); }
__host__ __device__ __forceinline__ void stage_rc(int b, int& R, int& C) { const int st = b / 1024, sb = b % 1024, swz = sb ^ (((sb >> 9) & 1) << 5); R = (st >> 1) * 16 + swz / 64; C = (st & 1) * 32 + (swz % 64) / 2; }
__host__ __device__ __forceinline__ int perm32(int rho) { const int n = rho >> 4, i = rho & 15; return 8 * (i >> 2) + 4 * n + (i & 3); }

struct Unit { int pm, pn, pb; };
struct Gemm { const bf16_t* A; const bf16_t* Bt; };
template <int M_, int N_, int K_, int LDA_, int LDB_, int NBATCH_, long BSA_, long BSB_> struct Shape { static constexpr int M = M_, N = N_, K = K_, lda = LDA_, ldb = LDB_, nbatch = NBATCH_; static constexpr long bsA = BSA_, bsB = BSB_; };

template <class SH> struct StaticOrder {
    static constexpr int nM = SH::M / BM, nN = SH::N / BM, per = nM * nN, nwg = per * SH::nbatch;
    int G, c;
    __device__ __forceinline__ void init(int G_, int c_) { G = G_; c = c_; }
    __device__ __forceinline__ bool next(int i, Unit& u) const {
        const long L = (long)i * G + c; if (L >= nwg) return false;
        int wgid = (int)L; { const int q = nwg / NXCD, r = nwg % NXCD, xcd = wgid % NXCD, off = wgid / NXCD; wgid = (xcd < r ? xcd * (q + 1) : r * (q + 1) + (xcd - r) * q) + off; }
        u.pb = wgid / per; wgid -= u.pb * per;
        const int nig = WGM * nN, gid = wgid / nig, fm = gid * WGM, gsz = (nM - fm) < WGM ? (nM - fm) : WGM;
        u.pm = fm + ((wgid % nig) % gsz); u.pn = (wgid % nig) / gsz; return true;
    }
};

struct EpiStoreBf16 {
    static constexpr bool PERM = true;
    bf16_t* O; long ldc; long bstride; int scols; float scale0;
    __device__ __forceinline__ void operator()(const f32x4 (&acc)[2][2][4][2], const Unit& u, int wr, int wc, int fr, int fq) const {
        const int row0 = u.pm * BM + wr * 64 + fr, col0 = u.pn * BM + wc * 32 + 8 * fq;
        bf16_t* base = O + (long)u.pb * bstride;
        const float sc = (u.pn * BM < scols) ? scale0 : 1.0f;
#pragma unroll
        for (int ai = 0; ai < 2; ++ai)
#pragma unroll
            for (int m = 0; m < 4; ++m) { bf16_t* rowp = base + (long)(row0 + ai * HALF + m * 16) * ldc + col0;
#pragma unroll
                for (int bj = 0; bj < 2; ++bj) { const f32x4 v0 = acc[ai][bj][m][0] * sc, v1 = acc[ai][bj][m][1] * sc;
                    u32x4 w; w.x = cvtpk(v0[0], v0[1]); w.y = cvtpk(v0[2], v0[3]); w.z = cvtpk(v1[0], v1[1]); w.w = cvtpk(v1[2], v1[3]);
                    *(u32x4*)(rowp + bj * HALF) = w; } }
    }
};
struct EpiDft2 {
    static constexpr bool PERM = true;
    bf16_t* O;
    __device__ __forceinline__ void operator()(const f32x4 (&acc)[2][2][4][2], const Unit& u, int wr, int wc, int fr, int fq) const {
        const int row0 = u.pm * BM + wr * 64 + fr, cl0 = wc * 32 + 8 * fq;
        bf16_t* base = O + (long)u.pb * SEQ * DM + u.pn * BM;
#pragma unroll
        for (int ai = 0; ai < 2; ++ai)
#pragma unroll
            for (int m = 0; m < 4; ++m) { const int np = row0 + ai * HALF + m * 16;
                bf16_t* rowp = base + (long)np * DM; bf16_t* mirp = base + (long)(SEQ - np) * DM;
#pragma unroll
                for (int bj = 0; bj < 2; ++bj) { const f32x4 v0 = acc[ai][bj][m][0], v1 = acc[ai][bj][m][1]; const int cl = cl0 + bj * HALF;
                    u32x4 w; w.x = cvtpk(v0[0], v0[1]); w.y = cvtpk(v0[2], v0[3]); w.z = cvtpk(v1[0], v1[1]); w.w = cvtpk(v1[2], v1[3]);
                    *(u32x4*)(rowp + cl) = w;
                    if (np != 0) {
#pragma unroll
                        for (int i = 0; i < 8; ++i) { const unsigned word = w[i >> 1]; mirp[(256 - cl - i) & 255] = (bf16_t)((i & 1) ? (word >> 16) : (word & 0xffffu)); } } }
                asm volatile("" ::: "memory"); }
    }
};
struct EpiYt {
    static constexpr bool PERM = true;
    bf16_t* Yt;
    __device__ __forceinline__ void operator()(const f32x4 (&acc)[2][2][4][2], const Unit& u, int wr, int wc, int fr, int fq) const {
        const int row0 = u.pm * BM + wr * 64 + fr, col0 = u.pn * BM + wc * 32 + 8 * fq;
#pragma unroll
        for (int ai = 0; ai < 2; ++ai)
#pragma unroll
            for (int m = 0; m < 4; ++m) { const int row = row0 + ai * HALF + m * 16; const int part = row >> 8, cp = row & 255;
#pragma unroll
                for (int bj = 0; bj < 2; ++bj) { const int col = col0 + bj * HALF; const int b = col >> 12, n = col & 4095;
                    const f32x4 v0 = acc[ai][bj][m][0], v1 = acc[ai][bj][m][1];
                    u32x4 w; w.x = cvtpk(v0[0], v0[1]); w.y = cvtpk(v0[2], v0[3]); w.z = cvtpk(v1[0], v1[1]); w.w = cvtpk(v1[2], v1[3]);
                    *(u32x4*)(Yt + ((((long)(b * 4 + u.pb) * 256 + cp) * 2 + part) << 12) + n) = w; }
                asm volatile("" ::: "memory"); }
    }
};
struct EpiResid {
    static constexpr bool PERM = false;
    const float* Xin; float* Xout; const float* gate; int gstride; float gs;
    __device__ __forceinline__ void operator()(const f32x4 (&acc)[2][2][4][2], const Unit& u, int wr, int wc, int fr, int fq) const {
        const int row0 = u.pm * BM + wr * 64 + fr, col0 = u.pn * BM + wc * 32 + 4 * fq;
        const float* gb = gate + (long)((u.pm * BM) >> 12) * gstride;
        f32x4 gv[2][2];
#pragma unroll
        for (int bj = 0; bj < 2; ++bj)
#pragma unroll
            for (int n = 0; n < 2; ++n) gv[bj][n] = *(const f32x4*)(gb + col0 + bj * HALF + n * 16);
#pragma unroll
        for (int ai = 0; ai < 2; ++ai)
#pragma unroll
            for (int m = 0; m < 4; ++m) { const long off = (long)(row0 + ai * HALF + m * 16) * DM + col0;
#pragma unroll
                for (int bj = 0; bj < 2; ++bj)
#pragma unroll
                    for (int n = 0; n < 2; ++n) { const f32x4 bs = *(const f32x4*)(Xin + off + bj * HALF + n * 16);
                        *(f32x4*)(Xout + off + bj * HALF + n * 16) = bs + gv[bj][n] * acc[ai][bj][m][n] * gs; }
                if (m & 1) asm volatile("" ::: "memory"); }
    }
};

template <class SH, class Epi>
__device__ __forceinline__ void gemm_phase(LAS unsigned char* lds, const Gemm g, int G_, int c_, const Epi& E) {
    StaticOrder<SH> S; S.init(G_, c_);
    int tid_ = threadIdx.x; asm volatile("" : "+v"(tid_));
    const int tid = tid_, wid = __builtin_amdgcn_readfirstlane(tid >> 6), lane = tid & 63, wr = wid >> 2, wc = wid & 3, fr = lane & 15, fq = lane >> 4;
    constexpr int K = SH::K, nt = K / BK;
    unsigned voffA[2], voffB[2];
#pragma unroll
    for (int i = 0; i < 2; ++i) { int R, C; stage_rc(tid * 16 + i * 8192, R, C); const int Rb = Epi::PERM ? ((R & ~31) + perm32(R & 31)) : R;
        voffA[i] = (unsigned)(R * SH::lda + C) * 2u; voffB[i] = (unsigned)(Rb * SH::ldb + C) * 2u; }
    constexpr size_t kstep = (size_t)(BK * 2);
    constexpr size_t hstepA = (size_t)HALF * SH::lda * 2, hstepB = (size_t)HALF * SH::ldb * 2;
    constexpr size_t tstepA = 2 * hstepA, tstepB = 2 * hstepB;
    const unsigned ldsw = (unsigned)wid * 1024u;
    const int aoff = lds_byte(wr * 64 + fr, fq * 8), boff = lds_byte(wc * 32 + fr, fq * 8);
#define PG8_SA(b, h) (((b) * 2 + (h)) * HTB)
#define PG8_SB(b, h) ((4 + (b) * 2 + (h)) * HTB)
#define PG8_STAGE(bufoff, gbase, voff) do { _Pragma("unroll") for (int _i = 0; _i < 2; ++_i) \
        __builtin_amdgcn_global_load_lds((const unsigned*)((const char*)(gbase) + (voff)[_i]), (LAS unsigned*)(lds + (bufoff) + ldsw + _i * 8192), 16, 0, 0); } while (0)
#define PG8_LDA(dst, b, h) do { _Pragma("unroll") for (int m = 0; m < 4; ++m) _Pragma("unroll") for (int k = 0; k < 2; ++k) dst[m][k] = *(const LAS bf16x8*)(lds + PG8_SA(b, h) + aoff + m * 2048 + k * 1024); } while (0)
#define PG8_LDB(dst, b, h) do { _Pragma("unroll") for (int n = 0; n < 2; ++n) _Pragma("unroll") for (int k = 0; k < 2; ++k) dst[n][k] = *(const LAS bf16x8*)(lds + PG8_SB(b, h) + boff + n * 2048 + k * 1024); } while (0)
#define PG8_MMA(ai, bj, At, Bt) do { __builtin_amdgcn_s_setprio(1); _Pragma("unroll") for (int m = 0; m < 4; ++m) _Pragma("unroll") for (int n = 0; n < 2; ++n) _Pragma("unroll") for (int k = 0; k < 2; ++k) \
        acc[ai][bj][m][n] = __builtin_amdgcn_mfma_f32_16x16x32_bf16(Bt[n][k], At[m][k], acc[ai][bj][m][n], 0, 0, 0); __builtin_amdgcn_s_setprio(0); } while (0)
#define PG8_WAIT_V(n) asm volatile("s_waitcnt vmcnt(" #n ")" ::: "memory")
#define PG8_WAIT_L(n) asm volatile("s_waitcnt lgkmcnt(" #n ")" ::: "memory")
#define PG8_BAR __builtin_amdgcn_s_barrier()
#define PG8_SCHED __builtin_amdgcn_sched_barrier(0)
    Unit cur, nxt; int ui = 0;
    if (!S.next(0, cur)) return;
    f32x4 acc[2][2][4][2];
#pragma unroll
    for (int a = 0; a < 2; ++a)
#pragma unroll
        for (int b = 0; b < 2; ++b)
#pragma unroll
            for (int m = 0; m < 4; ++m)
#pragma unroll
                for (int n = 0; n < 2; ++n) acc[a][b][m][n] = (f32x4){0.f, 0.f, 0.f, 0.f};
    bf16x8 At[4][2], B0[2][2], B1[2][2];
    const char* cA = (const char*)(g.A + (long)cur.pb * SH::bsA) + (size_t)cur.pm * tstepA; const char* cB = (const char*)(g.Bt + (long)cur.pb * SH::bsB) + (size_t)cur.pn * tstepB;
    PG8_STAGE(PG8_SB(0, 0), cB, voffB); PG8_STAGE(PG8_SB(0, 1), cB + hstepB, voffB); PG8_STAGE(PG8_SA(0, 0), cA, voffA); PG8_STAGE(PG8_SA(0, 1), cA + hstepA, voffA);
    if (wr == 1) PG8_BAR;
    PG8_WAIT_V(2); PG8_BAR;
    PG8_STAGE(PG8_SB(1, 0), cB + kstep, voffB); PG8_STAGE(PG8_SA(1, 0), cA + kstep, voffA); PG8_STAGE(PG8_SB(1, 1), cB + hstepB + kstep, voffB);
    PG8_WAIT_V(6); PG8_BAR;
    for (;;) {
        const bool has_next = S.next(ui + 1, nxt);
        const char* nA = has_next ? (const char*)(g.A + (long)nxt.pb * SH::bsA) + (size_t)nxt.pm * tstepA : cA; const char* nB = has_next ? (const char*)(g.Bt + (long)nxt.pb * SH::bsB) + (size_t)nxt.pn * tstepB : cB;
#pragma nounroll
        for (int t = 0; t < nt; t += 2) {
            const bool last = (t == nt - 2);
            const char* a1 = cA + (size_t)(t + 1) * kstep;
            const char* a2 = last ? nA : cA + (size_t)(t + 2) * kstep; const char* b2 = last ? nB : cB + (size_t)(t + 2) * kstep;
            const char* a3 = a2 + kstep; const char* b3 = b2 + kstep;
            PG8_LDB(B0, 0, 0); PG8_LDB(B1, 0, 1); PG8_SCHED; PG8_LDA(At, 0, 0); PG8_STAGE(PG8_SA(1, 1), a1 + hstepA, voffA);
            PG8_WAIT_V(8); PG8_WAIT_L(0); PG8_BAR; PG8_MMA(0, 0, At, B0); PG8_MMA(0, 1, At, B1); PG8_BAR; PG8_SCHED;
            PG8_LDA(At, 0, 1); PG8_STAGE(PG8_SB(0, 0), b2, voffB); PG8_STAGE(PG8_SB(0, 1), b2 + hstepB, voffB); PG8_STAGE(PG8_SA(0, 0), a2, voffA);
            PG8_WAIT_V(8); PG8_WAIT_L(0); PG8_BAR; PG8_MMA(1, 0, At, B0); PG8_MMA(1, 1, At, B1); PG8_BAR; PG8_SCHED;
            PG8_LDB(B0, 1, 0); PG8_LDB(B1, 1, 1); PG8_SCHED; PG8_LDA(At, 1, 0); PG8_STAGE(PG8_SA(0, 1), a2 + hstepA, voffA);
            PG8_WAIT_V(8); PG8_WAIT_L(0); PG8_BAR; PG8_MMA(0, 0, At, B0); PG8_MMA(0, 1, At, B1); PG8_BAR; PG8_SCHED;
            PG8_LDA(At, 1, 1); PG8_STAGE(PG8_SB(1, 0), b3, voffB); PG8_STAGE(PG8_SB(1, 1), b3 + hstepB, voffB); PG8_STAGE(PG8_SA(1, 0), a3, voffA);
            PG8_WAIT_V(8); PG8_WAIT_L(0); PG8_BAR; PG8_MMA(1, 0, At, B0); PG8_MMA(1, 1, At, B1); PG8_BAR; PG8_SCHED;
        }
        if (wr == 0) PG8_BAR;
        E(acc, cur, wr, wc, fr, fq);
        if (!has_next) break;
#pragma unroll
        for (int a = 0; a < 2; ++a)
#pragma unroll
            for (int b = 0; b < 2; ++b)
#pragma unroll
                for (int m = 0; m < 4; ++m)
#pragma unroll
                    for (int n = 0; n < 2; ++n) acc[a][b][m][n] = (f32x4){0.f, 0.f, 0.f, 0.f};
        cur = nxt; cA = nA; cB = nB; ++ui;
        if (wr == 1) PG8_BAR;
    }
    PG8_WAIT_V(0);
    PG8_BAR;
#undef PG8_SA
#undef PG8_SB
#undef PG8_STAGE
#undef PG8_LDA
#undef PG8_LDB
#undef PG8_MMA
#undef PG8_WAIT_V
#undef PG8_WAIT_L
#undef PG8_BAR
#undef PG8_SCHED
}
}

#define XB_TMO      128
#define XB_XCNT(j)  (256  + 64 * (j))
#define XB_XSUB(j)  (1280 + 64 * (j))
#define XB_XGEN(j)  (2304 + 64 * (j))
#define XB_TOP      3328
#define XB_TOPGEN   3392
#define XCD_BAR_WORDS 3456
#define XB_SPIN_CAP (1u << 18)
__device__ __forceinline__ unsigned xb_ld(unsigned* p)              { return __hip_atomic_load(p, __ATOMIC_RELAXED, __HIP_MEMORY_SCOPE_AGENT); }
__device__ __forceinline__ unsigned xb_add(unsigned* p, unsigned v) { return __hip_atomic_fetch_add(p, v, __ATOMIC_RELAXED, __HIP_MEMORY_SCOPE_AGENT); }
__device__ __forceinline__ unsigned xb_xcc_id() { return (unsigned)__builtin_amdgcn_s_getreg((3 << 11) | 20) & 0xFu; }
#define XB_SPIN(cond, bar) do { unsigned _sp = 0; while (cond) { __builtin_amdgcn_s_sleep(1); \
    if ((++_sp & 255u) == 0u) { if (xb_ld(&(bar)[XB_TMO])) break; if (_sp > XB_SPIN_CAP) { atomicAdd(&(bar)[XB_TMO], 1u); break; } } } } while (0)
struct XcdBarrier { unsigned* bar; unsigned x; volatile LAS unsigned* st; };
__device__ __forceinline__ XcdBarrier xcd_barrier_post(unsigned* bar, volatile LAS unsigned* st) {
    XcdBarrier b; b.bar = bar; b.x = xb_xcc_id(); b.st = st;
    if (threadIdx.x == 0) (void)xb_add(&bar[XB_XCNT(b.x)], 1u);
    return b;
}
__device__ __forceinline__ void xcd_barrier_complete(unsigned* bar, unsigned x, unsigned& nloc, unsigned& nx) {
    const unsigned G = gridDim.x * gridDim.y * gridDim.z;
    unsigned sum, cnt, mine, sp = 0u;
    for (;;) {
        sum = 0u; cnt = 0u; mine = 0u;
#pragma unroll
        for (unsigned j = 0; j < 16; ++j) { const unsigned c = xb_ld(&bar[XB_XCNT(j)]); sum += c; cnt += (c > 0u) ? 1u : 0u; mine = (j == x) ? c : mine; }
        if (sum == G) break;
        __builtin_amdgcn_s_sleep(1);
        if ((++sp & 255u) == 0u) { if (xb_ld(&bar[XB_TMO])) break; if (sp > XB_SPIN_CAP) { atomicAdd(&bar[XB_TMO], 1u); break; } }
    }
    nloc = mine > 0u ? mine : 1u; nx = cnt > 0u ? cnt : 1u;
}
__device__ __forceinline__ void xcd_barrier(const XcdBarrier& b) {
    asm volatile("s_waitcnt vmcnt(0)" ::: "memory");
    __syncthreads();
    if (threadIdx.x == 0) {
        unsigned* bar = b.bar;
        __builtin_amdgcn_s_waitcnt(0);
        unsigned nloc = b.st[0], nx = b.st[1];
        if (nloc == 0u) { xcd_barrier_complete(bar, b.x, nloc, nx); b.st[0] = nloc; b.st[1] = nx; }
        const unsigned old = xb_add(&bar[XB_XSUB(b.x)], 1u);
        const unsigned gen = old / nloc;
        if (old + 1u == (gen + 1u) * nloc) {
            __builtin_amdgcn_fence(__ATOMIC_RELEASE, "agent");
            asm volatile("s_waitcnt vmcnt(0)" ::: "memory");
            const unsigned og = xb_add(&bar[XB_TOP], 1u);
            const unsigned tg = og / nx;
            if (og + 1u == (tg + 1u) * nx) xb_add(&bar[XB_TOPGEN], 1u);
            else XB_SPIN(xb_ld(&bar[XB_TOPGEN]) == tg, bar);
            __builtin_amdgcn_fence(__ATOMIC_ACQUIRE, "agent");
            xb_add(&bar[XB_XGEN(b.x)], 1u);
            asm volatile("s_waitcnt vmcnt(0)" ::: "memory");
        } else {
            XB_SPIN(xb_ld(&bar[XB_XGEN(b.x)]) == gen, bar);
            __builtin_amdgcn_fence(__ATOMIC_ACQUIRE, "agent");
            asm volatile("s_waitcnt vmcnt(0)" ::: "memory");
        }
    }
    __syncthreads();
}

constexpr int RING_BYTES = 131072;
constexpr int LDSCTL_OFF = RING_BYTES, MISC_OFF = LDSCTL_OFF + 320;
constexpr int LDS_BYTES = 147456;
constexpr int NWAVES = 8;

struct Args { const float* in[17]; float* out; unsigned char* ws; };

struct Ctx {
    LAS unsigned char* lds;
    int tid, lane, wave, vcu, G;
};

__device__ __forceinline__ Ctx fresh(const Ctx& F) {
    Ctx C = F; int t = threadIdx.x; asm volatile("" : "+v"(t)); C.tid = t; C.lane = t & 63; return C;
}
__device__ __forceinline__ void p0_transpose_item(const float* W, int K, int N, bf16_t* WT, LAS float* scr, int item, int lane) {
    const int nblk = N / 32, kb = item / nblk, nb = item % nblk, k0 = 64 * kb, n0 = 32 * nb;
#pragma unroll 8
    for (int i = 0; i < 32; ++i) { const int kk = 2 * i + (lane >> 5); scr[kk * 33 + (lane & 31)] = W[(size_t)(k0 + kk) * N + n0 + (lane & 31)]; }
    asm volatile("s_waitcnt lgkmcnt(0)" ::: "memory");
    const int c = lane & 7;
#pragma unroll
    for (int j = 0; j < 4; ++j) { const int n = (lane >> 3) + 8 * j; const LAS float* s = scr + (8 * c) * 33 + n;
        u32x4 o; o.x = pk2(s[0 * 33], s[1 * 33]); o.y = pk2(s[2 * 33], s[3 * 33]); o.z = pk2(s[4 * 33], s[5 * 33]); o.w = pk2(s[6 * 33], s[7 * 33]);
        *(u32x4*)(WT + (size_t)(n0 + n) * K + k0 + 8 * c) = o; }
    asm volatile("s_waitcnt lgkmcnt(0)" ::: "memory");
}
__device__ __forceinline__ void cvt8(const float* src, bf16_t* dst) {
    const f32x4 a = *(const f32x4*)src, b = *(const f32x4*)(src + 4);
    u32x4 o; o.x = pk2(a[0], a[1]); o.y = pk2(a[2], a[3]); o.z = pk2(b[0], b[1]); o.w = pk2(b[2], b[3]);
    *(u32x4*)dst = o;
}

__device__ __forceinline__ void p0_prologue(const Ctx& F0, const Args& a) {
    const Ctx F = fresh(F0);
    unsigned char* ws = a.ws;
    const int gw = F.vcu * NWAVES + F.wave, NGW = F.G * NWAVES;
    const long gt = (long)F.vcu * 512 + F.tid, NGT = (long)F.G * 512;
    {
        LAS float* red = (LAS float*)(F.lds);
        const float* c = a.in[1]; const float* cctx = a.in[3]; const float* wmod = a.in[6]; const float* bmod = a.in[7];
        float* modb = (float*)(ws + WS_MOD);
        for (int item = F.vcu; item < 96; item += F.G) {
            const int l = item / 48, nc = item % 48, n0 = nc * 128 + 2 * F.lane, kb = F.wave * 128;
            float sv[9][2];
#pragma unroll
            for (int r = 0; r < 9; ++r)
#pragma unroll
                for (int j = 0; j < 2; ++j) { const int k = kb + 64 * j + F.lane; const float v = (r < 8) ? c[r * DM + k] : cctx[k]; sv[r][j] = v / (1.0f + __expf(-v)); }
            float acc[9][2];
#pragma unroll
            for (int r = 0; r < 9; ++r) { acc[r][0] = 0.f; acc[r][1] = 0.f; }
            const float* wp = wmod + (size_t)l * DM * NMOD + (size_t)kb * NMOD + n0;
#pragma unroll
            for (int j = 0; j < 2; ++j)
#pragma unroll 8
                for (int kl = 0; kl < 64; ++kl) {
                    const f32x2 w = *(const f32x2*)(wp + (size_t)(64 * j + kl) * NMOD);
#pragma unroll
                    for (int r = 0; r < 9; ++r) { const float s = __builtin_bit_cast(float, __builtin_amdgcn_readlane(__builtin_bit_cast(int, sv[r][j]), kl)); acc[r][0] += s * w[0]; acc[r][1] += s * w[1]; }
                }
            __syncthreads();
#pragma unroll
            for (int r = 0; r < 9; ++r) { red[(F.wave * 9 + r) * 128 + 2 * F.lane] = acc[r][0]; red[(F.wave * 9 + r) * 128 + 2 * F.lane + 1] = acc[r][1]; }
            __syncthreads();
            for (int o = F.tid; o < 9 * 128; o += 512) { const int r = o >> 7, nl = o & 127; float s = 0.f;
#pragma unroll
                for (int w = 0; w < 8; ++w) s += red[(w * 9 + r) * 128 + nl];
                modb[(size_t)(l * 9 + r) * NMOD + nc * 128 + nl] = s + bmod[l * NMOD + nc * 128 + nl]; }
        }
        __syncthreads();
    }
    {
        LAS float* scr = (LAS float*)(F.lds + F.wave * 16384);
        constexpr int I_QKV = (DM / 64) * (3 * DM / 32), I_O = (DM / 64) * (DM / 32), I_PQ = (DM / 64) * (2 * DM / 32);
        constexpr int NITEMS = I_QKV + 2 * I_O + 2 * I_PQ;
        for (int it = gw; it < NITEMS; it += NGW) {
            int r = it;
            if (r < I_QKV) { p0_transpose_item(a.in[8], DM, 3 * DM, (bf16_t*)(ws + WS_WQKV), scr, r, F.lane); continue; } r -= I_QKV;
            if (r < I_O) { p0_transpose_item(a.in[9], DM, DM, (bf16_t*)(ws + WS_WO), scr, r, F.lane); continue; } r -= I_O;
            if (r < I_O) { p0_transpose_item(a.in[11], DM, DM, (bf16_t*)(ws + WS_WF), scr, r, F.lane); continue; } r -= I_O;
            if (r < I_PQ) { p0_transpose_item(a.in[12], DM, 2 * DM, (bf16_t*)(ws + WS_WPQ), scr, r, F.lane); continue; } r -= I_PQ;
            p0_transpose_item(a.in[12] + (size_t)DM * 2 * DM, DM, 2 * DM, (bf16_t*)(ws + WS_WPQ) + (size_t)2 * DM * DM, scr, r, F.lane);
        }
    }
    for (long i = gt; i < 2 * 2 * 128 * 128 / 8; i += NGT) cvt8(a.in[13] + i * 8, (bf16_t*)(ws + WS_SK) + i * 8);
    {
        bf16_t* wc = (bf16_t*)(ws + WS_WC);
        for (long i = gt; i < 512 * 256 / 8; i += NGT) { const int nn = (int)(i >> 5), k0 = (int)(i & 31) * 8; float v[8];
#pragma unroll
            for (int j = 0; j < 8; ++j) { const int m = ((k0 + j) * (nn & 255)) & 255; const float fr = (float)m * (1.0f / 256.0f);
                v[j] = (nn < 256 ? __builtin_amdgcn_cosf(fr) : __builtin_amdgcn_sinf(fr)) * (1.0f / 16.0f); }
            u32x4 o; o.x = pk2(v[0], v[1]); o.y = pk2(v[2], v[3]); o.z = pk2(v[4], v[5]); o.w = pk2(v[6], v[7]);
            *(u32x4*)(wc + i * 8) = o; }
        bf16_t* cs = (bf16_t*)(ws + WS_CS);
        for (long i = gt; i < 2048L * 8192 / 8; i += NGT) { const int np = (int)(i >> 10), c0 = (int)(i & 1023) * 8; const int part = c0 >> 12; float v[8];
#pragma unroll
            for (int j = 0; j < 8; ++j) { const int n = (c0 + j) & 4095; const int m = (n * np) & 4095; const float fr = (float)m * (1.0f / 4096.0f);
                v[j] = (part == 0 ? __builtin_amdgcn_cosf(fr) : -__builtin_amdgcn_sinf(fr)) * (1.0f / 64.0f); }
            u32x4 o; o.x = pk2(v[0], v[1]); o.y = pk2(v[2], v[3]); o.z = pk2(v[4], v[5]); o.w = pk2(v[6], v[7]);
            *(u32x4*)(cs + i * 8) = o; }
    }
}

__device__ __forceinline__ unsigned fp4_pack8(const float* v, float sc) {
    unsigned w = 0;
#define FP4C(i) fminf(fmaxf(v[i] * sc, -6.f), 6.f)
    w = __builtin_amdgcn_cvt_scalef32_pk_fp4_f32(w, FP4C(0), FP4C(1), 1.0f, 0);
    w = __builtin_amdgcn_cvt_scalef32_pk_fp4_f32(w, FP4C(2), FP4C(3), 1.0f, 1);
    w = __builtin_amdgcn_cvt_scalef32_pk_fp4_f32(w, FP4C(4), FP4C(5), 1.0f, 2);
    w = __builtin_amdgcn_cvt_scalef32_pk_fp4_f32(w, FP4C(6), FP4C(7), 1.0f, 3);
#undef FP4C
    return w;
}
#define FP4_DEC(w, bs) __builtin_amdgcn_cvt_scalef32_pk_f32_fp4((w), 1.0f, (bs))
__device__ __forceinline__ unsigned i8_pack4(f32x4 v, float sc) {
    const int a = (int)rintf(fminf(fmaxf(v[0] * sc, -127.f), 127.f)), b = (int)rintf(fminf(fmaxf(v[1] * sc, -127.f), 127.f));
    const int c = (int)rintf(fminf(fmaxf(v[2] * sc, -127.f), 127.f)), d = (int)rintf(fminf(fmaxf(v[3] * sc, -127.f), 127.f));
    return (unsigned)(a & 0xff) | ((unsigned)(b & 0xff) << 8) | ((unsigned)(c & 0xff) << 16) | ((unsigned)(d & 0xff) << 24);
}
__device__ __forceinline__ void table_convert(const Ctx& F0, const Args& a, int sh0, int nsh, int nshare) {
    const Ctx F = fresh(F0);
    constexpr long PER = (long)NEXP * DM / 16;
    constexpr long TOTAL = 4 * PER;
    unsigned char* t8 = a.ws + WS_TAB;
    const long per_share = (TOTAL + nshare - 1) / nshare;
    const long i0 = (long)sh0 * per_share, i1 = min((long)(sh0 + nsh) * per_share, TOTAL);
    for (long i = i0 + F.tid; i < i1; i += 512) {
        const int q = (int)(i / PER); const long r = i - (long)q * PER; const int l = q >> 1, tb = q & 1;
        const int e = (int)(r >> 6), c16 = (int)(r & 63);
        const float* src = (tb ? a.in[15] : a.in[14]) + ((size_t)l * NEXP + e) * DM + c16 * 16;
        {   u32x4 o;
#pragma unroll
            for (int d = 0; d < 4; ++d) { const f32x4 v = *(const f32x4*)(src + 4 * d); o[d] = i8_pack4(v, tb ? V_SCALE : U_SCALE); }
            *(u32x4*)(t8 + (size_t)l * TAB_LAYER + (tb ? TAB_VOFF : 0) + ((size_t)(c16 >> 3) * NEXP + e) * 128 + (c16 & 7) * 16) = o;
        }
    }
}

__device__ __forceinline__ const float* norm_src(const Args& a, int mode, int m) { return (m < ML) ? ((mode == 0 ? a.in[0] : a.out) + (size_t)m * DM) : (a.in[2] + (size_t)(m - ML) * DM); }
__device__ __forceinline__ void norm_phase(const Ctx& F0, const Args& a, int mode, int layer, int off, const float* gw) {
    const Ctx F = fresh(F0);
    const int gwv = F.vcu * NWAVES + F.wave, NGW = F.G * NWAVES, lane = F.lane;
    const float* modb = (const float*)(a.ws + WS_MOD) + (size_t)layer * 9 * NMOD;
    bf16_t* hx = (bf16_t*)(a.ws + WS_HX);
    const int nrows = (mode == 0) ? MT : ML;
    f32x4 gv[4];
#pragma unroll
    for (int j = 0; j < 4; ++j) gv[j] = ((const f32x4*)gw)[lane + 64 * j];
    f32x4 v[4], vn[4];
    if (gwv < nrows) { const f32x4* xr = (const f32x4*)norm_src(a, mode, gwv) + lane;
#pragma unroll
        for (int j = 0; j < 4; ++j) vn[j] = xr[64 * j]; }
    for (int m = gwv; m < nrows; m += NGW) {
#pragma unroll
        for (int j = 0; j < 4; ++j) v[j] = vn[j];
        { const int mn = (m + NGW < nrows) ? m + NGW : m; const f32x4* xr = (const f32x4*)norm_src(a, mode, mn) + lane;
#pragma unroll
          for (int j = 0; j < 4; ++j) vn[j] = xr[64 * j]; }
        const float* mr = modb + (size_t)((m < ML) ? (m >> 12) : 8) * NMOD + off;
        f32x4 av[4], cv[4];
#pragma unroll
        for (int j = 0; j < 4; ++j) { av[j] = ((const f32x4*)mr)[lane + 64 * j]; cv[j] = ((const f32x4*)(mr + DM))[lane + 64 * j]; }
        float s = 0.f;
#pragma unroll
        for (int j = 0; j < 4; ++j) s += (v[j].x * v[j].x + v[j].y * v[j].y) + (v[j].z * v[j].z + v[j].w * v[j].w);
        const float rstd = 1.0f / sqrtf(wave_sum(s) * (1.0f / DM) + EPS);
        unsigned long long* o8 = (unsigned long long*)(hx + (size_t)m * DM) + lane;
#pragma unroll
        for (int j = 0; j < 4; ++j) { const f32x4 y = (v[j] * rstd * gv[j]) * (cv[j] + 1.0f) + av[j];
            o8[64 * j] = (unsigned long long)cvtpk(y.x, y.y) | ((unsigned long long)cvtpk(y.z, y.w) << 32);
            if (off == 3 * DM) *(unsigned*)(a.ws + WS_X8 + ((size_t)(2 * j + (lane >> 5)) * ML + m) * 128 + (4 * lane & 127)) = i8_pack4(y, XQ_SCALE); }
    }
}
__device__ __forceinline__ void final_norm_phase(const Ctx& F0, const Args& a) {
    const Ctx F = fresh(F0);
    const int gwv = F.vcu * NWAVES + F.wave, NGW = F.G * NWAVES;
    const float* gw = a.in[16];
    for (int m = gwv; m < ML; m += NGW) {
        f32x4* xr = (f32x4*)(a.out + (size_t)m * DM) + F.lane;
        f32x4 v[4]; float s = 0.f;
#pragma unroll
        for (int j = 0; j < 4; ++j) { v[j] = xr[64 * j]; s += (v[j].x * v[j].x + v[j].y * v[j].y) + (v[j].z * v[j].z + v[j].w * v[j].w); }
        const float rstd = 1.0f / sqrtf(wave_sum(s) * (1.0f / DM) + EPS);
#pragma unroll
        for (int j = 0; j < 4; ++j) xr[64 * j] = v[j] * rstd * ((const f32x4*)gw)[F.lane + 64 * j];
    }
}

constexpr int ATT_ROWB = 144, ATT_KTILEB = 128 * ATT_ROWB, ATT_VROWB = 272, ATT_VTILEB = 64 * ATT_VROWB, ATT_BIAS_B = 2048, ATT_K0 = ATT_BIAS_B, ATT_V0 = ATT_K0 + 2 * ATT_KTILEB;
constexpr float ATT_THR = 8.0f;
template <int NGH, bool LATENT>
__device__ __forceinline__ void attn_sub(const LAS unsigned char* Kt, const LAS unsigned char* Vt_, int ko, const LAS float* browA, const LAS float* browB, const int (&relidx)[8],
                                         const bf16x8 (&qf)[2], float& m_ref, float& l_run, f32x4 (&o)[4], int q16, int g4) {
    constexpr int NG = 2 * NGH;
    bf16x8 kf[2 * NG][2]; u32x2 vf[4][NG][2]; f32x4 sc[2 * NG];
#pragma unroll
    for (int gk = 0; gk < NG; ++gk)
#pragma unroll
        for (int b2 = 0; b2 < 2; ++b2)
#pragma unroll
            for (int ks = 0; ks < 2; ++ks) kf[2 * gk + b2][ks] = *(const LAS bf16x8*)(Kt + ((gk / NGH) * 64 + ko + 32 * (gk % NGH) + 16 * b2 + q16) * ATT_ROWB + 64 * ks + 16 * g4);
#pragma unroll
    for (int d = 0; d < 4; ++d)
#pragma unroll
        for (int gk = 0; gk < NG; ++gk) { const LAS unsigned char* vp = Vt_ + (16 * d + q16) * ATT_VROWB + 2 * ((gk / NGH) * 64 + ko + 32 * (gk % NGH) + 4 * g4);
            vf[d][gk][0] = *(const LAS u32x2*)vp; vf[d][gk][1] = *(const LAS u32x2*)(vp + 32); }
    if (LATENT) {
#pragma unroll
        for (int kk = 0; kk < 8; ++kk) { sc[kk >> 2][kk & 3] = browA[relidx[kk]] - m_ref; sc[2 + (kk >> 2)][kk & 3] = browB[relidx[kk]] - m_ref; }
    } else {
#pragma unroll
        for (int blk = 0; blk < 2 * NG; ++blk) sc[blk] = (f32x4){-m_ref, -m_ref, -m_ref, -m_ref};
    }
#pragma unroll
    for (int blk = 0; blk < 2 * NG; ++blk)
#pragma unroll
        for (int ks = 0; ks < 2; ++ks) sc[blk] = __builtin_amdgcn_mfma_f32_16x16x32_bf16(kf[blk][ks], qf[ks], sc[blk], 0, 0, 0);
    float mx = fmaxf(fmaxf(sc[0][0], sc[0][1]), fmaxf(sc[0][2], sc[0][3]));
#pragma unroll
    for (int blk = 1; blk < 2 * NG; ++blk) mx = fmaxf(mx, fmaxf(fmaxf(sc[blk][0], sc[blk][1]), fmaxf(sc[blk][2], sc[blk][3])));
    if (__builtin_amdgcn_ballot_w64(mx > ATT_THR) != 0ull) {
        mx = fmaxf(mx, __shfl_xor(mx, 16)); mx = fmaxf(mx, __shfl_xor(mx, 32));
        const float dl = mx > ATT_THR ? mx : 0.f;
        m_ref += dl;
        const float al = __builtin_amdgcn_exp2f(-dl);
        l_run *= al;
#pragma unroll
        for (int d = 0; d < 4; ++d) o[d] *= al;
#pragma unroll
        for (int blk = 0; blk < 2 * NG; ++blk) sc[blk] -= dl;
    }
    float ls0 = 0.f, ls1 = 0.f;
#pragma unroll
    for (int blk = 0; blk < 2 * NG; ++blk)
#pragma unroll
        for (int i = 0; i < 4; ++i) { const float e = __builtin_amdgcn_exp2f(sc[blk][i]); sc[blk][i] = e; if (blk & 1) ls1 += e; else ls0 += e; }
    l_run += ls0 + ls1;
    bf16x8 pf[NG];
#pragma unroll
    for (int gk = 0; gk < NG; ++gk) { u32x4 pw; pw.x = cvtpk(sc[2 * gk][0], sc[2 * gk][1]); pw.y = cvtpk(sc[2 * gk][2], sc[2 * gk][3]); pw.z = cvtpk(sc[2 * gk + 1][0], sc[2 * gk + 1][1]); pw.w = cvtpk(sc[2 * gk + 1][2], sc[2 * gk + 1][3]);
        pf[gk] = __builtin_bit_cast(bf16x8, pw); }
#pragma unroll
    for (int gk = 0; gk < NG; ++gk)
#pragma unroll
        for (int d = 0; d < 4; ++d) { u32x4 vw; vw.x = vf[d][gk][0].x; vw.y = vf[d][gk][0].y; vw.z = vf[d][gk][1].x; vw.w = vf[d][gk][1].y;
            o[d] = __builtin_amdgcn_mfma_f32_16x16x32_bf16(__builtin_bit_cast(bf16x8, vw), pf[gk], o[d], 0, 0, 0); }
}
__device__ __forceinline__ void attn_phase(const Ctx& F0, const Args& a) {
    const Ctx F = fresh(F0);
    const bf16_t* QK = (const bf16_t*)(a.ws + WS_QK);
    const bf16_t* VT = (const bf16_t*)(a.ws + WS_VT);
    bf16_t* AO = (bf16_t*)(a.ws + WS_HX);
    const float* rpb = a.in[10];
    LAS float* bias = (LAS float*)F.lds;
    const int tid = F.tid, lane = F.lane, q16 = lane & 15, g4 = lane >> 4;
    const int rr = F.wave >> 2, jt = F.wave & 3;
    const int qc = 16 * jt + q16, cs = min(max(qc - 8, 0), 48), ksj = min(max(16 * jt - 8, 0), 32);
    int relidx[8];
#pragma unroll
    for (int k = 0; k < 8; ++k) { const int kc = ksj + 16 * (k >> 2) + 4 * g4 + (k & 3); relidx[k] = (kc >= cs && kc < cs + 16) ? (kc - qc + 15) : 31; }
    const int krow = tid >> 3, kch = tid & 7, vrow = tid >> 4, vch = tid & 15;
    const unsigned lds_k = (unsigned)(krow * ATT_ROWB + kch * 16), lds_v = (unsigned)(vrow * ATT_VROWB + vch * 16);
    const int nunits = NB * 16 * 32, upb = (nunits + F.G - 1) / F.G;
    int cur_bh = -1;
    for (int k = 0; k < upb; ++k) {
        const int id = F.vcu * upb + k; if (id >= nunits) break;
        const int p = id & 31, bh = id >> 5, b = bh >> 4, h = bh & 15;
        if (bh != cur_bh) {
            __syncthreads();
            for (int i = tid; i < 16 * 32; i += 512) { const int dr = i >> 5, dc = i & 31; bias[i] = (dc < 31 && dr < 15) ? rpb[(h * 15 + dr) * 31 + dc] * LOG2E : -1e30f; }
            cur_bh = bh;
        }
        const int r0 = 2 * p, rs0 = min(max(r0 - 4, 0), 56), rs1 = min(max(r0 + 1 - 4, 0), 56);
        const int nlat = rs1 + 8 - rs0, nlt = (nlat + 1) >> 1, nsteps = nlt + 2;
        const int r = r0 + rr, rs = rr ? rs1 : rs0;
        const long tokq = (long)b * SEQ + r * GW + qc;
        const bf16_t* kbase = QK + 1024 + h * 64 + kch * 8;
        const bf16_t* vbase = VT + (long)(h * 64 + vrow) * MT + (vch & 7) * 8;
#define ATT_TOKA(step) ((step) < nlt ? ((long)b * SEQ + (long)(rs0 + 2 * (step)) * GW) : ((long)ML + b * CTXL + ((step) - nlt) * 128))
#define ATT_TOKB(step) ((step) < nlt ? ((long)b * SEQ + (long)min(rs0 + 2 * (step) + 1, rs0 + nlat - 1) * GW) : ((long)ML + b * CTXL + ((step) - nlt) * 128 + 64))
        u32x4 kA[2], vA[2], kB[2], vB[2];
#define ATT_LOAD(step, kr_, vr_) do { const int st_ = (step) < nsteps ? (step) : nsteps - 1; const long ta_ = ATT_TOKA(st_), tb_ = ATT_TOKB(st_);     \
        kr_[0] = *(const u32x4*)(kbase + (ta_ + krow) * 2048); kr_[1] = *(const u32x4*)(kbase + (tb_ + krow) * 2048); \
        const long tv_ = (vch < 8) ? ta_ : tb_; vr_[0] = *(const u32x4*)(vbase + tv_); vr_[1] = *(const u32x4*)(vbase + (long)32 * MT + tv_); } while (0)
#define ATT_WRITE(buf, kr_, vr_) do { *(LAS u32x4*)(F.lds + ATT_K0 + (buf) * ATT_KTILEB + lds_k) = kr_[0]; *(LAS u32x4*)(F.lds + ATT_K0 + (buf) * ATT_KTILEB + 64 * ATT_ROWB + lds_k) = kr_[1]; \
        *(LAS u32x4*)(F.lds + ATT_V0 + (buf) * ATT_VTILEB + lds_v) = vr_[0]; *(LAS u32x4*)(F.lds + ATT_V0 + (buf) * ATT_VTILEB + 32 * ATT_VROWB + lds_v) = vr_[1]; } while (0)
        ATT_LOAD(0, kA, vA); ATT_LOAD(1, kB, vB);
        bf16x8 qf[2];
#pragma unroll
        for (int ks = 0; ks < 2; ++ks) qf[ks] = *(const bf16x8*)(QK + tokq * 2048 + h * 64 + 32 * ks + 8 * g4);
        float m_ref = 0.f, l_run = 0.f;
        f32x4 o[4];
#pragma unroll
        for (int d = 0; d < 4; ++d) o[d] = (f32x4){0.f, 0.f, 0.f, 0.f};
        __syncthreads();
        ATT_WRITE(0, kA, vA);
        asm volatile("" :: "v"(qf[0]), "v"(qf[1]));
        __syncthreads();
#define ATT_COMPUTE(step, cur) do { \
            const LAS unsigned char* Kt = F.lds + ATT_K0 + (cur) * ATT_KTILEB; \
            const LAS unsigned char* Vt_ = F.lds + ATT_V0 + (cur) * ATT_VTILEB; \
            if ((step) < nlt) { const int krA = rs0 + 2 * (step), krB = krA + 1; \
                const bool actA = krA >= rs && krA < rs + 8, actB = krB < rs0 + nlat && krB >= rs && krB < rs + 8; \
                if (actA || actB) attn_sub<1, true>(Kt, Vt_, ksj, bias + (actA ? (krA - r + 7) : 15) * 32, bias + (actB ? (krB - r + 7) : 15) * 32, relidx, qf, m_ref, l_run, o, q16, g4); \
            } else attn_sub<2, false>(Kt, Vt_, 0, bias, bias, relidx, qf, m_ref, l_run, o, q16, g4); \
        } while (0)
        for (int step = 0; step < nsteps; step += 2) {
            ATT_COMPUTE(step, 0);
            if (step + 1 < nsteps) ATT_WRITE(1, kB, vB);
            ATT_LOAD(step + 2, kA, vA);
            __syncthreads();
            if (step + 1 < nsteps) { ATT_COMPUTE(step + 1, 1); }
            if (step + 2 < nsteps) ATT_WRITE(0, kA, vA);
            ATT_LOAD(step + 3, kB, vB);
            __syncthreads();
        }
#undef ATT_LOAD
#undef ATT_WRITE
#undef ATT_COMPUTE
#undef ATT_TOKA
#undef ATT_TOKB
        l_run += __shfl_xor(l_run, 16); l_run += __shfl_xor(l_run, 32);
        const float linv = 1.0f / l_run;
        bf16_t* op = AO + tokq * DM + h * 64 + 4 * g4;
#pragma unroll
        for (int d = 0; d < 4; ++d) { u32x2 w; w.x = cvtpk(o[d][0] * linv, o[d][1] * linv); w.y = cvtpk(o[d][2] * linv, o[d][3] * linv); *(u32x2*)(op + 16 * d) = w; }
    }
    __syncthreads();
}

__device__ __forceinline__ void ce_desc(float& a, float& b) { const float hi = fmaxf(a, b), lo = fminf(a, b); a = hi; b = lo; }
__device__ __forceinline__ void ce_dir(float& a, float& b, bool desc) { const float hi = fmaxf(a, b), lo = fminf(a, b); a = desc ? hi : lo; b = desc ? lo : hi; }
__device__ __forceinline__ void sort16_desc(float (&v)[16]) {
#pragma unroll
    for (int k = 2; k <= 16; k <<= 1)
#pragma unroll
        for (int j = k >> 1; j > 0; j >>= 1)
#pragma unroll
            for (int i = 0; i < 16; ++i) { const int l = i ^ j; if (l > i) ce_dir(v[i], v[l], (i & k) == 0); }
}
__device__ __forceinline__ void merge16_desc(float (&a)[16], const float (&b)[16]) {
#pragma unroll
    for (int i = 0; i < 16; ++i) a[i] = fmaxf(a[i], b[15 - i]);
#pragma unroll
    for (int j = 8; j > 0; j >>= 1)
#pragma unroll
        for (int i = 0; i < 16; ++i) { const int l = i ^ j; if (l > i) ce_desc(a[i], a[l]); }
}

struct CandTab { int i[64]; int j[64]; };
__host__ __device__ constexpr CandTab make_cand_tab() {
    CandTab t{}; int n = 0;
    for (int i = 0; i < 16; ++i) for (int j = 0; j < 16; ++j) if ((i + 1) * (j + 1) <= 16) { t.i[n] = i; t.j[n] = j; ++n; }
    for (; n < 64; ++n) { t.i[n] = -1; t.j[n] = -1; }
    return t;
}

__device__ __forceinline__ void peer_topk_phase(const Ctx& F0, const Args& a, int layer) {
    const Ctx F = fresh(F0);
    const bf16_t* QP = (const bf16_t*)(a.ws + WS_QK);
    const bf16_t* SK = (const bf16_t*)(a.ws + WS_SK) + (size_t)layer * 2 * 128 * 128;
    unsigned short* IDX = (unsigned short*)(a.ws + WS_IDX);
    float* GATE = (float*)(a.ws + WS_GATE);
    const int gwv = F.vcu * NWAVES + F.wave, NGW = F.G * NWAVES;
    const int lane = F.lane, t32 = lane & 31, hi = lane >> 5;
    __syncthreads();
    for (int c = F.tid; c < 4096; c += 512) *(LAS u32x4*)(F.lds + (c >> 4) * 272 + (c & 15) * 16) = *(const u32x4*)(SK + (size_t)c * 8);
    __syncthreads();
    for (int task = gwv; task < 1024 * 8; task += NGW) {
        const int tt = task >> 3, h = task & 7;
        const long tok = (long)tt * 32 + t32;
        float top[2][16];
#pragma unroll
        for (int p = 0; p < 2; ++p) {
            f32x16 acc[4];
#pragma unroll
            for (int eb = 0; eb < 4; ++eb)
#pragma unroll
                for (int i = 0; i < 16; ++i) acc[eb][i] = 0.f;
#pragma unroll
            for (int eb = 0; eb < 4; ++eb) asm volatile("" : "+v"(acc[eb]));
            const bf16_t* qp = QP + tok * 2048 + h * 256 + p * 128 + hi * 8;
            const LAS unsigned char* kp = F.lds + (p * 128 + t32) * 272 + hi * 16;
#pragma unroll
            for (int ks = 0; ks < 8; ++ks) {
                if ((ks & 1) == 0) asm volatile("" ::: "memory");
                const bf16x8 bq = *(const bf16x8*)(qp + ks * 16);
#pragma unroll
                for (int eb = 0; eb < 4; ++eb) { const bf16x8 ak = *(const LAS bf16x8*)(kp + eb * 32 * 272 + ks * 32); acc[eb] = __builtin_amdgcn_mfma_f32_32x32x16_bf16(ak, bq, acc[eb], 0, 0, 0); }
            }
            float cur[16];
#pragma unroll
            for (int eb = 0; eb < 4; ++eb) {
                float v[16];
#pragma unroll
                for (int i = 0; i < 16; ++i) { const unsigned e = 32 * eb + crow(i, hi); float x = acc[eb][i]; asm volatile("" : "+v"(x));
                    v[i] = __builtin_bit_cast(float, (__builtin_bit_cast(unsigned, x) & ~0x7Fu) | e); }
                sort16_desc(v);
                if (eb == 0) {
#pragma unroll
                    for (int i = 0; i < 16; ++i) cur[i] = v[i];
                } else merge16_desc(cur, v);
            }
            float oth[16];
#pragma unroll
            for (int i = 0; i < 16; ++i) oth[i] = __shfl_xor(cur[i], 32);
            merge16_desc(cur, oth);
#pragma unroll
            for (int i = 0; i < 16; ++i) top[p][i] = cur[i];
            __builtin_amdgcn_sched_barrier(0);
        }
        float best[16];
#pragma unroll
        for (int gI = 0; gI < 4; ++gI) {
            float v[16];
#pragma unroll
            for (int q = 0; q < 16; ++q) {
                constexpr CandTab CT = make_cand_tab();
                const int ci = CT.i[16 * gI + q], cj = CT.j[16 * gI + q];
                if (ci >= 0) {
                    const unsigned ua = __builtin_bit_cast(unsigned, top[0][ci]), ub = __builtin_bit_cast(unsigned, top[1][cj]);
                    float s = top[0][ci] + top[1][cj]; asm volatile("" : "+v"(s));
                    const unsigned code = ((ua & 0x7Fu) << 7) | (ub & 0x7Fu);
                    v[q] = __builtin_bit_cast(float, (__builtin_bit_cast(unsigned, s) & ~0x3FFFu) | code);
                } else v[q] = -3.0e38f;
            }
            sort16_desc(v);
            if (gI == 0) {
#pragma unroll
                for (int i = 0; i < 16; ++i) best[i] = v[i];
            } else merge16_desc(best, v);
            __builtin_amdgcn_sched_barrier(0);
        }
        float e[16], sum = 0.f;
#pragma unroll
        for (int i = 0; i < 16; ++i) { e[i] = __builtin_amdgcn_exp2f((best[i] - best[0]) * LOG2E); sum += e[i]; }
        const float inv = 1.0f / sum;
        if (hi == 0) {
            u32x4 w0, w1;
            w0.x = (__builtin_bit_cast(unsigned, best[0]) & 0x3FFFu) | ((__builtin_bit_cast(unsigned, best[1]) & 0x3FFFu) << 16);
            w0.y = (__builtin_bit_cast(unsigned, best[2]) & 0x3FFFu) | ((__builtin_bit_cast(unsigned, best[3]) & 0x3FFFu) << 16);
            w0.z = (__builtin_bit_cast(unsigned, best[4]) & 0x3FFFu) | ((__builtin_bit_cast(unsigned, best[5]) & 0x3FFFu) << 16);
            w0.w = (__builtin_bit_cast(unsigned, best[6]) & 0x3FFFu) | ((__builtin_bit_cast(unsigned, best[7]) & 0x3FFFu) << 16);
            w1.x = (__builtin_bit_cast(unsigned, best[8]) & 0x3FFFu) | ((__builtin_bit_cast(unsigned, best[9]) & 0x3FFFu) << 16);
            w1.y = (__builtin_bit_cast(unsigned, best[10]) & 0x3FFFu) | ((__builtin_bit_cast(unsigned, best[11]) & 0x3FFFu) << 16);
            w1.z = (__builtin_bit_cast(unsigned, best[12]) & 0x3FFFu) | ((__builtin_bit_cast(unsigned, best[13]) & 0x3FFFu) << 16);
            w1.w = (__builtin_bit_cast(unsigned, best[14]) & 0x3FFFu) | ((__builtin_bit_cast(unsigned, best[15]) & 0x3FFFu) << 16);
            u32x4* ip = (u32x4*)(IDX + tok * 128 + h * 16);
            ip[0] = w0; ip[1] = w1;
        } else {
            f32x4* gp = (f32x4*)(GATE + tok * 128 + h * 16);
#pragma unroll
            for (int q = 0; q < 4; ++q) gp[q] = (f32x4){e[4 * q] * inv, e[4 * q + 1] * inv, e[4 * q + 2] * inv, e[4 * q + 3] * inv};
        }
    }
    __syncthreads();
}

typedef long i64_t;
typedef _Float16 h2_t __attribute__((ext_vector_type(2)));
template <int CTRL> __device__ __forceinline__ float dpp_f(float v) { return __builtin_bit_cast(float, __builtin_amdgcn_update_dpp(0, __builtin_bit_cast(int, v), CTRL, 0xF, 0xF, true)); }
__device__ __forceinline__ void peer_u_phase(const Ctx& F0, const Args& a, int layer) {
    const Ctx F = fresh(F0);
    const int s = (int)(blockIdx.x & 7), j = (int)(blockIdx.x >> 3), nmem = F.G >> 3;
    const unsigned char* U8s = a.ws + WS_TAB + (size_t)layer * TAB_LAYER + (size_t)s * NEXP * 128;
    const unsigned char* X8s = a.ws + WS_X8 + (size_t)s * ML * 128;
    const bf16_t* HX = (const bf16_t*)(a.ws + WS_HX);
    const unsigned short* IDX = (const unsigned short*)(a.ws + WS_IDX);
    unsigned* PART = (unsigned*)(a.ws + WS_PART) + (size_t)s * ML * 64;
    const int lane = F.lane, rsub = lane >> 3, c16 = lane & 7;
    const bool c2 = (lane & 4) != 0, c1 = (lane & 2) != 0, c0 = (lane & 1) != 0;
    const int t0 = j * NWAVES + F.wave, stride = nmem * NWAVES, ntok = (ML - t0 + stride - 1) / stride;
#define U_TOK(i) ((size_t)(t0 + ((i) < ntok ? (i) : ntok - 1) * stride))
    u32x4 iN[2], R[16];
    { const size_t o_ = U_TOK(0) * 128 + 16 * rsub; iN[0] = *(const u32x4*)(IDX + o_); iN[1] = *(const u32x4*)(IDX + o_ + 8); }
#pragma unroll
    for (int i_ = 0; i_ < 16; ++i_) { const unsigned pair_ = iN[i_ >> 3][(i_ & 7) >> 1]; const unsigned e_ = (i_ & 1) ? (pair_ >> 16) : (pair_ & 0xffffu);
        R[i_] = *(const u32x4*)(U8s + (unsigned)(e_ * 128 + 16 * c16)); }
    { const size_t o_ = U_TOK(1) * 128 + 16 * rsub; iN[0] = *(const u32x4*)(IDX + o_); iN[1] = *(const u32x4*)(IDX + o_ + 8); }
    for (int i = 0; i < ntok; ++i) {
        const size_t t_ = U_TOK(i);
        const u32x4 xq = *(const u32x4*)(X8s + t_ * 128 + 16 * c16);
        u32x4 iNN[2];
        { const size_t o_ = U_TOK(i + 2) * 128 + 16 * rsub; iNN[0] = *(const u32x4*)(IDX + o_); iNN[1] = *(const u32x4*)(IDX + o_ + 8); }
        float v[16];
#pragma unroll
        for (int i_ = 0; i_ < 16; ++i_) {
            u32x4 r_ = R[i_]; asm volatile("" : "+v"(r_));
            int acc_ = 0;
#pragma unroll
            for (int d = 0; d < 4; ++d) acc_ = __builtin_amdgcn_sdot4((int)r_[d], (int)xq[d], acc_, false);
            v[i_] = (float)acc_;
            asm volatile("" : "+v"(v[i_]));
            const unsigned pair_ = iN[i_ >> 3][(i_ & 7) >> 1]; const unsigned e_ = (i_ & 1) ? (pair_ >> 16) : (pair_ & 0xffffu);
            R[i_] = *(const u32x4*)(U8s + (unsigned)(e_ * 128 + 16 * c16));
        }
        iN[0] = iNN[0]; iN[1] = iNN[1];
        float a8[8], a4[4], a2[2];
#pragma unroll
        for (int k = 0; k < 8; ++k) { const float keep = c2 ? v[k + 8] : v[k], send = c2 ? v[k] : v[k + 8]; a8[k] = keep + dpp_f<0x141>(send); }
#pragma unroll
        for (int k = 0; k < 4; ++k) { const float keep = c1 ? a8[k + 4] : a8[k], send = c1 ? a8[k] : a8[k + 4]; a4[k] = keep + dpp_f<0x4E>(send); }
#pragma unroll
        for (int k = 0; k < 2; ++k) { const float keep = c0 ? a4[k + 2] : a4[k], send = c0 ? a4[k] : a4[k + 2]; a2[k] = keep + dpp_f<0xB1>(send); }
        PART[t_ * 64 + lane] = cvtpk(a2[0], a2[1]);
    }
#undef U_TOK
}
__device__ __forceinline__ void peer_w_phase(const Ctx& F0, const Args& a) {
    const Ctx F = fresh(F0);
    const unsigned* PART = (const unsigned*)(a.ws + WS_PART);
    const float* GATE = (const float*)(a.ws + WS_GATE);
    unsigned char* WQ = a.ws + WS_WT;
    float* WSC = (float*)(a.ws + WS_WSC);
    const int gwv = F.vcu * NWAVES + F.wave, NGW = F.G * NWAVES;
    for (int t = gwv; t < ML; t += NGW) {
        f32x2 z = (f32x2){0.f, 0.f};
#pragma unroll
        for (int s = 0; s < 8; ++s) { const unsigned pw = PART[((size_t)s * ML + t) * 64 + F.lane]; z += (f32x2){bflo(pw), bfhi(pw)}; }
        const f32x2 g = *(const f32x2*)(GATE + (size_t)t * 128 + 2 * F.lane);
        f32x2 w; w.x = g.x * gelu_erf(z.x * (1.0f / (U_SCALE * XQ_SCALE))); w.y = g.y * gelu_erf(z.y * (1.0f / (U_SCALE * XQ_SCALE)));
        float wm = fmaxf(__builtin_fabsf(w.x), __builtin_fabsf(w.y));
#pragma unroll
        for (int o = 1; o < 64; o <<= 1) wm = fmaxf(wm, __shfl_xor(wm, o));
        wm = fmaxf(wm, 1e-20f);
        const float qs = 127.0f / wm;
        const int qa = (int)rintf(w.x * qs), qb = (int)rintf(w.y * qs);
        ((unsigned short*)WQ)[(size_t)t * 64 + F.lane] = (unsigned short)((qa & 0xff) | ((qb & 0xff) << 8));
        if (F.lane == 0) WSC[t] = wm * (1.0f / 127.0f);
    }
}
__device__ __forceinline__ void peer_v_phase(const Ctx& F0, const Args& a, int layer, float oscale = 1.0f) {
    const Ctx F = fresh(F0);
    const int s = (int)(blockIdx.x & 7), j = (int)(blockIdx.x >> 3), nmem = F.G >> 3;
    const unsigned char* V8s = a.ws + WS_TAB + (size_t)layer * TAB_LAYER + TAB_VOFF + (size_t)s * NEXP * 128;
    const unsigned short* IDX = (const unsigned short*)(a.ws + WS_IDX);
    const unsigned char* WQ = a.ws + WS_WT;
    const float* WSC = (const float*)(a.ws + WS_WSC);
    const float* modb = (const float*)(a.ws + WS_MOD) + (size_t)layer * 9 * NMOD;
    float* X = a.out;
    const int lane = F.lane, rsub = lane >> 3, c16 = lane & 7;
    LAS float* red = (LAS float*)(F.lds + F.wave * 4096);
    const float dbg_s = ((DBG_SKIP & (layer == 0 ? 2 : 8)) ? 0.f : oscale) * (1.0f / V_SCALE);
    const int t0 = j * NWAVES + F.wave, stride = nmem * NWAVES, ntok = (ML - t0 + stride - 1) / stride;
#define V_TOK(i) ((size_t)(t0 + ((i) < ntok ? (i) : ntok - 1) * stride))
#define V_EID(iv, i_) (((i_) & 1) ? (iv[(i_) >> 3][((i_) & 7) >> 1] >> 16) : (iv[(i_) >> 3][((i_) & 7) >> 1] & 0xffffu))
    u32x4 iN[2], R[16], wq;
    { const size_t o_ = V_TOK(0) * 128 + 16 * rsub; iN[0] = *(const u32x4*)(IDX + o_); iN[1] = *(const u32x4*)(IDX + o_ + 8); wq = *(const u32x4*)(WQ + o_); }
#pragma unroll
    for (int i_ = 0; i_ < 16; ++i_) R[i_] = *(const u32x4*)(V8s + (unsigned)(V_EID(iN, i_) * 128 + 16 * c16));
    { const size_t o_ = V_TOK(1) * 128 + 16 * rsub; iN[0] = *(const u32x4*)(IDX + o_); iN[1] = *(const u32x4*)(IDX + o_ + 8); }
    for (int i = 0; i < ntok; ++i) {
        u32x4 iNN[2], wqN;
        { const size_t o_ = V_TOK(i + 2) * 128 + 16 * rsub; iNN[0] = *(const u32x4*)(IDX + o_); iNN[1] = *(const u32x4*)(IDX + o_ + 8); }
        wqN = *(const u32x4*)(WQ + V_TOK(i + 1) * 128 + 16 * rsub);
        const size_t t_ = V_TOK(i);
        f32x2* xo_ = (f32x2*)(X + t_ * DM + 128 * s + 2 * lane);
        const f32x2 xold = *xo_;
        const f32x2 gate2 = *(const f32x2*)(modb + (t_ >> 12) * NMOD + 5 * DM + 128 * s + 2 * lane);
        const float wsc = WSC[t_];
        int acc[16];
#pragma unroll
        for (int c = 0; c < 16; ++c) acc[c] = 0;
#pragma unroll
        for (int g = 0; g < 4; ++g) {
            u32x4 ra = R[4 * g], rb = R[4 * g + 1], rc = R[4 * g + 2], rd = R[4 * g + 3];
            asm volatile("" : "+v"(ra), "+v"(rb), "+v"(rc), "+v"(rd));
            const unsigned wpk = wq[g];
#pragma unroll
            for (int blk = 0; blk < 4; ++blk) {
                const unsigned ab_lo = __builtin_amdgcn_perm(ra[blk], rb[blk], 0x01050004u), ab_hi = __builtin_amdgcn_perm(ra[blk], rb[blk], 0x03070206u);
                const unsigned cd_lo = __builtin_amdgcn_perm(rc[blk], rd[blk], 0x01050004u), cd_hi = __builtin_amdgcn_perm(rc[blk], rd[blk], 0x03070206u);
                acc[4 * blk + 0] = __builtin_amdgcn_sdot4((int)__builtin_amdgcn_perm(ab_lo, cd_lo, 0x01000504u), (int)wpk, acc[4 * blk + 0], false);
                acc[4 * blk + 1] = __builtin_amdgcn_sdot4((int)__builtin_amdgcn_perm(ab_lo, cd_lo, 0x03020706u), (int)wpk, acc[4 * blk + 1], false);
                acc[4 * blk + 2] = __builtin_amdgcn_sdot4((int)__builtin_amdgcn_perm(ab_hi, cd_hi, 0x01000504u), (int)wpk, acc[4 * blk + 2], false);
                acc[4 * blk + 3] = __builtin_amdgcn_sdot4((int)__builtin_amdgcn_perm(ab_hi, cd_hi, 0x03020706u), (int)wpk, acc[4 * blk + 3], false);
            }
#pragma unroll
            for (int c = 0; c < 16; ++c) asm volatile("" : "+v"(acc[c]));
#pragma unroll
            for (int k = 0; k < 4; ++k) R[4 * g + k] = *(const u32x4*)(V8s + (unsigned)(V_EID(iN, 4 * g + k) * 128 + 16 * c16));
        }
#pragma unroll
        for (int q = 0; q < 4; ++q) *(LAS f32x4*)(red + rsub * 128 + c16 * 16 + 4 * q) = (f32x4){(float)acc[4 * q], (float)acc[4 * q + 1], (float)acc[4 * q + 2], (float)acc[4 * q + 3]};
        f32x2 sum = (f32x2){0.f, 0.f};
#pragma unroll
        for (int r = 0; r < 8; ++r) sum += *(const LAS f32x2*)(red + r * 128 + 2 * lane);
        *xo_ = xold + gate2 * (dbg_s * wsc) * sum;
        wq = wqN; iN[0] = iNN[0]; iN[1] = iNN[1];
    }
#undef V_TOK
#undef V_EID
}

__device__ __forceinline__ void dft_nyquist_rows(const Ctx& F0, const Args& a) {
    const Ctx F = fresh(F0);
    const bf16_t* Yt = (const bf16_t*)(a.ws + WS_QK);
    bf16_t* Fo = (bf16_t*)(a.ws + WS_VT);
    const int gwv = F.vcu * NWAVES + F.wave, NGW = F.G * NWAVES;
    for (int o = gwv; o < NB * DM; o += NGW) {
        const bf16_t* src = Yt + (size_t)o * 8192;
        float s = 0.f;
#pragma unroll
        for (int it = 0; it < 8; ++it) { const u32x4 v = *(const u32x4*)(src + it * 512 + F.lane * 8);
#pragma unroll
            for (int d = 0; d < 4; ++d) s += bflo(v[d]) - bfhi(v[d]); }
        s = wave_sum(s) * (1.0f / 64.0f);
        if (F.lane == 0) Fo[((size_t)(o >> 10) * SEQ + 2048) * DM + (o & 1023)] = (bf16_t)f2bf(s);
    }
}

__global__ void __launch_bounds__(NWAVES * 64, 2) fwd_kernel(Args args) {
    extern __shared__ __attribute__((aligned(16))) unsigned char lds_raw[];
    Ctx F;
    F.lds = (LAS unsigned char*)lds_raw;
    F.tid = threadIdx.x; F.lane = F.tid & 63; F.wave = __builtin_amdgcn_readfirstlane(F.tid >> 6);
    F.G = gridDim.x; { const int bx = blockIdx.x; F.vcu = (F.G % 8 == 0) ? (bx % 8) * (F.G / 8) + bx / 8 : bx; }
    volatile LAS unsigned* MISC = (volatile LAS unsigned*)(F.lds + MISC_OFF);
    for (int u = F.tid; u < (LDS_BYTES - LDSCTL_OFF) / 4; u += NWAVES * 64) ((LAS unsigned*)(F.lds + LDSCTL_OFF))[u] = 0u;
    __syncthreads();
    unsigned char* ws = args.ws;
    XcdBarrier bar = xcd_barrier_post((unsigned*)(ws + WS_CTL) + CW_BAR, MISC + 8);
#define GRID_BAR() xcd_barrier(bar)
#ifndef DBG_REP
#define DBG_REP 0
#endif
#define REP(k, ...) do { __VA_ARGS__; if (DBG_REP == (k)) { GRID_BAR(); __VA_ARGS__; } } while (0)
#define PEER_BLOCK(layer) do { \
        norm_phase(F, args, 1, layer, 3 * DM, args.in[5] + (layer) * DM); \
        GRID_BAR(); \
        { using SHq = pg8::Shape<ML, 2048, DM, DM, DM, 1, 0, 0>; \
          REP(7, pg8::gemm_phase<SHq>(F.lds, pg8::Gemm{HX, (const bf16_t*)(ws + WS_WPQ) + (size_t)(layer) * 2048 * DM}, F.G, bx, pg8::EpiStoreBf16{QKb, 2048, 0, 0, 1.0f})); } \
        GRID_BAR(); \
        REP(8, peer_topk_phase(F, args, layer)); \
        GRID_BAR(); \
        REP(9, peer_u_phase(F, args, layer)); \
        GRID_BAR(); \
        REP(10, peer_w_phase(F, args)); \
        GRID_BAR(); \
        peer_v_phase(F, args, layer); if (DBG_REP == 11) { GRID_BAR(); peer_v_phase(F, args, layer, 0.f); } \
        GRID_BAR(); \
    } while (0)
    const float* modb = (const float*)(ws + WS_MOD);
    bf16_t* HX = (bf16_t*)(ws + WS_HX);
    bf16_t* QKb = (bf16_t*)(ws + WS_QK);
    bf16_t* VTb = (bf16_t*)(ws + WS_VT);
    const bf16_t* Wqkv = (const bf16_t*)(ws + WS_WQKV);
    const int bx = (int)blockIdx.x;

    REP(1, p0_prologue(F, args));
    GRID_BAR();
    REP(2, norm_phase(F, args, 0, 0, 0, args.in[4]));
    GRID_BAR();
    {
        using SH1 = pg8::Shape<MT, 2048, DM, DM, DM, 1, 0, 0>;
        pg8::gemm_phase<SH1>(F.lds, pg8::Gemm{HX, Wqkv}, F.G, bx, pg8::EpiStoreBf16{QKb, 2048, 0, 1024, 0.125f * LOG2E});
        using SH2 = pg8::Shape<DM, MT, DM, DM, DM, 1, 0, 0>;
        pg8::gemm_phase<SH2>(F.lds, pg8::Gemm{Wqkv + (size_t)2048 * DM, HX}, F.G, bx, pg8::EpiStoreBf16{VTb, MT, 0, 0, 1.0f});
        {
            const int nq = (MT / 256) * 8, nv = 4 * (MT / 256), rq = nq % F.G, rv = nv % F.G;
            const int sh_q = (rq == 0 || bx >= rq) ? 1 : 0, sh_v = (rv == 0 || bx >= rv) ? 1 : 0;
            const int before = (rq == 0 ? bx : max(0, bx - rq)) + (rv == 0 ? bx : max(0, bx - rv));
            const int total = (rq == 0 ? F.G : F.G - rq) + (rv == 0 ? F.G : F.G - rv);
            table_convert(F, args, before, sh_q + sh_v, total);
        }
        if (DBG_REP == 3) { pg8::gemm_phase<SH1>(F.lds, pg8::Gemm{HX, Wqkv}, F.G, bx, pg8::EpiStoreBf16{QKb, 2048, 0, 1024, 0.125f * LOG2E}); pg8::gemm_phase<SH2>(F.lds, pg8::Gemm{Wqkv + (size_t)2048 * DM, HX}, F.G, bx, pg8::EpiStoreBf16{VTb, MT, 0, 0, 1.0f}); }
    }
    GRID_BAR();
    REP(4, attn_phase(F, args));
    GRID_BAR();
    {
        using SH = pg8::Shape<ML, DM, DM, DM, DM, 1, 0, 0>;
        pg8::gemm_phase<SH>(F.lds, pg8::Gemm{HX, (const bf16_t*)(ws + WS_WO)}, F.G, bx, pg8::EpiResid{args.in[0], args.out, modb + 2 * DM, NMOD, (DBG_SKIP & 1) ? 0.f : 1.f});
    }
    GRID_BAR();
    PEER_BLOCK(0);
    norm_phase(F, args, 1, 1, 0, args.in[4] + DM);
    GRID_BAR();
    {
        using SH = pg8::Shape<512, ML, 256, 256, DM, 4, 0, 256>;
        pg8::gemm_phase<SH>(F.lds, pg8::Gemm{(const bf16_t*)(ws + WS_WC), HX}, F.G, bx, pg8::EpiYt{QKb});
    }
    GRID_BAR();
    {
        using SH = pg8::Shape<SEQ / 2, DM, 8192, 8192, 8192, NB, 0, (long)DM * 8192>;
        REP(14, pg8::gemm_phase<SH>(F.lds, pg8::Gemm{(const bf16_t*)(ws + WS_CS), QKb}, F.G, bx, pg8::EpiDft2{VTb}));
        dft_nyquist_rows(F, args);
    }
    GRID_BAR();
    {
        using SH = pg8::Shape<ML, DM, DM, DM, DM, 1, 0, 0>;
        pg8::gemm_phase<SH>(F.lds, pg8::Gemm{VTb, (const bf16_t*)(ws + WS_WF)}, F.G, bx, pg8::EpiResid{args.out, args.out, modb + (size_t)9 * NMOD + 2 * DM, NMOD, (DBG_SKIP & 4) ? 0.f : 1.f});
    }
    GRID_BAR();
    PEER_BLOCK(1);
    final_norm_phase(F, args);
#undef PEER_BLOCK
}

extern "C" void kernel_launch(void* const* d_in, const int* in_sizes, int n_in, void* d_out, int out_size, void* d_ws, size_t ws_size, hipStream_t stream) {
    static int grid = 0;
    if (grid == 0) {
        if (n_in != 17 || in_sizes[0] != ML * DM || out_size != ML * DM || ws_size < WS_END) { fprintf(stderr, "kernel_launch: unexpected shapes (n_in %d, in0 %d, out %d, ws %zu)\n", n_in, n_in > 0 ? in_sizes[0] : -1, out_size, ws_size); grid = -1; return; }
        int dev = 0, cus = 0, per_cu = 0;
        if (hipGetDevice(&dev) != hipSuccess || hipDeviceGetAttribute(&cus, hipDeviceAttributeMultiprocessorCount, dev) != hipSuccess) { grid = -1; return; }
        if (hipFuncSetAttribute((const void*)fwd_kernel, hipFuncAttributeMaxDynamicSharedMemorySize, LDS_BYTES) != hipSuccess) { fprintf(stderr, "kernel_launch: hipFuncSetAttribute failed\n"); grid = -1; return; }
        if (hipOccupancyMaxActiveBlocksPerMultiprocessor(&per_cu, (const void*)fwd_kernel, NWAVES * 64, LDS_BYTES) != hipSuccess || per_cu < 1)
            fprintf(stderr, "kernel_launch: note: occupancy query reports %d workgroups per CU\n", per_cu);
        (void)hipGetLastError();
        grid = cus;
        if (grid % 8 != 0) { fprintf(stderr, "kernel_launch: CU count %d is not a multiple of 8\n", cus); grid = -1; return; }
    }
    if (grid < 0) return;
    if (hipMemsetAsync((char*)d_ws + WS_CTL, 0, CTL_ZERO_BYTES, stream) != hipSuccess) { fprintf(stderr, "kernel_launch: memset failed\n"); return; }
    Args a{};
    for (int i = 0; i < 17; ++i) a.in[i] = (const float*)d_in[i];
    a.out = (float*)d_out; a.ws = (unsigned char*)d_ws;
    hipLaunchKernelGGL(fwd_kernel, dim3(grid), dim3(NWAVES * 64), LDS_BYTES, stream, a);
    const hipError_t le = hipPeekAtLastError();
    if (le != hipSuccess) fprintf(stderr, "kernel_launch: launch failed: %s\n", hipGetErrorName(le));
}
```

```cpp
#include <hip/hip_runtime.h>
#include <cstdio>
#include <cstdint>

#define LAS __attribute__((address_space(3)))
typedef unsigned short bf16_t;
typedef short bf16x8 __attribute__((ext_vector_type(8)));
typedef short s16x4 __attribute__((ext_vector_type(4)));
typedef float f32x2 __attribute__((ext_vector_type(2)));
typedef float f32x4 __attribute__((ext_vector_type(4)));
typedef float f32x16 __attribute__((ext_vector_type(16)));
typedef unsigned u32x2 __attribute__((ext_vector_type(2)));
typedef unsigned u32x4 __attribute__((ext_vector_type(4)));
typedef __bf16 bf16x2_t __attribute__((ext_vector_type(2)));

#ifndef DBG_SKIP
#define DBG_SKIP 0
#endif
constexpr int DM = 1024, NB = 8, SEQ = 4096, CTXL = 256, GW = 64;
constexpr int ML = NB * SEQ;
constexpr int MC = NB * CTXL;
constexpr int MT = ML + MC;
constexpr int NMOD = 6 * DM;
constexpr int NEXP = 16384;
constexpr float EPS = 1e-6f;
constexpr float LOG2E = 1.4426950408889634f;

constexpr size_t MiB = 1u << 20;
constexpr size_t WS_CTL = 0, CTL_ZERO_BYTES = 1 * MiB;
constexpr size_t WS_MOD = 1 * MiB;
constexpr size_t WS_WQKV = 2 * MiB;
constexpr size_t WS_WO = 8 * MiB;
constexpr size_t WS_WF = 10 * MiB;
constexpr size_t WS_WPQ = 12 * MiB;
constexpr size_t WS_SK = 20 * MiB;
constexpr size_t WS_WC = 20 * MiB + 256 * 1024;
constexpr size_t WS_CS = 22 * MiB;
constexpr size_t WS_TAB = 86 * MiB;
constexpr size_t WS_X8 = 150 * MiB;
constexpr size_t WS_WT = 182 * MiB;
constexpr size_t WS_PART = 282 * MiB;
constexpr float U_SCALE = 96.f;
constexpr float XQ_SCALE = 15.875f;
constexpr float V_SCALE = 28.2f;
constexpr size_t TAB_LAYER = 32 * MiB, TAB_VOFF = 16 * MiB;
constexpr size_t WS_WSC = 198 * MiB;
constexpr size_t WS_HX = 214 * MiB;
constexpr size_t WS_QK = 282 * MiB;
constexpr size_t WS_VT = 418 * MiB;
constexpr size_t WS_IDX = WS_VT;
constexpr size_t WS_GATE = WS_VT + 8 * MiB;
constexpr size_t WS_END = 486 * MiB;
constexpr int CW_BAR = 4096;

__device__ __forceinline__ unsigned f2bf(float f) { unsigned u = __builtin_bit_cast(unsigned, f); return (u + 0x7fffu + ((u >> 16) & 1u)) >> 16; }
__device__ __forceinline__ unsigned pk2(float lo, float hi) { return f2bf(lo) | (f2bf(hi) << 16); }
__device__ __forceinline__ unsigned cvtpk(float lo, float hi) { f32x2 v = {lo, hi}; bf16x2_t b = __builtin_convertvector(v, bf16x2_t); return __builtin_bit_cast(unsigned, b); }
__device__ __forceinline__ float bflo(unsigned u) { return __builtin_bit_cast(float, u << 16); }
__device__ __forceinline__ float bfhi(unsigned u) { return __builtin_bit_cast(float, u & 0xffff0000u); }
__device__ __forceinline__ float wave_sum(float v) {
#pragma unroll
    for (int o = 1; o < 64; o <<= 1) v += __shfl_xor(v, o);
    return v;
}
__device__ __forceinline__ unsigned fp8_pack4(float a, float b, float c, float d) {
    int w = 0;
    w = __builtin_amdgcn_cvt_pk_fp8_f32(__builtin_amdgcn_fmed3f(a, -448.f, 448.f), __builtin_amdgcn_fmed3f(b, -448.f, 448.f), w, false);
    w = __builtin_amdgcn_cvt_pk_fp8_f32(__builtin_amdgcn_fmed3f(c, -448.f, 448.f), __builtin_amdgcn_fmed3f(d, -448.f, 448.f), w, true);
    return (unsigned)w;
}
__device__ __forceinline__ int crow(int r, int hi) { return (r & 3) + 8 * (r >> 2) + 4 * hi; }
__device__ __forceinline__ float gelu_erf(float v) {
    const float av = __builtin_fabsf(v), d = av * 0.2316418882f + 1.0f;
    const float t = __builtin_amdgcn_rcpf(d);
    float q = t * 0.5307027145f + (-0.7265760135f); q = q * t + 0.7107068705f; q = q * t + (-0.142248368f); q = q * t + 0.127414796f; q = q * t;
    const float e = __builtin_amdgcn_exp2f((v * v) * (-0.72134752044f));
    const float m = v * (q * e), r = v - m;
    return v < 0.f ? m : r;
}

namespace pg8 {
constexpr float ACT8_SCALE = 16.f, W8_SCALE = 256.f;
constexpr float YT_SCALE = 16.f, CS_SCALE = 512.f;
constexpr int BM = 256, BK = 64, HALF = 128, HTB = HALF * BK * 2, STAGE_BYTES = 8 * HTB, NXCD = 8, WGM = 8;
__host__ __device__ __forceinline__ int lds_byte(int r, int c) { const int st = (r >> 4) * 2 + (c >> 5), rr = r & 15, cc = c & 31, ob = rr * 64 + cc * 2; return st * 1024 + (ob ^ (((ob >> 9) & 1) << 5)); }
__host__ __device__ __forceinline__ void stage_rc(int b, int& R, int& C) { const int st = b / 1024, sb = b % 1024, swz = sb ^ (((sb >> 9) & 1) << 5); R = (st >> 1) * 16 + swz / 64; C = (st & 1) * 32 + (swz % 64) / 2; }
__host__ __device__ __forceinline__ int perm32(int rho) { const int n = rho >> 4, i = rho & 15; return 8 * (i >> 2) + 4 * n + (i & 3); }

struct Unit { int pm, pn, pb; };
struct Gemm { const bf16_t* A; const bf16_t* Bt; };
template <int M_, int N_, int K_, int LDA_, int LDB_, int NBATCH_, long BSA_, long BSB_> struct Shape { static constexpr int M = M_, N = N_, K = K_, lda = LDA_, ldb = LDB_, nbatch = NBATCH_; static constexpr long bsA = BSA_, bsB = BSB_; };

template <class SH> struct StaticOrder {
    static constexpr int nM = SH::M / BM, nN = SH::N / BM, per = nM * nN, nwg = per * SH::nbatch;
    int G, c;
    __device__ __forceinline__ void init(int G_, int c_) { G = G_; c = c_; }
    __device__ __forceinline__ bool next(int i, Unit& u) const {
        const long L = (long)i * G + c; if (L >= nwg) return false;
        int wgid = (int)L; { const int q = nwg / NXCD, r = nwg % NXCD, xcd = wgid % NXCD, off = wgid / NXCD; wgid = (xcd < r ? xcd * (q + 1) : r * (q + 1) + (xcd - r) * q) + off; }
        u.pb = wgid / per; wgid -= u.pb * per;
        const int nig = WGM * nN, gid = wgid / nig, fm = gid * WGM, gsz = (nM - fm) < WGM ? (nM - fm) : WGM;
        u.pm = fm + ((wgid % nig) % gsz); u.pn = (wgid % nig) / gsz; return true;
    }
};

struct EpiStoreBf16 {
    static constexpr bool PERM = true;
    bf16_t* O; long ldc; long bstride; int scols; float scale0; float oscale = 1.0f;
    __device__ __forceinline__ void operator()(const f32x4 (&acc)[2][2][4][2], const Unit& u, int wr, int wc, int fr, int fq) const {
        const int row0 = u.pm * BM + wr * 64 + fr, col0 = u.pn * BM + wc * 32 + 8 * fq;
        bf16_t* base = O + (long)u.pb * bstride;
        const float sc = ((u.pn * BM < scols) ? scale0 : 1.0f) * oscale;
#pragma unroll
        for (int ai = 0; ai < 2; ++ai)
#pragma unroll
            for (int m = 0; m < 4; ++m) { bf16_t* rowp = base + (long)(row0 + ai * HALF + m * 16) * ldc + col0;
#pragma unroll
                for (int bj = 0; bj < 2; ++bj) { const f32x4 v0 = acc[ai][bj][m][0] * sc, v1 = acc[ai][bj][m][1] * sc;
                    u32x4 w; w.x = cvtpk(v0[0], v0[1]); w.y = cvtpk(v0[2], v0[3]); w.z = cvtpk(v1[0], v1[1]); w.w = cvtpk(v1[2], v1[3]);
                    *(u32x4*)(rowp + bj * HALF) = w; } }
    }
};
struct EpiDft2 {
    static constexpr bool PERM = true;
    unsigned char* O;
    __device__ __forceinline__ void operator()(const f32x4 (&acc)[2][2][4][2], const Unit& u, int wr, int wc, int fr, int fq) const {
        const int row0 = u.pm * BM + wr * 64 + fr, cl0 = wc * 32 + 8 * fq;
        unsigned char* base = O + (long)u.pb * SEQ * DM + u.pn * BM;
        constexpr float osc = ACT8_SCALE / (YT_SCALE * CS_SCALE);
#pragma unroll
        for (int ai = 0; ai < 2; ++ai)
#pragma unroll
            for (int m = 0; m < 4; ++m) { const int np = row0 + ai * HALF + m * 16;
                unsigned char* rowp = base + (long)np * DM; unsigned char* mirp = base + (long)(SEQ - np) * DM;
#pragma unroll
                for (int bj = 0; bj < 2; ++bj) { const f32x4 v0 = acc[ai][bj][m][0] * osc, v1 = acc[ai][bj][m][1] * osc; const int cl = cl0 + bj * HALF;
                    u32x2 w; w.x = fp8_pack4(v0[0], v0[1], v0[2], v0[3]); w.y = fp8_pack4(v1[0], v1[1], v1[2], v1[3]);
                    *(u32x2*)(rowp + cl) = w;
                    if (np != 0) {
#pragma unroll
                        for (int i = 0; i < 8; ++i) mirp[(256 - cl - i) & 255] = (unsigned char)((w[i >> 2] >> (8 * (i & 3))) & 0xffu); } }
                asm volatile("" ::: "memory"); }
    }
};
struct EpiYt {
    static constexpr bool PERM = true;
    unsigned char* Yt;
    __device__ __forceinline__ void operator()(const f32x4 (&acc)[2][2][4][2], const Unit& u, int wr, int wc, int fr, int fq) const {
        const int row0 = u.pm * BM + wr * 64 + fr, col0 = u.pn * BM + wc * 32 + 8 * fq;
#pragma unroll
        for (int ai = 0; ai < 2; ++ai)
#pragma unroll
            for (int m = 0; m < 4; ++m) { const int row = row0 + ai * HALF + m * 16; const int part = row >> 8, cp = row & 255;
#pragma unroll
                for (int bj = 0; bj < 2; ++bj) { const int col = col0 + bj * HALF; const int b = col >> 12, n = col & 4095;
                    const f32x4 v0 = acc[ai][bj][m][0] * YT_SCALE, v1 = acc[ai][bj][m][1] * YT_SCALE;
                    u32x2 w; w.x = fp8_pack4(v0[0], v0[1], v0[2], v0[3]); w.y = fp8_pack4(v1[0], v1[1], v1[2], v1[3]);
                    *(u32x2*)(Yt + ((((long)(b * 4 + u.pb) * 256 + cp) * 2 + part) << 12) + n) = w; }
                asm volatile("" ::: "memory"); }
    }
};
struct EpiResid {
    static constexpr bool PERM = false;
    const float* Xin; float* Xout; const float* gate; int gstride; float gs;
    __device__ __forceinline__ void operator()(const f32x4 (&acc)[2][2][4][2], const Unit& u, int wr, int wc, int fr, int fq) const {
        const int row0 = u.pm * BM + wr * 64 + fr, col0 = u.pn * BM + wc * 32 + 4 * fq;
        const float* gb = gate + (long)((u.pm * BM) >> 12) * gstride;
        f32x4 gv[2][2];
#pragma unroll
        for (int bj = 0; bj < 2; ++bj)
#pragma unroll
            for (int n = 0; n < 2; ++n) gv[bj][n] = *(const f32x4*)(gb + col0 + bj * HALF + n * 16);
#pragma unroll
        for (int ai = 0; ai < 2; ++ai)
#pragma unroll
            for (int m = 0; m < 4; ++m) { const long off = (long)(row0 + ai * HALF + m * 16) * DM + col0;
#pragma unroll
                for (int bj = 0; bj < 2; ++bj)
#pragma unroll
                    for (int n = 0; n < 2; ++n) { const f32x4 bs = *(const f32x4*)(Xin + off + bj * HALF + n * 16);
                        *(f32x4*)(Xout + off + bj * HALF + n * 16) = bs + gv[bj][n] * acc[ai][bj][m][n] * gs; }
                if (m & 1) asm volatile("" ::: "memory"); }
    }
};

template <class SH, class Epi, bool FP8 = false>
__device__ __forceinline__ void gemm_phase(LAS unsigned char* lds, const Gemm g, int G_, int c_, const Epi& E) {
    StaticOrder<SH> S; S.init(G_, c_);
    int tid_ = threadIdx.x; asm volatile("" : "+v"(tid_));
    const int tid = tid_, wid = __builtin_amdgcn_readfirstlane(tid >> 6), lane = tid & 63, wr = wid >> 2, wc = wid & 3, fr = lane & 15, fq = lane >> 4;
    constexpr int K = SH::K, nt = K / BK;
    unsigned voffA[2], voffB[2];
#pragma unroll
    for (int i = 0; i < 2; ++i) { int R, C; stage_rc(tid * 16 + i * 8192, R, C); const int Rb = Epi::PERM ? ((R & ~31) + perm32(R & 31)) : R;
        voffA[i] = (unsigned)(R * SH::lda + C) * 2u; voffB[i] = (unsigned)(Rb * SH::ldb + C) * 2u; }
    constexpr size_t kstep = (size_t)(BK * 2);
    constexpr size_t hstepA = (size_t)HALF * SH::lda * 2, hstepB = (size_t)HALF * SH::ldb * 2;
    constexpr size_t tstepA = 2 * hstepA, tstepB = 2 * hstepB;
    const unsigned ldsw = (unsigned)wid * 1024u;
    const int aoff = lds_byte(wr * 64 + fr, fq * 8), boff = lds_byte(wc * 32 + fr, fq * 8);
#define PG8_SA(b, h) (((b) * 2 + (h)) * HTB)
#define PG8_SB(b, h) ((4 + (b) * 2 + (h)) * HTB)
#define PG8_STAGE(bufoff, gbase, voff) do { _Pragma("unroll") for (int _i = 0; _i < 2; ++_i) \
        __builtin_amdgcn_global_load_lds((const unsigned*)((const char*)(gbase) + (voff)[_i]), (LAS unsigned*)(lds + (bufoff) + ldsw + _i * 8192), 16, 0, 0); } while (0)
#define PG8_LDA(dst, b, h) do { _Pragma("unroll") for (int m = 0; m < 4; ++m) { const u32x4 f0_ = *(const LAS u32x4*)(lds + PG8_SA(b, h) + aoff + m * 2048), f1_ = *(const LAS u32x4*)(lds + PG8_SA(b, h) + aoff + m * 2048 + 1024); dst[m] = __builtin_shufflevector(f0_, f1_, 0, 1, 2, 3, 4, 5, 6, 7); } } while (0)
#define PG8_LDB(dst, b, h) do { _Pragma("unroll") for (int n = 0; n < 2; ++n) { const u32x4 f0_ = *(const LAS u32x4*)(lds + PG8_SB(b, h) + boff + n * 2048), f1_ = *(const LAS u32x4*)(lds + PG8_SB(b, h) + boff + n * 2048 + 1024); dst[n] = __builtin_shufflevector(f0_, f1_, 0, 1, 2, 3, 4, 5, 6, 7); } } while (0)
typedef int v8i_t __attribute__((ext_vector_type(8)));
typedef unsigned u32x8 __attribute__((ext_vector_type(8)));
#define PG8_LOH(x) __builtin_bit_cast(bf16x8, __builtin_shufflevector(x, x, 0, 1, 2, 3))
#define PG8_HIH(x) __builtin_bit_cast(bf16x8, __builtin_shufflevector(x, x, 4, 5, 6, 7))
#define PG8_MMA(ai, bj, At, Bt) do { __builtin_amdgcn_s_setprio(1); _Pragma("unroll") for (int m = 0; m < 4; ++m) _Pragma("unroll") for (int n = 0; n < 2; ++n) { \
        if constexpr (FP8) asm volatile("v_mfma_scale_f32_16x16x128_f8f6f4 %0, %1, %2, %0, %3, %3 op_sel_hi:[0,0,0]" : "+v"(acc[ai][bj][m][n]) : "v"(Bt[n]), "v"(At[m]), "v"(fp8_one));   \
        else { acc[ai][bj][m][n] = __builtin_amdgcn_mfma_f32_16x16x32_bf16(PG8_LOH(Bt[n]), PG8_LOH(At[m]), acc[ai][bj][m][n], 0, 0, 0); \
               acc[ai][bj][m][n] = __builtin_amdgcn_mfma_f32_16x16x32_bf16(PG8_HIH(Bt[n]), PG8_HIH(At[m]), acc[ai][bj][m][n], 0, 0, 0); } } \
        __builtin_amdgcn_s_setprio(0); } while (0)
#define PG8_WAIT_V(n) asm volatile("s_waitcnt vmcnt(" #n ")" ::: "memory")
#define PG8_WAIT_L(n) asm volatile("s_waitcnt lgkmcnt(" #n ")" ::: "memory")
#define PG8_BAR __builtin_amdgcn_s_barrier()
#define PG8_SCHED __builtin_amdgcn_sched_barrier(0)
    Unit cur, nxt; int ui = 0;
    if (!S.next(0, cur)) return;
    f32x4 acc[2][2][4][2];
#pragma unroll
    for (int a = 0; a < 2; ++a)
#pragma unroll
        for (int b = 0; b < 2; ++b)
#pragma unroll
            for (int m = 0; m < 4; ++m)
#pragma unroll
                for (int n = 0; n < 2; ++n) acc[a][b][m][n] = (f32x4){0.f, 0.f, 0.f, 0.f};
    unsigned fp8_one = 0x7f7f7f7fu; asm volatile("" : "+v"(fp8_one));
    u32x8 At[4], B0[2], B1[2];
    const char* cA = (const char*)(g.A + (long)cur.pb * SH::bsA) + (size_t)cur.pm * tstepA; const char* cB = (const char*)(g.Bt + (long)cur.pb * SH::bsB) + (size_t)cur.pn * tstepB;
    PG8_STAGE(PG8_SB(0, 0), cB, voffB); PG8_STAGE(PG8_SB(0, 1), cB + hstepB, voffB); PG8_STAGE(PG8_SA(0, 0), cA, voffA); PG8_STAGE(PG8_SA(0, 1), cA + hstepA, voffA);
    if (wr == 1) PG8_BAR;
    PG8_WAIT_V(2); PG8_BAR;
    PG8_STAGE(PG8_SB(1, 0), cB + kstep, voffB); PG8_STAGE(PG8_SA(1, 0), cA + kstep, voffA); PG8_STAGE(PG8_SB(1, 1), cB + hstepB + kstep, voffB);
    PG8_WAIT_V(6); PG8_BAR;
    for (;;) {
        const bool has_next = S.next(ui + 1, nxt);
        const char* nA = has_next ? (const char*)(g.A + (long)nxt.pb * SH::bsA) + (size_t)nxt.pm * tstepA : cA; const char* nB = has_next ? (const char*)(g.Bt + (long)nxt.pb * SH::bsB) + (size_t)nxt.pn * tstepB : cB;
#pragma nounroll
        for (int t = 0; t < nt; t += 2) {
            const bool last = (t == nt - 2);
            const char* a1 = cA + (size_t)(t + 1) * kstep;
            const char* a2 = last ? nA : cA + (size_t)(t + 2) * kstep; const char* b2 = last ? nB : cB + (size_t)(t + 2) * kstep;
            const char* a3 = a2 + kstep; const char* b3 = b2 + kstep;
            PG8_LDB(B0, 0, 0); PG8_LDB(B1, 0, 1); PG8_SCHED; PG8_LDA(At, 0, 0); PG8_STAGE(PG8_SA(1, 1), a1 + hstepA, voffA);
            PG8_WAIT_V(8); PG8_WAIT_L(0); PG8_BAR; PG8_MMA(0, 0, At, B0); PG8_MMA(0, 1, At, B1); PG8_BAR; PG8_SCHED;
            PG8_LDA(At, 0, 1); PG8_STAGE(PG8_SB(0, 0), b2, voffB); PG8_STAGE(PG8_SB(0, 1), b2 + hstepB, voffB); PG8_STAGE(PG8_SA(0, 0), a2, voffA);
            PG8_WAIT_V(8); PG8_WAIT_L(0); PG8_BAR; PG8_MMA(1, 0, At, B0); PG8_MMA(1, 1, At, B1); PG8_BAR; PG8_SCHED;
            PG8_LDB(B0, 1, 0); PG8_LDB(B1, 1, 1); PG8_SCHED; PG8_LDA(At, 1, 0); PG8_STAGE(PG8_SA(0, 1), a2 + hstepA, voffA);
            PG8_WAIT_V(8); PG8_WAIT_L(0); PG8_BAR; PG8_MMA(0, 0, At, B0); PG8_MMA(0, 1, At, B1); PG8_BAR; PG8_SCHED;
            PG8_LDA(At, 1, 1); PG8_STAGE(PG8_SB(1, 0), b3, voffB); PG8_STAGE(PG8_SB(1, 1), b3 + hstepB, voffB); PG8_STAGE(PG8_SA(1, 0), a3, voffA);
            PG8_WAIT_V(8); PG8_WAIT_L(0); PG8_BAR; PG8_MMA(1, 0, At, B0); PG8_MMA(1, 1, At, B1); PG8_BAR; PG8_SCHED;
        }
        if (wr == 0) PG8_BAR;
        if constexpr (FP8) asm volatile("s_nop 15\n\ts_nop 15\n\ts_nop 7" ::: "memory");
        E(acc, cur, wr, wc, fr, fq);
        if (!has_next) break;
#pragma unroll
        for (int a = 0; a < 2; ++a)
#pragma unroll
            for (int b = 0; b < 2; ++b)
#pragma unroll
                for (int m = 0; m < 4; ++m)
#pragma unroll
                    for (int n = 0; n < 2; ++n) acc[a][b][m][n] = (f32x4){0.f, 0.f, 0.f, 0.f};
        cur = nxt; cA = nA; cB = nB; ++ui;
        if (wr == 1) PG8_BAR;
    }
    PG8_WAIT_V(0);
    PG8_BAR;
#undef PG8_SA
#undef PG8_SB
#undef PG8_STAGE
#undef PG8_LDA
#undef PG8_LDB
#undef PG8_MMA
#undef PG8_WAIT_V
#undef PG8_WAIT_L
#undef PG8_BAR
#undef PG8_SCHED
}
}

#define XB_TMO      128
#define XB_XCNT(j)  (256  + 64 * (j))
#define XB_XSUB(j)  (1280 + 64 * (j))
#define XB_XGEN(j)  (2304 + 64 * (j))
#define XB_TOP      3328
#define XB_TOPGEN   3392
#define XCD_BAR_WORDS 3456
#define XB_SPIN_CAP (1u << 18)
__device__ __forceinline__ unsigned xb_ld(unsigned* p)              { return __hip_atomic_load(p, __ATOMIC_RELAXED, __HIP_MEMORY_SCOPE_AGENT); }
__device__ __forceinline__ unsigned xb_add(unsigned* p, unsigned v) { return __hip_atomic_fetch_add(p, v, __ATOMIC_RELAXED, __HIP_MEMORY_SCOPE_AGENT); }
__device__ __forceinline__ unsigned xb_xcc_id() { return (unsigned)__builtin_amdgcn_s_getreg((3 << 11) | 20) & 0xFu; }
#define XB_SPIN(cond, bar) do { unsigned _sp = 0; while (cond) { __builtin_amdgcn_s_sleep(1); \
    if ((++_sp & 255u) == 0u) { if (xb_ld(&(bar)[XB_TMO])) break; if (_sp > XB_SPIN_CAP) { atomicAdd(&(bar)[XB_TMO], 1u); break; } } } } while (0)
struct XcdBarrier { unsigned* bar; unsigned x; volatile LAS unsigned* st; };
__device__ __forceinline__ XcdBarrier xcd_barrier_post(unsigned* bar, volatile LAS unsigned* st) {
    XcdBarrier b; b.bar = bar; b.x = xb_xcc_id(); b.st = st;
    if (threadIdx.x == 0) (void)xb_add(&bar[XB_XCNT(b.x)], 1u);
    return b;
}
__device__ __forceinline__ void xcd_barrier_complete(unsigned* bar, unsigned x, unsigned& nloc, unsigned& nx) {
    const unsigned G = gridDim.x * gridDim.y * gridDim.z;
    unsigned sum, cnt, mine, sp = 0u;
    for (;;) {
        sum = 0u; cnt = 0u; mine = 0u;
#pragma unroll
        for (unsigned j = 0; j < 16; ++j) { const unsigned c = xb_ld(&bar[XB_XCNT(j)]); sum += c; cnt += (c > 0u) ? 1u : 0u; mine = (j == x) ? c : mine; }
        if (sum == G) break;
        __builtin_amdgcn_s_sleep(1);
        if ((++sp & 255u) == 0u) { if (xb_ld(&bar[XB_TMO])) break; if (sp > XB_SPIN_CAP) { atomicAdd(&bar[XB_TMO], 1u); break; } }
    }
    nloc = mine > 0u ? mine : 1u; nx = cnt > 0u ? cnt : 1u;
}
__device__ __forceinline__ void xcd_barrier(const XcdBarrier& b) {
    asm volatile("s_waitcnt vmcnt(0)" ::: "memory");
    __syncthreads();
    if (threadIdx.x == 0) {
        unsigned* bar = b.bar;
        __builtin_amdgcn_s_waitcnt(0);
        unsigned nloc = b.st[0], nx = b.st[1];
        if (nloc == 0u) { xcd_barrier_complete(bar, b.x, nloc, nx); b.st[0] = nloc; b.st[1] = nx; }
        const unsigned old = xb_add(&bar[XB_XSUB(b.x)], 1u);
        const unsigned gen = old / nloc;
        if (old + 1u == (gen + 1u) * nloc) {
            __builtin_amdgcn_fence(__ATOMIC_RELEASE, "agent");
            asm volatile("s_waitcnt vmcnt(0)" ::: "memory");
            const unsigned og = xb_add(&bar[XB_TOP], 1u);
            const unsigned tg = og / nx;
            if (og + 1u == (tg + 1u) * nx) xb_add(&bar[XB_TOPGEN], 1u);
            else XB_SPIN(xb_ld(&bar[XB_TOPGEN]) == tg, bar);
            __builtin_amdgcn_fence(__ATOMIC_ACQUIRE, "agent");
            xb_add(&bar[XB_XGEN(b.x)], 1u);
            asm volatile("s_waitcnt vmcnt(0)" ::: "memory");
        } else {
            XB_SPIN(xb_ld(&bar[XB_XGEN(b.x)]) == gen, bar);
            __builtin_amdgcn_fence(__ATOMIC_ACQUIRE, "agent");
            asm volatile("s_waitcnt vmcnt(0)" ::: "memory");
        }
    }
    __syncthreads();
}

constexpr int RING_BYTES = 131072;
constexpr int LDSCTL_OFF = RING_BYTES, MISC_OFF = LDSCTL_OFF + 320;
constexpr int LDS_BYTES = 147456;
constexpr int NWAVES = 8;

struct Args { const float* in[17]; float* out; unsigned char* ws; };

struct Ctx {
    LAS unsigned char* lds;
    int tid, lane, wave, vcu, G;
};

__device__ __forceinline__ Ctx fresh(const Ctx& F) {
    Ctx C = F; int t = threadIdx.x; asm volatile("" : "+v"(t)); C.tid = t; C.lane = t & 63; return C;
}
__device__ __forceinline__ void p0_transpose_item(const float* W, int K, int N, bf16_t* WT, LAS float* scr, int item, int lane) {
    const int nblk = N / 32, kb = item / nblk, nb = item % nblk, k0 = 64 * kb, n0 = 32 * nb;
#pragma unroll 8
    for (int i = 0; i < 32; ++i) { const int kk = 2 * i + (lane >> 5); scr[kk * 33 + (lane & 31)] = W[(size_t)(k0 + kk) * N + n0 + (lane & 31)]; }
    asm volatile("s_waitcnt lgkmcnt(0)" ::: "memory");
    const int c = lane & 7;
#pragma unroll
    for (int j = 0; j < 4; ++j) { const int n = (lane >> 3) + 8 * j; const LAS float* s = scr + (8 * c) * 33 + n;
        u32x4 o; o.x = pk2(s[0 * 33], s[1 * 33]); o.y = pk2(s[2 * 33], s[3 * 33]); o.z = pk2(s[4 * 33], s[5 * 33]); o.w = pk2(s[6 * 33], s[7 * 33]);
        *(u32x4*)(WT + (size_t)(n0 + n) * K + k0 + 8 * c) = o; }
    asm volatile("s_waitcnt lgkmcnt(0)" ::: "memory");
}
__device__ __forceinline__ void p0_transpose_item8(const float* W, int K, int N, unsigned char* WT, LAS float* scr, int item, int lane) {
    const int nblk = N / 32, kb = item / nblk, nb = item % nblk, k0 = 64 * kb, n0 = 32 * nb;
#pragma unroll 8
    for (int i = 0; i < 32; ++i) { const int kk = 2 * i + (lane >> 5); scr[kk * 33 + (lane & 31)] = W[(size_t)(k0 + kk) * N + n0 + (lane & 31)]; }
    asm volatile("s_waitcnt lgkmcnt(0)" ::: "memory");
    const int c = lane & 7;
#pragma unroll
    for (int j = 0; j < 4; ++j) { const int n = (lane >> 3) + 8 * j; const LAS float* s = scr + (8 * c) * 33 + n; constexpr float sc = pg8::W8_SCALE;
        u32x2 o; o.x = fp8_pack4(s[0 * 33] * sc, s[1 * 33] * sc, s[2 * 33] * sc, s[3 * 33] * sc); o.y = fp8_pack4(s[4 * 33] * sc, s[5 * 33] * sc, s[6 * 33] * sc, s[7 * 33] * sc);
        *(u32x2*)(WT + (size_t)(n0 + n) * K + k0 + 8 * c) = o; }
    asm volatile("s_waitcnt lgkmcnt(0)" ::: "memory");
}
__device__ __forceinline__ void cvt8(const float* src, bf16_t* dst) {
    const f32x4 a = *(const f32x4*)src, b = *(const f32x4*)(src + 4);
    u32x4 o; o.x = pk2(a[0], a[1]); o.y = pk2(a[2], a[3]); o.z = pk2(b[0], b[1]); o.w = pk2(b[2], b[3]);
    *(u32x4*)dst = o;
}

__device__ __forceinline__ void p0_prologue(const Ctx& F0, const Args& a) {
    const Ctx F = fresh(F0);
    unsigned char* ws = a.ws;
    const int gw = F.vcu * NWAVES + F.wave, NGW = F.G * NWAVES;
    const long gt = (long)F.vcu * 512 + F.tid, NGT = (long)F.G * 512;
    {
        LAS float* red = (LAS float*)(F.lds);
        const float* c = a.in[1]; const float* cctx = a.in[3]; const float* wmod = a.in[6]; const float* bmod = a.in[7];
        float* modb = (float*)(ws + WS_MOD);
        for (int item = F.vcu; item < 96; item += F.G) {
            const int l = item / 48, nc = item % 48, n0 = nc * 128 + 2 * F.lane, kb = F.wave * 128;
            float sv[9][2];
#pragma unroll
            for (int r = 0; r < 9; ++r)
#pragma unroll
                for (int j = 0; j < 2; ++j) { const int k = kb + 64 * j + F.lane; const float v = (r < 8) ? c[r * DM + k] : cctx[k]; sv[r][j] = v / (1.0f + __expf(-v)); }
            float acc[9][2];
#pragma unroll
            for (int r = 0; r < 9; ++r) { acc[r][0] = 0.f; acc[r][1] = 0.f; }
            const float* wp = wmod + (size_t)l * DM * NMOD + (size_t)kb * NMOD + n0;
#pragma unroll
            for (int j = 0; j < 2; ++j)
#pragma unroll 8
                for (int kl = 0; kl < 64; ++kl) {
                    const f32x2 w = *(const f32x2*)(wp + (size_t)(64 * j + kl) * NMOD);
#pragma unroll
                    for (int r = 0; r < 9; ++r) { const float s = __builtin_bit_cast(float, __builtin_amdgcn_readlane(__builtin_bit_cast(int, sv[r][j]), kl)); acc[r][0] += s * w[0]; acc[r][1] += s * w[1]; }
                }
            __syncthreads();
#pragma unroll
            for (int r = 0; r < 9; ++r) { red[(F.wave * 9 + r) * 128 + 2 * F.lane] = acc[r][0]; red[(F.wave * 9 + r) * 128 + 2 * F.lane + 1] = acc[r][1]; }
            __syncthreads();
            for (int o = F.tid; o < 9 * 128; o += 512) { const int r = o >> 7, nl = o & 127; float s = 0.f;
#pragma unroll
                for (int w = 0; w < 8; ++w) s += red[(w * 9 + r) * 128 + nl];
                modb[(size_t)(l * 9 + r) * NMOD + nc * 128 + nl] = s + bmod[l * NMOD + nc * 128 + nl]; }
        }
        __syncthreads();
    }
    {
        LAS float* scr = (LAS float*)(F.lds + F.wave * 16384);
        constexpr int I_QKV = (DM / 64) * (3 * DM / 32), I_O = (DM / 64) * (DM / 32), I_PQ = (DM / 64) * (2 * DM / 32);
        constexpr int NITEMS = I_QKV + 2 * I_O + 2 * I_PQ;
        for (int it = gw; it < NITEMS; it += NGW) {
            int r = it;
            if (r < I_QKV) { p0_transpose_item8(a.in[8], DM, 3 * DM, ws + WS_WQKV, scr, r, F.lane); continue; } r -= I_QKV;
            if (r < I_O) { p0_transpose_item8(a.in[9], DM, DM, ws + WS_WO, scr, r, F.lane); continue; } r -= I_O;
            if (r < I_O) { p0_transpose_item8(a.in[11], DM, DM, ws + WS_WF, scr, r, F.lane); continue; } r -= I_O;
            if (r < I_PQ) { p0_transpose_item(a.in[12], DM, 2 * DM, (bf16_t*)(ws + WS_WPQ), scr, r, F.lane); continue; } r -= I_PQ;
            p0_transpose_item(a.in[12] + (size_t)DM * 2 * DM, DM, 2 * DM, (bf16_t*)(ws + WS_WPQ) + (size_t)2 * DM * DM, scr, r, F.lane);
        }
    }
    for (long i = gt; i < 2 * 2 * 128 * 128 / 8; i += NGT) cvt8(a.in[13] + i * 8, (bf16_t*)(ws + WS_SK) + i * 8);
    {
        bf16_t* wc = (bf16_t*)(ws + WS_WC);
        for (long i = gt; i < 512 * 256 / 8; i += NGT) { const int nn = (int)(i >> 5), k0 = (int)(i & 31) * 8; float v[8];
#pragma unroll
            for (int j = 0; j < 8; ++j) { const int m = ((k0 + j) * (nn & 255)) & 255; const float fr = (float)m * (1.0f / 256.0f);
                v[j] = (nn < 256 ? __builtin_amdgcn_cosf(fr) : __builtin_amdgcn_sinf(fr)) * (1.0f / 16.0f); }
            u32x4 o; o.x = pk2(v[0], v[1]); o.y = pk2(v[2], v[3]); o.z = pk2(v[4], v[5]); o.w = pk2(v[6], v[7]);
            *(u32x4*)(wc + i * 8) = o; }
        unsigned char* cs = ws + WS_CS;
        for (long i = gt; i < 2048L * 8192 / 8; i += NGT) { const int np = (int)(i >> 10), c0 = (int)(i & 1023) * 8; const int part = c0 >> 12; float v[8];
#pragma unroll
            for (int j = 0; j < 8; ++j) { const int n = (c0 + j) & 4095; const int m = (n * np) & 4095; const float fr = (float)m * (1.0f / 4096.0f);
                v[j] = (part == 0 ? __builtin_amdgcn_cosf(fr) : -__builtin_amdgcn_sinf(fr)) * (pg8::CS_SCALE / 64.0f); }
            u32x2 o; o.x = fp8_pack4(v[0], v[1], v[2], v[3]); o.y = fp8_pack4(v[4], v[5], v[6], v[7]);
            *(u32x2*)(cs + i * 8) = o; }
    }
}

__device__ __forceinline__ unsigned fp4_pack8(const float* v, float sc) {
    unsigned w = 0;
#define FP4C(i) fminf(fmaxf(v[i] * sc, -6.f), 6.f)
    w = __builtin_amdgcn_cvt_scalef32_pk_fp4_f32(w, FP4C(0), FP4C(1), 1.0f, 0);
    w = __builtin_amdgcn_cvt_scalef32_pk_fp4_f32(w, FP4C(2), FP4C(3), 1.0f, 1);
    w = __builtin_amdgcn_cvt_scalef32_pk_fp4_f32(w, FP4C(4), FP4C(5), 1.0f, 2);
    w = __builtin_amdgcn_cvt_scalef32_pk_fp4_f32(w, FP4C(6), FP4C(7), 1.0f, 3);
#undef FP4C
    return w;
}
#define FP4_DEC(w, bs) __builtin_amdgcn_cvt_scalef32_pk_f32_fp4((w), 1.0f, (bs))
__device__ __forceinline__ unsigned i8_pack4(f32x4 v, float sc) {
    const int a = (int)rintf(fminf(fmaxf(v[0] * sc, -127.f), 127.f)), b = (int)rintf(fminf(fmaxf(v[1] * sc, -127.f), 127.f));
    const int c = (int)rintf(fminf(fmaxf(v[2] * sc, -127.f), 127.f)), d = (int)rintf(fminf(fmaxf(v[3] * sc, -127.f), 127.f));
    return (unsigned)(a & 0xff) | ((unsigned)(b & 0xff) << 8) | ((unsigned)(c & 0xff) << 16) | ((unsigned)(d & 0xff) << 24);
}
__device__ __forceinline__ void table_convert(const Ctx& F0, const Args& a, int sh0, int nsh, int nshare) {
    const Ctx F = fresh(F0);
    constexpr long PER = (long)NEXP * DM / 16;
    constexpr long TOTAL = 4 * PER;
    unsigned char* t8 = a.ws + WS_TAB;
    const long per_share = (TOTAL + nshare - 1) / nshare;
    const long i0 = (long)sh0 * per_share, i1 = min((long)(sh0 + nsh) * per_share, TOTAL);
    for (long i = i0 + F.tid; i < i1; i += 512) {
        const int q = (int)(i / PER); const long r = i - (long)q * PER; const int l = q >> 1, tb = q & 1;
        const int e = (int)(r >> 6), c16 = (int)(r & 63);
        const float* src = (tb ? a.in[15] : a.in[14]) + ((size_t)l * NEXP + e) * DM + c16 * 16;
        if (tb) {
            u32x4 o;
#pragma unroll
            for (int d = 0; d < 4; ++d) { const f32x4 v = *(const f32x4*)(src + 4 * d); o[d] = i8_pack4(v, V_SCALE); }
            *(u32x4*)(t8 + (size_t)l * TAB_LAYER + TAB_VOFF + ((size_t)(c16 >> 3) * NEXP + e) * 128 + (c16 & 7) * 16) = o;
        } else {
            u32x2 o;
#pragma unroll
            for (int d = 0; d < 2; ++d) { unsigned w = 0;
#pragma unroll
                for (int jn = 0; jn < 8; ++jn) { const float x = src[8 * d + jn] * U_SCALE; const int q = (int)rintf(fminf(fmaxf(x, -8.f), 7.f)) + 8; w |= (unsigned)q << (4 * jn); }
                o[d] = w; }
            *(u32x2*)(t8 + (size_t)l * TAB_LAYER + ((size_t)(c16 >> 3) * NEXP + e) * 64 + (c16 & 7) * 8) = o;
        }
    }
}

__device__ __forceinline__ const float* norm_src(const Args& a, int mode, int m) { return (m < ML) ? ((mode == 0 ? a.in[0] : a.out) + (size_t)m * DM) : (a.in[2] + (size_t)(m - ML) * DM); }
__device__ __forceinline__ void norm_phase(const Ctx& F0, const Args& a, int mode, int layer, int off, const float* gw) {
    const Ctx F = fresh(F0);
    const int gwv = F.vcu * NWAVES + F.wave, NGW = F.G * NWAVES, lane = F.lane;
    const float* modb = (const float*)(a.ws + WS_MOD) + (size_t)layer * 9 * NMOD;
    bf16_t* hx = (bf16_t*)(a.ws + WS_HX);
    const int nrows = (mode == 0) ? MT : ML;
    f32x4 gv[4];
#pragma unroll
    for (int j = 0; j < 4; ++j) gv[j] = ((const f32x4*)gw)[lane + 64 * j];
    f32x4 v[4], vn[4];
    if (gwv < nrows) { const f32x4* xr = (const f32x4*)norm_src(a, mode, gwv) + lane;
#pragma unroll
        for (int j = 0; j < 4; ++j) vn[j] = xr[64 * j]; }
    for (int m = gwv; m < nrows; m += NGW) {
#pragma unroll
        for (int j = 0; j < 4; ++j) v[j] = vn[j];
        { const int mn = (m + NGW < nrows) ? m + NGW : m; const f32x4* xr = (const f32x4*)norm_src(a, mode, mn) + lane;
#pragma unroll
          for (int j = 0; j < 4; ++j) vn[j] = xr[64 * j]; }
        const float* mr = modb + (size_t)((m < ML) ? (m >> 12) : 8) * NMOD + off;
        f32x4 av[4], cv[4];
#pragma unroll
        for (int j = 0; j < 4; ++j) { av[j] = ((const f32x4*)mr)[lane + 64 * j]; cv[j] = ((const f32x4*)(mr + DM))[lane + 64 * j]; }
        float s = 0.f;
#pragma unroll
        for (int j = 0; j < 4; ++j) s += (v[j].x * v[j].x + v[j].y * v[j].y) + (v[j].z * v[j].z + v[j].w * v[j].w);
        const float rstd = 1.0f / sqrtf(wave_sum(s) * (1.0f / DM) + EPS);
        unsigned long long* o8 = (unsigned long long*)(hx + (size_t)m * DM) + lane;
        unsigned* o4 = (unsigned*)(a.ws + WS_HX + (size_t)m * DM) + lane;
#pragma unroll
        for (int j = 0; j < 4; ++j) { const f32x4 y = (v[j] * rstd * gv[j]) * (cv[j] + 1.0f) + av[j];
            if (mode == 0) { o4[64 * j] = fp8_pack4(y.x * pg8::ACT8_SCALE, y.y * pg8::ACT8_SCALE, y.z * pg8::ACT8_SCALE, y.w * pg8::ACT8_SCALE); continue; }
            o8[64 * j] = (unsigned long long)cvtpk(y.x, y.y) | ((unsigned long long)cvtpk(y.z, y.w) << 32);
            if (off == 3 * DM) *(unsigned*)(a.ws + WS_X8 + ((size_t)(2 * j + (lane >> 5)) * ML + m) * 128 + (4 * lane & 127)) = i8_pack4(y, XQ_SCALE); }
    }
}
__device__ __forceinline__ void final_norm_phase(const Ctx& F0, const Args& a) {
    const Ctx F = fresh(F0);
    const int gwv = F.vcu * NWAVES + F.wave, NGW = F.G * NWAVES;
    const float* gw = a.in[16];
    for (int m = gwv; m < ML; m += NGW) {
        f32x4* xr = (f32x4*)(a.out + (size_t)m * DM) + F.lane;
        f32x4 v[4]; float s = 0.f;
#pragma unroll
        for (int j = 0; j < 4; ++j) { v[j] = xr[64 * j]; s += (v[j].x * v[j].x + v[j].y * v[j].y) + (v[j].z * v[j].z + v[j].w * v[j].w); }
        const float rstd = 1.0f / sqrtf(wave_sum(s) * (1.0f / DM) + EPS);
#pragma unroll
        for (int j = 0; j < 4; ++j) xr[64 * j] = v[j] * rstd * ((const f32x4*)gw)[F.lane + 64 * j];
    }
}

constexpr int ATT_ROWB = 144, ATT_KTILEB = 128 * ATT_ROWB, ATT_VROWB = 272, ATT_VTILEB = 64 * ATT_VROWB, ATT_BIAS_B = 2048, ATT_K0 = ATT_BIAS_B, ATT_V0 = ATT_K0 + 2 * ATT_KTILEB;
constexpr float ATT_THR = 8.0f;
template <int NGH, bool LATENT>
__device__ __forceinline__ void attn_sub(const LAS unsigned char* Kt, const LAS unsigned char* Vt_, int ko, const LAS float* browA, const LAS float* browB, const int (&relidx)[8],
                                         const bf16x8 (&qf)[2], float& m_ref, float& l_run, f32x4 (&o)[4], int q16, int g4) {
    constexpr int NG = 2 * NGH;
    bf16x8 kf[2 * NG][2]; u32x2 vf[4][NG][2]; f32x4 sc[2 * NG];
#pragma unroll
    for (int gk = 0; gk < NG; ++gk)
#pragma unroll
        for (int b2 = 0; b2 < 2; ++b2)
#pragma unroll
            for (int ks = 0; ks < 2; ++ks) kf[2 * gk + b2][ks] = *(const LAS bf16x8*)(Kt + ((gk / NGH) * 64 + ko + 32 * (gk % NGH) + 16 * b2 + q16) * ATT_ROWB + 64 * ks + 16 * g4);
#pragma unroll
    for (int d = 0; d < 4; ++d)
#pragma unroll
        for (int gk = 0; gk < NG; ++gk) { const LAS unsigned char* vp = Vt_ + (16 * d + q16) * ATT_VROWB + 2 * ((gk / NGH) * 64 + ko + 32 * (gk % NGH) + 4 * g4);
            vf[d][gk][0] = *(const LAS u32x2*)vp; vf[d][gk][1] = *(const LAS u32x2*)(vp + 32); }
    if (LATENT) {
#pragma unroll
        for (int kk = 0; kk < 8; ++kk) { sc[kk >> 2][kk & 3] = browA[relidx[kk]] - m_ref; sc[2 + (kk >> 2)][kk & 3] = browB[relidx[kk]] - m_ref; }
    } else {
#pragma unroll
        for (int blk = 0; blk < 2 * NG; ++blk) sc[blk] = (f32x4){-m_ref, -m_ref, -m_ref, -m_ref};
    }
#pragma unroll
    for (int blk = 0; blk < 2 * NG; ++blk)
#pragma unroll
        for (int ks = 0; ks < 2; ++ks) sc[blk] = __builtin_amdgcn_mfma_f32_16x16x32_bf16(kf[blk][ks], qf[ks], sc[blk], 0, 0, 0);
    float mx = fmaxf(fmaxf(sc[0][0], sc[0][1]), fmaxf(sc[0][2], sc[0][3]));
#pragma unroll
    for (int blk = 1; blk < 2 * NG; ++blk) mx = fmaxf(mx, fmaxf(fmaxf(sc[blk][0], sc[blk][1]), fmaxf(sc[blk][2], sc[blk][3])));
    if (__builtin_amdgcn_ballot_w64(mx > ATT_THR) != 0ull) {
        mx = fmaxf(mx, __shfl_xor(mx, 16)); mx = fmaxf(mx, __shfl_xor(mx, 32));
        const float dl = mx > ATT_THR ? mx : 0.f;
        m_ref += dl;
        const float al = __builtin_amdgcn_exp2f(-dl);
        l_run *= al;
#pragma unroll
        for (int d = 0; d < 4; ++d) o[d] *= al;
#pragma unroll
        for (int blk = 0; blk < 2 * NG; ++blk) sc[blk] -= dl;
    }
    float ls0 = 0.f, ls1 = 0.f;
#pragma unroll
    for (int blk = 0; blk < 2 * NG; ++blk)
#pragma unroll
        for (int i = 0; i < 4; ++i) { const float e = __builtin_amdgcn_exp2f(sc[blk][i]); sc[blk][i] = e; if (blk & 1) ls1 += e; else ls0 += e; }
    l_run += ls0 + ls1;
    bf16x8 pf[NG];
#pragma unroll
    for (int gk = 0; gk < NG; ++gk) { u32x4 pw; pw.x = cvtpk(sc[2 * gk][0], sc[2 * gk][1]); pw.y = cvtpk(sc[2 * gk][2], sc[2 * gk][3]); pw.z = cvtpk(sc[2 * gk + 1][0], sc[2 * gk + 1][1]); pw.w = cvtpk(sc[2 * gk + 1][2], sc[2 * gk + 1][3]);
        pf[gk] = __builtin_bit_cast(bf16x8, pw); }
#pragma unroll
    for (int gk = 0; gk < NG; ++gk)
#pragma unroll
        for (int d = 0; d < 4; ++d) { u32x4 vw; vw.x = vf[d][gk][0].x; vw.y = vf[d][gk][0].y; vw.z = vf[d][gk][1].x; vw.w = vf[d][gk][1].y;
            o[d] = __builtin_amdgcn_mfma_f32_16x16x32_bf16(__builtin_bit_cast(bf16x8, vw), pf[gk], o[d], 0, 0, 0); }
}
__device__ __forceinline__ void attn_phase(const Ctx& F0, const Args& a) {
    const Ctx F = fresh(F0);
    const bf16_t* QK = (const bf16_t*)(a.ws + WS_QK);
    const bf16_t* VT = (const bf16_t*)(a.ws + WS_VT);
    unsigned char* AO = a.ws + WS_HX + 36 * MiB;
    const float* rpb = a.in[10];
    LAS float* bias = (LAS float*)F.lds;
    const int tid = F.tid, lane = F.lane, q16 = lane & 15, g4 = lane >> 4;
    const int rr = F.wave >> 2, jt = F.wave & 3;
    const int qc = 16 * jt + q16, cs = min(max(qc - 8, 0), 48), ksj = min(max(16 * jt - 8, 0), 32);
    int relidx[8];
#pragma unroll
    for (int k = 0; k < 8; ++k) { const int kc = ksj + 16 * (k >> 2) + 4 * g4 + (k & 3); relidx[k] = (kc >= cs && kc < cs + 16) ? (kc - qc + 15) : 31; }
    const int krow = tid >> 3, kch = tid & 7, vrow = tid >> 4, vch = tid & 15;
    const unsigned lds_k = (unsigned)(krow * ATT_ROWB + kch * 16), lds_v = (unsigned)(vrow * ATT_VROWB + vch * 16);
    const int nunits = NB * 16 * 32, upb = (nunits + F.G - 1) / F.G;
    int cur_bh = -1;
    for (int k = 0; k < upb; ++k) {
        const int id = F.vcu * upb + k; if (id >= nunits) break;
        const int p = id & 31, bh = id >> 5, b = bh >> 4, h = bh & 15;
        if (bh != cur_bh) {
            __syncthreads();
            for (int i = tid; i < 16 * 32; i += 512) { const int dr = i >> 5, dc = i & 31; bias[i] = (dc < 31 && dr < 15) ? rpb[(h * 15 + dr) * 31 + dc] * LOG2E : -1e30f; }
            cur_bh = bh;
        }
        const int r0 = 2 * p, rs0 = min(max(r0 - 4, 0), 56), rs1 = min(max(r0 + 1 - 4, 0), 56);
        const int nlat = rs1 + 8 - rs0, nlt = (nlat + 1) >> 1, nsteps = nlt + 2;
        const int r = r0 + rr, rs = rr ? rs1 : rs0;
        const long tokq = (long)b * SEQ + r * GW + qc;
        const bf16_t* kbase = QK + 1024 + h * 64 + kch * 8;
        const bf16_t* vbase = VT + (long)(h * 64 + vrow) * MT + (vch & 7) * 8;
#define ATT_TOKA(step) ((step) < nlt ? ((long)b * SEQ + (long)(rs0 + 2 * (step)) * GW) : ((long)ML + b * CTXL + ((step) - nlt) * 128))
#define ATT_TOKB(step) ((step) < nlt ? ((long)b * SEQ + (long)min(rs0 + 2 * (step) + 1, rs0 + nlat - 1) * GW) : ((long)ML + b * CTXL + ((step) - nlt) * 128 + 64))
        u32x4 kA[2], vA[2], kB[2], vB[2];
#define ATT_LOAD(step, kr_, vr_) do { const int st_ = (step) < nsteps ? (step) : nsteps - 1; const long ta_ = ATT_TOKA(st_), tb_ = ATT_TOKB(st_);     \
        kr_[0] = *(const u32x4*)(kbase + (ta_ + krow) * 2048); kr_[1] = *(const u32x4*)(kbase + (tb_ + krow) * 2048); \
        const long tv_ = (vch < 8) ? ta_ : tb_; vr_[0] = *(const u32x4*)(vbase + tv_); vr_[1] = *(const u32x4*)(vbase + (long)32 * MT + tv_); } while (0)
#define ATT_WRITE(buf, kr_, vr_) do { *(LAS u32x4*)(F.lds + ATT_K0 + (buf) * ATT_KTILEB + lds_k) = kr_[0]; *(LAS u32x4*)(F.lds + ATT_K0 + (buf) * ATT_KTILEB + 64 * ATT_ROWB + lds_k) = kr_[1]; \
        *(LAS u32x4*)(F.lds + ATT_V0 + (buf) * ATT_VTILEB + lds_v) = vr_[0]; *(LAS u32x4*)(F.lds + ATT_V0 + (buf) * ATT_VTILEB + 32 * ATT_VROWB + lds_v) = vr_[1]; } while (0)
        ATT_LOAD(0, kA, vA); ATT_LOAD(1, kB, vB);
        bf16x8 qf[2];
#pragma unroll
        for (int ks = 0; ks < 2; ++ks) qf[ks] = *(const bf16x8*)(QK + tokq * 2048 + h * 64 + 32 * ks + 8 * g4);
        float m_ref = 0.f, l_run = 0.f;
        f32x4 o[4];
#pragma unroll
        for (int d = 0; d < 4; ++d) o[d] = (f32x4){0.f, 0.f, 0.f, 0.f};
        __syncthreads();
        ATT_WRITE(0, kA, vA);
        asm volatile("" :: "v"(qf[0]), "v"(qf[1]));
        __syncthreads();
#define ATT_COMPUTE(step, cur) do { \
            const LAS unsigned char* Kt = F.lds + ATT_K0 + (cur) * ATT_KTILEB; \
            const LAS unsigned char* Vt_ = F.lds + ATT_V0 + (cur) * ATT_VTILEB; \
            if ((step) < nlt) { const int krA = rs0 + 2 * (step), krB = krA + 1; \
                const bool actA = krA >= rs && krA < rs + 8, actB = krB < rs0 + nlat && krB >= rs && krB < rs + 8; \
                if (actA || actB) attn_sub<1, true>(Kt, Vt_, ksj, bias + (actA ? (krA - r + 7) : 15) * 32, bias + (actB ? (krB - r + 7) : 15) * 32, relidx, qf, m_ref, l_run, o, q16, g4); \
            } else attn_sub<2, false>(Kt, Vt_, 0, bias, bias, relidx, qf, m_ref, l_run, o, q16, g4); \
        } while (0)
        for (int step = 0; step < nsteps; step += 2) {
            ATT_COMPUTE(step, 0);
            if (step + 1 < nsteps) ATT_WRITE(1, kB, vB);
            ATT_LOAD(step + 2, kA, vA);
            __syncthreads();
            if (step + 1 < nsteps) { ATT_COMPUTE(step + 1, 1); }
            if (step + 2 < nsteps) ATT_WRITE(0, kA, vA);
            ATT_LOAD(step + 3, kB, vB);
            __syncthreads();
        }
#undef ATT_LOAD
#undef ATT_WRITE
#undef ATT_COMPUTE
#undef ATT_TOKA
#undef ATT_TOKB
        l_run += __shfl_xor(l_run, 16); l_run += __shfl_xor(l_run, 32);
        const float linv = 1.0f / l_run;
        unsigned char* op = AO + tokq * DM + h * 64 + 4 * g4; const float ls = linv * pg8::ACT8_SCALE;
#pragma unroll
        for (int d = 0; d < 4; ++d) *(unsigned*)(op + 16 * d) = fp8_pack4(o[d][0] * ls, o[d][1] * ls, o[d][2] * ls, o[d][3] * ls);
    }
    __syncthreads();
}

__device__ __forceinline__ void ce_desc(float& a, float& b) { const float hi = fmaxf(a, b), lo = fminf(a, b); a = hi; b = lo; }
__device__ __forceinline__ void ce_dir(float& a, float& b, bool desc) { const float hi = fmaxf(a, b), lo = fminf(a, b); a = desc ? hi : lo; b = desc ? lo : hi; }
__device__ __forceinline__ void sort16_desc(float (&v)[16]) {
#pragma unroll
    for (int k = 2; k <= 16; k <<= 1)
#pragma unroll
        for (int j = k >> 1; j > 0; j >>= 1)
#pragma unroll
            for (int i = 0; i < 16; ++i) { const int l = i ^ j; if (l > i) ce_dir(v[i], v[l], (i & k) == 0); }
}
__device__ __forceinline__ void merge16_desc(float (&a)[16], const float (&b)[16]) {
#pragma unroll
    for (int i = 0; i < 16; ++i) a[i] = fmaxf(a[i], b[15 - i]);
#pragma unroll
    for (int j = 8; j > 0; j >>= 1)
#pragma unroll
        for (int i = 0; i < 16; ++i) { const int l = i ^ j; if (l > i) ce_desc(a[i], a[l]); }
}

struct CandTab { int i[64]; int j[64]; };
__host__ __device__ constexpr CandTab make_cand_tab() {
    CandTab t{}; int n = 0;
    for (int i = 0; i < 16; ++i) for (int j = 0; j < 16; ++j) if ((i + 1) * (j + 1) <= 16) { t.i[n] = i; t.j[n] = j; ++n; }
    for (; n < 64; ++n) { t.i[n] = -1; t.j[n] = -1; }
    return t;
}

__device__ __forceinline__ void peer_topk_phase(const Ctx& F0, const Args& a, int layer) {
    const Ctx F = fresh(F0);
    const bf16_t* QP = (const bf16_t*)(a.ws + WS_QK);
    const bf16_t* SK = (const bf16_t*)(a.ws + WS_SK) + (size_t)layer * 2 * 128 * 128;
    unsigned short* IDX = (unsigned short*)(a.ws + WS_IDX);
    float* GATE = (float*)(a.ws + WS_GATE);
    const int gwv = F.vcu * NWAVES + F.wave, NGW = F.G * NWAVES;
    const int lane = F.lane, t32 = lane & 31, hi = lane >> 5;
    __syncthreads();
    for (int c = F.tid; c < 4096; c += 512) *(LAS u32x4*)(F.lds + (c >> 4) * 272 + (c & 15) * 16) = *(const u32x4*)(SK + (size_t)c * 8);
    __syncthreads();
    for (int task = gwv; task < 1024 * 8; task += NGW) {
        const int tt = task >> 3, h = task & 7;
        const long tok = (long)tt * 32 + t32;
        float top[2][16];
#pragma unroll
        for (int p = 0; p < 2; ++p) {
            f32x16 acc[4];
#pragma unroll
            for (int eb = 0; eb < 4; ++eb)
#pragma unroll
                for (int i = 0; i < 16; ++i) acc[eb][i] = 0.f;
#pragma unroll
            for (int eb = 0; eb < 4; ++eb) asm volatile("" : "+v"(acc[eb]));
            const bf16_t* qp = QP + tok * 2048 + h * 256 + p * 128 + hi * 8;
            const LAS unsigned char* kp = F.lds + (p * 128 + t32) * 272 + hi * 16;
#pragma unroll
            for (int ks = 0; ks < 8; ++ks) {
                if ((ks & 1) == 0) asm volatile("" ::: "memory");
                const bf16x8 bq = *(const bf16x8*)(qp + ks * 16);
#pragma unroll
                for (int eb = 0; eb < 4; ++eb) { const bf16x8 ak = *(const LAS bf16x8*)(kp + eb * 32 * 272 + ks * 32); acc[eb] = __builtin_amdgcn_mfma_f32_32x32x16_bf16(ak, bq, acc[eb], 0, 0, 0); }
            }
            float cur[16];
#pragma unroll
            for (int eb = 0; eb < 4; ++eb) {
                float v[16];
#pragma unroll
                for (int i = 0; i < 16; ++i) { const unsigned e = 32 * eb + crow(i, hi); float x = acc[eb][i]; asm volatile("" : "+v"(x));
                    v[i] = __builtin_bit_cast(float, (__builtin_bit_cast(unsigned, x) & ~0x7Fu) | e); }
                sort16_desc(v);
                if (eb == 0) {
#pragma unroll
                    for (int i = 0; i < 16; ++i) cur[i] = v[i];
                } else merge16_desc(cur, v);
            }
            float oth[16];
#pragma unroll
            for (int i = 0; i < 16; ++i) oth[i] = __shfl_xor(cur[i], 32);
            merge16_desc(cur, oth);
#pragma unroll
            for (int i = 0; i < 16; ++i) top[p][i] = cur[i];
            __builtin_amdgcn_sched_barrier(0);
        }
        float best[16];
#pragma unroll
        for (int gI = 0; gI < 4; ++gI) {
            float v[16];
#pragma unroll
            for (int q = 0; q < 16; ++q) {
                constexpr CandTab CT = make_cand_tab();
                const int ci = CT.i[16 * gI + q], cj = CT.j[16 * gI + q];
                if (ci >= 0) {
                    const unsigned ua = __builtin_bit_cast(unsigned, top[0][ci]), ub = __builtin_bit_cast(unsigned, top[1][cj]);
                    float s = top[0][ci] + top[1][cj]; asm volatile("" : "+v"(s));
                    const unsigned code = ((ua & 0x7Fu) << 7) | (ub & 0x7Fu);
                    v[q] = __builtin_bit_cast(float, (__builtin_bit_cast(unsigned, s) & ~0x3FFFu) | code);
                } else v[q] = -3.0e38f;
            }
            sort16_desc(v);
            if (gI == 0) {
#pragma unroll
                for (int i = 0; i < 16; ++i) best[i] = v[i];
            } else merge16_desc(best, v);
            __builtin_amdgcn_sched_barrier(0);
        }
        float e[16], sum = 0.f;
#pragma unroll
        for (int i = 0; i < 16; ++i) { e[i] = __builtin_amdgcn_exp2f((best[i] - best[0]) * LOG2E); sum += e[i]; }
        const float inv = 1.0f / sum;
        if (hi == 0) {
            u32x4 w0, w1;
            w0.x = (__builtin_bit_cast(unsigned, best[0]) & 0x3FFFu) | ((__builtin_bit_cast(unsigned, best[1]) & 0x3FFFu) << 16);
            w0.y = (__builtin_bit_cast(unsigned, best[2]) & 0x3FFFu) | ((__builtin_bit_cast(unsigned, best[3]) & 0x3FFFu) << 16);
            w0.z = (__builtin_bit_cast(unsigned, best[4]) & 0x3FFFu) | ((__builtin_bit_cast(unsigned, best[5]) & 0x3FFFu) << 16);
            w0.w = (__builtin_bit_cast(unsigned, best[6]) & 0x3FFFu) | ((__builtin_bit_cast(unsigned, best[7]) & 0x3FFFu) << 16);
            w1.x = (__builtin_bit_cast(unsigned, best[8]) & 0x3FFFu) | ((__builtin_bit_cast(unsigned, best[9]) & 0x3FFFu) << 16);
            w1.y = (__builtin_bit_cast(unsigned, best[10]) & 0x3FFFu) | ((__builtin_bit_cast(unsigned, best[11]) & 0x3FFFu) << 16);
            w1.z = (__builtin_bit_cast(unsigned, best[12]) & 0x3FFFu) | ((__builtin_bit_cast(unsigned, best[13]) & 0x3FFFu) << 16);
            w1.w = (__builtin_bit_cast(unsigned, best[14]) & 0x3FFFu) | ((__builtin_bit_cast(unsigned, best[15]) & 0x3FFFu) << 16);
            u32x4* ip = (u32x4*)(IDX + tok * 128 + h * 16);
            ip[0] = w0; ip[1] = w1;
        } else {
            f32x4* gp = (f32x4*)(GATE + tok * 128 + h * 16);
#pragma unroll
            for (int q = 0; q < 4; ++q) gp[q] = (f32x4){e[4 * q] * inv, e[4 * q + 1] * inv, e[4 * q + 2] * inv, e[4 * q + 3] * inv};
        }
    }
    __syncthreads();
}

typedef long i64_t;
typedef _Float16 h2_t __attribute__((ext_vector_type(2)));
template <int CTRL> __device__ __forceinline__ float dpp_f(float v) { return __builtin_bit_cast(float, __builtin_amdgcn_update_dpp(0, __builtin_bit_cast(int, v), CTRL, 0xF, 0xF, true)); }
__device__ __forceinline__ void peer_u_phase(const Ctx& F0, const Args& a, int layer) {
    const Ctx F = fresh(F0);
    const int s = (int)(blockIdx.x & 7), j = (int)(blockIdx.x >> 3), nmem = F.G >> 3;
    const unsigned char* U8s = a.ws + WS_TAB + (size_t)layer * TAB_LAYER + (size_t)s * NEXP * 64;
    const unsigned char* X8s = a.ws + WS_X8 + (size_t)s * ML * 128;
    const unsigned short* IDX = (const unsigned short*)(a.ws + WS_IDX);
    unsigned* PART = (unsigned*)(a.ws + WS_PART) + (size_t)s * ML * 64;
    const int lane = F.lane, r16 = lane >> 2, c4 = lane & 3;
    const bool c1 = (lane & 2) != 0, c0 = (lane & 1) != 0;
    const int t0 = j * NWAVES + F.wave, stride = nmem * NWAVES, ntok = (ML - t0 + stride - 1) / stride;
#define U_TOK(i) ((size_t)(t0 + ((i) < ntok ? (i) : ntok - 1) * stride))
#define U_EID(iv, k) (((k) & 1) ? (iv[(k) >> 1] >> 16) : (iv[(k) >> 1] & 0xffffu))
#define U_LDI(dst, i) do { dst = *(const u32x4*)(IDX + U_TOK(i) * 128 + 8 * r16); } while (0)
#define U_LDX(dst, i) do { const unsigned char* xp_ = X8s + U_TOK(i) * 128 + 32 * c4; dst[0] = *(const u32x4*)xp_; dst[1] = *(const u32x4*)(xp_ + 16); } while (0)
#define U_LDR(Rset, iv) do { _Pragma("unroll") for (int k = 0; k < 8; ++k) Rset[k] = *(const u32x4*)(U8s + (unsigned)(U_EID(iv, k) * 64 + 16 * c4)); } while (0)
#define U_TOKEN(Rset, iref, xv, i) do { \
        unsigned xlo[4], xhi[4]; int sx = 0; \
        _Pragma("unroll") for (int d = 0; d < 4; ++d) { const unsigned n0 = (d < 2) ? xv[0][2 * d] : xv[1][2 * d - 4], n1 = (d < 2) ? xv[0][2 * d + 1] : xv[1][2 * d - 3]; \
            xlo[d] = __builtin_amdgcn_perm(n1, n0, 0x06040200u); xhi[d] = __builtin_amdgcn_perm(n1, n0, 0x07050301u); \
            sx = __builtin_amdgcn_sdot4((int)n0, 0x01010101, sx, false); sx = __builtin_amdgcn_sdot4((int)n1, 0x01010101, sx, false); } \
        float v[8]; \
        _Pragma("unroll") for (int k = 0; k < 8; ++k) { \
            u32x4 r_ = Rset[k]; asm volatile("" : "+v"(r_)); \
            int acc_ = 0; \
            _Pragma("unroll") for (int d = 0; d < 4; ++d) { acc_ = __builtin_amdgcn_sdot4((int)(r_[d] & 0x0F0F0F0Fu), (int)xlo[d], acc_, false); acc_ = __builtin_amdgcn_sdot4((int)((r_[d] >> 4) & 0x0F0F0F0Fu), (int)xhi[d], acc_, false); } \
            v[k] = (float)(acc_ - 8 * sx); \
            asm volatile("" : "+v"(v[k])); \
            Rset[k] = *(const u32x4*)(U8s + (unsigned)(U_EID(iref, k) * 64 + 16 * c4)); \
        } \
        float a4[4], a2[2]; \
        _Pragma("unroll") for (int k = 0; k < 4; ++k) { const float keep = c1 ? v[k + 4] : v[k], send = c1 ? v[k] : v[k + 4]; a4[k] = keep + dpp_f<0x4E>(send); } \
        _Pragma("unroll") for (int k = 0; k < 2; ++k) { const float keep = c0 ? a4[k + 2] : a4[k], send = c0 ? a4[k] : a4[k + 2]; a2[k] = keep + dpp_f<0xB1>(send); } \
        if ((i) < ntok) PART[U_TOK(i) * 64 + lane] = cvtpk(a2[0], a2[1]); \
    } while (0)
    u32x4 iA, iB, iC, iA2, iB2, iC2, RA[8], RB[8], RC[8], xA[2], xB[2], xC[2], xA2[2], xB2[2], xC2[2];
    U_LDI(iA, 0); U_LDI(iB, 1); U_LDI(iC, 2); U_LDX(xA, 0); U_LDX(xB, 1); U_LDX(xC, 2);
    U_LDR(RA, iA); U_LDR(RB, iB); U_LDR(RC, iC);
    U_LDI(iA, 3); U_LDI(iB, 4); U_LDI(iC, 5);
    asm volatile("" :: "v"(xA[0]), "v"(xA[1]), "v"(RA[0]), "v"(RA[1]), "v"(RA[2]), "v"(RA[3]), "v"(RA[4]), "v"(RA[5]), "v"(RA[6]), "v"(RA[7]));
    for (int i = 0; i < ntok; i += 3) {
        U_LDI(iA2, i + 6); U_LDI(iB2, i + 7); U_LDI(iC2, i + 8); U_LDX(xA2, i + 3); U_LDX(xB2, i + 4); U_LDX(xC2, i + 5);
        U_TOKEN(RA, iA, xA, i);
        U_TOKEN(RB, iB, xB, i + 1);
        U_TOKEN(RC, iC, xC, i + 2);
        iA = iA2; iB = iB2; iC = iC2; xA[0] = xA2[0]; xA[1] = xA2[1]; xB[0] = xB2[0]; xB[1] = xB2[1]; xC[0] = xC2[0]; xC[1] = xC2[1];
    }
#undef U_LDI
#undef U_LDX
#undef U_LDR
#undef U_TOKEN
#undef U_TOK
#undef U_EID
}
__device__ __forceinline__ void peer_w_phase(const Ctx& F0, const Args& a) {
    const Ctx F = fresh(F0);
    const unsigned* PART = (const unsigned*)(a.ws + WS_PART);
    const float* GATE = (const float*)(a.ws + WS_GATE);
    unsigned char* WQ = a.ws + WS_WT;
    float* WSC = (float*)(a.ws + WS_WSC);
    const int gwv = F.vcu * NWAVES + F.wave, NGW = F.G * NWAVES;
    for (int t = gwv; t < ML; t += NGW) {
        f32x2 z = (f32x2){0.f, 0.f};
#pragma unroll
        for (int s = 0; s < 8; ++s) { const unsigned pw = PART[((size_t)s * ML + t) * 64 + F.lane]; z += (f32x2){bflo(pw), bfhi(pw)}; }
        const f32x2 g = *(const f32x2*)(GATE + (size_t)t * 128 + 2 * F.lane);
        f32x2 w; w.x = g.x * gelu_erf(z.x * (1.0f / (U_SCALE * XQ_SCALE))); w.y = g.y * gelu_erf(z.y * (1.0f / (U_SCALE * XQ_SCALE)));
        float wm = fmaxf(__builtin_fabsf(w.x), __builtin_fabsf(w.y));
#pragma unroll
        for (int o = 1; o < 64; o <<= 1) wm = fmaxf(wm, __shfl_xor(wm, o));
        wm = fmaxf(wm, 1e-20f);
        const float qs = 127.0f / wm;
        const int qa = (int)rintf(w.x * qs), qb = (int)rintf(w.y * qs);
        ((unsigned short*)WQ)[(size_t)t * 64 + F.lane] = (unsigned short)((qa & 0xff) | ((qb & 0xff) << 8));
        if (F.lane == 0) WSC[t] = wm * (1.0f / 127.0f);
    }
}
__device__ __forceinline__ void peer_v_phase(const Ctx& F0, const Args& a, int layer, float oscale = 1.0f) {
    const Ctx F = fresh(F0);
    const int s = (int)(blockIdx.x & 7), j = (int)(blockIdx.x >> 3), nmem = F.G >> 3;
    const unsigned char* V8s = a.ws + WS_TAB + (size_t)layer * TAB_LAYER + TAB_VOFF + (size_t)s * NEXP * 128;
    const unsigned short* IDX = (const unsigned short*)(a.ws + WS_IDX);
    const unsigned char* WQ = a.ws + WS_WT;
    const float* WSC = (const float*)(a.ws + WS_WSC);
    const float* modb = (const float*)(a.ws + WS_MOD) + (size_t)layer * 9 * NMOD;
    float* X = a.out;
    const int lane = F.lane, rsub = lane >> 3, c16 = lane & 7;
    LAS float* red = (LAS float*)(F.lds + F.wave * 4096);
    const float dbg_s = ((DBG_SKIP & (layer == 0 ? 2 : 8)) ? 0.f : oscale) * (1.0f / V_SCALE);
    const int t0 = j * NWAVES + F.wave, stride = nmem * NWAVES, ntok = (ML - t0 + stride - 1) / stride;
#define V_TOK(i) ((size_t)(t0 + ((i) < ntok ? (i) : ntok - 1) * stride))
#define V_EID(iv, i_) (((i_) & 1) ? (iv[(i_) >> 3][((i_) & 7) >> 1] >> 16) : (iv[(i_) >> 3][((i_) & 7) >> 1] & 0xffffu))
    u32x4 iN[2], R[16], wq;
    { const size_t o_ = V_TOK(0) * 128 + 16 * rsub; iN[0] = *(const u32x4*)(IDX + o_); iN[1] = *(const u32x4*)(IDX + o_ + 8); wq = *(const u32x4*)(WQ + o_); }
#pragma unroll
    for (int i_ = 0; i_ < 16; ++i_) R[i_] = *(const u32x4*)(V8s + (unsigned)(V_EID(iN, i_) * 128 + 16 * c16));
    { const size_t o_ = V_TOK(1) * 128 + 16 * rsub; iN[0] = *(const u32x4*)(IDX + o_); iN[1] = *(const u32x4*)(IDX + o_ + 8); }
    for (int i = 0; i < ntok; ++i) {
        u32x4 iNN[2], wqN;
        { const size_t o_ = V_TOK(i + 2) * 128 + 16 * rsub; iNN[0] = *(const u32x4*)(IDX + o_); iNN[1] = *(const u32x4*)(IDX + o_ + 8); }
        wqN = *(const u32x4*)(WQ + V_TOK(i + 1) * 128 + 16 * rsub);
        const size_t t_ = V_TOK(i);
        f32x2* xo_ = (f32x2*)(X + t_ * DM + 128 * s + 2 * lane);
        const f32x2 xold = *xo_;
        const f32x2 gate2 = *(const f32x2*)(modb + (t_ >> 12) * NMOD + 5 * DM + 128 * s + 2 * lane);
        const float wsc = WSC[t_];
        int acc[16];
#pragma unroll
        for (int c = 0; c < 16; ++c) acc[c] = 0;
#pragma unroll
        for (int g = 0; g < 4; ++g) {
            u32x4 ra = R[4 * g], rb = R[4 * g + 1], rc = R[4 * g + 2], rd = R[4 * g + 3];
            asm volatile("" : "+v"(ra), "+v"(rb), "+v"(rc), "+v"(rd));
            const unsigned wpk = wq[g];
#pragma unroll
            for (int blk = 0; blk < 4; ++blk) {
                const unsigned ab_lo = __builtin_amdgcn_perm(ra[blk], rb[blk], 0x01050004u), ab_hi = __builtin_amdgcn_perm(ra[blk], rb[blk], 0x03070206u);
                const unsigned cd_lo = __builtin_amdgcn_perm(rc[blk], rd[blk], 0x01050004u), cd_hi = __builtin_amdgcn_perm(rc[blk], rd[blk], 0x03070206u);
                acc[4 * blk + 0] = __builtin_amdgcn_sdot4((int)__builtin_amdgcn_perm(ab_lo, cd_lo, 0x01000504u), (int)wpk, acc[4 * blk + 0], false);
                acc[4 * blk + 1] = __builtin_amdgcn_sdot4((int)__builtin_amdgcn_perm(ab_lo, cd_lo, 0x03020706u), (int)wpk, acc[4 * blk + 1], false);
                acc[4 * blk + 2] = __builtin_amdgcn_sdot4((int)__builtin_amdgcn_perm(ab_hi, cd_hi, 0x01000504u), (int)wpk, acc[4 * blk + 2], false);
                acc[4 * blk + 3] = __builtin_amdgcn_sdot4((int)__builtin_amdgcn_perm(ab_hi, cd_hi, 0x03020706u), (int)wpk, acc[4 * blk + 3], false);
            }
#pragma unroll
            for (int c = 0; c < 16; ++c) asm volatile("" : "+v"(acc[c]));
#pragma unroll
            for (int k = 0; k < 4; ++k) R[4 * g + k] = *(const u32x4*)(V8s + (unsigned)(V_EID(iN, 4 * g + k) * 128 + 16 * c16));
        }
#pragma unroll
        for (int q = 0; q < 4; ++q) *(LAS f32x4*)(red + rsub * 128 + c16 * 16 + 4 * q) = (f32x4){(float)acc[4 * q], (float)acc[4 * q + 1], (float)acc[4 * q + 2], (float)acc[4 * q + 3]};
        f32x2 sum = (f32x2){0.f, 0.f};
#pragma unroll
        for (int r = 0; r < 8; ++r) sum += *(const LAS f32x2*)(red + r * 128 + 2 * lane);
        *xo_ = xold + gate2 * (dbg_s * wsc) * sum;
        wq = wqN; iN[0] = iNN[0]; iN[1] = iNN[1];
    }
#undef V_TOK
#undef V_EID
}

__device__ __forceinline__ void dft_nyquist_rows(const Ctx& F0, const Args& a) {
    const Ctx F = fresh(F0);
    const unsigned char* Yt = a.ws + WS_QK;
    unsigned char* Fo = a.ws + WS_VT;
    const int gwv = F.vcu * NWAVES + F.wave, NGW = F.G * NWAVES;
    for (int o = gwv; o < NB * DM; o += NGW) {
        const unsigned char* src = Yt + (size_t)o * 8192;
        float s = 0.f;
#pragma unroll
        for (int it = 0; it < 4; ++it) { const u32x4 v = *(const u32x4*)(src + it * 1024 + F.lane * 16);
#pragma unroll
            for (int d = 0; d < 4; ++d) { const f32x2 lo = __builtin_amdgcn_cvt_pk_f32_fp8((int)v[d], false), hi = __builtin_amdgcn_cvt_pk_f32_fp8((int)v[d], true); s += (lo[0] - lo[1]) + (hi[0] - hi[1]); } }
        s = wave_sum(s) * (pg8::ACT8_SCALE / (64.0f * pg8::YT_SCALE));
        if (F.lane == 0) Fo[((size_t)(o >> 10) * SEQ + 2048) * DM + (o & 1023)] = (unsigned char)(fp8_pack4(s, 0.f, 0.f, 0.f) & 0xffu);
    }
}

__global__ void __launch_bounds__(NWAVES * 64, 2) fwd_kernel(Args args) {
    extern __shared__ __attribute__((aligned(16))) unsigned char lds_raw[];
    Ctx F;
    F.lds = (LAS unsigned char*)lds_raw;
    F.tid = threadIdx.x; F.lane = F.tid & 63; F.wave = __builtin_amdgcn_readfirstlane(F.tid >> 6);
    F.G = gridDim.x; { const int bx = blockIdx.x; F.vcu = (F.G % 8 == 0) ? (bx % 8) * (F.G / 8) + bx / 8 : bx; }
    volatile LAS unsigned* MISC = (volatile LAS unsigned*)(F.lds + MISC_OFF);
    for (int u = F.tid; u < (LDS_BYTES - LDSCTL_OFF) / 4; u += NWAVES * 64) ((LAS unsigned*)(F.lds + LDSCTL_OFF))[u] = 0u;
    __syncthreads();
    unsigned char* ws = args.ws;
    XcdBarrier bar = xcd_barrier_post((unsigned*)(ws + WS_CTL) + CW_BAR, MISC + 8);
#define GRID_BAR() xcd_barrier(bar)
#ifndef DBG_REP
#define DBG_REP 0
#endif
#define REP(k, ...) do { __VA_ARGS__; if (DBG_REP == (k)) { GRID_BAR(); __VA_ARGS__; } } while (0)
#define PEER_BLOCK(layer) do { \
        norm_phase(F, args, 1, layer, 3 * DM, args.in[5] + (layer) * DM); \
        GRID_BAR(); \
        { using SHq = pg8::Shape<ML, 2048, DM, DM, DM, 1, 0, 0>; \
          REP(7, pg8::gemm_phase<SHq>(F.lds, pg8::Gemm{HX, (const bf16_t*)(ws + WS_WPQ) + (size_t)(layer) * 2048 * DM}, F.G, bx, pg8::EpiStoreBf16{QKb, 2048, 0, 0, 1.0f})); } \
        GRID_BAR(); \
        REP(8, peer_topk_phase(F, args, layer)); \
        GRID_BAR(); \
        REP(9, peer_u_phase(F, args, layer)); \
        GRID_BAR(); \
        REP(10, peer_w_phase(F, args)); \
        GRID_BAR(); \
        peer_v_phase(F, args, layer); if (DBG_REP == 11) { GRID_BAR(); peer_v_phase(F, args, layer, 0.f); } \
        GRID_BAR(); \
    } while (0)
    const float* modb = (const float*)(ws + WS_MOD);
    bf16_t* HX = (bf16_t*)(ws + WS_HX);
    bf16_t* QKb = (bf16_t*)(ws + WS_QK);
    bf16_t* VTb = (bf16_t*)(ws + WS_VT);
    const bf16_t* Wqkv = (const bf16_t*)(ws + WS_WQKV);
    const int bx = (int)blockIdx.x;

    REP(1, p0_prologue(F, args));
    GRID_BAR();
    REP(2, norm_phase(F, args, 0, 0, 0, args.in[4]));
    GRID_BAR();
    {
        constexpr float o8 = 1.0f / (pg8::ACT8_SCALE * pg8::W8_SCALE);
        using SH1 = pg8::Shape<MT, 2048, DM / 2, DM / 2, DM / 2, 1, 0, 0>;
        pg8::gemm_phase<SH1, pg8::EpiStoreBf16, true>(F.lds, pg8::Gemm{HX, Wqkv}, F.G, bx, pg8::EpiStoreBf16{QKb, 2048, 0, 1024, 0.125f * LOG2E, o8});
        using SH2 = pg8::Shape<DM, MT, DM / 2, DM / 2, DM / 2, 1, 0, 0>;
        pg8::gemm_phase<SH2, pg8::EpiStoreBf16, true>(F.lds, pg8::Gemm{Wqkv + (size_t)2048 * DM / 2, HX}, F.G, bx, pg8::EpiStoreBf16{VTb, MT, 0, 0, 1.0f, o8});
        {
            const int nq = (MT / 256) * 8, nv = 4 * (MT / 256), rq = nq % F.G, rv = nv % F.G;
            const int sh_q = (rq == 0 || bx >= rq) ? 1 : 0, sh_v = (rv == 0 || bx >= rv) ? 1 : 0;
            const int before = (rq == 0 ? bx : max(0, bx - rq)) + (rv == 0 ? bx : max(0, bx - rv));
            const int total = (rq == 0 ? F.G : F.G - rq) + (rv == 0 ? F.G : F.G - rv);
            table_convert(F, args, before, sh_q + sh_v, total);
        }
    }
    GRID_BAR();
    REP(4, attn_phase(F, args));
    GRID_BAR();
    {
        using SH = pg8::Shape<ML, DM, DM / 2, DM / 2, DM / 2, 1, 0, 0>;
        pg8::gemm_phase<SH, pg8::EpiResid, true>(F.lds, pg8::Gemm{(const bf16_t*)(ws + WS_HX + 36 * MiB), (const bf16_t*)(ws + WS_WO)}, F.G, bx, pg8::EpiResid{args.in[0], args.out, modb + 2 * DM, NMOD, ((DBG_SKIP & 1) ? 0.f : 1.f) / (pg8::ACT8_SCALE * pg8::W8_SCALE)});
    }
    GRID_BAR();
    PEER_BLOCK(0);
    norm_phase(F, args, 1, 1, 0, args.in[4] + DM);
    GRID_BAR();
    {
        using SH = pg8::Shape<512, ML, 256, 256, DM, 4, 0, 256>;
        pg8::gemm_phase<SH>(F.lds, pg8::Gemm{(const bf16_t*)(ws + WS_WC), HX}, F.G, bx, pg8::EpiYt{(unsigned char*)QKb});
    }
    GRID_BAR();
    {
        using SH = pg8::Shape<SEQ / 2, DM, 4096, 4096, 4096, NB, 0, (long)DM * 4096>;
        REP(14, pg8::gemm_phase<SH, pg8::EpiDft2, true>(F.lds, pg8::Gemm{(const bf16_t*)(ws + WS_CS), QKb}, F.G, bx, pg8::EpiDft2{(unsigned char*)VTb}));
        dft_nyquist_rows(F, args);
    }
    GRID_BAR();
    {
        using SH = pg8::Shape<ML, DM, DM / 2, DM / 2, DM / 2, 1, 0, 0>;
        pg8::gemm_phase<SH, pg8::EpiResid, true>(F.lds, pg8::Gemm{VTb, (const bf16_t*)(ws + WS_WF)}, F.G, bx, pg8::EpiResid{args.out, args.out, modb + (size_t)9 * NMOD + 2 * DM, NMOD, ((DBG_SKIP & 4) ? 0.f : 1.f) / (pg8::ACT8_SCALE * pg8::W8_SCALE)});
    }
    GRID_BAR();
    PEER_BLOCK(1);
    final_norm_phase(F, args);
#undef PEER_BLOCK
}

extern "C" void kernel_launch(void* const* d_in, const int* in_sizes, int n_in, void* d_out, int out_size, void* d_ws, size_t ws_size, hipStream_t stream) {
    static int grid = 0;
    if (grid == 0) {
        if (n_in != 17 || in_sizes[0] != ML * DM || out_size != ML * DM || ws_size < WS_END) { fprintf(stderr, "kernel_launch: unexpected shapes (n_in %d, in0 %d, out %d, ws %zu)\n", n_in, n_in > 0 ? in_sizes[0] : -1, out_size, ws_size); grid = -1; return; }
        int dev = 0, cus = 0, per_cu = 0;
        if (hipGetDevice(&dev) != hipSuccess || hipDeviceGetAttribute(&cus, hipDeviceAttributeMultiprocessorCount, dev) != hipSuccess) { grid = -1; return; }
        if (hipFuncSetAttribute((const void*)fwd_kernel, hipFuncAttributeMaxDynamicSharedMemorySize, LDS_BYTES) != hipSuccess) { fprintf(stderr, "kernel_launch: hipFuncSetAttribute failed\n"); grid = -1; return; }
        if (hipOccupancyMaxActiveBlocksPerMultiprocessor(&per_cu, (const void*)fwd_kernel, NWAVES * 64, LDS_BYTES) != hipSuccess || per_cu < 1)
            fprintf(stderr, "kernel_launch: note: occupancy query reports %d workgroups per CU\n", per_cu);
        (void)hipGetLastError();
        grid = cus;
        if (grid % 8 != 0) { fprintf(stderr, "kernel_launch: CU count %d is not a multiple of 8\n", cus); grid = -1; return; }
    }
    if (grid < 0) return;
    if (hipMemsetAsync((char*)d_ws + WS_CTL, 0, CTL_ZERO_BYTES, stream) != hipSuccess) { fprintf(stderr, "kernel_launch: memset failed\n"); return; }
    Args a{};
    for (int i = 0; i < 17; ++i) a.in[i] = (const float*)d_in[i];
    a.out = (float*)d_out; a.ws = (unsigned char*)d_ws;
    hipLaunchKernelGGL(fwd_kernel, dim3(grid), dim3(NWAVES * 64), LDS_BYTES, stream, a);
    const hipError_t le = hipPeekAtLastError();
    if (le != hipSuccess) fprintf(stderr, "kernel_launch: launch failed: %s\n", hipGetErrorName(le));
}
```

```cpp
#include <hip/hip_runtime.h>
#include <cstdio>
#include <cstdint>

#define LAS __attribute__((address_space(3)))
typedef unsigned short bf16_t;
typedef short bf16x8 __attribute__((ext_vector_type(8)));
typedef short s16x4 __attribute__((ext_vector_type(4)));
typedef float f32x2 __attribute__((ext_vector_type(2)));
typedef float f32x4 __attribute__((ext_vector_type(4)));
typedef float f32x16 __attribute__((ext_vector_type(16)));
typedef unsigned u32x2 __attribute__((ext_vector_type(2)));
typedef unsigned u32x4 __attribute__((ext_vector_type(4)));
typedef __bf16 bf16x2_t __attribute__((ext_vector_type(2)));

#ifndef DBG_SKIP
#define DBG_SKIP 0
#endif
constexpr int DM = 1024, NB = 8, SEQ = 4096, CTXL = 256, GW = 64;
constexpr int ML = NB * SEQ;
constexpr int MC = NB * CTXL;
constexpr int MT = ML + MC;
constexpr int NMOD = 6 * DM;
constexpr int NEXP = 16384;
constexpr float EPS = 1e-6f;
constexpr float LOG2E = 1.4426950408889634f;

constexpr size_t MiB = 1u << 20;
constexpr size_t WS_CTL = 0, CTL_ZERO_BYTES = 1 * MiB;
constexpr size_t WS_MOD = 1 * MiB;
constexpr size_t WS_WQKV = 2 * MiB;
constexpr size_t WS_WO = 8 * MiB;
constexpr size_t WS_WF = 10 * MiB;
constexpr size_t WS_WPQ = 12 * MiB;
constexpr size_t WS_SK = 20 * MiB;
constexpr size_t WS_WC = 20 * MiB + 256 * 1024;
constexpr size_t WS_CS = 22 * MiB;
constexpr size_t WS_TAB = 86 * MiB;
constexpr size_t WS_X8 = 150 * MiB;
constexpr size_t WS_WT = 182 * MiB;
constexpr size_t WS_PART = 282 * MiB;
constexpr float U_SCALE = 96.f;
constexpr float XQ_SCALE = 15.875f;
constexpr float V_SCALE = 2.f;
constexpr size_t TAB_LAYER = 32 * MiB, TAB_VOFF = 16 * MiB;
constexpr size_t WS_WSC = 198 * MiB;
constexpr size_t WS_HX = 214 * MiB;
constexpr size_t WS_QK = 282 * MiB;
constexpr size_t WS_VT = 418 * MiB;
constexpr size_t WS_IDX = WS_VT;
constexpr size_t WS_GATE = WS_VT + 8 * MiB;
constexpr size_t WS_END = 486 * MiB;
constexpr int CW_BAR = 4096;

__device__ __forceinline__ unsigned f2bf(float f) { unsigned u = __builtin_bit_cast(unsigned, f); return (u + 0x7fffu + ((u >> 16) & 1u)) >> 16; }
__device__ __forceinline__ unsigned pk2(float lo, float hi) { return f2bf(lo) | (f2bf(hi) << 16); }
__device__ __forceinline__ unsigned cvtpk(float lo, float hi) { f32x2 v = {lo, hi}; bf16x2_t b = __builtin_convertvector(v, bf16x2_t); return __builtin_bit_cast(unsigned, b); }
__device__ __forceinline__ float bflo(unsigned u) { return __builtin_bit_cast(float, u << 16); }
__device__ __forceinline__ float bfhi(unsigned u) { return __builtin_bit_cast(float, u & 0xffff0000u); }
__device__ __forceinline__ float wave_sum(float v) {
#pragma unroll
    for (int o = 1; o < 64; o <<= 1) v += __shfl_xor(v, o);
    return v;
}
__device__ __forceinline__ unsigned fp8_pack4(float a, float b, float c, float d) {
    int w = 0;
    w = __builtin_amdgcn_cvt_pk_fp8_f32(__builtin_amdgcn_fmed3f(a, -448.f, 448.f), __builtin_amdgcn_fmed3f(b, -448.f, 448.f), w, false);
    w = __builtin_amdgcn_cvt_pk_fp8_f32(__builtin_amdgcn_fmed3f(c, -448.f, 448.f), __builtin_amdgcn_fmed3f(d, -448.f, 448.f), w, true);
    return (unsigned)w;
}
__device__ __forceinline__ int crow(int r, int hi) { return (r & 3) + 8 * (r >> 2) + 4 * hi; }
__device__ __forceinline__ float gelu_erf(float v) {
    const float av = __builtin_fabsf(v), d = av * 0.2316418882f + 1.0f;
    const float t = __builtin_amdgcn_rcpf(d);
    float q = t * 0.5307027145f + (-0.7265760135f); q = q * t + 0.7107068705f; q = q * t + (-0.142248368f); q = q * t + 0.127414796f; q = q * t;
    const float e = __builtin_amdgcn_exp2f((v * v) * (-0.72134752044f));
    const float m = v * (q * e), r = v - m;
    return v < 0.f ? m : r;
}

namespace pg8 {
constexpr float ACT8_SCALE = 16.f, W8_SCALE = 256.f;
constexpr float YT_SCALE = 16.f, CS_SCALE = 512.f;
constexpr int BM = 256, BK = 64, HALF = 128, HTB = HALF * BK * 2, STAGE_BYTES = 8 * HTB, NXCD = 8, WGM = 8;
__host__ __device__ __forceinline__ int lds_byte(int r, int c) { const int st = (r >> 4) * 2 + (c >> 5), rr = r & 15, cc = c & 31, ob = rr * 64 + cc * 2; return st * 1024 + (ob ^ (((ob >> 9) & 1) << 5)); }
__host__ __device__ __forceinline__ void stage_rc(int b, int& R, int& C) { const int st = b / 1024, sb = b % 1024, swz = sb ^ (((sb >> 9) & 1) << 5); R = (st >> 1) * 16 + swz / 64; C = (st & 1) * 32 + (swz % 64) / 2; }
__host__ __device__ __forceinline__ int perm32(int rho) { const int n = rho >> 4, i = rho & 15; return 8 * (i >> 2) + 4 * n + (i & 3); }

struct Unit { int pm, pn, pb; };
struct Gemm { const bf16_t* A; const bf16_t* Bt; };
template <int M_, int N_, int K_, int LDA_, int LDB_, int NBATCH_, long BSA_, long BSB_> struct Shape { static constexpr int M = M_, N = N_, K = K_, lda = LDA_, ldb = LDB_, nbatch = NBATCH_; static constexpr long bsA = BSA_, bsB = BSB_; };

template <class SH> struct StaticOrder {
    static constexpr int nM = SH::M / BM, nN = SH::N / BM, per = nM * nN, nwg = per * SH::nbatch;
    int G, c;
    __device__ __forceinline__ void init(int G_, int c_) { G = G_; c = c_; }
    __device__ __forceinline__ bool next(int i, Unit& u) const {
        const long L = (long)i * G + c; if (L >= nwg) return false;
        int wgid = (int)L; { const int q = nwg / NXCD, r = nwg % NXCD, xcd = wgid % NXCD, off = wgid / NXCD; wgid = (xcd < r ? xcd * (q + 1) : r * (q + 1) + (xcd - r) * q) + off; }
        u.pb = wgid / per; wgid -= u.pb * per;
        const int nig = WGM * nN, gid = wgid / nig, fm = gid * WGM, gsz = (nM - fm) < WGM ? (nM - fm) : WGM;
        u.pm = fm + ((wgid % nig) % gsz); u.pn = (wgid % nig) / gsz; return true;
    }
};

struct EpiStoreBf16 {
    static constexpr bool PERM = true;
    bf16_t* O; long ldc; long bstride; int scols; float scale0; float oscale = 1.0f;
    __device__ __forceinline__ void operator()(const f32x4 (&acc)[2][2][4][2], const Unit& u, int wr, int wc, int fr, int fq) const {
        const int row0 = u.pm * BM + wr * 64 + fr, col0 = u.pn * BM + wc * 32 + 8 * fq;
        bf16_t* base = O + (long)u.pb * bstride;
        const float sc = ((u.pn * BM < scols) ? scale0 : 1.0f) * oscale;
#pragma unroll
        for (int ai = 0; ai < 2; ++ai)
#pragma unroll
            for (int m = 0; m < 4; ++m) { bf16_t* rowp = base + (long)(row0 + ai * HALF + m * 16) * ldc + col0;
#pragma unroll
                for (int bj = 0; bj < 2; ++bj) { const f32x4 v0 = acc[ai][bj][m][0] * sc, v1 = acc[ai][bj][m][1] * sc;
                    u32x4 w; w.x = cvtpk(v0[0], v0[1]); w.y = cvtpk(v0[2], v0[3]); w.z = cvtpk(v1[0], v1[1]); w.w = cvtpk(v1[2], v1[3]);
                    *(u32x4*)(rowp + bj * HALF) = w; } }
    }
};
struct EpiDft2 {
    static constexpr bool PERM = true;
    unsigned char* O;
    __device__ __forceinline__ void operator()(const f32x4 (&acc)[2][2][4][2], const Unit& u, int wr, int wc, int fr, int fq) const {
        const int row0 = u.pm * BM + wr * 64 + fr, cl0 = wc * 32 + 8 * fq;
        unsigned char* base = O + (long)u.pb * SEQ * DM + u.pn * BM;
        constexpr float osc = ACT8_SCALE / (YT_SCALE * CS_SCALE);
#pragma unroll
        for (int ai = 0; ai < 2; ++ai)
#pragma unroll
            for (int m = 0; m < 4; ++m) { const int np = row0 + ai * HALF + m * 16;
                unsigned char* rowp = base + (long)np * DM; unsigned char* mirp = base + (long)(SEQ - np) * DM;
#pragma unroll
                for (int bj = 0; bj < 2; ++bj) { const f32x4 v0 = acc[ai][bj][m][0] * osc, v1 = acc[ai][bj][m][1] * osc; const int cl = cl0 + bj * HALF;
                    u32x2 w; w.x = fp8_pack4(v0[0], v0[1], v0[2], v0[3]); w.y = fp8_pack4(v1[0], v1[1], v1[2], v1[3]);
                    *(u32x2*)(rowp + cl) = w;
                    if (np != 0) {
#pragma unroll
                        for (int i = 0; i < 8; ++i) mirp[(256 - cl - i) & 255] = (unsigned char)((w[i >> 2] >> (8 * (i & 3))) & 0xffu); } }
                asm volatile("" ::: "memory"); }
    }
};
struct EpiYt {
    static constexpr bool PERM = true;
    unsigned char* Yt;
    __device__ __forceinline__ void operator()(const f32x4 (&acc)[2][2][4][2], const Unit& u, int wr, int wc, int fr, int fq) const {
        const int row0 = u.pm * BM + wr * 64 + fr, col0 = u.pn * BM + wc * 32 + 8 * fq;
#pragma unroll
        for (int ai = 0; ai < 2; ++ai)
#pragma unroll
            for (int m = 0; m < 4; ++m) { const int row = row0 + ai * HALF + m * 16; const int part = row >> 8, cp = row & 255;
#pragma unroll
                for (int bj = 0; bj < 2; ++bj) { const int col = col0 + bj * HALF; const int b = col >> 12, n = col & 4095;
                    const f32x4 v0 = acc[ai][bj][m][0] * YT_SCALE, v1 = acc[ai][bj][m][1] * YT_SCALE;
                    u32x2 w; w.x = fp8_pack4(v0[0], v0[1], v0[2], v0[3]); w.y = fp8_pack4(v1[0], v1[1], v1[2], v1[3]);
                    *(u32x2*)(Yt + ((((long)(b * 4 + u.pb) * 256 + cp) * 2 + part) << 12) + n) = w; }
                asm volatile("" ::: "memory"); }
    }
};
struct EpiResid {
    static constexpr bool PERM = false;
    const float* Xin; float* Xout; const float* gate; int gstride; float gs;
    __device__ __forceinline__ void operator()(const f32x4 (&acc)[2][2][4][2], const Unit& u, int wr, int wc, int fr, int fq) const {
        const int row0 = u.pm * BM + wr * 64 + fr, col0 = u.pn * BM + wc * 32 + 4 * fq;
        const float* gb = gate + (long)((u.pm * BM) >> 12) * gstride;
        f32x4 gv[2][2];
#pragma unroll
        for (int bj = 0; bj < 2; ++bj)
#pragma unroll
            for (int n = 0; n < 2; ++n) gv[bj][n] = *(const f32x4*)(gb + col0 + bj * HALF + n * 16);
#pragma unroll
        for (int ai = 0; ai < 2; ++ai)
#pragma unroll
            for (int m = 0; m < 4; ++m) { const long off = (long)(row0 + ai * HALF + m * 16) * DM + col0;
#pragma unroll
                for (int bj = 0; bj < 2; ++bj)
#pragma unroll
                    for (int n = 0; n < 2; ++n) { const f32x4 bs = *(const f32x4*)(Xin + off + bj * HALF + n * 16);
                        *(f32x4*)(Xout + off + bj * HALF + n * 16) = bs + gv[bj][n] * acc[ai][bj][m][n] * gs; }
                if (m & 1) asm volatile("" ::: "memory"); }
    }
};

template <class SH, class Epi, bool FP8 = false>
__device__ __forceinline__ void gemm_phase(LAS unsigned char* lds, const Gemm g, int G_, int c_, const Epi& E) {
    StaticOrder<SH> S; S.init(G_, c_);
    int tid_ = threadIdx.x; asm volatile("" : "+v"(tid_));
    const int tid = tid_, wid = __builtin_amdgcn_readfirstlane(tid >> 6), lane = tid & 63, wr = wid >> 2, wc = wid & 3, fr = lane & 15, fq = lane >> 4;
    constexpr int K = SH::K, nt = K / BK;
    unsigned voffA[2], voffB[2];
#pragma unroll
    for (int i = 0; i < 2; ++i) { int R, C; stage_rc(tid * 16 + i * 8192, R, C); const int Rb = Epi::PERM ? ((R & ~31) + perm32(R & 31)) : R;
        voffA[i] = (unsigned)(R * SH::lda + C) * 2u; voffB[i] = (unsigned)(Rb * SH::ldb + C) * 2u; }
    constexpr size_t kstep = (size_t)(BK * 2);
    constexpr size_t hstepA = (size_t)HALF * SH::lda * 2, hstepB = (size_t)HALF * SH::ldb * 2;
    constexpr size_t tstepA = 2 * hstepA, tstepB = 2 * hstepB;
    const unsigned ldsw = (unsigned)wid * 1024u;
    const int aoff = lds_byte(wr * 64 + fr, fq * 8), boff = lds_byte(wc * 32 + fr, fq * 8);
#define PG8_SA(b, h) (((b) * 2 + (h)) * HTB)
#define PG8_SB(b, h) ((4 + (b) * 2 + (h)) * HTB)
#define PG8_STAGE(bufoff, gbase, voff) do { _Pragma("unroll") for (int _i = 0; _i < 2; ++_i) \
        __builtin_amdgcn_global_load_lds((const unsigned*)((const char*)(gbase) + (voff)[_i]), (LAS unsigned*)(lds + (bufoff) + ldsw + _i * 8192), 16, 0, 0); } while (0)
#define PG8_LDA(dst, b, h) do { _Pragma("unroll") for (int m = 0; m < 4; ++m) { const u32x4 f0_ = *(const LAS u32x4*)(lds + PG8_SA(b, h) + aoff + m * 2048), f1_ = *(const LAS u32x4*)(lds + PG8_SA(b, h) + aoff + m * 2048 + 1024); dst[m] = __builtin_shufflevector(f0_, f1_, 0, 1, 2, 3, 4, 5, 6, 7); } } while (0)
#define PG8_LDB(dst, b, h) do { _Pragma("unroll") for (int n = 0; n < 2; ++n) { const u32x4 f0_ = *(const LAS u32x4*)(lds + PG8_SB(b, h) + boff + n * 2048), f1_ = *(const LAS u32x4*)(lds + PG8_SB(b, h) + boff + n * 2048 + 1024); dst[n] = __builtin_shufflevector(f0_, f1_, 0, 1, 2, 3, 4, 5, 6, 7); } } while (0)
typedef int v8i_t __attribute__((ext_vector_type(8)));
typedef unsigned u32x8 __attribute__((ext_vector_type(8)));
#define PG8_LOH(x) __builtin_bit_cast(bf16x8, __builtin_shufflevector(x, x, 0, 1, 2, 3))
#define PG8_HIH(x) __builtin_bit_cast(bf16x8, __builtin_shufflevector(x, x, 4, 5, 6, 7))
#define PG8_MMA(ai, bj, At, Bt) do { __builtin_amdgcn_s_setprio(1); _Pragma("unroll") for (int m = 0; m < 4; ++m) _Pragma("unroll") for (int n = 0; n < 2; ++n) { \
        if constexpr (FP8) asm volatile("v_mfma_scale_f32_16x16x128_f8f6f4 %0, %1, %2, %0, %3, %3 op_sel_hi:[0,0,0]" : "+v"(acc[ai][bj][m][n]) : "v"(Bt[n]), "v"(At[m]), "v"(fp8_one));   \
        else { acc[ai][bj][m][n] = __builtin_amdgcn_mfma_f32_16x16x32_bf16(PG8_LOH(Bt[n]), PG8_LOH(At[m]), acc[ai][bj][m][n], 0, 0, 0); \
               acc[ai][bj][m][n] = __builtin_amdgcn_mfma_f32_16x16x32_bf16(PG8_HIH(Bt[n]), PG8_HIH(At[m]), acc[ai][bj][m][n], 0, 0, 0); } } \
        __builtin_amdgcn_s_setprio(0); } while (0)
#define PG8_WAIT_V(n) asm volatile("s_waitcnt vmcnt(" #n ")" ::: "memory")
#define PG8_WAIT_L(n) asm volatile("s_waitcnt lgkmcnt(" #n ")" ::: "memory")
#define PG8_BAR __builtin_amdgcn_s_barrier()
#define PG8_SCHED __builtin_amdgcn_sched_barrier(0)
    Unit cur, nxt; int ui = 0;
    if (!S.next(0, cur)) return;
    f32x4 acc[2][2][4][2];
#pragma unroll
    for (int a = 0; a < 2; ++a)
#pragma unroll
        for (int b = 0; b < 2; ++b)
#pragma unroll
            for (int m = 0; m < 4; ++m)
#pragma unroll
                for (int n = 0; n < 2; ++n) acc[a][b][m][n] = (f32x4){0.f, 0.f, 0.f, 0.f};
    unsigned fp8_one = 0x7f7f7f7fu; asm volatile("" : "+v"(fp8_one));
    u32x8 At[4], B0[2], B1[2];
    const char* cA = (const char*)(g.A + (long)cur.pb * SH::bsA) + (size_t)cur.pm * tstepA; const char* cB = (const char*)(g.Bt + (long)cur.pb * SH::bsB) + (size_t)cur.pn * tstepB;
    PG8_STAGE(PG8_SB(0, 0), cB, voffB); PG8_STAGE(PG8_SB(0, 1), cB + hstepB, voffB); PG8_STAGE(PG8_SA(0, 0), cA, voffA); PG8_STAGE(PG8_SA(0, 1), cA + hstepA, voffA);
    if (wr == 1) PG8_BAR;
    PG8_WAIT_V(2); PG8_BAR;
    PG8_STAGE(PG8_SB(1, 0), cB + kstep, voffB); PG8_STAGE(PG8_SA(1, 0), cA + kstep, voffA); PG8_STAGE(PG8_SB(1, 1), cB + hstepB + kstep, voffB);
    PG8_WAIT_V(6); PG8_BAR;
    for (;;) {
        const bool has_next = S.next(ui + 1, nxt);
        const char* nA = has_next ? (const char*)(g.A + (long)nxt.pb * SH::bsA) + (size_t)nxt.pm * tstepA : cA; const char* nB = has_next ? (const char*)(g.Bt + (long)nxt.pb * SH::bsB) + (size_t)nxt.pn * tstepB : cB;
#pragma nounroll
        for (int t = 0; t < nt; t += 2) {
            const bool last = (t == nt - 2);
            const char* a1 = cA + (size_t)(t + 1) * kstep;
            const char* a2 = last ? nA : cA + (size_t)(t + 2) * kstep; const char* b2 = last ? nB : cB + (size_t)(t + 2) * kstep;
            const char* a3 = a2 + kstep; const char* b3 = b2 + kstep;
            PG8_LDB(B0, 0, 0); PG8_LDB(B1, 0, 1); PG8_SCHED; PG8_LDA(At, 0, 0); PG8_STAGE(PG8_SA(1, 1), a1 + hstepA, voffA);
            PG8_WAIT_V(8); PG8_WAIT_L(0); PG8_BAR; PG8_MMA(0, 0, At, B0); PG8_MMA(0, 1, At, B1); PG8_BAR; PG8_SCHED;
            PG8_LDA(At, 0, 1); PG8_STAGE(PG8_SB(0, 0), b2, voffB); PG8_STAGE(PG8_SB(0, 1), b2 + hstepB, voffB); PG8_STAGE(PG8_SA(0, 0), a2, voffA);
            PG8_WAIT_V(8); PG8_WAIT_L(0); PG8_BAR; PG8_MMA(1, 0, At, B0); PG8_MMA(1, 1, At, B1); PG8_BAR; PG8_SCHED;
            PG8_LDB(B0, 1, 0); PG8_LDB(B1, 1, 1); PG8_SCHED; PG8_LDA(At, 1, 0); PG8_STAGE(PG8_SA(0, 1), a2 + hstepA, voffA);
            PG8_WAIT_V(8); PG8_WAIT_L(0); PG8_BAR; PG8_MMA(0, 0, At, B0); PG8_MMA(0, 1, At, B1); PG8_BAR; PG8_SCHED;
            PG8_LDA(At, 1, 1); PG8_STAGE(PG8_SB(1, 0), b3, voffB); PG8_STAGE(PG8_SB(1, 1), b3 + hstepB, voffB); PG8_STAGE(PG8_SA(1, 0), a3, voffA);
            PG8_WAIT_V(8); PG8_WAIT_L(0); PG8_BAR; PG8_MMA(1, 0, At, B0); PG8_MMA(1, 1, At, B1); PG8_BAR; PG8_SCHED;
        }
        if (wr == 0) PG8_BAR;
        if constexpr (FP8) asm volatile("s_nop 15\n\ts_nop 15\n\ts_nop 7" ::: "memory");
        E(acc, cur, wr, wc, fr, fq);
        if (!has_next) break;
#pragma unroll
        for (int a = 0; a < 2; ++a)
#pragma unroll
            for (int b = 0; b < 2; ++b)
#pragma unroll
                for (int m = 0; m < 4; ++m)
#pragma unroll
                    for (int n = 0; n < 2; ++n) acc[a][b][m][n] = (f32x4){0.f, 0.f, 0.f, 0.f};
        cur = nxt; cA = nA; cB = nB; ++ui;
        if (wr == 1) PG8_BAR;
    }
    PG8_WAIT_V(0);
    PG8_BAR;
#undef PG8_SA
#undef PG8_SB
#undef PG8_STAGE
#undef PG8_LDA
#undef PG8_LDB
#undef PG8_MMA
#undef PG8_WAIT_V
#undef PG8_WAIT_L
#undef PG8_BAR
#undef PG8_SCHED
}
}

#define XB_TMO      128
#define XB_XCNT(j)  (256  + 64 * (j))
#define XB_XSUB(j)  (1280 + 64 * (j))
#define XB_XGEN(j)  (2304 + 64 * (j))
#define XB_TOP      3328
#define XB_TOPGEN   3392
#define XCD_BAR_WORDS 3456
#define XB_SPIN_CAP (1u << 18)
__device__ __forceinline__ unsigned xb_ld(unsigned* p)              { return __hip_atomic_load(p, __ATOMIC_RELAXED, __HIP_MEMORY_SCOPE_AGENT); }
__device__ __forceinline__ unsigned xb_add(unsigned* p, unsigned v) { return __hip_atomic_fetch_add(p, v, __ATOMIC_RELAXED, __HIP_MEMORY_SCOPE_AGENT); }
__device__ __forceinline__ unsigned xb_xcc_id() { return (unsigned)__builtin_amdgcn_s_getreg((3 << 11) | 20) & 0xFu; }
#define XB_SPIN(cond, bar) do { unsigned _sp = 0; while (cond) { __builtin_amdgcn_s_sleep(1); \
    if ((++_sp & 255u) == 0u) { if (xb_ld(&(bar)[XB_TMO])) break; if (_sp > XB_SPIN_CAP) { atomicAdd(&(bar)[XB_TMO], 1u); break; } } } } while (0)
struct XcdBarrier { unsigned* bar; unsigned x; volatile LAS unsigned* st; };
__device__ __forceinline__ XcdBarrier xcd_barrier_post(unsigned* bar, volatile LAS unsigned* st) {
    XcdBarrier b; b.bar = bar; b.x = xb_xcc_id(); b.st = st;
    if (threadIdx.x == 0) (void)xb_add(&bar[XB_XCNT(b.x)], 1u);
    return b;
}
__device__ __forceinline__ void xcd_barrier_complete(unsigned* bar, unsigned x, unsigned& nloc, unsigned& nx) {
    const unsigned G = gridDim.x * gridDim.y * gridDim.z;
    unsigned sum, cnt, mine, sp = 0u;
    for (;;) {
        sum = 0u; cnt = 0u; mine = 0u;
#pragma unroll
        for (unsigned j = 0; j < 16; ++j) { const unsigned c = xb_ld(&bar[XB_XCNT(j)]); sum += c; cnt += (c > 0u) ? 1u : 0u; mine = (j == x) ? c : mine; }
        if (sum == G) break;
        __builtin_amdgcn_s_sleep(1);
        if ((++sp & 255u) == 0u) { if (xb_ld(&bar[XB_TMO])) break; if (sp > XB_SPIN_CAP) { atomicAdd(&bar[XB_TMO], 1u); break; } }
    }
    nloc = mine > 0u ? mine : 1u; nx = cnt > 0u ? cnt : 1u;
}
__device__ __forceinline__ void xcd_barrier(const XcdBarrier& b) {
    asm volatile("s_waitcnt vmcnt(0)" ::: "memory");
    __syncthreads();
    if (threadIdx.x == 0) {
        unsigned* bar = b.bar;
        __builtin_amdgcn_s_waitcnt(0);
        unsigned nloc = b.st[0], nx = b.st[1];
        if (nloc == 0u) { xcd_barrier_complete(bar, b.x, nloc, nx); b.st[0] = nloc; b.st[1] = nx; }
        const unsigned old = xb_add(&bar[XB_XSUB(b.x)], 1u);
        const unsigned gen = old / nloc;
        if (old + 1u == (gen + 1u) * nloc) {
            __builtin_amdgcn_fence(__ATOMIC_RELEASE, "agent");
            asm volatile("s_waitcnt vmcnt(0)" ::: "memory");
            const unsigned og = xb_add(&bar[XB_TOP], 1u);
            const unsigned tg = og / nx;
            if (og + 1u == (tg + 1u) * nx) xb_add(&bar[XB_TOPGEN], 1u);
            else XB_SPIN(xb_ld(&bar[XB_TOPGEN]) == tg, bar);
            __builtin_amdgcn_fence(__ATOMIC_ACQUIRE, "agent");
            xb_add(&bar[XB_XGEN(b.x)], 1u);
            asm volatile("s_waitcnt vmcnt(0)" ::: "memory");
        } else {
            XB_SPIN(xb_ld(&bar[XB_XGEN(b.x)]) == gen, bar);
            __builtin_amdgcn_fence(__ATOMIC_ACQUIRE, "agent");
            asm volatile("s_waitcnt vmcnt(0)" ::: "memory");
        }
    }
    __syncthreads();
}

constexpr int RING_BYTES = 131072;
constexpr int LDSCTL_OFF = RING_BYTES, MISC_OFF = LDSCTL_OFF + 320;
constexpr int LDS_BYTES = 147456;
constexpr int NWAVES = 8;

struct Args { const float* in[17]; float* out; unsigned char* ws; };

struct Ctx {
    LAS unsigned char* lds;
    int tid, lane, wave, vcu, G;
};

__device__ __forceinline__ Ctx fresh(const Ctx& F) {
    Ctx C = F; int t = threadIdx.x; asm volatile("" : "+v"(t)); C.tid = t; C.lane = t & 63; return C;
}
__device__ __forceinline__ void p0_transpose_item(const float* W, int K, int N, bf16_t* WT, LAS float* scr, int item, int lane) {
    const int nblk = N / 32, kb = item / nblk, nb = item % nblk, k0 = 64 * kb, n0 = 32 * nb;
#pragma unroll 8
    for (int i = 0; i < 32; ++i) { const int kk = 2 * i + (lane >> 5); scr[kk * 33 + (lane & 31)] = W[(size_t)(k0 + kk) * N + n0 + (lane & 31)]; }
    asm volatile("s_waitcnt lgkmcnt(0)" ::: "memory");
    const int c = lane & 7;
#pragma unroll
    for (int j = 0; j < 4; ++j) { const int n = (lane >> 3) + 8 * j; const LAS float* s = scr + (8 * c) * 33 + n;
        u32x4 o; o.x = pk2(s[0 * 33], s[1 * 33]); o.y = pk2(s[2 * 33], s[3 * 33]); o.z = pk2(s[4 * 33], s[5 * 33]); o.w = pk2(s[6 * 33], s[7 * 33]);
        *(u32x4*)(WT + (size_t)(n0 + n) * K + k0 + 8 * c) = o; }
    asm volatile("s_waitcnt lgkmcnt(0)" ::: "memory");
}
__device__ __forceinline__ void p0_transpose_item8(const float* W, int K, int N, unsigned char* WT, LAS float* scr, int item, int lane) {
    const int nblk = N / 32, kb = item / nblk, nb = item % nblk, k0 = 64 * kb, n0 = 32 * nb;
#pragma unroll 8
    for (int i = 0; i < 32; ++i) { const int kk = 2 * i + (lane >> 5); scr[kk * 33 + (lane & 31)] = W[(size_t)(k0 + kk) * N + n0 + (lane & 31)]; }
    asm volatile("s_waitcnt lgkmcnt(0)" ::: "memory");
    const int c = lane & 7;
#pragma unroll
    for (int j = 0; j < 4; ++j) { const int n = (lane >> 3) + 8 * j; const LAS float* s = scr + (8 * c) * 33 + n; constexpr float sc = pg8::W8_SCALE;
        u32x2 o; o.x = fp8_pack4(s[0 * 33] * sc, s[1 * 33] * sc, s[2 * 33] * sc, s[3 * 33] * sc); o.y = fp8_pack4(s[4 * 33] * sc, s[5 * 33] * sc, s[6 * 33] * sc, s[7 * 33] * sc);
        *(u32x2*)(WT + (size_t)(n0 + n) * K + k0 + 8 * c) = o; }
    asm volatile("s_waitcnt lgkmcnt(0)" ::: "memory");
}
__device__ __forceinline__ void cvt8(const float* src, bf16_t* dst) {
    const f32x4 a = *(const f32x4*)src, b = *(const f32x4*)(src + 4);
    u32x4 o; o.x = pk2(a[0], a[1]); o.y = pk2(a[2], a[3]); o.z = pk2(b[0], b[1]); o.w = pk2(b[2], b[3]);
    *(u32x4*)dst = o;
}

__device__ __forceinline__ void p0_prologue(const Ctx& F0, const Args& a) {
    const Ctx F = fresh(F0);
    unsigned char* ws = a.ws;
    const int gw = F.vcu * NWAVES + F.wave, NGW = F.G * NWAVES;
    const long gt = (long)F.vcu * 512 + F.tid, NGT = (long)F.G * 512;
    {
        LAS float* red = (LAS float*)(F.lds);
        const float* c = a.in[1]; const float* cctx = a.in[3]; const float* wmod = a.in[6]; const float* bmod = a.in[7];
        float* modb = (float*)(ws + WS_MOD);
        for (int item = F.vcu; item < 96; item += F.G) {
            const int l = item / 48, nc = item % 48, n0 = nc * 128 + 2 * F.lane, kb = F.wave * 128;
            float sv[9][2];
#pragma unroll
            for (int r = 0; r < 9; ++r)
#pragma unroll
                for (int j = 0; j < 2; ++j) { const int k = kb + 64 * j + F.lane; const float v = (r < 8) ? c[r * DM + k] : cctx[k]; sv[r][j] = v / (1.0f + __expf(-v)); }
            float acc[9][2];
#pragma unroll
            for (int r = 0; r < 9; ++r) { acc[r][0] = 0.f; acc[r][1] = 0.f; }
            const float* wp = wmod + (size_t)l * DM * NMOD + (size_t)kb * NMOD + n0;
#pragma unroll
            for (int j = 0; j < 2; ++j)
#pragma unroll 8
                for (int kl = 0; kl < 64; ++kl) {
                    const f32x2 w = *(const f32x2*)(wp + (size_t)(64 * j + kl) * NMOD);
#pragma unroll
                    for (int r = 0; r < 9; ++r) { const float s = __builtin_bit_cast(float, __builtin_amdgcn_readlane(__builtin_bit_cast(int, sv[r][j]), kl)); acc[r][0] += s * w[0]; acc[r][1] += s * w[1]; }
                }
            __syncthreads();
#pragma unroll
            for (int r = 0; r < 9; ++r) { red[(F.wave * 9 + r) * 128 + 2 * F.lane] = acc[r][0]; red[(F.wave * 9 + r) * 128 + 2 * F.lane + 1] = acc[r][1]; }
            __syncthreads();
            for (int o = F.tid; o < 9 * 128; o += 512) { const int r = o >> 7, nl = o & 127; float s = 0.f;
#pragma unroll
                for (int w = 0; w < 8; ++w) s += red[(w * 9 + r) * 128 + nl];
                modb[(size_t)(l * 9 + r) * NMOD + nc * 128 + nl] = s + bmod[l * NMOD + nc * 128 + nl]; }
        }
        __syncthreads();
    }
    {
        LAS float* scr = (LAS float*)(F.lds + F.wave * 16384);
        constexpr int I_QKV = (DM / 64) * (3 * DM / 32), I_O = (DM / 64) * (DM / 32), I_PQ = (DM / 64) * (2 * DM / 32);
        constexpr int NITEMS = I_QKV + 2 * I_O + 2 * I_PQ;
        for (int it = gw; it < NITEMS; it += NGW) {
            int r = it;
            if (r < I_QKV) { p0_transpose_item8(a.in[8], DM, 3 * DM, ws + WS_WQKV, scr, r, F.lane); continue; } r -= I_QKV;
            if (r < I_O) { p0_transpose_item8(a.in[9], DM, DM, ws + WS_WO, scr, r, F.lane); continue; } r -= I_O;
            if (r < I_O) { p0_transpose_item8(a.in[11], DM, DM, ws + WS_WF, scr, r, F.lane); continue; } r -= I_O;
            if (r < I_PQ) { p0_transpose_item(a.in[12], DM, 2 * DM, (bf16_t*)(ws + WS_WPQ), scr, r, F.lane); continue; } r -= I_PQ;
            p0_transpose_item(a.in[12] + (size_t)DM * 2 * DM, DM, 2 * DM, (bf16_t*)(ws + WS_WPQ) + (size_t)2 * DM * DM, scr, r, F.lane);
        }
    }
    for (long i = gt; i < 2 * 2 * 128 * 128 / 8; i += NGT) cvt8(a.in[13] + i * 8, (bf16_t*)(ws + WS_SK) + i * 8);
    {
        bf16_t* wc = (bf16_t*)(ws + WS_WC);
        for (long i = gt; i < 512 * 256 / 8; i += NGT) { const int nn = (int)(i >> 5), k0 = (int)(i & 31) * 8; float v[8];
#pragma unroll
            for (int j = 0; j < 8; ++j) { const int m = ((k0 + j) * (nn & 255)) & 255; const float fr = (float)m * (1.0f / 256.0f);
                v[j] = (nn < 256 ? __builtin_amdgcn_cosf(fr) : __builtin_amdgcn_sinf(fr)) * (1.0f / 16.0f); }
            u32x4 o; o.x = pk2(v[0], v[1]); o.y = pk2(v[2], v[3]); o.z = pk2(v[4], v[5]); o.w = pk2(v[6], v[7]);
            *(u32x4*)(wc + i * 8) = o; }
        unsigned char* cs = ws + WS_CS;
        for (long i = gt; i < 2048L * 8192 / 8; i += NGT) { const int np = (int)(i >> 10), c0 = (int)(i & 1023) * 8; const int part = c0 >> 12; float v[8];
#pragma unroll
            for (int j = 0; j < 8; ++j) { const int n = (c0 + j) & 4095; const int m = (n * np) & 4095; const float fr = (float)m * (1.0f / 4096.0f);
                v[j] = (part == 0 ? __builtin_amdgcn_cosf(fr) : -__builtin_amdgcn_sinf(fr)) * (pg8::CS_SCALE / 64.0f); }
            u32x2 o; o.x = fp8_pack4(v[0], v[1], v[2], v[3]); o.y = fp8_pack4(v[4], v[5], v[6], v[7]);
            *(u32x2*)(cs + i * 8) = o; }
    }
}

__device__ __forceinline__ unsigned fp4_pack8(const float* v, float sc) {
    unsigned w = 0;
#define FP4C(i) fminf(fmaxf(v[i] * sc, -6.f), 6.f)
    w = __builtin_amdgcn_cvt_scalef32_pk_fp4_f32(w, FP4C(0), FP4C(1), 1.0f, 0);
    w = __builtin_amdgcn_cvt_scalef32_pk_fp4_f32(w, FP4C(2), FP4C(3), 1.0f, 1);
    w = __builtin_amdgcn_cvt_scalef32_pk_fp4_f32(w, FP4C(4), FP4C(5), 1.0f, 2);
    w = __builtin_amdgcn_cvt_scalef32_pk_fp4_f32(w, FP4C(6), FP4C(7), 1.0f, 3);
#undef FP4C
    return w;
}
#define FP4_DEC(w, bs) __builtin_amdgcn_cvt_scalef32_pk_f32_fp4((w), 1.0f, (bs))
__device__ __forceinline__ unsigned i8_pack4(f32x4 v, float sc) {
    const int a = (int)rintf(fminf(fmaxf(v[0] * sc, -127.f), 127.f)), b = (int)rintf(fminf(fmaxf(v[1] * sc, -127.f), 127.f));
    const int c = (int)rintf(fminf(fmaxf(v[2] * sc, -127.f), 127.f)), d = (int)rintf(fminf(fmaxf(v[3] * sc, -127.f), 127.f));
    return (unsigned)(a & 0xff) | ((unsigned)(b & 0xff) << 8) | ((unsigned)(c & 0xff) << 16) | ((unsigned)(d & 0xff) << 24);
}
__device__ __forceinline__ void table_convert(const Ctx& F0, const Args& a, int sh0, int nsh, int nshare) {
    const Ctx F = fresh(F0);
    constexpr long PER = (long)NEXP * DM / 16;
    constexpr long TOTAL = 4 * PER;
    unsigned char* t8 = a.ws + WS_TAB;
    const long per_share = (TOTAL + nshare - 1) / nshare;
    const long i0 = (long)sh0 * per_share, i1 = min((long)(sh0 + nsh) * per_share, TOTAL);
    for (long i = i0 + F.tid; i < i1; i += 512) {
        const int q = (int)(i / PER); const long r = i - (long)q * PER; const int l = q >> 1, tb = q & 1;
        const int e = (int)(r >> 6), c16 = (int)(r & 63);
        const float* src = (tb ? a.in[15] : a.in[14]) + ((size_t)l * NEXP + e) * DM + c16 * 16;
        if (tb) {
            u32x2 o;
#pragma unroll
            for (int d = 0; d < 2; ++d) { const f32x4 va = *(const f32x4*)(src + 8 * d), vb = *(const f32x4*)(src + 8 * d + 4);
                const float v8[8] = {va[0], va[1], va[2], va[3], vb[0], vb[1], vb[2], vb[3]};
                o[d] = fp4_pack8(v8, V_SCALE); }
            *(u32x2*)(t8 + (size_t)l * TAB_LAYER + TAB_VOFF + ((size_t)(c16 >> 4) * NEXP + e) * 128 + (c16 & 15) * 8) = o;
        } else {
            u32x2 o;
#pragma unroll
            for (int d = 0; d < 2; ++d) { unsigned w = 0;
#pragma unroll
                for (int jn = 0; jn < 8; ++jn) { const float x = src[8 * d + jn] * U_SCALE; const int q = (int)rintf(fminf(fmaxf(x, -8.f), 7.f)) + 8; w |= (unsigned)q << (4 * jn); }
                o[d] = w; }
            *(u32x2*)(t8 + (size_t)l * TAB_LAYER + ((size_t)(c16 >> 3) * NEXP + e) * 64 + (c16 & 7) * 8) = o;
        }
    }
}

__device__ __forceinline__ const float* norm_src(const Args& a, int mode, int m) { return (m < ML) ? ((mode == 0 ? a.in[0] : a.out) + (size_t)m * DM) : (a.in[2] + (size_t)(m - ML) * DM); }
__device__ __forceinline__ void norm_phase(const Ctx& F0, const Args& a, int mode, int layer, int off, const float* gw) {
    const Ctx F = fresh(F0);
    const int gwv = F.vcu * NWAVES + F.wave, NGW = F.G * NWAVES, lane = F.lane;
    const float* modb = (const float*)(a.ws + WS_MOD) + (size_t)layer * 9 * NMOD;
    bf16_t* hx = (bf16_t*)(a.ws + WS_HX);
    const int nrows = (mode == 0) ? MT : ML;
    f32x4 gv[4];
#pragma unroll
    for (int j = 0; j < 4; ++j) gv[j] = ((const f32x4*)gw)[lane + 64 * j];
    f32x4 v[4], vn[4];
    if (gwv < nrows) { const f32x4* xr = (const f32x4*)norm_src(a, mode, gwv) + lane;
#pragma unroll
        for (int j = 0; j < 4; ++j) vn[j] = xr[64 * j]; }
    for (int m = gwv; m < nrows; m += NGW) {
#pragma unroll
        for (int j = 0; j < 4; ++j) v[j] = vn[j];
        { const int mn = (m + NGW < nrows) ? m + NGW : m; const f32x4* xr = (const f32x4*)norm_src(a, mode, mn) + lane;
#pragma unroll
          for (int j = 0; j < 4; ++j) vn[j] = xr[64 * j]; }
        const float* mr = modb + (size_t)((m < ML) ? (m >> 12) : 8) * NMOD + off;
        f32x4 av[4], cv[4];
#pragma unroll
        for (int j = 0; j < 4; ++j) { av[j] = ((const f32x4*)mr)[lane + 64 * j]; cv[j] = ((const f32x4*)(mr + DM))[lane + 64 * j]; }
        float s = 0.f;
#pragma unroll
        for (int j = 0; j < 4; ++j) s += (v[j].x * v[j].x + v[j].y * v[j].y) + (v[j].z * v[j].z + v[j].w * v[j].w);
        const float rstd = 1.0f / sqrtf(wave_sum(s) * (1.0f / DM) + EPS);
        unsigned long long* o8 = (unsigned long long*)(hx + (size_t)m * DM) + lane;
        unsigned* o4 = (unsigned*)(a.ws + WS_HX + (size_t)m * DM) + lane;
#pragma unroll
        for (int j = 0; j < 4; ++j) { const f32x4 y = (v[j] * rstd * gv[j]) * (cv[j] + 1.0f) + av[j];
            if (mode == 0) { o4[64 * j] = fp8_pack4(y.x * pg8::ACT8_SCALE, y.y * pg8::ACT8_SCALE, y.z * pg8::ACT8_SCALE, y.w * pg8::ACT8_SCALE); continue; }
            o8[64 * j] = (unsigned long long)cvtpk(y.x, y.y) | ((unsigned long long)cvtpk(y.z, y.w) << 32);
            if (off == 3 * DM) *(unsigned*)(a.ws + WS_X8 + ((size_t)(2 * j + (lane >> 5)) * ML + m) * 128 + (4 * lane & 127)) = i8_pack4(y, XQ_SCALE); }
    }
}
__device__ __forceinline__ void final_norm_phase(const Ctx& F0, const Args& a) {
    const Ctx F = fresh(F0);
    const int gwv = F.vcu * NWAVES + F.wave, NGW = F.G * NWAVES;
    const float* gw = a.in[16];
    for (int m = gwv; m < ML; m += NGW) {
        f32x4* xr = (f32x4*)(a.out + (size_t)m * DM) + F.lane;
        f32x4 v[4]; float s = 0.f;
#pragma unroll
        for (int j = 0; j < 4; ++j) { v[j] = xr[64 * j]; s += (v[j].x * v[j].x + v[j].y * v[j].y) + (v[j].z * v[j].z + v[j].w * v[j].w); }
        const float rstd = 1.0f / sqrtf(wave_sum(s) * (1.0f / DM) + EPS);
#pragma unroll
        for (int j = 0; j < 4; ++j) xr[64 * j] = v[j] * rstd * ((const f32x4*)gw)[F.lane + 64 * j];
    }
}

constexpr int ATT_ROWB = 144, ATT_KTILEB = 128 * ATT_ROWB, ATT_VROWB = 272, ATT_VTILEB = 64 * ATT_VROWB, ATT_BIAS_B = 2048, ATT_K0 = ATT_BIAS_B, ATT_V0 = ATT_K0 + 2 * ATT_KTILEB;
constexpr float ATT_THR = 8.0f;
template <int NGH, bool LATENT>
__device__ __forceinline__ void attn_sub(const LAS unsigned char* Kt, const LAS unsigned char* Vt_, int ko, const LAS float* browA, const LAS float* browB, const int (&relidx)[8],
                                         const bf16x8 (&qf)[2], float& m_ref, float& l_run, f32x4 (&o)[4], int q16, int g4) {
    constexpr int NG = 2 * NGH;
    bf16x8 kf[2 * NG][2]; u32x2 vf[4][NG][2]; f32x4 sc[2 * NG];
#pragma unroll
    for (int gk = 0; gk < NG; ++gk)
#pragma unroll
        for (int b2 = 0; b2 < 2; ++b2)
#pragma unroll
            for (int ks = 0; ks < 2; ++ks) kf[2 * gk + b2][ks] = *(const LAS bf16x8*)(Kt + ((gk / NGH) * 64 + ko + 32 * (gk % NGH) + 16 * b2 + q16) * ATT_ROWB + 64 * ks + 16 * g4);
#pragma unroll
    for (int d = 0; d < 4; ++d)
#pragma unroll
        for (int gk = 0; gk < NG; ++gk) { const LAS unsigned char* vp = Vt_ + (16 * d + q16) * ATT_VROWB + 2 * ((gk / NGH) * 64 + ko + 32 * (gk % NGH) + 4 * g4);
            vf[d][gk][0] = *(const LAS u32x2*)vp; vf[d][gk][1] = *(const LAS u32x2*)(vp + 32); }
    if (LATENT) {
#pragma unroll
        for (int kk = 0; kk < 8; ++kk) { sc[kk >> 2][kk & 3] = browA[relidx[kk]] - m_ref; sc[2 + (kk >> 2)][kk & 3] = browB[relidx[kk]] - m_ref; }
    } else {
#pragma unroll
        for (int blk = 0; blk < 2 * NG; ++blk) sc[blk] = (f32x4){-m_ref, -m_ref, -m_ref, -m_ref};
    }
#pragma unroll
    for (int blk = 0; blk < 2 * NG; ++blk)
#pragma unroll
        for (int ks = 0; ks < 2; ++ks) sc[blk] = __builtin_amdgcn_mfma_f32_16x16x32_bf16(kf[blk][ks], qf[ks], sc[blk], 0, 0, 0);
    float mx = fmaxf(fmaxf(sc[0][0], sc[0][1]), fmaxf(sc[0][2], sc[0][3]));
#pragma unroll
    for (int blk = 1; blk < 2 * NG; ++blk) mx = fmaxf(mx, fmaxf(fmaxf(sc[blk][0], sc[blk][1]), fmaxf(sc[blk][2], sc[blk][3])));
    if (__builtin_amdgcn_ballot_w64(mx > ATT_THR) != 0ull) {
        mx = fmaxf(mx, __shfl_xor(mx, 16)); mx = fmaxf(mx, __shfl_xor(mx, 32));
        const float dl = mx > ATT_THR ? mx : 0.f;
        m_ref += dl;
        const float al = __builtin_amdgcn_exp2f(-dl);
        l_run *= al;
#pragma unroll
        for (int d = 0; d < 4; ++d) o[d] *= al;
#pragma unroll
        for (int blk = 0; blk < 2 * NG; ++blk) sc[blk] -= dl;
    }
    float ls0 = 0.f, ls1 = 0.f;
#pragma unroll
    for (int blk = 0; blk < 2 * NG; ++blk)
#pragma unroll
        for (int i = 0; i < 4; ++i) { const float e = __builtin_amdgcn_exp2f(sc[blk][i]); sc[blk][i] = e; if (blk & 1) ls1 += e; else ls0 += e; }
    l_run += ls0 + ls1;
    bf16x8 pf[NG];
#pragma unroll
    for (int gk = 0; gk < NG; ++gk) { u32x4 pw; pw.x = cvtpk(sc[2 * gk][0], sc[2 * gk][1]); pw.y = cvtpk(sc[2 * gk][2], sc[2 * gk][3]); pw.z = cvtpk(sc[2 * gk + 1][0], sc[2 * gk + 1][1]); pw.w = cvtpk(sc[2 * gk + 1][2], sc[2 * gk + 1][3]);
        pf[gk] = __builtin_bit_cast(bf16x8, pw); }
#pragma unroll
    for (int gk = 0; gk < NG; ++gk)
#pragma unroll
        for (int d = 0; d < 4; ++d) { u32x4 vw; vw.x = vf[d][gk][0].x; vw.y = vf[d][gk][0].y; vw.z = vf[d][gk][1].x; vw.w = vf[d][gk][1].y;
            o[d] = __builtin_amdgcn_mfma_f32_16x16x32_bf16(__builtin_bit_cast(bf16x8, vw), pf[gk], o[d], 0, 0, 0); }
}
__device__ __forceinline__ void attn_phase(const Ctx& F0, const Args& a) {
    const Ctx F = fresh(F0);
    const bf16_t* QK = (const bf16_t*)(a.ws + WS_QK);
    const bf16_t* VT = (const bf16_t*)(a.ws + WS_VT);
    unsigned char* AO = a.ws + WS_HX + 36 * MiB;
    const float* rpb = a.in[10];
    LAS float* bias = (LAS float*)F.lds;
    const int tid = F.tid, lane = F.lane, q16 = lane & 15, g4 = lane >> 4;
    const int rr = F.wave >> 2, jt = F.wave & 3;
    const int qc = 16 * jt + q16, cs = min(max(qc - 8, 0), 48), ksj = min(max(16 * jt - 8, 0), 32);
    int relidx[8];
#pragma unroll
    for (int k = 0; k < 8; ++k) { const int kc = ksj + 16 * (k >> 2) + 4 * g4 + (k & 3); relidx[k] = (kc >= cs && kc < cs + 16) ? (kc - qc + 15) : 31; }
    const int krow = tid >> 3, kch = tid & 7, vrow = tid >> 4, vch = tid & 15;
    const unsigned lds_k = (unsigned)(krow * ATT_ROWB + kch * 16), lds_v = (unsigned)(vrow * ATT_VROWB + vch * 16);
    const int nunits = NB * 16 * 32, upb = (nunits + F.G - 1) / F.G;
    int cur_bh = -1;
    for (int k = 0; k < upb; ++k) {
        const int id = F.vcu * upb + k; if (id >= nunits) break;
        const int p = id & 31, bh = id >> 5, b = bh >> 4, h = bh & 15;
        if (bh != cur_bh) {
            __syncthreads();
            for (int i = tid; i < 16 * 32; i += 512) { const int dr = i >> 5, dc = i & 31; bias[i] = (dc < 31 && dr < 15) ? rpb[(h * 15 + dr) * 31 + dc] * LOG2E : -1e30f; }
            cur_bh = bh;
        }
        const int r0 = 2 * p, rs0 = min(max(r0 - 4, 0), 56), rs1 = min(max(r0 + 1 - 4, 0), 56);
        const int nlat = rs1 + 8 - rs0, nlt = (nlat + 1) >> 1, nsteps = nlt + 2;
        const int r = r0 + rr, rs = rr ? rs1 : rs0;
        const long tokq = (long)b * SEQ + r * GW + qc;
        const bf16_t* kbase = QK + 1024 + h * 64 + kch * 8;
        const bf16_t* vbase = VT + (long)(h * 64 + vrow) * MT + (vch & 7) * 8;
#define ATT_TOKA(step) ((step) < nlt ? ((long)b * SEQ + (long)(rs0 + 2 * (step)) * GW) : ((long)ML + b * CTXL + ((step) - nlt) * 128))
#define ATT_TOKB(step) ((step) < nlt ? ((long)b * SEQ + (long)min(rs0 + 2 * (step) + 1, rs0 + nlat - 1) * GW) : ((long)ML + b * CTXL + ((step) - nlt) * 128 + 64))
        u32x4 kA[2], vA[2], kB[2], vB[2];
#define ATT_LOAD(step, kr_, vr_) do { const int st_ = (step) < nsteps ? (step) : nsteps - 1; const long ta_ = ATT_TOKA(st_), tb_ = ATT_TOKB(st_);     \
        kr_[0] = *(const u32x4*)(kbase + (ta_ + krow) * 2048); kr_[1] = *(const u32x4*)(kbase + (tb_ + krow) * 2048); \
        const long tv_ = (vch < 8) ? ta_ : tb_; vr_[0] = *(const u32x4*)(vbase + tv_); vr_[1] = *(const u32x4*)(vbase + (long)32 * MT + tv_); } while (0)
#define ATT_WRITE(buf, kr_, vr_) do { *(LAS u32x4*)(F.lds + ATT_K0 + (buf) * ATT_KTILEB + lds_k) = kr_[0]; *(LAS u32x4*)(F.lds + ATT_K0 + (buf) * ATT_KTILEB + 64 * ATT_ROWB + lds_k) = kr_[1]; \
        *(LAS u32x4*)(F.lds + ATT_V0 + (buf) * ATT_VTILEB + lds_v) = vr_[0]; *(LAS u32x4*)(F.lds + ATT_V0 + (buf) * ATT_VTILEB + 32 * ATT_VROWB + lds_v) = vr_[1]; } while (0)
        ATT_LOAD(0, kA, vA); ATT_LOAD(1, kB, vB);
        bf16x8 qf[2];
#pragma unroll
        for (int ks = 0; ks < 2; ++ks) qf[ks] = *(const bf16x8*)(QK + tokq * 2048 + h * 64 + 32 * ks + 8 * g4);
        float m_ref = 0.f, l_run = 0.f;
        f32x4 o[4];
#pragma unroll
        for (int d = 0; d < 4; ++d) o[d] = (f32x4){0.f, 0.f, 0.f, 0.f};
        __syncthreads();
        ATT_WRITE(0, kA, vA);
        asm volatile("" :: "v"(qf[0]), "v"(qf[1]));
        __syncthreads();
#define ATT_COMPUTE(step, cur) do { \
            const LAS unsigned char* Kt = F.lds + ATT_K0 + (cur) * ATT_KTILEB; \
            const LAS unsigned char* Vt_ = F.lds + ATT_V0 + (cur) * ATT_VTILEB; \
            if ((step) < nlt) { const int krA = rs0 + 2 * (step), krB = krA + 1; \
                const bool actA = krA >= rs && krA < rs + 8, actB = krB < rs0 + nlat && krB >= rs && krB < rs + 8; \
                if (actA || actB) attn_sub<1, true>(Kt, Vt_, ksj, bias + (actA ? (krA - r + 7) : 15) * 32, bias + (actB ? (krB - r + 7) : 15) * 32, relidx, qf, m_ref, l_run, o, q16, g4); \
            } else attn_sub<2, false>(Kt, Vt_, 0, bias, bias, relidx, qf, m_ref, l_run, o, q16, g4); \
        } while (0)
        for (int step = 0; step < nsteps; step += 2) {
            ATT_COMPUTE(step, 0);
            if (step + 1 < nsteps) ATT_WRITE(1, kB, vB);
            ATT_LOAD(step + 2, kA, vA);
            __syncthreads();
            if (step + 1 < nsteps) { ATT_COMPUTE(step + 1, 1); }
            if (step + 2 < nsteps) ATT_WRITE(0, kA, vA);
            ATT_LOAD(step + 3, kB, vB);
            __syncthreads();
        }
#undef ATT_LOAD
#undef ATT_WRITE
#undef ATT_COMPUTE
#undef ATT_TOKA
#undef ATT_TOKB
        l_run += __shfl_xor(l_run, 16); l_run += __shfl_xor(l_run, 32);
        const float linv = 1.0f / l_run;
        unsigned char* op = AO + tokq * DM + h * 64 + 4 * g4; const float ls = linv * pg8::ACT8_SCALE;
#pragma unroll
        for (int d = 0; d < 4; ++d) *(unsigned*)(op + 16 * d) = fp8_pack4(o[d][0] * ls, o[d][1] * ls, o[d][2] * ls, o[d][3] * ls);
    }
    __syncthreads();
}

__device__ __forceinline__ void ce_desc(float& a, float& b) { const float hi = fmaxf(a, b), lo = fminf(a, b); a = hi; b = lo; }
__device__ __forceinline__ void ce_dir(float& a, float& b, bool desc) { const float hi = fmaxf(a, b), lo = fminf(a, b); a = desc ? hi : lo; b = desc ? lo : hi; }
__device__ __forceinline__ void sort16_desc(float (&v)[16]) {
#pragma unroll
    for (int k = 2; k <= 16; k <<= 1)
#pragma unroll
        for (int j = k >> 1; j > 0; j >>= 1)
#pragma unroll
            for (int i = 0; i < 16; ++i) { const int l = i ^ j; if (l > i) ce_dir(v[i], v[l], (i & k) == 0); }
}
__device__ __forceinline__ void merge16_desc(float (&a)[16], const float (&b)[16]) {
#pragma unroll
    for (int i = 0; i < 16; ++i) a[i] = fmaxf(a[i], b[15 - i]);
#pragma unroll
    for (int j = 8; j > 0; j >>= 1)
#pragma unroll
        for (int i = 0; i < 16; ++i) { const int l = i ^ j; if (l > i) ce_desc(a[i], a[l]); }
}

struct CandTab { int i[64]; int j[64]; };
__host__ __device__ constexpr CandTab make_cand_tab() {
    CandTab t{}; int n = 0;
    for (int i = 0; i < 16; ++i) for (int j = 0; j < 16; ++j) if ((i + 1) * (j + 1) <= 16) { t.i[n] = i; t.j[n] = j; ++n; }
    for (; n < 64; ++n) { t.i[n] = -1; t.j[n] = -1; }
    return t;
}

__device__ __forceinline__ void peer_topk_phase(const Ctx& F0, const Args& a, int layer) {
    const Ctx F = fresh(F0);
    const bf16_t* QP = (const bf16_t*)(a.ws + WS_QK);
    const bf16_t* SK = (const bf16_t*)(a.ws + WS_SK) + (size_t)layer * 2 * 128 * 128;
    unsigned short* IDX = (unsigned short*)(a.ws + WS_IDX);
    float* GATE = (float*)(a.ws + WS_GATE);
    const int gwv = F.vcu * NWAVES + F.wave, NGW = F.G * NWAVES;
    const int lane = F.lane, t32 = lane & 31, hi = lane >> 5;
    __syncthreads();
    for (int c = F.tid; c < 4096; c += 512) *(LAS u32x4*)(F.lds + (c >> 4) * 272 + (c & 15) * 16) = *(const u32x4*)(SK + (size_t)c * 8);
    __syncthreads();
    for (int task = gwv; task < 1024 * 8; task += NGW) {
        const int tt = task >> 3, h = task & 7;
        const long tok = (long)tt * 32 + t32;
        float top[2][16];
#pragma unroll
        for (int p = 0; p < 2; ++p) {
            f32x16 acc[4];
#pragma unroll
            for (int eb = 0; eb < 4; ++eb)
#pragma unroll
                for (int i = 0; i < 16; ++i) acc[eb][i] = 0.f;
#pragma unroll
            for (int eb = 0; eb < 4; ++eb) asm volatile("" : "+v"(acc[eb]));
            const bf16_t* qp = QP + tok * 2048 + h * 256 + p * 128 + hi * 8;
            const LAS unsigned char* kp = F.lds + (p * 128 + t32) * 272 + hi * 16;
#pragma unroll
            for (int ks = 0; ks < 8; ++ks) {
                if ((ks & 1) == 0) asm volatile("" ::: "memory");
                const bf16x8 bq = *(const bf16x8*)(qp + ks * 16);
#pragma unroll
                for (int eb = 0; eb < 4; ++eb) { const bf16x8 ak = *(const LAS bf16x8*)(kp + eb * 32 * 272 + ks * 32); acc[eb] = __builtin_amdgcn_mfma_f32_32x32x16_bf16(ak, bq, acc[eb], 0, 0, 0); }
            }
            float cur[16];
#pragma unroll
            for (int eb = 0; eb < 4; ++eb) {
                float v[16];
#pragma unroll
                for (int i = 0; i < 16; ++i) { const unsigned e = 32 * eb + crow(i, hi); float x = acc[eb][i]; asm volatile("" : "+v"(x));
                    v[i] = __builtin_bit_cast(float, (__builtin_bit_cast(unsigned, x) & ~0x7Fu) | e); }
                sort16_desc(v);
                if (eb == 0) {
#pragma unroll
                    for (int i = 0; i < 16; ++i) cur[i] = v[i];
                } else merge16_desc(cur, v);
            }
            float oth[16];
#pragma unroll
            for (int i = 0; i < 16; ++i) oth[i] = __shfl_xor(cur[i], 32);
            merge16_desc(cur, oth);
#pragma unroll
            for (int i = 0; i < 16; ++i) top[p][i] = cur[i];
            __builtin_amdgcn_sched_barrier(0);
        }
        float best[16];
#pragma unroll
        for (int gI = 0; gI < 4; ++gI) {
            float v[16];
#pragma unroll
            for (int q = 0; q < 16; ++q) {
                constexpr CandTab CT = make_cand_tab();
                const int ci = CT.i[16 * gI + q], cj = CT.j[16 * gI + q];
                if (ci >= 0) {
                    const unsigned ua = __builtin_bit_cast(unsigned, top[0][ci]), ub = __builtin_bit_cast(unsigned, top[1][cj]);
                    float s = top[0][ci] + top[1][cj]; asm volatile("" : "+v"(s));
                    const unsigned code = ((ua & 0x7Fu) << 7) | (ub & 0x7Fu);
                    v[q] = __builtin_bit_cast(float, (__builtin_bit_cast(unsigned, s) & ~0x3FFFu) | code);
                } else v[q] = -3.0e38f;
            }
            sort16_desc(v);
            if (gI == 0) {
#pragma unroll
                for (int i = 0; i < 16; ++i) best[i] = v[i];
            } else merge16_desc(best, v);
            __builtin_amdgcn_sched_barrier(0);
        }
        float e[16], sum = 0.f;
#pragma unroll
        for (int i = 0; i < 16; ++i) { e[i] = __builtin_amdgcn_exp2f((best[i] - best[0]) * LOG2E); sum += e[i]; }
        const float inv = 1.0f / sum;
        if (hi == 0) {
            u32x4 w0, w1;
            w0.x = (__builtin_bit_cast(unsigned, best[0]) & 0x3FFFu) | ((__builtin_bit_cast(unsigned, best[1]) & 0x3FFFu) << 16);
            w0.y = (__builtin_bit_cast(unsigned, best[2]) & 0x3FFFu) | ((__builtin_bit_cast(unsigned, best[3]) & 0x3FFFu) << 16);
            w0.z = (__builtin_bit_cast(unsigned, best[4]) & 0x3FFFu) | ((__builtin_bit_cast(unsigned, best[5]) & 0x3FFFu) << 16);
            w0.w = (__builtin_bit_cast(unsigned, best[6]) & 0x3FFFu) | ((__builtin_bit_cast(unsigned, best[7]) & 0x3FFFu) << 16);
            w1.x = (__builtin_bit_cast(unsigned, best[8]) & 0x3FFFu) | ((__builtin_bit_cast(unsigned, best[9]) & 0x3FFFu) << 16);
            w1.y = (__builtin_bit_cast(unsigned, best[10]) & 0x3FFFu) | ((__builtin_bit_cast(unsigned, best[11]) & 0x3FFFu) << 16);
            w1.z = (__builtin_bit_cast(unsigned, best[12]) & 0x3FFFu) | ((__builtin_bit_cast(unsigned, best[13]) & 0x3FFFu) << 16);
            w1.w = (__builtin_bit_cast(unsigned, best[14]) & 0x3FFFu) | ((__builtin_bit_cast(unsigned, best[15]) & 0x3FFFu) << 16);
            u32x4* ip = (u32x4*)(IDX + tok * 128 + h * 16);
            ip[0] = w0; ip[1] = w1;
        } else {
            f32x4* gp = (f32x4*)(GATE + tok * 128 + h * 16);
#pragma unroll
            for (int q = 0; q < 4; ++q) gp[q] = (f32x4){e[4 * q] * inv, e[4 * q + 1] * inv, e[4 * q + 2] * inv, e[4 * q + 3] * inv};
        }
    }
    __syncthreads();
}

typedef long i64_t;
typedef unsigned u32x8_t __attribute__((ext_vector_type(8)));
typedef _Float16 h2_t __attribute__((ext_vector_type(2)));
template <int CTRL> __device__ __forceinline__ float dpp_f(float v) { return __builtin_bit_cast(float, __builtin_amdgcn_update_dpp(0, __builtin_bit_cast(int, v), CTRL, 0xF, 0xF, true)); }
__device__ __forceinline__ void peer_u_phase(const Ctx& F0, const Args& a, int layer) {
    const Ctx F = fresh(F0);
    const int s = (int)(blockIdx.x & 7), j = (int)(blockIdx.x >> 3), nmem = F.G >> 3;
    const unsigned char* U8s = a.ws + WS_TAB + (size_t)layer * TAB_LAYER + (size_t)s * NEXP * 64;
    const unsigned char* X8s = a.ws + WS_X8 + (size_t)s * ML * 128;
    const unsigned short* IDX = (const unsigned short*)(a.ws + WS_IDX);
    unsigned* PART = (unsigned*)(a.ws + WS_PART) + (size_t)s * ML * 64;
    const int lane = F.lane, r16 = lane >> 2, c4 = lane & 3;
    const bool c1 = (lane & 2) != 0, c0 = (lane & 1) != 0;
    const int t0 = j * NWAVES + F.wave, stride = nmem * NWAVES, ntok = (ML - t0 + stride - 1) / stride;
#define U_TOK(i) ((size_t)(t0 + ((i) < ntok ? (i) : ntok - 1) * stride))
#define U_EID(iv, k) (((k) & 1) ? (iv[(k) >> 1] >> 16) : (iv[(k) >> 1] & 0xffffu))
#define U_LDI(dst, i) do { dst = *(const u32x4*)(IDX + U_TOK(i) * 128 + 8 * r16); } while (0)
#define U_LDX(dst, i) do { const unsigned char* xp_ = X8s + U_TOK(i) * 128 + 32 * c4; dst[0] = *(const u32x4*)xp_; dst[1] = *(const u32x4*)(xp_ + 16); } while (0)
#define U_LDR(Rset, iv) do { _Pragma("unroll") for (int k = 0; k < 8; ++k) Rset[k] = *(const u32x4*)(U8s + (unsigned)(U_EID(iv, k) * 64 + 16 * c4)); } while (0)
#define U_TOKEN(Rset, iref, xv, i) do { \
        unsigned xlo[4], xhi[4]; int sx = 0; \
        _Pragma("unroll") for (int d = 0; d < 4; ++d) { const unsigned n0 = (d < 2) ? xv[0][2 * d] : xv[1][2 * d - 4], n1 = (d < 2) ? xv[0][2 * d + 1] : xv[1][2 * d - 3]; \
            xlo[d] = __builtin_amdgcn_perm(n1, n0, 0x06040200u); xhi[d] = __builtin_amdgcn_perm(n1, n0, 0x07050301u); \
            sx = __builtin_amdgcn_sdot4((int)n0, 0x01010101, sx, false); sx = __builtin_amdgcn_sdot4((int)n1, 0x01010101, sx, false); } \
        float v[8]; \
        _Pragma("unroll") for (int k = 0; k < 8; ++k) { \
            u32x4 r_ = Rset[k]; asm volatile("" : "+v"(r_)); \
            int acc_ = 0; \
            _Pragma("unroll") for (int d = 0; d < 4; ++d) { acc_ = __builtin_amdgcn_sdot4((int)(r_[d] & 0x0F0F0F0Fu), (int)xlo[d], acc_, false); acc_ = __builtin_amdgcn_sdot4((int)((r_[d] >> 4) & 0x0F0F0F0Fu), (int)xhi[d], acc_, false); } \
            v[k] = (float)(acc_ - 8 * sx); \
            asm volatile("" : "+v"(v[k])); \
            Rset[k] = *(const u32x4*)(U8s + (unsigned)(U_EID(iref, k) * 64 + 16 * c4)); \
        } \
        float a4[4], a2[2]; \
        _Pragma("unroll") for (int k = 0; k < 4; ++k) { const float keep = c1 ? v[k + 4] : v[k], send = c1 ? v[k] : v[k + 4]; a4[k] = keep + dpp_f<0x4E>(send); } \
        _Pragma("unroll") for (int k = 0; k < 2; ++k) { const float keep = c0 ? a4[k + 2] : a4[k], send = c0 ? a4[k] : a4[k + 2]; a2[k] = keep + dpp_f<0xB1>(send); } \
        if ((i) < ntok) PART[U_TOK(i) * 64 + lane] = cvtpk(a2[0], a2[1]); \
    } while (0)
    u32x4 iA, iB, iC, iA2, iB2, iC2, RA[8], RB[8], RC[8], xA[2], xB[2], xC[2], xA2[2], xB2[2], xC2[2];
    U_LDI(iA, 0); U_LDI(iB, 1); U_LDI(iC, 2); U_LDX(xA, 0); U_LDX(xB, 1); U_LDX(xC, 2);
    U_LDR(RA, iA); U_LDR(RB, iB); U_LDR(RC, iC);
    U_LDI(iA, 3); U_LDI(iB, 4); U_LDI(iC, 5);
    asm volatile("" :: "v"(xA[0]), "v"(xA[1]), "v"(RA[0]), "v"(RA[1]), "v"(RA[2]), "v"(RA[3]), "v"(RA[4]), "v"(RA[5]), "v"(RA[6]), "v"(RA[7]));
    for (int i = 0; i < ntok; i += 3) {
        U_LDI(iA2, i + 6); U_LDI(iB2, i + 7); U_LDI(iC2, i + 8); U_LDX(xA2, i + 3); U_LDX(xB2, i + 4); U_LDX(xC2, i + 5);
        U_TOKEN(RA, iA, xA, i);
        U_TOKEN(RB, iB, xB, i + 1);
        U_TOKEN(RC, iC, xC, i + 2);
        iA = iA2; iB = iB2; iC = iC2; xA[0] = xA2[0]; xA[1] = xA2[1]; xB[0] = xB2[0]; xB[1] = xB2[1]; xC[0] = xC2[0]; xC[1] = xC2[1];
    }
#undef U_LDI
#undef U_LDX
#undef U_LDR
#undef U_TOKEN
#undef U_TOK
#undef U_EID
}
__device__ __forceinline__ void peer_w_phase(const Ctx& F0, const Args& a) {
    const Ctx F = fresh(F0);
    const unsigned* PART = (const unsigned*)(a.ws + WS_PART);
    const float* GATE = (const float*)(a.ws + WS_GATE);
    unsigned char* WQ = a.ws + WS_WT;
    float* WSC = (float*)(a.ws + WS_WSC);
    const int gwv = F.vcu * NWAVES + F.wave, NGW = F.G * NWAVES;
    for (int t = gwv; t < ML; t += NGW) {
        f32x2 z = (f32x2){0.f, 0.f};
#pragma unroll
        for (int s = 0; s < 8; ++s) { const unsigned pw = PART[((size_t)s * ML + t) * 64 + F.lane]; z += (f32x2){bflo(pw), bfhi(pw)}; }
        const f32x2 g = *(const f32x2*)(GATE + (size_t)t * 128 + 2 * F.lane);
        f32x2 w; w.x = g.x * gelu_erf(z.x * (1.0f / (U_SCALE * XQ_SCALE))); w.y = g.y * gelu_erf(z.y * (1.0f / (U_SCALE * XQ_SCALE)));
        float wm = fmaxf(__builtin_fabsf(w.x), __builtin_fabsf(w.y));
#pragma unroll
        for (int o = 1; o < 64; o <<= 1) wm = fmaxf(wm, __shfl_xor(wm, o));
        wm = fmaxf(wm, 1e-20f);
        const float qs = 6.0f / wm, ax = fminf(fmaxf(w.x * qs, -6.f), 6.f), ay = fminf(fmaxf(w.y * qs, -6.f), 6.f);
        const unsigned ph = __builtin_amdgcn_cvt_scalef32_pk_fp4_f32(0u, ax, ay, 1.0f, 0) & 0xffu;
        const f32x2 dh = FP4_DEC(ph, 0);
        const unsigned pl = __builtin_amdgcn_cvt_scalef32_pk_fp4_f32(0u, fminf(fmaxf(4.f * (ax - dh.x), -6.f), 6.f), fminf(fmaxf(4.f * (ay - dh.y), -6.f), 6.f), 1.0f, 0) & 0xffu;
        ((unsigned short*)WQ)[(size_t)t * 128 + F.lane] = (unsigned short)((ph & 0xfu) | ((ph & 0xf0u) << 4));
        ((unsigned short*)WQ)[(size_t)t * 128 + 64 + F.lane] = (unsigned short)((pl & 0xfu) | ((pl & 0xf0u) << 4));
        if (F.lane == 0) WSC[t] = wm * (1.0f / 6.0f);
    }
}
#define V_MFMA4_FIRST(acc, av, bv, sa) asm volatile("v_mfma_scale_f32_16x16x128_f8f6f4 %0, %1, %2, 0, %3, %4 op_sel_hi:[0,0,0] cbsz:4 blgp:4" : "=&v"(acc) : "v"(av), "v"(bv), "v"(sa), "v"(sc_one))
#define V_MFMA4(acc, av, bv, sa) asm volatile("v_mfma_scale_f32_16x16x128_f8f6f4 %0, %1, %2, %0, %3, %4 op_sel_hi:[0,0,0] cbsz:4 blgp:4" : "+v"(acc) : "v"(av), "v"(bv), "v"(sa), "v"(sc_one))
template <int VAR = 0>
__device__ __forceinline__ void peer_v_phase(const Ctx& F0, const Args& a, int layer, float oscale = 1.0f) {
    const Ctx F = fresh(F0);
    const int s = (int)(blockIdx.x & 3), half = (int)((blockIdx.x >> 2) & 1), j = (int)(blockIdx.x >> 3), nmem = F.G >> 3;
    const unsigned char* V4s = a.ws + WS_TAB + (size_t)layer * TAB_LAYER + TAB_VOFF + (size_t)s * NEXP * 128;
    const unsigned short* IDX = (const unsigned short*)(a.ws + WS_IDX);
    const unsigned char* WQ = a.ws + WS_WT;
    const float* WSC = (const float*)(a.ws + WS_WSC);
    const float* modb = (const float*)(a.ws + WS_MOD) + (size_t)layer * 9 * NMOD;
    float* X = a.out;
    const int lane = F.lane, rsub = lane >> 3, c8 = lane & 7, n16 = lane & 15, g4 = lane >> 4;
    LAS unsigned char* tile = F.lds + F.wave * 16384;
    const float osc = ((DBG_SKIP & (layer == 0 ? 2 : 8)) ? 0.f : oscale) * (1.0f / V_SCALE);
    constexpr int MLH = ML / 2;
    const int t0 = half * MLH + j * NWAVES + F.wave, stride = nmem * NWAVES, ntok = (half * MLH + MLH - t0 + stride - 1) / stride;
    unsigned sc_one = 0x7f7f7f7fu, sc_lo = 0x7d7d7d7du; asm volatile("" : "+v"(sc_one), "+v"(sc_lo));
    typedef int v2i_t __attribute__((ext_vector_type(2)));
    LAS float* gl = (LAS float*)(F.lds + RING_BYTES + 4096);
    for (int u = F.tid; u < 4 * 256; u += NWAVES * 64) gl[u] = modb[(size_t)(4 * half + (u >> 8)) * NMOD + 5 * DM + 256 * s + (u & 255)] * osc;
    __syncthreads();
#define V_TOK(i) ((size_t)(t0 + ((i) < ntok ? (i) : ntok - 1) * stride))
    LAS unsigned char* wx[4]; LAS unsigned char* rb[8];
#pragma unroll
    for (int k = 0; k < 4; ++k) wx[k] = tile + rsub * 2048 + ((c8 ^ k ^ ((rsub & 1) << 2)) << 4);
#pragma unroll
    for (int nb = 0; nb < 8; ++nb) rb[nb] = tile + g4 * 2048 + (n16 >> 1) * 128 + 8 * (n16 & 1) + ((nb ^ ((n16 >> 2) & 3) ^ ((g4 & 1) << 2)) << 4);
    LAS unsigned char* stg = tile + g4 * 1024 + n16 * 8;
#define V_LDW(i) (((const unsigned*)WQ)[V_TOK(i) * 64 + lane])
#define V_LDI(i) (((const unsigned*)IDX)[V_TOK(i) * 64 + lane])
#define V_LDX(i) (*(const f32x4*)(X + V_TOK(i) * DM + 256 * s + 4 * lane))
#define V_LDS(i) (WSC[V_TOK(i)])
#define V_IDP(dst, ci) do { _Pragma("unroll") for (int k = 0; k < 8; ++k) dst[k] = (unsigned)__builtin_amdgcn_ds_bpermute((8 * rsub + k) * 4, (int)(ci)); } while (0)
#define V_EIDP(idp, i_) (((i_) & 1) ? (idp[(i_) >> 1] >> 16) : (idp[(i_) >> 1] & 0xffffu))
#define V_READS(nb0) do { \
        _Pragma("unroll") for (int nb = 0; nb < 4; ++nb) { _Pragma("unroll") for (int h = 0; h < 2; ++h) { _Pragma("unroll") for (int q = 0; q < 2; ++q) { \
            const v2i_t tr = __builtin_amdgcn_ds_read_tr8_b64_v2i32((LAS v2i_t*)(rb[(nb0) + nb] + 8192 * h + 1024 * q)); \
            bw[nb][h][2 * q] = (unsigned)tr[0]; bw[nb][h][2 * q + 1] = (unsigned)tr[1]; } } } \
        __builtin_amdgcn_sched_barrier(0); \
    } while (0)
#define V_MFMAS() do { \
        _Pragma("unroll") for (int nb = 0; nb < 4; ++nb) { V_MFMA4_FIRST(dE[nb], aE[0][0], bw[nb][0], sc_one); V_MFMA4_FIRST(dO[nb], aO[0][0], bw[nb][0], sc_one); } \
        _Pragma("unroll") for (int nb = 0; nb < 4; ++nb) { V_MFMA4(dE[nb], aE[0][1], bw[nb][0], sc_lo); V_MFMA4(dO[nb], aO[0][1], bw[nb][0], sc_lo); } \
        _Pragma("unroll") for (int nb = 0; nb < 4; ++nb) { V_MFMA4(dE[nb], aE[1][0], bw[nb][1], sc_one); V_MFMA4(dO[nb], aO[1][0], bw[nb][1], sc_one); } \
        _Pragma("unroll") for (int nb = 0; nb < 4; ++nb) { V_MFMA4(dE[nb], aE[1][1], bw[nb][1], sc_lo); V_MFMA4(dO[nb], aO[1][1], bw[nb][1], sc_lo); } \
        __builtin_amdgcn_sched_barrier(0); \
    } while (0)
#define V_OUTS(nb0) do { \
        asm volatile("s_nop 15\n\ts_nop 3" : "+v"(dE[0]), "+v"(dE[1]), "+v"(dE[2]), "+v"(dE[3]), "+v"(dO[0]), "+v"(dO[1]), "+v"(dO[2]), "+v"(dO[3]) :: "memory");     \
        _Pragma("unroll") for (int nb = 0; nb < 4; ++nb) { ov[(nb0) + nb] = (f32x2){dE[nb][0], dO[nb][0]}; asm volatile("" : "+v"(ov[(nb0) + nb])); } \
    } while (0)
#define V_BODY(j, CUR, NXT, LD) do { \
        const size_t t_ = V_TOK(j); \
        unsigned idp[8]; \
        V_IDP(idp, ci##NXT);                                             \
          \
        _Pragma("unroll") for (int i_ = 0; i_ < 16; ++i_) { \
            *(LAS u32x4*)(wx[(i_ >> 1) & 3] + i_ * 128) = R[i_]; \
            if (VAR == 0 || (VAR == 1 && i_ < 8)) R[i_] = *(const u32x4*)(V4s + (unsigned)(V_EIDP(idp, i_) * 128 + 16 * c8)); \
        } \
          \
        u32x4 aE[2][2], aO[2][2]; \
        _Pragma("unroll") for (int h = 0; h < 2; ++h) { _Pragma("unroll") for (int tm = 0; tm < 2; ++tm) { _Pragma("unroll") for (int k = 0; k < 4; ++k) { \
            const unsigned w_ = (unsigned)__builtin_amdgcn_ds_bpermute((32 * tm + 16 * h + 4 * g4 + k) * 4, (int)cw##CUR); \
            aE[h][tm][k] = row0 ? w_ : 0u; aO[h][tm][k] = aE[h][tm][k] << 4; } } } \
        asm volatile("s_waitcnt lgkmcnt(0)" ::: "memory");               \
        f32x4 dE[4], dO[4]; u32x4 bw[4][2]; f32x2 ov[8]; \
        V_READS(0); \
        V_MFMAS(); \
          \
        ci##CUR = V_LDI((j) + 3); cw##LD = V_LDW((j) + 2); xo##LD = V_LDX((j) + 2); ws##LD = V_LDS((j) + 2); \
        __builtin_amdgcn_sched_barrier(0); \
        V_READS(4);                                                      \
        V_OUTS(0); \
        V_MFMAS(); \
        V_OUTS(4); \
          \
        _Pragma("unroll") for (int nb = 0; nb < 8; ++nb) *(LAS f32x2*)(stg + nb * 128) = ov[nb]; \
        asm volatile("s_waitcnt lgkmcnt(0)" ::: "memory"); \
        const f32x4 sum = *(const LAS f32x4*)(tile + 16 * lane); \
        const f32x4 gt_ = *(const LAS f32x4*)(gl + ((t_ >> 12) & 3) * 256 + 4 * lane); \
        asm volatile("s_waitcnt lgkmcnt(0)" ::: "memory"); \
        if ((j) < ntok) *(f32x4*)(X + t_ * DM + 256 * s + 4 * lane) = xo##CUR + gt_ * ws##CUR * sum; \
    } while (0)
    u32x4 R[16];
    unsigned cwA, cwB, cwC, ciA, ciB, ciC;
    f32x4 xoA, xoB, xoC;
    float wsA, wsB, wsC;
    const bool row0 = (n16 == 0);
    ciA = V_LDI(0);
    cwA = V_LDW(0); cwB = V_LDW(1); xoA = V_LDX(0); xoB = V_LDX(1); wsA = V_LDS(0); wsB = V_LDS(1);
    { unsigned idp0[8]; V_IDP(idp0, ciA);
#pragma unroll
      for (int i_ = 0; i_ < 16; ++i_) R[i_] = *(const u32x4*)(V4s + (unsigned)(V_EIDP(idp0, i_) * 128 + 16 * c8)); }
    ciB = V_LDI(1); ciC = V_LDI(2);
    cwC = 0u; xoC = (f32x4){0.f, 0.f, 0.f, 0.f}; wsC = 0.f;
    asm volatile("" :: "v"(ciC));
    for (int i = 0; i < ntok; i += 3) {
        V_BODY(i, A, B, C);
        V_BODY(i + 1, B, C, A);
        V_BODY(i + 2, C, A, B);
    }
#undef V_BODY
#undef V_READS
#undef V_MFMAS
#undef V_OUTS
#undef V_LDW
#undef V_LDI
#undef V_LDX
#undef V_LDS
#undef V_IDP
#undef V_EIDP
#undef V_TOK
}
#undef V_MFMA4_FIRST
#undef V_MFMA4

__device__ __forceinline__ void dft_nyquist_rows(const Ctx& F0, const Args& a) {
    const Ctx F = fresh(F0);
    const unsigned char* Yt = a.ws + WS_QK;
    unsigned char* Fo = a.ws + WS_VT;
    const int gwv = F.vcu * NWAVES + F.wave, NGW = F.G * NWAVES;
    for (int o = gwv; o < NB * DM; o += NGW) {
        const unsigned char* src = Yt + (size_t)o * 8192;
        float s = 0.f;
#pragma unroll
        for (int it = 0; it < 4; ++it) { const u32x4 v = *(const u32x4*)(src + it * 1024 + F.lane * 16);
#pragma unroll
            for (int d = 0; d < 4; ++d) { const f32x2 lo = __builtin_amdgcn_cvt_pk_f32_fp8((int)v[d], false), hi = __builtin_amdgcn_cvt_pk_f32_fp8((int)v[d], true); s += (lo[0] - lo[1]) + (hi[0] - hi[1]); } }
        s = wave_sum(s) * (pg8::ACT8_SCALE / (64.0f * pg8::YT_SCALE));
        if (F.lane == 0) Fo[((size_t)(o >> 10) * SEQ + 2048) * DM + (o & 1023)] = (unsigned char)(fp8_pack4(s, 0.f, 0.f, 0.f) & 0xffu);
    }
}

__global__ void __launch_bounds__(NWAVES * 64, 2) fwd_kernel(Args args) {
    extern __shared__ __attribute__((aligned(16))) unsigned char lds_raw[];
    Ctx F;
    F.lds = (LAS unsigned char*)lds_raw;
    F.tid = threadIdx.x; F.lane = F.tid & 63; F.wave = __builtin_amdgcn_readfirstlane(F.tid >> 6);
    F.G = gridDim.x; { const int bx = blockIdx.x; F.vcu = (F.G % 8 == 0) ? (bx % 8) * (F.G / 8) + bx / 8 : bx; }
    volatile LAS unsigned* MISC = (volatile LAS unsigned*)(F.lds + MISC_OFF);
    for (int u = F.tid; u < (LDS_BYTES - LDSCTL_OFF) / 4; u += NWAVES * 64) ((LAS unsigned*)(F.lds + LDSCTL_OFF))[u] = 0u;
    __syncthreads();
    unsigned char* ws = args.ws;
    XcdBarrier bar = xcd_barrier_post((unsigned*)(ws + WS_CTL) + CW_BAR, MISC + 8);
#define GRID_BAR() xcd_barrier(bar)
#ifndef DBG_REP
#define DBG_REP 0
#endif
#ifndef DBG_VVAR
#define DBG_VVAR 0
#endif
#define REP(k, ...) do { __VA_ARGS__; if (DBG_REP == (k)) { GRID_BAR(); __VA_ARGS__; } } while (0)
#define PEER_BLOCK(layer) do { \
        norm_phase(F, args, 1, layer, 3 * DM, args.in[5] + (layer) * DM); \
        GRID_BAR(); \
        { using SHq = pg8::Shape<ML, 2048, DM, DM, DM, 1, 0, 0>; \
          REP(7, pg8::gemm_phase<SHq>(F.lds, pg8::Gemm{HX, (const bf16_t*)(ws + WS_WPQ) + (size_t)(layer) * 2048 * DM}, F.G, bx, pg8::EpiStoreBf16{QKb, 2048, 0, 0, 1.0f})); } \
        GRID_BAR(); \
        REP(8, peer_topk_phase(F, args, layer)); \
        GRID_BAR(); \
        REP(9, peer_u_phase(F, args, layer)); \
        GRID_BAR(); \
        REP(10, peer_w_phase(F, args)); \
        GRID_BAR(); \
        peer_v_phase(F, args, layer); if (DBG_REP == 11) { GRID_BAR(); peer_v_phase<DBG_VVAR>(F, args, layer, 0.f); } \
        GRID_BAR(); \
    } while (0)
    const float* modb = (const float*)(ws + WS_MOD);
    bf16_t* HX = (bf16_t*)(ws + WS_HX);
    bf16_t* QKb = (bf16_t*)(ws + WS_QK);
    bf16_t* VTb = (bf16_t*)(ws + WS_VT);
    const bf16_t* Wqkv = (const bf16_t*)(ws + WS_WQKV);
    const int bx = (int)blockIdx.x;

    REP(1, p0_prologue(F, args));
    GRID_BAR();
    REP(2, norm_phase(F, args, 0, 0, 0, args.in[4]));
    GRID_BAR();
    {
        constexpr float o8 = 1.0f / (pg8::ACT8_SCALE * pg8::W8_SCALE);
        using SH1 = pg8::Shape<MT, 2048, DM / 2, DM / 2, DM / 2, 1, 0, 0>;
        pg8::gemm_phase<SH1, pg8::EpiStoreBf16, true>(F.lds, pg8::Gemm{HX, Wqkv}, F.G, bx, pg8::EpiStoreBf16{QKb, 2048, 0, 1024, 0.125f * LOG2E, o8});
        using SH2 = pg8::Shape<DM, MT, DM / 2, DM / 2, DM / 2, 1, 0, 0>;
        pg8::gemm_phase<SH2, pg8::EpiStoreBf16, true>(F.lds, pg8::Gemm{Wqkv + (size_t)2048 * DM / 2, HX}, F.G, bx, pg8::EpiStoreBf16{VTb, MT, 0, 0, 1.0f, o8});
        {
            const int nq = (MT / 256) * 8, nv = 4 * (MT / 256), rq = nq % F.G, rv = nv % F.G;
            const int sh_q = (rq == 0 || bx >= rq) ? 1 : 0, sh_v = (rv == 0 || bx >= rv) ? 1 : 0;
            const int before = (rq == 0 ? bx : max(0, bx - rq)) + (rv == 0 ? bx : max(0, bx - rv));
            const int total = (rq == 0 ? F.G : F.G - rq) + (rv == 0 ? F.G : F.G - rv);
            table_convert(F, args, before, sh_q + sh_v, total);
        }
    }
    GRID_BAR();
    REP(4, attn_phase(F, args));
    GRID_BAR();
    {
        using SH = pg8::Shape<ML, DM, DM / 2, DM / 2, DM / 2, 1, 0, 0>;
        pg8::gemm_phase<SH, pg8::EpiResid, true>(F.lds, pg8::Gemm{(const bf16_t*)(ws + WS_HX + 36 * MiB), (const bf16_t*)(ws + WS_WO)}, F.G, bx, pg8::EpiResid{args.in[0], args.out, modb + 2 * DM, NMOD, ((DBG_SKIP & 1) ? 0.f : 1.f) / (pg8::ACT8_SCALE * pg8::W8_SCALE)});
    }
    GRID_BAR();
    PEER_BLOCK(0);
    norm_phase(F, args, 1, 1, 0, args.in[4] + DM);
    GRID_BAR();
    {
        using SH = pg8::Shape<512, ML, 256, 256, DM, 4, 0, 256>;
        pg8::gemm_phase<SH>(F.lds, pg8::Gemm{(const bf16_t*)(ws + WS_WC), HX}, F.G, bx, pg8::EpiYt{(unsigned char*)QKb});
    }
    GRID_BAR();
    {
        using SH = pg8::Shape<SEQ / 2, DM, 4096, 4096, 4096, NB, 0, (long)DM * 4096>;
        REP(14, pg8::gemm_phase<SH, pg8::EpiDft2, true>(F.lds, pg8::Gemm{(const bf16_t*)(ws + WS_CS), QKb}, F.G, bx, pg8::EpiDft2{(unsigned char*)VTb}));
        dft_nyquist_rows(F, args);
    }
    GRID_BAR();
    {
        using SH = pg8::Shape<ML, DM, DM / 2, DM / 2, DM / 2, 1, 0, 0>;
        pg8::gemm_phase<SH, pg8::EpiResid, true>(F.lds, pg8::Gemm{VTb, (const bf16_t*)(ws + WS_WF)}, F.G, bx, pg8::EpiResid{args.out, args.out, modb + (size_t)9 * NMOD + 2 * DM, NMOD, ((DBG_SKIP & 4) ? 0.f : 1.f) / (pg8::ACT8_SCALE * pg8::W8_SCALE)});
    }
    GRID_BAR();
    PEER_BLOCK(1);
    final_norm_phase(F, args);
#undef PEER_BLOCK
}

extern "C" void kernel_launch(void* const* d_in, const int* in_sizes, int n_in, void* d_out, int out_size, void* d_ws, size_t ws_size, hipStream_t stream) {
    static int grid = 0;
    if (grid == 0) {
        if (n_in != 17 || in_sizes[0] != ML * DM || out_size != ML * DM || ws_size < WS_END) { fprintf(stderr, "kernel_launch: unexpected shapes (n_in %d, in0 %d, out %d, ws %zu)\n", n_in, n_in > 0 ? in_sizes[0] : -1, out_size, ws_size); grid = -1; return; }
        int dev = 0, cus = 0, per_cu = 0;
        if (hipGetDevice(&dev) != hipSuccess || hipDeviceGetAttribute(&cus, hipDeviceAttributeMultiprocessorCount, dev) != hipSuccess) { grid = -1; return; }
        if (hipFuncSetAttribute((const void*)fwd_kernel, hipFuncAttributeMaxDynamicSharedMemorySize, LDS_BYTES) != hipSuccess) { fprintf(stderr, "kernel_launch: hipFuncSetAttribute failed\n"); grid = -1; return; }
        if (hipOccupancyMaxActiveBlocksPerMultiprocessor(&per_cu, (const void*)fwd_kernel, NWAVES * 64, LDS_BYTES) != hipSuccess || per_cu < 1)
            fprintf(stderr, "kernel_launch: note: occupancy query reports %d workgroups per CU\n", per_cu);
        (void)hipGetLastError();
        grid = cus;
        if (grid % 8 != 0) { fprintf(stderr, "kernel_launch: CU count %d is not a multiple of 8\n", cus); grid = -1; return; }
    }
    if (grid < 0) return;
    if (hipMemsetAsync((char*)d_ws + WS_CTL, 0, CTL_ZERO_BYTES, stream) != hipSuccess) { fprintf(stderr, "kernel_launch: memset failed\n"); return; }
    Args a{};
    for (int i = 0; i < 17; ++i) a.in[i] = (const float*)d_in[i];
    a.out = (float*)d_out; a.ws = (unsigned char*)d_ws;
    hipLaunchKernelGGL(fwd_kernel, dim3(grid), dim3(NWAVES * 64), LDS_BYTES, stream, a);
    const hipError_t le = hipPeekAtLastError();
    if (le != hipSuccess) fprintf(stderr, "kernel_launch: launch failed: %s\n", hipGetErrorName(le));
}
```

```cpp
#include <hip/hip_runtime.h>
#include <cstdio>
#include <cstdint>

#define LAS __attribute__((address_space(3)))
typedef unsigned short bf16_t;
typedef short bf16x8 __attribute__((ext_vector_type(8)));
typedef short s16x4 __attribute__((ext_vector_type(4)));
typedef float f32x2 __attribute__((ext_vector_type(2)));
typedef float f32x4 __attribute__((ext_vector_type(4)));
typedef float f32x16 __attribute__((ext_vector_type(16)));
typedef unsigned u32x2 __attribute__((ext_vector_type(2)));
typedef unsigned u32x4 __attribute__((ext_vector_type(4)));
typedef __bf16 bf16x2_t __attribute__((ext_vector_type(2)));

#ifndef DBG_SKIP
#define DBG_SKIP 0
#endif
constexpr int DM = 1024, NB = 8, SEQ = 4096, CTXL = 256, GW = 64;
constexpr int ML = NB * SEQ;
constexpr int MC = NB * CTXL;
constexpr int MT = ML + MC;
constexpr int NMOD = 6 * DM;
constexpr int NEXP = 16384;
constexpr float EPS = 1e-6f;
constexpr float LOG2E = 1.4426950408889634f;

constexpr size_t MiB = 1u << 20;
constexpr size_t WS_CTL = 0, CTL_ZERO_BYTES = 1 * MiB;
constexpr size_t WS_MOD = 1 * MiB;
constexpr size_t WS_WQKV = 2 * MiB;
constexpr size_t WS_WO = 8 * MiB;
constexpr size_t WS_WF = 10 * MiB;
constexpr size_t WS_WPQ = 12 * MiB;
constexpr size_t WS_SK = 20 * MiB;
constexpr size_t WS_WC = 20 * MiB + 256 * 1024;
constexpr size_t WS_CS = 22 * MiB;
constexpr size_t WS_TAB = 86 * MiB;
constexpr size_t WS_X8 = 150 * MiB;
constexpr size_t WS_WT = 182 * MiB;
constexpr size_t WS_PART = 282 * MiB;
constexpr float U_SCALE = 96.f;
constexpr float XQ_SCALE = 15.875f;
constexpr float V_SCALE = 2.f;
constexpr size_t TAB_LAYER = 32 * MiB, TAB_VOFF = 16 * MiB;
constexpr size_t WS_WSC = 198 * MiB;
constexpr size_t WS_HX = 214 * MiB;
constexpr size_t WS_QK = 282 * MiB;
constexpr size_t WS_VT = 418 * MiB;
constexpr size_t WS_IDX = WS_VT;
constexpr size_t WS_GATE = WS_VT + 8 * MiB;
constexpr size_t WS_END = 486 * MiB;
constexpr int CW_BAR = 4096;

__device__ __forceinline__ unsigned f2bf(float f) { unsigned u = __builtin_bit_cast(unsigned, f); return (u + 0x7fffu + ((u >> 16) & 1u)) >> 16; }
__device__ __forceinline__ unsigned pk2(float lo, float hi) { return f2bf(lo) | (f2bf(hi) << 16); }
__device__ __forceinline__ unsigned cvtpk(float lo, float hi) { f32x2 v = {lo, hi}; bf16x2_t b = __builtin_convertvector(v, bf16x2_t); return __builtin_bit_cast(unsigned, b); }
__device__ __forceinline__ float bflo(unsigned u) { return __builtin_bit_cast(float, u << 16); }
__device__ __forceinline__ float bfhi(unsigned u) { return __builtin_bit_cast(float, u & 0xffff0000u); }
__device__ __forceinline__ float wave_sum(float v) {
#pragma unroll
    for (int o = 1; o < 64; o <<= 1) v += __shfl_xor(v, o);
    return v;
}
__device__ __forceinline__ unsigned fp8_pack4(float a, float b, float c, float d) {
    int w = 0;
    w = __builtin_amdgcn_cvt_pk_fp8_f32(__builtin_amdgcn_fmed3f(a, -448.f, 448.f), __builtin_amdgcn_fmed3f(b, -448.f, 448.f), w, false);
    w = __builtin_amdgcn_cvt_pk_fp8_f32(__builtin_amdgcn_fmed3f(c, -448.f, 448.f), __builtin_amdgcn_fmed3f(d, -448.f, 448.f), w, true);
    return (unsigned)w;
}
__device__ __forceinline__ int crow(int r, int hi) { return (r & 3) + 8 * (r >> 2) + 4 * hi; }
__device__ __forceinline__ float gelu_erf(float v) {
    const float av = __builtin_fabsf(v), d = av * 0.2316418882f + 1.0f;
    const float t = __builtin_amdgcn_rcpf(d);
    float q = t * 0.5307027145f + (-0.7265760135f); q = q * t + 0.7107068705f; q = q * t + (-0.142248368f); q = q * t + 0.127414796f; q = q * t;
    const float e = __builtin_amdgcn_exp2f((v * v) * (-0.72134752044f));
    const float m = v * (q * e), r = v - m;
    return v < 0.f ? m : r;
}

namespace pg8 {
constexpr float ACT8_SCALE = 16.f, W8_SCALE = 256.f;
constexpr float YT_SCALE = 16.f, CS_SCALE = 512.f;
constexpr int BM = 256, BK = 64, HALF = 128, HTB = HALF * BK * 2, STAGE_BYTES = 8 * HTB, NXCD = 8, WGM = 8;
__host__ __device__ __forceinline__ int lds_byte(int r, int c) { const int st = (r >> 4) * 2 + (c >> 5), rr = r & 15, cc = c & 31, ob = rr * 64 + cc * 2; return st * 1024 + (ob ^ (((ob >> 9) & 1) << 5)); }
__host__ __device__ __forceinline__ void stage_rc(int b, int& R, int& C) { const int st = b / 1024, sb = b % 1024, swz = sb ^ (((sb >> 9) & 1) << 5); R = (st >> 1) * 16 + swz / 64; C = (st & 1) * 32 + (swz % 64) / 2; }
__host__ __device__ __forceinline__ int perm32(int rho) { const int n = rho >> 4, i = rho & 15; return 8 * (i >> 2) + 4 * n + (i & 3); }

struct Unit { int pm, pn, pb; };
struct Gemm { const bf16_t* A; const bf16_t* Bt; };
template <int M_, int N_, int K_, int LDA_, int LDB_, int NBATCH_, long BSA_, long BSB_> struct Shape { static constexpr int M = M_, N = N_, K = K_, lda = LDA_, ldb = LDB_, nbatch = NBATCH_; static constexpr long bsA = BSA_, bsB = BSB_; };

template <class SH> struct StaticOrder {
    static constexpr int nM = SH::M / BM, nN = SH::N / BM, per = nM * nN, nwg = per * SH::nbatch;
    int G, c;
    __device__ __forceinline__ void init(int G_, int c_) { G = G_; c = c_; }
    __device__ __forceinline__ bool next(int i, Unit& u) const {
        const long L = (long)i * G + c; if (L >= nwg) return false;
        int wgid = (int)L; { const int q = nwg / NXCD, r = nwg % NXCD, xcd = wgid % NXCD, off = wgid / NXCD; wgid = (xcd < r ? xcd * (q + 1) : r * (q + 1) + (xcd - r) * q) + off; }
        u.pb = wgid / per; wgid -= u.pb * per;
        const int nig = WGM * nN, gid = wgid / nig, fm = gid * WGM, gsz = (nM - fm) < WGM ? (nM - fm) : WGM;
        u.pm = fm + ((wgid % nig) % gsz); u.pn = (wgid % nig) / gsz; return true;
    }
};

struct EpiStoreBf16 {
    static constexpr bool PERM = true;
    bf16_t* O; long ldc; long bstride; int scols; float scale0; float oscale = 1.0f;
    __device__ __forceinline__ void operator()(const f32x4 (&acc)[2][2][4][2], const Unit& u, int wr, int wc, int fr, int fq) const {
        const int row0 = u.pm * BM + wr * 64 + fr, col0 = u.pn * BM + wc * 32 + 8 * fq;
        bf16_t* base = O + (long)u.pb * bstride;
        const float sc = ((u.pn * BM < scols) ? scale0 : 1.0f) * oscale;
#pragma unroll
        for (int ai = 0; ai < 2; ++ai)
#pragma unroll
            for (int m = 0; m < 4; ++m) { bf16_t* rowp = base + (long)(row0 + ai * HALF + m * 16) * ldc + col0;
#pragma unroll
                for (int bj = 0; bj < 2; ++bj) { const f32x4 v0 = acc[ai][bj][m][0] * sc, v1 = acc[ai][bj][m][1] * sc;
                    u32x4 w; w.x = cvtpk(v0[0], v0[1]); w.y = cvtpk(v0[2], v0[3]); w.z = cvtpk(v1[0], v1[1]); w.w = cvtpk(v1[2], v1[3]);
                    *(u32x4*)(rowp + bj * HALF) = w; } }
    }
};
struct EpiDft2 {
    static constexpr bool PERM = true;
    unsigned char* O;
    __device__ __forceinline__ void operator()(const f32x4 (&acc)[2][2][4][2], const Unit& u, int wr, int wc, int fr, int fq) const {
        const int row0 = u.pm * BM + wr * 64 + fr, cl0 = wc * 32 + 8 * fq;
        unsigned char* base = O + (long)u.pb * SEQ * DM + u.pn * BM;
        constexpr float osc = ACT8_SCALE / (YT_SCALE * CS_SCALE);
#pragma unroll
        for (int ai = 0; ai < 2; ++ai)
#pragma unroll
            for (int m = 0; m < 4; ++m) { const int np = row0 + ai * HALF + m * 16;
                unsigned char* rowp = base + (long)np * DM; unsigned char* mirp = base + (long)(SEQ - np) * DM;
#pragma unroll
                for (int bj = 0; bj < 2; ++bj) { const f32x4 v0 = acc[ai][bj][m][0] * osc, v1 = acc[ai][bj][m][1] * osc; const int cl = cl0 + bj * HALF;
                    u32x2 w; w.x = fp8_pack4(v0[0], v0[1], v0[2], v0[3]); w.y = fp8_pack4(v1[0], v1[1], v1[2], v1[3]);
                    *(u32x2*)(rowp + cl) = w;
                    if (np != 0) {
#pragma unroll
                        for (int i = 0; i < 8; ++i) mirp[(256 - cl - i) & 255] = (unsigned char)((w[i >> 2] >> (8 * (i & 3))) & 0xffu); } }
                asm volatile("" ::: "memory"); }
    }
};
struct EpiYt {
    static constexpr bool PERM = true;
    unsigned char* Yt;
    __device__ __forceinline__ void operator()(const f32x4 (&acc)[2][2][4][2], const Unit& u, int wr, int wc, int fr, int fq) const {
        const int row0 = u.pm * BM + wr * 64 + fr, col0 = u.pn * BM + wc * 32 + 8 * fq;
#pragma unroll
        for (int ai = 0; ai < 2; ++ai)
#pragma unroll
            for (int m = 0; m < 4; ++m) { const int row = row0 + ai * HALF + m * 16; const int part = row >> 8, cp = row & 255;
#pragma unroll
                for (int bj = 0; bj < 2; ++bj) { const int col = col0 + bj * HALF; const int b = col >> 12, n = col & 4095;
                    const f32x4 v0 = acc[ai][bj][m][0] * YT_SCALE, v1 = acc[ai][bj][m][1] * YT_SCALE;
                    u32x2 w; w.x = fp8_pack4(v0[0], v0[1], v0[2], v0[3]); w.y = fp8_pack4(v1[0], v1[1], v1[2], v1[3]);
                    *(u32x2*)(Yt + ((((long)(b * 4 + u.pb) * 256 + cp) * 2 + part) << 12) + n) = w; }
                asm volatile("" ::: "memory"); }
    }
};
struct EpiResid {
    static constexpr bool PERM = false;
    const float* Xin; float* Xout; const float* gate; int gstride; float gs;
    __device__ __forceinline__ void operator()(const f32x4 (&acc)[2][2][4][2], const Unit& u, int wr, int wc, int fr, int fq) const {
        const int row0 = u.pm * BM + wr * 64 + fr, col0 = u.pn * BM + wc * 32 + 4 * fq;
        const float* gb = gate + (long)((u.pm * BM) >> 12) * gstride;
        f32x4 gv[2][2];
#pragma unroll
        for (int bj = 0; bj < 2; ++bj)
#pragma unroll
            for (int n = 0; n < 2; ++n) gv[bj][n] = *(const f32x4*)(gb + col0 + bj * HALF + n * 16);
#pragma unroll
        for (int ai = 0; ai < 2; ++ai)
#pragma unroll
            for (int m = 0; m < 4; ++m) { const long off = (long)(row0 + ai * HALF + m * 16) * DM + col0;
#pragma unroll
                for (int bj = 0; bj < 2; ++bj)
#pragma unroll
                    for (int n = 0; n < 2; ++n) { const f32x4 bs = *(const f32x4*)(Xin + off + bj * HALF + n * 16);
                        *(f32x4*)(Xout + off + bj * HALF + n * 16) = bs + gv[bj][n] * acc[ai][bj][m][n] * gs; }
                if (m & 1) asm volatile("" ::: "memory"); }
    }
};

template <class SH, class Epi, bool FP8 = false>
__device__ __forceinline__ void gemm_phase(LAS unsigned char* lds, const Gemm g, int G_, int c_, const Epi& E) {
    StaticOrder<SH> S; S.init(G_, c_);
    int tid_ = threadIdx.x; asm volatile("" : "+v"(tid_));
    const int tid = tid_, wid = __builtin_amdgcn_readfirstlane(tid >> 6), lane = tid & 63, wr = wid >> 2, wc = wid & 3, fr = lane & 15, fq = lane >> 4;
    constexpr int K = SH::K, nt = K / BK;
    unsigned voffA[2], voffB[2];
#pragma unroll
    for (int i = 0; i < 2; ++i) { int R, C; stage_rc(tid * 16 + i * 8192, R, C); const int Rb = Epi::PERM ? ((R & ~31) + perm32(R & 31)) : R;
        voffA[i] = (unsigned)(R * SH::lda + C) * 2u; voffB[i] = (unsigned)(Rb * SH::ldb + C) * 2u; }
    constexpr size_t kstep = (size_t)(BK * 2);
    constexpr size_t hstepA = (size_t)HALF * SH::lda * 2, hstepB = (size_t)HALF * SH::ldb * 2;
    constexpr size_t tstepA = 2 * hstepA, tstepB = 2 * hstepB;
    const unsigned ldsw = (unsigned)wid * 1024u;
    const int aoff = lds_byte(wr * 64 + fr, fq * 8), boff = lds_byte(wc * 32 + fr, fq * 8);
#define PG8_SA(b, h) (((b) * 2 + (h)) * HTB)
#define PG8_SB(b, h) ((4 + (b) * 2 + (h)) * HTB)
#define PG8_STAGE(bufoff, gbase, voff) do { _Pragma("unroll") for (int _i = 0; _i < 2; ++_i) \
        __builtin_amdgcn_global_load_lds((const unsigned*)((const char*)(gbase) + (voff)[_i]), (LAS unsigned*)(lds + (bufoff) + ldsw + _i * 8192), 16, 0, 0); } while (0)
#define PG8_LDA(dst, b, h) do { _Pragma("unroll") for (int m = 0; m < 4; ++m) { const u32x4 f0_ = *(const LAS u32x4*)(lds + PG8_SA(b, h) + aoff + m * 2048), f1_ = *(const LAS u32x4*)(lds + PG8_SA(b, h) + aoff + m * 2048 + 1024); dst[m] = __builtin_shufflevector(f0_, f1_, 0, 1, 2, 3, 4, 5, 6, 7); } } while (0)
#define PG8_LDB(dst, b, h) do { _Pragma("unroll") for (int n = 0; n < 2; ++n) { const u32x4 f0_ = *(const LAS u32x4*)(lds + PG8_SB(b, h) + boff + n * 2048), f1_ = *(const LAS u32x4*)(lds + PG8_SB(b, h) + boff + n * 2048 + 1024); dst[n] = __builtin_shufflevector(f0_, f1_, 0, 1, 2, 3, 4, 5, 6, 7); } } while (0)
typedef int v8i_t __attribute__((ext_vector_type(8)));
typedef unsigned u32x8 __attribute__((ext_vector_type(8)));
#define PG8_LOH(x) __builtin_bit_cast(bf16x8, __builtin_shufflevector(x, x, 0, 1, 2, 3))
#define PG8_HIH(x) __builtin_bit_cast(bf16x8, __builtin_shufflevector(x, x, 4, 5, 6, 7))
#define PG8_MMA(ai, bj, At, Bt) do { __builtin_amdgcn_s_setprio(1); _Pragma("unroll") for (int m = 0; m < 4; ++m) _Pragma("unroll") for (int n = 0; n < 2; ++n) { \
        if constexpr (FP8) asm volatile("v_mfma_scale_f32_16x16x128_f8f6f4 %0, %1, %2, %0, %3, %3 op_sel_hi:[0,0,0]" : "+v"(acc[ai][bj][m][n]) : "v"(Bt[n]), "v"(At[m]), "v"(fp8_one));   \
        else { acc[ai][bj][m][n] = __builtin_amdgcn_mfma_f32_16x16x32_bf16(PG8_LOH(Bt[n]), PG8_LOH(At[m]), acc[ai][bj][m][n], 0, 0, 0); \
               acc[ai][bj][m][n] = __builtin_amdgcn_mfma_f32_16x16x32_bf16(PG8_HIH(Bt[n]), PG8_HIH(At[m]), acc[ai][bj][m][n], 0, 0, 0); } } \
        __builtin_amdgcn_s_setprio(0); } while (0)
#define PG8_WAIT_V(n) asm volatile("s_waitcnt vmcnt(" #n ")" ::: "memory")
#define PG8_WAIT_L(n) asm volatile("s_waitcnt lgkmcnt(" #n ")" ::: "memory")
#define PG8_BAR __builtin_amdgcn_s_barrier()
#define PG8_SCHED __builtin_amdgcn_sched_barrier(0)
    Unit cur, nxt; int ui = 0;
    if (!S.next(0, cur)) return;
    f32x4 acc[2][2][4][2];
#pragma unroll
    for (int a = 0; a < 2; ++a)
#pragma unroll
        for (int b = 0; b < 2; ++b)
#pragma unroll
            for (int m = 0; m < 4; ++m)
#pragma unroll
                for (int n = 0; n < 2; ++n) acc[a][b][m][n] = (f32x4){0.f, 0.f, 0.f, 0.f};
    unsigned fp8_one = 0x7f7f7f7fu; asm volatile("" : "+v"(fp8_one));
    u32x8 At[4], B0[2], B1[2];
    const char* cA = (const char*)(g.A + (long)cur.pb * SH::bsA) + (size_t)cur.pm * tstepA; const char* cB = (const char*)(g.Bt + (long)cur.pb * SH::bsB) + (size_t)cur.pn * tstepB;
    PG8_STAGE(PG8_SB(0, 0), cB, voffB); PG8_STAGE(PG8_SB(0, 1), cB + hstepB, voffB); PG8_STAGE(PG8_SA(0, 0), cA, voffA); PG8_STAGE(PG8_SA(0, 1), cA + hstepA, voffA);
    if (wr == 1) PG8_BAR;
    PG8_WAIT_V(2); PG8_BAR;
    PG8_STAGE(PG8_SB(1, 0), cB + kstep, voffB); PG8_STAGE(PG8_SA(1, 0), cA + kstep, voffA); PG8_STAGE(PG8_SB(1, 1), cB + hstepB + kstep, voffB);
    PG8_WAIT_V(6); PG8_BAR;
    for (;;) {
        const bool has_next = S.next(ui + 1, nxt);
        const char* nA = has_next ? (const char*)(g.A + (long)nxt.pb * SH::bsA) + (size_t)nxt.pm * tstepA : cA; const char* nB = has_next ? (const char*)(g.Bt + (long)nxt.pb * SH::bsB) + (size_t)nxt.pn * tstepB : cB;
#pragma nounroll
        for (int t = 0; t < nt; t += 2) {
            const bool last = (t == nt - 2);
            const char* a1 = cA + (size_t)(t + 1) * kstep;
            const char* a2 = last ? nA : cA + (size_t)(t + 2) * kstep; const char* b2 = last ? nB : cB + (size_t)(t + 2) * kstep;
            const char* a3 = a2 + kstep; const char* b3 = b2 + kstep;
            PG8_LDB(B0, 0, 0); PG8_LDB(B1, 0, 1); PG8_SCHED; PG8_LDA(At, 0, 0); PG8_STAGE(PG8_SA(1, 1), a1 + hstepA, voffA);
            PG8_WAIT_V(8); PG8_WAIT_L(0); PG8_BAR; PG8_MMA(0, 0, At, B0); PG8_MMA(0, 1, At, B1); PG8_BAR; PG8_SCHED;
            PG8_LDA(At, 0, 1); PG8_STAGE(PG8_SB(0, 0), b2, voffB); PG8_STAGE(PG8_SB(0, 1), b2 + hstepB, voffB); PG8_STAGE(PG8_SA(0, 0), a2, voffA);
            PG8_WAIT_V(8); PG8_WAIT_L(0); PG8_BAR; PG8_MMA(1, 0, At, B0); PG8_MMA(1, 1, At, B1); PG8_BAR; PG8_SCHED;
            PG8_LDB(B0, 1, 0); PG8_LDB(B1, 1, 1); PG8_SCHED; PG8_LDA(At, 1, 0); PG8_STAGE(PG8_SA(0, 1), a2 + hstepA, voffA);
            PG8_WAIT_V(8); PG8_WAIT_L(0); PG8_BAR; PG8_MMA(0, 0, At, B0); PG8_MMA(0, 1, At, B1); PG8_BAR; PG8_SCHED;
            PG8_LDA(At, 1, 1); PG8_STAGE(PG8_SB(1, 0), b3, voffB); PG8_STAGE(PG8_SB(1, 1), b3 + hstepB, voffB); PG8_STAGE(PG8_SA(1, 0), a3, voffA);
            PG8_WAIT_V(8); PG8_WAIT_L(0); PG8_BAR; PG8_MMA(1, 0, At, B0); PG8_MMA(1, 1, At, B1); PG8_BAR; PG8_SCHED;
        }
        if (wr == 0) PG8_BAR;
        if constexpr (FP8) asm volatile("s_nop 15\n\ts_nop 15\n\ts_nop 7" ::: "memory");
        E(acc, cur, wr, wc, fr, fq);
        if (!has_next) break;
#pragma unroll
        for (int a = 0; a < 2; ++a)
#pragma unroll
            for (int b = 0; b < 2; ++b)
#pragma unroll
                for (int m = 0; m < 4; ++m)
#pragma unroll
                    for (int n = 0; n < 2; ++n) acc[a][b][m][n] = (f32x4){0.f, 0.f, 0.f, 0.f};
        cur = nxt; cA = nA; cB = nB; ++ui;
        if (wr == 1) PG8_BAR;
    }
    PG8_WAIT_V(0);
    PG8_BAR;
#undef PG8_SA
#undef PG8_SB
#undef PG8_STAGE
#undef PG8_LDA
#undef PG8_LDB
#undef PG8_MMA
#undef PG8_WAIT_V
#undef PG8_WAIT_L
#undef PG8_BAR
#undef PG8_SCHED
}
}

#define XB_TMO      128
#define XB_XCNT(j)  (256  + 64 * (j))
#define XB_XSUB(j)  (1280 + 64 * (j))
#define XB_XGEN(j)  (2304 + 64 * (j))
#define XB_TOP      3328
#define XB_TOPGEN   3392
#define XCD_BAR_WORDS 3456
#define XB_SPIN_CAP (1u << 18)
__device__ __forceinline__ unsigned xb_ld(unsigned* p)              { return __hip_atomic_load(p, __ATOMIC_RELAXED, __HIP_MEMORY_SCOPE_AGENT); }
__device__ __forceinline__ unsigned xb_add(unsigned* p, unsigned v) { return __hip_atomic_fetch_add(p, v, __ATOMIC_RELAXED, __HIP_MEMORY_SCOPE_AGENT); }
__device__ __forceinline__ unsigned xb_xcc_id() { return (unsigned)__builtin_amdgcn_s_getreg((3 << 11) | 20) & 0xFu; }
#define XB_SPIN(cond, bar) do { unsigned _sp = 0; while (cond) { __builtin_amdgcn_s_sleep(1); \
    if ((++_sp & 255u) == 0u) { if (xb_ld(&(bar)[XB_TMO])) break; if (_sp > XB_SPIN_CAP) { atomicAdd(&(bar)[XB_TMO], 1u); break; } } } } while (0)
struct XcdBarrier { unsigned* bar; unsigned x; volatile LAS unsigned* st; };
__device__ __forceinline__ XcdBarrier xcd_barrier_post(unsigned* bar, volatile LAS unsigned* st) {
    XcdBarrier b; b.bar = bar; b.x = xb_xcc_id(); b.st = st;
    if (threadIdx.x == 0) (void)xb_add(&bar[XB_XCNT(b.x)], 1u);
    return b;
}
__device__ __forceinline__ void xcd_barrier_complete(unsigned* bar, unsigned x, unsigned& nloc, unsigned& nx) {
    const unsigned G = gridDim.x * gridDim.y * gridDim.z;
    unsigned sum, cnt, mine, sp = 0u;
    for (;;) {
        sum = 0u; cnt = 0u; mine = 0u;
#pragma unroll
        for (unsigned j = 0; j < 16; ++j) { const unsigned c = xb_ld(&bar[XB_XCNT(j)]); sum += c; cnt += (c > 0u) ? 1u : 0u; mine = (j == x) ? c : mine; }
        if (sum == G) break;
        __builtin_amdgcn_s_sleep(1);
        if ((++sp & 255u) == 0u) { if (xb_ld(&bar[XB_TMO])) break; if (sp > XB_SPIN_CAP) { atomicAdd(&bar[XB_TMO], 1u); break; } }
    }
    nloc = mine > 0u ? mine : 1u; nx = cnt > 0u ? cnt : 1u;
}
__device__ __forceinline__ void xcd_barrier(const XcdBarrier& b) {
    asm volatile("s_waitcnt vmcnt(0)" ::: "memory");
    __syncthreads();
    if (threadIdx.x == 0) {
        unsigned* bar = b.bar;
        __builtin_amdgcn_s_waitcnt(0);
        unsigned nloc = b.st[0], nx = b.st[1];
        if (nloc == 0u) { xcd_barrier_complete(bar, b.x, nloc, nx); b.st[0] = nloc; b.st[1] = nx; }
        const unsigned old = xb_add(&bar[XB_XSUB(b.x)], 1u);
        const unsigned gen = old / nloc;
        if (old + 1u == (gen + 1u) * nloc) {
            __builtin_amdgcn_fence(__ATOMIC_RELEASE, "agent");
            asm volatile("s_waitcnt vmcnt(0)" ::: "memory");
            const unsigned og = xb_add(&bar[XB_TOP], 1u);
            const unsigned tg = og / nx;
            if (og + 1u == (tg + 1u) * nx) xb_add(&bar[XB_TOPGEN], 1u);
            else XB_SPIN(xb_ld(&bar[XB_TOPGEN]) == tg, bar);
            __builtin_amdgcn_fence(__ATOMIC_ACQUIRE, "agent");
            xb_add(&bar[XB_XGEN(b.x)], 1u);
            asm volatile("s_waitcnt vmcnt(0)" ::: "memory");
        } else {
            XB_SPIN(xb_ld(&bar[XB_XGEN(b.x)]) == gen, bar);
            __builtin_amdgcn_fence(__ATOMIC_ACQUIRE, "agent");
            asm volatile("s_waitcnt vmcnt(0)" ::: "memory");
        }
    }
    __syncthreads();
}

constexpr int RING_BYTES = 131072;
constexpr int LDSCTL_OFF = RING_BYTES, MISC_OFF = LDSCTL_OFF + 320;
constexpr int LDS_BYTES = 147456;
constexpr int NWAVES = 8;

struct Args { const float* in[17]; float* out; unsigned char* ws; };

struct Ctx {
    LAS unsigned char* lds;
    int tid, lane, wave, vcu, G;
};

__device__ __forceinline__ Ctx fresh(const Ctx& F) {
    Ctx C = F; int t = threadIdx.x; asm volatile("" : "+v"(t)); C.tid = t; C.lane = t & 63; return C;
}
__device__ __forceinline__ void p0_transpose_item(const float* W, int K, int N, bf16_t* WT, LAS float* scr, int item, int lane) {
    const int nblk = N / 32, kb = item / nblk, nb = item % nblk, k0 = 64 * kb, n0 = 32 * nb;
#pragma unroll 8
    for (int i = 0; i < 32; ++i) { const int kk = 2 * i + (lane >> 5); scr[kk * 33 + (lane & 31)] = W[(size_t)(k0 + kk) * N + n0 + (lane & 31)]; }
    asm volatile("s_waitcnt lgkmcnt(0)" ::: "memory");
    const int c = lane & 7;
#pragma unroll
    for (int j = 0; j < 4; ++j) { const int n = (lane >> 3) + 8 * j; const LAS float* s = scr + (8 * c) * 33 + n;
        u32x4 o; o.x = pk2(s[0 * 33], s[1 * 33]); o.y = pk2(s[2 * 33], s[3 * 33]); o.z = pk2(s[4 * 33], s[5 * 33]); o.w = pk2(s[6 * 33], s[7 * 33]);
        *(u32x4*)(WT + (size_t)(n0 + n) * K + k0 + 8 * c) = o; }
    asm volatile("s_waitcnt lgkmcnt(0)" ::: "memory");
}
__device__ __forceinline__ void p0_transpose_item8(const float* W, int K, int N, unsigned char* WT, LAS float* scr, int item, int lane) {
    const int nblk = N / 32, kb = item / nblk, nb = item % nblk, k0 = 64 * kb, n0 = 32 * nb;
#pragma unroll 8
    for (int i = 0; i < 32; ++i) { const int kk = 2 * i + (lane >> 5); scr[kk * 33 + (lane & 31)] = W[(size_t)(k0 + kk) * N + n0 + (lane & 31)]; }
    asm volatile("s_waitcnt lgkmcnt(0)" ::: "memory");
    const int c = lane & 7;
#pragma unroll
    for (int j = 0; j < 4; ++j) { const int n = (lane >> 3) + 8 * j; const LAS float* s = scr + (8 * c) * 33 + n; constexpr float sc = pg8::W8_SCALE;
        u32x2 o; o.x = fp8_pack4(s[0 * 33] * sc, s[1 * 33] * sc, s[2 * 33] * sc, s[3 * 33] * sc); o.y = fp8_pack4(s[4 * 33] * sc, s[5 * 33] * sc, s[6 * 33] * sc, s[7 * 33] * sc);
        *(u32x2*)(WT + (size_t)(n0 + n) * K + k0 + 8 * c) = o; }
    asm volatile("s_waitcnt lgkmcnt(0)" ::: "memory");
}
__device__ __forceinline__ void cvt8(const float* src, bf16_t* dst) {
    const f32x4 a = *(const f32x4*)src, b = *(const f32x4*)(src + 4);
    u32x4 o; o.x = pk2(a[0], a[1]); o.y = pk2(a[2], a[3]); o.z = pk2(b[0], b[1]); o.w = pk2(b[2], b[3]);
    *(u32x4*)dst = o;
}

__device__ __forceinline__ void p0_prologue(const Ctx& F0, const Args& a) {
    const Ctx F = fresh(F0);
    unsigned char* ws = a.ws;
    const int gw = F.vcu * NWAVES + F.wave, NGW = F.G * NWAVES;
    const long gt = (long)F.vcu * 512 + F.tid, NGT = (long)F.G * 512;
    {
        LAS float* red = (LAS float*)(F.lds);
        const float* c = a.in[1]; const float* cctx = a.in[3]; const float* wmod = a.in[6]; const float* bmod = a.in[7];
        float* modb = (float*)(ws + WS_MOD);
        for (int item = F.vcu; item < 96; item += F.G) {
            const int l = item / 48, nc = item % 48, n0 = nc * 128 + 2 * F.lane, kb = F.wave * 128;
            float sv[9][2];
#pragma unroll
            for (int r = 0; r < 9; ++r)
#pragma unroll
                for (int j = 0; j < 2; ++j) { const int k = kb + 64 * j + F.lane; const float v = (r < 8) ? c[r * DM + k] : cctx[k]; sv[r][j] = v / (1.0f + __expf(-v)); }
            float acc[9][2];
#pragma unroll
            for (int r = 0; r < 9; ++r) { acc[r][0] = 0.f; acc[r][1] = 0.f; }
            const float* wp = wmod + (size_t)l * DM * NMOD + (size_t)kb * NMOD + n0;
#pragma unroll
            for (int j = 0; j < 2; ++j)
#pragma unroll 8
                for (int kl = 0; kl < 64; ++kl) {
                    const f32x2 w = *(const f32x2*)(wp + (size_t)(64 * j + kl) * NMOD);
#pragma unroll
                    for (int r = 0; r < 9; ++r) { const float s = __builtin_bit_cast(float, __builtin_amdgcn_readlane(__builtin_bit_cast(int, sv[r][j]), kl)); acc[r][0] += s * w[0]; acc[r][1] += s * w[1]; }
                }
            __syncthreads();
#pragma unroll
            for (int r = 0; r < 9; ++r) { red[(F.wave * 9 + r) * 128 + 2 * F.lane] = acc[r][0]; red[(F.wave * 9 + r) * 128 + 2 * F.lane + 1] = acc[r][1]; }
            __syncthreads();
            for (int o = F.tid; o < 9 * 128; o += 512) { const int r = o >> 7, nl = o & 127; float s = 0.f;
#pragma unroll
                for (int w = 0; w < 8; ++w) s += red[(w * 9 + r) * 128 + nl];
                modb[(size_t)(l * 9 + r) * NMOD + nc * 128 + nl] = s + bmod[l * NMOD + nc * 128 + nl]; }
        }
        __syncthreads();
    }
    {
        LAS float* scr = (LAS float*)(F.lds + F.wave * 16384);
        constexpr int I_QKV = (DM / 64) * (3 * DM / 32), I_O = (DM / 64) * (DM / 32), I_PQ = (DM / 64) * (2 * DM / 32);
        constexpr int NITEMS = I_QKV + 2 * I_O + 2 * I_PQ;
        for (int it = gw; it < NITEMS; it += NGW) {
            int r = it;
            if (r < I_QKV) { p0_transpose_item8(a.in[8], DM, 3 * DM, ws + WS_WQKV, scr, r, F.lane); continue; } r -= I_QKV;
            if (r < I_O) { p0_transpose_item8(a.in[9], DM, DM, ws + WS_WO, scr, r, F.lane); continue; } r -= I_O;
            if (r < I_O) { p0_transpose_item8(a.in[11], DM, DM, ws + WS_WF, scr, r, F.lane); continue; } r -= I_O;
            if (r < I_PQ) { p0_transpose_item(a.in[12], DM, 2 * DM, (bf16_t*)(ws + WS_WPQ), scr, r, F.lane); continue; } r -= I_PQ;
            p0_transpose_item(a.in[12] + (size_t)DM * 2 * DM, DM, 2 * DM, (bf16_t*)(ws + WS_WPQ) + (size_t)2 * DM * DM, scr, r, F.lane);
        }
    }
    for (long i = gt; i < 2 * 2 * 128 * 128 / 8; i += NGT) cvt8(a.in[13] + i * 8, (bf16_t*)(ws + WS_SK) + i * 8);
    {
        bf16_t* wc = (bf16_t*)(ws + WS_WC);
        for (long i = gt; i < 512 * 256 / 8; i += NGT) { const int nn = (int)(i >> 5), k0 = (int)(i & 31) * 8; float v[8];
#pragma unroll
            for (int j = 0; j < 8; ++j) { const int m = ((k0 + j) * (nn & 255)) & 255; const float fr = (float)m * (1.0f / 256.0f);
                v[j] = (nn < 256 ? __builtin_amdgcn_cosf(fr) : __builtin_amdgcn_sinf(fr)) * (1.0f / 16.0f); }
            u32x4 o; o.x = pk2(v[0], v[1]); o.y = pk2(v[2], v[3]); o.z = pk2(v[4], v[5]); o.w = pk2(v[6], v[7]);
            *(u32x4*)(wc + i * 8) = o; }
        unsigned char* cs = ws + WS_CS;
        for (long i = gt; i < 2048L * 8192 / 8; i += NGT) { const int np = (int)(i >> 10), c0 = (int)(i & 1023) * 8; const int part = c0 >> 12; float v[8];
#pragma unroll
            for (int j = 0; j < 8; ++j) { const int n = (c0 + j) & 4095; const int m = (n * np) & 4095; const float fr = (float)m * (1.0f / 4096.0f);
                v[j] = (part == 0 ? __builtin_amdgcn_cosf(fr) : -__builtin_amdgcn_sinf(fr)) * (pg8::CS_SCALE / 64.0f); }
            u32x2 o; o.x = fp8_pack4(v[0], v[1], v[2], v[3]); o.y = fp8_pack4(v[4], v[5], v[6], v[7]);
            *(u32x2*)(cs + i * 8) = o; }
    }
}

__device__ __forceinline__ unsigned fp4_pack8(const float* v, float sc) {
    unsigned w = 0;
#define FP4C(i) fminf(fmaxf(v[i] * sc, -6.f), 6.f)
    w = __builtin_amdgcn_cvt_scalef32_pk_fp4_f32(w, FP4C(0), FP4C(1), 1.0f, 0);
    w = __builtin_amdgcn_cvt_scalef32_pk_fp4_f32(w, FP4C(2), FP4C(3), 1.0f, 1);
    w = __builtin_amdgcn_cvt_scalef32_pk_fp4_f32(w, FP4C(4), FP4C(5), 1.0f, 2);
    w = __builtin_amdgcn_cvt_scalef32_pk_fp4_f32(w, FP4C(6), FP4C(7), 1.0f, 3);
#undef FP4C
    return w;
}
#define FP4_DEC(w, bs) __builtin_amdgcn_cvt_scalef32_pk_f32_fp4((w), 1.0f, (bs))
__device__ __forceinline__ unsigned i8_pack4(f32x4 v, float sc) {
    const int a = (int)rintf(fminf(fmaxf(v[0] * sc, -127.f), 127.f)), b = (int)rintf(fminf(fmaxf(v[1] * sc, -127.f), 127.f));
    const int c = (int)rintf(fminf(fmaxf(v[2] * sc, -127.f), 127.f)), d = (int)rintf(fminf(fmaxf(v[3] * sc, -127.f), 127.f));
    return (unsigned)(a & 0xff) | ((unsigned)(b & 0xff) << 8) | ((unsigned)(c & 0xff) << 16) | ((unsigned)(d & 0xff) << 24);
}
__device__ __forceinline__ void table_convert(const Ctx& F0, const Args& a, int sh0, int nsh, int nshare) {
    const Ctx F = fresh(F0);
    constexpr long PER = (long)NEXP * DM / 16;
    constexpr long TOTAL = 4 * PER;
    unsigned char* t8 = a.ws + WS_TAB;
    const long per_share = (TOTAL + nshare - 1) / nshare;
    const long i0 = (long)sh0 * per_share, i1 = min((long)(sh0 + nsh) * per_share, TOTAL);
    for (long i = i0 + F.tid; i < i1; i += 512) {
        const int q = (int)(i / PER); const long r = i - (long)q * PER; const int l = q >> 1, tb = q & 1;
        const int e = (int)(r >> 6), c16 = (int)(r & 63);
        const float* src = (tb ? a.in[15] : a.in[14]) + ((size_t)l * NEXP + e) * DM + c16 * 16;
        if (tb) {
            u32x2 o;
#pragma unroll
            for (int d = 0; d < 2; ++d) { const f32x4 va = *(const f32x4*)(src + 8 * d), vb = *(const f32x4*)(src + 8 * d + 4);
                const float v8[8] = {va[0], va[1], va[2], va[3], vb[0], vb[1], vb[2], vb[3]};
                o[d] = fp4_pack8(v8, V_SCALE); }
            *(u32x2*)(t8 + (size_t)l * TAB_LAYER + TAB_VOFF + ((size_t)(c16 >> 4) * NEXP + e) * 128 + (c16 & 15) * 8) = o;
        } else {
            u32x2 o;
#pragma unroll
            for (int d = 0; d < 2; ++d) { unsigned w = 0;
#pragma unroll
                for (int jn = 0; jn < 8; ++jn) { const float x = src[8 * d + jn] * U_SCALE; const int q = (int)rintf(fminf(fmaxf(x, -8.f), 7.f)) + 8; w |= (unsigned)q << (4 * jn); }
                o[d] = w; }
            *(u32x2*)(t8 + (size_t)l * TAB_LAYER + ((size_t)(c16 >> 3) * NEXP + e) * 64 + (c16 & 7) * 8) = o;
        }
    }
}

__device__ __forceinline__ const float* norm_src(const Args& a, int mode, int m) { return (m < ML) ? ((mode == 0 ? a.in[0] : a.out) + (size_t)m * DM) : (a.in[2] + (size_t)(m - ML) * DM); }
__device__ __forceinline__ void norm_phase(const Ctx& F0, const Args& a, int mode, int layer, int off, const float* gw) {
    const Ctx F = fresh(F0);
    const int gwv = F.vcu * NWAVES + F.wave, NGW = F.G * NWAVES, lane = F.lane;
    const float* modb = (const float*)(a.ws + WS_MOD) + (size_t)layer * 9 * NMOD;
    bf16_t* hx = (bf16_t*)(a.ws + WS_HX);
    const int nrows = (mode == 0) ? MT : ML;
    f32x4 gv[4];
#pragma unroll
    for (int j = 0; j < 4; ++j) gv[j] = ((const f32x4*)gw)[lane + 64 * j];
    f32x4 v[4], vn[4];
    if (gwv < nrows) { const f32x4* xr = (const f32x4*)norm_src(a, mode, gwv) + lane;
#pragma unroll
        for (int j = 0; j < 4; ++j) vn[j] = xr[64 * j]; }
    for (int m = gwv; m < nrows; m += NGW) {
#pragma unroll
        for (int j = 0; j < 4; ++j) v[j] = vn[j];
        { const int mn = (m + NGW < nrows) ? m + NGW : m; const f32x4* xr = (const f32x4*)norm_src(a, mode, mn) + lane;
#pragma unroll
          for (int j = 0; j < 4; ++j) vn[j] = xr[64 * j]; }
        const float* mr = modb + (size_t)((m < ML) ? (m >> 12) : 8) * NMOD + off;
        f32x4 av[4], cv[4];
#pragma unroll
        for (int j = 0; j < 4; ++j) { av[j] = ((const f32x4*)mr)[lane + 64 * j]; cv[j] = ((const f32x4*)(mr + DM))[lane + 64 * j]; }
        float s = 0.f;
#pragma unroll
        for (int j = 0; j < 4; ++j) s += (v[j].x * v[j].x + v[j].y * v[j].y) + (v[j].z * v[j].z + v[j].w * v[j].w);
        const float rstd = 1.0f / sqrtf(wave_sum(s) * (1.0f / DM) + EPS);
        unsigned long long* o8 = (unsigned long long*)(hx + (size_t)m * DM) + lane;
        unsigned* o4 = (unsigned*)(a.ws + WS_HX + (size_t)m * DM) + lane;
#pragma unroll
        for (int j = 0; j < 4; ++j) { const f32x4 y = (v[j] * rstd * gv[j]) * (cv[j] + 1.0f) + av[j];
            if (mode == 0) { o4[64 * j] = fp8_pack4(y.x * pg8::ACT8_SCALE, y.y * pg8::ACT8_SCALE, y.z * pg8::ACT8_SCALE, y.w * pg8::ACT8_SCALE); continue; }
            o8[64 * j] = (unsigned long long)cvtpk(y.x, y.y) | ((unsigned long long)cvtpk(y.z, y.w) << 32);
            if (off == 3 * DM) *(unsigned*)(a.ws + WS_X8 + ((size_t)(2 * j + (lane >> 5)) * ML + m) * 128 + (4 * lane & 127)) = i8_pack4(y, XQ_SCALE); }
    }
}
__device__ __forceinline__ void final_norm_phase(const Ctx& F0, const Args& a) {
    const Ctx F = fresh(F0);
    const int gwv = F.vcu * NWAVES + F.wave, NGW = F.G * NWAVES;
    const float* gw = a.in[16];
    for (int m = gwv; m < ML; m += NGW) {
        f32x4* xr = (f32x4*)(a.out + (size_t)m * DM) + F.lane;
        f32x4 v[4]; float s = 0.f;
#pragma unroll
        for (int j = 0; j < 4; ++j) { v[j] = xr[64 * j]; s += (v[j].x * v[j].x + v[j].y * v[j].y) + (v[j].z * v[j].z + v[j].w * v[j].w); }
        const float rstd = 1.0f / sqrtf(wave_sum(s) * (1.0f / DM) + EPS);
#pragma unroll
        for (int j = 0; j < 4; ++j) xr[64 * j] = v[j] * rstd * ((const f32x4*)gw)[F.lane + 64 * j];
    }
}

constexpr int ATT_ROWB = 144, ATT_KTILEB = 128 * ATT_ROWB, ATT_VROWB = 272, ATT_VTILEB = 64 * ATT_VROWB, ATT_BIAS_B = 2048, ATT_K0 = ATT_BIAS_B, ATT_V0 = ATT_K0 + 2 * ATT_KTILEB;
constexpr float ATT_THR = 8.0f;
template <int NGH, bool LATENT>
__device__ __forceinline__ void attn_sub(const LAS unsigned char* Kt, const LAS unsigned char* Vt_, int ko, const LAS float* browA, const LAS float* browB, const int (&relidx)[8],
                                         const bf16x8 (&qf)[2], float& m_ref, float& l_run, f32x4 (&o)[4], int q16, int g4) {
    constexpr int NG = 2 * NGH;
    bf16x8 kf[2 * NG][2]; u32x2 vf[4][NG][2]; f32x4 sc[2 * NG];
#pragma unroll
    for (int gk = 0; gk < NG; ++gk)
#pragma unroll
        for (int b2 = 0; b2 < 2; ++b2)
#pragma unroll
            for (int ks = 0; ks < 2; ++ks) kf[2 * gk + b2][ks] = *(const LAS bf16x8*)(Kt + ((gk / NGH) * 64 + ko + 32 * (gk % NGH) + 16 * b2 + q16) * ATT_ROWB + 64 * ks + 16 * g4);
#pragma unroll
    for (int d = 0; d < 4; ++d)
#pragma unroll
        for (int gk = 0; gk < NG; ++gk) { const LAS unsigned char* vp = Vt_ + (16 * d + q16) * ATT_VROWB + 2 * ((gk / NGH) * 64 + ko + 32 * (gk % NGH) + 4 * g4);
            vf[d][gk][0] = *(const LAS u32x2*)vp; vf[d][gk][1] = *(const LAS u32x2*)(vp + 32); }
    if (LATENT) {
#pragma unroll
        for (int kk = 0; kk < 8; ++kk) { sc[kk >> 2][kk & 3] = browA[relidx[kk]] - m_ref; sc[2 + (kk >> 2)][kk & 3] = browB[relidx[kk]] - m_ref; }
    } else {
#pragma unroll
        for (int blk = 0; blk < 2 * NG; ++blk) sc[blk] = (f32x4){-m_ref, -m_ref, -m_ref, -m_ref};
    }
#pragma unroll
    for (int blk = 0; blk < 2 * NG; ++blk)
#pragma unroll
        for (int ks = 0; ks < 2; ++ks) sc[blk] = __builtin_amdgcn_mfma_f32_16x16x32_bf16(kf[blk][ks], qf[ks], sc[blk], 0, 0, 0);
    float mx = fmaxf(fmaxf(sc[0][0], sc[0][1]), fmaxf(sc[0][2], sc[0][3]));
#pragma unroll
    for (int blk = 1; blk < 2 * NG; ++blk) mx = fmaxf(mx, fmaxf(fmaxf(sc[blk][0], sc[blk][1]), fmaxf(sc[blk][2], sc[blk][3])));
    if (__builtin_amdgcn_ballot_w64(mx > ATT_THR) != 0ull) {
        mx = fmaxf(mx, __shfl_xor(mx, 16)); mx = fmaxf(mx, __shfl_xor(mx, 32));
        const float dl = mx > ATT_THR ? mx : 0.f;
        m_ref += dl;
        const float al = __builtin_amdgcn_exp2f(-dl);
        l_run *= al;
#pragma unroll
        for (int d = 0; d < 4; ++d) o[d] *= al;
#pragma unroll
        for (int blk = 0; blk < 2 * NG; ++blk) sc[blk] -= dl;
    }
    float ls0 = 0.f, ls1 = 0.f;
#pragma unroll
    for (int blk = 0; blk < 2 * NG; ++blk)
#pragma unroll
        for (int i = 0; i < 4; ++i) { const float e = __builtin_amdgcn_exp2f(sc[blk][i]); sc[blk][i] = e; if (blk & 1) ls1 += e; else ls0 += e; }
    l_run += ls0 + ls1;
    bf16x8 pf[NG];
#pragma unroll
    for (int gk = 0; gk < NG; ++gk) { u32x4 pw; pw.x = cvtpk(sc[2 * gk][0], sc[2 * gk][1]); pw.y = cvtpk(sc[2 * gk][2], sc[2 * gk][3]); pw.z = cvtpk(sc[2 * gk + 1][0], sc[2 * gk + 1][1]); pw.w = cvtpk(sc[2 * gk + 1][2], sc[2 * gk + 1][3]);
        pf[gk] = __builtin_bit_cast(bf16x8, pw); }
#pragma unroll
    for (int gk = 0; gk < NG; ++gk)
#pragma unroll
        for (int d = 0; d < 4; ++d) { u32x4 vw; vw.x = vf[d][gk][0].x; vw.y = vf[d][gk][0].y; vw.z = vf[d][gk][1].x; vw.w = vf[d][gk][1].y;
            o[d] = __builtin_amdgcn_mfma_f32_16x16x32_bf16(__builtin_bit_cast(bf16x8, vw), pf[gk], o[d], 0, 0, 0); }
}
__device__ __forceinline__ void attn_phase(const Ctx& F0, const Args& a) {
    const Ctx F = fresh(F0);
    const bf16_t* QK = (const bf16_t*)(a.ws + WS_QK);
    const bf16_t* VT = (const bf16_t*)(a.ws + WS_VT);
    unsigned char* AO = a.ws + WS_HX + 36 * MiB;
    const float* rpb = a.in[10];
    LAS float* bias = (LAS float*)F.lds;
    const int tid = F.tid, lane = F.lane, q16 = lane & 15, g4 = lane >> 4;
    const int rr = F.wave >> 2, jt = F.wave & 3;
    const int qc = 16 * jt + q16, cs = min(max(qc - 8, 0), 48), ksj = min(max(16 * jt - 8, 0), 32);
    int relidx[8];
#pragma unroll
    for (int k = 0; k < 8; ++k) { const int kc = ksj + 16 * (k >> 2) + 4 * g4 + (k & 3); relidx[k] = (kc >= cs && kc < cs + 16) ? (kc - qc + 15) : 31; }
    const int krow = tid >> 3, kch = tid & 7, vrow = tid >> 4, vch = tid & 15;
    const unsigned lds_k = (unsigned)(krow * ATT_ROWB + kch * 16), lds_v = (unsigned)(vrow * ATT_VROWB + vch * 16);
    const int nunits = NB * 16 * 32, upb = (nunits + F.G - 1) / F.G;
    int cur_bh = -1;
    for (int k = 0; k < upb; ++k) {
        const int id = F.vcu * upb + k; if (id >= nunits) break;
        const int p = id & 31, bh = id >> 5, b = bh >> 4, h = bh & 15;
        if (bh != cur_bh) {
            __syncthreads();
            for (int i = tid; i < 16 * 32; i += 512) { const int dr = i >> 5, dc = i & 31; bias[i] = (dc < 31 && dr < 15) ? rpb[(h * 15 + dr) * 31 + dc] * LOG2E : -1e30f; }
            cur_bh = bh;
        }
        const int r0 = 2 * p, rs0 = min(max(r0 - 4, 0), 56), rs1 = min(max(r0 + 1 - 4, 0), 56);
        const int nlat = rs1 + 8 - rs0, nlt = (nlat + 1) >> 1, nsteps = nlt + 2;
        const int r = r0 + rr, rs = rr ? rs1 : rs0;
        const long tokq = (long)b * SEQ + r * GW + qc;
        const bf16_t* kbase = QK + 1024 + h * 64 + kch * 8;
        const bf16_t* vbase = VT + (long)(h * 64 + vrow) * MT + (vch & 7) * 8;
#define ATT_TOKA(step) ((step) < nlt ? ((long)b * SEQ + (long)(rs0 + 2 * (step)) * GW) : ((long)ML + b * CTXL + ((step) - nlt) * 128))
#define ATT_TOKB(step) ((step) < nlt ? ((long)b * SEQ + (long)min(rs0 + 2 * (step) + 1, rs0 + nlat - 1) * GW) : ((long)ML + b * CTXL + ((step) - nlt) * 128 + 64))
        u32x4 kA[2], vA[2], kB[2], vB[2];
#define ATT_LOAD(step, kr_, vr_) do { const int st_ = (step) < nsteps ? (step) : nsteps - 1; const long ta_ = ATT_TOKA(st_), tb_ = ATT_TOKB(st_);     \
        kr_[0] = *(const u32x4*)(kbase + (ta_ + krow) * 2048); kr_[1] = *(const u32x4*)(kbase + (tb_ + krow) * 2048); \
        const long tv_ = (vch < 8) ? ta_ : tb_; vr_[0] = *(const u32x4*)(vbase + tv_); vr_[1] = *(const u32x4*)(vbase + (long)32 * MT + tv_); } while (0)
#define ATT_WRITE(buf, kr_, vr_) do { *(LAS u32x4*)(F.lds + ATT_K0 + (buf) * ATT_KTILEB + lds_k) = kr_[0]; *(LAS u32x4*)(F.lds + ATT_K0 + (buf) * ATT_KTILEB + 64 * ATT_ROWB + lds_k) = kr_[1]; \
        *(LAS u32x4*)(F.lds + ATT_V0 + (buf) * ATT_VTILEB + lds_v) = vr_[0]; *(LAS u32x4*)(F.lds + ATT_V0 + (buf) * ATT_VTILEB + 32 * ATT_VROWB + lds_v) = vr_[1]; } while (0)
        ATT_LOAD(0, kA, vA); ATT_LOAD(1, kB, vB);
        bf16x8 qf[2];
#pragma unroll
        for (int ks = 0; ks < 2; ++ks) qf[ks] = *(const bf16x8*)(QK + tokq * 2048 + h * 64 + 32 * ks + 8 * g4);
        float m_ref = 0.f, l_run = 0.f;
        f32x4 o[4];
#pragma unroll
        for (int d = 0; d < 4; ++d) o[d] = (f32x4){0.f, 0.f, 0.f, 0.f};
        __syncthreads();
        ATT_WRITE(0, kA, vA);
        asm volatile("" :: "v"(qf[0]), "v"(qf[1]));
        __syncthreads();
#define ATT_COMPUTE(step, cur) do { \
            const LAS unsigned char* Kt = F.lds + ATT_K0 + (cur) * ATT_KTILEB; \
            const LAS unsigned char* Vt_ = F.lds + ATT_V0 + (cur) * ATT_VTILEB; \
            if ((step) < nlt) { const int krA = rs0 + 2 * (step), krB = krA + 1; \
                const bool actA = krA >= rs && krA < rs + 8, actB = krB < rs0 + nlat && krB >= rs && krB < rs + 8; \
                if (actA || actB) attn_sub<1, true>(Kt, Vt_, ksj, bias + (actA ? (krA - r + 7) : 15) * 32, bias + (actB ? (krB - r + 7) : 15) * 32, relidx, qf, m_ref, l_run, o, q16, g4); \
            } else attn_sub<2, false>(Kt, Vt_, 0, bias, bias, relidx, qf, m_ref, l_run, o, q16, g4); \
        } while (0)
        for (int step = 0; step < nsteps; step += 2) {
            ATT_COMPUTE(step, 0);
            if (step + 1 < nsteps) ATT_WRITE(1, kB, vB);
            ATT_LOAD(step + 2, kA, vA);
            __syncthreads();
            if (step + 1 < nsteps) { ATT_COMPUTE(step + 1, 1); }
            if (step + 2 < nsteps) ATT_WRITE(0, kA, vA);
            ATT_LOAD(step + 3, kB, vB);
            __syncthreads();
        }
#undef ATT_LOAD
#undef ATT_WRITE
#undef ATT_COMPUTE
#undef ATT_TOKA
#undef ATT_TOKB
        l_run += __shfl_xor(l_run, 16); l_run += __shfl_xor(l_run, 32);
        const float linv = 1.0f / l_run;
        unsigned char* op = AO + tokq * DM + h * 64 + 4 * g4; const float ls = linv * pg8::ACT8_SCALE;
#pragma unroll
        for (int d = 0; d < 4; ++d) *(unsigned*)(op + 16 * d) = fp8_pack4(o[d][0] * ls, o[d][1] * ls, o[d][2] * ls, o[d][3] * ls);
    }
    __syncthreads();
}

__device__ __forceinline__ void ce_desc(float& a, float& b) { const float hi = fmaxf(a, b), lo = fminf(a, b); a = hi; b = lo; }
__device__ __forceinline__ void ce_dir(float& a, float& b, bool desc) { const float hi = fmaxf(a, b), lo = fminf(a, b); a = desc ? hi : lo; b = desc ? lo : hi; }
__device__ __forceinline__ void sort16_desc(float (&v)[16]) {
#pragma unroll
    for (int k = 2; k <= 16; k <<= 1)
#pragma unroll
        for (int j = k >> 1; j > 0; j >>= 1)
#pragma unroll
            for (int i = 0; i < 16; ++i) { const int l = i ^ j; if (l > i) ce_dir(v[i], v[l], (i & k) == 0); }
}
__device__ __forceinline__ void merge16_desc(float (&a)[16], const float (&b)[16]) {
#pragma unroll
    for (int i = 0; i < 16; ++i) a[i] = fmaxf(a[i], b[15 - i]);
#pragma unroll
    for (int j = 8; j > 0; j >>= 1)
#pragma unroll
        for (int i = 0; i < 16; ++i) { const int l = i ^ j; if (l > i) ce_desc(a[i], a[l]); }
}

struct CandTab { int i[64]; int j[64]; };
__host__ __device__ constexpr CandTab make_cand_tab() {
    CandTab t{}; int n = 0;
    for (int i = 0; i < 16; ++i) for (int j = 0; j < 16; ++j) if ((i + 1) * (j + 1) <= 16) { t.i[n] = i; t.j[n] = j; ++n; }
    for (; n < 64; ++n) { t.i[n] = -1; t.j[n] = -1; }
    return t;
}

__device__ __forceinline__ void peer_topk_phase(const Ctx& F0, const Args& a, int layer) {
    const Ctx F = fresh(F0);
    const bf16_t* QP = (const bf16_t*)(a.ws + WS_QK);
    const bf16_t* SK = (const bf16_t*)(a.ws + WS_SK) + (size_t)layer * 2 * 128 * 128;
    unsigned short* IDX = (unsigned short*)(a.ws + WS_IDX);
    float* GATE = (float*)(a.ws + WS_GATE);
    const int gwv = F.vcu * NWAVES + F.wave, NGW = F.G * NWAVES;
    const int lane = F.lane, t32 = lane & 31, hi = lane >> 5;
    __syncthreads();
    for (int c = F.tid; c < 4096; c += 512) *(LAS u32x4*)(F.lds + (c >> 4) * 272 + (c & 15) * 16) = *(const u32x4*)(SK + (size_t)c * 8);
    __syncthreads();
    for (int task = gwv; task < 1024 * 8; task += NGW) {
        const int tt = task >> 3, h = task & 7;
        const long tok = (long)tt * 32 + t32;
        float top[2][16];
#pragma unroll
        for (int p = 0; p < 2; ++p) {
            f32x16 acc[4];
#pragma unroll
            for (int eb = 0; eb < 4; ++eb)
#pragma unroll
                for (int i = 0; i < 16; ++i) acc[eb][i] = 0.f;
#pragma unroll
            for (int eb = 0; eb < 4; ++eb) asm volatile("" : "+v"(acc[eb]));
            const bf16_t* qp = QP + tok * 2048 + h * 256 + p * 128 + hi * 8;
            const LAS unsigned char* kp = F.lds + (p * 128 + t32) * 272 + hi * 16;
#pragma unroll
            for (int ks = 0; ks < 8; ++ks) {
                if ((ks & 1) == 0) asm volatile("" ::: "memory");
                const bf16x8 bq = *(const bf16x8*)(qp + ks * 16);
#pragma unroll
                for (int eb = 0; eb < 4; ++eb) { const bf16x8 ak = *(const LAS bf16x8*)(kp + eb * 32 * 272 + ks * 32); acc[eb] = __builtin_amdgcn_mfma_f32_32x32x16_bf16(ak, bq, acc[eb], 0, 0, 0); }
            }
            float cur[16];
#pragma unroll
            for (int eb = 0; eb < 4; ++eb) {
                float v[16];
#pragma unroll
                for (int i = 0; i < 16; ++i) { const unsigned e = 32 * eb + crow(i, hi); float x = acc[eb][i]; asm volatile("" : "+v"(x));
                    v[i] = __builtin_bit_cast(float, (__builtin_bit_cast(unsigned, x) & ~0x7Fu) | e); }
                sort16_desc(v);
                if (eb == 0) {
#pragma unroll
                    for (int i = 0; i < 16; ++i) cur[i] = v[i];
                } else merge16_desc(cur, v);
            }
            float oth[16];
#pragma unroll
            for (int i = 0; i < 16; ++i) oth[i] = __shfl_xor(cur[i], 32);
            merge16_desc(cur, oth);
#pragma unroll
            for (int i = 0; i < 16; ++i) top[p][i] = cur[i];
            __builtin_amdgcn_sched_barrier(0);
        }
        float best[16];
#pragma unroll
        for (int gI = 0; gI < 4; ++gI) {
            float v[16];
#pragma unroll
            for (int q = 0; q < 16; ++q) {
                constexpr CandTab CT = make_cand_tab();
                const int ci = CT.i[16 * gI + q], cj = CT.j[16 * gI + q];
                if (ci >= 0) {
                    const unsigned ua = __builtin_bit_cast(unsigned, top[0][ci]), ub = __builtin_bit_cast(unsigned, top[1][cj]);
                    float s = top[0][ci] + top[1][cj]; asm volatile("" : "+v"(s));
                    const unsigned code = ((ua & 0x7Fu) << 7) | (ub & 0x7Fu);
                    v[q] = __builtin_bit_cast(float, (__builtin_bit_cast(unsigned, s) & ~0x3FFFu) | code);
                } else v[q] = -3.0e38f;
            }
            sort16_desc(v);
            if (gI == 0) {
#pragma unroll
                for (int i = 0; i < 16; ++i) best[i] = v[i];
            } else merge16_desc(best, v);
            __builtin_amdgcn_sched_barrier(0);
        }
        float e[16], sum = 0.f;
#pragma unroll
        for (int i = 0; i < 16; ++i) { e[i] = __builtin_amdgcn_exp2f((best[i] - best[0]) * LOG2E); sum += e[i]; }
        const float inv = 1.0f / sum;
        if (hi == 0) {
            u32x4 w0, w1;
            w0.x = (__builtin_bit_cast(unsigned, best[0]) & 0x3FFFu) | ((__builtin_bit_cast(unsigned, best[1]) & 0x3FFFu) << 16);
            w0.y = (__builtin_bit_cast(unsigned, best[2]) & 0x3FFFu) | ((__builtin_bit_cast(unsigned, best[3]) & 0x3FFFu) << 16);
            w0.z = (__builtin_bit_cast(unsigned, best[4]) & 0x3FFFu) | ((__builtin_bit_cast(unsigned, best[5]) & 0x3FFFu) << 16);
            w0.w = (__builtin_bit_cast(unsigned, best[6]) & 0x3FFFu) | ((__builtin_bit_cast(unsigned, best[7]) & 0x3FFFu) << 16);
            w1.x = (__builtin_bit_cast(unsigned, best[8]) & 0x3FFFu) | ((__builtin_bit_cast(unsigned, best[9]) & 0x3FFFu) << 16);
            w1.y = (__builtin_bit_cast(unsigned, best[10]) & 0x3FFFu) | ((__builtin_bit_cast(unsigned, best[11]) & 0x3FFFu) << 16);
            w1.z = (__builtin_bit_cast(unsigned, best[12]) & 0x3FFFu) | ((__builtin_bit_cast(unsigned, best[13]) & 0x3FFFu) << 16);
            w1.w = (__builtin_bit_cast(unsigned, best[14]) & 0x3FFFu) | ((__builtin_bit_cast(unsigned, best[15]) & 0x3FFFu) << 16);
            u32x4* ip = (u32x4*)(IDX + tok * 128 + h * 16);
            ip[0] = w0; ip[1] = w1;
        } else {
            f32x4* gp = (f32x4*)(GATE + tok * 128 + h * 16);
#pragma unroll
            for (int q = 0; q < 4; ++q) gp[q] = (f32x4){e[4 * q] * inv, e[4 * q + 1] * inv, e[4 * q + 2] * inv, e[4 * q + 3] * inv};
        }
    }
    __syncthreads();
}

typedef long i64_t;
typedef unsigned u32x8_t __attribute__((ext_vector_type(8)));
typedef _Float16 h2_t __attribute__((ext_vector_type(2)));
template <int CTRL> __device__ __forceinline__ float dpp_f(float v) { return __builtin_bit_cast(float, __builtin_amdgcn_update_dpp(0, __builtin_bit_cast(int, v), CTRL, 0xF, 0xF, true)); }
__device__ __forceinline__ void peer_u_phase(const Ctx& F0, const Args& a, int layer) {
    const Ctx F = fresh(F0);
    const int s = (int)(blockIdx.x & 7), j = (int)(blockIdx.x >> 3), nmem = F.G >> 3;
    const unsigned char* U8s = a.ws + WS_TAB + (size_t)layer * TAB_LAYER + (size_t)s * NEXP * 64;
    const unsigned char* X8s = a.ws + WS_X8 + (size_t)s * ML * 128;
    const unsigned short* IDX = (const unsigned short*)(a.ws + WS_IDX);
    unsigned* PART = (unsigned*)(a.ws + WS_PART) + (size_t)s * ML * 64;
    const int lane = F.lane, r16 = lane >> 2, c4 = lane & 3;
    const bool c1 = (lane & 2) != 0, c0 = (lane & 1) != 0;
    const int t0 = j * NWAVES + F.wave, stride = nmem * NWAVES, ntok = (ML - t0 + stride - 1) / stride;
#define U_TOK(i) ((size_t)(t0 + ((i) < ntok ? (i) : ntok - 1) * stride))
#define U_EID(iv, k) (((k) & 1) ? (iv[(k) >> 1] >> 16) : (iv[(k) >> 1] & 0xffffu))
#define U_LDI(dst, i) do { dst = *(const u32x4*)(IDX + U_TOK(i) * 128 + 8 * r16); } while (0)
#define U_LDX(dst, i) do { const unsigned char* xp_ = X8s + U_TOK(i) * 128 + 32 * c4; dst[0] = *(const u32x4*)xp_; dst[1] = *(const u32x4*)(xp_ + 16); } while (0)
#define U_LDR(Rset, iv) do { _Pragma("unroll") for (int k = 0; k < 8; ++k) Rset[k] = *(const u32x4*)(U8s + (unsigned)(U_EID(iv, k) * 64 + 16 * c4)); } while (0)
#define U_TOKEN(Rset, iref, xv, i) do { \
        unsigned xlo[4], xhi[4]; int sx = 0; \
        _Pragma("unroll") for (int d = 0; d < 4; ++d) { const unsigned n0 = (d < 2) ? xv[0][2 * d] : xv[1][2 * d - 4], n1 = (d < 2) ? xv[0][2 * d + 1] : xv[1][2 * d - 3]; \
            xlo[d] = __builtin_amdgcn_perm(n1, n0, 0x06040200u); xhi[d] = __builtin_amdgcn_perm(n1, n0, 0x07050301u); \
            sx = __builtin_amdgcn_sdot4((int)n0, 0x01010101, sx, false); sx = __builtin_amdgcn_sdot4((int)n1, 0x01010101, sx, false); } \
        float v[8]; \
        _Pragma("unroll") for (int k = 0; k < 8; ++k) { \
            u32x4 r_ = Rset[k]; asm volatile("" : "+v"(r_)); \
            int acc_ = 0; \
            _Pragma("unroll") for (int d = 0; d < 4; ++d) { acc_ = __builtin_amdgcn_sdot4((int)(r_[d] & 0x0F0F0F0Fu), (int)xlo[d], acc_, false); acc_ = __builtin_amdgcn_sdot4((int)((r_[d] >> 4) & 0x0F0F0F0Fu), (int)xhi[d], acc_, false); } \
            v[k] = (float)(acc_ - 8 * sx); \
            asm volatile("" : "+v"(v[k])); \
            Rset[k] = *(const u32x4*)(U8s + (unsigned)(U_EID(iref, k) * 64 + 16 * c4)); \
        } \
        float a4[4], a2[2]; \
        _Pragma("unroll") for (int k = 0; k < 4; ++k) { const float keep = c1 ? v[k + 4] : v[k], send = c1 ? v[k] : v[k + 4]; a4[k] = keep + dpp_f<0x4E>(send); } \
        _Pragma("unroll") for (int k = 0; k < 2; ++k) { const float keep = c0 ? a4[k + 2] : a4[k], send = c0 ? a4[k] : a4[k + 2]; a2[k] = keep + dpp_f<0xB1>(send); } \
        if ((i) < ntok) PART[U_TOK(i) * 64 + lane] = cvtpk(a2[0], a2[1]); \
    } while (0)
    u32x4 iA, iB, iC, iA2, iB2, iC2, RA[8], RB[8], RC[8], xA[2], xB[2], xC[2], xA2[2], xB2[2], xC2[2];
    U_LDI(iA, 0); U_LDI(iB, 1); U_LDI(iC, 2); U_LDX(xA, 0); U_LDX(xB, 1); U_LDX(xC, 2);
    U_LDR(RA, iA); U_LDR(RB, iB); U_LDR(RC, iC);
    U_LDI(iA, 3); U_LDI(iB, 4); U_LDI(iC, 5);
    asm volatile("" :: "v"(xA[0]), "v"(xA[1]), "v"(RA[0]), "v"(RA[1]), "v"(RA[2]), "v"(RA[3]), "v"(RA[4]), "v"(RA[5]), "v"(RA[6]), "v"(RA[7]));
    for (int i = 0; i < ntok; i += 3) {
        U_LDI(iA2, i + 6); U_LDI(iB2, i + 7); U_LDI(iC2, i + 8); U_LDX(xA2, i + 3); U_LDX(xB2, i + 4); U_LDX(xC2, i + 5);
        U_TOKEN(RA, iA, xA, i);
        U_TOKEN(RB, iB, xB, i + 1);
        U_TOKEN(RC, iC, xC, i + 2);
        iA = iA2; iB = iB2; iC = iC2; xA[0] = xA2[0]; xA[1] = xA2[1]; xB[0] = xB2[0]; xB[1] = xB2[1]; xC[0] = xC2[0]; xC[1] = xC2[1];
    }
#undef U_LDI
#undef U_LDX
#undef U_LDR
#undef U_TOKEN
#undef U_TOK
#undef U_EID
}
__device__ __forceinline__ void peer_w_phase(const Ctx& F0, const Args& a) {
    const Ctx F = fresh(F0);
    const unsigned* PART = (const unsigned*)(a.ws + WS_PART);
    const float* GATE = (const float*)(a.ws + WS_GATE);
    unsigned char* WQ = a.ws + WS_WT;
    float* WSC = (float*)(a.ws + WS_WSC);
    const int gwv = F.vcu * NWAVES + F.wave, NGW = F.G * NWAVES;
    for (int t = gwv; t < ML; t += NGW) {
        f32x2 z = (f32x2){0.f, 0.f};
#pragma unroll
        for (int s = 0; s < 8; ++s) { const unsigned pw = PART[((size_t)s * ML + t) * 64 + F.lane]; z += (f32x2){bflo(pw), bfhi(pw)}; }
        const f32x2 g = *(const f32x2*)(GATE + (size_t)t * 128 + 2 * F.lane);
        f32x2 w; w.x = g.x * gelu_erf(z.x * (1.0f / (U_SCALE * XQ_SCALE))); w.y = g.y * gelu_erf(z.y * (1.0f / (U_SCALE * XQ_SCALE)));
        float wm = fmaxf(__builtin_fabsf(w.x), __builtin_fabsf(w.y));
#pragma unroll
        for (int o = 1; o < 64; o <<= 1) wm = fmaxf(wm, __shfl_xor(wm, o));
        wm = fmaxf(wm, 1e-20f);
        const float qs = 6.0f / wm, ax = fminf(fmaxf(w.x * qs, -6.f), 6.f), ay = fminf(fmaxf(w.y * qs, -6.f), 6.f);
        const unsigned ph = __builtin_amdgcn_cvt_scalef32_pk_fp4_f32(0u, ax, ay, 1.0f, 0) & 0xffu;
        const f32x2 dh = FP4_DEC(ph, 0);
        const unsigned pl = __builtin_amdgcn_cvt_scalef32_pk_fp4_f32(0u, fminf(fmaxf(4.f * (ax - dh.x), -6.f), 6.f), fminf(fmaxf(4.f * (ay - dh.y), -6.f), 6.f), 1.0f, 0) & 0xffu;
        ((unsigned short*)WQ)[(size_t)t * 128 + F.lane] = (unsigned short)((ph & 0xfu) | ((ph & 0xf0u) << 4));
        ((unsigned short*)WQ)[(size_t)t * 128 + 64 + F.lane] = (unsigned short)((pl & 0xfu) | ((pl & 0xf0u) << 4));
        if (F.lane == 0) WSC[t] = wm * (1.0f / 6.0f);
    }
}
#define V_MFMA4_FIRST(acc, av, bv, sa) asm volatile("v_mfma_scale_f32_16x16x128_f8f6f4 %0, %1, %2, 0, %3, %4 op_sel_hi:[0,0,0] cbsz:4 blgp:4" : "=&v"(acc) : "v"(av), "v"(bv), "v"(sa), "v"(sc_one))
#define V_MFMA4(acc, av, bv, sa) asm volatile("v_mfma_scale_f32_16x16x128_f8f6f4 %0, %1, %2, %0, %3, %4 op_sel_hi:[0,0,0] cbsz:4 blgp:4" : "+v"(acc) : "v"(av), "v"(bv), "v"(sa), "v"(sc_one))
template <int VAR = 0>
__device__ __forceinline__ void peer_v_phase(const Ctx& F0, const Args& a, int layer, float oscale = 1.0f) {
    const Ctx F = fresh(F0);
    const int s = (int)(blockIdx.x & 3), half = (int)((blockIdx.x >> 2) & 1), j = (int)(blockIdx.x >> 3), nmem = F.G >> 3;
    const unsigned char* V4s = a.ws + WS_TAB + (size_t)layer * TAB_LAYER + TAB_VOFF + (size_t)s * NEXP * 128;
    const unsigned short* IDX = (const unsigned short*)(a.ws + WS_IDX);
    const unsigned char* WQ = a.ws + WS_WT;
    const float* WSC = (const float*)(a.ws + WS_WSC);
    const float* modb = (const float*)(a.ws + WS_MOD) + (size_t)layer * 9 * NMOD;
    float* X = a.out;
    const int lane = F.lane, rsub = lane >> 3, c8 = lane & 7, n16 = lane & 15, g4 = lane >> 4;
    LAS unsigned char* tile = F.lds + F.wave * 16384;
    const float osc = ((DBG_SKIP & (layer == 0 ? 2 : 8)) ? 0.f : oscale) * (1.0f / V_SCALE);
    constexpr int MLH = ML / 2;
    const int t0 = half * MLH + j * NWAVES + F.wave, stride = nmem * NWAVES, ntok = (half * MLH + MLH - t0 + stride - 1) / stride;
    unsigned sc_one = 0x7f7f7f7fu; asm volatile("" : "+v"(sc_one));
    typedef int v2i_t __attribute__((ext_vector_type(2)));
    LAS float* gl = (LAS float*)(F.lds + RING_BYTES + 4096);
    for (int u = F.tid; u < 4 * 256; u += NWAVES * 64) gl[u] = modb[(size_t)(4 * half + (u >> 8)) * NMOD + 5 * DM + 256 * s + (u & 255)] * osc;
    __syncthreads();
#define V_TOK(i) ((size_t)(t0 + ((i) < ntok ? (i) : ntok - 1) * stride))
    LAS unsigned char* wx[4]; LAS unsigned char* rb[4];
#pragma unroll
    for (int k = 0; k < 4; ++k) wx[k] = tile + rsub * 2048 + ((c8 ^ k ^ ((rsub & 1) << 2)) << 4);
#pragma unroll
    for (int nb = 0; nb < 4; ++nb) rb[nb] = tile + g4 * 2048 + (n16 >> 1) * 128 + 8 * (n16 & 1) + ((nb ^ ((n16 >> 2) & 3) ^ ((g4 & 1) << 2)) << 4);
    LAS unsigned char* stg = tile + g4 * 1024 + n16 * 8;
#define V_LDW(i) (((const unsigned*)WQ)[V_TOK(i) * 64 + lane])
#define V_LDI(i) (((const unsigned*)IDX)[V_TOK(i) * 64 + lane])
#define V_LDX(i) (*(const f32x4*)(X + V_TOK(i) * DM + 256 * s + 4 * lane))
#define V_LDS(i) (WSC[V_TOK(i)])
#define V_IDP(dst, ci) do { _Pragma("unroll") for (int k = 0; k < 8; ++k) dst[k] = (unsigned)__builtin_amdgcn_ds_bpermute((8 * rsub + k) * 4, (int)(ci)); } while (0)
#define V_EIDP(idp, i_) (((i_) & 1) ? (idp[(i_) >> 1] >> 16) : (idp[(i_) >> 1] & 0xffffu))
#define V_READS(nb0) do { \
        unsigned x64 = (nb0) ? 64u : 0u; asm volatile("" : "+v"(x64));                   \
        _Pragma("unroll") for (int nb = 0; nb < 4; ++nb) { LAS unsigned char* rbn = (LAS unsigned char*)((unsigned)(size_t)rb[nb] ^ x64); \
          _Pragma("unroll") for (int h = 0; h < 2; ++h) { _Pragma("unroll") for (int q = 0; q < 2; ++q) { \
            const v2i_t tr = __builtin_amdgcn_ds_read_tr8_b64_v2i32((LAS v2i_t*)(rbn + 8192 * h + 1024 * q)); \
            bw[nb][h][2 * q] = (unsigned)tr[0]; bw[nb][h][2 * q + 1] = (unsigned)tr[1]; } } } \
        __builtin_amdgcn_sched_barrier(0); \
    } while (0)
#define V_MFMAS() do { \
        _Pragma("unroll") for (int nb = 0; nb < 4; ++nb) V_MFMA4_FIRST(dA[nb], aop[0], bw[nb][0], sc_a); \
        _Pragma("unroll") for (int nb = 0; nb < 4; ++nb) V_MFMA4(dA[nb], aop[1], bw[nb][1], sc_a); \
        __builtin_amdgcn_sched_barrier(0); \
    } while (0)
#define V_OUTS(nb0) do { \
        asm volatile("s_nop 15\n\ts_nop 3" : "+v"(dA[0]), "+v"(dA[1]), "+v"(dA[2]), "+v"(dA[3]) :: "memory");     \
        _Pragma("unroll") for (int nb = 0; nb < 4; ++nb) { ov[(nb0) + nb] = (f32x2){dA[nb][0] + dA[nb][2], dA[nb][1] + dA[nb][3]}; asm volatile("" : "+v"(ov[(nb0) + nb])); } \
    } while (0)
#define V_BODY(j, CUR, NXT, LD) do { \
        const size_t t_ = V_TOK(j); \
        unsigned idp[8]; \
        V_IDP(idp, ci##NXT);                                             \
          \
        _Pragma("unroll") for (int i_ = 0; i_ < 16; ++i_) { \
            *(LAS u32x4*)(wx[(i_ >> 1) & 3] + i_ * 128) = R[i_]; \
            if (VAR == 0 || (VAR == 1 && i_ < 8)) R[i_] = *(const u32x4*)(V4s + (unsigned)(V_EIDP(idp, i_) * 128 + 16 * c8)); \
        } \
          \
        u32x4 aop[2]; \
        _Pragma("unroll") for (int h = 0; h < 2; ++h) { _Pragma("unroll") for (int k = 0; k < 4; ++k) { \
            const unsigned w_ = (unsigned)__builtin_amdgcn_ds_bpermute(abase + (16 * h + k) * 4, (int)cw##CUR); \
            aop[h][k] = (n16 < 4) ? (w_ << ash) : 0u; } } \
        asm volatile("s_waitcnt lgkmcnt(0)" ::: "memory");               \
        f32x4 dA[4]; u32x4 bw[4][2]; f32x2 ov[8]; \
        V_READS(0); \
        V_MFMAS(); \
          \
        ci##CUR = V_LDI((j) + 3); cw##LD = V_LDW((j) + 2); xo##LD = V_LDX((j) + 2); ws##LD = V_LDS((j) + 2); \
        __builtin_amdgcn_sched_barrier(0); \
        V_READS(4);                                                      \
        V_OUTS(0); \
        V_MFMAS(); \
        V_OUTS(4); \
          \
        _Pragma("unroll") for (int nb = 0; nb < 8; ++nb) *(LAS f32x2*)(stg + nb * 128) = ov[nb]; \
        asm volatile("s_waitcnt lgkmcnt(0)" ::: "memory"); \
        const f32x4 sum = *(const LAS f32x4*)(tile + 16 * lane); \
        const f32x4 gt_ = *(const LAS f32x4*)(gl + ((t_ >> 12) & 3) * 256 + 4 * lane); \
        asm volatile("s_waitcnt lgkmcnt(0)" ::: "memory"); \
        if ((j) < ntok) *(f32x4*)(X + t_ * DM + 256 * s + 4 * lane) = xo##CUR + gt_ * ws##CUR * sum; \
    } while (0)
    u32x4 R[16];
    unsigned cwA, cwB, cwC, ciA, ciB, ciC;
    f32x4 xoA, xoB, xoC;
    float wsA, wsB, wsC;
    const int abase = (32 * ((n16 >> 1) & 1) + 4 * g4) * 4, ash = 4 * (n16 & 1);
    unsigned sc_a = (n16 & 2) ? 0x7d7d7d7du : 0x7f7f7f7fu; asm volatile("" : "+v"(sc_a));
    ciA = V_LDI(0);
    cwA = V_LDW(0); cwB = V_LDW(1); xoA = V_LDX(0); xoB = V_LDX(1); wsA = V_LDS(0); wsB = V_LDS(1);
    { unsigned idp0[8]; V_IDP(idp0, ciA);
#pragma unroll
      for (int i_ = 0; i_ < 16; ++i_) R[i_] = *(const u32x4*)(V4s + (unsigned)(V_EIDP(idp0, i_) * 128 + 16 * c8)); }
    ciB = V_LDI(1); ciC = V_LDI(2);
    cwC = 0u; xoC = (f32x4){0.f, 0.f, 0.f, 0.f}; wsC = 0.f;
    asm volatile("" :: "v"(ciC));
    for (int i = 0; i < ntok; i += 3) {
        V_BODY(i, A, B, C);
        V_BODY(i + 1, B, C, A);
        V_BODY(i + 2, C, A, B);
    }
#undef V_BODY
#undef V_READS
#undef V_MFMAS
#undef V_OUTS
#undef V_LDW
#undef V_LDI
#undef V_LDX
#undef V_LDS
#undef V_IDP
#undef V_EIDP
#undef V_TOK
}
#undef V_MFMA4_FIRST
#undef V_MFMA4

__device__ __forceinline__ void dft_nyquist_rows(const Ctx& F0, const Args& a) {
    const Ctx F = fresh(F0);
    const unsigned char* Yt = a.ws + WS_QK;
    unsigned char* Fo = a.ws + WS_VT;
    const int gwv = F.vcu * NWAVES + F.wave, NGW = F.G * NWAVES;
    for (int o = gwv; o < NB * DM; o += NGW) {
        const unsigned char* src = Yt + (size_t)o * 8192;
        float s = 0.f;
#pragma unroll
        for (int it = 0; it < 4; ++it) { const u32x4 v = *(const u32x4*)(src + it * 1024 + F.lane * 16);
#pragma unroll
            for (int d = 0; d < 4; ++d) { const f32x2 lo = __builtin_amdgcn_cvt_pk_f32_fp8((int)v[d], false), hi = __builtin_amdgcn_cvt_pk_f32_fp8((int)v[d], true); s += (lo[0] - lo[1]) + (hi[0] - hi[1]); } }
        s = wave_sum(s) * (pg8::ACT8_SCALE / (64.0f * pg8::YT_SCALE));
        if (F.lane == 0) Fo[((size_t)(o >> 10) * SEQ + 2048) * DM + (o & 1023)] = (unsigned char)(fp8_pack4(s, 0.f, 0.f, 0.f) & 0xffu);
    }
}

__global__ void __launch_bounds__(NWAVES * 64, 2) fwd_kernel(Args args) {
    extern __shared__ __attribute__((aligned(16))) unsigned char lds_raw[];
    Ctx F;
    F.lds = (LAS unsigned char*)lds_raw;
    F.tid = threadIdx.x; F.lane = F.tid & 63; F.wave = __builtin_amdgcn_readfirstlane(F.tid >> 6);
    F.G = gridDim.x; { const int bx = blockIdx.x; F.vcu = (F.G % 8 == 0) ? (bx % 8) * (F.G / 8) + bx / 8 : bx; }
    volatile LAS unsigned* MISC = (volatile LAS unsigned*)(F.lds + MISC_OFF);
    for (int u = F.tid; u < (LDS_BYTES - LDSCTL_OFF) / 4; u += NWAVES * 64) ((LAS unsigned*)(F.lds + LDSCTL_OFF))[u] = 0u;
    __syncthreads();
    unsigned char* ws = args.ws;
    XcdBarrier bar = xcd_barrier_post((unsigned*)(ws + WS_CTL) + CW_BAR, MISC + 8);
#define GRID_BAR() xcd_barrier(bar)
#ifndef DBG_REP
#define DBG_REP 0
#endif
#ifndef DBG_VVAR
#define DBG_VVAR 0
#endif
#define REP(k, ...) do { __VA_ARGS__; if (DBG_REP == (k)) { GRID_BAR(); __VA_ARGS__; } } while (0)
#define PEER_BLOCK(layer) do { \
        norm_phase(F, args, 1, layer, 3 * DM, args.in[5] + (layer) * DM); \
        GRID_BAR(); \
        { using SHq = pg8::Shape<ML, 2048, DM, DM, DM, 1, 0, 0>; \
          REP(7, pg8::gemm_phase<SHq>(F.lds, pg8::Gemm{HX, (const bf16_t*)(ws + WS_WPQ) + (size_t)(layer) * 2048 * DM}, F.G, bx, pg8::EpiStoreBf16{QKb, 2048, 0, 0, 1.0f})); } \
        GRID_BAR(); \
        REP(8, peer_topk_phase(F, args, layer)); \
        GRID_BAR(); \
        REP(9, peer_u_phase(F, args, layer)); \
        GRID_BAR(); \
        REP(10, peer_w_phase(F, args)); \
        GRID_BAR(); \
        peer_v_phase(F, args, layer); if (DBG_REP == 11) { GRID_BAR(); peer_v_phase<DBG_VVAR>(F, args, layer, 0.f); } \
        GRID_BAR(); \
    } while (0)
    const float* modb = (const float*)(ws + WS_MOD);
    bf16_t* HX = (bf16_t*)(ws + WS_HX);
    bf16_t* QKb = (bf16_t*)(ws + WS_QK);
    bf16_t* VTb = (bf16_t*)(ws + WS_VT);
    const bf16_t* Wqkv = (const bf16_t*)(ws + WS_WQKV);
    const int bx = (int)blockIdx.x;

    REP(1, p0_prologue(F, args));
    GRID_BAR();
    REP(2, norm_phase(F, args, 0, 0, 0, args.in[4]));
    GRID_BAR();
    {
        constexpr float o8 = 1.0f / (pg8::ACT8_SCALE * pg8::W8_SCALE);
        using SH1 = pg8::Shape<MT, 2048, DM / 2, DM / 2, DM / 2, 1, 0, 0>;
        pg8::gemm_phase<SH1, pg8::EpiStoreBf16, true>(F.lds, pg8::Gemm{HX, Wqkv}, F.G, bx, pg8::EpiStoreBf16{QKb, 2048, 0, 1024, 0.125f * LOG2E, o8});
        using SH2 = pg8::Shape<DM, MT, DM / 2, DM / 2, DM / 2, 1, 0, 0>;
        pg8::gemm_phase<SH2, pg8::EpiStoreBf16, true>(F.lds, pg8::Gemm{Wqkv + (size_t)2048 * DM / 2, HX}, F.G, bx, pg8::EpiStoreBf16{VTb, MT, 0, 0, 1.0f, o8});
        {
            const int nq = (MT / 256) * 8, nv = 4 * (MT / 256), rq = nq % F.G, rv = nv % F.G;
            const int sh_q = (rq == 0 || bx >= rq) ? 1 : 0, sh_v = (rv == 0 || bx >= rv) ? 1 : 0;
            const int before = (rq == 0 ? bx : max(0, bx - rq)) + (rv == 0 ? bx : max(0, bx - rv));
            const int total = (rq == 0 ? F.G : F.G - rq) + (rv == 0 ? F.G : F.G - rv);
            table_convert(F, args, before, sh_q + sh_v, total);
        }
    }
    GRID_BAR();
    REP(4, attn_phase(F, args));
    GRID_BAR();
    {
        using SH = pg8::Shape<ML, DM, DM / 2, DM / 2, DM / 2, 1, 0, 0>;
        pg8::gemm_phase<SH, pg8::EpiResid, true>(F.lds, pg8::Gemm{(const bf16_t*)(ws + WS_HX + 36 * MiB), (const bf16_t*)(ws + WS_WO)}, F.G, bx, pg8::EpiResid{args.in[0], args.out, modb + 2 * DM, NMOD, ((DBG_SKIP & 1) ? 0.f : 1.f) / (pg8::ACT8_SCALE * pg8::W8_SCALE)});
    }
    GRID_BAR();
    PEER_BLOCK(0);
    norm_phase(F, args, 1, 1, 0, args.in[4] + DM);
    GRID_BAR();
    {
        using SH = pg8::Shape<512, ML, 256, 256, DM, 4, 0, 256>;
        pg8::gemm_phase<SH>(F.lds, pg8::Gemm{(const bf16_t*)(ws + WS_WC), HX}, F.G, bx, pg8::EpiYt{(unsigned char*)QKb});
    }
    GRID_BAR();
    {
        using SH = pg8::Shape<SEQ / 2, DM, 4096, 4096, 4096, NB, 0, (long)DM * 4096>;
        REP(14, pg8::gemm_phase<SH, pg8::EpiDft2, true>(F.lds, pg8::Gemm{(const bf16_t*)(ws + WS_CS), QKb}, F.G, bx, pg8::EpiDft2{(unsigned char*)VTb}));
        dft_nyquist_rows(F, args);
    }
    GRID_BAR();
    {
        using SH = pg8::Shape<ML, DM, DM / 2, DM / 2, DM / 2, 1, 0, 0>;
        pg8::gemm_phase<SH, pg8::EpiResid, true>(F.lds, pg8::Gemm{VTb, (const bf16_t*)(ws + WS_WF)}, F.G, bx, pg8::EpiResid{args.out, args.out, modb + (size_t)9 * NMOD + 2 * DM, NMOD, ((DBG_SKIP & 4) ? 0.f : 1.f) / (pg8::ACT8_SCALE * pg8::W8_SCALE)});
    }
    GRID_BAR();
    PEER_BLOCK(1);
    final_norm_phase(F, args);
#undef PEER_BLOCK
}

extern "C" void kernel_launch(void* const* d_in, const int* in_sizes, int n_in, void* d_out, int out_size, void* d_ws, size_t ws_size, hipStream_t stream) {
    static int grid = 0;
    if (grid == 0) {
        if (n_in != 17 || in_sizes[0] != ML * DM || out_size != ML * DM || ws_size < WS_END) { fprintf(stderr, "kernel_launch: unexpected shapes (n_in %d, in0 %d, out %d, ws %zu)\n", n_in, n_in > 0 ? in_sizes[0] : -1, out_size, ws_size); grid = -1; return; }
        int dev = 0, cus = 0, per_cu = 0;
        if (hipGetDevice(&dev) != hipSuccess || hipDeviceGetAttribute(&cus, hipDeviceAttributeMultiprocessorCount, dev) != hipSuccess) { grid = -1; return; }
        if (hipFuncSetAttribute((const void*)fwd_kernel, hipFuncAttributeMaxDynamicSharedMemorySize, LDS_BYTES) != hipSuccess) { fprintf(stderr, "kernel_launch: hipFuncSetAttribute failed\n"); grid = -1; return; }
        if (hipOccupancyMaxActiveBlocksPerMultiprocessor(&per_cu, (const void*)fwd_kernel, NWAVES * 64, LDS_BYTES) != hipSuccess || per_cu < 1)
            fprintf(stderr, "kernel_launch: note: occupancy query reports %d workgroups per CU\n", per_cu);
        (void)hipGetLastError();
        grid = cus;
        if (grid % 8 != 0) { fprintf(stderr, "kernel_launch: CU count %d is not a multiple of 8\n", cus); grid = -1; return; }
    }
    if (grid < 0) return;
    if (hipMemsetAsync((char*)d_ws + WS_CTL, 0, CTL_ZERO_BYTES, stream) != hipSuccess) { fprintf(stderr, "kernel_launch: memset failed\n"); return; }
    Args a{};
    for (int i = 0; i < 17; ++i) a.in[i] = (const float*)d_in[i];
    a.out = (float*)d_out; a.ws = (unsigned char*)d_ws;
    hipLaunchKernelGGL(fwd_kernel, dim3(grid), dim3(NWAVES * 64), LDS_BYTES, stream, a);
    const hipError_t le = hipPeekAtLastError();
    if (le != hipSuccess) fprintf(stderr, "kernel_launch: launch failed: %s\n", hipGetErrorName(le));
}
```

```cpp
#include <hip/hip_runtime.h>
#include <cstdio>
#include <cstdint>

#define LAS __attribute__((address_space(3)))
typedef unsigned short bf16_t;
typedef short bf16x8 __attribute__((ext_vector_type(8)));
typedef short s16x4 __attribute__((ext_vector_type(4)));
typedef float f32x2 __attribute__((ext_vector_type(2)));
typedef float f32x4 __attribute__((ext_vector_type(4)));
typedef float f32x16 __attribute__((ext_vector_type(16)));
typedef unsigned u32x2 __attribute__((ext_vector_type(2)));
typedef unsigned u32x4 __attribute__((ext_vector_type(4)));
typedef __bf16 bf16x2_t __attribute__((ext_vector_type(2)));

#ifndef DBG_SKIP
#define DBG_SKIP 0
#endif
constexpr int DM = 1024, NB = 8, SEQ = 4096, CTXL = 256, GW = 64;
constexpr int ML = NB * SEQ;
constexpr int MC = NB * CTXL;
constexpr int MT = ML + MC;
constexpr int NMOD = 6 * DM;
constexpr int NEXP = 16384;
constexpr float EPS = 1e-6f;
constexpr float LOG2E = 1.4426950408889634f;

constexpr size_t MiB = 1u << 20;
constexpr size_t WS_CTL = 0, CTL_ZERO_BYTES = 1 * MiB;
constexpr size_t WS_MOD = 1 * MiB;
constexpr size_t WS_WQKV = 2 * MiB;
constexpr size_t WS_WO = 8 * MiB;
constexpr size_t WS_WF = 10 * MiB;
constexpr size_t WS_WPQ = 12 * MiB;
constexpr size_t WS_SK = 20 * MiB;
constexpr size_t WS_WC = 20 * MiB + 256 * 1024;
constexpr size_t WS_CS = 22 * MiB;
constexpr size_t WS_TAB = 38 * MiB;
constexpr size_t WS_X8 = 150 * MiB;
constexpr size_t WS_WT = 182 * MiB;
constexpr size_t WS_PART = 282 * MiB;
constexpr float U_SCALE = 96.f;
constexpr float XQ_SCALE = 15.875f;
constexpr float V_SCALE = 2.f;
constexpr size_t WS_XB = 70 * MiB;
constexpr size_t TAB_LAYER = 16 * MiB, TAB_VOFF = 8 * MiB;
constexpr size_t WS_WSC = 198 * MiB;
constexpr size_t WS_HX = 214 * MiB;
constexpr size_t WS_QK = 282 * MiB;
constexpr size_t WS_VT = 418 * MiB;
constexpr size_t WS_IDX = WS_VT;
constexpr size_t WS_GATE = WS_VT + 8 * MiB;
constexpr size_t WS_END = 486 * MiB;
constexpr int CW_BAR = 4096;

__device__ __forceinline__ unsigned f2bf(float f) { unsigned u = __builtin_bit_cast(unsigned, f); return (u + 0x7fffu + ((u >> 16) & 1u)) >> 16; }
__device__ __forceinline__ unsigned pk2(float lo, float hi) { return f2bf(lo) | (f2bf(hi) << 16); }
__device__ __forceinline__ f32x4 bf4_f32(u32x2 w) { return (f32x4){__builtin_bit_cast(float, w.x << 16), __builtin_bit_cast(float, w.x & 0xffff0000u), __builtin_bit_cast(float, w.y << 16), __builtin_bit_cast(float, w.y & 0xffff0000u)}; }
__device__ __forceinline__ unsigned cvtpk(float lo, float hi) { f32x2 v = {lo, hi}; bf16x2_t b = __builtin_convertvector(v, bf16x2_t); return __builtin_bit_cast(unsigned, b); }
__device__ __forceinline__ float bflo(unsigned u) { return __builtin_bit_cast(float, u << 16); }
__device__ __forceinline__ float bfhi(unsigned u) { return __builtin_bit_cast(float, u & 0xffff0000u); }
__device__ __forceinline__ float wave_sum(float v) {
#pragma unroll
    for (int o = 1; o < 64; o <<= 1) v += __shfl_xor(v, o);
    return v;
}
__device__ __forceinline__ unsigned fp8_pack4(float a, float b, float c, float d) {
    int w = 0;
    w = __builtin_amdgcn_cvt_pk_fp8_f32(__builtin_amdgcn_fmed3f(a, -448.f, 448.f), __builtin_amdgcn_fmed3f(b, -448.f, 448.f), w, false);
    w = __builtin_amdgcn_cvt_pk_fp8_f32(__builtin_amdgcn_fmed3f(c, -448.f, 448.f), __builtin_amdgcn_fmed3f(d, -448.f, 448.f), w, true);
    return (unsigned)w;
}
__device__ __forceinline__ int crow(int r, int hi) { return (r & 3) + 8 * (r >> 2) + 4 * hi; }
__device__ __forceinline__ float gelu_erf(float v) {
    const float av = __builtin_fabsf(v), d = av * 0.2316418882f + 1.0f;
    const float t = __builtin_amdgcn_rcpf(d);
    float q = t * 0.5307027145f + (-0.7265760135f); q = q * t + 0.7107068705f; q = q * t + (-0.142248368f); q = q * t + 0.127414796f; q = q * t;
    const float e = __builtin_amdgcn_exp2f((v * v) * (-0.72134752044f));
    const float m = v * (q * e), r = v - m;
    return v < 0.f ? m : r;
}

namespace pg8 {
constexpr float ACT8_SCALE = 16.f, W8_SCALE = 256.f;
constexpr float YT_SCALE = 16.f, CS_SCALE = 512.f;
constexpr int BM = 256, BK = 64, HALF = 128, HTB = HALF * BK * 2, STAGE_BYTES = 8 * HTB, NXCD = 8, WGM = 8;
__host__ __device__ __forceinline__ int lds_byte(int r, int c) { const int st = (r >> 4) * 2 + (c >> 5), rr = r & 15, cc = c & 31, ob = rr * 64 + cc * 2; return st * 1024 + (ob ^ (((ob >> 9) & 1) << 5)); }
__host__ __device__ __forceinline__ void stage_rc(int b, int& R, int& C) { const int st = b / 1024, sb = b % 1024, swz = sb ^ (((sb >> 9) & 1) << 5); R = (st >> 1) * 16 + swz / 64; C = (st & 1) * 32 + (swz % 64) / 2; }
__host__ __device__ __forceinline__ int perm32(int rho) { const int n = rho >> 4, i = rho & 15; return 8 * (i >> 2) + 4 * n + (i & 3); }

struct Unit { int pm, pn, pb; };
struct Gemm { const bf16_t* A; const bf16_t* Bt; };
template <int M_, int N_, int K_, int LDA_, int LDB_, int NBATCH_, long BSA_, long BSB_> struct Shape { static constexpr int M = M_, N = N_, K = K_, lda = LDA_, ldb = LDB_, nbatch = NBATCH_; static constexpr long bsA = BSA_, bsB = BSB_; };

template <class SH> struct StaticOrder {
    static constexpr int nM = SH::M / BM, nN = SH::N / BM, per = nM * nN, nwg = per * SH::nbatch;
    int G, c;
    __device__ __forceinline__ void init(int G_, int c_) { G = G_; c = c_; }
    __device__ __forceinline__ bool next(int i, Unit& u) const {
        const long L = (long)i * G + c; if (L >= nwg) return false;
        int wgid = (int)L; { const int q = nwg / NXCD, r = nwg % NXCD, xcd = wgid % NXCD, off = wgid / NXCD; wgid = (xcd < r ? xcd * (q + 1) : r * (q + 1) + (xcd - r) * q) + off; }
        u.pb = wgid / per; wgid -= u.pb * per;
        const int nig = WGM * nN, gid = wgid / nig, fm = gid * WGM, gsz = (nM - fm) < WGM ? (nM - fm) : WGM;
        u.pm = fm + ((wgid % nig) % gsz); u.pn = (wgid % nig) / gsz; return true;
    }
};

struct EpiStoreBf16 {
    static constexpr bool PERM = true;
    bf16_t* O; long ldc; long bstride; int scols; float scale0; float oscale = 1.0f;
    __device__ __forceinline__ void operator()(const f32x4 (&acc)[2][2][4][2], const Unit& u, int wr, int wc, int fr, int fq) const {
        const int row0 = u.pm * BM + wr * 64 + fr, col0 = u.pn * BM + wc * 32 + 8 * fq;
        bf16_t* base = O + (long)u.pb * bstride;
        const float sc = ((u.pn * BM < scols) ? scale0 : 1.0f) * oscale;
#pragma unroll
        for (int ai = 0; ai < 2; ++ai)
#pragma unroll
            for (int m = 0; m < 4; ++m) { bf16_t* rowp = base + (long)(row0 + ai * HALF + m * 16) * ldc + col0;
#pragma unroll
                for (int bj = 0; bj < 2; ++bj) { const f32x4 v0 = acc[ai][bj][m][0] * sc, v1 = acc[ai][bj][m][1] * sc;
                    u32x4 w; w.x = cvtpk(v0[0], v0[1]); w.y = cvtpk(v0[2], v0[3]); w.z = cvtpk(v1[0], v1[1]); w.w = cvtpk(v1[2], v1[3]);
                    *(u32x4*)(rowp + bj * HALF) = w; } }
    }
};
struct EpiDft2 {
    static constexpr bool PERM = true;
    unsigned char* O;
    __device__ __forceinline__ void operator()(const f32x4 (&acc)[2][2][4][2], const Unit& u, int wr, int wc, int fr, int fq) const {
        const int row0 = u.pm * BM + wr * 64 + fr, cl0 = wc * 32 + 8 * fq;
        unsigned char* base = O + (long)u.pb * SEQ * DM + u.pn * BM;
        constexpr float osc = ACT8_SCALE / (YT_SCALE * CS_SCALE);
#pragma unroll
        for (int ai = 0; ai < 2; ++ai)
#pragma unroll
            for (int m = 0; m < 4; ++m) { const int np = row0 + ai * HALF + m * 16;
                unsigned char* rowp = base + (long)np * DM; unsigned char* mirp = base + (long)(SEQ - np) * DM;
#pragma unroll
                for (int bj = 0; bj < 2; ++bj) { const f32x4 v0 = acc[ai][bj][m][0] * osc, v1 = acc[ai][bj][m][1] * osc; const int cl = cl0 + bj * HALF;
                    u32x2 w; w.x = fp8_pack4(v0[0], v0[1], v0[2], v0[3]); w.y = fp8_pack4(v1[0], v1[1], v1[2], v1[3]);
                    *(u32x2*)(rowp + cl) = w;
                    if (np != 0) {
#pragma unroll
                        for (int i = 0; i < 8; ++i) mirp[(256 - cl - i) & 255] = (unsigned char)((w[i >> 2] >> (8 * (i & 3))) & 0xffu); } }
                asm volatile("" ::: "memory"); }
    }
};
struct EpiYt {
    static constexpr bool PERM = true;
    unsigned char* Yt;
    __device__ __forceinline__ void operator()(const f32x4 (&acc)[2][2][4][2], const Unit& u, int wr, int wc, int fr, int fq) const {
        const int row0 = u.pm * BM + wr * 64 + fr, col0 = u.pn * BM + wc * 32 + 8 * fq;
#pragma unroll
        for (int ai = 0; ai < 2; ++ai)
#pragma unroll
            for (int m = 0; m < 4; ++m) { const int row = row0 + ai * HALF + m * 16; const int part = row >> 8, cp = row & 255;
#pragma unroll
                for (int bj = 0; bj < 2; ++bj) { const int col = col0 + bj * HALF; const int b = col >> 12, n = col & 4095;
                    const f32x4 v0 = acc[ai][bj][m][0] * YT_SCALE, v1 = acc[ai][bj][m][1] * YT_SCALE;
                    u32x2 w; w.x = fp8_pack4(v0[0], v0[1], v0[2], v0[3]); w.y = fp8_pack4(v1[0], v1[1], v1[2], v1[3]);
                    *(u32x2*)(Yt + ((((long)(b * 4 + u.pb) * 256 + cp) * 2 + part) << 12) + n) = w; }
                asm volatile("" ::: "memory"); }
    }
};
template <bool IN_BF16>
struct EpiResid {
    static constexpr bool PERM = false;
    const void* Xin; bf16_t* Xout; const float* gate; int gstride; float gs;
    __device__ __forceinline__ void operator()(const f32x4 (&acc)[2][2][4][2], const Unit& u, int wr, int wc, int fr, int fq) const {
        const int row0 = u.pm * BM + wr * 64 + fr, col0 = u.pn * BM + wc * 32 + 4 * fq;
        const float* gb = gate + (long)((u.pm * BM) >> 12) * gstride;
        f32x4 gv[2][2];
#pragma unroll
        for (int bj = 0; bj < 2; ++bj)
#pragma unroll
            for (int n = 0; n < 2; ++n) gv[bj][n] = *(const f32x4*)(gb + col0 + bj * HALF + n * 16);
#pragma unroll
        for (int ai = 0; ai < 2; ++ai)
#pragma unroll
            for (int m = 0; m < 4; ++m) { const long off = (long)(row0 + ai * HALF + m * 16) * DM + col0;
#pragma unroll
                for (int bj = 0; bj < 2; ++bj)
#pragma unroll
                    for (int n = 0; n < 2; ++n) { const long o_ = off + bj * HALF + n * 16;
                        const f32x4 bs = IN_BF16 ? bf4_f32(*(const u32x2*)((const bf16_t*)Xin + o_)) : *(const f32x4*)((const float*)Xin + o_);
                        const f32x4 r_ = bs + gv[bj][n] * acc[ai][bj][m][n] * gs;
                        *(u32x2*)(Xout + o_) = (u32x2){cvtpk(r_.x, r_.y), cvtpk(r_.z, r_.w)}; }
                if (m & 1) asm volatile("" ::: "memory"); }
    }
};

template <class SH, class Epi, bool FP8 = false>
__device__ __forceinline__ void gemm_phase(LAS unsigned char* lds, const Gemm g, int G_, int c_, const Epi& E) {
    StaticOrder<SH> S; S.init(G_, c_);
    int tid_ = threadIdx.x; asm volatile("" : "+v"(tid_));
    const int tid = tid_, wid = __builtin_amdgcn_readfirstlane(tid >> 6), lane = tid & 63, wr = wid >> 2, wc = wid & 3, fr = lane & 15, fq = lane >> 4;
    constexpr int K = SH::K, nt = K / BK;
    unsigned voffA[2], voffB[2];
#pragma unroll
    for (int i = 0; i < 2; ++i) { int R, C; stage_rc(tid * 16 + i * 8192, R, C); const int Rb = Epi::PERM ? ((R & ~31) + perm32(R & 31)) : R;
        voffA[i] = (unsigned)(R * SH::lda + C) * 2u; voffB[i] = (unsigned)(Rb * SH::ldb + C) * 2u; }
    constexpr size_t kstep = (size_t)(BK * 2);
    constexpr size_t hstepA = (size_t)HALF * SH::lda * 2, hstepB = (size_t)HALF * SH::ldb * 2;
    constexpr size_t tstepA = 2 * hstepA, tstepB = 2 * hstepB;
    const unsigned ldsw = (unsigned)wid * 1024u;
    const int aoff = lds_byte(wr * 64 + fr, fq * 8), boff = lds_byte(wc * 32 + fr, fq * 8);
#define PG8_SA(b, h) (((b) * 2 + (h)) * HTB)
#define PG8_SB(b, h) ((4 + (b) * 2 + (h)) * HTB)
#define PG8_STAGE(bufoff, gbase, voff) do { _Pragma("unroll") for (int _i = 0; _i < 2; ++_i) \
        __builtin_amdgcn_global_load_lds((const unsigned*)((const char*)(gbase) + (voff)[_i]), (LAS unsigned*)(lds + (bufoff) + ldsw + _i * 8192), 16, 0, 0); } while (0)
#define PG8_LDA(dst, b, h) do { _Pragma("unroll") for (int m = 0; m < 4; ++m) { const u32x4 f0_ = *(const LAS u32x4*)(lds + PG8_SA(b, h) + aoff + m * 2048), f1_ = *(const LAS u32x4*)(lds + PG8_SA(b, h) + aoff + m * 2048 + 1024); dst[m] = __builtin_shufflevector(f0_, f1_, 0, 1, 2, 3, 4, 5, 6, 7); } } while (0)
#define PG8_LDB(dst, b, h) do { _Pragma("unroll") for (int n = 0; n < 2; ++n) { const u32x4 f0_ = *(const LAS u32x4*)(lds + PG8_SB(b, h) + boff + n * 2048), f1_ = *(const LAS u32x4*)(lds + PG8_SB(b, h) + boff + n * 2048 + 1024); dst[n] = __builtin_shufflevector(f0_, f1_, 0, 1, 2, 3, 4, 5, 6, 7); } } while (0)
typedef int v8i_t __attribute__((ext_vector_type(8)));
typedef unsigned u32x8 __attribute__((ext_vector_type(8)));
#define PG8_LOH(x) __builtin_bit_cast(bf16x8, __builtin_shufflevector(x, x, 0, 1, 2, 3))
#define PG8_HIH(x) __builtin_bit_cast(bf16x8, __builtin_shufflevector(x, x, 4, 5, 6, 7))
#define PG8_MMA(ai, bj, At, Bt) do { __builtin_amdgcn_s_setprio(1); _Pragma("unroll") for (int m = 0; m < 4; ++m) _Pragma("unroll") for (int n = 0; n < 2; ++n) { \
        if constexpr (FP8) asm volatile("v_mfma_scale_f32_16x16x128_f8f6f4 %0, %1, %2, %0, %3, %3 op_sel_hi:[0,0,0]" : "+v"(acc[ai][bj][m][n]) : "v"(Bt[n]), "v"(At[m]), "v"(fp8_one));   \
        else { acc[ai][bj][m][n] = __builtin_amdgcn_mfma_f32_16x16x32_bf16(PG8_LOH(Bt[n]), PG8_LOH(At[m]), acc[ai][bj][m][n], 0, 0, 0); \
               acc[ai][bj][m][n] = __builtin_amdgcn_mfma_f32_16x16x32_bf16(PG8_HIH(Bt[n]), PG8_HIH(At[m]), acc[ai][bj][m][n], 0, 0, 0); } } \
        __builtin_amdgcn_s_setprio(0); } while (0)
#define PG8_WAIT_V(n) asm volatile("s_waitcnt vmcnt(" #n ")" ::: "memory")
#define PG8_WAIT_L(n) asm volatile("s_waitcnt lgkmcnt(" #n ")" ::: "memory")
#define PG8_BAR __builtin_amdgcn_s_barrier()
#define PG8_SCHED __builtin_amdgcn_sched_barrier(0)
    Unit cur, nxt; int ui = 0;
    if (!S.next(0, cur)) return;
    f32x4 acc[2][2][4][2];
#pragma unroll
    for (int a = 0; a < 2; ++a)
#pragma unroll
        for (int b = 0; b < 2; ++b)
#pragma unroll
            for (int m = 0; m < 4; ++m)
#pragma unroll
                for (int n = 0; n < 2; ++n) acc[a][b][m][n] = (f32x4){0.f, 0.f, 0.f, 0.f};
    unsigned fp8_one = 0x7f7f7f7fu; asm volatile("" : "+v"(fp8_one));
    u32x8 At[4], B0[2], B1[2];
    const char* cA = (const char*)(g.A + (long)cur.pb * SH::bsA) + (size_t)cur.pm * tstepA; const char* cB = (const char*)(g.Bt + (long)cur.pb * SH::bsB) + (size_t)cur.pn * tstepB;
    PG8_STAGE(PG8_SB(0, 0), cB, voffB); PG8_STAGE(PG8_SB(0, 1), cB + hstepB, voffB); PG8_STAGE(PG8_SA(0, 0), cA, voffA); PG8_STAGE(PG8_SA(0, 1), cA + hstepA, voffA);
    if (wr == 1) PG8_BAR;
    PG8_WAIT_V(2); PG8_BAR;
    PG8_STAGE(PG8_SB(1, 0), cB + kstep, voffB); PG8_STAGE(PG8_SA(1, 0), cA + kstep, voffA); PG8_STAGE(PG8_SB(1, 1), cB + hstepB + kstep, voffB);
    PG8_WAIT_V(6); PG8_BAR;
    for (;;) {
        const bool has_next = S.next(ui + 1, nxt);
        const char* nA = has_next ? (const char*)(g.A + (long)nxt.pb * SH::bsA) + (size_t)nxt.pm * tstepA : cA; const char* nB = has_next ? (const char*)(g.Bt + (long)nxt.pb * SH::bsB) + (size_t)nxt.pn * tstepB : cB;
#pragma nounroll
        for (int t = 0; t < nt; t += 2) {
            const bool last = (t == nt - 2);
            const char* a1 = cA + (size_t)(t + 1) * kstep;
            const char* a2 = last ? nA : cA + (size_t)(t + 2) * kstep; const char* b2 = last ? nB : cB + (size_t)(t + 2) * kstep;
            const char* a3 = a2 + kstep; const char* b3 = b2 + kstep;
            PG8_LDB(B0, 0, 0); PG8_LDB(B1, 0, 1); PG8_SCHED; PG8_LDA(At, 0, 0); PG8_STAGE(PG8_SA(1, 1), a1 + hstepA, voffA);
            PG8_WAIT_V(8); PG8_WAIT_L(0); PG8_BAR; PG8_MMA(0, 0, At, B0); PG8_MMA(0, 1, At, B1); PG8_BAR; PG8_SCHED;
            PG8_LDA(At, 0, 1); PG8_STAGE(PG8_SB(0, 0), b2, voffB); PG8_STAGE(PG8_SB(0, 1), b2 + hstepB, voffB); PG8_STAGE(PG8_SA(0, 0), a2, voffA);
            PG8_WAIT_V(8); PG8_WAIT_L(0); PG8_BAR; PG8_MMA(1, 0, At, B0); PG8_MMA(1, 1, At, B1); PG8_BAR; PG8_SCHED;
            PG8_LDB(B0, 1, 0); PG8_LDB(B1, 1, 1); PG8_SCHED; PG8_LDA(At, 1, 0); PG8_STAGE(PG8_SA(0, 1), a2 + hstepA, voffA);
            PG8_WAIT_V(8); PG8_WAIT_L(0); PG8_BAR; PG8_MMA(0, 0, At, B0); PG8_MMA(0, 1, At, B1); PG8_BAR; PG8_SCHED;
            PG8_LDA(At, 1, 1); PG8_STAGE(PG8_SB(1, 0), b3, voffB); PG8_STAGE(PG8_SB(1, 1), b3 + hstepB, voffB); PG8_STAGE(PG8_SA(1, 0), a3, voffA);
            PG8_WAIT_V(8); PG8_WAIT_L(0); PG8_BAR; PG8_MMA(1, 0, At, B0); PG8_MMA(1, 1, At, B1); PG8_BAR; PG8_SCHED;
        }
        if (wr == 0) PG8_BAR;
        if constexpr (FP8) asm volatile("s_nop 15\n\ts_nop 15\n\ts_nop 7" ::: "memory");
        E(acc, cur, wr, wc, fr, fq);
        if (!has_next) break;
#pragma unroll
        for (int a = 0; a < 2; ++a)
#pragma unroll
            for (int b = 0; b < 2; ++b)
#pragma unroll
                for (int m = 0; m < 4; ++m)
#pragma unroll
                    for (int n = 0; n < 2; ++n) acc[a][b][m][n] = (f32x4){0.f, 0.f, 0.f, 0.f};
        cur = nxt; cA = nA; cB = nB; ++ui;
        if (wr == 1) PG8_BAR;
    }
    PG8_WAIT_V(0);
    PG8_BAR;
#undef PG8_SA
#undef PG8_SB
#undef PG8_STAGE
#undef PG8_LDA
#undef PG8_LDB
#undef PG8_MMA
#undef PG8_WAIT_V
#undef PG8_WAIT_L
#undef PG8_BAR
#undef PG8_SCHED
}
}

#define XB_TMO      128
#define XB_XCNT(j)  (256  + 64 * (j))
#define XB_XSUB(j)  (1280 + 64 * (j))
#define XB_XGEN(j)  (2304 + 64 * (j))
#define XB_TOP      3328
#define XB_TOPGEN   3392
#define XCD_BAR_WORDS 3456
#define XB_SPIN_CAP (1u << 18)
__device__ __forceinline__ unsigned xb_ld(unsigned* p)              { return __hip_atomic_load(p, __ATOMIC_RELAXED, __HIP_MEMORY_SCOPE_AGENT); }
__device__ __forceinline__ unsigned xb_add(unsigned* p, unsigned v) { return __hip_atomic_fetch_add(p, v, __ATOMIC_RELAXED, __HIP_MEMORY_SCOPE_AGENT); }
__device__ __forceinline__ unsigned xb_xcc_id() { return (unsigned)__builtin_amdgcn_s_getreg((3 << 11) | 20) & 0xFu; }
#define XB_SPIN(cond, bar) do { unsigned _sp = 0; while (cond) { __builtin_amdgcn_s_sleep(1); \
    if ((++_sp & 255u) == 0u) { if (xb_ld(&(bar)[XB_TMO])) break; if (_sp > XB_SPIN_CAP) { atomicAdd(&(bar)[XB_TMO], 1u); break; } } } } while (0)
struct XcdBarrier { unsigned* bar; unsigned x; volatile LAS unsigned* st; };
__device__ __forceinline__ XcdBarrier xcd_barrier_post(unsigned* bar, volatile LAS unsigned* st) {
    XcdBarrier b; b.bar = bar; b.x = xb_xcc_id(); b.st = st;
    if (threadIdx.x == 0) (void)xb_add(&bar[XB_XCNT(b.x)], 1u);
    return b;
}
__device__ __forceinline__ void xcd_barrier_complete(unsigned* bar, unsigned x, unsigned& nloc, unsigned& nx) {
    const unsigned G = gridDim.x * gridDim.y * gridDim.z;
    unsigned sum, cnt, mine, sp = 0u;
    for (;;) {
        sum = 0u; cnt = 0u; mine = 0u;
#pragma unroll
        for (unsigned j = 0; j < 16; ++j) { const unsigned c = xb_ld(&bar[XB_XCNT(j)]); sum += c; cnt += (c > 0u) ? 1u : 0u; mine = (j == x) ? c : mine; }
        if (sum == G) break;
        __builtin_amdgcn_s_sleep(1);
        if ((++sp & 255u) == 0u) { if (xb_ld(&bar[XB_TMO])) break; if (sp > XB_SPIN_CAP) { atomicAdd(&bar[XB_TMO], 1u); break; } }
    }
    nloc = mine > 0u ? mine : 1u; nx = cnt > 0u ? cnt : 1u;
}
__device__ __forceinline__ void xcd_barrier(const XcdBarrier& b) {
    asm volatile("s_waitcnt vmcnt(0)" ::: "memory");
    __syncthreads();
    if (threadIdx.x == 0) {
        unsigned* bar = b.bar;
        __builtin_amdgcn_s_waitcnt(0);
        unsigned nloc = b.st[0], nx = b.st[1];
        if (nloc == 0u) { xcd_barrier_complete(bar, b.x, nloc, nx); b.st[0] = nloc; b.st[1] = nx; }
        const unsigned old = xb_add(&bar[XB_XSUB(b.x)], 1u);
        const unsigned gen = old / nloc;
        if (old + 1u == (gen + 1u) * nloc) {
            __builtin_amdgcn_fence(__ATOMIC_RELEASE, "agent");
            asm volatile("s_waitcnt vmcnt(0)" ::: "memory");
            const unsigned og = xb_add(&bar[XB_TOP], 1u);
            const unsigned tg = og / nx;
            if (og + 1u == (tg + 1u) * nx) xb_add(&bar[XB_TOPGEN], 1u);
            else XB_SPIN(xb_ld(&bar[XB_TOPGEN]) == tg, bar);
            __builtin_amdgcn_fence(__ATOMIC_ACQUIRE, "agent");
            xb_add(&bar[XB_XGEN(b.x)], 1u);
            asm volatile("s_waitcnt vmcnt(0)" ::: "memory");
        } else {
            XB_SPIN(xb_ld(&bar[XB_XGEN(b.x)]) == gen, bar);
            __builtin_amdgcn_fence(__ATOMIC_ACQUIRE, "agent");
            asm volatile("s_waitcnt vmcnt(0)" ::: "memory");
        }
    }
    __syncthreads();
}

constexpr int RING_BYTES = 131072;
constexpr int LDSCTL_OFF = RING_BYTES, MISC_OFF = LDSCTL_OFF + 320;
constexpr int LDS_BYTES = 147456;
constexpr int NWAVES = 8;

struct Args { const float* in[17]; float* out; unsigned char* ws; };

struct Ctx {
    LAS unsigned char* lds;
    int tid, lane, wave, vcu, G;
};

__device__ __forceinline__ Ctx fresh(const Ctx& F) {
    Ctx C = F; int t = threadIdx.x; asm volatile("" : "+v"(t)); C.tid = t; C.lane = t & 63; return C;
}
__device__ __forceinline__ void p0_transpose_item(const float* W, int K, int N, bf16_t* WT, LAS float* scr, int item, int lane) {
    const int nblk = N / 32, kb = item / nblk, nb = item % nblk, k0 = 64 * kb, n0 = 32 * nb;
#pragma unroll 8
    for (int i = 0; i < 32; ++i) { const int kk = 2 * i + (lane >> 5); scr[kk * 33 + (lane & 31)] = W[(size_t)(k0 + kk) * N + n0 + (lane & 31)]; }
    asm volatile("s_waitcnt lgkmcnt(0)" ::: "memory");
    const int c = lane & 7;
#pragma unroll
    for (int j = 0; j < 4; ++j) { const int n = (lane >> 3) + 8 * j; const LAS float* s = scr + (8 * c) * 33 + n;
        u32x4 o; o.x = pk2(s[0 * 33], s[1 * 33]); o.y = pk2(s[2 * 33], s[3 * 33]); o.z = pk2(s[4 * 33], s[5 * 33]); o.w = pk2(s[6 * 33], s[7 * 33]);
        *(u32x4*)(WT + (size_t)(n0 + n) * K + k0 + 8 * c) = o; }
    asm volatile("s_waitcnt lgkmcnt(0)" ::: "memory");
}
__device__ __forceinline__ void p0_transpose_item8(const float* W, int K, int N, unsigned char* WT, LAS float* scr, int item, int lane) {
    const int nblk = N / 32, kb = item / nblk, nb = item % nblk, k0 = 64 * kb, n0 = 32 * nb;
#pragma unroll 8
    for (int i = 0; i < 32; ++i) { const int kk = 2 * i + (lane >> 5); scr[kk * 33 + (lane & 31)] = W[(size_t)(k0 + kk) * N + n0 + (lane & 31)]; }
    asm volatile("s_waitcnt lgkmcnt(0)" ::: "memory");
    const int c = lane & 7;
#pragma unroll
    for (int j = 0; j < 4; ++j) { const int n = (lane >> 3) + 8 * j; const LAS float* s = scr + (8 * c) * 33 + n; constexpr float sc = pg8::W8_SCALE;
        u32x2 o; o.x = fp8_pack4(s[0 * 33] * sc, s[1 * 33] * sc, s[2 * 33] * sc, s[3 * 33] * sc); o.y = fp8_pack4(s[4 * 33] * sc, s[5 * 33] * sc, s[6 * 33] * sc, s[7 * 33] * sc);
        *(u32x2*)(WT + (size_t)(n0 + n) * K + k0 + 8 * c) = o; }
    asm volatile("s_waitcnt lgkmcnt(0)" ::: "memory");
}
__device__ __forceinline__ void cvt8(const float* src, bf16_t* dst) {
    const f32x4 a = *(const f32x4*)src, b = *(const f32x4*)(src + 4);
    u32x4 o; o.x = pk2(a[0], a[1]); o.y = pk2(a[2], a[3]); o.z = pk2(b[0], b[1]); o.w = pk2(b[2], b[3]);
    *(u32x4*)dst = o;
}

__device__ __forceinline__ void p0_prologue(const Ctx& F0, const Args& a) {
    const Ctx F = fresh(F0);
    unsigned char* ws = a.ws;
    const int gw = F.vcu * NWAVES + F.wave, NGW = F.G * NWAVES;
    const long gt = (long)F.vcu * 512 + F.tid, NGT = (long)F.G * 512;
    {
        LAS float* red = (LAS float*)(F.lds);
        const float* c = a.in[1]; const float* cctx = a.in[3]; const float* wmod = a.in[6]; const float* bmod = a.in[7];
        float* modb = (float*)(ws + WS_MOD);
        for (int item = F.vcu; item < 96; item += F.G) {
            const int l = item / 48, nc = item % 48, n0 = nc * 128 + 2 * F.lane, kb = F.wave * 128;
            float sv[9][2];
#pragma unroll
            for (int r = 0; r < 9; ++r)
#pragma unroll
                for (int j = 0; j < 2; ++j) { const int k = kb + 64 * j + F.lane; const float v = (r < 8) ? c[r * DM + k] : cctx[k]; sv[r][j] = v / (1.0f + __expf(-v)); }
            float acc[9][2];
#pragma unroll
            for (int r = 0; r < 9; ++r) { acc[r][0] = 0.f; acc[r][1] = 0.f; }
            const float* wp = wmod + (size_t)l * DM * NMOD + (size_t)kb * NMOD + n0;
#pragma unroll
            for (int j = 0; j < 2; ++j)
#pragma unroll 8
                for (int kl = 0; kl < 64; ++kl) {
                    const f32x2 w = *(const f32x2*)(wp + (size_t)(64 * j + kl) * NMOD);
#pragma unroll
                    for (int r = 0; r < 9; ++r) { const float s = __builtin_bit_cast(float, __builtin_amdgcn_readlane(__builtin_bit_cast(int, sv[r][j]), kl)); acc[r][0] += s * w[0]; acc[r][1] += s * w[1]; }
                }
            __syncthreads();
#pragma unroll
            for (int r = 0; r < 9; ++r) { red[(F.wave * 9 + r) * 128 + 2 * F.lane] = acc[r][0]; red[(F.wave * 9 + r) * 128 + 2 * F.lane + 1] = acc[r][1]; }
            __syncthreads();
            for (int o = F.tid; o < 9 * 128; o += 512) { const int r = o >> 7, nl = o & 127; float s = 0.f;
#pragma unroll
                for (int w = 0; w < 8; ++w) s += red[(w * 9 + r) * 128 + nl];
                modb[(size_t)(l * 9 + r) * NMOD + nc * 128 + nl] = s + bmod[l * NMOD + nc * 128 + nl]; }
        }
        __syncthreads();
    }
    {
        LAS float* scr = (LAS float*)(F.lds + F.wave * 16384);
        constexpr int I_QKV = (DM / 64) * (3 * DM / 32), I_O = (DM / 64) * (DM / 32), I_PQ = (DM / 64) * (2 * DM / 32);
        constexpr int NITEMS = I_QKV + 2 * I_O + 2 * I_PQ;
        for (int it = gw; it < NITEMS; it += NGW) {
            int r = it;
            if (r < I_QKV) { p0_transpose_item8(a.in[8], DM, 3 * DM, ws + WS_WQKV, scr, r, F.lane); continue; } r -= I_QKV;
            if (r < I_O) { p0_transpose_item8(a.in[9], DM, DM, ws + WS_WO, scr, r, F.lane); continue; } r -= I_O;
            if (r < I_O) { p0_transpose_item8(a.in[11], DM, DM, ws + WS_WF, scr, r, F.lane); continue; } r -= I_O;
            if (r < I_PQ) { p0_transpose_item(a.in[12], DM, 2 * DM, (bf16_t*)(ws + WS_WPQ), scr, r, F.lane); continue; } r -= I_PQ;
            p0_transpose_item(a.in[12] + (size_t)DM * 2 * DM, DM, 2 * DM, (bf16_t*)(ws + WS_WPQ) + (size_t)2 * DM * DM, scr, r, F.lane);
        }
    }
    for (long i = gt; i < 2 * 2 * 128 * 128 / 8; i += NGT) cvt8(a.in[13] + i * 8, (bf16_t*)(ws + WS_SK) + i * 8);
    {
        bf16_t* wc = (bf16_t*)(ws + WS_WC);
        for (long i = gt; i < 512 * 256 / 8; i += NGT) { const int nn = (int)(i >> 5), k0 = (int)(i & 31) * 8; float v[8];
#pragma unroll
            for (int j = 0; j < 8; ++j) { const int m = ((k0 + j) * (nn & 255)) & 255; const float fr = (float)m * (1.0f / 256.0f);
                v[j] = (nn < 256 ? __builtin_amdgcn_cosf(fr) : __builtin_amdgcn_sinf(fr)) * (1.0f / 16.0f); }
            u32x4 o; o.x = pk2(v[0], v[1]); o.y = pk2(v[2], v[3]); o.z = pk2(v[4], v[5]); o.w = pk2(v[6], v[7]);
            *(u32x4*)(wc + i * 8) = o; }
        unsigned char* cs = ws + WS_CS;
        for (long i = gt; i < 2048L * 8192 / 8; i += NGT) { const int np = (int)(i >> 10), c0 = (int)(i & 1023) * 8; const int part = c0 >> 12; float v[8];
#pragma unroll
            for (int j = 0; j < 8; ++j) { const int n = (c0 + j) & 4095; const int m = (n * np) & 4095; const float fr = (float)m * (1.0f / 4096.0f);
                v[j] = (part == 0 ? __builtin_amdgcn_cosf(fr) : -__builtin_amdgcn_sinf(fr)) * (pg8::CS_SCALE / 64.0f); }
            u32x2 o; o.x = fp8_pack4(v[0], v[1], v[2], v[3]); o.y = fp8_pack4(v[4], v[5], v[6], v[7]);
            *(u32x2*)(cs + i * 8) = o; }
    }
}

__device__ __forceinline__ unsigned fp4_pack8(const float* v, float sc) {
    unsigned w = 0;
#define FP4C(i) fminf(fmaxf(v[i] * sc, -6.f), 6.f)
    w = __builtin_amdgcn_cvt_scalef32_pk_fp4_f32(w, FP4C(0), FP4C(1), 1.0f, 0);
    w = __builtin_amdgcn_cvt_scalef32_pk_fp4_f32(w, FP4C(2), FP4C(3), 1.0f, 1);
    w = __builtin_amdgcn_cvt_scalef32_pk_fp4_f32(w, FP4C(4), FP4C(5), 1.0f, 2);
    w = __builtin_amdgcn_cvt_scalef32_pk_fp4_f32(w, FP4C(6), FP4C(7), 1.0f, 3);
#undef FP4C
    return w;
}
#define FP4_DEC(w, bs) __builtin_amdgcn_cvt_scalef32_pk_f32_fp4((w), 1.0f, (bs))
__device__ __forceinline__ unsigned i8_pack4(f32x4 v, float sc) {
    const int a = (int)rintf(fminf(fmaxf(v[0] * sc, -127.f), 127.f)), b = (int)rintf(fminf(fmaxf(v[1] * sc, -127.f), 127.f));
    const int c = (int)rintf(fminf(fmaxf(v[2] * sc, -127.f), 127.f)), d = (int)rintf(fminf(fmaxf(v[3] * sc, -127.f), 127.f));
    return (unsigned)(a & 0xff) | ((unsigned)(b & 0xff) << 8) | ((unsigned)(c & 0xff) << 16) | ((unsigned)(d & 0xff) << 24);
}
__device__ __forceinline__ void table_convert(const Ctx& F0, const Args& a, int sh0, int nsh, int nshare) {
    const Ctx F = fresh(F0);
    constexpr long PER = (long)NEXP * DM / 16;
    constexpr long TOTAL = 4 * PER;
    unsigned char* t8 = a.ws + WS_TAB;
    const long per_share = (TOTAL + nshare - 1) / nshare;
    const long i0 = (long)sh0 * per_share, i1 = min((long)(sh0 + nsh) * per_share, TOTAL);
    for (long i = i0 + F.tid; i < i1; i += 512) {
        const int q = (int)(i / PER); const long r = i - (long)q * PER; const int l = q >> 1, tb = q & 1;
        const int e = (int)(r >> 6), c16 = (int)(r & 63);
        const float* src = (tb ? a.in[15] : a.in[14]) + ((size_t)l * NEXP + e) * DM + c16 * 16;
        if (tb) {
            u32x2 o;
#pragma unroll
            for (int d = 0; d < 2; ++d) { const f32x4 va = *(const f32x4*)(src + 8 * d), vb = *(const f32x4*)(src + 8 * d + 4);
                const float v8[8] = {va[0], va[1], va[2], va[3], vb[0], vb[1], vb[2], vb[3]};
                o[d] = fp4_pack8(v8, V_SCALE); }
            *(u32x2*)(t8 + (size_t)l * TAB_LAYER + TAB_VOFF + ((size_t)(c16 >> 4) * NEXP + e) * 128 + (c16 & 15) * 8) = o;
        } else {
            u32x2 o;
#pragma unroll
            for (int d = 0; d < 2; ++d) { unsigned w = 0;
#pragma unroll
                for (int jn = 0; jn < 8; ++jn) { const float x = src[8 * d + jn] * U_SCALE; const int q = (int)rintf(fminf(fmaxf(x, -8.f), 7.f)) + 8; w |= (unsigned)q << (4 * jn); }
                o[d] = w; }
            *(u32x2*)(t8 + (size_t)l * TAB_LAYER + ((size_t)(c16 >> 3) * NEXP + e) * 64 + (c16 & 7) * 8) = o;
        }
    }
}

__device__ __forceinline__ const float* norm_src(const Args& a, int mode, int m) { return (m < ML) ? ((mode == 0 ? a.in[0] : a.out) + (size_t)m * DM) : (a.in[2] + (size_t)(m - ML) * DM); }
__device__ __forceinline__ void norm_phase(const Ctx& F0, const Args& a, int mode, int layer, int off, const float* gw) {
    const Ctx F = fresh(F0);
    const int gwv = F.vcu * NWAVES + F.wave, NGW = F.G * NWAVES, lane = F.lane;
    const float* modb = (const float*)(a.ws + WS_MOD) + (size_t)layer * 9 * NMOD;
    bf16_t* hx = (bf16_t*)(a.ws + WS_HX);
    const int nrows = (mode == 0) ? MT : ML;
    f32x4 gv[4];
#pragma unroll
    for (int j = 0; j < 4; ++j) gv[j] = ((const f32x4*)gw)[lane + 64 * j];
    const u32x2* XBr = (const u32x2*)(a.ws + WS_XB);
    f32x4 v[4], vn[4]; u32x2 vr[4];
    if (gwv < nrows) {
        if (mode == 0) { const f32x4* xr = (const f32x4*)norm_src(a, mode, gwv) + lane;
#pragma unroll
            for (int j = 0; j < 4; ++j) vn[j] = xr[64 * j]; }
        else {
#pragma unroll
            for (int j = 0; j < 4; ++j) vr[j] = XBr[(size_t)gwv * 256 + lane + 64 * j]; } }
    for (int m = gwv; m < nrows; m += NGW) {
        const int mn = (m + NGW < nrows) ? m + NGW : m;
        if (mode == 0) {
#pragma unroll
            for (int j = 0; j < 4; ++j) v[j] = vn[j];
            const f32x4* xr = (const f32x4*)norm_src(a, mode, mn) + lane;
#pragma unroll
            for (int j = 0; j < 4; ++j) vn[j] = xr[64 * j];
        } else {
#pragma unroll
            for (int j = 0; j < 4; ++j) v[j] = bf4_f32(vr[j]);
#pragma unroll
            for (int j = 0; j < 4; ++j) vr[j] = XBr[(size_t)mn * 256 + lane + 64 * j];
        }
        const float* mr = modb + (size_t)((m < ML) ? (m >> 12) : 8) * NMOD + off;
        f32x4 av[4], cv[4];
#pragma unroll
        for (int j = 0; j < 4; ++j) { av[j] = ((const f32x4*)mr)[lane + 64 * j]; cv[j] = ((const f32x4*)(mr + DM))[lane + 64 * j]; }
        float s = 0.f;
#pragma unroll
        for (int j = 0; j < 4; ++j) s += (v[j].x * v[j].x + v[j].y * v[j].y) + (v[j].z * v[j].z + v[j].w * v[j].w);
        const float rstd = 1.0f / sqrtf(wave_sum(s) * (1.0f / DM) + EPS);
        unsigned long long* o8 = (unsigned long long*)(hx + (size_t)m * DM) + lane;
        unsigned* o4 = (unsigned*)(a.ws + WS_HX + (size_t)m * DM) + lane;
#pragma unroll
        for (int j = 0; j < 4; ++j) { const f32x4 y = (v[j] * rstd * gv[j]) * (cv[j] + 1.0f) + av[j];
            if (mode == 0) { o4[64 * j] = fp8_pack4(y.x * pg8::ACT8_SCALE, y.y * pg8::ACT8_SCALE, y.z * pg8::ACT8_SCALE, y.w * pg8::ACT8_SCALE); continue; }
            o8[64 * j] = (unsigned long long)cvtpk(y.x, y.y) | ((unsigned long long)cvtpk(y.z, y.w) << 32);
            if (off == 3 * DM) *(unsigned*)(a.ws + WS_X8 + ((size_t)(2 * j + (lane >> 5)) * ML + m) * 128 + (4 * lane & 127)) = i8_pack4(y, XQ_SCALE); }
    }
}
__device__ __forceinline__ void final_norm_phase(const Ctx& F0, const Args& a) {
    const Ctx F = fresh(F0);
    const int gwv = F.vcu * NWAVES + F.wave, NGW = F.G * NWAVES;
    const float* gw = a.in[16];
    const u32x2* XBr = (const u32x2*)(a.ws + WS_XB);
    f32x4 gv[4]; u32x2 vr[4];
#pragma unroll
    for (int j = 0; j < 4; ++j) gv[j] = ((const f32x4*)gw)[F.lane + 64 * j];
    if (gwv < ML) {
#pragma unroll
        for (int j = 0; j < 4; ++j) vr[j] = XBr[(size_t)gwv * 256 + F.lane + 64 * j]; }
    for (int m = gwv; m < ML; m += NGW) {
        f32x4* xr = (f32x4*)(a.out + (size_t)m * DM) + F.lane;
        f32x4 v[4]; float s = 0.f;
#pragma unroll
        for (int j = 0; j < 4; ++j) { v[j] = bf4_f32(vr[j]); s += (v[j].x * v[j].x + v[j].y * v[j].y) + (v[j].z * v[j].z + v[j].w * v[j].w); }
        { const int mn = (m + NGW < ML) ? m + NGW : m;
#pragma unroll
          for (int j = 0; j < 4; ++j) vr[j] = XBr[(size_t)mn * 256 + F.lane + 64 * j]; }
        const float rstd = 1.0f / sqrtf(wave_sum(s) * (1.0f / DM) + EPS);
#pragma unroll
        for (int j = 0; j < 4; ++j) xr[64 * j] = v[j] * rstd * gv[j];
    }
}

constexpr int ATT_ROWB = 144, ATT_KTILEB = 128 * ATT_ROWB, ATT_VROWB = 272, ATT_VTILEB = 64 * ATT_VROWB, ATT_BIAS_B = 2048, ATT_K0 = ATT_BIAS_B, ATT_V0 = ATT_K0 + 2 * ATT_KTILEB;
constexpr float ATT_THR = 8.0f;
template <int NGH, bool LATENT>
__device__ __forceinline__ void attn_sub(const LAS unsigned char* Kt, const LAS unsigned char* Vt_, int ko, const LAS float* browA, const LAS float* browB, const int (&relidx)[8],
                                         const bf16x8 (&qf)[2], float& m_ref, float& l_run, f32x4 (&o)[4], int q16, int g4) {
    constexpr int NG = 2 * NGH;
    bf16x8 kf[2 * NG][2]; u32x2 vf[4][NG][2]; f32x4 sc[2 * NG];
#pragma unroll
    for (int gk = 0; gk < NG; ++gk)
#pragma unroll
        for (int b2 = 0; b2 < 2; ++b2)
#pragma unroll
            for (int ks = 0; ks < 2; ++ks) kf[2 * gk + b2][ks] = *(const LAS bf16x8*)(Kt + ((gk / NGH) * 64 + ko + 32 * (gk % NGH) + 16 * b2 + q16) * ATT_ROWB + 64 * ks + 16 * g4);
#pragma unroll
    for (int d = 0; d < 4; ++d)
#pragma unroll
        for (int gk = 0; gk < NG; ++gk) { const LAS unsigned char* vp = Vt_ + (16 * d + q16) * ATT_VROWB + 2 * ((gk / NGH) * 64 + ko + 32 * (gk % NGH) + 4 * g4);
            vf[d][gk][0] = *(const LAS u32x2*)vp; vf[d][gk][1] = *(const LAS u32x2*)(vp + 32); }
    if (LATENT) {
#pragma unroll
        for (int kk = 0; kk < 8; ++kk) { sc[kk >> 2][kk & 3] = browA[relidx[kk]] - m_ref; sc[2 + (kk >> 2)][kk & 3] = browB[relidx[kk]] - m_ref; }
    } else {
#pragma unroll
        for (int blk = 0; blk < 2 * NG; ++blk) sc[blk] = (f32x4){-m_ref, -m_ref, -m_ref, -m_ref};
    }
#pragma unroll
    for (int blk = 0; blk < 2 * NG; ++blk)
#pragma unroll
        for (int ks = 0; ks < 2; ++ks) sc[blk] = __builtin_amdgcn_mfma_f32_16x16x32_bf16(kf[blk][ks], qf[ks], sc[blk], 0, 0, 0);
    float mx = fmaxf(fmaxf(sc[0][0], sc[0][1]), fmaxf(sc[0][2], sc[0][3]));
#pragma unroll
    for (int blk = 1; blk < 2 * NG; ++blk) mx = fmaxf(mx, fmaxf(fmaxf(sc[blk][0], sc[blk][1]), fmaxf(sc[blk][2], sc[blk][3])));
    if (__builtin_amdgcn_ballot_w64(mx > ATT_THR) != 0ull) {
        mx = fmaxf(mx, __shfl_xor(mx, 16)); mx = fmaxf(mx, __shfl_xor(mx, 32));
        const float dl = mx > ATT_THR ? mx : 0.f;
        m_ref += dl;
        const float al = __builtin_amdgcn_exp2f(-dl);
        l_run *= al;
#pragma unroll
        for (int d = 0; d < 4; ++d) o[d] *= al;
#pragma unroll
        for (int blk = 0; blk < 2 * NG; ++blk) sc[blk] -= dl;
    }
    float ls0 = 0.f, ls1 = 0.f;
#pragma unroll
    for (int blk = 0; blk < 2 * NG; ++blk)
#pragma unroll
        for (int i = 0; i < 4; ++i) { const float e = __builtin_amdgcn_exp2f(sc[blk][i]); sc[blk][i] = e; if (blk & 1) ls1 += e; else ls0 += e; }
    l_run += ls0 + ls1;
    bf16x8 pf[NG];
#pragma unroll
    for (int gk = 0; gk < NG; ++gk) { u32x4 pw; pw.x = cvtpk(sc[2 * gk][0], sc[2 * gk][1]); pw.y = cvtpk(sc[2 * gk][2], sc[2 * gk][3]); pw.z = cvtpk(sc[2 * gk + 1][0], sc[2 * gk + 1][1]); pw.w = cvtpk(sc[2 * gk + 1][2], sc[2 * gk + 1][3]);
        pf[gk] = __builtin_bit_cast(bf16x8, pw); }
#pragma unroll
    for (int gk = 0; gk < NG; ++gk)
#pragma unroll
        for (int d = 0; d < 4; ++d) { u32x4 vw; vw.x = vf[d][gk][0].x; vw.y = vf[d][gk][0].y; vw.z = vf[d][gk][1].x; vw.w = vf[d][gk][1].y;
            o[d] = __builtin_amdgcn_mfma_f32_16x16x32_bf16(__builtin_bit_cast(bf16x8, vw), pf[gk], o[d], 0, 0, 0); }
}
__device__ __forceinline__ void attn_phase(const Ctx& F0, const Args& a) {
    const Ctx F = fresh(F0);
    const bf16_t* QK = (const bf16_t*)(a.ws + WS_QK);
    const bf16_t* VT = (const bf16_t*)(a.ws + WS_VT);
    unsigned char* AO = a.ws + WS_HX + 36 * MiB;
    const float* rpb = a.in[10];
    LAS float* bias = (LAS float*)F.lds;
    const int tid = F.tid, lane = F.lane, q16 = lane & 15, g4 = lane >> 4;
    const int rr = F.wave >> 2, jt = F.wave & 3;
    const int qc = 16 * jt + q16, cs = min(max(qc - 8, 0), 48), ksj = min(max(16 * jt - 8, 0), 32);
    int relidx[8];
#pragma unroll
    for (int k = 0; k < 8; ++k) { const int kc = ksj + 16 * (k >> 2) + 4 * g4 + (k & 3); relidx[k] = (kc >= cs && kc < cs + 16) ? (kc - qc + 15) : 31; }
    const int krow = tid >> 3, kch = tid & 7, vrow = tid >> 4, vch = tid & 15;
    const unsigned lds_k = (unsigned)(krow * ATT_ROWB + kch * 16), lds_v = (unsigned)(vrow * ATT_VROWB + vch * 16);
    const int nunits = NB * 16 * 32, upb = (nunits + F.G - 1) / F.G;
    int cur_bh = -1;
    for (int k = 0; k < upb; ++k) {
        const int id = F.vcu * upb + k; if (id >= nunits) break;
        const int p = id & 31, bh = id >> 5, b = bh >> 4, h = bh & 15;
        if (bh != cur_bh) {
            __syncthreads();
            for (int i = tid; i < 16 * 32; i += 512) { const int dr = i >> 5, dc = i & 31; bias[i] = (dc < 31 && dr < 15) ? rpb[(h * 15 + dr) * 31 + dc] * LOG2E : -1e30f; }
            cur_bh = bh;
        }
        const int r0 = 2 * p, rs0 = min(max(r0 - 4, 0), 56), rs1 = min(max(r0 + 1 - 4, 0), 56);
        const int nlat = rs1 + 8 - rs0, nlt = (nlat + 1) >> 1, nsteps = nlt + 2;
        const int r = r0 + rr, rs = rr ? rs1 : rs0;
        const long tokq = (long)b * SEQ + r * GW + qc;
        const bf16_t* kbase = QK + 1024 + h * 64 + kch * 8;
        const bf16_t* vbase = VT + (long)(h * 64 + vrow) * MT + (vch & 7) * 8;
#define ATT_TOKA(step) ((step) < nlt ? ((long)b * SEQ + (long)(rs0 + 2 * (step)) * GW) : ((long)ML + b * CTXL + ((step) - nlt) * 128))
#define ATT_TOKB(step) ((step) < nlt ? ((long)b * SEQ + (long)min(rs0 + 2 * (step) + 1, rs0 + nlat - 1) * GW) : ((long)ML + b * CTXL + ((step) - nlt) * 128 + 64))
        u32x4 kA[2], vA[2], kB[2], vB[2];
#define ATT_LOAD(step, kr_, vr_) do { const int st_ = (step) < nsteps ? (step) : nsteps - 1; const long ta_ = ATT_TOKA(st_), tb_ = ATT_TOKB(st_);     \
        kr_[0] = *(const u32x4*)(kbase + (ta_ + krow) * 2048); kr_[1] = *(const u32x4*)(kbase + (tb_ + krow) * 2048); \
        const long tv_ = (vch < 8) ? ta_ : tb_; vr_[0] = *(const u32x4*)(vbase + tv_); vr_[1] = *(const u32x4*)(vbase + (long)32 * MT + tv_); } while (0)
#define ATT_WRITE(buf, kr_, vr_) do { *(LAS u32x4*)(F.lds + ATT_K0 + (buf) * ATT_KTILEB + lds_k) = kr_[0]; *(LAS u32x4*)(F.lds + ATT_K0 + (buf) * ATT_KTILEB + 64 * ATT_ROWB + lds_k) = kr_[1]; \
        *(LAS u32x4*)(F.lds + ATT_V0 + (buf) * ATT_VTILEB + lds_v) = vr_[0]; *(LAS u32x4*)(F.lds + ATT_V0 + (buf) * ATT_VTILEB + 32 * ATT_VROWB + lds_v) = vr_[1]; } while (0)
        ATT_LOAD(0, kA, vA); ATT_LOAD(1, kB, vB);
        bf16x8 qf[2];
#pragma unroll
        for (int ks = 0; ks < 2; ++ks) qf[ks] = *(const bf16x8*)(QK + tokq * 2048 + h * 64 + 32 * ks + 8 * g4);
        float m_ref = 0.f, l_run = 0.f;
        f32x4 o[4];
#pragma unroll
        for (int d = 0; d < 4; ++d) o[d] = (f32x4){0.f, 0.f, 0.f, 0.f};
        __syncthreads();
        ATT_WRITE(0, kA, vA);
        asm volatile("" :: "v"(qf[0]), "v"(qf[1]));
        __syncthreads();
#define ATT_COMPUTE(step, cur) do { \
            const LAS unsigned char* Kt = F.lds + ATT_K0 + (cur) * ATT_KTILEB; \
            const LAS unsigned char* Vt_ = F.lds + ATT_V0 + (cur) * ATT_VTILEB; \
            if ((step) < nlt) { const int krA = rs0 + 2 * (step), krB = krA + 1; \
                const bool actA = krA >= rs && krA < rs + 8, actB = krB < rs0 + nlat && krB >= rs && krB < rs + 8; \
                if (actA || actB) attn_sub<1, true>(Kt, Vt_, ksj, bias + (actA ? (krA - r + 7) : 15) * 32, bias + (actB ? (krB - r + 7) : 15) * 32, relidx, qf, m_ref, l_run, o, q16, g4); \
            } else attn_sub<2, false>(Kt, Vt_, 0, bias, bias, relidx, qf, m_ref, l_run, o, q16, g4); \
        } while (0)
        for (int step = 0; step < nsteps; step += 2) {
            ATT_COMPUTE(step, 0);
            if (step + 1 < nsteps) ATT_WRITE(1, kB, vB);
            ATT_LOAD(step + 2, kA, vA);
            __syncthreads();
            if (step + 1 < nsteps) { ATT_COMPUTE(step + 1, 1); }
            if (step + 2 < nsteps) ATT_WRITE(0, kA, vA);
            ATT_LOAD(step + 3, kB, vB);
            __syncthreads();
        }
#undef ATT_LOAD
#undef ATT_WRITE
#undef ATT_COMPUTE
#undef ATT_TOKA
#undef ATT_TOKB
        l_run += __shfl_xor(l_run, 16); l_run += __shfl_xor(l_run, 32);
        const float linv = 1.0f / l_run;
        unsigned char* op = AO + tokq * DM + h * 64 + 4 * g4; const float ls = linv * pg8::ACT8_SCALE;
#pragma unroll
        for (int d = 0; d < 4; ++d) *(unsigned*)(op + 16 * d) = fp8_pack4(o[d][0] * ls, o[d][1] * ls, o[d][2] * ls, o[d][3] * ls);
    }
    __syncthreads();
}

__device__ __forceinline__ void ce_desc(float& a, float& b) { const float hi = fmaxf(a, b), lo = fminf(a, b); a = hi; b = lo; }
__device__ __forceinline__ void ce_dir(float& a, float& b, bool desc) { const float hi = fmaxf(a, b), lo = fminf(a, b); a = desc ? hi : lo; b = desc ? lo : hi; }
__device__ __forceinline__ void sort16_desc(float (&v)[16]) {
#pragma unroll
    for (int k = 2; k <= 16; k <<= 1)
#pragma unroll
        for (int j = k >> 1; j > 0; j >>= 1)
#pragma unroll
            for (int i = 0; i < 16; ++i) { const int l = i ^ j; if (l > i) ce_dir(v[i], v[l], (i & k) == 0); }
}
__device__ __forceinline__ void merge16_desc(float (&a)[16], const float (&b)[16]) {
#pragma unroll
    for (int i = 0; i < 16; ++i) a[i] = fmaxf(a[i], b[15 - i]);
#pragma unroll
    for (int j = 8; j > 0; j >>= 1)
#pragma unroll
        for (int i = 0; i < 16; ++i) { const int l = i ^ j; if (l > i) ce_desc(a[i], a[l]); }
}

struct CandTab { int i[64]; int j[64]; };
__host__ __device__ constexpr CandTab make_cand_tab() {
    CandTab t{}; int n = 0;
    for (int i = 0; i < 16; ++i) for (int j = 0; j < 16; ++j) if ((i + 1) * (j + 1) <= 16) { t.i[n] = i; t.j[n] = j; ++n; }
    for (; n < 64; ++n) { t.i[n] = -1; t.j[n] = -1; }
    return t;
}

__device__ __forceinline__ void peer_topk_phase(const Ctx& F0, const Args& a, int layer) {
    const Ctx F = fresh(F0);
    const bf16_t* QP = (const bf16_t*)(a.ws + WS_QK);
    const bf16_t* SK = (const bf16_t*)(a.ws + WS_SK) + (size_t)layer * 2 * 128 * 128;
    unsigned short* IDX = (unsigned short*)(a.ws + WS_IDX);
    float* GATE = (float*)(a.ws + WS_GATE);
    const int gwv = F.vcu * NWAVES + F.wave, NGW = F.G * NWAVES;
    const int lane = F.lane, t32 = lane & 31, hi = lane >> 5;
    __syncthreads();
    for (int c = F.tid; c < 4096; c += 512) *(LAS u32x4*)(F.lds + (c >> 4) * 272 + (c & 15) * 16) = *(const u32x4*)(SK + (size_t)c * 8);
    __syncthreads();
    for (int task = gwv; task < 1024 * 8; task += NGW) {
        const int tt = task >> 3, h = task & 7;
        const long tok = (long)tt * 32 + t32;
        float top[2][16];
#pragma unroll
        for (int p = 0; p < 2; ++p) {
            f32x16 acc[4];
#pragma unroll
            for (int eb = 0; eb < 4; ++eb)
#pragma unroll
                for (int i = 0; i < 16; ++i) acc[eb][i] = 0.f;
#pragma unroll
            for (int eb = 0; eb < 4; ++eb) asm volatile("" : "+v"(acc[eb]));
            const bf16_t* qp = QP + tok * 2048 + h * 256 + p * 128 + hi * 8;
            const LAS unsigned char* kp = F.lds + (p * 128 + t32) * 272 + hi * 16;
#pragma unroll
            for (int ks = 0; ks < 8; ++ks) {
                if ((ks & 1) == 0) asm volatile("" ::: "memory");
                const bf16x8 bq = *(const bf16x8*)(qp + ks * 16);
#pragma unroll
                for (int eb = 0; eb < 4; ++eb) { const bf16x8 ak = *(const LAS bf16x8*)(kp + eb * 32 * 272 + ks * 32); acc[eb] = __builtin_amdgcn_mfma_f32_32x32x16_bf16(ak, bq, acc[eb], 0, 0, 0); }
            }
            float cur[16];
#pragma unroll
            for (int eb = 0; eb < 4; ++eb) {
                float v[16];
#pragma unroll
                for (int i = 0; i < 16; ++i) { const unsigned e = 32 * eb + crow(i, hi); float x = acc[eb][i]; asm volatile("" : "+v"(x));
                    v[i] = __builtin_bit_cast(float, (__builtin_bit_cast(unsigned, x) & ~0x7Fu) | e); }
                sort16_desc(v);
                if (eb == 0) {
#pragma unroll
                    for (int i = 0; i < 16; ++i) cur[i] = v[i];
                } else merge16_desc(cur, v);
            }
            float oth[16];
#pragma unroll
            for (int i = 0; i < 16; ++i) oth[i] = __shfl_xor(cur[i], 32);
            merge16_desc(cur, oth);
#pragma unroll
            for (int i = 0; i < 16; ++i) top[p][i] = cur[i];
            __builtin_amdgcn_sched_barrier(0);
        }
        float best[16];
#pragma unroll
        for (int gI = 0; gI < 4; ++gI) {
            float v[16];
#pragma unroll
            for (int q = 0; q < 16; ++q) {
                constexpr CandTab CT = make_cand_tab();
                const int ci = CT.i[16 * gI + q], cj = CT.j[16 * gI + q];
                if (ci >= 0) {
                    const unsigned ua = __builtin_bit_cast(unsigned, top[0][ci]), ub = __builtin_bit_cast(unsigned, top[1][cj]);
                    float s = top[0][ci] + top[1][cj]; asm volatile("" : "+v"(s));
                    const unsigned code = ((ua & 0x7Fu) << 7) | (ub & 0x7Fu);
                    v[q] = __builtin_bit_cast(float, (__builtin_bit_cast(unsigned, s) & ~0x3FFFu) | code);
                } else v[q] = -3.0e38f;
            }
            sort16_desc(v);
            if (gI == 0) {
#pragma unroll
                for (int i = 0; i < 16; ++i) best[i] = v[i];
            } else merge16_desc(best, v);
            __builtin_amdgcn_sched_barrier(0);
        }
        float e[16], sum = 0.f;
#pragma unroll
        for (int i = 0; i < 16; ++i) { e[i] = __builtin_amdgcn_exp2f((best[i] - best[0]) * LOG2E); sum += e[i]; }
        const float inv = 1.0f / sum;
        if (hi == 0) {
            u32x4 w0, w1;
            w0.x = (__builtin_bit_cast(unsigned, best[0]) & 0x3FFFu) | ((__builtin_bit_cast(unsigned, best[1]) & 0x3FFFu) << 16);
            w0.y = (__builtin_bit_cast(unsigned, best[2]) & 0x3FFFu) | ((__builtin_bit_cast(unsigned, best[3]) & 0x3FFFu) << 16);
            w0.z = (__builtin_bit_cast(unsigned, best[4]) & 0x3FFFu) | ((__builtin_bit_cast(unsigned, best[5]) & 0x3FFFu) << 16);
            w0.w = (__builtin_bit_cast(unsigned, best[6]) & 0x3FFFu) | ((__builtin_bit_cast(unsigned, best[7]) & 0x3FFFu) << 16);
            w1.x = (__builtin_bit_cast(unsigned, best[8]) & 0x3FFFu) | ((__builtin_bit_cast(unsigned, best[9]) & 0x3FFFu) << 16);
            w1.y = (__builtin_bit_cast(unsigned, best[10]) & 0x3FFFu) | ((__builtin_bit_cast(unsigned, best[11]) & 0x3FFFu) << 16);
            w1.z = (__builtin_bit_cast(unsigned, best[12]) & 0x3FFFu) | ((__builtin_bit_cast(unsigned, best[13]) & 0x3FFFu) << 16);
            w1.w = (__builtin_bit_cast(unsigned, best[14]) & 0x3FFFu) | ((__builtin_bit_cast(unsigned, best[15]) & 0x3FFFu) << 16);
            u32x4* ip = (u32x4*)(IDX + tok * 128 + h * 16);
            ip[0] = w0; ip[1] = w1;
        } else {
            f32x4* gp = (f32x4*)(GATE + tok * 128 + h * 16);
#pragma unroll
            for (int q = 0; q < 4; ++q) gp[q] = (f32x4){e[4 * q] * inv, e[4 * q + 1] * inv, e[4 * q + 2] * inv, e[4 * q + 3] * inv};
        }
    }
    __syncthreads();
}

typedef long i64_t;
typedef unsigned u32x8_t __attribute__((ext_vector_type(8)));
typedef _Float16 h2_t __attribute__((ext_vector_type(2)));
template <int CTRL> __device__ __forceinline__ float dpp_f(float v) { return __builtin_bit_cast(float, __builtin_amdgcn_update_dpp(0, __builtin_bit_cast(int, v), CTRL, 0xF, 0xF, true)); }
__device__ __forceinline__ void peer_u_phase(const Ctx& F0, const Args& a, int layer) {
    const Ctx F = fresh(F0);
    const int s = (int)(blockIdx.x & 7), j = (int)(blockIdx.x >> 3), nmem = F.G >> 3;
    const unsigned char* U8s = a.ws + WS_TAB + (size_t)layer * TAB_LAYER + (size_t)s * NEXP * 64;
    const unsigned char* X8s = a.ws + WS_X8 + (size_t)s * ML * 128;
    const unsigned short* IDX = (const unsigned short*)(a.ws + WS_IDX);
    unsigned* PART = (unsigned*)(a.ws + WS_PART) + (size_t)s * ML * 64;
    const int lane = F.lane, r16 = lane >> 2, c4 = lane & 3;
    const bool c1 = (lane & 2) != 0, c0 = (lane & 1) != 0;
    const int t0 = j * NWAVES + F.wave, stride = nmem * NWAVES, ntok = (ML - t0 + stride - 1) / stride;
#define U_TOK(i) ((size_t)(t0 + ((i) < ntok ? (i) : ntok - 1) * stride))
#define U_EID(iv, k) (((k) & 1) ? (iv[(k) >> 1] >> 16) : (iv[(k) >> 1] & 0xffffu))
#define U_LDI(dst, i) do { dst = *(const u32x4*)(IDX + U_TOK(i) * 128 + 8 * r16); } while (0)
#define U_LDX(dst, i) do { const unsigned char* xp_ = X8s + U_TOK(i) * 128 + 32 * c4; dst[0] = *(const u32x4*)xp_; dst[1] = *(const u32x4*)(xp_ + 16); } while (0)
#define U_LDR(Rset, iv) do { _Pragma("unroll") for (int k = 0; k < 8; ++k) Rset[k] = *(const u32x4*)(U8s + (unsigned)(U_EID(iv, k) * 64 + 16 * c4)); } while (0)
#define U_TOKEN(Rset, iref, xv, i) do { \
        unsigned xlo[4], xhi[4]; int sx = 0; \
        _Pragma("unroll") for (int d = 0; d < 4; ++d) { const unsigned n0 = (d < 2) ? xv[0][2 * d] : xv[1][2 * d - 4], n1 = (d < 2) ? xv[0][2 * d + 1] : xv[1][2 * d - 3]; \
            xlo[d] = __builtin_amdgcn_perm(n1, n0, 0x06040200u); xhi[d] = __builtin_amdgcn_perm(n1, n0, 0x07050301u); \
            sx = __builtin_amdgcn_sdot4((int)n0, 0x01010101, sx, false); sx = __builtin_amdgcn_sdot4((int)n1, 0x01010101, sx, false); } \
        float v[8]; \
        _Pragma("unroll") for (int k = 0; k < 8; ++k) { \
            u32x4 r_ = Rset[k]; asm volatile("" : "+v"(r_)); \
            int acc_ = 0; \
            _Pragma("unroll") for (int d = 0; d < 4; ++d) { acc_ = __builtin_amdgcn_sdot4((int)(r_[d] & 0x0F0F0F0Fu), (int)xlo[d], acc_, false); acc_ = __builtin_amdgcn_sdot4((int)((r_[d] >> 4) & 0x0F0F0F0Fu), (int)xhi[d], acc_, false); } \
            v[k] = (float)(acc_ - 8 * sx); \
            asm volatile("" : "+v"(v[k])); \
            Rset[k] = *(const u32x4*)(U8s + (unsigned)(U_EID(iref, k) * 64 + 16 * c4)); \
        } \
        float a4[4], a2[2]; \
        _Pragma("unroll") for (int k = 0; k < 4; ++k) { const float keep = c1 ? v[k + 4] : v[k], send = c1 ? v[k] : v[k + 4]; a4[k] = keep + dpp_f<0x4E>(send); } \
        _Pragma("unroll") for (int k = 0; k < 2; ++k) { const float keep = c0 ? a4[k + 2] : a4[k], send = c0 ? a4[k] : a4[k + 2]; a2[k] = keep + dpp_f<0xB1>(send); } \
        if ((i) < ntok) PART[U_TOK(i) * 64 + lane] = cvtpk(a2[0], a2[1]); \
    } while (0)
    u32x4 iA, iB, iC, iA2, iB2, iC2, RA[8], RB[8], RC[8], xA[2], xB[2], xC[2], xA2[2], xB2[2], xC2[2];
    U_LDI(iA, 0); U_LDI(iB, 1); U_LDI(iC, 2); U_LDX(xA, 0); U_LDX(xB, 1); U_LDX(xC, 2);
    U_LDR(RA, iA); U_LDR(RB, iB); U_LDR(RC, iC);
    U_LDI(iA, 3); U_LDI(iB, 4); U_LDI(iC, 5);
    asm volatile("" :: "v"(xA[0]), "v"(xA[1]), "v"(RA[0]), "v"(RA[1]), "v"(RA[2]), "v"(RA[3]), "v"(RA[4]), "v"(RA[5]), "v"(RA[6]), "v"(RA[7]));
    for (int i = 0; i < ntok; i += 3) {
        U_LDI(iA2, i + 6); U_LDI(iB2, i + 7); U_LDI(iC2, i + 8); U_LDX(xA2, i + 3); U_LDX(xB2, i + 4); U_LDX(xC2, i + 5);
        U_TOKEN(RA, iA, xA, i);
        U_TOKEN(RB, iB, xB, i + 1);
        U_TOKEN(RC, iC, xC, i + 2);
        iA = iA2; iB = iB2; iC = iC2; xA[0] = xA2[0]; xA[1] = xA2[1]; xB[0] = xB2[0]; xB[1] = xB2[1]; xC[0] = xC2[0]; xC[1] = xC2[1];
    }
#undef U_LDI
#undef U_LDX
#undef U_LDR
#undef U_TOKEN
#undef U_TOK
#undef U_EID
}
__device__ __forceinline__ void peer_w_phase(const Ctx& F0, const Args& a) {
    const Ctx F = fresh(F0);
    const unsigned* PART = (const unsigned*)(a.ws + WS_PART);
    const float* GATE = (const float*)(a.ws + WS_GATE);
    unsigned char* WQ = a.ws + WS_WT;
    float* WSC = (float*)(a.ws + WS_WSC);
    const int gwv = F.vcu * NWAVES + F.wave, NGW = F.G * NWAVES;
    for (int t = gwv; t < ML; t += NGW) {
        f32x2 z = (f32x2){0.f, 0.f};
#pragma unroll
        for (int s = 0; s < 8; ++s) { const unsigned pw = PART[((size_t)s * ML + t) * 64 + F.lane]; z += (f32x2){bflo(pw), bfhi(pw)}; }
        const f32x2 g = *(const f32x2*)(GATE + (size_t)t * 128 + 2 * F.lane);
        f32x2 w; w.x = g.x * gelu_erf(z.x * (1.0f / (U_SCALE * XQ_SCALE))); w.y = g.y * gelu_erf(z.y * (1.0f / (U_SCALE * XQ_SCALE)));
        float wm = fmaxf(__builtin_fabsf(w.x), __builtin_fabsf(w.y));
#pragma unroll
        for (int o = 1; o < 64; o <<= 1) wm = fmaxf(wm, __shfl_xor(wm, o));
        wm = fmaxf(wm, 1e-20f);
        const float qs = 6.0f / wm, ax = fminf(fmaxf(w.x * qs, -6.f), 6.f), ay = fminf(fmaxf(w.y * qs, -6.f), 6.f);
        const unsigned ph = __builtin_amdgcn_cvt_scalef32_pk_fp4_f32(0u, ax, ay, 1.0f, 0) & 0xffu;
        const f32x2 dh = FP4_DEC(ph, 0);
        const unsigned pl = __builtin_amdgcn_cvt_scalef32_pk_fp4_f32(0u, fminf(fmaxf(4.f * (ax - dh.x), -6.f), 6.f), fminf(fmaxf(4.f * (ay - dh.y), -6.f), 6.f), 1.0f, 0) & 0xffu;
        ((unsigned short*)WQ)[(size_t)t * 128 + F.lane] = (unsigned short)((ph & 0xfu) | ((ph & 0xf0u) << 4));
        ((unsigned short*)WQ)[(size_t)t * 128 + 64 + F.lane] = (unsigned short)((pl & 0xfu) | ((pl & 0xf0u) << 4));
        if (F.lane == 0) WSC[t] = wm * (1.0f / 6.0f);
    }
}
#define V_MFMA4_FIRST(acc, av, bv, sa) asm volatile("v_mfma_scale_f32_16x16x128_f8f6f4 %0, %1, %2, 0, %3, %4 op_sel_hi:[0,0,0] cbsz:4 blgp:4" : "=&v"(acc) : "v"(av), "v"(bv), "v"(sa), "v"(sc_one))
#define V_MFMA4(acc, av, bv, sa) asm volatile("v_mfma_scale_f32_16x16x128_f8f6f4 %0, %1, %2, %0, %3, %4 op_sel_hi:[0,0,0] cbsz:4 blgp:4" : "+v"(acc) : "v"(av), "v"(bv), "v"(sa), "v"(sc_one))
template <int VAR = 0>
__device__ __forceinline__ void peer_v_phase(const Ctx& F0, const Args& a, int layer, float oscale = 1.0f) {
    const Ctx F = fresh(F0);
    const int s = (int)(blockIdx.x & 3), half = (int)((blockIdx.x >> 2) & 1), j = (int)(blockIdx.x >> 3), nmem = F.G >> 3;
    const unsigned char* V4s = a.ws + WS_TAB + (size_t)layer * TAB_LAYER + TAB_VOFF + (size_t)s * NEXP * 128;
    const unsigned short* IDX = (const unsigned short*)(a.ws + WS_IDX);
    const unsigned char* WQ = a.ws + WS_WT;
    const float* WSC = (const float*)(a.ws + WS_WSC);
    const float* modb = (const float*)(a.ws + WS_MOD) + (size_t)layer * 9 * NMOD;
    bf16_t* X = (bf16_t*)(a.ws + WS_XB);
    const int lane = F.lane, rsub = lane >> 3, c8 = lane & 7, n16 = lane & 15, g4 = lane >> 4;
    LAS unsigned char* tile = F.lds + F.wave * 16384;
    const float osc = ((DBG_SKIP & (layer == 0 ? 2 : 8)) ? 0.f : oscale) * (1.0f / V_SCALE);
    constexpr int MLH = ML / 2;
    const int t0 = half * MLH + j * NWAVES + F.wave, stride = nmem * NWAVES, ntok = (half * MLH + MLH - t0 + stride - 1) / stride;
    unsigned sc_one = 0x7f7f7f7fu; asm volatile("" : "+v"(sc_one));
    typedef int v2i_t __attribute__((ext_vector_type(2)));
    LAS float* gl = (LAS float*)(F.lds + RING_BYTES + 4096);
    for (int u = F.tid; u < 4 * 256; u += NWAVES * 64) gl[u] = modb[(size_t)(4 * half + (u >> 8)) * NMOD + 5 * DM + 256 * s + (u & 255)] * osc;
    __syncthreads();
#define V_TOK(i) ((size_t)(t0 + ((i) < ntok ? (i) : ntok - 1) * stride))
    LAS unsigned char* wx[4]; LAS unsigned char* rb[4];
#pragma unroll
    for (int k = 0; k < 4; ++k) wx[k] = tile + rsub * 2048 + ((c8 ^ k ^ ((rsub & 1) << 2)) << 4);
#pragma unroll
    for (int nb = 0; nb < 4; ++nb) rb[nb] = tile + g4 * 2048 + (n16 >> 1) * 128 + 8 * (n16 & 1) + ((nb ^ ((n16 >> 2) & 3) ^ ((g4 & 1) << 2)) << 4);
    LAS unsigned char* stg = tile + g4 * 1024 + n16 * 8;
#define V_LDW(i) (((const unsigned*)WQ)[V_TOK(i) * 64 + lane])
#define V_LDI(i) (((const unsigned*)IDX)[V_TOK(i) * 64 + lane])
#define V_LDX(i) (*(const u32x2*)(X + V_TOK(i) * DM + 256 * s + 4 * lane))
#define V_LDS(i) (WSC[V_TOK(i)])
#define V_IDP(dst, ci) do { _Pragma("unroll") for (int k = 0; k < 8; ++k) dst[k] = (unsigned)__builtin_amdgcn_ds_bpermute((8 * rsub + k) * 4, (int)(ci)); } while (0)
#define V_EIDP(idp, i_) (((i_) & 1) ? (idp[(i_) >> 1] >> 16) : (idp[(i_) >> 1] & 0xffffu))
#define V_READS(nb0) do { \
        unsigned x64 = (nb0) ? 64u : 0u; asm volatile("" : "+v"(x64));                   \
        _Pragma("unroll") for (int nb = 0; nb < 4; ++nb) { LAS unsigned char* rbn = (LAS unsigned char*)((unsigned)(size_t)rb[nb] ^ x64); \
          _Pragma("unroll") for (int h = 0; h < 2; ++h) { _Pragma("unroll") for (int q = 0; q < 2; ++q) { \
            const v2i_t tr = __builtin_amdgcn_ds_read_tr8_b64_v2i32((LAS v2i_t*)(rbn + 8192 * h + 1024 * q)); \
            bw[nb][h][2 * q] = (unsigned)tr[0]; bw[nb][h][2 * q + 1] = (unsigned)tr[1]; } } } \
        __builtin_amdgcn_sched_barrier(0); \
    } while (0)
#define V_MFMAS() do { \
        _Pragma("unroll") for (int nb = 0; nb < 4; ++nb) V_MFMA4_FIRST(dA[nb], aop[0], bw[nb][0], sc_a); \
        _Pragma("unroll") for (int nb = 0; nb < 4; ++nb) V_MFMA4(dA[nb], aop[1], bw[nb][1], sc_a); \
        __builtin_amdgcn_sched_barrier(0); \
    } while (0)
#define V_OUTS(nb0) do { \
        asm volatile("s_nop 15\n\ts_nop 3" : "+v"(dA[0]), "+v"(dA[1]), "+v"(dA[2]), "+v"(dA[3]) :: "memory");     \
        _Pragma("unroll") for (int nb = 0; nb < 4; ++nb) { ov[(nb0) + nb] = (f32x2){dA[nb][0] + dA[nb][2], dA[nb][1] + dA[nb][3]}; asm volatile("" : "+v"(ov[(nb0) + nb])); } \
    } while (0)
#define V_BODY(j, CUR, NXT, LD) do { \
        const size_t t_ = V_TOK(j); \
        unsigned idp[8]; \
        V_IDP(idp, ci##NXT);                                             \
          \
        _Pragma("unroll") for (int i_ = 0; i_ < 16; ++i_) { \
            *(LAS u32x4*)(wx[(i_ >> 1) & 3] + i_ * 128) = R[i_]; \
            if (VAR == 0 || (VAR == 1 && i_ < 8)) R[i_] = *(const u32x4*)(V4s + (unsigned)(V_EIDP(idp, i_) * 128 + 16 * c8)); \
        } \
          \
        u32x4 aop[2]; \
        _Pragma("unroll") for (int h = 0; h < 2; ++h) { _Pragma("unroll") for (int k = 0; k < 4; ++k) { \
            const unsigned w_ = (unsigned)__builtin_amdgcn_ds_bpermute(abase + (16 * h + k) * 4, (int)cw##CUR); \
            aop[h][k] = (n16 < 4) ? (w_ << ash) : 0u; } } \
        asm volatile("s_waitcnt lgkmcnt(0)" ::: "memory");               \
        f32x4 dA[4]; u32x4 bw[4][2]; f32x2 ov[8]; \
        V_READS(0); \
        V_MFMAS(); \
          \
        ci##CUR = V_LDI((j) + 3); cw##LD = V_LDW((j) + 2); xo##LD = V_LDX((j) + 2); ws##LD = V_LDS((j) + 2); \
        __builtin_amdgcn_sched_barrier(0); \
        V_READS(4);                                                      \
        V_OUTS(0); \
        V_MFMAS(); \
        V_OUTS(4); \
          \
        _Pragma("unroll") for (int nb = 0; nb < 8; ++nb) *(LAS f32x2*)(stg + nb * 128) = ov[nb]; \
        asm volatile("s_waitcnt lgkmcnt(0)" ::: "memory"); \
        const f32x4 sum = *(const LAS f32x4*)(tile + 16 * lane); \
        const f32x4 gt_ = *(const LAS f32x4*)(gl + ((t_ >> 12) & 3) * 256 + 4 * lane); \
        asm volatile("s_waitcnt lgkmcnt(0)" ::: "memory"); \
        if ((j) < ntok) { const f32x4 r_ = bf4_f32(xo##CUR) + gt_ * ws##CUR * sum; *(u32x2*)(X + t_ * DM + 256 * s + 4 * lane) = (u32x2){cvtpk(r_.x, r_.y), cvtpk(r_.z, r_.w)}; } \
    } while (0)
    u32x4 R[16];
    unsigned cwA, cwB, cwC, ciA, ciB, ciC;
    u32x2 xoA, xoB, xoC;
    float wsA, wsB, wsC;
    const int abase = (32 * ((n16 >> 1) & 1) + 4 * g4) * 4, ash = 4 * (n16 & 1);
    unsigned sc_a = (n16 & 2) ? 0x7d7d7d7du : 0x7f7f7f7fu; asm volatile("" : "+v"(sc_a));
    ciA = V_LDI(0);
    cwA = V_LDW(0); cwB = V_LDW(1); xoA = V_LDX(0); xoB = V_LDX(1); wsA = V_LDS(0); wsB = V_LDS(1);
    { unsigned idp0[8]; V_IDP(idp0, ciA);
#pragma unroll
      for (int i_ = 0; i_ < 16; ++i_) R[i_] = *(const u32x4*)(V4s + (unsigned)(V_EIDP(idp0, i_) * 128 + 16 * c8)); }
    ciB = V_LDI(1); ciC = V_LDI(2);
    cwC = 0u; xoC = (u32x2){0u, 0u}; wsC = 0.f;
    asm volatile("" :: "v"(ciC));
    for (int i = 0; i < ntok; i += 3) {
        V_BODY(i, A, B, C);
        V_BODY(i + 1, B, C, A);
        V_BODY(i + 2, C, A, B);
    }
#undef V_BODY
#undef V_READS
#undef V_MFMAS
#undef V_OUTS
#undef V_LDW
#undef V_LDI
#undef V_LDX
#undef V_LDS
#undef V_IDP
#undef V_EIDP
#undef V_TOK
}
#undef V_MFMA4_FIRST
#undef V_MFMA4

__device__ __forceinline__ void dft_nyquist_rows(const Ctx& F0, const Args& a) {
    const Ctx F = fresh(F0);
    const unsigned char* Yt = a.ws + WS_QK;
    unsigned char* Fo = a.ws + WS_VT;
    const int gwv = F.vcu * NWAVES + F.wave, NGW = F.G * NWAVES;
    for (int o = gwv; o < NB * DM; o += NGW) {
        const unsigned char* src = Yt + (size_t)o * 8192;
        float s = 0.f;
#pragma unroll
        for (int it = 0; it < 4; ++it) { const u32x4 v = *(const u32x4*)(src + it * 1024 + F.lane * 16);
#pragma unroll
            for (int d = 0; d < 4; ++d) { const f32x2 lo = __builtin_amdgcn_cvt_pk_f32_fp8((int)v[d], false), hi = __builtin_amdgcn_cvt_pk_f32_fp8((int)v[d], true); s += (lo[0] - lo[1]) + (hi[0] - hi[1]); } }
        s = wave_sum(s) * (pg8::ACT8_SCALE / (64.0f * pg8::YT_SCALE));
        if (F.lane == 0) Fo[((size_t)(o >> 10) * SEQ + 2048) * DM + (o & 1023)] = (unsigned char)(fp8_pack4(s, 0.f, 0.f, 0.f) & 0xffu);
    }
}

__global__ void __launch_bounds__(NWAVES * 64, 2) fwd_kernel(Args args) {
    extern __shared__ __attribute__((aligned(16))) unsigned char lds_raw[];
    Ctx F;
    F.lds = (LAS unsigned char*)lds_raw;
    F.tid = threadIdx.x; F.lane = F.tid & 63; F.wave = __builtin_amdgcn_readfirstlane(F.tid >> 6);
    F.G = gridDim.x; { const int bx = blockIdx.x; F.vcu = (F.G % 8 == 0) ? (bx % 8) * (F.G / 8) + bx / 8 : bx; }
    volatile LAS unsigned* MISC = (volatile LAS unsigned*)(F.lds + MISC_OFF);
    for (int u = F.tid; u < (LDS_BYTES - LDSCTL_OFF) / 4; u += NWAVES * 64) ((LAS unsigned*)(F.lds + LDSCTL_OFF))[u] = 0u;
    __syncthreads();
    unsigned char* ws = args.ws;
    XcdBarrier bar = xcd_barrier_post((unsigned*)(ws + WS_CTL) + CW_BAR, MISC + 8);
#define GRID_BAR() xcd_barrier(bar)
#ifndef DBG_REP
#define DBG_REP 0
#endif
#ifndef DBG_VVAR
#define DBG_VVAR 0
#endif
#define REP(k, ...) do { __VA_ARGS__; if (DBG_REP == (k)) { GRID_BAR(); __VA_ARGS__; } } while (0)
#define PEER_BLOCK(layer) do { \
        norm_phase(F, args, 1, layer, 3 * DM, args.in[5] + (layer) * DM); \
        GRID_BAR(); \
        { using SHq = pg8::Shape<ML, 2048, DM, DM, DM, 1, 0, 0>; \
          REP(7, pg8::gemm_phase<SHq>(F.lds, pg8::Gemm{HX, (const bf16_t*)(ws + WS_WPQ) + (size_t)(layer) * 2048 * DM}, F.G, bx, pg8::EpiStoreBf16{QKb, 2048, 0, 0, 1.0f})); } \
        GRID_BAR(); \
        REP(8, peer_topk_phase(F, args, layer)); \
        GRID_BAR(); \
        REP(9, peer_u_phase(F, args, layer)); \
        GRID_BAR(); \
        REP(10, peer_w_phase(F, args)); \
        GRID_BAR(); \
        peer_v_phase(F, args, layer); if (DBG_REP == 11) { GRID_BAR(); peer_v_phase<DBG_VVAR>(F, args, layer, 0.f); } \
        GRID_BAR(); \
    } while (0)
    const float* modb = (const float*)(ws + WS_MOD);
    bf16_t* HX = (bf16_t*)(ws + WS_HX);
    bf16_t* QKb = (bf16_t*)(ws + WS_QK);
    bf16_t* VTb = (bf16_t*)(ws + WS_VT);
    const bf16_t* Wqkv = (const bf16_t*)(ws + WS_WQKV);
    const int bx = (int)blockIdx.x;

    REP(1, p0_prologue(F, args));
    GRID_BAR();
    REP(2, norm_phase(F, args, 0, 0, 0, args.in[4]));
    GRID_BAR();
    {
        constexpr float o8 = 1.0f / (pg8::ACT8_SCALE * pg8::W8_SCALE);
        using SH1 = pg8::Shape<MT, 2048, DM / 2, DM / 2, DM / 2, 1, 0, 0>;
        pg8::gemm_phase<SH1, pg8::EpiStoreBf16, true>(F.lds, pg8::Gemm{HX, Wqkv}, F.G, bx, pg8::EpiStoreBf16{QKb, 2048, 0, 1024, 0.125f * LOG2E, o8});
        using SH2 = pg8::Shape<DM, MT, DM / 2, DM / 2, DM / 2, 1, 0, 0>;
        pg8::gemm_phase<SH2, pg8::EpiStoreBf16, true>(F.lds, pg8::Gemm{Wqkv + (size_t)2048 * DM / 2, HX}, F.G, bx, pg8::EpiStoreBf16{VTb, MT, 0, 0, 1.0f, o8});
        {
            const int nq = (MT / 256) * 8, nv = 4 * (MT / 256), rq = nq % F.G, rv = nv % F.G;
            const int sh_q = (rq == 0 || bx >= rq) ? 1 : 0, sh_v = (rv == 0 || bx >= rv) ? 1 : 0;
            const int before = (rq == 0 ? bx : max(0, bx - rq)) + (rv == 0 ? bx : max(0, bx - rv));
            const int total = (rq == 0 ? F.G : F.G - rq) + (rv == 0 ? F.G : F.G - rv);
            table_convert(F, args, before, sh_q + sh_v, total);
        }
    }
    GRID_BAR();
    REP(4, attn_phase(F, args));
    GRID_BAR();
    {
        using SH = pg8::Shape<ML, DM, DM / 2, DM / 2, DM / 2, 1, 0, 0>;
        pg8::gemm_phase<SH, pg8::EpiResid<false>, true>(F.lds, pg8::Gemm{(const bf16_t*)(ws + WS_HX + 36 * MiB), (const bf16_t*)(ws + WS_WO)}, F.G, bx, pg8::EpiResid<false>{args.in[0], (bf16_t*)(ws + WS_XB), modb + 2 * DM, NMOD, ((DBG_SKIP & 1) ? 0.f : 1.f) / (pg8::ACT8_SCALE * pg8::W8_SCALE)});
    }
    GRID_BAR();
    PEER_BLOCK(0);
    norm_phase(F, args, 1, 1, 0, args.in[4] + DM);
    GRID_BAR();
    {
        using SH = pg8::Shape<512, ML, 256, 256, DM, 4, 0, 256>;
        pg8::gemm_phase<SH>(F.lds, pg8::Gemm{(const bf16_t*)(ws + WS_WC), HX}, F.G, bx, pg8::EpiYt{(unsigned char*)QKb});
    }
    GRID_BAR();
    {
        using SH = pg8::Shape<SEQ / 2, DM, 4096, 4096, 4096, NB, 0, (long)DM * 4096>;
        REP(14, pg8::gemm_phase<SH, pg8::EpiDft2, true>(F.lds, pg8::Gemm{(const bf16_t*)(ws + WS_CS), QKb}, F.G, bx, pg8::EpiDft2{(unsigned char*)VTb}));
        dft_nyquist_rows(F, args);
    }
    GRID_BAR();
    {
        using SH = pg8::Shape<ML, DM, DM / 2, DM / 2, DM / 2, 1, 0, 0>;
        pg8::gemm_phase<SH, pg8::EpiResid<true>, true>(F.lds, pg8::Gemm{VTb, (const bf16_t*)(ws + WS_WF)}, F.G, bx, pg8::EpiResid<true>{ws + WS_XB, (bf16_t*)(ws + WS_XB), modb + (size_t)9 * NMOD + 2 * DM, NMOD, ((DBG_SKIP & 4) ? 0.f : 1.f) / (pg8::ACT8_SCALE * pg8::W8_SCALE)});
    }
    GRID_BAR();
    PEER_BLOCK(1);
    final_norm_phase(F, args);
#undef PEER_BLOCK
}

extern "C" void kernel_launch(void* const* d_in, const int* in_sizes, int n_in, void* d_out, int out_size, void* d_ws, size_t ws_size, hipStream_t stream) {
    static int grid = 0;
    if (grid == 0) {
        if (n_in != 17 || in_sizes[0] != ML * DM || out_size != ML * DM || ws_size < WS_END) { fprintf(stderr, "kernel_launch: unexpected shapes (n_in %d, in0 %d, out %d, ws %zu)\n", n_in, n_in > 0 ? in_sizes[0] : -1, out_size, ws_size); grid = -1; return; }
        int dev = 0, cus = 0, per_cu = 0;
        if (hipGetDevice(&dev) != hipSuccess || hipDeviceGetAttribute(&cus, hipDeviceAttributeMultiprocessorCount, dev) != hipSuccess) { grid = -1; return; }
        if (hipFuncSetAttribute((const void*)fwd_kernel, hipFuncAttributeMaxDynamicSharedMemorySize, LDS_BYTES) != hipSuccess) { fprintf(stderr, "kernel_launch: hipFuncSetAttribute failed\n"); grid = -1; return; }
        if (hipOccupancyMaxActiveBlocksPerMultiprocessor(&per_cu, (const void*)fwd_kernel, NWAVES * 64, LDS_BYTES) != hipSuccess || per_cu < 1)
            fprintf(stderr, "kernel_launch: note: occupancy query reports %d workgroups per CU\n", per_cu);
        (void)hipGetLastError();
        grid = cus;
        if (grid % 8 != 0) { fprintf(stderr, "kernel_launch: CU count %d is not a multiple of 8\n", cus); grid = -1; return; }
    }
    if (grid < 0) return;
    if (hipMemsetAsync((char*)d_ws + WS_CTL, 0, CTL_ZERO_BYTES, stream) != hipSuccess) { fprintf(stderr, "kernel_launch: memset failed\n"); return; }
    Args a{};
    for (int i = 0; i < 17; ++i) a.in[i] = (const float*)d_in[i];
    a.out = (float*)d_out; a.ws = (unsigned char*)d_ws;
    hipLaunchKernelGGL(fwd_kernel, dim3(grid), dim3(NWAVES * 64), LDS_BYTES, stream, a);
    const hipError_t le = hipPeekAtLastError();
    if (le != hipSuccess) fprintf(stderr, "kernel_launch: launch failed: %s\n", hipGetErrorName(le));
}
```

```cpp
#include <hip/hip_runtime.h>
#include <cstdio>
#include <cstdint>

#define LAS __attribute__((address_space(3)))
typedef unsigned short bf16_t;
typedef short bf16x8 __attribute__((ext_vector_type(8)));
typedef short s16x4 __attribute__((ext_vector_type(4)));
typedef float f32x2 __attribute__((ext_vector_type(2)));
typedef float f32x4 __attribute__((ext_vector_type(4)));
typedef float f32x16 __attribute__((ext_vector_type(16)));
typedef unsigned u32x2 __attribute__((ext_vector_type(2)));
typedef unsigned u32x4 __attribute__((ext_vector_type(4)));
typedef __bf16 bf16x2_t __attribute__((ext_vector_type(2)));

#ifndef DBG_SKIP
#define DBG_SKIP 0
#endif
constexpr int DM = 1024, NB = 8, SEQ = 4096, CTXL = 256, GW = 64;
constexpr int ML = NB * SEQ;
constexpr int MC = NB * CTXL;
constexpr int MT = ML + MC;
constexpr int NMOD = 6 * DM;
constexpr int NEXP = 16384;
constexpr float EPS = 1e-6f;
constexpr float LOG2E = 1.4426950408889634f;

constexpr size_t MiB = 1u << 20;
constexpr size_t WS_CTL = 0, CTL_ZERO_BYTES = 1 * MiB;
constexpr size_t WS_MOD = 1 * MiB;
constexpr size_t WS_WQKV = 2 * MiB;
constexpr size_t WS_WO = 8 * MiB;
constexpr size_t WS_WF = 10 * MiB;
constexpr size_t WS_WPQ = 12 * MiB;
constexpr size_t WS_SK = 20 * MiB;
constexpr size_t WS_WC = 20 * MiB + 256 * 1024;
constexpr size_t WS_CS = 22 * MiB;
constexpr size_t WS_TAB = 38 * MiB;
constexpr size_t WS_X8 = 150 * MiB;
constexpr size_t WS_WT = 182 * MiB;
constexpr size_t WS_PART = 282 * MiB;
constexpr float U_SCALE = 64.f;
constexpr float XQ_SCALE = 0.75f;
constexpr float V_SCALE = 2.f;
constexpr size_t WS_XB = 70 * MiB;
constexpr size_t TAB_LAYER = 16 * MiB, TAB_VOFF = 8 * MiB;
constexpr size_t WS_WSC = 198 * MiB;
constexpr size_t WS_HX = 214 * MiB;
constexpr size_t WS_QK = 282 * MiB;
constexpr size_t WS_VT = 418 * MiB;
constexpr size_t WS_IDX = WS_VT;
constexpr size_t WS_GATE = WS_VT + 8 * MiB;
constexpr size_t WS_END = 486 * MiB;
constexpr int CW_BAR = 4096;

__device__ __forceinline__ unsigned f2bf(float f) { unsigned u = __builtin_bit_cast(unsigned, f); return (u + 0x7fffu + ((u >> 16) & 1u)) >> 16; }
__device__ __forceinline__ unsigned pk2(float lo, float hi) { return f2bf(lo) | (f2bf(hi) << 16); }
__device__ __forceinline__ f32x4 bf4_f32(u32x2 w) { return (f32x4){__builtin_bit_cast(float, w.x << 16), __builtin_bit_cast(float, w.x & 0xffff0000u), __builtin_bit_cast(float, w.y << 16), __builtin_bit_cast(float, w.y & 0xffff0000u)}; }
__device__ __forceinline__ unsigned cvtpk(float lo, float hi) { f32x2 v = {lo, hi}; bf16x2_t b = __builtin_convertvector(v, bf16x2_t); return __builtin_bit_cast(unsigned, b); }
__device__ __forceinline__ float bflo(unsigned u) { return __builtin_bit_cast(float, u << 16); }
__device__ __forceinline__ float bfhi(unsigned u) { return __builtin_bit_cast(float, u & 0xffff0000u); }
__device__ __forceinline__ float wave_sum(float v) {
#pragma unroll
    for (int o = 1; o < 64; o <<= 1) v += __shfl_xor(v, o);
    return v;
}
__device__ __forceinline__ unsigned fp8_pack4(float a, float b, float c, float d) {
    int w = 0;
    w = __builtin_amdgcn_cvt_pk_fp8_f32(__builtin_amdgcn_fmed3f(a, -448.f, 448.f), __builtin_amdgcn_fmed3f(b, -448.f, 448.f), w, false);
    w = __builtin_amdgcn_cvt_pk_fp8_f32(__builtin_amdgcn_fmed3f(c, -448.f, 448.f), __builtin_amdgcn_fmed3f(d, -448.f, 448.f), w, true);
    return (unsigned)w;
}
__device__ __forceinline__ int crow(int r, int hi) { return (r & 3) + 8 * (r >> 2) + 4 * hi; }
__device__ __forceinline__ float gelu_erf(float v) {
    const float av = __builtin_fabsf(v), d = av * 0.2316418882f + 1.0f;
    const float t = __builtin_amdgcn_rcpf(d);
    float q = t * 0.5307027145f + (-0.7265760135f); q = q * t + 0.7107068705f; q = q * t + (-0.142248368f); q = q * t + 0.127414796f; q = q * t;
    const float e = __builtin_amdgcn_exp2f((v * v) * (-0.72134752044f));
    const float m = v * (q * e), r = v - m;
    return v < 0.f ? m : r;
}

namespace pg8 {
constexpr float ACT8_SCALE = 16.f, W8_SCALE = 256.f;
constexpr float YT_SCALE = 16.f, CS_SCALE = 512.f;
constexpr int BM = 256, BK = 64, HALF = 128, HTB = HALF * BK * 2, STAGE_BYTES = 8 * HTB, NXCD = 8, WGM = 8;
__host__ __device__ __forceinline__ int lds_byte(int r, int c) { const int st = (r >> 4) * 2 + (c >> 5), rr = r & 15, cc = c & 31, ob = rr * 64 + cc * 2; return st * 1024 + (ob ^ (((ob >> 9) & 1) << 5)); }
__host__ __device__ __forceinline__ void stage_rc(int b, int& R, int& C) { const int st = b / 1024, sb = b % 1024, swz = sb ^ (((sb >> 9) & 1) << 5); R = (st >> 1) * 16 + swz / 64; C = (st & 1) * 32 + (swz % 64) / 2; }
__host__ __device__ __forceinline__ int perm32(int rho) { const int n = rho >> 4, i = rho & 15; return 8 * (i >> 2) + 4 * n + (i & 3); }

struct Unit { int pm, pn, pb; };
struct Gemm { const bf16_t* A; const bf16_t* Bt; };
template <int M_, int N_, int K_, int LDA_, int LDB_, int NBATCH_, long BSA_, long BSB_> struct Shape { static constexpr int M = M_, N = N_, K = K_, lda = LDA_, ldb = LDB_, nbatch = NBATCH_; static constexpr long bsA = BSA_, bsB = BSB_; };

template <class SH> struct StaticOrder {
    static constexpr int nM = SH::M / BM, nN = SH::N / BM, per = nM * nN, nwg = per * SH::nbatch;
    int G, c;
    __device__ __forceinline__ void init(int G_, int c_) { G = G_; c = c_; }
    __device__ __forceinline__ bool next(int i, Unit& u) const {
        const long L = (long)i * G + c; if (L >= nwg) return false;
        int wgid = (int)L; { const int q = nwg / NXCD, r = nwg % NXCD, xcd = wgid % NXCD, off = wgid / NXCD; wgid = (xcd < r ? xcd * (q + 1) : r * (q + 1) + (xcd - r) * q) + off; }
        u.pb = wgid / per; wgid -= u.pb * per;
        const int nig = WGM * nN, gid = wgid / nig, fm = gid * WGM, gsz = (nM - fm) < WGM ? (nM - fm) : WGM;
        u.pm = fm + ((wgid % nig) % gsz); u.pn = (wgid % nig) / gsz; return true;
    }
};

struct EpiStoreBf16 {
    static constexpr bool PERM = true;
    bf16_t* O; long ldc; long bstride; int scols; float scale0; float oscale = 1.0f;
    __device__ __forceinline__ void operator()(const f32x4 (&acc)[2][2][4][2], const Unit& u, int wr, int wc, int fr, int fq) const {
        const int row0 = u.pm * BM + wr * 64 + fr, col0 = u.pn * BM + wc * 32 + 8 * fq;
        bf16_t* base = O + (long)u.pb * bstride;
        const float sc = ((u.pn * BM < scols) ? scale0 : 1.0f) * oscale;
#pragma unroll
        for (int ai = 0; ai < 2; ++ai)
#pragma unroll
            for (int m = 0; m < 4; ++m) { bf16_t* rowp = base + (long)(row0 + ai * HALF + m * 16) * ldc + col0;
#pragma unroll
                for (int bj = 0; bj < 2; ++bj) { const f32x4 v0 = acc[ai][bj][m][0] * sc, v1 = acc[ai][bj][m][1] * sc;
                    u32x4 w; w.x = cvtpk(v0[0], v0[1]); w.y = cvtpk(v0[2], v0[3]); w.z = cvtpk(v1[0], v1[1]); w.w = cvtpk(v1[2], v1[3]);
                    *(u32x4*)(rowp + bj * HALF) = w; } }
    }
};
struct EpiDft2 {
    static constexpr bool PERM = true;
    unsigned char* O;
    __device__ __forceinline__ void operator()(const f32x4 (&acc)[2][2][4][2], const Unit& u, int wr, int wc, int fr, int fq) const {
        const int row0 = u.pm * BM + wr * 64 + fr, cl0 = wc * 32 + 8 * fq;
        unsigned char* base = O + (long)u.pb * SEQ * DM + u.pn * BM;
        constexpr float osc = ACT8_SCALE / (YT_SCALE * CS_SCALE);
#pragma unroll
        for (int ai = 0; ai < 2; ++ai)
#pragma unroll
            for (int m = 0; m < 4; ++m) { const int np = row0 + ai * HALF + m * 16;
                unsigned char* rowp = base + (long)np * DM; unsigned char* mirp = base + (long)(SEQ - np) * DM;
#pragma unroll
                for (int bj = 0; bj < 2; ++bj) { const f32x4 v0 = acc[ai][bj][m][0] * osc, v1 = acc[ai][bj][m][1] * osc; const int cl = cl0 + bj * HALF;
                    u32x2 w; w.x = fp8_pack4(v0[0], v0[1], v0[2], v0[3]); w.y = fp8_pack4(v1[0], v1[1], v1[2], v1[3]);
                    *(u32x2*)(rowp + cl) = w;
                    if (np != 0) {
#pragma unroll
                        for (int i = 0; i < 8; ++i) mirp[(256 - cl - i) & 255] = (unsigned char)((w[i >> 2] >> (8 * (i & 3))) & 0xffu); } }
                asm volatile("" ::: "memory"); }
    }
};
struct EpiYt {
    static constexpr bool PERM = true;
    unsigned char* Yt;
    __device__ __forceinline__ void operator()(const f32x4 (&acc)[2][2][4][2], const Unit& u, int wr, int wc, int fr, int fq) const {
        const int row0 = u.pm * BM + wr * 64 + fr, col0 = u.pn * BM + wc * 32 + 8 * fq;
#pragma unroll
        for (int ai = 0; ai < 2; ++ai)
#pragma unroll
            for (int m = 0; m < 4; ++m) { const int row = row0 + ai * HALF + m * 16; const int part = row >> 8, cp = row & 255;
#pragma unroll
                for (int bj = 0; bj < 2; ++bj) { const int col = col0 + bj * HALF; const int b = col >> 12, n = col & 4095;
                    const f32x4 v0 = acc[ai][bj][m][0] * YT_SCALE, v1 = acc[ai][bj][m][1] * YT_SCALE;
                    u32x2 w; w.x = fp8_pack4(v0[0], v0[1], v0[2], v0[3]); w.y = fp8_pack4(v1[0], v1[1], v1[2], v1[3]);
                    *(u32x2*)(Yt + ((((long)(b * 4 + u.pb) * 256 + cp) * 2 + part) << 12) + n) = w; }
                asm volatile("" ::: "memory"); }
    }
};
template <bool IN_BF16>
struct EpiResid {
    static constexpr bool PERM = false;
    const void* Xin; bf16_t* Xout; const float* gate; int gstride; float gs;
    __device__ __forceinline__ void operator()(const f32x4 (&acc)[2][2][4][2], const Unit& u, int wr, int wc, int fr, int fq) const {
        const int row0 = u.pm * BM + wr * 64 + fr, col0 = u.pn * BM + wc * 32 + 4 * fq;
        const float* gb = gate + (long)((u.pm * BM) >> 12) * gstride;
        f32x4 gv[2][2];
#pragma unroll
        for (int bj = 0; bj < 2; ++bj)
#pragma unroll
            for (int n = 0; n < 2; ++n) gv[bj][n] = *(const f32x4*)(gb + col0 + bj * HALF + n * 16);
#pragma unroll
        for (int ai = 0; ai < 2; ++ai)
#pragma unroll
            for (int m = 0; m < 4; ++m) { const long off = (long)(row0 + ai * HALF + m * 16) * DM + col0;
#pragma unroll
                for (int bj = 0; bj < 2; ++bj)
#pragma unroll
                    for (int n = 0; n < 2; ++n) { const long o_ = off + bj * HALF + n * 16;
                        const f32x4 bs = IN_BF16 ? bf4_f32(*(const u32x2*)((const bf16_t*)Xin + o_)) : *(const f32x4*)((const float*)Xin + o_);
                        const f32x4 r_ = bs + gv[bj][n] * acc[ai][bj][m][n] * gs;
                        *(u32x2*)(Xout + o_) = (u32x2){cvtpk(r_.x, r_.y), cvtpk(r_.z, r_.w)}; }
                if (m & 1) asm volatile("" ::: "memory"); }
    }
};

template <class SH, class Epi, bool FP8 = false>
__device__ __forceinline__ void gemm_phase(LAS unsigned char* lds, const Gemm g, int G_, int c_, const Epi& E) {
    StaticOrder<SH> S; S.init(G_, c_);
    int tid_ = threadIdx.x; asm volatile("" : "+v"(tid_));
    const int tid = tid_, wid = __builtin_amdgcn_readfirstlane(tid >> 6), lane = tid & 63, wr = wid >> 2, wc = wid & 3, fr = lane & 15, fq = lane >> 4;
    constexpr int K = SH::K, nt = K / BK;
    unsigned voffA[2], voffB[2];
#pragma unroll
    for (int i = 0; i < 2; ++i) { int R, C; stage_rc(tid * 16 + i * 8192, R, C); const int Rb = Epi::PERM ? ((R & ~31) + perm32(R & 31)) : R;
        voffA[i] = (unsigned)(R * SH::lda + C) * 2u; voffB[i] = (unsigned)(Rb * SH::ldb + C) * 2u; }
    constexpr size_t kstep = (size_t)(BK * 2);
    constexpr size_t hstepA = (size_t)HALF * SH::lda * 2, hstepB = (size_t)HALF * SH::ldb * 2;
    constexpr size_t tstepA = 2 * hstepA, tstepB = 2 * hstepB;
    const unsigned ldsw = (unsigned)wid * 1024u;
    const int aoff = lds_byte(wr * 64 + fr, fq * 8), boff = lds_byte(wc * 32 + fr, fq * 8);
#define PG8_SA(b, h) (((b) * 2 + (h)) * HTB)
#define PG8_SB(b, h) ((4 + (b) * 2 + (h)) * HTB)
#define PG8_STAGE(bufoff, gbase, voff) do { _Pragma("unroll") for (int _i = 0; _i < 2; ++_i) \
        __builtin_amdgcn_global_load_lds((const unsigned*)((const char*)(gbase) + (voff)[_i]), (LAS unsigned*)(lds + (bufoff) + ldsw + _i * 8192), 16, 0, 0); } while (0)
#define PG8_LDA(dst, b, h) do { _Pragma("unroll") for (int m = 0; m < 4; ++m) { const u32x4 f0_ = *(const LAS u32x4*)(lds + PG8_SA(b, h) + aoff + m * 2048), f1_ = *(const LAS u32x4*)(lds + PG8_SA(b, h) + aoff + m * 2048 + 1024); dst[m] = __builtin_shufflevector(f0_, f1_, 0, 1, 2, 3, 4, 5, 6, 7); } } while (0)
#define PG8_LDB(dst, b, h) do { _Pragma("unroll") for (int n = 0; n < 2; ++n) { const u32x4 f0_ = *(const LAS u32x4*)(lds + PG8_SB(b, h) + boff + n * 2048), f1_ = *(const LAS u32x4*)(lds + PG8_SB(b, h) + boff + n * 2048 + 1024); dst[n] = __builtin_shufflevector(f0_, f1_, 0, 1, 2, 3, 4, 5, 6, 7); } } while (0)
typedef int v8i_t __attribute__((ext_vector_type(8)));
typedef unsigned u32x8 __attribute__((ext_vector_type(8)));
#define PG8_LOH(x) __builtin_bit_cast(bf16x8, __builtin_shufflevector(x, x, 0, 1, 2, 3))
#define PG8_HIH(x) __builtin_bit_cast(bf16x8, __builtin_shufflevector(x, x, 4, 5, 6, 7))
#define PG8_MMA(ai, bj, At, Bt) do { __builtin_amdgcn_s_setprio(1); _Pragma("unroll") for (int m = 0; m < 4; ++m) _Pragma("unroll") for (int n = 0; n < 2; ++n) { \
        if constexpr (FP8) asm volatile("v_mfma_scale_f32_16x16x128_f8f6f4 %0, %1, %2, %0, %3, %3 op_sel_hi:[0,0,0]" : "+v"(acc[ai][bj][m][n]) : "v"(Bt[n]), "v"(At[m]), "v"(fp8_one));   \
        else { acc[ai][bj][m][n] = __builtin_amdgcn_mfma_f32_16x16x32_bf16(PG8_LOH(Bt[n]), PG8_LOH(At[m]), acc[ai][bj][m][n], 0, 0, 0); \
               acc[ai][bj][m][n] = __builtin_amdgcn_mfma_f32_16x16x32_bf16(PG8_HIH(Bt[n]), PG8_HIH(At[m]), acc[ai][bj][m][n], 0, 0, 0); } } \
        __builtin_amdgcn_s_setprio(0); } while (0)
#define PG8_WAIT_V(n) asm volatile("s_waitcnt vmcnt(" #n ")" ::: "memory")
#define PG8_WAIT_L(n) asm volatile("s_waitcnt lgkmcnt(" #n ")" ::: "memory")
#define PG8_BAR __builtin_amdgcn_s_barrier()
#define PG8_SCHED __builtin_amdgcn_sched_barrier(0)
    Unit cur, nxt; int ui = 0;
    if (!S.next(0, cur)) return;
    f32x4 acc[2][2][4][2];
#pragma unroll
    for (int a = 0; a < 2; ++a)
#pragma unroll
        for (int b = 0; b < 2; ++b)
#pragma unroll
            for (int m = 0; m < 4; ++m)
#pragma unroll
                for (int n = 0; n < 2; ++n) acc[a][b][m][n] = (f32x4){0.f, 0.f, 0.f, 0.f};
    unsigned fp8_one = 0x7f7f7f7fu; asm volatile("" : "+v"(fp8_one));
    u32x8 At[4], B0[2], B1[2];
    const char* cA = (const char*)(g.A + (long)cur.pb * SH::bsA) + (size_t)cur.pm * tstepA; const char* cB = (const char*)(g.Bt + (long)cur.pb * SH::bsB) + (size_t)cur.pn * tstepB;
    PG8_STAGE(PG8_SB(0, 0), cB, voffB); PG8_STAGE(PG8_SB(0, 1), cB + hstepB, voffB); PG8_STAGE(PG8_SA(0, 0), cA, voffA); PG8_STAGE(PG8_SA(0, 1), cA + hstepA, voffA);
    if (wr == 1) PG8_BAR;
    PG8_WAIT_V(2); PG8_BAR;
    PG8_STAGE(PG8_SB(1, 0), cB + kstep, voffB); PG8_STAGE(PG8_SA(1, 0), cA + kstep, voffA); PG8_STAGE(PG8_SB(1, 1), cB + hstepB + kstep, voffB);
    PG8_WAIT_V(6); PG8_BAR;
    for (;;) {
        const bool has_next = S.next(ui + 1, nxt);
        const char* nA = has_next ? (const char*)(g.A + (long)nxt.pb * SH::bsA) + (size_t)nxt.pm * tstepA : cA; const char* nB = has_next ? (const char*)(g.Bt + (long)nxt.pb * SH::bsB) + (size_t)nxt.pn * tstepB : cB;
#pragma nounroll
        for (int t = 0; t < nt; t += 2) {
            const bool last = (t == nt - 2);
            const char* a1 = cA + (size_t)(t + 1) * kstep;
            const char* a2 = last ? nA : cA + (size_t)(t + 2) * kstep; const char* b2 = last ? nB : cB + (size_t)(t + 2) * kstep;
            const char* a3 = a2 + kstep; const char* b3 = b2 + kstep;
            PG8_LDB(B0, 0, 0); PG8_LDB(B1, 0, 1); PG8_SCHED; PG8_LDA(At, 0, 0); PG8_STAGE(PG8_SA(1, 1), a1 + hstepA, voffA);
            PG8_WAIT_V(8); PG8_WAIT_L(0); PG8_BAR; PG8_MMA(0, 0, At, B0); PG8_MMA(0, 1, At, B1); PG8_BAR; PG8_SCHED;
            PG8_LDA(At, 0, 1); PG8_STAGE(PG8_SB(0, 0), b2, voffB); PG8_STAGE(PG8_SB(0, 1), b2 + hstepB, voffB); PG8_STAGE(PG8_SA(0, 0), a2, voffA);
            PG8_WAIT_V(8); PG8_WAIT_L(0); PG8_BAR; PG8_MMA(1, 0, At, B0); PG8_MMA(1, 1, At, B1); PG8_BAR; PG8_SCHED;
            PG8_LDB(B0, 1, 0); PG8_LDB(B1, 1, 1); PG8_SCHED; PG8_LDA(At, 1, 0); PG8_STAGE(PG8_SA(0, 1), a2 + hstepA, voffA);
            PG8_WAIT_V(8); PG8_WAIT_L(0); PG8_BAR; PG8_MMA(0, 0, At, B0); PG8_MMA(0, 1, At, B1); PG8_BAR; PG8_SCHED;
            PG8_LDA(At, 1, 1); PG8_STAGE(PG8_SB(1, 0), b3, voffB); PG8_STAGE(PG8_SB(1, 1), b3 + hstepB, voffB); PG8_STAGE(PG8_SA(1, 0), a3, voffA);
            PG8_WAIT_V(8); PG8_WAIT_L(0); PG8_BAR; PG8_MMA(1, 0, At, B0); PG8_MMA(1, 1, At, B1); PG8_BAR; PG8_SCHED;
        }
        if (wr == 0) PG8_BAR;
        if constexpr (FP8) asm volatile("s_nop 15\n\ts_nop 15\n\ts_nop 7" ::: "memory");
        E(acc, cur, wr, wc, fr, fq);
        if (!has_next) break;
#pragma unroll
        for (int a = 0; a < 2; ++a)
#pragma unroll
            for (int b = 0; b < 2; ++b)
#pragma unroll
                for (int m = 0; m < 4; ++m)
#pragma unroll
                    for (int n = 0; n < 2; ++n) acc[a][b][m][n] = (f32x4){0.f, 0.f, 0.f, 0.f};
        cur = nxt; cA = nA; cB = nB; ++ui;
        if (wr == 1) PG8_BAR;
    }
    PG8_WAIT_V(0);
    PG8_BAR;
#undef PG8_SA
#undef PG8_SB
#undef PG8_STAGE
#undef PG8_LDA
#undef PG8_LDB
#undef PG8_MMA
#undef PG8_WAIT_V
#undef PG8_WAIT_L
#undef PG8_BAR
#undef PG8_SCHED
}
}

#define XB_TMO      128
#define XB_XCNT(j)  (256  + 64 * (j))
#define XB_XSUB(j)  (1280 + 64 * (j))
#define XB_XGEN(j)  (2304 + 64 * (j))
#define XB_TOP      3328
#define XB_TOPGEN   3392
#define XCD_BAR_WORDS 3456
#define XB_SPIN_CAP (1u << 18)
__device__ __forceinline__ unsigned xb_ld(unsigned* p)              { return __hip_atomic_load(p, __ATOMIC_RELAXED, __HIP_MEMORY_SCOPE_AGENT); }
__device__ __forceinline__ unsigned xb_add(unsigned* p, unsigned v) { return __hip_atomic_fetch_add(p, v, __ATOMIC_RELAXED, __HIP_MEMORY_SCOPE_AGENT); }
__device__ __forceinline__ unsigned xb_xcc_id() { return (unsigned)__builtin_amdgcn_s_getreg((3 << 11) | 20) & 0xFu; }
#define XB_SPIN(cond, bar) do { unsigned _sp = 0; while (cond) { __builtin_amdgcn_s_sleep(1); \
    if ((++_sp & 255u) == 0u) { if (xb_ld(&(bar)[XB_TMO])) break; if (_sp > XB_SPIN_CAP) { atomicAdd(&(bar)[XB_TMO], 1u); break; } } } } while (0)
struct XcdBarrier { unsigned* bar; unsigned x; volatile LAS unsigned* st; };
__device__ __forceinline__ XcdBarrier xcd_barrier_post(unsigned* bar, volatile LAS unsigned* st) {
    XcdBarrier b; b.bar = bar; b.x = xb_xcc_id(); b.st = st;
    if (threadIdx.x == 0) (void)xb_add(&bar[XB_XCNT(b.x)], 1u);
    return b;
}
__device__ __forceinline__ void xcd_barrier_complete(unsigned* bar, unsigned x, unsigned& nloc, unsigned& nx) {
    const unsigned G = gridDim.x * gridDim.y * gridDim.z;
    unsigned sum, cnt, mine, sp = 0u;
    for (;;) {
        sum = 0u; cnt = 0u; mine = 0u;
#pragma unroll
        for (unsigned j = 0; j < 16; ++j) { const unsigned c = xb_ld(&bar[XB_XCNT(j)]); sum += c; cnt += (c > 0u) ? 1u : 0u; mine = (j == x) ? c : mine; }
        if (sum == G) break;
        __builtin_amdgcn_s_sleep(1);
        if ((++sp & 255u) == 0u) { if (xb_ld(&bar[XB_TMO])) break; if (sp > XB_SPIN_CAP) { atomicAdd(&bar[XB_TMO], 1u); break; } }
    }
    nloc = mine > 0u ? mine : 1u; nx = cnt > 0u ? cnt : 1u;
}
__device__ __forceinline__ void xcd_barrier(const XcdBarrier& b) {
    asm volatile("s_waitcnt vmcnt(0)" ::: "memory");
    __syncthreads();
    if (threadIdx.x == 0) {
        unsigned* bar = b.bar;
        __builtin_amdgcn_s_waitcnt(0);
        unsigned nloc = b.st[0], nx = b.st[1];
        if (nloc == 0u) { xcd_barrier_complete(bar, b.x, nloc, nx); b.st[0] = nloc; b.st[1] = nx; }
        const unsigned old = xb_add(&bar[XB_XSUB(b.x)], 1u);
        const unsigned gen = old / nloc;
        if (old + 1u == (gen + 1u) * nloc) {
            __builtin_amdgcn_fence(__ATOMIC_RELEASE, "agent");
            asm volatile("s_waitcnt vmcnt(0)" ::: "memory");
            const unsigned og = xb_add(&bar[XB_TOP], 1u);
            const unsigned tg = og / nx;
            if (og + 1u == (tg + 1u) * nx) xb_add(&bar[XB_TOPGEN], 1u);
            else XB_SPIN(xb_ld(&bar[XB_TOPGEN]) == tg, bar);
            __builtin_amdgcn_fence(__ATOMIC_ACQUIRE, "agent");
            xb_add(&bar[XB_XGEN(b.x)], 1u);
            asm volatile("s_waitcnt vmcnt(0)" ::: "memory");
        } else {
            XB_SPIN(xb_ld(&bar[XB_XGEN(b.x)]) == gen, bar);
            __builtin_amdgcn_fence(__ATOMIC_ACQUIRE, "agent");
            asm volatile("s_waitcnt vmcnt(0)" ::: "memory");
        }
    }
    __syncthreads();
}

constexpr int RING_BYTES = 131072;
constexpr int LDSCTL_OFF = RING_BYTES, MISC_OFF = LDSCTL_OFF + 320;
constexpr int LDS_BYTES = 147456;
constexpr int NWAVES = 8;

struct Args { const float* in[17]; float* out; unsigned char* ws; };

struct Ctx {
    LAS unsigned char* lds;
    int tid, lane, wave, vcu, G;
};

__device__ __forceinline__ Ctx fresh(const Ctx& F) {
    Ctx C = F; int t = threadIdx.x; asm volatile("" : "+v"(t)); C.tid = t; C.lane = t & 63; return C;
}
__device__ __forceinline__ void p0_transpose_item(const float* W, int K, int N, bf16_t* WT, LAS float* scr, int item, int lane) {
    const int nblk = N / 32, kb = item / nblk, nb = item % nblk, k0 = 64 * kb, n0 = 32 * nb;
#pragma unroll 8
    for (int i = 0; i < 32; ++i) { const int kk = 2 * i + (lane >> 5); scr[kk * 33 + (lane & 31)] = W[(size_t)(k0 + kk) * N + n0 + (lane & 31)]; }
    asm volatile("s_waitcnt lgkmcnt(0)" ::: "memory");
    const int c = lane & 7;
#pragma unroll
    for (int j = 0; j < 4; ++j) { const int n = (lane >> 3) + 8 * j; const LAS float* s = scr + (8 * c) * 33 + n;
        u32x4 o; o.x = pk2(s[0 * 33], s[1 * 33]); o.y = pk2(s[2 * 33], s[3 * 33]); o.z = pk2(s[4 * 33], s[5 * 33]); o.w = pk2(s[6 * 33], s[7 * 33]);
        *(u32x4*)(WT + (size_t)(n0 + n) * K + k0 + 8 * c) = o; }
    asm volatile("s_waitcnt lgkmcnt(0)" ::: "memory");
}
__device__ __forceinline__ void p0_transpose_item8(const float* W, int K, int N, unsigned char* WT, LAS float* scr, int item, int lane) {
    const int nblk = N / 32, kb = item / nblk, nb = item % nblk, k0 = 64 * kb, n0 = 32 * nb;
#pragma unroll 8
    for (int i = 0; i < 32; ++i) { const int kk = 2 * i + (lane >> 5); scr[kk * 33 + (lane & 31)] = W[(size_t)(k0 + kk) * N + n0 + (lane & 31)]; }
    asm volatile("s_waitcnt lgkmcnt(0)" ::: "memory");
    const int c = lane & 7;
#pragma unroll
    for (int j = 0; j < 4; ++j) { const int n = (lane >> 3) + 8 * j; const LAS float* s = scr + (8 * c) * 33 + n; constexpr float sc = pg8::W8_SCALE;
        u32x2 o; o.x = fp8_pack4(s[0 * 33] * sc, s[1 * 33] * sc, s[2 * 33] * sc, s[3 * 33] * sc); o.y = fp8_pack4(s[4 * 33] * sc, s[5 * 33] * sc, s[6 * 33] * sc, s[7 * 33] * sc);
        *(u32x2*)(WT + (size_t)(n0 + n) * K + k0 + 8 * c) = o; }
    asm volatile("s_waitcnt lgkmcnt(0)" ::: "memory");
}
__device__ __forceinline__ void cvt8(const float* src, bf16_t* dst) {
    const f32x4 a = *(const f32x4*)src, b = *(const f32x4*)(src + 4);
    u32x4 o; o.x = pk2(a[0], a[1]); o.y = pk2(a[2], a[3]); o.z = pk2(b[0], b[1]); o.w = pk2(b[2], b[3]);
    *(u32x4*)dst = o;
}

__device__ __forceinline__ void p0_prologue(const Ctx& F0, const Args& a) {
    const Ctx F = fresh(F0);
    unsigned char* ws = a.ws;
    const int gw = F.vcu * NWAVES + F.wave, NGW = F.G * NWAVES;
    const long gt = (long)F.vcu * 512 + F.tid, NGT = (long)F.G * 512;
    {
        LAS float* red = (LAS float*)(F.lds);
        const float* c = a.in[1]; const float* cctx = a.in[3]; const float* wmod = a.in[6]; const float* bmod = a.in[7];
        float* modb = (float*)(ws + WS_MOD);
        for (int item = F.vcu; item < 96; item += F.G) {
            const int l = item / 48, nc = item % 48, n0 = nc * 128 + 2 * F.lane, kb = F.wave * 128;
            float sv[9][2];
#pragma unroll
            for (int r = 0; r < 9; ++r)
#pragma unroll
                for (int j = 0; j < 2; ++j) { const int k = kb + 64 * j + F.lane; const float v = (r < 8) ? c[r * DM + k] : cctx[k]; sv[r][j] = v / (1.0f + __expf(-v)); }
            float acc[9][2];
#pragma unroll
            for (int r = 0; r < 9; ++r) { acc[r][0] = 0.f; acc[r][1] = 0.f; }
            const float* wp = wmod + (size_t)l * DM * NMOD + (size_t)kb * NMOD + n0;
#pragma unroll
            for (int j = 0; j < 2; ++j)
#pragma unroll 8
                for (int kl = 0; kl < 64; ++kl) {
                    const f32x2 w = *(const f32x2*)(wp + (size_t)(64 * j + kl) * NMOD);
#pragma unroll
                    for (int r = 0; r < 9; ++r) { const float s = __builtin_bit_cast(float, __builtin_amdgcn_readlane(__builtin_bit_cast(int, sv[r][j]), kl)); acc[r][0] += s * w[0]; acc[r][1] += s * w[1]; }
                }
            __syncthreads();
#pragma unroll
            for (int r = 0; r < 9; ++r) { red[(F.wave * 9 + r) * 128 + 2 * F.lane] = acc[r][0]; red[(F.wave * 9 + r) * 128 + 2 * F.lane + 1] = acc[r][1]; }
            __syncthreads();
            for (int o = F.tid; o < 9 * 128; o += 512) { const int r = o >> 7, nl = o & 127; float s = 0.f;
#pragma unroll
                for (int w = 0; w < 8; ++w) s += red[(w * 9 + r) * 128 + nl];
                modb[(size_t)(l * 9 + r) * NMOD + nc * 128 + nl] = s + bmod[l * NMOD + nc * 128 + nl]; }
        }
        __syncthreads();
    }
    {
        LAS float* scr = (LAS float*)(F.lds + F.wave * 16384);
        constexpr int I_QKV = (DM / 64) * (3 * DM / 32), I_O = (DM / 64) * (DM / 32), I_PQ = (DM / 64) * (2 * DM / 32);
        constexpr int NITEMS = I_QKV + 2 * I_O + 2 * I_PQ;
        for (int it = gw; it < NITEMS; it += NGW) {
            int r = it;
            if (r < I_QKV) { p0_transpose_item8(a.in[8], DM, 3 * DM, ws + WS_WQKV, scr, r, F.lane); continue; } r -= I_QKV;
            if (r < I_O) { p0_transpose_item8(a.in[9], DM, DM, ws + WS_WO, scr, r, F.lane); continue; } r -= I_O;
            if (r < I_O) { p0_transpose_item8(a.in[11], DM, DM, ws + WS_WF, scr, r, F.lane); continue; } r -= I_O;
            if (r < I_PQ) { p0_transpose_item(a.in[12], DM, 2 * DM, (bf16_t*)(ws + WS_WPQ), scr, r, F.lane); continue; } r -= I_PQ;
            p0_transpose_item(a.in[12] + (size_t)DM * 2 * DM, DM, 2 * DM, (bf16_t*)(ws + WS_WPQ) + (size_t)2 * DM * DM, scr, r, F.lane);
        }
    }
    for (long i = gt; i < 2 * 2 * 128 * 128 / 8; i += NGT) cvt8(a.in[13] + i * 8, (bf16_t*)(ws + WS_SK) + i * 8);
    {
        bf16_t* wc = (bf16_t*)(ws + WS_WC);
        for (long i = gt; i < 512 * 256 / 8; i += NGT) { const int nn = (int)(i >> 5), k0 = (int)(i & 31) * 8; float v[8];
#pragma unroll
            for (int j = 0; j < 8; ++j) { const int m = ((k0 + j) * (nn & 255)) & 255; const float fr = (float)m * (1.0f / 256.0f);
                v[j] = (nn < 256 ? __builtin_amdgcn_cosf(fr) : __builtin_amdgcn_sinf(fr)) * (1.0f / 16.0f); }
            u32x4 o; o.x = pk2(v[0], v[1]); o.y = pk2(v[2], v[3]); o.z = pk2(v[4], v[5]); o.w = pk2(v[6], v[7]);
            *(u32x4*)(wc + i * 8) = o; }
        unsigned char* cs = ws + WS_CS;
        for (long i = gt; i < 2048L * 8192 / 8; i += NGT) { const int np = (int)(i >> 10), c0 = (int)(i & 1023) * 8; const int part = c0 >> 12; float v[8];
#pragma unroll
            for (int j = 0; j < 8; ++j) { const int n = (c0 + j) & 4095; const int m = (n * np) & 4095; const float fr = (float)m * (1.0f / 4096.0f);
                v[j] = (part == 0 ? __builtin_amdgcn_cosf(fr) : -__builtin_amdgcn_sinf(fr)) * (pg8::CS_SCALE / 64.0f); }
            u32x2 o; o.x = fp8_pack4(v[0], v[1], v[2], v[3]); o.y = fp8_pack4(v[4], v[5], v[6], v[7]);
            *(u32x2*)(cs + i * 8) = o; }
    }
}

__device__ __forceinline__ unsigned fp4_pack8(const float* v, float sc) {
    unsigned w = 0;
#define FP4C(i) fminf(fmaxf(v[i] * sc, -6.f), 6.f)
    w = __builtin_amdgcn_cvt_scalef32_pk_fp4_f32(w, FP4C(0), FP4C(1), 1.0f, 0);
    w = __builtin_amdgcn_cvt_scalef32_pk_fp4_f32(w, FP4C(2), FP4C(3), 1.0f, 1);
    w = __builtin_amdgcn_cvt_scalef32_pk_fp4_f32(w, FP4C(4), FP4C(5), 1.0f, 2);
    w = __builtin_amdgcn_cvt_scalef32_pk_fp4_f32(w, FP4C(6), FP4C(7), 1.0f, 3);
#undef FP4C
    return w;
}
#define FP4_DEC(w, bs) __builtin_amdgcn_cvt_scalef32_pk_f32_fp4((w), 1.0f, (bs))
__device__ __forceinline__ unsigned i8_pack4(f32x4 v, float sc) {
    const int a = (int)rintf(fminf(fmaxf(v[0] * sc, -127.f), 127.f)), b = (int)rintf(fminf(fmaxf(v[1] * sc, -127.f), 127.f));
    const int c = (int)rintf(fminf(fmaxf(v[2] * sc, -127.f), 127.f)), d = (int)rintf(fminf(fmaxf(v[3] * sc, -127.f), 127.f));
    return (unsigned)(a & 0xff) | ((unsigned)(b & 0xff) << 8) | ((unsigned)(c & 0xff) << 16) | ((unsigned)(d & 0xff) << 24);
}
__device__ __forceinline__ void table_convert(const Ctx& F0, const Args& a, int sh0, int nsh, int nshare) {
    const Ctx F = fresh(F0);
    constexpr long PER = (long)NEXP * DM / 16;
    constexpr long TOTAL = 4 * PER;
    unsigned char* t8 = a.ws + WS_TAB;
    const long per_share = (TOTAL + nshare - 1) / nshare;
    const long i0 = (long)sh0 * per_share, i1 = min((long)(sh0 + nsh) * per_share, TOTAL);
    for (long i = i0 + F.tid; i < i1; i += 512) {
        const int q = (int)(i / PER); const long r = i - (long)q * PER; const int l = q >> 1, tb = q & 1;
        const int e = (int)(r >> 6), c16 = (int)(r & 63);
        const float* src = (tb ? a.in[15] : a.in[14]) + ((size_t)l * NEXP + e) * DM + c16 * 16;
        if (tb) {
            u32x2 o;
#pragma unroll
            for (int d = 0; d < 2; ++d) { const f32x4 va = *(const f32x4*)(src + 8 * d), vb = *(const f32x4*)(src + 8 * d + 4);
                const float v8[8] = {va[0], va[1], va[2], va[3], vb[0], vb[1], vb[2], vb[3]};
                o[d] = fp4_pack8(v8, V_SCALE); }
            *(u32x2*)(t8 + (size_t)l * TAB_LAYER + TAB_VOFF + ((size_t)(c16 >> 4) * NEXP + e) * 128 + (c16 & 15) * 8) = o;
        } else {
            u32x2 o;
#pragma unroll
            for (int d = 0; d < 2; ++d) { const f32x4 va = *(const f32x4*)(src + 8 * d), vb = *(const f32x4*)(src + 8 * d + 4);
                const float v8[8] = {va[0], va[1], va[2], va[3], vb[0], vb[1], vb[2], vb[3]};
                o[d] = fp4_pack8(v8, U_SCALE); }
            *(u32x2*)(t8 + (size_t)l * TAB_LAYER + ((size_t)(c16 >> 4) * NEXP + e) * 128 + (c16 & 15) * 8) = o;
        }
    }
}

__device__ __forceinline__ const float* norm_src(const Args& a, int mode, int m) { return (m < ML) ? ((mode == 0 ? a.in[0] : a.out) + (size_t)m * DM) : (a.in[2] + (size_t)(m - ML) * DM); }
__device__ __forceinline__ void norm_phase(const Ctx& F0, const Args& a, int mode, int layer, int off, const float* gw) {
    const Ctx F = fresh(F0);
    const int gwv = F.vcu * NWAVES + F.wave, NGW = F.G * NWAVES, lane = F.lane;
    const float* modb = (const float*)(a.ws + WS_MOD) + (size_t)layer * 9 * NMOD;
    bf16_t* hx = (bf16_t*)(a.ws + WS_HX);
    const int nrows = (mode == 0) ? MT : ML;
    f32x4 gv[4];
#pragma unroll
    for (int j = 0; j < 4; ++j) gv[j] = ((const f32x4*)gw)[lane + 64 * j];
    const u32x2* XBr = (const u32x2*)(a.ws + WS_XB);
    f32x4 v[4], vn[4]; u32x2 vr[4];
    if (gwv < nrows) {
        if (mode == 0) { const f32x4* xr = (const f32x4*)norm_src(a, mode, gwv) + lane;
#pragma unroll
            for (int j = 0; j < 4; ++j) vn[j] = xr[64 * j]; }
        else {
#pragma unroll
            for (int j = 0; j < 4; ++j) vr[j] = XBr[(size_t)gwv * 256 + lane + 64 * j]; } }
    for (int m = gwv; m < nrows; m += NGW) {
        const int mn = (m + NGW < nrows) ? m + NGW : m;
        if (mode == 0) {
#pragma unroll
            for (int j = 0; j < 4; ++j) v[j] = vn[j];
            const f32x4* xr = (const f32x4*)norm_src(a, mode, mn) + lane;
#pragma unroll
            for (int j = 0; j < 4; ++j) vn[j] = xr[64 * j];
        } else {
#pragma unroll
            for (int j = 0; j < 4; ++j) v[j] = bf4_f32(vr[j]);
#pragma unroll
            for (int j = 0; j < 4; ++j) vr[j] = XBr[(size_t)mn * 256 + lane + 64 * j];
        }
        const float* mr = modb + (size_t)((m < ML) ? (m >> 12) : 8) * NMOD + off;
        f32x4 av[4], cv[4];
#pragma unroll
        for (int j = 0; j < 4; ++j) { av[j] = ((const f32x4*)mr)[lane + 64 * j]; cv[j] = ((const f32x4*)(mr + DM))[lane + 64 * j]; }
        float s = 0.f;
#pragma unroll
        for (int j = 0; j < 4; ++j) s += (v[j].x * v[j].x + v[j].y * v[j].y) + (v[j].z * v[j].z + v[j].w * v[j].w);
        const float rstd = 1.0f / sqrtf(wave_sum(s) * (1.0f / DM) + EPS);
        unsigned long long* o8 = (unsigned long long*)(hx + (size_t)m * DM) + lane;
        unsigned* o4 = (unsigned*)(a.ws + WS_HX + (size_t)m * DM) + lane;
#pragma unroll
        for (int j = 0; j < 4; ++j) { const f32x4 y = (v[j] * rstd * gv[j]) * (cv[j] + 1.0f) + av[j];
            if (mode == 0) { o4[64 * j] = fp8_pack4(y.x * pg8::ACT8_SCALE, y.y * pg8::ACT8_SCALE, y.z * pg8::ACT8_SCALE, y.w * pg8::ACT8_SCALE); continue; }
            o8[64 * j] = (unsigned long long)cvtpk(y.x, y.y) | ((unsigned long long)cvtpk(y.z, y.w) << 32);
            if (off == 3 * DM) {
                const float q0 = fminf(fmaxf(y.x * XQ_SCALE, -6.f), 6.f), q1 = fminf(fmaxf(y.y * XQ_SCALE, -6.f), 6.f), q2 = fminf(fmaxf(y.z * XQ_SCALE, -6.f), 6.f), q3 = fminf(fmaxf(y.w * XQ_SCALE, -6.f), 6.f);
                unsigned ph = __builtin_amdgcn_cvt_scalef32_pk_fp4_f32(0u, q0, q1, 1.0f, 0); ph = __builtin_amdgcn_cvt_scalef32_pk_fp4_f32(ph, q2, q3, 1.0f, 1);
                const f32x2 d0 = FP4_DEC(ph, 0), d1 = FP4_DEC(ph, 1);
                unsigned pl = __builtin_amdgcn_cvt_scalef32_pk_fp4_f32(0u, 4.f * (q0 - d0.x), 4.f * (q1 - d0.y), 1.0f, 0); pl = __builtin_amdgcn_cvt_scalef32_pk_fp4_f32(pl, 4.f * (q2 - d1.x), 4.f * (q3 - d1.y), 1.0f, 1);
                unsigned short* xq = (unsigned short*)(a.ws + WS_X8 + ((size_t)j * ML + m) * 256) + lane;
                xq[0] = (unsigned short)(ph & 0xffffu); xq[64] = (unsigned short)(pl & 0xffffu); } }
    }
}
__device__ __forceinline__ void final_norm_phase(const Ctx& F0, const Args& a) {
    const Ctx F = fresh(F0);
    const int gwv = F.vcu * NWAVES + F.wave, NGW = F.G * NWAVES;
    const float* gw = a.in[16];
    const u32x2* XBr = (const u32x2*)(a.ws + WS_XB);
    f32x4 gv[4]; u32x2 vr[4];
#pragma unroll
    for (int j = 0; j < 4; ++j) gv[j] = ((const f32x4*)gw)[F.lane + 64 * j];
    if (gwv < ML) {
#pragma unroll
        for (int j = 0; j < 4; ++j) vr[j] = XBr[(size_t)gwv * 256 + F.lane + 64 * j]; }
    for (int m = gwv; m < ML; m += NGW) {
        f32x4* xr = (f32x4*)(a.out + (size_t)m * DM) + F.lane;
        f32x4 v[4]; float s = 0.f;
#pragma unroll
        for (int j = 0; j < 4; ++j) { v[j] = bf4_f32(vr[j]); s += (v[j].x * v[j].x + v[j].y * v[j].y) + (v[j].z * v[j].z + v[j].w * v[j].w); }
        { const int mn = (m + NGW < ML) ? m + NGW : m;
#pragma unroll
          for (int j = 0; j < 4; ++j) vr[j] = XBr[(size_t)mn * 256 + F.lane + 64 * j]; }
        const float rstd = 1.0f / sqrtf(wave_sum(s) * (1.0f / DM) + EPS);
#pragma unroll
        for (int j = 0; j < 4; ++j) xr[64 * j] = v[j] * rstd * gv[j];
    }
}

constexpr int ATT_ROWB = 144, ATT_KTILEB = 128 * ATT_ROWB, ATT_VROWB = 272, ATT_VTILEB = 64 * ATT_VROWB, ATT_BIAS_B = 2048, ATT_K0 = ATT_BIAS_B, ATT_V0 = ATT_K0 + 2 * ATT_KTILEB;
constexpr float ATT_THR = 8.0f;
template <int NGH, bool LATENT>
__device__ __forceinline__ void attn_sub(const LAS unsigned char* Kt, const LAS unsigned char* Vt_, int ko, const LAS float* browA, const LAS float* browB, const int (&relidx)[8],
                                         const bf16x8 (&qf)[2], float& m_ref, float& l_run, f32x4 (&o)[4], int q16, int g4) {
    constexpr int NG = 2 * NGH;
    bf16x8 kf[2 * NG][2]; u32x2 vf[4][NG][2]; f32x4 sc[2 * NG];
#pragma unroll
    for (int gk = 0; gk < NG; ++gk)
#pragma unroll
        for (int b2 = 0; b2 < 2; ++b2)
#pragma unroll
            for (int ks = 0; ks < 2; ++ks) kf[2 * gk + b2][ks] = *(const LAS bf16x8*)(Kt + ((gk / NGH) * 64 + ko + 32 * (gk % NGH) + 16 * b2 + q16) * ATT_ROWB + 64 * ks + 16 * g4);
#pragma unroll
    for (int d = 0; d < 4; ++d)
#pragma unroll
        for (int gk = 0; gk < NG; ++gk) { const LAS unsigned char* vp = Vt_ + (16 * d + q16) * ATT_VROWB + 2 * ((gk / NGH) * 64 + ko + 32 * (gk % NGH) + 4 * g4);
            vf[d][gk][0] = *(const LAS u32x2*)vp; vf[d][gk][1] = *(const LAS u32x2*)(vp + 32); }
    if (LATENT) {
#pragma unroll
        for (int kk = 0; kk < 8; ++kk) { sc[kk >> 2][kk & 3] = browA[relidx[kk]] - m_ref; sc[2 + (kk >> 2)][kk & 3] = browB[relidx[kk]] - m_ref; }
    } else {
#pragma unroll
        for (int blk = 0; blk < 2 * NG; ++blk) sc[blk] = (f32x4){-m_ref, -m_ref, -m_ref, -m_ref};
    }
#pragma unroll
    for (int blk = 0; blk < 2 * NG; ++blk)
#pragma unroll
        for (int ks = 0; ks < 2; ++ks) sc[blk] = __builtin_amdgcn_mfma_f32_16x16x32_bf16(kf[blk][ks], qf[ks], sc[blk], 0, 0, 0);
    float mx = fmaxf(fmaxf(sc[0][0], sc[0][1]), fmaxf(sc[0][2], sc[0][3]));
#pragma unroll
    for (int blk = 1; blk < 2 * NG; ++blk) mx = fmaxf(mx, fmaxf(fmaxf(sc[blk][0], sc[blk][1]), fmaxf(sc[blk][2], sc[blk][3])));
    if (__builtin_amdgcn_ballot_w64(mx > ATT_THR) != 0ull) {
        mx = fmaxf(mx, __shfl_xor(mx, 16)); mx = fmaxf(mx, __shfl_xor(mx, 32));
        const float dl = mx > ATT_THR ? mx : 0.f;
        m_ref += dl;
        const float al = __builtin_amdgcn_exp2f(-dl);
        l_run *= al;
#pragma unroll
        for (int d = 0; d < 4; ++d) o[d] *= al;
#pragma unroll
        for (int blk = 0; blk < 2 * NG; ++blk) sc[blk] -= dl;
    }
    float ls0 = 0.f, ls1 = 0.f;
#pragma unroll
    for (int blk = 0; blk < 2 * NG; ++blk)
#pragma unroll
        for (int i = 0; i < 4; ++i) { const float e = __builtin_amdgcn_exp2f(sc[blk][i]); sc[blk][i] = e; if (blk & 1) ls1 += e; else ls0 += e; }
    l_run += ls0 + ls1;
    bf16x8 pf[NG];
#pragma unroll
    for (int gk = 0; gk < NG; ++gk) { u32x4 pw; pw.x = cvtpk(sc[2 * gk][0], sc[2 * gk][1]); pw.y = cvtpk(sc[2 * gk][2], sc[2 * gk][3]); pw.z = cvtpk(sc[2 * gk + 1][0], sc[2 * gk + 1][1]); pw.w = cvtpk(sc[2 * gk + 1][2], sc[2 * gk + 1][3]);
        pf[gk] = __builtin_bit_cast(bf16x8, pw); }
#pragma unroll
    for (int gk = 0; gk < NG; ++gk)
#pragma unroll
        for (int d = 0; d < 4; ++d) { u32x4 vw; vw.x = vf[d][gk][0].x; vw.y = vf[d][gk][0].y; vw.z = vf[d][gk][1].x; vw.w = vf[d][gk][1].y;
            o[d] = __builtin_amdgcn_mfma_f32_16x16x32_bf16(__builtin_bit_cast(bf16x8, vw), pf[gk], o[d], 0, 0, 0); }
}
__device__ __forceinline__ void attn_phase(const Ctx& F0, const Args& a) {
    const Ctx F = fresh(F0);
    const bf16_t* QK = (const bf16_t*)(a.ws + WS_QK);
    const bf16_t* VT = (const bf16_t*)(a.ws + WS_VT);
    unsigned char* AO = a.ws + WS_HX + 36 * MiB;
    const float* rpb = a.in[10];
    LAS float* bias = (LAS float*)F.lds;
    const int tid = F.tid, lane = F.lane, q16 = lane & 15, g4 = lane >> 4;
    const int rr = F.wave >> 2, jt = F.wave & 3;
    const int qc = 16 * jt + q16, cs = min(max(qc - 8, 0), 48), ksj = min(max(16 * jt - 8, 0), 32);
    int relidx[8];
#pragma unroll
    for (int k = 0; k < 8; ++k) { const int kc = ksj + 16 * (k >> 2) + 4 * g4 + (k & 3); relidx[k] = (kc >= cs && kc < cs + 16) ? (kc - qc + 15) : 31; }
    const int krow = tid >> 3, kch = tid & 7, vrow = tid >> 4, vch = tid & 15;
    const unsigned lds_k = (unsigned)(krow * ATT_ROWB + kch * 16), lds_v = (unsigned)(vrow * ATT_VROWB + vch * 16);
    const int nunits = NB * 16 * 32, upb = (nunits + F.G - 1) / F.G;
    int cur_bh = -1;
    for (int k = 0; k < upb; ++k) {
        const int id = F.vcu * upb + k; if (id >= nunits) break;
        const int p = id & 31, bh = id >> 5, b = bh >> 4, h = bh & 15;
        if (bh != cur_bh) {
            __syncthreads();
            for (int i = tid; i < 16 * 32; i += 512) { const int dr = i >> 5, dc = i & 31; bias[i] = (dc < 31 && dr < 15) ? rpb[(h * 15 + dr) * 31 + dc] * LOG2E : -1e30f; }
            cur_bh = bh;
        }
        const int r0 = 2 * p, rs0 = min(max(r0 - 4, 0), 56), rs1 = min(max(r0 + 1 - 4, 0), 56);
        const int nlat = rs1 + 8 - rs0, nlt = (nlat + 1) >> 1, nsteps = nlt + 2;
        const int r = r0 + rr, rs = rr ? rs1 : rs0;
        const long tokq = (long)b * SEQ + r * GW + qc;
        const bf16_t* kbase = QK + 1024 + h * 64 + kch * 8;
        const bf16_t* vbase = VT + (long)(h * 64 + vrow) * MT + (vch & 7) * 8;
#define ATT_TOKA(step) ((step) < nlt ? ((long)b * SEQ + (long)(rs0 + 2 * (step)) * GW) : ((long)ML + b * CTXL + ((step) - nlt) * 128))
#define ATT_TOKB(step) ((step) < nlt ? ((long)b * SEQ + (long)min(rs0 + 2 * (step) + 1, rs0 + nlat - 1) * GW) : ((long)ML + b * CTXL + ((step) - nlt) * 128 + 64))
        u32x4 kA[2], vA[2], kB[2], vB[2];
#define ATT_LOAD(step, kr_, vr_) do { const int st_ = (step) < nsteps ? (step) : nsteps - 1; const long ta_ = ATT_TOKA(st_), tb_ = ATT_TOKB(st_);     \
        kr_[0] = *(const u32x4*)(kbase + (ta_ + krow) * 2048); kr_[1] = *(const u32x4*)(kbase + (tb_ + krow) * 2048); \
        const long tv_ = (vch < 8) ? ta_ : tb_; vr_[0] = *(const u32x4*)(vbase + tv_); vr_[1] = *(const u32x4*)(vbase + (long)32 * MT + tv_); } while (0)
#define ATT_WRITE(buf, kr_, vr_) do { *(LAS u32x4*)(F.lds + ATT_K0 + (buf) * ATT_KTILEB + lds_k) = kr_[0]; *(LAS u32x4*)(F.lds + ATT_K0 + (buf) * ATT_KTILEB + 64 * ATT_ROWB + lds_k) = kr_[1]; \
        *(LAS u32x4*)(F.lds + ATT_V0 + (buf) * ATT_VTILEB + lds_v) = vr_[0]; *(LAS u32x4*)(F.lds + ATT_V0 + (buf) * ATT_VTILEB + 32 * ATT_VROWB + lds_v) = vr_[1]; } while (0)
        ATT_LOAD(0, kA, vA); ATT_LOAD(1, kB, vB);
        bf16x8 qf[2];
#pragma unroll
        for (int ks = 0; ks < 2; ++ks) qf[ks] = *(const bf16x8*)(QK + tokq * 2048 + h * 64 + 32 * ks + 8 * g4);
        float m_ref = 0.f, l_run = 0.f;
        f32x4 o[4];
#pragma unroll
        for (int d = 0; d < 4; ++d) o[d] = (f32x4){0.f, 0.f, 0.f, 0.f};
        __syncthreads();
        ATT_WRITE(0, kA, vA);
        asm volatile("" :: "v"(qf[0]), "v"(qf[1]));
        __syncthreads();
#define ATT_COMPUTE(step, cur) do { \
            const LAS unsigned char* Kt = F.lds + ATT_K0 + (cur) * ATT_KTILEB; \
            const LAS unsigned char* Vt_ = F.lds + ATT_V0 + (cur) * ATT_VTILEB; \
            if ((step) < nlt) { const int krA = rs0 + 2 * (step), krB = krA + 1; \
                const bool actA = krA >= rs && krA < rs + 8, actB = krB < rs0 + nlat && krB >= rs && krB < rs + 8; \
                if (actA || actB) attn_sub<1, true>(Kt, Vt_, ksj, bias + (actA ? (krA - r + 7) : 15) * 32, bias + (actB ? (krB - r + 7) : 15) * 32, relidx, qf, m_ref, l_run, o, q16, g4); \
            } else attn_sub<2, false>(Kt, Vt_, 0, bias, bias, relidx, qf, m_ref, l_run, o, q16, g4); \
        } while (0)
        for (int step = 0; step < nsteps; step += 2) {
            ATT_COMPUTE(step, 0);
            if (step + 1 < nsteps) ATT_WRITE(1, kB, vB);
            ATT_LOAD(step + 2, kA, vA);
            __syncthreads();
            if (step + 1 < nsteps) { ATT_COMPUTE(step + 1, 1); }
            if (step + 2 < nsteps) ATT_WRITE(0, kA, vA);
            ATT_LOAD(step + 3, kB, vB);
            __syncthreads();
        }
#undef ATT_LOAD
#undef ATT_WRITE
#undef ATT_COMPUTE
#undef ATT_TOKA
#undef ATT_TOKB
        l_run += __shfl_xor(l_run, 16); l_run += __shfl_xor(l_run, 32);
        const float linv = 1.0f / l_run;
        unsigned char* op = AO + tokq * DM + h * 64 + 4 * g4; const float ls = linv * pg8::ACT8_SCALE;
#pragma unroll
        for (int d = 0; d < 4; ++d) *(unsigned*)(op + 16 * d) = fp8_pack4(o[d][0] * ls, o[d][1] * ls, o[d][2] * ls, o[d][3] * ls);
    }
    __syncthreads();
}

__device__ __forceinline__ void ce_desc(float& a, float& b) { const float hi = fmaxf(a, b), lo = fminf(a, b); a = hi; b = lo; }
__device__ __forceinline__ void ce_dir(float& a, float& b, bool desc) { const float hi = fmaxf(a, b), lo = fminf(a, b); a = desc ? hi : lo; b = desc ? lo : hi; }
__device__ __forceinline__ void sort16_desc(float (&v)[16]) {
#pragma unroll
    for (int k = 2; k <= 16; k <<= 1)
#pragma unroll
        for (int j = k >> 1; j > 0; j >>= 1)
#pragma unroll
            for (int i = 0; i < 16; ++i) { const int l = i ^ j; if (l > i) ce_dir(v[i], v[l], (i & k) == 0); }
}
__device__ __forceinline__ void merge16_desc(float (&a)[16], const float (&b)[16]) {
#pragma unroll
    for (int i = 0; i < 16; ++i) a[i] = fmaxf(a[i], b[15 - i]);
#pragma unroll
    for (int j = 8; j > 0; j >>= 1)
#pragma unroll
        for (int i = 0; i < 16; ++i) { const int l = i ^ j; if (l > i) ce_desc(a[i], a[l]); }
}

struct CandTab { int i[64]; int j[64]; };
__host__ __device__ constexpr CandTab make_cand_tab() {
    CandTab t{}; int n = 0;
    for (int i = 0; i < 16; ++i) for (int j = 0; j < 16; ++j) if ((i + 1) * (j + 1) <= 16) { t.i[n] = i; t.j[n] = j; ++n; }
    for (; n < 64; ++n) { t.i[n] = -1; t.j[n] = -1; }
    return t;
}

__device__ __forceinline__ void peer_topk_phase(const Ctx& F0, const Args& a, int layer) {
    const Ctx F = fresh(F0);
    const bf16_t* QP = (const bf16_t*)(a.ws + WS_QK);
    const bf16_t* SK = (const bf16_t*)(a.ws + WS_SK) + (size_t)layer * 2 * 128 * 128;
    unsigned short* IDX = (unsigned short*)(a.ws + WS_IDX);
    float* GATE = (float*)(a.ws + WS_GATE);
    const int gwv = F.vcu * NWAVES + F.wave, NGW = F.G * NWAVES;
    const int lane = F.lane, t32 = lane & 31, hi = lane >> 5;
    __syncthreads();
    for (int c = F.tid; c < 4096; c += 512) *(LAS u32x4*)(F.lds + (c >> 4) * 272 + (c & 15) * 16) = *(const u32x4*)(SK + (size_t)c * 8);
    __syncthreads();
    for (int task = gwv; task < 1024 * 8; task += NGW) {
        const int tt = task >> 3, h = task & 7;
        const long tok = (long)tt * 32 + t32;
        float top[2][16];
#pragma unroll
        for (int p = 0; p < 2; ++p) {
            f32x16 acc[4];
#pragma unroll
            for (int eb = 0; eb < 4; ++eb)
#pragma unroll
                for (int i = 0; i < 16; ++i) acc[eb][i] = 0.f;
#pragma unroll
            for (int eb = 0; eb < 4; ++eb) asm volatile("" : "+v"(acc[eb]));
            const bf16_t* qp = QP + tok * 2048 + h * 256 + p * 128 + hi * 8;
            const LAS unsigned char* kp = F.lds + (p * 128 + t32) * 272 + hi * 16;
#pragma unroll
            for (int ks = 0; ks < 8; ++ks) {
                if ((ks & 1) == 0) asm volatile("" ::: "memory");
                const bf16x8 bq = *(const bf16x8*)(qp + ks * 16);
#pragma unroll
                for (int eb = 0; eb < 4; ++eb) { const bf16x8 ak = *(const LAS bf16x8*)(kp + eb * 32 * 272 + ks * 32); acc[eb] = __builtin_amdgcn_mfma_f32_32x32x16_bf16(ak, bq, acc[eb], 0, 0, 0); }
            }
            float cur[16];
#pragma unroll
            for (int eb = 0; eb < 4; ++eb) {
                float v[16];
#pragma unroll
                for (int i = 0; i < 16; ++i) { const unsigned e = 32 * eb + crow(i, hi); float x = acc[eb][i]; asm volatile("" : "+v"(x));
                    v[i] = __builtin_bit_cast(float, (__builtin_bit_cast(unsigned, x) & ~0x7Fu) | e); }
                sort16_desc(v);
                if (eb == 0) {
#pragma unroll
                    for (int i = 0; i < 16; ++i) cur[i] = v[i];
                } else merge16_desc(cur, v);
            }
            float oth[16];
#pragma unroll
            for (int i = 0; i < 16; ++i) oth[i] = __shfl_xor(cur[i], 32);
            merge16_desc(cur, oth);
#pragma unroll
            for (int i = 0; i < 16; ++i) top[p][i] = cur[i];
            __builtin_amdgcn_sched_barrier(0);
        }
        float best[16];
#pragma unroll
        for (int gI = 0; gI < 4; ++gI) {
            float v[16];
#pragma unroll
            for (int q = 0; q < 16; ++q) {
                constexpr CandTab CT = make_cand_tab();
                const int ci = CT.i[16 * gI + q], cj = CT.j[16 * gI + q];
                if (ci >= 0) {
                    const unsigned ua = __builtin_bit_cast(unsigned, top[0][ci]), ub = __builtin_bit_cast(unsigned, top[1][cj]);
                    float s = top[0][ci] + top[1][cj]; asm volatile("" : "+v"(s));
                    const unsigned code = ((ua & 0x7Fu) << 7) | (ub & 0x7Fu);
                    v[q] = __builtin_bit_cast(float, (__builtin_bit_cast(unsigned, s) & ~0x3FFFu) | code);
                } else v[q] = -3.0e38f;
            }
            sort16_desc(v);
            if (gI == 0) {
#pragma unroll
                for (int i = 0; i < 16; ++i) best[i] = v[i];
            } else merge16_desc(best, v);
            __builtin_amdgcn_sched_barrier(0);
        }
        float e[16], sum = 0.f;
#pragma unroll
        for (int i = 0; i < 16; ++i) { e[i] = __builtin_amdgcn_exp2f((best[i] - best[0]) * LOG2E); sum += e[i]; }
        const float inv = 1.0f / sum;
        if (hi == 0) {
            u32x4 w0, w1;
            w0.x = (__builtin_bit_cast(unsigned, best[0]) & 0x3FFFu) | ((__builtin_bit_cast(unsigned, best[1]) & 0x3FFFu) << 16);
            w0.y = (__builtin_bit_cast(unsigned, best[2]) & 0x3FFFu) | ((__builtin_bit_cast(unsigned, best[3]) & 0x3FFFu) << 16);
            w0.z = (__builtin_bit_cast(unsigned, best[4]) & 0x3FFFu) | ((__builtin_bit_cast(unsigned, best[5]) & 0x3FFFu) << 16);
            w0.w = (__builtin_bit_cast(unsigned, best[6]) & 0x3FFFu) | ((__builtin_bit_cast(unsigned, best[7]) & 0x3FFFu) << 16);
            w1.x = (__builtin_bit_cast(unsigned, best[8]) & 0x3FFFu) | ((__builtin_bit_cast(unsigned, best[9]) & 0x3FFFu) << 16);
            w1.y = (__builtin_bit_cast(unsigned, best[10]) & 0x3FFFu) | ((__builtin_bit_cast(unsigned, best[11]) & 0x3FFFu) << 16);
            w1.z = (__builtin_bit_cast(unsigned, best[12]) & 0x3FFFu) | ((__builtin_bit_cast(unsigned, best[13]) & 0x3FFFu) << 16);
            w1.w = (__builtin_bit_cast(unsigned, best[14]) & 0x3FFFu) | ((__builtin_bit_cast(unsigned, best[15]) & 0x3FFFu) << 16);
            u32x4* ip = (u32x4*)(IDX + tok * 128 + h * 16);
            ip[0] = w0; ip[1] = w1;
        } else {
            f32x4* gp = (f32x4*)(GATE + tok * 128 + h * 16);
#pragma unroll
            for (int q = 0; q < 4; ++q) gp[q] = (f32x4){e[4 * q] * inv, e[4 * q + 1] * inv, e[4 * q + 2] * inv, e[4 * q + 3] * inv};
        }
    }
    __syncthreads();
}

typedef long i64_t;
typedef unsigned u32x8_t __attribute__((ext_vector_type(8)));
typedef _Float16 h2_t __attribute__((ext_vector_type(2)));
#define U_MFMA4_FIRST(acc, av, bv) asm volatile("v_mfma_scale_f32_16x16x128_f8f6f4 %0, %1, %2, 0, %3, %4 op_sel_hi:[0,0,0] cbsz:4 blgp:4" : "=&v"(acc) : "v"(av), "v"(bv), "v"(sc_a), "v"(sc_one))
#define U_MFMA4(acc, av, bv) asm volatile("v_mfma_scale_f32_16x16x128_f8f6f4 %0, %1, %2, %0, %3, %4 op_sel_hi:[0,0,0] cbsz:4 blgp:4" : "+v"(acc) : "v"(av), "v"(bv), "v"(sc_a), "v"(sc_one))
template <int UVAR = 0>
__device__ __forceinline__ void peer_u_phase(const Ctx& F0, const Args& a, int layer) {
    const Ctx F = fresh(F0);
    const int s = (int)(blockIdx.x & 3), half = (int)((blockIdx.x >> 2) & 1), j = (int)(blockIdx.x >> 3), nmem = F.G >> 3;
    const unsigned char* U4s = a.ws + WS_TAB + (size_t)layer * TAB_LAYER + (size_t)s * NEXP * 128;
    const unsigned* XQ = (const unsigned*)(a.ws + WS_X8 + (size_t)s * ML * 256);
    const unsigned short* IDX = (const unsigned short*)(a.ws + WS_IDX);
    unsigned* PART = (unsigned*)(a.ws + WS_PART) + (size_t)s * ML * 64;
    const int lane = F.lane, rsub = lane >> 3, c8 = lane & 7, n16 = lane & 15, g4 = lane >> 4;
    LAS unsigned char* tile = F.lds + F.wave * 16384;
    constexpr float osc = 1.0f / (U_SCALE * XQ_SCALE);
    constexpr int MLH = ML / 2;
    const int t0 = half * MLH + j * NWAVES + F.wave, stride = nmem * NWAVES, ntok = (half * MLH + MLH - t0 + stride - 1) / stride;
    unsigned sc_one = 0x7f7f7f7fu; asm volatile("" : "+v"(sc_one));
    unsigned sc_a = (n16 & 1) ? 0x7d7d7d7du : 0x7f7f7f7fu; asm volatile("" : "+v"(sc_a));
    const int abase = (32 * (n16 & 1) + 4 * g4) * 4;
#define U_TOK(i) ((size_t)(t0 + ((i) < ntok ? (i) : ntok - 1) * stride))
    const unsigned wx0 = (unsigned)(size_t)(tile + rsub * 2048 + (c8 << 4));
    const unsigned rb0 = (unsigned)(size_t)(tile + n16 * 128 + ((g4 ^ ((n16 >> 1) & 7)) << 4));
    LAS unsigned char* stg = tile + g4 * 512 + n16 * 4;
#define U_LDXQ(i) (XQ[U_TOK(i) * 64 + lane])
#define U_LDI(i) (((const unsigned*)IDX)[U_TOK(i) * 64 + lane])
#define U_IDP(dst, ci) do { _Pragma("unroll") for (int k = 0; k < 8; ++k) dst[k] = (unsigned)__builtin_amdgcn_ds_bpermute((8 * rsub + k) * 4, (int)(ci)); } while (0)
#define U_EIDP(idp, i_) (((i_) & 1) ? (idp[(i_) >> 1] >> 16) : (idp[(i_) >> 1] & 0xffffu))
#define U_READS(nb0) do { \
        _Pragma("unroll") for (int nb = 0; nb < 4; ++nb) { _Pragma("unroll") for (int ks = 0; ks < 2; ++ks) \
            bw[nb][ks] = *(const LAS u32x4*)((LAS unsigned char*)(size_t)(rb0 ^ (64u * ks)) + 2048 * ((nb0) + nb)); } \
        __builtin_amdgcn_sched_barrier(0); \
    } while (0)
#define U_MFMAS() do { \
        _Pragma("unroll") for (int nb = 0; nb < 4; ++nb) U_MFMA4_FIRST(dA[nb], aop[0], bw[nb][0]); \
        _Pragma("unroll") for (int nb = 0; nb < 4; ++nb) U_MFMA4(dA[nb], aop[1], bw[nb][1]); \
        __builtin_amdgcn_sched_barrier(0); \
    } while (0)
#define U_OUTS(nb0) do { \
        asm volatile("s_nop 15\n\ts_nop 3" : "+v"(dA[0]), "+v"(dA[1]), "+v"(dA[2]), "+v"(dA[3]) :: "memory");     \
        _Pragma("unroll") for (int nb = 0; nb < 4; ++nb) { ov[(nb0) + nb] = dA[nb][0] + dA[nb][1]; asm volatile("" : "+v"(ov[(nb0) + nb])); } \
    } while (0)
#define U_BODY(j, CUR, NXT, LD) do { \
        unsigned idp[8]; \
        U_IDP(idp, ci##NXT);                                             \
          \
        _Pragma("unroll") for (int i_ = 0; i_ < 16; ++i_) { \
            *(LAS u32x4*)((LAS unsigned char*)(size_t)(wx0 ^ (unsigned)(((i_) >> 1) << 4)) + i_ * 128) = R[i_]; \
            if (UVAR == 0 || (UVAR == 1 && i_ < 8)) R[i_] = *(const u32x4*)(U4s + (unsigned)(U_EIDP(idp, i_) * 128 + 16 * c8)); \
        } \
          \
        u32x4 aop[2]; \
        _Pragma("unroll") for (int ks = 0; ks < 2; ++ks) { _Pragma("unroll") for (int k = 0; k < 4; ++k) { \
            const unsigned w_ = (unsigned)__builtin_amdgcn_ds_bpermute(abase + (16 * ks + k) * 4, (int)cx##CUR); \
            aop[ks][k] = (n16 < 2) ? w_ : 0u; } } \
        asm volatile("s_waitcnt lgkmcnt(0)" ::: "memory");               \
        f32x4 dA[4]; u32x4 bw[4][2]; float ov[8]; \
        U_READS(0); \
        U_MFMAS(); \
          \
        ci##CUR = U_LDI((j) + 3); cx##LD = U_LDXQ((j) + 2); \
        __builtin_amdgcn_sched_barrier(0); \
        U_READS(4);                                                      \
        U_OUTS(0); \
        U_MFMAS(); \
        U_OUTS(4); \
          \
        _Pragma("unroll") for (int nb = 0; nb < 8; ++nb) *(LAS float*)(stg + nb * 64) = ov[nb]; \
        asm volatile("s_waitcnt lgkmcnt(0)" ::: "memory"); \
        const f32x2 sum = *(const LAS f32x2*)(tile + 8 * lane); \
        asm volatile("s_waitcnt lgkmcnt(0)" ::: "memory"); \
        if ((j) < ntok) PART[U_TOK(j) * 64 + lane] = cvtpk(sum.x * osc, sum.y * osc); \
    } while (0)
    u32x4 R[16];
    unsigned cxA, cxB, cxC, ciA, ciB, ciC;
    ciA = U_LDI(0);
    cxA = U_LDXQ(0); cxB = U_LDXQ(1);
    { unsigned idp0[8]; U_IDP(idp0, ciA);
#pragma unroll
      for (int i_ = 0; i_ < 16; ++i_) R[i_] = *(const u32x4*)(U4s + (unsigned)(U_EIDP(idp0, i_) * 128 + 16 * c8)); }
    ciB = U_LDI(1); ciC = U_LDI(2);
    cxC = 0u;
    asm volatile("" :: "v"(ciC));
    for (int i = 0; i < ntok; i += 3) {
        U_BODY(i, A, B, C);
        U_BODY(i + 1, B, C, A);
        U_BODY(i + 2, C, A, B);
    }
#undef U_BODY
#undef U_READS
#undef U_MFMAS
#undef U_OUTS
#undef U_LDXQ
#undef U_LDI
#undef U_IDP
#undef U_EIDP
#undef U_TOK
}
#undef U_MFMA4_FIRST
#undef U_MFMA4
__device__ __forceinline__ void peer_w_phase(const Ctx& F0, const Args& a) {
    const Ctx F = fresh(F0);
    const unsigned* PART = (const unsigned*)(a.ws + WS_PART);
    const float* GATE = (const float*)(a.ws + WS_GATE);
    unsigned char* WQ = a.ws + WS_WT;
    float* WSC = (float*)(a.ws + WS_WSC);
    const int gwv = F.vcu * NWAVES + F.wave, NGW = F.G * NWAVES;
    for (int t = gwv; t < ML; t += NGW) {
        f32x2 z = (f32x2){0.f, 0.f};
#pragma unroll
        for (int s = 0; s < 4; ++s) { const unsigned pw = PART[((size_t)s * ML + t) * 64 + F.lane]; z += (f32x2){bflo(pw), bfhi(pw)}; }
        const f32x2 g = *(const f32x2*)(GATE + (size_t)t * 128 + 2 * F.lane);
        f32x2 w; w.x = g.x * gelu_erf(z.x); w.y = g.y * gelu_erf(z.y);
        float wm = fmaxf(__builtin_fabsf(w.x), __builtin_fabsf(w.y));
#pragma unroll
        for (int o = 1; o < 64; o <<= 1) wm = fmaxf(wm, __shfl_xor(wm, o));
        wm = fmaxf(wm, 1e-20f);
        const float qs = 6.0f / wm, ax = fminf(fmaxf(w.x * qs, -6.f), 6.f), ay = fminf(fmaxf(w.y * qs, -6.f), 6.f);
        const unsigned ph = __builtin_amdgcn_cvt_scalef32_pk_fp4_f32(0u, ax, ay, 1.0f, 0) & 0xffu;
        const f32x2 dh = FP4_DEC(ph, 0);
        const unsigned pl = __builtin_amdgcn_cvt_scalef32_pk_fp4_f32(0u, fminf(fmaxf(4.f * (ax - dh.x), -6.f), 6.f), fminf(fmaxf(4.f * (ay - dh.y), -6.f), 6.f), 1.0f, 0) & 0xffu;
        ((unsigned short*)WQ)[(size_t)t * 128 + F.lane] = (unsigned short)((ph & 0xfu) | ((ph & 0xf0u) << 4));
        ((unsigned short*)WQ)[(size_t)t * 128 + 64 + F.lane] = (unsigned short)((pl & 0xfu) | ((pl & 0xf0u) << 4));
        if (F.lane == 0) WSC[t] = wm * (1.0f / 6.0f);
    }
}
#define V_MFMA4_FIRST(acc, av, bv, sa) asm volatile("v_mfma_scale_f32_16x16x128_f8f6f4 %0, %1, %2, 0, %3, %4 op_sel_hi:[0,0,0] cbsz:4 blgp:4" : "=&v"(acc) : "v"(av), "v"(bv), "v"(sa), "v"(sc_one))
#define V_MFMA4(acc, av, bv, sa) asm volatile("v_mfma_scale_f32_16x16x128_f8f6f4 %0, %1, %2, %0, %3, %4 op_sel_hi:[0,0,0] cbsz:4 blgp:4" : "+v"(acc) : "v"(av), "v"(bv), "v"(sa), "v"(sc_one))
template <int VAR = 0>
__device__ __forceinline__ void peer_v_phase(const Ctx& F0, const Args& a, int layer, float oscale = 1.0f) {
    const Ctx F = fresh(F0);
    const int s = (int)(blockIdx.x & 3), half = (int)((blockIdx.x >> 2) & 1), j = (int)(blockIdx.x >> 3), nmem = F.G >> 3;
    const unsigned char* V4s = a.ws + WS_TAB + (size_t)layer * TAB_LAYER + TAB_VOFF + (size_t)s * NEXP * 128;
    const unsigned short* IDX = (const unsigned short*)(a.ws + WS_IDX);
    const unsigned char* WQ = a.ws + WS_WT;
    const float* WSC = (const float*)(a.ws + WS_WSC);
    const float* modb = (const float*)(a.ws + WS_MOD) + (size_t)layer * 9 * NMOD;
    bf16_t* X = (bf16_t*)(a.ws + WS_XB);
    const int lane = F.lane, rsub = lane >> 3, c8 = lane & 7, n16 = lane & 15, g4 = lane >> 4;
    LAS unsigned char* tile = F.lds + F.wave * 16384;
    const float osc = ((DBG_SKIP & (layer == 0 ? 2 : 8)) ? 0.f : oscale) * (1.0f / V_SCALE);
    constexpr int MLH = ML / 2;
    const int t0 = half * MLH + j * NWAVES + F.wave, stride = nmem * NWAVES, ntok = (half * MLH + MLH - t0 + stride - 1) / stride;
    unsigned sc_one = 0x7f7f7f7fu; asm volatile("" : "+v"(sc_one));
    typedef int v2i_t __attribute__((ext_vector_type(2)));
    LAS float* gl = (LAS float*)(F.lds + RING_BYTES + 4096);
    for (int u = F.tid; u < 4 * 256; u += NWAVES * 64) gl[u] = modb[(size_t)(4 * half + (u >> 8)) * NMOD + 5 * DM + 256 * s + (u & 255)] * osc;
    __syncthreads();
#define V_TOK(i) ((size_t)(t0 + ((i) < ntok ? (i) : ntok - 1) * stride))
    LAS unsigned char* wx[4]; LAS unsigned char* rb[4];
#pragma unroll
    for (int k = 0; k < 4; ++k) wx[k] = tile + rsub * 2048 + ((c8 ^ k ^ ((rsub & 1) << 2)) << 4);
#pragma unroll
    for (int nb = 0; nb < 4; ++nb) rb[nb] = tile + g4 * 2048 + (n16 >> 1) * 128 + 8 * (n16 & 1) + ((nb ^ ((n16 >> 2) & 3) ^ ((g4 & 1) << 2)) << 4);
    LAS unsigned char* stg = tile + g4 * 1024 + n16 * 8;
#define V_LDW(i) (((const unsigned*)WQ)[V_TOK(i) * 64 + lane])
#define V_LDI(i) (((const unsigned*)IDX)[V_TOK(i) * 64 + lane])
#define V_LDX(i) (*(const u32x2*)(X + V_TOK(i) * DM + 256 * s + 4 * lane))
#define V_LDS(i) (WSC[V_TOK(i)])
#define V_IDP(dst, ci) do { _Pragma("unroll") for (int k = 0; k < 8; ++k) dst[k] = (unsigned)__builtin_amdgcn_ds_bpermute((8 * rsub + k) * 4, (int)(ci)); } while (0)
#define V_EIDP(idp, i_) (((i_) & 1) ? (idp[(i_) >> 1] >> 16) : (idp[(i_) >> 1] & 0xffffu))
#define V_READS(nb0) do { \
        unsigned x64 = (nb0) ? 64u : 0u; asm volatile("" : "+v"(x64));                   \
        _Pragma("unroll") for (int nb = 0; nb < 4; ++nb) { LAS unsigned char* rbn = (LAS unsigned char*)((unsigned)(size_t)rb[nb] ^ x64); \
          _Pragma("unroll") for (int h = 0; h < 2; ++h) { _Pragma("unroll") for (int q = 0; q < 2; ++q) { \
            const v2i_t tr = __builtin_amdgcn_ds_read_tr8_b64_v2i32((LAS v2i_t*)(rbn + 8192 * h + 1024 * q)); \
            bw[nb][h][2 * q] = (unsigned)tr[0]; bw[nb][h][2 * q + 1] = (unsigned)tr[1]; } } } \
        __builtin_amdgcn_sched_barrier(0); \
    } while (0)
#define V_MFMAS() do { \
        _Pragma("unroll") for (int nb = 0; nb < 4; ++nb) V_MFMA4_FIRST(dA[nb], aop[0], bw[nb][0], sc_a); \
        _Pragma("unroll") for (int nb = 0; nb < 4; ++nb) V_MFMA4(dA[nb], aop[1], bw[nb][1], sc_a); \
        __builtin_amdgcn_sched_barrier(0); \
    } while (0)
#define V_OUTS(nb0) do { \
        asm volatile("s_nop 15\n\ts_nop 3" : "+v"(dA[0]), "+v"(dA[1]), "+v"(dA[2]), "+v"(dA[3]) :: "memory");     \
        _Pragma("unroll") for (int nb = 0; nb < 4; ++nb) { ov[(nb0) + nb] = (f32x2){dA[nb][0] + dA[nb][2], dA[nb][1] + dA[nb][3]}; asm volatile("" : "+v"(ov[(nb0) + nb])); } \
    } while (0)
#define V_BODY(j, CUR, NXT, LD) do { \
        const size_t t_ = V_TOK(j); \
        unsigned idp[8]; \
        V_IDP(idp, ci##NXT);                                             \
          \
        _Pragma("unroll") for (int i_ = 0; i_ < 16; ++i_) { \
            *(LAS u32x4*)(wx[(i_ >> 1) & 3] + i_ * 128) = R[i_]; \
            if (VAR == 0 || (VAR == 1 && i_ < 8)) R[i_] = *(const u32x4*)(V4s + (unsigned)(V_EIDP(idp, i_) * 128 + 16 * c8)); \
        } \
          \
        u32x4 aop[2]; \
        _Pragma("unroll") for (int h = 0; h < 2; ++h) { _Pragma("unroll") for (int k = 0; k < 4; ++k) { \
            const unsigned w_ = (unsigned)__builtin_amdgcn_ds_bpermute(abase + (16 * h + k) * 4, (int)cw##CUR); \
            aop[h][k] = (n16 < 4) ? (w_ << ash) : 0u; } } \
        asm volatile("s_waitcnt lgkmcnt(0)" ::: "memory");               \
        f32x4 dA[4]; u32x4 bw[4][2]; f32x2 ov[8]; \
        V_READS(0); \
        V_MFMAS(); \
          \
        ci##CUR = V_LDI((j) + 3); cw##LD = V_LDW((j) + 2); xo##LD = V_LDX((j) + 2); ws##LD = V_LDS((j) + 2); \
        __builtin_amdgcn_sched_barrier(0); \
        V_READS(4);                                                      \
        V_OUTS(0); \
        V_MFMAS(); \
        V_OUTS(4); \
          \
        _Pragma("unroll") for (int nb = 0; nb < 8; ++nb) *(LAS f32x2*)(stg + nb * 128) = ov[nb]; \
        asm volatile("s_waitcnt lgkmcnt(0)" ::: "memory"); \
        const f32x4 sum = *(const LAS f32x4*)(tile + 16 * lane); \
        const f32x4 gt_ = *(const LAS f32x4*)(gl + ((t_ >> 12) & 3) * 256 + 4 * lane); \
        asm volatile("s_waitcnt lgkmcnt(0)" ::: "memory"); \
        if ((j) < ntok) { const f32x4 r_ = bf4_f32(xo##CUR) + gt_ * ws##CUR * sum; *(u32x2*)(X + t_ * DM + 256 * s + 4 * lane) = (u32x2){cvtpk(r_.x, r_.y), cvtpk(r_.z, r_.w)}; } \
    } while (0)
    u32x4 R[16];
    unsigned cwA, cwB, cwC, ciA, ciB, ciC;
    u32x2 xoA, xoB, xoC;
    float wsA, wsB, wsC;
    const int abase = (32 * ((n16 >> 1) & 1) + 4 * g4) * 4, ash = 4 * (n16 & 1);
    unsigned sc_a = (n16 & 2) ? 0x7d7d7d7du : 0x7f7f7f7fu; asm volatile("" : "+v"(sc_a));
    ciA = V_LDI(0);
    cwA = V_LDW(0); cwB = V_LDW(1); xoA = V_LDX(0); xoB = V_LDX(1); wsA = V_LDS(0); wsB = V_LDS(1);
    { unsigned idp0[8]; V_IDP(idp0, ciA);
#pragma unroll
      for (int i_ = 0; i_ < 16; ++i_) R[i_] = *(const u32x4*)(V4s + (unsigned)(V_EIDP(idp0, i_) * 128 + 16 * c8)); }
    ciB = V_LDI(1); ciC = V_LDI(2);
    cwC = 0u; xoC = (u32x2){0u, 0u}; wsC = 0.f;
    asm volatile("" :: "v"(ciC));
    for (int i = 0; i < ntok; i += 3) {
        V_BODY(i, A, B, C);
        V_BODY(i + 1, B, C, A);
        V_BODY(i + 2, C, A, B);
    }
#undef V_BODY
#undef V_READS
#undef V_MFMAS
#undef V_OUTS
#undef V_LDW
#undef V_LDI
#undef V_LDX
#undef V_LDS
#undef V_IDP
#undef V_EIDP
#undef V_TOK
}
#undef V_MFMA4_FIRST
#undef V_MFMA4

__device__ __forceinline__ void dft_nyquist_rows(const Ctx& F0, const Args& a) {
    const Ctx F = fresh(F0);
    const unsigned char* Yt = a.ws + WS_QK;
    unsigned char* Fo = a.ws + WS_VT;
    const int gwv = F.vcu * NWAVES + F.wave, NGW = F.G * NWAVES;
    for (int o = gwv; o < NB * DM; o += NGW) {
        const unsigned char* src = Yt + (size_t)o * 8192;
        float s = 0.f;
#pragma unroll
        for (int it = 0; it < 4; ++it) { const u32x4 v = *(const u32x4*)(src + it * 1024 + F.lane * 16);
#pragma unroll
            for (int d = 0; d < 4; ++d) { const f32x2 lo = __builtin_amdgcn_cvt_pk_f32_fp8((int)v[d], false), hi = __builtin_amdgcn_cvt_pk_f32_fp8((int)v[d], true); s += (lo[0] - lo[1]) + (hi[0] - hi[1]); } }
        s = wave_sum(s) * (pg8::ACT8_SCALE / (64.0f * pg8::YT_SCALE));
        if (F.lane == 0) Fo[((size_t)(o >> 10) * SEQ + 2048) * DM + (o & 1023)] = (unsigned char)(fp8_pack4(s, 0.f, 0.f, 0.f) & 0xffu);
    }
}

__global__ void __launch_bounds__(NWAVES * 64, 2) fwd_kernel(Args args) {
    extern __shared__ __attribute__((aligned(16))) unsigned char lds_raw[];
    Ctx F;
    F.lds = (LAS unsigned char*)lds_raw;
    F.tid = threadIdx.x; F.lane = F.tid & 63; F.wave = __builtin_amdgcn_readfirstlane(F.tid >> 6);
    F.G = gridDim.x; { const int bx = blockIdx.x; F.vcu = (F.G % 8 == 0) ? (bx % 8) * (F.G / 8) + bx / 8 : bx; }
    volatile LAS unsigned* MISC = (volatile LAS unsigned*)(F.lds + MISC_OFF);
    for (int u = F.tid; u < (LDS_BYTES - LDSCTL_OFF) / 4; u += NWAVES * 64) ((LAS unsigned*)(F.lds + LDSCTL_OFF))[u] = 0u;
    __syncthreads();
    unsigned char* ws = args.ws;
    XcdBarrier bar = xcd_barrier_post((unsigned*)(ws + WS_CTL) + CW_BAR, MISC + 8);
#define GRID_BAR() xcd_barrier(bar)
#ifndef DBG_REP
#define DBG_REP 0
#endif
#ifndef DBG_VVAR
#define DBG_VVAR 0
#endif
#define REP(k, ...) do { __VA_ARGS__; if (DBG_REP == (k)) { GRID_BAR(); __VA_ARGS__; } } while (0)
#define PEER_BLOCK(layer) do { \
        norm_phase(F, args, 1, layer, 3 * DM, args.in[5] + (layer) * DM); \
        GRID_BAR(); \
        { using SHq = pg8::Shape<ML, 2048, DM, DM, DM, 1, 0, 0>; \
          REP(7, pg8::gemm_phase<SHq>(F.lds, pg8::Gemm{HX, (const bf16_t*)(ws + WS_WPQ) + (size_t)(layer) * 2048 * DM}, F.G, bx, pg8::EpiStoreBf16{QKb, 2048, 0, 0, 1.0f})); } \
        GRID_BAR(); \
        REP(8, peer_topk_phase(F, args, layer)); \
        GRID_BAR(); \
        REP(9, peer_u_phase(F, args, layer)); \
        GRID_BAR(); \
        REP(10, peer_w_phase(F, args)); \
        GRID_BAR(); \
        peer_v_phase(F, args, layer); if (DBG_REP == 11) { GRID_BAR(); peer_v_phase<DBG_VVAR>(F, args, layer, 0.f); } \
        GRID_BAR(); \
    } while (0)
    const float* modb = (const float*)(ws + WS_MOD);
    bf16_t* HX = (bf16_t*)(ws + WS_HX);
    bf16_t* QKb = (bf16_t*)(ws + WS_QK);
    bf16_t* VTb = (bf16_t*)(ws + WS_VT);
    const bf16_t* Wqkv = (const bf16_t*)(ws + WS_WQKV);
    const int bx = (int)blockIdx.x;

    REP(1, p0_prologue(F, args));
    GRID_BAR();
    REP(2, norm_phase(F, args, 0, 0, 0, args.in[4]));
    GRID_BAR();
    {
        constexpr float o8 = 1.0f / (pg8::ACT8_SCALE * pg8::W8_SCALE);
        using SH1 = pg8::Shape<MT, 2048, DM / 2, DM / 2, DM / 2, 1, 0, 0>;
        pg8::gemm_phase<SH1, pg8::EpiStoreBf16, true>(F.lds, pg8::Gemm{HX, Wqkv}, F.G, bx, pg8::EpiStoreBf16{QKb, 2048, 0, 1024, 0.125f * LOG2E, o8});
        using SH2 = pg8::Shape<DM, MT, DM / 2, DM / 2, DM / 2, 1, 0, 0>;
        pg8::gemm_phase<SH2, pg8::EpiStoreBf16, true>(F.lds, pg8::Gemm{Wqkv + (size_t)2048 * DM / 2, HX}, F.G, bx, pg8::EpiStoreBf16{VTb, MT, 0, 0, 1.0f, o8});
        {
            const int nq = (MT / 256) * 8, nv = 4 * (MT / 256), rq = nq % F.G, rv = nv % F.G;
            const int sh_q = (rq == 0 || bx >= rq) ? 1 : 0, sh_v = (rv == 0 || bx >= rv) ? 1 : 0;
            const int before = (rq == 0 ? bx : max(0, bx - rq)) + (rv == 0 ? bx : max(0, bx - rv));
            const int total = (rq == 0 ? F.G : F.G - rq) + (rv == 0 ? F.G : F.G - rv);
            table_convert(F, args, before, sh_q + sh_v, total);
        }
    }
    GRID_BAR();
    REP(4, attn_phase(F, args));
    GRID_BAR();
    {
        using SH = pg8::Shape<ML, DM, DM / 2, DM / 2, DM / 2, 1, 0, 0>;
        pg8::gemm_phase<SH, pg8::EpiResid<false>, true>(F.lds, pg8::Gemm{(const bf16_t*)(ws + WS_HX + 36 * MiB), (const bf16_t*)(ws + WS_WO)}, F.G, bx, pg8::EpiResid<false>{args.in[0], (bf16_t*)(ws + WS_XB), modb + 2 * DM, NMOD, ((DBG_SKIP & 1) ? 0.f : 1.f) / (pg8::ACT8_SCALE * pg8::W8_SCALE)});
    }
    GRID_BAR();
    PEER_BLOCK(0);
    norm_phase(F, args, 1, 1, 0, args.in[4] + DM);
    GRID_BAR();
    {
        using SH = pg8::Shape<512, ML, 256, 256, DM, 4, 0, 256>;
        pg8::gemm_phase<SH>(F.lds, pg8::Gemm{(const bf16_t*)(ws + WS_WC), HX}, F.G, bx, pg8::EpiYt{(unsigned char*)QKb});
    }
    GRID_BAR();
    {
        using SH = pg8::Shape<SEQ / 2, DM, 4096, 4096, 4096, NB, 0, (long)DM * 4096>;
        REP(14, pg8::gemm_phase<SH, pg8::EpiDft2, true>(F.lds, pg8::Gemm{(const bf16_t*)(ws + WS_CS), QKb}, F.G, bx, pg8::EpiDft2{(unsigned char*)VTb}));
        dft_nyquist_rows(F, args);
    }
    GRID_BAR();
    {
        using SH = pg8::Shape<ML, DM, DM / 2, DM / 2, DM / 2, 1, 0, 0>;
        pg8::gemm_phase<SH, pg8::EpiResid<true>, true>(F.lds, pg8::Gemm{VTb, (const bf16_t*)(ws + WS_WF)}, F.G, bx, pg8::EpiResid<true>{ws + WS_XB, (bf16_t*)(ws + WS_XB), modb + (size_t)9 * NMOD + 2 * DM, NMOD, ((DBG_SKIP & 4) ? 0.f : 1.f) / (pg8::ACT8_SCALE * pg8::W8_SCALE)});
    }
    GRID_BAR();
    PEER_BLOCK(1);
    final_norm_phase(F, args);
#undef PEER_BLOCK
}

extern "C" void kernel_launch(void* const* d_in, const int* in_sizes, int n_in, void* d_out, int out_size, void* d_ws, size_t ws_size, hipStream_t stream) {
    static int grid = 0;
    if (grid == 0) {
        if (n_in != 17 || in_sizes[0] != ML * DM || out_size != ML * DM || ws_size < WS_END) { fprintf(stderr, "kernel_launch: unexpected shapes (n_in %d, in0 %d, out %d, ws %zu)\n", n_in, n_in > 0 ? in_sizes[0] : -1, out_size, ws_size); grid = -1; return; }
        int dev = 0, cus = 0, per_cu = 0;
        if (hipGetDevice(&dev) != hipSuccess || hipDeviceGetAttribute(&cus, hipDeviceAttributeMultiprocessorCount, dev) != hipSuccess) { grid = -1; return; }
        if (hipFuncSetAttribute((const void*)fwd_kernel, hipFuncAttributeMaxDynamicSharedMemorySize, LDS_BYTES) != hipSuccess) { fprintf(stderr, "kernel_launch: hipFuncSetAttribute failed\n"); grid = -1; return; }
        if (hipOccupancyMaxActiveBlocksPerMultiprocessor(&per_cu, (const void*)fwd_kernel, NWAVES * 64, LDS_BYTES) != hipSuccess || per_cu < 1)
            fprintf(stderr, "kernel_launch: note: occupancy query reports %d workgroups per CU\n", per_cu);
        (void)hipGetLastError();
        grid = cus;
        if (grid % 8 != 0) { fprintf(stderr, "kernel_launch: CU count %d is not a multiple of 8\n", cus); grid = -1; return; }
    }
    if (grid < 0) return;
    if (hipMemsetAsync((char*)d_ws + WS_CTL, 0, CTL_ZERO_BYTES, stream) != hipSuccess) { fprintf(stderr, "kernel_launch: memset failed\n"); return; }
    Args a{};
    for (int i = 0; i < 17; ++i) a.in[i] = (const float*)d_in[i];
    a.out = (float*)d_out; a.ws = (unsigned char*)d_ws;
    hipLaunchKernelGGL(fwd_kernel, dim3(grid), dim3(NWAVES * 64), LDS_BYTES, stream, a);
    const hipError_t le = hipPeekAtLastError();
    if (le != hipSuccess) fprintf(stderr, "kernel_launch: launch failed: %s\n", hipGetErrorName(le));
}
```

```cpp
#include <hip/hip_runtime.h>
#include <cstdio>
#include <cstdint>

#define LAS __attribute__((address_space(3)))
typedef unsigned short bf16_t;
typedef short bf16x8 __attribute__((ext_vector_type(8)));
typedef short s16x4 __attribute__((ext_vector_type(4)));
typedef float f32x2 __attribute__((ext_vector_type(2)));
typedef float f32x4 __attribute__((ext_vector_type(4)));
typedef float f32x16 __attribute__((ext_vector_type(16)));
typedef unsigned u32x2 __attribute__((ext_vector_type(2)));
typedef unsigned u32x4 __attribute__((ext_vector_type(4)));
typedef __bf16 bf16x2_t __attribute__((ext_vector_type(2)));

#ifndef DBG_SKIP
#define DBG_SKIP 0
#endif
constexpr int DM = 1024, NB = 8, SEQ = 4096, CTXL = 256, GW = 64;
constexpr int ML = NB * SEQ;
constexpr int MC = NB * CTXL;
constexpr int MT = ML + MC;
constexpr int NMOD = 6 * DM;
constexpr int NEXP = 16384;
constexpr float EPS = 1e-6f;
constexpr float LOG2E = 1.4426950408889634f;

constexpr size_t MiB = 1u << 20;
constexpr size_t WS_CTL = 0, CTL_ZERO_BYTES = 1 * MiB;
constexpr size_t WS_MOD = 1 * MiB;
constexpr size_t WS_WQKV = 2 * MiB;
constexpr size_t WS_WO = 8 * MiB;
constexpr size_t WS_WF = 10 * MiB;
constexpr size_t WS_WPQ = 12 * MiB;
constexpr size_t WS_SK = 20 * MiB;
constexpr size_t WS_WC = 20 * MiB + 256 * 1024;
constexpr size_t WS_CS = 22 * MiB;
constexpr size_t WS_TAB = 38 * MiB;
constexpr size_t WS_X8 = 150 * MiB;
constexpr size_t WS_WT = 182 * MiB;
constexpr size_t WS_PART = 282 * MiB;
constexpr float U_SCALE = 64.f;
constexpr float XQ_SCALE = 0.75f;
constexpr float V_SCALE = 2.f;
constexpr size_t WS_XB = 70 * MiB;
constexpr size_t TAB_LAYER = 16 * MiB, TAB_VOFF = 8 * MiB;
constexpr size_t WS_WSC = 198 * MiB;
constexpr size_t WS_HX = 214 * MiB;
constexpr size_t WS_QK = 282 * MiB;
constexpr size_t WS_VT = 418 * MiB;
constexpr size_t WS_IDX = WS_VT;
constexpr size_t WS_GATE = WS_VT + 8 * MiB;
constexpr size_t WS_END = 486 * MiB;
constexpr int CW_BAR = 4096;

__device__ __forceinline__ unsigned f2bf(float f) { unsigned u = __builtin_bit_cast(unsigned, f); return (u + 0x7fffu + ((u >> 16) & 1u)) >> 16; }
__device__ __forceinline__ unsigned pk2(float lo, float hi) { return f2bf(lo) | (f2bf(hi) << 16); }
__device__ __forceinline__ f32x4 bf4_f32(u32x2 w) { return (f32x4){__builtin_bit_cast(float, w.x << 16), __builtin_bit_cast(float, w.x & 0xffff0000u), __builtin_bit_cast(float, w.y << 16), __builtin_bit_cast(float, w.y & 0xffff0000u)}; }
__device__ __forceinline__ unsigned cvtpk(float lo, float hi) { f32x2 v = {lo, hi}; bf16x2_t b = __builtin_convertvector(v, bf16x2_t); return __builtin_bit_cast(unsigned, b); }
__device__ __forceinline__ float bflo(unsigned u) { return __builtin_bit_cast(float, u << 16); }
__device__ __forceinline__ float bfhi(unsigned u) { return __builtin_bit_cast(float, u & 0xffff0000u); }
__device__ __forceinline__ float wave_sum(float v) {
#pragma unroll
    for (int o = 1; o < 64; o <<= 1) v += __shfl_xor(v, o);
    return v;
}
__device__ __forceinline__ unsigned fp8_pack4(float a, float b, float c, float d) {
    int w = 0;
    w = __builtin_amdgcn_cvt_pk_fp8_f32(__builtin_amdgcn_fmed3f(a, -448.f, 448.f), __builtin_amdgcn_fmed3f(b, -448.f, 448.f), w, false);
    w = __builtin_amdgcn_cvt_pk_fp8_f32(__builtin_amdgcn_fmed3f(c, -448.f, 448.f), __builtin_amdgcn_fmed3f(d, -448.f, 448.f), w, true);
    return (unsigned)w;
}
__device__ __forceinline__ int crow(int r, int hi) { return (r & 3) + 8 * (r >> 2) + 4 * hi; }
__device__ __forceinline__ float gelu_erf(float v) {
    const float av = __builtin_fabsf(v), d = av * 0.2316418882f + 1.0f;
    const float t = __builtin_amdgcn_rcpf(d);
    float q = t * 0.5307027145f + (-0.7265760135f); q = q * t + 0.7107068705f; q = q * t + (-0.142248368f); q = q * t + 0.127414796f; q = q * t;
    const float e = __builtin_amdgcn_exp2f((v * v) * (-0.72134752044f));
    const float m = v * (q * e), r = v - m;
    return v < 0.f ? m : r;
}

namespace pg8 {
constexpr float ACT8_SCALE = 16.f, W8_SCALE = 256.f;
constexpr float YT_SCALE = 16.f, CS_SCALE = 512.f;
constexpr int BM = 256, BK = 64, HALF = 128, HTB = HALF * BK * 2, STAGE_BYTES = 8 * HTB, NXCD = 8, WGM = 8;
__host__ __device__ __forceinline__ int lds_byte(int r, int c) { const int st = (r >> 4) * 2 + (c >> 5), rr = r & 15, cc = c & 31, ob = rr * 64 + cc * 2; return st * 1024 + (ob ^ (((ob >> 9) & 1) << 5)); }
__host__ __device__ __forceinline__ void stage_rc(int b, int& R, int& C) { const int st = b / 1024, sb = b % 1024, swz = sb ^ (((sb >> 9) & 1) << 5); R = (st >> 1) * 16 + swz / 64; C = (st & 1) * 32 + (swz % 64) / 2; }
__host__ __device__ __forceinline__ int perm32(int rho) { const int n = rho >> 4, i = rho & 15; return 8 * (i >> 2) + 4 * n + (i & 3); }

struct Unit { int pm, pn, pb; };
struct Gemm { const bf16_t* A; const bf16_t* Bt; };
template <int M_, int N_, int K_, int LDA_, int LDB_, int NBATCH_, long BSA_, long BSB_> struct Shape { static constexpr int M = M_, N = N_, K = K_, lda = LDA_, ldb = LDB_, nbatch = NBATCH_; static constexpr long bsA = BSA_, bsB = BSB_; };

template <class SH> struct StaticOrder {
    static constexpr int nM = SH::M / BM, nN = SH::N / BM, per = nM * nN, nwg = per * SH::nbatch;
    int G, c;
    __device__ __forceinline__ void init(int G_, int c_) { G = G_; c = c_; }
    __device__ __forceinline__ bool next(int i, Unit& u) const {
        const long L = (long)i * G + c; if (L >= nwg) return false;
        int wgid = (int)L; { const int q = nwg / NXCD, r = nwg % NXCD, xcd = wgid % NXCD, off = wgid / NXCD; wgid = (xcd < r ? xcd * (q + 1) : r * (q + 1) + (xcd - r) * q) + off; }
        u.pb = wgid / per; wgid -= u.pb * per;
        const int nig = WGM * nN, gid = wgid / nig, fm = gid * WGM, gsz = (nM - fm) < WGM ? (nM - fm) : WGM;
        u.pm = fm + ((wgid % nig) % gsz); u.pn = (wgid % nig) / gsz; return true;
    }
};

struct EpiStoreBf16 {
    static constexpr bool PERM = true;
    bf16_t* O; long ldc; long bstride; int scols; float scale0; float oscale = 1.0f;
    __device__ __forceinline__ void operator()(const f32x4 (&acc)[2][2][4][2], const Unit& u, int wr, int wc, int fr, int fq) const {
        const int row0 = u.pm * BM + wr * 64 + fr, col0 = u.pn * BM + wc * 32 + 8 * fq;
        bf16_t* base = O + (long)u.pb * bstride;
        const float sc = ((u.pn * BM < scols) ? scale0 : 1.0f) * oscale;
#pragma unroll
        for (int ai = 0; ai < 2; ++ai)
#pragma unroll
            for (int m = 0; m < 4; ++m) { bf16_t* rowp = base + (long)(row0 + ai * HALF + m * 16) * ldc + col0;
#pragma unroll
                for (int bj = 0; bj < 2; ++bj) { const f32x4 v0 = acc[ai][bj][m][0] * sc, v1 = acc[ai][bj][m][1] * sc;
                    u32x4 w; w.x = cvtpk(v0[0], v0[1]); w.y = cvtpk(v0[2], v0[3]); w.z = cvtpk(v1[0], v1[1]); w.w = cvtpk(v1[2], v1[3]);
                    *(u32x4*)(rowp + bj * HALF) = w; } }
    }
};
struct EpiDft2 {
    static constexpr bool PERM = true;
    unsigned char* O;
    __device__ __forceinline__ void operator()(const f32x4 (&acc)[2][2][4][2], const Unit& u, int wr, int wc, int fr, int fq) const {
        const int row0 = u.pm * BM + wr * 64 + fr, cl0 = wc * 32 + 8 * fq;
        unsigned char* base = O + (long)u.pb * SEQ * DM + u.pn * BM;
        constexpr float osc = ACT8_SCALE / (YT_SCALE * CS_SCALE);
#pragma unroll
        for (int ai = 0; ai < 2; ++ai)
#pragma unroll
            for (int m = 0; m < 4; ++m) { const int np = row0 + ai * HALF + m * 16;
                unsigned char* rowp = base + (long)np * DM; unsigned char* mirp = base + (long)(SEQ - np) * DM;
#pragma unroll
                for (int bj = 0; bj < 2; ++bj) { const f32x4 v0 = acc[ai][bj][m][0] * osc, v1 = acc[ai][bj][m][1] * osc; const int cl = cl0 + bj * HALF;
                    u32x2 w; w.x = fp8_pack4(v0[0], v0[1], v0[2], v0[3]); w.y = fp8_pack4(v1[0], v1[1], v1[2], v1[3]);
                    *(u32x2*)(rowp + cl) = w;
                    if (np != 0) {
#pragma unroll
                        for (int i = 0; i < 8; ++i) mirp[(256 - cl - i) & 255] = (unsigned char)((w[i >> 2] >> (8 * (i & 3))) & 0xffu); } }
                asm volatile("" ::: "memory"); }
    }
};
struct EpiYt {
    static constexpr bool PERM = true;
    unsigned char* Yt;
    __device__ __forceinline__ void operator()(const f32x4 (&acc)[2][2][4][2], const Unit& u, int wr, int wc, int fr, int fq) const {
        const int row0 = u.pm * BM + wr * 64 + fr, col0 = u.pn * BM + wc * 32 + 8 * fq;
#pragma unroll
        for (int ai = 0; ai < 2; ++ai)
#pragma unroll
            for (int m = 0; m < 4; ++m) { const int row = row0 + ai * HALF + m * 16; const int part = row >> 8, cp = row & 255;
#pragma unroll
                for (int bj = 0; bj < 2; ++bj) { const int col = col0 + bj * HALF; const int b = col >> 12, n = col & 4095;
                    const f32x4 v0 = acc[ai][bj][m][0] * YT_SCALE, v1 = acc[ai][bj][m][1] * YT_SCALE;
                    u32x2 w; w.x = fp8_pack4(v0[0], v0[1], v0[2], v0[3]); w.y = fp8_pack4(v1[0], v1[1], v1[2], v1[3]);
                    *(u32x2*)(Yt + ((((long)(b * 4 + u.pb) * 256 + cp) * 2 + part) << 12) + n) = w; }
                asm volatile("" ::: "memory"); }
    }
};
template <bool IN_BF16>
struct EpiResid {
    static constexpr bool PERM = false;
    const void* Xin; bf16_t* Xout; const float* gate; int gstride; float gs;
    __device__ __forceinline__ void operator()(const f32x4 (&acc)[2][2][4][2], const Unit& u, int wr, int wc, int fr, int fq) const {
        const int row0 = u.pm * BM + wr * 64 + fr, col0 = u.pn * BM + wc * 32 + 4 * fq;
        const float* gb = gate + (long)((u.pm * BM) >> 12) * gstride;
        f32x4 gv[2][2];
#pragma unroll
        for (int bj = 0; bj < 2; ++bj)
#pragma unroll
            for (int n = 0; n < 2; ++n) gv[bj][n] = *(const f32x4*)(gb + col0 + bj * HALF + n * 16);
#pragma unroll
        for (int ai = 0; ai < 2; ++ai)
#pragma unroll
            for (int m = 0; m < 4; ++m) { const long off = (long)(row0 + ai * HALF + m * 16) * DM + col0;
#pragma unroll
                for (int bj = 0; bj < 2; ++bj)
#pragma unroll
                    for (int n = 0; n < 2; ++n) { const long o_ = off + bj * HALF + n * 16;
                        const f32x4 bs = IN_BF16 ? bf4_f32(*(const u32x2*)((const bf16_t*)Xin + o_)) : *(const f32x4*)((const float*)Xin + o_);
                        const f32x4 r_ = bs + gv[bj][n] * acc[ai][bj][m][n] * gs;
                        *(u32x2*)(Xout + o_) = (u32x2){cvtpk(r_.x, r_.y), cvtpk(r_.z, r_.w)}; }
                if (m & 1) asm volatile("" ::: "memory"); }
    }
};

template <class SH, class Epi, bool FP8 = false>
__device__ __forceinline__ void gemm_phase(LAS unsigned char* lds, const Gemm g, int G_, int c_, const Epi& E) {
    StaticOrder<SH> S; S.init(G_, c_);
    int tid_ = threadIdx.x; asm volatile("" : "+v"(tid_));
    const int tid = tid_, wid = __builtin_amdgcn_readfirstlane(tid >> 6), lane = tid & 63, wr = wid >> 2, wc = wid & 3, fr = lane & 15, fq = lane >> 4;
    constexpr int K = SH::K, nt = K / BK;
    unsigned voffA[2], voffB[2];
#pragma unroll
    for (int i = 0; i < 2; ++i) { int R, C; stage_rc(tid * 16 + i * 8192, R, C); const int Rb = Epi::PERM ? ((R & ~31) + perm32(R & 31)) : R;
        voffA[i] = (unsigned)(R * SH::lda + C) * 2u; voffB[i] = (unsigned)(Rb * SH::ldb + C) * 2u; }
    constexpr size_t kstep = (size_t)(BK * 2);
    constexpr size_t hstepA = (size_t)HALF * SH::lda * 2, hstepB = (size_t)HALF * SH::ldb * 2;
    constexpr size_t tstepA = 2 * hstepA, tstepB = 2 * hstepB;
    const unsigned ldsw = (unsigned)wid * 1024u;
    const int aoff = lds_byte(wr * 64 + fr, fq * 8), boff = lds_byte(wc * 32 + fr, fq * 8);
#define PG8_SA(b, h) (((b) * 2 + (h)) * HTB)
#define PG8_SB(b, h) ((4 + (b) * 2 + (h)) * HTB)
#define PG8_STAGE(bufoff, gbase, voff) do { _Pragma("unroll") for (int _i = 0; _i < 2; ++_i) \
        __builtin_amdgcn_global_load_lds((const unsigned*)((const char*)(gbase) + (voff)[_i]), (LAS unsigned*)(lds + (bufoff) + ldsw + _i * 8192), 16, 0, 0); } while (0)
#define PG8_LDA(dst, b, h) do { _Pragma("unroll") for (int m = 0; m < 4; ++m) { const u32x4 f0_ = *(const LAS u32x4*)(lds + PG8_SA(b, h) + aoff + m * 2048), f1_ = *(const LAS u32x4*)(lds + PG8_SA(b, h) + aoff + m * 2048 + 1024); dst[m] = __builtin_shufflevector(f0_, f1_, 0, 1, 2, 3, 4, 5, 6, 7); } } while (0)
#define PG8_LDB(dst, b, h) do { _Pragma("unroll") for (int n = 0; n < 2; ++n) { const u32x4 f0_ = *(const LAS u32x4*)(lds + PG8_SB(b, h) + boff + n * 2048), f1_ = *(const LAS u32x4*)(lds + PG8_SB(b, h) + boff + n * 2048 + 1024); dst[n] = __builtin_shufflevector(f0_, f1_, 0, 1, 2, 3, 4, 5, 6, 7); } } while (0)
typedef int v8i_t __attribute__((ext_vector_type(8)));
typedef unsigned u32x8 __attribute__((ext_vector_type(8)));
#define PG8_LOH(x) __builtin_bit_cast(bf16x8, __builtin_shufflevector(x, x, 0, 1, 2, 3))
#define PG8_HIH(x) __builtin_bit_cast(bf16x8, __builtin_shufflevector(x, x, 4, 5, 6, 7))
#define PG8_MMA(ai, bj, At, Bt) do { __builtin_amdgcn_s_setprio(1); _Pragma("unroll") for (int m = 0; m < 4; ++m) _Pragma("unroll") for (int n = 0; n < 2; ++n) { \
        if constexpr (FP8) asm volatile("v_mfma_scale_f32_16x16x128_f8f6f4 %0, %1, %2, %0, %3, %3 op_sel_hi:[0,0,0]" : "+v"(acc[ai][bj][m][n]) : "v"(Bt[n]), "v"(At[m]), "v"(fp8_one));   \
        else { acc[ai][bj][m][n] = __builtin_amdgcn_mfma_f32_16x16x32_bf16(PG8_LOH(Bt[n]), PG8_LOH(At[m]), acc[ai][bj][m][n], 0, 0, 0); \
               acc[ai][bj][m][n] = __builtin_amdgcn_mfma_f32_16x16x32_bf16(PG8_HIH(Bt[n]), PG8_HIH(At[m]), acc[ai][bj][m][n], 0, 0, 0); } } \
        __builtin_amdgcn_s_setprio(0); } while (0)
#define PG8_WAIT_V(n) asm volatile("s_waitcnt vmcnt(" #n ")" ::: "memory")
#define PG8_WAIT_L(n) asm volatile("s_waitcnt lgkmcnt(" #n ")" ::: "memory")
#define PG8_BAR __builtin_amdgcn_s_barrier()
#define PG8_SCHED __builtin_amdgcn_sched_barrier(0)
    Unit cur, nxt; int ui = 0;
    if (!S.next(0, cur)) return;
    f32x4 acc[2][2][4][2];
#pragma unroll
    for (int a = 0; a < 2; ++a)
#pragma unroll
        for (int b = 0; b < 2; ++b)
#pragma unroll
            for (int m = 0; m < 4; ++m)
#pragma unroll
                for (int n = 0; n < 2; ++n) acc[a][b][m][n] = (f32x4){0.f, 0.f, 0.f, 0.f};
    unsigned fp8_one = 0x7f7f7f7fu; asm volatile("" : "+v"(fp8_one));
    u32x8 At[4], B0[2], B1[2];
    const char* cA = (const char*)(g.A + (long)cur.pb * SH::bsA) + (size_t)cur.pm * tstepA; const char* cB = (const char*)(g.Bt + (long)cur.pb * SH::bsB) + (size_t)cur.pn * tstepB;
    PG8_STAGE(PG8_SB(0, 0), cB, voffB); PG8_STAGE(PG8_SB(0, 1), cB + hstepB, voffB); PG8_STAGE(PG8_SA(0, 0), cA, voffA); PG8_STAGE(PG8_SA(0, 1), cA + hstepA, voffA);
    if (wr == 1) PG8_BAR;
    PG8_WAIT_V(2); PG8_BAR;
    PG8_STAGE(PG8_SB(1, 0), cB + kstep, voffB); PG8_STAGE(PG8_SA(1, 0), cA + kstep, voffA); PG8_STAGE(PG8_SB(1, 1), cB + hstepB + kstep, voffB);
    PG8_WAIT_V(6); PG8_BAR;
    for (;;) {
        const bool has_next = S.next(ui + 1, nxt);
        const char* nA = has_next ? (const char*)(g.A + (long)nxt.pb * SH::bsA) + (size_t)nxt.pm * tstepA : cA; const char* nB = has_next ? (const char*)(g.Bt + (long)nxt.pb * SH::bsB) + (size_t)nxt.pn * tstepB : cB;
#pragma nounroll
        for (int t = 0; t < nt; t += 2) {
            const bool last = (t == nt - 2);
            const char* a1 = cA + (size_t)(t + 1) * kstep;
            const char* a2 = last ? nA : cA + (size_t)(t + 2) * kstep; const char* b2 = last ? nB : cB + (size_t)(t + 2) * kstep;
            const char* a3 = a2 + kstep; const char* b3 = b2 + kstep;
            PG8_LDB(B0, 0, 0); PG8_LDB(B1, 0, 1); PG8_SCHED; PG8_LDA(At, 0, 0); PG8_STAGE(PG8_SA(1, 1), a1 + hstepA, voffA);
            PG8_WAIT_V(8); PG8_WAIT_L(0); PG8_BAR; PG8_MMA(0, 0, At, B0); PG8_MMA(0, 1, At, B1); PG8_BAR; PG8_SCHED;
            PG8_LDA(At, 0, 1); PG8_STAGE(PG8_SB(0, 0), b2, voffB); PG8_STAGE(PG8_SB(0, 1), b2 + hstepB, voffB); PG8_STAGE(PG8_SA(0, 0), a2, voffA);
            PG8_WAIT_V(8); PG8_WAIT_L(0); PG8_BAR; PG8_MMA(1, 0, At, B0); PG8_MMA(1, 1, At, B1); PG8_BAR; PG8_SCHED;
            PG8_LDB(B0, 1, 0); PG8_LDB(B1, 1, 1); PG8_SCHED; PG8_LDA(At, 1, 0); PG8_STAGE(PG8_SA(0, 1), a2 + hstepA, voffA);
            PG8_WAIT_V(8); PG8_WAIT_L(0); PG8_BAR; PG8_MMA(0, 0, At, B0); PG8_MMA(0, 1, At, B1); PG8_BAR; PG8_SCHED;
            PG8_LDA(At, 1, 1); PG8_STAGE(PG8_SB(1, 0), b3, voffB); PG8_STAGE(PG8_SB(1, 1), b3 + hstepB, voffB); PG8_STAGE(PG8_SA(1, 0), a3, voffA);
            PG8_WAIT_V(8); PG8_WAIT_L(0); PG8_BAR; PG8_MMA(1, 0, At, B0); PG8_MMA(1, 1, At, B1); PG8_BAR; PG8_SCHED;
        }
        if (wr == 0) PG8_BAR;
        if constexpr (FP8) asm volatile("s_nop 15\n\ts_nop 15\n\ts_nop 7" ::: "memory");
        E(acc, cur, wr, wc, fr, fq);
        if (!has_next) break;
#pragma unroll
        for (int a = 0; a < 2; ++a)
#pragma unroll
            for (int b = 0; b < 2; ++b)
#pragma unroll
                for (int m = 0; m < 4; ++m)
#pragma unroll
                    for (int n = 0; n < 2; ++n) acc[a][b][m][n] = (f32x4){0.f, 0.f, 0.f, 0.f};
        cur = nxt; cA = nA; cB = nB; ++ui;
        if (wr == 1) PG8_BAR;
    }
    PG8_WAIT_V(0);
    PG8_BAR;
#undef PG8_SA
#undef PG8_SB
#undef PG8_STAGE
#undef PG8_LDA
#undef PG8_LDB
#undef PG8_MMA
#undef PG8_WAIT_V
#undef PG8_WAIT_L
#undef PG8_BAR
#undef PG8_SCHED
}
}

#define XB_TMO      128
#define XB_XCNT(j)  (256  + 64 * (j))
#define XB_XSUB(j)  (1280 + 64 * (j))
#define XB_XGEN(j)  (2304 + 64 * (j))
#define XB_TOP      3328
#define XB_TOPGEN   3392
#define XCD_BAR_WORDS 3456
#define XB_SPIN_CAP (1u << 18)
__device__ __forceinline__ unsigned xb_ld(unsigned* p)              { return __hip_atomic_load(p, __ATOMIC_RELAXED, __HIP_MEMORY_SCOPE_AGENT); }
__device__ __forceinline__ unsigned xb_add(unsigned* p, unsigned v) { return __hip_atomic_fetch_add(p, v, __ATOMIC_RELAXED, __HIP_MEMORY_SCOPE_AGENT); }
__device__ __forceinline__ unsigned xb_xcc_id() { return (unsigned)__builtin_amdgcn_s_getreg((3 << 11) | 20) & 0xFu; }
#define XB_SPIN(cond, bar) do { unsigned _sp = 0; while (cond) { __builtin_amdgcn_s_sleep(1); \
    if ((++_sp & 255u) == 0u) { if (xb_ld(&(bar)[XB_TMO])) break; if (_sp > XB_SPIN_CAP) { atomicAdd(&(bar)[XB_TMO], 1u); break; } } } } while (0)
struct XcdBarrier { unsigned* bar; unsigned x; volatile LAS unsigned* st; };
__device__ __forceinline__ XcdBarrier xcd_barrier_post(unsigned* bar, volatile LAS unsigned* st) {
    XcdBarrier b; b.bar = bar; b.x = xb_xcc_id(); b.st = st;
    if (threadIdx.x == 0) (void)xb_add(&bar[XB_XCNT(b.x)], 1u);
    return b;
}
__device__ __forceinline__ void xcd_barrier_complete(unsigned* bar, unsigned x, unsigned& nloc, unsigned& nx) {
    const unsigned G = gridDim.x * gridDim.y * gridDim.z;
    unsigned sum, cnt, mine, sp = 0u;
    for (;;) {
        sum = 0u; cnt = 0u; mine = 0u;
#pragma unroll
        for (unsigned j = 0; j < 16; ++j) { const unsigned c = xb_ld(&bar[XB_XCNT(j)]); sum += c; cnt += (c > 0u) ? 1u : 0u; mine = (j == x) ? c : mine; }
        if (sum == G) break;
        __builtin_amdgcn_s_sleep(1);
        if ((++sp & 255u) == 0u) { if (xb_ld(&bar[XB_TMO])) break; if (sp > XB_SPIN_CAP) { atomicAdd(&bar[XB_TMO], 1u); break; } }
    }
    nloc = mine > 0u ? mine : 1u; nx = cnt > 0u ? cnt : 1u;
}
__device__ __forceinline__ void xcd_barrier(const XcdBarrier& b) {
    asm volatile("s_waitcnt vmcnt(0)" ::: "memory");
    __syncthreads();
    if (threadIdx.x == 0) {
        unsigned* bar = b.bar;
        __builtin_amdgcn_s_waitcnt(0);
        unsigned nloc = b.st[0], nx = b.st[1];
        if (nloc == 0u) { xcd_barrier_complete(bar, b.x, nloc, nx); b.st[0] = nloc; b.st[1] = nx; }
        const unsigned old = xb_add(&bar[XB_XSUB(b.x)], 1u);
        const unsigned gen = old / nloc;
        if (old + 1u == (gen + 1u) * nloc) {
            __builtin_amdgcn_fence(__ATOMIC_RELEASE, "agent");
            asm volatile("s_waitcnt vmcnt(0)" ::: "memory");
            const unsigned og = xb_add(&bar[XB_TOP], 1u);
            const unsigned tg = og / nx;
            if (og + 1u == (tg + 1u) * nx) xb_add(&bar[XB_TOPGEN], 1u);
            else XB_SPIN(xb_ld(&bar[XB_TOPGEN]) == tg, bar);
            __builtin_amdgcn_fence(__ATOMIC_ACQUIRE, "agent");
            xb_add(&bar[XB_XGEN(b.x)], 1u);
            asm volatile("s_waitcnt vmcnt(0)" ::: "memory");
        } else {
            XB_SPIN(xb_ld(&bar[XB_XGEN(b.x)]) == gen, bar);
            __builtin_amdgcn_fence(__ATOMIC_ACQUIRE, "agent");
            asm volatile("s_waitcnt vmcnt(0)" ::: "memory");
        }
    }
    __syncthreads();
}

constexpr int RING_BYTES = 131072;
constexpr int LDSCTL_OFF = RING_BYTES, MISC_OFF = LDSCTL_OFF + 320;
constexpr int LDS_BYTES = 147456;
constexpr int NWAVES = 8;

struct Args { const float* in[17]; float* out; unsigned char* ws; };

struct Ctx {
    LAS unsigned char* lds;
    int tid, lane, wave, vcu, G;
};

__device__ __forceinline__ Ctx fresh(const Ctx& F) {
    Ctx C = F; int t = threadIdx.x; asm volatile("" : "+v"(t)); C.tid = t; C.lane = t & 63; return C;
}
__device__ __forceinline__ void p0_transpose_item(const float* W, int K, int N, bf16_t* WT, LAS float* scr, int item, int lane) {
    const int nblk = N / 32, kb = item / nblk, nb = item % nblk, k0 = 64 * kb, n0 = 32 * nb;
#pragma unroll 8
    for (int i = 0; i < 32; ++i) { const int kk = 2 * i + (lane >> 5); scr[kk * 33 + (lane & 31)] = W[(size_t)(k0 + kk) * N + n0 + (lane & 31)]; }
    asm volatile("s_waitcnt lgkmcnt(0)" ::: "memory");
    const int c = lane & 7;
#pragma unroll
    for (int j = 0; j < 4; ++j) { const int n = (lane >> 3) + 8 * j; const LAS float* s = scr + (8 * c) * 33 + n;
        u32x4 o; o.x = pk2(s[0 * 33], s[1 * 33]); o.y = pk2(s[2 * 33], s[3 * 33]); o.z = pk2(s[4 * 33], s[5 * 33]); o.w = pk2(s[6 * 33], s[7 * 33]);
        *(u32x4*)(WT + (size_t)(n0 + n) * K + k0 + 8 * c) = o; }
    asm volatile("s_waitcnt lgkmcnt(0)" ::: "memory");
}
__device__ __forceinline__ void p0_transpose_item8(const float* W, int K, int N, unsigned char* WT, LAS float* scr, int item, int lane) {
    const int nblk = N / 32, kb = item / nblk, nb = item % nblk, k0 = 64 * kb, n0 = 32 * nb;
#pragma unroll 8
    for (int i = 0; i < 32; ++i) { const int kk = 2 * i + (lane >> 5); scr[kk * 33 + (lane & 31)] = W[(size_t)(k0 + kk) * N + n0 + (lane & 31)]; }
    asm volatile("s_waitcnt lgkmcnt(0)" ::: "memory");
    const int c = lane & 7;
#pragma unroll
    for (int j = 0; j < 4; ++j) { const int n = (lane >> 3) + 8 * j; const LAS float* s = scr + (8 * c) * 33 + n; constexpr float sc = pg8::W8_SCALE;
        u32x2 o; o.x = fp8_pack4(s[0 * 33] * sc, s[1 * 33] * sc, s[2 * 33] * sc, s[3 * 33] * sc); o.y = fp8_pack4(s[4 * 33] * sc, s[5 * 33] * sc, s[6 * 33] * sc, s[7 * 33] * sc);
        *(u32x2*)(WT + (size_t)(n0 + n) * K + k0 + 8 * c) = o; }
    asm volatile("s_waitcnt lgkmcnt(0)" ::: "memory");
}
__device__ __forceinline__ void cvt8(const float* src, bf16_t* dst) {
    const f32x4 a = *(const f32x4*)src, b = *(const f32x4*)(src + 4);
    u32x4 o; o.x = pk2(a[0], a[1]); o.y = pk2(a[2], a[3]); o.z = pk2(b[0], b[1]); o.w = pk2(b[2], b[3]);
    *(u32x4*)dst = o;
}

__device__ __forceinline__ void p0_prologue(const Ctx& F0, const Args& a) {
    const Ctx F = fresh(F0);
    unsigned char* ws = a.ws;
    const int gw = F.vcu * NWAVES + F.wave, NGW = F.G * NWAVES;
    const long gt = (long)F.vcu * 512 + F.tid, NGT = (long)F.G * 512;
    {
        LAS float* red = (LAS float*)(F.lds);
        const float* c = a.in[1]; const float* cctx = a.in[3]; const float* wmod = a.in[6]; const float* bmod = a.in[7];
        float* modb = (float*)(ws + WS_MOD);
        for (int item = F.vcu; item < 96; item += F.G) {
            const int l = item / 48, nc = item % 48, n0 = nc * 128 + 2 * F.lane, kb = F.wave * 128;
            float sv[9][2];
#pragma unroll
            for (int r = 0; r < 9; ++r)
#pragma unroll
                for (int j = 0; j < 2; ++j) { const int k = kb + 64 * j + F.lane; const float v = (r < 8) ? c[r * DM + k] : cctx[k]; sv[r][j] = v / (1.0f + __expf(-v)); }
            float acc[9][2];
#pragma unroll
            for (int r = 0; r < 9; ++r) { acc[r][0] = 0.f; acc[r][1] = 0.f; }
            const float* wp = wmod + (size_t)l * DM * NMOD + (size_t)kb * NMOD + n0;
#pragma unroll
            for (int j = 0; j < 2; ++j)
#pragma unroll 8
                for (int kl = 0; kl < 64; ++kl) {
                    const f32x2 w = *(const f32x2*)(wp + (size_t)(64 * j + kl) * NMOD);
#pragma unroll
                    for (int r = 0; r < 9; ++r) { const float s = __builtin_bit_cast(float, __builtin_amdgcn_readlane(__builtin_bit_cast(int, sv[r][j]), kl)); acc[r][0] += s * w[0]; acc[r][1] += s * w[1]; }
                }
            __syncthreads();
#pragma unroll
            for (int r = 0; r < 9; ++r) { red[(F.wave * 9 + r) * 128 + 2 * F.lane] = acc[r][0]; red[(F.wave * 9 + r) * 128 + 2 * F.lane + 1] = acc[r][1]; }
            __syncthreads();
            for (int o = F.tid; o < 9 * 128; o += 512) { const int r = o >> 7, nl = o & 127; float s = 0.f;
#pragma unroll
                for (int w = 0; w < 8; ++w) s += red[(w * 9 + r) * 128 + nl];
                modb[(size_t)(l * 9 + r) * NMOD + nc * 128 + nl] = s + bmod[l * NMOD + nc * 128 + nl]; }
        }
        __syncthreads();
    }
    {
        LAS float* scr = (LAS float*)(F.lds + F.wave * 16384);
        constexpr int I_QKV = (DM / 64) * (3 * DM / 32), I_O = (DM / 64) * (DM / 32), I_PQ = (DM / 64) * (2 * DM / 32);
        constexpr int NITEMS = I_QKV + 2 * I_O + 2 * I_PQ;
        for (int it = gw; it < NITEMS; it += NGW) {
            int r = it;
            if (r < I_QKV) { p0_transpose_item8(a.in[8], DM, 3 * DM, ws + WS_WQKV, scr, r, F.lane); continue; } r -= I_QKV;
            if (r < I_O) { p0_transpose_item8(a.in[9], DM, DM, ws + WS_WO, scr, r, F.lane); continue; } r -= I_O;
            if (r < I_O) { p0_transpose_item8(a.in[11], DM, DM, ws + WS_WF, scr, r, F.lane); continue; } r -= I_O;
            if (r < I_PQ) { p0_transpose_item8(a.in[12], DM, 2 * DM, ws + WS_WPQ, scr, r, F.lane); continue; } r -= I_PQ;
            p0_transpose_item8(a.in[12] + (size_t)DM * 2 * DM, DM, 2 * DM, ws + WS_WPQ + (size_t)2 * DM * DM, scr, r, F.lane);
        }
    }
    for (long i = gt; i < 2 * 2 * 128 * 128 / 8; i += NGT) cvt8(a.in[13] + i * 8, (bf16_t*)(ws + WS_SK) + i * 8);
    {
        bf16_t* wc = (bf16_t*)(ws + WS_WC);
        for (long i = gt; i < 512 * 256 / 8; i += NGT) { const int nn = (int)(i >> 5), k0 = (int)(i & 31) * 8; float v[8];
#pragma unroll
            for (int j = 0; j < 8; ++j) { const int m = ((k0 + j) * (nn & 255)) & 255; const float fr = (float)m * (1.0f / 256.0f);
                v[j] = (nn < 256 ? __builtin_amdgcn_cosf(fr) : __builtin_amdgcn_sinf(fr)) * (1.0f / 16.0f); }
            u32x4 o; o.x = pk2(v[0], v[1]); o.y = pk2(v[2], v[3]); o.z = pk2(v[4], v[5]); o.w = pk2(v[6], v[7]);
            *(u32x4*)(wc + i * 8) = o; }
        unsigned char* cs = ws + WS_CS;
        for (long i = gt; i < 2048L * 8192 / 8; i += NGT) { const int np = (int)(i >> 10), c0 = (int)(i & 1023) * 8; const int part = c0 >> 12; float v[8];
#pragma unroll
            for (int j = 0; j < 8; ++j) { const int n = (c0 + j) & 4095; const int m = (n * np) & 4095; const float fr = (float)m * (1.0f / 4096.0f);
                v[j] = (part == 0 ? __builtin_amdgcn_cosf(fr) : -__builtin_amdgcn_sinf(fr)) * (pg8::CS_SCALE / 64.0f); }
            u32x2 o; o.x = fp8_pack4(v[0], v[1], v[2], v[3]); o.y = fp8_pack4(v[4], v[5], v[6], v[7]);
            *(u32x2*)(cs + i * 8) = o; }
    }
}

__device__ __forceinline__ unsigned fp4_pack8(const float* v, float sc) {
    unsigned w = 0;
#define FP4C(i) fminf(fmaxf(v[i] * sc, -6.f), 6.f)
    w = __builtin_amdgcn_cvt_scalef32_pk_fp4_f32(w, FP4C(0), FP4C(1), 1.0f, 0);
    w = __builtin_amdgcn_cvt_scalef32_pk_fp4_f32(w, FP4C(2), FP4C(3), 1.0f, 1);
    w = __builtin_amdgcn_cvt_scalef32_pk_fp4_f32(w, FP4C(4), FP4C(5), 1.0f, 2);
    w = __builtin_amdgcn_cvt_scalef32_pk_fp4_f32(w, FP4C(6), FP4C(7), 1.0f, 3);
#undef FP4C
    return w;
}
#define FP4_DEC(w, bs) __builtin_amdgcn_cvt_scalef32_pk_f32_fp4((w), 1.0f, (bs))
__device__ __forceinline__ unsigned i8_pack4(f32x4 v, float sc) {
    const int a = (int)rintf(fminf(fmaxf(v[0] * sc, -127.f), 127.f)), b = (int)rintf(fminf(fmaxf(v[1] * sc, -127.f), 127.f));
    const int c = (int)rintf(fminf(fmaxf(v[2] * sc, -127.f), 127.f)), d = (int)rintf(fminf(fmaxf(v[3] * sc, -127.f), 127.f));
    return (unsigned)(a & 0xff) | ((unsigned)(b & 0xff) << 8) | ((unsigned)(c & 0xff) << 16) | ((unsigned)(d & 0xff) << 24);
}
__device__ __forceinline__ void table_convert(const Ctx& F0, const Args& a, int sh0, int nsh, int nshare) {
    const Ctx F = fresh(F0);
    constexpr long PER = (long)NEXP * DM / 16;
    constexpr long TOTAL = 4 * PER;
    unsigned char* t8 = a.ws + WS_TAB;
    const long per_share = (TOTAL + nshare - 1) / nshare;
    const long i0 = (long)sh0 * per_share, i1 = min((long)(sh0 + nsh) * per_share, TOTAL);
    for (long i = i0 + F.tid; i < i1; i += 512) {
        const int q = (int)(i / PER); const long r = i - (long)q * PER; const int l = q >> 1, tb = q & 1;
        const int e = (int)(r >> 6), c16 = (int)(r & 63);
        const float* src = (tb ? a.in[15] : a.in[14]) + ((size_t)l * NEXP + e) * DM + c16 * 16;
        if (tb) {
            u32x2 o;
#pragma unroll
            for (int d = 0; d < 2; ++d) { const f32x4 va = *(const f32x4*)(src + 8 * d), vb = *(const f32x4*)(src + 8 * d + 4);
                const float v8[8] = {va[0], va[1], va[2], va[3], vb[0], vb[1], vb[2], vb[3]};
                o[d] = fp4_pack8(v8, V_SCALE); }
            *(u32x2*)(t8 + (size_t)l * TAB_LAYER + TAB_VOFF + ((size_t)(c16 >> 4) * NEXP + e) * 128 + (c16 & 15) * 8) = o;
        } else {
            u32x2 o;
#pragma unroll
            for (int d = 0; d < 2; ++d) { const f32x4 va = *(const f32x4*)(src + 8 * d), vb = *(const f32x4*)(src + 8 * d + 4);
                const float v8[8] = {va[0], va[1], va[2], va[3], vb[0], vb[1], vb[2], vb[3]};
                o[d] = fp4_pack8(v8, U_SCALE); }
            *(u32x2*)(t8 + (size_t)l * TAB_LAYER + ((size_t)(c16 >> 4) * NEXP + e) * 128 + (c16 & 15) * 8) = o;
        }
    }
}

__device__ __forceinline__ const float* norm_src(const Args& a, int mode, int m) { return (m < ML) ? ((mode == 0 ? a.in[0] : a.out) + (size_t)m * DM) : (a.in[2] + (size_t)(m - ML) * DM); }
__device__ __forceinline__ void norm_phase(const Ctx& F0, const Args& a, int mode, int layer, int off, const float* gw) {
    const Ctx F = fresh(F0);
    const int gwv = F.vcu * NWAVES + F.wave, NGW = F.G * NWAVES, lane = F.lane;
    const float* modb = (const float*)(a.ws + WS_MOD) + (size_t)layer * 9 * NMOD;
    bf16_t* hx = (bf16_t*)(a.ws + WS_HX);
    const int nrows = (mode == 0) ? MT : ML;
    f32x4 gv[4];
#pragma unroll
    for (int j = 0; j < 4; ++j) gv[j] = ((const f32x4*)gw)[lane + 64 * j];
    const u32x2* XBr = (const u32x2*)(a.ws + WS_XB);
    f32x4 v[4], vn[4]; u32x2 vr[4];
    if (gwv < nrows) {
        if (mode == 0) { const f32x4* xr = (const f32x4*)norm_src(a, mode, gwv) + lane;
#pragma unroll
            for (int j = 0; j < 4; ++j) vn[j] = xr[64 * j]; }
        else {
#pragma unroll
            for (int j = 0; j < 4; ++j) vr[j] = XBr[(size_t)gwv * 256 + lane + 64 * j]; } }
    for (int m = gwv; m < nrows; m += NGW) {
        const int mn = (m + NGW < nrows) ? m + NGW : m;
        if (mode == 0) {
#pragma unroll
            for (int j = 0; j < 4; ++j) v[j] = vn[j];
            const f32x4* xr = (const f32x4*)norm_src(a, mode, mn) + lane;
#pragma unroll
            for (int j = 0; j < 4; ++j) vn[j] = xr[64 * j];
        } else {
#pragma unroll
            for (int j = 0; j < 4; ++j) v[j] = bf4_f32(vr[j]);
#pragma unroll
            for (int j = 0; j < 4; ++j) vr[j] = XBr[(size_t)mn * 256 + lane + 64 * j];
        }
        const float* mr = modb + (size_t)((m < ML) ? (m >> 12) : 8) * NMOD + off;
        f32x4 av[4], cv[4];
#pragma unroll
        for (int j = 0; j < 4; ++j) { av[j] = ((const f32x4*)mr)[lane + 64 * j]; cv[j] = ((const f32x4*)(mr + DM))[lane + 64 * j]; }
        float s = 0.f;
#pragma unroll
        for (int j = 0; j < 4; ++j) s += (v[j].x * v[j].x + v[j].y * v[j].y) + (v[j].z * v[j].z + v[j].w * v[j].w);
        const float rstd = 1.0f / sqrtf(wave_sum(s) * (1.0f / DM) + EPS);
        unsigned long long* o8 = (unsigned long long*)(hx + (size_t)m * DM) + lane;
        unsigned* o4 = (unsigned*)(a.ws + WS_HX + (size_t)m * DM) + lane;
#pragma unroll
        for (int j = 0; j < 4; ++j) { const f32x4 y = (v[j] * rstd * gv[j]) * (cv[j] + 1.0f) + av[j];
            if (mode == 0 || off == 3 * DM) o4[64 * j] = fp8_pack4(y.x * pg8::ACT8_SCALE, y.y * pg8::ACT8_SCALE, y.z * pg8::ACT8_SCALE, y.w * pg8::ACT8_SCALE);
            if (mode == 0) continue;
            if (off != 3 * DM)
            o8[64 * j] = (unsigned long long)cvtpk(y.x, y.y) | ((unsigned long long)cvtpk(y.z, y.w) << 32);
            if (off == 3 * DM) {
                const float q0 = fminf(fmaxf(y.x * XQ_SCALE, -6.f), 6.f), q1 = fminf(fmaxf(y.y * XQ_SCALE, -6.f), 6.f), q2 = fminf(fmaxf(y.z * XQ_SCALE, -6.f), 6.f), q3 = fminf(fmaxf(y.w * XQ_SCALE, -6.f), 6.f);
                unsigned ph = __builtin_amdgcn_cvt_scalef32_pk_fp4_f32(0u, q0, q1, 1.0f, 0); ph = __builtin_amdgcn_cvt_scalef32_pk_fp4_f32(ph, q2, q3, 1.0f, 1);
                const f32x2 d0 = FP4_DEC(ph, 0), d1 = FP4_DEC(ph, 1);
                unsigned pl = __builtin_amdgcn_cvt_scalef32_pk_fp4_f32(0u, 4.f * (q0 - d0.x), 4.f * (q1 - d0.y), 1.0f, 0); pl = __builtin_amdgcn_cvt_scalef32_pk_fp4_f32(pl, 4.f * (q2 - d1.x), 4.f * (q3 - d1.y), 1.0f, 1);
                unsigned short* xq = (unsigned short*)(a.ws + WS_X8 + ((size_t)j * ML + m) * 256) + lane;
                xq[0] = (unsigned short)(ph & 0xffffu); xq[64] = (unsigned short)(pl & 0xffffu); } }
    }
}
__device__ __forceinline__ void final_norm_phase(const Ctx& F0, const Args& a) {
    const Ctx F = fresh(F0);
    const int gwv = F.vcu * NWAVES + F.wave, NGW = F.G * NWAVES;
    const float* gw = a.in[16];
    const u32x2* XBr = (const u32x2*)(a.ws + WS_XB);
    f32x4 gv[4]; u32x2 vr[4];
#pragma unroll
    for (int j = 0; j < 4; ++j) gv[j] = ((const f32x4*)gw)[F.lane + 64 * j];
    if (gwv < ML) {
#pragma unroll
        for (int j = 0; j < 4; ++j) vr[j] = XBr[(size_t)gwv * 256 + F.lane + 64 * j]; }
    for (int m = gwv; m < ML; m += NGW) {
        f32x4* xr = (f32x4*)(a.out + (size_t)m * DM) + F.lane;
        f32x4 v[4]; float s = 0.f;
#pragma unroll
        for (int j = 0; j < 4; ++j) { v[j] = bf4_f32(vr[j]); s += (v[j].x * v[j].x + v[j].y * v[j].y) + (v[j].z * v[j].z + v[j].w * v[j].w); }
        { const int mn = (m + NGW < ML) ? m + NGW : m;
#pragma unroll
          for (int j = 0; j < 4; ++j) vr[j] = XBr[(size_t)mn * 256 + F.lane + 64 * j]; }
        const float rstd = 1.0f / sqrtf(wave_sum(s) * (1.0f / DM) + EPS);
#pragma unroll
        for (int j = 0; j < 4; ++j) xr[64 * j] = v[j] * rstd * gv[j];
    }
}

constexpr int ATT_ROWB = 144, ATT_KTILEB = 128 * ATT_ROWB, ATT_VROWB = 272, ATT_VTILEB = 64 * ATT_VROWB, ATT_BIAS_B = 2048, ATT_K0 = ATT_BIAS_B, ATT_V0 = ATT_K0 + 2 * ATT_KTILEB;
constexpr float ATT_THR = 8.0f;
template <int NGH, bool LATENT>
__device__ __forceinline__ void attn_sub(const LAS unsigned char* Kt, const LAS unsigned char* Vt_, int ko, const LAS float* browA, const LAS float* browB, const int (&relidx)[8],
                                         const bf16x8 (&qf)[2], float& m_ref, float& l_run, f32x4 (&o)[4], int q16, int g4) {
    constexpr int NG = 2 * NGH;
    bf16x8 kf[2 * NG][2]; u32x2 vf[4][NG][2]; f32x4 sc[2 * NG];
#pragma unroll
    for (int gk = 0; gk < NG; ++gk)
#pragma unroll
        for (int b2 = 0; b2 < 2; ++b2)
#pragma unroll
            for (int ks = 0; ks < 2; ++ks) kf[2 * gk + b2][ks] = *(const LAS bf16x8*)(Kt + ((gk / NGH) * 64 + ko + 32 * (gk % NGH) + 16 * b2 + q16) * ATT_ROWB + 64 * ks + 16 * g4);
#pragma unroll
    for (int d = 0; d < 4; ++d)
#pragma unroll
        for (int gk = 0; gk < NG; ++gk) { const LAS unsigned char* vp = Vt_ + (16 * d + q16) * ATT_VROWB + 2 * ((gk / NGH) * 64 + ko + 32 * (gk % NGH) + 4 * g4);
            vf[d][gk][0] = *(const LAS u32x2*)vp; vf[d][gk][1] = *(const LAS u32x2*)(vp + 32); }
    if (LATENT) {
#pragma unroll
        for (int kk = 0; kk < 8; ++kk) { sc[kk >> 2][kk & 3] = browA[relidx[kk]] - m_ref; sc[2 + (kk >> 2)][kk & 3] = browB[relidx[kk]] - m_ref; }
    } else {
#pragma unroll
        for (int blk = 0; blk < 2 * NG; ++blk) sc[blk] = (f32x4){-m_ref, -m_ref, -m_ref, -m_ref};
    }
#pragma unroll
    for (int blk = 0; blk < 2 * NG; ++blk)
#pragma unroll
        for (int ks = 0; ks < 2; ++ks) sc[blk] = __builtin_amdgcn_mfma_f32_16x16x32_bf16(kf[blk][ks], qf[ks], sc[blk], 0, 0, 0);
    float mx = fmaxf(fmaxf(sc[0][0], sc[0][1]), fmaxf(sc[0][2], sc[0][3]));
#pragma unroll
    for (int blk = 1; blk < 2 * NG; ++blk) mx = fmaxf(mx, fmaxf(fmaxf(sc[blk][0], sc[blk][1]), fmaxf(sc[blk][2], sc[blk][3])));
    if (__builtin_amdgcn_ballot_w64(mx > ATT_THR) != 0ull) {
        mx = fmaxf(mx, __shfl_xor(mx, 16)); mx = fmaxf(mx, __shfl_xor(mx, 32));
        const float dl = mx > ATT_THR ? mx : 0.f;
        m_ref += dl;
        const float al = __builtin_amdgcn_exp2f(-dl);
        l_run *= al;
#pragma unroll
        for (int d = 0; d < 4; ++d) o[d] *= al;
#pragma unroll
        for (int blk = 0; blk < 2 * NG; ++blk) sc[blk] -= dl;
    }
    float ls0 = 0.f, ls1 = 0.f;
#pragma unroll
    for (int blk = 0; blk < 2 * NG; ++blk)
#pragma unroll
        for (int i = 0; i < 4; ++i) { const float e = __builtin_amdgcn_exp2f(sc[blk][i]); sc[blk][i] = e; if (blk & 1) ls1 += e; else ls0 += e; }
    l_run += ls0 + ls1;
    bf16x8 pf[NG];
#pragma unroll
    for (int gk = 0; gk < NG; ++gk) { u32x4 pw; pw.x = cvtpk(sc[2 * gk][0], sc[2 * gk][1]); pw.y = cvtpk(sc[2 * gk][2], sc[2 * gk][3]); pw.z = cvtpk(sc[2 * gk + 1][0], sc[2 * gk + 1][1]); pw.w = cvtpk(sc[2 * gk + 1][2], sc[2 * gk + 1][3]);
        pf[gk] = __builtin_bit_cast(bf16x8, pw); }
#pragma unroll
    for (int gk = 0; gk < NG; ++gk)
#pragma unroll
        for (int d = 0; d < 4; ++d) { u32x4 vw; vw.x = vf[d][gk][0].x; vw.y = vf[d][gk][0].y; vw.z = vf[d][gk][1].x; vw.w = vf[d][gk][1].y;
            o[d] = __builtin_amdgcn_mfma_f32_16x16x32_bf16(__builtin_bit_cast(bf16x8, vw), pf[gk], o[d], 0, 0, 0); }
}
__device__ __forceinline__ void attn_phase(const Ctx& F0, const Args& a) {
    const Ctx F = fresh(F0);
    const bf16_t* QK = (const bf16_t*)(a.ws + WS_QK);
    const bf16_t* VT = (const bf16_t*)(a.ws + WS_VT);
    unsigned char* AO = a.ws + WS_HX + 36 * MiB;
    const float* rpb = a.in[10];
    LAS float* bias = (LAS float*)F.lds;
    const int tid = F.tid, lane = F.lane, q16 = lane & 15, g4 = lane >> 4;
    const int rr = F.wave >> 2, jt = F.wave & 3;
    const int qc = 16 * jt + q16, cs = min(max(qc - 8, 0), 48), ksj = min(max(16 * jt - 8, 0), 32);
    int relidx[8];
#pragma unroll
    for (int k = 0; k < 8; ++k) { const int kc = ksj + 16 * (k >> 2) + 4 * g4 + (k & 3); relidx[k] = (kc >= cs && kc < cs + 16) ? (kc - qc + 15) : 31; }
    const int krow = tid >> 3, kch = tid & 7, vrow = tid >> 4, vch = tid & 15;
    const unsigned lds_k = (unsigned)(krow * ATT_ROWB + kch * 16), lds_v = (unsigned)(vrow * ATT_VROWB + vch * 16);
    const int nunits = NB * 16 * 32, upb = (nunits + F.G - 1) / F.G;
    int cur_bh = -1;
    for (int k = 0; k < upb; ++k) {
        const int id = F.vcu * upb + k; if (id >= nunits) break;
        const int p = id & 31, bh = id >> 5, b = bh >> 4, h = bh & 15;
        if (bh != cur_bh) {
            __syncthreads();
            for (int i = tid; i < 16 * 32; i += 512) { const int dr = i >> 5, dc = i & 31; bias[i] = (dc < 31 && dr < 15) ? rpb[(h * 15 + dr) * 31 + dc] * LOG2E : -1e30f; }
            cur_bh = bh;
        }
        const int r0 = 2 * p, rs0 = min(max(r0 - 4, 0), 56), rs1 = min(max(r0 + 1 - 4, 0), 56);
        const int nlat = rs1 + 8 - rs0, nlt = (nlat + 1) >> 1, nsteps = nlt + 2;
        const int r = r0 + rr, rs = rr ? rs1 : rs0;
        const long tokq = (long)b * SEQ + r * GW + qc;
        const bf16_t* kbase = QK + 1024 + h * 64 + kch * 8;
        const bf16_t* vbase = VT + (long)(h * 64 + vrow) * MT + (vch & 7) * 8;
#define ATT_TOKA(step) ((step) < nlt ? ((long)b * SEQ + (long)(rs0 + 2 * (step)) * GW) : ((long)ML + b * CTXL + ((step) - nlt) * 128))
#define ATT_TOKB(step) ((step) < nlt ? ((long)b * SEQ + (long)min(rs0 + 2 * (step) + 1, rs0 + nlat - 1) * GW) : ((long)ML + b * CTXL + ((step) - nlt) * 128 + 64))
        u32x4 kA[2], vA[2], kB[2], vB[2];
#define ATT_LOAD(step, kr_, vr_) do { const int st_ = (step) < nsteps ? (step) : nsteps - 1; const long ta_ = ATT_TOKA(st_), tb_ = ATT_TOKB(st_);     \
        kr_[0] = *(const u32x4*)(kbase + (ta_ + krow) * 2048); kr_[1] = *(const u32x4*)(kbase + (tb_ + krow) * 2048); \
        const long tv_ = (vch < 8) ? ta_ : tb_; vr_[0] = *(const u32x4*)(vbase + tv_); vr_[1] = *(const u32x4*)(vbase + (long)32 * MT + tv_); } while (0)
#define ATT_WRITE(buf, kr_, vr_) do { *(LAS u32x4*)(F.lds + ATT_K0 + (buf) * ATT_KTILEB + lds_k) = kr_[0]; *(LAS u32x4*)(F.lds + ATT_K0 + (buf) * ATT_KTILEB + 64 * ATT_ROWB + lds_k) = kr_[1]; \
        *(LAS u32x4*)(F.lds + ATT_V0 + (buf) * ATT_VTILEB + lds_v) = vr_[0]; *(LAS u32x4*)(F.lds + ATT_V0 + (buf) * ATT_VTILEB + 32 * ATT_VROWB + lds_v) = vr_[1]; } while (0)
        ATT_LOAD(0, kA, vA); ATT_LOAD(1, kB, vB);
        bf16x8 qf[2];
#pragma unroll
        for (int ks = 0; ks < 2; ++ks) qf[ks] = *(const bf16x8*)(QK + tokq * 2048 + h * 64 + 32 * ks + 8 * g4);
        float m_ref = 0.f, l_run = 0.f;
        f32x4 o[4];
#pragma unroll
        for (int d = 0; d < 4; ++d) o[d] = (f32x4){0.f, 0.f, 0.f, 0.f};
        __syncthreads();
        ATT_WRITE(0, kA, vA);
        asm volatile("" :: "v"(qf[0]), "v"(qf[1]));
        __syncthreads();
#define ATT_COMPUTE(step, cur) do { \
            const LAS unsigned char* Kt = F.lds + ATT_K0 + (cur) * ATT_KTILEB; \
            const LAS unsigned char* Vt_ = F.lds + ATT_V0 + (cur) * ATT_VTILEB; \
            if ((step) < nlt) { const int krA = rs0 + 2 * (step), krB = krA + 1; \
                const bool actA = krA >= rs && krA < rs + 8, actB = krB < rs0 + nlat && krB >= rs && krB < rs + 8; \
                if (actA || actB) attn_sub<1, true>(Kt, Vt_, ksj, bias + (actA ? (krA - r + 7) : 15) * 32, bias + (actB ? (krB - r + 7) : 15) * 32, relidx, qf, m_ref, l_run, o, q16, g4); \
            } else attn_sub<2, false>(Kt, Vt_, 0, bias, bias, relidx, qf, m_ref, l_run, o, q16, g4); \
        } while (0)
        for (int step = 0; step < nsteps; step += 2) {
            ATT_COMPUTE(step, 0);
            if (step + 1 < nsteps) ATT_WRITE(1, kB, vB);
            ATT_LOAD(step + 2, kA, vA);
            __syncthreads();
            if (step + 1 < nsteps) { ATT_COMPUTE(step + 1, 1); }
            if (step + 2 < nsteps) ATT_WRITE(0, kA, vA);
            ATT_LOAD(step + 3, kB, vB);
            __syncthreads();
        }
#undef ATT_LOAD
#undef ATT_WRITE
#undef ATT_COMPUTE
#undef ATT_TOKA
#undef ATT_TOKB
        l_run += __shfl_xor(l_run, 16); l_run += __shfl_xor(l_run, 32);
        const float linv = 1.0f / l_run;
        unsigned char* op = AO + tokq * DM + h * 64 + 4 * g4; const float ls = linv * pg8::ACT8_SCALE;
#pragma unroll
        for (int d = 0; d < 4; ++d) *(unsigned*)(op + 16 * d) = fp8_pack4(o[d][0] * ls, o[d][1] * ls, o[d][2] * ls, o[d][3] * ls);
    }
    __syncthreads();
}

__device__ __forceinline__ void ce_desc(float& a, float& b) { const float hi = fmaxf(a, b), lo = fminf(a, b); a = hi; b = lo; }
__device__ __forceinline__ void ce_dir(float& a, float& b, bool desc) { const float hi = fmaxf(a, b), lo = fminf(a, b); a = desc ? hi : lo; b = desc ? lo : hi; }
__device__ __forceinline__ void sort16_desc(float (&v)[16]) {
#pragma unroll
    for (int k = 2; k <= 16; k <<= 1)
#pragma unroll
        for (int j = k >> 1; j > 0; j >>= 1)
#pragma unroll
            for (int i = 0; i < 16; ++i) { const int l = i ^ j; if (l > i) ce_dir(v[i], v[l], (i & k) == 0); }
}
__device__ __forceinline__ void merge16_desc(float (&a)[16], const float (&b)[16]) {
#pragma unroll
    for (int i = 0; i < 16; ++i) a[i] = fmaxf(a[i], b[15 - i]);
#pragma unroll
    for (int j = 8; j > 0; j >>= 1)
#pragma unroll
        for (int i = 0; i < 16; ++i) { const int l = i ^ j; if (l > i) ce_desc(a[i], a[l]); }
}

struct CandTab { int i[64]; int j[64]; };
__host__ __device__ constexpr CandTab make_cand_tab() {
    CandTab t{}; int n = 0;
    for (int i = 0; i < 16; ++i) for (int j = 0; j < 16; ++j) if ((i + 1) * (j + 1) <= 16) { t.i[n] = i; t.j[n] = j; ++n; }
    for (; n < 64; ++n) { t.i[n] = -1; t.j[n] = -1; }
    return t;
}

__device__ __forceinline__ void peer_topk_phase(const Ctx& F0, const Args& a, int layer) {
    const Ctx F = fresh(F0);
    const bf16_t* QP = (const bf16_t*)(a.ws + WS_QK);
    const bf16_t* SK = (const bf16_t*)(a.ws + WS_SK) + (size_t)layer * 2 * 128 * 128;
    unsigned short* IDX = (unsigned short*)(a.ws + WS_IDX);
    float* GATE = (float*)(a.ws + WS_GATE);
    const int gwv = F.vcu * NWAVES + F.wave, NGW = F.G * NWAVES;
    const int lane = F.lane, t32 = lane & 31, hi = lane >> 5;
    __syncthreads();
    for (int c = F.tid; c < 4096; c += 512) *(LAS u32x4*)(F.lds + (c >> 4) * 272 + (c & 15) * 16) = *(const u32x4*)(SK + (size_t)c * 8);
    __syncthreads();
    for (int task = gwv; task < 1024 * 8; task += NGW) {
        const int tt = task >> 3, h = task & 7;
        const long tok = (long)tt * 32 + t32;
        float top[2][16];
#pragma unroll
        for (int p = 0; p < 2; ++p) {
            f32x16 acc[4];
#pragma unroll
            for (int eb = 0; eb < 4; ++eb)
#pragma unroll
                for (int i = 0; i < 16; ++i) acc[eb][i] = 0.f;
#pragma unroll
            for (int eb = 0; eb < 4; ++eb) asm volatile("" : "+v"(acc[eb]));
            const bf16_t* qp = QP + tok * 2048 + h * 256 + p * 128 + hi * 8;
            const LAS unsigned char* kp = F.lds + (p * 128 + t32) * 272 + hi * 16;
#pragma unroll
            for (int ks = 0; ks < 8; ++ks) {
                if ((ks & 1) == 0) asm volatile("" ::: "memory");
                const bf16x8 bq = *(const bf16x8*)(qp + ks * 16);
#pragma unroll
                for (int eb = 0; eb < 4; ++eb) { const bf16x8 ak = *(const LAS bf16x8*)(kp + eb * 32 * 272 + ks * 32); acc[eb] = __builtin_amdgcn_mfma_f32_32x32x16_bf16(ak, bq, acc[eb], 0, 0, 0); }
            }
            float cur[16];
#pragma unroll
            for (int eb = 0; eb < 4; ++eb) {
                float v[16];
#pragma unroll
                for (int i = 0; i < 16; ++i) { const unsigned e = 32 * eb + crow(i, hi); float x = acc[eb][i]; asm volatile("" : "+v"(x));
                    v[i] = __builtin_bit_cast(float, (__builtin_bit_cast(unsigned, x) & ~0x7Fu) | e); }
                sort16_desc(v);
                if (eb == 0) {
#pragma unroll
                    for (int i = 0; i < 16; ++i) cur[i] = v[i];
                } else merge16_desc(cur, v);
            }
            float oth[16];
#pragma unroll
            for (int i = 0; i < 16; ++i) oth[i] = __shfl_xor(cur[i], 32);
            merge16_desc(cur, oth);
#pragma unroll
            for (int i = 0; i < 16; ++i) top[p][i] = cur[i];
            __builtin_amdgcn_sched_barrier(0);
        }
        float best[16];
#pragma unroll
        for (int gI = 0; gI < 4; ++gI) {
            float v[16];
#pragma unroll
            for (int q = 0; q < 16; ++q) {
                constexpr CandTab CT = make_cand_tab();
                const int ci = CT.i[16 * gI + q], cj = CT.j[16 * gI + q];
                if (ci >= 0) {
                    const unsigned ua = __builtin_bit_cast(unsigned, top[0][ci]), ub = __builtin_bit_cast(unsigned, top[1][cj]);
                    float s = top[0][ci] + top[1][cj]; asm volatile("" : "+v"(s));
                    const unsigned code = ((ua & 0x7Fu) << 7) | (ub & 0x7Fu);
                    v[q] = __builtin_bit_cast(float, (__builtin_bit_cast(unsigned, s) & ~0x3FFFu) | code);
                } else v[q] = -3.0e38f;
            }
            sort16_desc(v);
            if (gI == 0) {
#pragma unroll
                for (int i = 0; i < 16; ++i) best[i] = v[i];
            } else merge16_desc(best, v);
            __builtin_amdgcn_sched_barrier(0);
        }
        float e[16], sum = 0.f;
#pragma unroll
        for (int i = 0; i < 16; ++i) { e[i] = __builtin_amdgcn_exp2f((best[i] - best[0]) * LOG2E); sum += e[i]; }
        const float inv = 1.0f / sum;
        if (hi == 0) {
            u32x4 w0, w1;
            w0.x = (__builtin_bit_cast(unsigned, best[0]) & 0x3FFFu) | ((__builtin_bit_cast(unsigned, best[1]) & 0x3FFFu) << 16);
            w0.y = (__builtin_bit_cast(unsigned, best[2]) & 0x3FFFu) | ((__builtin_bit_cast(unsigned, best[3]) & 0x3FFFu) << 16);
            w0.z = (__builtin_bit_cast(unsigned, best[4]) & 0x3FFFu) | ((__builtin_bit_cast(unsigned, best[5]) & 0x3FFFu) << 16);
            w0.w = (__builtin_bit_cast(unsigned, best[6]) & 0x3FFFu) | ((__builtin_bit_cast(unsigned, best[7]) & 0x3FFFu) << 16);
            w1.x = (__builtin_bit_cast(unsigned, best[8]) & 0x3FFFu) | ((__builtin_bit_cast(unsigned, best[9]) & 0x3FFFu) << 16);
            w1.y = (__builtin_bit_cast(unsigned, best[10]) & 0x3FFFu) | ((__builtin_bit_cast(unsigned, best[11]) & 0x3FFFu) << 16);
            w1.z = (__builtin_bit_cast(unsigned, best[12]) & 0x3FFFu) | ((__builtin_bit_cast(unsigned, best[13]) & 0x3FFFu) << 16);
            w1.w = (__builtin_bit_cast(unsigned, best[14]) & 0x3FFFu) | ((__builtin_bit_cast(unsigned, best[15]) & 0x3FFFu) << 16);
            u32x4* ip = (u32x4*)(IDX + tok * 128 + h * 16);
            ip[0] = w0; ip[1] = w1;
        } else {
            f32x4* gp = (f32x4*)(GATE + tok * 128 + h * 16);
#pragma unroll
            for (int q = 0; q < 4; ++q) gp[q] = (f32x4){e[4 * q] * inv, e[4 * q + 1] * inv, e[4 * q + 2] * inv, e[4 * q + 3] * inv};
        }
    }
    __syncthreads();
}

typedef long i64_t;
typedef unsigned u32x8_t __attribute__((ext_vector_type(8)));
typedef _Float16 h2_t __attribute__((ext_vector_type(2)));
#define U_MFMA4_FIRST(acc, av, bv) asm volatile("v_mfma_scale_f32_16x16x128_f8f6f4 %0, %1, %2, 0, %3, %4 op_sel_hi:[0,0,0] cbsz:4 blgp:4" : "=&v"(acc) : "v"(av), "v"(bv), "v"(sc_a), "v"(sc_one))
#define U_MFMA4(acc, av, bv) asm volatile("v_mfma_scale_f32_16x16x128_f8f6f4 %0, %1, %2, %0, %3, %4 op_sel_hi:[0,0,0] cbsz:4 blgp:4" : "+v"(acc) : "v"(av), "v"(bv), "v"(sc_a), "v"(sc_one))
template <int UVAR = 0>
__device__ __forceinline__ void peer_u_phase(const Ctx& F0, const Args& a, int layer) {
    const Ctx F = fresh(F0);
    const int s = (int)(blockIdx.x & 3), half = (int)((blockIdx.x >> 2) & 1), j = (int)(blockIdx.x >> 3), nmem = F.G >> 3;
    const unsigned char* U4s = a.ws + WS_TAB + (size_t)layer * TAB_LAYER + (size_t)s * NEXP * 128;
    const unsigned* XQ = (const unsigned*)(a.ws + WS_X8 + (size_t)s * ML * 256);
    const unsigned short* IDX = (const unsigned short*)(a.ws + WS_IDX);
    unsigned* PART = (unsigned*)(a.ws + WS_PART) + (size_t)s * ML * 64;
    const int lane = F.lane, rsub = lane >> 3, c8 = lane & 7, n16 = lane & 15, g4 = lane >> 4;
    LAS unsigned char* tile = F.lds + F.wave * 16384;
    constexpr float osc = 1.0f / (U_SCALE * XQ_SCALE);
    constexpr int MLH = ML / 2;
    const int t0 = half * MLH + j * NWAVES + F.wave, stride = nmem * NWAVES, ntok = (half * MLH + MLH - t0 + stride - 1) / stride;
    unsigned sc_one = 0x7f7f7f7fu; asm volatile("" : "+v"(sc_one));
    unsigned sc_a = (n16 & 1) ? 0x7d7d7d7du : 0x7f7f7f7fu; asm volatile("" : "+v"(sc_a));
    const int abase = (32 * (n16 & 1) + 4 * g4) * 4;
#define U_TOK(i) ((size_t)(t0 + ((i) < ntok ? (i) : ntok - 1) * stride))
    const unsigned wx0 = (unsigned)(size_t)(tile + rsub * 2048 + (c8 << 4));
    const unsigned rb0 = (unsigned)(size_t)(tile + n16 * 128 + ((g4 ^ ((n16 >> 1) & 7)) << 4));
    LAS unsigned char* stg = tile + g4 * 512 + n16 * 4;
#define U_LDXQ(i) (XQ[U_TOK(i) * 64 + lane])
#define U_LDI(i) (((const unsigned*)IDX)[U_TOK(i) * 64 + lane])
#define U_IDP(dst, ci) do { _Pragma("unroll") for (int k = 0; k < 8; ++k) dst[k] = (unsigned)__builtin_amdgcn_ds_bpermute((8 * rsub + k) * 4, (int)(ci)); } while (0)
#define U_EIDP(idp, i_) (((i_) & 1) ? (idp[(i_) >> 1] >> 16) : (idp[(i_) >> 1] & 0xffffu))
#define U_READS(nb0) do { \
        _Pragma("unroll") for (int nb = 0; nb < 4; ++nb) { _Pragma("unroll") for (int ks = 0; ks < 2; ++ks) \
            bw[nb][ks] = *(const LAS u32x4*)((LAS unsigned char*)(size_t)(rb0 ^ (64u * ks)) + 2048 * ((nb0) + nb)); } \
        __builtin_amdgcn_sched_barrier(0); \
    } while (0)
#define U_MFMAS() do { \
        _Pragma("unroll") for (int nb = 0; nb < 4; ++nb) U_MFMA4_FIRST(dA[nb], aop[0], bw[nb][0]); \
        _Pragma("unroll") for (int nb = 0; nb < 4; ++nb) U_MFMA4(dA[nb], aop[1], bw[nb][1]); \
        __builtin_amdgcn_sched_barrier(0); \
    } while (0)
#define U_OUTS(nb0) do { \
        asm volatile("s_nop 15\n\ts_nop 3" : "+v"(dA[0]), "+v"(dA[1]), "+v"(dA[2]), "+v"(dA[3]) :: "memory");     \
        _Pragma("unroll") for (int nb = 0; nb < 4; ++nb) { ov[(nb0) + nb] = dA[nb][0] + dA[nb][1]; asm volatile("" : "+v"(ov[(nb0) + nb])); } \
    } while (0)
#define U_BODY(j, CUR, NXT, LD) do { \
        unsigned idp[8]; \
        U_IDP(idp, ci##NXT);                                             \
          \
        _Pragma("unroll") for (int i_ = 0; i_ < 16; ++i_) { \
            *(LAS u32x4*)((LAS unsigned char*)(size_t)(wx0 ^ (unsigned)(((i_) >> 1) << 4)) + i_ * 128) = R[i_]; \
            if (UVAR == 0 || (UVAR == 1 && i_ < 8)) R[i_] = *(const u32x4*)(U4s + (unsigned)(U_EIDP(idp, i_) * 128 + 16 * c8)); \
        } \
          \
        u32x4 aop[2]; \
        _Pragma("unroll") for (int ks = 0; ks < 2; ++ks) { _Pragma("unroll") for (int k = 0; k < 4; ++k) { \
            const unsigned w_ = (unsigned)__builtin_amdgcn_ds_bpermute(abase + (16 * ks + k) * 4, (int)cx##CUR); \
            aop[ks][k] = (n16 < 2) ? w_ : 0u; } } \
        asm volatile("s_waitcnt lgkmcnt(0)" ::: "memory");               \
        f32x4 dA[4]; u32x4 bw[4][2]; float ov[8]; \
        U_READS(0); \
        U_MFMAS(); \
          \
        ci##CUR = U_LDI((j) + 3); cx##LD = U_LDXQ((j) + 2); \
        __builtin_amdgcn_sched_barrier(0); \
        U_READS(4);                                                      \
        U_OUTS(0); \
        U_MFMAS(); \
        U_OUTS(4); \
          \
        _Pragma("unroll") for (int nb = 0; nb < 8; ++nb) *(LAS float*)(stg + nb * 64) = ov[nb]; \
        asm volatile("s_waitcnt lgkmcnt(0)" ::: "memory"); \
        const f32x2 sum = *(const LAS f32x2*)(tile + 8 * lane); \
        asm volatile("s_waitcnt lgkmcnt(0)" ::: "memory"); \
        if ((j) < ntok) PART[U_TOK(j) * 64 + lane] = cvtpk(sum.x * osc, sum.y * osc); \
    } while (0)
    u32x4 R[16];
    unsigned cxA, cxB, cxC, ciA, ciB, ciC;
    ciA = U_LDI(0);
    cxA = U_LDXQ(0); cxB = U_LDXQ(1);
    { unsigned idp0[8]; U_IDP(idp0, ciA);
#pragma unroll
      for (int i_ = 0; i_ < 16; ++i_) R[i_] = *(const u32x4*)(U4s + (unsigned)(U_EIDP(idp0, i_) * 128 + 16 * c8)); }
    ciB = U_LDI(1); ciC = U_LDI(2);
    cxC = 0u;
    asm volatile("" :: "v"(ciC));
    for (int i = 0; i < ntok; i += 3) {
        U_BODY(i, A, B, C);
        U_BODY(i + 1, B, C, A);
        U_BODY(i + 2, C, A, B);
    }
#undef U_BODY
#undef U_READS
#undef U_MFMAS
#undef U_OUTS
#undef U_LDXQ
#undef U_LDI
#undef U_IDP
#undef U_EIDP
#undef U_TOK
}
#undef U_MFMA4_FIRST
#undef U_MFMA4
__device__ __forceinline__ void peer_w_phase(const Ctx& F0, const Args& a) {
    const Ctx F = fresh(F0);
    const unsigned* PART = (const unsigned*)(a.ws + WS_PART);
    const float* GATE = (const float*)(a.ws + WS_GATE);
    unsigned char* WQ = a.ws + WS_WT;
    float* WSC = (float*)(a.ws + WS_WSC);
    const int gwv = F.vcu * NWAVES + F.wave, NGW = F.G * NWAVES;
    for (int t = gwv; t < ML; t += NGW) {
        f32x2 z = (f32x2){0.f, 0.f};
#pragma unroll
        for (int s = 0; s < 4; ++s) { const unsigned pw = PART[((size_t)s * ML + t) * 64 + F.lane]; z += (f32x2){bflo(pw), bfhi(pw)}; }
        const f32x2 g = *(const f32x2*)(GATE + (size_t)t * 128 + 2 * F.lane);
        f32x2 w; w.x = g.x * gelu_erf(z.x); w.y = g.y * gelu_erf(z.y);
        float wm = fmaxf(__builtin_fabsf(w.x), __builtin_fabsf(w.y));
#pragma unroll
        for (int o = 1; o < 64; o <<= 1) wm = fmaxf(wm, __shfl_xor(wm, o));
        wm = fmaxf(wm, 1e-20f);
        const float qs = 6.0f / wm, ax = fminf(fmaxf(w.x * qs, -6.f), 6.f), ay = fminf(fmaxf(w.y * qs, -6.f), 6.f);
        const unsigned ph = __builtin_amdgcn_cvt_scalef32_pk_fp4_f32(0u, ax, ay, 1.0f, 0) & 0xffu;
        const f32x2 dh = FP4_DEC(ph, 0);
        const unsigned pl = __builtin_amdgcn_cvt_scalef32_pk_fp4_f32(0u, fminf(fmaxf(4.f * (ax - dh.x), -6.f), 6.f), fminf(fmaxf(4.f * (ay - dh.y), -6.f), 6.f), 1.0f, 0) & 0xffu;
        ((unsigned short*)WQ)[(size_t)t * 128 + F.lane] = (unsigned short)((ph & 0xfu) | ((ph & 0xf0u) << 4));
        ((unsigned short*)WQ)[(size_t)t * 128 + 64 + F.lane] = (unsigned short)((pl & 0xfu) | ((pl & 0xf0u) << 4));
        if (F.lane == 0) WSC[t] = wm * (1.0f / 6.0f);
    }
}
#define V_MFMA4_FIRST(acc, av, bv, sa) asm volatile("v_mfma_scale_f32_16x16x128_f8f6f4 %0, %1, %2, 0, %3, %4 op_sel_hi:[0,0,0] cbsz:4 blgp:4" : "=&v"(acc) : "v"(av), "v"(bv), "v"(sa), "v"(sc_one))
#define V_MFMA4(acc, av, bv, sa) asm volatile("v_mfma_scale_f32_16x16x128_f8f6f4 %0, %1, %2, %0, %3, %4 op_sel_hi:[0,0,0] cbsz:4 blgp:4" : "+v"(acc) : "v"(av), "v"(bv), "v"(sa), "v"(sc_one))
template <int VAR = 0>
__device__ __forceinline__ void peer_v_phase(const Ctx& F0, const Args& a, int layer, float oscale = 1.0f) {
    const Ctx F = fresh(F0);
    const int s = (int)(blockIdx.x & 3), half = (int)((blockIdx.x >> 2) & 1), j = (int)(blockIdx.x >> 3), nmem = F.G >> 3;
    const unsigned char* V4s = a.ws + WS_TAB + (size_t)layer * TAB_LAYER + TAB_VOFF + (size_t)s * NEXP * 128;
    const unsigned short* IDX = (const unsigned short*)(a.ws + WS_IDX);
    const unsigned char* WQ = a.ws + WS_WT;
    const float* WSC = (const float*)(a.ws + WS_WSC);
    const float* modb = (const float*)(a.ws + WS_MOD) + (size_t)layer * 9 * NMOD;
    bf16_t* X = (bf16_t*)(a.ws + WS_XB);
    const int lane = F.lane, rsub = lane >> 3, c8 = lane & 7, n16 = lane & 15, g4 = lane >> 4;
    LAS unsigned char* tile = F.lds + F.wave * 16384;
    const float osc = ((DBG_SKIP & (layer == 0 ? 2 : 8)) ? 0.f : oscale) * (1.0f / V_SCALE);
    constexpr int MLH = ML / 2;
    const int t0 = half * MLH + j * NWAVES + F.wave, stride = nmem * NWAVES, ntok = (half * MLH + MLH - t0 + stride - 1) / stride;
    unsigned sc_one = 0x7f7f7f7fu; asm volatile("" : "+v"(sc_one));
    typedef int v2i_t __attribute__((ext_vector_type(2)));
    LAS float* gl = (LAS float*)(F.lds + RING_BYTES + 4096);
    for (int u = F.tid; u < 4 * 256; u += NWAVES * 64) gl[u] = modb[(size_t)(4 * half + (u >> 8)) * NMOD + 5 * DM + 256 * s + (u & 255)] * osc;
    __syncthreads();
#define V_TOK(i) ((size_t)(t0 + ((i) < ntok ? (i) : ntok - 1) * stride))
    LAS unsigned char* wx[4]; LAS unsigned char* rb[4];
#pragma unroll
    for (int k = 0; k < 4; ++k) wx[k] = tile + rsub * 2048 + ((c8 ^ k ^ ((rsub & 1) << 2)) << 4);
#pragma unroll
    for (int nb = 0; nb < 4; ++nb) rb[nb] = tile + g4 * 2048 + (n16 >> 1) * 128 + 8 * (n16 & 1) + ((nb ^ ((n16 >> 2) & 3) ^ ((g4 & 1) << 2)) << 4);
    LAS unsigned char* stg = tile + g4 * 1024 + n16 * 8;
#define V_LDW(i) (((const unsigned*)WQ)[V_TOK(i) * 64 + lane])
#define V_LDI(i) (((const unsigned*)IDX)[V_TOK(i) * 64 + lane])
#define V_LDX(i) (*(const u32x2*)(X + V_TOK(i) * DM + 256 * s + 4 * lane))
#define V_LDS(i) (WSC[V_TOK(i)])
#define V_IDP(dst, ci) do { _Pragma("unroll") for (int k = 0; k < 8; ++k) dst[k] = (unsigned)__builtin_amdgcn_ds_bpermute((8 * rsub + k) * 4, (int)(ci)); } while (0)
#define V_EIDP(idp, i_) (((i_) & 1) ? (idp[(i_) >> 1] >> 16) : (idp[(i_) >> 1] & 0xffffu))
#define V_READS(nb0) do { \
        unsigned x64 = (nb0) ? 64u : 0u; asm volatile("" : "+v"(x64));                   \
        _Pragma("unroll") for (int nb = 0; nb < 4; ++nb) { LAS unsigned char* rbn = (LAS unsigned char*)((unsigned)(size_t)rb[nb] ^ x64); \
          _Pragma("unroll") for (int h = 0; h < 2; ++h) { _Pragma("unroll") for (int q = 0; q < 2; ++q) { \
            const v2i_t tr = __builtin_amdgcn_ds_read_tr8_b64_v2i32((LAS v2i_t*)(rbn + 8192 * h + 1024 * q)); \
            bw[nb][h][2 * q] = (unsigned)tr[0]; bw[nb][h][2 * q + 1] = (unsigned)tr[1]; } } } \
        __builtin_amdgcn_sched_barrier(0); \
    } while (0)
#define V_MFMAS() do { \
        _Pragma("unroll") for (int nb = 0; nb < 4; ++nb) V_MFMA4_FIRST(dA[nb], aop[0], bw[nb][0], sc_a); \
        _Pragma("unroll") for (int nb = 0; nb < 4; ++nb) V_MFMA4(dA[nb], aop[1], bw[nb][1], sc_a); \
        __builtin_amdgcn_sched_barrier(0); \
    } while (0)
#define V_OUTS(nb0) do { \
        asm volatile("s_nop 15\n\ts_nop 3" : "+v"(dA[0]), "+v"(dA[1]), "+v"(dA[2]), "+v"(dA[3]) :: "memory");     \
        _Pragma("unroll") for (int nb = 0; nb < 4; ++nb) { ov[(nb0) + nb] = (f32x2){dA[nb][0] + dA[nb][2], dA[nb][1] + dA[nb][3]}; asm volatile("" : "+v"(ov[(nb0) + nb])); } \
    } while (0)
#define V_BODY(j, CUR, NXT, LD) do { \
        const size_t t_ = V_TOK(j); \
        unsigned idp[8]; \
        V_IDP(idp, ci##NXT);                                             \
          \
        _Pragma("unroll") for (int i_ = 0; i_ < 16; ++i_) { \
            *(LAS u32x4*)(wx[(i_ >> 1) & 3] + i_ * 128) = R[i_]; \
            if (VAR == 0 || (VAR == 1 && i_ < 8)) R[i_] = *(const u32x4*)(V4s + (unsigned)(V_EIDP(idp, i_) * 128 + 16 * c8)); \
        } \
          \
        u32x4 aop[2]; \
        _Pragma("unroll") for (int h = 0; h < 2; ++h) { _Pragma("unroll") for (int k = 0; k < 4; ++k) { \
            const unsigned w_ = (unsigned)__builtin_amdgcn_ds_bpermute(abase + (16 * h + k) * 4, (int)cw##CUR); \
            aop[h][k] = (n16 < 4) ? (w_ << ash) : 0u; } } \
        asm volatile("s_waitcnt lgkmcnt(0)" ::: "memory");               \
        f32x4 dA[4]; u32x4 bw[4][2]; f32x2 ov[8]; \
        V_READS(0); \
        V_MFMAS(); \
          \
        ci##CUR = V_LDI((j) + 3); cw##LD = V_LDW((j) + 2); xo##LD = V_LDX((j) + 2); ws##LD = V_LDS((j) + 2); \
        __builtin_amdgcn_sched_barrier(0); \
        V_READS(4);                                                      \
        V_OUTS(0); \
        V_MFMAS(); \
        V_OUTS(4); \
          \
        _Pragma("unroll") for (int nb = 0; nb < 8; ++nb) *(LAS f32x2*)(stg + nb * 128) = ov[nb]; \
        asm volatile("s_waitcnt lgkmcnt(0)" ::: "memory"); \
        const f32x4 sum = *(const LAS f32x4*)(tile + 16 * lane); \
        const f32x4 gt_ = *(const LAS f32x4*)(gl + ((t_ >> 12) & 3) * 256 + 4 * lane); \
        asm volatile("s_waitcnt lgkmcnt(0)" ::: "memory"); \
        if ((j) < ntok) { const f32x4 r_ = bf4_f32(xo##CUR) + gt_ * ws##CUR * sum; *(u32x2*)(X + t_ * DM + 256 * s + 4 * lane) = (u32x2){cvtpk(r_.x, r_.y), cvtpk(r_.z, r_.w)}; } \
    } while (0)
    u32x4 R[16];
    unsigned cwA, cwB, cwC, ciA, ciB, ciC;
    u32x2 xoA, xoB, xoC;
    float wsA, wsB, wsC;
    const int abase = (32 * ((n16 >> 1) & 1) + 4 * g4) * 4, ash = 4 * (n16 & 1);
    unsigned sc_a = (n16 & 2) ? 0x7d7d7d7du : 0x7f7f7f7fu; asm volatile("" : "+v"(sc_a));
    ciA = V_LDI(0);
    cwA = V_LDW(0); cwB = V_LDW(1); xoA = V_LDX(0); xoB = V_LDX(1); wsA = V_LDS(0); wsB = V_LDS(1);
    { unsigned idp0[8]; V_IDP(idp0, ciA);
#pragma unroll
      for (int i_ = 0; i_ < 16; ++i_) R[i_] = *(const u32x4*)(V4s + (unsigned)(V_EIDP(idp0, i_) * 128 + 16 * c8)); }
    ciB = V_LDI(1); ciC = V_LDI(2);
    cwC = 0u; xoC = (u32x2){0u, 0u}; wsC = 0.f;
    asm volatile("" :: "v"(ciC));
    for (int i = 0; i < ntok; i += 3) {
        V_BODY(i, A, B, C);
        V_BODY(i + 1, B, C, A);
        V_BODY(i + 2, C, A, B);
    }
#undef V_BODY
#undef V_READS
#undef V_MFMAS
#undef V_OUTS
#undef V_LDW
#undef V_LDI
#undef V_LDX
#undef V_LDS
#undef V_IDP
#undef V_EIDP
#undef V_TOK
}
#undef V_MFMA4_FIRST
#undef V_MFMA4

__device__ __forceinline__ void dft_nyquist_rows(const Ctx& F0, const Args& a) {
    const Ctx F = fresh(F0);
    const unsigned char* Yt = a.ws + WS_QK;
    unsigned char* Fo = a.ws + WS_VT;
    const int gwv = F.vcu * NWAVES + F.wave, NGW = F.G * NWAVES;
    for (int o = gwv; o < NB * DM; o += NGW) {
        const unsigned char* src = Yt + (size_t)o * 8192;
        float s = 0.f;
#pragma unroll
        for (int it = 0; it < 4; ++it) { const u32x4 v = *(const u32x4*)(src + it * 1024 + F.lane * 16);
#pragma unroll
            for (int d = 0; d < 4; ++d) { const f32x2 lo = __builtin_amdgcn_cvt_pk_f32_fp8((int)v[d], false), hi = __builtin_amdgcn_cvt_pk_f32_fp8((int)v[d], true); s += (lo[0] - lo[1]) + (hi[0] - hi[1]); } }
        s = wave_sum(s) * (pg8::ACT8_SCALE / (64.0f * pg8::YT_SCALE));
        if (F.lane == 0) Fo[((size_t)(o >> 10) * SEQ + 2048) * DM + (o & 1023)] = (unsigned char)(fp8_pack4(s, 0.f, 0.f, 0.f) & 0xffu);
    }
}

__global__ void __launch_bounds__(NWAVES * 64, 2) fwd_kernel(Args args) {
    extern __shared__ __attribute__((aligned(16))) unsigned char lds_raw[];
    Ctx F;
    F.lds = (LAS unsigned char*)lds_raw;
    F.tid = threadIdx.x; F.lane = F.tid & 63; F.wave = __builtin_amdgcn_readfirstlane(F.tid >> 6);
    F.G = gridDim.x; { const int bx = blockIdx.x; F.vcu = (F.G % 8 == 0) ? (bx % 8) * (F.G / 8) + bx / 8 : bx; }
    volatile LAS unsigned* MISC = (volatile LAS unsigned*)(F.lds + MISC_OFF);
    for (int u = F.tid; u < (LDS_BYTES - LDSCTL_OFF) / 4; u += NWAVES * 64) ((LAS unsigned*)(F.lds + LDSCTL_OFF))[u] = 0u;
    __syncthreads();
    unsigned char* ws = args.ws;
    XcdBarrier bar = xcd_barrier_post((unsigned*)(ws + WS_CTL) + CW_BAR, MISC + 8);
#define GRID_BAR() xcd_barrier(bar)
#ifndef DBG_REP
#define DBG_REP 0
#endif
#ifndef DBG_VVAR
#define DBG_VVAR 0
#endif
#define REP(k, ...) do { __VA_ARGS__; if (DBG_REP == (k)) { GRID_BAR(); __VA_ARGS__; } } while (0)
#define PEER_BLOCK(layer) do { \
        norm_phase(F, args, 1, layer, 3 * DM, args.in[5] + (layer) * DM); \
        GRID_BAR(); \
        { using SHq = pg8::Shape<ML, 2048, DM / 2, DM / 2, DM / 2, 1, 0, 0>;       \
          REP(7, pg8::gemm_phase<SHq, pg8::EpiStoreBf16, true>(F.lds, pg8::Gemm{HX, (const bf16_t*)(ws + WS_WPQ) + (size_t)(layer) * 2048 * DM / 2}, F.G, bx, pg8::EpiStoreBf16{QKb, 2048, 0, 0, 1.0f, 1.0f / (pg8::ACT8_SCALE * pg8::W8_SCALE)})); } \
        GRID_BAR(); \
        REP(8, peer_topk_phase(F, args, layer)); \
        GRID_BAR(); \
        REP(9, peer_u_phase(F, args, layer)); \
        GRID_BAR(); \
        REP(10, peer_w_phase(F, args)); \
        GRID_BAR(); \
        peer_v_phase(F, args, layer); if (DBG_REP == 11) { GRID_BAR(); peer_v_phase<DBG_VVAR>(F, args, layer, 0.f); } \
        GRID_BAR(); \
    } while (0)
    const float* modb = (const float*)(ws + WS_MOD);
    bf16_t* HX = (bf16_t*)(ws + WS_HX);
    bf16_t* QKb = (bf16_t*)(ws + WS_QK);
    bf16_t* VTb = (bf16_t*)(ws + WS_VT);
    const bf16_t* Wqkv = (const bf16_t*)(ws + WS_WQKV);
    const int bx = (int)blockIdx.x;

    REP(1, p0_prologue(F, args));
    GRID_BAR();
    REP(2, norm_phase(F, args, 0, 0, 0, args.in[4]));
    GRID_BAR();
    {
        constexpr float o8 = 1.0f / (pg8::ACT8_SCALE * pg8::W8_SCALE);
        using SH1 = pg8::Shape<MT, 2048, DM / 2, DM / 2, DM / 2, 1, 0, 0>;
        pg8::gemm_phase<SH1, pg8::EpiStoreBf16, true>(F.lds, pg8::Gemm{HX, Wqkv}, F.G, bx, pg8::EpiStoreBf16{QKb, 2048, 0, 1024, 0.125f * LOG2E, o8});
        using SH2 = pg8::Shape<DM, MT, DM / 2, DM / 2, DM / 2, 1, 0, 0>;
        pg8::gemm_phase<SH2, pg8::EpiStoreBf16, true>(F.lds, pg8::Gemm{Wqkv + (size_t)2048 * DM / 2, HX}, F.G, bx, pg8::EpiStoreBf16{VTb, MT, 0, 0, 1.0f, o8});
        {
            const int nq = (MT / 256) * 8, nv = 4 * (MT / 256), rq = nq % F.G, rv = nv % F.G;
            const int sh_q = (rq == 0 || bx >= rq) ? 1 : 0, sh_v = (rv == 0 || bx >= rv) ? 1 : 0;
            const int before = (rq == 0 ? bx : max(0, bx - rq)) + (rv == 0 ? bx : max(0, bx - rv));
            const int total = (rq == 0 ? F.G : F.G - rq) + (rv == 0 ? F.G : F.G - rv);
            table_convert(F, args, before, sh_q + sh_v, total);
        }
    }
    GRID_BAR();
    REP(4, attn_phase(F, args));
    GRID_BAR();
    {
        using SH = pg8::Shape<ML, DM, DM / 2, DM / 2, DM / 2, 1, 0, 0>;
        pg8::gemm_phase<SH, pg8::EpiResid<false>, true>(F.lds, pg8::Gemm{(const bf16_t*)(ws + WS_HX + 36 * MiB), (const bf16_t*)(ws + WS_WO)}, F.G, bx, pg8::EpiResid<false>{args.in[0], (bf16_t*)(ws + WS_XB), modb + 2 * DM, NMOD, ((DBG_SKIP & 1) ? 0.f : 1.f) / (pg8::ACT8_SCALE * pg8::W8_SCALE)});
    }
    GRID_BAR();
    PEER_BLOCK(0);
    norm_phase(F, args, 1, 1, 0, args.in[4] + DM);
    GRID_BAR();
    {
        using SH = pg8::Shape<512, ML, 256, 256, DM, 4, 0, 256>;
        pg8::gemm_phase<SH>(F.lds, pg8::Gemm{(const bf16_t*)(ws + WS_WC), HX}, F.G, bx, pg8::EpiYt{(unsigned char*)QKb});
    }
    GRID_BAR();
    {
        using SH = pg8::Shape<SEQ / 2, DM, 4096, 4096, 4096, NB, 0, (long)DM * 4096>;
        REP(14, pg8::gemm_phase<SH, pg8::EpiDft2, true>(F.lds, pg8::Gemm{(const bf16_t*)(ws + WS_CS), QKb}, F.G, bx, pg8::EpiDft2{(unsigned char*)VTb}));
        dft_nyquist_rows(F, args);
    }
    GRID_BAR();
    {
        using SH = pg8::Shape<ML, DM, DM / 2, DM / 2, DM / 2, 1, 0, 0>;
        pg8::gemm_phase<SH, pg8::EpiResid<true>, true>(F.lds, pg8::Gemm{VTb, (const bf16_t*)(ws + WS_WF)}, F.G, bx, pg8::EpiResid<true>{ws + WS_XB, (bf16_t*)(ws + WS_XB), modb + (size_t)9 * NMOD + 2 * DM, NMOD, ((DBG_SKIP & 4) ? 0.f : 1.f) / (pg8::ACT8_SCALE * pg8::W8_SCALE)});
    }
    GRID_BAR();
    PEER_BLOCK(1);
    if (DBG_REP == 20) { for (int r = 0; r < 16; ++r) GRID_BAR(); }
    final_norm_phase(F, args);
#undef PEER_BLOCK
}

extern "C" void kernel_launch(void* const* d_in, const int* in_sizes, int n_in, void* d_out, int out_size, void* d_ws, size_t ws_size, hipStream_t stream) {
    static int grid = 0;
    if (grid == 0) {
        if (n_in != 17 || in_sizes[0] != ML * DM || out_size != ML * DM || ws_size < WS_END) { fprintf(stderr, "kernel_launch: unexpected shapes (n_in %d, in0 %d, out %d, ws %zu)\n", n_in, n_in > 0 ? in_sizes[0] : -1, out_size, ws_size); grid = -1; return; }
        int dev = 0, cus = 0, per_cu = 0;
        if (hipGetDevice(&dev) != hipSuccess || hipDeviceGetAttribute(&cus, hipDeviceAttributeMultiprocessorCount, dev) != hipSuccess) { grid = -1; return; }
        if (hipFuncSetAttribute((const void*)fwd_kernel, hipFuncAttributeMaxDynamicSharedMemorySize, LDS_BYTES) != hipSuccess) { fprintf(stderr, "kernel_launch: hipFuncSetAttribute failed\n"); grid = -1; return; }
        if (hipOccupancyMaxActiveBlocksPerMultiprocessor(&per_cu, (const void*)fwd_kernel, NWAVES * 64, LDS_BYTES) != hipSuccess || per_cu < 1)
            fprintf(stderr, "kernel_launch: note: occupancy query reports %d workgroups per CU\n", per_cu);
        (void)hipGetLastError();
        grid = cus;
        if (grid % 8 != 0) { fprintf(stderr, "kernel_launch: CU count %d is not a multiple of 8\n", cus); grid = -1; return; }
    }
    if (grid < 0) return;
    if (hipMemsetAsync((char*)d_ws + WS_CTL, 0, CTL_ZERO_BYTES, stream) != hipSuccess) { fprintf(stderr, "kernel_launch: memset failed\n"); return; }
    Args a{};
    for (int i = 0; i < 17; ++i) a.in[i] = (const float*)d_in[i];
    a.out = (float*)d_out; a.ws = (unsigned char*)d_ws;
    hipLaunchKernelGGL(fwd_kernel, dim3(grid), dim3(NWAVES * 64), LDS_BYTES, stream, a);
    const hipError_t le = hipPeekAtLastError();
    if (le != hipSuccess) fprintf(stderr, "kernel_launch: launch failed: %s\n", hipGetErrorName(le));
}
```

```cpp
#include <hip/hip_runtime.h>
#include <cstdio>
#include <cstdint>

#define LAS __attribute__((address_space(3)))
typedef unsigned short bf16_t;
typedef short bf16x8 __attribute__((ext_vector_type(8)));
typedef short s16x4 __attribute__((ext_vector_type(4)));
typedef float f32x2 __attribute__((ext_vector_type(2)));
typedef float f32x4 __attribute__((ext_vector_type(4)));
typedef float f32x16 __attribute__((ext_vector_type(16)));
typedef unsigned u32x2 __attribute__((ext_vector_type(2)));
typedef unsigned u32x4 __attribute__((ext_vector_type(4)));
typedef __bf16 bf16x2_t __attribute__((ext_vector_type(2)));

#ifndef DBG_SKIP
#define DBG_SKIP 0
#endif
constexpr int DM = 1024, NB = 8, SEQ = 4096, CTXL = 256, GW = 64;
constexpr int ML = NB * SEQ;
constexpr int MC = NB * CTXL;
constexpr int MT = ML + MC;
constexpr int NMOD = 6 * DM;
constexpr int NEXP = 16384;
constexpr float EPS = 1e-6f;
constexpr float LOG2E = 1.4426950408889634f;

constexpr size_t MiB = 1u << 20;
constexpr size_t WS_CTL = 0, CTL_ZERO_BYTES = 1 * MiB;
constexpr size_t WS_MOD = 1 * MiB;
constexpr size_t WS_WQKV = 2 * MiB;
constexpr size_t WS_WO = 8 * MiB;
constexpr size_t WS_WF = 10 * MiB;
constexpr size_t WS_WPQ = 12 * MiB;
constexpr size_t WS_SK = 20 * MiB;
constexpr size_t WS_WC = 20 * MiB + 256 * 1024;
constexpr size_t WS_CS = 22 * MiB;
constexpr size_t WS_TAB = 38 * MiB;
constexpr size_t WS_X8 = 150 * MiB;
constexpr size_t WS_WT = 182 * MiB;
constexpr size_t WS_PART = 282 * MiB;
constexpr float U_SCALE = 64.f;
constexpr float XQ_SCALE = 0.75f;
constexpr float V_SCALE = 2.f;
constexpr size_t WS_XB = 70 * MiB;
constexpr size_t TAB_LAYER = 16 * MiB, TAB_VOFF = 8 * MiB;
constexpr size_t WS_WSC = 198 * MiB;
constexpr size_t WS_HX = 214 * MiB;
constexpr size_t WS_QK = 282 * MiB;
constexpr size_t WS_VT = 418 * MiB;
constexpr size_t WS_IDX = WS_VT;
constexpr size_t WS_GATE = WS_VT + 8 * MiB;
constexpr size_t WS_END = 486 * MiB;
constexpr int CW_BAR = 4096;

__device__ __forceinline__ unsigned f2bf(float f) { unsigned u = __builtin_bit_cast(unsigned, f); return (u + 0x7fffu + ((u >> 16) & 1u)) >> 16; }
__device__ __forceinline__ unsigned pk2(float lo, float hi) { return f2bf(lo) | (f2bf(hi) << 16); }
__device__ __forceinline__ f32x4 bf4_f32(u32x2 w) { return (f32x4){__builtin_bit_cast(float, w.x << 16), __builtin_bit_cast(float, w.x & 0xffff0000u), __builtin_bit_cast(float, w.y << 16), __builtin_bit_cast(float, w.y & 0xffff0000u)}; }
__device__ __forceinline__ unsigned cvtpk(float lo, float hi) { f32x2 v = {lo, hi}; bf16x2_t b = __builtin_convertvector(v, bf16x2_t); return __builtin_bit_cast(unsigned, b); }
__device__ __forceinline__ float bflo(unsigned u) { return __builtin_bit_cast(float, u << 16); }
__device__ __forceinline__ float bfhi(unsigned u) { return __builtin_bit_cast(float, u & 0xffff0000u); }
__device__ __forceinline__ float wave_sum(float v) {
#pragma unroll
    for (int o = 1; o < 64; o <<= 1) v += __shfl_xor(v, o);
    return v;
}
__device__ __forceinline__ unsigned fp8_pack4(float a, float b, float c, float d) {
    int w = 0;
    w = __builtin_amdgcn_cvt_pk_fp8_f32(__builtin_amdgcn_fmed3f(a, -448.f, 448.f), __builtin_amdgcn_fmed3f(b, -448.f, 448.f), w, false);
    w = __builtin_amdgcn_cvt_pk_fp8_f32(__builtin_amdgcn_fmed3f(c, -448.f, 448.f), __builtin_amdgcn_fmed3f(d, -448.f, 448.f), w, true);
    return (unsigned)w;
}
__device__ __forceinline__ int crow(int r, int hi) { return (r & 3) + 8 * (r >> 2) + 4 * hi; }
__device__ __forceinline__ float gelu_erf(float v) {
    const float av = __builtin_fabsf(v), d = av * 0.2316418882f + 1.0f;
    const float t = __builtin_amdgcn_rcpf(d);
    float q = t * 0.5307027145f + (-0.7265760135f); q = q * t + 0.7107068705f; q = q * t + (-0.142248368f); q = q * t + 0.127414796f; q = q * t;
    const float e = __builtin_amdgcn_exp2f((v * v) * (-0.72134752044f));
    const float m = v * (q * e), r = v - m;
    return v < 0.f ? m : r;
}

namespace pg8 {
constexpr float ACT8_SCALE = 16.f, W8_SCALE = 256.f;
constexpr float YT_SCALE = 16.f, CS_SCALE = 512.f;
constexpr int BM = 256, BK = 64, HALF = 128, HTB = HALF * BK * 2, STAGE_BYTES = 8 * HTB, NXCD = 8, WGM = 8;
__host__ __device__ __forceinline__ int lds_byte(int r, int c) { const int st = (r >> 4) * 2 + (c >> 5), rr = r & 15, cc = c & 31, ob = rr * 64 + cc * 2; return st * 1024 + (ob ^ (((ob >> 9) & 1) << 5)); }
__host__ __device__ __forceinline__ void stage_rc(int b, int& R, int& C) { const int st = b / 1024, sb = b % 1024, swz = sb ^ (((sb >> 9) & 1) << 5); R = (st >> 1) * 16 + swz / 64; C = (st & 1) * 32 + (swz % 64) / 2; }
__host__ __device__ __forceinline__ int perm32(int rho) { const int n = rho >> 4, i = rho & 15; return 8 * (i >> 2) + 4 * n + (i & 3); }

struct Unit { int pm, pn, pb; };
struct Gemm { const bf16_t* A; const bf16_t* Bt; };
template <int M_, int N_, int K_, int LDA_, int LDB_, int NBATCH_, long BSA_, long BSB_> struct Shape { static constexpr int M = M_, N = N_, K = K_, lda = LDA_, ldb = LDB_, nbatch = NBATCH_; static constexpr long bsA = BSA_, bsB = BSB_; };

template <class SH> struct StaticOrder {
    static constexpr int nM = SH::M / BM, nN = SH::N / BM, per = nM * nN, nwg = per * SH::nbatch;
    int G, c;
    __device__ __forceinline__ void init(int G_, int c_) { G = G_; c = c_; }
    __device__ __forceinline__ bool next(int i, Unit& u) const {
        const long L = (long)i * G + c; if (L >= nwg) return false;
        int wgid = (int)L; { const int q = nwg / NXCD, r = nwg % NXCD, xcd = wgid % NXCD, off = wgid / NXCD; wgid = (xcd < r ? xcd * (q + 1) : r * (q + 1) + (xcd - r) * q) + off; }
        u.pb = wgid / per; wgid -= u.pb * per;
        const int nig = WGM * nN, gid = wgid / nig, fm = gid * WGM, gsz = (nM - fm) < WGM ? (nM - fm) : WGM;
        u.pm = fm + ((wgid % nig) % gsz); u.pn = (wgid % nig) / gsz; return true;
    }
};

struct EpiStoreBf16 {
    static constexpr bool PERM = true;
    bf16_t* O; long ldc; long bstride; int scols; float scale0; float oscale = 1.0f;
    __device__ __forceinline__ void operator()(const f32x4 (&acc)[2][2][4][2], const Unit& u, int wr, int wc, int fr, int fq) const {
        const int row0 = u.pm * BM + wr * 64 + fr, col0 = u.pn * BM + wc * 32 + 8 * fq;
        bf16_t* base = O + (long)u.pb * bstride;
        const float sc = ((u.pn * BM < scols) ? scale0 : 1.0f) * oscale;
#pragma unroll
        for (int ai = 0; ai < 2; ++ai)
#pragma unroll
            for (int m = 0; m < 4; ++m) { bf16_t* rowp = base + (long)(row0 + ai * HALF + m * 16) * ldc + col0;
#pragma unroll
                for (int bj = 0; bj < 2; ++bj) { const f32x4 v0 = acc[ai][bj][m][0] * sc, v1 = acc[ai][bj][m][1] * sc;
                    u32x4 w; w.x = cvtpk(v0[0], v0[1]); w.y = cvtpk(v0[2], v0[3]); w.z = cvtpk(v1[0], v1[1]); w.w = cvtpk(v1[2], v1[3]);
                    *(u32x4*)(rowp + bj * HALF) = w; } }
    }
};
struct EpiDft2 {
    static constexpr bool PERM = true;
    unsigned char* O;
    __device__ __forceinline__ void operator()(const f32x4 (&acc)[2][2][4][2], const Unit& u, int wr, int wc, int fr, int fq) const {
        const int row0 = u.pm * BM + wr * 64 + fr, cl0 = wc * 32 + 8 * fq;
        unsigned char* base = O + (long)u.pb * SEQ * DM + u.pn * BM;
        constexpr float osc = ACT8_SCALE / (YT_SCALE * CS_SCALE);
#pragma unroll
        for (int ai = 0; ai < 2; ++ai)
#pragma unroll
            for (int m = 0; m < 4; ++m) { const int np = row0 + ai * HALF + m * 16;
                unsigned char* rowp = base + (long)np * DM; unsigned char* mirp = base + (long)(SEQ - np) * DM;
#pragma unroll
                for (int bj = 0; bj < 2; ++bj) { const f32x4 v0 = acc[ai][bj][m][0] * osc, v1 = acc[ai][bj][m][1] * osc; const int cl = cl0 + bj * HALF;
                    u32x2 w; w.x = fp8_pack4(v0[0], v0[1], v0[2], v0[3]); w.y = fp8_pack4(v1[0], v1[1], v1[2], v1[3]);
                    *(u32x2*)(rowp + cl) = w;
                    if (np != 0) {
#pragma unroll
                        for (int i = 0; i < 8; ++i) mirp[(256 - cl - i) & 255] = (unsigned char)((w[i >> 2] >> (8 * (i & 3))) & 0xffu); } }
                asm volatile("" ::: "memory"); }
    }
};
struct EpiYt {
    static constexpr bool PERM = true;
    unsigned char* Yt;
    __device__ __forceinline__ void operator()(const f32x4 (&acc)[2][2][4][2], const Unit& u, int wr, int wc, int fr, int fq) const {
        const int row0 = u.pm * BM + wr * 64 + fr, col0 = u.pn * BM + wc * 32 + 8 * fq;
#pragma unroll
        for (int ai = 0; ai < 2; ++ai)
#pragma unroll
            for (int m = 0; m < 4; ++m) { const int row = row0 + ai * HALF + m * 16; const int part = row >> 8, cp = row & 255;
#pragma unroll
                for (int bj = 0; bj < 2; ++bj) { const int col = col0 + bj * HALF; const int b = col >> 12, n = col & 4095;
                    const f32x4 v0 = acc[ai][bj][m][0] * YT_SCALE, v1 = acc[ai][bj][m][1] * YT_SCALE;
                    u32x2 w; w.x = fp8_pack4(v0[0], v0[1], v0[2], v0[3]); w.y = fp8_pack4(v1[0], v1[1], v1[2], v1[3]);
                    *(u32x2*)(Yt + ((((long)(b * 4 + u.pb) * 256 + cp) * 2 + part) << 12) + n) = w; }
                asm volatile("" ::: "memory"); }
    }
};
template <bool IN_BF16>
struct EpiResid {
    static constexpr bool PERM = false;
    const void* Xin; bf16_t* Xout; const float* gate; int gstride; float gs;
    __device__ __forceinline__ void operator()(const f32x4 (&acc)[2][2][4][2], const Unit& u, int wr, int wc, int fr, int fq) const {
        const int row0 = u.pm * BM + wr * 64 + fr, col0 = u.pn * BM + wc * 32 + 4 * fq;
        const float* gb = gate + (long)((u.pm * BM) >> 12) * gstride;
        f32x4 gv[2][2];
#pragma unroll
        for (int bj = 0; bj < 2; ++bj)
#pragma unroll
            for (int n = 0; n < 2; ++n) gv[bj][n] = *(const f32x4*)(gb + col0 + bj * HALF + n * 16);
#pragma unroll
        for (int ai = 0; ai < 2; ++ai)
#pragma unroll
            for (int m = 0; m < 4; ++m) { const long off = (long)(row0 + ai * HALF + m * 16) * DM + col0;
#pragma unroll
                for (int bj = 0; bj < 2; ++bj)
#pragma unroll
                    for (int n = 0; n < 2; ++n) { const long o_ = off + bj * HALF + n * 16;
                        const f32x4 bs = IN_BF16 ? bf4_f32(*(const u32x2*)((const bf16_t*)Xin + o_)) : *(const f32x4*)((const float*)Xin + o_);
                        const f32x4 r_ = bs + gv[bj][n] * acc[ai][bj][m][n] * gs;
                        *(u32x2*)(Xout + o_) = (u32x2){cvtpk(r_.x, r_.y), cvtpk(r_.z, r_.w)}; }
                if (m & 1) asm volatile("" ::: "memory"); }
    }
};

template <class SH, class Epi, bool FP8 = false>
__device__ __forceinline__ void gemm_phase(LAS unsigned char* lds, const Gemm g, int G_, int c_, const Epi& E) {
    StaticOrder<SH> S; S.init(G_, c_);
    int tid_ = threadIdx.x; asm volatile("" : "+v"(tid_));
    const int tid = tid_, wid = __builtin_amdgcn_readfirstlane(tid >> 6), lane = tid & 63, wr = wid >> 2, wc = wid & 3, fr = lane & 15, fq = lane >> 4;
    constexpr int K = SH::K, nt = K / BK;
    unsigned voffA[2], voffB[2];
#pragma unroll
    for (int i = 0; i < 2; ++i) { int R, C; stage_rc(tid * 16 + i * 8192, R, C); const int Rb = Epi::PERM ? ((R & ~31) + perm32(R & 31)) : R;
        voffA[i] = (unsigned)(R * SH::lda + C) * 2u; voffB[i] = (unsigned)(Rb * SH::ldb + C) * 2u; }
    constexpr size_t kstep = (size_t)(BK * 2);
    constexpr size_t hstepA = (size_t)HALF * SH::lda * 2, hstepB = (size_t)HALF * SH::ldb * 2;
    constexpr size_t tstepA = 2 * hstepA, tstepB = 2 * hstepB;
    const unsigned ldsw = (unsigned)wid * 1024u;
    const int aoff = lds_byte(wr * 64 + fr, fq * 8), boff = lds_byte(wc * 32 + fr, fq * 8);
#define PG8_SA(b, h) (((b) * 2 + (h)) * HTB)
#define PG8_SB(b, h) ((4 + (b) * 2 + (h)) * HTB)
#define PG8_STAGE(bufoff, gbase, voff) do { _Pragma("unroll") for (int _i = 0; _i < 2; ++_i) \
        __builtin_amdgcn_global_load_lds((const unsigned*)((const char*)(gbase) + (voff)[_i]), (LAS unsigned*)(lds + (bufoff) + ldsw + _i * 8192), 16, 0, 0); } while (0)
#define PG8_LDA(dst, b, h) do { _Pragma("unroll") for (int m = 0; m < 4; ++m) { const u32x4 f0_ = *(const LAS u32x4*)(lds + PG8_SA(b, h) + aoff + m * 2048), f1_ = *(const LAS u32x4*)(lds + PG8_SA(b, h) + aoff + m * 2048 + 1024); dst[m] = __builtin_shufflevector(f0_, f1_, 0, 1, 2, 3, 4, 5, 6, 7); } } while (0)
#define PG8_LDB(dst, b, h) do { _Pragma("unroll") for (int n = 0; n < 2; ++n) { const u32x4 f0_ = *(const LAS u32x4*)(lds + PG8_SB(b, h) + boff + n * 2048), f1_ = *(const LAS u32x4*)(lds + PG8_SB(b, h) + boff + n * 2048 + 1024); dst[n] = __builtin_shufflevector(f0_, f1_, 0, 1, 2, 3, 4, 5, 6, 7); } } while (0)
typedef int v8i_t __attribute__((ext_vector_type(8)));
typedef unsigned u32x8 __attribute__((ext_vector_type(8)));
#define PG8_LOH(x) __builtin_bit_cast(bf16x8, __builtin_shufflevector(x, x, 0, 1, 2, 3))
#define PG8_HIH(x) __builtin_bit_cast(bf16x8, __builtin_shufflevector(x, x, 4, 5, 6, 7))
#define PG8_MMA(ai, bj, At, Bt) do { __builtin_amdgcn_s_setprio(1); _Pragma("unroll") for (int m = 0; m < 4; ++m) _Pragma("unroll") for (int n = 0; n < 2; ++n) { \
        if constexpr (FP8) asm volatile("v_mfma_scale_f32_16x16x128_f8f6f4 %0, %1, %2, %0, %3, %3 op_sel_hi:[0,0,0]" : "+v"(acc[ai][bj][m][n]) : "v"(Bt[n]), "v"(At[m]), "v"(fp8_one));   \
        else { acc[ai][bj][m][n] = __builtin_amdgcn_mfma_f32_16x16x32_bf16(PG8_LOH(Bt[n]), PG8_LOH(At[m]), acc[ai][bj][m][n], 0, 0, 0); \
               acc[ai][bj][m][n] = __builtin_amdgcn_mfma_f32_16x16x32_bf16(PG8_HIH(Bt[n]), PG8_HIH(At[m]), acc[ai][bj][m][n], 0, 0, 0); } } \
        __builtin_amdgcn_s_setprio(0); } while (0)
#define PG8_WAIT_V(n) asm volatile("s_waitcnt vmcnt(" #n ")" ::: "memory")
#define PG8_WAIT_L(n) asm volatile("s_waitcnt lgkmcnt(" #n ")" ::: "memory")
#define PG8_BAR __builtin_amdgcn_s_barrier()
#define PG8_SCHED __builtin_amdgcn_sched_barrier(0)
    Unit cur, nxt; int ui = 0;
    if (!S.next(0, cur)) return;
    f32x4 acc[2][2][4][2];
#pragma unroll
    for (int a = 0; a < 2; ++a)
#pragma unroll
        for (int b = 0; b < 2; ++b)
#pragma unroll
            for (int m = 0; m < 4; ++m)
#pragma unroll
                for (int n = 0; n < 2; ++n) acc[a][b][m][n] = (f32x4){0.f, 0.f, 0.f, 0.f};
    unsigned fp8_one = 0x7f7f7f7fu; asm volatile("" : "+v"(fp8_one));
    u32x8 At[4], B0[2], B1[2];
    const char* cA = (const char*)(g.A + (long)cur.pb * SH::bsA) + (size_t)cur.pm * tstepA; const char* cB = (const char*)(g.Bt + (long)cur.pb * SH::bsB) + (size_t)cur.pn * tstepB;
    PG8_STAGE(PG8_SB(0, 0), cB, voffB); PG8_STAGE(PG8_SB(0, 1), cB + hstepB, voffB); PG8_STAGE(PG8_SA(0, 0), cA, voffA); PG8_STAGE(PG8_SA(0, 1), cA + hstepA, voffA);
    if (wr == 1) PG8_BAR;
    PG8_WAIT_V(2); PG8_BAR;
    PG8_STAGE(PG8_SB(1, 0), cB + kstep, voffB); PG8_STAGE(PG8_SA(1, 0), cA + kstep, voffA); PG8_STAGE(PG8_SB(1, 1), cB + hstepB + kstep, voffB);
    PG8_WAIT_V(6); PG8_BAR;
    for (;;) {
        const bool has_next = S.next(ui + 1, nxt);
        const char* nA = has_next ? (const char*)(g.A + (long)nxt.pb * SH::bsA) + (size_t)nxt.pm * tstepA : cA; const char* nB = has_next ? (const char*)(g.Bt + (long)nxt.pb * SH::bsB) + (size_t)nxt.pn * tstepB : cB;
#pragma nounroll
        for (int t = 0; t < nt; t += 2) {
            const bool last = (t == nt - 2);
            const char* a1 = cA + (size_t)(t + 1) * kstep;
            const char* a2 = last ? nA : cA + (size_t)(t + 2) * kstep; const char* b2 = last ? nB : cB + (size_t)(t + 2) * kstep;
            const char* a3 = a2 + kstep; const char* b3 = b2 + kstep;
            PG8_LDB(B0, 0, 0); PG8_LDB(B1, 0, 1); PG8_SCHED; PG8_LDA(At, 0, 0); PG8_STAGE(PG8_SA(1, 1), a1 + hstepA, voffA);
            PG8_WAIT_V(8); PG8_WAIT_L(0); PG8_BAR; PG8_MMA(0, 0, At, B0); PG8_MMA(0, 1, At, B1); PG8_BAR; PG8_SCHED;
            PG8_LDA(At, 0, 1); PG8_STAGE(PG8_SB(0, 0), b2, voffB); PG8_STAGE(PG8_SB(0, 1), b2 + hstepB, voffB); PG8_STAGE(PG8_SA(0, 0), a2, voffA);
            PG8_WAIT_V(8); PG8_WAIT_L(0); PG8_BAR; PG8_MMA(1, 0, At, B0); PG8_MMA(1, 1, At, B1); PG8_BAR; PG8_SCHED;
            PG8_LDB(B0, 1, 0); PG8_LDB(B1, 1, 1); PG8_SCHED; PG8_LDA(At, 1, 0); PG8_STAGE(PG8_SA(0, 1), a2 + hstepA, voffA);
            PG8_WAIT_V(8); PG8_WAIT_L(0); PG8_BAR; PG8_MMA(0, 0, At, B0); PG8_MMA(0, 1, At, B1); PG8_BAR; PG8_SCHED;
            PG8_LDA(At, 1, 1); PG8_STAGE(PG8_SB(1, 0), b3, voffB); PG8_STAGE(PG8_SB(1, 1), b3 + hstepB, voffB); PG8_STAGE(PG8_SA(1, 0), a3, voffA);
            PG8_WAIT_V(8); PG8_WAIT_L(0); PG8_BAR; PG8_MMA(1, 0, At, B0); PG8_MMA(1, 1, At, B1); PG8_BAR; PG8_SCHED;
        }
        if (wr == 0) PG8_BAR;
        if constexpr (FP8) asm volatile("s_nop 15\n\ts_nop 15\n\ts_nop 7" ::: "memory");
        E(acc, cur, wr, wc, fr, fq);
        if (!has_next) break;
#pragma unroll
        for (int a = 0; a < 2; ++a)
#pragma unroll
            for (int b = 0; b < 2; ++b)
#pragma unroll
                for (int m = 0; m < 4; ++m)
#pragma unroll
                    for (int n = 0; n < 2; ++n) acc[a][b][m][n] = (f32x4){0.f, 0.f, 0.f, 0.f};
        cur = nxt; cA = nA; cB = nB; ++ui;
        if (wr == 1) PG8_BAR;
    }
    PG8_WAIT_V(0);
    PG8_BAR;
#undef PG8_SA
#undef PG8_SB
#undef PG8_STAGE
#undef PG8_LDA
#undef PG8_LDB
#undef PG8_MMA
#undef PG8_WAIT_V
#undef PG8_WAIT_L
#undef PG8_BAR
#undef PG8_SCHED
}
}

#define XB_TMO      128
#define XB_XCNT(j)  (256  + 64 * (j))
#define XB_XSUB(j)  (1280 + 64 * (j))
#define XB_XGEN(j)  (2304 + 64 * (j))
#define XB_TOP      3328
#define XB_TOPGEN   3392
#define XCD_BAR_WORDS 3456
#define XB_SPIN_CAP (1u << 18)
__device__ __forceinline__ unsigned xb_ld(unsigned* p)              { return __hip_atomic_load(p, __ATOMIC_RELAXED, __HIP_MEMORY_SCOPE_AGENT); }
__device__ __forceinline__ unsigned xb_add(unsigned* p, unsigned v) { return __hip_atomic_fetch_add(p, v, __ATOMIC_RELAXED, __HIP_MEMORY_SCOPE_AGENT); }
__device__ __forceinline__ unsigned xb_xcc_id() { return (unsigned)__builtin_amdgcn_s_getreg((3 << 11) | 20) & 0xFu; }
#define XB_SPIN(cond, bar) do { unsigned _sp = 0; while (cond) { __builtin_amdgcn_s_sleep(1); \
    if ((++_sp & 255u) == 0u) { if (xb_ld(&(bar)[XB_TMO])) break; if (_sp > XB_SPIN_CAP) { atomicAdd(&(bar)[XB_TMO], 1u); break; } } } } while (0)
struct XcdBarrier { unsigned* bar; unsigned x; volatile LAS unsigned* st; };
__device__ __forceinline__ XcdBarrier xcd_barrier_post(unsigned* bar, volatile LAS unsigned* st) {
    XcdBarrier b; b.bar = bar; b.x = xb_xcc_id(); b.st = st;
    if (threadIdx.x == 0) (void)xb_add(&bar[XB_XCNT(b.x)], 1u);
    return b;
}
__device__ __forceinline__ void xcd_barrier_complete(unsigned* bar, unsigned x, unsigned& nloc, unsigned& nx) {
    const unsigned G = gridDim.x * gridDim.y * gridDim.z;
    unsigned sum, cnt, mine, sp = 0u;
    for (;;) {
        sum = 0u; cnt = 0u; mine = 0u;
#pragma unroll
        for (unsigned j = 0; j < 16; ++j) { const unsigned c = xb_ld(&bar[XB_XCNT(j)]); sum += c; cnt += (c > 0u) ? 1u : 0u; mine = (j == x) ? c : mine; }
        if (sum == G) break;
        __builtin_amdgcn_s_sleep(1);
        if ((++sp & 255u) == 0u) { if (xb_ld(&bar[XB_TMO])) break; if (sp > XB_SPIN_CAP) { atomicAdd(&bar[XB_TMO], 1u); break; } }
    }
    nloc = mine > 0u ? mine : 1u; nx = cnt > 0u ? cnt : 1u;
}
__device__ __forceinline__ void xcd_barrier(const XcdBarrier& b) {
    asm volatile("s_waitcnt vmcnt(0)" ::: "memory");
    __syncthreads();
    if (threadIdx.x == 0) {
        unsigned* bar = b.bar;
        __builtin_amdgcn_s_waitcnt(0);
        unsigned nloc = b.st[0], nx = b.st[1];
        if (nloc == 0u) { xcd_barrier_complete(bar, b.x, nloc, nx); b.st[0] = nloc; b.st[1] = nx; }
        const unsigned old = xb_add(&bar[XB_XSUB(b.x)], 1u);
        const unsigned gen = old / nloc;
        if (old + 1u == (gen + 1u) * nloc) {
            __builtin_amdgcn_fence(__ATOMIC_RELEASE, "agent");
            asm volatile("s_waitcnt vmcnt(0)" ::: "memory");
            const unsigned og = xb_add(&bar[XB_TOP], 1u);
            const unsigned tg = og / nx;
            if (og + 1u == (tg + 1u) * nx) xb_add(&bar[XB_TOPGEN], 1u);
            else XB_SPIN(xb_ld(&bar[XB_TOPGEN]) == tg, bar);
            __builtin_amdgcn_fence(__ATOMIC_ACQUIRE, "agent");
            xb_add(&bar[XB_XGEN(b.x)], 1u);
            asm volatile("s_waitcnt vmcnt(0)" ::: "memory");
        } else {
            XB_SPIN(xb_ld(&bar[XB_XGEN(b.x)]) == gen, bar);
            __builtin_amdgcn_fence(__ATOMIC_ACQUIRE, "agent");
            asm volatile("s_waitcnt vmcnt(0)" ::: "memory");
        }
    }
    __syncthreads();
}

constexpr int RING_BYTES = 131072;
constexpr int LDSCTL_OFF = RING_BYTES, MISC_OFF = LDSCTL_OFF + 320;
constexpr int LDS_BYTES = 147456;
constexpr int NWAVES = 8;

struct Args { const float* in[17]; float* out; unsigned char* ws; };

struct Ctx {
    LAS unsigned char* lds;
    int tid, lane, wave, vcu, G;
};

__device__ __forceinline__ Ctx fresh(const Ctx& F) {
    Ctx C = F; int t = threadIdx.x; asm volatile("" : "+v"(t)); C.tid = t; C.lane = t & 63; return C;
}
__device__ __forceinline__ void p0_transpose_item(const float* W, int K, int N, bf16_t* WT, LAS float* scr, int item, int lane) {
    const int nblk = N / 32, kb = item / nblk, nb = item % nblk, k0 = 64 * kb, n0 = 32 * nb;
#pragma unroll 8
    for (int i = 0; i < 32; ++i) { const int kk = 2 * i + (lane >> 5); scr[kk * 33 + (lane & 31)] = W[(size_t)(k0 + kk) * N + n0 + (lane & 31)]; }
    asm volatile("s_waitcnt lgkmcnt(0)" ::: "memory");
    const int c = lane & 7;
#pragma unroll
    for (int j = 0; j < 4; ++j) { const int n = (lane >> 3) + 8 * j; const LAS float* s = scr + (8 * c) * 33 + n;
        u32x4 o; o.x = pk2(s[0 * 33], s[1 * 33]); o.y = pk2(s[2 * 33], s[3 * 33]); o.z = pk2(s[4 * 33], s[5 * 33]); o.w = pk2(s[6 * 33], s[7 * 33]);
        *(u32x4*)(WT + (size_t)(n0 + n) * K + k0 + 8 * c) = o; }
    asm volatile("s_waitcnt lgkmcnt(0)" ::: "memory");
}
__device__ __forceinline__ void p0_transpose_item8(const float* W, int K, int N, unsigned char* WT, LAS float* scr, int item, int lane) {
    const int nblk = N / 32, kb = item / nblk, nb = item % nblk, k0 = 64 * kb, n0 = 32 * nb;
#pragma unroll 8
    for (int i = 0; i < 32; ++i) { const int kk = 2 * i + (lane >> 5); scr[kk * 33 + (lane & 31)] = W[(size_t)(k0 + kk) * N + n0 + (lane & 31)]; }
    asm volatile("s_waitcnt lgkmcnt(0)" ::: "memory");
    const int c = lane & 7;
#pragma unroll
    for (int j = 0; j < 4; ++j) { const int n = (lane >> 3) + 8 * j; const LAS float* s = scr + (8 * c) * 33 + n; constexpr float sc = pg8::W8_SCALE;
        u32x2 o; o.x = fp8_pack4(s[0 * 33] * sc, s[1 * 33] * sc, s[2 * 33] * sc, s[3 * 33] * sc); o.y = fp8_pack4(s[4 * 33] * sc, s[5 * 33] * sc, s[6 * 33] * sc, s[7 * 33] * sc);
        *(u32x2*)(WT + (size_t)(n0 + n) * K + k0 + 8 * c) = o; }
    asm volatile("s_waitcnt lgkmcnt(0)" ::: "memory");
}
__device__ __forceinline__ void cvt8(const float* src, bf16_t* dst) {
    const f32x4 a = *(const f32x4*)src, b = *(const f32x4*)(src + 4);
    u32x4 o; o.x = pk2(a[0], a[1]); o.y = pk2(a[2], a[3]); o.z = pk2(b[0], b[1]); o.w = pk2(b[2], b[3]);
    *(u32x4*)dst = o;
}

__device__ __forceinline__ void p0_prologue(const Ctx& F0, const Args& a) {
    const Ctx F = fresh(F0);
    unsigned char* ws = a.ws;
    const int gw = F.vcu * NWAVES + F.wave, NGW = F.G * NWAVES;
    const long gt = (long)F.vcu * 512 + F.tid, NGT = (long)F.G * 512;
    {
        LAS float* red = (LAS float*)(F.lds);
        const float* c = a.in[1]; const float* cctx = a.in[3]; const float* wmod = a.in[6]; const float* bmod = a.in[7];
        float* modb = (float*)(ws + WS_MOD);
        for (int item = F.vcu; item < 96; item += F.G) {
            const int l = item / 48, nc = item % 48, n0 = nc * 128 + 2 * F.lane, kb = F.wave * 128;
            float sv[9][2];
#pragma unroll
            for (int r = 0; r < 9; ++r)
#pragma unroll
                for (int j = 0; j < 2; ++j) { const int k = kb + 64 * j + F.lane; const float v = (r < 8) ? c[r * DM + k] : cctx[k]; sv[r][j] = v / (1.0f + __expf(-v)); }
            float acc[9][2];
#pragma unroll
            for (int r = 0; r < 9; ++r) { acc[r][0] = 0.f; acc[r][1] = 0.f; }
            const float* wp = wmod + (size_t)l * DM * NMOD + (size_t)kb * NMOD + n0;
#pragma unroll
            for (int j = 0; j < 2; ++j)
#pragma unroll 8
                for (int kl = 0; kl < 64; ++kl) {
                    const f32x2 w = *(const f32x2*)(wp + (size_t)(64 * j + kl) * NMOD);
#pragma unroll
                    for (int r = 0; r < 9; ++r) { const float s = __builtin_bit_cast(float, __builtin_amdgcn_readlane(__builtin_bit_cast(int, sv[r][j]), kl)); acc[r][0] += s * w[0]; acc[r][1] += s * w[1]; }
                }
            __syncthreads();
#pragma unroll
            for (int r = 0; r < 9; ++r) { red[(F.wave * 9 + r) * 128 + 2 * F.lane] = acc[r][0]; red[(F.wave * 9 + r) * 128 + 2 * F.lane + 1] = acc[r][1]; }
            __syncthreads();
            for (int o = F.tid; o < 9 * 128; o += 512) { const int r = o >> 7, nl = o & 127; float s = 0.f;
#pragma unroll
                for (int w = 0; w < 8; ++w) s += red[(w * 9 + r) * 128 + nl];
                modb[(size_t)(l * 9 + r) * NMOD + nc * 128 + nl] = s + bmod[l * NMOD + nc * 128 + nl]; }
        }
        __syncthreads();
    }
    {
        LAS float* scr = (LAS float*)(F.lds + F.wave * 16384);
        constexpr int I_QKV = (DM / 64) * (3 * DM / 32), I_O = (DM / 64) * (DM / 32), I_PQ = (DM / 64) * (2 * DM / 32);
        constexpr int NITEMS = I_QKV + 2 * I_O + 2 * I_PQ;
        for (int it = gw; it < NITEMS; it += NGW) {
            int r = it;
            if (r < I_QKV) { p0_transpose_item8(a.in[8], DM, 3 * DM, ws + WS_WQKV, scr, r, F.lane); continue; } r -= I_QKV;
            if (r < I_O) { p0_transpose_item8(a.in[9], DM, DM, ws + WS_WO, scr, r, F.lane); continue; } r -= I_O;
            if (r < I_O) { p0_transpose_item8(a.in[11], DM, DM, ws + WS_WF, scr, r, F.lane); continue; } r -= I_O;
            if (r < I_PQ) { p0_transpose_item8(a.in[12], DM, 2 * DM, ws + WS_WPQ, scr, r, F.lane); continue; } r -= I_PQ;
            p0_transpose_item8(a.in[12] + (size_t)DM * 2 * DM, DM, 2 * DM, ws + WS_WPQ + (size_t)2 * DM * DM, scr, r, F.lane);
        }
    }
    for (long i = gt; i < 2 * 2 * 128 * 128 / 8; i += NGT) cvt8(a.in[13] + i * 8, (bf16_t*)(ws + WS_SK) + i * 8);
    {
        bf16_t* wc = (bf16_t*)(ws + WS_WC);
        for (long i = gt; i < 512 * 256 / 8; i += NGT) { const int nn = (int)(i >> 5), k0 = (int)(i & 31) * 8; float v[8];
#pragma unroll
            for (int j = 0; j < 8; ++j) { const int m = ((k0 + j) * (nn & 255)) & 255; const float fr = (float)m * (1.0f / 256.0f);
                v[j] = (nn < 256 ? __builtin_amdgcn_cosf(fr) : __builtin_amdgcn_sinf(fr)) * (1.0f / 16.0f); }
            u32x4 o; o.x = pk2(v[0], v[1]); o.y = pk2(v[2], v[3]); o.z = pk2(v[4], v[5]); o.w = pk2(v[6], v[7]);
            *(u32x4*)(wc + i * 8) = o; }
        unsigned char* cs = ws + WS_CS;
        for (long i = gt; i < 2048L * 8192 / 8; i += NGT) { const int np = (int)(i >> 10), c0 = (int)(i & 1023) * 8; const int part = c0 >> 12; float v[8];
#pragma unroll
            for (int j = 0; j < 8; ++j) { const int n = (c0 + j) & 4095; const int m = (n * np) & 4095; const float fr = (float)m * (1.0f / 4096.0f);
                v[j] = (part == 0 ? __builtin_amdgcn_cosf(fr) : -__builtin_amdgcn_sinf(fr)) * (pg8::CS_SCALE / 64.0f); }
            u32x2 o; o.x = fp8_pack4(v[0], v[1], v[2], v[3]); o.y = fp8_pack4(v[4], v[5], v[6], v[7]);
            *(u32x2*)(cs + i * 8) = o; }
    }
}

__device__ __forceinline__ unsigned fp4_pack8(const float* v, float sc) {
    unsigned w = 0;
#define FP4C(i) fminf(fmaxf(v[i] * sc, -6.f), 6.f)
    w = __builtin_amdgcn_cvt_scalef32_pk_fp4_f32(w, FP4C(0), FP4C(1), 1.0f, 0);
    w = __builtin_amdgcn_cvt_scalef32_pk_fp4_f32(w, FP4C(2), FP4C(3), 1.0f, 1);
    w = __builtin_amdgcn_cvt_scalef32_pk_fp4_f32(w, FP4C(4), FP4C(5), 1.0f, 2);
    w = __builtin_amdgcn_cvt_scalef32_pk_fp4_f32(w, FP4C(6), FP4C(7), 1.0f, 3);
#undef FP4C
    return w;
}
#define FP4_DEC(w, bs) __builtin_amdgcn_cvt_scalef32_pk_f32_fp4((w), 1.0f, (bs))
__device__ __forceinline__ unsigned i8_pack4(f32x4 v, float sc) {
    const int a = (int)rintf(fminf(fmaxf(v[0] * sc, -127.f), 127.f)), b = (int)rintf(fminf(fmaxf(v[1] * sc, -127.f), 127.f));
    const int c = (int)rintf(fminf(fmaxf(v[2] * sc, -127.f), 127.f)), d = (int)rintf(fminf(fmaxf(v[3] * sc, -127.f), 127.f));
    return (unsigned)(a & 0xff) | ((unsigned)(b & 0xff) << 8) | ((unsigned)(c & 0xff) << 16) | ((unsigned)(d & 0xff) << 24);
}
constexpr long TC_PER = (long)NEXP * DM / 16, TC_TOTAL = 4 * TC_PER;
__device__ __forceinline__ void tc_issue(const Args& a, long i, f32x4 (&v)[4]) {
    const int q = (int)(i / TC_PER); const long r = i - (long)q * TC_PER; const int l = q >> 1, tb = q & 1;
    const int e = (int)(r >> 6), c16 = (int)(r & 63);
    const float* src = (tb ? a.in[15] : a.in[14]) + ((size_t)l * NEXP + e) * DM + c16 * 16;
#pragma unroll
    for (int d = 0; d < 4; ++d) v[d] = *(const f32x4*)(src + 4 * d);
}
__device__ __forceinline__ void tc_finish(const Args& a, long i, const f32x4 (&v)[4]) {
    const int q = (int)(i / TC_PER); const long r = i - (long)q * TC_PER; const int l = q >> 1, tb = q & 1;
    const int e = (int)(r >> 6), c16 = (int)(r & 63);
    const float sc = tb ? V_SCALE : U_SCALE;
    u32x2 o;
#pragma unroll
    for (int d = 0; d < 2; ++d) { const float v8[8] = {v[2 * d][0], v[2 * d][1], v[2 * d][2], v[2 * d][3], v[2 * d + 1][0], v[2 * d + 1][1], v[2 * d + 1][2], v[2 * d + 1][3]};
        o[d] = fp4_pack8(v8, sc); }
    *(u32x2*)(a.ws + WS_TAB + (size_t)l * TAB_LAYER + (tb ? TAB_VOFF : 0) + ((size_t)(c16 >> 4) * NEXP + e) * 128 + (c16 & 15) * 8) = o;
}
__device__ __forceinline__ void table_convert(const Ctx& F0, const Args& a, int sh0, int nsh, int nshare) {
    const Ctx F = fresh(F0);
    constexpr long PER = (long)NEXP * DM / 16;
    constexpr long TOTAL = 4 * PER;
    unsigned char* t8 = a.ws + WS_TAB;
    const long per_share = (TOTAL + nshare - 1) / nshare;
    const long i0 = (long)sh0 * per_share, i1 = min((long)(sh0 + nsh) * per_share, TOTAL);
    for (long i = i0 + F.tid; i < i1; i += 512) {
        const int q = (int)(i / PER); const long r = i - (long)q * PER; const int l = q >> 1, tb = q & 1;
        const int e = (int)(r >> 6), c16 = (int)(r & 63);
        const float* src = (tb ? a.in[15] : a.in[14]) + ((size_t)l * NEXP + e) * DM + c16 * 16;
        if (tb) {
            u32x2 o;
#pragma unroll
            for (int d = 0; d < 2; ++d) { const f32x4 va = *(const f32x4*)(src + 8 * d), vb = *(const f32x4*)(src + 8 * d + 4);
                const float v8[8] = {va[0], va[1], va[2], va[3], vb[0], vb[1], vb[2], vb[3]};
                o[d] = fp4_pack8(v8, V_SCALE); }
            *(u32x2*)(t8 + (size_t)l * TAB_LAYER + TAB_VOFF + ((size_t)(c16 >> 4) * NEXP + e) * 128 + (c16 & 15) * 8) = o;
        } else {
            u32x2 o;
#pragma unroll
            for (int d = 0; d < 2; ++d) { const f32x4 va = *(const f32x4*)(src + 8 * d), vb = *(const f32x4*)(src + 8 * d + 4);
                const float v8[8] = {va[0], va[1], va[2], va[3], vb[0], vb[1], vb[2], vb[3]};
                o[d] = fp4_pack8(v8, U_SCALE); }
            *(u32x2*)(t8 + (size_t)l * TAB_LAYER + ((size_t)(c16 >> 4) * NEXP + e) * 128 + (c16 & 15) * 8) = o;
        }
    }
}

__device__ __forceinline__ const float* norm_src(const Args& a, int mode, int m) { return (m < ML) ? ((mode == 0 ? a.in[0] : a.out) + (size_t)m * DM) : (a.in[2] + (size_t)(m - ML) * DM); }
__device__ __forceinline__ void norm_phase(const Ctx& F0, const Args& a, int mode, int layer, int off, const float* gw) {
    const Ctx F = fresh(F0);
    const int gwv = F.vcu * NWAVES + F.wave, NGW = F.G * NWAVES, lane = F.lane;
    const float* modb = (const float*)(a.ws + WS_MOD) + (size_t)layer * 9 * NMOD;
    bf16_t* hx = (bf16_t*)(a.ws + WS_HX);
    const int nrows = (mode == 0) ? MT : ML;
    f32x4 gv[4];
#pragma unroll
    for (int j = 0; j < 4; ++j) gv[j] = ((const f32x4*)gw)[lane + 64 * j];
    const u32x2* XBr = (const u32x2*)(a.ws + WS_XB);
    f32x4 v[4], vn[4]; u32x2 vr[4];
    if (gwv < nrows) {
        if (mode == 0) { const f32x4* xr = (const f32x4*)norm_src(a, mode, gwv) + lane;
#pragma unroll
            for (int j = 0; j < 4; ++j) vn[j] = xr[64 * j]; }
        else {
#pragma unroll
            for (int j = 0; j < 4; ++j) vr[j] = XBr[(size_t)gwv * 256 + lane + 64 * j]; } }
    for (int m = gwv; m < nrows; m += NGW) {
        const int mn = (m + NGW < nrows) ? m + NGW : m;
        if (mode == 0) {
#pragma unroll
            for (int j = 0; j < 4; ++j) v[j] = vn[j];
            const f32x4* xr = (const f32x4*)norm_src(a, mode, mn) + lane;
#pragma unroll
            for (int j = 0; j < 4; ++j) vn[j] = xr[64 * j];
        } else {
#pragma unroll
            for (int j = 0; j < 4; ++j) v[j] = bf4_f32(vr[j]);
#pragma unroll
            for (int j = 0; j < 4; ++j) vr[j] = XBr[(size_t)mn * 256 + lane + 64 * j];
        }
        const float* mr = modb + (size_t)((m < ML) ? (m >> 12) : 8) * NMOD + off;
        f32x4 av[4], cv[4];
#pragma unroll
        for (int j = 0; j < 4; ++j) { av[j] = ((const f32x4*)mr)[lane + 64 * j]; cv[j] = ((const f32x4*)(mr + DM))[lane + 64 * j]; }
        float s = 0.f;
#pragma unroll
        for (int j = 0; j < 4; ++j) s += (v[j].x * v[j].x + v[j].y * v[j].y) + (v[j].z * v[j].z + v[j].w * v[j].w);
        const float rstd = 1.0f / sqrtf(wave_sum(s) * (1.0f / DM) + EPS);
        unsigned long long* o8 = (unsigned long long*)(hx + (size_t)m * DM) + lane;
        unsigned* o4 = (unsigned*)(a.ws + WS_HX + (size_t)m * DM) + lane;
#pragma unroll
        for (int j = 0; j < 4; ++j) { const f32x4 y = (v[j] * rstd * gv[j]) * (cv[j] + 1.0f) + av[j];
            if (mode == 0 || off == 3 * DM) o4[64 * j] = fp8_pack4(y.x * pg8::ACT8_SCALE, y.y * pg8::ACT8_SCALE, y.z * pg8::ACT8_SCALE, y.w * pg8::ACT8_SCALE);
            if (mode == 0) continue;
            if (off != 3 * DM)
            o8[64 * j] = (unsigned long long)cvtpk(y.x, y.y) | ((unsigned long long)cvtpk(y.z, y.w) << 32);
            if (off == 3 * DM) {
                const float q0 = fminf(fmaxf(y.x * XQ_SCALE, -6.f), 6.f), q1 = fminf(fmaxf(y.y * XQ_SCALE, -6.f), 6.f), q2 = fminf(fmaxf(y.z * XQ_SCALE, -6.f), 6.f), q3 = fminf(fmaxf(y.w * XQ_SCALE, -6.f), 6.f);
                unsigned ph = __builtin_amdgcn_cvt_scalef32_pk_fp4_f32(0u, q0, q1, 1.0f, 0); ph = __builtin_amdgcn_cvt_scalef32_pk_fp4_f32(ph, q2, q3, 1.0f, 1);
                const f32x2 d0 = FP4_DEC(ph, 0), d1 = FP4_DEC(ph, 1);
                unsigned pl = __builtin_amdgcn_cvt_scalef32_pk_fp4_f32(0u, 4.f * (q0 - d0.x), 4.f * (q1 - d0.y), 1.0f, 0); pl = __builtin_amdgcn_cvt_scalef32_pk_fp4_f32(pl, 4.f * (q2 - d1.x), 4.f * (q3 - d1.y), 1.0f, 1);
                unsigned short* xq = (unsigned short*)(a.ws + WS_X8 + ((size_t)j * ML + m) * 256) + lane;
                xq[0] = (unsigned short)(ph & 0xffffu); xq[64] = (unsigned short)(pl & 0xffffu); } }
    }
}
__device__ __forceinline__ void final_norm_phase(const Ctx& F0, const Args& a) {
    const Ctx F = fresh(F0);
    const int gwv = F.vcu * NWAVES + F.wave, NGW = F.G * NWAVES;
    const float* gw = a.in[16];
    const u32x2* XBr = (const u32x2*)(a.ws + WS_XB);
    f32x4 gv[4]; u32x2 vr[4];
#pragma unroll
    for (int j = 0; j < 4; ++j) gv[j] = ((const f32x4*)gw)[F.lane + 64 * j];
    if (gwv < ML) {
#pragma unroll
        for (int j = 0; j < 4; ++j) vr[j] = XBr[(size_t)gwv * 256 + F.lane + 64 * j]; }
    for (int m = gwv; m < ML; m += NGW) {
        f32x4* xr = (f32x4*)(a.out + (size_t)m * DM) + F.lane;
        f32x4 v[4]; float s = 0.f;
#pragma unroll
        for (int j = 0; j < 4; ++j) { v[j] = bf4_f32(vr[j]); s += (v[j].x * v[j].x + v[j].y * v[j].y) + (v[j].z * v[j].z + v[j].w * v[j].w); }
        { const int mn = (m + NGW < ML) ? m + NGW : m;
#pragma unroll
          for (int j = 0; j < 4; ++j) vr[j] = XBr[(size_t)mn * 256 + F.lane + 64 * j]; }
        const float rstd = 1.0f / sqrtf(wave_sum(s) * (1.0f / DM) + EPS);
#pragma unroll
        for (int j = 0; j < 4; ++j) xr[64 * j] = v[j] * rstd * gv[j];
    }
}

constexpr int ATT_ROWB = 144, ATT_KTILEB = 128 * ATT_ROWB, ATT_VROWB = 272, ATT_VTILEB = 64 * ATT_VROWB, ATT_BIAS_B = 2048, ATT_K0 = ATT_BIAS_B, ATT_V0 = ATT_K0 + 2 * ATT_KTILEB;
constexpr float ATT_THR = 8.0f;
template <int NGH, bool LATENT>
__device__ __forceinline__ void attn_sub(const LAS unsigned char* Kt, const LAS unsigned char* Vt_, int ko, const LAS float* browA, const LAS float* browB, const int (&relidx)[8],
                                         const bf16x8 (&qf)[2], float& m_ref, float& l_run, f32x4 (&o)[4], int q16, int g4) {
    constexpr int NG = 2 * NGH;
    bf16x8 kf[2 * NG][2]; u32x2 vf[4][NG][2]; f32x4 sc[2 * NG];
#pragma unroll
    for (int gk = 0; gk < NG; ++gk)
#pragma unroll
        for (int b2 = 0; b2 < 2; ++b2)
#pragma unroll
            for (int ks = 0; ks < 2; ++ks) kf[2 * gk + b2][ks] = *(const LAS bf16x8*)(Kt + ((gk / NGH) * 64 + ko + 32 * (gk % NGH) + 16 * b2 + q16) * ATT_ROWB + 64 * ks + 16 * g4);
#pragma unroll
    for (int d = 0; d < 4; ++d)
#pragma unroll
        for (int gk = 0; gk < NG; ++gk) { const LAS unsigned char* vp = Vt_ + (16 * d + q16) * ATT_VROWB + 2 * ((gk / NGH) * 64 + ko + 32 * (gk % NGH) + 4 * g4);
            vf[d][gk][0] = *(const LAS u32x2*)vp; vf[d][gk][1] = *(const LAS u32x2*)(vp + 32); }
    if (LATENT) {
#pragma unroll
        for (int kk = 0; kk < 8; ++kk) { sc[kk >> 2][kk & 3] = browA[relidx[kk]] - m_ref; sc[2 + (kk >> 2)][kk & 3] = browB[relidx[kk]] - m_ref; }
    } else {
#pragma unroll
        for (int blk = 0; blk < 2 * NG; ++blk) sc[blk] = (f32x4){-m_ref, -m_ref, -m_ref, -m_ref};
    }
#pragma unroll
    for (int blk = 0; blk < 2 * NG; ++blk)
#pragma unroll
        for (int ks = 0; ks < 2; ++ks) sc[blk] = __builtin_amdgcn_mfma_f32_16x16x32_bf16(kf[blk][ks], qf[ks], sc[blk], 0, 0, 0);
    float mx = fmaxf(fmaxf(sc[0][0], sc[0][1]), fmaxf(sc[0][2], sc[0][3]));
#pragma unroll
    for (int blk = 1; blk < 2 * NG; ++blk) mx = fmaxf(mx, fmaxf(fmaxf(sc[blk][0], sc[blk][1]), fmaxf(sc[blk][2], sc[blk][3])));
    if (__builtin_amdgcn_ballot_w64(mx > ATT_THR) != 0ull) {
        mx = fmaxf(mx, __shfl_xor(mx, 16)); mx = fmaxf(mx, __shfl_xor(mx, 32));
        const float dl = mx > ATT_THR ? mx : 0.f;
        m_ref += dl;
        const float al = __builtin_amdgcn_exp2f(-dl);
        l_run *= al;
#pragma unroll
        for (int d = 0; d < 4; ++d) o[d] *= al;
#pragma unroll
        for (int blk = 0; blk < 2 * NG; ++blk) sc[blk] -= dl;
    }
    float ls0 = 0.f, ls1 = 0.f;
#pragma unroll
    for (int blk = 0; blk < 2 * NG; ++blk)
#pragma unroll
        for (int i = 0; i < 4; ++i) { const float e = __builtin_amdgcn_exp2f(sc[blk][i]); sc[blk][i] = e; if (blk & 1) ls1 += e; else ls0 += e; }
    l_run += ls0 + ls1;
    bf16x8 pf[NG];
#pragma unroll
    for (int gk = 0; gk < NG; ++gk) { u32x4 pw; pw.x = cvtpk(sc[2 * gk][0], sc[2 * gk][1]); pw.y = cvtpk(sc[2 * gk][2], sc[2 * gk][3]); pw.z = cvtpk(sc[2 * gk + 1][0], sc[2 * gk + 1][1]); pw.w = cvtpk(sc[2 * gk + 1][2], sc[2 * gk + 1][3]);
        pf[gk] = __builtin_bit_cast(bf16x8, pw); }
#pragma unroll
    for (int gk = 0; gk < NG; ++gk)
#pragma unroll
        for (int d = 0; d < 4; ++d) { u32x4 vw; vw.x = vf[d][gk][0].x; vw.y = vf[d][gk][0].y; vw.z = vf[d][gk][1].x; vw.w = vf[d][gk][1].y;
            o[d] = __builtin_amdgcn_mfma_f32_16x16x32_bf16(__builtin_bit_cast(bf16x8, vw), pf[gk], o[d], 0, 0, 0); }
}
__device__ __forceinline__ void attn_phase(const Ctx& F0, const Args& a) {
    const Ctx F = fresh(F0);
    const bf16_t* QK = (const bf16_t*)(a.ws + WS_QK);
    const bf16_t* VT = (const bf16_t*)(a.ws + WS_VT);
    unsigned char* AO = a.ws + WS_HX + 36 * MiB;
    const float* rpb = a.in[10];
    LAS float* bias = (LAS float*)F.lds;
    const int tid = F.tid, lane = F.lane, q16 = lane & 15, g4 = lane >> 4;
    const int rr = F.wave >> 2, jt = F.wave & 3;
    const int qc = 16 * jt + q16, cs = min(max(qc - 8, 0), 48), ksj = min(max(16 * jt - 8, 0), 32);
    int relidx[8];
#pragma unroll
    for (int k = 0; k < 8; ++k) { const int kc = ksj + 16 * (k >> 2) + 4 * g4 + (k & 3); relidx[k] = (kc >= cs && kc < cs + 16) ? (kc - qc + 15) : 31; }
    const int krow = tid >> 3, kch = tid & 7, vrow = tid >> 4, vch = tid & 15;
    const unsigned lds_k = (unsigned)(krow * ATT_ROWB + kch * 16), lds_v = (unsigned)(vrow * ATT_VROWB + vch * 16);
    const int nunits = NB * 16 * 32, upb = (nunits + F.G - 1) / F.G;
    int cur_bh = -1;
    for (int k = 0; k < upb; ++k) {
        const int id = F.vcu * upb + k; if (id >= nunits) break;
        const int p = id & 31, bh = id >> 5, b = bh >> 4, h = bh & 15;
        if (bh != cur_bh) {
            __syncthreads();
            for (int i = tid; i < 16 * 32; i += 512) { const int dr = i >> 5, dc = i & 31; bias[i] = (dc < 31 && dr < 15) ? rpb[(h * 15 + dr) * 31 + dc] * LOG2E : -1e30f; }
            cur_bh = bh;
        }
        const int r0 = 2 * p, rs0 = min(max(r0 - 4, 0), 56), rs1 = min(max(r0 + 1 - 4, 0), 56);
        const int nlat = rs1 + 8 - rs0, nlt = (nlat + 1) >> 1, nsteps = nlt + 2;
        const int r = r0 + rr, rs = rr ? rs1 : rs0;
        const long tokq = (long)b * SEQ + r * GW + qc;
        const bf16_t* kbase = QK + 1024 + h * 64 + kch * 8;
        const bf16_t* vbase = VT + (long)(h * 64 + vrow) * MT + (vch & 7) * 8;
#define ATT_TOKA(step) ((step) < nlt ? ((long)b * SEQ + (long)(rs0 + 2 * (step)) * GW) : ((long)ML + b * CTXL + ((step) - nlt) * 128))
#define ATT_TOKB(step) ((step) < nlt ? ((long)b * SEQ + (long)min(rs0 + 2 * (step) + 1, rs0 + nlat - 1) * GW) : ((long)ML + b * CTXL + ((step) - nlt) * 128 + 64))
        u32x4 kA[2], vA[2], kB[2], vB[2];
#define ATT_LOAD(step, kr_, vr_) do { const int st_ = (step) < nsteps ? (step) : nsteps - 1; const long ta_ = ATT_TOKA(st_), tb_ = ATT_TOKB(st_);     \
        kr_[0] = *(const u32x4*)(kbase + (ta_ + krow) * 2048); kr_[1] = *(const u32x4*)(kbase + (tb_ + krow) * 2048); \
        const long tv_ = (vch < 8) ? ta_ : tb_; vr_[0] = *(const u32x4*)(vbase + tv_); vr_[1] = *(const u32x4*)(vbase + (long)32 * MT + tv_); } while (0)
#define ATT_WRITE(buf, kr_, vr_) do { *(LAS u32x4*)(F.lds + ATT_K0 + (buf) * ATT_KTILEB + lds_k) = kr_[0]; *(LAS u32x4*)(F.lds + ATT_K0 + (buf) * ATT_KTILEB + 64 * ATT_ROWB + lds_k) = kr_[1]; \
        *(LAS u32x4*)(F.lds + ATT_V0 + (buf) * ATT_VTILEB + lds_v) = vr_[0]; *(LAS u32x4*)(F.lds + ATT_V0 + (buf) * ATT_VTILEB + 32 * ATT_VROWB + lds_v) = vr_[1]; } while (0)
        ATT_LOAD(0, kA, vA); ATT_LOAD(1, kB, vB);
        f32x4 tcv0[4], tcv1[4];
        const int tci0 = (id * 2) * 512 + tid;
        tc_issue(a, tci0, tcv0); tc_issue(a, tci0 + 512, tcv1);
        bf16x8 qf[2];
#pragma unroll
        for (int ks = 0; ks < 2; ++ks) qf[ks] = *(const bf16x8*)(QK + tokq * 2048 + h * 64 + 32 * ks + 8 * g4);
        float m_ref = 0.f, l_run = 0.f;
        f32x4 o[4];
#pragma unroll
        for (int d = 0; d < 4; ++d) o[d] = (f32x4){0.f, 0.f, 0.f, 0.f};
        __syncthreads();
        ATT_WRITE(0, kA, vA);
        asm volatile("" :: "v"(qf[0]), "v"(qf[1]));
        __syncthreads();
#define ATT_COMPUTE(step, cur) do { \
            const LAS unsigned char* Kt = F.lds + ATT_K0 + (cur) * ATT_KTILEB; \
            const LAS unsigned char* Vt_ = F.lds + ATT_V0 + (cur) * ATT_VTILEB; \
            if ((step) < nlt) { const int krA = rs0 + 2 * (step), krB = krA + 1; \
                const bool actA = krA >= rs && krA < rs + 8, actB = krB < rs0 + nlat && krB >= rs && krB < rs + 8; \
                if (actA || actB) attn_sub<1, true>(Kt, Vt_, ksj, bias + (actA ? (krA - r + 7) : 15) * 32, bias + (actB ? (krB - r + 7) : 15) * 32, relidx, qf, m_ref, l_run, o, q16, g4); \
            } else attn_sub<2, false>(Kt, Vt_, 0, bias, bias, relidx, qf, m_ref, l_run, o, q16, g4); \
        } while (0)
        for (int step = 0; step < nsteps; step += 2) {
            ATT_COMPUTE(step, 0);
            if (step + 1 < nsteps) ATT_WRITE(1, kB, vB);
            ATT_LOAD(step + 2, kA, vA);
            __syncthreads();
            if (step + 1 < nsteps) { ATT_COMPUTE(step + 1, 1); }
            if (step + 2 < nsteps) ATT_WRITE(0, kA, vA);
            ATT_LOAD(step + 3, kB, vB);
            __syncthreads();
        }
#undef ATT_LOAD
#undef ATT_WRITE
#undef ATT_COMPUTE
#undef ATT_TOKA
#undef ATT_TOKB
        { int ti_ = (id * 2) * 512 + tid; asm volatile("" : "+v"(ti_));
          tc_finish(a, ti_, tcv0); tc_finish(a, ti_ + 512, tcv1); }
        l_run += __shfl_xor(l_run, 16); l_run += __shfl_xor(l_run, 32);
        const float linv = 1.0f / l_run;
        unsigned char* op = AO + tokq * DM + h * 64 + 4 * g4; const float ls = linv * pg8::ACT8_SCALE;
#pragma unroll
        for (int d = 0; d < 4; ++d) *(unsigned*)(op + 16 * d) = fp8_pack4(o[d][0] * ls, o[d][1] * ls, o[d][2] * ls, o[d][3] * ls);
    }
    __syncthreads();
}

__device__ __forceinline__ void ce_desc(float& a, float& b) { const float hi = fmaxf(a, b), lo = fminf(a, b); a = hi; b = lo; }
__device__ __forceinline__ void ce_dir(float& a, float& b, bool desc) { const float hi = fmaxf(a, b), lo = fminf(a, b); a = desc ? hi : lo; b = desc ? lo : hi; }
__device__ __forceinline__ void sort16_desc(float (&v)[16]) {
#define S16CE(i, j) { const float hi_ = fmaxf(v[i], v[j]), lo_ = fminf(v[i], v[j]); v[i] = hi_; v[j] = lo_; }
    S16CE(0,13) S16CE(1,12) S16CE(2,15) S16CE(3,14) S16CE(4,8) S16CE(5,6) S16CE(7,11) S16CE(9,10)
    S16CE(0,5) S16CE(1,7) S16CE(2,9) S16CE(3,4) S16CE(6,13) S16CE(8,14) S16CE(10,15) S16CE(11,12)
    S16CE(0,1) S16CE(2,3) S16CE(4,5) S16CE(6,8) S16CE(7,9) S16CE(10,11) S16CE(12,13) S16CE(14,15)
    S16CE(0,2) S16CE(1,3) S16CE(4,10) S16CE(5,11) S16CE(6,7) S16CE(8,9) S16CE(12,14) S16CE(13,15)
    S16CE(1,2) S16CE(3,12) S16CE(4,6) S16CE(5,7) S16CE(8,10) S16CE(9,11) S16CE(13,14)
    S16CE(1,4) S16CE(2,6) S16CE(5,8) S16CE(7,10) S16CE(9,13) S16CE(11,14)
    S16CE(2,4) S16CE(3,6) S16CE(9,12) S16CE(11,13)
    S16CE(3,5) S16CE(6,8) S16CE(7,9) S16CE(10,12)
    S16CE(3,4) S16CE(5,6) S16CE(7,8) S16CE(9,10) S16CE(11,12)
    S16CE(6,7) S16CE(8,9)
#undef S16CE
}
__device__ __forceinline__ void merge16_desc(float (&a)[16], const float (&b)[16]) {
#pragma unroll
    for (int i = 0; i < 16; ++i) a[i] = fmaxf(a[i], b[15 - i]);
#pragma unroll
    for (int j = 8; j > 0; j >>= 1)
#pragma unroll
        for (int i = 0; i < 16; ++i) { const int l = i ^ j; if (l > i) ce_desc(a[i], a[l]); }
}

struct CandTab { int i[64]; int j[64]; };
__host__ __device__ constexpr CandTab make_cand_tab() {
    CandTab t{}; int n = 0;
    for (int i = 0; i < 16; ++i) for (int j = 0; j < 16; ++j) if ((i + 1) * (j + 1) <= 16) { t.i[n] = i; t.j[n] = j; ++n; }
    for (; n < 64; ++n) { t.i[n] = -1; t.j[n] = -1; }
    return t;
}

__device__ __forceinline__ void peer_topk_phase(const Ctx& F0, const Args& a, int layer) {
    const Ctx F = fresh(F0);
    const bf16_t* QP = (const bf16_t*)(a.ws + WS_QK);
    const bf16_t* SK = (const bf16_t*)(a.ws + WS_SK) + (size_t)layer * 2 * 128 * 128;
    unsigned short* IDX = (unsigned short*)(a.ws + WS_IDX);
    float* GATE = (float*)(a.ws + WS_GATE);
    const int gwv = F.vcu * NWAVES + F.wave, NGW = F.G * NWAVES;
    const int lane = F.lane, t32 = lane & 31, hi = lane >> 5;
    __syncthreads();
    for (int c = F.tid; c < 4096; c += 512) *(LAS u32x4*)(F.lds + (c >> 4) * 272 + (c & 15) * 16) = *(const u32x4*)(SK + (size_t)c * 8);
    __syncthreads();
#define TK_LDQ(dst, task_, p_) do { const int tk_ = (task_) < 1024 * 8 ? (task_) : 1024 * 8 - 1; const bf16_t* qp_ = QP + ((long)(tk_ >> 3) * 32 + t32) * 2048 + (tk_ & 7) * 256 + (p_) * 128 + hi * 8; \
        _Pragma("unroll") for (int ks = 0; ks < 8; ++ks) dst[ks] = *(const bf16x8*)(qp_ + ks * 16); } while (0)
    bf16x8 qn[8];
    TK_LDQ(qn, gwv, 0);
    for (int task = gwv; task < 1024 * 8; task += NGW) {
        const int tt = task >> 3, h = task & 7;
        const long tok = (long)tt * 32 + t32;
        float top[2][16];
#pragma unroll
        for (int p = 0; p < 2; ++p) {
            bf16x8 qc[8];
#pragma unroll
            for (int ks = 0; ks < 8; ++ks) qc[ks] = qn[ks];
            if (p == 0) TK_LDQ(qn, task, 1); else TK_LDQ(qn, task + NGW, 0);
            f32x16 acc[4];
#pragma unroll
            for (int eb = 0; eb < 4; ++eb)
#pragma unroll
                for (int i = 0; i < 16; ++i) acc[eb][i] = 0.f;
#pragma unroll
            for (int eb = 0; eb < 4; ++eb) asm volatile("" : "+v"(acc[eb]));
            const LAS unsigned char* kp = F.lds + (p * 128 + t32) * 272 + hi * 16;
#pragma unroll
            for (int ks = 0; ks < 8; ++ks) {
                if ((ks & 1) == 0) asm volatile("" ::: "memory");
                const bf16x8 bq = qc[ks];
#pragma unroll
                for (int eb = 0; eb < 4; ++eb) { const bf16x8 ak = *(const LAS bf16x8*)(kp + eb * 32 * 272 + ks * 32); acc[eb] = __builtin_amdgcn_mfma_f32_32x32x16_bf16(ak, bq, acc[eb], 0, 0, 0); }
            }
            float cur[16];
#pragma unroll
            for (int eb = 0; eb < 4; ++eb) {
                float v[16];
#pragma unroll
                for (int i = 0; i < 16; ++i) { const unsigned e = 32 * eb + crow(i, hi); float x = acc[eb][i]; asm volatile("" : "+v"(x));
                    v[i] = __builtin_bit_cast(float, (__builtin_bit_cast(unsigned, x) & ~0x7Fu) | e); }
                sort16_desc(v);
                if (eb == 0) {
#pragma unroll
                    for (int i = 0; i < 16; ++i) cur[i] = v[i];
                } else merge16_desc(cur, v);
            }
            float oth[16];
#pragma unroll
            for (int i = 0; i < 16; ++i) oth[i] = __shfl_xor(cur[i], 32);
            merge16_desc(cur, oth);
#pragma unroll
            for (int i = 0; i < 16; ++i) top[p][i] = cur[i];
            __builtin_amdgcn_sched_barrier(0);
        }
        float best[16];
#pragma unroll
        for (int gI = 0; gI < 4; ++gI) {
            float v[16];
#pragma unroll
            for (int q = 0; q < 16; ++q) {
                constexpr CandTab CT = make_cand_tab();
                const int ci = CT.i[16 * gI + q], cj = CT.j[16 * gI + q];
                if (ci >= 0) {
                    const unsigned ua = __builtin_bit_cast(unsigned, top[0][ci]), ub = __builtin_bit_cast(unsigned, top[1][cj]);
                    float s = top[0][ci] + top[1][cj]; asm volatile("" : "+v"(s));
                    const unsigned code = ((ua & 0x7Fu) << 7) | (ub & 0x7Fu);
                    v[q] = __builtin_bit_cast(float, (__builtin_bit_cast(unsigned, s) & ~0x3FFFu) | code);
                } else v[q] = -3.0e38f;
            }
            sort16_desc(v);
            if (gI == 0) {
#pragma unroll
                for (int i = 0; i < 16; ++i) best[i] = v[i];
            } else merge16_desc(best, v);
            __builtin_amdgcn_sched_barrier(0);
        }
        float e[16], sum = 0.f;
#pragma unroll
        for (int i = 0; i < 16; ++i) { e[i] = __builtin_amdgcn_exp2f((best[i] - best[0]) * LOG2E); sum += e[i]; }
        const float inv = 1.0f / sum;
        if (hi == 0) {
            u32x4 w0, w1;
            w0.x = (__builtin_bit_cast(unsigned, best[0]) & 0x3FFFu) | ((__builtin_bit_cast(unsigned, best[1]) & 0x3FFFu) << 16);
            w0.y = (__builtin_bit_cast(unsigned, best[2]) & 0x3FFFu) | ((__builtin_bit_cast(unsigned, best[3]) & 0x3FFFu) << 16);
            w0.z = (__builtin_bit_cast(unsigned, best[4]) & 0x3FFFu) | ((__builtin_bit_cast(unsigned, best[5]) & 0x3FFFu) << 16);
            w0.w = (__builtin_bit_cast(unsigned, best[6]) & 0x3FFFu) | ((__builtin_bit_cast(unsigned, best[7]) & 0x3FFFu) << 16);
            w1.x = (__builtin_bit_cast(unsigned, best[8]) & 0x3FFFu) | ((__builtin_bit_cast(unsigned, best[9]) & 0x3FFFu) << 16);
            w1.y = (__builtin_bit_cast(unsigned, best[10]) & 0x3FFFu) | ((__builtin_bit_cast(unsigned, best[11]) & 0x3FFFu) << 16);
            w1.z = (__builtin_bit_cast(unsigned, best[12]) & 0x3FFFu) | ((__builtin_bit_cast(unsigned, best[13]) & 0x3FFFu) << 16);
            w1.w = (__builtin_bit_cast(unsigned, best[14]) & 0x3FFFu) | ((__builtin_bit_cast(unsigned, best[15]) & 0x3FFFu) << 16);
            u32x4* ip = (u32x4*)(IDX + tok * 128 + h * 16);
            ip[0] = w0; ip[1] = w1;
        } else {
            f32x4* gp = (f32x4*)(GATE + tok * 128 + h * 16);
#pragma unroll
            for (int q = 0; q < 4; ++q) gp[q] = (f32x4){e[4 * q] * inv, e[4 * q + 1] * inv, e[4 * q + 2] * inv, e[4 * q + 3] * inv};
        }
    }
#undef TK_LDQ
    __syncthreads();
}

typedef long i64_t;
typedef unsigned u32x8_t __attribute__((ext_vector_type(8)));
typedef _Float16 h2_t __attribute__((ext_vector_type(2)));
#define U_MFMA4_FIRST(acc, av, bv) asm volatile("v_mfma_scale_f32_16x16x128_f8f6f4 %0, %1, %2, 0, %3, %4 op_sel_hi:[0,0,0] cbsz:4 blgp:4" : "=&v"(acc) : "v"(av), "v"(bv), "v"(sc_a), "v"(sc_one))
#define U_MFMA4(acc, av, bv) asm volatile("v_mfma_scale_f32_16x16x128_f8f6f4 %0, %1, %2, %0, %3, %4 op_sel_hi:[0,0,0] cbsz:4 blgp:4" : "+v"(acc) : "v"(av), "v"(bv), "v"(sc_a), "v"(sc_one))
template <int UVAR = 0>
__device__ __forceinline__ void peer_u_phase(const Ctx& F0, const Args& a, int layer) {
    const Ctx F = fresh(F0);
    const int s = (int)(blockIdx.x & 3), half = (int)((blockIdx.x >> 2) & 1), j = (int)(blockIdx.x >> 3), nmem = F.G >> 3;
    const unsigned char* U4s = a.ws + WS_TAB + (size_t)layer * TAB_LAYER + (size_t)s * NEXP * 128;
    const unsigned* XQ = (const unsigned*)(a.ws + WS_X8 + (size_t)s * ML * 256);
    const unsigned short* IDX = (const unsigned short*)(a.ws + WS_IDX);
    unsigned* PART = (unsigned*)(a.ws + WS_PART) + (size_t)s * ML * 64;
    const int lane = F.lane, rsub = lane >> 3, c8 = lane & 7, n16 = lane & 15, g4 = lane >> 4;
    LAS unsigned char* tile = F.lds + F.wave * 16384;
    constexpr float osc = 1.0f / (U_SCALE * XQ_SCALE);
    constexpr int MLH = ML / 2;
    const int t0 = half * MLH + j * NWAVES + F.wave, stride = nmem * NWAVES, ntok = (half * MLH + MLH - t0 + stride - 1) / stride;
    unsigned sc_one = 0x7f7f7f7fu; asm volatile("" : "+v"(sc_one));
    unsigned sc_a = (n16 & 1) ? 0x7d7d7d7du : 0x7f7f7f7fu; asm volatile("" : "+v"(sc_a));
    const int abase = (32 * (n16 & 1) + 4 * g4) * 4;
#define U_TOK(i) ((size_t)(t0 + ((i) < ntok ? (i) : ntok - 1) * stride))
    const unsigned wx0 = (unsigned)(size_t)(tile + rsub * 2048 + (c8 << 4));
    const unsigned rb0 = (unsigned)(size_t)(tile + n16 * 128 + ((g4 ^ ((n16 >> 1) & 7)) << 4));
    LAS unsigned char* stg = tile + g4 * 512 + n16 * 4;
#define U_LDXQ(i) (XQ[U_TOK(i) * 64 + lane])
#define U_LDI(i) (((const unsigned*)IDX)[U_TOK(i) * 64 + lane])
#define U_IDP(dst, ci) do { _Pragma("unroll") for (int k = 0; k < 8; ++k) dst[k] = (unsigned)__builtin_amdgcn_ds_bpermute((8 * rsub + k) * 4, (int)(ci)); } while (0)
#define U_EIDP(idp, i_) (((i_) & 1) ? (idp[(i_) >> 1] >> 16) : (idp[(i_) >> 1] & 0xffffu))
#define U_READS(nb0) do { \
        _Pragma("unroll") for (int nb = 0; nb < 4; ++nb) { _Pragma("unroll") for (int ks = 0; ks < 2; ++ks) \
            bw[nb][ks] = *(const LAS u32x4*)((LAS unsigned char*)(size_t)(rb0 ^ (64u * ks)) + 2048 * ((nb0) + nb)); } \
        __builtin_amdgcn_sched_barrier(0); \
    } while (0)
#define U_MFMAS() do { \
        _Pragma("unroll") for (int nb = 0; nb < 4; ++nb) U_MFMA4_FIRST(dA[nb], aop[0], bw[nb][0]); \
        _Pragma("unroll") for (int nb = 0; nb < 4; ++nb) U_MFMA4(dA[nb], aop[1], bw[nb][1]); \
        __builtin_amdgcn_sched_barrier(0); \
    } while (0)
#define U_OUTS(nb0) do { \
        asm volatile("s_nop 15\n\ts_nop 3" : "+v"(dA[0]), "+v"(dA[1]), "+v"(dA[2]), "+v"(dA[3]) :: "memory");     \
        _Pragma("unroll") for (int nb = 0; nb < 4; ++nb) { ov[(nb0) + nb] = dA[nb][0] + dA[nb][1]; asm volatile("" : "+v"(ov[(nb0) + nb])); } \
    } while (0)
#define U_BODY(j, CUR, NXT, LD) do { \
        unsigned idp[8]; \
        U_IDP(idp, ci##NXT);                                             \
          \
        _Pragma("unroll") for (int i_ = 0; i_ < 16; ++i_) { \
            *(LAS u32x4*)((LAS unsigned char*)(size_t)(wx0 ^ (unsigned)(((i_) >> 1) << 4)) + i_ * 128) = R[i_]; \
            if (UVAR == 0 || (UVAR == 1 && i_ < 8)) R[i_] = *(const u32x4*)(U4s + (unsigned)(U_EIDP(idp, i_) * 128 + 16 * c8)); \
        } \
          \
        u32x4 aop[2]; \
        _Pragma("unroll") for (int ks = 0; ks < 2; ++ks) { _Pragma("unroll") for (int k = 0; k < 4; ++k) { \
            const unsigned w_ = (unsigned)__builtin_amdgcn_ds_bpermute(abase + (16 * ks + k) * 4, (int)cx##CUR); \
            aop[ks][k] = (n16 < 2) ? w_ : 0u; } } \
        asm volatile("s_waitcnt lgkmcnt(0)" ::: "memory");               \
        f32x4 dA[4]; u32x4 bw[4][2]; float ov[8]; \
        U_READS(0); \
        U_MFMAS(); \
          \
        ci##CUR = U_LDI((j) + 3); cx##LD = U_LDXQ((j) + 2); \
        __builtin_amdgcn_sched_barrier(0); \
        U_READS(4);                                                      \
        U_OUTS(0); \
        U_MFMAS(); \
        U_OUTS(4); \
          \
        _Pragma("unroll") for (int nb = 0; nb < 8; ++nb) *(LAS float*)(stg + nb * 64) = ov[nb]; \
        asm volatile("s_waitcnt lgkmcnt(0)" ::: "memory"); \
        const f32x2 sum = *(const LAS f32x2*)(tile + 8 * lane); \
        asm volatile("s_waitcnt lgkmcnt(0)" ::: "memory"); \
        if ((j) < ntok) PART[U_TOK(j) * 64 + lane] = cvtpk(sum.x * osc, sum.y * osc); \
    } while (0)
    u32x4 R[16];
    unsigned cxA, cxB, cxC, ciA, ciB, ciC;
    ciA = U_LDI(0);
    cxA = U_LDXQ(0); cxB = U_LDXQ(1);
    { unsigned idp0[8]; U_IDP(idp0, ciA);
#pragma unroll
      for (int i_ = 0; i_ < 16; ++i_) R[i_] = *(const u32x4*)(U4s + (unsigned)(U_EIDP(idp0, i_) * 128 + 16 * c8)); }
    ciB = U_LDI(1); ciC = U_LDI(2);
    cxC = 0u;
    asm volatile("" :: "v"(ciC));
    for (int i = 0; i < ntok; i += 3) {
        U_BODY(i, A, B, C);
        U_BODY(i + 1, B, C, A);
        U_BODY(i + 2, C, A, B);
    }
#undef U_BODY
#undef U_READS
#undef U_MFMAS
#undef U_OUTS
#undef U_LDXQ
#undef U_LDI
#undef U_IDP
#undef U_EIDP
#undef U_TOK
}
#undef U_MFMA4_FIRST
#undef U_MFMA4
__device__ __forceinline__ void peer_w_phase(const Ctx& F0, const Args& a) {
    const Ctx F = fresh(F0);
    const unsigned* PART = (const unsigned*)(a.ws + WS_PART);
    const float* GATE = (const float*)(a.ws + WS_GATE);
    unsigned char* WQ = a.ws + WS_WT;
    float* WSC = (float*)(a.ws + WS_WSC);
    const int gwv = F.vcu * NWAVES + F.wave, NGW = F.G * NWAVES;
    unsigned pn[4]; f32x2 gn;
#define W_LD(t_) do { const int tt_ = (t_) < ML ? (t_) : ML - 1; _Pragma("unroll") for (int s = 0; s < 4; ++s) pn[s] = PART[((size_t)s * ML + tt_) * 64 + F.lane]; gn = *(const f32x2*)(GATE + (size_t)tt_ * 128 + 2 * F.lane); } while (0)
    W_LD(gwv);
    for (int t = gwv; t < ML; t += NGW) {
        f32x2 z = (f32x2){0.f, 0.f};
#pragma unroll
        for (int s = 0; s < 4; ++s) z += (f32x2){bflo(pn[s]), bfhi(pn[s])};
        const f32x2 g = gn;
        W_LD(t + NGW);
        f32x2 w; w.x = g.x * gelu_erf(z.x); w.y = g.y * gelu_erf(z.y);
        float wm = fmaxf(__builtin_fabsf(w.x), __builtin_fabsf(w.y));
#pragma unroll
        for (int o = 1; o < 64; o <<= 1) wm = fmaxf(wm, __shfl_xor(wm, o));
        wm = fmaxf(wm, 1e-20f);
        const float qs = 6.0f / wm, ax = fminf(fmaxf(w.x * qs, -6.f), 6.f), ay = fminf(fmaxf(w.y * qs, -6.f), 6.f);
        const unsigned ph = __builtin_amdgcn_cvt_scalef32_pk_fp4_f32(0u, ax, ay, 1.0f, 0) & 0xffu;
        const f32x2 dh = FP4_DEC(ph, 0);
        const unsigned pl = __builtin_amdgcn_cvt_scalef32_pk_fp4_f32(0u, fminf(fmaxf(4.f * (ax - dh.x), -6.f), 6.f), fminf(fmaxf(4.f * (ay - dh.y), -6.f), 6.f), 1.0f, 0) & 0xffu;
        ((unsigned short*)WQ)[(size_t)t * 128 + F.lane] = (unsigned short)((ph & 0xfu) | ((ph & 0xf0u) << 4));
        ((unsigned short*)WQ)[(size_t)t * 128 + 64 + F.lane] = (unsigned short)((pl & 0xfu) | ((pl & 0xf0u) << 4));
        if (F.lane == 0) WSC[t] = wm * (1.0f / 6.0f);
    }
#undef W_LD
}
#define V_MFMA4_FIRST(acc, av, bv, sa) asm volatile("v_mfma_scale_f32_16x16x128_f8f6f4 %0, %1, %2, 0, %3, %4 op_sel_hi:[0,0,0] cbsz:4 blgp:4" : "=&v"(acc) : "v"(av), "v"(bv), "v"(sa), "v"(sc_one))
#define V_MFMA4(acc, av, bv, sa) asm volatile("v_mfma_scale_f32_16x16x128_f8f6f4 %0, %1, %2, %0, %3, %4 op_sel_hi:[0,0,0] cbsz:4 blgp:4" : "+v"(acc) : "v"(av), "v"(bv), "v"(sa), "v"(sc_one))
template <int VAR = 0>
__device__ __forceinline__ void peer_v_phase(const Ctx& F0, const Args& a, int layer, float oscale = 1.0f) {
    const Ctx F = fresh(F0);
    const int s = (int)(blockIdx.x & 3), half = (int)((blockIdx.x >> 2) & 1), j = (int)(blockIdx.x >> 3), nmem = F.G >> 3;
    const unsigned char* V4s = a.ws + WS_TAB + (size_t)layer * TAB_LAYER + TAB_VOFF + (size_t)s * NEXP * 128;
    const unsigned short* IDX = (const unsigned short*)(a.ws + WS_IDX);
    const unsigned char* WQ = a.ws + WS_WT;
    const float* WSC = (const float*)(a.ws + WS_WSC);
    const float* modb = (const float*)(a.ws + WS_MOD) + (size_t)layer * 9 * NMOD;
    bf16_t* X = (bf16_t*)(a.ws + WS_XB);
    const int lane = F.lane, rsub = lane >> 3, c8 = lane & 7, n16 = lane & 15, g4 = lane >> 4;
    LAS unsigned char* tile = F.lds + F.wave * 16384;
    const float osc = ((DBG_SKIP & (layer == 0 ? 2 : 8)) ? 0.f : oscale) * (1.0f / V_SCALE);
    constexpr int MLH = ML / 2;
    const int t0 = half * MLH + j * NWAVES + F.wave, stride = nmem * NWAVES, ntok = (half * MLH + MLH - t0 + stride - 1) / stride;
    unsigned sc_one = 0x7f7f7f7fu; asm volatile("" : "+v"(sc_one));
    typedef int v2i_t __attribute__((ext_vector_type(2)));
    LAS float* gl = (LAS float*)(F.lds + RING_BYTES + 4096);
    for (int u = F.tid; u < 4 * 256; u += NWAVES * 64) gl[u] = modb[(size_t)(4 * half + (u >> 8)) * NMOD + 5 * DM + 256 * s + (u & 255)] * osc;
    __syncthreads();
#define V_TOK(i) ((size_t)(t0 + ((i) < ntok ? (i) : ntok - 1) * stride))
    LAS unsigned char* wx[4]; LAS unsigned char* rb[4];
#pragma unroll
    for (int k = 0; k < 4; ++k) wx[k] = tile + rsub * 2048 + ((c8 ^ k ^ ((rsub & 1) << 2)) << 4);
#pragma unroll
    for (int nb = 0; nb < 4; ++nb) rb[nb] = tile + g4 * 2048 + (n16 >> 1) * 128 + 8 * (n16 & 1) + ((nb ^ ((n16 >> 2) & 3) ^ ((g4 & 1) << 2)) << 4);
    LAS unsigned char* stg = tile + g4 * 1024 + n16 * 8;
#define V_LDW(i) (((const unsigned*)WQ)[V_TOK(i) * 64 + lane])
#define V_LDI(i) (((const unsigned*)IDX)[V_TOK(i) * 64 + lane])
#define V_LDX(i) (*(const u32x2*)(X + V_TOK(i) * DM + 256 * s + 4 * lane))
#define V_LDS(i) (WSC[V_TOK(i)])
#define V_IDP(dst, ci) do { _Pragma("unroll") for (int k = 0; k < 8; ++k) dst[k] = (unsigned)__builtin_amdgcn_ds_bpermute((8 * rsub + k) * 4, (int)(ci)); } while (0)
#define V_EIDP(idp, i_) (((i_) & 1) ? (idp[(i_) >> 1] >> 16) : (idp[(i_) >> 1] & 0xffffu))
#define V_READS(nb0) do { \
        unsigned x64 = (nb0) ? 64u : 0u; asm volatile("" : "+v"(x64));                   \
        _Pragma("unroll") for (int nb = 0; nb < 4; ++nb) { LAS unsigned char* rbn = (LAS unsigned char*)((unsigned)(size_t)rb[nb] ^ x64); \
          _Pragma("unroll") for (int h = 0; h < 2; ++h) { _Pragma("unroll") for (int q = 0; q < 2; ++q) { \
            const v2i_t tr = __builtin_amdgcn_ds_read_tr8_b64_v2i32((LAS v2i_t*)(rbn + 8192 * h + 1024 * q)); \
            bw[nb][h][2 * q] = (unsigned)tr[0]; bw[nb][h][2 * q + 1] = (unsigned)tr[1]; } } } \
        __builtin_amdgcn_sched_barrier(0); \
    } while (0)
#define V_MFMAS() do { \
        _Pragma("unroll") for (int nb = 0; nb < 4; ++nb) V_MFMA4_FIRST(dA[nb], aop[0], bw[nb][0], sc_a); \
        _Pragma("unroll") for (int nb = 0; nb < 4; ++nb) V_MFMA4(dA[nb], aop[1], bw[nb][1], sc_a); \
        __builtin_amdgcn_sched_barrier(0); \
    } while (0)
#define V_OUTS(nb0) do { \
        asm volatile("s_nop 15\n\ts_nop 3" : "+v"(dA[0]), "+v"(dA[1]), "+v"(dA[2]), "+v"(dA[3]) :: "memory");     \
        _Pragma("unroll") for (int nb = 0; nb < 4; ++nb) { ov[(nb0) + nb] = (f32x2){dA[nb][0] + dA[nb][2], dA[nb][1] + dA[nb][3]}; asm volatile("" : "+v"(ov[(nb0) + nb])); } \
    } while (0)
#define V_BODY(j, CUR, NXT, LD) do { \
        const size_t t_ = V_TOK(j); \
        unsigned idp[8]; \
        V_IDP(idp, ci##NXT);                                             \
          \
        _Pragma("unroll") for (int i_ = 0; i_ < 16; ++i_) { \
            *(LAS u32x4*)(wx[(i_ >> 1) & 3] + i_ * 128) = R[i_]; \
            if (VAR == 0 || (VAR == 1 && i_ < 8)) R[i_] = *(const u32x4*)(V4s + (unsigned)(V_EIDP(idp, i_) * 128 + 16 * c8)); \
        } \
          \
        u32x4 aop[2]; \
        _Pragma("unroll") for (int h = 0; h < 2; ++h) { _Pragma("unroll") for (int k = 0; k < 4; ++k) { \
            const unsigned w_ = (unsigned)__builtin_amdgcn_ds_bpermute(abase + (16 * h + k) * 4, (int)cw##CUR); \
            aop[h][k] = (n16 < 4) ? (w_ << ash) : 0u; } } \
        asm volatile("s_waitcnt lgkmcnt(0)" ::: "memory");               \
        f32x4 dA[4]; u32x4 bw[4][2]; f32x2 ov[8]; \
        V_READS(0); \
        V_MFMAS(); \
          \
        ci##CUR = V_LDI((j) + 3); cw##LD = V_LDW((j) + 2); xo##LD = V_LDX((j) + 2); ws##LD = V_LDS((j) + 2); \
        __builtin_amdgcn_sched_barrier(0); \
        V_READS(4);                                                      \
        V_OUTS(0); \
        V_MFMAS(); \
        V_OUTS(4); \
          \
        _Pragma("unroll") for (int nb = 0; nb < 8; ++nb) *(LAS f32x2*)(stg + nb * 128) = ov[nb]; \
        asm volatile("s_waitcnt lgkmcnt(0)" ::: "memory"); \
        const f32x4 sum = *(const LAS f32x4*)(tile + 16 * lane); \
        const f32x4 gt_ = *(const LAS f32x4*)(gl + ((t_ >> 12) & 3) * 256 + 4 * lane); \
        asm volatile("s_waitcnt lgkmcnt(0)" ::: "memory"); \
        if ((j) < ntok) { const f32x4 r_ = bf4_f32(xo##CUR) + gt_ * ws##CUR * sum; *(u32x2*)(X + t_ * DM + 256 * s + 4 * lane) = (u32x2){cvtpk(r_.x, r_.y), cvtpk(r_.z, r_.w)}; } \
    } while (0)
    u32x4 R[16];
    unsigned cwA, cwB, cwC, ciA, ciB, ciC;
    u32x2 xoA, xoB, xoC;
    float wsA, wsB, wsC;
    const int abase = (32 * ((n16 >> 1) & 1) + 4 * g4) * 4, ash = 4 * (n16 & 1);
    unsigned sc_a = (n16 & 2) ? 0x7d7d7d7du : 0x7f7f7f7fu; asm volatile("" : "+v"(sc_a));
    ciA = V_LDI(0);
    cwA = V_LDW(0); cwB = V_LDW(1); xoA = V_LDX(0); xoB = V_LDX(1); wsA = V_LDS(0); wsB = V_LDS(1);
    { unsigned idp0[8]; V_IDP(idp0, ciA);
#pragma unroll
      for (int i_ = 0; i_ < 16; ++i_) R[i_] = *(const u32x4*)(V4s + (unsigned)(V_EIDP(idp0, i_) * 128 + 16 * c8)); }
    ciB = V_LDI(1); ciC = V_LDI(2);
    cwC = 0u; xoC = (u32x2){0u, 0u}; wsC = 0.f;
    asm volatile("" :: "v"(ciC));
    for (int i = 0; i < ntok; i += 3) {
        V_BODY(i, A, B, C);
        V_BODY(i + 1, B, C, A);
        V_BODY(i + 2, C, A, B);
    }
#undef V_BODY
#undef V_READS
#undef V_MFMAS
#undef V_OUTS
#undef V_LDW
#undef V_LDI
#undef V_LDX
#undef V_LDS
#undef V_IDP
#undef V_EIDP
#undef V_TOK
}
#undef V_MFMA4_FIRST
#undef V_MFMA4

__device__ __forceinline__ void dft_nyquist_rows(const Ctx& F0, const Args& a) {
    const Ctx F = fresh(F0);
    const unsigned char* Yt = a.ws + WS_QK;
    unsigned char* Fo = a.ws + WS_VT;
    const int gwv = F.vcu * NWAVES + F.wave, NGW = F.G * NWAVES;
    for (int o = gwv; o < NB * DM; o += NGW) {
        const unsigned char* src = Yt + (size_t)o * 8192;
        float s = 0.f;
#pragma unroll
        for (int it = 0; it < 4; ++it) { const u32x4 v = *(const u32x4*)(src + it * 1024 + F.lane * 16);
#pragma unroll
            for (int d = 0; d < 4; ++d) { const f32x2 lo = __builtin_amdgcn_cvt_pk_f32_fp8((int)v[d], false), hi = __builtin_amdgcn_cvt_pk_f32_fp8((int)v[d], true); s += (lo[0] - lo[1]) + (hi[0] - hi[1]); } }
        s = wave_sum(s) * (pg8::ACT8_SCALE / (64.0f * pg8::YT_SCALE));
        if (F.lane == 0) Fo[((size_t)(o >> 10) * SEQ + 2048) * DM + (o & 1023)] = (unsigned char)(fp8_pack4(s, 0.f, 0.f, 0.f) & 0xffu);
    }
}

__global__ void __launch_bounds__(NWAVES * 64, 2) fwd_kernel(Args args) {
    extern __shared__ __attribute__((aligned(16))) unsigned char lds_raw[];
    Ctx F;
    F.lds = (LAS unsigned char*)lds_raw;
    F.tid = threadIdx.x; F.lane = F.tid & 63; F.wave = __builtin_amdgcn_readfirstlane(F.tid >> 6);
    F.G = gridDim.x; { const int bx = blockIdx.x; F.vcu = (F.G % 8 == 0) ? (bx % 8) * (F.G / 8) + bx / 8 : bx; }
    volatile LAS unsigned* MISC = (volatile LAS unsigned*)(F.lds + MISC_OFF);
    for (int u = F.tid; u < (LDS_BYTES - LDSCTL_OFF) / 4; u += NWAVES * 64) ((LAS unsigned*)(F.lds + LDSCTL_OFF))[u] = 0u;
    __syncthreads();
    unsigned char* ws = args.ws;
    XcdBarrier bar = xcd_barrier_post((unsigned*)(ws + WS_CTL) + CW_BAR, MISC + 8);
#define GRID_BAR() xcd_barrier(bar)
#ifndef DBG_REP
#define DBG_REP 0
#endif
#ifndef DBG_VVAR
#define DBG_VVAR 0
#endif
#define REP(k, ...) do { __VA_ARGS__; if (DBG_REP == (k)) { GRID_BAR(); __VA_ARGS__; } } while (0)
#define PEER_BLOCK(layer) do { \
        norm_phase(F, args, 1, layer, 3 * DM, args.in[5] + (layer) * DM); \
        GRID_BAR(); \
        { using SHq = pg8::Shape<ML, 2048, DM / 2, DM / 2, DM / 2, 1, 0, 0>;       \
          REP(7, pg8::gemm_phase<SHq, pg8::EpiStoreBf16, true>(F.lds, pg8::Gemm{HX, (const bf16_t*)(ws + WS_WPQ) + (size_t)(layer) * 2048 * DM / 2}, F.G, bx, pg8::EpiStoreBf16{QKb, 2048, 0, 0, 1.0f, 1.0f / (pg8::ACT8_SCALE * pg8::W8_SCALE)})); } \
        GRID_BAR(); \
        REP(8, peer_topk_phase(F, args, layer)); \
        GRID_BAR(); \
        REP(9, peer_u_phase(F, args, layer)); \
        GRID_BAR(); \
        REP(10, peer_w_phase(F, args)); \
        GRID_BAR(); \
        peer_v_phase(F, args, layer); if (DBG_REP == 11) { GRID_BAR(); peer_v_phase<DBG_VVAR>(F, args, layer, 0.f); } \
        GRID_BAR(); \
    } while (0)
    const float* modb = (const float*)(ws + WS_MOD);
    bf16_t* HX = (bf16_t*)(ws + WS_HX);
    bf16_t* QKb = (bf16_t*)(ws + WS_QK);
    bf16_t* VTb = (bf16_t*)(ws + WS_VT);
    const bf16_t* Wqkv = (const bf16_t*)(ws + WS_WQKV);
    const int bx = (int)blockIdx.x;

    REP(1, p0_prologue(F, args));
    GRID_BAR();
    REP(2, norm_phase(F, args, 0, 0, 0, args.in[4]));
    GRID_BAR();
    {
        constexpr float o8 = 1.0f / (pg8::ACT8_SCALE * pg8::W8_SCALE);
        using SH1 = pg8::Shape<MT, 2048, DM / 2, DM / 2, DM / 2, 1, 0, 0>;
        pg8::gemm_phase<SH1, pg8::EpiStoreBf16, true>(F.lds, pg8::Gemm{HX, Wqkv}, F.G, bx, pg8::EpiStoreBf16{QKb, 2048, 0, 1024, 0.125f * LOG2E, o8});
        using SH2 = pg8::Shape<DM, MT, DM / 2, DM / 2, DM / 2, 1, 0, 0>;
        const int bxv = F.G - 1 - bx;
        pg8::gemm_phase<SH2, pg8::EpiStoreBf16, true>(F.lds, pg8::Gemm{Wqkv + (size_t)2048 * DM / 2, HX}, F.G, bxv, pg8::EpiStoreBf16{VTb, MT, 0, 0, 1.0f, o8});
    }
    GRID_BAR();
    REP(4, attn_phase(F, args));
    GRID_BAR();
    {
        using SH = pg8::Shape<ML, DM, DM / 2, DM / 2, DM / 2, 1, 0, 0>;
        pg8::gemm_phase<SH, pg8::EpiResid<false>, true>(F.lds, pg8::Gemm{(const bf16_t*)(ws + WS_HX + 36 * MiB), (const bf16_t*)(ws + WS_WO)}, F.G, bx, pg8::EpiResid<false>{args.in[0], (bf16_t*)(ws + WS_XB), modb + 2 * DM, NMOD, ((DBG_SKIP & 1) ? 0.f : 1.f) / (pg8::ACT8_SCALE * pg8::W8_SCALE)});
    }
    GRID_BAR();
    PEER_BLOCK(0);
    norm_phase(F, args, 1, 1, 0, args.in[4] + DM);
    GRID_BAR();
    {
        using SH = pg8::Shape<512, ML, 256, 256, DM, 4, 0, 256>;
        pg8::gemm_phase<SH>(F.lds, pg8::Gemm{(const bf16_t*)(ws + WS_WC), HX}, F.G, bx, pg8::EpiYt{(unsigned char*)QKb});
    }
    GRID_BAR();
    {
        using SH = pg8::Shape<SEQ / 2, DM, 4096, 4096, 4096, NB, 0, (long)DM * 4096>;
        REP(14, pg8::gemm_phase<SH, pg8::EpiDft2, true>(F.lds, pg8::Gemm{(const bf16_t*)(ws + WS_CS), QKb}, F.G, bx, pg8::EpiDft2{(unsigned char*)VTb}));
        dft_nyquist_rows(F, args);
    }
    GRID_BAR();
    {
        using SH = pg8::Shape<ML, DM, DM / 2, DM / 2, DM / 2, 1, 0, 0>;
        pg8::gemm_phase<SH, pg8::EpiResid<true>, true>(F.lds, pg8::Gemm{VTb, (const bf16_t*)(ws + WS_WF)}, F.G, bx, pg8::EpiResid<true>{ws + WS_XB, (bf16_t*)(ws + WS_XB), modb + (size_t)9 * NMOD + 2 * DM, NMOD, ((DBG_SKIP & 4) ? 0.f : 1.f) / (pg8::ACT8_SCALE * pg8::W8_SCALE)});
    }
    GRID_BAR();
    PEER_BLOCK(1);
    if (DBG_REP == 20) { for (int r = 0; r < 16; ++r) GRID_BAR(); }
    final_norm_phase(F, args);
#undef PEER_BLOCK
}

extern "C" void kernel_launch(void* const* d_in, const int* in_sizes, int n_in, void* d_out, int out_size, void* d_ws, size_t ws_size, hipStream_t stream) {
    static int grid = 0;
    if (grid == 0) {
        if (n_in != 17 || in_sizes[0] != ML * DM || out_size != ML * DM || ws_size < WS_END) { fprintf(stderr, "kernel_launch: unexpected shapes (n_in %d, in0 %d, out %d, ws %zu)\n", n_in, n_in > 0 ? in_sizes[0] : -1, out_size, ws_size); grid = -1; return; }
        int dev = 0, cus = 0, per_cu = 0;
        if (hipGetDevice(&dev) != hipSuccess || hipDeviceGetAttribute(&cus, hipDeviceAttributeMultiprocessorCount, dev) != hipSuccess) { grid = -1; return; }
        if (hipFuncSetAttribute((const void*)fwd_kernel, hipFuncAttributeMaxDynamicSharedMemorySize, LDS_BYTES) != hipSuccess) { fprintf(stderr, "kernel_launch: hipFuncSetAttribute failed\n"); grid = -1; return; }
        if (hipOccupancyMaxActiveBlocksPerMultiprocessor(&per_cu, (const void*)fwd_kernel, NWAVES * 64, LDS_BYTES) != hipSuccess || per_cu < 1)
            fprintf(stderr, "kernel_launch: note: occupancy query reports %d workgroups per CU\n", per_cu);
        (void)hipGetLastError();
        grid = cus;
        if (grid % 8 != 0) { fprintf(stderr, "kernel_launch: CU count %d is not a multiple of 8\n", cus); grid = -1; return; }
    }
    if (grid < 0) return;
    if (hipMemsetAsync((char*)d_ws + WS_CTL, 0, CTL_ZERO_BYTES, stream) != hipSuccess) { fprintf(stderr, "kernel_launch: memset failed\n"); return; }
    Args a{};
    for (int i = 0; i < 17; ++i) a.in[i] = (const float*)d_in[i];
    a.out = (float*)d_out; a.ws = (unsigned char*)d_ws;
    hipLaunchKernelGGL(fwd_kernel, dim3(grid), dim3(NWAVES * 64), LDS_BYTES, stream, a);
    const hipError_t le = hipPeekAtLastError();
    if (le != hipSuccess) fprintf(stderr, "kernel_launch: launch failed: %s\n", hipGetErrorName(le));
}
```

```cpp
#include <hip/hip_runtime.h>
#include <cstdio>
#include <cstdint>

#define LAS __attribute__((address_space(3)))
typedef unsigned short bf16_t;
typedef short bf16x8 __attribute__((ext_vector_type(8)));
typedef short s16x4 __attribute__((ext_vector_type(4)));
typedef float f32x2 __attribute__((ext_vector_type(2)));
typedef float f32x4 __attribute__((ext_vector_type(4)));
typedef float f32x16 __attribute__((ext_vector_type(16)));
typedef unsigned u32x2 __attribute__((ext_vector_type(2)));
typedef unsigned u32x4 __attribute__((ext_vector_type(4)));
typedef __bf16 bf16x2_t __attribute__((ext_vector_type(2)));

#ifndef DBG_SKIP
#define DBG_SKIP 0
#endif
constexpr int DM = 1024, NB = 8, SEQ = 4096, CTXL = 256, GW = 64;
constexpr int ML = NB * SEQ;
constexpr int MC = NB * CTXL;
constexpr int MT = ML + MC;
constexpr int NMOD = 6 * DM;
constexpr int NEXP = 16384;
constexpr float EPS = 1e-6f;
constexpr float LOG2E = 1.4426950408889634f;

constexpr size_t MiB = 1u << 20;
constexpr size_t WS_CTL = 0, CTL_ZERO_BYTES = 1 * MiB;
constexpr size_t WS_MOD = 1 * MiB;
constexpr size_t WS_WQKV = 2 * MiB;
constexpr size_t WS_WO = 8 * MiB;
constexpr size_t WS_WF = 10 * MiB;
constexpr size_t WS_WPQ = 12 * MiB;
constexpr size_t WS_SK = 20 * MiB;
constexpr size_t WS_WC = 20 * MiB + 256 * 1024;
constexpr size_t WS_CS = 22 * MiB;
constexpr size_t WS_TAB = 38 * MiB;
constexpr size_t WS_X8 = 150 * MiB;
constexpr size_t WS_WT = 182 * MiB;
constexpr size_t WS_PART = 282 * MiB;
constexpr float U_SCALE = 64.f;
constexpr float XQ_SCALE = 0.75f;
constexpr float V_SCALE = 2.f;
constexpr size_t WS_XB = 70 * MiB;
constexpr size_t TAB_LAYER = 16 * MiB, TAB_VOFF = 8 * MiB;
constexpr size_t WS_WSC = 198 * MiB;
constexpr size_t WS_YNI = 199 * MiB;
constexpr size_t WS_YN = WS_YNI + 64 * 1024;
constexpr size_t WS_HX = 214 * MiB;
constexpr size_t WS_QK = 282 * MiB;
constexpr size_t WS_VT = 418 * MiB;
constexpr size_t WS_IDX = WS_VT;
constexpr size_t WS_GATE = WS_VT + 8 * MiB;
constexpr size_t WS_END = 486 * MiB;
constexpr int CW_BAR = 4096;

__device__ __forceinline__ unsigned f2bf(float f) { unsigned u = __builtin_bit_cast(unsigned, f); return (u + 0x7fffu + ((u >> 16) & 1u)) >> 16; }
__device__ __forceinline__ unsigned pk2(float lo, float hi) { return f2bf(lo) | (f2bf(hi) << 16); }
__device__ __forceinline__ f32x4 bf4_f32(u32x2 w) { return (f32x4){__builtin_bit_cast(float, w.x << 16), __builtin_bit_cast(float, w.x & 0xffff0000u), __builtin_bit_cast(float, w.y << 16), __builtin_bit_cast(float, w.y & 0xffff0000u)}; }
__device__ __forceinline__ unsigned cvtpk(float lo, float hi) { f32x2 v = {lo, hi}; bf16x2_t b = __builtin_convertvector(v, bf16x2_t); return __builtin_bit_cast(unsigned, b); }
__device__ __forceinline__ float bflo(unsigned u) { return __builtin_bit_cast(float, u << 16); }
__device__ __forceinline__ float bfhi(unsigned u) { return __builtin_bit_cast(float, u & 0xffff0000u); }
__device__ __forceinline__ float wave_sum(float v) {
#pragma unroll
    for (int o = 1; o < 64; o <<= 1) v += __shfl_xor(v, o);
    return v;
}
__device__ __forceinline__ unsigned fp8_pack4(float a, float b, float c, float d) {
    int w = 0;
    w = __builtin_amdgcn_cvt_pk_fp8_f32(__builtin_amdgcn_fmed3f(a, -448.f, 448.f), __builtin_amdgcn_fmed3f(b, -448.f, 448.f), w, false);
    w = __builtin_amdgcn_cvt_pk_fp8_f32(__builtin_amdgcn_fmed3f(c, -448.f, 448.f), __builtin_amdgcn_fmed3f(d, -448.f, 448.f), w, true);
    return (unsigned)w;
}
__device__ __forceinline__ int crow(int r, int hi) { return (r & 3) + 8 * (r >> 2) + 4 * hi; }
__device__ __forceinline__ float gelu_erf(float v) {
    const float av = __builtin_fabsf(v), d = av * 0.2316418882f + 1.0f;
    const float t = __builtin_amdgcn_rcpf(d);
    float q = t * 0.5307027145f + (-0.7265760135f); q = q * t + 0.7107068705f; q = q * t + (-0.142248368f); q = q * t + 0.127414796f; q = q * t;
    const float e = __builtin_amdgcn_exp2f((v * v) * (-0.72134752044f));
    const float m = v * (q * e), r = v - m;
    return v < 0.f ? m : r;
}

namespace pg8 {
constexpr float ACT8_SCALE = 16.f, W8_SCALE = 256.f;
constexpr float YT_SCALE = 16.f, CS_SCALE = 512.f;
constexpr int BM = 256, BK = 64, HALF = 128, HTB = HALF * BK * 2, STAGE_BYTES = 8 * HTB, NXCD = 8, WGM = 8;
__host__ __device__ __forceinline__ int lds_byte(int r, int c) { const int st = (r >> 4) * 2 + (c >> 5), rr = r & 15, cc = c & 31, ob = rr * 64 + cc * 2; return st * 1024 + (ob ^ (((ob >> 9) & 1) << 5)); }
__host__ __device__ __forceinline__ void stage_rc(int b, int& R, int& C) { const int st = b / 1024, sb = b % 1024, swz = sb ^ (((sb >> 9) & 1) << 5); R = (st >> 1) * 16 + swz / 64; C = (st & 1) * 32 + (swz % 64) / 2; }
__host__ __device__ __forceinline__ int perm32(int rho) { const int n = rho >> 4, i = rho & 15; return 8 * (i >> 2) + 4 * n + (i & 3); }

struct Unit { int pm, pn, pb; };
struct Gemm { const bf16_t* A; const bf16_t* Bt; };
template <int M_, int N_, int K_, int LDA_, int LDB_, int NBATCH_, long BSA_, long BSB_> struct Shape { static constexpr int M = M_, N = N_, K = K_, lda = LDA_, ldb = LDB_, nbatch = NBATCH_; static constexpr long bsA = BSA_, bsB = BSB_; };

template <class SH> struct StaticOrder {
    static constexpr int nM = SH::M / BM, nN = SH::N / BM, per = nM * nN, nwg = per * SH::nbatch;
    int G, c;
    __device__ __forceinline__ void init(int G_, int c_) { G = G_; c = c_; }
    __device__ __forceinline__ bool next(int i, Unit& u) const {
        const long L = (long)i * G + c; if (L >= nwg) return false;
        int wgid = (int)L; { const int q = nwg / NXCD, r = nwg % NXCD, xcd = wgid % NXCD, off = wgid / NXCD; wgid = (xcd < r ? xcd * (q + 1) : r * (q + 1) + (xcd - r) * q) + off; }
        u.pb = wgid / per; wgid -= u.pb * per;
        const int nig = WGM * nN, gid = wgid / nig, fm = gid * WGM, gsz = (nM - fm) < WGM ? (nM - fm) : WGM;
        u.pm = fm + ((wgid % nig) % gsz); u.pn = (wgid % nig) / gsz; return true;
    }
};

struct EpiStoreBf16 {
    static constexpr bool PERM = true;
    bf16_t* O; long ldc; long bstride; int scols; float scale0; float oscale = 1.0f;
    __device__ __forceinline__ void operator()(const f32x4 (&acc)[2][2][4][2], const Unit& u, int wr, int wc, int fr, int fq) const {
        const int row0 = u.pm * BM + wr * 64 + fr, col0 = u.pn * BM + wc * 32 + 8 * fq;
        bf16_t* base = O + (long)u.pb * bstride;
        const float sc = ((u.pn * BM < scols) ? scale0 : 1.0f) * oscale;
#pragma unroll
        for (int ai = 0; ai < 2; ++ai)
#pragma unroll
            for (int m = 0; m < 4; ++m) { bf16_t* rowp = base + (long)(row0 + ai * HALF + m * 16) * ldc + col0;
#pragma unroll
                for (int bj = 0; bj < 2; ++bj) { const f32x4 v0 = acc[ai][bj][m][0] * sc, v1 = acc[ai][bj][m][1] * sc;
                    u32x4 w; w.x = cvtpk(v0[0], v0[1]); w.y = cvtpk(v0[2], v0[3]); w.z = cvtpk(v1[0], v1[1]); w.w = cvtpk(v1[2], v1[3]);
                    *(u32x4*)(rowp + bj * HALF) = w; } }
    }
};
struct EpiDft2 {
    static constexpr bool PERM = true;
    unsigned char* O; const float* yn;
    __device__ __forceinline__ void operator()(const f32x4 (&acc)[2][2][4][2], const Unit& u, int wr, int wc, int fr, int fq) const {
        const int row0 = u.pm * BM + wr * 64 + fr, cl0 = wc * 32 + 8 * fq;
        unsigned char* base = O + (long)u.pb * SEQ * DM + u.pn * BM;
        constexpr float osc = ACT8_SCALE / (YT_SCALE * CS_SCALE);
        f32x4 y0[2], y1[2];
#pragma unroll
        for (int bj = 0; bj < 2; ++bj) { const float* yp = yn + (long)u.pb * DM + u.pn * BM + cl0 + bj * HALF; y0[bj] = *(const f32x4*)yp * (ACT8_SCALE / 64.0f); y1[bj] = *(const f32x4*)(yp + 4) * (ACT8_SCALE / 64.0f); }
#pragma unroll
        for (int ai = 0; ai < 2; ++ai)
#pragma unroll
            for (int m = 0; m < 4; ++m) { const int np = row0 + ai * HALF + m * 16;
                unsigned char* rowp = base + (long)np * DM; unsigned char* mirp = base + (long)(SEQ - np) * DM;
#pragma unroll
                for (int bj = 0; bj < 2; ++bj) { const float sg = (np & 1) ? -1.0f : 1.0f; const f32x4 v0 = acc[ai][bj][m][0] * osc + y0[bj] * sg, v1 = acc[ai][bj][m][1] * osc + y1[bj] * sg; const int cl = cl0 + bj * HALF;
                    u32x2 w; w.x = fp8_pack4(v0[0], v0[1], v0[2], v0[3]); w.y = fp8_pack4(v1[0], v1[1], v1[2], v1[3]);
                    *(u32x2*)(rowp + cl) = w;
                    if (np != 0) {
#pragma unroll
                        for (int i = 0; i < 8; ++i) mirp[(256 - cl - i) & 255] = (unsigned char)((w[i >> 2] >> (8 * (i & 3))) & 0xffu); } }
                asm volatile("" ::: "memory"); }
    }
};
struct EpiYt {
    static constexpr bool PERM = true;
    unsigned char* Yt; int part;
    __device__ __forceinline__ void operator()(const f32x4 (&acc)[2][2][4][2], const Unit& u, int wr, int wc, int fr, int fq) const {
        const int row0 = u.pm * BM + wr * 64 + fr, col0 = u.pn * BM + wc * 32 + 8 * fq;
#pragma unroll
        for (int ai = 0; ai < 2; ++ai)
#pragma unroll
            for (int m = 0; m < 4; ++m) { const int cp = row0 + ai * HALF + m * 16;
#pragma unroll
                for (int bj = 0; bj < 2; ++bj) { const int col = col0 + bj * HALF; const int b = col >> 11, k = col & 2047;
                    const f32x4 v0 = acc[ai][bj][m][0] * YT_SCALE, v1 = acc[ai][bj][m][1] * YT_SCALE;
                    u32x2 w; w.x = fp8_pack4(v0[0], v0[1], v0[2], v0[3]); w.y = fp8_pack4(v1[0], v1[1], v1[2], v1[3]);
                    *(u32x2*)(Yt + (((long)(b * 4 + u.pb) * 256 + cp) << 12) + part * 2048 + k) = w; }
                asm volatile("" ::: "memory"); }
    }
};
template <bool IN_BF16>
struct EpiResid {
    static constexpr bool PERM = false;
    const void* Xin; bf16_t* Xout; const float* gate; int gstride; float gs;
    __device__ __forceinline__ void operator()(const f32x4 (&acc)[2][2][4][2], const Unit& u, int wr, int wc, int fr, int fq) const {
        const int row0 = u.pm * BM + wr * 64 + fr, col0 = u.pn * BM + wc * 32 + 4 * fq;
        const float* gb = gate + (long)((u.pm * BM) >> 12) * gstride;
        f32x4 gv[2][2];
#pragma unroll
        for (int bj = 0; bj < 2; ++bj)
#pragma unroll
            for (int n = 0; n < 2; ++n) gv[bj][n] = *(const f32x4*)(gb + col0 + bj * HALF + n * 16);
        f32x4 xf[2][8]; u32x2 xb[2][8];
#define ER_OFF(b_, k_) ((long)(row0 + ((b_) >> 1) * HALF + (2 * ((b_) & 1) + ((k_) >> 2)) * 16) * DM + col0 + (((k_) >> 1) & 1) * HALF + ((k_) & 1) * 16)
#define ER_LOAD(b_) do { _Pragma("unroll") for (int k_ = 0; k_ < 8; ++k_) { const long o_ = ER_OFF(b_, k_); \
            if (IN_BF16) xb[(b_) & 1][k_] = *(const u32x2*)((const bf16_t*)Xin + o_); else xf[(b_) & 1][k_] = *(const f32x4*)((const float*)Xin + o_); } } while (0)
        ER_LOAD(0);
#pragma unroll
        for (int b_ = 0; b_ < 4; ++b_) {
            if (b_ + 1 < 4) ER_LOAD(b_ + 1);
#pragma unroll
            for (int k_ = 0; k_ < 8; ++k_) { const long o_ = ER_OFF(b_, k_); const int ai = b_ >> 1, m = 2 * (b_ & 1) + (k_ >> 2), bj = (k_ >> 1) & 1, n = k_ & 1;
                const f32x4 bs = IN_BF16 ? bf4_f32(xb[b_ & 1][k_]) : xf[b_ & 1][k_];
                const f32x4 r_ = bs + gv[bj][n] * acc[ai][bj][m][n] * gs;
                *(u32x2*)(Xout + o_) = (u32x2){cvtpk(r_.x, r_.y), cvtpk(r_.z, r_.w)}; }
            asm volatile("" ::: "memory");
        }
#undef ER_OFF
#undef ER_LOAD
    }
};

template <class SH, class Epi, bool FP8 = false>
__device__ __forceinline__ void gemm_phase(LAS unsigned char* lds, const Gemm g, int G_, int c_, const Epi& E) {
    StaticOrder<SH> S; S.init(G_, c_);
    int tid_ = threadIdx.x; asm volatile("" : "+v"(tid_));
    const int tid = tid_, wid = __builtin_amdgcn_readfirstlane(tid >> 6), lane = tid & 63, wr = wid >> 2, wc = wid & 3, fr = lane & 15, fq = lane >> 4;
    constexpr int K = SH::K, nt = K / BK;
    unsigned voffA[2], voffB[2];
#pragma unroll
    for (int i = 0; i < 2; ++i) { int R, C; stage_rc(tid * 16 + i * 8192, R, C); const int Rb = Epi::PERM ? ((R & ~31) + perm32(R & 31)) : R;
        voffA[i] = (unsigned)(R * SH::lda + C) * 2u; voffB[i] = (unsigned)(Rb * SH::ldb + C) * 2u; }
    constexpr size_t kstep = (size_t)(BK * 2);
    constexpr size_t hstepA = (size_t)HALF * SH::lda * 2, hstepB = (size_t)HALF * SH::ldb * 2;
    constexpr size_t tstepA = 2 * hstepA, tstepB = 2 * hstepB;
    const unsigned ldsw = (unsigned)wid * 1024u;
    const int aoff = lds_byte(wr * 64 + fr, fq * 8), boff = lds_byte(wc * 32 + fr, fq * 8);
#define PG8_SA(b, h) (((b) * 2 + (h)) * HTB)
#define PG8_SB(b, h) ((4 + (b) * 2 + (h)) * HTB)
#define PG8_STAGE(bufoff, gbase, voff) do { _Pragma("unroll") for (int _i = 0; _i < 2; ++_i) \
        __builtin_amdgcn_global_load_lds((const unsigned*)((const char*)(gbase) + (voff)[_i]), (LAS unsigned*)(lds + (bufoff) + ldsw + _i * 8192), 16, 0, 0); } while (0)
#define PG8_LDA(dst, b, h) do { _Pragma("unroll") for (int m = 0; m < 4; ++m) { const u32x4 f0_ = *(const LAS u32x4*)(lds + PG8_SA(b, h) + aoff + m * 2048), f1_ = *(const LAS u32x4*)(lds + PG8_SA(b, h) + aoff + m * 2048 + 1024); dst[m] = __builtin_shufflevector(f0_, f1_, 0, 1, 2, 3, 4, 5, 6, 7); } } while (0)
#define PG8_LDB(dst, b, h) do { _Pragma("unroll") for (int n = 0; n < 2; ++n) { const u32x4 f0_ = *(const LAS u32x4*)(lds + PG8_SB(b, h) + boff + n * 2048), f1_ = *(const LAS u32x4*)(lds + PG8_SB(b, h) + boff + n * 2048 + 1024); dst[n] = __builtin_shufflevector(f0_, f1_, 0, 1, 2, 3, 4, 5, 6, 7); } } while (0)
typedef int v8i_t __attribute__((ext_vector_type(8)));
typedef unsigned u32x8 __attribute__((ext_vector_type(8)));
#define PG8_LOH(x) __builtin_bit_cast(bf16x8, __builtin_shufflevector(x, x, 0, 1, 2, 3))
#define PG8_HIH(x) __builtin_bit_cast(bf16x8, __builtin_shufflevector(x, x, 4, 5, 6, 7))
#define PG8_MMA(ai, bj, At, Bt) do { __builtin_amdgcn_s_setprio(1); _Pragma("unroll") for (int m = 0; m < 4; ++m) _Pragma("unroll") for (int n = 0; n < 2; ++n) { \
        if constexpr (FP8) asm volatile("v_mfma_scale_f32_16x16x128_f8f6f4 %0, %1, %2, %0, %3, %3 op_sel_hi:[0,0,0]" : "+v"(acc[ai][bj][m][n]) : "v"(Bt[n]), "v"(At[m]), "v"(fp8_one));   \
        else { acc[ai][bj][m][n] = __builtin_amdgcn_mfma_f32_16x16x32_bf16(PG8_LOH(Bt[n]), PG8_LOH(At[m]), acc[ai][bj][m][n], 0, 0, 0); \
               acc[ai][bj][m][n] = __builtin_amdgcn_mfma_f32_16x16x32_bf16(PG8_HIH(Bt[n]), PG8_HIH(At[m]), acc[ai][bj][m][n], 0, 0, 0); } } \
        __builtin_amdgcn_s_setprio(0); } while (0)
#define PG8_WAIT_V(n) asm volatile("s_waitcnt vmcnt(" #n ")" ::: "memory")
#define PG8_WAIT_L(n) asm volatile("s_waitcnt lgkmcnt(" #n ")" ::: "memory")
#define PG8_BAR __builtin_amdgcn_s_barrier()
#define PG8_SCHED __builtin_amdgcn_sched_barrier(0)
    Unit cur, nxt; int ui = 0;
    if (!S.next(0, cur)) return;
    f32x4 acc[2][2][4][2];
#pragma unroll
    for (int a = 0; a < 2; ++a)
#pragma unroll
        for (int b = 0; b < 2; ++b)
#pragma unroll
            for (int m = 0; m < 4; ++m)
#pragma unroll
                for (int n = 0; n < 2; ++n) acc[a][b][m][n] = (f32x4){0.f, 0.f, 0.f, 0.f};
    unsigned fp8_one = 0x7f7f7f7fu; asm volatile("" : "+v"(fp8_one));
    u32x8 At[4], B0[2], B1[2];
    const char* cA = (const char*)(g.A + (long)cur.pb * SH::bsA) + (size_t)cur.pm * tstepA; const char* cB = (const char*)(g.Bt + (long)cur.pb * SH::bsB) + (size_t)cur.pn * tstepB;
    PG8_STAGE(PG8_SB(0, 0), cB, voffB); PG8_STAGE(PG8_SB(0, 1), cB + hstepB, voffB); PG8_STAGE(PG8_SA(0, 0), cA, voffA); PG8_STAGE(PG8_SA(0, 1), cA + hstepA, voffA);
    if (wr == 1) PG8_BAR;
    PG8_WAIT_V(2); PG8_BAR;
    PG8_STAGE(PG8_SB(1, 0), cB + kstep, voffB); PG8_STAGE(PG8_SA(1, 0), cA + kstep, voffA); PG8_STAGE(PG8_SB(1, 1), cB + hstepB + kstep, voffB);
    PG8_WAIT_V(6); PG8_BAR;
    for (;;) {
        const bool has_next = S.next(ui + 1, nxt);
        const char* nA = has_next ? (const char*)(g.A + (long)nxt.pb * SH::bsA) + (size_t)nxt.pm * tstepA : cA; const char* nB = has_next ? (const char*)(g.Bt + (long)nxt.pb * SH::bsB) + (size_t)nxt.pn * tstepB : cB;
#pragma nounroll
        for (int t = 0; t < nt; t += 2) {
            const bool last = (t == nt - 2);
            const char* a1 = cA + (size_t)(t + 1) * kstep;
            const char* a2 = last ? nA : cA + (size_t)(t + 2) * kstep; const char* b2 = last ? nB : cB + (size_t)(t + 2) * kstep;
            const char* a3 = a2 + kstep; const char* b3 = b2 + kstep;
            PG8_LDB(B0, 0, 0); PG8_LDB(B1, 0, 1); PG8_SCHED; PG8_LDA(At, 0, 0); PG8_STAGE(PG8_SA(1, 1), a1 + hstepA, voffA);
            PG8_WAIT_V(8); PG8_WAIT_L(0); PG8_BAR; PG8_MMA(0, 0, At, B0); PG8_MMA(0, 1, At, B1); PG8_BAR; PG8_SCHED;
            PG8_LDA(At, 0, 1); PG8_STAGE(PG8_SB(0, 0), b2, voffB); PG8_STAGE(PG8_SB(0, 1), b2 + hstepB, voffB); PG8_STAGE(PG8_SA(0, 0), a2, voffA);
            PG8_WAIT_V(8); PG8_WAIT_L(0); PG8_BAR; PG8_MMA(1, 0, At, B0); PG8_MMA(1, 1, At, B1); PG8_BAR; PG8_SCHED;
            PG8_LDB(B0, 1, 0); PG8_LDB(B1, 1, 1); PG8_SCHED; PG8_LDA(At, 1, 0); PG8_STAGE(PG8_SA(0, 1), a2 + hstepA, voffA);
            PG8_WAIT_V(8); PG8_WAIT_L(0); PG8_BAR; PG8_MMA(0, 0, At, B0); PG8_MMA(0, 1, At, B1); PG8_BAR; PG8_SCHED;
            PG8_LDA(At, 1, 1); PG8_STAGE(PG8_SB(1, 0), b3, voffB); PG8_STAGE(PG8_SB(1, 1), b3 + hstepB, voffB); PG8_STAGE(PG8_SA(1, 0), a3, voffA);
            PG8_WAIT_V(8); PG8_WAIT_L(0); PG8_BAR; PG8_MMA(1, 0, At, B0); PG8_MMA(1, 1, At, B1); PG8_BAR; PG8_SCHED;
        }
        if (wr == 0) PG8_BAR;
        if constexpr (FP8) asm volatile("s_nop 15\n\ts_nop 15\n\ts_nop 7" ::: "memory");
        E(acc, cur, wr, wc, fr, fq);
        if (!has_next) break;
#pragma unroll
        for (int a = 0; a < 2; ++a)
#pragma unroll
            for (int b = 0; b < 2; ++b)
#pragma unroll
                for (int m = 0; m < 4; ++m)
#pragma unroll
                    for (int n = 0; n < 2; ++n) acc[a][b][m][n] = (f32x4){0.f, 0.f, 0.f, 0.f};
        cur = nxt; cA = nA; cB = nB; ++ui;
        if (wr == 1) PG8_BAR;
    }
    PG8_WAIT_V(0);
    PG8_BAR;
#undef PG8_SA
#undef PG8_SB
#undef PG8_STAGE
#undef PG8_LDA
#undef PG8_LDB
#undef PG8_MMA
#undef PG8_WAIT_V
#undef PG8_WAIT_L
#undef PG8_BAR
#undef PG8_SCHED
}
}

#define XB_TMO      128
#define XB_XCNT(j)  (256  + 64 * (j))
#define XB_XSUB(j)  (1280 + 64 * (j))
#define XB_XGEN(j)  (2304 + 64 * (j))
#define XB_TOP      3328
#define XB_TOPGEN   3392
#define XCD_BAR_WORDS 3456
#define XB_SPIN_CAP (1u << 18)
__device__ __forceinline__ unsigned xb_ld(unsigned* p)              { return __hip_atomic_load(p, __ATOMIC_RELAXED, __HIP_MEMORY_SCOPE_AGENT); }
__device__ __forceinline__ unsigned xb_add(unsigned* p, unsigned v) { return __hip_atomic_fetch_add(p, v, __ATOMIC_RELAXED, __HIP_MEMORY_SCOPE_AGENT); }
__device__ __forceinline__ unsigned xb_xcc_id() { return (unsigned)__builtin_amdgcn_s_getreg((3 << 11) | 20) & 0xFu; }
#define XB_SPIN(cond, bar) do { unsigned _sp = 0; while (cond) { __builtin_amdgcn_s_sleep(1); \
    if ((++_sp & 255u) == 0u) { if (xb_ld(&(bar)[XB_TMO])) break; if (_sp > XB_SPIN_CAP) { atomicAdd(&(bar)[XB_TMO], 1u); break; } } } } while (0)
struct XcdBarrier { unsigned* bar; unsigned x; volatile LAS unsigned* st; };
__device__ __forceinline__ XcdBarrier xcd_barrier_post(unsigned* bar, volatile LAS unsigned* st) {
    XcdBarrier b; b.bar = bar; b.x = xb_xcc_id(); b.st = st;
    if (threadIdx.x == 0) (void)xb_add(&bar[XB_XCNT(b.x)], 1u);
    return b;
}
__device__ __forceinline__ void xcd_barrier_complete(unsigned* bar, unsigned x, unsigned& nloc, unsigned& nx) {
    const unsigned G = gridDim.x * gridDim.y * gridDim.z;
    unsigned sum, cnt, mine, sp = 0u;
    for (;;) {
        sum = 0u; cnt = 0u; mine = 0u;
#pragma unroll
        for (unsigned j = 0; j < 16; ++j) { const unsigned c = xb_ld(&bar[XB_XCNT(j)]); sum += c; cnt += (c > 0u) ? 1u : 0u; mine = (j == x) ? c : mine; }
        if (sum == G) break;
        __builtin_amdgcn_s_sleep(1);
        if ((++sp & 255u) == 0u) { if (xb_ld(&bar[XB_TMO])) break; if (sp > XB_SPIN_CAP) { atomicAdd(&bar[XB_TMO], 1u); break; } }
    }
    nloc = mine > 0u ? mine : 1u; nx = cnt > 0u ? cnt : 1u;
}
__device__ __forceinline__ void xcd_barrier(const XcdBarrier& b) {
    asm volatile("s_waitcnt vmcnt(0)" ::: "memory");
    __syncthreads();
    if (threadIdx.x == 0) {
        unsigned* bar = b.bar;
        __builtin_amdgcn_s_waitcnt(0);
        unsigned nloc = b.st[0], nx = b.st[1];
        if (nloc == 0u) { xcd_barrier_complete(bar, b.x, nloc, nx); b.st[0] = nloc; b.st[1] = nx; }
        const unsigned old = xb_add(&bar[XB_XSUB(b.x)], 1u);
        const unsigned gen = old / nloc;
        if (old + 1u == (gen + 1u) * nloc) {
            __builtin_amdgcn_fence(__ATOMIC_RELEASE, "agent");
            asm volatile("s_waitcnt vmcnt(0)" ::: "memory");
            const unsigned og = xb_add(&bar[XB_TOP], 1u);
            const unsigned tg = og / nx;
            if (og + 1u == (tg + 1u) * nx) xb_add(&bar[XB_TOPGEN], 1u);
            else XB_SPIN(xb_ld(&bar[XB_TOPGEN]) == tg, bar);
            __builtin_amdgcn_fence(__ATOMIC_ACQUIRE, "agent");
            xb_add(&bar[XB_XGEN(b.x)], 1u);
            asm volatile("s_waitcnt vmcnt(0)" ::: "memory");
        } else {
            XB_SPIN(xb_ld(&bar[XB_XGEN(b.x)]) == gen, bar);
            __builtin_amdgcn_fence(__ATOMIC_ACQUIRE, "agent");
            asm volatile("s_waitcnt vmcnt(0)" ::: "memory");
        }
    }
    __syncthreads();
}

constexpr int RING_BYTES = 131072;
constexpr int LDSCTL_OFF = RING_BYTES, MISC_OFF = LDSCTL_OFF + 320;
constexpr int LDS_BYTES = 147456;
constexpr int NWAVES = 8;

struct Args { const float* in[17]; float* out; unsigned char* ws; };

struct Ctx {
    LAS unsigned char* lds;
    int tid, lane, wave, vcu, G;
};

__device__ __forceinline__ Ctx fresh(const Ctx& F) {
    Ctx C = F; int t = threadIdx.x; asm volatile("" : "+v"(t)); C.tid = t; C.lane = t & 63; return C;
}
__device__ __forceinline__ void p0_transpose_item(const float* W, int K, int N, bf16_t* WT, LAS float* scr, int item, int lane) {
    const int nblk = N / 32, kb = item / nblk, nb = item % nblk, k0 = 64 * kb, n0 = 32 * nb;
#pragma unroll 8
    for (int i = 0; i < 32; ++i) { const int kk = 2 * i + (lane >> 5); scr[kk * 33 + (lane & 31)] = W[(size_t)(k0 + kk) * N + n0 + (lane & 31)]; }
    asm volatile("s_waitcnt lgkmcnt(0)" ::: "memory");
    const int c = lane & 7;
#pragma unroll
    for (int j = 0; j < 4; ++j) { const int n = (lane >> 3) + 8 * j; const LAS float* s = scr + (8 * c) * 33 + n;
        u32x4 o; o.x = pk2(s[0 * 33], s[1 * 33]); o.y = pk2(s[2 * 33], s[3 * 33]); o.z = pk2(s[4 * 33], s[5 * 33]); o.w = pk2(s[6 * 33], s[7 * 33]);
        *(u32x4*)(WT + (size_t)(n0 + n) * K + k0 + 8 * c) = o; }
    asm volatile("s_waitcnt lgkmcnt(0)" ::: "memory");
}
__device__ __forceinline__ void p0_transpose_item8(const float* W, int K, int N, unsigned char* WT, LAS float* scr, int item, int lane) {
    const int nblk = N / 32, kb = item / nblk, nb = item % nblk, k0 = 64 * kb, n0 = 32 * nb;
#pragma unroll 8
    for (int i = 0; i < 32; ++i) { const int kk = 2 * i + (lane >> 5); scr[kk * 33 + (lane & 31)] = W[(size_t)(k0 + kk) * N + n0 + (lane & 31)]; }
    asm volatile("s_waitcnt lgkmcnt(0)" ::: "memory");
    const int c = lane & 7;
#pragma unroll
    for (int j = 0; j < 4; ++j) { const int n = (lane >> 3) + 8 * j; const LAS float* s = scr + (8 * c) * 33 + n; constexpr float sc = pg8::W8_SCALE;
        u32x2 o; o.x = fp8_pack4(s[0 * 33] * sc, s[1 * 33] * sc, s[2 * 33] * sc, s[3 * 33] * sc); o.y = fp8_pack4(s[4 * 33] * sc, s[5 * 33] * sc, s[6 * 33] * sc, s[7 * 33] * sc);
        *(u32x2*)(WT + (size_t)(n0 + n) * K + k0 + 8 * c) = o; }
    asm volatile("s_waitcnt lgkmcnt(0)" ::: "memory");
}
__device__ __forceinline__ void cvt8(const float* src, bf16_t* dst) {
    const f32x4 a = *(const f32x4*)src, b = *(const f32x4*)(src + 4);
    u32x4 o; o.x = pk2(a[0], a[1]); o.y = pk2(a[2], a[3]); o.z = pk2(b[0], b[1]); o.w = pk2(b[2], b[3]);
    *(u32x4*)dst = o;
}

__device__ __forceinline__ void p0_prologue(const Ctx& F0, const Args& a) {
    const Ctx F = fresh(F0);
    unsigned char* ws = a.ws;
    const int gw = F.vcu * NWAVES + F.wave, NGW = F.G * NWAVES;
    const long gt = (long)F.vcu * 512 + F.tid, NGT = (long)F.G * 512;
    {
        LAS float* red = (LAS float*)(F.lds);
        const float* c = a.in[1]; const float* cctx = a.in[3]; const float* wmod = a.in[6]; const float* bmod = a.in[7];
        float* modb = (float*)(ws + WS_MOD);
        for (int item = F.vcu; item < 96; item += F.G) {
            const int l = item / 48, nc = item % 48, n0 = nc * 128 + 2 * F.lane, kb = F.wave * 128;
            float sv[9][2];
#pragma unroll
            for (int r = 0; r < 9; ++r)
#pragma unroll
                for (int j = 0; j < 2; ++j) { const int k = kb + 64 * j + F.lane; const float v = (r < 8) ? c[r * DM + k] : cctx[k]; sv[r][j] = v / (1.0f + __expf(-v)); }
            float acc[9][2];
#pragma unroll
            for (int r = 0; r < 9; ++r) { acc[r][0] = 0.f; acc[r][1] = 0.f; }
            const float* wp = wmod + (size_t)l * DM * NMOD + (size_t)kb * NMOD + n0;
#pragma unroll
            for (int j = 0; j < 2; ++j)
#pragma unroll 8
                for (int kl = 0; kl < 64; ++kl) {
                    const f32x2 w = *(const f32x2*)(wp + (size_t)(64 * j + kl) * NMOD);
#pragma unroll
                    for (int r = 0; r < 9; ++r) { const float s = __builtin_bit_cast(float, __builtin_amdgcn_readlane(__builtin_bit_cast(int, sv[r][j]), kl)); acc[r][0] += s * w[0]; acc[r][1] += s * w[1]; }
                }
            __syncthreads();
#pragma unroll
            for (int r = 0; r < 9; ++r) { red[(F.wave * 9 + r) * 128 + 2 * F.lane] = acc[r][0]; red[(F.wave * 9 + r) * 128 + 2 * F.lane + 1] = acc[r][1]; }
            __syncthreads();
            for (int o = F.tid; o < 9 * 128; o += 512) { const int r = o >> 7, nl = o & 127; float s = 0.f;
#pragma unroll
                for (int w = 0; w < 8; ++w) s += red[(w * 9 + r) * 128 + nl];
                modb[(size_t)(l * 9 + r) * NMOD + nc * 128 + nl] = s + bmod[l * NMOD + nc * 128 + nl]; }
        }
        __syncthreads();
    }
    {
        LAS float* scr = (LAS float*)(F.lds + F.wave * 16384);
        constexpr int I_QKV = (DM / 64) * (3 * DM / 32), I_O = (DM / 64) * (DM / 32), I_PQ = (DM / 64) * (2 * DM / 32);
        constexpr int NITEMS = I_QKV + 2 * I_O + 2 * I_PQ;
        for (int it = gw; it < NITEMS; it += NGW) {
            int r = it;
            if (r < I_QKV) { p0_transpose_item8(a.in[8], DM, 3 * DM, ws + WS_WQKV, scr, r, F.lane); continue; } r -= I_QKV;
            if (r < I_O) { p0_transpose_item8(a.in[9], DM, DM, ws + WS_WO, scr, r, F.lane); continue; } r -= I_O;
            if (r < I_O) { p0_transpose_item8(a.in[11], DM, DM, ws + WS_WF, scr, r, F.lane); continue; } r -= I_O;
            if (r < I_PQ) { p0_transpose_item8(a.in[12], DM, 2 * DM, ws + WS_WPQ, scr, r, F.lane); continue; } r -= I_PQ;
            p0_transpose_item8(a.in[12] + (size_t)DM * 2 * DM, DM, 2 * DM, ws + WS_WPQ + (size_t)2 * DM * DM, scr, r, F.lane);
        }
    }
    for (long i = gt; i < 2 * 2 * 128 * 128 / 8; i += NGT) cvt8(a.in[13] + i * 8, (bf16_t*)(ws + WS_SK) + i * 8);
    {
        bf16_t* wc = (bf16_t*)(ws + WS_WC);
        for (long i = gt; i < 512 * 256 / 8; i += NGT) { const int nn = (int)(i >> 5), k0 = (int)(i & 31) * 8; float v[8];
#pragma unroll
            for (int j = 0; j < 8; ++j) { const int m = ((k0 + j) * (nn & 255)) & 255; const float fr = (float)m * (1.0f / 256.0f);
                v[j] = (nn < 256 ? __builtin_amdgcn_cosf(fr) : __builtin_amdgcn_sinf(fr)) * (1.0f / 16.0f); }
            u32x4 o; o.x = pk2(v[0], v[1]); o.y = pk2(v[2], v[3]); o.z = pk2(v[4], v[5]); o.w = pk2(v[6], v[7]);
            *(u32x4*)(wc + i * 8) = o; }
        unsigned char* cs = ws + WS_CS;
        for (long i = gt; i < 2048L * 4096 / 8; i += NGT) { const int np = (int)(i >> 9), c0 = (int)(i & 511) * 8; const int part = c0 >> 11; float v[8];
#pragma unroll
            for (int j = 0; j < 8; ++j) { const int n = (c0 + j) & 2047; const int m = (n * np) & 4095; const float fr = (float)m * (1.0f / 4096.0f);
                v[j] = (part == 0 ? __builtin_amdgcn_cosf(fr) : -__builtin_amdgcn_sinf(fr)) * (pg8::CS_SCALE / 64.0f); }
            u32x2 o; o.x = fp8_pack4(v[0], v[1], v[2], v[3]); o.y = fp8_pack4(v[4], v[5], v[6], v[7]);
            *(u32x2*)(cs + i * 8) = o; }
    }
}

__device__ __forceinline__ unsigned fp4_pack8(const float* v, float sc) {
    unsigned w = 0;
#define FP4C(i) fminf(fmaxf(v[i] * sc, -6.f), 6.f)
    w = __builtin_amdgcn_cvt_scalef32_pk_fp4_f32(w, FP4C(0), FP4C(1), 1.0f, 0);
    w = __builtin_amdgcn_cvt_scalef32_pk_fp4_f32(w, FP4C(2), FP4C(3), 1.0f, 1);
    w = __builtin_amdgcn_cvt_scalef32_pk_fp4_f32(w, FP4C(4), FP4C(5), 1.0f, 2);
    w = __builtin_amdgcn_cvt_scalef32_pk_fp4_f32(w, FP4C(6), FP4C(7), 1.0f, 3);
#undef FP4C
    return w;
}
#define FP4_DEC(w, bs) __builtin_amdgcn_cvt_scalef32_pk_f32_fp4((w), 1.0f, (bs))
__device__ __forceinline__ unsigned i8_pack4(f32x4 v, float sc) {
    const int a = (int)rintf(fminf(fmaxf(v[0] * sc, -127.f), 127.f)), b = (int)rintf(fminf(fmaxf(v[1] * sc, -127.f), 127.f));
    const int c = (int)rintf(fminf(fmaxf(v[2] * sc, -127.f), 127.f)), d = (int)rintf(fminf(fmaxf(v[3] * sc, -127.f), 127.f));
    return (unsigned)(a & 0xff) | ((unsigned)(b & 0xff) << 8) | ((unsigned)(c & 0xff) << 16) | ((unsigned)(d & 0xff) << 24);
}
constexpr long TC_PER = (long)NEXP * DM / 16, TC_TOTAL = 4 * TC_PER;
__device__ __forceinline__ void tc_issue(const Args& a, long i, f32x4 (&v)[4]) {
    const int q = (int)(i / TC_PER); const long r = i - (long)q * TC_PER; const int l = q >> 1, tb = q & 1;
    const int e = (int)(r >> 6), c16 = (int)(r & 63);
    const float* src = (tb ? a.in[15] : a.in[14]) + ((size_t)l * NEXP + e) * DM + c16 * 16;
#pragma unroll
    for (int d = 0; d < 4; ++d) v[d] = *(const f32x4*)(src + 4 * d);
}
__device__ __forceinline__ void tc_finish(const Args& a, long i, const f32x4 (&v)[4]) {
    const int q = (int)(i / TC_PER); const long r = i - (long)q * TC_PER; const int l = q >> 1, tb = q & 1;
    const int e = (int)(r >> 6), c16 = (int)(r & 63);
    const float sc = tb ? V_SCALE : U_SCALE;
    u32x2 o;
#pragma unroll
    for (int d = 0; d < 2; ++d) { const float v8[8] = {v[2 * d][0], v[2 * d][1], v[2 * d][2], v[2 * d][3], v[2 * d + 1][0], v[2 * d + 1][1], v[2 * d + 1][2], v[2 * d + 1][3]};
        o[d] = fp4_pack8(v8, sc); }
    *(u32x2*)(a.ws + WS_TAB + (size_t)l * TAB_LAYER + (tb ? TAB_VOFF : 0) + ((size_t)(c16 >> 4) * NEXP + e) * 128 + (c16 & 15) * 8) = o;
}
__device__ __forceinline__ void table_convert(const Ctx& F0, const Args& a, int sh0, int nsh, int nshare) {
    const Ctx F = fresh(F0);
    constexpr long PER = (long)NEXP * DM / 16;
    constexpr long TOTAL = 4 * PER;
    unsigned char* t8 = a.ws + WS_TAB;
    const long per_share = (TOTAL + nshare - 1) / nshare;
    const long i0 = (long)sh0 * per_share, i1 = min((long)(sh0 + nsh) * per_share, TOTAL);
    for (long i = i0 + F.tid; i < i1; i += 512) {
        const int q = (int)(i / PER); const long r = i - (long)q * PER; const int l = q >> 1, tb = q & 1;
        const int e = (int)(r >> 6), c16 = (int)(r & 63);
        const float* src = (tb ? a.in[15] : a.in[14]) + ((size_t)l * NEXP + e) * DM + c16 * 16;
        if (tb) {
            u32x2 o;
#pragma unroll
            for (int d = 0; d < 2; ++d) { const f32x4 va = *(const f32x4*)(src + 8 * d), vb = *(const f32x4*)(src + 8 * d + 4);
                const float v8[8] = {va[0], va[1], va[2], va[3], vb[0], vb[1], vb[2], vb[3]};
                o[d] = fp4_pack8(v8, V_SCALE); }
            *(u32x2*)(t8 + (size_t)l * TAB_LAYER + TAB_VOFF + ((size_t)(c16 >> 4) * NEXP + e) * 128 + (c16 & 15) * 8) = o;
        } else {
            u32x2 o;
#pragma unroll
            for (int d = 0; d < 2; ++d) { const f32x4 va = *(const f32x4*)(src + 8 * d), vb = *(const f32x4*)(src + 8 * d + 4);
                const float v8[8] = {va[0], va[1], va[2], va[3], vb[0], vb[1], vb[2], vb[3]};
                o[d] = fp4_pack8(v8, U_SCALE); }
            *(u32x2*)(t8 + (size_t)l * TAB_LAYER + ((size_t)(c16 >> 4) * NEXP + e) * 128 + (c16 & 15) * 8) = o;
        }
    }
}

__device__ __forceinline__ const float* norm_src(const Args& a, int mode, int m) { return (m < ML) ? ((mode == 0 ? a.in[0] : a.out) + (size_t)m * DM) : (a.in[2] + (size_t)(m - ML) * DM); }
__device__ __forceinline__ void norm_phase(const Ctx& F0, const Args& a, int mode, int layer, int off, const float* gw) {
    const Ctx F = fresh(F0);
    const int gwv = F.vcu * NWAVES + F.wave, NGW = F.G * NWAVES, lane = F.lane;
    const float* modb = (const float*)(a.ws + WS_MOD) + (size_t)layer * 9 * NMOD;
    bf16_t* hx = (bf16_t*)(a.ws + WS_HX);
    const int nrows = (mode == 0) ? MT : ML;
    f32x4 gv[4];
#pragma unroll
    for (int j = 0; j < 4; ++j) gv[j] = ((const f32x4*)gw)[lane + 64 * j];
    if (mode != 0) {
        const u32x2* XBc = (const u32x2*)(a.ws + WS_XB);
        constexpr int CH = 16, NPF = 4;
        for (int c = gwv; c < ML / CH; c += NGW) {
            const int r0 = c * CH;
            u32x2 rb[NPF][4]; f32x4 v[4], av[4], cv[4];
#pragma unroll
            for (int p = 0; p < NPF; ++p)
#pragma unroll
                for (int j = 0; j < 4; ++j) rb[p][j] = XBc[(size_t)(r0 + p) * 256 + lane + 64 * j];
            { const float* mr = modb + (size_t)(r0 >> 12) * NMOD + off;
#pragma unroll
              for (int j = 0; j < 4; ++j) { av[j] = ((const f32x4*)mr)[lane + 64 * j]; cv[j] = ((const f32x4*)(mr + DM))[lane + 64 * j]; } }
            asm volatile("" :: "v"(cv[3]));
#pragma unroll 1
            for (int q = 0; q < CH / NPF; ++q) {
#pragma unroll
              for (int p = 0; p < NPF; ++p) {
                const int m = r0 + q * NPF + p;
#pragma unroll
                for (int j = 0; j < 4; ++j) v[j] = bf4_f32(rb[p][j]);
                { const int rn = min(m + NPF, r0 + CH - 1);
#pragma unroll
                  for (int j = 0; j < 4; ++j) rb[p][j] = XBc[(size_t)rn * 256 + lane + 64 * j]; }
              float s = 0.f;
#pragma unroll
              for (int j = 0; j < 4; ++j) s += (v[j].x * v[j].x + v[j].y * v[j].y) + (v[j].z * v[j].z + v[j].w * v[j].w);
              const float rstd = 1.0f / sqrtf(wave_sum(s) * (1.0f / DM) + EPS);
              unsigned long long* o8 = (unsigned long long*)(hx + (size_t)m * DM) + lane;
              unsigned* o4 = (unsigned*)(a.ws + WS_HX + (size_t)m * DM) + lane;
#pragma unroll
              for (int j = 0; j < 4; ++j) { const f32x4 y = (v[j] * rstd * gv[j]) * (cv[j] + 1.0f) + av[j];
                  if (mode == 0 || off == 3 * DM) o4[64 * j] = fp8_pack4(y.x * pg8::ACT8_SCALE, y.y * pg8::ACT8_SCALE, y.z * pg8::ACT8_SCALE, y.w * pg8::ACT8_SCALE);
                  if (mode == 0) continue;
                  if (off != 3 * DM)
                  o8[64 * j] = (unsigned long long)cvtpk(y.x, y.y) | ((unsigned long long)cvtpk(y.z, y.w) << 32);
                  if (off == 3 * DM) {
                      const float q0 = fminf(fmaxf(y.x * XQ_SCALE, -6.f), 6.f), q1 = fminf(fmaxf(y.y * XQ_SCALE, -6.f), 6.f), q2 = fminf(fmaxf(y.z * XQ_SCALE, -6.f), 6.f), q3 = fminf(fmaxf(y.w * XQ_SCALE, -6.f), 6.f);
                      unsigned ph = __builtin_amdgcn_cvt_scalef32_pk_fp4_f32(0u, q0, q1, 1.0f, 0); ph = __builtin_amdgcn_cvt_scalef32_pk_fp4_f32(ph, q2, q3, 1.0f, 1);
                      const f32x2 d0 = FP4_DEC(ph, 0), d1 = FP4_DEC(ph, 1);
                      unsigned pl = __builtin_amdgcn_cvt_scalef32_pk_fp4_f32(0u, 4.f * (q0 - d0.x), 4.f * (q1 - d0.y), 1.0f, 0); pl = __builtin_amdgcn_cvt_scalef32_pk_fp4_f32(pl, 4.f * (q2 - d1.x), 4.f * (q3 - d1.y), 1.0f, 1);
                      unsigned short* xq = (unsigned short*)(a.ws + WS_X8 + ((size_t)j * ML + m) * 256) + lane;
                      xq[0] = (unsigned short)(ph & 0xffffu); xq[64] = (unsigned short)(pl & 0xffffu); } }
              }
            }
        }
        return;
    }
    const u32x2* XBr = (const u32x2*)(a.ws + WS_XB);
    f32x4 v[4], vn[4]; u32x2 vr[4];
    if (gwv < nrows) {
        if (mode == 0) { const f32x4* xr = (const f32x4*)norm_src(a, mode, gwv) + lane;
#pragma unroll
            for (int j = 0; j < 4; ++j) vn[j] = xr[64 * j]; }
        else {
#pragma unroll
            for (int j = 0; j < 4; ++j) vr[j] = XBr[(size_t)gwv * 256 + lane + 64 * j]; } }
    for (int m = gwv; m < nrows; m += NGW) {
        const int mn = (m + NGW < nrows) ? m + NGW : m;
        if (mode == 0) {
#pragma unroll
            for (int j = 0; j < 4; ++j) v[j] = vn[j];
            const f32x4* xr = (const f32x4*)norm_src(a, mode, mn) + lane;
#pragma unroll
            for (int j = 0; j < 4; ++j) vn[j] = xr[64 * j];
        } else {
#pragma unroll
            for (int j = 0; j < 4; ++j) v[j] = bf4_f32(vr[j]);
#pragma unroll
            for (int j = 0; j < 4; ++j) vr[j] = XBr[(size_t)mn * 256 + lane + 64 * j];
        }
        const float* mr = modb + (size_t)((m < ML) ? (m >> 12) : 8) * NMOD + off;
        f32x4 av[4], cv[4];
#pragma unroll
        for (int j = 0; j < 4; ++j) { av[j] = ((const f32x4*)mr)[lane + 64 * j]; cv[j] = ((const f32x4*)(mr + DM))[lane + 64 * j]; }
        float s = 0.f;
#pragma unroll
        for (int j = 0; j < 4; ++j) s += (v[j].x * v[j].x + v[j].y * v[j].y) + (v[j].z * v[j].z + v[j].w * v[j].w);
        const float rstd = 1.0f / sqrtf(wave_sum(s) * (1.0f / DM) + EPS);
        unsigned long long* o8 = (unsigned long long*)(hx + (size_t)m * DM) + lane;
        unsigned* o4 = (unsigned*)(a.ws + WS_HX + (size_t)m * DM) + lane;
#pragma unroll
        for (int j = 0; j < 4; ++j) { const f32x4 y = (v[j] * rstd * gv[j]) * (cv[j] + 1.0f) + av[j];
            if (mode == 0 || off == 3 * DM) o4[64 * j] = fp8_pack4(y.x * pg8::ACT8_SCALE, y.y * pg8::ACT8_SCALE, y.z * pg8::ACT8_SCALE, y.w * pg8::ACT8_SCALE);
            if (mode == 0) continue;
            if (off != 3 * DM)
            o8[64 * j] = (unsigned long long)cvtpk(y.x, y.y) | ((unsigned long long)cvtpk(y.z, y.w) << 32);
            if (off == 3 * DM) {
                const float q0 = fminf(fmaxf(y.x * XQ_SCALE, -6.f), 6.f), q1 = fminf(fmaxf(y.y * XQ_SCALE, -6.f), 6.f), q2 = fminf(fmaxf(y.z * XQ_SCALE, -6.f), 6.f), q3 = fminf(fmaxf(y.w * XQ_SCALE, -6.f), 6.f);
                unsigned ph = __builtin_amdgcn_cvt_scalef32_pk_fp4_f32(0u, q0, q1, 1.0f, 0); ph = __builtin_amdgcn_cvt_scalef32_pk_fp4_f32(ph, q2, q3, 1.0f, 1);
                const f32x2 d0 = FP4_DEC(ph, 0), d1 = FP4_DEC(ph, 1);
                unsigned pl = __builtin_amdgcn_cvt_scalef32_pk_fp4_f32(0u, 4.f * (q0 - d0.x), 4.f * (q1 - d0.y), 1.0f, 0); pl = __builtin_amdgcn_cvt_scalef32_pk_fp4_f32(pl, 4.f * (q2 - d1.x), 4.f * (q3 - d1.y), 1.0f, 1);
                unsigned short* xq = (unsigned short*)(a.ws + WS_X8 + ((size_t)j * ML + m) * 256) + lane;
                xq[0] = (unsigned short)(ph & 0xffffu); xq[64] = (unsigned short)(pl & 0xffffu); } }
    }
}
__device__ __forceinline__ void norm_fold_phase(const Ctx& F0, const Args& a, int layer, const float* gw) {
    const Ctx F = fresh(F0);
    const int gwv = F.vcu * NWAVES + F.wave, NGW = F.G * NWAVES, lane = F.lane;
    const float* modb = (const float*)(a.ws + WS_MOD) + (size_t)layer * 9 * NMOD;
    const u32x2* XBr = (const u32x2*)(a.ws + WS_XB);
    unsigned long long* hc = (unsigned long long*)(a.ws + WS_HX);
    unsigned long long* hs = (unsigned long long*)(a.ws + WS_HX + 32 * MiB);
    float* yni = (float*)(a.ws + WS_YNI);
    f32x4 gv[4];
#pragma unroll
    for (int j = 0; j < 4; ++j) gv[j] = ((const f32x4*)gw)[lane + 64 * j];
    u32x2 ra[4], rb[4];
#define NF_ROWS(task_, na_, nb_) const int b_ = (task_) >> 11, t_ = (task_) & 2047; const int na_ = b_ * SEQ + t_, nb_ = b_ * SEQ + (t_ == 0 ? 2048 : SEQ - t_)
    if (gwv < NB * 2048) { NF_ROWS(gwv, na, nb);
#pragma unroll
        for (int j = 0; j < 4; ++j) { ra[j] = XBr[(size_t)na * 256 + lane + 64 * j]; rb[j] = XBr[(size_t)nb * 256 + lane + 64 * j]; } }
    for (int task = gwv; task < NB * 2048; task += NGW) {
        const int b = task >> 11, t = task & 2047;
        f32x4 va[4], vb[4];
#pragma unroll
        for (int j = 0; j < 4; ++j) { va[j] = bf4_f32(ra[j]); vb[j] = bf4_f32(rb[j]); }
        { const int tn = (task + NGW < NB * 2048) ? task + NGW : task; NF_ROWS(tn, na, nb);
#pragma unroll
          for (int j = 0; j < 4; ++j) { ra[j] = XBr[(size_t)na * 256 + lane + 64 * j]; rb[j] = XBr[(size_t)nb * 256 + lane + 64 * j]; } }
        const float* mr = modb + (size_t)b * NMOD;
        f32x4 av[4], cv[4];
#pragma unroll
        for (int j = 0; j < 4; ++j) { av[j] = ((const f32x4*)mr)[lane + 64 * j]; cv[j] = ((const f32x4*)(mr + DM))[lane + 64 * j]; }
        float sa = 0.f, sb = 0.f;
#pragma unroll
        for (int j = 0; j < 4; ++j) { sa += (va[j].x * va[j].x + va[j].y * va[j].y) + (va[j].z * va[j].z + va[j].w * va[j].w); sb += (vb[j].x * vb[j].x + vb[j].y * vb[j].y) + (vb[j].z * vb[j].z + vb[j].w * vb[j].w); }
        const float ra_ = 1.0f / sqrtf(wave_sum(sa) * (1.0f / DM) + EPS), rb_ = 1.0f / sqrtf(wave_sum(sb) * (1.0f / DM) + EPS);
        const size_t orow = ((size_t)b * 2048 + t) * 256 + lane;
#pragma unroll
        for (int j = 0; j < 4; ++j) {
            const f32x4 ya = (va[j] * ra_ * gv[j]) * (cv[j] + 1.0f) + av[j], yb = (vb[j] * rb_ * gv[j]) * (cv[j] + 1.0f) + av[j];
            f32x4 ys, yd;
            if (t == 0) { ys = ya; yd = (f32x4){0.f, 0.f, 0.f, 0.f}; ((f32x4*)(yni + (size_t)b * DM))[lane + 64 * j] = yb; }
            else { ys = ya + yb; yd = ya - yb; }
            hc[orow + 64 * j] = (unsigned long long)cvtpk(ys.x, ys.y) | ((unsigned long long)cvtpk(ys.z, ys.w) << 32);
            hs[orow + 64 * j] = (unsigned long long)cvtpk(yd.x, yd.y) | ((unsigned long long)cvtpk(yd.z, yd.w) << 32);
        }
    }
#undef NF_ROWS
}
__device__ __forceinline__ void final_norm_phase(const Ctx& F0, const Args& a) {
    const Ctx F = fresh(F0);
    const int gwv = F.vcu * NWAVES + F.wave, NGW = F.G * NWAVES;
    const float* gw = a.in[16];
    const u32x2* XBr = (const u32x2*)(a.ws + WS_XB);
    f32x4 gv[4]; u32x2 vr[4];
#pragma unroll
    for (int j = 0; j < 4; ++j) gv[j] = ((const f32x4*)gw)[F.lane + 64 * j];
    if (gwv < ML) {
#pragma unroll
        for (int j = 0; j < 4; ++j) vr[j] = XBr[(size_t)gwv * 256 + F.lane + 64 * j]; }
    for (int m = gwv; m < ML; m += NGW) {
        f32x4* xr = (f32x4*)(a.out + (size_t)m * DM) + F.lane;
        f32x4 v[4]; float s = 0.f;
#pragma unroll
        for (int j = 0; j < 4; ++j) { v[j] = bf4_f32(vr[j]); s += (v[j].x * v[j].x + v[j].y * v[j].y) + (v[j].z * v[j].z + v[j].w * v[j].w); }
        { const int mn = (m + NGW < ML) ? m + NGW : m;
#pragma unroll
          for (int j = 0; j < 4; ++j) vr[j] = XBr[(size_t)mn * 256 + F.lane + 64 * j]; }
        const float rstd = 1.0f / sqrtf(wave_sum(s) * (1.0f / DM) + EPS);
#pragma unroll
        for (int j = 0; j < 4; ++j) xr[64 * j] = v[j] * rstd * gv[j];
    }
}

constexpr int ATT_ROWB = 144, ATT_KTILEB = 128 * ATT_ROWB, ATT_VROWB = 272, ATT_VTILEB = 64 * ATT_VROWB, ATT_BIAS_B = 2048, ATT_K0 = ATT_BIAS_B, ATT_V0 = ATT_K0 + 2 * ATT_KTILEB;
constexpr float ATT_THR = 8.0f;
template <int NGH, bool LATENT>
__device__ __forceinline__ void attn_sub(const LAS unsigned char* Kt, const LAS unsigned char* Vt_, int ko, const LAS float* browA, const LAS float* browB, const int (&relidx)[8],
                                         const bf16x8 (&qf)[2], float& m_ref, float& l_run, f32x4 (&o)[4], int q16, int g4) {
    constexpr int NG = 2 * NGH;
    bf16x8 kf[2 * NG][2]; u32x2 vf[4][NG][2]; f32x4 sc[2 * NG];
#pragma unroll
    for (int gk = 0; gk < NG; ++gk)
#pragma unroll
        for (int b2 = 0; b2 < 2; ++b2)
#pragma unroll
            for (int ks = 0; ks < 2; ++ks) kf[2 * gk + b2][ks] = *(const LAS bf16x8*)(Kt + ((gk / NGH) * 64 + ko + 32 * (gk % NGH) + 16 * b2 + q16) * ATT_ROWB + 64 * ks + 16 * g4);
#pragma unroll
    for (int d = 0; d < 4; ++d)
#pragma unroll
        for (int gk = 0; gk < NG; ++gk) { const LAS unsigned char* vp = Vt_ + (16 * d + q16) * ATT_VROWB + 2 * ((gk / NGH) * 64 + ko + 32 * (gk % NGH) + 4 * g4);
            vf[d][gk][0] = *(const LAS u32x2*)vp; vf[d][gk][1] = *(const LAS u32x2*)(vp + 32); }
    if (LATENT) {
#pragma unroll
        for (int kk = 0; kk < 8; ++kk) { sc[kk >> 2][kk & 3] = browA[relidx[kk]] - m_ref; sc[2 + (kk >> 2)][kk & 3] = browB[relidx[kk]] - m_ref; }
    } else {
#pragma unroll
        for (int blk = 0; blk < 2 * NG; ++blk) sc[blk] = (f32x4){-m_ref, -m_ref, -m_ref, -m_ref};
    }
#pragma unroll
    for (int blk = 0; blk < 2 * NG; ++blk)
#pragma unroll
        for (int ks = 0; ks < 2; ++ks) sc[blk] = __builtin_amdgcn_mfma_f32_16x16x32_bf16(kf[blk][ks], qf[ks], sc[blk], 0, 0, 0);
    float mx = fmaxf(fmaxf(sc[0][0], sc[0][1]), fmaxf(sc[0][2], sc[0][3]));
#pragma unroll
    for (int blk = 1; blk < 2 * NG; ++blk) mx = fmaxf(mx, fmaxf(fmaxf(sc[blk][0], sc[blk][1]), fmaxf(sc[blk][2], sc[blk][3])));
    if (__builtin_amdgcn_ballot_w64(mx > ATT_THR) != 0ull) {
        mx = fmaxf(mx, __shfl_xor(mx, 16)); mx = fmaxf(mx, __shfl_xor(mx, 32));
        const float dl = mx > ATT_THR ? mx : 0.f;
        m_ref += dl;
        const float al = __builtin_amdgcn_exp2f(-dl);
        l_run *= al;
#pragma unroll
        for (int d = 0; d < 4; ++d) o[d] *= al;
#pragma unroll
        for (int blk = 0; blk < 2 * NG; ++blk) sc[blk] -= dl;
    }
    float ls0 = 0.f, ls1 = 0.f;
#pragma unroll
    for (int blk = 0; blk < 2 * NG; ++blk)
#pragma unroll
        for (int i = 0; i < 4; ++i) { const float e = __builtin_amdgcn_exp2f(sc[blk][i]); sc[blk][i] = e; if (blk & 1) ls1 += e; else ls0 += e; }
    l_run += ls0 + ls1;
    bf16x8 pf[NG];
#pragma unroll
    for (int gk = 0; gk < NG; ++gk) { u32x4 pw; pw.x = cvtpk(sc[2 * gk][0], sc[2 * gk][1]); pw.y = cvtpk(sc[2 * gk][2], sc[2 * gk][3]); pw.z = cvtpk(sc[2 * gk + 1][0], sc[2 * gk + 1][1]); pw.w = cvtpk(sc[2 * gk + 1][2], sc[2 * gk + 1][3]);
        pf[gk] = __builtin_bit_cast(bf16x8, pw); }
#pragma unroll
    for (int gk = 0; gk < NG; ++gk)
#pragma unroll
        for (int d = 0; d < 4; ++d) { u32x4 vw; vw.x = vf[d][gk][0].x; vw.y = vf[d][gk][0].y; vw.z = vf[d][gk][1].x; vw.w = vf[d][gk][1].y;
            o[d] = __builtin_amdgcn_mfma_f32_16x16x32_bf16(__builtin_bit_cast(bf16x8, vw), pf[gk], o[d], 0, 0, 0); }
}
__device__ __forceinline__ void attn_phase(const Ctx& F0, const Args& a) {
    const Ctx F = fresh(F0);
    const bf16_t* QK = (const bf16_t*)(a.ws + WS_QK);
    const bf16_t* VT = (const bf16_t*)(a.ws + WS_VT);
    unsigned char* AO = a.ws + WS_HX + 36 * MiB;
    const float* rpb = a.in[10];
    LAS float* bias = (LAS float*)F.lds;
    const int tid = F.tid, lane = F.lane, q16 = lane & 15, g4 = lane >> 4;
    const int rr = F.wave >> 2, jt = F.wave & 3;
    const int qc = 16 * jt + q16, cs = min(max(qc - 8, 0), 48), ksj = min(max(16 * jt - 8, 0), 32);
    int relidx[8];
#pragma unroll
    for (int k = 0; k < 8; ++k) { const int kc = ksj + 16 * (k >> 2) + 4 * g4 + (k & 3); relidx[k] = (kc >= cs && kc < cs + 16) ? (kc - qc + 15) : 31; }
    const int krow = tid >> 3, kch = tid & 7, vrow = tid >> 4, vch = tid & 15;
    const unsigned lds_k = (unsigned)(krow * ATT_ROWB + kch * 16), lds_v = (unsigned)(vrow * ATT_VROWB + vch * 16);
    const int nunits = NB * 16 * 32, upb = (nunits + F.G - 1) / F.G;
    int cur_bh = -1;
    for (int k = 0; k < upb; ++k) {
        const int id = F.vcu * upb + k; if (id >= nunits) break;
        const int p = id & 31, bh = id >> 5, b = bh >> 4, h = bh & 15;
        if (bh != cur_bh) {
            __syncthreads();
            for (int i = tid; i < 16 * 32; i += 512) { const int dr = i >> 5, dc = i & 31; bias[i] = (dc < 31 && dr < 15) ? rpb[(h * 15 + dr) * 31 + dc] * LOG2E : -1e30f; }
            cur_bh = bh;
        }
        const int r0 = 2 * p, rs0 = min(max(r0 - 4, 0), 56), rs1 = min(max(r0 + 1 - 4, 0), 56);
        const int nlat = rs1 + 8 - rs0, nlt = (nlat + 1) >> 1, nsteps = nlt + 2;
        const int r = r0 + rr, rs = rr ? rs1 : rs0;
        const long tokq = (long)b * SEQ + r * GW + qc;
        const bf16_t* kbase = QK + 1024 + h * 64 + kch * 8;
        const bf16_t* vbase = VT + (long)(h * 64 + vrow) * MT + (vch & 7) * 8;
#define ATT_TOKA(step) ((step) < nlt ? ((long)b * SEQ + (long)(rs0 + 2 * (step)) * GW) : ((long)ML + b * CTXL + ((step) - nlt) * 128))
#define ATT_TOKB(step) ((step) < nlt ? ((long)b * SEQ + (long)min(rs0 + 2 * (step) + 1, rs0 + nlat - 1) * GW) : ((long)ML + b * CTXL + ((step) - nlt) * 128 + 64))
        u32x4 kA[2], vA[2], kB[2], vB[2];
#define ATT_LOAD(step, kr_, vr_) do { const int st_ = (step) < nsteps ? (step) : nsteps - 1; const long ta_ = ATT_TOKA(st_), tb_ = ATT_TOKB(st_);     \
        kr_[0] = *(const u32x4*)(kbase + (ta_ + krow) * 2048); kr_[1] = *(const u32x4*)(kbase + (tb_ + krow) * 2048); \
        const long tv_ = (vch < 8) ? ta_ : tb_; vr_[0] = *(const u32x4*)(vbase + tv_); vr_[1] = *(const u32x4*)(vbase + (long)32 * MT + tv_); } while (0)
#define ATT_WRITE(buf, kr_, vr_) do { *(LAS u32x4*)(F.lds + ATT_K0 + (buf) * ATT_KTILEB + lds_k) = kr_[0]; *(LAS u32x4*)(F.lds + ATT_K0 + (buf) * ATT_KTILEB + 64 * ATT_ROWB + lds_k) = kr_[1]; \
        *(LAS u32x4*)(F.lds + ATT_V0 + (buf) * ATT_VTILEB + lds_v) = vr_[0]; *(LAS u32x4*)(F.lds + ATT_V0 + (buf) * ATT_VTILEB + 32 * ATT_VROWB + lds_v) = vr_[1]; } while (0)
        ATT_LOAD(0, kA, vA); ATT_LOAD(1, kB, vB);
        f32x4 tcv0[4], tcv1[4];
        const int tci0 = (id * 2) * 512 + tid;
        tc_issue(a, tci0, tcv0); tc_issue(a, tci0 + 512, tcv1);
        bf16x8 qf[2];
#pragma unroll
        for (int ks = 0; ks < 2; ++ks) qf[ks] = *(const bf16x8*)(QK + tokq * 2048 + h * 64 + 32 * ks + 8 * g4);
        float m_ref = 0.f, l_run = 0.f;
        f32x4 o[4];
#pragma unroll
        for (int d = 0; d < 4; ++d) o[d] = (f32x4){0.f, 0.f, 0.f, 0.f};
        __syncthreads();
        ATT_WRITE(0, kA, vA);
        asm volatile("" :: "v"(qf[0]), "v"(qf[1]));
        __syncthreads();
#define ATT_COMPUTE(step, cur) do { \
            const LAS unsigned char* Kt = F.lds + ATT_K0 + (cur) * ATT_KTILEB; \
            const LAS unsigned char* Vt_ = F.lds + ATT_V0 + (cur) * ATT_VTILEB; \
            if ((step) < nlt) { const int krA = rs0 + 2 * (step), krB = krA + 1; \
                const bool actA = krA >= rs && krA < rs + 8, actB = krB < rs0 + nlat && krB >= rs && krB < rs + 8; \
                if (actA || actB) attn_sub<1, true>(Kt, Vt_, ksj, bias + (actA ? (krA - r + 7) : 15) * 32, bias + (actB ? (krB - r + 7) : 15) * 32, relidx, qf, m_ref, l_run, o, q16, g4); \
            } else attn_sub<2, false>(Kt, Vt_, 0, bias, bias, relidx, qf, m_ref, l_run, o, q16, g4); \
        } while (0)
        for (int step = 0; step < nsteps; step += 2) {
            ATT_COMPUTE(step, 0);
            if (step + 1 < nsteps) ATT_WRITE(1, kB, vB);
            ATT_LOAD(step + 2, kA, vA);
            __syncthreads();
            if (step + 1 < nsteps) { ATT_COMPUTE(step + 1, 1); }
            if (step + 2 < nsteps) ATT_WRITE(0, kA, vA);
            ATT_LOAD(step + 3, kB, vB);
            __syncthreads();
        }
#undef ATT_LOAD
#undef ATT_WRITE
#undef ATT_COMPUTE
#undef ATT_TOKA
#undef ATT_TOKB
        { int ti_ = (id * 2) * 512 + tid; asm volatile("" : "+v"(ti_));
          tc_finish(a, ti_, tcv0); tc_finish(a, ti_ + 512, tcv1); }
        l_run += __shfl_xor(l_run, 16); l_run += __shfl_xor(l_run, 32);
        const float linv = 1.0f / l_run;
        unsigned char* op = AO + tokq * DM + h * 64 + 4 * g4; const float ls = linv * pg8::ACT8_SCALE;
#pragma unroll
        for (int d = 0; d < 4; ++d) *(unsigned*)(op + 16 * d) = fp8_pack4(o[d][0] * ls, o[d][1] * ls, o[d][2] * ls, o[d][3] * ls);
    }
    __syncthreads();
}

__device__ __forceinline__ void ce_desc(float& a, float& b) { const float hi = fmaxf(a, b), lo = fminf(a, b); a = hi; b = lo; }
__device__ __forceinline__ void ce_dir(float& a, float& b, bool desc) { const float hi = fmaxf(a, b), lo = fminf(a, b); a = desc ? hi : lo; b = desc ? lo : hi; }
__device__ __forceinline__ void sort16_desc(float (&v)[16]) {
#define S16CE(i, j) { const float hi_ = fmaxf(v[i], v[j]), lo_ = fminf(v[i], v[j]); v[i] = hi_; v[j] = lo_; }
    S16CE(0,13) S16CE(1,12) S16CE(2,15) S16CE(3,14) S16CE(4,8) S16CE(5,6) S16CE(7,11) S16CE(9,10)
    S16CE(0,5) S16CE(1,7) S16CE(2,9) S16CE(3,4) S16CE(6,13) S16CE(8,14) S16CE(10,15) S16CE(11,12)
    S16CE(0,1) S16CE(2,3) S16CE(4,5) S16CE(6,8) S16CE(7,9) S16CE(10,11) S16CE(12,13) S16CE(14,15)
    S16CE(0,2) S16CE(1,3) S16CE(4,10) S16CE(5,11) S16CE(6,7) S16CE(8,9) S16CE(12,14) S16CE(13,15)
    S16CE(1,2) S16CE(3,12) S16CE(4,6) S16CE(5,7) S16CE(8,10) S16CE(9,11) S16CE(13,14)
    S16CE(1,4) S16CE(2,6) S16CE(5,8) S16CE(7,10) S16CE(9,13) S16CE(11,14)
    S16CE(2,4) S16CE(3,6) S16CE(9,12) S16CE(11,13)
    S16CE(3,5) S16CE(6,8) S16CE(7,9) S16CE(10,12)
    S16CE(3,4) S16CE(5,6) S16CE(7,8) S16CE(9,10) S16CE(11,12)
    S16CE(6,7) S16CE(8,9)
#undef S16CE
}
__device__ __forceinline__ void merge16_desc(float (&a)[16], const float (&b)[16]) {
#pragma unroll
    for (int i = 0; i < 16; ++i) a[i] = fmaxf(a[i], b[15 - i]);
#pragma unroll
    for (int j = 8; j > 0; j >>= 1)
#pragma unroll
        for (int i = 0; i < 16; ++i) { const int l = i ^ j; if (l > i) ce_desc(a[i], a[l]); }
}

struct CandTab { int i[64]; int j[64]; };
__host__ __device__ constexpr CandTab make_cand_tab() {
    CandTab t{}; int n = 0;
    for (int i = 0; i < 16; ++i) for (int j = 0; j < 16; ++j) if ((i + 1) * (j + 1) <= 16) { t.i[n] = i; t.j[n] = j; ++n; }
    for (; n < 64; ++n) { t.i[n] = -1; t.j[n] = -1; }
    return t;
}

__device__ __forceinline__ void peer_topk_phase(const Ctx& F0, const Args& a, int layer) {
    const Ctx F = fresh(F0);
    const bf16_t* QP = (const bf16_t*)(a.ws + WS_QK);
    const bf16_t* SK = (const bf16_t*)(a.ws + WS_SK) + (size_t)layer * 2 * 128 * 128;
    unsigned short* IDX = (unsigned short*)(a.ws + WS_IDX);
    float* GATE = (float*)(a.ws + WS_GATE);
    const int gwv = F.vcu * NWAVES + F.wave, NGW = F.G * NWAVES;
    const int lane = F.lane, t32 = lane & 31, hi = lane >> 5;
    __syncthreads();
    for (int c = F.tid; c < 4096; c += 512) *(LAS u32x4*)(F.lds + (c >> 4) * 272 + (c & 15) * 16) = *(const u32x4*)(SK + (size_t)c * 8);
    __syncthreads();
#define TK_LDQ(dst, task_, p_) do { const int tk_ = (task_) < 1024 * 8 ? (task_) : 1024 * 8 - 1; const bf16_t* qp_ = QP + ((long)(tk_ >> 3) * 32 + t32) * 2048 + (tk_ & 7) * 256 + (p_) * 128 + hi * 8; \
        _Pragma("unroll") for (int ks = 0; ks < 8; ++ks) dst[ks] = *(const bf16x8*)(qp_ + ks * 16); } while (0)
    bf16x8 qn[8];
    TK_LDQ(qn, gwv, 0);
    for (int task = gwv; task < 1024 * 8; task += NGW) {
        const int tt = task >> 3, h = task & 7;
        const long tok = (long)tt * 32 + t32;
        float top[2][16];
#pragma unroll
        for (int p = 0; p < 2; ++p) {
            bf16x8 qc[8];
#pragma unroll
            for (int ks = 0; ks < 8; ++ks) qc[ks] = qn[ks];
            if (p == 0) TK_LDQ(qn, task, 1); else TK_LDQ(qn, task + NGW, 0);
            f32x16 acc[4];
#pragma unroll
            for (int eb = 0; eb < 4; ++eb)
#pragma unroll
                for (int i = 0; i < 16; ++i) acc[eb][i] = 0.f;
#pragma unroll
            for (int eb = 0; eb < 4; ++eb) asm volatile("" : "+v"(acc[eb]));
            const LAS unsigned char* kp = F.lds + (p * 128 + t32) * 272 + hi * 16;
#pragma unroll
            for (int ks = 0; ks < 8; ++ks) {
                if ((ks & 1) == 0) asm volatile("" ::: "memory");
                const bf16x8 bq = qc[ks];
#pragma unroll
                for (int eb = 0; eb < 4; ++eb) { const bf16x8 ak = *(const LAS bf16x8*)(kp + eb * 32 * 272 + ks * 32); acc[eb] = __builtin_amdgcn_mfma_f32_32x32x16_bf16(ak, bq, acc[eb], 0, 0, 0); }
            }
            float cur[16];
#pragma unroll
            for (int eb = 0; eb < 4; ++eb) {
                float v[16];
#pragma unroll
                for (int i = 0; i < 16; ++i) { const unsigned e = 32 * eb + crow(i, hi); float x = acc[eb][i]; asm volatile("" : "+v"(x));
                    v[i] = __builtin_bit_cast(float, (__builtin_bit_cast(unsigned, x) & ~0x7Fu) | e); }
                sort16_desc(v);
                if (eb == 0) {
#pragma unroll
                    for (int i = 0; i < 16; ++i) cur[i] = v[i];
                } else merge16_desc(cur, v);
            }
            float oth[16];
#pragma unroll
            for (int i = 0; i < 16; ++i) oth[i] = __shfl_xor(cur[i], 32);
            merge16_desc(cur, oth);
#pragma unroll
            for (int i = 0; i < 16; ++i) top[p][i] = cur[i];
            __builtin_amdgcn_sched_barrier(0);
        }
        float best[16];
#pragma unroll
        for (int gI = 0; gI < 4; ++gI) {
            float v[16];
#pragma unroll
            for (int q = 0; q < 16; ++q) {
                constexpr CandTab CT = make_cand_tab();
                const int ci = CT.i[16 * gI + q], cj = CT.j[16 * gI + q];
                if (ci >= 0) {
                    const unsigned ua = __builtin_bit_cast(unsigned, top[0][ci]), ub = __builtin_bit_cast(unsigned, top[1][cj]);
                    float s = top[0][ci] + top[1][cj]; asm volatile("" : "+v"(s));
                    const unsigned code = ((ua & 0x7Fu) << 7) | (ub & 0x7Fu);
                    v[q] = __builtin_bit_cast(float, (__builtin_bit_cast(unsigned, s) & ~0x3FFFu) | code);
                } else v[q] = -3.0e38f;
            }
            sort16_desc(v);
            if (gI == 0) {
#pragma unroll
                for (int i = 0; i < 16; ++i) best[i] = v[i];
            } else merge16_desc(best, v);
            __builtin_amdgcn_sched_barrier(0);
        }
        float e[16], sum = 0.f;
#pragma unroll
        for (int i = 0; i < 16; ++i) { e[i] = __builtin_amdgcn_exp2f((best[i] - best[0]) * LOG2E); sum += e[i]; }
        const float inv = 1.0f / sum;
        if (hi == 0) {
            u32x4 w0, w1;
            w0.x = (__builtin_bit_cast(unsigned, best[0]) & 0x3FFFu) | ((__builtin_bit_cast(unsigned, best[1]) & 0x3FFFu) << 16);
            w0.y = (__builtin_bit_cast(unsigned, best[2]) & 0x3FFFu) | ((__builtin_bit_cast(unsigned, best[3]) & 0x3FFFu) << 16);
            w0.z = (__builtin_bit_cast(unsigned, best[4]) & 0x3FFFu) | ((__builtin_bit_cast(unsigned, best[5]) & 0x3FFFu) << 16);
            w0.w = (__builtin_bit_cast(unsigned, best[6]) & 0x3FFFu) | ((__builtin_bit_cast(unsigned, best[7]) & 0x3FFFu) << 16);
            w1.x = (__builtin_bit_cast(unsigned, best[8]) & 0x3FFFu) | ((__builtin_bit_cast(unsigned, best[9]) & 0x3FFFu) << 16);
            w1.y = (__builtin_bit_cast(unsigned, best[10]) & 0x3FFFu) | ((__builtin_bit_cast(unsigned, best[11]) & 0x3FFFu) << 16);
            w1.z = (__builtin_bit_cast(unsigned, best[12]) & 0x3FFFu) | ((__builtin_bit_cast(unsigned, best[13]) & 0x3FFFu) << 16);
            w1.w = (__builtin_bit_cast(unsigned, best[14]) & 0x3FFFu) | ((__builtin_bit_cast(unsigned, best[15]) & 0x3FFFu) << 16);
            u32x4* ip = (u32x4*)(IDX + tok * 128 + h * 16);
            ip[0] = w0; ip[1] = w1;
        } else {
            f32x4* gp = (f32x4*)(GATE + tok * 128 + h * 16);
#pragma unroll
            for (int q = 0; q < 4; ++q) gp[q] = (f32x4){e[4 * q] * inv, e[4 * q + 1] * inv, e[4 * q + 2] * inv, e[4 * q + 3] * inv};
        }
    }
#undef TK_LDQ
    __syncthreads();
}

typedef long i64_t;
typedef unsigned u32x8_t __attribute__((ext_vector_type(8)));
typedef _Float16 h2_t __attribute__((ext_vector_type(2)));
#define U_MFMA4_FIRST(acc, av, bv) asm volatile("v_mfma_scale_f32_16x16x128_f8f6f4 %0, %1, %2, 0, %3, %4 op_sel_hi:[0,0,0] cbsz:4 blgp:4" : "=&v"(acc) : "v"(av), "v"(bv), "v"(sc_a), "v"(sc_one))
#define U_MFMA4(acc, av, bv) asm volatile("v_mfma_scale_f32_16x16x128_f8f6f4 %0, %1, %2, %0, %3, %4 op_sel_hi:[0,0,0] cbsz:4 blgp:4" : "+v"(acc) : "v"(av), "v"(bv), "v"(sc_a), "v"(sc_one))
template <int UVAR = 0>
__device__ __forceinline__ void peer_u_phase(const Ctx& F0, const Args& a, int layer) {
    const Ctx F = fresh(F0);
    const int s = (int)(blockIdx.x & 3), half = (int)((blockIdx.x >> 2) & 1), j = (int)(blockIdx.x >> 3), nmem = F.G >> 3;
    const unsigned char* U4s = a.ws + WS_TAB + (size_t)layer * TAB_LAYER + (size_t)s * NEXP * 128;
    const unsigned* XQ = (const unsigned*)(a.ws + WS_X8 + (size_t)s * ML * 256);
    const unsigned short* IDX = (const unsigned short*)(a.ws + WS_IDX);
    unsigned* PART = (unsigned*)(a.ws + WS_PART) + (size_t)s * ML * 64;
    const int lane = F.lane, rsub = lane >> 3, c8 = lane & 7, n16 = lane & 15, g4 = lane >> 4;
    LAS unsigned char* tile = F.lds + F.wave * 16384;
    constexpr float osc = 1.0f / (U_SCALE * XQ_SCALE);
    constexpr int MLH = ML / 2;
    const int t0 = half * MLH + j * NWAVES + F.wave, stride = nmem * NWAVES, ntok = (half * MLH + MLH - t0 + stride - 1) / stride;
    unsigned sc_one = 0x7f7f7f7fu; asm volatile("" : "+v"(sc_one));
    unsigned sc_a = (n16 & 1) ? 0x7d7d7d7du : 0x7f7f7f7fu; asm volatile("" : "+v"(sc_a));
    const int abase = (32 * (n16 & 1) + 4 * g4) * 4;
#define U_TOK(i) ((size_t)(t0 + ((i) < ntok ? (i) : ntok - 1) * stride))
    const unsigned wx0 = (unsigned)(size_t)(tile + rsub * 2048 + (c8 << 4));
    const unsigned rb0 = (unsigned)(size_t)(tile + n16 * 128 + ((g4 ^ ((n16 >> 1) & 7)) << 4));
    LAS unsigned char* stg = tile + g4 * 512 + n16 * 4;
#define U_LDXQ(i) (XQ[U_TOK(i) * 64 + lane])
#define U_LDI(i) (((const unsigned*)IDX)[U_TOK(i) * 64 + lane])
#define U_IDP(dst, ci) do { _Pragma("unroll") for (int k = 0; k < 8; ++k) dst[k] = (unsigned)__builtin_amdgcn_ds_bpermute((8 * rsub + k) * 4, (int)(ci)); } while (0)
#define U_EIDP(idp, i_) (((i_) & 1) ? (idp[(i_) >> 1] >> 16) : (idp[(i_) >> 1] & 0xffffu))
#define U_READS(nb0) do { \
        _Pragma("unroll") for (int nb = 0; nb < 4; ++nb) { _Pragma("unroll") for (int ks = 0; ks < 2; ++ks) \
            bw[nb][ks] = *(const LAS u32x4*)((LAS unsigned char*)(size_t)(rb0 ^ (64u * ks)) + 2048 * ((nb0) + nb)); } \
        __builtin_amdgcn_sched_barrier(0); \
    } while (0)
#define U_MFMAS() do { \
        _Pragma("unroll") for (int nb = 0; nb < 4; ++nb) U_MFMA4_FIRST(dA[nb], aop[0], bw[nb][0]); \
        _Pragma("unroll") for (int nb = 0; nb < 4; ++nb) U_MFMA4(dA[nb], aop[1], bw[nb][1]); \
        __builtin_amdgcn_sched_barrier(0); \
    } while (0)
#define U_OUTS(nb0) do { \
        asm volatile("s_nop 15\n\ts_nop 3" : "+v"(dA[0]), "+v"(dA[1]), "+v"(dA[2]), "+v"(dA[3]) :: "memory");     \
        _Pragma("unroll") for (int nb = 0; nb < 4; ++nb) { ov[(nb0) + nb] = dA[nb][0] + dA[nb][1]; asm volatile("" : "+v"(ov[(nb0) + nb])); } \
    } while (0)
#define U_BODY(j, CUR, NXT, LD) do { \
        unsigned idp[8]; \
        U_IDP(idp, ci##NXT);                                             \
          \
        _Pragma("unroll") for (int i_ = 0; i_ < 16; ++i_) { \
            *(LAS u32x4*)((LAS unsigned char*)(size_t)(wx0 ^ (unsigned)(((i_) >> 1) << 4)) + i_ * 128) = R[i_]; \
            if (UVAR == 0 || (UVAR == 1 && i_ < 8)) R[i_] = *(const u32x4*)(U4s + (unsigned)(U_EIDP(idp, i_) * 128 + 16 * c8)); \
        } \
          \
        u32x4 aop[2]; \
        _Pragma("unroll") for (int ks = 0; ks < 2; ++ks) { _Pragma("unroll") for (int k = 0; k < 4; ++k) { \
            const unsigned w_ = (unsigned)__builtin_amdgcn_ds_bpermute(abase + (16 * ks + k) * 4, (int)cx##CUR); \
            aop[ks][k] = (n16 < 2) ? w_ : 0u; } } \
        asm volatile("s_waitcnt lgkmcnt(0)" ::: "memory");               \
        f32x4 dA[4]; u32x4 bw[4][2]; float ov[8]; \
        U_READS(0); \
        U_MFMAS(); \
          \
        ci##CUR = U_LDI((j) + 3); cx##LD = U_LDXQ((j) + 2); \
        __builtin_amdgcn_sched_barrier(0); \
        U_READS(4);                                                      \
        U_OUTS(0); \
        U_MFMAS(); \
        U_OUTS(4); \
          \
        _Pragma("unroll") for (int nb = 0; nb < 8; ++nb) *(LAS float*)(stg + nb * 64) = ov[nb]; \
        asm volatile("s_waitcnt lgkmcnt(0)" ::: "memory"); \
        const f32x2 sum = *(const LAS f32x2*)(tile + 8 * lane); \
        asm volatile("s_waitcnt lgkmcnt(0)" ::: "memory"); \
        if ((j) < ntok) PART[U_TOK(j) * 64 + lane] = cvtpk(sum.x * osc, sum.y * osc); \
    } while (0)
    u32x4 R[16];
    unsigned cxA, cxB, cxC, ciA, ciB, ciC;
    ciA = U_LDI(0);
    cxA = U_LDXQ(0); cxB = U_LDXQ(1);
    { unsigned idp0[8]; U_IDP(idp0, ciA);
#pragma unroll
      for (int i_ = 0; i_ < 16; ++i_) R[i_] = *(const u32x4*)(U4s + (unsigned)(U_EIDP(idp0, i_) * 128 + 16 * c8)); }
    ciB = U_LDI(1); ciC = U_LDI(2);
    cxC = 0u;
    asm volatile("" :: "v"(ciC));
    for (int i = 0; i < ntok; i += 3) {
        U_BODY(i, A, B, C);
        U_BODY(i + 1, B, C, A);
        U_BODY(i + 2, C, A, B);
    }
#undef U_BODY
#undef U_READS
#undef U_MFMAS
#undef U_OUTS
#undef U_LDXQ
#undef U_LDI
#undef U_IDP
#undef U_EIDP
#undef U_TOK
}
#undef U_MFMA4_FIRST
#undef U_MFMA4
__device__ __forceinline__ void peer_w_phase(const Ctx& F0, const Args& a) {
    const Ctx F = fresh(F0);
    const unsigned* PART = (const unsigned*)(a.ws + WS_PART);
    const float* GATE = (const float*)(a.ws + WS_GATE);
    unsigned char* WQ = a.ws + WS_WT;
    float* WSC = (float*)(a.ws + WS_WSC);
    const int gwv = F.vcu * NWAVES + F.wave, NGW = F.G * NWAVES;
    unsigned pn[4]; f32x2 gn;
#define W_LD(t_) do { const int tt_ = (t_) < ML ? (t_) : ML - 1; _Pragma("unroll") for (int s = 0; s < 4; ++s) pn[s] = PART[((size_t)s * ML + tt_) * 64 + F.lane]; gn = *(const f32x2*)(GATE + (size_t)tt_ * 128 + 2 * F.lane); } while (0)
    W_LD(gwv);
    for (int t = gwv; t < ML; t += NGW) {
        f32x2 z = (f32x2){0.f, 0.f};
#pragma unroll
        for (int s = 0; s < 4; ++s) z += (f32x2){bflo(pn[s]), bfhi(pn[s])};
        const f32x2 g = gn;
        W_LD(t + NGW);
        f32x2 w; w.x = g.x * gelu_erf(z.x); w.y = g.y * gelu_erf(z.y);
        float wm = fmaxf(__builtin_fabsf(w.x), __builtin_fabsf(w.y));
#pragma unroll
        for (int o = 1; o < 64; o <<= 1) wm = fmaxf(wm, __shfl_xor(wm, o));
        wm = fmaxf(wm, 1e-20f);
        const float qs = 6.0f / wm, ax = fminf(fmaxf(w.x * qs, -6.f), 6.f), ay = fminf(fmaxf(w.y * qs, -6.f), 6.f);
        const unsigned ph = __builtin_amdgcn_cvt_scalef32_pk_fp4_f32(0u, ax, ay, 1.0f, 0) & 0xffu;
        const f32x2 dh = FP4_DEC(ph, 0);
        const unsigned pl = __builtin_amdgcn_cvt_scalef32_pk_fp4_f32(0u, fminf(fmaxf(4.f * (ax - dh.x), -6.f), 6.f), fminf(fmaxf(4.f * (ay - dh.y), -6.f), 6.f), 1.0f, 0) & 0xffu;
        ((unsigned short*)WQ)[(size_t)t * 128 + F.lane] = (unsigned short)((ph & 0xfu) | ((ph & 0xf0u) << 4));
        ((unsigned short*)WQ)[(size_t)t * 128 + 64 + F.lane] = (unsigned short)((pl & 0xfu) | ((pl & 0xf0u) << 4));
        if (F.lane == 0) WSC[t] = wm * (1.0f / 6.0f);
    }
#undef W_LD
}
#define V_MFMA4_FIRST(acc, av, bv, sa) asm volatile("v_mfma_scale_f32_16x16x128_f8f6f4 %0, %1, %2, 0, %3, %4 op_sel_hi:[0,0,0] cbsz:4 blgp:4" : "=&v"(acc) : "v"(av), "v"(bv), "v"(sa), "v"(sc_one))
#define V_MFMA4(acc, av, bv, sa) asm volatile("v_mfma_scale_f32_16x16x128_f8f6f4 %0, %1, %2, %0, %3, %4 op_sel_hi:[0,0,0] cbsz:4 blgp:4" : "+v"(acc) : "v"(av), "v"(bv), "v"(sa), "v"(sc_one))
template <int VAR = 0>
__device__ __forceinline__ void peer_v_phase(const Ctx& F0, const Args& a, int layer, float oscale = 1.0f) {
    const Ctx F = fresh(F0);
    const int s = (int)(blockIdx.x & 3), half = (int)((blockIdx.x >> 2) & 1), j = (int)(blockIdx.x >> 3), nmem = F.G >> 3;
    const unsigned char* V4s = a.ws + WS_TAB + (size_t)layer * TAB_LAYER + TAB_VOFF + (size_t)s * NEXP * 128;
    const unsigned short* IDX = (const unsigned short*)(a.ws + WS_IDX);
    const unsigned char* WQ = a.ws + WS_WT;
    const float* WSC = (const float*)(a.ws + WS_WSC);
    const float* modb = (const float*)(a.ws + WS_MOD) + (size_t)layer * 9 * NMOD;
    bf16_t* X = (bf16_t*)(a.ws + WS_XB);
    const int lane = F.lane, rsub = lane >> 3, c8 = lane & 7, n16 = lane & 15, g4 = lane >> 4;
    LAS unsigned char* tile = F.lds + F.wave * 16384;
    const float osc = ((DBG_SKIP & (layer == 0 ? 2 : 8)) ? 0.f : oscale) * (1.0f / V_SCALE);
    constexpr int MLH = ML / 2;
    const int t0 = half * MLH + j * NWAVES + F.wave, stride = nmem * NWAVES, ntok = (half * MLH + MLH - t0 + stride - 1) / stride;
    unsigned sc_one = 0x7f7f7f7fu; asm volatile("" : "+v"(sc_one));
    typedef int v2i_t __attribute__((ext_vector_type(2)));
    LAS float* gl = (LAS float*)(F.lds + RING_BYTES + 4096);
    for (int u = F.tid; u < 4 * 256; u += NWAVES * 64) gl[u] = modb[(size_t)(4 * half + (u >> 8)) * NMOD + 5 * DM + 256 * s + (u & 255)] * osc;
    __syncthreads();
#define V_TOK(i) ((size_t)(t0 + ((i) < ntok ? (i) : ntok - 1) * stride))
    LAS unsigned char* wx[4]; LAS unsigned char* rb[4];
#pragma unroll
    for (int k = 0; k < 4; ++k) wx[k] = tile + rsub * 2048 + ((c8 ^ k ^ ((rsub & 1) << 2)) << 4);
#pragma unroll
    for (int nb = 0; nb < 4; ++nb) rb[nb] = tile + g4 * 2048 + (n16 >> 1) * 128 + 8 * (n16 & 1) + ((nb ^ ((n16 >> 2) & 3) ^ ((g4 & 1) << 2)) << 4);
    LAS unsigned char* stg = tile + g4 * 1024 + n16 * 8;
#define V_LDW(i) (((const unsigned*)WQ)[V_TOK(i) * 64 + lane])
#define V_LDI(i) (((const unsigned*)IDX)[V_TOK(i) * 64 + lane])
#define V_LDX(i) (*(const u32x2*)(X + V_TOK(i) * DM + 256 * s + 4 * lane))
#define V_LDS(i) (WSC[V_TOK(i)])
#define V_IDP(dst, ci) do { _Pragma("unroll") for (int k = 0; k < 8; ++k) dst[k] = (unsigned)__builtin_amdgcn_ds_bpermute((8 * rsub + k) * 4, (int)(ci)); } while (0)
#define V_EIDP(idp, i_) (((i_) & 1) ? (idp[(i_) >> 1] >> 16) : (idp[(i_) >> 1] & 0xffffu))
#define V_READS(nb0) do { \
        unsigned x64 = (nb0) ? 64u : 0u; asm volatile("" : "+v"(x64));                   \
        _Pragma("unroll") for (int nb = 0; nb < 4; ++nb) { LAS unsigned char* rbn = (LAS unsigned char*)((unsigned)(size_t)rb[nb] ^ x64); \
          _Pragma("unroll") for (int h = 0; h < 2; ++h) { _Pragma("unroll") for (int q = 0; q < 2; ++q) { \
            const v2i_t tr = __builtin_amdgcn_ds_read_tr8_b64_v2i32((LAS v2i_t*)(rbn + 8192 * h + 1024 * q)); \
            bw[nb][h][2 * q] = (unsigned)tr[0]; bw[nb][h][2 * q + 1] = (unsigned)tr[1]; } } } \
        __builtin_amdgcn_sched_barrier(0); \
    } while (0)
#define V_MFMAS() do { \
        _Pragma("unroll") for (int nb = 0; nb < 4; ++nb) V_MFMA4_FIRST(dA[nb], aop[0], bw[nb][0], sc_a); \
        _Pragma("unroll") for (int nb = 0; nb < 4; ++nb) V_MFMA4(dA[nb], aop[1], bw[nb][1], sc_a); \
        __builtin_amdgcn_sched_barrier(0); \
    } while (0)
#define V_OUTS(nb0) do { \
        asm volatile("s_nop 15\n\ts_nop 3" : "+v"(dA[0]), "+v"(dA[1]), "+v"(dA[2]), "+v"(dA[3]) :: "memory");     \
        _Pragma("unroll") for (int nb = 0; nb < 4; ++nb) { ov[(nb0) + nb] = (f32x2){dA[nb][0] + dA[nb][2], dA[nb][1] + dA[nb][3]}; asm volatile("" : "+v"(ov[(nb0) + nb])); } \
    } while (0)
#define V_BODY(j, CUR, NXT, LD) do { \
        const size_t t_ = V_TOK(j); \
        unsigned idp[8]; \
        V_IDP(idp, ci##NXT);                                             \
          \
        _Pragma("unroll") for (int i_ = 0; i_ < 16; ++i_) { \
            *(LAS u32x4*)(wx[(i_ >> 1) & 3] + i_ * 128) = R[i_]; \
            if (VAR == 0 || (VAR == 1 && i_ < 8)) R[i_] = *(const u32x4*)(V4s + (unsigned)(V_EIDP(idp, i_) * 128 + 16 * c8)); \
        } \
          \
        u32x4 aop[2]; \
        _Pragma("unroll") for (int h = 0; h < 2; ++h) { _Pragma("unroll") for (int k = 0; k < 4; ++k) { \
            const unsigned w_ = (unsigned)__builtin_amdgcn_ds_bpermute(abase + (16 * h + k) * 4, (int)cw##CUR); \
            aop[h][k] = (n16 < 4) ? (w_ << ash) : 0u; } } \
        asm volatile("s_waitcnt lgkmcnt(0)" ::: "memory");               \
        f32x4 dA[4]; u32x4 bw[4][2]; f32x2 ov[8]; \
        V_READS(0); \
        V_MFMAS(); \
          \
        ci##CUR = V_LDI((j) + 3); cw##LD = V_LDW((j) + 2); xo##LD = V_LDX((j) + 2); ws##LD = V_LDS((j) + 2); \
        __builtin_amdgcn_sched_barrier(0); \
        V_READS(4);                                                      \
        V_OUTS(0); \
        V_MFMAS(); \
        V_OUTS(4); \
          \
        _Pragma("unroll") for (int nb = 0; nb < 8; ++nb) *(LAS f32x2*)(stg + nb * 128) = ov[nb]; \
        asm volatile("s_waitcnt lgkmcnt(0)" ::: "memory"); \
        const f32x4 sum = *(const LAS f32x4*)(tile + 16 * lane); \
        const f32x4 gt_ = *(const LAS f32x4*)(gl + ((t_ >> 12) & 3) * 256 + 4 * lane); \
        asm volatile("s_waitcnt lgkmcnt(0)" ::: "memory"); \
        if ((j) < ntok) { const f32x4 r_ = bf4_f32(xo##CUR) + gt_ * ws##CUR * sum; *(u32x2*)(X + t_ * DM + 256 * s + 4 * lane) = (u32x2){cvtpk(r_.x, r_.y), cvtpk(r_.z, r_.w)}; } \
    } while (0)
    u32x4 R[16];
    unsigned cwA, cwB, cwC, ciA, ciB, ciC;
    u32x2 xoA, xoB, xoC;
    float wsA, wsB, wsC;
    const int abase = (32 * ((n16 >> 1) & 1) + 4 * g4) * 4, ash = 4 * (n16 & 1);
    unsigned sc_a = (n16 & 2) ? 0x7d7d7d7du : 0x7f7f7f7fu; asm volatile("" : "+v"(sc_a));
    ciA = V_LDI(0);
    cwA = V_LDW(0); cwB = V_LDW(1); xoA = V_LDX(0); xoB = V_LDX(1); wsA = V_LDS(0); wsB = V_LDS(1);
    { unsigned idp0[8]; V_IDP(idp0, ciA);
#pragma unroll
      for (int i_ = 0; i_ < 16; ++i_) R[i_] = *(const u32x4*)(V4s + (unsigned)(V_EIDP(idp0, i_) * 128 + 16 * c8)); }
    ciB = V_LDI(1); ciC = V_LDI(2);
    cwC = 0u; xoC = (u32x2){0u, 0u}; wsC = 0.f;
    asm volatile("" :: "v"(ciC));
    for (int i = 0; i < ntok; i += 3) {
        V_BODY(i, A, B, C);
        V_BODY(i + 1, B, C, A);
        V_BODY(i + 2, C, A, B);
    }
#undef V_BODY
#undef V_READS
#undef V_MFMAS
#undef V_OUTS
#undef V_LDW
#undef V_LDI
#undef V_LDX
#undef V_LDS
#undef V_IDP
#undef V_EIDP
#undef V_TOK
}
#undef V_MFMA4_FIRST
#undef V_MFMA4

__device__ __forceinline__ void dft_nyquist_rows(const Ctx& F0, const Args& a) {
    const Ctx F = fresh(F0);
    const unsigned char* Yt = a.ws + WS_QK;
    const float* YN = (const float*)(a.ws + WS_YN);
    unsigned char* Fo = a.ws + WS_VT;
    const int gwv = F.vcu * NWAVES + F.wave, NGW = F.G * NWAVES;
    for (int o = gwv; o < NB * DM; o += NGW) {
        const unsigned char* src = Yt + (size_t)o * 4096;
        float s = 0.f;
#pragma unroll
        for (int it = 0; it < 2; ++it) { const u32x4 v = *(const u32x4*)(src + it * 1024 + F.lane * 16);
#pragma unroll
            for (int d = 0; d < 4; ++d) { const f32x2 lo = __builtin_amdgcn_cvt_pk_f32_fp8((int)v[d], false), hi = __builtin_amdgcn_cvt_pk_f32_fp8((int)v[d], true); s += (lo[0] - lo[1]) + (hi[0] - hi[1]); } }
        s = wave_sum(s) * (pg8::ACT8_SCALE / (64.0f * pg8::YT_SCALE)) + YN[o] * (pg8::ACT8_SCALE / 64.0f);
        if (F.lane == 0) Fo[((size_t)(o >> 10) * SEQ + 2048) * DM + (o & 1023)] = (unsigned char)(fp8_pack4(s, 0.f, 0.f, 0.f) & 0xffu);
    }
}
__device__ __forceinline__ void dft_yn_rows(const Ctx& F0, const Args& a) {
    const Ctx F = fresh(F0);
    const float* yi = (const float*)(a.ws + WS_YNI);
    const bf16_t* wc = (const bf16_t*)(a.ws + WS_WC);
    float* YN = (float*)(a.ws + WS_YN);
    const int gwv = F.vcu * NWAVES + F.wave, NGW = F.G * NWAVES;
    for (int o = gwv; o < NB * DM; o += NGW) {
        const int cp = o & 255;
        const f32x4 x = *(const f32x4*)(yi + (size_t)(o & ~255) + 4 * F.lane);
        const u32x2 w = *(const u32x2*)(wc + (size_t)cp * 256 + 4 * F.lane);
        const f32x4 wf = bf4_f32(w);
        const float s = wave_sum(x.x * wf.x + x.y * wf.y + x.z * wf.z + x.w * wf.w);
        if (F.lane == 0) YN[o] = s;
    }
}

__global__ void __launch_bounds__(NWAVES * 64, 2) fwd_kernel(Args args) {
    extern __shared__ __attribute__((aligned(16))) unsigned char lds_raw[];
    Ctx F;
    F.lds = (LAS unsigned char*)lds_raw;
    F.tid = threadIdx.x; F.lane = F.tid & 63; F.wave = __builtin_amdgcn_readfirstlane(F.tid >> 6);
    F.G = gridDim.x; { const int bx = blockIdx.x; F.vcu = (F.G % 8 == 0) ? (bx % 8) * (F.G / 8) + bx / 8 : bx; }
    volatile LAS unsigned* MISC = (volatile LAS unsigned*)(F.lds + MISC_OFF);
    for (int u = F.tid; u < (LDS_BYTES - LDSCTL_OFF) / 4; u += NWAVES * 64) ((LAS unsigned*)(F.lds + LDSCTL_OFF))[u] = 0u;
    __syncthreads();
    unsigned char* ws = args.ws;
    XcdBarrier bar = xcd_barrier_post((unsigned*)(ws + WS_CTL) + CW_BAR, MISC + 8);
#define GRID_BAR() xcd_barrier(bar)
#ifndef DBG_REP
#define DBG_REP 0
#endif
#ifndef DBG_VVAR
#define DBG_VVAR 0
#endif
#define REP(k, ...) do { __VA_ARGS__; if (DBG_REP == (k)) { GRID_BAR(); __VA_ARGS__; } } while (0)
#define PEER_BLOCK(layer) do { \
        norm_phase(F, args, 1, layer, 3 * DM, args.in[5] + (layer) * DM); \
        GRID_BAR(); \
        { using SHq = pg8::Shape<ML, 2048, DM / 2, DM / 2, DM / 2, 1, 0, 0>;       \
          REP(7, pg8::gemm_phase<SHq, pg8::EpiStoreBf16, true>(F.lds, pg8::Gemm{HX, (const bf16_t*)(ws + WS_WPQ) + (size_t)(layer) * 2048 * DM / 2}, F.G, bx, pg8::EpiStoreBf16{QKb, 2048, 0, 0, 1.0f, 1.0f / (pg8::ACT8_SCALE * pg8::W8_SCALE)})); } \
        GRID_BAR(); \
        REP(8, peer_topk_phase(F, args, layer)); \
        GRID_BAR(); \
        REP(9, peer_u_phase(F, args, layer)); \
        GRID_BAR(); \
        REP(10, peer_w_phase(F, args)); \
        GRID_BAR(); \
        peer_v_phase(F, args, layer); if (DBG_REP == 11) { GRID_BAR(); peer_v_phase<DBG_VVAR>(F, args, layer, 0.f); } \
        GRID_BAR(); \
    } while (0)
    const float* modb = (const float*)(ws + WS_MOD);
    bf16_t* HX = (bf16_t*)(ws + WS_HX);
    bf16_t* QKb = (bf16_t*)(ws + WS_QK);
    bf16_t* VTb = (bf16_t*)(ws + WS_VT);
    const bf16_t* Wqkv = (const bf16_t*)(ws + WS_WQKV);
    const int bx = (int)blockIdx.x;

    REP(1, p0_prologue(F, args));
    GRID_BAR();
    REP(2, norm_phase(F, args, 0, 0, 0, args.in[4]));
    GRID_BAR();
    {
        constexpr float o8 = 1.0f / (pg8::ACT8_SCALE * pg8::W8_SCALE);
        using SH1 = pg8::Shape<MT, 2048, DM / 2, DM / 2, DM / 2, 1, 0, 0>;
        pg8::gemm_phase<SH1, pg8::EpiStoreBf16, true>(F.lds, pg8::Gemm{HX, Wqkv}, F.G, bx, pg8::EpiStoreBf16{QKb, 2048, 0, 1024, 0.125f * LOG2E, o8});
        using SH2 = pg8::Shape<DM, MT, DM / 2, DM / 2, DM / 2, 1, 0, 0>;
        const int bxv = F.G - 1 - bx;
        pg8::gemm_phase<SH2, pg8::EpiStoreBf16, true>(F.lds, pg8::Gemm{Wqkv + (size_t)2048 * DM / 2, HX}, F.G, bxv, pg8::EpiStoreBf16{VTb, MT, 0, 0, 1.0f, o8});
    }
    GRID_BAR();
    REP(4, attn_phase(F, args));
    GRID_BAR();
    {
        using SH = pg8::Shape<ML, DM, DM / 2, DM / 2, DM / 2, 1, 0, 0>;
        pg8::gemm_phase<SH, pg8::EpiResid<false>, true>(F.lds, pg8::Gemm{(const bf16_t*)(ws + WS_HX + 36 * MiB), (const bf16_t*)(ws + WS_WO)}, F.G, bx, pg8::EpiResid<false>{args.in[0], (bf16_t*)(ws + WS_XB), modb + 2 * DM, NMOD, ((DBG_SKIP & 1) ? 0.f : 1.f) / (pg8::ACT8_SCALE * pg8::W8_SCALE)});
    }
    GRID_BAR();
    PEER_BLOCK(0);
    norm_fold_phase(F, args, 1, args.in[4] + DM);
    GRID_BAR();
    {
        using SH = pg8::Shape<256, ML / 2, 256, 256, DM, 4, 0, 256>;
        pg8::gemm_phase<SH>(F.lds, pg8::Gemm{(const bf16_t*)(ws + WS_WC), HX}, F.G, bx, pg8::EpiYt{(unsigned char*)QKb, 0});
        pg8::gemm_phase<SH>(F.lds, pg8::Gemm{(const bf16_t*)(ws + WS_WC) + 256 * 256, (const bf16_t*)(ws + WS_HX + 32 * MiB)}, F.G, bx, pg8::EpiYt{(unsigned char*)QKb, 1});
        dft_yn_rows(F, args);
    }
    GRID_BAR();
    {
        using SH = pg8::Shape<SEQ / 2, DM, 2048, 2048, 2048, NB, 0, (long)DM * 2048>;
        REP(14, pg8::gemm_phase<SH, pg8::EpiDft2, true>(F.lds, pg8::Gemm{(const bf16_t*)(ws + WS_CS), QKb}, F.G, bx, pg8::EpiDft2{(unsigned char*)VTb, (const float*)(ws + WS_YN)}));
        dft_nyquist_rows(F, args);
    }
    GRID_BAR();
    {
        using SH = pg8::Shape<ML, DM, DM / 2, DM / 2, DM / 2, 1, 0, 0>;
        pg8::gemm_phase<SH, pg8::EpiResid<true>, true>(F.lds, pg8::Gemm{VTb, (const bf16_t*)(ws + WS_WF)}, F.G, bx, pg8::EpiResid<true>{ws + WS_XB, (bf16_t*)(ws + WS_XB), modb + (size_t)9 * NMOD + 2 * DM, NMOD, ((DBG_SKIP & 4) ? 0.f : 1.f) / (pg8::ACT8_SCALE * pg8::W8_SCALE)});
    }
    GRID_BAR();
    PEER_BLOCK(1);
    if (DBG_REP == 20) { for (int r = 0; r < 16; ++r) GRID_BAR(); }
    final_norm_phase(F, args);
#undef PEER_BLOCK
}

extern "C" void kernel_launch(void* const* d_in, const int* in_sizes, int n_in, void* d_out, int out_size, void* d_ws, size_t ws_size, hipStream_t stream) {
    static int grid = 0;
    if (grid == 0) {
        if (n_in != 17 || in_sizes[0] != ML * DM || out_size != ML * DM || ws_size < WS_END) { fprintf(stderr, "kernel_launch: unexpected shapes (n_in %d, in0 %d, out %d, ws %zu)\n", n_in, n_in > 0 ? in_sizes[0] : -1, out_size, ws_size); grid = -1; return; }
        int dev = 0, cus = 0, per_cu = 0;
        if (hipGetDevice(&dev) != hipSuccess || hipDeviceGetAttribute(&cus, hipDeviceAttributeMultiprocessorCount, dev) != hipSuccess) { grid = -1; return; }
        if (hipFuncSetAttribute((const void*)fwd_kernel, hipFuncAttributeMaxDynamicSharedMemorySize, LDS_BYTES) != hipSuccess) { fprintf(stderr, "kernel_launch: hipFuncSetAttribute failed\n"); grid = -1; return; }
        if (hipOccupancyMaxActiveBlocksPerMultiprocessor(&per_cu, (const void*)fwd_kernel, NWAVES * 64, LDS_BYTES) != hipSuccess || per_cu < 1)
            fprintf(stderr, "kernel_launch: note: occupancy query reports %d workgroups per CU\n", per_cu);
        (void)hipGetLastError();
        grid = cus;
        if (grid % 8 != 0) { fprintf(stderr, "kernel_launch: CU count %d is not a multiple of 8\n", cus); grid = -1; return; }
    }
    if (grid < 0) return;
    if (hipMemsetAsync((char*)d_ws + WS_CTL, 0, CTL_ZERO_BYTES, stream) != hipSuccess) { fprintf(stderr, "kernel_launch: memset failed\n"); return; }
    Args a{};
    for (int i = 0; i < 17; ++i) a.in[i] = (const float*)d_in[i];
    a.out = (float*)d_out; a.ws = (unsigned char*)d_ws;
    hipLaunchKernelGGL(fwd_kernel, dim3(grid), dim3(NWAVES * 64), LDS_BYTES, stream, a);
    const hipError_t le = hipPeekAtLastError();
    if (le != hipSuccess) fprintf(stderr, "kernel_launch: launch failed: %s\n", hipGetErrorName(le));
}
```

```cpp
#include <hip/hip_runtime.h>
#include <cstdio>
#include <cstdint>

#define LAS __attribute__((address_space(3)))
typedef unsigned short bf16_t;
typedef short bf16x8 __attribute__((ext_vector_type(8)));
typedef short s16x4 __attribute__((ext_vector_type(4)));
typedef float f32x2 __attribute__((ext_vector_type(2)));
typedef float f32x4 __attribute__((ext_vector_type(4)));
typedef float f32x16 __attribute__((ext_vector_type(16)));
typedef unsigned u32x2 __attribute__((ext_vector_type(2)));
typedef unsigned u32x4 __attribute__((ext_vector_type(4)));
typedef __bf16 bf16x2_t __attribute__((ext_vector_type(2)));

#ifndef DBG_SKIP
#define DBG_SKIP 0
#endif
constexpr int DM = 1024, NB = 8, SEQ = 4096, CTXL = 256, GW = 64;
constexpr int ML = NB * SEQ;
constexpr int MC = NB * CTXL;
constexpr int MT = ML + MC;
constexpr int NMOD = 6 * DM;
constexpr int NEXP = 16384;
constexpr float EPS = 1e-6f;
constexpr float LOG2E = 1.4426950408889634f;

constexpr size_t MiB = 1u << 20;
constexpr size_t WS_CTL = 0, CTL_ZERO_BYTES = 1 * MiB;
constexpr size_t WS_MOD = 1 * MiB;
constexpr size_t WS_WQKV = 2 * MiB;
constexpr size_t WS_WO = 8 * MiB;
constexpr size_t WS_WF = 10 * MiB;
constexpr size_t WS_WPQ = 12 * MiB;
constexpr size_t WS_SK = 20 * MiB;
constexpr size_t WS_WC = 20 * MiB + 256 * 1024;
constexpr size_t WS_CS = 22 * MiB;
constexpr size_t WS_TAB = 38 * MiB;
constexpr size_t WS_X8 = 150 * MiB;
constexpr size_t WS_WT = 182 * MiB;
constexpr size_t WS_PART = 282 * MiB;
constexpr float U_SCALE = 64.f;
constexpr float XQ_SCALE = 0.75f;
constexpr float V_SCALE = 2.f;
constexpr size_t WS_XB = 70 * MiB;
constexpr size_t TAB_LAYER = 16 * MiB, TAB_VOFF = 8 * MiB;
constexpr size_t WS_WSC = 198 * MiB;
constexpr size_t WS_YNI = 199 * MiB;
constexpr size_t WS_YN = WS_YNI + 64 * 1024;
constexpr size_t WS_HX = 214 * MiB;
constexpr size_t WS_QK = 282 * MiB;
constexpr size_t WS_VT = 418 * MiB;
constexpr size_t WS_IDX = WS_VT;
constexpr size_t WS_GATE = WS_VT + 8 * MiB;
constexpr size_t WS_END = 486 * MiB;
constexpr int CW_BAR = 4096;

__device__ __forceinline__ unsigned f2bf(float f) { unsigned u = __builtin_bit_cast(unsigned, f); return (u + 0x7fffu + ((u >> 16) & 1u)) >> 16; }
__device__ __forceinline__ unsigned pk2(float lo, float hi) { return f2bf(lo) | (f2bf(hi) << 16); }
__device__ __forceinline__ f32x4 bf4_f32(u32x2 w) { return (f32x4){__builtin_bit_cast(float, w.x << 16), __builtin_bit_cast(float, w.x & 0xffff0000u), __builtin_bit_cast(float, w.y << 16), __builtin_bit_cast(float, w.y & 0xffff0000u)}; }
__device__ __forceinline__ unsigned cvtpk(float lo, float hi) { f32x2 v = {lo, hi}; bf16x2_t b = __builtin_convertvector(v, bf16x2_t); return __builtin_bit_cast(unsigned, b); }
__device__ __forceinline__ float bflo(unsigned u) { return __builtin_bit_cast(float, u << 16); }
__device__ __forceinline__ float bfhi(unsigned u) { return __builtin_bit_cast(float, u & 0xffff0000u); }
__device__ __forceinline__ float wave_sum(float v) {
#pragma unroll
    for (int o = 1; o < 64; o <<= 1) v += __shfl_xor(v, o);
    return v;
}
__device__ __forceinline__ unsigned fp8_pack4(float a, float b, float c, float d) {
    int w = 0;
    w = __builtin_amdgcn_cvt_pk_fp8_f32(__builtin_amdgcn_fmed3f(a, -448.f, 448.f), __builtin_amdgcn_fmed3f(b, -448.f, 448.f), w, false);
    w = __builtin_amdgcn_cvt_pk_fp8_f32(__builtin_amdgcn_fmed3f(c, -448.f, 448.f), __builtin_amdgcn_fmed3f(d, -448.f, 448.f), w, true);
    return (unsigned)w;
}
__device__ __forceinline__ int crow(int r, int hi) { return (r & 3) + 8 * (r >> 2) + 4 * hi; }
__device__ __forceinline__ float gelu_erf(float v) {
    const float av = __builtin_fabsf(v), d = av * 0.2316418882f + 1.0f;
    const float t = __builtin_amdgcn_rcpf(d);
    float q = t * 0.5307027145f + (-0.7265760135f); q = q * t + 0.7107068705f; q = q * t + (-0.142248368f); q = q * t + 0.127414796f; q = q * t;
    const float e = __builtin_amdgcn_exp2f((v * v) * (-0.72134752044f));
    const float m = v * (q * e), r = v - m;
    return v < 0.f ? m : r;
}

namespace pg8 {
constexpr float ACT8_SCALE = 16.f, W8_SCALE = 256.f;
constexpr float YT_SCALE = 16.f, CS_SCALE = 512.f;
constexpr int BM = 256, BK = 64, HALF = 128, HTB = HALF * BK * 2, STAGE_BYTES = 8 * HTB, NXCD = 8, WGM = 8;
__host__ __device__ __forceinline__ int lds_byte(int r, int c) { const int st = (r >> 4) * 2 + (c >> 5), rr = r & 15, cc = c & 31, ob = rr * 64 + cc * 2; return st * 1024 + (ob ^ (((ob >> 9) & 1) << 5)); }
__host__ __device__ __forceinline__ void stage_rc(int b, int& R, int& C) { const int st = b / 1024, sb = b % 1024, swz = sb ^ (((sb >> 9) & 1) << 5); R = (st >> 1) * 16 + swz / 64; C = (st & 1) * 32 + (swz % 64) / 2; }
__host__ __device__ __forceinline__ int perm32(int rho) { const int n = rho >> 4, i = rho & 15; return 8 * (i >> 2) + 4 * n + (i & 3); }

struct Unit { int pm, pn, pb; };
struct Gemm { const bf16_t* A; const bf16_t* Bt; };
template <int M_, int N_, int K_, int LDA_, int LDB_, int NBATCH_, long BSA_, long BSB_> struct Shape { static constexpr int M = M_, N = N_, K = K_, lda = LDA_, ldb = LDB_, nbatch = NBATCH_; static constexpr long bsA = BSA_, bsB = BSB_; };

template <class SH> struct StaticOrder {
    static constexpr int nM = SH::M / BM, nN = SH::N / BM, per = nM * nN, nwg = per * SH::nbatch;
    int G, c;
    __device__ __forceinline__ void init(int G_, int c_) { G = G_; c = c_; }
    __device__ __forceinline__ bool next(int i, Unit& u) const {
        const long L = (long)i * G + c; if (L >= nwg) return false;
        int wgid = (int)L; { const int q = nwg / NXCD, r = nwg % NXCD, xcd = wgid % NXCD, off = wgid / NXCD; wgid = (xcd < r ? xcd * (q + 1) : r * (q + 1) + (xcd - r) * q) + off; }
        u.pb = wgid / per; wgid -= u.pb * per;
        const int nig = WGM * nN, gid = wgid / nig, fm = gid * WGM, gsz = (nM - fm) < WGM ? (nM - fm) : WGM;
        u.pm = fm + ((wgid % nig) % gsz); u.pn = (wgid % nig) / gsz; return true;
    }
};

struct EpiStoreBf16 {
    static constexpr bool PERM = true;
    bf16_t* O; long ldc; long bstride; int scols; float scale0; float oscale = 1.0f;
    __device__ __forceinline__ void operator()(const f32x4 (&acc)[2][2][4][2], const Unit& u, int wr, int wc, int fr, int fq) const {
        const int row0 = u.pm * BM + wr * 64 + fr, col0 = u.pn * BM + wc * 32 + 8 * fq;
        bf16_t* base = O + (long)u.pb * bstride;
        const float sc = ((u.pn * BM < scols) ? scale0 : 1.0f) * oscale;
#pragma unroll
        for (int ai = 0; ai < 2; ++ai)
#pragma unroll
            for (int m = 0; m < 4; ++m) { bf16_t* rowp = base + (long)(row0 + ai * HALF + m * 16) * ldc + col0;
#pragma unroll
                for (int bj = 0; bj < 2; ++bj) { const f32x4 v0 = acc[ai][bj][m][0] * sc, v1 = acc[ai][bj][m][1] * sc;
                    u32x4 w; w.x = cvtpk(v0[0], v0[1]); w.y = cvtpk(v0[2], v0[3]); w.z = cvtpk(v1[0], v1[1]); w.w = cvtpk(v1[2], v1[3]);
                    *(u32x4*)(rowp + bj * HALF) = w; } }
    }
};
struct EpiDft2 {
    static constexpr bool PERM = true;
    unsigned char* O; const float* yn;
    __device__ __forceinline__ void operator()(const f32x4 (&acc)[2][2][4][2], const Unit& u, int wr, int wc, int fr, int fq) const {
        const int row0 = u.pm * BM + wr * 64 + fr, cl0 = wc * 32 + 8 * fq;
        unsigned char* base = O + (long)u.pb * SEQ * DM + u.pn * BM;
        constexpr float osc = ACT8_SCALE / (YT_SCALE * CS_SCALE);
        f32x4 y0[2], y1[2];
#pragma unroll
        for (int bj = 0; bj < 2; ++bj) { const float* yp = yn + (long)u.pb * DM + u.pn * BM + cl0 + bj * HALF; y0[bj] = *(const f32x4*)yp * (ACT8_SCALE / 64.0f); y1[bj] = *(const f32x4*)(yp + 4) * (ACT8_SCALE / 64.0f); }
#pragma unroll
        for (int ai = 0; ai < 2; ++ai)
#pragma unroll
            for (int m = 0; m < 4; ++m) { const int np = row0 + ai * HALF + m * 16;
                unsigned char* rowp = base + (long)np * DM; unsigned char* mirp = base + (long)(SEQ - np) * DM;
#pragma unroll
                for (int bj = 0; bj < 2; ++bj) { const float sg = (np & 1) ? -1.0f : 1.0f; const f32x4 v0 = acc[ai][bj][m][0] * osc + y0[bj] * sg, v1 = acc[ai][bj][m][1] * osc + y1[bj] * sg; const int cl = cl0 + bj * HALF;
                    u32x2 w; w.x = fp8_pack4(v0[0], v0[1], v0[2], v0[3]); w.y = fp8_pack4(v1[0], v1[1], v1[2], v1[3]);
                    *(u32x2*)(rowp + cl) = w;
                    if (np != 0) {
#pragma unroll
                        for (int i = 0; i < 8; ++i) mirp[(256 - cl - i) & 255] = (unsigned char)((w[i >> 2] >> (8 * (i & 3))) & 0xffu); } }
                asm volatile("" ::: "memory"); }
    }
};
struct EpiYt {
    static constexpr bool PERM = true;
    unsigned char* Yt; int part;
    __device__ __forceinline__ void operator()(const f32x4 (&acc)[2][2][4][2], const Unit& u, int wr, int wc, int fr, int fq) const {
        const int row0 = u.pm * BM + wr * 64 + fr, col0 = u.pn * BM + wc * 32 + 8 * fq;
#pragma unroll
        for (int ai = 0; ai < 2; ++ai)
#pragma unroll
            for (int m = 0; m < 4; ++m) { const int cp = row0 + ai * HALF + m * 16;
#pragma unroll
                for (int bj = 0; bj < 2; ++bj) { const int col = col0 + bj * HALF; const int b = col >> 11, k = col & 2047;
                    const f32x4 v0 = acc[ai][bj][m][0] * YT_SCALE, v1 = acc[ai][bj][m][1] * YT_SCALE;
                    u32x2 w; w.x = fp8_pack4(v0[0], v0[1], v0[2], v0[3]); w.y = fp8_pack4(v1[0], v1[1], v1[2], v1[3]);
                    *(u32x2*)(Yt + (((long)(b * 4 + u.pb) * 256 + cp) << 12) + part * 2048 + k) = w; }
                asm volatile("" ::: "memory"); }
    }
};
template <bool IN_BF16>
struct EpiResid {
    static constexpr bool PERM = false;
    const void* Xin; bf16_t* Xout; const float* gate; int gstride; float gs;
    __device__ __forceinline__ void operator()(const f32x4 (&acc)[2][2][4][2], const Unit& u, int wr, int wc, int fr, int fq) const {
        const int row0 = u.pm * BM + wr * 64 + fr, col0 = u.pn * BM + wc * 32 + 4 * fq;
        const float* gb = gate + (long)((u.pm * BM) >> 12) * gstride;
        f32x4 gv[2][2];
#pragma unroll
        for (int bj = 0; bj < 2; ++bj)
#pragma unroll
            for (int n = 0; n < 2; ++n) gv[bj][n] = *(const f32x4*)(gb + col0 + bj * HALF + n * 16);
        f32x4 xf[2][8]; u32x2 xb[2][8];
#define ER_OFF(b_, k_) ((long)(row0 + ((b_) >> 1) * HALF + (2 * ((b_) & 1) + ((k_) >> 2)) * 16) * DM + col0 + (((k_) >> 1) & 1) * HALF + ((k_) & 1) * 16)
#define ER_LOAD(b_) do { _Pragma("unroll") for (int k_ = 0; k_ < 8; ++k_) { const long o_ = ER_OFF(b_, k_); \
            if (IN_BF16) xb[(b_) & 1][k_] = *(const u32x2*)((const bf16_t*)Xin + o_); else xf[(b_) & 1][k_] = *(const f32x4*)((const float*)Xin + o_); } } while (0)
        ER_LOAD(0);
#pragma unroll
        for (int b_ = 0; b_ < 4; ++b_) {
            if (b_ + 1 < 4) ER_LOAD(b_ + 1);
#pragma unroll
            for (int k_ = 0; k_ < 8; ++k_) { const long o_ = ER_OFF(b_, k_); const int ai = b_ >> 1, m = 2 * (b_ & 1) + (k_ >> 2), bj = (k_ >> 1) & 1, n = k_ & 1;
                const f32x4 bs = IN_BF16 ? bf4_f32(xb[b_ & 1][k_]) : xf[b_ & 1][k_];
                const f32x4 r_ = bs + gv[bj][n] * acc[ai][bj][m][n] * gs;
                *(u32x2*)(Xout + o_) = (u32x2){cvtpk(r_.x, r_.y), cvtpk(r_.z, r_.w)}; }
            asm volatile("" ::: "memory");
        }
#undef ER_OFF
#undef ER_LOAD
    }
};

template <class SH, class Epi, bool FP8 = false>
__device__ __forceinline__ void gemm_phase(LAS unsigned char* lds, const Gemm g, int G_, int c_, const Epi& E) {
    StaticOrder<SH> S; S.init(G_, c_);
    int tid_ = threadIdx.x; asm volatile("" : "+v"(tid_));
    const int tid = tid_, wid = __builtin_amdgcn_readfirstlane(tid >> 6), lane = tid & 63, wr = wid >> 2, wc = wid & 3, fr = lane & 15, fq = lane >> 4;
    constexpr int K = SH::K, nt = K / BK;
    unsigned voffA[2], voffB[2];
#pragma unroll
    for (int i = 0; i < 2; ++i) { int R, C; stage_rc(tid * 16 + i * 8192, R, C); const int Rb = Epi::PERM ? ((R & ~31) + perm32(R & 31)) : R;
        voffA[i] = (unsigned)(R * SH::lda + C) * 2u; voffB[i] = (unsigned)(Rb * SH::ldb + C) * 2u; }
    constexpr size_t kstep = (size_t)(BK * 2);
    constexpr size_t hstepA = (size_t)HALF * SH::lda * 2, hstepB = (size_t)HALF * SH::ldb * 2;
    constexpr size_t tstepA = 2 * hstepA, tstepB = 2 * hstepB;
    const unsigned ldsw = (unsigned)wid * 1024u;
    const int aoff = lds_byte(wr * 64 + fr, fq * 8), boff = lds_byte(wc * 32 + fr, fq * 8);
#define PG8_SA(b, h) (((b) * 2 + (h)) * HTB)
#define PG8_SB(b, h) ((4 + (b) * 2 + (h)) * HTB)
#define PG8_STAGE(bufoff, gbase, voff) do { _Pragma("unroll") for (int _i = 0; _i < 2; ++_i) \
        __builtin_amdgcn_global_load_lds((const unsigned*)((const char*)(gbase) + (voff)[_i]), (LAS unsigned*)(lds + (bufoff) + ldsw + _i * 8192), 16, 0, 0); } while (0)
#define PG8_LDA(dst, b, h) do { _Pragma("unroll") for (int m = 0; m < 4; ++m) { const u32x4 f0_ = *(const LAS u32x4*)(lds + PG8_SA(b, h) + aoff + m * 2048), f1_ = *(const LAS u32x4*)(lds + PG8_SA(b, h) + aoff + m * 2048 + 1024); dst[m] = __builtin_shufflevector(f0_, f1_, 0, 1, 2, 3, 4, 5, 6, 7); } } while (0)
#define PG8_LDB(dst, b, h) do { _Pragma("unroll") for (int n = 0; n < 2; ++n) { const u32x4 f0_ = *(const LAS u32x4*)(lds + PG8_SB(b, h) + boff + n * 2048), f1_ = *(const LAS u32x4*)(lds + PG8_SB(b, h) + boff + n * 2048 + 1024); dst[n] = __builtin_shufflevector(f0_, f1_, 0, 1, 2, 3, 4, 5, 6, 7); } } while (0)
typedef int v8i_t __attribute__((ext_vector_type(8)));
typedef unsigned u32x8 __attribute__((ext_vector_type(8)));
#define PG8_LOH(x) __builtin_bit_cast(bf16x8, __builtin_shufflevector(x, x, 0, 1, 2, 3))
#define PG8_HIH(x) __builtin_bit_cast(bf16x8, __builtin_shufflevector(x, x, 4, 5, 6, 7))
#define PG8_MMA(ai, bj, At, Bt) do { __builtin_amdgcn_s_setprio(1); _Pragma("unroll") for (int m = 0; m < 4; ++m) _Pragma("unroll") for (int n = 0; n < 2; ++n) { \
        if constexpr (FP8) asm volatile("v_mfma_scale_f32_16x16x128_f8f6f4 %0, %1, %2, %0, %3, %3 op_sel_hi:[0,0,0]" : "+v"(acc[ai][bj][m][n]) : "v"(Bt[n]), "v"(At[m]), "v"(fp8_one));   \
        else { acc[ai][bj][m][n] = __builtin_amdgcn_mfma_f32_16x16x32_bf16(PG8_LOH(Bt[n]), PG8_LOH(At[m]), acc[ai][bj][m][n], 0, 0, 0); \
               acc[ai][bj][m][n] = __builtin_amdgcn_mfma_f32_16x16x32_bf16(PG8_HIH(Bt[n]), PG8_HIH(At[m]), acc[ai][bj][m][n], 0, 0, 0); } } \
        __builtin_amdgcn_s_setprio(0); } while (0)
#define PG8_WAIT_V(n) asm volatile("s_waitcnt vmcnt(" #n ")" ::: "memory")
#define PG8_WAIT_L(n) asm volatile("s_waitcnt lgkmcnt(" #n ")" ::: "memory")
#define PG8_BAR __builtin_amdgcn_s_barrier()
#define PG8_SCHED __builtin_amdgcn_sched_barrier(0)
    Unit cur, nxt; int ui = 0;
    if (!S.next(0, cur)) return;
    f32x4 acc[2][2][4][2];
#pragma unroll
    for (int a = 0; a < 2; ++a)
#pragma unroll
        for (int b = 0; b < 2; ++b)
#pragma unroll
            for (int m = 0; m < 4; ++m)
#pragma unroll
                for (int n = 0; n < 2; ++n) acc[a][b][m][n] = (f32x4){0.f, 0.f, 0.f, 0.f};
    unsigned fp8_one = 0x7f7f7f7fu; asm volatile("" : "+v"(fp8_one));
    u32x8 At[4], B0[2], B1[2];
    const char* cA = (const char*)(g.A + (long)cur.pb * SH::bsA) + (size_t)cur.pm * tstepA; const char* cB = (const char*)(g.Bt + (long)cur.pb * SH::bsB) + (size_t)cur.pn * tstepB;
    PG8_STAGE(PG8_SB(0, 0), cB, voffB); PG8_STAGE(PG8_SB(0, 1), cB + hstepB, voffB); PG8_STAGE(PG8_SA(0, 0), cA, voffA); PG8_STAGE(PG8_SA(0, 1), cA + hstepA, voffA);
    if (wr == 1) PG8_BAR;
    PG8_WAIT_V(2); PG8_BAR;
    PG8_STAGE(PG8_SB(1, 0), cB + kstep, voffB); PG8_STAGE(PG8_SA(1, 0), cA + kstep, voffA); PG8_STAGE(PG8_SB(1, 1), cB + hstepB + kstep, voffB);
    PG8_WAIT_V(6); PG8_BAR;
    for (;;) {
        const bool has_next = S.next(ui + 1, nxt);
        const char* nA = has_next ? (const char*)(g.A + (long)nxt.pb * SH::bsA) + (size_t)nxt.pm * tstepA : cA; const char* nB = has_next ? (const char*)(g.Bt + (long)nxt.pb * SH::bsB) + (size_t)nxt.pn * tstepB : cB;
#pragma nounroll
        for (int t = 0; t < nt; t += 2) {
            const bool last = (t == nt - 2);
            const char* a1 = cA + (size_t)(t + 1) * kstep;
            const char* a2 = last ? nA : cA + (size_t)(t + 2) * kstep; const char* b2 = last ? nB : cB + (size_t)(t + 2) * kstep;
            const char* a3 = a2 + kstep; const char* b3 = b2 + kstep;
            PG8_LDB(B0, 0, 0); PG8_LDB(B1, 0, 1); PG8_SCHED; PG8_LDA(At, 0, 0); PG8_STAGE(PG8_SA(1, 1), a1 + hstepA, voffA);
            PG8_WAIT_V(8); PG8_WAIT_L(0); PG8_BAR; PG8_MMA(0, 0, At, B0); PG8_MMA(0, 1, At, B1); PG8_BAR; PG8_SCHED;
            PG8_LDA(At, 0, 1); PG8_STAGE(PG8_SB(0, 0), b2, voffB); PG8_STAGE(PG8_SB(0, 1), b2 + hstepB, voffB); PG8_STAGE(PG8_SA(0, 0), a2, voffA);
            PG8_WAIT_V(8); PG8_WAIT_L(0); PG8_BAR; PG8_MMA(1, 0, At, B0); PG8_MMA(1, 1, At, B1); PG8_BAR; PG8_SCHED;
            PG8_LDB(B0, 1, 0); PG8_LDB(B1, 1, 1); PG8_SCHED; PG8_LDA(At, 1, 0); PG8_STAGE(PG8_SA(0, 1), a2 + hstepA, voffA);
            PG8_WAIT_V(8); PG8_WAIT_L(0); PG8_BAR; PG8_MMA(0, 0, At, B0); PG8_MMA(0, 1, At, B1); PG8_BAR; PG8_SCHED;
            PG8_LDA(At, 1, 1); PG8_STAGE(PG8_SB(1, 0), b3, voffB); PG8_STAGE(PG8_SB(1, 1), b3 + hstepB, voffB); PG8_STAGE(PG8_SA(1, 0), a3, voffA);
            PG8_WAIT_V(8); PG8_WAIT_L(0); PG8_BAR; PG8_MMA(1, 0, At, B0); PG8_MMA(1, 1, At, B1); PG8_BAR; PG8_SCHED;
        }
        if (wr == 0) PG8_BAR;
        if constexpr (FP8) asm volatile("s_nop 15\n\ts_nop 15\n\ts_nop 7" ::: "memory");
        E(acc, cur, wr, wc, fr, fq);
        if (!has_next) break;
#pragma unroll
        for (int a = 0; a < 2; ++a)
#pragma unroll
            for (int b = 0; b < 2; ++b)
#pragma unroll
                for (int m = 0; m < 4; ++m)
#pragma unroll
                    for (int n = 0; n < 2; ++n) acc[a][b][m][n] = (f32x4){0.f, 0.f, 0.f, 0.f};
        cur = nxt; cA = nA; cB = nB; ++ui;
        if (wr == 1) PG8_BAR;
    }
    PG8_WAIT_V(0);
    PG8_BAR;
#undef PG8_SA
#undef PG8_SB
#undef PG8_STAGE
#undef PG8_LDA
#undef PG8_LDB
#undef PG8_MMA
#undef PG8_WAIT_V
#undef PG8_WAIT_L
#undef PG8_BAR
#undef PG8_SCHED
}
}

#define XB_TMO      128
#define XB_XCNT(j)  (256  + 64 * (j))
#define XB_XSUB(j)  (1280 + 64 * (j))
#define XB_XGEN(j)  (2304 + 64 * (j))
#define XB_TOP      3328
#define XB_TOPGEN   3392
#define XCD_BAR_WORDS 3456
#define XB_SPIN_CAP (1u << 18)
__device__ __forceinline__ unsigned xb_ld(unsigned* p)              { return __hip_atomic_load(p, __ATOMIC_RELAXED, __HIP_MEMORY_SCOPE_AGENT); }
__device__ __forceinline__ unsigned xb_add(unsigned* p, unsigned v) { return __hip_atomic_fetch_add(p, v, __ATOMIC_RELAXED, __HIP_MEMORY_SCOPE_AGENT); }
__device__ __forceinline__ unsigned xb_xcc_id() { return (unsigned)__builtin_amdgcn_s_getreg((3 << 11) | 20) & 0xFu; }
#define XB_SPIN(cond, bar) do { unsigned _sp = 0; while (cond) { __builtin_amdgcn_s_sleep(1); \
    if ((++_sp & 255u) == 0u) { if (xb_ld(&(bar)[XB_TMO])) break; if (_sp > XB_SPIN_CAP) { atomicAdd(&(bar)[XB_TMO], 1u); break; } } } } while (0)
struct XcdBarrier { unsigned* bar; unsigned x; volatile LAS unsigned* st; };
__device__ __forceinline__ XcdBarrier xcd_barrier_post(unsigned* bar, volatile LAS unsigned* st) {
    XcdBarrier b; b.bar = bar; b.x = xb_xcc_id(); b.st = st;
    if (threadIdx.x == 0) (void)xb_add(&bar[XB_XCNT(b.x)], 1u);
    return b;
}
__device__ __forceinline__ void xcd_barrier_complete(unsigned* bar, unsigned x, unsigned& nloc, unsigned& nx) {
    const unsigned G = gridDim.x * gridDim.y * gridDim.z;
    unsigned sum, cnt, mine, sp = 0u;
    for (;;) {
        sum = 0u; cnt = 0u; mine = 0u;
#pragma unroll
        for (unsigned j = 0; j < 16; ++j) { const unsigned c = xb_ld(&bar[XB_XCNT(j)]); sum += c; cnt += (c > 0u) ? 1u : 0u; mine = (j == x) ? c : mine; }
        if (sum == G) break;
        __builtin_amdgcn_s_sleep(1);
        if ((++sp & 255u) == 0u) { if (xb_ld(&bar[XB_TMO])) break; if (sp > XB_SPIN_CAP) { atomicAdd(&bar[XB_TMO], 1u); break; } }
    }
    nloc = mine > 0u ? mine : 1u; nx = cnt > 0u ? cnt : 1u;
}
__device__ __forceinline__ void xcd_barrier(const XcdBarrier& b) {
    asm volatile("s_waitcnt vmcnt(0)" ::: "memory");
    __syncthreads();
    if (threadIdx.x == 0) {
        unsigned* bar = b.bar;
        __builtin_amdgcn_s_waitcnt(0);
        unsigned nloc = b.st[0], nx = b.st[1];
        if (nloc == 0u) { xcd_barrier_complete(bar, b.x, nloc, nx); b.st[0] = nloc; b.st[1] = nx; }
        const unsigned old = xb_add(&bar[XB_XSUB(b.x)], 1u);
        const unsigned gen = old / nloc;
        if (old + 1u == (gen + 1u) * nloc) {
            __builtin_amdgcn_fence(__ATOMIC_RELEASE, "agent");
            asm volatile("s_waitcnt vmcnt(0)" ::: "memory");
            const unsigned og = xb_add(&bar[XB_TOP], 1u);
            const unsigned tg = og / nx;
            if (og + 1u == (tg + 1u) * nx) xb_add(&bar[XB_TOPGEN], 1u);
            else XB_SPIN(xb_ld(&bar[XB_TOPGEN]) == tg, bar);
            __builtin_amdgcn_fence(__ATOMIC_ACQUIRE, "agent");
            xb_add(&bar[XB_XGEN(b.x)], 1u);
            asm volatile("s_waitcnt vmcnt(0)" ::: "memory");
        } else {
            XB_SPIN(xb_ld(&bar[XB_XGEN(b.x)]) == gen, bar);
            __builtin_amdgcn_fence(__ATOMIC_ACQUIRE, "agent");
            asm volatile("s_waitcnt vmcnt(0)" ::: "memory");
        }
    }
    __syncthreads();
}

constexpr int RING_BYTES = 131072;
constexpr int LDSCTL_OFF = RING_BYTES, MISC_OFF = LDSCTL_OFF + 320;
constexpr int LDS_BYTES = 147456;
constexpr int NWAVES = 8;

struct Args { const float* in[17]; float* out; unsigned char* ws; };

struct Ctx {
    LAS unsigned char* lds;
    int tid, lane, wave, vcu, G;
};

__device__ __forceinline__ Ctx fresh(const Ctx& F) {
    Ctx C = F; int t = threadIdx.x; asm volatile("" : "+v"(t)); C.tid = t; C.lane = t & 63; return C;
}
__device__ __forceinline__ void p0_transpose_item(const float* W, int K, int N, bf16_t* WT, LAS float* scr, int item, int lane) {
    const int nblk = N / 32, kb = item / nblk, nb = item % nblk, k0 = 64 * kb, n0 = 32 * nb;
#pragma unroll 8
    for (int i = 0; i < 32; ++i) { const int kk = 2 * i + (lane >> 5); scr[kk * 33 + (lane & 31)] = W[(size_t)(k0 + kk) * N + n0 + (lane & 31)]; }
    asm volatile("s_waitcnt lgkmcnt(0)" ::: "memory");
    const int c = lane & 7;
#pragma unroll
    for (int j = 0; j < 4; ++j) { const int n = (lane >> 3) + 8 * j; const LAS float* s = scr + (8 * c) * 33 + n;
        u32x4 o; o.x = pk2(s[0 * 33], s[1 * 33]); o.y = pk2(s[2 * 33], s[3 * 33]); o.z = pk2(s[4 * 33], s[5 * 33]); o.w = pk2(s[6 * 33], s[7 * 33]);
        *(u32x4*)(WT + (size_t)(n0 + n) * K + k0 + 8 * c) = o; }
    asm volatile("s_waitcnt lgkmcnt(0)" ::: "memory");
}
__device__ __forceinline__ void p0_transpose_item8(const float* W, int K, int N, unsigned char* WT, LAS float* scr, int item, int lane) {
    const int nblk = N / 32, kb = item / nblk, nb = item % nblk, k0 = 64 * kb, n0 = 32 * nb;
#pragma unroll 8
    for (int i = 0; i < 32; ++i) { const int kk = 2 * i + (lane >> 5); scr[kk * 33 + (lane & 31)] = W[(size_t)(k0 + kk) * N + n0 + (lane & 31)]; }
    asm volatile("s_waitcnt lgkmcnt(0)" ::: "memory");
    const int c = lane & 7;
#pragma unroll
    for (int j = 0; j < 4; ++j) { const int n = (lane >> 3) + 8 * j; const LAS float* s = scr + (8 * c) * 33 + n; constexpr float sc = pg8::W8_SCALE;
        u32x2 o; o.x = fp8_pack4(s[0 * 33] * sc, s[1 * 33] * sc, s[2 * 33] * sc, s[3 * 33] * sc); o.y = fp8_pack4(s[4 * 33] * sc, s[5 * 33] * sc, s[6 * 33] * sc, s[7 * 33] * sc);
        *(u32x2*)(WT + (size_t)(n0 + n) * K + k0 + 8 * c) = o; }
    asm volatile("s_waitcnt lgkmcnt(0)" ::: "memory");
}
__device__ __forceinline__ void cvt8(const float* src, bf16_t* dst) {
    const f32x4 a = *(const f32x4*)src, b = *(const f32x4*)(src + 4);
    u32x4 o; o.x = pk2(a[0], a[1]); o.y = pk2(a[2], a[3]); o.z = pk2(b[0], b[1]); o.w = pk2(b[2], b[3]);
    *(u32x4*)dst = o;
}

__device__ __forceinline__ void p0_prologue(const Ctx& F0, const Args& a) {
    const Ctx F = fresh(F0);
    unsigned char* ws = a.ws;
    const int gw = F.vcu * NWAVES + F.wave, NGW = F.G * NWAVES;
    const long gt = (long)F.vcu * 512 + F.tid, NGT = (long)F.G * 512;
    {
        LAS float* red = (LAS float*)(F.lds);
        const float* c = a.in[1]; const float* cctx = a.in[3]; const float* wmod = a.in[6]; const float* bmod = a.in[7];
        float* modb = (float*)(ws + WS_MOD);
        for (int item = F.vcu; item < 96; item += F.G) {
            const int l = item / 48, nc = item % 48, n0 = nc * 128 + 2 * F.lane, kb = F.wave * 128;
            float sv[9][2];
#pragma unroll
            for (int r = 0; r < 9; ++r)
#pragma unroll
                for (int j = 0; j < 2; ++j) { const int k = kb + 64 * j + F.lane; const float v = (r < 8) ? c[r * DM + k] : cctx[k]; sv[r][j] = v / (1.0f + __expf(-v)); }
            float acc[9][2];
#pragma unroll
            for (int r = 0; r < 9; ++r) { acc[r][0] = 0.f; acc[r][1] = 0.f; }
            const float* wp = wmod + (size_t)l * DM * NMOD + (size_t)kb * NMOD + n0;
#pragma unroll
            for (int j = 0; j < 2; ++j)
#pragma unroll 8
                for (int kl = 0; kl < 64; ++kl) {
                    const f32x2 w = *(const f32x2*)(wp + (size_t)(64 * j + kl) * NMOD);
#pragma unroll
                    for (int r = 0; r < 9; ++r) { const float s = __builtin_bit_cast(float, __builtin_amdgcn_readlane(__builtin_bit_cast(int, sv[r][j]), kl)); acc[r][0] += s * w[0]; acc[r][1] += s * w[1]; }
                }
            __syncthreads();
#pragma unroll
            for (int r = 0; r < 9; ++r) { red[(F.wave * 9 + r) * 128 + 2 * F.lane] = acc[r][0]; red[(F.wave * 9 + r) * 128 + 2 * F.lane + 1] = acc[r][1]; }
            __syncthreads();
            for (int o = F.tid; o < 9 * 128; o += 512) { const int r = o >> 7, nl = o & 127; float s = 0.f;
#pragma unroll
                for (int w = 0; w < 8; ++w) s += red[(w * 9 + r) * 128 + nl];
                modb[(size_t)(l * 9 + r) * NMOD + nc * 128 + nl] = s + bmod[l * NMOD + nc * 128 + nl]; }
        }
        __syncthreads();
    }
    {
        LAS float* scr = (LAS float*)(F.lds + F.wave * 16384);
        constexpr int I_QKV = (DM / 64) * (3 * DM / 32), I_O = (DM / 64) * (DM / 32), I_PQ = (DM / 64) * (2 * DM / 32);
        constexpr int NITEMS = I_QKV + 2 * I_O + 2 * I_PQ;
        for (int it = gw; it < NITEMS; it += NGW) {
            int r = it;
            if (r < I_QKV) { p0_transpose_item8(a.in[8], DM, 3 * DM, ws + WS_WQKV, scr, r, F.lane); continue; } r -= I_QKV;
            if (r < I_O) { p0_transpose_item8(a.in[9], DM, DM, ws + WS_WO, scr, r, F.lane); continue; } r -= I_O;
            if (r < I_O) { p0_transpose_item8(a.in[11], DM, DM, ws + WS_WF, scr, r, F.lane); continue; } r -= I_O;
            if (r < I_PQ) { p0_transpose_item8(a.in[12], DM, 2 * DM, ws + WS_WPQ, scr, r, F.lane); continue; } r -= I_PQ;
            p0_transpose_item8(a.in[12] + (size_t)DM * 2 * DM, DM, 2 * DM, ws + WS_WPQ + (size_t)2 * DM * DM, scr, r, F.lane);
        }
    }
    for (long i = gt; i < 2 * 2 * 128 * 128 / 8; i += NGT) cvt8(a.in[13] + i * 8, (bf16_t*)(ws + WS_SK) + i * 8);
    {
        bf16_t* wc = (bf16_t*)(ws + WS_WC);
        for (long i = gt; i < 512 * 256 / 8; i += NGT) { const int nn = (int)(i >> 5), k0 = (int)(i & 31) * 8; float v[8];
#pragma unroll
            for (int j = 0; j < 8; ++j) { const int m = ((k0 + j) * (nn & 255)) & 255; const float fr = (float)m * (1.0f / 256.0f);
                v[j] = (nn < 256 ? __builtin_amdgcn_cosf(fr) : __builtin_amdgcn_sinf(fr)) * (1.0f / 16.0f); }
            u32x4 o; o.x = pk2(v[0], v[1]); o.y = pk2(v[2], v[3]); o.z = pk2(v[4], v[5]); o.w = pk2(v[6], v[7]);
            *(u32x4*)(wc + i * 8) = o; }
        unsigned char* cs = ws + WS_CS;
        for (long i = gt; i < 2048L * 4096 / 8; i += NGT) { const int np = (int)(i >> 9), c0 = (int)(i & 511) * 8; const int part = c0 >> 11; float v[8];
#pragma unroll
            for (int j = 0; j < 8; ++j) { const int n = (c0 + j) & 2047; const int m = (n * np) & 4095; const float fr = (float)m * (1.0f / 4096.0f);
                v[j] = (part == 0 ? __builtin_amdgcn_cosf(fr) : -__builtin_amdgcn_sinf(fr)) * (pg8::CS_SCALE / 64.0f); }
            u32x2 o; o.x = fp8_pack4(v[0], v[1], v[2], v[3]); o.y = fp8_pack4(v[4], v[5], v[6], v[7]);
            *(u32x2*)(cs + i * 8) = o; }
    }
}

__device__ __forceinline__ unsigned fp4_pack8(const float* v, float sc) {
    unsigned w = 0;
#define FP4C(i) fminf(fmaxf(v[i] * sc, -6.f), 6.f)
    w = __builtin_amdgcn_cvt_scalef32_pk_fp4_f32(w, FP4C(0), FP4C(1), 1.0f, 0);
    w = __builtin_amdgcn_cvt_scalef32_pk_fp4_f32(w, FP4C(2), FP4C(3), 1.0f, 1);
    w = __builtin_amdgcn_cvt_scalef32_pk_fp4_f32(w, FP4C(4), FP4C(5), 1.0f, 2);
    w = __builtin_amdgcn_cvt_scalef32_pk_fp4_f32(w, FP4C(6), FP4C(7), 1.0f, 3);
#undef FP4C
    return w;
}
#define FP4_DEC(w, bs) __builtin_amdgcn_cvt_scalef32_pk_f32_fp4((w), 1.0f, (bs))
__device__ __forceinline__ unsigned i8_pack4(f32x4 v, float sc) {
    const int a = (int)rintf(fminf(fmaxf(v[0] * sc, -127.f), 127.f)), b = (int)rintf(fminf(fmaxf(v[1] * sc, -127.f), 127.f));
    const int c = (int)rintf(fminf(fmaxf(v[2] * sc, -127.f), 127.f)), d = (int)rintf(fminf(fmaxf(v[3] * sc, -127.f), 127.f));
    return (unsigned)(a & 0xff) | ((unsigned)(b & 0xff) << 8) | ((unsigned)(c & 0xff) << 16) | ((unsigned)(d & 0xff) << 24);
}
constexpr long TC_PER = (long)NEXP * DM / 16, TC_TOTAL = 4 * TC_PER;
__device__ __forceinline__ void tc_issue(const Args& a, long i, f32x4 (&v)[4]) {
    const int q = (int)(i / TC_PER); const long r = i - (long)q * TC_PER; const int l = q >> 1, tb = q & 1;
    const int e = (int)(r >> 6), c16 = (int)(r & 63);
    const float* src = (tb ? a.in[15] : a.in[14]) + ((size_t)l * NEXP + e) * DM + c16 * 16;
#pragma unroll
    for (int d = 0; d < 4; ++d) v[d] = *(const f32x4*)(src + 4 * d);
}
__device__ __forceinline__ void tc_finish(const Args& a, long i, const f32x4 (&v)[4]) {
    const int q = (int)(i / TC_PER); const long r = i - (long)q * TC_PER; const int l = q >> 1, tb = q & 1;
    const int e = (int)(r >> 6), c16 = (int)(r & 63);
    const float sc = tb ? V_SCALE : U_SCALE;
    u32x2 o;
#pragma unroll
    for (int d = 0; d < 2; ++d) { const float v8[8] = {v[2 * d][0], v[2 * d][1], v[2 * d][2], v[2 * d][3], v[2 * d + 1][0], v[2 * d + 1][1], v[2 * d + 1][2], v[2 * d + 1][3]};
        o[d] = fp4_pack8(v8, sc); }
    *(u32x2*)(a.ws + WS_TAB + (size_t)l * TAB_LAYER + (tb ? TAB_VOFF : 0) + ((size_t)(c16 >> 4) * NEXP + e) * 128 + (c16 & 15) * 8) = o;
}
__device__ __forceinline__ void table_convert(const Ctx& F0, const Args& a, int sh0, int nsh, int nshare) {
    const Ctx F = fresh(F0);
    constexpr long PER = (long)NEXP * DM / 16;
    constexpr long TOTAL = 4 * PER, T0 = TOTAL / 4;
    unsigned char* t8 = a.ws + WS_TAB;
    const long per_share = (TOTAL - T0 + nshare - 1) / nshare;
    const long i0 = T0 + (long)sh0 * per_share, i1 = min(T0 + (long)(sh0 + nsh) * per_share, TOTAL);
    for (long i = i0 + F.tid; i < i1; i += 512) {
        const int q = (int)(i / PER); const long r = i - (long)q * PER; const int l = q >> 1, tb = q & 1;
        const int e = (int)(r >> 6), c16 = (int)(r & 63);
        const float* src = (tb ? a.in[15] : a.in[14]) + ((size_t)l * NEXP + e) * DM + c16 * 16;
        if (tb) {
            u32x2 o;
#pragma unroll
            for (int d = 0; d < 2; ++d) { const f32x4 va = *(const f32x4*)(src + 8 * d), vb = *(const f32x4*)(src + 8 * d + 4);
                const float v8[8] = {va[0], va[1], va[2], va[3], vb[0], vb[1], vb[2], vb[3]};
                o[d] = fp4_pack8(v8, V_SCALE); }
            *(u32x2*)(t8 + (size_t)l * TAB_LAYER + TAB_VOFF + ((size_t)(c16 >> 4) * NEXP + e) * 128 + (c16 & 15) * 8) = o;
        } else {
            u32x2 o;
#pragma unroll
            for (int d = 0; d < 2; ++d) { const f32x4 va = *(const f32x4*)(src + 8 * d), vb = *(const f32x4*)(src + 8 * d + 4);
                const float v8[8] = {va[0], va[1], va[2], va[3], vb[0], vb[1], vb[2], vb[3]};
                o[d] = fp4_pack8(v8, U_SCALE); }
            *(u32x2*)(t8 + (size_t)l * TAB_LAYER + ((size_t)(c16 >> 4) * NEXP + e) * 128 + (c16 & 15) * 8) = o;
        }
    }
}

__device__ __forceinline__ const float* norm_src(const Args& a, int mode, int m) { return (m < ML) ? ((mode == 0 ? a.in[0] : a.out) + (size_t)m * DM) : (a.in[2] + (size_t)(m - ML) * DM); }
__device__ __forceinline__ void norm_phase(const Ctx& F0, const Args& a, int mode, int layer, int off, const float* gw) {
    const Ctx F = fresh(F0);
    const int gwv = F.vcu * NWAVES + F.wave, NGW = F.G * NWAVES, lane = F.lane;
    const float* modb = (const float*)(a.ws + WS_MOD) + (size_t)layer * 9 * NMOD;
    bf16_t* hx = (bf16_t*)(a.ws + WS_HX);
    const int nrows = (mode == 0) ? MT : ML;
    f32x4 gv[4];
#pragma unroll
    for (int j = 0; j < 4; ++j) gv[j] = ((const f32x4*)gw)[lane + 64 * j];
    if (mode != 0) {
        const u32x2* XBc = (const u32x2*)(a.ws + WS_XB);
        constexpr int CH = 16, NPF = 4;
        for (int c = gwv; c < ML / CH; c += NGW) {
            const int r0 = c * CH;
            u32x2 rb[NPF][4]; f32x4 v[4], av[4], cv[4];
#pragma unroll
            for (int p = 0; p < NPF; ++p)
#pragma unroll
                for (int j = 0; j < 4; ++j) rb[p][j] = XBc[(size_t)(r0 + p) * 256 + lane + 64 * j];
            { const float* mr = modb + (size_t)(r0 >> 12) * NMOD + off;
#pragma unroll
              for (int j = 0; j < 4; ++j) { av[j] = ((const f32x4*)mr)[lane + 64 * j]; cv[j] = ((const f32x4*)(mr + DM))[lane + 64 * j]; } }
            asm volatile("" :: "v"(cv[3]));
#pragma unroll 1
            for (int q = 0; q < CH / NPF; ++q) {
#pragma unroll
              for (int p = 0; p < NPF; ++p) {
                const int m = r0 + q * NPF + p;
#pragma unroll
                for (int j = 0; j < 4; ++j) v[j] = bf4_f32(rb[p][j]);
                { const int rn = min(m + NPF, r0 + CH - 1);
#pragma unroll
                  for (int j = 0; j < 4; ++j) rb[p][j] = XBc[(size_t)rn * 256 + lane + 64 * j]; }
              float s = 0.f;
#pragma unroll
              for (int j = 0; j < 4; ++j) s += (v[j].x * v[j].x + v[j].y * v[j].y) + (v[j].z * v[j].z + v[j].w * v[j].w);
              const float rstd = 1.0f / sqrtf(wave_sum(s) * (1.0f / DM) + EPS);
              unsigned long long* o8 = (unsigned long long*)(hx + (size_t)m * DM) + lane;
              unsigned* o4 = (unsigned*)(a.ws + WS_HX + (size_t)m * DM) + lane;
#pragma unroll
              for (int j = 0; j < 4; ++j) { const f32x4 y = (v[j] * rstd * gv[j]) * (cv[j] + 1.0f) + av[j];
                  if (mode == 0 || off == 3 * DM) o4[64 * j] = fp8_pack4(y.x * pg8::ACT8_SCALE, y.y * pg8::ACT8_SCALE, y.z * pg8::ACT8_SCALE, y.w * pg8::ACT8_SCALE);
                  if (mode == 0) continue;
                  if (off != 3 * DM)
                  o8[64 * j] = (unsigned long long)cvtpk(y.x, y.y) | ((unsigned long long)cvtpk(y.z, y.w) << 32);
                  if (off == 3 * DM) {
                      const float q0 = fminf(fmaxf(y.x * XQ_SCALE, -6.f), 6.f), q1 = fminf(fmaxf(y.y * XQ_SCALE, -6.f), 6.f), q2 = fminf(fmaxf(y.z * XQ_SCALE, -6.f), 6.f), q3 = fminf(fmaxf(y.w * XQ_SCALE, -6.f), 6.f);
                      unsigned ph = __builtin_amdgcn_cvt_scalef32_pk_fp4_f32(0u, q0, q1, 1.0f, 0); ph = __builtin_amdgcn_cvt_scalef32_pk_fp4_f32(ph, q2, q3, 1.0f, 1);
                      const f32x2 d0 = FP4_DEC(ph, 0), d1 = FP4_DEC(ph, 1);
                      unsigned pl = __builtin_amdgcn_cvt_scalef32_pk_fp4_f32(0u, 4.f * (q0 - d0.x), 4.f * (q1 - d0.y), 1.0f, 0); pl = __builtin_amdgcn_cvt_scalef32_pk_fp4_f32(pl, 4.f * (q2 - d1.x), 4.f * (q3 - d1.y), 1.0f, 1);
                      unsigned short* xq = (unsigned short*)(a.ws + WS_X8 + ((size_t)j * ML + m) * 256) + lane;
                      xq[0] = (unsigned short)(ph & 0xffffu); xq[64] = (unsigned short)(pl & 0xffffu); } }
              }
            }
        }
        return;
    }
    const u32x2* XBr = (const u32x2*)(a.ws + WS_XB);
    f32x4 v[4], vn[4]; u32x2 vr[4];
    if (gwv < nrows) {
        if (mode == 0) { const f32x4* xr = (const f32x4*)norm_src(a, mode, gwv) + lane;
#pragma unroll
            for (int j = 0; j < 4; ++j) vn[j] = xr[64 * j]; }
        else {
#pragma unroll
            for (int j = 0; j < 4; ++j) vr[j] = XBr[(size_t)gwv * 256 + lane + 64 * j]; } }
    for (int m = gwv; m < nrows; m += NGW) {
        const int mn = (m + NGW < nrows) ? m + NGW : m;
        if (mode == 0) {
#pragma unroll
            for (int j = 0; j < 4; ++j) v[j] = vn[j];
            const f32x4* xr = (const f32x4*)norm_src(a, mode, mn) + lane;
#pragma unroll
            for (int j = 0; j < 4; ++j) vn[j] = xr[64 * j];
        } else {
#pragma unroll
            for (int j = 0; j < 4; ++j) v[j] = bf4_f32(vr[j]);
#pragma unroll
            for (int j = 0; j < 4; ++j) vr[j] = XBr[(size_t)mn * 256 + lane + 64 * j];
        }
        const float* mr = modb + (size_t)((m < ML) ? (m >> 12) : 8) * NMOD + off;
        f32x4 av[4], cv[4];
#pragma unroll
        for (int j = 0; j < 4; ++j) { av[j] = ((const f32x4*)mr)[lane + 64 * j]; cv[j] = ((const f32x4*)(mr + DM))[lane + 64 * j]; }
        float s = 0.f;
#pragma unroll
        for (int j = 0; j < 4; ++j) s += (v[j].x * v[j].x + v[j].y * v[j].y) + (v[j].z * v[j].z + v[j].w * v[j].w);
        const float rstd = 1.0f / sqrtf(wave_sum(s) * (1.0f / DM) + EPS);
        unsigned long long* o8 = (unsigned long long*)(hx + (size_t)m * DM) + lane;
        unsigned* o4 = (unsigned*)(a.ws + WS_HX + (size_t)m * DM) + lane;
#pragma unroll
        for (int j = 0; j < 4; ++j) { const f32x4 y = (v[j] * rstd * gv[j]) * (cv[j] + 1.0f) + av[j];
            if (mode == 0 || off == 3 * DM) o4[64 * j] = fp8_pack4(y.x * pg8::ACT8_SCALE, y.y * pg8::ACT8_SCALE, y.z * pg8::ACT8_SCALE, y.w * pg8::ACT8_SCALE);
            if (mode == 0) continue;
            if (off != 3 * DM)
            o8[64 * j] = (unsigned long long)cvtpk(y.x, y.y) | ((unsigned long long)cvtpk(y.z, y.w) << 32);
            if (off == 3 * DM) {
                const float q0 = fminf(fmaxf(y.x * XQ_SCALE, -6.f), 6.f), q1 = fminf(fmaxf(y.y * XQ_SCALE, -6.f), 6.f), q2 = fminf(fmaxf(y.z * XQ_SCALE, -6.f), 6.f), q3 = fminf(fmaxf(y.w * XQ_SCALE, -6.f), 6.f);
                unsigned ph = __builtin_amdgcn_cvt_scalef32_pk_fp4_f32(0u, q0, q1, 1.0f, 0); ph = __builtin_amdgcn_cvt_scalef32_pk_fp4_f32(ph, q2, q3, 1.0f, 1);
                const f32x2 d0 = FP4_DEC(ph, 0), d1 = FP4_DEC(ph, 1);
                unsigned pl = __builtin_amdgcn_cvt_scalef32_pk_fp4_f32(0u, 4.f * (q0 - d0.x), 4.f * (q1 - d0.y), 1.0f, 0); pl = __builtin_amdgcn_cvt_scalef32_pk_fp4_f32(pl, 4.f * (q2 - d1.x), 4.f * (q3 - d1.y), 1.0f, 1);
                unsigned short* xq = (unsigned short*)(a.ws + WS_X8 + ((size_t)j * ML + m) * 256) + lane;
                xq[0] = (unsigned short)(ph & 0xffffu); xq[64] = (unsigned short)(pl & 0xffffu); } }
    }
}
__device__ __forceinline__ void norm_fold_phase(const Ctx& F0, const Args& a, int layer, const float* gw) {
    const Ctx F = fresh(F0);
    const int gwv = F.vcu * NWAVES + F.wave, NGW = F.G * NWAVES, lane = F.lane;
    const float* modb = (const float*)(a.ws + WS_MOD) + (size_t)layer * 9 * NMOD;
    const u32x2* XBr = (const u32x2*)(a.ws + WS_XB);
    unsigned long long* hc = (unsigned long long*)(a.ws + WS_HX);
    unsigned long long* hs = (unsigned long long*)(a.ws + WS_HX + 32 * MiB);
    float* yni = (float*)(a.ws + WS_YNI);
    f32x4 gv[4];
#pragma unroll
    for (int j = 0; j < 4; ++j) gv[j] = ((const f32x4*)gw)[lane + 64 * j];
    u32x2 ra[4], rb[4];
#define NF_ROWS(task_, na_, nb_) const int b_ = (task_) >> 11, t_ = (task_) & 2047; const int na_ = b_ * SEQ + t_, nb_ = b_ * SEQ + (t_ == 0 ? 2048 : SEQ - t_)
    if (gwv < NB * 2048) { NF_ROWS(gwv, na, nb);
#pragma unroll
        for (int j = 0; j < 4; ++j) { ra[j] = XBr[(size_t)na * 256 + lane + 64 * j]; rb[j] = XBr[(size_t)nb * 256 + lane + 64 * j]; } }
    for (int task = gwv; task < NB * 2048; task += NGW) {
        const int b = task >> 11, t = task & 2047;
        f32x4 va[4], vb[4];
#pragma unroll
        for (int j = 0; j < 4; ++j) { va[j] = bf4_f32(ra[j]); vb[j] = bf4_f32(rb[j]); }
        { const int tn = (task + NGW < NB * 2048) ? task + NGW : task; NF_ROWS(tn, na, nb);
#pragma unroll
          for (int j = 0; j < 4; ++j) { ra[j] = XBr[(size_t)na * 256 + lane + 64 * j]; rb[j] = XBr[(size_t)nb * 256 + lane + 64 * j]; } }
        const float* mr = modb + (size_t)b * NMOD;
        f32x4 av[4], cv[4];
#pragma unroll
        for (int j = 0; j < 4; ++j) { av[j] = ((const f32x4*)mr)[lane + 64 * j]; cv[j] = ((const f32x4*)(mr + DM))[lane + 64 * j]; }
        float sa = 0.f, sb = 0.f;
#pragma unroll
        for (int j = 0; j < 4; ++j) { sa += (va[j].x * va[j].x + va[j].y * va[j].y) + (va[j].z * va[j].z + va[j].w * va[j].w); sb += (vb[j].x * vb[j].x + vb[j].y * vb[j].y) + (vb[j].z * vb[j].z + vb[j].w * vb[j].w); }
        const float ra_ = 1.0f / sqrtf(wave_sum(sa) * (1.0f / DM) + EPS), rb_ = 1.0f / sqrtf(wave_sum(sb) * (1.0f / DM) + EPS);
        const size_t orow = ((size_t)b * 2048 + t) * 256 + lane;
#pragma unroll
        for (int j = 0; j < 4; ++j) {
            const f32x4 ya = (va[j] * ra_ * gv[j]) * (cv[j] + 1.0f) + av[j], yb = (vb[j] * rb_ * gv[j]) * (cv[j] + 1.0f) + av[j];
            f32x4 ys, yd;
            if (t == 0) { ys = ya; yd = (f32x4){0.f, 0.f, 0.f, 0.f}; ((f32x4*)(yni + (size_t)b * DM))[lane + 64 * j] = yb; }
            else { ys = ya + yb; yd = ya - yb; }
            hc[orow + 64 * j] = (unsigned long long)cvtpk(ys.x, ys.y) | ((unsigned long long)cvtpk(ys.z, ys.w) << 32);
            hs[orow + 64 * j] = (unsigned long long)cvtpk(yd.x, yd.y) | ((unsigned long long)cvtpk(yd.z, yd.w) << 32);
        }
    }
#undef NF_ROWS
}
__device__ __forceinline__ void final_norm_phase(const Ctx& F0, const Args& a) {
    const Ctx F = fresh(F0);
    const int gwv = F.vcu * NWAVES + F.wave, NGW = F.G * NWAVES;
    const float* gw = a.in[16];
    const u32x2* XBr = (const u32x2*)(a.ws + WS_XB);
    f32x4 gv[4]; u32x2 vr[4];
#pragma unroll
    for (int j = 0; j < 4; ++j) gv[j] = ((const f32x4*)gw)[F.lane + 64 * j];
    if (gwv < ML) {
#pragma unroll
        for (int j = 0; j < 4; ++j) vr[j] = XBr[(size_t)gwv * 256 + F.lane + 64 * j]; }
    for (int m = gwv; m < ML; m += NGW) {
        f32x4* xr = (f32x4*)(a.out + (size_t)m * DM) + F.lane;
        f32x4 v[4]; float s = 0.f;
#pragma unroll
        for (int j = 0; j < 4; ++j) { v[j] = bf4_f32(vr[j]); s += (v[j].x * v[j].x + v[j].y * v[j].y) + (v[j].z * v[j].z + v[j].w * v[j].w); }
        { const int mn = (m + NGW < ML) ? m + NGW : m;
#pragma unroll
          for (int j = 0; j < 4; ++j) vr[j] = XBr[(size_t)mn * 256 + F.lane + 64 * j]; }
        const float rstd = 1.0f / sqrtf(wave_sum(s) * (1.0f / DM) + EPS);
#pragma unroll
        for (int j = 0; j < 4; ++j) xr[64 * j] = v[j] * rstd * gv[j];
    }
}

constexpr int ATT_ROWB = 144, ATT_KTILEB = 128 * ATT_ROWB, ATT_VROWB = 272, ATT_VTILEB = 64 * ATT_VROWB, ATT_BIAS_B = 2048, ATT_K0 = ATT_BIAS_B, ATT_V0 = ATT_K0 + 2 * ATT_KTILEB;
constexpr float ATT_THR = 8.0f;
template <int NGH, bool LATENT>
__device__ __forceinline__ void attn_sub(const LAS unsigned char* Kt, const LAS unsigned char* Vt_, int ko, const LAS float* browA, const LAS float* browB, const int (&relidx)[8],
                                         const bf16x8 (&qf)[2], float& m_ref, float& l_run, f32x4 (&o)[4], int q16, int g4) {
    constexpr int NG = 2 * NGH;
    bf16x8 kf[2 * NG][2]; u32x2 vf[4][NG][2]; f32x4 sc[2 * NG];
#pragma unroll
    for (int gk = 0; gk < NG; ++gk)
#pragma unroll
        for (int b2 = 0; b2 < 2; ++b2)
#pragma unroll
            for (int ks = 0; ks < 2; ++ks) kf[2 * gk + b2][ks] = *(const LAS bf16x8*)(Kt + ((gk / NGH) * 64 + ko + 32 * (gk % NGH) + 16 * b2 + q16) * ATT_ROWB + 64 * ks + 16 * g4);
#pragma unroll
    for (int d = 0; d < 4; ++d)
#pragma unroll
        for (int gk = 0; gk < NG; ++gk) { const LAS unsigned char* vp = Vt_ + (16 * d + q16) * ATT_VROWB + 2 * ((gk / NGH) * 64 + ko + 32 * (gk % NGH) + 4 * g4);
            vf[d][gk][0] = *(const LAS u32x2*)vp; vf[d][gk][1] = *(const LAS u32x2*)(vp + 32); }
    if (LATENT) {
#pragma unroll
        for (int kk = 0; kk < 8; ++kk) { sc[kk >> 2][kk & 3] = browA[relidx[kk]] - m_ref; sc[2 + (kk >> 2)][kk & 3] = browB[relidx[kk]] - m_ref; }
    } else {
#pragma unroll
        for (int blk = 0; blk < 2 * NG; ++blk) sc[blk] = (f32x4){-m_ref, -m_ref, -m_ref, -m_ref};
    }
#pragma unroll
    for (int blk = 0; blk < 2 * NG; ++blk)
#pragma unroll
        for (int ks = 0; ks < 2; ++ks) sc[blk] = __builtin_amdgcn_mfma_f32_16x16x32_bf16(kf[blk][ks], qf[ks], sc[blk], 0, 0, 0);
    float mx = fmaxf(fmaxf(sc[0][0], sc[0][1]), fmaxf(sc[0][2], sc[0][3]));
#pragma unroll
    for (int blk = 1; blk < 2 * NG; ++blk) mx = fmaxf(mx, fmaxf(fmaxf(sc[blk][0], sc[blk][1]), fmaxf(sc[blk][2], sc[blk][3])));
    if (__builtin_amdgcn_ballot_w64(mx > ATT_THR) != 0ull) {
        mx = fmaxf(mx, __shfl_xor(mx, 16)); mx = fmaxf(mx, __shfl_xor(mx, 32));
        const float dl = mx > ATT_THR ? mx : 0.f;
        m_ref += dl;
        const float al = __builtin_amdgcn_exp2f(-dl);
        l_run *= al;
#pragma unroll
        for (int d = 0; d < 4; ++d) o[d] *= al;
#pragma unroll
        for (int blk = 0; blk < 2 * NG; ++blk) sc[blk] -= dl;
    }
    float ls0 = 0.f, ls1 = 0.f;
#pragma unroll
    for (int blk = 0; blk < 2 * NG; ++blk)
#pragma unroll
        for (int i = 0; i < 4; ++i) { const float e = __builtin_amdgcn_exp2f(sc[blk][i]); sc[blk][i] = e; if (blk & 1) ls1 += e; else ls0 += e; }
    l_run += ls0 + ls1;
    bf16x8 pf[NG];
#pragma unroll
    for (int gk = 0; gk < NG; ++gk) { u32x4 pw; pw.x = cvtpk(sc[2 * gk][0], sc[2 * gk][1]); pw.y = cvtpk(sc[2 * gk][2], sc[2 * gk][3]); pw.z = cvtpk(sc[2 * gk + 1][0], sc[2 * gk + 1][1]); pw.w = cvtpk(sc[2 * gk + 1][2], sc[2 * gk + 1][3]);
        pf[gk] = __builtin_bit_cast(bf16x8, pw); }
#pragma unroll
    for (int gk = 0; gk < NG; ++gk)
#pragma unroll
        for (int d = 0; d < 4; ++d) { u32x4 vw; vw.x = vf[d][gk][0].x; vw.y = vf[d][gk][0].y; vw.z = vf[d][gk][1].x; vw.w = vf[d][gk][1].y;
            o[d] = __builtin_amdgcn_mfma_f32_16x16x32_bf16(__builtin_bit_cast(bf16x8, vw), pf[gk], o[d], 0, 0, 0); }
}
__device__ __forceinline__ void attn_phase(const Ctx& F0, const Args& a) {
    const Ctx F = fresh(F0);
    const bf16_t* QK = (const bf16_t*)(a.ws + WS_QK);
    const bf16_t* VT = (const bf16_t*)(a.ws + WS_VT);
    unsigned char* AO = a.ws + WS_HX + 36 * MiB;
    const float* rpb = a.in[10];
    LAS float* bias = (LAS float*)F.lds;
    const int tid = F.tid, lane = F.lane, q16 = lane & 15, g4 = lane >> 4;
    const int rr = F.wave >> 2, jt = F.wave & 3;
    const int qc = 16 * jt + q16, cs = min(max(qc - 8, 0), 48), ksj = min(max(16 * jt - 8, 0), 32);
    int relidx[8];
#pragma unroll
    for (int k = 0; k < 8; ++k) { const int kc = ksj + 16 * (k >> 2) + 4 * g4 + (k & 3); relidx[k] = (kc >= cs && kc < cs + 16) ? (kc - qc + 15) : 31; }
    const int krow = tid >> 3, kch = tid & 7, vrow = tid >> 4, vch = tid & 15;
    const unsigned lds_k = (unsigned)(krow * ATT_ROWB + kch * 16), lds_v = (unsigned)(vrow * ATT_VROWB + vch * 16);
    const int nunits = NB * 16 * 16, upb = (nunits + F.G - 1) / F.G;
    int cur_bh = -1;
    for (int k = 0; k < upb; ++k) {
        const int id = F.vcu * upb + k; if (id >= nunits) break;
        const int p = id & 15, bh = id >> 4, b = bh >> 4, h = bh & 15;
        if (bh != cur_bh) {
            __syncthreads();
            for (int i = tid; i < 16 * 32; i += 512) { const int dr = i >> 5, dc = i & 31; bias[i] = (dc < 31 && dr < 15) ? rpb[(h * 15 + dr) * 31 + dc] * LOG2E : -1e30f; }
            cur_bh = bh;
        }
        const int r0 = 4 * p, rs0 = min(max(r0 - 4, 0), 56), rs1 = min(max(r0 + 3 - 4, 0), 56);
        const int nlat = rs1 + 8 - rs0, nlt = (nlat + 1) >> 1, nsteps = nlt + 2;
        const int rA = r0 + rr, rB = r0 + 2 + rr, rsA = min(max(rA - 4, 0), 56), rsB = min(max(rB - 4, 0), 56);
        const long tokqA = (long)b * SEQ + rA * GW + qc, tokqB = (long)b * SEQ + rB * GW + qc;
        const bf16_t* kbase = QK + 1024 + h * 64 + kch * 8;
        const bf16_t* vbase = VT + (long)(h * 64 + vrow) * MT + (vch & 7) * 8;
#define ATT_TOKA(step) ((step) < nlt ? ((long)b * SEQ + (long)(rs0 + 2 * (step)) * GW) : ((long)ML + b * CTXL + ((step) - nlt) * 128))
#define ATT_TOKB(step) ((step) < nlt ? ((long)b * SEQ + (long)min(rs0 + 2 * (step) + 1, rs0 + nlat - 1) * GW) : ((long)ML + b * CTXL + ((step) - nlt) * 128 + 64))
        u32x4 kA[2], vA[2];
#define ATT_LOAD(step, kr_, vr_) do { const int st_ = (step) < nsteps ? (step) : nsteps - 1; const long ta_ = ATT_TOKA(st_), tb_ = ATT_TOKB(st_);     \
        kr_[0] = *(const u32x4*)(kbase + (ta_ + krow) * 2048); kr_[1] = *(const u32x4*)(kbase + (tb_ + krow) * 2048); \
        const long tv_ = (vch < 8) ? ta_ : tb_; vr_[0] = *(const u32x4*)(vbase + tv_); vr_[1] = *(const u32x4*)(vbase + (long)32 * MT + tv_); } while (0)
#define ATT_WRITE(buf, kr_, vr_) do { *(LAS u32x4*)(F.lds + ATT_K0 + (buf) * ATT_KTILEB + lds_k) = kr_[0]; *(LAS u32x4*)(F.lds + ATT_K0 + (buf) * ATT_KTILEB + 64 * ATT_ROWB + lds_k) = kr_[1]; \
        *(LAS u32x4*)(F.lds + ATT_V0 + (buf) * ATT_VTILEB + lds_v) = vr_[0]; *(LAS u32x4*)(F.lds + ATT_V0 + (buf) * ATT_VTILEB + 32 * ATT_VROWB + lds_v) = vr_[1]; } while (0)
        ATT_LOAD(0, kA, vA);
        f32x4 tcv0[4];
        const int tci0 = id * 512 + tid;
        tc_issue(a, tci0, tcv0);
        bf16x8 qfA[2], qfB[2];
#pragma unroll
        for (int ks = 0; ks < 2; ++ks) { qfA[ks] = *(const bf16x8*)(QK + tokqA * 2048 + h * 64 + 32 * ks + 8 * g4); qfB[ks] = *(const bf16x8*)(QK + tokqB * 2048 + h * 64 + 32 * ks + 8 * g4); }
        float mA = 0.f, lA = 0.f, mB = 0.f, lB = 0.f;
        f32x4 oA[4], oB[4];
#pragma unroll
        for (int d = 0; d < 4; ++d) { oA[d] = (f32x4){0.f, 0.f, 0.f, 0.f}; oB[d] = (f32x4){0.f, 0.f, 0.f, 0.f}; }
        __syncthreads();
        ATT_WRITE(0, kA, vA);
        ATT_LOAD(1, kA, vA);
        asm volatile("" :: "v"(qfA[0]), "v"(qfA[1]), "v"(qfB[0]), "v"(qfB[1]));
        __syncthreads();
#define ATT_COMPUTE(step, cur) do { \
            const LAS unsigned char* Kt = F.lds + ATT_K0 + (cur) * ATT_KTILEB; \
            const LAS unsigned char* Vt_ = F.lds + ATT_V0 + (cur) * ATT_VTILEB; \
            unsigned kt2_ = (unsigned)(size_t)Kt, vt2_ = (unsigned)(size_t)Vt_; asm volatile("" : "+v"(kt2_), "+v"(vt2_));     \
            const LAS unsigned char* KtB = (const LAS unsigned char*)(size_t)kt2_; const LAS unsigned char* VtB = (const LAS unsigned char*)(size_t)vt2_; \
            if ((step) < nlt) { const int kra = rs0 + 2 * (step), krb = kra + 1; const bool vb_ = krb < rs0 + nlat; \
                { const bool a0 = kra >= rsA && kra < rsA + 8, a1 = vb_ && krb >= rsA && krb < rsA + 8; \
                  if (a0 || a1) attn_sub<1, true>(Kt, Vt_, ksj, bias + (a0 ? (kra - rA + 7) : 15) * 32, bias + (a1 ? (krb - rA + 7) : 15) * 32, relidx, qfA, mA, lA, oA, q16, g4); } \
                { const bool b0 = kra >= rsB && kra < rsB + 8, b1 = vb_ && krb >= rsB && krb < rsB + 8; \
                  if (b0 || b1) attn_sub<1, true>(KtB, VtB, ksj, bias + (b0 ? (kra - rB + 7) : 15) * 32, bias + (b1 ? (krb - rB + 7) : 15) * 32, relidx, qfB, mB, lB, oB, q16, g4); } \
            } else {                                                     \
                attn_sub<1, false>(Kt, Vt_, 0, bias, bias, relidx, qfA, mA, lA, oA, q16, g4); attn_sub<1, false>(Kt, Vt_, 32, bias, bias, relidx, qfA, mA, lA, oA, q16, g4); \
                attn_sub<1, false>(KtB, VtB, 0, bias, bias, relidx, qfB, mB, lB, oB, q16, g4); attn_sub<1, false>(KtB, VtB, 32, bias, bias, relidx, qfB, mB, lB, oB, q16, g4); } \
        } while (0)
        for (int step = 0; step < nsteps; step += 2) {
            ATT_COMPUTE(step, 0);
            if (step + 1 < nsteps) ATT_WRITE(1, kA, vA);
            ATT_LOAD(step + 2, kA, vA);
            __syncthreads();
            if (step + 1 < nsteps) { ATT_COMPUTE(step + 1, 1); }
            if (step + 2 < nsteps) ATT_WRITE(0, kA, vA);
            ATT_LOAD(step + 3, kA, vA);
            __syncthreads();
        }
#undef ATT_LOAD
#undef ATT_WRITE
#undef ATT_COMPUTE
#undef ATT_TOKA
#undef ATT_TOKB
        { int ti_ = id * 512 + tid; asm volatile("" : "+v"(ti_));
          tc_finish(a, ti_, tcv0); }
        lA += __shfl_xor(lA, 16); lA += __shfl_xor(lA, 32); lB += __shfl_xor(lB, 16); lB += __shfl_xor(lB, 32);
        { int tq_ = b * SEQ + rA * GW + qc; asm volatile("" : "+v"(tq_));
          unsigned char* op = AO + (long)tq_ * DM + h * 64 + 4 * g4; const float ls = pg8::ACT8_SCALE / lA;
#pragma unroll
          for (int d = 0; d < 4; ++d) *(unsigned*)(op + 16 * d) = fp8_pack4(oA[d][0] * ls, oA[d][1] * ls, oA[d][2] * ls, oA[d][3] * ls); }
        { int tq_ = b * SEQ + rB * GW + qc; asm volatile("" : "+v"(tq_));
          unsigned char* op = AO + (long)tq_ * DM + h * 64 + 4 * g4; const float ls = pg8::ACT8_SCALE / lB;
#pragma unroll
          for (int d = 0; d < 4; ++d) *(unsigned*)(op + 16 * d) = fp8_pack4(oB[d][0] * ls, oB[d][1] * ls, oB[d][2] * ls, oB[d][3] * ls); }
    }
    __syncthreads();
}

__device__ __forceinline__ void ce_desc(float& a, float& b) { const float hi = fmaxf(a, b), lo = fminf(a, b); a = hi; b = lo; }
__device__ __forceinline__ void ce_dir(float& a, float& b, bool desc) { const float hi = fmaxf(a, b), lo = fminf(a, b); a = desc ? hi : lo; b = desc ? lo : hi; }
__device__ __forceinline__ void sort16_desc(float (&v)[16]) {
#define S16CE(i, j) { const float hi_ = fmaxf(v[i], v[j]), lo_ = fminf(v[i], v[j]); v[i] = hi_; v[j] = lo_; }
    S16CE(0,13) S16CE(1,12) S16CE(2,15) S16CE(3,14) S16CE(4,8) S16CE(5,6) S16CE(7,11) S16CE(9,10)
    S16CE(0,5) S16CE(1,7) S16CE(2,9) S16CE(3,4) S16CE(6,13) S16CE(8,14) S16CE(10,15) S16CE(11,12)
    S16CE(0,1) S16CE(2,3) S16CE(4,5) S16CE(6,8) S16CE(7,9) S16CE(10,11) S16CE(12,13) S16CE(14,15)
    S16CE(0,2) S16CE(1,3) S16CE(4,10) S16CE(5,11) S16CE(6,7) S16CE(8,9) S16CE(12,14) S16CE(13,15)
    S16CE(1,2) S16CE(3,12) S16CE(4,6) S16CE(5,7) S16CE(8,10) S16CE(9,11) S16CE(13,14)
    S16CE(1,4) S16CE(2,6) S16CE(5,8) S16CE(7,10) S16CE(9,13) S16CE(11,14)
    S16CE(2,4) S16CE(3,6) S16CE(9,12) S16CE(11,13)
    S16CE(3,5) S16CE(6,8) S16CE(7,9) S16CE(10,12)
    S16CE(3,4) S16CE(5,6) S16CE(7,8) S16CE(9,10) S16CE(11,12)
    S16CE(6,7) S16CE(8,9)
#undef S16CE
}
__device__ __forceinline__ void merge16_desc(float (&a)[16], const float (&b)[16]) {
#pragma unroll
    for (int i = 0; i < 16; ++i) a[i] = fmaxf(a[i], b[15 - i]);
#pragma unroll
    for (int j = 8; j > 0; j >>= 1)
#pragma unroll
        for (int i = 0; i < 16; ++i) { const int l = i ^ j; if (l > i) ce_desc(a[i], a[l]); }
}

struct CandTab { int i[64]; int j[64]; };
__host__ __device__ constexpr CandTab make_cand_tab() {
    CandTab t{}; int n = 0;
    for (int i = 0; i < 16; ++i) for (int j = 0; j < 16; ++j) if ((i + 1) * (j + 1) <= 16) { t.i[n] = i; t.j[n] = j; ++n; }
    for (; n < 64; ++n) { t.i[n] = -1; t.j[n] = -1; }
    return t;
}

__device__ __forceinline__ void peer_topk_phase(const Ctx& F0, const Args& a, int layer) {
    const Ctx F = fresh(F0);
    const bf16_t* QP = (const bf16_t*)(a.ws + WS_QK);
    const bf16_t* SK = (const bf16_t*)(a.ws + WS_SK) + (size_t)layer * 2 * 128 * 128;
    unsigned short* IDX = (unsigned short*)(a.ws + WS_IDX);
    float* GATE = (float*)(a.ws + WS_GATE);
    const int gwv = F.vcu * NWAVES + F.wave, NGW = F.G * NWAVES;
    const int lane = F.lane, t32 = lane & 31, hi = lane >> 5;
    __syncthreads();
    for (int c = F.tid; c < 4096; c += 512) *(LAS u32x4*)(F.lds + (c >> 4) * 272 + (c & 15) * 16) = *(const u32x4*)(SK + (size_t)c * 8);
    __syncthreads();
#define TK_LDQ(dst, task_, p_) do { const int tk_ = (task_) < 1024 * 8 ? (task_) : 1024 * 8 - 1; const bf16_t* qp_ = QP + ((long)(tk_ >> 3) * 32 + t32) * 2048 + (tk_ & 7) * 256 + (p_) * 128 + hi * 8; \
        _Pragma("unroll") for (int ks = 0; ks < 8; ++ks) dst[ks] = *(const bf16x8*)(qp_ + ks * 16); } while (0)
    bf16x8 qn[8];
    TK_LDQ(qn, gwv, 0);
    for (int task = gwv; task < 1024 * 8; task += NGW) {
        const int tt = task >> 3, h = task & 7;
        const long tok = (long)tt * 32 + t32;
        float top[2][16];
#pragma unroll
        for (int p = 0; p < 2; ++p) {
            bf16x8 qc[8];
#pragma unroll
            for (int ks = 0; ks < 8; ++ks) qc[ks] = qn[ks];
            if (p == 0) TK_LDQ(qn, task, 1); else TK_LDQ(qn, task + NGW, 0);
            f32x16 acc[4];
#pragma unroll
            for (int eb = 0; eb < 4; ++eb)
#pragma unroll
                for (int i = 0; i < 16; ++i) acc[eb][i] = 0.f;
#pragma unroll
            for (int eb = 0; eb < 4; ++eb) asm volatile("" : "+v"(acc[eb]));
            const LAS unsigned char* kp = F.lds + (p * 128 + t32) * 272 + hi * 16;
#pragma unroll
            for (int ks = 0; ks < 8; ++ks) {
                if ((ks & 1) == 0) asm volatile("" ::: "memory");
                const bf16x8 bq = qc[ks];
#pragma unroll
                for (int eb = 0; eb < 4; ++eb) { const bf16x8 ak = *(const LAS bf16x8*)(kp + eb * 32 * 272 + ks * 32); acc[eb] = __builtin_amdgcn_mfma_f32_32x32x16_bf16(ak, bq, acc[eb], 0, 0, 0); }
            }
            float cur[16];
#pragma unroll
            for (int eb = 0; eb < 4; ++eb) {
                float v[16];
#pragma unroll
                for (int i = 0; i < 16; ++i) { const unsigned e = 32 * eb + crow(i, hi); float x = acc[eb][i]; asm volatile("" : "+v"(x));
                    v[i] = __builtin_bit_cast(float, (__builtin_bit_cast(unsigned, x) & ~0x7Fu) | e); }
                sort16_desc(v);
                if (eb == 0) {
#pragma unroll
                    for (int i = 0; i < 16; ++i) cur[i] = v[i];
                } else merge16_desc(cur, v);
            }
            float oth[16];
#pragma unroll
            for (int i = 0; i < 16; ++i) oth[i] = __shfl_xor(cur[i], 32);
            merge16_desc(cur, oth);
#pragma unroll
            for (int i = 0; i < 16; ++i) top[p][i] = cur[i];
            __builtin_amdgcn_sched_barrier(0);
        }
        float best[16];
#pragma unroll
        for (int gI = 0; gI < 4; ++gI) {
            float v[16];
#pragma unroll
            for (int q = 0; q < 16; ++q) {
                constexpr CandTab CT = make_cand_tab();
                const int ci = CT.i[16 * gI + q], cj = CT.j[16 * gI + q];
                if (ci >= 0) {
                    const unsigned ua = __builtin_bit_cast(unsigned, top[0][ci]), ub = __builtin_bit_cast(unsigned, top[1][cj]);
                    float s = top[0][ci] + top[1][cj]; asm volatile("" : "+v"(s));
                    const unsigned code = ((ua & 0x7Fu) << 7) | (ub & 0x7Fu);
                    v[q] = __builtin_bit_cast(float, (__builtin_bit_cast(unsigned, s) & ~0x3FFFu) | code);
                } else v[q] = -3.0e38f;
            }
            sort16_desc(v);
            if (gI == 0) {
#pragma unroll
                for (int i = 0; i < 16; ++i) best[i] = v[i];
            } else merge16_desc(best, v);
            __builtin_amdgcn_sched_barrier(0);
        }
        float e[16], sum = 0.f;
#pragma unroll
        for (int i = 0; i < 16; ++i) { e[i] = __builtin_amdgcn_exp2f((best[i] - best[0]) * LOG2E); sum += e[i]; }
        const float inv = 1.0f / sum;
        if (hi == 0) {
            u32x4 w0, w1;
            w0.x = (__builtin_bit_cast(unsigned, best[0]) & 0x3FFFu) | ((__builtin_bit_cast(unsigned, best[1]) & 0x3FFFu) << 16);
            w0.y = (__builtin_bit_cast(unsigned, best[2]) & 0x3FFFu) | ((__builtin_bit_cast(unsigned, best[3]) & 0x3FFFu) << 16);
            w0.z = (__builtin_bit_cast(unsigned, best[4]) & 0x3FFFu) | ((__builtin_bit_cast(unsigned, best[5]) & 0x3FFFu) << 16);
            w0.w = (__builtin_bit_cast(unsigned, best[6]) & 0x3FFFu) | ((__builtin_bit_cast(unsigned, best[7]) & 0x3FFFu) << 16);
            w1.x = (__builtin_bit_cast(unsigned, best[8]) & 0x3FFFu) | ((__builtin_bit_cast(unsigned, best[9]) & 0x3FFFu) << 16);
            w1.y = (__builtin_bit_cast(unsigned, best[10]) & 0x3FFFu) | ((__builtin_bit_cast(unsigned, best[11]) & 0x3FFFu) << 16);
            w1.z = (__builtin_bit_cast(unsigned, best[12]) & 0x3FFFu) | ((__builtin_bit_cast(unsigned, best[13]) & 0x3FFFu) << 16);
            w1.w = (__builtin_bit_cast(unsigned, best[14]) & 0x3FFFu) | ((__builtin_bit_cast(unsigned, best[15]) & 0x3FFFu) << 16);
            u32x4* ip = (u32x4*)(IDX + tok * 128 + h * 16);
            ip[0] = w0; ip[1] = w1;
        } else {
            f32x4* gp = (f32x4*)(GATE + tok * 128 + h * 16);
#pragma unroll
            for (int q = 0; q < 4; ++q) gp[q] = (f32x4){e[4 * q] * inv, e[4 * q + 1] * inv, e[4 * q + 2] * inv, e[4 * q + 3] * inv};
        }
    }
#undef TK_LDQ
    __syncthreads();
}

typedef long i64_t;
typedef unsigned u32x8_t __attribute__((ext_vector_type(8)));
typedef _Float16 h2_t __attribute__((ext_vector_type(2)));
#define U_MFMA4_FIRST(acc, av, bv) asm volatile("v_mfma_scale_f32_16x16x128_f8f6f4 %0, %1, %2, 0, %3, %4 op_sel_hi:[0,0,0] cbsz:4 blgp:4" : "=&v"(acc) : "v"(av), "v"(bv), "v"(sc_a), "v"(sc_one))
#define U_MFMA4(acc, av, bv) asm volatile("v_mfma_scale_f32_16x16x128_f8f6f4 %0, %1, %2, %0, %3, %4 op_sel_hi:[0,0,0] cbsz:4 blgp:4" : "+v"(acc) : "v"(av), "v"(bv), "v"(sc_a), "v"(sc_one))
template <int UVAR = 0>
__device__ __forceinline__ void peer_u_phase(const Ctx& F0, const Args& a, int layer) {
    const Ctx F = fresh(F0);
    const int s = (int)(blockIdx.x & 3), half = (int)((blockIdx.x >> 2) & 1), j = (int)(blockIdx.x >> 3), nmem = F.G >> 3;
    const unsigned char* U4s = a.ws + WS_TAB + (size_t)layer * TAB_LAYER + (size_t)s * NEXP * 128;
    const unsigned* XQ = (const unsigned*)(a.ws + WS_X8 + (size_t)s * ML * 256);
    const unsigned short* IDX = (const unsigned short*)(a.ws + WS_IDX);
    unsigned* PART = (unsigned*)(a.ws + WS_PART) + (size_t)s * ML * 64;
    const int lane = F.lane, rsub = lane >> 3, c8 = lane & 7, n16 = lane & 15, g4 = lane >> 4;
    LAS unsigned char* tile = F.lds + F.wave * 16384;
    constexpr float osc = 1.0f / (U_SCALE * XQ_SCALE);
    constexpr int MLH = ML / 2;
    const int t0 = half * MLH + j * NWAVES + F.wave, stride = nmem * NWAVES, ntok = (half * MLH + MLH - t0 + stride - 1) / stride;
    unsigned sc_one = 0x7f7f7f7fu; asm volatile("" : "+v"(sc_one));
    unsigned sc_a = (n16 & 1) ? 0x7d7d7d7du : 0x7f7f7f7fu; asm volatile("" : "+v"(sc_a));
    const int abase = (32 * (n16 & 1) + 4 * g4) * 4;
#define U_TOK(i) ((size_t)(t0 + ((i) < ntok ? (i) : ntok - 1) * stride))
    const unsigned wx0 = (unsigned)(size_t)(tile + rsub * 2048 + (c8 << 4));
    const unsigned rb0 = (unsigned)(size_t)(tile + n16 * 128 + ((g4 ^ ((n16 >> 1) & 7)) << 4));
    LAS unsigned char* stg = tile + g4 * 512 + n16 * 4;
#define U_LDXQ(i) (XQ[U_TOK(i) * 64 + lane])
#define U_LDI(i) (((const unsigned*)IDX)[U_TOK(i) * 64 + lane])
#define U_IDP(dst, ci) do { _Pragma("unroll") for (int k = 0; k < 8; ++k) dst[k] = (unsigned)__builtin_amdgcn_ds_bpermute((8 * rsub + k) * 4, (int)(ci)); } while (0)
#define U_EIDP(idp, i_) (((i_) & 1) ? (idp[(i_) >> 1] >> 16) : (idp[(i_) >> 1] & 0xffffu))
#define U_READS(nb0) do { \
        _Pragma("unroll") for (int nb = 0; nb < 4; ++nb) { _Pragma("unroll") for (int ks = 0; ks < 2; ++ks) \
            bw[nb][ks] = *(const LAS u32x4*)((LAS unsigned char*)(size_t)(rb0 ^ (64u * ks)) + 2048 * ((nb0) + nb)); } \
        __builtin_amdgcn_sched_barrier(0); \
    } while (0)
#define U_MFMAS() do { \
        _Pragma("unroll") for (int nb = 0; nb < 4; ++nb) U_MFMA4_FIRST(dA[nb], aop[0], bw[nb][0]); \
        _Pragma("unroll") for (int nb = 0; nb < 4; ++nb) U_MFMA4(dA[nb], aop[1], bw[nb][1]); \
        __builtin_amdgcn_sched_barrier(0); \
    } while (0)
#define U_OUTS(nb0) do { \
        asm volatile("s_nop 15\n\ts_nop 3" : "+v"(dA[0]), "+v"(dA[1]), "+v"(dA[2]), "+v"(dA[3]) :: "memory");     \
        _Pragma("unroll") for (int nb = 0; nb < 4; ++nb) { ov[(nb0) + nb] = dA[nb][0] + dA[nb][1]; asm volatile("" : "+v"(ov[(nb0) + nb])); } \
    } while (0)
#define U_BODY(j, CUR, NXT, LD) do { \
        unsigned idp[8]; \
        U_IDP(idp, ci##NXT);                                             \
          \
        _Pragma("unroll") for (int i_ = 0; i_ < 16; ++i_) { \
            *(LAS u32x4*)((LAS unsigned char*)(size_t)(wx0 ^ (unsigned)(((i_) >> 1) << 4)) + i_ * 128) = R[i_]; \
            if (UVAR == 0 || (UVAR == 1 && i_ < 8)) R[i_] = *(const u32x4*)(U4s + (unsigned)(U_EIDP(idp, i_) * 128 + 16 * c8)); \
        } \
          \
        u32x4 aop[2]; \
        _Pragma("unroll") for (int ks = 0; ks < 2; ++ks) { _Pragma("unroll") for (int k = 0; k < 4; ++k) { \
            const unsigned w_ = (unsigned)__builtin_amdgcn_ds_bpermute(abase + (16 * ks + k) * 4, (int)cx##CUR); \
            aop[ks][k] = (n16 < 2) ? w_ : 0u; } } \
        asm volatile("s_waitcnt lgkmcnt(0)" ::: "memory");               \
        f32x4 dA[4]; u32x4 bw[4][2]; float ov[8]; \
        U_READS(0); \
        U_MFMAS(); \
          \
        ci##CUR = U_LDI((j) + 3); cx##LD = U_LDXQ((j) + 2); \
        __builtin_amdgcn_sched_barrier(0); \
        U_READS(4);                                                      \
        U_OUTS(0); \
        U_MFMAS(); \
        U_OUTS(4); \
          \
        _Pragma("unroll") for (int nb = 0; nb < 8; ++nb) *(LAS float*)(stg + nb * 64) = ov[nb]; \
        asm volatile("s_waitcnt lgkmcnt(0)" ::: "memory"); \
        const f32x2 sum = *(const LAS f32x2*)(tile + 8 * lane); \
        asm volatile("s_waitcnt lgkmcnt(0)" ::: "memory"); \
        if ((j) < ntok) PART[U_TOK(j) * 64 + lane] = cvtpk(sum.x * osc, sum.y * osc); \
    } while (0)
    u32x4 R[16];
    unsigned cxA, cxB, cxC, ciA, ciB, ciC;
    ciA = U_LDI(0);
    cxA = U_LDXQ(0); cxB = U_LDXQ(1);
    { unsigned idp0[8]; U_IDP(idp0, ciA);
#pragma unroll
      for (int i_ = 0; i_ < 16; ++i_) R[i_] = *(const u32x4*)(U4s + (unsigned)(U_EIDP(idp0, i_) * 128 + 16 * c8)); }
    ciB = U_LDI(1); ciC = U_LDI(2);
    cxC = 0u;
    asm volatile("" :: "v"(ciC));
    for (int i = 0; i < ntok; i += 3) {
        U_BODY(i, A, B, C);
        U_BODY(i + 1, B, C, A);
        U_BODY(i + 2, C, A, B);
    }
#undef U_BODY
#undef U_READS
#undef U_MFMAS
#undef U_OUTS
#undef U_LDXQ
#undef U_LDI
#undef U_IDP
#undef U_EIDP
#undef U_TOK
}
#undef U_MFMA4_FIRST
#undef U_MFMA4
__device__ __forceinline__ void peer_w_phase(const Ctx& F0, const Args& a) {
    const Ctx F = fresh(F0);
    const unsigned* PART = (const unsigned*)(a.ws + WS_PART);
    const float* GATE = (const float*)(a.ws + WS_GATE);
    unsigned char* WQ = a.ws + WS_WT;
    float* WSC = (float*)(a.ws + WS_WSC);
    const int gwv = F.vcu * NWAVES + F.wave, NGW = F.G * NWAVES;
    unsigned pn[4]; f32x2 gn;
#define W_LD(t_) do { const int tt_ = (t_) < ML ? (t_) : ML - 1; _Pragma("unroll") for (int s = 0; s < 4; ++s) pn[s] = PART[((size_t)s * ML + tt_) * 64 + F.lane]; gn = *(const f32x2*)(GATE + (size_t)tt_ * 128 + 2 * F.lane); } while (0)
    W_LD(gwv);
    for (int t = gwv; t < ML; t += NGW) {
        f32x2 z = (f32x2){0.f, 0.f};
#pragma unroll
        for (int s = 0; s < 4; ++s) z += (f32x2){bflo(pn[s]), bfhi(pn[s])};
        const f32x2 g = gn;
        W_LD(t + NGW);
        f32x2 w; w.x = g.x * gelu_erf(z.x); w.y = g.y * gelu_erf(z.y);
        float wm = fmaxf(__builtin_fabsf(w.x), __builtin_fabsf(w.y));
#pragma unroll
        for (int o = 1; o < 64; o <<= 1) wm = fmaxf(wm, __shfl_xor(wm, o));
        wm = fmaxf(wm, 1e-20f);
        const float qs = 6.0f / wm, ax = fminf(fmaxf(w.x * qs, -6.f), 6.f), ay = fminf(fmaxf(w.y * qs, -6.f), 6.f);
        const unsigned ph = __builtin_amdgcn_cvt_scalef32_pk_fp4_f32(0u, ax, ay, 1.0f, 0) & 0xffu;
        const f32x2 dh = FP4_DEC(ph, 0);
        const unsigned pl = __builtin_amdgcn_cvt_scalef32_pk_fp4_f32(0u, fminf(fmaxf(4.f * (ax - dh.x), -6.f), 6.f), fminf(fmaxf(4.f * (ay - dh.y), -6.f), 6.f), 1.0f, 0) & 0xffu;
        ((unsigned short*)WQ)[(size_t)t * 128 + F.lane] = (unsigned short)((ph & 0xfu) | ((ph & 0xf0u) << 4));
        ((unsigned short*)WQ)[(size_t)t * 128 + 64 + F.lane] = (unsigned short)((pl & 0xfu) | ((pl & 0xf0u) << 4));
        if (F.lane == 0) WSC[t] = wm * (1.0f / 6.0f);
    }
#undef W_LD
}
#define V_MFMA4_FIRST(acc, av, bv, sa) asm volatile("v_mfma_scale_f32_16x16x128_f8f6f4 %0, %1, %2, 0, %3, %4 op_sel_hi:[0,0,0] cbsz:4 blgp:4" : "=&v"(acc) : "v"(av), "v"(bv), "v"(sa), "v"(sc_one))
#define V_MFMA4(acc, av, bv, sa) asm volatile("v_mfma_scale_f32_16x16x128_f8f6f4 %0, %1, %2, %0, %3, %4 op_sel_hi:[0,0,0] cbsz:4 blgp:4" : "+v"(acc) : "v"(av), "v"(bv), "v"(sa), "v"(sc_one))
template <int VAR = 0>
__device__ __forceinline__ void peer_v_phase(const Ctx& F0, const Args& a, int layer, float oscale = 1.0f) {
    const Ctx F = fresh(F0);
    const int s = (int)(blockIdx.x & 3), half = (int)((blockIdx.x >> 2) & 1), j = (int)(blockIdx.x >> 3), nmem = F.G >> 3;
    const unsigned char* V4s = a.ws + WS_TAB + (size_t)layer * TAB_LAYER + TAB_VOFF + (size_t)s * NEXP * 128;
    const unsigned short* IDX = (const unsigned short*)(a.ws + WS_IDX);
    const unsigned char* WQ = a.ws + WS_WT;
    const float* WSC = (const float*)(a.ws + WS_WSC);
    const float* modb = (const float*)(a.ws + WS_MOD) + (size_t)layer * 9 * NMOD;
    bf16_t* X = (bf16_t*)(a.ws + WS_XB);
    const int lane = F.lane, rsub = lane >> 3, c8 = lane & 7, n16 = lane & 15, g4 = lane >> 4;
    LAS unsigned char* tile = F.lds + F.wave * 16384;
    const float osc = ((DBG_SKIP & (layer == 0 ? 2 : 8)) ? 0.f : oscale) * (1.0f / V_SCALE);
    constexpr int MLH = ML / 2;
    const int t0 = half * MLH + j * NWAVES + F.wave, stride = nmem * NWAVES, ntok = (half * MLH + MLH - t0 + stride - 1) / stride;
    unsigned sc_one = 0x7f7f7f7fu; asm volatile("" : "+v"(sc_one));
    typedef int v2i_t __attribute__((ext_vector_type(2)));
    LAS float* gl = (LAS float*)(F.lds + RING_BYTES + 4096);
    for (int u = F.tid; u < 4 * 256; u += NWAVES * 64) gl[u] = modb[(size_t)(4 * half + (u >> 8)) * NMOD + 5 * DM + 256 * s + (u & 255)] * osc;
    __syncthreads();
#define V_TOK(i) ((size_t)(t0 + ((i) < ntok ? (i) : ntok - 1) * stride))
    LAS unsigned char* wx[4]; LAS unsigned char* rb[4];
#pragma unroll
    for (int k = 0; k < 4; ++k) wx[k] = tile + rsub * 2048 + ((c8 ^ k ^ ((rsub & 1) << 2)) << 4);
#pragma unroll
    for (int nb = 0; nb < 4; ++nb) rb[nb] = tile + g4 * 2048 + (n16 >> 1) * 128 + 8 * (n16 & 1) + ((nb ^ ((n16 >> 2) & 3) ^ ((g4 & 1) << 2)) << 4);
    LAS unsigned char* stg = tile + g4 * 1024 + n16 * 8;
#define V_LDW(i) (((const unsigned*)WQ)[V_TOK(i) * 64 + lane])
#define V_LDI(i) (((const unsigned*)IDX)[V_TOK(i) * 64 + lane])
#define V_LDX(i) (*(const u32x2*)(X + V_TOK(i) * DM + 256 * s + 4 * lane))
#define V_LDS(i) (WSC[V_TOK(i)])
#define V_IDP(dst, ci) do { _Pragma("unroll") for (int k = 0; k < 8; ++k) dst[k] = (unsigned)__builtin_amdgcn_ds_bpermute((8 * rsub + k) * 4, (int)(ci)); } while (0)
#define V_EIDP(idp, i_) (((i_) & 1) ? (idp[(i_) >> 1] >> 16) : (idp[(i_) >> 1] & 0xffffu))
#define V_READS(nb0) do { \
        unsigned x64 = (nb0) ? 64u : 0u; asm volatile("" : "+v"(x64));                   \
        _Pragma("unroll") for (int nb = 0; nb < 4; ++nb) { LAS unsigned char* rbn = (LAS unsigned char*)((unsigned)(size_t)rb[nb] ^ x64); \
          _Pragma("unroll") for (int h = 0; h < 2; ++h) { _Pragma("unroll") for (int q = 0; q < 2; ++q) { \
            const v2i_t tr = __builtin_amdgcn_ds_read_tr8_b64_v2i32((LAS v2i_t*)(rbn + 8192 * h + 1024 * q)); \
            bw[nb][h][2 * q] = (unsigned)tr[0]; bw[nb][h][2 * q + 1] = (unsigned)tr[1]; } } } \
        __builtin_amdgcn_sched_barrier(0); \
    } while (0)
#define V_MFMAS() do { \
        _Pragma("unroll") for (int nb = 0; nb < 4; ++nb) V_MFMA4_FIRST(dA[nb], aop[0], bw[nb][0], sc_a); \
        _Pragma("unroll") for (int nb = 0; nb < 4; ++nb) V_MFMA4(dA[nb], aop[1], bw[nb][1], sc_a); \
        __builtin_amdgcn_sched_barrier(0); \
    } while (0)
#define V_OUTS(nb0) do { \
        asm volatile("s_nop 15\n\ts_nop 3" : "+v"(dA[0]), "+v"(dA[1]), "+v"(dA[2]), "+v"(dA[3]) :: "memory");     \
        _Pragma("unroll") for (int nb = 0; nb < 4; ++nb) { ov[(nb0) + nb] = (f32x2){dA[nb][0] + dA[nb][2], dA[nb][1] + dA[nb][3]}; asm volatile("" : "+v"(ov[(nb0) + nb])); } \
    } while (0)
#define V_BODY(j, CUR, NXT, LD) do { \
        const size_t t_ = V_TOK(j); \
        unsigned idp[8]; \
        V_IDP(idp, ci##NXT);                                             \
          \
        _Pragma("unroll") for (int i_ = 0; i_ < 16; ++i_) { \
            *(LAS u32x4*)(wx[(i_ >> 1) & 3] + i_ * 128) = R[i_]; \
            if (VAR == 0 || (VAR == 1 && i_ < 8)) R[i_] = *(const u32x4*)(V4s + (unsigned)(V_EIDP(idp, i_) * 128 + 16 * c8)); \
        } \
          \
        u32x4 aop[2]; \
        _Pragma("unroll") for (int h = 0; h < 2; ++h) { _Pragma("unroll") for (int k = 0; k < 4; ++k) { \
            const unsigned w_ = (unsigned)__builtin_amdgcn_ds_bpermute(abase + (16 * h + k) * 4, (int)cw##CUR); \
            aop[h][k] = (n16 < 4) ? (w_ << ash) : 0u; } } \
        asm volatile("s_waitcnt lgkmcnt(0)" ::: "memory");               \
        f32x4 dA[4]; u32x4 bw[4][2]; f32x2 ov[8]; \
        V_READS(0); \
        V_MFMAS(); \
          \
        ci##CUR = V_LDI((j) + 3); cw##LD = V_LDW((j) + 2); xo##LD = V_LDX((j) + 2); ws##LD = V_LDS((j) + 2); \
        __builtin_amdgcn_sched_barrier(0); \
        V_READS(4);                                                      \
        V_OUTS(0); \
        V_MFMAS(); \
        V_OUTS(4); \
          \
        _Pragma("unroll") for (int nb = 0; nb < 8; ++nb) *(LAS f32x2*)(stg + nb * 128) = ov[nb]; \
        asm volatile("s_waitcnt lgkmcnt(0)" ::: "memory"); \
        const f32x4 sum = *(const LAS f32x4*)(tile + 16 * lane); \
        const f32x4 gt_ = *(const LAS f32x4*)(gl + ((t_ >> 12) & 3) * 256 + 4 * lane); \
        asm volatile("s_waitcnt lgkmcnt(0)" ::: "memory"); \
        if ((j) < ntok) { const f32x4 r_ = bf4_f32(xo##CUR) + gt_ * ws##CUR * sum; *(u32x2*)(X + t_ * DM + 256 * s + 4 * lane) = (u32x2){cvtpk(r_.x, r_.y), cvtpk(r_.z, r_.w)}; } \
    } while (0)
    u32x4 R[16];
    unsigned cwA, cwB, cwC, ciA, ciB, ciC;
    u32x2 xoA, xoB, xoC;
    float wsA, wsB, wsC;
    const int abase = (32 * ((n16 >> 1) & 1) + 4 * g4) * 4, ash = 4 * (n16 & 1);
    unsigned sc_a = (n16 & 2) ? 0x7d7d7d7du : 0x7f7f7f7fu; asm volatile("" : "+v"(sc_a));
    ciA = V_LDI(0);
    cwA = V_LDW(0); cwB = V_LDW(1); xoA = V_LDX(0); xoB = V_LDX(1); wsA = V_LDS(0); wsB = V_LDS(1);
    { unsigned idp0[8]; V_IDP(idp0, ciA);
#pragma unroll
      for (int i_ = 0; i_ < 16; ++i_) R[i_] = *(const u32x4*)(V4s + (unsigned)(V_EIDP(idp0, i_) * 128 + 16 * c8)); }
    ciB = V_LDI(1); ciC = V_LDI(2);
    cwC = 0u; xoC = (u32x2){0u, 0u}; wsC = 0.f;
    asm volatile("" :: "v"(ciC));
    for (int i = 0; i < ntok; i += 3) {
        V_BODY(i, A, B, C);
        V_BODY(i + 1, B, C, A);
        V_BODY(i + 2, C, A, B);
    }
#undef V_BODY
#undef V_READS
#undef V_MFMAS
#undef V_OUTS
#undef V_LDW
#undef V_LDI
#undef V_LDX
#undef V_LDS
#undef V_IDP
#undef V_EIDP
#undef V_TOK
}
#undef V_MFMA4_FIRST
#undef V_MFMA4

__device__ __forceinline__ void dft_nyquist_rows(const Ctx& F0, const Args& a) {
    const Ctx F = fresh(F0);
    const unsigned char* Yt = a.ws + WS_QK;
    const float* YN = (const float*)(a.ws + WS_YN);
    unsigned char* Fo = a.ws + WS_VT;
    const int gwv = F.vcu * NWAVES + F.wave, NGW = F.G * NWAVES;
    for (int o = gwv; o < NB * DM; o += NGW) {
        const unsigned char* src = Yt + (size_t)o * 4096;
        float s = 0.f;
#pragma unroll
        for (int it = 0; it < 2; ++it) { const u32x4 v = *(const u32x4*)(src + it * 1024 + F.lane * 16);
#pragma unroll
            for (int d = 0; d < 4; ++d) { const f32x2 lo = __builtin_amdgcn_cvt_pk_f32_fp8((int)v[d], false), hi = __builtin_amdgcn_cvt_pk_f32_fp8((int)v[d], true); s += (lo[0] - lo[1]) + (hi[0] - hi[1]); } }
        s = wave_sum(s) * (pg8::ACT8_SCALE / (64.0f * pg8::YT_SCALE)) + YN[o] * (pg8::ACT8_SCALE / 64.0f);
        if (F.lane == 0) Fo[((size_t)(o >> 10) * SEQ + 2048) * DM + (o & 1023)] = (unsigned char)(fp8_pack4(s, 0.f, 0.f, 0.f) & 0xffu);
    }
}
__device__ __forceinline__ void dft_yn_rows(const Ctx& F0, const Args& a) {
    const Ctx F = fresh(F0);
    const float* yi = (const float*)(a.ws + WS_YNI);
    const bf16_t* wc = (const bf16_t*)(a.ws + WS_WC);
    float* YN = (float*)(a.ws + WS_YN);
    const int gwv = F.vcu * NWAVES + F.wave, NGW = F.G * NWAVES;
    for (int o = gwv; o < NB * DM; o += NGW) {
        const int cp = o & 255;
        const f32x4 x = *(const f32x4*)(yi + (size_t)(o & ~255) + 4 * F.lane);
        const u32x2 w = *(const u32x2*)(wc + (size_t)cp * 256 + 4 * F.lane);
        const f32x4 wf = bf4_f32(w);
        const float s = wave_sum(x.x * wf.x + x.y * wf.y + x.z * wf.z + x.w * wf.w);
        if (F.lane == 0) YN[o] = s;
    }
}

__global__ void __launch_bounds__(NWAVES * 64, 2) fwd_kernel(Args args) {
    extern __shared__ __attribute__((aligned(16))) unsigned char lds_raw[];
    Ctx F;
    F.lds = (LAS unsigned char*)lds_raw;
    F.tid = threadIdx.x; F.lane = F.tid & 63; F.wave = __builtin_amdgcn_readfirstlane(F.tid >> 6);
    F.G = gridDim.x; { const int bx = blockIdx.x; F.vcu = (F.G % 8 == 0) ? (bx % 8) * (F.G / 8) + bx / 8 : bx; }
    volatile LAS unsigned* MISC = (volatile LAS unsigned*)(F.lds + MISC_OFF);
    for (int u = F.tid; u < (LDS_BYTES - LDSCTL_OFF) / 4; u += NWAVES * 64) ((LAS unsigned*)(F.lds + LDSCTL_OFF))[u] = 0u;
    __syncthreads();
    unsigned char* ws = args.ws;
    XcdBarrier bar = xcd_barrier_post((unsigned*)(ws + WS_CTL) + CW_BAR, MISC + 8);
#define GRID_BAR() xcd_barrier(bar)
#ifndef DBG_REP
#define DBG_REP 0
#endif
#ifndef DBG_VVAR
#define DBG_VVAR 0
#endif
#define REP(k, ...) do { __VA_ARGS__; if (DBG_REP == (k)) { GRID_BAR(); __VA_ARGS__; } } while (0)
#define PEER_BLOCK(layer) do { \
        norm_phase(F, args, 1, layer, 3 * DM, args.in[5] + (layer) * DM); \
        GRID_BAR(); \
        { using SHq = pg8::Shape<ML, 2048, DM / 2, DM / 2, DM / 2, 1, 0, 0>;       \
          REP(7, pg8::gemm_phase<SHq, pg8::EpiStoreBf16, true>(F.lds, pg8::Gemm{HX, (const bf16_t*)(ws + WS_WPQ) + (size_t)(layer) * 2048 * DM / 2}, F.G, bx, pg8::EpiStoreBf16{QKb, 2048, 0, 0, 1.0f, 1.0f / (pg8::ACT8_SCALE * pg8::W8_SCALE)})); } \
        GRID_BAR(); \
        REP(8, peer_topk_phase(F, args, layer)); \
        GRID_BAR(); \
        REP(9, peer_u_phase(F, args, layer)); \
        GRID_BAR(); \
        REP(10, peer_w_phase(F, args)); \
        GRID_BAR(); \
        peer_v_phase(F, args, layer); if (DBG_REP == 11) { GRID_BAR(); peer_v_phase<DBG_VVAR>(F, args, layer, 0.f); } \
        GRID_BAR(); \
    } while (0)
    const float* modb = (const float*)(ws + WS_MOD);
    bf16_t* HX = (bf16_t*)(ws + WS_HX);
    bf16_t* QKb = (bf16_t*)(ws + WS_QK);
    bf16_t* VTb = (bf16_t*)(ws + WS_VT);
    const bf16_t* Wqkv = (const bf16_t*)(ws + WS_WQKV);
    const int bx = (int)blockIdx.x;

    REP(1, p0_prologue(F, args));
    GRID_BAR();
    REP(2, norm_phase(F, args, 0, 0, 0, args.in[4]));
    GRID_BAR();
    {
        constexpr float o8 = 1.0f / (pg8::ACT8_SCALE * pg8::W8_SCALE);
        using SH1 = pg8::Shape<MT, 2048, DM / 2, DM / 2, DM / 2, 1, 0, 0>;
        pg8::gemm_phase<SH1, pg8::EpiStoreBf16, true>(F.lds, pg8::Gemm{HX, Wqkv}, F.G, bx, pg8::EpiStoreBf16{QKb, 2048, 0, 1024, 0.125f * LOG2E, o8});
        using SH2 = pg8::Shape<DM, MT, DM / 2, DM / 2, DM / 2, 1, 0, 0>;
        const int bxv = F.G - 1 - bx;
        pg8::gemm_phase<SH2, pg8::EpiStoreBf16, true>(F.lds, pg8::Gemm{Wqkv + (size_t)2048 * DM / 2, HX}, F.G, bxv, pg8::EpiStoreBf16{VTb, MT, 0, 0, 1.0f, o8});
        {
            const int nq = (MT / 256) * 8, nv = 4 * (MT / 256), rq = nq % F.G, rv = nv % F.G;
            const int sh_q = (rq == 0 || bx >= rq) ? 1 : 0, sh_v = (rv == 0 || bxv >= rv) ? 1 : 0;
            const int nq_sh = (rq == 0 ? F.G : F.G - rq);
            const int before_q = (rq == 0 ? bx : max(0, bx - rq)), before_v = nq_sh + ((rv == 0) ? bx : min(bx, F.G - rv));
            const int total = (rq == 0 ? F.G : F.G - rq) + (rv == 0 ? F.G : F.G - rv);
            if (sh_q) table_convert(F, args, before_q, 1, total);
            if (sh_v) table_convert(F, args, before_v, 1, total);
        }
    }
    GRID_BAR();
    REP(4, attn_phase(F, args));
    GRID_BAR();
    {
        using SH = pg8::Shape<ML, DM, DM / 2, DM / 2, DM / 2, 1, 0, 0>;
        pg8::gemm_phase<SH, pg8::EpiResid<false>, true>(F.lds, pg8::Gemm{(const bf16_t*)(ws + WS_HX + 36 * MiB), (const bf16_t*)(ws + WS_WO)}, F.G, bx, pg8::EpiResid<false>{args.in[0], (bf16_t*)(ws + WS_XB), modb + 2 * DM, NMOD, ((DBG_SKIP & 1) ? 0.f : 1.f) / (pg8::ACT8_SCALE * pg8::W8_SCALE)});
    }
    GRID_BAR();
    PEER_BLOCK(0);
    norm_fold_phase(F, args, 1, args.in[4] + DM);
    GRID_BAR();
    {
        using SH = pg8::Shape<256, ML / 2, 256, 256, DM, 4, 0, 256>;
        pg8::gemm_phase<SH>(F.lds, pg8::Gemm{(const bf16_t*)(ws + WS_WC), HX}, F.G, bx, pg8::EpiYt{(unsigned char*)QKb, 0});
        pg8::gemm_phase<SH>(F.lds, pg8::Gemm{(const bf16_t*)(ws + WS_WC) + 256 * 256, (const bf16_t*)(ws + WS_HX + 32 * MiB)}, F.G, bx, pg8::EpiYt{(unsigned char*)QKb, 1});
        dft_yn_rows(F, args);
    }
    GRID_BAR();
    {
        using SH = pg8::Shape<SEQ / 2, DM, 2048, 2048, 2048, NB, 0, (long)DM * 2048>;
        REP(14, pg8::gemm_phase<SH, pg8::EpiDft2, true>(F.lds, pg8::Gemm{(const bf16_t*)(ws + WS_CS), QKb}, F.G, bx, pg8::EpiDft2{(unsigned char*)VTb, (const float*)(ws + WS_YN)}));
        dft_nyquist_rows(F, args);
    }
    GRID_BAR();
    {
        using SH = pg8::Shape<ML, DM, DM / 2, DM / 2, DM / 2, 1, 0, 0>;
        pg8::gemm_phase<SH, pg8::EpiResid<true>, true>(F.lds, pg8::Gemm{VTb, (const bf16_t*)(ws + WS_WF)}, F.G, bx, pg8::EpiResid<true>{ws + WS_XB, (bf16_t*)(ws + WS_XB), modb + (size_t)9 * NMOD + 2 * DM, NMOD, ((DBG_SKIP & 4) ? 0.f : 1.f) / (pg8::ACT8_SCALE * pg8::W8_SCALE)});
    }
    GRID_BAR();
    PEER_BLOCK(1);
    if (DBG_REP == 20) { for (int r = 0; r < 16; ++r) GRID_BAR(); }
    final_norm_phase(F, args);
#undef PEER_BLOCK
}

extern "C" void kernel_launch(void* const* d_in, const int* in_sizes, int n_in, void* d_out, int out_size, void* d_ws, size_t ws_size, hipStream_t stream) {
    static int grid = 0;
    if (grid == 0) {
        if (n_in != 17 || in_sizes[0] != ML * DM || out_size != ML * DM || ws_size < WS_END) { fprintf(stderr, "kernel_launch: unexpected shapes (n_in %d, in0 %d, out %d, ws %zu)\n", n_in, n_in > 0 ? in_sizes[0] : -1, out_size, ws_size); grid = -1; return; }
        int dev = 0, cus = 0, per_cu = 0;
        if (hipGetDevice(&dev) != hipSuccess || hipDeviceGetAttribute(&cus, hipDeviceAttributeMultiprocessorCount, dev) != hipSuccess) { grid = -1; return; }
        if (hipFuncSetAttribute((const void*)fwd_kernel, hipFuncAttributeMaxDynamicSharedMemorySize, LDS_BYTES) != hipSuccess) { fprintf(stderr, "kernel_launch: hipFuncSetAttribute failed\n"); grid = -1; return; }
        if (hipOccupancyMaxActiveBlocksPerMultiprocessor(&per_cu, (const void*)fwd_kernel, NWAVES * 64, LDS_BYTES) != hipSuccess || per_cu < 1)
            fprintf(stderr, "kernel_launch: note: occupancy query reports %d workgroups per CU\n", per_cu);
        (void)hipGetLastError();
        grid = cus;
        if (grid % 8 != 0) { fprintf(stderr, "kernel_launch: CU count %d is not a multiple of 8\n", cus); grid = -1; return; }
    }
    if (grid < 0) return;
    if (hipMemsetAsync((char*)d_ws + WS_CTL, 0, CTL_ZERO_BYTES, stream) != hipSuccess) { fprintf(stderr, "kernel_launch: memset failed\n"); return; }
    Args a{};
    for (int i = 0; i < 17; ++i) a.in[i] = (const float*)d_in[i];
    a.out = (float*)d_out; a.ws = (unsigned char*)d_ws;
    hipLaunchKernelGGL(fwd_kernel, dim3(grid), dim3(NWAVES * 64), LDS_BYTES, stream, a);
    const hipError_t le = hipPeekAtLastError();
    if (le != hipSuccess) fprintf(stderr, "kernel_launch: launch failed: %s\n", hipGetErrorName(le));
}
```

```cpp
#include <hip/hip_runtime.h>
#include <cstdio>
#include <cstdint>

#define LAS __attribute__((address_space(3)))
typedef unsigned short bf16_t;
typedef short bf16x8 __attribute__((ext_vector_type(8)));
typedef short s16x4 __attribute__((ext_vector_type(4)));
typedef float f32x2 __attribute__((ext_vector_type(2)));
typedef float f32x4 __attribute__((ext_vector_type(4)));
typedef float f32x16 __attribute__((ext_vector_type(16)));
typedef unsigned u32x2 __attribute__((ext_vector_type(2)));
typedef unsigned u32x4 __attribute__((ext_vector_type(4)));
typedef __bf16 bf16x2_t __attribute__((ext_vector_type(2)));

#ifndef DBG_SKIP
#define DBG_SKIP 0
#endif
constexpr int DM = 1024, NB = 8, SEQ = 4096, CTXL = 256, GW = 64;
constexpr int ML = NB * SEQ;
constexpr int MC = NB * CTXL;
constexpr int MT = ML + MC;
constexpr int NMOD = 6 * DM;
constexpr int NEXP = 16384;
constexpr float EPS = 1e-6f;
constexpr float LOG2E = 1.4426950408889634f;

constexpr size_t MiB = 1u << 20;
constexpr size_t WS_CTL = 0, CTL_ZERO_BYTES = 1 * MiB;
constexpr size_t WS_MOD = 1 * MiB;
constexpr size_t WS_WQKV = 2 * MiB;
constexpr size_t WS_WO = 8 * MiB;
constexpr size_t WS_WF = 10 * MiB;
constexpr size_t WS_WPQ = 12 * MiB;
constexpr size_t WS_SK = 20 * MiB;
constexpr size_t WS_WC = 20 * MiB + 256 * 1024;
constexpr size_t WS_CS = 22 * MiB;
constexpr size_t WS_TAB = 38 * MiB;
constexpr size_t WS_X8 = 150 * MiB;
constexpr size_t WS_WT = 182 * MiB;
constexpr size_t WS_PART = 282 * MiB;
constexpr float U_SCALE = 64.f;
constexpr float XQ_SCALE = 0.75f;
constexpr float V_SCALE = 2.f;
constexpr size_t WS_XB = 70 * MiB;
constexpr size_t TAB_LAYER = 16 * MiB, TAB_VOFF = 8 * MiB;
constexpr size_t WS_WSC = 198 * MiB;
constexpr size_t WS_YNI = 199 * MiB;
constexpr size_t WS_YN = WS_YNI + 64 * 1024;
constexpr size_t WS_HX = 214 * MiB;
constexpr size_t WS_QK = 282 * MiB;
constexpr size_t WS_VT = 418 * MiB;
constexpr size_t WS_IDX = WS_VT;
constexpr size_t WS_GATE = WS_VT + 8 * MiB;
constexpr size_t WS_END = 486 * MiB;
constexpr int CW_BAR = 4096;

__device__ __forceinline__ unsigned f2bf(float f) { unsigned u = __builtin_bit_cast(unsigned, f); return (u + 0x7fffu + ((u >> 16) & 1u)) >> 16; }
__device__ __forceinline__ unsigned pk2(float lo, float hi) { return f2bf(lo) | (f2bf(hi) << 16); }
__device__ __forceinline__ f32x4 bf4_f32(u32x2 w) { return (f32x4){__builtin_bit_cast(float, w.x << 16), __builtin_bit_cast(float, w.x & 0xffff0000u), __builtin_bit_cast(float, w.y << 16), __builtin_bit_cast(float, w.y & 0xffff0000u)}; }
__device__ __forceinline__ unsigned cvtpk(float lo, float hi) { f32x2 v = {lo, hi}; bf16x2_t b = __builtin_convertvector(v, bf16x2_t); return __builtin_bit_cast(unsigned, b); }
__device__ __forceinline__ float bflo(unsigned u) { return __builtin_bit_cast(float, u << 16); }
__device__ __forceinline__ float bfhi(unsigned u) { return __builtin_bit_cast(float, u & 0xffff0000u); }
__device__ __forceinline__ float wave_sum(float v) {
#pragma unroll
    for (int o = 1; o < 64; o <<= 1) v += __shfl_xor(v, o);
    return v;
}
__device__ __forceinline__ unsigned fp8_pack4(float a, float b, float c, float d) {
    int w = 0;
    w = __builtin_amdgcn_cvt_pk_fp8_f32(__builtin_amdgcn_fmed3f(a, -448.f, 448.f), __builtin_amdgcn_fmed3f(b, -448.f, 448.f), w, false);
    w = __builtin_amdgcn_cvt_pk_fp8_f32(__builtin_amdgcn_fmed3f(c, -448.f, 448.f), __builtin_amdgcn_fmed3f(d, -448.f, 448.f), w, true);
    return (unsigned)w;
}
__device__ __forceinline__ int crow(int r, int hi) { return (r & 3) + 8 * (r >> 2) + 4 * hi; }
__device__ __forceinline__ float gelu_erf(float v) {
    const float av = __builtin_fabsf(v), d = av * 0.2316418882f + 1.0f;
    const float t = __builtin_amdgcn_rcpf(d);
    float q = t * 0.5307027145f + (-0.7265760135f); q = q * t + 0.7107068705f; q = q * t + (-0.142248368f); q = q * t + 0.127414796f; q = q * t;
    const float e = __builtin_amdgcn_exp2f((v * v) * (-0.72134752044f));
    const float m = v * (q * e), r = v - m;
    return v < 0.f ? m : r;
}

namespace pg8 {
constexpr float ACT8_SCALE = 16.f, W8_SCALE = 256.f;
constexpr float YT_SCALE = 16.f, CS_SCALE = 512.f;
constexpr int BM = 256, BK = 64, HALF = 128, HTB = HALF * BK * 2, STAGE_BYTES = 8 * HTB, NXCD = 8, WGM = 8;
__host__ __device__ __forceinline__ int lds_byte(int r, int c) { const int st = (r >> 4) * 2 + (c >> 5), rr = r & 15, cc = c & 31, ob = rr * 64 + cc * 2; return st * 1024 + (ob ^ (((ob >> 9) & 1) << 5)); }
__host__ __device__ __forceinline__ void stage_rc(int b, int& R, int& C) { const int st = b / 1024, sb = b % 1024, swz = sb ^ (((sb >> 9) & 1) << 5); R = (st >> 1) * 16 + swz / 64; C = (st & 1) * 32 + (swz % 64) / 2; }
__host__ __device__ __forceinline__ int perm32(int rho) { const int n = rho >> 4, i = rho & 15; return 8 * (i >> 2) + 4 * n + (i & 3); }

struct Unit { int pm, pn, pb; };
struct Gemm { const bf16_t* A; const bf16_t* Bt; };
template <int M_, int N_, int K_, int LDA_, int LDB_, int NBATCH_, long BSA_, long BSB_> struct Shape { static constexpr int M = M_, N = N_, K = K_, lda = LDA_, ldb = LDB_, nbatch = NBATCH_; static constexpr long bsA = BSA_, bsB = BSB_; };

template <class SH> struct StaticOrder {
    static constexpr int nM = SH::M / BM, nN = SH::N / BM, per = nM * nN, nwg = per * SH::nbatch;
    int G, c;
    __device__ __forceinline__ void init(int G_, int c_) { G = G_; c = c_; }
    __device__ __forceinline__ bool next(int i, Unit& u) const {
        const long L = (long)i * G + c; if (L >= nwg) return false;
        int wgid = (int)L; { const int q = nwg / NXCD, r = nwg % NXCD, xcd = wgid % NXCD, off = wgid / NXCD; wgid = (xcd < r ? xcd * (q + 1) : r * (q + 1) + (xcd - r) * q) + off; }
        u.pb = wgid / per; wgid -= u.pb * per;
        const int nig = WGM * nN, gid = wgid / nig, fm = gid * WGM, gsz = (nM - fm) < WGM ? (nM - fm) : WGM;
        u.pm = fm + ((wgid % nig) % gsz); u.pn = (wgid % nig) / gsz; return true;
    }
};

struct EpiStoreBf16 {
    static constexpr bool PERM = true;
    bf16_t* O; long ldc; long bstride; int scols; float scale0; float oscale = 1.0f;
    __device__ __forceinline__ void operator()(const f32x4 (&acc)[2][2][4][2], const Unit& u, int wr, int wc, int fr, int fq) const {
        const int row0 = u.pm * BM + wr * 64 + fr, col0 = u.pn * BM + wc * 32 + 8 * fq;
        bf16_t* base = O + (long)u.pb * bstride;
        const float sc = ((u.pn * BM < scols) ? scale0 : 1.0f) * oscale;
#pragma unroll
        for (int ai = 0; ai < 2; ++ai)
#pragma unroll
            for (int m = 0; m < 4; ++m) { bf16_t* rowp = base + (long)(row0 + ai * HALF + m * 16) * ldc + col0;
#pragma unroll
                for (int bj = 0; bj < 2; ++bj) { const f32x4 v0 = acc[ai][bj][m][0] * sc, v1 = acc[ai][bj][m][1] * sc;
                    u32x4 w; w.x = cvtpk(v0[0], v0[1]); w.y = cvtpk(v0[2], v0[3]); w.z = cvtpk(v1[0], v1[1]); w.w = cvtpk(v1[2], v1[3]);
                    *(u32x4*)(rowp + bj * HALF) = w; } }
    }
};
struct EpiDft2 {
    static constexpr bool PERM = true;
    unsigned char* O; const float* yn;
    __device__ __forceinline__ void operator()(const f32x4 (&acc)[2][2][4][2], const Unit& u, int wr, int wc, int fr, int fq) const {
        const int row0 = u.pm * BM + wr * 64 + fr, cl0 = wc * 32 + 8 * fq;
        unsigned char* base = O + (long)u.pb * SEQ * DM + u.pn * BM;
        constexpr float osc = ACT8_SCALE / (YT_SCALE * CS_SCALE);
        f32x4 y0[2], y1[2];
#pragma unroll
        for (int bj = 0; bj < 2; ++bj) { const float* yp = yn + (long)u.pb * DM + u.pn * BM + cl0 + bj * HALF; y0[bj] = *(const f32x4*)yp * (ACT8_SCALE / 64.0f); y1[bj] = *(const f32x4*)(yp + 4) * (ACT8_SCALE / 64.0f); }
#pragma unroll
        for (int ai = 0; ai < 2; ++ai)
#pragma unroll
            for (int m = 0; m < 4; ++m) { const int np = row0 + ai * HALF + m * 16;
                unsigned char* rowp = base + (long)np * DM; unsigned char* mirp = base + (long)(SEQ - np) * DM;
#pragma unroll
                for (int bj = 0; bj < 2; ++bj) { const float sg = (np & 1) ? -1.0f : 1.0f; const f32x4 v0 = acc[ai][bj][m][0] * osc + y0[bj] * sg, v1 = acc[ai][bj][m][1] * osc + y1[bj] * sg; const int cl = cl0 + bj * HALF;
                    u32x2 w; w.x = fp8_pack4(v0[0], v0[1], v0[2], v0[3]); w.y = fp8_pack4(v1[0], v1[1], v1[2], v1[3]);
                    *(u32x2*)(rowp + cl) = w;
                    if (np != 0) {
#pragma unroll
                        for (int i = 0; i < 8; ++i) mirp[(256 - cl - i) & 255] = (unsigned char)((w[i >> 2] >> (8 * (i & 3))) & 0xffu); } }
                asm volatile("" ::: "memory"); }
    }
};
struct EpiYt {
    static constexpr bool PERM = true;
    unsigned char* Yt; int part;
    __device__ __forceinline__ void operator()(const f32x4 (&acc)[2][2][4][2], const Unit& u, int wr, int wc, int fr, int fq) const {
        const int row0 = u.pm * BM + wr * 64 + fr, col0 = u.pn * BM + wc * 32 + 8 * fq;
#pragma unroll
        for (int ai = 0; ai < 2; ++ai)
#pragma unroll
            for (int m = 0; m < 4; ++m) { const int cp = row0 + ai * HALF + m * 16;
#pragma unroll
                for (int bj = 0; bj < 2; ++bj) { const int col = col0 + bj * HALF; const int b = col >> 11, k = col & 2047;
                    const f32x4 v0 = acc[ai][bj][m][0] * YT_SCALE, v1 = acc[ai][bj][m][1] * YT_SCALE;
                    u32x2 w; w.x = fp8_pack4(v0[0], v0[1], v0[2], v0[3]); w.y = fp8_pack4(v1[0], v1[1], v1[2], v1[3]);
                    *(u32x2*)(Yt + (((long)(b * 4 + u.pb) * 256 + cp) << 12) + part * 2048 + k) = w; }
                asm volatile("" ::: "memory"); }
    }
};
template <bool IN_BF16>
struct EpiResid {
    static constexpr bool PERM = false;
    const void* Xin; bf16_t* Xout; const float* gate; int gstride; float gs;
    __device__ __forceinline__ void operator()(const f32x4 (&acc)[2][2][4][2], const Unit& u, int wr, int wc, int fr, int fq) const {
        const int row0 = u.pm * BM + wr * 64 + fr, col0 = u.pn * BM + wc * 32 + 4 * fq;
        const float* gb = gate + (long)((u.pm * BM) >> 12) * gstride;
        f32x4 gv[2][2];
#pragma unroll
        for (int bj = 0; bj < 2; ++bj)
#pragma unroll
            for (int n = 0; n < 2; ++n) gv[bj][n] = *(const f32x4*)(gb + col0 + bj * HALF + n * 16);
        f32x4 xf[2][8]; u32x2 xb[2][8];
#define ER_OFF(b_, k_) ((long)(row0 + ((b_) >> 1) * HALF + (2 * ((b_) & 1) + ((k_) >> 2)) * 16) * DM + col0 + (((k_) >> 1) & 1) * HALF + ((k_) & 1) * 16)
#define ER_LOAD(b_) do { _Pragma("unroll") for (int k_ = 0; k_ < 8; ++k_) { const long o_ = ER_OFF(b_, k_); \
            if (IN_BF16) xb[(b_) & 1][k_] = *(const u32x2*)((const bf16_t*)Xin + o_); else xf[(b_) & 1][k_] = *(const f32x4*)((const float*)Xin + o_); } } while (0)
        ER_LOAD(0);
#pragma unroll
        for (int b_ = 0; b_ < 4; ++b_) {
            if (b_ + 1 < 4) ER_LOAD(b_ + 1);
#pragma unroll
            for (int k_ = 0; k_ < 8; ++k_) { const long o_ = ER_OFF(b_, k_); const int ai = b_ >> 1, m = 2 * (b_ & 1) + (k_ >> 2), bj = (k_ >> 1) & 1, n = k_ & 1;
                const f32x4 bs = IN_BF16 ? bf4_f32(xb[b_ & 1][k_]) : xf[b_ & 1][k_];
                const f32x4 r_ = bs + gv[bj][n] * acc[ai][bj][m][n] * gs;
                *(u32x2*)(Xout + o_) = (u32x2){cvtpk(r_.x, r_.y), cvtpk(r_.z, r_.w)}; }
            asm volatile("" ::: "memory");
        }
#undef ER_OFF
#undef ER_LOAD
    }
};

template <class SH, class Epi, bool FP8 = false>
__device__ __forceinline__ void gemm_phase(LAS unsigned char* lds, const Gemm g, int G_, int c_, const Epi& E) {
    StaticOrder<SH> S; S.init(G_, c_);
    int tid_ = threadIdx.x; asm volatile("" : "+v"(tid_));
    const int tid = tid_, wid = __builtin_amdgcn_readfirstlane(tid >> 6), lane = tid & 63, wr = wid >> 2, wc = wid & 3, fr = lane & 15, fq = lane >> 4;
    constexpr int K = SH::K, nt = K / BK;
    unsigned voffA[2], voffB[2];
#pragma unroll
    for (int i = 0; i < 2; ++i) { int R, C; stage_rc(tid * 16 + i * 8192, R, C); const int Rb = Epi::PERM ? ((R & ~31) + perm32(R & 31)) : R;
        voffA[i] = (unsigned)(R * SH::lda + C) * 2u; voffB[i] = (unsigned)(Rb * SH::ldb + C) * 2u; }
    constexpr size_t kstep = (size_t)(BK * 2);
    constexpr size_t hstepA = (size_t)HALF * SH::lda * 2, hstepB = (size_t)HALF * SH::ldb * 2;
    constexpr size_t tstepA = 2 * hstepA, tstepB = 2 * hstepB;
    const unsigned ldsw = (unsigned)wid * 1024u;
    const int aoff = lds_byte(wr * 64 + fr, fq * 8), boff = lds_byte(wc * 32 + fr, fq * 8);
#define PG8_SA(b, h) (((b) * 2 + (h)) * HTB)
#define PG8_SB(b, h) ((4 + (b) * 2 + (h)) * HTB)
#define PG8_STAGE(bufoff, gbase, voff) do { _Pragma("unroll") for (int _i = 0; _i < 2; ++_i) \
        __builtin_amdgcn_global_load_lds((const unsigned*)((const char*)(gbase) + (voff)[_i]), (LAS unsigned*)(lds + (bufoff) + ldsw + _i * 8192), 16, 0, 0); } while (0)
#define PG8_LDA(dst, b, h) do { _Pragma("unroll") for (int m = 0; m < 4; ++m) { const u32x4 f0_ = *(const LAS u32x4*)(lds + PG8_SA(b, h) + aoff + m * 2048), f1_ = *(const LAS u32x4*)(lds + PG8_SA(b, h) + aoff + m * 2048 + 1024); dst[m] = __builtin_shufflevector(f0_, f1_, 0, 1, 2, 3, 4, 5, 6, 7); } } while (0)
#define PG8_LDB(dst, b, h) do { _Pragma("unroll") for (int n = 0; n < 2; ++n) { const u32x4 f0_ = *(const LAS u32x4*)(lds + PG8_SB(b, h) + boff + n * 2048), f1_ = *(const LAS u32x4*)(lds + PG8_SB(b, h) + boff + n * 2048 + 1024); dst[n] = __builtin_shufflevector(f0_, f1_, 0, 1, 2, 3, 4, 5, 6, 7); } } while (0)
typedef int v8i_t __attribute__((ext_vector_type(8)));
typedef unsigned u32x8 __attribute__((ext_vector_type(8)));
#define PG8_LOH(x) __builtin_bit_cast(bf16x8, __builtin_shufflevector(x, x, 0, 1, 2, 3))
#define PG8_HIH(x) __builtin_bit_cast(bf16x8, __builtin_shufflevector(x, x, 4, 5, 6, 7))
#define PG8_MMA(ai, bj, At, Bt) do { __builtin_amdgcn_s_setprio(1); _Pragma("unroll") for (int m = 0; m < 4; ++m) _Pragma("unroll") for (int n = 0; n < 2; ++n) { \
        if constexpr (FP8) asm volatile("v_mfma_scale_f32_16x16x128_f8f6f4 %0, %1, %2, %0, %3, %3 op_sel_hi:[0,0,0]" : "+v"(acc[ai][bj][m][n]) : "v"(Bt[n]), "v"(At[m]), "v"(fp8_one));   \
        else { acc[ai][bj][m][n] = __builtin_amdgcn_mfma_f32_16x16x32_bf16(PG8_LOH(Bt[n]), PG8_LOH(At[m]), acc[ai][bj][m][n], 0, 0, 0); \
               acc[ai][bj][m][n] = __builtin_amdgcn_mfma_f32_16x16x32_bf16(PG8_HIH(Bt[n]), PG8_HIH(At[m]), acc[ai][bj][m][n], 0, 0, 0); } } \
        __builtin_amdgcn_s_setprio(0); } while (0)
#define PG8_WAIT_V(n) asm volatile("s_waitcnt vmcnt(" #n ")" ::: "memory")
#define PG8_WAIT_L(n) asm volatile("s_waitcnt lgkmcnt(" #n ")" ::: "memory")
#define PG8_BAR __builtin_amdgcn_s_barrier()
#define PG8_SCHED __builtin_amdgcn_sched_barrier(0)
    Unit cur, nxt; int ui = 0;
    if (!S.next(0, cur)) return;
    f32x4 acc[2][2][4][2];
#pragma unroll
    for (int a = 0; a < 2; ++a)
#pragma unroll
        for (int b = 0; b < 2; ++b)
#pragma unroll
            for (int m = 0; m < 4; ++m)
#pragma unroll
                for (int n = 0; n < 2; ++n) acc[a][b][m][n] = (f32x4){0.f, 0.f, 0.f, 0.f};
    unsigned fp8_one = 0x7f7f7f7fu; asm volatile("" : "+v"(fp8_one));
    u32x8 At[4], B0[2], B1[2];
    const char* cA = (const char*)(g.A + (long)cur.pb * SH::bsA) + (size_t)cur.pm * tstepA; const char* cB = (const char*)(g.Bt + (long)cur.pb * SH::bsB) + (size_t)cur.pn * tstepB;
    PG8_STAGE(PG8_SB(0, 0), cB, voffB); PG8_STAGE(PG8_SB(0, 1), cB + hstepB, voffB); PG8_STAGE(PG8_SA(0, 0), cA, voffA); PG8_STAGE(PG8_SA(0, 1), cA + hstepA, voffA);
    if (wr == 1) PG8_BAR;
    PG8_WAIT_V(2); PG8_BAR;
    PG8_STAGE(PG8_SB(1, 0), cB + kstep, voffB); PG8_STAGE(PG8_SA(1, 0), cA + kstep, voffA); PG8_STAGE(PG8_SB(1, 1), cB + hstepB + kstep, voffB);
    PG8_WAIT_V(6); PG8_BAR;
    for (;;) {
        const bool has_next = S.next(ui + 1, nxt);
        const char* nA = has_next ? (const char*)(g.A + (long)nxt.pb * SH::bsA) + (size_t)nxt.pm * tstepA : cA; const char* nB = has_next ? (const char*)(g.Bt + (long)nxt.pb * SH::bsB) + (size_t)nxt.pn * tstepB : cB;
#pragma nounroll
        for (int t = 0; t < nt; t += 2) {
            const bool last = (t == nt - 2);
            const char* a1 = cA + (size_t)(t + 1) * kstep;
            const char* a2 = last ? nA : cA + (size_t)(t + 2) * kstep; const char* b2 = last ? nB : cB + (size_t)(t + 2) * kstep;
            const char* a3 = a2 + kstep; const char* b3 = b2 + kstep;
            PG8_LDB(B0, 0, 0); PG8_LDB(B1, 0, 1); PG8_SCHED; PG8_LDA(At, 0, 0); PG8_STAGE(PG8_SA(1, 1), a1 + hstepA, voffA);
            PG8_WAIT_V(8); PG8_WAIT_L(0); PG8_BAR; PG8_MMA(0, 0, At, B0); PG8_MMA(0, 1, At, B1); PG8_BAR; PG8_SCHED;
            PG8_LDA(At, 0, 1); PG8_STAGE(PG8_SB(0, 0), b2, voffB); PG8_STAGE(PG8_SB(0, 1), b2 + hstepB, voffB); PG8_STAGE(PG8_SA(0, 0), a2, voffA);
            PG8_WAIT_V(8); PG8_WAIT_L(0); PG8_BAR; PG8_MMA(1, 0, At, B0); PG8_MMA(1, 1, At, B1); PG8_BAR; PG8_SCHED;
            PG8_LDB(B0, 1, 0); PG8_LDB(B1, 1, 1); PG8_SCHED; PG8_LDA(At, 1, 0); PG8_STAGE(PG8_SA(0, 1), a2 + hstepA, voffA);
            PG8_WAIT_V(8); PG8_WAIT_L(0); PG8_BAR; PG8_MMA(0, 0, At, B0); PG8_MMA(0, 1, At, B1); PG8_BAR; PG8_SCHED;
            PG8_LDA(At, 1, 1); PG8_STAGE(PG8_SB(1, 0), b3, voffB); PG8_STAGE(PG8_SB(1, 1), b3 + hstepB, voffB); PG8_STAGE(PG8_SA(1, 0), a3, voffA);
            PG8_WAIT_V(8); PG8_WAIT_L(0); PG8_BAR; PG8_MMA(1, 0, At, B0); PG8_MMA(1, 1, At, B1); PG8_BAR; PG8_SCHED;
        }
        if (wr == 0) PG8_BAR;
        if constexpr (FP8) asm volatile("s_nop 15\n\ts_nop 15\n\ts_nop 7" ::: "memory");
        E(acc, cur, wr, wc, fr, fq);
        if (!has_next) break;
#pragma unroll
        for (int a = 0; a < 2; ++a)
#pragma unroll
            for (int b = 0; b < 2; ++b)
#pragma unroll
                for (int m = 0; m < 4; ++m)
#pragma unroll
                    for (int n = 0; n < 2; ++n) acc[a][b][m][n] = (f32x4){0.f, 0.f, 0.f, 0.f};
        cur = nxt; cA = nA; cB = nB; ++ui;
        if (wr == 1) PG8_BAR;
    }
    PG8_WAIT_V(0);
    PG8_BAR;
#undef PG8_SA
#undef PG8_SB
#undef PG8_STAGE
#undef PG8_LDA
#undef PG8_LDB
#undef PG8_MMA
#undef PG8_WAIT_V
#undef PG8_WAIT_L
#undef PG8_BAR
#undef PG8_SCHED
}
}

#define XB_TMO      128
#define XB_XCNT(j)  (256  + 64 * (j))
#define XB_XSUB(j)  (1280 + 64 * (j))
#define XB_XGEN(j)  (2304 + 64 * (j))
#define XB_TOP      3328
#define XB_TOPGEN   3392
#define XCD_BAR_WORDS 3456
#define XB_SPIN_CAP (1u << 18)
__device__ __forceinline__ unsigned xb_ld(unsigned* p)              { return __hip_atomic_load(p, __ATOMIC_RELAXED, __HIP_MEMORY_SCOPE_AGENT); }
__device__ __forceinline__ unsigned xb_add(unsigned* p, unsigned v) { return __hip_atomic_fetch_add(p, v, __ATOMIC_RELAXED, __HIP_MEMORY_SCOPE_AGENT); }
__device__ __forceinline__ unsigned xb_xcc_id() { return (unsigned)__builtin_amdgcn_s_getreg((3 << 11) | 20) & 0xFu; }
#define XB_SPIN(cond, bar) do { unsigned _sp = 0; while (cond) { __builtin_amdgcn_s_sleep(1); \
    if ((++_sp & 255u) == 0u) { if (xb_ld(&(bar)[XB_TMO])) break; if (_sp > XB_SPIN_CAP) { atomicAdd(&(bar)[XB_TMO], 1u); break; } } } } while (0)
struct XcdBarrier { unsigned* bar; unsigned x; volatile LAS unsigned* st; };
__device__ __forceinline__ XcdBarrier xcd_barrier_post(unsigned* bar, volatile LAS unsigned* st) {
    XcdBarrier b; b.bar = bar; b.x = xb_xcc_id(); b.st = st;
    if (threadIdx.x == 0) (void)xb_add(&bar[XB_XCNT(b.x)], 1u);
    return b;
}
__device__ __forceinline__ void xcd_barrier_complete(unsigned* bar, unsigned x, unsigned& nloc, unsigned& nx) {
    const unsigned G = gridDim.x * gridDim.y * gridDim.z;
    unsigned sum, cnt, mine, sp = 0u;
    for (;;) {
        sum = 0u; cnt = 0u; mine = 0u;
#pragma unroll
        for (unsigned j = 0; j < 16; ++j) { const unsigned c = xb_ld(&bar[XB_XCNT(j)]); sum += c; cnt += (c > 0u) ? 1u : 0u; mine = (j == x) ? c : mine; }
        if (sum == G) break;
        __builtin_amdgcn_s_sleep(1);
        if ((++sp & 255u) == 0u) { if (xb_ld(&bar[XB_TMO])) break; if (sp > XB_SPIN_CAP) { atomicAdd(&bar[XB_TMO], 1u); break; } }
    }
    nloc = mine > 0u ? mine : 1u; nx = cnt > 0u ? cnt : 1u;
}
__device__ __forceinline__ void xcd_barrier(const XcdBarrier& b) {
    asm volatile("s_waitcnt vmcnt(0)" ::: "memory");
    __syncthreads();
    if (threadIdx.x == 0) {
        unsigned* bar = b.bar;
        __builtin_amdgcn_s_waitcnt(0);
        unsigned nloc = b.st[0], nx = b.st[1];
        if (nloc == 0u) { xcd_barrier_complete(bar, b.x, nloc, nx); b.st[0] = nloc; b.st[1] = nx; }
        const unsigned old = xb_add(&bar[XB_XSUB(b.x)], 1u);
        const unsigned gen = old / nloc;
        if (old + 1u == (gen + 1u) * nloc) {
            __builtin_amdgcn_fence(__ATOMIC_RELEASE, "agent");
            asm volatile("s_waitcnt vmcnt(0)" ::: "memory");
            const unsigned og = xb_add(&bar[XB_TOP], 1u);
            const unsigned tg = og / nx;
            if (og + 1u == (tg + 1u) * nx) xb_add(&bar[XB_TOPGEN], 1u);
            else XB_SPIN(xb_ld(&bar[XB_TOPGEN]) == tg, bar);
            __builtin_amdgcn_fence(__ATOMIC_ACQUIRE, "agent");
            xb_add(&bar[XB_XGEN(b.x)], 1u);
            asm volatile("s_waitcnt vmcnt(0)" ::: "memory");
        } else {
            XB_SPIN(xb_ld(&bar[XB_XGEN(b.x)]) == gen, bar);
            __builtin_amdgcn_fence(__ATOMIC_ACQUIRE, "agent");
            asm volatile("s_waitcnt vmcnt(0)" ::: "memory");
        }
    }
    __syncthreads();
}

constexpr int RING_BYTES = 131072;
constexpr int LDSCTL_OFF = RING_BYTES, MISC_OFF = LDSCTL_OFF + 320;
constexpr int LDS_BYTES = 147456;
constexpr int NWAVES = 8;

struct Args { const float* in[17]; float* out; unsigned char* ws; };

struct Ctx {
    LAS unsigned char* lds;
    int tid, lane, wave, vcu, G;
};

__device__ __forceinline__ Ctx fresh(const Ctx& F) {
    Ctx C = F; int t = threadIdx.x; asm volatile("" : "+v"(t)); C.tid = t; C.lane = t & 63; return C;
}
__device__ __forceinline__ void p0_transpose_item(const float* W, int K, int N, bf16_t* WT, LAS float* scr, int item, int lane) {
    const int nblk = N / 32, kb = item / nblk, nb = item % nblk, k0 = 64 * kb, n0 = 32 * nb;
#pragma unroll 8
    for (int i = 0; i < 32; ++i) { const int kk = 2 * i + (lane >> 5); scr[kk * 33 + (lane & 31)] = W[(size_t)(k0 + kk) * N + n0 + (lane & 31)]; }
    asm volatile("s_waitcnt lgkmcnt(0)" ::: "memory");
    const int c = lane & 7;
#pragma unroll
    for (int j = 0; j < 4; ++j) { const int n = (lane >> 3) + 8 * j; const LAS float* s = scr + (8 * c) * 33 + n;
        u32x4 o; o.x = pk2(s[0 * 33], s[1 * 33]); o.y = pk2(s[2 * 33], s[3 * 33]); o.z = pk2(s[4 * 33], s[5 * 33]); o.w = pk2(s[6 * 33], s[7 * 33]);
        *(u32x4*)(WT + (size_t)(n0 + n) * K + k0 + 8 * c) = o; }
    asm volatile("s_waitcnt lgkmcnt(0)" ::: "memory");
}
__device__ __forceinline__ void p0_transpose_item8(const float* W, int K, int N, unsigned char* WT, LAS float* scr, int item, int lane) {
    const int nblk = N / 32, kb = item / nblk, nb = item % nblk, k0 = 64 * kb, n0 = 32 * nb;
#pragma unroll 8
    for (int i = 0; i < 32; ++i) { const int kk = 2 * i + (lane >> 5); scr[kk * 33 + (lane & 31)] = W[(size_t)(k0 + kk) * N + n0 + (lane & 31)]; }
    asm volatile("s_waitcnt lgkmcnt(0)" ::: "memory");
    const int c = lane & 7;
#pragma unroll
    for (int j = 0; j < 4; ++j) { const int n = (lane >> 3) + 8 * j; const LAS float* s = scr + (8 * c) * 33 + n; constexpr float sc = pg8::W8_SCALE;
        u32x2 o; o.x = fp8_pack4(s[0 * 33] * sc, s[1 * 33] * sc, s[2 * 33] * sc, s[3 * 33] * sc); o.y = fp8_pack4(s[4 * 33] * sc, s[5 * 33] * sc, s[6 * 33] * sc, s[7 * 33] * sc);
        *(u32x2*)(WT + (size_t)(n0 + n) * K + k0 + 8 * c) = o; }
    asm volatile("s_waitcnt lgkmcnt(0)" ::: "memory");
}
__device__ __forceinline__ void cvt8(const float* src, bf16_t* dst) {
    const f32x4 a = *(const f32x4*)src, b = *(const f32x4*)(src + 4);
    u32x4 o; o.x = pk2(a[0], a[1]); o.y = pk2(a[2], a[3]); o.z = pk2(b[0], b[1]); o.w = pk2(b[2], b[3]);
    *(u32x4*)dst = o;
}

__device__ __forceinline__ void p0_prologue(const Ctx& F0, const Args& a) {
    const Ctx F = fresh(F0);
    unsigned char* ws = a.ws;
    const int nrest = (F.G > 160) ? F.G - 96 : F.G, vrest = (F.G > 160) ? F.vcu - 96 : F.vcu;
    const int gw = vrest * NWAVES + F.wave, NGW = nrest * NWAVES;
    const long gt = (long)vrest * 512 + F.tid, NGT = (long)nrest * 512;
    {
        LAS float* red = (LAS float*)(F.lds);
        const float* c = a.in[1]; const float* cctx = a.in[3]; const float* wmod = a.in[6]; const float* bmod = a.in[7];
        float* modb = (float*)(ws + WS_MOD);
        for (int item = F.vcu; item < 96; item += F.G) {
            const int l = item / 48, nc = item % 48, n0 = nc * 128 + 2 * F.lane, kb = F.wave * 128;
            float sv[9][2];
#pragma unroll
            for (int r = 0; r < 9; ++r)
#pragma unroll
                for (int j = 0; j < 2; ++j) { const int k = kb + 64 * j + F.lane; const float v = (r < 8) ? c[r * DM + k] : cctx[k]; sv[r][j] = v / (1.0f + __expf(-v)); }
            float acc[9][2];
#pragma unroll
            for (int r = 0; r < 9; ++r) { acc[r][0] = 0.f; acc[r][1] = 0.f; }
            const float* wp = wmod + (size_t)l * DM * NMOD + (size_t)kb * NMOD + n0;
#pragma unroll
            for (int j = 0; j < 2; ++j)
#pragma unroll 8
                for (int kl = 0; kl < 64; ++kl) {
                    const f32x2 w = *(const f32x2*)(wp + (size_t)(64 * j + kl) * NMOD);
#pragma unroll
                    for (int r = 0; r < 9; ++r) { const float s = __builtin_bit_cast(float, __builtin_amdgcn_readlane(__builtin_bit_cast(int, sv[r][j]), kl)); acc[r][0] += s * w[0]; acc[r][1] += s * w[1]; }
                }
            __syncthreads();
#pragma unroll
            for (int r = 0; r < 9; ++r) { red[(F.wave * 9 + r) * 128 + 2 * F.lane] = acc[r][0]; red[(F.wave * 9 + r) * 128 + 2 * F.lane + 1] = acc[r][1]; }
            __syncthreads();
            for (int o = F.tid; o < 9 * 128; o += 512) { const int r = o >> 7, nl = o & 127; float s = 0.f;
#pragma unroll
                for (int w = 0; w < 8; ++w) s += red[(w * 9 + r) * 128 + nl];
                modb[(size_t)(l * 9 + r) * NMOD + nc * 128 + nl] = s + bmod[l * NMOD + nc * 128 + nl]; }
        }
        __syncthreads();
    }
    if (vrest < 0) return;
    {
        LAS float* scr = (LAS float*)(F.lds + F.wave * 16384);
        constexpr int I_QKV = (DM / 64) * (3 * DM / 32), I_O = (DM / 64) * (DM / 32), I_PQ = (DM / 64) * (2 * DM / 32);
        constexpr int NITEMS = I_QKV + 2 * I_O + 2 * I_PQ;
        for (int it = gw; it < NITEMS; it += NGW) {
            int r = it;
            if (r < I_QKV) { p0_transpose_item8(a.in[8], DM, 3 * DM, ws + WS_WQKV, scr, r, F.lane); continue; } r -= I_QKV;
            if (r < I_O) { p0_transpose_item8(a.in[9], DM, DM, ws + WS_WO, scr, r, F.lane); continue; } r -= I_O;
            if (r < I_O) { p0_transpose_item8(a.in[11], DM, DM, ws + WS_WF, scr, r, F.lane); continue; } r -= I_O;
            if (r < I_PQ) { p0_transpose_item8(a.in[12], DM, 2 * DM, ws + WS_WPQ, scr, r, F.lane); continue; } r -= I_PQ;
            p0_transpose_item8(a.in[12] + (size_t)DM * 2 * DM, DM, 2 * DM, ws + WS_WPQ + (size_t)2 * DM * DM, scr, r, F.lane);
        }
    }
    for (long i = gt; i < 2 * 2 * 128 * 128 / 8; i += NGT) cvt8(a.in[13] + i * 8, (bf16_t*)(ws + WS_SK) + i * 8);
    {
        bf16_t* wc = (bf16_t*)(ws + WS_WC);
        for (long i = gt; i < 512 * 256 / 8; i += NGT) { const int nn = (int)(i >> 5), k0 = (int)(i & 31) * 8; float v[8];
#pragma unroll
            for (int j = 0; j < 8; ++j) { const int m = ((k0 + j) * (nn & 255)) & 255; const float fr = (float)m * (1.0f / 256.0f);
                v[j] = (nn < 256 ? __builtin_amdgcn_cosf(fr) : __builtin_amdgcn_sinf(fr)) * (1.0f / 16.0f); }
            u32x4 o; o.x = pk2(v[0], v[1]); o.y = pk2(v[2], v[3]); o.z = pk2(v[4], v[5]); o.w = pk2(v[6], v[7]);
            *(u32x4*)(wc + i * 8) = o; }
        unsigned char* cs = ws + WS_CS;
        for (long i = gt; i < 2048L * 4096 / 8; i += NGT) { const int np = (int)(i >> 9), c0 = (int)(i & 511) * 8; const int part = c0 >> 11; float v[8];
#pragma unroll
            for (int j = 0; j < 8; ++j) { const int n = (c0 + j) & 2047; const int m = (n * np) & 4095; const float fr = (float)m * (1.0f / 4096.0f);
                v[j] = (part == 0 ? __builtin_amdgcn_cosf(fr) : -__builtin_amdgcn_sinf(fr)) * (pg8::CS_SCALE / 64.0f); }
            u32x2 o; o.x = fp8_pack4(v[0], v[1], v[2], v[3]); o.y = fp8_pack4(v[4], v[5], v[6], v[7]);
            *(u32x2*)(cs + i * 8) = o; }
    }
}

__device__ __forceinline__ unsigned fp4_pack8(const float* v, float sc) {
    unsigned w = 0;
#define FP4C(i) fminf(fmaxf(v[i] * sc, -6.f), 6.f)
    w = __builtin_amdgcn_cvt_scalef32_pk_fp4_f32(w, FP4C(0), FP4C(1), 1.0f, 0);
    w = __builtin_amdgcn_cvt_scalef32_pk_fp4_f32(w, FP4C(2), FP4C(3), 1.0f, 1);
    w = __builtin_amdgcn_cvt_scalef32_pk_fp4_f32(w, FP4C(4), FP4C(5), 1.0f, 2);
    w = __builtin_amdgcn_cvt_scalef32_pk_fp4_f32(w, FP4C(6), FP4C(7), 1.0f, 3);
#undef FP4C
    return w;
}
#define FP4_DEC(w, bs) __builtin_amdgcn_cvt_scalef32_pk_f32_fp4((w), 1.0f, (bs))
__device__ __forceinline__ unsigned i8_pack4(f32x4 v, float sc) {
    const int a = (int)rintf(fminf(fmaxf(v[0] * sc, -127.f), 127.f)), b = (int)rintf(fminf(fmaxf(v[1] * sc, -127.f), 127.f));
    const int c = (int)rintf(fminf(fmaxf(v[2] * sc, -127.f), 127.f)), d = (int)rintf(fminf(fmaxf(v[3] * sc, -127.f), 127.f));
    return (unsigned)(a & 0xff) | ((unsigned)(b & 0xff) << 8) | ((unsigned)(c & 0xff) << 16) | ((unsigned)(d & 0xff) << 24);
}
constexpr long TC_PER = (long)NEXP * DM / 16, TC_TOTAL = 4 * TC_PER;
__device__ __forceinline__ void tc_issue(const Args& a, long i, f32x4 (&v)[4]) {
    const int q = (int)(i / TC_PER); const long r = i - (long)q * TC_PER; const int l = q >> 1, tb = q & 1;
    const int e = (int)(r >> 6), c16 = (int)(r & 63);
    const float* src = (tb ? a.in[15] : a.in[14]) + ((size_t)l * NEXP + e) * DM + c16 * 16;
#pragma unroll
    for (int d = 0; d < 4; ++d) v[d] = *(const f32x4*)(src + 4 * d);
}
__device__ __forceinline__ void tc_finish(const Args& a, long i, const f32x4 (&v)[4]) {
    const int q = (int)(i / TC_PER); const long r = i - (long)q * TC_PER; const int l = q >> 1, tb = q & 1;
    const int e = (int)(r >> 6), c16 = (int)(r & 63);
    const float sc = tb ? V_SCALE : U_SCALE;
    u32x2 o;
#pragma unroll
    for (int d = 0; d < 2; ++d) { const float v8[8] = {v[2 * d][0], v[2 * d][1], v[2 * d][2], v[2 * d][3], v[2 * d + 1][0], v[2 * d + 1][1], v[2 * d + 1][2], v[2 * d + 1][3]};
        o[d] = fp4_pack8(v8, sc); }
    *(u32x2*)(a.ws + WS_TAB + (size_t)l * TAB_LAYER + (tb ? TAB_VOFF : 0) + ((size_t)(c16 >> 4) * NEXP + e) * 128 + (c16 & 15) * 8) = o;
}
__device__ __forceinline__ void table_convert(const Ctx& F0, const Args& a, int sh0, int nsh, int nshare) {
    const Ctx F = fresh(F0);
    constexpr long PER = (long)NEXP * DM / 16;
    constexpr long TOTAL = 4 * PER, T0 = TOTAL / 4;
    unsigned char* t8 = a.ws + WS_TAB;
    const long per_share = (TOTAL - T0 + nshare - 1) / nshare;
    const long i0 = T0 + (long)sh0 * per_share, i1 = min(T0 + (long)(sh0 + nsh) * per_share, TOTAL);
    for (long i = i0 + F.tid; i < i1; i += 512) {
        const int q = (int)(i / PER); const long r = i - (long)q * PER; const int l = q >> 1, tb = q & 1;
        const int e = (int)(r >> 6), c16 = (int)(r & 63);
        const float* src = (tb ? a.in[15] : a.in[14]) + ((size_t)l * NEXP + e) * DM + c16 * 16;
        if (tb) {
            u32x2 o;
#pragma unroll
            for (int d = 0; d < 2; ++d) { const f32x4 va = *(const f32x4*)(src + 8 * d), vb = *(const f32x4*)(src + 8 * d + 4);
                const float v8[8] = {va[0], va[1], va[2], va[3], vb[0], vb[1], vb[2], vb[3]};
                o[d] = fp4_pack8(v8, V_SCALE); }
            *(u32x2*)(t8 + (size_t)l * TAB_LAYER + TAB_VOFF + ((size_t)(c16 >> 4) * NEXP + e) * 128 + (c16 & 15) * 8) = o;
        } else {
            u32x2 o;
#pragma unroll
            for (int d = 0; d < 2; ++d) { const f32x4 va = *(const f32x4*)(src + 8 * d), vb = *(const f32x4*)(src + 8 * d + 4);
                const float v8[8] = {va[0], va[1], va[2], va[3], vb[0], vb[1], vb[2], vb[3]};
                o[d] = fp4_pack8(v8, U_SCALE); }
            *(u32x2*)(t8 + (size_t)l * TAB_LAYER + ((size_t)(c16 >> 4) * NEXP + e) * 128 + (c16 & 15) * 8) = o;
        }
    }
}

__device__ __forceinline__ const float* norm_src(const Args& a, int mode, int m) { return (m < ML) ? ((mode == 0 ? a.in[0] : a.out) + (size_t)m * DM) : (a.in[2] + (size_t)(m - ML) * DM); }
__device__ __forceinline__ void norm_phase(const Ctx& F0, const Args& a, int mode, int layer, int off, const float* gw) {
    const Ctx F = fresh(F0);
    const int gwv = F.vcu * NWAVES + F.wave, NGW = F.G * NWAVES, lane = F.lane;
    const float* modb = (const float*)(a.ws + WS_MOD) + (size_t)layer * 9 * NMOD;
    bf16_t* hx = (bf16_t*)(a.ws + WS_HX);
    const int nrows = (mode == 0) ? MT : ML;
    f32x4 gv[4];
#pragma unroll
    for (int j = 0; j < 4; ++j) gv[j] = ((const f32x4*)gw)[lane + 64 * j];
    if (mode != 0) {
        const u32x2* XBc = (const u32x2*)(a.ws + WS_XB);
        constexpr int CH = 16, NPF = 4;
        for (int c = gwv; c < ML / CH; c += NGW) {
            const int r0 = c * CH;
            u32x2 rb[NPF][4]; f32x4 v[4], av[4], cv[4];
#pragma unroll
            for (int p = 0; p < NPF; ++p)
#pragma unroll
                for (int j = 0; j < 4; ++j) rb[p][j] = XBc[(size_t)(r0 + p) * 256 + lane + 64 * j];
            { const float* mr = modb + (size_t)(r0 >> 12) * NMOD + off;
#pragma unroll
              for (int j = 0; j < 4; ++j) { av[j] = ((const f32x4*)mr)[lane + 64 * j]; cv[j] = ((const f32x4*)(mr + DM))[lane + 64 * j]; } }
            asm volatile("" :: "v"(cv[3]));
#pragma unroll 1
            for (int q = 0; q < CH / NPF; ++q) {
#pragma unroll
              for (int p = 0; p < NPF; ++p) {
                const int m = r0 + q * NPF + p;
#pragma unroll
                for (int j = 0; j < 4; ++j) v[j] = bf4_f32(rb[p][j]);
                { const int rn = min(m + NPF, r0 + CH - 1);
#pragma unroll
                  for (int j = 0; j < 4; ++j) rb[p][j] = XBc[(size_t)rn * 256 + lane + 64 * j]; }
              float s = 0.f;
#pragma unroll
              for (int j = 0; j < 4; ++j) s += (v[j].x * v[j].x + v[j].y * v[j].y) + (v[j].z * v[j].z + v[j].w * v[j].w);
              const float rstd = 1.0f / sqrtf(wave_sum(s) * (1.0f / DM) + EPS);
              unsigned long long* o8 = (unsigned long long*)(hx + (size_t)m * DM) + lane;
              unsigned* o4 = (unsigned*)(a.ws + WS_HX + (size_t)m * DM) + lane;
#pragma unroll
              for (int j = 0; j < 4; ++j) { const f32x4 y = (v[j] * rstd * gv[j]) * (cv[j] + 1.0f) + av[j];
                  if (mode == 0 || off == 3 * DM) o4[64 * j] = fp8_pack4(y.x * pg8::ACT8_SCALE, y.y * pg8::ACT8_SCALE, y.z * pg8::ACT8_SCALE, y.w * pg8::ACT8_SCALE);
                  if (mode == 0) continue;
                  if (off != 3 * DM)
                  o8[64 * j] = (unsigned long long)cvtpk(y.x, y.y) | ((unsigned long long)cvtpk(y.z, y.w) << 32);
                  if (off == 3 * DM) {
                      const float q0 = fminf(fmaxf(y.x * XQ_SCALE, -6.f), 6.f), q1 = fminf(fmaxf(y.y * XQ_SCALE, -6.f), 6.f), q2 = fminf(fmaxf(y.z * XQ_SCALE, -6.f), 6.f), q3 = fminf(fmaxf(y.w * XQ_SCALE, -6.f), 6.f);
                      unsigned ph = __builtin_amdgcn_cvt_scalef32_pk_fp4_f32(0u, q0, q1, 1.0f, 0); ph = __builtin_amdgcn_cvt_scalef32_pk_fp4_f32(ph, q2, q3, 1.0f, 1);
                      const f32x2 d0 = FP4_DEC(ph, 0), d1 = FP4_DEC(ph, 1);
                      unsigned pl = __builtin_amdgcn_cvt_scalef32_pk_fp4_f32(0u, 4.f * (q0 - d0.x), 4.f * (q1 - d0.y), 1.0f, 0); pl = __builtin_amdgcn_cvt_scalef32_pk_fp4_f32(pl, 4.f * (q2 - d1.x), 4.f * (q3 - d1.y), 1.0f, 1);
                      unsigned short* xq = (unsigned short*)(a.ws + WS_X8 + ((size_t)j * ML + m) * 256) + lane;
                      xq[0] = (unsigned short)(ph & 0xffffu); xq[64] = (unsigned short)(pl & 0xffffu); } }
              }
            }
        }
        return;
    }
    const u32x2* XBr = (const u32x2*)(a.ws + WS_XB);
    f32x4 v[4], vn[4]; u32x2 vr[4];
    if (gwv < nrows) {
        if (mode == 0) { const f32x4* xr = (const f32x4*)norm_src(a, mode, gwv) + lane;
#pragma unroll
            for (int j = 0; j < 4; ++j) vn[j] = xr[64 * j]; }
        else {
#pragma unroll
            for (int j = 0; j < 4; ++j) vr[j] = XBr[(size_t)gwv * 256 + lane + 64 * j]; } }
    for (int m = gwv; m < nrows; m += NGW) {
        const int mn = (m + NGW < nrows) ? m + NGW : m;
        if (mode == 0) {
#pragma unroll
            for (int j = 0; j < 4; ++j) v[j] = vn[j];
            const f32x4* xr = (const f32x4*)norm_src(a, mode, mn) + lane;
#pragma unroll
            for (int j = 0; j < 4; ++j) vn[j] = xr[64 * j];
        } else {
#pragma unroll
            for (int j = 0; j < 4; ++j) v[j] = bf4_f32(vr[j]);
#pragma unroll
            for (int j = 0; j < 4; ++j) vr[j] = XBr[(size_t)mn * 256 + lane + 64 * j];
        }
        const float* mr = modb + (size_t)((m < ML) ? (m >> 12) : 8) * NMOD + off;
        f32x4 av[4], cv[4];
#pragma unroll
        for (int j = 0; j < 4; ++j) { av[j] = ((const f32x4*)mr)[lane + 64 * j]; cv[j] = ((const f32x4*)(mr + DM))[lane + 64 * j]; }
        float s = 0.f;
#pragma unroll
        for (int j = 0; j < 4; ++j) s += (v[j].x * v[j].x + v[j].y * v[j].y) + (v[j].z * v[j].z + v[j].w * v[j].w);
        const float rstd = 1.0f / sqrtf(wave_sum(s) * (1.0f / DM) + EPS);
        unsigned long long* o8 = (unsigned long long*)(hx + (size_t)m * DM) + lane;
        unsigned* o4 = (unsigned*)(a.ws + WS_HX + (size_t)m * DM) + lane;
#pragma unroll
        for (int j = 0; j < 4; ++j) { const f32x4 y = (v[j] * rstd * gv[j]) * (cv[j] + 1.0f) + av[j];
            if (mode == 0 || off == 3 * DM) o4[64 * j] = fp8_pack4(y.x * pg8::ACT8_SCALE, y.y * pg8::ACT8_SCALE, y.z * pg8::ACT8_SCALE, y.w * pg8::ACT8_SCALE);
            if (mode == 0) continue;
            if (off != 3 * DM)
            o8[64 * j] = (unsigned long long)cvtpk(y.x, y.y) | ((unsigned long long)cvtpk(y.z, y.w) << 32);
            if (off == 3 * DM) {
                const float q0 = fminf(fmaxf(y.x * XQ_SCALE, -6.f), 6.f), q1 = fminf(fmaxf(y.y * XQ_SCALE, -6.f), 6.f), q2 = fminf(fmaxf(y.z * XQ_SCALE, -6.f), 6.f), q3 = fminf(fmaxf(y.w * XQ_SCALE, -6.f), 6.f);
                unsigned ph = __builtin_amdgcn_cvt_scalef32_pk_fp4_f32(0u, q0, q1, 1.0f, 0); ph = __builtin_amdgcn_cvt_scalef32_pk_fp4_f32(ph, q2, q3, 1.0f, 1);
                const f32x2 d0 = FP4_DEC(ph, 0), d1 = FP4_DEC(ph, 1);
                unsigned pl = __builtin_amdgcn_cvt_scalef32_pk_fp4_f32(0u, 4.f * (q0 - d0.x), 4.f * (q1 - d0.y), 1.0f, 0); pl = __builtin_amdgcn_cvt_scalef32_pk_fp4_f32(pl, 4.f * (q2 - d1.x), 4.f * (q3 - d1.y), 1.0f, 1);
                unsigned short* xq = (unsigned short*)(a.ws + WS_X8 + ((size_t)j * ML + m) * 256) + lane;
                xq[0] = (unsigned short)(ph & 0xffffu); xq[64] = (unsigned short)(pl & 0xffffu); } }
    }
}
__device__ __forceinline__ void norm_fold_phase(const Ctx& F0, const Args& a, int layer, const float* gw) {
    const Ctx F = fresh(F0);
    const int gwv = F.vcu * NWAVES + F.wave, NGW = F.G * NWAVES, lane = F.lane;
    const float* modb = (const float*)(a.ws + WS_MOD) + (size_t)layer * 9 * NMOD;
    const u32x2* XBr = (const u32x2*)(a.ws + WS_XB);
    unsigned long long* hc = (unsigned long long*)(a.ws + WS_HX);
    unsigned long long* hs = (unsigned long long*)(a.ws + WS_HX + 32 * MiB);
    float* yni = (float*)(a.ws + WS_YNI);
    f32x4 gv[4];
#pragma unroll
    for (int j = 0; j < 4; ++j) gv[j] = ((const f32x4*)gw)[lane + 64 * j];
    u32x2 ra[4], rb[4];
#define NF_ROWS(task_, na_, nb_) const int b_ = (task_) >> 11, t_ = (task_) & 2047; const int na_ = b_ * SEQ + t_, nb_ = b_ * SEQ + (t_ == 0 ? 2048 : SEQ - t_)
    if (gwv < NB * 2048) { NF_ROWS(gwv, na, nb);
#pragma unroll
        for (int j = 0; j < 4; ++j) { ra[j] = XBr[(size_t)na * 256 + lane + 64 * j]; rb[j] = XBr[(size_t)nb * 256 + lane + 64 * j]; } }
    for (int task = gwv; task < NB * 2048; task += NGW) {
        const int b = task >> 11, t = task & 2047;
        f32x4 va[4], vb[4];
#pragma unroll
        for (int j = 0; j < 4; ++j) { va[j] = bf4_f32(ra[j]); vb[j] = bf4_f32(rb[j]); }
        { const int tn = (task + NGW < NB * 2048) ? task + NGW : task; NF_ROWS(tn, na, nb);
#pragma unroll
          for (int j = 0; j < 4; ++j) { ra[j] = XBr[(size_t)na * 256 + lane + 64 * j]; rb[j] = XBr[(size_t)nb * 256 + lane + 64 * j]; } }
        const float* mr = modb + (size_t)b * NMOD;
        f32x4 av[4], cv[4];
#pragma unroll
        for (int j = 0; j < 4; ++j) { av[j] = ((const f32x4*)mr)[lane + 64 * j]; cv[j] = ((const f32x4*)(mr + DM))[lane + 64 * j]; }
        float sa = 0.f, sb = 0.f;
#pragma unroll
        for (int j = 0; j < 4; ++j) { sa += (va[j].x * va[j].x + va[j].y * va[j].y) + (va[j].z * va[j].z + va[j].w * va[j].w); sb += (vb[j].x * vb[j].x + vb[j].y * vb[j].y) + (vb[j].z * vb[j].z + vb[j].w * vb[j].w); }
        const float ra_ = 1.0f / sqrtf(wave_sum(sa) * (1.0f / DM) + EPS), rb_ = 1.0f / sqrtf(wave_sum(sb) * (1.0f / DM) + EPS);
        const size_t orow = ((size_t)b * 2048 + t) * 256 + lane;
#pragma unroll
        for (int j = 0; j < 4; ++j) {
            const f32x4 ya = (va[j] * ra_ * gv[j]) * (cv[j] + 1.0f) + av[j], yb = (vb[j] * rb_ * gv[j]) * (cv[j] + 1.0f) + av[j];
            f32x4 ys, yd;
            if (t == 0) { ys = ya; yd = (f32x4){0.f, 0.f, 0.f, 0.f}; ((f32x4*)(yni + (size_t)b * DM))[lane + 64 * j] = yb; }
            else { ys = ya + yb; yd = ya - yb; }
            hc[orow + 64 * j] = (unsigned long long)cvtpk(ys.x, ys.y) | ((unsigned long long)cvtpk(ys.z, ys.w) << 32);
            hs[orow + 64 * j] = (unsigned long long)cvtpk(yd.x, yd.y) | ((unsigned long long)cvtpk(yd.z, yd.w) << 32);
        }
    }
#undef NF_ROWS
}
__device__ __forceinline__ void final_norm_phase(const Ctx& F0, const Args& a) {
    const Ctx F = fresh(F0);
    const int gwv = F.vcu * NWAVES + F.wave, NGW = F.G * NWAVES;
    const float* gw = a.in[16];
    const u32x2* XBr = (const u32x2*)(a.ws + WS_XB);
    f32x4 gv[4]; u32x2 vr[4];
#pragma unroll
    for (int j = 0; j < 4; ++j) gv[j] = ((const f32x4*)gw)[F.lane + 64 * j];
    if (gwv < ML) {
#pragma unroll
        for (int j = 0; j < 4; ++j) vr[j] = XBr[(size_t)gwv * 256 + F.lane + 64 * j]; }
    for (int m = gwv; m < ML; m += NGW) {
        f32x4* xr = (f32x4*)(a.out + (size_t)m * DM) + F.lane;
        f32x4 v[4]; float s = 0.f;
#pragma unroll
        for (int j = 0; j < 4; ++j) { v[j] = bf4_f32(vr[j]); s += (v[j].x * v[j].x + v[j].y * v[j].y) + (v[j].z * v[j].z + v[j].w * v[j].w); }
        { const int mn = (m + NGW < ML) ? m + NGW : m;
#pragma unroll
          for (int j = 0; j < 4; ++j) vr[j] = XBr[(size_t)mn * 256 + F.lane + 64 * j]; }
        const float rstd = 1.0f / sqrtf(wave_sum(s) * (1.0f / DM) + EPS);
#pragma unroll
        for (int j = 0; j < 4; ++j) xr[64 * j] = v[j] * rstd * gv[j];
    }
}

constexpr int ATT_ROWB = 144, ATT_KTILEB = 128 * ATT_ROWB, ATT_VROWB = 272, ATT_VTILEB = 64 * ATT_VROWB, ATT_BIAS_B = 2048, ATT_K0 = ATT_BIAS_B, ATT_V0 = ATT_K0 + 2 * ATT_KTILEB;
constexpr float ATT_THR = 8.0f;
template <int NGH, bool LATENT>
__device__ __forceinline__ void attn_sub(const LAS unsigned char* Kt, const LAS unsigned char* Vt_, int ko, const LAS float* browA, const LAS float* browB, const int (&relidx)[8],
                                         const bf16x8 (&qf)[2], float& m_ref, float& l_run, f32x4 (&o)[4], int q16, int g4) {
    constexpr int NG = 2 * NGH;
    bf16x8 kf[2 * NG][2]; u32x2 vf[4][NG][2]; f32x4 sc[2 * NG];
#pragma unroll
    for (int gk = 0; gk < NG; ++gk)
#pragma unroll
        for (int b2 = 0; b2 < 2; ++b2)
#pragma unroll
            for (int ks = 0; ks < 2; ++ks) kf[2 * gk + b2][ks] = *(const LAS bf16x8*)(Kt + ((gk / NGH) * 64 + ko + 32 * (gk % NGH) + 16 * b2 + q16) * ATT_ROWB + 64 * ks + 16 * g4);
#pragma unroll
    for (int d = 0; d < 4; ++d)
#pragma unroll
        for (int gk = 0; gk < NG; ++gk) { const LAS unsigned char* vp = Vt_ + (16 * d + q16) * ATT_VROWB + 2 * ((gk / NGH) * 64 + ko + 32 * (gk % NGH) + 4 * g4);
            vf[d][gk][0] = *(const LAS u32x2*)vp; vf[d][gk][1] = *(const LAS u32x2*)(vp + 32); }
    if (LATENT) {
#pragma unroll
        for (int kk = 0; kk < 8; ++kk) { sc[kk >> 2][kk & 3] = browA[relidx[kk]] - m_ref; sc[2 + (kk >> 2)][kk & 3] = browB[relidx[kk]] - m_ref; }
    } else {
#pragma unroll
        for (int blk = 0; blk < 2 * NG; ++blk) sc[blk] = (f32x4){-m_ref, -m_ref, -m_ref, -m_ref};
    }
#pragma unroll
    for (int blk = 0; blk < 2 * NG; ++blk)
#pragma unroll
        for (int ks = 0; ks < 2; ++ks) sc[blk] = __builtin_amdgcn_mfma_f32_16x16x32_bf16(kf[blk][ks], qf[ks], sc[blk], 0, 0, 0);
    float mx = fmaxf(fmaxf(sc[0][0], sc[0][1]), fmaxf(sc[0][2], sc[0][3]));
#pragma unroll
    for (int blk = 1; blk < 2 * NG; ++blk) mx = fmaxf(mx, fmaxf(fmaxf(sc[blk][0], sc[blk][1]), fmaxf(sc[blk][2], sc[blk][3])));
    if (__builtin_amdgcn_ballot_w64(mx > ATT_THR) != 0ull) {
        mx = fmaxf(mx, __shfl_xor(mx, 16)); mx = fmaxf(mx, __shfl_xor(mx, 32));
        const float dl = mx > ATT_THR ? mx : 0.f;
        m_ref += dl;
        const float al = __builtin_amdgcn_exp2f(-dl);
        l_run *= al;
#pragma unroll
        for (int d = 0; d < 4; ++d) o[d] *= al;
#pragma unroll
        for (int blk = 0; blk < 2 * NG; ++blk) sc[blk] -= dl;
    }
    float ls0 = 0.f, ls1 = 0.f;
#pragma unroll
    for (int blk = 0; blk < 2 * NG; ++blk)
#pragma unroll
        for (int i = 0; i < 4; ++i) { const float e = __builtin_amdgcn_exp2f(sc[blk][i]); sc[blk][i] = e; if (blk & 1) ls1 += e; else ls0 += e; }
    l_run += ls0 + ls1;
    bf16x8 pf[NG];
#pragma unroll
    for (int gk = 0; gk < NG; ++gk) { u32x4 pw; pw.x = cvtpk(sc[2 * gk][0], sc[2 * gk][1]); pw.y = cvtpk(sc[2 * gk][2], sc[2 * gk][3]); pw.z = cvtpk(sc[2 * gk + 1][0], sc[2 * gk + 1][1]); pw.w = cvtpk(sc[2 * gk + 1][2], sc[2 * gk + 1][3]);
        pf[gk] = __builtin_bit_cast(bf16x8, pw); }
#pragma unroll
    for (int gk = 0; gk < NG; ++gk)
#pragma unroll
        for (int d = 0; d < 4; ++d) { u32x4 vw; vw.x = vf[d][gk][0].x; vw.y = vf[d][gk][0].y; vw.z = vf[d][gk][1].x; vw.w = vf[d][gk][1].y;
            o[d] = __builtin_amdgcn_mfma_f32_16x16x32_bf16(__builtin_bit_cast(bf16x8, vw), pf[gk], o[d], 0, 0, 0); }
}
__device__ __forceinline__ void attn_phase(const Ctx& F0, const Args& a) {
    const Ctx F = fresh(F0);
    const bf16_t* QK = (const bf16_t*)(a.ws + WS_QK);
    const bf16_t* VT = (const bf16_t*)(a.ws + WS_VT);
    unsigned char* AO = a.ws + WS_HX + 36 * MiB;
    const float* rpb = a.in[10];
    LAS float* bias = (LAS float*)F.lds;
    const int tid = F.tid, lane = F.lane, q16 = lane & 15, g4 = lane >> 4;
    const int rr = F.wave >> 2, jt = F.wave & 3;
    const int qc = 16 * jt + q16, cs = min(max(qc - 8, 0), 48), ksj = min(max(16 * jt - 8, 0), 32);
    int relidx[8];
#pragma unroll
    for (int k = 0; k < 8; ++k) { const int kc = ksj + 16 * (k >> 2) + 4 * g4 + (k & 3); relidx[k] = (kc >= cs && kc < cs + 16) ? (kc - qc + 15) : 31; }
    const int krow = tid >> 3, kch = tid & 7, vrow = tid >> 4, vch = tid & 15;
    const unsigned lds_k = (unsigned)(krow * ATT_ROWB + kch * 16), lds_v = (unsigned)(vrow * ATT_VROWB + vch * 16);
    const int nunits = NB * 16 * 16, upb = (nunits + F.G - 1) / F.G;
    int cur_bh = -1;
    for (int k = 0; k < upb; ++k) {
        const int id = F.vcu * upb + k; if (id >= nunits) break;
        const int p = id & 15, bh = id >> 4, b = bh >> 4, h = bh & 15;
        if (bh != cur_bh) {
            __syncthreads();
            for (int i = tid; i < 16 * 32; i += 512) { const int dr = i >> 5, dc = i & 31; bias[i] = (dc < 31 && dr < 15) ? rpb[(h * 15 + dr) * 31 + dc] * LOG2E : -1e30f; }
            cur_bh = bh;
        }
        const int r0 = 4 * p, rs0 = min(max(r0 - 4, 0), 56), rs1 = min(max(r0 + 3 - 4, 0), 56);
        const int nlat = rs1 + 8 - rs0, nlt = (nlat + 1) >> 1, nsteps = nlt + 2;
        const int rA = r0 + rr, rB = r0 + 2 + rr, rsA = min(max(rA - 4, 0), 56), rsB = min(max(rB - 4, 0), 56);
        const long tokqA = (long)b * SEQ + rA * GW + qc, tokqB = (long)b * SEQ + rB * GW + qc;
        const bf16_t* kbase = QK + 1024 + h * 64 + kch * 8;
        const bf16_t* vbase = VT + (long)(h * 64 + vrow) * MT + (vch & 7) * 8;
#define ATT_TOKA(step) ((step) < nlt ? ((long)b * SEQ + (long)(rs0 + 2 * (step)) * GW) : ((long)ML + b * CTXL + ((step) - nlt) * 128))
#define ATT_TOKB(step) ((step) < nlt ? ((long)b * SEQ + (long)min(rs0 + 2 * (step) + 1, rs0 + nlat - 1) * GW) : ((long)ML + b * CTXL + ((step) - nlt) * 128 + 64))
        u32x4 kA[2], vA[2];
#define ATT_LOAD(step, kr_, vr_) do { const int st_ = (step) < nsteps ? (step) : nsteps - 1; const long ta_ = ATT_TOKA(st_), tb_ = ATT_TOKB(st_);     \
        kr_[0] = *(const u32x4*)(kbase + (ta_ + krow) * 2048); kr_[1] = *(const u32x4*)(kbase + (tb_ + krow) * 2048); \
        const long tv_ = (vch < 8) ? ta_ : tb_; vr_[0] = *(const u32x4*)(vbase + tv_); vr_[1] = *(const u32x4*)(vbase + (long)32 * MT + tv_); } while (0)
#define ATT_WRITE(buf, kr_, vr_) do { *(LAS u32x4*)(F.lds + ATT_K0 + (buf) * ATT_KTILEB + lds_k) = kr_[0]; *(LAS u32x4*)(F.lds + ATT_K0 + (buf) * ATT_KTILEB + 64 * ATT_ROWB + lds_k) = kr_[1]; \
        *(LAS u32x4*)(F.lds + ATT_V0 + (buf) * ATT_VTILEB + lds_v) = vr_[0]; *(LAS u32x4*)(F.lds + ATT_V0 + (buf) * ATT_VTILEB + 32 * ATT_VROWB + lds_v) = vr_[1]; } while (0)
        ATT_LOAD(0, kA, vA);
        f32x4 tcv0[4];
        const int tci0 = id * 512 + tid;
        tc_issue(a, tci0, tcv0);
        bf16x8 qfA[2], qfB[2];
#pragma unroll
        for (int ks = 0; ks < 2; ++ks) { qfA[ks] = *(const bf16x8*)(QK + tokqA * 2048 + h * 64 + 32 * ks + 8 * g4); qfB[ks] = *(const bf16x8*)(QK + tokqB * 2048 + h * 64 + 32 * ks + 8 * g4); }
        float mA = 0.f, lA = 0.f, mB = 0.f, lB = 0.f;
        f32x4 oA[4], oB[4];
#pragma unroll
        for (int d = 0; d < 4; ++d) { oA[d] = (f32x4){0.f, 0.f, 0.f, 0.f}; oB[d] = (f32x4){0.f, 0.f, 0.f, 0.f}; }
        __syncthreads();
        ATT_WRITE(0, kA, vA);
        ATT_LOAD(1, kA, vA);
        asm volatile("" :: "v"(qfA[0]), "v"(qfA[1]), "v"(qfB[0]), "v"(qfB[1]));
        __syncthreads();
#define ATT_COMPUTE(step, cur) do { \
            const LAS unsigned char* Kt = F.lds + ATT_K0 + (cur) * ATT_KTILEB; \
            const LAS unsigned char* Vt_ = F.lds + ATT_V0 + (cur) * ATT_VTILEB; \
            unsigned kt2_ = (unsigned)(size_t)Kt, vt2_ = (unsigned)(size_t)Vt_; asm volatile("" : "+v"(kt2_), "+v"(vt2_));     \
            const LAS unsigned char* KtB = (const LAS unsigned char*)(size_t)kt2_; const LAS unsigned char* VtB = (const LAS unsigned char*)(size_t)vt2_; \
            if ((step) < nlt) { const int kra = rs0 + 2 * (step), krb = kra + 1; const bool vb_ = krb < rs0 + nlat; \
                { const bool a0 = kra >= rsA && kra < rsA + 8, a1 = vb_ && krb >= rsA && krb < rsA + 8; \
                  if (a0 || a1) attn_sub<1, true>(Kt, Vt_, ksj, bias + (a0 ? (kra - rA + 7) : 15) * 32, bias + (a1 ? (krb - rA + 7) : 15) * 32, relidx, qfA, mA, lA, oA, q16, g4); } \
                { const bool b0 = kra >= rsB && kra < rsB + 8, b1 = vb_ && krb >= rsB && krb < rsB + 8; \
                  if (b0 || b1) attn_sub<1, true>(KtB, VtB, ksj, bias + (b0 ? (kra - rB + 7) : 15) * 32, bias + (b1 ? (krb - rB + 7) : 15) * 32, relidx, qfB, mB, lB, oB, q16, g4); } \
            } else {                                                     \
                attn_sub<1, false>(Kt, Vt_, 0, bias, bias, relidx, qfA, mA, lA, oA, q16, g4); attn_sub<1, false>(Kt, Vt_, 32, bias, bias, relidx, qfA, mA, lA, oA, q16, g4); \
                attn_sub<1, false>(KtB, VtB, 0, bias, bias, relidx, qfB, mB, lB, oB, q16, g4); attn_sub<1, false>(KtB, VtB, 32, bias, bias, relidx, qfB, mB, lB, oB, q16, g4); } \
        } while (0)
        for (int step = 0; step < nsteps; step += 2) {
            ATT_COMPUTE(step, 0);
            if (step + 1 < nsteps) ATT_WRITE(1, kA, vA);
            ATT_LOAD(step + 2, kA, vA);
            __syncthreads();
            if (step + 1 < nsteps) { ATT_COMPUTE(step + 1, 1); }
            if (step + 2 < nsteps) ATT_WRITE(0, kA, vA);
            ATT_LOAD(step + 3, kA, vA);
            __syncthreads();
        }
#undef ATT_LOAD
#undef ATT_WRITE
#undef ATT_COMPUTE
#undef ATT_TOKA
#undef ATT_TOKB
        { int ti_ = id * 512 + tid; asm volatile("" : "+v"(ti_));
          tc_finish(a, ti_, tcv0); }
        lA += __shfl_xor(lA, 16); lA += __shfl_xor(lA, 32); lB += __shfl_xor(lB, 16); lB += __shfl_xor(lB, 32);
        { int tq_ = b * SEQ + rA * GW + qc; asm volatile("" : "+v"(tq_));
          unsigned char* op = AO + (long)tq_ * DM + h * 64 + 4 * g4; const float ls = pg8::ACT8_SCALE / lA;
#pragma unroll
          for (int d = 0; d < 4; ++d) *(unsigned*)(op + 16 * d) = fp8_pack4(oA[d][0] * ls, oA[d][1] * ls, oA[d][2] * ls, oA[d][3] * ls); }
        { int tq_ = b * SEQ + rB * GW + qc; asm volatile("" : "+v"(tq_));
          unsigned char* op = AO + (long)tq_ * DM + h * 64 + 4 * g4; const float ls = pg8::ACT8_SCALE / lB;
#pragma unroll
          for (int d = 0; d < 4; ++d) *(unsigned*)(op + 16 * d) = fp8_pack4(oB[d][0] * ls, oB[d][1] * ls, oB[d][2] * ls, oB[d][3] * ls); }
    }
    __syncthreads();
}

__device__ __forceinline__ void ce_desc(float& a, float& b) { const float hi = fmaxf(a, b), lo = fminf(a, b); a = hi; b = lo; }
__device__ __forceinline__ void ce_dir(float& a, float& b, bool desc) { const float hi = fmaxf(a, b), lo = fminf(a, b); a = desc ? hi : lo; b = desc ? lo : hi; }
__device__ __forceinline__ void sort16_desc(float (&v)[16]) {
#define S16CE(i, j) { const float hi_ = fmaxf(v[i], v[j]), lo_ = fminf(v[i], v[j]); v[i] = hi_; v[j] = lo_; }
    S16CE(0,13) S16CE(1,12) S16CE(2,15) S16CE(3,14) S16CE(4,8) S16CE(5,6) S16CE(7,11) S16CE(9,10)
    S16CE(0,5) S16CE(1,7) S16CE(2,9) S16CE(3,4) S16CE(6,13) S16CE(8,14) S16CE(10,15) S16CE(11,12)
    S16CE(0,1) S16CE(2,3) S16CE(4,5) S16CE(6,8) S16CE(7,9) S16CE(10,11) S16CE(12,13) S16CE(14,15)
    S16CE(0,2) S16CE(1,3) S16CE(4,10) S16CE(5,11) S16CE(6,7) S16CE(8,9) S16CE(12,14) S16CE(13,15)
    S16CE(1,2) S16CE(3,12) S16CE(4,6) S16CE(5,7) S16CE(8,10) S16CE(9,11) S16CE(13,14)
    S16CE(1,4) S16CE(2,6) S16CE(5,8) S16CE(7,10) S16CE(9,13) S16CE(11,14)
    S16CE(2,4) S16CE(3,6) S16CE(9,12) S16CE(11,13)
    S16CE(3,5) S16CE(6,8) S16CE(7,9) S16CE(10,12)
    S16CE(3,4) S16CE(5,6) S16CE(7,8) S16CE(9,10) S16CE(11,12)
    S16CE(6,7) S16CE(8,9)
#undef S16CE
}
__device__ __forceinline__ void merge16_desc(float (&a)[16], const float (&b)[16]) {
#pragma unroll
    for (int i = 0; i < 16; ++i) a[i] = fmaxf(a[i], b[15 - i]);
#pragma unroll
    for (int j = 8; j > 0; j >>= 1)
#pragma unroll
        for (int i = 0; i < 16; ++i) { const int l = i ^ j; if (l > i) ce_desc(a[i], a[l]); }
}

struct CandTab { int i[64]; int j[64]; };
__host__ __device__ constexpr CandTab make_cand_tab() {
    CandTab t{}; int n = 0;
    for (int i = 0; i < 16; ++i) for (int j = 0; j < 16; ++j) if ((i + 1) * (j + 1) <= 16) { t.i[n] = i; t.j[n] = j; ++n; }
    for (; n < 64; ++n) { t.i[n] = -1; t.j[n] = -1; }
    return t;
}

__device__ __forceinline__ void peer_topk_phase(const Ctx& F0, const Args& a, int layer) {
    const Ctx F = fresh(F0);
    const bf16_t* QP = (const bf16_t*)(a.ws + WS_QK);
    const bf16_t* SK = (const bf16_t*)(a.ws + WS_SK) + (size_t)layer * 2 * 128 * 128;
    unsigned short* IDX = (unsigned short*)(a.ws + WS_IDX);
    float* GATE = (float*)(a.ws + WS_GATE);
    const int gwv = F.vcu * NWAVES + F.wave, NGW = F.G * NWAVES;
    const int lane = F.lane, t32 = lane & 31, hi = lane >> 5;
    __syncthreads();
    for (int c = F.tid; c < 4096; c += 512) *(LAS u32x4*)(F.lds + (c >> 4) * 272 + (c & 15) * 16) = *(const u32x4*)(SK + (size_t)c * 8);
    __syncthreads();
#define TK_LDQ(dst, task_, p_) do { const int tk_ = (task_) < 1024 * 8 ? (task_) : 1024 * 8 - 1; const bf16_t* qp_ = QP + ((long)(tk_ >> 3) * 32 + t32) * 2048 + (tk_ & 7) * 256 + (p_) * 128 + hi * 8; \
        _Pragma("unroll") for (int ks = 0; ks < 8; ++ks) dst[ks] = *(const bf16x8*)(qp_ + ks * 16); } while (0)
    bf16x8 qn[8];
    TK_LDQ(qn, gwv, 0);
    for (int task = gwv; task < 1024 * 8; task += NGW) {
        const int tt = task >> 3, h = task & 7;
        const long tok = (long)tt * 32 + t32;
        float top[2][16];
#pragma unroll
        for (int p = 0; p < 2; ++p) {
            bf16x8 qc[8];
#pragma unroll
            for (int ks = 0; ks < 8; ++ks) qc[ks] = qn[ks];
            if (p == 0) TK_LDQ(qn, task, 1); else TK_LDQ(qn, task + NGW, 0);
            f32x16 acc[4];
#pragma unroll
            for (int eb = 0; eb < 4; ++eb)
#pragma unroll
                for (int i = 0; i < 16; ++i) acc[eb][i] = 0.f;
#pragma unroll
            for (int eb = 0; eb < 4; ++eb) asm volatile("" : "+v"(acc[eb]));
            const LAS unsigned char* kp = F.lds + (p * 128 + t32) * 272 + hi * 16;
#pragma unroll
            for (int ks = 0; ks < 8; ++ks) {
                if ((ks & 1) == 0) asm volatile("" ::: "memory");
                const bf16x8 bq = qc[ks];
#pragma unroll
                for (int eb = 0; eb < 4; ++eb) { const bf16x8 ak = *(const LAS bf16x8*)(kp + eb * 32 * 272 + ks * 32); acc[eb] = __builtin_amdgcn_mfma_f32_32x32x16_bf16(ak, bq, acc[eb], 0, 0, 0); }
            }
            float cur[16];
#pragma unroll
            for (int eb = 0; eb < 4; ++eb) {
                float v[16];
#pragma unroll
                for (int i = 0; i < 16; ++i) { const unsigned e = 32 * eb + crow(i, hi); float x = acc[eb][i]; asm volatile("" : "+v"(x));
                    v[i] = __builtin_bit_cast(float, (__builtin_bit_cast(unsigned, x) & ~0x7Fu) | e); }
                sort16_desc(v);
                if (eb == 0) {
#pragma unroll
                    for (int i = 0; i < 16; ++i) cur[i] = v[i];
                } else merge16_desc(cur, v);
            }
            float oth[16];
#pragma unroll
            for (int i = 0; i < 16; ++i) oth[i] = __shfl_xor(cur[i], 32);
            merge16_desc(cur, oth);
#pragma unroll
            for (int i = 0; i < 16; ++i) top[p][i] = cur[i];
            __builtin_amdgcn_sched_barrier(0);
        }
        float best[16];
#pragma unroll
        for (int gI = 0; gI < 4; ++gI) {
            float v[16];
#pragma unroll
            for (int q = 0; q < 16; ++q) {
                constexpr CandTab CT = make_cand_tab();
                const int ci = CT.i[16 * gI + q], cj = CT.j[16 * gI + q];
                if (ci >= 0) {
                    const unsigned ua = __builtin_bit_cast(unsigned, top[0][ci]), ub = __builtin_bit_cast(unsigned, top[1][cj]);
                    float s = top[0][ci] + top[1][cj]; asm volatile("" : "+v"(s));
                    const unsigned code = ((ua & 0x7Fu) << 7) | (ub & 0x7Fu);
                    v[q] = __builtin_bit_cast(float, (__builtin_bit_cast(unsigned, s) & ~0x3FFFu) | code);
                } else v[q] = -3.0e38f;
            }
            sort16_desc(v);
            if (gI == 0) {
#pragma unroll
                for (int i = 0; i < 16; ++i) best[i] = v[i];
            } else merge16_desc(best, v);
            __builtin_amdgcn_sched_barrier(0);
        }
        float e[16], sum = 0.f;
#pragma unroll
        for (int i = 0; i < 16; ++i) { e[i] = __builtin_amdgcn_exp2f((best[i] - best[0]) * LOG2E); sum += e[i]; }
        const float inv = 1.0f / sum;
        if (hi == 0) {
            u32x4 w0, w1;
            w0.x = (__builtin_bit_cast(unsigned, best[0]) & 0x3FFFu) | ((__builtin_bit_cast(unsigned, best[1]) & 0x3FFFu) << 16);
            w0.y = (__builtin_bit_cast(unsigned, best[2]) & 0x3FFFu) | ((__builtin_bit_cast(unsigned, best[3]) & 0x3FFFu) << 16);
            w0.z = (__builtin_bit_cast(unsigned, best[4]) & 0x3FFFu) | ((__builtin_bit_cast(unsigned, best[5]) & 0x3FFFu) << 16);
            w0.w = (__builtin_bit_cast(unsigned, best[6]) & 0x3FFFu) | ((__builtin_bit_cast(unsigned, best[7]) & 0x3FFFu) << 16);
            w1.x = (__builtin_bit_cast(unsigned, best[8]) & 0x3FFFu) | ((__builtin_bit_cast(unsigned, best[9]) & 0x3FFFu) << 16);
            w1.y = (__builtin_bit_cast(unsigned, best[10]) & 0x3FFFu) | ((__builtin_bit_cast(unsigned, best[11]) & 0x3FFFu) << 16);
            w1.z = (__builtin_bit_cast(unsigned, best[12]) & 0x3FFFu) | ((__builtin_bit_cast(unsigned, best[13]) & 0x3FFFu) << 16);
            w1.w = (__builtin_bit_cast(unsigned, best[14]) & 0x3FFFu) | ((__builtin_bit_cast(unsigned, best[15]) & 0x3FFFu) << 16);
            u32x4* ip = (u32x4*)(IDX + tok * 128 + h * 16);
            ip[0] = w0; ip[1] = w1;
        } else {
            f32x4* gp = (f32x4*)(GATE + tok * 128 + h * 16);
#pragma unroll
            for (int q = 0; q < 4; ++q) gp[q] = (f32x4){e[4 * q] * inv, e[4 * q + 1] * inv, e[4 * q + 2] * inv, e[4 * q + 3] * inv};
        }
    }
#undef TK_LDQ
    __syncthreads();
}

typedef long i64_t;
typedef unsigned u32x8_t __attribute__((ext_vector_type(8)));
typedef _Float16 h2_t __attribute__((ext_vector_type(2)));
#define U_MFMA4_FIRST(acc, av, bv) asm volatile("v_mfma_scale_f32_16x16x128_f8f6f4 %0, %1, %2, 0, %3, %4 op_sel_hi:[0,0,0] cbsz:4 blgp:4" : "=&v"(acc) : "v"(av), "v"(bv), "v"(sc_a), "v"(sc_one))
#define U_MFMA4(acc, av, bv) asm volatile("v_mfma_scale_f32_16x16x128_f8f6f4 %0, %1, %2, %0, %3, %4 op_sel_hi:[0,0,0] cbsz:4 blgp:4" : "+v"(acc) : "v"(av), "v"(bv), "v"(sc_a), "v"(sc_one))
template <int UVAR = 0>
__device__ __forceinline__ void peer_u_phase(const Ctx& F0, const Args& a, int layer) {
    const Ctx F = fresh(F0);
    const int s = (int)(blockIdx.x & 3), half = (int)((blockIdx.x >> 2) & 1), j = (int)(blockIdx.x >> 3), nmem = F.G >> 3;
    const unsigned char* U4s = a.ws + WS_TAB + (size_t)layer * TAB_LAYER + (size_t)s * NEXP * 128;
    const unsigned* XQ = (const unsigned*)(a.ws + WS_X8 + (size_t)s * ML * 256);
    const unsigned short* IDX = (const unsigned short*)(a.ws + WS_IDX);
    unsigned* PART = (unsigned*)(a.ws + WS_PART) + (size_t)s * ML * 64;
    const int lane = F.lane, rsub = lane >> 3, c8 = lane & 7, n16 = lane & 15, g4 = lane >> 4;
    LAS unsigned char* tile = F.lds + F.wave * 16384;
    constexpr float osc = 1.0f / (U_SCALE * XQ_SCALE);
    constexpr int MLH = ML / 2;
    const int t0 = half * MLH + j * NWAVES + F.wave, stride = nmem * NWAVES, ntok = (half * MLH + MLH - t0 + stride - 1) / stride;
    unsigned sc_one = 0x7f7f7f7fu; asm volatile("" : "+v"(sc_one));
    unsigned sc_a = (n16 & 1) ? 0x7d7d7d7du : 0x7f7f7f7fu; asm volatile("" : "+v"(sc_a));
    const int abase = (32 * (n16 & 1) + 4 * g4) * 4;
#define U_TOK(i) ((size_t)(t0 + ((i) < ntok ? (i) : ntok - 1) * stride))
    const unsigned wx0 = (unsigned)(size_t)(tile + rsub * 2048 + (c8 << 4));
    const unsigned rb0 = (unsigned)(size_t)(tile + n16 * 128 + ((g4 ^ ((n16 >> 1) & 7)) << 4));
    LAS unsigned char* stg = tile + g4 * 512 + n16 * 4;
#define U_LDXQ(i) (XQ[U_TOK(i) * 64 + lane])
#define U_LDI(i) (((const unsigned*)IDX)[U_TOK(i) * 64 + lane])
#define U_IDP(dst, ci) do { _Pragma("unroll") for (int k = 0; k < 8; ++k) dst[k] = (unsigned)__builtin_amdgcn_ds_bpermute((8 * rsub + k) * 4, (int)(ci)); } while (0)
#define U_EIDP(idp, i_) (((i_) & 1) ? (idp[(i_) >> 1] >> 16) : (idp[(i_) >> 1] & 0xffffu))
#define U_READS(nb0) do { \
        _Pragma("unroll") for (int nb = 0; nb < 4; ++nb) { _Pragma("unroll") for (int ks = 0; ks < 2; ++ks) \
            bw[nb][ks] = *(const LAS u32x4*)((LAS unsigned char*)(size_t)(rb0 ^ (64u * ks)) + 2048 * ((nb0) + nb)); } \
        __builtin_amdgcn_sched_barrier(0); \
    } while (0)
#define U_MFMAS() do { \
        _Pragma("unroll") for (int nb = 0; nb < 4; ++nb) U_MFMA4_FIRST(dA[nb], aop[0], bw[nb][0]); \
        _Pragma("unroll") for (int nb = 0; nb < 4; ++nb) U_MFMA4(dA[nb], aop[1], bw[nb][1]); \
        __builtin_amdgcn_sched_barrier(0); \
    } while (0)
#define U_OUTS(nb0) do { \
        asm volatile("s_nop 15\n\ts_nop 3" : "+v"(dA[0]), "+v"(dA[1]), "+v"(dA[2]), "+v"(dA[3]) :: "memory");     \
        _Pragma("unroll") for (int nb = 0; nb < 4; ++nb) { ov[(nb0) + nb] = dA[nb][0] + dA[nb][1]; asm volatile("" : "+v"(ov[(nb0) + nb])); } \
    } while (0)
#define U_BODY(j, CUR, NXT, LD) do { \
        unsigned idp[8]; \
        U_IDP(idp, ci##NXT);                                             \
          \
        _Pragma("unroll") for (int i_ = 0; i_ < 16; ++i_) { \
            *(LAS u32x4*)((LAS unsigned char*)(size_t)(wx0 ^ (unsigned)(((i_) >> 1) << 4)) + i_ * 128) = R[i_]; \
            if (UVAR == 0 || (UVAR == 1 && i_ < 8)) R[i_] = *(const u32x4*)(U4s + (unsigned)(U_EIDP(idp, i_) * 128 + 16 * c8)); \
        } \
          \
        u32x4 aop[2]; \
        _Pragma("unroll") for (int ks = 0; ks < 2; ++ks) { _Pragma("unroll") for (int k = 0; k < 4; ++k) { \
            const unsigned w_ = (unsigned)__builtin_amdgcn_ds_bpermute(abase + (16 * ks + k) * 4, (int)cx##CUR); \
            aop[ks][k] = (n16 < 2) ? w_ : 0u; } } \
        asm volatile("s_waitcnt lgkmcnt(0)" ::: "memory");               \
        f32x4 dA[4]; u32x4 bw[4][2]; float ov[8]; \
        U_READS(0); \
        U_MFMAS(); \
          \
        ci##CUR = U_LDI((j) + 3); cx##LD = U_LDXQ((j) + 2); \
        __builtin_amdgcn_sched_barrier(0); \
        U_READS(4);                                                      \
        U_OUTS(0); \
        U_MFMAS(); \
        U_OUTS(4); \
          \
        _Pragma("unroll") for (int nb = 0; nb < 8; ++nb) *(LAS float*)(stg + nb * 64) = ov[nb]; \
        asm volatile("s_waitcnt lgkmcnt(0)" ::: "memory"); \
        const f32x2 sum = *(const LAS f32x2*)(tile + 8 * lane); \
        asm volatile("s_waitcnt lgkmcnt(0)" ::: "memory"); \
        if ((j) < ntok) PART[U_TOK(j) * 64 + lane] = cvtpk(sum.x * osc, sum.y * osc); \
    } while (0)
    u32x4 R[16];
    unsigned cxA, cxB, cxC, ciA, ciB, ciC;
    ciA = U_LDI(0);
    cxA = U_LDXQ(0); cxB = U_LDXQ(1);
    { unsigned idp0[8]; U_IDP(idp0, ciA);
#pragma unroll
      for (int i_ = 0; i_ < 16; ++i_) R[i_] = *(const u32x4*)(U4s + (unsigned)(U_EIDP(idp0, i_) * 128 + 16 * c8)); }
    ciB = U_LDI(1); ciC = U_LDI(2);
    cxC = 0u;
    asm volatile("" :: "v"(ciC));
    for (int i = 0; i < ntok; i += 3) {
        U_BODY(i, A, B, C);
        U_BODY(i + 1, B, C, A);
        U_BODY(i + 2, C, A, B);
    }
#undef U_BODY
#undef U_READS
#undef U_MFMAS
#undef U_OUTS
#undef U_LDXQ
#undef U_LDI
#undef U_IDP
#undef U_EIDP
#undef U_TOK
}
#undef U_MFMA4_FIRST
#undef U_MFMA4
__device__ __forceinline__ void peer_w_phase(const Ctx& F0, const Args& a) {
    const Ctx F = fresh(F0);
    const unsigned* PART = (const unsigned*)(a.ws + WS_PART);
    const float* GATE = (const float*)(a.ws + WS_GATE);
    unsigned char* WQ = a.ws + WS_WT;
    float* WSC = (float*)(a.ws + WS_WSC);
    const int gwv = F.vcu * NWAVES + F.wave, NGW = F.G * NWAVES;
    unsigned pn[4]; f32x2 gn;
#define W_LD(t_) do { const int tt_ = (t_) < ML ? (t_) : ML - 1; _Pragma("unroll") for (int s = 0; s < 4; ++s) pn[s] = PART[((size_t)s * ML + tt_) * 64 + F.lane]; gn = *(const f32x2*)(GATE + (size_t)tt_ * 128 + 2 * F.lane); } while (0)
    W_LD(gwv);
    for (int t = gwv; t < ML; t += NGW) {
        f32x2 z = (f32x2){0.f, 0.f};
#pragma unroll
        for (int s = 0; s < 4; ++s) z += (f32x2){bflo(pn[s]), bfhi(pn[s])};
        const f32x2 g = gn;
        W_LD(t + NGW);
        f32x2 w; w.x = g.x * gelu_erf(z.x); w.y = g.y * gelu_erf(z.y);
        float wm = fmaxf(__builtin_fabsf(w.x), __builtin_fabsf(w.y));
#pragma unroll
        for (int o = 1; o < 64; o <<= 1) wm = fmaxf(wm, __shfl_xor(wm, o));
        wm = fmaxf(wm, 1e-20f);
        const float qs = 6.0f / wm, ax = fminf(fmaxf(w.x * qs, -6.f), 6.f), ay = fminf(fmaxf(w.y * qs, -6.f), 6.f);
        const unsigned ph = __builtin_amdgcn_cvt_scalef32_pk_fp4_f32(0u, ax, ay, 1.0f, 0) & 0xffu;
        const f32x2 dh = FP4_DEC(ph, 0);
        const unsigned pl = __builtin_amdgcn_cvt_scalef32_pk_fp4_f32(0u, fminf(fmaxf(4.f * (ax - dh.x), -6.f), 6.f), fminf(fmaxf(4.f * (ay - dh.y), -6.f), 6.f), 1.0f, 0) & 0xffu;
        ((unsigned short*)WQ)[(size_t)t * 128 + F.lane] = (unsigned short)((ph & 0xfu) | ((ph & 0xf0u) << 4));
        ((unsigned short*)WQ)[(size_t)t * 128 + 64 + F.lane] = (unsigned short)((pl & 0xfu) | ((pl & 0xf0u) << 4));
        if (F.lane == 0) WSC[t] = wm * (1.0f / 6.0f);
    }
#undef W_LD
}
#define V_MFMA4_FIRST(acc, av, bv, sa) asm volatile("v_mfma_scale_f32_16x16x128_f8f6f4 %0, %1, %2, 0, %3, %4 op_sel_hi:[0,0,0] cbsz:4 blgp:4" : "=&v"(acc) : "v"(av), "v"(bv), "v"(sa), "v"(sc_one))
#define V_MFMA4(acc, av, bv, sa) asm volatile("v_mfma_scale_f32_16x16x128_f8f6f4 %0, %1, %2, %0, %3, %4 op_sel_hi:[0,0,0] cbsz:4 blgp:4" : "+v"(acc) : "v"(av), "v"(bv), "v"(sa), "v"(sc_one))
template <int VAR = 0>
__device__ __forceinline__ void peer_v_phase(const Ctx& F0, const Args& a, int layer, float oscale = 1.0f) {
    const Ctx F = fresh(F0);
    const int s = (int)(blockIdx.x & 3), half = (int)((blockIdx.x >> 2) & 1), j = (int)(blockIdx.x >> 3), nmem = F.G >> 3;
    const unsigned char* V4s = a.ws + WS_TAB + (size_t)layer * TAB_LAYER + TAB_VOFF + (size_t)s * NEXP * 128;
    const unsigned short* IDX = (const unsigned short*)(a.ws + WS_IDX);
    const unsigned char* WQ = a.ws + WS_WT;
    const float* WSC = (const float*)(a.ws + WS_WSC);
    const float* modb = (const float*)(a.ws + WS_MOD) + (size_t)layer * 9 * NMOD;
    bf16_t* X = (bf16_t*)(a.ws + WS_XB);
    const int lane = F.lane, rsub = lane >> 3, c8 = lane & 7, n16 = lane & 15, g4 = lane >> 4;
    LAS unsigned char* tile = F.lds + F.wave * 16384;
    const float osc = ((DBG_SKIP & (layer == 0 ? 2 : 8)) ? 0.f : oscale) * (1.0f / V_SCALE);
    constexpr int MLH = ML / 2;
    const int t0 = half * MLH + j * NWAVES + F.wave, stride = nmem * NWAVES, ntok = (half * MLH + MLH - t0 + stride - 1) / stride;
    unsigned sc_one = 0x7f7f7f7fu; asm volatile("" : "+v"(sc_one));
    typedef int v2i_t __attribute__((ext_vector_type(2)));
    LAS float* gl = (LAS float*)(F.lds + RING_BYTES + 4096);
    for (int u = F.tid; u < 4 * 256; u += NWAVES * 64) gl[u] = modb[(size_t)(4 * half + (u >> 8)) * NMOD + 5 * DM + 256 * s + (u & 255)] * osc;
    __syncthreads();
#define V_TOK(i) ((size_t)(t0 + ((i) < ntok ? (i) : ntok - 1) * stride))
    LAS unsigned char* wx[4]; LAS unsigned char* rb[4];
#pragma unroll
    for (int k = 0; k < 4; ++k) wx[k] = tile + rsub * 2048 + ((c8 ^ k ^ ((rsub & 1) << 2)) << 4);
#pragma unroll
    for (int nb = 0; nb < 4; ++nb) rb[nb] = tile + g4 * 2048 + (n16 >> 1) * 128 + 8 * (n16 & 1) + ((nb ^ ((n16 >> 2) & 3) ^ ((g4 & 1) << 2)) << 4);
    LAS unsigned char* stg = tile + g4 * 1024 + n16 * 8;
#define V_LDW(i) (((const unsigned*)WQ)[V_TOK(i) * 64 + lane])
#define V_LDI(i) (((const unsigned*)IDX)[V_TOK(i) * 64 + lane])
#define V_LDX(i) (*(const u32x2*)(X + V_TOK(i) * DM + 256 * s + 4 * lane))
#define V_LDS(i) (WSC[V_TOK(i)])
#define V_IDP(dst, ci) do { _Pragma("unroll") for (int k = 0; k < 8; ++k) dst[k] = (unsigned)__builtin_amdgcn_ds_bpermute((8 * rsub + k) * 4, (int)(ci)); } while (0)
#define V_EIDP(idp, i_) (((i_) & 1) ? (idp[(i_) >> 1] >> 16) : (idp[(i_) >> 1] & 0xffffu))
#define V_READS(nb0) do { \
        unsigned x64 = (nb0) ? 64u : 0u; asm volatile("" : "+v"(x64));                   \
        _Pragma("unroll") for (int nb = 0; nb < 4; ++nb) { LAS unsigned char* rbn = (LAS unsigned char*)((unsigned)(size_t)rb[nb] ^ x64); \
          _Pragma("unroll") for (int h = 0; h < 2; ++h) { _Pragma("unroll") for (int q = 0; q < 2; ++q) { \
            const v2i_t tr = __builtin_amdgcn_ds_read_tr8_b64_v2i32((LAS v2i_t*)(rbn + 8192 * h + 1024 * q)); \
            bw[nb][h][2 * q] = (unsigned)tr[0]; bw[nb][h][2 * q + 1] = (unsigned)tr[1]; } } } \
        __builtin_amdgcn_sched_barrier(0); \
    } while (0)
#define V_MFMAS() do { \
        _Pragma("unroll") for (int nb = 0; nb < 4; ++nb) V_MFMA4_FIRST(dA[nb], aop[0], bw[nb][0], sc_a); \
        _Pragma("unroll") for (int nb = 0; nb < 4; ++nb) V_MFMA4(dA[nb], aop[1], bw[nb][1], sc_a); \
        __builtin_amdgcn_sched_barrier(0); \
    } while (0)
#define V_OUTS(nb0) do { \
        asm volatile("s_nop 15\n\ts_nop 3" : "+v"(dA[0]), "+v"(dA[1]), "+v"(dA[2]), "+v"(dA[3]) :: "memory");     \
        _Pragma("unroll") for (int nb = 0; nb < 4; ++nb) { ov[(nb0) + nb] = (f32x2){dA[nb][0] + dA[nb][2], dA[nb][1] + dA[nb][3]}; asm volatile("" : "+v"(ov[(nb0) + nb])); } \
    } while (0)
#define V_BODY(j, CUR, NXT, LD) do { \
        const size_t t_ = V_TOK(j); \
        unsigned idp[8]; \
        V_IDP(idp, ci##NXT);                                             \
          \
        _Pragma("unroll") for (int i_ = 0; i_ < 16; ++i_) { \
            *(LAS u32x4*)(wx[(i_ >> 1) & 3] + i_ * 128) = R[i_]; \
            if (VAR == 0 || (VAR == 1 && i_ < 8)) R[i_] = *(const u32x4*)(V4s + (unsigned)(V_EIDP(idp, i_) * 128 + 16 * c8)); \
        } \
          \
        u32x4 aop[2]; \
        _Pragma("unroll") for (int h = 0; h < 2; ++h) { _Pragma("unroll") for (int k = 0; k < 4; ++k) { \
            const unsigned w_ = (unsigned)__builtin_amdgcn_ds_bpermute(abase + (16 * h + k) * 4, (int)cw##CUR); \
            aop[h][k] = (n16 < 4) ? (w_ << ash) : 0u; } } \
        asm volatile("s_waitcnt lgkmcnt(0)" ::: "memory");               \
        f32x4 dA[4]; u32x4 bw[4][2]; f32x2 ov[8]; \
        V_READS(0); \
        V_MFMAS(); \
          \
        ci##CUR = V_LDI((j) + 3); cw##LD = V_LDW((j) + 2); xo##LD = V_LDX((j) + 2); ws##LD = V_LDS((j) + 2); \
        __builtin_amdgcn_sched_barrier(0); \
        V_READS(4);                                                      \
        V_OUTS(0); \
        V_MFMAS(); \
        V_OUTS(4); \
          \
        _Pragma("unroll") for (int nb = 0; nb < 8; ++nb) *(LAS f32x2*)(stg + nb * 128) = ov[nb]; \
        asm volatile("s_waitcnt lgkmcnt(0)" ::: "memory"); \
        const f32x4 sum = *(const LAS f32x4*)(tile + 16 * lane); \
        const f32x4 gt_ = *(const LAS f32x4*)(gl + ((t_ >> 12) & 3) * 256 + 4 * lane); \
        asm volatile("s_waitcnt lgkmcnt(0)" ::: "memory"); \
        if ((j) < ntok) { const f32x4 r_ = bf4_f32(xo##CUR) + gt_ * ws##CUR * sum; *(u32x2*)(X + t_ * DM + 256 * s + 4 * lane) = (u32x2){cvtpk(r_.x, r_.y), cvtpk(r_.z, r_.w)}; } \
    } while (0)
    u32x4 R[16];
    unsigned cwA, cwB, cwC, ciA, ciB, ciC;
    u32x2 xoA, xoB, xoC;
    float wsA, wsB, wsC;
    const int abase = (32 * ((n16 >> 1) & 1) + 4 * g4) * 4, ash = 4 * (n16 & 1);
    unsigned sc_a = (n16 & 2) ? 0x7d7d7d7du : 0x7f7f7f7fu; asm volatile("" : "+v"(sc_a));
    ciA = V_LDI(0);
    cwA = V_LDW(0); cwB = V_LDW(1); xoA = V_LDX(0); xoB = V_LDX(1); wsA = V_LDS(0); wsB = V_LDS(1);
    { unsigned idp0[8]; V_IDP(idp0, ciA);
#pragma unroll
      for (int i_ = 0; i_ < 16; ++i_) R[i_] = *(const u32x4*)(V4s + (unsigned)(V_EIDP(idp0, i_) * 128 + 16 * c8)); }
    ciB = V_LDI(1); ciC = V_LDI(2);
    cwC = 0u; xoC = (u32x2){0u, 0u}; wsC = 0.f;
    asm volatile("" :: "v"(ciC));
    for (int i = 0; i < ntok; i += 3) {
        V_BODY(i, A, B, C);
        V_BODY(i + 1, B, C, A);
        V_BODY(i + 2, C, A, B);
    }
#undef V_BODY
#undef V_READS
#undef V_MFMAS
#undef V_OUTS
#undef V_LDW
#undef V_LDI
#undef V_LDX
#undef V_LDS
#undef V_IDP
#undef V_EIDP
#undef V_TOK
}
#undef V_MFMA4_FIRST
#undef V_MFMA4

__device__ __forceinline__ void dft_nyquist_rows(const Ctx& F0, const Args& a) {
    const Ctx F = fresh(F0);
    const unsigned char* Yt = a.ws + WS_QK;
    const float* YN = (const float*)(a.ws + WS_YN);
    unsigned char* Fo = a.ws + WS_VT;
    const int gwv = F.vcu * NWAVES + F.wave, NGW = F.G * NWAVES;
    for (int o = gwv; o < NB * DM; o += NGW) {
        const unsigned char* src = Yt + (size_t)o * 4096;
        float s = 0.f;
#pragma unroll
        for (int it = 0; it < 2; ++it) { const u32x4 v = *(const u32x4*)(src + it * 1024 + F.lane * 16);
#pragma unroll
            for (int d = 0; d < 4; ++d) { const f32x2 lo = __builtin_amdgcn_cvt_pk_f32_fp8((int)v[d], false), hi = __builtin_amdgcn_cvt_pk_f32_fp8((int)v[d], true); s += (lo[0] - lo[1]) + (hi[0] - hi[1]); } }
        s = wave_sum(s) * (pg8::ACT8_SCALE / (64.0f * pg8::YT_SCALE)) + YN[o] * (pg8::ACT8_SCALE / 64.0f);
        if (F.lane == 0) Fo[((size_t)(o >> 10) * SEQ + 2048) * DM + (o & 1023)] = (unsigned char)(fp8_pack4(s, 0.f, 0.f, 0.f) & 0xffu);
    }
}
__device__ __forceinline__ void dft_yn_rows(const Ctx& F0, const Args& a) {
    const Ctx F = fresh(F0);
    const float* yi = (const float*)(a.ws + WS_YNI);
    const bf16_t* wc = (const bf16_t*)(a.ws + WS_WC);
    float* YN = (float*)(a.ws + WS_YN);
    const int gwv = F.vcu * NWAVES + F.wave, NGW = F.G * NWAVES;
    for (int o = gwv; o < NB * DM; o += NGW) {
        const int cp = o & 255;
        const f32x4 x = *(const f32x4*)(yi + (size_t)(o & ~255) + 4 * F.lane);
        const u32x2 w = *(const u32x2*)(wc + (size_t)cp * 256 + 4 * F.lane);
        const f32x4 wf = bf4_f32(w);
        const float s = wave_sum(x.x * wf.x + x.y * wf.y + x.z * wf.z + x.w * wf.w);
        if (F.lane == 0) YN[o] = s;
    }
}

__global__ void __launch_bounds__(NWAVES * 64, 2) fwd_kernel(Args args) {
    extern __shared__ __attribute__((aligned(16))) unsigned char lds_raw[];
    Ctx F;
    F.lds = (LAS unsigned char*)lds_raw;
    F.tid = threadIdx.x; F.lane = F.tid & 63; F.wave = __builtin_amdgcn_readfirstlane(F.tid >> 6);
    F.G = gridDim.x; { const int bx = blockIdx.x; F.vcu = (F.G % 8 == 0) ? (bx % 8) * (F.G / 8) + bx / 8 : bx; }
    volatile LAS unsigned* MISC = (volatile LAS unsigned*)(F.lds + MISC_OFF);
    for (int u = F.tid; u < (LDS_BYTES - LDSCTL_OFF) / 4; u += NWAVES * 64) ((LAS unsigned*)(F.lds + LDSCTL_OFF))[u] = 0u;
    __syncthreads();
    unsigned char* ws = args.ws;
    XcdBarrier bar = xcd_barrier_post((unsigned*)(ws + WS_CTL) + CW_BAR, MISC + 8);
#define GRID_BAR() xcd_barrier(bar)
#ifndef DBG_REP
#define DBG_REP 0
#endif
#ifndef DBG_VVAR
#define DBG_VVAR 0
#endif
#define REP(k, ...) do { __VA_ARGS__; if (DBG_REP == (k)) { GRID_BAR(); __VA_ARGS__; } } while (0)
#define PEER_BLOCK(layer) do { \
        norm_phase(F, args, 1, layer, 3 * DM, args.in[5] + (layer) * DM); \
        GRID_BAR(); \
        { using SHq = pg8::Shape<ML, 2048, DM / 2, DM / 2, DM / 2, 1, 0, 0>;       \
          REP(7, pg8::gemm_phase<SHq, pg8::EpiStoreBf16, true>(F.lds, pg8::Gemm{HX, (const bf16_t*)(ws + WS_WPQ) + (size_t)(layer) * 2048 * DM / 2}, F.G, bx, pg8::EpiStoreBf16{QKb, 2048, 0, 0, 1.0f, 1.0f / (pg8::ACT8_SCALE * pg8::W8_SCALE)})); } \
        GRID_BAR(); \
        REP(8, peer_topk_phase(F, args, layer)); \
        GRID_BAR(); \
        REP(9, peer_u_phase(F, args, layer)); \
        GRID_BAR(); \
        REP(10, peer_w_phase(F, args)); \
        GRID_BAR(); \
        peer_v_phase(F, args, layer); if (DBG_REP == 11) { GRID_BAR(); peer_v_phase<DBG_VVAR>(F, args, layer, 0.f); } \
        GRID_BAR(); \
    } while (0)
    const float* modb = (const float*)(ws + WS_MOD);
    bf16_t* HX = (bf16_t*)(ws + WS_HX);
    bf16_t* QKb = (bf16_t*)(ws + WS_QK);
    bf16_t* VTb = (bf16_t*)(ws + WS_VT);
    const bf16_t* Wqkv = (const bf16_t*)(ws + WS_WQKV);
    const int bx = (int)blockIdx.x;

    REP(1, p0_prologue(F, args));
    GRID_BAR();
    REP(2, norm_phase(F, args, 0, 0, 0, args.in[4]));
    GRID_BAR();
    {
        constexpr float o8 = 1.0f / (pg8::ACT8_SCALE * pg8::W8_SCALE);
        using SH1 = pg8::Shape<MT, 2048, DM / 2, DM / 2, DM / 2, 1, 0, 0>;
        pg8::gemm_phase<SH1, pg8::EpiStoreBf16, true>(F.lds, pg8::Gemm{HX, Wqkv}, F.G, bx, pg8::EpiStoreBf16{QKb, 2048, 0, 1024, 0.125f * LOG2E, o8});
        using SH2 = pg8::Shape<DM, MT, DM / 2, DM / 2, DM / 2, 1, 0, 0>;
        const int bxv = F.G - 1 - bx;
        pg8::gemm_phase<SH2, pg8::EpiStoreBf16, true>(F.lds, pg8::Gemm{Wqkv + (size_t)2048 * DM / 2, HX}, F.G, bxv, pg8::EpiStoreBf16{VTb, MT, 0, 0, 1.0f, o8});
        {
            const int nq = (MT / 256) * 8, nv = 4 * (MT / 256), rq = nq % F.G, rv = nv % F.G;
            const int sh_q = (rq == 0 || bx >= rq) ? 1 : 0, sh_v = (rv == 0 || bxv >= rv) ? 1 : 0;
            const int nq_sh = (rq == 0 ? F.G : F.G - rq);
            const int before_q = (rq == 0 ? bx : max(0, bx - rq)), before_v = nq_sh + ((rv == 0) ? bx : min(bx, F.G - rv));
            const int total = (rq == 0 ? F.G : F.G - rq) + (rv == 0 ? F.G : F.G - rv);
            if (sh_q) table_convert(F, args, before_q, 1, total);
            if (sh_v) table_convert(F, args, before_v, 1, total);
        }
    }
    GRID_BAR();
    REP(4, attn_phase(F, args));
    GRID_BAR();
    {
        using SH = pg8::Shape<ML, DM, DM / 2, DM / 2, DM / 2, 1, 0, 0>;
        pg8::gemm_phase<SH, pg8::EpiResid<false>, true>(F.lds, pg8::Gemm{(const bf16_t*)(ws + WS_HX + 36 * MiB), (const bf16_t*)(ws + WS_WO)}, F.G, bx, pg8::EpiResid<false>{args.in[0], (bf16_t*)(ws + WS_XB), modb + 2 * DM, NMOD, ((DBG_SKIP & 1) ? 0.f : 1.f) / (pg8::ACT8_SCALE * pg8::W8_SCALE)});
    }
    GRID_BAR();
    PEER_BLOCK(0);
    norm_fold_phase(F, args, 1, args.in[4] + DM);
    GRID_BAR();
    {
        using SH = pg8::Shape<256, ML / 2, 256, 256, DM, 4, 0, 256>;
        pg8::gemm_phase<SH>(F.lds, pg8::Gemm{(const bf16_t*)(ws + WS_WC), HX}, F.G, bx, pg8::EpiYt{(unsigned char*)QKb, 0});
        pg8::gemm_phase<SH>(F.lds, pg8::Gemm{(const bf16_t*)(ws + WS_WC) + 256 * 256, (const bf16_t*)(ws + WS_HX + 32 * MiB)}, F.G, bx, pg8::EpiYt{(unsigned char*)QKb, 1});
        dft_yn_rows(F, args);
    }
    GRID_BAR();
    {
        using SH = pg8::Shape<SEQ / 2, DM, 2048, 2048, 2048, NB, 0, (long)DM * 2048>;
        REP(14, pg8::gemm_phase<SH, pg8::EpiDft2, true>(F.lds, pg8::Gemm{(const bf16_t*)(ws + WS_CS), QKb}, F.G, bx, pg8::EpiDft2{(unsigned char*)VTb, (const float*)(ws + WS_YN)}));
        dft_nyquist_rows(F, args);
    }
    GRID_BAR();
    {
        using SH = pg8::Shape<ML, DM, DM / 2, DM / 2, DM / 2, 1, 0, 0>;
        pg8::gemm_phase<SH, pg8::EpiResid<true>, true>(F.lds, pg8::Gemm{VTb, (const bf16_t*)(ws + WS_WF)}, F.G, bx, pg8::EpiResid<true>{ws + WS_XB, (bf16_t*)(ws + WS_XB), modb + (size_t)9 * NMOD + 2 * DM, NMOD, ((DBG_SKIP & 4) ? 0.f : 1.f) / (pg8::ACT8_SCALE * pg8::W8_SCALE)});
    }
    GRID_BAR();
    PEER_BLOCK(1);
    if (DBG_REP == 20) { for (int r = 0; r < 16; ++r) GRID_BAR(); }
    final_norm_phase(F, args);
#undef PEER_BLOCK
}

extern "C" void kernel_launch(void* const* d_in, const int* in_sizes, int n_in, void* d_out, int out_size, void* d_ws, size_t ws_size, hipStream_t stream) {
    static int grid = 0;
    if (grid == 0) {
        if (n_in != 17 || in_sizes[0] != ML * DM || out_size != ML * DM || ws_size < WS_END) { fprintf(stderr, "kernel_launch: unexpected shapes (n_in %d, in0 %d, out %d, ws %zu)\n", n_in, n_in > 0 ? in_sizes[0] : -1, out_size, ws_size); grid = -1; return; }
        int dev = 0, cus = 0, per_cu = 0;
        if (hipGetDevice(&dev) != hipSuccess || hipDeviceGetAttribute(&cus, hipDeviceAttributeMultiprocessorCount, dev) != hipSuccess) { grid = -1; return; }
        if (hipFuncSetAttribute((const void*)fwd_kernel, hipFuncAttributeMaxDynamicSharedMemorySize, LDS_BYTES) != hipSuccess) { fprintf(stderr, "kernel_launch: hipFuncSetAttribute failed\n"); grid = -1; return; }
        if (hipOccupancyMaxActiveBlocksPerMultiprocessor(&per_cu, (const void*)fwd_kernel, NWAVES * 64, LDS_BYTES) != hipSuccess || per_cu < 1)
            fprintf(stderr, "kernel_launch: note: occupancy query reports %d workgroups per CU\n", per_cu);
        (void)hipGetLastError();
        grid = cus;
        if (grid % 8 != 0) { fprintf(stderr, "kernel_launch: CU count %d is not a multiple of 8\n", cus); grid = -1; return; }
    }
    if (grid < 0) return;
    if (hipMemsetAsync((char*)d_ws + WS_CTL, 0, CTL_ZERO_BYTES, stream) != hipSuccess) { fprintf(stderr, "kernel_launch: memset failed\n"); return; }
    Args a{};
    for (int i = 0; i < 17; ++i) a.in[i] = (const float*)d_in[i];
    a.out = (float*)d_out; a.ws = (unsigned char*)d_ws;
    hipLaunchKernelGGL(fwd_kernel, dim3(grid), dim3(NWAVES * 64), LDS_BYTES, stream, a);
    const hipError_t le = hipPeekAtLastError();
    if (le != hipSuccess) fprintf(stderr, "kernel_launch: launch failed: %s\n", hipGetErrorName(le));
}
```

```cpp
#include <hip/hip_runtime.h>
#include <cstdio>
#include <cstdint>

#define LAS __attribute__((address_space(3)))
typedef unsigned short bf16_t;
typedef short bf16x8 __attribute__((ext_vector_type(8)));
typedef short s16x4 __attribute__((ext_vector_type(4)));
typedef float f32x2 __attribute__((ext_vector_type(2)));
typedef float f32x4 __attribute__((ext_vector_type(4)));
typedef float f32x16 __attribute__((ext_vector_type(16)));
typedef unsigned u32x2 __attribute__((ext_vector_type(2)));
typedef unsigned u32x4 __attribute__((ext_vector_type(4)));
typedef __bf16 bf16x2_t __attribute__((ext_vector_type(2)));

#ifndef DBG_SKIP
#define DBG_SKIP 0
#endif
constexpr int DM = 1024, NB = 8, SEQ = 4096, CTXL = 256, GW = 64;
constexpr int ML = NB * SEQ;
constexpr int MC = NB * CTXL;
constexpr int MT = ML + MC;
constexpr int NMOD = 6 * DM;
constexpr int NEXP = 16384;
constexpr float EPS = 1e-6f;
constexpr float LOG2E = 1.4426950408889634f;

constexpr size_t MiB = 1u << 20;
constexpr size_t WS_CTL = 0, CTL_ZERO_BYTES = 1 * MiB;
constexpr size_t WS_MOD = 1 * MiB;
constexpr size_t WS_WQKV = 2 * MiB;
constexpr size_t WS_WO = 8 * MiB;
constexpr size_t WS_WF = 10 * MiB;
constexpr size_t WS_WPQ = 12 * MiB;
constexpr size_t WS_SK = 20 * MiB;
constexpr size_t WS_WC = 20 * MiB + 256 * 1024;
constexpr size_t WS_CS = 22 * MiB;
constexpr size_t WS_TAB = 38 * MiB;
constexpr size_t WS_X8 = 150 * MiB;
constexpr size_t WS_WT = 182 * MiB;
constexpr size_t WS_PART = 282 * MiB;
constexpr float U_SCALE = 64.f;
constexpr float XQ_SCALE = 0.75f;
constexpr float V_SCALE = 2.f;
constexpr size_t WS_XB = 70 * MiB;
constexpr size_t TAB_LAYER = 16 * MiB, TAB_VOFF = 8 * MiB;
constexpr size_t WS_WSC = 198 * MiB;
constexpr size_t WS_YNI = 199 * MiB;
constexpr size_t WS_YN = WS_YNI + 64 * 1024;
constexpr size_t WS_HX = 214 * MiB;
constexpr size_t WS_QK = 282 * MiB;
constexpr size_t WS_VT = 418 * MiB;
constexpr size_t WS_IDX = WS_VT;
constexpr size_t WS_GATE = WS_VT + 8 * MiB;
constexpr size_t WS_END = 486 * MiB;
constexpr int CW_BAR = 4096;

__device__ __forceinline__ unsigned f2bf(float f) { unsigned u = __builtin_bit_cast(unsigned, f); return (u + 0x7fffu + ((u >> 16) & 1u)) >> 16; }
__device__ __forceinline__ unsigned pk2(float lo, float hi) { return f2bf(lo) | (f2bf(hi) << 16); }
__device__ __forceinline__ f32x4 bf4_f32(u32x2 w) { return (f32x4){__builtin_bit_cast(float, w.x << 16), __builtin_bit_cast(float, w.x & 0xffff0000u), __builtin_bit_cast(float, w.y << 16), __builtin_bit_cast(float, w.y & 0xffff0000u)}; }
__device__ __forceinline__ unsigned cvtpk(float lo, float hi) { f32x2 v = {lo, hi}; bf16x2_t b = __builtin_convertvector(v, bf16x2_t); return __builtin_bit_cast(unsigned, b); }
__device__ __forceinline__ float bflo(unsigned u) { return __builtin_bit_cast(float, u << 16); }
__device__ __forceinline__ float bfhi(unsigned u) { return __builtin_bit_cast(float, u & 0xffff0000u); }
__device__ __forceinline__ float wave_sum(float v) {
#pragma unroll
    for (int o = 1; o < 64; o <<= 1) v += __shfl_xor(v, o);
    return v;
}
__device__ __forceinline__ unsigned fp8_pack4(float a, float b, float c, float d) {
    int w = 0;
    w = __builtin_amdgcn_cvt_pk_fp8_f32(__builtin_amdgcn_fmed3f(a, -448.f, 448.f), __builtin_amdgcn_fmed3f(b, -448.f, 448.f), w, false);
    w = __builtin_amdgcn_cvt_pk_fp8_f32(__builtin_amdgcn_fmed3f(c, -448.f, 448.f), __builtin_amdgcn_fmed3f(d, -448.f, 448.f), w, true);
    return (unsigned)w;
}
__device__ __forceinline__ int crow(int r, int hi) { return (r & 3) + 8 * (r >> 2) + 4 * hi; }
__device__ __forceinline__ float gelu_erf(float v) {
    const float av = __builtin_fabsf(v), d = av * 0.2316418882f + 1.0f;
    const float t = __builtin_amdgcn_rcpf(d);
    float q = t * 0.5307027145f + (-0.7265760135f); q = q * t + 0.7107068705f; q = q * t + (-0.142248368f); q = q * t + 0.127414796f; q = q * t;
    const float e = __builtin_amdgcn_exp2f((v * v) * (-0.72134752044f));
    const float m = v * (q * e), r = v - m;
    return v < 0.f ? m : r;
}

namespace pg8 {
constexpr float ACT8_SCALE = 16.f, W8_SCALE = 256.f;
constexpr float YT_SCALE = 16.f, CS_SCALE = 512.f;
constexpr int BM = 256, BK = 64, HALF = 128, HTB = HALF * BK * 2, STAGE_BYTES = 8 * HTB, NXCD = 8, WGM = 8;
__host__ __device__ __forceinline__ int lds_byte(int r, int c) { const int st = (r >> 4) * 2 + (c >> 5), rr = r & 15, cc = c & 31, ob = rr * 64 + cc * 2; return st * 1024 + (ob ^ (((ob >> 9) & 1) << 5)); }
__host__ __device__ __forceinline__ void stage_rc(int b, int& R, int& C) { const int st = b / 1024, sb = b % 1024, swz = sb ^ (((sb >> 9) & 1) << 5); R = (st >> 1) * 16 + swz / 64; C = (st & 1) * 32 + (swz % 64) / 2; }
__host__ __device__ __forceinline__ int perm32(int rho) { const int n = rho >> 4, i = rho & 15; return 8 * (i >> 2) + 4 * n + (i & 3); }

struct Unit { int pm, pn, pb; };
struct Gemm { const bf16_t* A; const bf16_t* Bt; };
template <int M_, int N_, int K_, int LDA_, int LDB_, int NBATCH_, long BSA_, long BSB_> struct Shape { static constexpr int M = M_, N = N_, K = K_, lda = LDA_, ldb = LDB_, nbatch = NBATCH_; static constexpr long bsA = BSA_, bsB = BSB_; };

template <class SH> struct StaticOrder {
    static constexpr int nM = SH::M / BM, nN = SH::N / BM, per = nM * nN, nwg = per * SH::nbatch;
    int G, c;
    __device__ __forceinline__ void init(int G_, int c_) { G = G_; c = c_; }
    __device__ __forceinline__ bool next(int i, Unit& u) const {
        const long L = (long)i * G + c; if (L >= nwg) return false;
        int wgid = (int)L; { const int q = nwg / NXCD, r = nwg % NXCD, xcd = wgid % NXCD, off = wgid / NXCD; wgid = (xcd < r ? xcd * (q + 1) : r * (q + 1) + (xcd - r) * q) + off; }
        u.pb = wgid / per; wgid -= u.pb * per;
        const int nig = WGM * nN, gid = wgid / nig, fm = gid * WGM, gsz = (nM - fm) < WGM ? (nM - fm) : WGM;
        u.pm = fm + ((wgid % nig) % gsz); u.pn = (wgid % nig) / gsz; return true;
    }
};

struct EpiStoreBf16 {
    static constexpr bool PERM = true;
    bf16_t* O; long ldc; long bstride; int scols; float scale0; float oscale = 1.0f;
    __device__ __forceinline__ void operator()(const f32x4 (&acc)[2][2][4][2], const Unit& u, int wr, int wc, int fr, int fq) const {
        const int row0 = u.pm * BM + wr * 64 + fr, col0 = u.pn * BM + wc * 32 + 8 * fq;
        bf16_t* base = O + (long)u.pb * bstride;
        const float sc = ((u.pn * BM < scols) ? scale0 : 1.0f) * oscale;
#pragma unroll
        for (int ai = 0; ai < 2; ++ai)
#pragma unroll
            for (int m = 0; m < 4; ++m) { bf16_t* rowp = base + (long)(row0 + ai * HALF + m * 16) * ldc + col0;
#pragma unroll
                for (int bj = 0; bj < 2; ++bj) { const f32x4 v0 = acc[ai][bj][m][0] * sc, v1 = acc[ai][bj][m][1] * sc;
                    u32x4 w; w.x = cvtpk(v0[0], v0[1]); w.y = cvtpk(v0[2], v0[3]); w.z = cvtpk(v1[0], v1[1]); w.w = cvtpk(v1[2], v1[3]);
                    *(u32x4*)(rowp + bj * HALF) = w; } }
    }
};
struct EpiDft2 {
    static constexpr bool PERM = true;
    unsigned char* O; const float* yn;
    __device__ __forceinline__ void operator()(const f32x4 (&acc)[2][2][4][2], const Unit& u, int wr, int wc, int fr, int fq) const {
        const int row0 = u.pm * BM + wr * 64 + fr, cl0 = wc * 32 + 8 * fq;
        unsigned char* base = O + (long)u.pb * SEQ * DM + u.pn * BM;
        constexpr float osc = ACT8_SCALE / (YT_SCALE * CS_SCALE);
        f32x4 y0[2], y1[2];
#pragma unroll
        for (int bj = 0; bj < 2; ++bj) { const float* yp = yn + (long)u.pb * DM + u.pn * BM + cl0 + bj * HALF; y0[bj] = *(const f32x4*)yp * (ACT8_SCALE / 64.0f); y1[bj] = *(const f32x4*)(yp + 4) * (ACT8_SCALE / 64.0f); }
#pragma unroll
        for (int ai = 0; ai < 2; ++ai)
#pragma unroll
            for (int m = 0; m < 4; ++m) { const int np = row0 + ai * HALF + m * 16;
                unsigned char* rowp = base + (long)np * DM; unsigned char* mirp = base + (long)(SEQ - np) * DM;
#pragma unroll
                for (int bj = 0; bj < 2; ++bj) { const float sg = (np & 1) ? -1.0f : 1.0f; const f32x4 v0 = acc[ai][bj][m][0] * osc + y0[bj] * sg, v1 = acc[ai][bj][m][1] * osc + y1[bj] * sg; const int cl = cl0 + bj * HALF;
                    u32x2 w; w.x = fp8_pack4(v0[0], v0[1], v0[2], v0[3]); w.y = fp8_pack4(v1[0], v1[1], v1[2], v1[3]);
                    *(u32x2*)(rowp + cl) = w;
                    if (np != 0) {
#pragma unroll
                        for (int i = 0; i < 8; ++i) mirp[(256 - cl - i) & 255] = (unsigned char)((w[i >> 2] >> (8 * (i & 3))) & 0xffu); } }
                asm volatile("" ::: "memory"); }
    }
};
struct EpiYt {
    static constexpr bool PERM = true;
    unsigned char* Yt; int part;
    __device__ __forceinline__ void operator()(const f32x4 (&acc)[2][2][4][2], const Unit& u, int wr, int wc, int fr, int fq) const {
        const int row0 = u.pm * BM + wr * 64 + fr, col0 = u.pn * BM + wc * 32 + 8 * fq;
#pragma unroll
        for (int ai = 0; ai < 2; ++ai)
#pragma unroll
            for (int m = 0; m < 4; ++m) { const int cp = row0 + ai * HALF + m * 16;
#pragma unroll
                for (int bj = 0; bj < 2; ++bj) { const int col = col0 + bj * HALF; const int b = col >> 11, k = col & 2047;
                    const f32x4 v0 = acc[ai][bj][m][0] * YT_SCALE, v1 = acc[ai][bj][m][1] * YT_SCALE;
                    u32x2 w; w.x = fp8_pack4(v0[0], v0[1], v0[2], v0[3]); w.y = fp8_pack4(v1[0], v1[1], v1[2], v1[3]);
                    *(u32x2*)(Yt + (((long)(b * 4 + u.pb) * 256 + cp) << 12) + part * 2048 + k) = w; }
                asm volatile("" ::: "memory"); }
    }
};
template <bool IN_BF16>
struct EpiResid {
    static constexpr bool PERM = false;
    const void* Xin; bf16_t* Xout; const float* gate; int gstride; float gs;
    __device__ __forceinline__ void operator()(const f32x4 (&acc)[2][2][4][2], const Unit& u, int wr, int wc, int fr, int fq) const {
        const int row0 = u.pm * BM + wr * 64 + fr, col0 = u.pn * BM + wc * 32 + 4 * fq;
        const float* gb = gate + (long)((u.pm * BM) >> 12) * gstride;
        f32x4 gv[2][2];
#pragma unroll
        for (int bj = 0; bj < 2; ++bj)
#pragma unroll
            for (int n = 0; n < 2; ++n) gv[bj][n] = *(const f32x4*)(gb + col0 + bj * HALF + n * 16);
        f32x4 xf[2][8]; u32x2 xb[2][8];
#define ER_OFF(b_, k_) ((long)(row0 + ((b_) >> 1) * HALF + (2 * ((b_) & 1) + ((k_) >> 2)) * 16) * DM + col0 + (((k_) >> 1) & 1) * HALF + ((k_) & 1) * 16)
#define ER_LOAD(b_) do { _Pragma("unroll") for (int k_ = 0; k_ < 8; ++k_) { const long o_ = ER_OFF(b_, k_); \
            if (IN_BF16) xb[(b_) & 1][k_] = *(const u32x2*)((const bf16_t*)Xin + o_); else xf[(b_) & 1][k_] = *(const f32x4*)((const float*)Xin + o_); } } while (0)
        ER_LOAD(0);
#pragma unroll
        for (int b_ = 0; b_ < 4; ++b_) {
            if (b_ + 1 < 4) ER_LOAD(b_ + 1);
#pragma unroll
            for (int k_ = 0; k_ < 8; ++k_) { const long o_ = ER_OFF(b_, k_); const int ai = b_ >> 1, m = 2 * (b_ & 1) + (k_ >> 2), bj = (k_ >> 1) & 1, n = k_ & 1;
                const f32x4 bs = IN_BF16 ? bf4_f32(xb[b_ & 1][k_]) : xf[b_ & 1][k_];
                const f32x4 r_ = bs + gv[bj][n] * acc[ai][bj][m][n] * gs;
                *(u32x2*)(Xout + o_) = (u32x2){cvtpk(r_.x, r_.y), cvtpk(r_.z, r_.w)}; }
            asm volatile("" ::: "memory");
        }
#undef ER_OFF
#undef ER_LOAD
    }
};

template <class SH, class Epi, bool FP8 = false>
__device__ __forceinline__ void gemm_phase(LAS unsigned char* lds, const Gemm g, int G_, int c_, const Epi& E) {
    StaticOrder<SH> S; S.init(G_, c_);
    int tid_ = threadIdx.x; asm volatile("" : "+v"(tid_));
    const int tid = tid_, wid = __builtin_amdgcn_readfirstlane(tid >> 6), lane = tid & 63, wr = wid >> 2, wc = wid & 3, fr = lane & 15, fq = lane >> 4;
    constexpr int K = SH::K, nt = K / BK;
    unsigned voffA[2], voffB[2];
#pragma unroll
    for (int i = 0; i < 2; ++i) { int R, C; stage_rc(tid * 16 + i * 8192, R, C); const int Rb = Epi::PERM ? ((R & ~31) + perm32(R & 31)) : R;
        voffA[i] = (unsigned)(R * SH::lda + C) * 2u; voffB[i] = (unsigned)(Rb * SH::ldb + C) * 2u; }
    constexpr size_t kstep = (size_t)(BK * 2);
    constexpr size_t hstepA = (size_t)HALF * SH::lda * 2, hstepB = (size_t)HALF * SH::ldb * 2;
    constexpr size_t tstepA = 2 * hstepA, tstepB = 2 * hstepB;
    const unsigned ldsw = (unsigned)wid * 1024u;
    const int aoff = lds_byte(wr * 64 + fr, fq * 8), boff = lds_byte(wc * 32 + fr, fq * 8);
#define PG8_SA(b, h) (((b) * 2 + (h)) * HTB)
#define PG8_SB(b, h) ((4 + (b) * 2 + (h)) * HTB)
#define PG8_STAGE(bufoff, gbase, voff) do { _Pragma("unroll") for (int _i = 0; _i < 2; ++_i) \
        __builtin_amdgcn_global_load_lds((const unsigned*)((const char*)(gbase) + (voff)[_i]), (LAS unsigned*)(lds + (bufoff) + ldsw + _i * 8192), 16, 0, 0); } while (0)
#define PG8_LDA(dst, b, h) do { _Pragma("unroll") for (int m = 0; m < 4; ++m) { const u32x4 f0_ = *(const LAS u32x4*)(lds + PG8_SA(b, h) + aoff + m * 2048), f1_ = *(const LAS u32x4*)(lds + PG8_SA(b, h) + aoff + m * 2048 + 1024); dst[m] = __builtin_shufflevector(f0_, f1_, 0, 1, 2, 3, 4, 5, 6, 7); } } while (0)
#define PG8_LDB(dst, b, h) do { _Pragma("unroll") for (int n = 0; n < 2; ++n) { const u32x4 f0_ = *(const LAS u32x4*)(lds + PG8_SB(b, h) + boff + n * 2048), f1_ = *(const LAS u32x4*)(lds + PG8_SB(b, h) + boff + n * 2048 + 1024); dst[n] = __builtin_shufflevector(f0_, f1_, 0, 1, 2, 3, 4, 5, 6, 7); } } while (0)
typedef int v8i_t __attribute__((ext_vector_type(8)));
typedef unsigned u32x8 __attribute__((ext_vector_type(8)));
#define PG8_LOH(x) __builtin_bit_cast(bf16x8, __builtin_shufflevector(x, x, 0, 1, 2, 3))
#define PG8_HIH(x) __builtin_bit_cast(bf16x8, __builtin_shufflevector(x, x, 4, 5, 6, 7))
#define PG8_MMA(ai, bj, At, Bt) do { __builtin_amdgcn_s_setprio(1); _Pragma("unroll") for (int m = 0; m < 4; ++m) _Pragma("unroll") for (int n = 0; n < 2; ++n) { \
        if constexpr (FP8) asm volatile("v_mfma_scale_f32_16x16x128_f8f6f4 %0, %1, %2, %0, %3, %3 op_sel_hi:[0,0,0]" : "+v"(acc[ai][bj][m][n]) : "v"(Bt[n]), "v"(At[m]), "v"(fp8_one));   \
        else { acc[ai][bj][m][n] = __builtin_amdgcn_mfma_f32_16x16x32_bf16(PG8_LOH(Bt[n]), PG8_LOH(At[m]), acc[ai][bj][m][n], 0, 0, 0); \
               acc[ai][bj][m][n] = __builtin_amdgcn_mfma_f32_16x16x32_bf16(PG8_HIH(Bt[n]), PG8_HIH(At[m]), acc[ai][bj][m][n], 0, 0, 0); } } \
        __builtin_amdgcn_s_setprio(0); } while (0)
#define PG8_WAIT_V(n) asm volatile("s_waitcnt vmcnt(" #n ")" ::: "memory")
#define PG8_WAIT_L(n) asm volatile("s_waitcnt lgkmcnt(" #n ")" ::: "memory")
#define PG8_BAR __builtin_amdgcn_s_barrier()
#define PG8_SCHED __builtin_amdgcn_sched_barrier(0)
    Unit cur, nxt; int ui = 0;
    if (!S.next(0, cur)) return;
    f32x4 acc[2][2][4][2];
#pragma unroll
    for (int a = 0; a < 2; ++a)
#pragma unroll
        for (int b = 0; b < 2; ++b)
#pragma unroll
            for (int m = 0; m < 4; ++m)
#pragma unroll
                for (int n = 0; n < 2; ++n) acc[a][b][m][n] = (f32x4){0.f, 0.f, 0.f, 0.f};
    unsigned fp8_one = 0x7f7f7f7fu; asm volatile("" : "+v"(fp8_one));
    u32x8 At[4], B0[2], B1[2];
    const char* cA = (const char*)(g.A + (long)cur.pb * SH::bsA) + (size_t)cur.pm * tstepA; const char* cB = (const char*)(g.Bt + (long)cur.pb * SH::bsB) + (size_t)cur.pn * tstepB;
    PG8_STAGE(PG8_SB(0, 0), cB, voffB); PG8_STAGE(PG8_SB(0, 1), cB + hstepB, voffB); PG8_STAGE(PG8_SA(0, 0), cA, voffA); PG8_STAGE(PG8_SA(0, 1), cA + hstepA, voffA);
    if (wr == 1) PG8_BAR;
    PG8_WAIT_V(2); PG8_BAR;
    PG8_STAGE(PG8_SB(1, 0), cB + kstep, voffB); PG8_STAGE(PG8_SA(1, 0), cA + kstep, voffA); PG8_STAGE(PG8_SB(1, 1), cB + hstepB + kstep, voffB);
    PG8_WAIT_V(6); PG8_BAR;
    for (;;) {
        const bool has_next = S.next(ui + 1, nxt);
        const char* nA = has_next ? (const char*)(g.A + (long)nxt.pb * SH::bsA) + (size_t)nxt.pm * tstepA : cA; const char* nB = has_next ? (const char*)(g.Bt + (long)nxt.pb * SH::bsB) + (size_t)nxt.pn * tstepB : cB;
#pragma nounroll
        for (int t = 0; t < nt; t += 2) {
            const bool last = (t == nt - 2);
            const char* a1 = cA + (size_t)(t + 1) * kstep;
            const char* a2 = last ? nA : cA + (size_t)(t + 2) * kstep; const char* b2 = last ? nB : cB + (size_t)(t + 2) * kstep;
            const char* a3 = a2 + kstep; const char* b3 = b2 + kstep;
            PG8_LDB(B0, 0, 0); PG8_LDB(B1, 0, 1); PG8_SCHED; PG8_LDA(At, 0, 0); PG8_STAGE(PG8_SA(1, 1), a1 + hstepA, voffA);
            PG8_WAIT_V(8); PG8_WAIT_L(0); PG8_BAR; PG8_MMA(0, 0, At, B0); PG8_MMA(0, 1, At, B1); PG8_BAR; PG8_SCHED;
            PG8_LDA(At, 0, 1); PG8_STAGE(PG8_SB(0, 0), b2, voffB); PG8_STAGE(PG8_SB(0, 1), b2 + hstepB, voffB); PG8_STAGE(PG8_SA(0, 0), a2, voffA);
            PG8_WAIT_V(8); PG8_WAIT_L(0); PG8_BAR; PG8_MMA(1, 0, At, B0); PG8_MMA(1, 1, At, B1); PG8_BAR; PG8_SCHED;
            PG8_LDB(B0, 1, 0); PG8_LDB(B1, 1, 1); PG8_SCHED; PG8_LDA(At, 1, 0); PG8_STAGE(PG8_SA(0, 1), a2 + hstepA, voffA);
            PG8_WAIT_V(8); PG8_WAIT_L(0); PG8_BAR; PG8_MMA(0, 0, At, B0); PG8_MMA(0, 1, At, B1); PG8_BAR; PG8_SCHED;
            PG8_LDA(At, 1, 1); PG8_STAGE(PG8_SB(1, 0), b3, voffB); PG8_STAGE(PG8_SB(1, 1), b3 + hstepB, voffB); PG8_STAGE(PG8_SA(1, 0), a3, voffA);
            PG8_WAIT_V(8); PG8_WAIT_L(0); PG8_BAR; PG8_MMA(1, 0, At, B0); PG8_MMA(1, 1, At, B1); PG8_BAR; PG8_SCHED;
        }
        if (wr == 0) PG8_BAR;
        if constexpr (FP8) asm volatile("s_nop 15\n\ts_nop 15\n\ts_nop 7" ::: "memory");
        E(acc, cur, wr, wc, fr, fq);
        if (!has_next) break;
#pragma unroll
        for (int a = 0; a < 2; ++a)
#pragma unroll
            for (int b = 0; b < 2; ++b)
#pragma unroll
                for (int m = 0; m < 4; ++m)
#pragma unroll
                    for (int n = 0; n < 2; ++n) acc[a][b][m][n] = (f32x4){0.f, 0.f, 0.f, 0.f};
        cur = nxt; cA = nA; cB = nB; ++ui;
        if (wr == 1) PG8_BAR;
    }
    PG8_WAIT_V(0);
    PG8_BAR;
#undef PG8_SA
#undef PG8_SB
#undef PG8_STAGE
#undef PG8_LDA
#undef PG8_LDB
#undef PG8_MMA
#undef PG8_WAIT_V
#undef PG8_WAIT_L
#undef PG8_BAR
#undef PG8_SCHED
}
}

#define XB_TMO      128
#define XB_XCNT(j)  (256  + 64 * (j))
#define XB_XSUB(j)  (1280 + 64 * (j))
#define XB_XGEN(j)  (2304 + 64 * (j))
#define XB_TOP      3328
#define XB_TOPGEN   3392
#define XCD_BAR_WORDS 3456
#define XB_SPIN_CAP (1u << 18)
__device__ __forceinline__ unsigned xb_ld(unsigned* p)              { return __hip_atomic_load(p, __ATOMIC_RELAXED, __HIP_MEMORY_SCOPE_AGENT); }
__device__ __forceinline__ unsigned xb_add(unsigned* p, unsigned v) { return __hip_atomic_fetch_add(p, v, __ATOMIC_RELAXED, __HIP_MEMORY_SCOPE_AGENT); }
__device__ __forceinline__ unsigned xb_xcc_id() { return (unsigned)__builtin_amdgcn_s_getreg((3 << 11) | 20) & 0xFu; }
#define XB_SPIN(cond, bar) do { unsigned _sp = 0; while (cond) { __builtin_amdgcn_s_sleep(1); \
    if ((++_sp & 255u) == 0u) { if (xb_ld(&(bar)[XB_TMO])) break; if (_sp > XB_SPIN_CAP) { atomicAdd(&(bar)[XB_TMO], 1u); break; } } } } while (0)
struct XcdBarrier { unsigned* bar; unsigned x; volatile LAS unsigned* st; };
__device__ __forceinline__ XcdBarrier xcd_barrier_post(unsigned* bar, volatile LAS unsigned* st) {
    XcdBarrier b; b.bar = bar; b.x = xb_xcc_id(); b.st = st;
    if (threadIdx.x == 0) (void)xb_add(&bar[XB_XCNT(b.x)], 1u);
    return b;
}
__device__ __forceinline__ void xcd_barrier_complete(unsigned* bar, unsigned x, unsigned& nloc, unsigned& nx) {
    const unsigned G = gridDim.x * gridDim.y * gridDim.z;
    unsigned sum, cnt, mine, sp = 0u;
    for (;;) {
        sum = 0u; cnt = 0u; mine = 0u;
#pragma unroll
        for (unsigned j = 0; j < 16; ++j) { const unsigned c = xb_ld(&bar[XB_XCNT(j)]); sum += c; cnt += (c > 0u) ? 1u : 0u; mine = (j == x) ? c : mine; }
        if (sum == G) break;
        __builtin_amdgcn_s_sleep(1);
        if ((++sp & 255u) == 0u) { if (xb_ld(&bar[XB_TMO])) break; if (sp > XB_SPIN_CAP) { atomicAdd(&bar[XB_TMO], 1u); break; } }
    }
    nloc = mine > 0u ? mine : 1u; nx = cnt > 0u ? cnt : 1u;
}
__device__ __forceinline__ void xcd_barrier(const XcdBarrier& b) {
    asm volatile("s_waitcnt vmcnt(0)" ::: "memory");
    __syncthreads();
    if (threadIdx.x == 0) {
        unsigned* bar = b.bar;
        __builtin_amdgcn_s_waitcnt(0);
        unsigned nloc = b.st[0], nx = b.st[1];
        if (nloc == 0u) { xcd_barrier_complete(bar, b.x, nloc, nx); b.st[0] = nloc; b.st[1] = nx; }
        const unsigned old = xb_add(&bar[XB_XSUB(b.x)], 1u);
        const unsigned gen = old / nloc;
        if (old + 1u == (gen + 1u) * nloc) {
            __builtin_amdgcn_fence(__ATOMIC_RELEASE, "agent");
            asm volatile("s_waitcnt vmcnt(0)" ::: "memory");
            const unsigned og = xb_add(&bar[XB_TOP], 1u);
            const unsigned tg = og / nx;
            if (og + 1u == (tg + 1u) * nx) xb_add(&bar[XB_TOPGEN], 1u);
            else XB_SPIN(xb_ld(&bar[XB_TOPGEN]) == tg, bar);
            __builtin_amdgcn_fence(__ATOMIC_ACQUIRE, "agent");
            xb_add(&bar[XB_XGEN(b.x)], 1u);
            asm volatile("s_waitcnt vmcnt(0)" ::: "memory");
        } else {
            XB_SPIN(xb_ld(&bar[XB_XGEN(b.x)]) == gen, bar);
            __builtin_amdgcn_fence(__ATOMIC_ACQUIRE, "agent");
            asm volatile("s_waitcnt vmcnt(0)" ::: "memory");
        }
    }
    __syncthreads();
}

constexpr int RING_BYTES = 131072;
constexpr int LDSCTL_OFF = RING_BYTES, MISC_OFF = LDSCTL_OFF + 320;
constexpr int LDS_BYTES = 147456;
constexpr int NWAVES = 8;

struct Args { const float* in[17]; float* out; unsigned char* ws; };

struct Ctx {
    LAS unsigned char* lds;
    int tid, lane, wave, vcu, G;
};

__device__ __forceinline__ Ctx fresh(const Ctx& F) {
    Ctx C = F; int t = threadIdx.x; asm volatile("" : "+v"(t)); C.tid = t; C.lane = t & 63; return C;
}
__device__ __forceinline__ void p0_transpose_item(const float* W, int K, int N, bf16_t* WT, LAS float* scr, int item, int lane) {
    const int nblk = N / 32, kb = item / nblk, nb = item % nblk, k0 = 64 * kb, n0 = 32 * nb;
#pragma unroll 8
    for (int i = 0; i < 32; ++i) { const int kk = 2 * i + (lane >> 5); scr[kk * 33 + (lane & 31)] = W[(size_t)(k0 + kk) * N + n0 + (lane & 31)]; }
    asm volatile("s_waitcnt lgkmcnt(0)" ::: "memory");
    const int c = lane & 7;
#pragma unroll
    for (int j = 0; j < 4; ++j) { const int n = (lane >> 3) + 8 * j; const LAS float* s = scr + (8 * c) * 33 + n;
        u32x4 o; o.x = pk2(s[0 * 33], s[1 * 33]); o.y = pk2(s[2 * 33], s[3 * 33]); o.z = pk2(s[4 * 33], s[5 * 33]); o.w = pk2(s[6 * 33], s[7 * 33]);
        *(u32x4*)(WT + (size_t)(n0 + n) * K + k0 + 8 * c) = o; }
    asm volatile("s_waitcnt lgkmcnt(0)" ::: "memory");
}
__device__ __forceinline__ void p0_transpose_item8(const float* W, int K, int N, unsigned char* WT, LAS float* scr, int item, int lane) {
    const int nblk = N / 32, kb = item / nblk, nb = item % nblk, k0 = 64 * kb, n0 = 32 * nb;
#pragma unroll 8
    for (int i = 0; i < 32; ++i) { const int kk = 2 * i + (lane >> 5); scr[kk * 33 + (lane & 31)] = W[(size_t)(k0 + kk) * N + n0 + (lane & 31)]; }
    asm volatile("s_waitcnt lgkmcnt(0)" ::: "memory");
    const int c = lane & 7;
#pragma unroll
    for (int j = 0; j < 4; ++j) { const int n = (lane >> 3) + 8 * j; const LAS float* s = scr + (8 * c) * 33 + n; constexpr float sc = pg8::W8_SCALE;
        u32x2 o; o.x = fp8_pack4(s[0 * 33] * sc, s[1 * 33] * sc, s[2 * 33] * sc, s[3 * 33] * sc); o.y = fp8_pack4(s[4 * 33] * sc, s[5 * 33] * sc, s[6 * 33] * sc, s[7 * 33] * sc);
        *(u32x2*)(WT + (size_t)(n0 + n) * K + k0 + 8 * c) = o; }
    asm volatile("s_waitcnt lgkmcnt(0)" ::: "memory");
}
__device__ __forceinline__ void cvt8(const float* src, bf16_t* dst) {
    const f32x4 a = *(const f32x4*)src, b = *(const f32x4*)(src + 4);
    u32x4 o; o.x = pk2(a[0], a[1]); o.y = pk2(a[2], a[3]); o.z = pk2(b[0], b[1]); o.w = pk2(b[2], b[3]);
    *(u32x4*)dst = o;
}

__device__ __forceinline__ void p0_prologue(const Ctx& F0, const Args& a) {
    const Ctx F = fresh(F0);
    unsigned char* ws = a.ws;
    const int nrest = (F.G > 160) ? F.G - 96 : F.G, vrest = (F.G > 160) ? F.vcu - 96 : F.vcu;
    const int gw = vrest * NWAVES + F.wave, NGW = nrest * NWAVES;
    const long gt = (long)vrest * 512 + F.tid, NGT = (long)nrest * 512;
    {
        LAS float* red = (LAS float*)(F.lds);
        const float* c = a.in[1]; const float* cctx = a.in[3]; const float* wmod = a.in[6]; const float* bmod = a.in[7];
        float* modb = (float*)(ws + WS_MOD);
        for (int item = F.vcu; item < 96; item += F.G) {
            const int l = item / 48, nc = item % 48, n0 = nc * 128 + 2 * F.lane, kb = F.wave * 128;
            float sv[9][2];
#pragma unroll
            for (int r = 0; r < 9; ++r)
#pragma unroll
                for (int j = 0; j < 2; ++j) { const int k = kb + 64 * j + F.lane; const float v = (r < 8) ? c[r * DM + k] : cctx[k]; sv[r][j] = v / (1.0f + __expf(-v)); }
            float acc[9][2];
#pragma unroll
            for (int r = 0; r < 9; ++r) { acc[r][0] = 0.f; acc[r][1] = 0.f; }
            const float* wp = wmod + (size_t)l * DM * NMOD + (size_t)kb * NMOD + n0;
#pragma unroll
            for (int j = 0; j < 2; ++j)
#pragma unroll 8
                for (int kl = 0; kl < 64; ++kl) {
                    const f32x2 w = *(const f32x2*)(wp + (size_t)(64 * j + kl) * NMOD);
#pragma unroll
                    for (int r = 0; r < 9; ++r) { const float s = __builtin_bit_cast(float, __builtin_amdgcn_readlane(__builtin_bit_cast(int, sv[r][j]), kl)); acc[r][0] += s * w[0]; acc[r][1] += s * w[1]; }
                }
            __syncthreads();
#pragma unroll
            for (int r = 0; r < 9; ++r) { red[(F.wave * 9 + r) * 128 + 2 * F.lane] = acc[r][0]; red[(F.wave * 9 + r) * 128 + 2 * F.lane + 1] = acc[r][1]; }
            __syncthreads();
            for (int o = F.tid; o < 9 * 128; o += 512) { const int r = o >> 7, nl = o & 127; float s = 0.f;
#pragma unroll
                for (int w = 0; w < 8; ++w) s += red[(w * 9 + r) * 128 + nl];
                modb[(size_t)(l * 9 + r) * NMOD + nc * 128 + nl] = s + bmod[l * NMOD + nc * 128 + nl]; }
        }
        __syncthreads();
    }
    if (vrest < 0) return;
    {
        LAS float* scr = (LAS float*)(F.lds + F.wave * 16384);
        constexpr int I_QKV = (DM / 64) * (3 * DM / 32), I_O = (DM / 64) * (DM / 32), I_PQ = (DM / 64) * (2 * DM / 32);
        constexpr int NITEMS = I_QKV + 2 * I_O + 2 * I_PQ;
        for (int it = gw; it < NITEMS; it += NGW) {
            int r = it;
            if (r < I_QKV) { p0_transpose_item8(a.in[8], DM, 3 * DM, ws + WS_WQKV, scr, r, F.lane); continue; } r -= I_QKV;
            if (r < I_O) { p0_transpose_item8(a.in[9], DM, DM, ws + WS_WO, scr, r, F.lane); continue; } r -= I_O;
            if (r < I_O) { p0_transpose_item8(a.in[11], DM, DM, ws + WS_WF, scr, r, F.lane); continue; } r -= I_O;
            if (r < I_PQ) { p0_transpose_item8(a.in[12], DM, 2 * DM, ws + WS_WPQ, scr, r, F.lane); continue; } r -= I_PQ;
            p0_transpose_item8(a.in[12] + (size_t)DM * 2 * DM, DM, 2 * DM, ws + WS_WPQ + (size_t)2 * DM * DM, scr, r, F.lane);
        }
    }
    for (long i = gt; i < 2 * 2 * 128 * 128 / 8; i += NGT) cvt8(a.in[13] + i * 8, (bf16_t*)(ws + WS_SK) + i * 8);
    {
        bf16_t* wc = (bf16_t*)(ws + WS_WC);
        for (long i = gt; i < 512 * 256 / 8; i += NGT) { const int nn = (int)(i >> 5), k0 = (int)(i & 31) * 8; float v[8];
#pragma unroll
            for (int j = 0; j < 8; ++j) { const int m = ((k0 + j) * (nn & 255)) & 255; const float fr = (float)m * (1.0f / 256.0f);
                v[j] = (nn < 256 ? __builtin_amdgcn_cosf(fr) : __builtin_amdgcn_sinf(fr)) * (1.0f / 16.0f); }
            u32x4 o; o.x = pk2(v[0], v[1]); o.y = pk2(v[2], v[3]); o.z = pk2(v[4], v[5]); o.w = pk2(v[6], v[7]);
            *(u32x4*)(wc + i * 8) = o; }
        unsigned char* cs = ws + WS_CS;
        for (long i = gt; i < 2048L * 4096 / 8; i += NGT) { const int np = (int)(i >> 9), c0 = (int)(i & 511) * 8; const int part = c0 >> 11; float v[8];
#pragma unroll
            for (int j = 0; j < 8; ++j) { const int n = (c0 + j) & 2047; const int m = (n * np) & 4095; const float fr = (float)m * (1.0f / 4096.0f);
                v[j] = (part == 0 ? __builtin_amdgcn_cosf(fr) : -__builtin_amdgcn_sinf(fr)) * (pg8::CS_SCALE / 64.0f); }
            u32x2 o; o.x = fp8_pack4(v[0], v[1], v[2], v[3]); o.y = fp8_pack4(v[4], v[5], v[6], v[7]);
            *(u32x2*)(cs + i * 8) = o; }
    }
}

__device__ __forceinline__ unsigned fp4_pack8(const float* v, float sc) {
    unsigned w = 0;
#define FP4C(i) fminf(fmaxf(v[i] * sc, -6.f), 6.f)
    w = __builtin_amdgcn_cvt_scalef32_pk_fp4_f32(w, FP4C(0), FP4C(1), 1.0f, 0);
    w = __builtin_amdgcn_cvt_scalef32_pk_fp4_f32(w, FP4C(2), FP4C(3), 1.0f, 1);
    w = __builtin_amdgcn_cvt_scalef32_pk_fp4_f32(w, FP4C(4), FP4C(5), 1.0f, 2);
    w = __builtin_amdgcn_cvt_scalef32_pk_fp4_f32(w, FP4C(6), FP4C(7), 1.0f, 3);
#undef FP4C
    return w;
}
#define FP4_DEC(w, bs) __builtin_amdgcn_cvt_scalef32_pk_f32_fp4((w), 1.0f, (bs))
__device__ __forceinline__ unsigned i8_pack4(f32x4 v, float sc) {
    const int a = (int)rintf(fminf(fmaxf(v[0] * sc, -127.f), 127.f)), b = (int)rintf(fminf(fmaxf(v[1] * sc, -127.f), 127.f));
    const int c = (int)rintf(fminf(fmaxf(v[2] * sc, -127.f), 127.f)), d = (int)rintf(fminf(fmaxf(v[3] * sc, -127.f), 127.f));
    return (unsigned)(a & 0xff) | ((unsigned)(b & 0xff) << 8) | ((unsigned)(c & 0xff) << 16) | ((unsigned)(d & 0xff) << 24);
}
constexpr long TC_PER = (long)NEXP * DM / 16, TC_TOTAL = 4 * TC_PER;
__device__ __forceinline__ void tc_issue(const Args& a, long i, f32x4 (&v)[4]) {
    const int q = (int)(i / TC_PER); const long r = i - (long)q * TC_PER; const int l = q >> 1, tb = q & 1;
    const int e = (int)(r >> 6), c16 = (int)(r & 63);
    const float* src = (tb ? a.in[15] : a.in[14]) + ((size_t)l * NEXP + e) * DM + c16 * 16;
#pragma unroll
    for (int d = 0; d < 4; ++d) v[d] = *(const f32x4*)(src + 4 * d);
}
__device__ __forceinline__ void tc_finish(const Args& a, long i, const f32x4 (&v)[4]) {
    const int q = (int)(i / TC_PER); const long r = i - (long)q * TC_PER; const int l = q >> 1, tb = q & 1;
    const int e = (int)(r >> 6), c16 = (int)(r & 63);
    const float sc = tb ? V_SCALE : U_SCALE;
    u32x2 o;
#pragma unroll
    for (int d = 0; d < 2; ++d) { const float v8[8] = {v[2 * d][0], v[2 * d][1], v[2 * d][2], v[2 * d][3], v[2 * d + 1][0], v[2 * d + 1][1], v[2 * d + 1][2], v[2 * d + 1][3]};
        o[d] = fp4_pack8(v8, sc); }
    *(u32x2*)(a.ws + WS_TAB + (size_t)l * TAB_LAYER + (tb ? TAB_VOFF : 0) + ((size_t)(c16 >> 4) * NEXP + e) * 128 + (c16 & 15) * 8) = o;
}
__device__ __forceinline__ void table_convert(const Ctx& F0, const Args& a, int sh0, int nsh, int nshare) {
    const Ctx F = fresh(F0);
    constexpr long PER = (long)NEXP * DM / 16;
    constexpr long TOTAL = 4 * PER, T0 = TOTAL / 4;
    unsigned char* t8 = a.ws + WS_TAB;
    const long per_share = (TOTAL - T0 + nshare - 1) / nshare;
    const long i0 = T0 + (long)sh0 * per_share, i1 = min(T0 + (long)(sh0 + nsh) * per_share, TOTAL);
    for (long i = i0 + F.tid; i < i1; i += 512) {
        const int q = (int)(i / PER); const long r = i - (long)q * PER; const int l = q >> 1, tb = q & 1;
        const int e = (int)(r >> 6), c16 = (int)(r & 63);
        const float* src = (tb ? a.in[15] : a.in[14]) + ((size_t)l * NEXP + e) * DM + c16 * 16;
        if (tb) {
            u32x2 o;
#pragma unroll
            for (int d = 0; d < 2; ++d) { const f32x4 va = *(const f32x4*)(src + 8 * d), vb = *(const f32x4*)(src + 8 * d + 4);
                const float v8[8] = {va[0], va[1], va[2], va[3], vb[0], vb[1], vb[2], vb[3]};
                o[d] = fp4_pack8(v8, V_SCALE); }
            *(u32x2*)(t8 + (size_t)l * TAB_LAYER + TAB_VOFF + ((size_t)(c16 >> 4) * NEXP + e) * 128 + (c16 & 15) * 8) = o;
        } else {
            u32x2 o;
#pragma unroll
            for (int d = 0; d < 2; ++d) { const f32x4 va = *(const f32x4*)(src + 8 * d), vb = *(const f32x4*)(src + 8 * d + 4);
                const float v8[8] = {va[0], va[1], va[2], va[3], vb[0], vb[1], vb[2], vb[3]};
                o[d] = fp4_pack8(v8, U_SCALE); }
            *(u32x2*)(t8 + (size_t)l * TAB_LAYER + ((size_t)(c16 >> 4) * NEXP + e) * 128 + (c16 & 15) * 8) = o;
        }
    }
}

__device__ __forceinline__ const float* norm_src(const Args& a, int mode, int m) { return (m < ML) ? ((mode == 0 ? a.in[0] : a.out) + (size_t)m * DM) : (a.in[2] + (size_t)(m - ML) * DM); }
__device__ __forceinline__ void norm_phase(const Ctx& F0, const Args& a, int mode, int layer, int off, const float* gw) {
    const Ctx F = fresh(F0);
    const int gwv = F.vcu * NWAVES + F.wave, NGW = F.G * NWAVES, lane = F.lane;
    const float* modb = (const float*)(a.ws + WS_MOD) + (size_t)layer * 9 * NMOD;
    bf16_t* hx = (bf16_t*)(a.ws + WS_HX);
    const int nrows = (mode == 0) ? MT : ML;
    f32x4 gv[4];
#pragma unroll
    for (int j = 0; j < 4; ++j) gv[j] = ((const f32x4*)gw)[lane + 64 * j];
    if (mode != 0) {
        const u32x2* XBc = (const u32x2*)(a.ws + WS_XB);
        constexpr int CH = 16, NPF = 4;
        for (int c = gwv; c < ML / CH; c += NGW) {
            const int r0 = c * CH;
            u32x2 rb[NPF][4]; f32x4 v[4], av[4], cv[4];
#pragma unroll
            for (int p = 0; p < NPF; ++p)
#pragma unroll
                for (int j = 0; j < 4; ++j) rb[p][j] = XBc[(size_t)(r0 + p) * 256 + lane + 64 * j];
            { const float* mr = modb + (size_t)(r0 >> 12) * NMOD + off;
#pragma unroll
              for (int j = 0; j < 4; ++j) { av[j] = ((const f32x4*)mr)[lane + 64 * j]; cv[j] = ((const f32x4*)(mr + DM))[lane + 64 * j]; } }
            asm volatile("" :: "v"(cv[3]));
#pragma unroll 1
            for (int q = 0; q < CH / NPF; ++q) {
#pragma unroll
              for (int p = 0; p < NPF; ++p) {
                const int m = r0 + q * NPF + p;
#pragma unroll
                for (int j = 0; j < 4; ++j) v[j] = bf4_f32(rb[p][j]);
                { const int rn = min(m + NPF, r0 + CH - 1);
#pragma unroll
                  for (int j = 0; j < 4; ++j) rb[p][j] = XBc[(size_t)rn * 256 + lane + 64 * j]; }
              float s = 0.f;
#pragma unroll
              for (int j = 0; j < 4; ++j) s += (v[j].x * v[j].x + v[j].y * v[j].y) + (v[j].z * v[j].z + v[j].w * v[j].w);
              const float rstd = 1.0f / sqrtf(wave_sum(s) * (1.0f / DM) + EPS);
              unsigned long long* o8 = (unsigned long long*)(hx + (size_t)m * DM) + lane;
              unsigned* o4 = (unsigned*)(a.ws + WS_HX + (size_t)m * DM) + lane;
#pragma unroll
              for (int j = 0; j < 4; ++j) { const f32x4 y = (v[j] * rstd * gv[j]) * (cv[j] + 1.0f) + av[j];
                  if (mode == 0 || off == 3 * DM) o4[64 * j] = fp8_pack4(y.x * pg8::ACT8_SCALE, y.y * pg8::ACT8_SCALE, y.z * pg8::ACT8_SCALE, y.w * pg8::ACT8_SCALE);
                  if (mode == 0) continue;
                  if (off != 3 * DM)
                  o8[64 * j] = (unsigned long long)cvtpk(y.x, y.y) | ((unsigned long long)cvtpk(y.z, y.w) << 32);
                  if (off == 3 * DM) {
                      const float q0 = fminf(fmaxf(y.x * XQ_SCALE, -6.f), 6.f), q1 = fminf(fmaxf(y.y * XQ_SCALE, -6.f), 6.f), q2 = fminf(fmaxf(y.z * XQ_SCALE, -6.f), 6.f), q3 = fminf(fmaxf(y.w * XQ_SCALE, -6.f), 6.f);
                      unsigned ph = __builtin_amdgcn_cvt_scalef32_pk_fp4_f32(0u, q0, q1, 1.0f, 0); ph = __builtin_amdgcn_cvt_scalef32_pk_fp4_f32(ph, q2, q3, 1.0f, 1);
                      const f32x2 d0 = FP4_DEC(ph, 0), d1 = FP4_DEC(ph, 1);
                      unsigned pl = __builtin_amdgcn_cvt_scalef32_pk_fp4_f32(0u, 4.f * (q0 - d0.x), 4.f * (q1 - d0.y), 1.0f, 0); pl = __builtin_amdgcn_cvt_scalef32_pk_fp4_f32(pl, 4.f * (q2 - d1.x), 4.f * (q3 - d1.y), 1.0f, 1);
                      unsigned short* xq = (unsigned short*)(a.ws + WS_X8 + ((size_t)j * ML + m) * 256) + lane;
                      xq[0] = (unsigned short)(ph & 0xffffu); xq[64] = (unsigned short)(pl & 0xffffu); } }
              }
            }
        }
        return;
    }
    f32x4 rA[4], aA[4], cA[4], rB[4], aB[4], cB[4];
#define N0_LOAD(rs_, as_, cs_, row_) do { const int rw_ = min((row_), nrows - 1); const f32x4* xr_ = (const f32x4*)norm_src(a, 0, rw_) + lane; \
        const float* mr_ = modb + (size_t)((rw_ < ML) ? (rw_ >> 12) : 8) * NMOD + off; \
        _Pragma("unroll") for (int j = 0; j < 4; ++j) { rs_[j] = xr_[64 * j]; as_[j] = ((const f32x4*)mr_)[lane + 64 * j]; cs_[j] = ((const f32x4*)(mr_ + DM))[lane + 64 * j]; } } while (0)
#define N0_ROW(rs_, as_, cs_, m_) do { \
        float s = 0.f; \
        _Pragma("unroll") for (int j = 0; j < 4; ++j) s += (rs_[j].x * rs_[j].x + rs_[j].y * rs_[j].y) + (rs_[j].z * rs_[j].z + rs_[j].w * rs_[j].w); \
        const float rstd = 1.0f / sqrtf(wave_sum(s) * (1.0f / DM) + EPS); \
        unsigned* o4 = (unsigned*)(a.ws + WS_HX + (size_t)(m_) * DM) + lane;            \
        f32x4 y[4]; \
        _Pragma("unroll") for (int j = 0; j < 4; ++j) y[j] = (rs_[j] * rstd * gv[j]) * (cs_[j] + 1.0f) + as_[j]; \
        N0_LOAD(rs_, as_, cs_, (m_) + 2 * NGW);                                       \
        _Pragma("unroll") for (int j = 0; j < 4; ++j) o4[64 * j] = fp8_pack4(y[j].x * pg8::ACT8_SCALE, y[j].y * pg8::ACT8_SCALE, y[j].z * pg8::ACT8_SCALE, y[j].w * pg8::ACT8_SCALE); \
    } while (0)
    if (gwv < nrows) { N0_LOAD(rA, aA, cA, gwv); N0_LOAD(rB, aB, cB, gwv + NGW); }
    for (int m = gwv; m < nrows; m += 2 * NGW) {
        N0_ROW(rA, aA, cA, m);
        if (m + NGW < nrows) N0_ROW(rB, aB, cB, m + NGW);
    }
#undef N0_LOAD
#undef N0_ROW
}
__device__ __forceinline__ void norm_fold_phase(const Ctx& F0, const Args& a, int layer, const float* gw) {
    const Ctx F = fresh(F0);
    const int gwv = F.vcu * NWAVES + F.wave, NGW = F.G * NWAVES, lane = F.lane;
    const float* modb = (const float*)(a.ws + WS_MOD) + (size_t)layer * 9 * NMOD;
    const u32x2* XBr = (const u32x2*)(a.ws + WS_XB);
    unsigned long long* hc = (unsigned long long*)(a.ws + WS_HX);
    unsigned long long* hs = (unsigned long long*)(a.ws + WS_HX + 32 * MiB);
    float* yni = (float*)(a.ws + WS_YNI);
    f32x4 gv[4];
#pragma unroll
    for (int j = 0; j < 4; ++j) gv[j] = ((const f32x4*)gw)[lane + 64 * j];
    u32x2 ra[4], rb[4];
#define NF_ROWS(task_, na_, nb_) const int b_ = (task_) >> 11, t_ = (task_) & 2047; const int na_ = b_ * SEQ + t_, nb_ = b_ * SEQ + (t_ == 0 ? 2048 : SEQ - t_)
    if (gwv < NB * 2048) { NF_ROWS(gwv, na, nb);
#pragma unroll
        for (int j = 0; j < 4; ++j) { ra[j] = XBr[(size_t)na * 256 + lane + 64 * j]; rb[j] = XBr[(size_t)nb * 256 + lane + 64 * j]; } }
    for (int task = gwv; task < NB * 2048; task += NGW) {
        const int b = task >> 11, t = task & 2047;
        f32x4 va[4], vb[4];
#pragma unroll
        for (int j = 0; j < 4; ++j) { va[j] = bf4_f32(ra[j]); vb[j] = bf4_f32(rb[j]); }
        { const int tn = (task + NGW < NB * 2048) ? task + NGW : task; NF_ROWS(tn, na, nb);
#pragma unroll
          for (int j = 0; j < 4; ++j) { ra[j] = XBr[(size_t)na * 256 + lane + 64 * j]; rb[j] = XBr[(size_t)nb * 256 + lane + 64 * j]; } }
        const float* mr = modb + (size_t)b * NMOD;
        f32x4 av[4], cv[4];
#pragma unroll
        for (int j = 0; j < 4; ++j) { av[j] = ((const f32x4*)mr)[lane + 64 * j]; cv[j] = ((const f32x4*)(mr + DM))[lane + 64 * j]; }
        float sa = 0.f, sb = 0.f;
#pragma unroll
        for (int j = 0; j < 4; ++j) { sa += (va[j].x * va[j].x + va[j].y * va[j].y) + (va[j].z * va[j].z + va[j].w * va[j].w); sb += (vb[j].x * vb[j].x + vb[j].y * vb[j].y) + (vb[j].z * vb[j].z + vb[j].w * vb[j].w); }
        const float ra_ = 1.0f / sqrtf(wave_sum(sa) * (1.0f / DM) + EPS), rb_ = 1.0f / sqrtf(wave_sum(sb) * (1.0f / DM) + EPS);
        const size_t orow = ((size_t)b * 2048 + t) * 256 + lane;
#pragma unroll
        for (int j = 0; j < 4; ++j) {
            const f32x4 ya = (va[j] * ra_ * gv[j]) * (cv[j] + 1.0f) + av[j], yb = (vb[j] * rb_ * gv[j]) * (cv[j] + 1.0f) + av[j];
            f32x4 ys, yd;
            if (t == 0) { ys = ya; yd = (f32x4){0.f, 0.f, 0.f, 0.f}; ((f32x4*)(yni + (size_t)b * DM))[lane + 64 * j] = yb; }
            else { ys = ya + yb; yd = ya - yb; }
            hc[orow + 64 * j] = (unsigned long long)cvtpk(ys.x, ys.y) | ((unsigned long long)cvtpk(ys.z, ys.w) << 32);
            hs[orow + 64 * j] = (unsigned long long)cvtpk(yd.x, yd.y) | ((unsigned long long)cvtpk(yd.z, yd.w) << 32);
        }
    }
#undef NF_ROWS
}
__device__ __forceinline__ void final_norm_phase(const Ctx& F0, const Args& a) {
    const Ctx F = fresh(F0);
    const int gwv = F.vcu * NWAVES + F.wave, NGW = F.G * NWAVES;
    const float* gw = a.in[16];
    const u32x2* XBr = (const u32x2*)(a.ws + WS_XB);
    f32x4 gv[4]; u32x2 vr[4];
#pragma unroll
    for (int j = 0; j < 4; ++j) gv[j] = ((const f32x4*)gw)[F.lane + 64 * j];
    if (gwv < ML) {
#pragma unroll
        for (int j = 0; j < 4; ++j) vr[j] = XBr[(size_t)gwv * 256 + F.lane + 64 * j]; }
    for (int m = gwv; m < ML; m += NGW) {
        f32x4* xr = (f32x4*)(a.out + (size_t)m * DM) + F.lane;
        f32x4 v[4]; float s = 0.f;
#pragma unroll
        for (int j = 0; j < 4; ++j) { v[j] = bf4_f32(vr[j]); s += (v[j].x * v[j].x + v[j].y * v[j].y) + (v[j].z * v[j].z + v[j].w * v[j].w); }
        { const int mn = (m + NGW < ML) ? m + NGW : m;
#pragma unroll
          for (int j = 0; j < 4; ++j) vr[j] = XBr[(size_t)mn * 256 + F.lane + 64 * j]; }
        const float rstd = 1.0f / sqrtf(wave_sum(s) * (1.0f / DM) + EPS);
#pragma unroll
        for (int j = 0; j < 4; ++j) xr[64 * j] = v[j] * rstd * gv[j];
    }
}

constexpr int ATT_ROWB = 144, ATT_KTILEB = 128 * ATT_ROWB, ATT_VROWB = 272, ATT_VTILEB = 64 * ATT_VROWB, ATT_BIAS_B = 2048, ATT_K0 = ATT_BIAS_B, ATT_V0 = ATT_K0 + 2 * ATT_KTILEB;
constexpr float ATT_THR = 8.0f;
template <int NGH, bool LATENT>
__device__ __forceinline__ void attn_sub(const LAS unsigned char* Kt, const LAS unsigned char* Vt_, int ko, const LAS float* browA, const LAS float* browB, const int (&relidx)[8],
                                         const bf16x8 (&qf)[2], float& m_ref, float& l_run, f32x4 (&o)[4], int q16, int g4) {
    constexpr int NG = 2 * NGH;
    bf16x8 kf[2 * NG][2]; u32x2 vf[4][NG][2]; f32x4 sc[2 * NG];
#pragma unroll
    for (int gk = 0; gk < NG; ++gk)
#pragma unroll
        for (int b2 = 0; b2 < 2; ++b2)
#pragma unroll
            for (int ks = 0; ks < 2; ++ks) kf[2 * gk + b2][ks] = *(const LAS bf16x8*)(Kt + ((gk / NGH) * 64 + ko + 32 * (gk % NGH) + 16 * b2 + q16) * ATT_ROWB + 64 * ks + 16 * g4);
#pragma unroll
    for (int d = 0; d < 4; ++d)
#pragma unroll
        for (int gk = 0; gk < NG; ++gk) { const LAS unsigned char* vp = Vt_ + (16 * d + q16) * ATT_VROWB + 2 * ((gk / NGH) * 64 + ko + 32 * (gk % NGH) + 4 * g4);
            vf[d][gk][0] = *(const LAS u32x2*)vp; vf[d][gk][1] = *(const LAS u32x2*)(vp + 32); }
    if (LATENT) {
#pragma unroll
        for (int kk = 0; kk < 8; ++kk) { sc[kk >> 2][kk & 3] = browA[relidx[kk]] - m_ref; sc[2 + (kk >> 2)][kk & 3] = browB[relidx[kk]] - m_ref; }
    } else {
#pragma unroll
        for (int blk = 0; blk < 2 * NG; ++blk) sc[blk] = (f32x4){-m_ref, -m_ref, -m_ref, -m_ref};
    }
#pragma unroll
    for (int blk = 0; blk < 2 * NG; ++blk)
#pragma unroll
        for (int ks = 0; ks < 2; ++ks) sc[blk] = __builtin_amdgcn_mfma_f32_16x16x32_bf16(kf[blk][ks], qf[ks], sc[blk], 0, 0, 0);
    float mx = fmaxf(fmaxf(sc[0][0], sc[0][1]), fmaxf(sc[0][2], sc[0][3]));
#pragma unroll
    for (int blk = 1; blk < 2 * NG; ++blk) mx = fmaxf(mx, fmaxf(fmaxf(sc[blk][0], sc[blk][1]), fmaxf(sc[blk][2], sc[blk][3])));
    if (__builtin_amdgcn_ballot_w64(mx > ATT_THR) != 0ull) {
        mx = fmaxf(mx, __shfl_xor(mx, 16)); mx = fmaxf(mx, __shfl_xor(mx, 32));
        const float dl = mx > ATT_THR ? mx : 0.f;
        m_ref += dl;
        const float al = __builtin_amdgcn_exp2f(-dl);
        l_run *= al;
#pragma unroll
        for (int d = 0; d < 4; ++d) o[d] *= al;
#pragma unroll
        for (int blk = 0; blk < 2 * NG; ++blk) sc[blk] -= dl;
    }
    float ls0 = 0.f, ls1 = 0.f;
#pragma unroll
    for (int blk = 0; blk < 2 * NG; ++blk)
#pragma unroll
        for (int i = 0; i < 4; ++i) { const float e = __builtin_amdgcn_exp2f(sc[blk][i]); sc[blk][i] = e; if (blk & 1) ls1 += e; else ls0 += e; }
    l_run += ls0 + ls1;
    bf16x8 pf[NG];
#pragma unroll
    for (int gk = 0; gk < NG; ++gk) { u32x4 pw; pw.x = cvtpk(sc[2 * gk][0], sc[2 * gk][1]); pw.y = cvtpk(sc[2 * gk][2], sc[2 * gk][3]); pw.z = cvtpk(sc[2 * gk + 1][0], sc[2 * gk + 1][1]); pw.w = cvtpk(sc[2 * gk + 1][2], sc[2 * gk + 1][3]);
        pf[gk] = __builtin_bit_cast(bf16x8, pw); }
#pragma unroll
    for (int gk = 0; gk < NG; ++gk)
#pragma unroll
        for (int d = 0; d < 4; ++d) { u32x4 vw; vw.x = vf[d][gk][0].x; vw.y = vf[d][gk][0].y; vw.z = vf[d][gk][1].x; vw.w = vf[d][gk][1].y;
            o[d] = __builtin_amdgcn_mfma_f32_16x16x32_bf16(__builtin_bit_cast(bf16x8, vw), pf[gk], o[d], 0, 0, 0); }
}
__device__ __forceinline__ void attn_phase(const Ctx& F0, const Args& a) {
    const Ctx F = fresh(F0);
    const bf16_t* QK = (const bf16_t*)(a.ws + WS_QK);
    const bf16_t* VT = (const bf16_t*)(a.ws + WS_VT);
    unsigned char* AO = a.ws + WS_HX + 36 * MiB;
    const float* rpb = a.in[10];
    LAS float* bias = (LAS float*)F.lds;
    const int tid = F.tid, lane = F.lane, q16 = lane & 15, g4 = lane >> 4;
    const int rr = F.wave >> 2, jt = F.wave & 3;
    const int qc = 16 * jt + q16, cs = min(max(qc - 8, 0), 48), ksj = min(max(16 * jt - 8, 0), 32);
    int relidx[8];
#pragma unroll
    for (int k = 0; k < 8; ++k) { const int kc = ksj + 16 * (k >> 2) + 4 * g4 + (k & 3); relidx[k] = (kc >= cs && kc < cs + 16) ? (kc - qc + 15) : 31; }
    const int krow = tid >> 3, kch = tid & 7, vrow = tid >> 4, vch = tid & 15;
    const unsigned lds_k = (unsigned)(krow * ATT_ROWB + kch * 16), lds_v = (unsigned)(vrow * ATT_VROWB + vch * 16);
    const int nunits = NB * 16 * 16, upb = (nunits + F.G - 1) / F.G;
    int cur_bh = -1;
    for (int k = 0; k < upb; ++k) {
        const int id = F.vcu * upb + k; if (id >= nunits) break;
        const int p = id & 15, bh = id >> 4, b = bh >> 4, h = bh & 15;
        if (bh != cur_bh) {
            __syncthreads();
            for (int i = tid; i < 16 * 32; i += 512) { const int dr = i >> 5, dc = i & 31; bias[i] = (dc < 31 && dr < 15) ? rpb[(h * 15 + dr) * 31 + dc] * LOG2E : -1e30f; }
            cur_bh = bh;
        }
        const int r0 = 4 * p, rs0 = min(max(r0 - 4, 0), 56), rs1 = min(max(r0 + 3 - 4, 0), 56);
        const int nlat = rs1 + 8 - rs0, nlt = (nlat + 1) >> 1, nsteps = nlt + 2;
        const int rA = r0 + rr, rB = r0 + 2 + rr, rsA = min(max(rA - 4, 0), 56), rsB = min(max(rB - 4, 0), 56);
        const long tokqA = (long)b * SEQ + rA * GW + qc, tokqB = (long)b * SEQ + rB * GW + qc;
        const bf16_t* kbase = QK + 1024 + h * 64 + kch * 8;
        const bf16_t* vbase = VT + (long)(h * 64 + vrow) * MT + (vch & 7) * 8;
#define ATT_TOKA(step) ((step) < nlt ? ((long)b * SEQ + (long)(rs0 + 2 * (step)) * GW) : ((long)ML + b * CTXL + ((step) - nlt) * 128))
#define ATT_TOKB(step) ((step) < nlt ? ((long)b * SEQ + (long)min(rs0 + 2 * (step) + 1, rs0 + nlat - 1) * GW) : ((long)ML + b * CTXL + ((step) - nlt) * 128 + 64))
        u32x4 kA[2], vA[2];
#define ATT_LOAD(step, kr_, vr_) do { const int st_ = (step) < nsteps ? (step) : nsteps - 1; const long ta_ = ATT_TOKA(st_), tb_ = ATT_TOKB(st_);     \
        kr_[0] = *(const u32x4*)(kbase + (ta_ + krow) * 2048); kr_[1] = *(const u32x4*)(kbase + (tb_ + krow) * 2048); \
        const long tv_ = (vch < 8) ? ta_ : tb_; vr_[0] = *(const u32x4*)(vbase + tv_); vr_[1] = *(const u32x4*)(vbase + (long)32 * MT + tv_); } while (0)
#define ATT_WRITE(buf, kr_, vr_) do { *(LAS u32x4*)(F.lds + ATT_K0 + (buf) * ATT_KTILEB + lds_k) = kr_[0]; *(LAS u32x4*)(F.lds + ATT_K0 + (buf) * ATT_KTILEB + 64 * ATT_ROWB + lds_k) = kr_[1]; \
        *(LAS u32x4*)(F.lds + ATT_V0 + (buf) * ATT_VTILEB + lds_v) = vr_[0]; *(LAS u32x4*)(F.lds + ATT_V0 + (buf) * ATT_VTILEB + 32 * ATT_VROWB + lds_v) = vr_[1]; } while (0)
        ATT_LOAD(0, kA, vA);
        f32x4 tcv0[4];
        const int tci0 = id * 512 + tid;
        tc_issue(a, tci0, tcv0);
        bf16x8 qfA[2], qfB[2];
#pragma unroll
        for (int ks = 0; ks < 2; ++ks) { qfA[ks] = *(const bf16x8*)(QK + tokqA * 2048 + h * 64 + 32 * ks + 8 * g4); qfB[ks] = *(const bf16x8*)(QK + tokqB * 2048 + h * 64 + 32 * ks + 8 * g4); }
        float mA = 0.f, lA = 0.f, mB = 0.f, lB = 0.f;
        f32x4 oA[4], oB[4];
#pragma unroll
        for (int d = 0; d < 4; ++d) { oA[d] = (f32x4){0.f, 0.f, 0.f, 0.f}; oB[d] = (f32x4){0.f, 0.f, 0.f, 0.f}; }
        __syncthreads();
        ATT_WRITE(0, kA, vA);
        ATT_LOAD(1, kA, vA);
        asm volatile("" :: "v"(qfA[0]), "v"(qfA[1]), "v"(qfB[0]), "v"(qfB[1]));
        __syncthreads();
#define ATT_COMPUTE(step, cur) do { \
            const LAS unsigned char* Kt = F.lds + ATT_K0 + (cur) * ATT_KTILEB; \
            const LAS unsigned char* Vt_ = F.lds + ATT_V0 + (cur) * ATT_VTILEB; \
            unsigned kt2_ = (unsigned)(size_t)Kt, vt2_ = (unsigned)(size_t)Vt_; asm volatile("" : "+v"(kt2_), "+v"(vt2_));     \
            const LAS unsigned char* KtB = (const LAS unsigned char*)(size_t)kt2_; const LAS unsigned char* VtB = (const LAS unsigned char*)(size_t)vt2_; \
            if ((step) < nlt) { const int kra = rs0 + 2 * (step), krb = kra + 1; const bool vb_ = krb < rs0 + nlat; \
                { const bool a0 = kra >= rsA && kra < rsA + 8, a1 = vb_ && krb >= rsA && krb < rsA + 8; \
                  if (a0 || a1) attn_sub<1, true>(Kt, Vt_, ksj, bias + (a0 ? (kra - rA + 7) : 15) * 32, bias + (a1 ? (krb - rA + 7) : 15) * 32, relidx, qfA, mA, lA, oA, q16, g4); } \
                { const bool b0 = kra >= rsB && kra < rsB + 8, b1 = vb_ && krb >= rsB && krb < rsB + 8; \
                  if (b0 || b1) attn_sub<1, true>(KtB, VtB, ksj, bias + (b0 ? (kra - rB + 7) : 15) * 32, bias + (b1 ? (krb - rB + 7) : 15) * 32, relidx, qfB, mB, lB, oB, q16, g4); } \
            } else {                                                     \
                attn_sub<1, false>(Kt, Vt_, 0, bias, bias, relidx, qfA, mA, lA, oA, q16, g4); attn_sub<1, false>(Kt, Vt_, 32, bias, bias, relidx, qfA, mA, lA, oA, q16, g4); \
                attn_sub<1, false>(KtB, VtB, 0, bias, bias, relidx, qfB, mB, lB, oB, q16, g4); attn_sub<1, false>(KtB, VtB, 32, bias, bias, relidx, qfB, mB, lB, oB, q16, g4); } \
        } while (0)
        for (int step = 0; step < nsteps; step += 2) {
            ATT_COMPUTE(step, 0);
            if (step + 1 < nsteps) ATT_WRITE(1, kA, vA);
            ATT_LOAD(step + 2, kA, vA);
            __syncthreads();
            if (step + 1 < nsteps) { ATT_COMPUTE(step + 1, 1); }
            if (step + 2 < nsteps) ATT_WRITE(0, kA, vA);
            ATT_LOAD(step + 3, kA, vA);
            __syncthreads();
        }
#undef ATT_LOAD
#undef ATT_WRITE
#undef ATT_COMPUTE
#undef ATT_TOKA
#undef ATT_TOKB
        { int ti_ = id * 512 + tid; asm volatile("" : "+v"(ti_));
          tc_finish(a, ti_, tcv0); }
        lA += __shfl_xor(lA, 16); lA += __shfl_xor(lA, 32); lB += __shfl_xor(lB, 16); lB += __shfl_xor(lB, 32);
        { int tq_ = b * SEQ + rA * GW + qc; asm volatile("" : "+v"(tq_));
          unsigned char* op = AO + (long)tq_ * DM + h * 64 + 4 * g4; const float ls = pg8::ACT8_SCALE / lA;
#pragma unroll
          for (int d = 0; d < 4; ++d) *(unsigned*)(op + 16 * d) = fp8_pack4(oA[d][0] * ls, oA[d][1] * ls, oA[d][2] * ls, oA[d][3] * ls); }
        { int tq_ = b * SEQ + rB * GW + qc; asm volatile("" : "+v"(tq_));
          unsigned char* op = AO + (long)tq_ * DM + h * 64 + 4 * g4; const float ls = pg8::ACT8_SCALE / lB;
#pragma unroll
          for (int d = 0; d < 4; ++d) *(unsigned*)(op + 16 * d) = fp8_pack4(oB[d][0] * ls, oB[d][1] * ls, oB[d][2] * ls, oB[d][3] * ls); }
    }
    __syncthreads();
}

__device__ __forceinline__ void ce_desc(float& a, float& b) { const float hi = fmaxf(a, b), lo = fminf(a, b); a = hi; b = lo; }
__device__ __forceinline__ void ce_dir(float& a, float& b, bool desc) { const float hi = fmaxf(a, b), lo = fminf(a, b); a = desc ? hi : lo; b = desc ? lo : hi; }
__device__ __forceinline__ void sort16_desc(float (&v)[16]) {
#define S16CE(i, j) { const float hi_ = fmaxf(v[i], v[j]), lo_ = fminf(v[i], v[j]); v[i] = hi_; v[j] = lo_; }
    S16CE(0,13) S16CE(1,12) S16CE(2,15) S16CE(3,14) S16CE(4,8) S16CE(5,6) S16CE(7,11) S16CE(9,10)
    S16CE(0,5) S16CE(1,7) S16CE(2,9) S16CE(3,4) S16CE(6,13) S16CE(8,14) S16CE(10,15) S16CE(11,12)
    S16CE(0,1) S16CE(2,3) S16CE(4,5) S16CE(6,8) S16CE(7,9) S16CE(10,11) S16CE(12,13) S16CE(14,15)
    S16CE(0,2) S16CE(1,3) S16CE(4,10) S16CE(5,11) S16CE(6,7) S16CE(8,9) S16CE(12,14) S16CE(13,15)
    S16CE(1,2) S16CE(3,12) S16CE(4,6) S16CE(5,7) S16CE(8,10) S16CE(9,11) S16CE(13,14)
    S16CE(1,4) S16CE(2,6) S16CE(5,8) S16CE(7,10) S16CE(9,13) S16CE(11,14)
    S16CE(2,4) S16CE(3,6) S16CE(9,12) S16CE(11,13)
    S16CE(3,5) S16CE(6,8) S16CE(7,9) S16CE(10,12)
    S16CE(3,4) S16CE(5,6) S16CE(7,8) S16CE(9,10) S16CE(11,12)
    S16CE(6,7) S16CE(8,9)
#undef S16CE
}
__device__ __forceinline__ void merge16_desc(float (&a)[16], const float (&b)[16]) {
#pragma unroll
    for (int i = 0; i < 16; ++i) a[i] = fmaxf(a[i], b[15 - i]);
#pragma unroll
    for (int j = 8; j > 0; j >>= 1)
#pragma unroll
        for (int i = 0; i < 16; ++i) { const int l = i ^ j; if (l > i) ce_desc(a[i], a[l]); }
}

struct CandTab { int i[64]; int j[64]; };
__host__ __device__ constexpr CandTab make_cand_tab() {
    CandTab t{}; int n = 0;
    for (int i = 0; i < 16; ++i) for (int j = 0; j < 16; ++j) if ((i + 1) * (j + 1) <= 16) { t.i[n] = i; t.j[n] = j; ++n; }
    for (; n < 64; ++n) { t.i[n] = -1; t.j[n] = -1; }
    return t;
}

__device__ __forceinline__ void peer_topk_phase(const Ctx& F0, const Args& a, int layer) {
    const Ctx F = fresh(F0);
    const bf16_t* QP = (const bf16_t*)(a.ws + WS_QK);
    const bf16_t* SK = (const bf16_t*)(a.ws + WS_SK) + (size_t)layer * 2 * 128 * 128;
    unsigned short* IDX = (unsigned short*)(a.ws + WS_IDX);
    float* GATE = (float*)(a.ws + WS_GATE);
    const int gwv = F.vcu * NWAVES + F.wave, NGW = F.G * NWAVES;
    const int lane = F.lane, t32 = lane & 31, hi = lane >> 5;
    __syncthreads();
    for (int c = F.tid; c < 4096; c += 512) *(LAS u32x4*)(F.lds + (c >> 4) * 272 + (c & 15) * 16) = *(const u32x4*)(SK + (size_t)c * 8);
    __syncthreads();
#define TK_LDQ(dst, task_, p_) do { const int tk_ = (task_) < 1024 * 8 ? (task_) : 1024 * 8 - 1; const bf16_t* qp_ = QP + ((long)(tk_ >> 3) * 32 + t32) * 2048 + (tk_ & 7) * 256 + (p_) * 128 + hi * 8; \
        _Pragma("unroll") for (int ks = 0; ks < 8; ++ks) dst[ks] = *(const bf16x8*)(qp_ + ks * 16); } while (0)
    bf16x8 qn[8];
    TK_LDQ(qn, gwv, 0);
    for (int task = gwv; task < 1024 * 8; task += NGW) {
        const int tt = task >> 3, h = task & 7;
        const long tok = (long)tt * 32 + t32;
        float top[2][16];
#pragma unroll
        for (int p = 0; p < 2; ++p) {
            bf16x8 qc[8];
#pragma unroll
            for (int ks = 0; ks < 8; ++ks) qc[ks] = qn[ks];
            if (p == 0) TK_LDQ(qn, task, 1); else TK_LDQ(qn, task + NGW, 0);
            f32x16 acc[4];
#pragma unroll
            for (int eb = 0; eb < 4; ++eb)
#pragma unroll
                for (int i = 0; i < 16; ++i) acc[eb][i] = 0.f;
#pragma unroll
            for (int eb = 0; eb < 4; ++eb) asm volatile("" : "+v"(acc[eb]));
            const LAS unsigned char* kp = F.lds + (p * 128 + t32) * 272 + hi * 16;
#pragma unroll
            for (int ks = 0; ks < 8; ++ks) {
                if ((ks & 1) == 0) asm volatile("" ::: "memory");
                const bf16x8 bq = qc[ks];
#pragma unroll
                for (int eb = 0; eb < 4; ++eb) { const bf16x8 ak = *(const LAS bf16x8*)(kp + eb * 32 * 272 + ks * 32); acc[eb] = __builtin_amdgcn_mfma_f32_32x32x16_bf16(ak, bq, acc[eb], 0, 0, 0); }
            }
            float cur[16];
#pragma unroll
            for (int eb = 0; eb < 4; ++eb) {
                float v[16];
#pragma unroll
                for (int i = 0; i < 16; ++i) { const unsigned e = 32 * eb + crow(i, hi); float x = acc[eb][i]; asm volatile("" : "+v"(x));
                    v[i] = __builtin_bit_cast(float, (__builtin_bit_cast(unsigned, x) & ~0x7Fu) | e); }
                sort16_desc(v);
                if (eb == 0) {
#pragma unroll
                    for (int i = 0; i < 16; ++i) cur[i] = v[i];
                } else merge16_desc(cur, v);
            }
            float oth[16];
#pragma unroll
            for (int i = 0; i < 16; ++i) oth[i] = __shfl_xor(cur[i], 32);
            merge16_desc(cur, oth);
#pragma unroll
            for (int i = 0; i < 16; ++i) top[p][i] = cur[i];
            __builtin_amdgcn_sched_barrier(0);
        }
        float best[16];
#pragma unroll
        for (int gI = 0; gI < 4; ++gI) {
            float v[16];
#pragma unroll
            for (int q = 0; q < 16; ++q) {
                constexpr CandTab CT = make_cand_tab();
                const int ci = CT.i[16 * gI + q], cj = CT.j[16 * gI + q];
                if (ci >= 0) {
                    const unsigned ua = __builtin_bit_cast(unsigned, top[0][ci]), ub = __builtin_bit_cast(unsigned, top[1][cj]);
                    float s = top[0][ci] + top[1][cj]; asm volatile("" : "+v"(s));
                    const unsigned code = ((ua & 0x7Fu) << 7) | (ub & 0x7Fu);
                    v[q] = __builtin_bit_cast(float, (__builtin_bit_cast(unsigned, s) & ~0x3FFFu) | code);
                } else v[q] = -3.0e38f;
            }
            sort16_desc(v);
            if (gI == 0) {
#pragma unroll
                for (int i = 0; i < 16; ++i) best[i] = v[i];
            } else merge16_desc(best, v);
            __builtin_amdgcn_sched_barrier(0);
        }
        float e[16], sum = 0.f;
#pragma unroll
        for (int i = 0; i < 16; ++i) { e[i] = __builtin_amdgcn_exp2f((best[i] - best[0]) * LOG2E); sum += e[i]; }
        const float inv = 1.0f / sum;
        if (hi == 0) {
            u32x4 w0, w1;
            w0.x = (__builtin_bit_cast(unsigned, best[0]) & 0x3FFFu) | ((__builtin_bit_cast(unsigned, best[1]) & 0x3FFFu) << 16);
            w0.y = (__builtin_bit_cast(unsigned, best[2]) & 0x3FFFu) | ((__builtin_bit_cast(unsigned, best[3]) & 0x3FFFu) << 16);
            w0.z = (__builtin_bit_cast(unsigned, best[4]) & 0x3FFFu) | ((__builtin_bit_cast(unsigned, best[5]) & 0x3FFFu) << 16);
            w0.w = (__builtin_bit_cast(unsigned, best[6]) & 0x3FFFu) | ((__builtin_bit_cast(unsigned, best[7]) & 0x3FFFu) << 16);
            w1.x = (__builtin_bit_cast(unsigned, best[8]) & 0x3FFFu) | ((__builtin_bit_cast(unsigned, best[9]) & 0x3FFFu) << 16);
            w1.y = (__builtin_bit_cast(unsigned, best[10]) & 0x3FFFu) | ((__builtin_bit_cast(unsigned, best[11]) & 0x3FFFu) << 16);
            w1.z = (__builtin_bit_cast(unsigned, best[12]) & 0x3FFFu) | ((__builtin_bit_cast(unsigned, best[13]) & 0x3FFFu) << 16);
            w1.w = (__builtin_bit_cast(unsigned, best[14]) & 0x3FFFu) | ((__builtin_bit_cast(unsigned, best[15]) & 0x3FFFu) << 16);
            u32x4* ip = (u32x4*)(IDX + tok * 128 + h * 16);
            ip[0] = w0; ip[1] = w1;
        } else {
            f32x4* gp = (f32x4*)(GATE + tok * 128 + h * 16);
#pragma unroll
            for (int q = 0; q < 4; ++q) gp[q] = (f32x4){e[4 * q] * inv, e[4 * q + 1] * inv, e[4 * q + 2] * inv, e[4 * q + 3] * inv};
        }
    }
#undef TK_LDQ
    __syncthreads();
}

typedef long i64_t;
typedef unsigned u32x8_t __attribute__((ext_vector_type(8)));
typedef _Float16 h2_t __attribute__((ext_vector_type(2)));
#define U_MFMA4_FIRST(acc, av, bv) asm volatile("v_mfma_scale_f32_16x16x128_f8f6f4 %0, %1, %2, 0, %3, %4 op_sel_hi:[0,0,0] cbsz:4 blgp:4" : "=&v"(acc) : "v"(av), "v"(bv), "v"(sc_a), "v"(sc_one))
#define U_MFMA4(acc, av, bv) asm volatile("v_mfma_scale_f32_16x16x128_f8f6f4 %0, %1, %2, %0, %3, %4 op_sel_hi:[0,0,0] cbsz:4 blgp:4" : "+v"(acc) : "v"(av), "v"(bv), "v"(sc_a), "v"(sc_one))
template <int UVAR = 0>
__device__ __forceinline__ void peer_u_phase(const Ctx& F0, const Args& a, int layer) {
    const Ctx F = fresh(F0);
    const int s = (int)(blockIdx.x & 3), half = (int)((blockIdx.x >> 2) & 1), j = (int)(blockIdx.x >> 3), nmem = F.G >> 3;
    const unsigned char* U4s = a.ws + WS_TAB + (size_t)layer * TAB_LAYER + (size_t)s * NEXP * 128;
    const unsigned* XQ = (const unsigned*)(a.ws + WS_X8 + (size_t)s * ML * 256);
    const unsigned short* IDX = (const unsigned short*)(a.ws + WS_IDX);
    unsigned* PART = (unsigned*)(a.ws + WS_PART) + (size_t)s * ML * 64;
    const int lane = F.lane, rsub = lane >> 3, c8 = lane & 7, n16 = lane & 15, g4 = lane >> 4;
    LAS unsigned char* tile = F.lds + F.wave * 16384;
    constexpr float osc = 1.0f / (U_SCALE * XQ_SCALE);
    constexpr int MLH = ML / 2;
    const int t0 = half * MLH + j * NWAVES + F.wave, stride = nmem * NWAVES, ntok = (half * MLH + MLH - t0 + stride - 1) / stride;
    unsigned sc_one = 0x7f7f7f7fu; asm volatile("" : "+v"(sc_one));
    unsigned sc_a = (n16 & 1) ? 0x7d7d7d7du : 0x7f7f7f7fu; asm volatile("" : "+v"(sc_a));
    const int abase = (32 * (n16 & 1) + 4 * g4) * 4;
#define U_TOK(i) ((size_t)(t0 + ((i) < ntok ? (i) : ntok - 1) * stride))
    const unsigned wx0 = (unsigned)(size_t)(tile + rsub * 2048 + (c8 << 4));
    const unsigned rb0 = (unsigned)(size_t)(tile + n16 * 128 + ((g4 ^ ((n16 >> 1) & 7)) << 4));
    LAS unsigned char* stg = tile + g4 * 512 + n16 * 4;
#define U_LDXQ(i) (XQ[U_TOK(i) * 64 + lane])
#define U_LDI(i) (((const unsigned*)IDX)[U_TOK(i) * 64 + lane])
#define U_IDP(dst, ci) do { _Pragma("unroll") for (int k = 0; k < 8; ++k) dst[k] = (unsigned)__builtin_amdgcn_ds_bpermute((8 * rsub + k) * 4, (int)(ci)); } while (0)
#define U_EIDP(idp, i_) (((i_) & 1) ? (idp[(i_) >> 1] >> 16) : (idp[(i_) >> 1] & 0xffffu))
#define U_READS(nb0) do { \
        _Pragma("unroll") for (int nb = 0; nb < 4; ++nb) { _Pragma("unroll") for (int ks = 0; ks < 2; ++ks) \
            bw[nb][ks] = *(const LAS u32x4*)((LAS unsigned char*)(size_t)(rb0 ^ (64u * ks)) + 2048 * ((nb0) + nb)); } \
        __builtin_amdgcn_sched_barrier(0); \
    } while (0)
#define U_MFMAS() do { \
        _Pragma("unroll") for (int nb = 0; nb < 4; ++nb) U_MFMA4_FIRST(dA[nb], aop[0], bw[nb][0]); \
        _Pragma("unroll") for (int nb = 0; nb < 4; ++nb) U_MFMA4(dA[nb], aop[1], bw[nb][1]); \
        __builtin_amdgcn_sched_barrier(0); \
    } while (0)
#define U_OUTS(nb0) do { \
        asm volatile("s_nop 15\n\ts_nop 3" : "+v"(dA[0]), "+v"(dA[1]), "+v"(dA[2]), "+v"(dA[3]) :: "memory");     \
        _Pragma("unroll") for (int nb = 0; nb < 4; ++nb) { ov[(nb0) + nb] = dA[nb][0] + dA[nb][1]; asm volatile("" : "+v"(ov[(nb0) + nb])); } \
    } while (0)
#define U_BODY(j, CUR, NXT, LD) do { \
        unsigned idp[8]; \
        U_IDP(idp, ci##NXT);                                             \
          \
        _Pragma("unroll") for (int i_ = 0; i_ < 16; ++i_) { \
            *(LAS u32x4*)((LAS unsigned char*)(size_t)(wx0 ^ (unsigned)(((i_) >> 1) << 4)) + i_ * 128) = R[i_]; \
            if (UVAR == 0 || (UVAR == 1 && i_ < 8)) R[i_] = *(const u32x4*)(U4s + (unsigned)(U_EIDP(idp, i_) * 128 + 16 * c8)); \
        } \
          \
        u32x4 aop[2]; \
        _Pragma("unroll") for (int ks = 0; ks < 2; ++ks) { _Pragma("unroll") for (int k = 0; k < 4; ++k) { \
            const unsigned w_ = (unsigned)__builtin_amdgcn_ds_bpermute(abase + (16 * ks + k) * 4, (int)cx##CUR); \
            aop[ks][k] = (n16 < 2) ? w_ : 0u; } } \
        asm volatile("s_waitcnt lgkmcnt(0)" ::: "memory");               \
        f32x4 dA[4]; u32x4 bw[4][2]; float ov[8]; \
        U_READS(0); \
        U_MFMAS(); \
          \
        ci##CUR = U_LDI((j) + 3); cx##LD = U_LDXQ((j) + 2); \
        __builtin_amdgcn_sched_barrier(0); \
        U_READS(4);                                                      \
        U_OUTS(0); \
        U_MFMAS(); \
        U_OUTS(4); \
          \
        _Pragma("unroll") for (int nb = 0; nb < 8; ++nb) *(LAS float*)(stg + nb * 64) = ov[nb]; \
        asm volatile("s_waitcnt lgkmcnt(0)" ::: "memory"); \
        const f32x2 sum = *(const LAS f32x2*)(tile + 8 * lane); \
        asm volatile("s_waitcnt lgkmcnt(0)" ::: "memory"); \
        if ((j) < ntok) PART[U_TOK(j) * 64 + lane] = cvtpk(sum.x * osc, sum.y * osc); \
    } while (0)
    u32x4 R[16];
    unsigned cxA, cxB, cxC, ciA, ciB, ciC;
    ciA = U_LDI(0);
    cxA = U_LDXQ(0); cxB = U_LDXQ(1);
    { unsigned idp0[8]; U_IDP(idp0, ciA);
#pragma unroll
      for (int i_ = 0; i_ < 16; ++i_) R[i_] = *(const u32x4*)(U4s + (unsigned)(U_EIDP(idp0, i_) * 128 + 16 * c8)); }
    ciB = U_LDI(1); ciC = U_LDI(2);
    cxC = 0u;
    asm volatile("" :: "v"(ciC));
    for (int i = 0; i < ntok; i += 3) {
        U_BODY(i, A, B, C);
        U_BODY(i + 1, B, C, A);
        U_BODY(i + 2, C, A, B);
    }
#undef U_BODY
#undef U_READS
#undef U_MFMAS
#undef U_OUTS
#undef U_LDXQ
#undef U_LDI
#undef U_IDP
#undef U_EIDP
#undef U_TOK
}
#undef U_MFMA4_FIRST
#undef U_MFMA4
__device__ __forceinline__ void peer_w_phase(const Ctx& F0, const Args& a) {
    const Ctx F = fresh(F0);
    const unsigned* PART = (const unsigned*)(a.ws + WS_PART);
    const float* GATE = (const float*)(a.ws + WS_GATE);
    unsigned char* WQ = a.ws + WS_WT;
    float* WSC = (float*)(a.ws + WS_WSC);
    const int gwv = F.vcu * NWAVES + F.wave, NGW = F.G * NWAVES;
    unsigned pn[4]; f32x2 gn;
#define W_LD(t_) do { const int tt_ = (t_) < ML ? (t_) : ML - 1; _Pragma("unroll") for (int s = 0; s < 4; ++s) pn[s] = PART[((size_t)s * ML + tt_) * 64 + F.lane]; gn = *(const f32x2*)(GATE + (size_t)tt_ * 128 + 2 * F.lane); } while (0)
    W_LD(gwv);
    for (int t = gwv; t < ML; t += NGW) {
        f32x2 z = (f32x2){0.f, 0.f};
#pragma unroll
        for (int s = 0; s < 4; ++s) z += (f32x2){bflo(pn[s]), bfhi(pn[s])};
        const f32x2 g = gn;
        W_LD(t + NGW);
        f32x2 w; w.x = g.x * gelu_erf(z.x); w.y = g.y * gelu_erf(z.y);
        float wm = fmaxf(__builtin_fabsf(w.x), __builtin_fabsf(w.y));
#pragma unroll
        for (int o = 1; o < 64; o <<= 1) wm = fmaxf(wm, __shfl_xor(wm, o));
        wm = fmaxf(wm, 1e-20f);
        const float qs = 6.0f / wm, ax = fminf(fmaxf(w.x * qs, -6.f), 6.f), ay = fminf(fmaxf(w.y * qs, -6.f), 6.f);
        const unsigned ph = __builtin_amdgcn_cvt_scalef32_pk_fp4_f32(0u, ax, ay, 1.0f, 0) & 0xffu;
        const f32x2 dh = FP4_DEC(ph, 0);
        const unsigned pl = __builtin_amdgcn_cvt_scalef32_pk_fp4_f32(0u, fminf(fmaxf(4.f * (ax - dh.x), -6.f), 6.f), fminf(fmaxf(4.f * (ay - dh.y), -6.f), 6.f), 1.0f, 0) & 0xffu;
        ((unsigned short*)WQ)[(size_t)t * 128 + F.lane] = (unsigned short)((ph & 0xfu) | ((ph & 0xf0u) << 4));
        ((unsigned short*)WQ)[(size_t)t * 128 + 64 + F.lane] = (unsigned short)((pl & 0xfu) | ((pl & 0xf0u) << 4));
        if (F.lane == 0) WSC[t] = wm * (1.0f / 6.0f);
    }
#undef W_LD
}
#define V_MFMA4_FIRST(acc, av, bv, sa) asm volatile("v_mfma_scale_f32_16x16x128_f8f6f4 %0, %1, %2, 0, %3, %4 op_sel_hi:[0,0,0] cbsz:4 blgp:4" : "=&v"(acc) : "v"(av), "v"(bv), "v"(sa), "v"(sc_one))
#define V_MFMA4(acc, av, bv, sa) asm volatile("v_mfma_scale_f32_16x16x128_f8f6f4 %0, %1, %2, %0, %3, %4 op_sel_hi:[0,0,0] cbsz:4 blgp:4" : "+v"(acc) : "v"(av), "v"(bv), "v"(sa), "v"(sc_one))
template <int VAR = 0>
__device__ __forceinline__ void peer_v_phase(const Ctx& F0, const Args& a, int layer, float oscale = 1.0f) {
    const Ctx F = fresh(F0);
    const int s = (int)(blockIdx.x & 3), half = (int)((blockIdx.x >> 2) & 1), j = (int)(blockIdx.x >> 3), nmem = F.G >> 3;
    const unsigned char* V4s = a.ws + WS_TAB + (size_t)layer * TAB_LAYER + TAB_VOFF + (size_t)s * NEXP * 128;
    const unsigned short* IDX = (const unsigned short*)(a.ws + WS_IDX);
    const unsigned char* WQ = a.ws + WS_WT;
    const float* WSC = (const float*)(a.ws + WS_WSC);
    const float* modb = (const float*)(a.ws + WS_MOD) + (size_t)layer * 9 * NMOD;
    bf16_t* X = (bf16_t*)(a.ws + WS_XB);
    const int lane = F.lane, rsub = lane >> 3, c8 = lane & 7, n16 = lane & 15, g4 = lane >> 4;
    LAS unsigned char* tile = F.lds + F.wave * 16384;
    const float osc = ((DBG_SKIP & (layer == 0 ? 2 : 8)) ? 0.f : oscale) * (1.0f / V_SCALE);
    constexpr int MLH = ML / 2;
    const int t0 = half * MLH + j * NWAVES + F.wave, stride = nmem * NWAVES, ntok = (half * MLH + MLH - t0 + stride - 1) / stride;
    unsigned sc_one = 0x7f7f7f7fu; asm volatile("" : "+v"(sc_one));
    typedef int v2i_t __attribute__((ext_vector_type(2)));
    LAS float* gl = (LAS float*)(F.lds + RING_BYTES + 4096);
    for (int u = F.tid; u < 4 * 256; u += NWAVES * 64) gl[u] = modb[(size_t)(4 * half + (u >> 8)) * NMOD + 5 * DM + 256 * s + (u & 255)] * osc;
    __syncthreads();
#define V_TOK(i) ((size_t)(t0 + ((i) < ntok ? (i) : ntok - 1) * stride))
    LAS unsigned char* wx[4]; LAS unsigned char* rb[4];
#pragma unroll
    for (int k = 0; k < 4; ++k) wx[k] = tile + rsub * 2048 + ((c8 ^ k ^ ((rsub & 1) << 2)) << 4);
#pragma unroll
    for (int nb = 0; nb < 4; ++nb) rb[nb] = tile + g4 * 2048 + (n16 >> 1) * 128 + 8 * (n16 & 1) + ((nb ^ ((n16 >> 2) & 3) ^ ((g4 & 1) << 2)) << 4);
    LAS unsigned char* stg = tile + g4 * 1024 + n16 * 8;
#define V_LDW(i) (((const unsigned*)WQ)[V_TOK(i) * 64 + lane])
#define V_LDI(i) (((const unsigned*)IDX)[V_TOK(i) * 64 + lane])
#define V_LDX(i) (*(const u32x2*)(X + V_TOK(i) * DM + 256 * s + 4 * lane))
#define V_LDS(i) (WSC[V_TOK(i)])
#define V_IDP(dst, ci) do { _Pragma("unroll") for (int k = 0; k < 8; ++k) dst[k] = (unsigned)__builtin_amdgcn_ds_bpermute((8 * rsub + k) * 4, (int)(ci)); } while (0)
#define V_EIDP(idp, i_) (((i_) & 1) ? (idp[(i_) >> 1] >> 16) : (idp[(i_) >> 1] & 0xffffu))
#define V_READS(nb0) do { \
        unsigned x64 = (nb0) ? 64u : 0u; asm volatile("" : "+v"(x64));                   \
        _Pragma("unroll") for (int nb = 0; nb < 4; ++nb) { LAS unsigned char* rbn = (LAS unsigned char*)((unsigned)(size_t)rb[nb] ^ x64); \
          _Pragma("unroll") for (int h = 0; h < 2; ++h) { _Pragma("unroll") for (int q = 0; q < 2; ++q) { \
            const v2i_t tr = __builtin_amdgcn_ds_read_tr8_b64_v2i32((LAS v2i_t*)(rbn + 8192 * h + 1024 * q)); \
            bw[nb][h][2 * q] = (unsigned)tr[0]; bw[nb][h][2 * q + 1] = (unsigned)tr[1]; } } } \
        __builtin_amdgcn_sched_barrier(0); \
    } while (0)
#define V_MFMAS() do { \
        _Pragma("unroll") for (int nb = 0; nb < 4; ++nb) V_MFMA4_FIRST(dA[nb], aop[0], bw[nb][0], sc_a); \
        _Pragma("unroll") for (int nb = 0; nb < 4; ++nb) V_MFMA4(dA[nb], aop[1], bw[nb][1], sc_a); \
        __builtin_amdgcn_sched_barrier(0); \
    } while (0)
#define V_OUTS(nb0) do { \
        asm volatile("s_nop 15\n\ts_nop 3" : "+v"(dA[0]), "+v"(dA[1]), "+v"(dA[2]), "+v"(dA[3]) :: "memory");     \
        _Pragma("unroll") for (int nb = 0; nb < 4; ++nb) { ov[(nb0) + nb] = (f32x2){dA[nb][0] + dA[nb][2], dA[nb][1] + dA[nb][3]}; asm volatile("" : "+v"(ov[(nb0) + nb])); } \
    } while (0)
#define V_BODY(j, CUR, NXT, LD) do { \
        const size_t t_ = V_TOK(j); \
        unsigned idp[8]; \
        V_IDP(idp, ci##NXT);                                             \
          \
        _Pragma("unroll") for (int i_ = 0; i_ < 16; ++i_) { \
            *(LAS u32x4*)(wx[(i_ >> 1) & 3] + i_ * 128) = R[i_]; \
            if (VAR == 0 || (VAR == 1 && i_ < 8)) R[i_] = *(const u32x4*)(V4s + (unsigned)(V_EIDP(idp, i_) * 128 + 16 * c8)); \
        } \
          \
        u32x4 aop[2]; \
        _Pragma("unroll") for (int h = 0; h < 2; ++h) { _Pragma("unroll") for (int k = 0; k < 4; ++k) { \
            const unsigned w_ = (unsigned)__builtin_amdgcn_ds_bpermute(abase + (16 * h + k) * 4, (int)cw##CUR); \
            aop[h][k] = (n16 < 4) ? (w_ << ash) : 0u; } } \
        asm volatile("s_waitcnt lgkmcnt(0)" ::: "memory");               \
        f32x4 dA[4]; u32x4 bw[4][2]; f32x2 ov[8]; \
        V_READS(0); \
        V_MFMAS(); \
          \
        ci##CUR = V_LDI((j) + 3); cw##LD = V_LDW((j) + 2); xo##LD = V_LDX((j) + 2); ws##LD = V_LDS((j) + 2); \
        __builtin_amdgcn_sched_barrier(0); \
        V_READS(4);                                                      \
        V_OUTS(0); \
        V_MFMAS(); \
        V_OUTS(4); \
          \
        _Pragma("unroll") for (int nb = 0; nb < 8; ++nb) *(LAS f32x2*)(stg + nb * 128) = ov[nb]; \
        asm volatile("s_waitcnt lgkmcnt(0)" ::: "memory"); \
        const f32x4 sum = *(const LAS f32x4*)(tile + 16 * lane); \
        const f32x4 gt_ = *(const LAS f32x4*)(gl + ((t_ >> 12) & 3) * 256 + 4 * lane); \
        asm volatile("s_waitcnt lgkmcnt(0)" ::: "memory"); \
        if ((j) < ntok) { const f32x4 r_ = bf4_f32(xo##CUR) + gt_ * ws##CUR * sum; *(u32x2*)(X + t_ * DM + 256 * s + 4 * lane) = (u32x2){cvtpk(r_.x, r_.y), cvtpk(r_.z, r_.w)}; } \
    } while (0)
    u32x4 R[16];
    unsigned cwA, cwB, cwC, ciA, ciB, ciC;
    u32x2 xoA, xoB, xoC;
    float wsA, wsB, wsC;
    const int abase = (32 * ((n16 >> 1) & 1) + 4 * g4) * 4, ash = 4 * (n16 & 1);
    unsigned sc_a = (n16 & 2) ? 0x7d7d7d7du : 0x7f7f7f7fu; asm volatile("" : "+v"(sc_a));
    ciA = V_LDI(0);
    cwA = V_LDW(0); cwB = V_LDW(1); xoA = V_LDX(0); xoB = V_LDX(1); wsA = V_LDS(0); wsB = V_LDS(1);
    { unsigned idp0[8]; V_IDP(idp0, ciA);
#pragma unroll
      for (int i_ = 0; i_ < 16; ++i_) R[i_] = *(const u32x4*)(V4s + (unsigned)(V_EIDP(idp0, i_) * 128 + 16 * c8)); }
    ciB = V_LDI(1); ciC = V_LDI(2);
    cwC = 0u; xoC = (u32x2){0u, 0u}; wsC = 0.f;
    asm volatile("" :: "v"(ciC));
    for (int i = 0; i < ntok; i += 3) {
        V_BODY(i, A, B, C);
        V_BODY(i + 1, B, C, A);
        V_BODY(i + 2, C, A, B);
    }
#undef V_BODY
#undef V_READS
#undef V_MFMAS
#undef V_OUTS
#undef V_LDW
#undef V_LDI
#undef V_LDX
#undef V_LDS
#undef V_IDP
#undef V_EIDP
#undef V_TOK
}
#undef V_MFMA4_FIRST
#undef V_MFMA4

__device__ __forceinline__ void dft_nyquist_rows(const Ctx& F0, const Args& a) {
    const Ctx F = fresh(F0);
    const unsigned char* Yt = a.ws + WS_QK;
    const float* YN = (const float*)(a.ws + WS_YN);
    unsigned char* Fo = a.ws + WS_VT;
    const int gwv = F.vcu * NWAVES + F.wave, NGW = F.G * NWAVES;
    for (int o = gwv; o < NB * DM; o += NGW) {
        const unsigned char* src = Yt + (size_t)o * 4096;
        float s = 0.f;
#pragma unroll
        for (int it = 0; it < 2; ++it) { const u32x4 v = *(const u32x4*)(src + it * 1024 + F.lane * 16);
#pragma unroll
            for (int d = 0; d < 4; ++d) { const f32x2 lo = __builtin_amdgcn_cvt_pk_f32_fp8((int)v[d], false), hi = __builtin_amdgcn_cvt_pk_f32_fp8((int)v[d], true); s += (lo[0] - lo[1]) + (hi[0] - hi[1]); } }
        s = wave_sum(s) * (pg8::ACT8_SCALE / (64.0f * pg8::YT_SCALE)) + YN[o] * (pg8::ACT8_SCALE / 64.0f);
        if (F.lane == 0) Fo[((size_t)(o >> 10) * SEQ + 2048) * DM + (o & 1023)] = (unsigned char)(fp8_pack4(s, 0.f, 0.f, 0.f) & 0xffu);
    }
}
__device__ __forceinline__ void dft_yn_rows(const Ctx& F0, const Args& a) {
    const Ctx F = fresh(F0);
    const float* yi = (const float*)(a.ws + WS_YNI);
    const bf16_t* wc = (const bf16_t*)(a.ws + WS_WC);
    float* YN = (float*)(a.ws + WS_YN);
    const int gwv = F.vcu * NWAVES + F.wave, NGW = F.G * NWAVES;
    for (int o = gwv; o < NB * DM; o += NGW) {
        const int cp = o & 255;
        const f32x4 x = *(const f32x4*)(yi + (size_t)(o & ~255) + 4 * F.lane);
        const u32x2 w = *(const u32x2*)(wc + (size_t)cp * 256 + 4 * F.lane);
        const f32x4 wf = bf4_f32(w);
        const float s = wave_sum(x.x * wf.x + x.y * wf.y + x.z * wf.z + x.w * wf.w);
        if (F.lane == 0) YN[o] = s;
    }
}

__global__ void __launch_bounds__(NWAVES * 64, 2) fwd_kernel(Args args) {
    extern __shared__ __attribute__((aligned(16))) unsigned char lds_raw[];
    Ctx F;
    F.lds = (LAS unsigned char*)lds_raw;
    F.tid = threadIdx.x; F.lane = F.tid & 63; F.wave = __builtin_amdgcn_readfirstlane(F.tid >> 6);
    F.G = gridDim.x; { const int bx = blockIdx.x; F.vcu = (F.G % 8 == 0) ? (bx % 8) * (F.G / 8) + bx / 8 : bx; }
    volatile LAS unsigned* MISC = (volatile LAS unsigned*)(F.lds + MISC_OFF);
    for (int u = F.tid; u < (LDS_BYTES - LDSCTL_OFF) / 4; u += NWAVES * 64) ((LAS unsigned*)(F.lds + LDSCTL_OFF))[u] = 0u;
    __syncthreads();
    unsigned char* ws = args.ws;
    XcdBarrier bar = xcd_barrier_post((unsigned*)(ws + WS_CTL) + CW_BAR, MISC + 8);
#define GRID_BAR() xcd_barrier(bar)
#ifndef DBG_REP
#define DBG_REP 0
#endif
#ifndef DBG_VVAR
#define DBG_VVAR 0
#endif
#define REP(k, ...) do { __VA_ARGS__; if (DBG_REP == (k)) { GRID_BAR(); __VA_ARGS__; } } while (0)
#define PEER_BLOCK(layer) do { \
        norm_phase(F, args, 1, layer, 3 * DM, args.in[5] + (layer) * DM); \
        GRID_BAR(); \
        { using SHq = pg8::Shape<ML, 2048, DM / 2, DM / 2, DM / 2, 1, 0, 0>;       \
          REP(7, pg8::gemm_phase<SHq, pg8::EpiStoreBf16, true>(F.lds, pg8::Gemm{HX, (const bf16_t*)(ws + WS_WPQ) + (size_t)(layer) * 2048 * DM / 2}, F.G, bx, pg8::EpiStoreBf16{QKb, 2048, 0, 0, 1.0f, 1.0f / (pg8::ACT8_SCALE * pg8::W8_SCALE)})); } \
        GRID_BAR(); \
        REP(8, peer_topk_phase(F, args, layer)); \
        GRID_BAR(); \
        REP(9, peer_u_phase(F, args, layer)); \
        GRID_BAR(); \
        REP(10, peer_w_phase(F, args)); \
        GRID_BAR(); \
        peer_v_phase(F, args, layer); if (DBG_REP == 11) { GRID_BAR(); peer_v_phase<DBG_VVAR>(F, args, layer, 0.f); } \
        GRID_BAR(); \
    } while (0)
    const float* modb = (const float*)(ws + WS_MOD);
    bf16_t* HX = (bf16_t*)(ws + WS_HX);
    bf16_t* QKb = (bf16_t*)(ws + WS_QK);
    bf16_t* VTb = (bf16_t*)(ws + WS_VT);
    const bf16_t* Wqkv = (const bf16_t*)(ws + WS_WQKV);
    const int bx = (int)blockIdx.x;

    REP(1, p0_prologue(F, args));
    GRID_BAR();
    REP(2, norm_phase(F, args, 0, 0, 0, args.in[4]));
    GRID_BAR();
    {
        constexpr float o8 = 1.0f / (pg8::ACT8_SCALE * pg8::W8_SCALE);
        using SH1 = pg8::Shape<MT, 2048, DM / 2, DM / 2, DM / 2, 1, 0, 0>;
        pg8::gemm_phase<SH1, pg8::EpiStoreBf16, true>(F.lds, pg8::Gemm{HX, Wqkv}, F.G, bx, pg8::EpiStoreBf16{QKb, 2048, 0, 1024, 0.125f * LOG2E, o8});
        using SH2 = pg8::Shape<DM, MT, DM / 2, DM / 2, DM / 2, 1, 0, 0>;
        const int bxv = F.G - 1 - bx;
        pg8::gemm_phase<SH2, pg8::EpiStoreBf16, true>(F.lds, pg8::Gemm{Wqkv + (size_t)2048 * DM / 2, HX}, F.G, bxv, pg8::EpiStoreBf16{VTb, MT, 0, 0, 1.0f, o8});
        {
            const int nq = (MT / 256) * 8, nv = 4 * (MT / 256), rq = nq % F.G, rv = nv % F.G;
            const int sh_q = (rq == 0 || bx >= rq) ? 1 : 0, sh_v = (rv == 0 || bxv >= rv) ? 1 : 0;
            const int nq_sh = (rq == 0 ? F.G : F.G - rq);
            const int before_q = (rq == 0 ? bx : max(0, bx - rq)), before_v = nq_sh + ((rv == 0) ? bx : min(bx, F.G - rv));
            const int total = (rq == 0 ? F.G : F.G - rq) + (rv == 0 ? F.G : F.G - rv);
            if (sh_q) table_convert(F, args, before_q, 1, total);
            if (sh_v) table_convert(F, args, before_v, 1, total);
        }
    }
    GRID_BAR();
    REP(4, attn_phase(F, args));
    GRID_BAR();
    {
        using SH = pg8::Shape<ML, DM, DM / 2, DM / 2, DM / 2, 1, 0, 0>;
        pg8::gemm_phase<SH, pg8::EpiResid<false>, true>(F.lds, pg8::Gemm{(const bf16_t*)(ws + WS_HX + 36 * MiB), (const bf16_t*)(ws + WS_WO)}, F.G, bx, pg8::EpiResid<false>{args.in[0], (bf16_t*)(ws + WS_XB), modb + 2 * DM, NMOD, ((DBG_SKIP & 1) ? 0.f : 1.f) / (pg8::ACT8_SCALE * pg8::W8_SCALE)});
    }
    GRID_BAR();
    PEER_BLOCK(0);
    norm_fold_phase(F, args, 1, args.in[4] + DM);
    GRID_BAR();
    {
        using SH = pg8::Shape<256, ML / 2, 256, 256, DM, 4, 0, 256>;
        pg8::gemm_phase<SH>(F.lds, pg8::Gemm{(const bf16_t*)(ws + WS_WC), HX}, F.G, bx, pg8::EpiYt{(unsigned char*)QKb, 0});
        pg8::gemm_phase<SH>(F.lds, pg8::Gemm{(const bf16_t*)(ws + WS_WC) + 256 * 256, (const bf16_t*)(ws + WS_HX + 32 * MiB)}, F.G, bx, pg8::EpiYt{(unsigned char*)QKb, 1});
        dft_yn_rows(F, args);
    }
    GRID_BAR();
    {
        using SH = pg8::Shape<SEQ / 2, DM, 2048, 2048, 2048, NB, 0, (long)DM * 2048>;
        REP(14, pg8::gemm_phase<SH, pg8::EpiDft2, true>(F.lds, pg8::Gemm{(const bf16_t*)(ws + WS_CS), QKb}, F.G, bx, pg8::EpiDft2{(unsigned char*)VTb, (const float*)(ws + WS_YN)}));
        dft_nyquist_rows(F, args);
    }
    GRID_BAR();
    {
        using SH = pg8::Shape<ML, DM, DM / 2, DM / 2, DM / 2, 1, 0, 0>;
        pg8::gemm_phase<SH, pg8::EpiResid<true>, true>(F.lds, pg8::Gemm{VTb, (const bf16_t*)(ws + WS_WF)}, F.G, bx, pg8::EpiResid<true>{ws + WS_XB, (bf16_t*)(ws + WS_XB), modb + (size_t)9 * NMOD + 2 * DM, NMOD, ((DBG_SKIP & 4) ? 0.f : 1.f) / (pg8::ACT8_SCALE * pg8::W8_SCALE)});
    }
    GRID_BAR();
    PEER_BLOCK(1);
    if (DBG_REP == 20) { for (int r = 0; r < 16; ++r) GRID_BAR(); }
    final_norm_phase(F, args);
#undef PEER_BLOCK
}

extern "C" void kernel_launch(void* const* d_in, const int* in_sizes, int n_in, void* d_out, int out_size, void* d_ws, size_t ws_size, hipStream_t stream) {
    static int grid = 0;
    if (grid == 0) {
        if (n_in != 17 || in_sizes[0] != ML * DM || out_size != ML * DM || ws_size < WS_END) { fprintf(stderr, "kernel_launch: unexpected shapes (n_in %d, in0 %d, out %d, ws %zu)\n", n_in, n_in > 0 ? in_sizes[0] : -1, out_size, ws_size); grid = -1; return; }
        int dev = 0, cus = 0, per_cu = 0;
        if (hipGetDevice(&dev) != hipSuccess || hipDeviceGetAttribute(&cus, hipDeviceAttributeMultiprocessorCount, dev) != hipSuccess) { grid = -1; return; }
        if (hipFuncSetAttribute((const void*)fwd_kernel, hipFuncAttributeMaxDynamicSharedMemorySize, LDS_BYTES) != hipSuccess) { fprintf(stderr, "kernel_launch: hipFuncSetAttribute failed\n"); grid = -1; return; }
        if (hipOccupancyMaxActiveBlocksPerMultiprocessor(&per_cu, (const void*)fwd_kernel, NWAVES * 64, LDS_BYTES) != hipSuccess || per_cu < 1)
            fprintf(stderr, "kernel_launch: note: occupancy query reports %d workgroups per CU\n", per_cu);
        (void)hipGetLastError();
        grid = cus;
        if (grid % 8 != 0) { fprintf(stderr, "kernel_launch: CU count %d is not a multiple of 8\n", cus); grid = -1; return; }
    }
    if (grid < 0) return;
    if (hipMemsetAsync((char*)d_ws + WS_CTL, 0, CTL_ZERO_BYTES, stream) != hipSuccess) { fprintf(stderr, "kernel_launch: memset failed\n"); return; }
    Args a{};
    for (int i = 0; i < 17; ++i) a.in[i] = (const float*)d_in[i];
    a.out = (float*)d_out; a.ws = (unsigned char*)d_ws;
    hipLaunchKernelGGL(fwd_kernel, dim3(grid), dim3(NWAVES * 64), LDS_BYTES, stream, a);
    const hipError_t le = hipPeekAtLastError();
    if (le != hipSuccess) fprintf(stderr, "kernel_launch: launch failed: %s\n", hipGetErrorName(le));
}
```

```cpp
#include <hip/hip_runtime.h>
#include <cstdio>
#include <cstdint>

#define LAS __attribute__((address_space(3)))
typedef unsigned short bf16_t;
typedef short bf16x8 __attribute__((ext_vector_type(8)));
typedef short s16x4 __attribute__((ext_vector_type(4)));
typedef float f32x2 __attribute__((ext_vector_type(2)));
typedef float f32x4 __attribute__((ext_vector_type(4)));
typedef float f32x16 __attribute__((ext_vector_type(16)));
typedef unsigned u32x2 __attribute__((ext_vector_type(2)));
typedef unsigned u32x4 __attribute__((ext_vector_type(4)));
typedef __bf16 bf16x2_t __attribute__((ext_vector_type(2)));

#ifndef DBG_SKIP
#define DBG_SKIP 0
#endif
constexpr int DM = 1024, NB = 8, SEQ = 4096, CTXL = 256, GW = 64;
constexpr int ML = NB * SEQ;
constexpr int MC = NB * CTXL;
constexpr int MT = ML + MC;
constexpr int NMOD = 6 * DM;
constexpr int NEXP = 16384;
constexpr float EPS = 1e-6f;
constexpr float LOG2E = 1.4426950408889634f;

constexpr size_t MiB = 1u << 20;
constexpr size_t WS_CTL = 0, CTL_ZERO_BYTES = 1 * MiB;
constexpr size_t WS_MOD = 1 * MiB;
constexpr size_t WS_WQKV = 2 * MiB;
constexpr size_t WS_WO = 8 * MiB;
constexpr size_t WS_WF = 10 * MiB;
constexpr size_t WS_WPQ = 12 * MiB;
constexpr size_t WS_SK = 20 * MiB;
constexpr size_t WS_WC = 20 * MiB + 256 * 1024;
constexpr size_t WS_CS = 22 * MiB;
constexpr size_t WS_TAB = 38 * MiB;
constexpr size_t WS_X8 = 150 * MiB;
constexpr size_t WS_WT = 182 * MiB;
constexpr size_t WS_PART = 282 * MiB;
constexpr float U_SCALE = 64.f;
constexpr float XQ_SCALE = 0.75f;
constexpr float V_SCALE = 2.f;
constexpr size_t WS_XB = 70 * MiB;
constexpr size_t TAB_LAYER = 16 * MiB, TAB_VOFF = 8 * MiB;
constexpr size_t WS_WSC = 198 * MiB;
constexpr size_t WS_YNI = 199 * MiB;
constexpr size_t WS_YN = WS_YNI + 64 * 1024;
constexpr size_t WS_HX = 214 * MiB;
constexpr size_t WS_QK = 282 * MiB;
constexpr size_t WS_VT = 418 * MiB;
constexpr size_t WS_IDX = WS_VT;
constexpr size_t WS_GATE = WS_VT + 8 * MiB;
constexpr size_t WS_END = 486 * MiB;
constexpr int CW_BAR = 4096;

__device__ __forceinline__ unsigned f2bf(float f) { unsigned u = __builtin_bit_cast(unsigned, f); return (u + 0x7fffu + ((u >> 16) & 1u)) >> 16; }
__device__ __forceinline__ unsigned pk2(float lo, float hi) { return f2bf(lo) | (f2bf(hi) << 16); }
__device__ __forceinline__ f32x4 bf4_f32(u32x2 w) { return (f32x4){__builtin_bit_cast(float, w.x << 16), __builtin_bit_cast(float, w.x & 0xffff0000u), __builtin_bit_cast(float, w.y << 16), __builtin_bit_cast(float, w.y & 0xffff0000u)}; }
__device__ __forceinline__ unsigned cvtpk(float lo, float hi) { f32x2 v = {lo, hi}; bf16x2_t b = __builtin_convertvector(v, bf16x2_t); return __builtin_bit_cast(unsigned, b); }
__device__ __forceinline__ float bflo(unsigned u) { return __builtin_bit_cast(float, u << 16); }
__device__ __forceinline__ float bfhi(unsigned u) { return __builtin_bit_cast(float, u & 0xffff0000u); }
__device__ __forceinline__ float wave_sum(float v) {
#pragma unroll
    for (int o = 1; o < 64; o <<= 1) v += __shfl_xor(v, o);
    return v;
}
__device__ __forceinline__ unsigned fp8_pack4(float a, float b, float c, float d) {
    int w = 0;
    w = __builtin_amdgcn_cvt_pk_fp8_f32(__builtin_amdgcn_fmed3f(a, -448.f, 448.f), __builtin_amdgcn_fmed3f(b, -448.f, 448.f), w, false);
    w = __builtin_amdgcn_cvt_pk_fp8_f32(__builtin_amdgcn_fmed3f(c, -448.f, 448.f), __builtin_amdgcn_fmed3f(d, -448.f, 448.f), w, true);
    return (unsigned)w;
}
__device__ __forceinline__ int crow(int r, int hi) { return (r & 3) + 8 * (r >> 2) + 4 * hi; }
__device__ __forceinline__ float gelu_erf(float v) {
    const float av = __builtin_fabsf(v), d = av * 0.2316418882f + 1.0f;
    const float t = __builtin_amdgcn_rcpf(d);
    float q = t * 0.5307027145f + (-0.7265760135f); q = q * t + 0.7107068705f; q = q * t + (-0.142248368f); q = q * t + 0.127414796f; q = q * t;
    const float e = __builtin_amdgcn_exp2f((v * v) * (-0.72134752044f));
    const float m = v * (q * e), r = v - m;
    return v < 0.f ? m : r;
}

namespace pg8 {
constexpr float ACT8_SCALE = 16.f, W8_SCALE = 256.f;
constexpr float YT_SCALE = 16.f, CS_SCALE = 512.f;
constexpr int BM = 256, BK = 64, HALF = 128, HTB = HALF * BK * 2, STAGE_BYTES = 8 * HTB, NXCD = 8, WGM = 8;
__host__ __device__ __forceinline__ int lds_byte(int r, int c) { const int st = (r >> 4) * 2 + (c >> 5), rr = r & 15, cc = c & 31, ob = rr * 64 + cc * 2; return st * 1024 + (ob ^ (((ob >> 9) & 1) << 5)); }
__host__ __device__ __forceinline__ void stage_rc(int b, int& R, int& C) { const int st = b / 1024, sb = b % 1024, swz = sb ^ (((sb >> 9) & 1) << 5); R = (st >> 1) * 16 + swz / 64; C = (st & 1) * 32 + (swz % 64) / 2; }
__host__ __device__ __forceinline__ int perm32(int rho) { const int n = rho >> 4, i = rho & 15; return 8 * (i >> 2) + 4 * n + (i & 3); }

struct Unit { int pm, pn, pb; };
struct Gemm { const bf16_t* A; const bf16_t* Bt; };
template <int M_, int N_, int K_, int LDA_, int LDB_, int NBATCH_, long BSA_, long BSB_> struct Shape { static constexpr int M = M_, N = N_, K = K_, lda = LDA_, ldb = LDB_, nbatch = NBATCH_; static constexpr long bsA = BSA_, bsB = BSB_; };

template <class SH> struct StaticOrder {
    static constexpr int nM = SH::M / BM, nN = SH::N / BM, per = nM * nN, nwg = per * SH::nbatch;
    int G, c;
    __device__ __forceinline__ void init(int G_, int c_) { G = G_; c = c_; }
    __device__ __forceinline__ bool next(int i, Unit& u) const {
        const long L = (long)i * G + c; if (L >= nwg) return false;
        int wgid = (int)L; { const int q = nwg / NXCD, r = nwg % NXCD, xcd = wgid % NXCD, off = wgid / NXCD; wgid = (xcd < r ? xcd * (q + 1) : r * (q + 1) + (xcd - r) * q) + off; }
        u.pb = wgid / per; wgid -= u.pb * per;
        const int nig = WGM * nN, gid = wgid / nig, fm = gid * WGM, gsz = (nM - fm) < WGM ? (nM - fm) : WGM;
        u.pm = fm + ((wgid % nig) % gsz); u.pn = (wgid % nig) / gsz; return true;
    }
};

struct EpiStoreBf16 {
    static constexpr bool PERM = true;
    bf16_t* O; long ldc; long bstride; int scols; float scale0; float oscale = 1.0f;
    __device__ __forceinline__ void operator()(const f32x4 (&acc)[2][2][4][2], const Unit& u, int wr, int wc, int fr, int fq) const {
        const int row0 = u.pm * BM + wr * 64 + fr, col0 = u.pn * BM + wc * 32 + 8 * fq;
        bf16_t* base = O + (long)u.pb * bstride;
        const float sc = ((u.pn * BM < scols) ? scale0 : 1.0f) * oscale;
#pragma unroll
        for (int ai = 0; ai < 2; ++ai)
#pragma unroll
            for (int m = 0; m < 4; ++m) { bf16_t* rowp = base + (long)(row0 + ai * HALF + m * 16) * ldc + col0;
#pragma unroll
                for (int bj = 0; bj < 2; ++bj) { const f32x4 v0 = acc[ai][bj][m][0] * sc, v1 = acc[ai][bj][m][1] * sc;
                    u32x4 w; w.x = cvtpk(v0[0], v0[1]); w.y = cvtpk(v0[2], v0[3]); w.z = cvtpk(v1[0], v1[1]); w.w = cvtpk(v1[2], v1[3]);
                    *(u32x4*)(rowp + bj * HALF) = w; } }
    }
};
struct EpiDft2 {
    static constexpr bool PERM = true;
    unsigned char* O; const float* yn;
    __device__ __forceinline__ void operator()(const f32x4 (&acc)[2][2][4][2], const Unit& u, int wr, int wc, int fr, int fq) const {
        const int row0 = u.pm * BM + wr * 64 + fr, cl0 = wc * 32 + 8 * fq;
        unsigned char* base = O + (long)u.pb * SEQ * DM + u.pn * BM;
        constexpr float osc = ACT8_SCALE / (YT_SCALE * CS_SCALE);
        f32x4 y0[2], y1[2];
#pragma unroll
        for (int bj = 0; bj < 2; ++bj) { const float* yp = yn + (long)u.pb * DM + u.pn * BM + cl0 + bj * HALF; y0[bj] = *(const f32x4*)yp * (ACT8_SCALE / 64.0f); y1[bj] = *(const f32x4*)(yp + 4) * (ACT8_SCALE / 64.0f); }
#pragma unroll
        for (int ai = 0; ai < 2; ++ai)
#pragma unroll
            for (int m = 0; m < 4; ++m) { const int np = row0 + ai * HALF + m * 16;
                unsigned char* rowp = base + (long)np * DM; unsigned char* mirp = base + (long)(SEQ - np) * DM;
#pragma unroll
                for (int bj = 0; bj < 2; ++bj) { const float sg = (np & 1) ? -1.0f : 1.0f; const f32x4 v0 = acc[ai][bj][m][0] * osc + y0[bj] * sg, v1 = acc[ai][bj][m][1] * osc + y1[bj] * sg; const int cl = cl0 + bj * HALF;
                    u32x2 w; w.x = fp8_pack4(v0[0], v0[1], v0[2], v0[3]); w.y = fp8_pack4(v1[0], v1[1], v1[2], v1[3]);
                    *(u32x2*)(rowp + cl) = w;
                    if (np != 0) {
#pragma unroll
                        for (int i = 0; i < 8; ++i) mirp[(256 - cl - i) & 255] = (unsigned char)((w[i >> 2] >> (8 * (i & 3))) & 0xffu); } }
                asm volatile("" ::: "memory"); }
    }
};
struct EpiYt {
    static constexpr bool PERM = true;
    unsigned char* Yt; int part;
    __device__ __forceinline__ void operator()(const f32x4 (&acc)[2][2][4][2], const Unit& u, int wr, int wc, int fr, int fq) const {
        const int row0 = u.pm * BM + wr * 64 + fr, col0 = u.pn * BM + wc * 32 + 8 * fq;
#pragma unroll
        for (int ai = 0; ai < 2; ++ai)
#pragma unroll
            for (int m = 0; m < 4; ++m) { const int cp = row0 + ai * HALF + m * 16;
#pragma unroll
                for (int bj = 0; bj < 2; ++bj) { const int col = col0 + bj * HALF; const int b = col >> 11, k = col & 2047;
                    const f32x4 v0 = acc[ai][bj][m][0] * YT_SCALE, v1 = acc[ai][bj][m][1] * YT_SCALE;
                    u32x2 w; w.x = fp8_pack4(v0[0], v0[1], v0[2], v0[3]); w.y = fp8_pack4(v1[0], v1[1], v1[2], v1[3]);
                    *(u32x2*)(Yt + (((long)(b * 4 + u.pb) * 256 + cp) << 12) + part * 2048 + k) = w; }
                asm volatile("" ::: "memory"); }
    }
};
template <bool IN_BF16>
struct EpiResid {
    static constexpr bool PERM = false;
    const void* Xin; bf16_t* Xout; const float* gate; int gstride; float gs;
    __device__ __forceinline__ void operator()(const f32x4 (&acc)[2][2][4][2], const Unit& u, int wr, int wc, int fr, int fq) const {
        const int row0 = u.pm * BM + wr * 64 + fr, col0 = u.pn * BM + wc * 32 + 4 * fq;
        const float* gb = gate + (long)((u.pm * BM) >> 12) * gstride;
        f32x4 gv[2][2];
#pragma unroll
        for (int bj = 0; bj < 2; ++bj)
#pragma unroll
            for (int n = 0; n < 2; ++n) gv[bj][n] = *(const f32x4*)(gb + col0 + bj * HALF + n * 16);
        f32x4 xf[2][8]; u32x2 xb[2][8];
#define ER_OFF(b_, k_) ((long)(row0 + ((b_) >> 1) * HALF + (2 * ((b_) & 1) + ((k_) >> 2)) * 16) * DM + col0 + (((k_) >> 1) & 1) * HALF + ((k_) & 1) * 16)
#define ER_LOAD(b_) do { _Pragma("unroll") for (int k_ = 0; k_ < 8; ++k_) { const long o_ = ER_OFF(b_, k_); \
            if (IN_BF16) xb[(b_) & 1][k_] = *(const u32x2*)((const bf16_t*)Xin + o_); else xf[(b_) & 1][k_] = *(const f32x4*)((const float*)Xin + o_); } } while (0)
        ER_LOAD(0);
#pragma unroll
        for (int b_ = 0; b_ < 4; ++b_) {
            if (b_ + 1 < 4) ER_LOAD(b_ + 1);
#pragma unroll
            for (int k_ = 0; k_ < 8; ++k_) { const long o_ = ER_OFF(b_, k_); const int ai = b_ >> 1, m = 2 * (b_ & 1) + (k_ >> 2), bj = (k_ >> 1) & 1, n = k_ & 1;
                const f32x4 bs = IN_BF16 ? bf4_f32(xb[b_ & 1][k_]) : xf[b_ & 1][k_];
                const f32x4 r_ = bs + gv[bj][n] * acc[ai][bj][m][n] * gs;
                *(u32x2*)(Xout + o_) = (u32x2){cvtpk(r_.x, r_.y), cvtpk(r_.z, r_.w)}; }
            asm volatile("" ::: "memory");
        }
#undef ER_OFF
#undef ER_LOAD
    }
};

template <class SH, class Epi, bool FP8 = false>
__device__ __forceinline__ void gemm_phase(LAS unsigned char* lds, const Gemm g, int G_, int c_, const Epi& E) {
    StaticOrder<SH> S; S.init(G_, c_);
    int tid_ = threadIdx.x; asm volatile("" : "+v"(tid_));
    const int tid = tid_, wid = __builtin_amdgcn_readfirstlane(tid >> 6), lane = tid & 63, wr = wid >> 2, wc = wid & 3, fr = lane & 15, fq = lane >> 4;
    constexpr int K = SH::K, nt = K / BK;
    unsigned voffA[2], voffB[2];
#pragma unroll
    for (int i = 0; i < 2; ++i) { int R, C; stage_rc(tid * 16 + i * 8192, R, C); const int Rb = Epi::PERM ? ((R & ~31) + perm32(R & 31)) : R;
        voffA[i] = (unsigned)(R * SH::lda + C) * 2u; voffB[i] = (unsigned)(Rb * SH::ldb + C) * 2u; }
    constexpr size_t kstep = (size_t)(BK * 2);
    constexpr size_t hstepA = (size_t)HALF * SH::lda * 2, hstepB = (size_t)HALF * SH::ldb * 2;
    constexpr size_t tstepA = 2 * hstepA, tstepB = 2 * hstepB;
    const unsigned ldsw = (unsigned)wid * 1024u;
    const int aoff = lds_byte(wr * 64 + fr, fq * 8), boff = lds_byte(wc * 32 + fr, fq * 8);
#define PG8_SA(b, h) (((b) * 2 + (h)) * HTB)
#define PG8_SB(b, h) ((4 + (b) * 2 + (h)) * HTB)
#define PG8_STAGE(bufoff, gbase, voff) do { _Pragma("unroll") for (int _i = 0; _i < 2; ++_i) \
        __builtin_amdgcn_global_load_lds((const unsigned*)((const char*)(gbase) + (voff)[_i]), (LAS unsigned*)(lds + (bufoff) + ldsw + _i * 8192), 16, 0, 0); } while (0)
#define PG8_LDA(dst, b, h) do { _Pragma("unroll") for (int m = 0; m < 4; ++m) { const u32x4 f0_ = *(const LAS u32x4*)(lds + PG8_SA(b, h) + aoff + m * 2048), f1_ = *(const LAS u32x4*)(lds + PG8_SA(b, h) + aoff + m * 2048 + 1024); dst[m] = __builtin_shufflevector(f0_, f1_, 0, 1, 2, 3, 4, 5, 6, 7); } } while (0)
#define PG8_LDB(dst, b, h) do { _Pragma("unroll") for (int n = 0; n < 2; ++n) { const u32x4 f0_ = *(const LAS u32x4*)(lds + PG8_SB(b, h) + boff + n * 2048), f1_ = *(const LAS u32x4*)(lds + PG8_SB(b, h) + boff + n * 2048 + 1024); dst[n] = __builtin_shufflevector(f0_, f1_, 0, 1, 2, 3, 4, 5, 6, 7); } } while (0)
typedef int v8i_t __attribute__((ext_vector_type(8)));
typedef unsigned u32x8 __attribute__((ext_vector_type(8)));
#define PG8_LOH(x) __builtin_bit_cast(bf16x8, __builtin_shufflevector(x, x, 0, 1, 2, 3))
#define PG8_HIH(x) __builtin_bit_cast(bf16x8, __builtin_shufflevector(x, x, 4, 5, 6, 7))
#define PG8_MMA(ai, bj, At, Bt) do { __builtin_amdgcn_s_setprio(1); _Pragma("unroll") for (int m = 0; m < 4; ++m) _Pragma("unroll") for (int n = 0; n < 2; ++n) { \
        if constexpr (FP8) asm volatile("v_mfma_scale_f32_16x16x128_f8f6f4 %0, %1, %2, %0, %3, %3 op_sel_hi:[0,0,0]" : "+v"(acc[ai][bj][m][n]) : "v"(Bt[n]), "v"(At[m]), "v"(fp8_one));   \
        else { acc[ai][bj][m][n] = __builtin_amdgcn_mfma_f32_16x16x32_bf16(PG8_LOH(Bt[n]), PG8_LOH(At[m]), acc[ai][bj][m][n], 0, 0, 0); \
               acc[ai][bj][m][n] = __builtin_amdgcn_mfma_f32_16x16x32_bf16(PG8_HIH(Bt[n]), PG8_HIH(At[m]), acc[ai][bj][m][n], 0, 0, 0); } } \
        __builtin_amdgcn_s_setprio(0); } while (0)
#define PG8_WAIT_V(n) asm volatile("s_waitcnt vmcnt(" #n ")" ::: "memory")
#define PG8_WAIT_L(n) asm volatile("s_waitcnt lgkmcnt(" #n ")" ::: "memory")
#define PG8_BAR __builtin_amdgcn_s_barrier()
#define PG8_SCHED __builtin_amdgcn_sched_barrier(0)
    Unit cur, nxt; int ui = 0;
    if (!S.next(0, cur)) return;
    f32x4 acc[2][2][4][2];
#pragma unroll
    for (int a = 0; a < 2; ++a)
#pragma unroll
        for (int b = 0; b < 2; ++b)
#pragma unroll
            for (int m = 0; m < 4; ++m)
#pragma unroll
                for (int n = 0; n < 2; ++n) acc[a][b][m][n] = (f32x4){0.f, 0.f, 0.f, 0.f};
    unsigned fp8_one = 0x7f7f7f7fu; asm volatile("" : "+v"(fp8_one));
    u32x8 At[4], B0[2], B1[2];
    const char* cA = (const char*)(g.A + (long)cur.pb * SH::bsA) + (size_t)cur.pm * tstepA; const char* cB = (const char*)(g.Bt + (long)cur.pb * SH::bsB) + (size_t)cur.pn * tstepB;
    PG8_STAGE(PG8_SB(0, 0), cB, voffB); PG8_STAGE(PG8_SB(0, 1), cB + hstepB, voffB); PG8_STAGE(PG8_SA(0, 0), cA, voffA); PG8_STAGE(PG8_SA(0, 1), cA + hstepA, voffA);
    if (wr == 1) PG8_BAR;
    PG8_WAIT_V(2); PG8_BAR;
    PG8_STAGE(PG8_SB(1, 0), cB + kstep, voffB); PG8_STAGE(PG8_SA(1, 0), cA + kstep, voffA); PG8_STAGE(PG8_SB(1, 1), cB + hstepB + kstep, voffB);
    PG8_WAIT_V(6); PG8_BAR;
    for (;;) {
        const bool has_next = S.next(ui + 1, nxt);
        const char* nA = has_next ? (const char*)(g.A + (long)nxt.pb * SH::bsA) + (size_t)nxt.pm * tstepA : cA; const char* nB = has_next ? (const char*)(g.Bt + (long)nxt.pb * SH::bsB) + (size_t)nxt.pn * tstepB : cB;
#pragma nounroll
        for (int t = 0; t < nt; t += 2) {
            const bool last = (t == nt - 2);
            const char* a1 = cA + (size_t)(t + 1) * kstep;
            const char* a2 = last ? nA : cA + (size_t)(t + 2) * kstep; const char* b2 = last ? nB : cB + (size_t)(t + 2) * kstep;
            const char* a3 = a2 + kstep; const char* b3 = b2 + kstep;
            PG8_LDB(B0, 0, 0); PG8_LDB(B1, 0, 1); PG8_SCHED; PG8_LDA(At, 0, 0); PG8_STAGE(PG8_SA(1, 1), a1 + hstepA, voffA);
            PG8_WAIT_V(8); PG8_WAIT_L(0); PG8_BAR; PG8_MMA(0, 0, At, B0); PG8_MMA(0, 1, At, B1); PG8_BAR; PG8_SCHED;
            PG8_LDA(At, 0, 1); PG8_STAGE(PG8_SB(0, 0), b2, voffB); PG8_STAGE(PG8_SB(0, 1), b2 + hstepB, voffB); PG8_STAGE(PG8_SA(0, 0), a2, voffA);
            PG8_WAIT_V(8); PG8_WAIT_L(0); PG8_BAR; PG8_MMA(1, 0, At, B0); PG8_MMA(1, 1, At, B1); PG8_BAR; PG8_SCHED;
            PG8_LDB(B0, 1, 0); PG8_LDB(B1, 1, 1); PG8_SCHED; PG8_LDA(At, 1, 0); PG8_STAGE(PG8_SA(0, 1), a2 + hstepA, voffA);
            PG8_WAIT_V(8); PG8_WAIT_L(0); PG8_BAR; PG8_MMA(0, 0, At, B0); PG8_MMA(0, 1, At, B1); PG8_BAR; PG8_SCHED;
            PG8_LDA(At, 1, 1); PG8_STAGE(PG8_SB(1, 0), b3, voffB); PG8_STAGE(PG8_SB(1, 1), b3 + hstepB, voffB); PG8_STAGE(PG8_SA(1, 0), a3, voffA);
            PG8_WAIT_V(8); PG8_WAIT_L(0); PG8_BAR; PG8_MMA(1, 0, At, B0); PG8_MMA(1, 1, At, B1); PG8_BAR; PG8_SCHED;
        }
        if (wr == 0) PG8_BAR;
        if constexpr (FP8) asm volatile("s_nop 15\n\ts_nop 15\n\ts_nop 7" ::: "memory");
        E(acc, cur, wr, wc, fr, fq);
        if (!has_next) break;
#pragma unroll
        for (int a = 0; a < 2; ++a)
#pragma unroll
            for (int b = 0; b < 2; ++b)
#pragma unroll
                for (int m = 0; m < 4; ++m)
#pragma unroll
                    for (int n = 0; n < 2; ++n) acc[a][b][m][n] = (f32x4){0.f, 0.f, 0.f, 0.f};
        cur = nxt; cA = nA; cB = nB; ++ui;
        if (wr == 1) PG8_BAR;
    }
    PG8_WAIT_V(0);
    PG8_BAR;
#undef PG8_SA
#undef PG8_SB
#undef PG8_STAGE
#undef PG8_LDA
#undef PG8_LDB
#undef PG8_MMA
#undef PG8_WAIT_V
#undef PG8_WAIT_L
#undef PG8_BAR
#undef PG8_SCHED
}
}

#define XB_TMO      128
#define XB_XCNT(j)  (256  + 64 * (j))
#define XB_XSUB(j)  (1280 + 64 * (j))
#define XB_XGEN(j)  (2304 + 64 * (j))
#define XB_TOP      3328
#define XB_TOPGEN   3392
#define XCD_BAR_WORDS 3456
#define XB_SPIN_CAP (1u << 18)
__device__ __forceinline__ unsigned xb_ld(unsigned* p)              { return __hip_atomic_load(p, __ATOMIC_RELAXED, __HIP_MEMORY_SCOPE_AGENT); }
__device__ __forceinline__ unsigned xb_add(unsigned* p, unsigned v) { return __hip_atomic_fetch_add(p, v, __ATOMIC_RELAXED, __HIP_MEMORY_SCOPE_AGENT); }
__device__ __forceinline__ unsigned xb_xcc_id() { return (unsigned)__builtin_amdgcn_s_getreg((3 << 11) | 20) & 0xFu; }
#define XB_SPIN(cond, bar) do { unsigned _sp = 0; while (cond) { __builtin_amdgcn_s_sleep(1); \
    if ((++_sp & 255u) == 0u) { if (xb_ld(&(bar)[XB_TMO])) break; if (_sp > XB_SPIN_CAP) { atomicAdd(&(bar)[XB_TMO], 1u); break; } } } } while (0)
struct XcdBarrier { unsigned* bar; unsigned x; volatile LAS unsigned* st; };
__device__ __forceinline__ XcdBarrier xcd_barrier_post(unsigned* bar, volatile LAS unsigned* st) {
    XcdBarrier b; b.bar = bar; b.x = xb_xcc_id(); b.st = st;
    if (threadIdx.x == 0) (void)xb_add(&bar[XB_XCNT(b.x)], 1u);
    return b;
}
__device__ __forceinline__ void xcd_barrier_complete(unsigned* bar, unsigned x, unsigned& nloc, unsigned& nx) {
    const unsigned G = gridDim.x * gridDim.y * gridDim.z;
    unsigned sum, cnt, mine, sp = 0u;
    for (;;) {
        sum = 0u; cnt = 0u; mine = 0u;
#pragma unroll
        for (unsigned j = 0; j < 16; ++j) { const unsigned c = xb_ld(&bar[XB_XCNT(j)]); sum += c; cnt += (c > 0u) ? 1u : 0u; mine = (j == x) ? c : mine; }
        if (sum == G) break;
        __builtin_amdgcn_s_sleep(1);
        if ((++sp & 255u) == 0u) { if (xb_ld(&bar[XB_TMO])) break; if (sp > XB_SPIN_CAP) { atomicAdd(&bar[XB_TMO], 1u); break; } }
    }
    nloc = mine > 0u ? mine : 1u; nx = cnt > 0u ? cnt : 1u;
}
__device__ __forceinline__ void xcd_barrier(const XcdBarrier& b) {
    asm volatile("s_waitcnt vmcnt(0)" ::: "memory");
    __syncthreads();
    if (threadIdx.x == 0) {
        unsigned* bar = b.bar;
        __builtin_amdgcn_s_waitcnt(0);
        unsigned nloc = b.st[0], nx = b.st[1];
        if (nloc == 0u) { xcd_barrier_complete(bar, b.x, nloc, nx); b.st[0] = nloc; b.st[1] = nx; }
        const unsigned old = xb_add(&bar[XB_XSUB(b.x)], 1u);
        const unsigned gen = old / nloc;
        if (old + 1u == (gen + 1u) * nloc) {
            __builtin_amdgcn_fence(__ATOMIC_RELEASE, "agent");
            asm volatile("s_waitcnt vmcnt(0)" ::: "memory");
            const unsigned og = xb_add(&bar[XB_TOP], 1u);
            const unsigned tg = og / nx;
            if (og + 1u == (tg + 1u) * nx) xb_add(&bar[XB_TOPGEN], 1u);
            else XB_SPIN(xb_ld(&bar[XB_TOPGEN]) == tg, bar);
            __builtin_amdgcn_fence(__ATOMIC_ACQUIRE, "agent");
            xb_add(&bar[XB_XGEN(b.x)], 1u);
            asm volatile("s_waitcnt vmcnt(0)" ::: "memory");
        } else {
            XB_SPIN(xb_ld(&bar[XB_XGEN(b.x)]) == gen, bar);
            __builtin_amdgcn_fence(__ATOMIC_ACQUIRE, "agent");
            asm volatile("s_waitcnt vmcnt(0)" ::: "memory");
        }
    }
    __syncthreads();
}

constexpr int RING_BYTES = 131072;
constexpr int LDSCTL_OFF = RING_BYTES, MISC_OFF = LDSCTL_OFF + 320;
constexpr int LDS_BYTES = 147456;
constexpr int NWAVES = 8;

struct Args { const float* in[17]; float* out; unsigned char* ws; };

struct Ctx {
    LAS unsigned char* lds;
    int tid, lane, wave, vcu, G;
};

__device__ __forceinline__ Ctx fresh(const Ctx& F) {
    Ctx C = F; int t = threadIdx.x; asm volatile("" : "+v"(t)); C.tid = t; C.lane = t & 63; return C;
}
__device__ __forceinline__ void p0_transpose_item(const float* W, int K, int N, bf16_t* WT, LAS float* scr, int item, int lane) {
    const int nblk = N / 32, kb = item / nblk, nb = item % nblk, k0 = 64 * kb, n0 = 32 * nb;
#pragma unroll 8
    for (int i = 0; i < 32; ++i) { const int kk = 2 * i + (lane >> 5); scr[kk * 33 + (lane & 31)] = W[(size_t)(k0 + kk) * N + n0 + (lane & 31)]; }
    asm volatile("s_waitcnt lgkmcnt(0)" ::: "memory");
    const int c = lane & 7;
#pragma unroll
    for (int j = 0; j < 4; ++j) { const int n = (lane >> 3) + 8 * j; const LAS float* s = scr + (8 * c) * 33 + n;
        u32x4 o; o.x = pk2(s[0 * 33], s[1 * 33]); o.y = pk2(s[2 * 33], s[3 * 33]); o.z = pk2(s[4 * 33], s[5 * 33]); o.w = pk2(s[6 * 33], s[7 * 33]);
        *(u32x4*)(WT + (size_t)(n0 + n) * K + k0 + 8 * c) = o; }
    asm volatile("s_waitcnt lgkmcnt(0)" ::: "memory");
}
__device__ __forceinline__ void p0_transpose_item8(const float* W, int K, int N, unsigned char* WT, LAS float* scr, int item, int lane) {
    const int nblk = N / 32, kb = item / nblk, nb = item % nblk, k0 = 64 * kb, n0 = 32 * nb;
#pragma unroll 8
    for (int i = 0; i < 32; ++i) { const int kk = 2 * i + (lane >> 5); scr[kk * 33 + (lane & 31)] = W[(size_t)(k0 + kk) * N + n0 + (lane & 31)]; }
    asm volatile("s_waitcnt lgkmcnt(0)" ::: "memory");
    const int c = lane & 7;
#pragma unroll
    for (int j = 0; j < 4; ++j) { const int n = (lane >> 3) + 8 * j; const LAS float* s = scr + (8 * c) * 33 + n; constexpr float sc = pg8::W8_SCALE;
        u32x2 o; o.x = fp8_pack4(s[0 * 33] * sc, s[1 * 33] * sc, s[2 * 33] * sc, s[3 * 33] * sc); o.y = fp8_pack4(s[4 * 33] * sc, s[5 * 33] * sc, s[6 * 33] * sc, s[7 * 33] * sc);
        *(u32x2*)(WT + (size_t)(n0 + n) * K + k0 + 8 * c) = o; }
    asm volatile("s_waitcnt lgkmcnt(0)" ::: "memory");
}
__device__ __forceinline__ void cvt8(const float* src, bf16_t* dst) {
    const f32x4 a = *(const f32x4*)src, b = *(const f32x4*)(src + 4);
    u32x4 o; o.x = pk2(a[0], a[1]); o.y = pk2(a[2], a[3]); o.z = pk2(b[0], b[1]); o.w = pk2(b[2], b[3]);
    *(u32x4*)dst = o;
}

__device__ __forceinline__ void p0_prologue(const Ctx& F0, const Args& a) {
    const Ctx F = fresh(F0);
    unsigned char* ws = a.ws;
    const int nrest = (F.G > 160) ? F.G - 96 : F.G, vrest = (F.G > 160) ? F.vcu - 96 : F.vcu;
    const int gw = vrest * NWAVES + F.wave, NGW = nrest * NWAVES;
    const long gt = (long)vrest * 512 + F.tid, NGT = (long)nrest * 512;
    {
        LAS float* red = (LAS float*)(F.lds);
        const float* c = a.in[1]; const float* cctx = a.in[3]; const float* wmod = a.in[6]; const float* bmod = a.in[7];
        float* modb = (float*)(ws + WS_MOD);
        for (int item = F.vcu; item < 96; item += F.G) {
            const int l = item / 48, nc = item % 48, n0 = nc * 128 + 2 * F.lane, kb = F.wave * 128;
            float sv[9][2];
#pragma unroll
            for (int r = 0; r < 9; ++r)
#pragma unroll
                for (int j = 0; j < 2; ++j) { const int k = kb + 64 * j + F.lane; const float v = (r < 8) ? c[r * DM + k] : cctx[k]; sv[r][j] = v / (1.0f + __expf(-v)); }
            float acc[9][2];
#pragma unroll
            for (int r = 0; r < 9; ++r) { acc[r][0] = 0.f; acc[r][1] = 0.f; }
            const float* wp = wmod + (size_t)l * DM * NMOD + (size_t)kb * NMOD + n0;
#pragma unroll
            for (int j = 0; j < 2; ++j)
#pragma unroll 8
                for (int kl = 0; kl < 64; ++kl) {
                    const f32x2 w = *(const f32x2*)(wp + (size_t)(64 * j + kl) * NMOD);
#pragma unroll
                    for (int r = 0; r < 9; ++r) { const float s = __builtin_bit_cast(float, __builtin_amdgcn_readlane(__builtin_bit_cast(int, sv[r][j]), kl)); acc[r][0] += s * w[0]; acc[r][1] += s * w[1]; }
                }
            __syncthreads();
#pragma unroll
            for (int r = 0; r < 9; ++r) { red[(F.wave * 9 + r) * 128 + 2 * F.lane] = acc[r][0]; red[(F.wave * 9 + r) * 128 + 2 * F.lane + 1] = acc[r][1]; }
            __syncthreads();
            for (int o = F.tid; o < 9 * 128; o += 512) { const int r = o >> 7, nl = o & 127; float s = 0.f;
#pragma unroll
                for (int w = 0; w < 8; ++w) s += red[(w * 9 + r) * 128 + nl];
                modb[(size_t)(l * 9 + r) * NMOD + nc * 128 + nl] = s + bmod[l * NMOD + nc * 128 + nl]; }
        }
        __syncthreads();
    }
    if (vrest < 0) return;
    {
        LAS float* scr = (LAS float*)(F.lds + F.wave * 16384);
        constexpr int I_QKV = (DM / 64) * (3 * DM / 32), I_O = (DM / 64) * (DM / 32), I_PQ = (DM / 64) * (2 * DM / 32);
        constexpr int NITEMS = I_QKV + 2 * I_O + 2 * I_PQ;
        for (int it = gw; it < NITEMS; it += NGW) {
            int r = it;
            if (r < I_QKV) { p0_transpose_item8(a.in[8], DM, 3 * DM, ws + WS_WQKV, scr, r, F.lane); continue; } r -= I_QKV;
            if (r < I_O) { p0_transpose_item8(a.in[9], DM, DM, ws + WS_WO, scr, r, F.lane); continue; } r -= I_O;
            if (r < I_O) { p0_transpose_item8(a.in[11], DM, DM, ws + WS_WF, scr, r, F.lane); continue; } r -= I_O;
            if (r < I_PQ) { p0_transpose_item8(a.in[12], DM, 2 * DM, ws + WS_WPQ, scr, r, F.lane); continue; } r -= I_PQ;
            p0_transpose_item8(a.in[12] + (size_t)DM * 2 * DM, DM, 2 * DM, ws + WS_WPQ + (size_t)2 * DM * DM, scr, r, F.lane);
        }
    }
    for (long i = gt; i < 2 * 2 * 128 * 128 / 8; i += NGT) cvt8(a.in[13] + i * 8, (bf16_t*)(ws + WS_SK) + i * 8);
    {
        bf16_t* wc = (bf16_t*)(ws + WS_WC);
        for (long i = gt; i < 512 * 256 / 8; i += NGT) { const int nn = (int)(i >> 5), k0 = (int)(i & 31) * 8; float v[8];
#pragma unroll
            for (int j = 0; j < 8; ++j) { const int m = ((k0 + j) * (nn & 255)) & 255; const float fr = (float)m * (1.0f / 256.0f);
                v[j] = (nn < 256 ? __builtin_amdgcn_cosf(fr) : __builtin_amdgcn_sinf(fr)) * (1.0f / 16.0f); }
            u32x4 o; o.x = pk2(v[0], v[1]); o.y = pk2(v[2], v[3]); o.z = pk2(v[4], v[5]); o.w = pk2(v[6], v[7]);
            *(u32x4*)(wc + i * 8) = o; }
        unsigned char* cs = ws + WS_CS;
        for (long i = gt; i < 2048L * 4096 / 8; i += NGT) { const int np = (int)(i >> 9), c0 = (int)(i & 511) * 8; const int part = c0 >> 11; float v[8];
#pragma unroll
            for (int j = 0; j < 8; ++j) { const int n = (c0 + j) & 2047; const int m = (n * np) & 4095; const float fr = (float)m * (1.0f / 4096.0f);
                v[j] = (part == 0 ? __builtin_amdgcn_cosf(fr) : -__builtin_amdgcn_sinf(fr)) * (pg8::CS_SCALE / 64.0f); }
            u32x2 o; o.x = fp8_pack4(v[0], v[1], v[2], v[3]); o.y = fp8_pack4(v[4], v[5], v[6], v[7]);
            *(u32x2*)(cs + i * 8) = o; }
    }
}

__device__ __forceinline__ unsigned fp4_pack8(const float* v, float sc) {
    unsigned w = 0;
#define FP4C(i) fminf(fmaxf(v[i] * sc, -6.f), 6.f)
    w = __builtin_amdgcn_cvt_scalef32_pk_fp4_f32(w, FP4C(0), FP4C(1), 1.0f, 0);
    w = __builtin_amdgcn_cvt_scalef32_pk_fp4_f32(w, FP4C(2), FP4C(3), 1.0f, 1);
    w = __builtin_amdgcn_cvt_scalef32_pk_fp4_f32(w, FP4C(4), FP4C(5), 1.0f, 2);
    w = __builtin_amdgcn_cvt_scalef32_pk_fp4_f32(w, FP4C(6), FP4C(7), 1.0f, 3);
#undef FP4C
    return w;
}
#define FP4_DEC(w, bs) __builtin_amdgcn_cvt_scalef32_pk_f32_fp4((w), 1.0f, (bs))
__device__ __forceinline__ unsigned i8_pack4(f32x4 v, float sc) {
    const int a = (int)rintf(fminf(fmaxf(v[0] * sc, -127.f), 127.f)), b = (int)rintf(fminf(fmaxf(v[1] * sc, -127.f), 127.f));
    const int c = (int)rintf(fminf(fmaxf(v[2] * sc, -127.f), 127.f)), d = (int)rintf(fminf(fmaxf(v[3] * sc, -127.f), 127.f));
    return (unsigned)(a & 0xff) | ((unsigned)(b & 0xff) << 8) | ((unsigned)(c & 0xff) << 16) | ((unsigned)(d & 0xff) << 24);
}
constexpr long TC_PER = (long)NEXP * DM / 16, TC_TOTAL = 4 * TC_PER;
__device__ __forceinline__ void tc_issue(const Args& a, long i, f32x4 (&v)[4]) {
    const int q = (int)(i / TC_PER); const long r = i - (long)q * TC_PER; const int l = q >> 1, tb = q & 1;
    const int e = (int)(r >> 6), c16 = (int)(r & 63);
    const float* src = (tb ? a.in[15] : a.in[14]) + ((size_t)l * NEXP + e) * DM + c16 * 16;
#pragma unroll
    for (int d = 0; d < 4; ++d) v[d] = *(const f32x4*)(src + 4 * d);
}
__device__ __forceinline__ void tc_finish(const Args& a, long i, const f32x4 (&v)[4]) {
    const int q = (int)(i / TC_PER); const long r = i - (long)q * TC_PER; const int l = q >> 1, tb = q & 1;
    const int e = (int)(r >> 6), c16 = (int)(r & 63);
    const float sc = tb ? V_SCALE : U_SCALE;
    u32x2 o;
#pragma unroll
    for (int d = 0; d < 2; ++d) { const float v8[8] = {v[2 * d][0], v[2 * d][1], v[2 * d][2], v[2 * d][3], v[2 * d + 1][0], v[2 * d + 1][1], v[2 * d + 1][2], v[2 * d + 1][3]};
        o[d] = fp4_pack8(v8, sc); }
    *(u32x2*)(a.ws + WS_TAB + (size_t)l * TAB_LAYER + (tb ? TAB_VOFF : 0) + ((size_t)(c16 >> 4) * NEXP + e) * 128 + (c16 & 15) * 8) = o;
}
__device__ __forceinline__ void table_convert(const Ctx& F0, const Args& a, int sh0, int nsh, int nshare) {
    const Ctx F = fresh(F0);
    constexpr long PER = (long)NEXP * DM / 16;
    constexpr long TOTAL = 4 * PER, T0 = TOTAL / 4;
    unsigned char* t8 = a.ws + WS_TAB;
    const long per_share = (TOTAL - T0 + nshare - 1) / nshare;
    const long i0 = T0 + (long)sh0 * per_share, i1 = min(T0 + (long)(sh0 + nsh) * per_share, TOTAL);
    for (long i = i0 + F.tid; i < i1; i += 512) {
        const int q = (int)(i / PER); const long r = i - (long)q * PER; const int l = q >> 1, tb = q & 1;
        const int e = (int)(r >> 6), c16 = (int)(r & 63);
        const float* src = (tb ? a.in[15] : a.in[14]) + ((size_t)l * NEXP + e) * DM + c16 * 16;
        if (tb) {
            u32x2 o;
#pragma unroll
            for (int d = 0; d < 2; ++d) { const f32x4 va = *(const f32x4*)(src + 8 * d), vb = *(const f32x4*)(src + 8 * d + 4);
                const float v8[8] = {va[0], va[1], va[2], va[3], vb[0], vb[1], vb[2], vb[3]};
                o[d] = fp4_pack8(v8, V_SCALE); }
            *(u32x2*)(t8 + (size_t)l * TAB_LAYER + TAB_VOFF + ((size_t)(c16 >> 4) * NEXP + e) * 128 + (c16 & 15) * 8) = o;
        } else {
            u32x2 o;
#pragma unroll
            for (int d = 0; d < 2; ++d) { const f32x4 va = *(const f32x4*)(src + 8 * d), vb = *(const f32x4*)(src + 8 * d + 4);
                const float v8[8] = {va[0], va[1], va[2], va[3], vb[0], vb[1], vb[2], vb[3]};
                o[d] = fp4_pack8(v8, U_SCALE); }
            *(u32x2*)(t8 + (size_t)l * TAB_LAYER + ((size_t)(c16 >> 4) * NEXP + e) * 128 + (c16 & 15) * 8) = o;
        }
    }
}

__device__ __forceinline__ const float* norm_src(const Args& a, int mode, int m) { return (m < ML) ? ((mode == 0 ? a.in[0] : a.out) + (size_t)m * DM) : (a.in[2] + (size_t)(m - ML) * DM); }
__device__ __forceinline__ void norm_phase(const Ctx& F0, const Args& a, int mode, int layer, int off, const float* gw) {
    const Ctx F = fresh(F0);
    const int gwv = F.vcu * NWAVES + F.wave, NGW = F.G * NWAVES, lane = F.lane;
    const float* modb = (const float*)(a.ws + WS_MOD) + (size_t)layer * 9 * NMOD;
    bf16_t* hx = (bf16_t*)(a.ws + WS_HX);
    const int nrows = (mode == 0) ? MT : ML;
    f32x4 gv[4];
#pragma unroll
    for (int j = 0; j < 4; ++j) gv[j] = ((const f32x4*)gw)[lane + 64 * j];
    if (mode != 0) {
        const u32x2* XBc = (const u32x2*)(a.ws + WS_XB);
        constexpr int CH = 16, NPF = 4;
        for (int c = gwv; c < ML / CH; c += NGW) {
            const int r0 = c * CH;
            u32x2 rb[NPF][4]; f32x4 v[4], av[4], cv[4];
#pragma unroll
            for (int p = 0; p < NPF; ++p)
#pragma unroll
                for (int j = 0; j < 4; ++j) rb[p][j] = XBc[(size_t)(r0 + p) * 256 + lane + 64 * j];
            { const float* mr = modb + (size_t)(r0 >> 12) * NMOD + off;
#pragma unroll
              for (int j = 0; j < 4; ++j) { av[j] = ((const f32x4*)mr)[lane + 64 * j]; cv[j] = ((const f32x4*)(mr + DM))[lane + 64 * j]; } }
            asm volatile("" :: "v"(cv[3]));
#pragma unroll 1
            for (int q = 0; q < CH / NPF; ++q) {
#pragma unroll
              for (int p = 0; p < NPF; ++p) {
                const int m = r0 + q * NPF + p;
#pragma unroll
                for (int j = 0; j < 4; ++j) v[j] = bf4_f32(rb[p][j]);
                { const int rn = min(m + NPF, r0 + CH - 1);
#pragma unroll
                  for (int j = 0; j < 4; ++j) rb[p][j] = XBc[(size_t)rn * 256 + lane + 64 * j]; }
              float s = 0.f;
#pragma unroll
              for (int j = 0; j < 4; ++j) s += (v[j].x * v[j].x + v[j].y * v[j].y) + (v[j].z * v[j].z + v[j].w * v[j].w);
              const float rstd = 1.0f / sqrtf(wave_sum(s) * (1.0f / DM) + EPS);
              unsigned long long* o8 = (unsigned long long*)(hx + (size_t)m * DM) + lane;
              unsigned* o4 = (unsigned*)(a.ws + WS_HX + (size_t)m * DM) + lane;
#pragma unroll
              for (int j = 0; j < 4; ++j) { const f32x4 y = (v[j] * rstd * gv[j]) * (cv[j] + 1.0f) + av[j];
                  if (mode == 0 || off == 3 * DM) o4[64 * j] = fp8_pack4(y.x * pg8::ACT8_SCALE, y.y * pg8::ACT8_SCALE, y.z * pg8::ACT8_SCALE, y.w * pg8::ACT8_SCALE);
                  if (mode == 0) continue;
                  if (off != 3 * DM)
                  o8[64 * j] = (unsigned long long)cvtpk(y.x, y.y) | ((unsigned long long)cvtpk(y.z, y.w) << 32);
                  if (off == 3 * DM) {
                      const float q0 = fminf(fmaxf(y.x * XQ_SCALE, -6.f), 6.f), q1 = fminf(fmaxf(y.y * XQ_SCALE, -6.f), 6.f), q2 = fminf(fmaxf(y.z * XQ_SCALE, -6.f), 6.f), q3 = fminf(fmaxf(y.w * XQ_SCALE, -6.f), 6.f);
                      unsigned ph = __builtin_amdgcn_cvt_scalef32_pk_fp4_f32(0u, q0, q1, 1.0f, 0); ph = __builtin_amdgcn_cvt_scalef32_pk_fp4_f32(ph, q2, q3, 1.0f, 1);
                      const f32x2 d0 = FP4_DEC(ph, 0), d1 = FP4_DEC(ph, 1);
                      unsigned pl = __builtin_amdgcn_cvt_scalef32_pk_fp4_f32(0u, 4.f * (q0 - d0.x), 4.f * (q1 - d0.y), 1.0f, 0); pl = __builtin_amdgcn_cvt_scalef32_pk_fp4_f32(pl, 4.f * (q2 - d1.x), 4.f * (q3 - d1.y), 1.0f, 1);
                      unsigned short* xq = (unsigned short*)(a.ws + WS_X8 + ((size_t)j * ML + m) * 256) + lane;
                      xq[0] = (unsigned short)(ph & 0xffffu); xq[64] = (unsigned short)(pl & 0xffffu); } }
              }
            }
        }
        return;
    }
    const u32x2* XBr = (const u32x2*)(a.ws + WS_XB);
    f32x4 v[4], vn[4]; u32x2 vr[4];
    if (gwv < nrows) {
        if (mode == 0) { const f32x4* xr = (const f32x4*)norm_src(a, mode, gwv) + lane;
#pragma unroll
            for (int j = 0; j < 4; ++j) vn[j] = xr[64 * j]; }
        else {
#pragma unroll
            for (int j = 0; j < 4; ++j) vr[j] = XBr[(size_t)gwv * 256 + lane + 64 * j]; } }
    for (int m = gwv; m < nrows; m += NGW) {
        const int mn = (m + NGW < nrows) ? m + NGW : m;
        if (mode == 0) {
#pragma unroll
            for (int j = 0; j < 4; ++j) v[j] = vn[j];
            const f32x4* xr = (const f32x4*)norm_src(a, mode, mn) + lane;
#pragma unroll
            for (int j = 0; j < 4; ++j) vn[j] = xr[64 * j];
        } else {
#pragma unroll
            for (int j = 0; j < 4; ++j) v[j] = bf4_f32(vr[j]);
#pragma unroll
            for (int j = 0; j < 4; ++j) vr[j] = XBr[(size_t)mn * 256 + lane + 64 * j];
        }
        const float* mr = modb + (size_t)((m < ML) ? (m >> 12) : 8) * NMOD + off;
        f32x4 av[4], cv[4];
#pragma unroll
        for (int j = 0; j < 4; ++j) { av[j] = ((const f32x4*)mr)[lane + 64 * j]; cv[j] = ((const f32x4*)(mr + DM))[lane + 64 * j]; }
        float s = 0.f;
#pragma unroll
        for (int j = 0; j < 4; ++j) s += (v[j].x * v[j].x + v[j].y * v[j].y) + (v[j].z * v[j].z + v[j].w * v[j].w);
        const float rstd = 1.0f / sqrtf(wave_sum(s) * (1.0f / DM) + EPS);
        unsigned long long* o8 = (unsigned long long*)(hx + (size_t)m * DM) + lane;
        unsigned* o4 = (unsigned*)(a.ws + WS_HX + (size_t)m * DM) + lane;
#pragma unroll
        for (int j = 0; j < 4; ++j) { const f32x4 y = (v[j] * rstd * gv[j]) * (cv[j] + 1.0f) + av[j];
            if (mode == 0 || off == 3 * DM) o4[64 * j] = fp8_pack4(y.x * pg8::ACT8_SCALE, y.y * pg8::ACT8_SCALE, y.z * pg8::ACT8_SCALE, y.w * pg8::ACT8_SCALE);
            if (mode == 0) continue;
            if (off != 3 * DM)
            o8[64 * j] = (unsigned long long)cvtpk(y.x, y.y) | ((unsigned long long)cvtpk(y.z, y.w) << 32);
            if (off == 3 * DM) {
                const float q0 = fminf(fmaxf(y.x * XQ_SCALE, -6.f), 6.f), q1 = fminf(fmaxf(y.y * XQ_SCALE, -6.f), 6.f), q2 = fminf(fmaxf(y.z * XQ_SCALE, -6.f), 6.f), q3 = fminf(fmaxf(y.w * XQ_SCALE, -6.f), 6.f);
                unsigned ph = __builtin_amdgcn_cvt_scalef32_pk_fp4_f32(0u, q0, q1, 1.0f, 0); ph = __builtin_amdgcn_cvt_scalef32_pk_fp4_f32(ph, q2, q3, 1.0f, 1);
                const f32x2 d0 = FP4_DEC(ph, 0), d1 = FP4_DEC(ph, 1);
                unsigned pl = __builtin_amdgcn_cvt_scalef32_pk_fp4_f32(0u, 4.f * (q0 - d0.x), 4.f * (q1 - d0.y), 1.0f, 0); pl = __builtin_amdgcn_cvt_scalef32_pk_fp4_f32(pl, 4.f * (q2 - d1.x), 4.f * (q3 - d1.y), 1.0f, 1);
                unsigned short* xq = (unsigned short*)(a.ws + WS_X8 + ((size_t)j * ML + m) * 256) + lane;
                xq[0] = (unsigned short)(ph & 0xffffu); xq[64] = (unsigned short)(pl & 0xffffu); } }
    }
}
__device__ __forceinline__ void norm_fold_phase(const Ctx& F0, const Args& a, int layer, const float* gw) {
    const Ctx F = fresh(F0);
    const int gwv = F.vcu * NWAVES + F.wave, NGW = F.G * NWAVES, lane = F.lane;
    const float* modb = (const float*)(a.ws + WS_MOD) + (size_t)layer * 9 * NMOD;
    const u32x2* XBr = (const u32x2*)(a.ws + WS_XB);
    unsigned long long* hc = (unsigned long long*)(a.ws + WS_HX);
    unsigned long long* hs = (unsigned long long*)(a.ws + WS_HX + 32 * MiB);
    float* yni = (float*)(a.ws + WS_YNI);
    f32x4 gv[4];
#pragma unroll
    for (int j = 0; j < 4; ++j) gv[j] = ((const f32x4*)gw)[lane + 64 * j];
    u32x2 ra[4], rb[4];
#define NF_ROWS(task_, na_, nb_) const int b_ = (task_) >> 11, t_ = (task_) & 2047; const int na_ = b_ * SEQ + t_, nb_ = b_ * SEQ + (t_ == 0 ? 2048 : SEQ - t_)
    if (gwv < NB * 2048) { NF_ROWS(gwv, na, nb);
#pragma unroll
        for (int j = 0; j < 4; ++j) { ra[j] = XBr[(size_t)na * 256 + lane + 64 * j]; rb[j] = XBr[(size_t)nb * 256 + lane + 64 * j]; } }
    for (int task = gwv; task < NB * 2048; task += NGW) {
        const int b = task >> 11, t = task & 2047;
        f32x4 va[4], vb[4];
#pragma unroll
        for (int j = 0; j < 4; ++j) { va[j] = bf4_f32(ra[j]); vb[j] = bf4_f32(rb[j]); }
        { const int tn = (task + NGW < NB * 2048) ? task + NGW : task; NF_ROWS(tn, na, nb);
#pragma unroll
          for (int j = 0; j < 4; ++j) { ra[j] = XBr[(size_t)na * 256 + lane + 64 * j]; rb[j] = XBr[(size_t)nb * 256 + lane + 64 * j]; } }
        const float* mr = modb + (size_t)b * NMOD;
        f32x4 av[4], cv[4];
#pragma unroll
        for (int j = 0; j < 4; ++j) { av[j] = ((const f32x4*)mr)[lane + 64 * j]; cv[j] = ((const f32x4*)(mr + DM))[lane + 64 * j]; }
        float sa = 0.f, sb = 0.f;
#pragma unroll
        for (int j = 0; j < 4; ++j) { sa += (va[j].x * va[j].x + va[j].y * va[j].y) + (va[j].z * va[j].z + va[j].w * va[j].w); sb += (vb[j].x * vb[j].x + vb[j].y * vb[j].y) + (vb[j].z * vb[j].z + vb[j].w * vb[j].w); }
        const float ra_ = 1.0f / sqrtf(wave_sum(sa) * (1.0f / DM) + EPS), rb_ = 1.0f / sqrtf(wave_sum(sb) * (1.0f / DM) + EPS);
        const size_t orow = ((size_t)b * 2048 + t) * 256 + lane;
#pragma unroll
        for (int j = 0; j < 4; ++j) {
            const f32x4 ya = (va[j] * ra_ * gv[j]) * (cv[j] + 1.0f) + av[j], yb = (vb[j] * rb_ * gv[j]) * (cv[j] + 1.0f) + av[j];
            f32x4 ys, yd;
            if (t == 0) { ys = ya; yd = (f32x4){0.f, 0.f, 0.f, 0.f}; ((f32x4*)(yni + (size_t)b * DM))[lane + 64 * j] = yb; }
            else { ys = ya + yb; yd = ya - yb; }
            hc[orow + 64 * j] = (unsigned long long)cvtpk(ys.x, ys.y) | ((unsigned long long)cvtpk(ys.z, ys.w) << 32);
            hs[orow + 64 * j] = (unsigned long long)cvtpk(yd.x, yd.y) | ((unsigned long long)cvtpk(yd.z, yd.w) << 32);
        }
    }
#undef NF_ROWS
}
__device__ __forceinline__ void final_norm_phase(const Ctx& F0, const Args& a) {
    const Ctx F = fresh(F0);
    const int gwv = F.vcu * NWAVES + F.wave, NGW = F.G * NWAVES;
    const float* gw = a.in[16];
    const u32x2* XBr = (const u32x2*)(a.ws + WS_XB);
    f32x4 gv[4]; u32x2 vr[4];
#pragma unroll
    for (int j = 0; j < 4; ++j) gv[j] = ((const f32x4*)gw)[F.lane + 64 * j];
    if (gwv < ML) {
#pragma unroll
        for (int j = 0; j < 4; ++j) vr[j] = XBr[(size_t)gwv * 256 + F.lane + 64 * j]; }
    for (int m = gwv; m < ML; m += NGW) {
        f32x4* xr = (f32x4*)(a.out + (size_t)m * DM) + F.lane;
        f32x4 v[4]; float s = 0.f;
#pragma unroll
        for (int j = 0; j < 4; ++j) { v[j] = bf4_f32(vr[j]); s += (v[j].x * v[j].x + v[j].y * v[j].y) + (v[j].z * v[j].z + v[j].w * v[j].w); }
        { const int mn = (m + NGW < ML) ? m + NGW : m;
#pragma unroll
          for (int j = 0; j < 4; ++j) vr[j] = XBr[(size_t)mn * 256 + F.lane + 64 * j]; }
        const float rstd = 1.0f / sqrtf(wave_sum(s) * (1.0f / DM) + EPS);
#pragma unroll
        for (int j = 0; j < 4; ++j) xr[64 * j] = v[j] * rstd * gv[j];
    }
}

constexpr int ATT_ROWB = 144, ATT_KTILEB = 128 * ATT_ROWB, ATT_VROWB = 272, ATT_VTILEB = 64 * ATT_VROWB, ATT_BIAS_B = 2048, ATT_K0 = ATT_BIAS_B, ATT_V0 = ATT_K0 + 2 * ATT_KTILEB;
constexpr float ATT_THR = 8.0f;
template <int NGH, bool LATENT>
__device__ __forceinline__ void attn_sub(const LAS unsigned char* Kt, const LAS unsigned char* Vt_, int ko, const LAS float* browA, const LAS float* browB, const int (&relidx)[8],
                                         const bf16x8 (&qf)[2], float& m_ref, float& l_run, f32x4 (&o)[4], int q16, int g4) {
    constexpr int NG = 2 * NGH;
    bf16x8 kf[2 * NG][2]; u32x2 vf[4][NG][2]; f32x4 sc[2 * NG];
#pragma unroll
    for (int gk = 0; gk < NG; ++gk)
#pragma unroll
        for (int b2 = 0; b2 < 2; ++b2)
#pragma unroll
            for (int ks = 0; ks < 2; ++ks) kf[2 * gk + b2][ks] = *(const LAS bf16x8*)(Kt + ((gk / NGH) * 64 + ko + 32 * (gk % NGH) + 16 * b2 + q16) * ATT_ROWB + 64 * ks + 16 * g4);
#pragma unroll
    for (int d = 0; d < 4; ++d)
#pragma unroll
        for (int gk = 0; gk < NG; ++gk) { const LAS unsigned char* vp = Vt_ + (16 * d + q16) * ATT_VROWB + 2 * ((gk / NGH) * 64 + ko + 32 * (gk % NGH) + 4 * g4);
            vf[d][gk][0] = *(const LAS u32x2*)vp; vf[d][gk][1] = *(const LAS u32x2*)(vp + 32); }
    if (LATENT) {
#pragma unroll
        for (int kk = 0; kk < 8; ++kk) { sc[kk >> 2][kk & 3] = browA[relidx[kk]] - m_ref; sc[2 + (kk >> 2)][kk & 3] = browB[relidx[kk]] - m_ref; }
    } else {
#pragma unroll
        for (int blk = 0; blk < 2 * NG; ++blk) sc[blk] = (f32x4){-m_ref, -m_ref, -m_ref, -m_ref};
    }
#pragma unroll
    for (int blk = 0; blk < 2 * NG; ++blk)
#pragma unroll
        for (int ks = 0; ks < 2; ++ks) sc[blk] = __builtin_amdgcn_mfma_f32_16x16x32_bf16(kf[blk][ks], qf[ks], sc[blk], 0, 0, 0);
    float mx = fmaxf(fmaxf(sc[0][0], sc[0][1]), fmaxf(sc[0][2], sc[0][3]));
#pragma unroll
    for (int blk = 1; blk < 2 * NG; ++blk) mx = fmaxf(mx, fmaxf(fmaxf(sc[blk][0], sc[blk][1]), fmaxf(sc[blk][2], sc[blk][3])));
    if (__builtin_amdgcn_ballot_w64(mx > ATT_THR) != 0ull) {
        mx = fmaxf(mx, __shfl_xor(mx, 16)); mx = fmaxf(mx, __shfl_xor(mx, 32));
        const float dl = mx > ATT_THR ? mx : 0.f;
        m_ref += dl;
        const float al = __builtin_amdgcn_exp2f(-dl);
        l_run *= al;
#pragma unroll
        for (int d = 0; d < 4; ++d) o[d] *= al;
#pragma unroll
        for (int blk = 0; blk < 2 * NG; ++blk) sc[blk] -= dl;
    }
    float ls0 = 0.f, ls1 = 0.f;
#pragma unroll
    for (int blk = 0; blk < 2 * NG; ++blk)
#pragma unroll
        for (int i = 0; i < 4; ++i) { const float e = __builtin_amdgcn_exp2f(sc[blk][i]); sc[blk][i] = e; if (blk & 1) ls1 += e; else ls0 += e; }
    l_run += ls0 + ls1;
    bf16x8 pf[NG];
#pragma unroll
    for (int gk = 0; gk < NG; ++gk) { u32x4 pw; pw.x = cvtpk(sc[2 * gk][0], sc[2 * gk][1]); pw.y = cvtpk(sc[2 * gk][2], sc[2 * gk][3]); pw.z = cvtpk(sc[2 * gk + 1][0], sc[2 * gk + 1][1]); pw.w = cvtpk(sc[2 * gk + 1][2], sc[2 * gk + 1][3]);
        pf[gk] = __builtin_bit_cast(bf16x8, pw); }
#pragma unroll
    for (int gk = 0; gk < NG; ++gk)
#pragma unroll
        for (int d = 0; d < 4; ++d) { u32x4 vw; vw.x = vf[d][gk][0].x; vw.y = vf[d][gk][0].y; vw.z = vf[d][gk][1].x; vw.w = vf[d][gk][1].y;
            o[d] = __builtin_amdgcn_mfma_f32_16x16x32_bf16(__builtin_bit_cast(bf16x8, vw), pf[gk], o[d], 0, 0, 0); }
}
__device__ __forceinline__ void attn_phase(const Ctx& F0, const Args& a) {
    const Ctx F = fresh(F0);
    const bf16_t* QK = (const bf16_t*)(a.ws + WS_QK);
    const bf16_t* VT = (const bf16_t*)(a.ws + WS_VT);
    unsigned char* AO = a.ws + WS_HX + 36 * MiB;
    const float* rpb = a.in[10];
    LAS float* bias = (LAS float*)F.lds;
    const int tid = F.tid, lane = F.lane, q16 = lane & 15, g4 = lane >> 4;
    const int rr = F.wave >> 2, jt = F.wave & 3;
    const int qc = 16 * jt + q16, cs = min(max(qc - 8, 0), 48), ksj = min(max(16 * jt - 8, 0), 32);
    int relidx[8];
#pragma unroll
    for (int k = 0; k < 8; ++k) { const int kc = ksj + 16 * (k >> 2) + 4 * g4 + (k & 3); relidx[k] = (kc >= cs && kc < cs + 16) ? (kc - qc + 15) : 31; }
    const int krow = tid >> 3, kch = tid & 7, vrow = tid >> 4, vch = tid & 15;
    const unsigned lds_k = (unsigned)(krow * ATT_ROWB + kch * 16), lds_v = (unsigned)(vrow * ATT_VROWB + vch * 16);
    const int nunits = NB * 16 * 16, upb = (nunits + F.G - 1) / F.G;
    int cur_bh = -1;
    for (int k = 0; k < upb; ++k) {
        const int id = F.vcu * upb + k; if (id >= nunits) break;
        const int p = id & 15, bh = id >> 4, b = bh >> 4, h = bh & 15;
        if (bh != cur_bh) {
            __syncthreads();
            for (int i = tid; i < 16 * 32; i += 512) { const int dr = i >> 5, dc = i & 31; bias[i] = (dc < 31 && dr < 15) ? rpb[(h * 15 + dr) * 31 + dc] * LOG2E : -1e30f; }
            cur_bh = bh;
        }
        const int r0 = 4 * p, rs0 = min(max(r0 - 4, 0), 56), rs1 = min(max(r0 + 3 - 4, 0), 56);
        const int nlat = rs1 + 8 - rs0, nlt = (nlat + 1) >> 1, nsteps = nlt + 2;
        const int rA = r0 + rr, rB = r0 + 2 + rr, rsA = min(max(rA - 4, 0), 56), rsB = min(max(rB - 4, 0), 56);
        const long tokqA = (long)b * SEQ + rA * GW + qc, tokqB = (long)b * SEQ + rB * GW + qc;
        const bf16_t* kbase = QK + 1024 + h * 64 + kch * 8;
        const bf16_t* vbase = VT + (long)(h * 64 + vrow) * MT + (vch & 7) * 8;
#define ATT_TOKA(step) ((step) < nlt ? ((long)b * SEQ + (long)(rs0 + 2 * (step)) * GW) : ((long)ML + b * CTXL + ((step) - nlt) * 128))
#define ATT_TOKB(step) ((step) < nlt ? ((long)b * SEQ + (long)min(rs0 + 2 * (step) + 1, rs0 + nlat - 1) * GW) : ((long)ML + b * CTXL + ((step) - nlt) * 128 + 64))
        u32x4 kA[2], vA[2];
#define ATT_LOAD(step, kr_, vr_) do { const int st_ = (step) < nsteps ? (step) : nsteps - 1; const long ta_ = ATT_TOKA(st_), tb_ = ATT_TOKB(st_);     \
        kr_[0] = *(const u32x4*)(kbase + (ta_ + krow) * 2048); kr_[1] = *(const u32x4*)(kbase + (tb_ + krow) * 2048); \
        const long tv_ = (vch < 8) ? ta_ : tb_; vr_[0] = *(const u32x4*)(vbase + tv_); vr_[1] = *(const u32x4*)(vbase + (long)32 * MT + tv_); } while (0)
#define ATT_WRITE(buf, kr_, vr_) do { *(LAS u32x4*)(F.lds + ATT_K0 + (buf) * ATT_KTILEB + lds_k) = kr_[0]; *(LAS u32x4*)(F.lds + ATT_K0 + (buf) * ATT_KTILEB + 64 * ATT_ROWB + lds_k) = kr_[1]; \
        *(LAS u32x4*)(F.lds + ATT_V0 + (buf) * ATT_VTILEB + lds_v) = vr_[0]; *(LAS u32x4*)(F.lds + ATT_V0 + (buf) * ATT_VTILEB + 32 * ATT_VROWB + lds_v) = vr_[1]; } while (0)
        ATT_LOAD(0, kA, vA);
        f32x4 tcv0[4];
        const int tci0 = id * 512 + tid;
        tc_issue(a, tci0, tcv0);
        bf16x8 qfA[2], qfB[2];
#pragma unroll
        for (int ks = 0; ks < 2; ++ks) { qfA[ks] = *(const bf16x8*)(QK + tokqA * 2048 + h * 64 + 32 * ks + 8 * g4); qfB[ks] = *(const bf16x8*)(QK + tokqB * 2048 + h * 64 + 32 * ks + 8 * g4); }
        float mA = 0.f, lA = 0.f, mB = 0.f, lB = 0.f;
        f32x4 oA[4], oB[4];
#pragma unroll
        for (int d = 0; d < 4; ++d) { oA[d] = (f32x4){0.f, 0.f, 0.f, 0.f}; oB[d] = (f32x4){0.f, 0.f, 0.f, 0.f}; }
        __syncthreads();
        ATT_WRITE(0, kA, vA);
        ATT_LOAD(1, kA, vA);
        asm volatile("" :: "v"(qfA[0]), "v"(qfA[1]), "v"(qfB[0]), "v"(qfB[1]));
        __syncthreads();
#define ATT_COMPUTE(step, cur) do { \
            const LAS unsigned char* Kt = F.lds + ATT_K0 + (cur) * ATT_KTILEB; \
            const LAS unsigned char* Vt_ = F.lds + ATT_V0 + (cur) * ATT_VTILEB; \
            unsigned kt2_ = (unsigned)(size_t)Kt, vt2_ = (unsigned)(size_t)Vt_; asm volatile("" : "+v"(kt2_), "+v"(vt2_));     \
            const LAS unsigned char* KtB = (const LAS unsigned char*)(size_t)kt2_; const LAS unsigned char* VtB = (const LAS unsigned char*)(size_t)vt2_; \
            if ((step) < nlt) { const int kra = rs0 + 2 * (step), krb = kra + 1; const bool vb_ = krb < rs0 + nlat; \
                { const bool a0 = kra >= rsA && kra < rsA + 8, a1 = vb_ && krb >= rsA && krb < rsA + 8; \
                  if (a0 || a1) attn_sub<1, true>(Kt, Vt_, ksj, bias + (a0 ? (kra - rA + 7) : 15) * 32, bias + (a1 ? (krb - rA + 7) : 15) * 32, relidx, qfA, mA, lA, oA, q16, g4); } \
                { const bool b0 = kra >= rsB && kra < rsB + 8, b1 = vb_ && krb >= rsB && krb < rsB + 8; \
                  if (b0 || b1) attn_sub<1, true>(KtB, VtB, ksj, bias + (b0 ? (kra - rB + 7) : 15) * 32, bias + (b1 ? (krb - rB + 7) : 15) * 32, relidx, qfB, mB, lB, oB, q16, g4); } \
            } else {                                                     \
                attn_sub<1, false>(Kt, Vt_, 0, bias, bias, relidx, qfA, mA, lA, oA, q16, g4); attn_sub<1, false>(Kt, Vt_, 32, bias, bias, relidx, qfA, mA, lA, oA, q16, g4); \
                attn_sub<1, false>(KtB, VtB, 0, bias, bias, relidx, qfB, mB, lB, oB, q16, g4); attn_sub<1, false>(KtB, VtB, 32, bias, bias, relidx, qfB, mB, lB, oB, q16, g4); } \
        } while (0)
        for (int step = 0; step < nsteps; step += 2) {
            ATT_COMPUTE(step, 0);
            if (step + 1 < nsteps) ATT_WRITE(1, kA, vA);
            ATT_LOAD(step + 2, kA, vA);
            __syncthreads();
            if (step + 1 < nsteps) { ATT_COMPUTE(step + 1, 1); }
            if (step + 2 < nsteps) ATT_WRITE(0, kA, vA);
            ATT_LOAD(step + 3, kA, vA);
            __syncthreads();
        }
#undef ATT_LOAD
#undef ATT_WRITE
#undef ATT_COMPUTE
#undef ATT_TOKA
#undef ATT_TOKB
        { int ti_ = id * 512 + tid; asm volatile("" : "+v"(ti_));
          tc_finish(a, ti_, tcv0); }
        lA += __shfl_xor(lA, 16); lA += __shfl_xor(lA, 32); lB += __shfl_xor(lB, 16); lB += __shfl_xor(lB, 32);
        { int tq_ = b * SEQ + rA * GW + qc; asm volatile("" : "+v"(tq_));
          unsigned char* op = AO + (long)tq_ * DM + h * 64 + 4 * g4; const float ls = pg8::ACT8_SCALE / lA;
#pragma unroll
          for (int d = 0; d < 4; ++d) *(unsigned*)(op + 16 * d) = fp8_pack4(oA[d][0] * ls, oA[d][1] * ls, oA[d][2] * ls, oA[d][3] * ls); }
        { int tq_ = b * SEQ + rB * GW + qc; asm volatile("" : "+v"(tq_));
          unsigned char* op = AO + (long)tq_ * DM + h * 64 + 4 * g4; const float ls = pg8::ACT8_SCALE / lB;
#pragma unroll
          for (int d = 0; d < 4; ++d) *(unsigned*)(op + 16 * d) = fp8_pack4(oB[d][0] * ls, oB[d][1] * ls, oB[d][2] * ls, oB[d][3] * ls); }
    }
    __syncthreads();
}

__device__ __forceinline__ void ce_desc(float& a, float& b) { const float hi = fmaxf(a, b), lo = fminf(a, b); a = hi; b = lo; }
__device__ __forceinline__ void ce_dir(float& a, float& b, bool desc) { const float hi = fmaxf(a, b), lo = fminf(a, b); a = desc ? hi : lo; b = desc ? lo : hi; }
__device__ __forceinline__ void sort16_desc(float (&v)[16]) {
#define S16CE(i, j) { const float hi_ = fmaxf(v[i], v[j]), lo_ = fminf(v[i], v[j]); v[i] = hi_; v[j] = lo_; }
    S16CE(0,13) S16CE(1,12) S16CE(2,15) S16CE(3,14) S16CE(4,8) S16CE(5,6) S16CE(7,11) S16CE(9,10)
    S16CE(0,5) S16CE(1,7) S16CE(2,9) S16CE(3,4) S16CE(6,13) S16CE(8,14) S16CE(10,15) S16CE(11,12)
    S16CE(0,1) S16CE(2,3) S16CE(4,5) S16CE(6,8) S16CE(7,9) S16CE(10,11) S16CE(12,13) S16CE(14,15)
    S16CE(0,2) S16CE(1,3) S16CE(4,10) S16CE(5,11) S16CE(6,7) S16CE(8,9) S16CE(12,14) S16CE(13,15)
    S16CE(1,2) S16CE(3,12) S16CE(4,6) S16CE(5,7) S16CE(8,10) S16CE(9,11) S16CE(13,14)
    S16CE(1,4) S16CE(2,6) S16CE(5,8) S16CE(7,10) S16CE(9,13) S16CE(11,14)
    S16CE(2,4) S16CE(3,6) S16CE(9,12) S16CE(11,13)
    S16CE(3,5) S16CE(6,8) S16CE(7,9) S16CE(10,12)
    S16CE(3,4) S16CE(5,6) S16CE(7,8) S16CE(9,10) S16CE(11,12)
    S16CE(6,7) S16CE(8,9)
#undef S16CE
}
__device__ __forceinline__ void merge16_desc(float (&a)[16], const float (&b)[16]) {
#pragma unroll
    for (int i = 0; i < 16; ++i) a[i] = fmaxf(a[i], b[15 - i]);
#pragma unroll
    for (int j = 8; j > 0; j >>= 1)
#pragma unroll
        for (int i = 0; i < 16; ++i) { const int l = i ^ j; if (l > i) ce_desc(a[i], a[l]); }
}

struct CandTab { int i[64]; int j[64]; };
__host__ __device__ constexpr CandTab make_cand_tab() {
    CandTab t{}; int n = 0;
    for (int i = 0; i < 16; ++i) for (int j = 0; j < 16; ++j) if ((i + 1) * (j + 1) <= 16) { t.i[n] = i; t.j[n] = j; ++n; }
    for (; n < 64; ++n) { t.i[n] = -1; t.j[n] = -1; }
    return t;
}

__device__ __forceinline__ void peer_topk_phase(const Ctx& F0, const Args& a, int layer) {
    const Ctx F = fresh(F0);
    const bf16_t* QP = (const bf16_t*)(a.ws + WS_QK);
    const bf16_t* SK = (const bf16_t*)(a.ws + WS_SK) + (size_t)layer * 2 * 128 * 128;
    unsigned short* IDX = (unsigned short*)(a.ws + WS_IDX);
    float* GATE = (float*)(a.ws + WS_GATE);
    const int gwv = F.vcu * NWAVES + F.wave, NGW = F.G * NWAVES;
    const int lane = F.lane, t32 = lane & 31, hi = lane >> 5;
    __syncthreads();
    for (int c = F.tid; c < 4096; c += 512) *(LAS u32x4*)(F.lds + (c >> 4) * 272 + (c & 15) * 16) = *(const u32x4*)(SK + (size_t)c * 8);
    __syncthreads();
#define TK_LDQ(dst, task_, p_) do { const int tk_ = (task_) < 1024 * 8 ? (task_) : 1024 * 8 - 1; const bf16_t* qp_ = QP + ((long)(tk_ >> 3) * 32 + t32) * 2048 + (tk_ & 7) * 256 + (p_) * 128 + hi * 8; \
        _Pragma("unroll") for (int ks = 0; ks < 8; ++ks) dst[ks] = *(const bf16x8*)(qp_ + ks * 16); } while (0)
    bf16x8 qn[8];
    TK_LDQ(qn, gwv, 0);
    for (int task = gwv; task < 1024 * 8; task += NGW) {
        const int tt = task >> 3, h = task & 7;
        const long tok = (long)tt * 32 + t32;
        float top[2][16];
#pragma unroll
        for (int p = 0; p < 2; ++p) {
            bf16x8 qc[8];
#pragma unroll
            for (int ks = 0; ks < 8; ++ks) qc[ks] = qn[ks];
            if (p == 0) TK_LDQ(qn, task, 1); else TK_LDQ(qn, task + NGW, 0);
            f32x16 acc[4];
#pragma unroll
            for (int eb = 0; eb < 4; ++eb)
#pragma unroll
                for (int i = 0; i < 16; ++i) acc[eb][i] = 0.f;
#pragma unroll
            for (int eb = 0; eb < 4; ++eb) asm volatile("" : "+v"(acc[eb]));
            const LAS unsigned char* kp = F.lds + (p * 128 + t32) * 272 + hi * 16;
#pragma unroll
            for (int ks = 0; ks < 8; ++ks) {
                if ((ks & 1) == 0) asm volatile("" ::: "memory");
                const bf16x8 bq = qc[ks];
#pragma unroll
                for (int eb = 0; eb < 4; ++eb) { const bf16x8 ak = *(const LAS bf16x8*)(kp + eb * 32 * 272 + ks * 32); acc[eb] = __builtin_amdgcn_mfma_f32_32x32x16_bf16(ak, bq, acc[eb], 0, 0, 0); }
            }
            float cur[16];
#pragma unroll
            for (int eb = 0; eb < 4; ++eb) {
                float v[16];
#pragma unroll
                for (int i = 0; i < 16; ++i) { const unsigned e = 32 * eb + crow(i, hi); float x = acc[eb][i]; asm volatile("" : "+v"(x));
                    v[i] = __builtin_bit_cast(float, (__builtin_bit_cast(unsigned, x) & ~0x7Fu) | e); }
                sort16_desc(v);
                if (eb == 0) {
#pragma unroll
                    for (int i = 0; i < 16; ++i) cur[i] = v[i];
                } else merge16_desc(cur, v);
            }
            float oth[16];
#pragma unroll
            for (int i = 0; i < 16; ++i) oth[i] = __shfl_xor(cur[i], 32);
            merge16_desc(cur, oth);
#pragma unroll
            for (int i = 0; i < 16; ++i) top[p][i] = cur[i];
            __builtin_amdgcn_sched_barrier(0);
        }
        float best[16];
#pragma unroll
        for (int gI = 0; gI < 4; ++gI) {
            float v[16];
#pragma unroll
            for (int q = 0; q < 16; ++q) {
                constexpr CandTab CT = make_cand_tab();
                const int ci = CT.i[16 * gI + q], cj = CT.j[16 * gI + q];
                if (ci >= 0) {
                    const unsigned ua = __builtin_bit_cast(unsigned, top[0][ci]), ub = __builtin_bit_cast(unsigned, top[1][cj]);
                    float s = top[0][ci] + top[1][cj]; asm volatile("" : "+v"(s));
                    const unsigned code = ((ua & 0x7Fu) << 7) | (ub & 0x7Fu);
                    v[q] = __builtin_bit_cast(float, (__builtin_bit_cast(unsigned, s) & ~0x3FFFu) | code);
                } else v[q] = -3.0e38f;
            }
            sort16_desc(v);
            if (gI == 0) {
#pragma unroll
                for (int i = 0; i < 16; ++i) best[i] = v[i];
            } else merge16_desc(best, v);
            __builtin_amdgcn_sched_barrier(0);
        }
        float e[16], sum = 0.f;
#pragma unroll
        for (int i = 0; i < 16; ++i) { e[i] = __builtin_amdgcn_exp2f((best[i] - best[0]) * LOG2E); sum += e[i]; }
        const float inv = 1.0f / sum;
        if (hi == 0) {
            u32x4 w0, w1;
            w0.x = (__builtin_bit_cast(unsigned, best[0]) & 0x3FFFu) | ((__builtin_bit_cast(unsigned, best[1]) & 0x3FFFu) << 16);
            w0.y = (__builtin_bit_cast(unsigned, best[2]) & 0x3FFFu) | ((__builtin_bit_cast(unsigned, best[3]) & 0x3FFFu) << 16);
            w0.z = (__builtin_bit_cast(unsigned, best[4]) & 0x3FFFu) | ((__builtin_bit_cast(unsigned, best[5]) & 0x3FFFu) << 16);
            w0.w = (__builtin_bit_cast(unsigned, best[6]) & 0x3FFFu) | ((__builtin_bit_cast(unsigned, best[7]) & 0x3FFFu) << 16);
            w1.x = (__builtin_bit_cast(unsigned, best[8]) & 0x3FFFu) | ((__builtin_bit_cast(unsigned, best[9]) & 0x3FFFu) << 16);
            w1.y = (__builtin_bit_cast(unsigned, best[10]) & 0x3FFFu) | ((__builtin_bit_cast(unsigned, best[11]) & 0x3FFFu) << 16);
            w1.z = (__builtin_bit_cast(unsigned, best[12]) & 0x3FFFu) | ((__builtin_bit_cast(unsigned, best[13]) & 0x3FFFu) << 16);
            w1.w = (__builtin_bit_cast(unsigned, best[14]) & 0x3FFFu) | ((__builtin_bit_cast(unsigned, best[15]) & 0x3FFFu) << 16);
            u32x4* ip = (u32x4*)(IDX + tok * 128 + h * 16);
            ip[0] = w0; ip[1] = w1;
        } else {
            f32x4* gp = (f32x4*)(GATE + tok * 128 + h * 16);
#pragma unroll
            for (int q = 0; q < 4; ++q) gp[q] = (f32x4){e[4 * q] * inv, e[4 * q + 1] * inv, e[4 * q + 2] * inv, e[4 * q + 3] * inv};
        }
    }
#undef TK_LDQ
    __syncthreads();
}

typedef long i64_t;
typedef unsigned u32x8_t __attribute__((ext_vector_type(8)));
typedef _Float16 h2_t __attribute__((ext_vector_type(2)));
#define U_MFMA4_FIRST(acc, av, bv) asm volatile("v_mfma_scale_f32_16x16x128_f8f6f4 %0, %1, %2, 0, %3, %4 op_sel_hi:[0,0,0] cbsz:4 blgp:4" : "=&v"(acc) : "v"(av), "v"(bv), "v"(sc_a), "v"(sc_one))
#define U_MFMA4(acc, av, bv) asm volatile("v_mfma_scale_f32_16x16x128_f8f6f4 %0, %1, %2, %0, %3, %4 op_sel_hi:[0,0,0] cbsz:4 blgp:4" : "+v"(acc) : "v"(av), "v"(bv), "v"(sc_a), "v"(sc_one))
template <int UVAR = 0>
__device__ __forceinline__ void peer_u_phase(const Ctx& F0, const Args& a, int layer) {
    const Ctx F = fresh(F0);
    const int s = (int)(blockIdx.x & 3), half = (int)((blockIdx.x >> 2) & 1), j = (int)(blockIdx.x >> 3), nmem = F.G >> 3;
    const unsigned char* U4s = a.ws + WS_TAB + (size_t)layer * TAB_LAYER + (size_t)s * NEXP * 128;
    const unsigned* XQ = (const unsigned*)(a.ws + WS_X8 + (size_t)s * ML * 256);
    const unsigned short* IDX = (const unsigned short*)(a.ws + WS_IDX);
    unsigned* PART = (unsigned*)(a.ws + WS_PART) + (size_t)s * ML * 64;
    const int lane = F.lane, rsub = lane >> 3, c8 = lane & 7, n16 = lane & 15, g4 = lane >> 4;
    LAS unsigned char* tile = F.lds + F.wave * 16384;
    constexpr float osc = 1.0f / (U_SCALE * XQ_SCALE);
    constexpr int MLH = ML / 2;
    const int t0 = half * MLH + j * NWAVES + F.wave, stride = nmem * NWAVES, ntok = (half * MLH + MLH - t0 + stride - 1) / stride;
    unsigned sc_one = 0x7f7f7f7fu; asm volatile("" : "+v"(sc_one));
    unsigned sc_a = (n16 & 1) ? 0x7d7d7d7du : 0x7f7f7f7fu; asm volatile("" : "+v"(sc_a));
    const int abase = (32 * (n16 & 1) + 4 * g4) * 4;
#define U_TOK(i) ((size_t)(t0 + ((i) < ntok ? (i) : ntok - 1) * stride))
    const unsigned wx0 = (unsigned)(size_t)(tile + rsub * 2048 + (c8 << 4));
    const unsigned rb0 = (unsigned)(size_t)(tile + n16 * 128 + ((g4 ^ ((n16 >> 1) & 7)) << 4));
    LAS unsigned char* stg = tile + g4 * 512 + n16 * 4;
#define U_LDXQ(i) (XQ[U_TOK(i) * 64 + lane])
#define U_LDI(i) (((const unsigned*)IDX)[U_TOK(i) * 64 + lane])
#define U_IDP(dst, ci) do { _Pragma("unroll") for (int k = 0; k < 8; ++k) dst[k] = (unsigned)__builtin_amdgcn_ds_bpermute((8 * rsub + k) * 4, (int)(ci)); } while (0)
#define U_EIDP(idp, i_) (((i_) & 1) ? (idp[(i_) >> 1] >> 16) : (idp[(i_) >> 1] & 0xffffu))
#define U_READS(nb0) do { \
        _Pragma("unroll") for (int nb = 0; nb < 4; ++nb) { _Pragma("unroll") for (int ks = 0; ks < 2; ++ks) \
            bw[nb][ks] = *(const LAS u32x4*)((LAS unsigned char*)(size_t)(rb0 ^ (64u * ks)) + 2048 * ((nb0) + nb)); } \
        __builtin_amdgcn_sched_barrier(0); \
    } while (0)
#define U_MFMAS() do { \
        _Pragma("unroll") for (int nb = 0; nb < 4; ++nb) U_MFMA4_FIRST(dA[nb], aop[0], bw[nb][0]); \
        _Pragma("unroll") for (int nb = 0; nb < 4; ++nb) U_MFMA4(dA[nb], aop[1], bw[nb][1]); \
        __builtin_amdgcn_sched_barrier(0); \
    } while (0)
#define U_OUTS(nb0) do { \
        asm volatile("s_nop 15\n\ts_nop 3" : "+v"(dA[0]), "+v"(dA[1]), "+v"(dA[2]), "+v"(dA[3]) :: "memory");     \
        _Pragma("unroll") for (int nb = 0; nb < 4; ++nb) { ov[(nb0) + nb] = dA[nb][0] + dA[nb][1]; asm volatile("" : "+v"(ov[(nb0) + nb])); } \
    } while (0)
#define U_BODY(j, CUR, NXT, LD) do { \
        unsigned idp[8]; \
        U_IDP(idp, ci##NXT);                                             \
          \
        _Pragma("unroll") for (int i_ = 0; i_ < 16; ++i_) { \
            *(LAS u32x4*)((LAS unsigned char*)(size_t)(wx0 ^ (unsigned)(((i_) >> 1) << 4)) + i_ * 128) = R[i_]; \
            if (UVAR == 0 || (UVAR == 1 && i_ < 8)) R[i_] = *(const u32x4*)(U4s + (unsigned)(U_EIDP(idp, i_) * 128 + 16 * c8)); \
        } \
          \
        u32x4 aop[2]; \
        _Pragma("unroll") for (int ks = 0; ks < 2; ++ks) { _Pragma("unroll") for (int k = 0; k < 4; ++k) { \
            const unsigned w_ = (unsigned)__builtin_amdgcn_ds_bpermute(abase + (16 * ks + k) * 4, (int)cx##CUR); \
            aop[ks][k] = (n16 < 2) ? w_ : 0u; } } \
        asm volatile("s_waitcnt lgkmcnt(0)" ::: "memory");               \
        f32x4 dA[4]; u32x4 bw[4][2]; float ov[8]; \
        U_READS(0); \
        U_MFMAS(); \
          \
        ci##CUR = U_LDI((j) + 3); cx##LD = U_LDXQ((j) + 2); \
        __builtin_amdgcn_sched_barrier(0); \
        U_READS(4);                                                      \
        U_OUTS(0); \
        U_MFMAS(); \
        U_OUTS(4); \
          \
        _Pragma("unroll") for (int nb = 0; nb < 8; ++nb) *(LAS float*)(stg + nb * 64) = ov[nb]; \
        asm volatile("s_waitcnt lgkmcnt(0)" ::: "memory"); \
        const f32x2 sum = *(const LAS f32x2*)(tile + 8 * lane); \
        asm volatile("s_waitcnt lgkmcnt(0)" ::: "memory"); \
        if ((j) < ntok) PART[U_TOK(j) * 64 + lane] = cvtpk(sum.x * osc, sum.y * osc); \
    } while (0)
    u32x4 R[16];
    unsigned cxA, cxB, cxC, ciA, ciB, ciC;
    ciA = U_LDI(0);
    cxA = U_LDXQ(0); cxB = U_LDXQ(1);
    { unsigned idp0[8]; U_IDP(idp0, ciA);
#pragma unroll
      for (int i_ = 0; i_ < 16; ++i_) R[i_] = *(const u32x4*)(U4s + (unsigned)(U_EIDP(idp0, i_) * 128 + 16 * c8)); }
    ciB = U_LDI(1); ciC = U_LDI(2);
    cxC = 0u;
    asm volatile("" :: "v"(ciC));
    for (int i = 0; i < ntok; i += 3) {
        U_BODY(i, A, B, C);
        U_BODY(i + 1, B, C, A);
        U_BODY(i + 2, C, A, B);
    }
#undef U_BODY
#undef U_READS
#undef U_MFMAS
#undef U_OUTS
#undef U_LDXQ
#undef U_LDI
#undef U_IDP
#undef U_EIDP
#undef U_TOK
}
#undef U_MFMA4_FIRST
#undef U_MFMA4
__device__ __forceinline__ void peer_w_phase(const Ctx& F0, const Args& a) {
    const Ctx F = fresh(F0);
    const unsigned* PART = (const unsigned*)(a.ws + WS_PART);
    const float* GATE = (const float*)(a.ws + WS_GATE);
    unsigned char* WQ = a.ws + WS_WT;
    float* WSC = (float*)(a.ws + WS_WSC);
    const int gwv = F.vcu * NWAVES + F.wave, NGW = F.G * NWAVES;
    unsigned pn[4]; f32x2 gn;
#define W_LD(t_) do { const int tt_ = (t_) < ML ? (t_) : ML - 1; _Pragma("unroll") for (int s = 0; s < 4; ++s) pn[s] = PART[((size_t)s * ML + tt_) * 64 + F.lane]; gn = *(const f32x2*)(GATE + (size_t)tt_ * 128 + 2 * F.lane); } while (0)
    W_LD(gwv);
    for (int t = gwv; t < ML; t += NGW) {
        f32x2 z = (f32x2){0.f, 0.f};
#pragma unroll
        for (int s = 0; s < 4; ++s) z += (f32x2){bflo(pn[s]), bfhi(pn[s])};
        const f32x2 g = gn;
        W_LD(t + NGW);
        f32x2 w; w.x = g.x * gelu_erf(z.x); w.y = g.y * gelu_erf(z.y);
        float wm = fmaxf(__builtin_fabsf(w.x), __builtin_fabsf(w.y));
#pragma unroll
        for (int o = 1; o < 64; o <<= 1) wm = fmaxf(wm, __shfl_xor(wm, o));
        wm = fmaxf(wm, 1e-20f);
        const float qs = 6.0f / wm, ax = fminf(fmaxf(w.x * qs, -6.f), 6.f), ay = fminf(fmaxf(w.y * qs, -6.f), 6.f);
        const unsigned ph = __builtin_amdgcn_cvt_scalef32_pk_fp4_f32(0u, ax, ay, 1.0f, 0) & 0xffu;
        const f32x2 dh = FP4_DEC(ph, 0);
        const unsigned pl = __builtin_amdgcn_cvt_scalef32_pk_fp4_f32(0u, fminf(fmaxf(4.f * (ax - dh.x), -6.f), 6.f), fminf(fmaxf(4.f * (ay - dh.y), -6.f), 6.f), 1.0f, 0) & 0xffu;
        ((unsigned short*)WQ)[(size_t)t * 128 + F.lane] = (unsigned short)((ph & 0xfu) | ((ph & 0xf0u) << 4));
        ((unsigned short*)WQ)[(size_t)t * 128 + 64 + F.lane] = (unsigned short)((pl & 0xfu) | ((pl & 0xf0u) << 4));
        if (F.lane == 0) WSC[t] = wm * (1.0f / 6.0f);
    }
#undef W_LD
}
#define V_MFMA4_FIRST(acc, av, bv, sa) asm volatile("v_mfma_scale_f32_16x16x128_f8f6f4 %0, %1, %2, 0, %3, %4 op_sel_hi:[0,0,0] cbsz:4 blgp:4" : "=&v"(acc) : "v"(av), "v"(bv), "v"(sa), "v"(sc_one))
#define V_MFMA4(acc, av, bv, sa) asm volatile("v_mfma_scale_f32_16x16x128_f8f6f4 %0, %1, %2, %0, %3, %4 op_sel_hi:[0,0,0] cbsz:4 blgp:4" : "+v"(acc) : "v"(av), "v"(bv), "v"(sa), "v"(sc_one))
template <int VAR = 0>
__device__ __forceinline__ void peer_v_phase(const Ctx& F0, const Args& a, int layer, float oscale = 1.0f) {
    const Ctx F = fresh(F0);
    const int s = (int)(blockIdx.x & 3), half = (int)((blockIdx.x >> 2) & 1), j = (int)(blockIdx.x >> 3), nmem = F.G >> 3;
    const unsigned char* V4s = a.ws + WS_TAB + (size_t)layer * TAB_LAYER + TAB_VOFF + (size_t)s * NEXP * 128;
    const unsigned short* IDX = (const unsigned short*)(a.ws + WS_IDX);
    const unsigned char* WQ = a.ws + WS_WT;
    const float* WSC = (const float*)(a.ws + WS_WSC);
    const float* modb = (const float*)(a.ws + WS_MOD) + (size_t)layer * 9 * NMOD;
    bf16_t* X = (bf16_t*)(a.ws + WS_XB);
    const int lane = F.lane, rsub = lane >> 3, c8 = lane & 7, n16 = lane & 15, g4 = lane >> 4;
    LAS unsigned char* tile = F.lds + F.wave * 16384;
    const float osc = ((DBG_SKIP & (layer == 0 ? 2 : 8)) ? 0.f : oscale) * (1.0f / V_SCALE);
    constexpr int MLH = ML / 2;
    const int t0 = half * MLH + j * NWAVES + F.wave, stride = nmem * NWAVES, ntok = (half * MLH + MLH - t0 + stride - 1) / stride;
    unsigned sc_one = 0x7f7f7f7fu; asm volatile("" : "+v"(sc_one));
    typedef int v2i_t __attribute__((ext_vector_type(2)));
    LAS float* gl = (LAS float*)(F.lds + RING_BYTES + 4096);
    for (int u = F.tid; u < 4 * 256; u += NWAVES * 64) gl[u] = modb[(size_t)(4 * half + (u >> 8)) * NMOD + 5 * DM + 256 * s + (u & 255)] * osc;
    __syncthreads();
#define V_TOK(i) ((size_t)(t0 + ((i) < ntok ? (i) : ntok - 1) * stride))
    LAS unsigned char* wx[4]; LAS unsigned char* rb[4];
#pragma unroll
    for (int k = 0; k < 4; ++k) wx[k] = tile + rsub * 2048 + ((c8 ^ k ^ ((rsub & 1) << 2)) << 4);
#pragma unroll
    for (int nb = 0; nb < 4; ++nb) rb[nb] = tile + g4 * 2048 + (n16 >> 1) * 128 + 8 * (n16 & 1) + ((nb ^ ((n16 >> 2) & 3) ^ ((g4 & 1) << 2)) << 4);
    LAS unsigned char* stg = tile + g4 * 1024 + n16 * 8;
#define V_LDW(i) (((const unsigned*)WQ)[V_TOK(i) * 64 + lane])
#define V_LDI(i) (((const unsigned*)IDX)[V_TOK(i) * 64 + lane])
#define V_LDX(i) (*(const u32x2*)(X + V_TOK(i) * DM + 256 * s + 4 * lane))
#define V_LDS(i) (WSC[V_TOK(i)])
#define V_IDP(dst, ci) do { _Pragma("unroll") for (int k = 0; k < 8; ++k) dst[k] = (unsigned)__builtin_amdgcn_ds_bpermute((8 * rsub + k) * 4, (int)(ci)); } while (0)
#define V_EIDP(idp, i_) (((i_) & 1) ? (idp[(i_) >> 1] >> 16) : (idp[(i_) >> 1] & 0xffffu))
#define V_READS(nb0) do { \
        unsigned x64 = (nb0) ? 64u : 0u; asm volatile("" : "+v"(x64));                   \
        _Pragma("unroll") for (int nb = 0; nb < 4; ++nb) { LAS unsigned char* rbn = (LAS unsigned char*)((unsigned)(size_t)rb[nb] ^ x64); \
          _Pragma("unroll") for (int h = 0; h < 2; ++h) { _Pragma("unroll") for (int q = 0; q < 2; ++q) { \
            const v2i_t tr = __builtin_amdgcn_ds_read_tr8_b64_v2i32((LAS v2i_t*)(rbn + 8192 * h + 1024 * q)); \
            bw[nb][h][2 * q] = (unsigned)tr[0]; bw[nb][h][2 * q + 1] = (unsigned)tr[1]; } } } \
        __builtin_amdgcn_sched_barrier(0); \
    } while (0)
#define V_MFMAS() do { \
        _Pragma("unroll") for (int nb = 0; nb < 4; ++nb) V_MFMA4_FIRST(dA[nb], aop[0], bw[nb][0], sc_a); \
        _Pragma("unroll") for (int nb = 0; nb < 4; ++nb) V_MFMA4(dA[nb], aop[1], bw[nb][1], sc_a); \
        __builtin_amdgcn_sched_barrier(0); \
    } while (0)
#define V_OUTS(nb0) do { \
        asm volatile("s_nop 15\n\ts_nop 3" : "+v"(dA[0]), "+v"(dA[1]), "+v"(dA[2]), "+v"(dA[3]) :: "memory");     \
        _Pragma("unroll") for (int nb = 0; nb < 4; ++nb) { ov[(nb0) + nb] = (f32x2){dA[nb][0] + dA[nb][2], dA[nb][1] + dA[nb][3]}; asm volatile("" : "+v"(ov[(nb0) + nb])); } \
    } while (0)
#define V_BODY(j, CUR, NXT, LD) do { \
        const size_t t_ = V_TOK(j); \
        unsigned idp[8]; \
        V_IDP(idp, ci##NXT);                                             \
          \
        _Pragma("unroll") for (int i_ = 0; i_ < 16; ++i_) { \
            *(LAS u32x4*)(wx[(i_ >> 1) & 3] + i_ * 128) = R[i_]; \
            if (VAR == 0 || (VAR == 1 && i_ < 8)) R[i_] = *(const u32x4*)(V4s + (unsigned)(V_EIDP(idp, i_) * 128 + 16 * c8)); \
        } \
          \
        u32x4 aop[2]; \
        _Pragma("unroll") for (int h = 0; h < 2; ++h) { _Pragma("unroll") for (int k = 0; k < 4; ++k) { \
            const unsigned w_ = (unsigned)__builtin_amdgcn_ds_bpermute(abase + (16 * h + k) * 4, (int)cw##CUR); \
            aop[h][k] = (n16 < 4) ? (w_ << ash) : 0u; } } \
        asm volatile("s_waitcnt lgkmcnt(0)" ::: "memory");               \
        f32x4 dA[4]; u32x4 bw[4][2]; f32x2 ov[8]; \
        V_READS(0); \
        V_MFMAS(); \
          \
        ci##CUR = V_LDI((j) + 3); cw##LD = V_LDW((j) + 2); xo##LD = V_LDX((j) + 2); ws##LD = V_LDS((j) + 2); \
        __builtin_amdgcn_sched_barrier(0); \
        V_READS(4);                                                      \
        V_OUTS(0); \
        V_MFMAS(); \
        V_OUTS(4); \
          \
        _Pragma("unroll") for (int nb = 0; nb < 8; ++nb) *(LAS f32x2*)(stg + nb * 128) = ov[nb]; \
        asm volatile("s_waitcnt lgkmcnt(0)" ::: "memory"); \
        const f32x4 sum = *(const LAS f32x4*)(tile + 16 * lane); \
        const f32x4 gt_ = *(const LAS f32x4*)(gl + ((t_ >> 12) & 3) * 256 + 4 * lane); \
        asm volatile("s_waitcnt lgkmcnt(0)" ::: "memory"); \
        if ((j) < ntok) { const f32x4 r_ = bf4_f32(xo##CUR) + gt_ * ws##CUR * sum; *(u32x2*)(X + t_ * DM + 256 * s + 4 * lane) = (u32x2){cvtpk(r_.x, r_.y), cvtpk(r_.z, r_.w)}; } \
    } while (0)
    u32x4 R[16];
    unsigned cwA, cwB, cwC, ciA, ciB, ciC;
    u32x2 xoA, xoB, xoC;
    float wsA, wsB, wsC;
    const int abase = (32 * ((n16 >> 1) & 1) + 4 * g4) * 4, ash = 4 * (n16 & 1);
    unsigned sc_a = (n16 & 2) ? 0x7d7d7d7du : 0x7f7f7f7fu; asm volatile("" : "+v"(sc_a));
    ciA = V_LDI(0);
    cwA = V_LDW(0); cwB = V_LDW(1); xoA = V_LDX(0); xoB = V_LDX(1); wsA = V_LDS(0); wsB = V_LDS(1);
    { unsigned idp0[8]; V_IDP(idp0, ciA);
#pragma unroll
      for (int i_ = 0; i_ < 16; ++i_) R[i_] = *(const u32x4*)(V4s + (unsigned)(V_EIDP(idp0, i_) * 128 + 16 * c8)); }
    ciB = V_LDI(1); ciC = V_LDI(2);
    cwC = 0u; xoC = (u32x2){0u, 0u}; wsC = 0.f;
    asm volatile("" :: "v"(ciC));
    for (int i = 0; i < ntok; i += 3) {
        V_BODY(i, A, B, C);
        V_BODY(i + 1, B, C, A);
        V_BODY(i + 2, C, A, B);
    }
#undef V_BODY
#undef V_READS
#undef V_MFMAS
#undef V_OUTS
#undef V_LDW
#undef V_LDI
#undef V_LDX
#undef V_LDS
#undef V_IDP
#undef V_EIDP
#undef V_TOK
}
#undef V_MFMA4_FIRST
#undef V_MFMA4

__device__ __forceinline__ void dft_nyquist_rows(const Ctx& F0, const Args& a) {
    const Ctx F = fresh(F0);
    const unsigned char* Yt = a.ws + WS_QK;
    const float* YN = (const float*)(a.ws + WS_YN);
    unsigned char* Fo = a.ws + WS_VT;
    const int gwv = F.vcu * NWAVES + F.wave, NGW = F.G * NWAVES;
    for (int o = gwv; o < NB * DM; o += NGW) {
        const unsigned char* src = Yt + (size_t)o * 4096;
        float s = 0.f;
#pragma unroll
        for (int it = 0; it < 2; ++it) { const u32x4 v = *(const u32x4*)(src + it * 1024 + F.lane * 16);
#pragma unroll
            for (int d = 0; d < 4; ++d) { const f32x2 lo = __builtin_amdgcn_cvt_pk_f32_fp8((int)v[d], false), hi = __builtin_amdgcn_cvt_pk_f32_fp8((int)v[d], true); s += (lo[0] - lo[1]) + (hi[0] - hi[1]); } }
        s = wave_sum(s) * (pg8::ACT8_SCALE / (64.0f * pg8::YT_SCALE)) + YN[o] * (pg8::ACT8_SCALE / 64.0f);
        if (F.lane == 0) Fo[((size_t)(o >> 10) * SEQ + 2048) * DM + (o & 1023)] = (unsigned char)(fp8_pack4(s, 0.f, 0.f, 0.f) & 0xffu);
    }
}
__device__ __forceinline__ void dft_yn_rows(const Ctx& F0, const Args& a) {
    const Ctx F = fresh(F0);
    const float* yi = (const float*)(a.ws + WS_YNI);
    const bf16_t* wc = (const bf16_t*)(a.ws + WS_WC);
    float* YN = (float*)(a.ws + WS_YN);
    const int gwv = F.vcu * NWAVES + F.wave, NGW = F.G * NWAVES;
    for (int o = gwv; o < NB * DM; o += NGW) {
        const int cp = o & 255;
        const f32x4 x = *(const f32x4*)(yi + (size_t)(o & ~255) + 4 * F.lane);
        const u32x2 w = *(const u32x2*)(wc + (size_t)cp * 256 + 4 * F.lane);
        const f32x4 wf = bf4_f32(w);
        const float s = wave_sum(x.x * wf.x + x.y * wf.y + x.z * wf.z + x.w * wf.w);
        if (F.lane == 0) YN[o] = s;
    }
}

__global__ void __launch_bounds__(NWAVES * 64, 2) fwd_kernel(Args args) {
    extern __shared__ __attribute__((aligned(16))) unsigned char lds_raw[];
    Ctx F;
    F.lds = (LAS unsigned char*)lds_raw;
    F.tid = threadIdx.x; F.lane = F.tid & 63; F.wave = __builtin_amdgcn_readfirstlane(F.tid >> 6);
    F.G = gridDim.x; { const int bx = blockIdx.x; F.vcu = (F.G % 8 == 0) ? (bx % 8) * (F.G / 8) + bx / 8 : bx; }
    volatile LAS unsigned* MISC = (volatile LAS unsigned*)(F.lds + MISC_OFF);
    for (int u = F.tid; u < (LDS_BYTES - LDSCTL_OFF) / 4; u += NWAVES * 64) ((LAS unsigned*)(F.lds + LDSCTL_OFF))[u] = 0u;
    __syncthreads();
    unsigned char* ws = args.ws;
    XcdBarrier bar = xcd_barrier_post((unsigned*)(ws + WS_CTL) + CW_BAR, MISC + 8);
#define GRID_BAR() xcd_barrier(bar)
#ifndef DBG_REP
#define DBG_REP 0
#endif
#ifndef DBG_VVAR
#define DBG_VVAR 0
#endif
#define REP(k, ...) do { __VA_ARGS__; if (DBG_REP == (k)) { GRID_BAR(); __VA_ARGS__; } } while (0)
#define PEER_BLOCK(layer) do { \
        norm_phase(F, args, 1, layer, 3 * DM, args.in[5] + (layer) * DM); \
        GRID_BAR(); \
        { using SHq = pg8::Shape<ML, 2048, DM / 2, DM / 2, DM / 2, 1, 0, 0>;       \
          REP(7, pg8::gemm_phase<SHq, pg8::EpiStoreBf16, true>(F.lds, pg8::Gemm{HX, (const bf16_t*)(ws + WS_WPQ) + (size_t)(layer) * 2048 * DM / 2}, F.G, bx, pg8::EpiStoreBf16{QKb, 2048, 0, 0, 1.0f, 1.0f / (pg8::ACT8_SCALE * pg8::W8_SCALE)})); } \
        GRID_BAR(); \
        REP(8, peer_topk_phase(F, args, layer)); \
        GRID_BAR(); \
        REP(9, peer_u_phase(F, args, layer)); \
        GRID_BAR(); \
        REP(10, peer_w_phase(F, args)); \
        GRID_BAR(); \
        peer_v_phase(F, args, layer); if (DBG_REP == 11) { GRID_BAR(); peer_v_phase<DBG_VVAR>(F, args, layer, 0.f); } \
        GRID_BAR(); \
    } while (0)
    const float* modb = (const float*)(ws + WS_MOD);
    bf16_t* HX = (bf16_t*)(ws + WS_HX);
    bf16_t* QKb = (bf16_t*)(ws + WS_QK);
    bf16_t* VTb = (bf16_t*)(ws + WS_VT);
    const bf16_t* Wqkv = (const bf16_t*)(ws + WS_WQKV);
    const int bx = (int)blockIdx.x;

    REP(1, p0_prologue(F, args));
    GRID_BAR();
    REP(2, norm_phase(F, args, 0, 0, 0, args.in[4]));
    GRID_BAR();
    {
        constexpr float o8 = 1.0f / (pg8::ACT8_SCALE * pg8::W8_SCALE);
        using SH1 = pg8::Shape<MT, 2048, DM / 2, DM / 2, DM / 2, 1, 0, 0>;
        pg8::gemm_phase<SH1, pg8::EpiStoreBf16, true>(F.lds, pg8::Gemm{HX, Wqkv}, F.G, bx, pg8::EpiStoreBf16{QKb, 2048, 0, 1024, 0.125f * LOG2E, o8});
        using SH2 = pg8::Shape<DM, MT, DM / 2, DM / 2, DM / 2, 1, 0, 0>;
        const int bxv = F.G - 1 - bx;
        pg8::gemm_phase<SH2, pg8::EpiStoreBf16, true>(F.lds, pg8::Gemm{Wqkv + (size_t)2048 * DM / 2, HX}, F.G, bxv, pg8::EpiStoreBf16{VTb, MT, 0, 0, 1.0f, o8});
        {
            const int nq = (MT / 256) * 8, nv = 4 * (MT / 256), rq = nq % F.G, rv = nv % F.G;
            const int sh_q = (rq == 0 || bx >= rq) ? 1 : 0, sh_v = (rv == 0 || bxv >= rv) ? 1 : 0;
            const int nq_sh = (rq == 0 ? F.G : F.G - rq);
            const int before_q = (rq == 0 ? bx : max(0, bx - rq)), before_v = nq_sh + ((rv == 0) ? bx : min(bx, F.G - rv));
            const int total = (rq == 0 ? F.G : F.G - rq) + (rv == 0 ? F.G : F.G - rv);
            if (sh_q) table_convert(F, args, before_q, 1, total);
            if (sh_v) table_convert(F, args, before_v, 1, total);
        }
    }
    GRID_BAR();
    REP(4, attn_phase(F, args));
    GRID_BAR();
    {
        using SH = pg8::Shape<ML, DM, DM / 2, DM / 2, DM / 2, 1, 0, 0>;
        pg8::gemm_phase<SH, pg8::EpiResid<false>, true>(F.lds, pg8::Gemm{(const bf16_t*)(ws + WS_HX + 36 * MiB), (const bf16_t*)(ws + WS_WO)}, F.G, bx, pg8::EpiResid<false>{args.in[0], (bf16_t*)(ws + WS_XB), modb + 2 * DM, NMOD, ((DBG_SKIP & 1) ? 0.f : 1.f) / (pg8::ACT8_SCALE * pg8::W8_SCALE)});
    }
    GRID_BAR();
    PEER_BLOCK(0);
    norm_fold_phase(F, args, 1, args.in[4] + DM);
    GRID_BAR();
    {
        using SH = pg8::Shape<256, ML / 2, 256, 256, DM, 4, 0, 256>;
        pg8::gemm_phase<SH>(F.lds, pg8::Gemm{(const bf16_t*)(ws + WS_WC), HX}, F.G, bx, pg8::EpiYt{(unsigned char*)QKb, 0});
        pg8::gemm_phase<SH>(F.lds, pg8::Gemm{(const bf16_t*)(ws + WS_WC) + 256 * 256, (const bf16_t*)(ws + WS_HX + 32 * MiB)}, F.G, bx, pg8::EpiYt{(unsigned char*)QKb, 1});
        dft_yn_rows(F, args);
    }
    GRID_BAR();
    {
        using SH = pg8::Shape<SEQ / 2, DM, 2048, 2048, 2048, NB, 0, (long)DM * 2048>;
        REP(14, pg8::gemm_phase<SH, pg8::EpiDft2, true>(F.lds, pg8::Gemm{(const bf16_t*)(ws + WS_CS), QKb}, F.G, bx, pg8::EpiDft2{(unsigned char*)VTb, (const float*)(ws + WS_YN)}));
        dft_nyquist_rows(F, args);
    }
    GRID_BAR();
    {
        using SH = pg8::Shape<ML, DM, DM / 2, DM / 2, DM / 2, 1, 0, 0>;
        pg8::gemm_phase<SH, pg8::EpiResid<true>, true>(F.lds, pg8::Gemm{VTb, (const bf16_t*)(ws + WS_WF)}, F.G, bx, pg8::EpiResid<true>{ws + WS_XB, (bf16_t*)(ws + WS_XB), modb + (size_t)9 * NMOD + 2 * DM, NMOD, ((DBG_SKIP & 4) ? 0.f : 1.f) / (pg8::ACT8_SCALE * pg8::W8_SCALE)});
    }
    GRID_BAR();
    PEER_BLOCK(1);
    if (DBG_REP == 20) { for (int r = 0; r < 16; ++r) GRID_BAR(); }
    final_norm_phase(F, args);
#undef PEER_BLOCK
}

extern "C" void kernel_launch(void* const* d_in, const int* in_sizes, int n_in, void* d_out, int out_size, void* d_ws, size_t ws_size, hipStream_t stream) {
    static int grid = 0;
    if (grid == 0) {
        if (n_in != 17 || in_sizes[0] != ML * DM || out_size != ML * DM || ws_size < WS_END) { fprintf(stderr, "kernel_launch: unexpected shapes (n_in %d, in0 %d, out %d, ws %zu)\n", n_in, n_in > 0 ? in_sizes[0] : -1, out_size, ws_size); grid = -1; return; }
        int dev = 0, cus = 0, per_cu = 0;
        if (hipGetDevice(&dev) != hipSuccess || hipDeviceGetAttribute(&cus, hipDeviceAttributeMultiprocessorCount, dev) != hipSuccess) { grid = -1; return; }
        if (hipFuncSetAttribute((const void*)fwd_kernel, hipFuncAttributeMaxDynamicSharedMemorySize, LDS_BYTES) != hipSuccess) { fprintf(stderr, "kernel_launch: hipFuncSetAttribute failed\n"); grid = -1; return; }
        if (hipOccupancyMaxActiveBlocksPerMultiprocessor(&per_cu, (const void*)fwd_kernel, NWAVES * 64, LDS_BYTES) != hipSuccess || per_cu < 1)
            fprintf(stderr, "kernel_launch: note: occupancy query reports %d workgroups per CU\n", per_cu);
        (void)hipGetLastError();
        grid = cus;
        if (grid % 8 != 0) { fprintf(stderr, "kernel_launch: CU count %d is not a multiple of 8\n", cus); grid = -1; return; }
    }
    if (grid < 0) return;
    if (hipMemsetAsync((char*)d_ws + WS_CTL, 0, CTL_ZERO_BYTES, stream) != hipSuccess) { fprintf(stderr, "kernel_launch: memset failed\n"); return; }
    Args a{};
    for (int i = 0; i < 17; ++i) a.in[i] = (const float*)d_in[i];
    a.out = (float*)d_out; a.ws = (unsigned char*)d_ws;
    hipLaunchKernelGGL(fwd_kernel, dim3(grid), dim3(NWAVES * 64), LDS_BYTES, stream, a);
    const hipError_t le = hipPeekAtLastError();
    if (le != hipSuccess) fprintf(stderr, "kernel_launch: launch failed: %s\n", hipGetErrorName(le));
}
```

```cpp
#include <hip/hip_runtime.h>
#include <cstdio>
#include <cstdint>

#define LAS __attribute__((address_space(3)))
typedef unsigned short bf16_t;
typedef short bf16x8 __attribute__((ext_vector_type(8)));
typedef short s16x4 __attribute__((ext_vector_type(4)));
typedef float f32x2 __attribute__((ext_vector_type(2)));
typedef float f32x4 __attribute__((ext_vector_type(4)));
typedef float f32x16 __attribute__((ext_vector_type(16)));
typedef unsigned u32x2 __attribute__((ext_vector_type(2)));
typedef unsigned u32x4 __attribute__((ext_vector_type(4)));
typedef __bf16 bf16x2_t __attribute__((ext_vector_type(2)));

#ifndef DBG_SKIP
#define DBG_SKIP 0
#endif
constexpr int DM = 1024, NB = 8, SEQ = 4096, CTXL = 256, GW = 64;
constexpr int ML = NB * SEQ;
constexpr int MC = NB * CTXL;
constexpr int MT = ML + MC;
constexpr int NMOD = 6 * DM;
constexpr int NEXP = 16384;
constexpr float EPS = 1e-6f;
constexpr float LOG2E = 1.4426950408889634f;

constexpr size_t MiB = 1u << 20;
constexpr size_t WS_CTL = 0, CTL_ZERO_BYTES = 1 * MiB;
constexpr size_t WS_MOD = 1 * MiB;
constexpr size_t WS_WQKV = 2 * MiB;
constexpr size_t WS_WO = 8 * MiB;
constexpr size_t WS_WF = 10 * MiB;
constexpr size_t WS_WPQ = 12 * MiB;
constexpr size_t WS_SK = 20 * MiB;
constexpr size_t WS_WC = 20 * MiB + 256 * 1024;
constexpr size_t WS_CS = 22 * MiB;
constexpr size_t WS_TAB = 38 * MiB;
constexpr size_t WS_X8 = 150 * MiB;
constexpr size_t WS_WT = 182 * MiB;
constexpr size_t WS_PART = 282 * MiB;
constexpr float U_SCALE = 64.f;
constexpr float XQ_SCALE = 0.75f;
constexpr float V_SCALE = 2.f;
constexpr size_t WS_XB = 70 * MiB;
constexpr size_t TAB_LAYER = 16 * MiB, TAB_VOFF = 8 * MiB;
constexpr size_t WS_WSC = 198 * MiB;
constexpr size_t WS_YNI = 199 * MiB;
constexpr size_t WS_YN = WS_YNI + 64 * 1024;
constexpr size_t WS_HX = 214 * MiB;
constexpr size_t WS_QK = 282 * MiB;
constexpr size_t WS_VT = 418 * MiB;
constexpr size_t WS_IDX = WS_VT;
constexpr size_t WS_GATE = WS_VT + 8 * MiB;
constexpr size_t WS_END = 486 * MiB;
constexpr int CW_BAR = 4096;

__device__ __forceinline__ unsigned f2bf(float f) { unsigned u = __builtin_bit_cast(unsigned, f); return (u + 0x7fffu + ((u >> 16) & 1u)) >> 16; }
__device__ __forceinline__ unsigned pk2(float lo, float hi) { return f2bf(lo) | (f2bf(hi) << 16); }
__device__ __forceinline__ f32x4 bf4_f32(u32x2 w) { return (f32x4){__builtin_bit_cast(float, w.x << 16), __builtin_bit_cast(float, w.x & 0xffff0000u), __builtin_bit_cast(float, w.y << 16), __builtin_bit_cast(float, w.y & 0xffff0000u)}; }
__device__ __forceinline__ unsigned cvtpk(float lo, float hi) { f32x2 v = {lo, hi}; bf16x2_t b = __builtin_convertvector(v, bf16x2_t); return __builtin_bit_cast(unsigned, b); }
__device__ __forceinline__ float bflo(unsigned u) { return __builtin_bit_cast(float, u << 16); }
__device__ __forceinline__ float bfhi(unsigned u) { return __builtin_bit_cast(float, u & 0xffff0000u); }
__device__ __forceinline__ float wave_sum(float v) {
#pragma unroll
    for (int o = 1; o < 64; o <<= 1) v += __shfl_xor(v, o);
    return v;
}
__device__ __forceinline__ unsigned fp8_pack4(float a, float b, float c, float d) {
    int w = 0;
    w = __builtin_amdgcn_cvt_pk_fp8_f32(__builtin_amdgcn_fmed3f(a, -448.f, 448.f), __builtin_amdgcn_fmed3f(b, -448.f, 448.f), w, false);
    w = __builtin_amdgcn_cvt_pk_fp8_f32(__builtin_amdgcn_fmed3f(c, -448.f, 448.f), __builtin_amdgcn_fmed3f(d, -448.f, 448.f), w, true);
    return (unsigned)w;
}
__device__ __forceinline__ int crow(int r, int hi) { return (r & 3) + 8 * (r >> 2) + 4 * hi; }
__device__ __forceinline__ float gelu_erf(float v) {
    const float av = __builtin_fabsf(v), d = av * 0.2316418882f + 1.0f;
    const float t = __builtin_amdgcn_rcpf(d);
    float q = t * 0.5307027145f + (-0.7265760135f); q = q * t + 0.7107068705f; q = q * t + (-0.142248368f); q = q * t + 0.127414796f; q = q * t;
    const float e = __builtin_amdgcn_exp2f((v * v) * (-0.72134752044f));
    const float m = v * (q * e), r = v - m;
    return v < 0.f ? m : r;
}

namespace pg8 {
constexpr float ACT8_SCALE = 16.f, W8_SCALE = 256.f;
constexpr float YT_SCALE = 16.f, CS_SCALE = 512.f;
constexpr int BM = 256, BK = 64, HALF = 128, HTB = HALF * BK * 2, STAGE_BYTES = 8 * HTB, NXCD = 8, WGM = 8;
__host__ __device__ __forceinline__ int lds_byte(int r, int c) { const int st = (r >> 4) * 2 + (c >> 5), rr = r & 15, cc = c & 31, ob = rr * 64 + cc * 2; return st * 1024 + (ob ^ (((ob >> 9) & 1) << 5)); }
__host__ __device__ __forceinline__ void stage_rc(int b, int& R, int& C) { const int st = b / 1024, sb = b % 1024, swz = sb ^ (((sb >> 9) & 1) << 5); R = (st >> 1) * 16 + swz / 64; C = (st & 1) * 32 + (swz % 64) / 2; }
__host__ __device__ __forceinline__ int perm32(int rho) { const int n = rho >> 4, i = rho & 15; return 8 * (i >> 2) + 4 * n + (i & 3); }

struct Unit { int pm, pn, pb; };
struct Gemm { const bf16_t* A; const bf16_t* Bt; };
template <int M_, int N_, int K_, int LDA_, int LDB_, int NBATCH_, long BSA_, long BSB_> struct Shape { static constexpr int M = M_, N = N_, K = K_, lda = LDA_, ldb = LDB_, nbatch = NBATCH_; static constexpr long bsA = BSA_, bsB = BSB_; };

template <class SH> struct StaticOrder {
    static constexpr int nM = SH::M / BM, nN = SH::N / BM, per = nM * nN, nwg = per * SH::nbatch;
    int G, c;
    __device__ __forceinline__ void init(int G_, int c_) { G = G_; c = c_; }
    __device__ __forceinline__ bool next(int i, Unit& u) const {
        const long L = (long)i * G + c; if (L >= nwg) return false;
        int wgid = (int)L; { const int q = nwg / NXCD, r = nwg % NXCD, xcd = wgid % NXCD, off = wgid / NXCD; wgid = (xcd < r ? xcd * (q + 1) : r * (q + 1) + (xcd - r) * q) + off; }
        u.pb = wgid / per; wgid -= u.pb * per;
        const int nig = WGM * nN, gid = wgid / nig, fm = gid * WGM, gsz = (nM - fm) < WGM ? (nM - fm) : WGM;
        u.pm = fm + ((wgid % nig) % gsz); u.pn = (wgid % nig) / gsz; return true;
    }
};

struct EpiStoreBf16 {
    static constexpr bool PERM = true;
    bf16_t* O; long ldc; long bstride; int scols; float scale0; float oscale = 1.0f;
    __device__ __forceinline__ void operator()(const f32x4 (&acc)[2][2][4][2], const Unit& u, int wr, int wc, int fr, int fq) const {
        const int row0 = u.pm * BM + wr * 64 + fr, col0 = u.pn * BM + wc * 32 + 8 * fq;
        bf16_t* base = O + (long)u.pb * bstride;
        const float sc = ((u.pn * BM < scols) ? scale0 : 1.0f) * oscale;
#pragma unroll
        for (int ai = 0; ai < 2; ++ai)
#pragma unroll
            for (int m = 0; m < 4; ++m) { bf16_t* rowp = base + (long)(row0 + ai * HALF + m * 16) * ldc + col0;
#pragma unroll
                for (int bj = 0; bj < 2; ++bj) { const f32x4 v0 = acc[ai][bj][m][0] * sc, v1 = acc[ai][bj][m][1] * sc;
                    u32x4 w; w.x = cvtpk(v0[0], v0[1]); w.y = cvtpk(v0[2], v0[3]); w.z = cvtpk(v1[0], v1[1]); w.w = cvtpk(v1[2], v1[3]);
                    asm volatile("global_store_dwordx4 %0, %1, off sc1\n\ts_nop 1" :: "v"(rowp + bj * HALF), "v"(w) : "memory"); } }
    }
};
struct EpiDft2 {
    static constexpr bool PERM = true;
    unsigned char* O; const float* yn;
    __device__ __forceinline__ void operator()(const f32x4 (&acc)[2][2][4][2], const Unit& u, int wr, int wc, int fr, int fq) const {
        const int row0 = u.pm * BM + wr * 64 + fr, cl0 = wc * 32 + 8 * fq;
        unsigned char* base = O + (long)u.pb * SEQ * DM + u.pn * BM;
        constexpr float osc = ACT8_SCALE / (YT_SCALE * CS_SCALE);
        f32x4 y0[2], y1[2];
#pragma unroll
        for (int bj = 0; bj < 2; ++bj) { const float* yp = yn + (long)u.pb * DM + u.pn * BM + cl0 + bj * HALF; y0[bj] = *(const f32x4*)yp * (ACT8_SCALE / 64.0f); y1[bj] = *(const f32x4*)(yp + 4) * (ACT8_SCALE / 64.0f); }
#pragma unroll
        for (int ai = 0; ai < 2; ++ai)
#pragma unroll
            for (int m = 0; m < 4; ++m) { const int np = row0 + ai * HALF + m * 16;
                unsigned char* rowp = base + (long)np * DM; unsigned char* mirp = base + (long)(SEQ - np) * DM;
#pragma unroll
                for (int bj = 0; bj < 2; ++bj) { const float sg = (np & 1) ? -1.0f : 1.0f; const f32x4 v0 = acc[ai][bj][m][0] * osc + y0[bj] * sg, v1 = acc[ai][bj][m][1] * osc + y1[bj] * sg; const int cl = cl0 + bj * HALF;
                    u32x2 w; w.x = fp8_pack4(v0[0], v0[1], v0[2], v0[3]); w.y = fp8_pack4(v1[0], v1[1], v1[2], v1[3]);
                    *(u32x2*)(rowp + cl) = w;
                    if (np != 0) {
                        if (cl != 0) {
                            u32x2 rv; rv.x = __builtin_bswap32(w.y); rv.y = __builtin_bswap32(w.x);
                            asm volatile("global_store_dwordx2 %0, %1, off" :: "v"(mirp + 249 - cl), "v"(rv) : "memory");
                        } else {
#pragma unroll
                            for (int i = 0; i < 8; ++i) mirp[(256 - cl - i) & 255] = (unsigned char)((w[i >> 2] >> (8 * (i & 3))) & 0xffu); } } }
                asm volatile("" ::: "memory"); }
    }
};
struct EpiYt {
    static constexpr bool PERM = true;
    unsigned char* Yt; int part;
    __device__ __forceinline__ void operator()(const f32x4 (&acc)[2][2][4][2], const Unit& u, int wr, int wc, int fr, int fq) const {
        const int row0 = u.pm * BM + wr * 64 + fr, col0 = u.pn * BM + wc * 32 + 8 * fq;
#pragma unroll
        for (int ai = 0; ai < 2; ++ai)
#pragma unroll
            for (int m = 0; m < 4; ++m) { const int cp = row0 + ai * HALF + m * 16;
#pragma unroll
                for (int bj = 0; bj < 2; ++bj) { const int col = col0 + bj * HALF; const int b = col >> 11, k = col & 2047;
                    const f32x4 v0 = acc[ai][bj][m][0] * YT_SCALE, v1 = acc[ai][bj][m][1] * YT_SCALE;
                    u32x2 w; w.x = fp8_pack4(v0[0], v0[1], v0[2], v0[3]); w.y = fp8_pack4(v1[0], v1[1], v1[2], v1[3]);
                    *(u32x2*)(Yt + (((long)(b * 4 + u.pb) * 256 + cp) << 12) + part * 2048 + k) = w; }
                asm volatile("" ::: "memory"); }
    }
};
template <bool IN_BF16>
struct EpiResid {
    static constexpr bool PERM = true;
    const void* Xin; bf16_t* Xout; const float* gate; int gstride; float gs;
    __device__ __forceinline__ void operator()(const f32x4 (&acc)[2][2][4][2], const Unit& u, int wr, int wc, int fr, int fq) const {
        const int row0 = u.pm * BM + wr * 64 + fr, col0 = u.pn * BM + wc * 32 + 8 * fq;
        const float* gb = gate + (long)((u.pm * BM) >> 12) * gstride;
        f32x4 gv[2][2];
#pragma unroll
        for (int bj = 0; bj < 2; ++bj)
#pragma unroll
            for (int n = 0; n < 2; ++n) gv[bj][n] = *(const f32x4*)(gb + col0 + bj * HALF + n * 4);
        f32x4 xf[2][8]; u32x4 xb[2][4];
#define ER_OFF(b_, q_) ((long)(row0 + ((b_) >> 1) * HALF + (2 * ((b_) & 1) + ((q_) >> 1)) * 16) * DM + col0 + ((q_) & 1) * HALF)
#define ER_LOAD(b_) do { _Pragma("unroll") for (int q_ = 0; q_ < 4; ++q_) { const long o_ = ER_OFF(b_, q_); \
            if (IN_BF16) xb[(b_) & 1][q_] = *(const u32x4*)((const bf16_t*)Xin + o_); \
            else { xf[(b_) & 1][2 * q_] = *(const f32x4*)((const float*)Xin + o_); xf[(b_) & 1][2 * q_ + 1] = *(const f32x4*)((const float*)Xin + o_ + 4); } } } while (0)
        ER_LOAD(0);
#pragma unroll
        for (int b_ = 0; b_ < 4; ++b_) {
            if (b_ + 1 < 4) ER_LOAD(b_ + 1);
#pragma unroll
            for (int q_ = 0; q_ < 4; ++q_) { const long o_ = ER_OFF(b_, q_); const int ai = b_ >> 1, m = 2 * (b_ & 1) + (q_ >> 1), bj = q_ & 1;
                const u32x4 xq = xb[b_ & 1][q_];
                const f32x4 bs0 = IN_BF16 ? bf4_f32((u32x2){xq.x, xq.y}) : xf[b_ & 1][2 * q_], bs1 = IN_BF16 ? bf4_f32((u32x2){xq.z, xq.w}) : xf[b_ & 1][2 * q_ + 1];
                const f32x4 r0 = bs0 + gv[bj][0] * acc[ai][bj][m][0] * gs, r1 = bs1 + gv[bj][1] * acc[ai][bj][m][1] * gs;
                u32x4 w; w.x = cvtpk(r0.x, r0.y); w.y = cvtpk(r0.z, r0.w); w.z = cvtpk(r1.x, r1.y); w.w = cvtpk(r1.z, r1.w);
                asm volatile("global_store_dwordx4 %0, %1, off sc1\n\ts_nop 1" :: "v"(Xout + o_), "v"(w) : "memory"); }
            asm volatile("" ::: "memory");
        }
#undef ER_OFF
#undef ER_LOAD
    }
};

template <class SH, class Epi, bool FP8 = false>
__device__ __forceinline__ void gemm_phase(LAS unsigned char* lds, const Gemm g, int G_, int c_, const Epi& E) {
    StaticOrder<SH> S; S.init(G_, c_);
    int tid_ = threadIdx.x; asm volatile("" : "+v"(tid_));
    const int tid = tid_, wid = __builtin_amdgcn_readfirstlane(tid >> 6), lane = tid & 63, wr = wid >> 2, wc = wid & 3, fr = lane & 15, fq = lane >> 4;
    constexpr int K = SH::K, nt = K / BK;
    unsigned voffA[2], voffB[2];
#pragma unroll
    for (int i = 0; i < 2; ++i) { int R, C; stage_rc(tid * 16 + i * 8192, R, C); const int Rb = Epi::PERM ? ((R & ~31) + perm32(R & 31)) : R;
        voffA[i] = (unsigned)(R * SH::lda + C) * 2u; voffB[i] = (unsigned)(Rb * SH::ldb + C) * 2u; }
    constexpr size_t kstep = (size_t)(BK * 2);
    constexpr size_t hstepA = (size_t)HALF * SH::lda * 2, hstepB = (size_t)HALF * SH::ldb * 2;
    constexpr size_t tstepA = 2 * hstepA, tstepB = 2 * hstepB;
    const unsigned ldsw = (unsigned)wid * 1024u;
    const int aoff = lds_byte(wr * 64 + fr, fq * 8), boff = lds_byte(wc * 32 + fr, fq * 8);
#define PG8_SA(b, h) (((b) * 2 + (h)) * HTB)
#define PG8_SB(b, h) ((4 + (b) * 2 + (h)) * HTB)
#define PG8_STAGE(bufoff, gbase, voff) do { _Pragma("unroll") for (int _i = 0; _i < 2; ++_i) \
        __builtin_amdgcn_global_load_lds((const unsigned*)((const char*)(gbase) + (voff)[_i]), (LAS unsigned*)(lds + (bufoff) + ldsw + _i * 8192), 16, 0, 0); } while (0)
#define PG8_LDA(dst, b, h) do { _Pragma("unroll") for (int m = 0; m < 4; ++m) { const u32x4 f0_ = *(const LAS u32x4*)(lds + PG8_SA(b, h) + aoff + m * 2048), f1_ = *(const LAS u32x4*)(lds + PG8_SA(b, h) + aoff + m * 2048 + 1024); dst[m] = __builtin_shufflevector(f0_, f1_, 0, 1, 2, 3, 4, 5, 6, 7); } } while (0)
#define PG8_LDB(dst, b, h) do { _Pragma("unroll") for (int n = 0; n < 2; ++n) { const u32x4 f0_ = *(const LAS u32x4*)(lds + PG8_SB(b, h) + boff + n * 2048), f1_ = *(const LAS u32x4*)(lds + PG8_SB(b, h) + boff + n * 2048 + 1024); dst[n] = __builtin_shufflevector(f0_, f1_, 0, 1, 2, 3, 4, 5, 6, 7); } } while (0)
typedef int v8i_t __attribute__((ext_vector_type(8)));
typedef unsigned u32x8 __attribute__((ext_vector_type(8)));
#define PG8_LOH(x) __builtin_bit_cast(bf16x8, __builtin_shufflevector(x, x, 0, 1, 2, 3))
#define PG8_HIH(x) __builtin_bit_cast(bf16x8, __builtin_shufflevector(x, x, 4, 5, 6, 7))
#define PG8_MMA(ai, bj, At, Bt) do { __builtin_amdgcn_s_setprio(1); _Pragma("unroll") for (int m = 0; m < 4; ++m) _Pragma("unroll") for (int n = 0; n < 2; ++n) { \
        if constexpr (FP8) asm volatile("v_mfma_scale_f32_16x16x128_f8f6f4 %0, %1, %2, %0, %3, %3 op_sel_hi:[0,0,0]" : "+v"(acc[ai][bj][m][n]) : "v"(Bt[n]), "v"(At[m]), "v"(fp8_one));   \
        else { acc[ai][bj][m][n] = __builtin_amdgcn_mfma_f32_16x16x32_bf16(PG8_LOH(Bt[n]), PG8_LOH(At[m]), acc[ai][bj][m][n], 0, 0, 0); \
               acc[ai][bj][m][n] = __builtin_amdgcn_mfma_f32_16x16x32_bf16(PG8_HIH(Bt[n]), PG8_HIH(At[m]), acc[ai][bj][m][n], 0, 0, 0); } } \
        __builtin_amdgcn_s_setprio(0); } while (0)
#define PG8_WAIT_V(n) asm volatile("s_waitcnt vmcnt(" #n ")" ::: "memory")
#define PG8_WAIT_L(n) asm volatile("s_waitcnt lgkmcnt(" #n ")" ::: "memory")
#define PG8_BAR __builtin_amdgcn_s_barrier()
#define PG8_SCHED __builtin_amdgcn_sched_barrier(0)
    Unit cur, nxt; int ui = 0;
    if (!S.next(0, cur)) return;
    f32x4 acc[2][2][4][2];
#pragma unroll
    for (int a = 0; a < 2; ++a)
#pragma unroll
        for (int b = 0; b < 2; ++b)
#pragma unroll
            for (int m = 0; m < 4; ++m)
#pragma unroll
                for (int n = 0; n < 2; ++n) acc[a][b][m][n] = (f32x4){0.f, 0.f, 0.f, 0.f};
    unsigned fp8_one = 0x7f7f7f7fu; asm volatile("" : "+v"(fp8_one));
    u32x8 At[4], B0[2], B1[2];
    const char* cA = (const char*)(g.A + (long)cur.pb * SH::bsA) + (size_t)cur.pm * tstepA; const char* cB = (const char*)(g.Bt + (long)cur.pb * SH::bsB) + (size_t)cur.pn * tstepB;
    PG8_STAGE(PG8_SB(0, 0), cB, voffB); PG8_STAGE(PG8_SB(0, 1), cB + hstepB, voffB); PG8_STAGE(PG8_SA(0, 0), cA, voffA); PG8_STAGE(PG8_SA(0, 1), cA + hstepA, voffA);
    if (wr == 1) PG8_BAR;
    PG8_WAIT_V(2); PG8_BAR;
    PG8_STAGE(PG8_SB(1, 0), cB + kstep, voffB); PG8_STAGE(PG8_SA(1, 0), cA + kstep, voffA); PG8_STAGE(PG8_SB(1, 1), cB + hstepB + kstep, voffB);
    PG8_WAIT_V(6); PG8_BAR;
    for (;;) {
        const bool has_next = S.next(ui + 1, nxt);
        const char* nA = has_next ? (const char*)(g.A + (long)nxt.pb * SH::bsA) + (size_t)nxt.pm * tstepA : cA; const char* nB = has_next ? (const char*)(g.Bt + (long)nxt.pb * SH::bsB) + (size_t)nxt.pn * tstepB : cB;
#pragma nounroll
        for (int t = 0; t < nt; t += 2) {
            const bool last = (t == nt - 2);
            const char* a1 = cA + (size_t)(t + 1) * kstep;
            const char* a2 = last ? nA : cA + (size_t)(t + 2) * kstep; const char* b2 = last ? nB : cB + (size_t)(t + 2) * kstep;
            const char* a3 = a2 + kstep; const char* b3 = b2 + kstep;
            PG8_LDB(B0, 0, 0); PG8_LDB(B1, 0, 1); PG8_SCHED; PG8_LDA(At, 0, 0); PG8_STAGE(PG8_SA(1, 1), a1 + hstepA, voffA);
            PG8_WAIT_V(8); PG8_WAIT_L(0); PG8_BAR; PG8_MMA(0, 0, At, B0); PG8_MMA(0, 1, At, B1); PG8_BAR; PG8_SCHED;
            PG8_LDA(At, 0, 1); PG8_STAGE(PG8_SB(0, 0), b2, voffB); PG8_STAGE(PG8_SB(0, 1), b2 + hstepB, voffB); PG8_STAGE(PG8_SA(0, 0), a2, voffA);
            PG8_WAIT_V(8); PG8_WAIT_L(0); PG8_BAR; PG8_MMA(1, 0, At, B0); PG8_MMA(1, 1, At, B1); PG8_BAR; PG8_SCHED;
            PG8_LDB(B0, 1, 0); PG8_LDB(B1, 1, 1); PG8_SCHED; PG8_LDA(At, 1, 0); PG8_STAGE(PG8_SA(0, 1), a2 + hstepA, voffA);
            PG8_WAIT_V(8); PG8_WAIT_L(0); PG8_BAR; PG8_MMA(0, 0, At, B0); PG8_MMA(0, 1, At, B1); PG8_BAR; PG8_SCHED;
            PG8_LDA(At, 1, 1); PG8_STAGE(PG8_SB(1, 0), b3, voffB); PG8_STAGE(PG8_SB(1, 1), b3 + hstepB, voffB); PG8_STAGE(PG8_SA(1, 0), a3, voffA);
            PG8_WAIT_V(8); PG8_WAIT_L(0); PG8_BAR; PG8_MMA(1, 0, At, B0); PG8_MMA(1, 1, At, B1); PG8_BAR; PG8_SCHED;
        }
        if (wr == 0) PG8_BAR;
        if constexpr (FP8) asm volatile("s_nop 15\n\ts_nop 15\n\ts_nop 7" ::: "memory");
        E(acc, cur, wr, wc, fr, fq);
        if (!has_next) break;
#pragma unroll
        for (int a = 0; a < 2; ++a)
#pragma unroll
            for (int b = 0; b < 2; ++b)
#pragma unroll
                for (int m = 0; m < 4; ++m)
#pragma unroll
                    for (int n = 0; n < 2; ++n) acc[a][b][m][n] = (f32x4){0.f, 0.f, 0.f, 0.f};
        cur = nxt; cA = nA; cB = nB; ++ui;
        if (wr == 1) PG8_BAR;
    }
    PG8_WAIT_V(0);
    PG8_BAR;
#undef PG8_SA
#undef PG8_SB
#undef PG8_STAGE
#undef PG8_LDA
#undef PG8_LDB
#undef PG8_MMA
#undef PG8_WAIT_V
#undef PG8_WAIT_L
#undef PG8_BAR
#undef PG8_SCHED
}
}

#define XB_TMO      128
#define XB_XCNT(j)  (256  + 64 * (j))
#define XB_XSUB(j)  (1280 + 64 * (j))
#define XB_XGEN(j)  (2304 + 64 * (j))
#define XB_TOP      3328
#define XB_TOPGEN   3392
#define XCD_BAR_WORDS 3456
#define XB_SPIN_CAP (1u << 18)
__device__ __forceinline__ unsigned xb_ld(unsigned* p)              { return __hip_atomic_load(p, __ATOMIC_RELAXED, __HIP_MEMORY_SCOPE_AGENT); }
__device__ __forceinline__ unsigned xb_add(unsigned* p, unsigned v) { return __hip_atomic_fetch_add(p, v, __ATOMIC_RELAXED, __HIP_MEMORY_SCOPE_AGENT); }
__device__ __forceinline__ unsigned xb_xcc_id() { return (unsigned)__builtin_amdgcn_s_getreg((3 << 11) | 20) & 0xFu; }
#define XB_SPIN(cond, bar) do { unsigned _sp = 0; while (cond) { __builtin_amdgcn_s_sleep(1); \
    if ((++_sp & 255u) == 0u) { if (xb_ld(&(bar)[XB_TMO])) break; if (_sp > XB_SPIN_CAP) { atomicAdd(&(bar)[XB_TMO], 1u); break; } } } } while (0)
struct XcdBarrier { unsigned* bar; unsigned x; volatile LAS unsigned* st; };
__device__ __forceinline__ XcdBarrier xcd_barrier_post(unsigned* bar, volatile LAS unsigned* st) {
    XcdBarrier b; b.bar = bar; b.x = xb_xcc_id(); b.st = st;
    if (threadIdx.x == 0) (void)xb_add(&bar[XB_XCNT(b.x)], 1u);
    return b;
}
__device__ __forceinline__ void xcd_barrier_complete(unsigned* bar, unsigned x, unsigned& nloc, unsigned& nx) {
    const unsigned G = gridDim.x * gridDim.y * gridDim.z;
    unsigned sum, cnt, mine, sp = 0u;
    for (;;) {
        sum = 0u; cnt = 0u; mine = 0u;
#pragma unroll
        for (unsigned j = 0; j < 16; ++j) { const unsigned c = xb_ld(&bar[XB_XCNT(j)]); sum += c; cnt += (c > 0u) ? 1u : 0u; mine = (j == x) ? c : mine; }
        if (sum == G) break;
        __builtin_amdgcn_s_sleep(1);
        if ((++sp & 255u) == 0u) { if (xb_ld(&bar[XB_TMO])) break; if (sp > XB_SPIN_CAP) { atomicAdd(&bar[XB_TMO], 1u); break; } }
    }
    nloc = mine > 0u ? mine : 1u; nx = cnt > 0u ? cnt : 1u;
}
template <bool REL = true>
__device__ __forceinline__ void xcd_barrier(const XcdBarrier& b) {
    asm volatile("s_waitcnt vmcnt(0)" ::: "memory");
    __syncthreads();
    if (threadIdx.x == 0) {
        unsigned* bar = b.bar;
        __builtin_amdgcn_s_waitcnt(0);
        unsigned nloc = b.st[0], nx = b.st[1];
        if (nloc == 0u) { xcd_barrier_complete(bar, b.x, nloc, nx); b.st[0] = nloc; b.st[1] = nx; }
        const unsigned old = xb_add(&bar[XB_XSUB(b.x)], 1u);
        const unsigned gen = old / nloc;
        if (old + 1u == (gen + 1u) * nloc) {
            if (REL) { __builtin_amdgcn_fence(__ATOMIC_RELEASE, "agent");
                       asm volatile("s_waitcnt vmcnt(0)" ::: "memory"); }
            const unsigned og = xb_add(&bar[XB_TOP], 1u);
            const unsigned tg = og / nx;
            if (og + 1u == (tg + 1u) * nx) {
#pragma unroll
                for (unsigned j = 0; j < 16; ++j) (void)xb_add(&bar[XB_XGEN(j)], 1u);
            } else XB_SPIN(xb_ld(&bar[XB_XGEN(b.x)]) == gen, bar);
            __builtin_amdgcn_fence(__ATOMIC_ACQUIRE, "agent");
            asm volatile("s_waitcnt vmcnt(0)" ::: "memory");
        } else {
            if (REL && old == gen * nloc) asm volatile("buffer_wbl2 sc1" ::: "memory");
            XB_SPIN(xb_ld(&bar[XB_XGEN(b.x)]) == gen, bar);
            __builtin_amdgcn_fence(__ATOMIC_ACQUIRE, "agent");
            asm volatile("s_waitcnt vmcnt(0)" ::: "memory");
        }
    }
    __syncthreads();
}

constexpr int RING_BYTES = 131072;
constexpr int LDSCTL_OFF = RING_BYTES, MISC_OFF = LDSCTL_OFF + 320;
constexpr int LDS_BYTES = 147456;
constexpr int NWAVES = 8;

struct Args { const float* in[17]; float* out; unsigned char* ws; };

struct Ctx {
    LAS unsigned char* lds;
    int tid, lane, wave, vcu, G;
};

__device__ __forceinline__ Ctx fresh(const Ctx& F) {
    Ctx C = F; int t = threadIdx.x; asm volatile("" : "+v"(t)); C.tid = t; C.lane = t & 63; return C;
}
__device__ __forceinline__ void p0_transpose_item(const float* W, int K, int N, bf16_t* WT, LAS float* scr, int item, int lane) {
    const int nblk = N / 32, kb = item / nblk, nb = item % nblk, k0 = 64 * kb, n0 = 32 * nb;
#pragma unroll 8
    for (int i = 0; i < 32; ++i) { const int kk = 2 * i + (lane >> 5); scr[kk * 33 + (lane & 31)] = W[(size_t)(k0 + kk) * N + n0 + (lane & 31)]; }
    asm volatile("s_waitcnt lgkmcnt(0)" ::: "memory");
    const int c = lane & 7;
#pragma unroll
    for (int j = 0; j < 4; ++j) { const int n = (lane >> 3) + 8 * j; const LAS float* s = scr + (8 * c) * 33 + n;
        u32x4 o; o.x = pk2(s[0 * 33], s[1 * 33]); o.y = pk2(s[2 * 33], s[3 * 33]); o.z = pk2(s[4 * 33], s[5 * 33]); o.w = pk2(s[6 * 33], s[7 * 33]);
        *(u32x4*)(WT + (size_t)(n0 + n) * K + k0 + 8 * c) = o; }
    asm volatile("s_waitcnt lgkmcnt(0)" ::: "memory");
}
__device__ __forceinline__ void p0_transpose_item8(const float* W, int K, int N, unsigned char* WT, LAS float* scr, int item, int lane) {
    const int nblk = N / 32, kb = item / nblk, nb = item % nblk, k0 = 64 * kb, n0 = 32 * nb;
#pragma unroll 8
    for (int i = 0; i < 32; ++i) { const int kk = 2 * i + (lane >> 5); scr[kk * 33 + (lane & 31)] = W[(size_t)(k0 + kk) * N + n0 + (lane & 31)]; }
    asm volatile("s_waitcnt lgkmcnt(0)" ::: "memory");
    const int c = lane & 7;
#pragma unroll
    for (int j = 0; j < 4; ++j) { const int n = (lane >> 3) + 8 * j; const LAS float* s = scr + (8 * c) * 33 + n; constexpr float sc = pg8::W8_SCALE;
        u32x2 o; o.x = fp8_pack4(s[0 * 33] * sc, s[1 * 33] * sc, s[2 * 33] * sc, s[3 * 33] * sc); o.y = fp8_pack4(s[4 * 33] * sc, s[5 * 33] * sc, s[6 * 33] * sc, s[7 * 33] * sc);
        *(u32x2*)(WT + (size_t)(n0 + n) * K + k0 + 8 * c) = o; }
    asm volatile("s_waitcnt lgkmcnt(0)" ::: "memory");
}
__device__ __forceinline__ void cvt8(const float* src, bf16_t* dst) {
    const f32x4 a = *(const f32x4*)src, b = *(const f32x4*)(src + 4);
    u32x4 o; o.x = pk2(a[0], a[1]); o.y = pk2(a[2], a[3]); o.z = pk2(b[0], b[1]); o.w = pk2(b[2], b[3]);
    *(u32x4*)dst = o;
}

__device__ __forceinline__ void p0_prologue(const Ctx& F0, const Args& a) {
    const Ctx F = fresh(F0);
    unsigned char* ws = a.ws;
    const int nrest = (F.G > 160) ? F.G - 96 : F.G, vrest = (F.G > 160) ? F.vcu - 96 : F.vcu;
    const int gw = vrest * NWAVES + F.wave, NGW = nrest * NWAVES;
    const long gt = (long)vrest * 512 + F.tid, NGT = (long)nrest * 512;
    {
        LAS float* red = (LAS float*)(F.lds);
        const float* c = a.in[1]; const float* cctx = a.in[3]; const float* wmod = a.in[6]; const float* bmod = a.in[7];
        float* modb = (float*)(ws + WS_MOD);
        for (int item = F.vcu; item < 96; item += F.G) {
            const int l = item / 48, nc = item % 48, n0 = nc * 128 + 2 * F.lane, kb = F.wave * 128;
            float sv[9][2];
#pragma unroll
            for (int r = 0; r < 9; ++r)
#pragma unroll
                for (int j = 0; j < 2; ++j) { const int k = kb + 64 * j + F.lane; const float v = (r < 8) ? c[r * DM + k] : cctx[k]; sv[r][j] = v / (1.0f + __expf(-v)); }
            float acc[9][2];
#pragma unroll
            for (int r = 0; r < 9; ++r) { acc[r][0] = 0.f; acc[r][1] = 0.f; }
            const float* wp = wmod + (size_t)l * DM * NMOD + (size_t)kb * NMOD + n0;
#pragma unroll
            for (int j = 0; j < 2; ++j)
#pragma unroll 8
                for (int kl = 0; kl < 64; ++kl) {
                    const f32x2 w = *(const f32x2*)(wp + (size_t)(64 * j + kl) * NMOD);
#pragma unroll
                    for (int r = 0; r < 9; ++r) { const float s = __builtin_bit_cast(float, __builtin_amdgcn_readlane(__builtin_bit_cast(int, sv[r][j]), kl)); acc[r][0] += s * w[0]; acc[r][1] += s * w[1]; }
                }
            __syncthreads();
#pragma unroll
            for (int r = 0; r < 9; ++r) { red[(F.wave * 9 + r) * 128 + 2 * F.lane] = acc[r][0]; red[(F.wave * 9 + r) * 128 + 2 * F.lane + 1] = acc[r][1]; }
            __syncthreads();
            for (int o = F.tid; o < 9 * 128; o += 512) { const int r = o >> 7, nl = o & 127; float s = 0.f;
#pragma unroll
                for (int w = 0; w < 8; ++w) s += red[(w * 9 + r) * 128 + nl];
                modb[(size_t)(l * 9 + r) * NMOD + nc * 128 + nl] = s + bmod[l * NMOD + nc * 128 + nl]; }
        }
        __syncthreads();
    }
    if (vrest < 0) return;
    {
        LAS float* scr = (LAS float*)(F.lds + F.wave * 16384);
        constexpr int I_QKV = (DM / 64) * (3 * DM / 32), I_O = (DM / 64) * (DM / 32), I_PQ = (DM / 64) * (2 * DM / 32);
        constexpr int NITEMS = I_QKV + 2 * I_O + 2 * I_PQ;
        for (int it = gw; it < NITEMS; it += NGW) {
            int r = it;
            if (r < I_QKV) { p0_transpose_item8(a.in[8], DM, 3 * DM, ws + WS_WQKV, scr, r, F.lane); continue; } r -= I_QKV;
            if (r < I_O) { p0_transpose_item8(a.in[9], DM, DM, ws + WS_WO, scr, r, F.lane); continue; } r -= I_O;
            if (r < I_O) { p0_transpose_item8(a.in[11], DM, DM, ws + WS_WF, scr, r, F.lane); continue; } r -= I_O;
            if (r < I_PQ) { p0_transpose_item8(a.in[12], DM, 2 * DM, ws + WS_WPQ, scr, r, F.lane); continue; } r -= I_PQ;
            p0_transpose_item8(a.in[12] + (size_t)DM * 2 * DM, DM, 2 * DM, ws + WS_WPQ + (size_t)2 * DM * DM, scr, r, F.lane);
        }
    }
    for (long i = gt; i < 2 * 2 * 128 * 128 / 8; i += NGT) cvt8(a.in[13] + i * 8, (bf16_t*)(ws + WS_SK) + i * 8);
    {
        bf16_t* wc = (bf16_t*)(ws + WS_WC);
        for (long i = gt; i < 512 * 256 / 8; i += NGT) { const int nn = (int)(i >> 5), k0 = (int)(i & 31) * 8; float v[8];
#pragma unroll
            for (int j = 0; j < 8; ++j) { const int m = ((k0 + j) * (nn & 255)) & 255; const float fr = (float)m * (1.0f / 256.0f);
                v[j] = (nn < 256 ? __builtin_amdgcn_cosf(fr) : __builtin_amdgcn_sinf(fr)) * (1.0f / 16.0f); }
            u32x4 o; o.x = pk2(v[0], v[1]); o.y = pk2(v[2], v[3]); o.z = pk2(v[4], v[5]); o.w = pk2(v[6], v[7]);
            *(u32x4*)(wc + i * 8) = o; }
        unsigned char* cs = ws + WS_CS;
        for (long i = gt; i < 2048L * 4096 / 8; i += NGT) { const int np = (int)(i >> 9), c0 = (int)(i & 511) * 8; const int part = c0 >> 11; float v[8];
#pragma unroll
            for (int j = 0; j < 8; ++j) { const int n = (c0 + j) & 2047; const int m = (n * np) & 4095; const float fr = (float)m * (1.0f / 4096.0f);
                v[j] = (part == 0 ? __builtin_amdgcn_cosf(fr) : -__builtin_amdgcn_sinf(fr)) * (pg8::CS_SCALE / 64.0f); }
            u32x2 o; o.x = fp8_pack4(v[0], v[1], v[2], v[3]); o.y = fp8_pack4(v[4], v[5], v[6], v[7]);
            *(u32x2*)(cs + i * 8) = o; }
    }
}

__device__ __forceinline__ unsigned fp4_pack8(const float* v, float sc) {
    unsigned w = 0;
#define FP4C(i) fminf(fmaxf(v[i] * sc, -6.f), 6.f)
    w = __builtin_amdgcn_cvt_scalef32_pk_fp4_f32(w, FP4C(0), FP4C(1), 1.0f, 0);
    w = __builtin_amdgcn_cvt_scalef32_pk_fp4_f32(w, FP4C(2), FP4C(3), 1.0f, 1);
    w = __builtin_amdgcn_cvt_scalef32_pk_fp4_f32(w, FP4C(4), FP4C(5), 1.0f, 2);
    w = __builtin_amdgcn_cvt_scalef32_pk_fp4_f32(w, FP4C(6), FP4C(7), 1.0f, 3);
#undef FP4C
    return w;
}
#define FP4_DEC(w, bs) __builtin_amdgcn_cvt_scalef32_pk_f32_fp4((w), 1.0f, (bs))
__device__ __forceinline__ unsigned i8_pack4(f32x4 v, float sc) {
    const int a = (int)rintf(fminf(fmaxf(v[0] * sc, -127.f), 127.f)), b = (int)rintf(fminf(fmaxf(v[1] * sc, -127.f), 127.f));
    const int c = (int)rintf(fminf(fmaxf(v[2] * sc, -127.f), 127.f)), d = (int)rintf(fminf(fmaxf(v[3] * sc, -127.f), 127.f));
    return (unsigned)(a & 0xff) | ((unsigned)(b & 0xff) << 8) | ((unsigned)(c & 0xff) << 16) | ((unsigned)(d & 0xff) << 24);
}
constexpr long TC_PER = (long)NEXP * DM / 16, TC_TOTAL = 4 * TC_PER;
__device__ __forceinline__ void tc_issue(const Args& a, long i, f32x4 (&v)[4]) {
    const int q = (int)(i / TC_PER); const long r = i - (long)q * TC_PER; const int l = q >> 1, tb = q & 1;
    const int e = (int)(r >> 6), c16 = (int)(r & 63);
    const float* src = (tb ? a.in[15] : a.in[14]) + ((size_t)l * NEXP + e) * DM + c16 * 16;
#pragma unroll
    for (int d = 0; d < 4; ++d) v[d] = *(const f32x4*)(src + 4 * d);
}
__device__ __forceinline__ void tc_finish(const Args& a, long i, const f32x4 (&v)[4]) {
    const int q = (int)(i / TC_PER); const long r = i - (long)q * TC_PER; const int l = q >> 1, tb = q & 1;
    const int e = (int)(r >> 6), c16 = (int)(r & 63);
    const float sc = tb ? V_SCALE : U_SCALE;
    u32x2 o;
#pragma unroll
    for (int d = 0; d < 2; ++d) { const float v8[8] = {v[2 * d][0], v[2 * d][1], v[2 * d][2], v[2 * d][3], v[2 * d + 1][0], v[2 * d + 1][1], v[2 * d + 1][2], v[2 * d + 1][3]};
        o[d] = fp4_pack8(v8, sc); }
    *(u32x2*)(a.ws + WS_TAB + (size_t)l * TAB_LAYER + (tb ? TAB_VOFF : 0) + ((size_t)(c16 >> 4) * NEXP + e) * 128 + (c16 & 15) * 8) = o;
}
__device__ __forceinline__ void table_convert(const Ctx& F0, const Args& a, int sh0, int nsh, int nshare) {
    const Ctx F = fresh(F0);
    constexpr long PER = (long)NEXP * DM / 16;
    constexpr long TOTAL = 4 * PER, T0 = TOTAL / 4;
    unsigned char* t8 = a.ws + WS_TAB;
    const long per_share = (TOTAL - T0 + nshare - 1) / nshare;
    const long i0 = T0 + (long)sh0 * per_share, i1 = min(T0 + (long)(sh0 + nsh) * per_share, TOTAL);
    for (long i = i0 + F.tid; i < i1; i += 512) {
        const int q = (int)(i / PER); const long r = i - (long)q * PER; const int l = q >> 1, tb = q & 1;
        const int e = (int)(r >> 6), c16 = (int)(r & 63);
        const float* src = (tb ? a.in[15] : a.in[14]) + ((size_t)l * NEXP + e) * DM + c16 * 16;
        if (tb) {
            u32x2 o;
#pragma unroll
            for (int d = 0; d < 2; ++d) { const f32x4 va = *(const f32x4*)(src + 8 * d), vb = *(const f32x4*)(src + 8 * d + 4);
                const float v8[8] = {va[0], va[1], va[2], va[3], vb[0], vb[1], vb[2], vb[3]};
                o[d] = fp4_pack8(v8, V_SCALE); }
            *(u32x2*)(t8 + (size_t)l * TAB_LAYER + TAB_VOFF + ((size_t)(c16 >> 4) * NEXP + e) * 128 + (c16 & 15) * 8) = o;
        } else {
            u32x2 o;
#pragma unroll
            for (int d = 0; d < 2; ++d) { const f32x4 va = *(const f32x4*)(src + 8 * d), vb = *(const f32x4*)(src + 8 * d + 4);
                const float v8[8] = {va[0], va[1], va[2], va[3], vb[0], vb[1], vb[2], vb[3]};
                o[d] = fp4_pack8(v8, U_SCALE); }
            *(u32x2*)(t8 + (size_t)l * TAB_LAYER + ((size_t)(c16 >> 4) * NEXP + e) * 128 + (c16 & 15) * 8) = o;
        }
    }
}

__device__ __forceinline__ const float* norm_src(const Args& a, int mode, int m) { return (m < ML) ? ((mode == 0 ? a.in[0] : a.out) + (size_t)m * DM) : (a.in[2] + (size_t)(m - ML) * DM); }
__device__ __forceinline__ void norm_phase(const Ctx& F0, const Args& a, int mode, int layer, int off, const float* gw) {
    const Ctx F = fresh(F0);
    const int gwv = F.vcu * NWAVES + F.wave, NGW = F.G * NWAVES, lane = F.lane;
    const float* modb = (const float*)(a.ws + WS_MOD) + (size_t)layer * 9 * NMOD;
    bf16_t* hx = (bf16_t*)(a.ws + WS_HX);
    const int nrows = (mode == 0) ? MT : ML;
    f32x4 gv[4];
#pragma unroll
    for (int j = 0; j < 4; ++j) gv[j] = ((const f32x4*)gw)[lane + 64 * j];
    if (mode != 0) {
        const u32x2* XBc = (const u32x2*)(a.ws + WS_XB);
        constexpr int CH = 16, NPF = 4;
        for (int c = gwv; c < ML / CH; c += NGW) {
            const int r0 = c * CH;
            u32x2 rb[NPF][4]; f32x4 v[4], av[4], cv[4];
#pragma unroll
            for (int p = 0; p < NPF; ++p)
#pragma unroll
                for (int j = 0; j < 4; ++j) rb[p][j] = XBc[(size_t)(r0 + p) * 256 + lane + 64 * j];
            { const float* mr = modb + (size_t)(r0 >> 12) * NMOD + off;
#pragma unroll
              for (int j = 0; j < 4; ++j) { av[j] = ((const f32x4*)mr)[lane + 64 * j]; cv[j] = ((const f32x4*)(mr + DM))[lane + 64 * j]; } }
            asm volatile("" :: "v"(cv[3]));
#pragma unroll 1
            for (int q = 0; q < CH / NPF; ++q) {
#pragma unroll
              for (int p = 0; p < NPF; ++p) {
                const int m = r0 + q * NPF + p;
#pragma unroll
                for (int j = 0; j < 4; ++j) v[j] = bf4_f32(rb[p][j]);
                { const int rn = min(m + NPF, r0 + CH - 1);
#pragma unroll
                  for (int j = 0; j < 4; ++j) rb[p][j] = XBc[(size_t)rn * 256 + lane + 64 * j]; }
              float s = 0.f;
#pragma unroll
              for (int j = 0; j < 4; ++j) s += (v[j].x * v[j].x + v[j].y * v[j].y) + (v[j].z * v[j].z + v[j].w * v[j].w);
              const float rstd = 1.0f / sqrtf(wave_sum(s) * (1.0f / DM) + EPS);
              unsigned long long* o8 = (unsigned long long*)(hx + (size_t)m * DM) + lane;
              unsigned* o4 = (unsigned*)(a.ws + WS_HX + (size_t)m * DM) + lane;
#pragma unroll
              for (int j = 0; j < 4; ++j) { const f32x4 y = (v[j] * rstd * gv[j]) * (cv[j] + 1.0f) + av[j];
                  if (mode == 0 || off == 3 * DM) o4[64 * j] = fp8_pack4(y.x * pg8::ACT8_SCALE, y.y * pg8::ACT8_SCALE, y.z * pg8::ACT8_SCALE, y.w * pg8::ACT8_SCALE);
                  if (mode == 0) continue;
                  if (off != 3 * DM)
                  o8[64 * j] = (unsigned long long)cvtpk(y.x, y.y) | ((unsigned long long)cvtpk(y.z, y.w) << 32);
                  if (off == 3 * DM) {
                      const float q0 = fminf(fmaxf(y.x * XQ_SCALE, -6.f), 6.f), q1 = fminf(fmaxf(y.y * XQ_SCALE, -6.f), 6.f), q2 = fminf(fmaxf(y.z * XQ_SCALE, -6.f), 6.f), q3 = fminf(fmaxf(y.w * XQ_SCALE, -6.f), 6.f);
                      unsigned ph = __builtin_amdgcn_cvt_scalef32_pk_fp4_f32(0u, q0, q1, 1.0f, 0); ph = __builtin_amdgcn_cvt_scalef32_pk_fp4_f32(ph, q2, q3, 1.0f, 1);
                      const f32x2 d0 = FP4_DEC(ph, 0), d1 = FP4_DEC(ph, 1);
                      unsigned pl = __builtin_amdgcn_cvt_scalef32_pk_fp4_f32(0u, 4.f * (q0 - d0.x), 4.f * (q1 - d0.y), 1.0f, 0); pl = __builtin_amdgcn_cvt_scalef32_pk_fp4_f32(pl, 4.f * (q2 - d1.x), 4.f * (q3 - d1.y), 1.0f, 1);
                      unsigned short* xq = (unsigned short*)(a.ws + WS_X8 + ((size_t)j * ML + m) * 256) + lane;
                      xq[0] = (unsigned short)(ph & 0xffffu); xq[64] = (unsigned short)(pl & 0xffffu); } }
              }
            }
        }
        return;
    }
    const u32x2* XBr = (const u32x2*)(a.ws + WS_XB);
    f32x4 v[4], vn[4]; u32x2 vr[4];
    if (gwv < nrows) {
        if (mode == 0) { const f32x4* xr = (const f32x4*)norm_src(a, mode, gwv) + lane;
#pragma unroll
            for (int j = 0; j < 4; ++j) vn[j] = xr[64 * j]; }
        else {
#pragma unroll
            for (int j = 0; j < 4; ++j) vr[j] = XBr[(size_t)gwv * 256 + lane + 64 * j]; } }
    for (int m = gwv; m < nrows; m += NGW) {
        const int mn = (m + NGW < nrows) ? m + NGW : m;
        if (mode == 0) {
#pragma unroll
            for (int j = 0; j < 4; ++j) v[j] = vn[j];
            const f32x4* xr = (const f32x4*)norm_src(a, mode, mn) + lane;
#pragma unroll
            for (int j = 0; j < 4; ++j) vn[j] = xr[64 * j];
        } else {
#pragma unroll
            for (int j = 0; j < 4; ++j) v[j] = bf4_f32(vr[j]);
#pragma unroll
            for (int j = 0; j < 4; ++j) vr[j] = XBr[(size_t)mn * 256 + lane + 64 * j];
        }
        const float* mr = modb + (size_t)((m < ML) ? (m >> 12) : 8) * NMOD + off;
        f32x4 av[4], cv[4];
#pragma unroll
        for (int j = 0; j < 4; ++j) { av[j] = ((const f32x4*)mr)[lane + 64 * j]; cv[j] = ((const f32x4*)(mr + DM))[lane + 64 * j]; }
        float s = 0.f;
#pragma unroll
        for (int j = 0; j < 4; ++j) s += (v[j].x * v[j].x + v[j].y * v[j].y) + (v[j].z * v[j].z + v[j].w * v[j].w);
        const float rstd = 1.0f / sqrtf(wave_sum(s) * (1.0f / DM) + EPS);
        unsigned long long* o8 = (unsigned long long*)(hx + (size_t)m * DM) + lane;
        unsigned* o4 = (unsigned*)(a.ws + WS_HX + (size_t)m * DM) + lane;
#pragma unroll
        for (int j = 0; j < 4; ++j) { const f32x4 y = (v[j] * rstd * gv[j]) * (cv[j] + 1.0f) + av[j];
            if (mode == 0 || off == 3 * DM) o4[64 * j] = fp8_pack4(y.x * pg8::ACT8_SCALE, y.y * pg8::ACT8_SCALE, y.z * pg8::ACT8_SCALE, y.w * pg8::ACT8_SCALE);
            if (mode == 0) continue;
            if (off != 3 * DM)
            o8[64 * j] = (unsigned long long)cvtpk(y.x, y.y) | ((unsigned long long)cvtpk(y.z, y.w) << 32);
            if (off == 3 * DM) {
                const float q0 = fminf(fmaxf(y.x * XQ_SCALE, -6.f), 6.f), q1 = fminf(fmaxf(y.y * XQ_SCALE, -6.f), 6.f), q2 = fminf(fmaxf(y.z * XQ_SCALE, -6.f), 6.f), q3 = fminf(fmaxf(y.w * XQ_SCALE, -6.f), 6.f);
                unsigned ph = __builtin_amdgcn_cvt_scalef32_pk_fp4_f32(0u, q0, q1, 1.0f, 0); ph = __builtin_amdgcn_cvt_scalef32_pk_fp4_f32(ph, q2, q3, 1.0f, 1);
                const f32x2 d0 = FP4_DEC(ph, 0), d1 = FP4_DEC(ph, 1);
                unsigned pl = __builtin_amdgcn_cvt_scalef32_pk_fp4_f32(0u, 4.f * (q0 - d0.x), 4.f * (q1 - d0.y), 1.0f, 0); pl = __builtin_amdgcn_cvt_scalef32_pk_fp4_f32(pl, 4.f * (q2 - d1.x), 4.f * (q3 - d1.y), 1.0f, 1);
                unsigned short* xq = (unsigned short*)(a.ws + WS_X8 + ((size_t)j * ML + m) * 256) + lane;
                xq[0] = (unsigned short)(ph & 0xffffu); xq[64] = (unsigned short)(pl & 0xffffu); } }
    }
}
__device__ __forceinline__ void norm_fold_phase(const Ctx& F0, const Args& a, int layer, const float* gw) {
    const Ctx F = fresh(F0);
    const int gwv = F.vcu * NWAVES + F.wave, NGW = F.G * NWAVES, lane = F.lane;
    const float* modb = (const float*)(a.ws + WS_MOD) + (size_t)layer * 9 * NMOD;
    const u32x2* XBr = (const u32x2*)(a.ws + WS_XB);
    unsigned long long* hc = (unsigned long long*)(a.ws + WS_HX);
    unsigned long long* hs = (unsigned long long*)(a.ws + WS_HX + 32 * MiB);
    float* yni = (float*)(a.ws + WS_YNI);
    f32x4 gv[4];
#pragma unroll
    for (int j = 0; j < 4; ++j) gv[j] = ((const f32x4*)gw)[lane + 64 * j];
    u32x2 ra[4], rb[4];
#define NF_ROWS(task_, na_, nb_) const int b_ = (task_) >> 11, t_ = (task_) & 2047; const int na_ = b_ * SEQ + t_, nb_ = b_ * SEQ + (t_ == 0 ? 2048 : SEQ - t_)
    if (gwv < NB * 2048) { NF_ROWS(gwv, na, nb);
#pragma unroll
        for (int j = 0; j < 4; ++j) { ra[j] = XBr[(size_t)na * 256 + lane + 64 * j]; rb[j] = XBr[(size_t)nb * 256 + lane + 64 * j]; } }
    for (int task = gwv; task < NB * 2048; task += NGW) {
        const int b = task >> 11, t = task & 2047;
        f32x4 va[4], vb[4];
#pragma unroll
        for (int j = 0; j < 4; ++j) { va[j] = bf4_f32(ra[j]); vb[j] = bf4_f32(rb[j]); }
        { const int tn = (task + NGW < NB * 2048) ? task + NGW : task; NF_ROWS(tn, na, nb);
#pragma unroll
          for (int j = 0; j < 4; ++j) { ra[j] = XBr[(size_t)na * 256 + lane + 64 * j]; rb[j] = XBr[(size_t)nb * 256 + lane + 64 * j]; } }
        const float* mr = modb + (size_t)b * NMOD;
        f32x4 av[4], cv[4];
#pragma unroll
        for (int j = 0; j < 4; ++j) { av[j] = ((const f32x4*)mr)[lane + 64 * j]; cv[j] = ((const f32x4*)(mr + DM))[lane + 64 * j]; }
        float sa = 0.f, sb = 0.f;
#pragma unroll
        for (int j = 0; j < 4; ++j) { sa += (va[j].x * va[j].x + va[j].y * va[j].y) + (va[j].z * va[j].z + va[j].w * va[j].w); sb += (vb[j].x * vb[j].x + vb[j].y * vb[j].y) + (vb[j].z * vb[j].z + vb[j].w * vb[j].w); }
        const float ra_ = 1.0f / sqrtf(wave_sum(sa) * (1.0f / DM) + EPS), rb_ = 1.0f / sqrtf(wave_sum(sb) * (1.0f / DM) + EPS);
        const size_t orow = ((size_t)b * 2048 + t) * 256 + lane;
#pragma unroll
        for (int j = 0; j < 4; ++j) {
            const f32x4 ya = (va[j] * ra_ * gv[j]) * (cv[j] + 1.0f) + av[j], yb = (vb[j] * rb_ * gv[j]) * (cv[j] + 1.0f) + av[j];
            f32x4 ys, yd;
            if (t == 0) { ys = ya; yd = (f32x4){0.f, 0.f, 0.f, 0.f}; ((f32x4*)(yni + (size_t)b * DM))[lane + 64 * j] = yb; }
            else { ys = ya + yb; yd = ya - yb; }
            hc[orow + 64 * j] = (unsigned long long)cvtpk(ys.x, ys.y) | ((unsigned long long)cvtpk(ys.z, ys.w) << 32);
            hs[orow + 64 * j] = (unsigned long long)cvtpk(yd.x, yd.y) | ((unsigned long long)cvtpk(yd.z, yd.w) << 32);
        }
    }
#undef NF_ROWS
}
__device__ __forceinline__ void final_norm_phase(const Ctx& F0, const Args& a) {
    const Ctx F = fresh(F0);
    const int gwv = F.vcu * NWAVES + F.wave, NGW = F.G * NWAVES;
    const float* gw = a.in[16];
    const u32x2* XBr = (const u32x2*)(a.ws + WS_XB);
    f32x4 gv[4]; u32x2 vr[4];
#pragma unroll
    for (int j = 0; j < 4; ++j) gv[j] = ((const f32x4*)gw)[F.lane + 64 * j];
    if (gwv < ML) {
#pragma unroll
        for (int j = 0; j < 4; ++j) vr[j] = XBr[(size_t)gwv * 256 + F.lane + 64 * j]; }
    for (int m = gwv; m < ML; m += NGW) {
        f32x4* xr = (f32x4*)(a.out + (size_t)m * DM) + F.lane;
        f32x4 v[4]; float s = 0.f;
#pragma unroll
        for (int j = 0; j < 4; ++j) { v[j] = bf4_f32(vr[j]); s += (v[j].x * v[j].x + v[j].y * v[j].y) + (v[j].z * v[j].z + v[j].w * v[j].w); }
        { const int mn = (m + NGW < ML) ? m + NGW : m;
#pragma unroll
          for (int j = 0; j < 4; ++j) vr[j] = XBr[(size_t)mn * 256 + F.lane + 64 * j]; }
        const float rstd = 1.0f / sqrtf(wave_sum(s) * (1.0f / DM) + EPS);
#pragma unroll
        for (int j = 0; j < 4; ++j) xr[64 * j] = v[j] * rstd * gv[j];
    }
}

constexpr int ATT_ROWB = 144, ATT_KTILEB = 128 * ATT_ROWB, ATT_VROWB = 272, ATT_VTILEB = 64 * ATT_VROWB, ATT_BIAS_B = 2048, ATT_K0 = ATT_BIAS_B, ATT_V0 = ATT_K0 + 2 * ATT_KTILEB;
constexpr float ATT_THR = 8.0f;
template <int NGH, bool LATENT>
__device__ __forceinline__ void attn_sub(const LAS unsigned char* Kt, const LAS unsigned char* Vt_, int ko, const LAS float* browA, const LAS float* browB, const int (&relidx)[8],
                                         const bf16x8 (&qf)[2], float& m_ref, float& l_run, f32x4 (&o)[4], int q16, int g4) {
    constexpr int NG = 2 * NGH;
    bf16x8 kf[2 * NG][2]; u32x2 vf[4][NG][2]; f32x4 sc[2 * NG];
#pragma unroll
    for (int gk = 0; gk < NG; ++gk)
#pragma unroll
        for (int b2 = 0; b2 < 2; ++b2)
#pragma unroll
            for (int ks = 0; ks < 2; ++ks) kf[2 * gk + b2][ks] = *(const LAS bf16x8*)(Kt + ((gk / NGH) * 64 + ko + 32 * (gk % NGH) + 16 * b2 + q16) * ATT_ROWB + 64 * ks + 16 * g4);
#pragma unroll
    for (int d = 0; d < 4; ++d)
#pragma unroll
        for (int gk = 0; gk < NG; ++gk) { const LAS unsigned char* vp = Vt_ + (16 * d + q16) * ATT_VROWB + 2 * ((gk / NGH) * 64 + ko + 32 * (gk % NGH) + 4 * g4);
            vf[d][gk][0] = *(const LAS u32x2*)vp; vf[d][gk][1] = *(const LAS u32x2*)(vp + 32); }
    if (LATENT) {
#pragma unroll
        for (int kk = 0; kk < 8; ++kk) { sc[kk >> 2][kk & 3] = browA[relidx[kk]] - m_ref; sc[2 + (kk >> 2)][kk & 3] = browB[relidx[kk]] - m_ref; }
    } else {
#pragma unroll
        for (int blk = 0; blk < 2 * NG; ++blk) sc[blk] = (f32x4){-m_ref, -m_ref, -m_ref, -m_ref};
    }
#pragma unroll
    for (int blk = 0; blk < 2 * NG; ++blk)
#pragma unroll
        for (int ks = 0; ks < 2; ++ks) sc[blk] = __builtin_amdgcn_mfma_f32_16x16x32_bf16(kf[blk][ks], qf[ks], sc[blk], 0, 0, 0);
    float mx = fmaxf(fmaxf(sc[0][0], sc[0][1]), fmaxf(sc[0][2], sc[0][3]));
#pragma unroll
    for (int blk = 1; blk < 2 * NG; ++blk) mx = fmaxf(mx, fmaxf(fmaxf(sc[blk][0], sc[blk][1]), fmaxf(sc[blk][2], sc[blk][3])));
    if (__builtin_amdgcn_ballot_w64(mx > ATT_THR) != 0ull) {
        mx = fmaxf(mx, __shfl_xor(mx, 16)); mx = fmaxf(mx, __shfl_xor(mx, 32));
        const float dl = mx > ATT_THR ? mx : 0.f;
        m_ref += dl;
        const float al = __builtin_amdgcn_exp2f(-dl);
        l_run *= al;
#pragma unroll
        for (int d = 0; d < 4; ++d) o[d] *= al;
#pragma unroll
        for (int blk = 0; blk < 2 * NG; ++blk) sc[blk] -= dl;
    }
    float ls0 = 0.f, ls1 = 0.f;
#pragma unroll
    for (int blk = 0; blk < 2 * NG; ++blk)
#pragma unroll
        for (int i = 0; i < 4; ++i) { const float e = __builtin_amdgcn_exp2f(sc[blk][i]); sc[blk][i] = e; if (blk & 1) ls1 += e; else ls0 += e; }
    l_run += ls0 + ls1;
    bf16x8 pf[NG];
#pragma unroll
    for (int gk = 0; gk < NG; ++gk) { u32x4 pw; pw.x = cvtpk(sc[2 * gk][0], sc[2 * gk][1]); pw.y = cvtpk(sc[2 * gk][2], sc[2 * gk][3]); pw.z = cvtpk(sc[2 * gk + 1][0], sc[2 * gk + 1][1]); pw.w = cvtpk(sc[2 * gk + 1][2], sc[2 * gk + 1][3]);
        pf[gk] = __builtin_bit_cast(bf16x8, pw); }
#pragma unroll
    for (int gk = 0; gk < NG; ++gk)
#pragma unroll
        for (int d = 0; d < 4; ++d) { u32x4 vw; vw.x = vf[d][gk][0].x; vw.y = vf[d][gk][0].y; vw.z = vf[d][gk][1].x; vw.w = vf[d][gk][1].y;
            o[d] = __builtin_amdgcn_mfma_f32_16x16x32_bf16(__builtin_bit_cast(bf16x8, vw), pf[gk], o[d], 0, 0, 0); }
}
__device__ __forceinline__ void attn_phase(const Ctx& F0, const Args& a) {
    const Ctx F = fresh(F0);
    const bf16_t* QK = (const bf16_t*)(a.ws + WS_QK);
    const bf16_t* VT = (const bf16_t*)(a.ws + WS_VT);
    unsigned char* AO = a.ws + WS_HX + 36 * MiB;
    const float* rpb = a.in[10];
    LAS float* bias = (LAS float*)F.lds;
    const int tid = F.tid, lane = F.lane, q16 = lane & 15, g4 = lane >> 4;
    const int rr = F.wave >> 2, jt = F.wave & 3;
    const int qc = 16 * jt + q16, cs = min(max(qc - 8, 0), 48), ksj = min(max(16 * jt - 8, 0), 32);
    int relidx[8];
#pragma unroll
    for (int k = 0; k < 8; ++k) { const int kc = ksj + 16 * (k >> 2) + 4 * g4 + (k & 3); relidx[k] = (kc >= cs && kc < cs + 16) ? (kc - qc + 15) : 31; }
    const int krow = tid >> 3, kch = tid & 7, vrow = tid >> 4, vch = tid & 15;
    const unsigned lds_k = (unsigned)(krow * ATT_ROWB + kch * 16), lds_v = (unsigned)(vrow * ATT_VROWB + vch * 16);
    const int nunits = NB * 16 * 16, upb = (nunits + F.G - 1) / F.G;
    int cur_bh = -1;
    for (int k = 0; k < upb; ++k) {
        const int id = F.vcu * upb + k; if (id >= nunits) break;
        const int p = id & 15, bh = id >> 4, b = bh >> 4, h = bh & 15;
        if (bh != cur_bh) {
            __syncthreads();
            for (int i = tid; i < 16 * 32; i += 512) { const int dr = i >> 5, dc = i & 31; bias[i] = (dc < 31 && dr < 15) ? rpb[(h * 15 + dr) * 31 + dc] * LOG2E : -1e30f; }
            cur_bh = bh;
        }
        const int r0 = 4 * p, rs0 = min(max(r0 - 4, 0), 56), rs1 = min(max(r0 + 3 - 4, 0), 56);
        const int nlat = rs1 + 8 - rs0, nlt = (nlat + 1) >> 1, nsteps = nlt + 2;
        const int rA = r0 + rr, rB = r0 + 2 + rr, rsA = min(max(rA - 4, 0), 56), rsB = min(max(rB - 4, 0), 56);
        const long tokqA = (long)b * SEQ + rA * GW + qc, tokqB = (long)b * SEQ + rB * GW + qc;
        const bf16_t* kbase = QK + 1024 + h * 64 + kch * 8;
        const bf16_t* vbase = VT + (long)(h * 64 + vrow) * MT + (vch & 7) * 8;
#define ATT_TOKA(step) ((step) < nlt ? ((long)b * SEQ + (long)(rs0 + 2 * (step)) * GW) : ((long)ML + b * CTXL + ((step) - nlt) * 128))
#define ATT_TOKB(step) ((step) < nlt ? ((long)b * SEQ + (long)min(rs0 + 2 * (step) + 1, rs0 + nlat - 1) * GW) : ((long)ML + b * CTXL + ((step) - nlt) * 128 + 64))
        u32x4 kA[2], vA[2];
#define ATT_LOAD(step, kr_, vr_) do { const int st_ = (step) < nsteps ? (step) : nsteps - 1; const long ta_ = ATT_TOKA(st_), tb_ = ATT_TOKB(st_);     \
        kr_[0] = *(const u32x4*)(kbase + (ta_ + krow) * 2048); kr_[1] = *(const u32x4*)(kbase + (tb_ + krow) * 2048); \
        const long tv_ = (vch < 8) ? ta_ : tb_; vr_[0] = *(const u32x4*)(vbase + tv_); vr_[1] = *(const u32x4*)(vbase + (long)32 * MT + tv_); } while (0)
#define ATT_WRITE(buf, kr_, vr_) do { *(LAS u32x4*)(F.lds + ATT_K0 + (buf) * ATT_KTILEB + lds_k) = kr_[0]; *(LAS u32x4*)(F.lds + ATT_K0 + (buf) * ATT_KTILEB + 64 * ATT_ROWB + lds_k) = kr_[1]; \
        *(LAS u32x4*)(F.lds + ATT_V0 + (buf) * ATT_VTILEB + lds_v) = vr_[0]; *(LAS u32x4*)(F.lds + ATT_V0 + (buf) * ATT_VTILEB + 32 * ATT_VROWB + lds_v) = vr_[1]; } while (0)
        ATT_LOAD(0, kA, vA);
        f32x4 tcv0[4];
        const int tci0 = id * 512 + tid;
        tc_issue(a, tci0, tcv0);
        bf16x8 qfA[2], qfB[2];
#pragma unroll
        for (int ks = 0; ks < 2; ++ks) { qfA[ks] = *(const bf16x8*)(QK + tokqA * 2048 + h * 64 + 32 * ks + 8 * g4); qfB[ks] = *(const bf16x8*)(QK + tokqB * 2048 + h * 64 + 32 * ks + 8 * g4); }
        float mA = 0.f, lA = 0.f, mB = 0.f, lB = 0.f;
        f32x4 oA[4], oB[4];
#pragma unroll
        for (int d = 0; d < 4; ++d) { oA[d] = (f32x4){0.f, 0.f, 0.f, 0.f}; oB[d] = (f32x4){0.f, 0.f, 0.f, 0.f}; }
        __syncthreads();
        ATT_WRITE(0, kA, vA);
        ATT_LOAD(1, kA, vA);
        asm volatile("" :: "v"(qfA[0]), "v"(qfA[1]), "v"(qfB[0]), "v"(qfB[1]));
        __syncthreads();
#define ATT_COMPUTE(step, cur) do { \
            const LAS unsigned char* Kt = F.lds + ATT_K0 + (cur) * ATT_KTILEB; \
            const LAS unsigned char* Vt_ = F.lds + ATT_V0 + (cur) * ATT_VTILEB; \
            unsigned kt2_ = (unsigned)(size_t)Kt, vt2_ = (unsigned)(size_t)Vt_; asm volatile("" : "+v"(kt2_), "+v"(vt2_));     \
            const LAS unsigned char* KtB = (const LAS unsigned char*)(size_t)kt2_; const LAS unsigned char* VtB = (const LAS unsigned char*)(size_t)vt2_; \
            if ((step) < nlt) { const int kra = rs0 + 2 * (step), krb = kra + 1; const bool vb_ = krb < rs0 + nlat; \
                { const bool a0 = kra >= rsA && kra < rsA + 8, a1 = vb_ && krb >= rsA && krb < rsA + 8; \
                  if (a0 || a1) attn_sub<1, true>(Kt, Vt_, ksj, bias + (a0 ? (kra - rA + 7) : 15) * 32, bias + (a1 ? (krb - rA + 7) : 15) * 32, relidx, qfA, mA, lA, oA, q16, g4); } \
                { const bool b0 = kra >= rsB && kra < rsB + 8, b1 = vb_ && krb >= rsB && krb < rsB + 8; \
                  if (b0 || b1) attn_sub<1, true>(KtB, VtB, ksj, bias + (b0 ? (kra - rB + 7) : 15) * 32, bias + (b1 ? (krb - rB + 7) : 15) * 32, relidx, qfB, mB, lB, oB, q16, g4); } \
            } else {                                                     \
                attn_sub<1, false>(Kt, Vt_, 0, bias, bias, relidx, qfA, mA, lA, oA, q16, g4); attn_sub<1, false>(Kt, Vt_, 32, bias, bias, relidx, qfA, mA, lA, oA, q16, g4); \
                attn_sub<1, false>(KtB, VtB, 0, bias, bias, relidx, qfB, mB, lB, oB, q16, g4); attn_sub<1, false>(KtB, VtB, 32, bias, bias, relidx, qfB, mB, lB, oB, q16, g4); } \
        } while (0)
        for (int step = 0; step < nsteps; step += 2) {
            ATT_COMPUTE(step, 0);
            if (step + 1 < nsteps) ATT_WRITE(1, kA, vA);
            ATT_LOAD(step + 2, kA, vA);
            __syncthreads();
            if (step + 1 < nsteps) { ATT_COMPUTE(step + 1, 1); }
            if (step + 2 < nsteps) ATT_WRITE(0, kA, vA);
            ATT_LOAD(step + 3, kA, vA);
            __syncthreads();
        }
#undef ATT_LOAD
#undef ATT_WRITE
#undef ATT_COMPUTE
#undef ATT_TOKA
#undef ATT_TOKB
        { int ti_ = id * 512 + tid; asm volatile("" : "+v"(ti_));
          tc_finish(a, ti_, tcv0); }
        lA += __shfl_xor(lA, 16); lA += __shfl_xor(lA, 32); lB += __shfl_xor(lB, 16); lB += __shfl_xor(lB, 32);
        { int tq_ = b * SEQ + rA * GW + qc; asm volatile("" : "+v"(tq_));
          unsigned char* op = AO + (long)tq_ * DM + h * 64 + 4 * g4; const float ls = pg8::ACT8_SCALE / lA;
#pragma unroll
          for (int d = 0; d < 4; ++d) *(unsigned*)(op + 16 * d) = fp8_pack4(oA[d][0] * ls, oA[d][1] * ls, oA[d][2] * ls, oA[d][3] * ls); }
        { int tq_ = b * SEQ + rB * GW + qc; asm volatile("" : "+v"(tq_));
          unsigned char* op = AO + (long)tq_ * DM + h * 64 + 4 * g4; const float ls = pg8::ACT8_SCALE / lB;
#pragma unroll
          for (int d = 0; d < 4; ++d) *(unsigned*)(op + 16 * d) = fp8_pack4(oB[d][0] * ls, oB[d][1] * ls, oB[d][2] * ls, oB[d][3] * ls); }
    }
    __syncthreads();
}

__device__ __forceinline__ void ce_desc(float& a, float& b) { const float hi = fmaxf(a, b), lo = fminf(a, b); a = hi; b = lo; }
__device__ __forceinline__ void ce_dir(float& a, float& b, bool desc) { const float hi = fmaxf(a, b), lo = fminf(a, b); a = desc ? hi : lo; b = desc ? lo : hi; }
__device__ __forceinline__ void sort16_desc(float (&v)[16]) {
#define S16CE(i, j) { const float hi_ = fmaxf(v[i], v[j]), lo_ = fminf(v[i], v[j]); v[i] = hi_; v[j] = lo_; }
    S16CE(0,13) S16CE(1,12) S16CE(2,15) S16CE(3,14) S16CE(4,8) S16CE(5,6) S16CE(7,11) S16CE(9,10)
    S16CE(0,5) S16CE(1,7) S16CE(2,9) S16CE(3,4) S16CE(6,13) S16CE(8,14) S16CE(10,15) S16CE(11,12)
    S16CE(0,1) S16CE(2,3) S16CE(4,5) S16CE(6,8) S16CE(7,9) S16CE(10,11) S16CE(12,13) S16CE(14,15)
    S16CE(0,2) S16CE(1,3) S16CE(4,10) S16CE(5,11) S16CE(6,7) S16CE(8,9) S16CE(12,14) S16CE(13,15)
    S16CE(1,2) S16CE(3,12) S16CE(4,6) S16CE(5,7) S16CE(8,10) S16CE(9,11) S16CE(13,14)
    S16CE(1,4) S16CE(2,6) S16CE(5,8) S16CE(7,10) S16CE(9,13) S16CE(11,14)
    S16CE(2,4) S16CE(3,6) S16CE(9,12) S16CE(11,13)
    S16CE(3,5) S16CE(6,8) S16CE(7,9) S16CE(10,12)
    S16CE(3,4) S16CE(5,6) S16CE(7,8) S16CE(9,10) S16CE(11,12)
    S16CE(6,7) S16CE(8,9)
#undef S16CE
}
__device__ __forceinline__ void merge16_desc(float (&a)[16], const float (&b)[16]) {
#pragma unroll
    for (int i = 0; i < 16; ++i) a[i] = fmaxf(a[i], b[15 - i]);
#pragma unroll
    for (int j = 8; j > 0; j >>= 1)
#pragma unroll
        for (int i = 0; i < 16; ++i) { const int l = i ^ j; if (l > i) ce_desc(a[i], a[l]); }
}

struct CandTab { int i[64]; int j[64]; };
__host__ __device__ constexpr CandTab make_cand_tab() {
    CandTab t{}; int n = 0;
    for (int i = 0; i < 16; ++i) for (int j = 0; j < 16; ++j) if ((i + 1) * (j + 1) <= 16) { t.i[n] = i; t.j[n] = j; ++n; }
    for (; n < 64; ++n) { t.i[n] = -1; t.j[n] = -1; }
    return t;
}

__device__ __forceinline__ void peer_topk_phase(const Ctx& F0, const Args& a, int layer) {
    const Ctx F = fresh(F0);
    const bf16_t* QP = (const bf16_t*)(a.ws + WS_QK);
    const bf16_t* SK = (const bf16_t*)(a.ws + WS_SK) + (size_t)layer * 2 * 128 * 128;
    unsigned short* IDX = (unsigned short*)(a.ws + WS_IDX);
    float* GATE = (float*)(a.ws + WS_GATE);
    const int gwv = F.vcu * NWAVES + F.wave, NGW = F.G * NWAVES;
    const int lane = F.lane, t32 = lane & 31, hi = lane >> 5;
    __syncthreads();
    for (int c = F.tid; c < 4096; c += 512) *(LAS u32x4*)(F.lds + (c >> 4) * 272 + (c & 15) * 16) = *(const u32x4*)(SK + (size_t)c * 8);
    __syncthreads();
#define TK_LDQ(dst, task_, p_) do { const int tk_ = (task_) < 1024 * 8 ? (task_) : 1024 * 8 - 1; const bf16_t* qp_ = QP + ((long)(tk_ >> 3) * 32 + t32) * 2048 + (tk_ & 7) * 256 + (p_) * 128 + hi * 8; \
        _Pragma("unroll") for (int ks = 0; ks < 8; ++ks) dst[ks] = *(const bf16x8*)(qp_ + ks * 16); } while (0)
    bf16x8 qn[8];
    TK_LDQ(qn, gwv, 0);
    for (int task = gwv; task < 1024 * 8; task += NGW) {
        const int tt = task >> 3, h = task & 7;
        const long tok = (long)tt * 32 + t32;
        float top[2][16];
#pragma unroll
        for (int p = 0; p < 2; ++p) {
            bf16x8 qc[8];
#pragma unroll
            for (int ks = 0; ks < 8; ++ks) qc[ks] = qn[ks];
            if (p == 0) TK_LDQ(qn, task, 1); else TK_LDQ(qn, task + NGW, 0);
            f32x16 acc[4];
#pragma unroll
            for (int eb = 0; eb < 4; ++eb)
#pragma unroll
                for (int i = 0; i < 16; ++i) acc[eb][i] = 0.f;
#pragma unroll
            for (int eb = 0; eb < 4; ++eb) asm volatile("" : "+v"(acc[eb]));
            const LAS unsigned char* kp = F.lds + (p * 128 + t32) * 272 + hi * 16;
#pragma unroll
            for (int ks = 0; ks < 8; ++ks) {
                if ((ks & 1) == 0) asm volatile("" ::: "memory");
                const bf16x8 bq = qc[ks];
#pragma unroll
                for (int eb = 0; eb < 4; ++eb) { const bf16x8 ak = *(const LAS bf16x8*)(kp + eb * 32 * 272 + ks * 32); acc[eb] = __builtin_amdgcn_mfma_f32_32x32x16_bf16(ak, bq, acc[eb], 0, 0, 0); }
            }
            float cur[16];
#pragma unroll
            for (int eb = 0; eb < 4; ++eb) {
                float v[16];
#pragma unroll
                for (int i = 0; i < 16; ++i) { const unsigned e = 32 * eb + crow(i, hi); float x = acc[eb][i]; asm volatile("" : "+v"(x));
                    v[i] = __builtin_bit_cast(float, (__builtin_bit_cast(unsigned, x) & ~0x7Fu) | e); }
                sort16_desc(v);
                if (eb == 0) {
#pragma unroll
                    for (int i = 0; i < 16; ++i) cur[i] = v[i];
                } else merge16_desc(cur, v);
            }
            float oth[16];
#pragma unroll
            for (int i = 0; i < 16; ++i) oth[i] = __shfl_xor(cur[i], 32);
            merge16_desc(cur, oth);
#pragma unroll
            for (int i = 0; i < 16; ++i) top[p][i] = cur[i];
            __builtin_amdgcn_sched_barrier(0);
        }
        float best[16];
#pragma unroll
        for (int gI = 0; gI < 4; ++gI) {
            float v[16];
#pragma unroll
            for (int q = 0; q < 16; ++q) {
                constexpr CandTab CT = make_cand_tab();
                const int ci = CT.i[16 * gI + q], cj = CT.j[16 * gI + q];
                if (ci >= 0) {
                    const unsigned ua = __builtin_bit_cast(unsigned, top[0][ci]), ub = __builtin_bit_cast(unsigned, top[1][cj]);
                    float s = top[0][ci] + top[1][cj]; asm volatile("" : "+v"(s));
                    const unsigned code = ((ua & 0x7Fu) << 7) | (ub & 0x7Fu);
                    v[q] = __builtin_bit_cast(float, (__builtin_bit_cast(unsigned, s) & ~0x3FFFu) | code);
                } else v[q] = -3.0e38f;
            }
            sort16_desc(v);
            if (gI == 0) {
#pragma unroll
                for (int i = 0; i < 16; ++i) best[i] = v[i];
            } else merge16_desc(best, v);
            __builtin_amdgcn_sched_barrier(0);
        }
        float e[16], sum = 0.f;
#pragma unroll
        for (int i = 0; i < 16; ++i) { e[i] = __builtin_amdgcn_exp2f((best[i] - best[0]) * LOG2E); sum += e[i]; }
        const float inv = 1.0f / sum;
        if (hi == 0) {
            u32x4 w0, w1;
            w0.x = (__builtin_bit_cast(unsigned, best[0]) & 0x3FFFu) | ((__builtin_bit_cast(unsigned, best[1]) & 0x3FFFu) << 16);
            w0.y = (__builtin_bit_cast(unsigned, best[2]) & 0x3FFFu) | ((__builtin_bit_cast(unsigned, best[3]) & 0x3FFFu) << 16);
            w0.z = (__builtin_bit_cast(unsigned, best[4]) & 0x3FFFu) | ((__builtin_bit_cast(unsigned, best[5]) & 0x3FFFu) << 16);
            w0.w = (__builtin_bit_cast(unsigned, best[6]) & 0x3FFFu) | ((__builtin_bit_cast(unsigned, best[7]) & 0x3FFFu) << 16);
            w1.x = (__builtin_bit_cast(unsigned, best[8]) & 0x3FFFu) | ((__builtin_bit_cast(unsigned, best[9]) & 0x3FFFu) << 16);
            w1.y = (__builtin_bit_cast(unsigned, best[10]) & 0x3FFFu) | ((__builtin_bit_cast(unsigned, best[11]) & 0x3FFFu) << 16);
            w1.z = (__builtin_bit_cast(unsigned, best[12]) & 0x3FFFu) | ((__builtin_bit_cast(unsigned, best[13]) & 0x3FFFu) << 16);
            w1.w = (__builtin_bit_cast(unsigned, best[14]) & 0x3FFFu) | ((__builtin_bit_cast(unsigned, best[15]) & 0x3FFFu) << 16);
            u32x4* ip = (u32x4*)(IDX + tok * 128 + h * 16);
            ip[0] = w0; ip[1] = w1;
        } else {
            f32x4* gp = (f32x4*)(GATE + tok * 128 + h * 16);
#pragma unroll
            for (int q = 0; q < 4; ++q) gp[q] = (f32x4){e[4 * q] * inv, e[4 * q + 1] * inv, e[4 * q + 2] * inv, e[4 * q + 3] * inv};
        }
    }
#undef TK_LDQ
    __syncthreads();
}

typedef long i64_t;
typedef unsigned u32x8_t __attribute__((ext_vector_type(8)));
typedef _Float16 h2_t __attribute__((ext_vector_type(2)));
#define U_MFMA4_FIRST(acc, av, bv) asm volatile("v_mfma_scale_f32_16x16x128_f8f6f4 %0, %1, %2, 0, %3, %4 op_sel_hi:[0,0,0] cbsz:4 blgp:4" : "=&v"(acc) : "v"(av), "v"(bv), "v"(sc_a), "v"(sc_one))
#define U_MFMA4(acc, av, bv) asm volatile("v_mfma_scale_f32_16x16x128_f8f6f4 %0, %1, %2, %0, %3, %4 op_sel_hi:[0,0,0] cbsz:4 blgp:4" : "+v"(acc) : "v"(av), "v"(bv), "v"(sc_a), "v"(sc_one))
template <int UVAR = 0>
__device__ __forceinline__ void peer_u_phase(const Ctx& F0, const Args& a, int layer) {
    const Ctx F = fresh(F0);
    const int s = (int)(blockIdx.x & 3), half = (int)((blockIdx.x >> 2) & 1), j = (int)(blockIdx.x >> 3), nmem = F.G >> 3;
    const unsigned char* U4s = a.ws + WS_TAB + (size_t)layer * TAB_LAYER + (size_t)s * NEXP * 128;
    const unsigned* XQ = (const unsigned*)(a.ws + WS_X8 + (size_t)s * ML * 256);
    const unsigned short* IDX = (const unsigned short*)(a.ws + WS_IDX);
    unsigned* PART = (unsigned*)(a.ws + WS_PART) + (size_t)s * ML * 64;
    const int lane = F.lane, rsub = lane >> 3, c8 = lane & 7, n16 = lane & 15, g4 = lane >> 4;
    LAS unsigned char* tile = F.lds + F.wave * 16384;
    constexpr float osc = 1.0f / (U_SCALE * XQ_SCALE);
    constexpr int MLH = ML / 2;
    const int t0 = half * MLH + j * NWAVES + F.wave, stride = nmem * NWAVES, ntok = (half * MLH + MLH - t0 + stride - 1) / stride;
    unsigned sc_one = 0x7f7f7f7fu; asm volatile("" : "+v"(sc_one));
    unsigned sc_a = (n16 & 1) ? 0x7d7d7d7du : 0x7f7f7f7fu; asm volatile("" : "+v"(sc_a));
    const int abase = (32 * (n16 & 1) + 4 * g4) * 4;
#define U_TOK(i) ((size_t)(t0 + ((i) < ntok ? (i) : ntok - 1) * stride))
    const unsigned wx0 = (unsigned)(size_t)(tile + rsub * 2048 + (c8 << 4));
    const unsigned rb0 = (unsigned)(size_t)(tile + n16 * 128 + ((g4 ^ ((n16 >> 1) & 7)) << 4));
    LAS unsigned char* stg = tile + g4 * 512 + n16 * 4;
#define U_LDXQ(i) (XQ[U_TOK(i) * 64 + lane])
#define U_LDI(i) (((const unsigned*)IDX)[U_TOK(i) * 64 + lane])
#define U_IDP(dst, ci) do { _Pragma("unroll") for (int k = 0; k < 8; ++k) dst[k] = (unsigned)__builtin_amdgcn_ds_bpermute((8 * rsub + k) * 4, (int)(ci)); } while (0)
#define U_EIDP(idp, i_) (((i_) & 1) ? (idp[(i_) >> 1] >> 16) : (idp[(i_) >> 1] & 0xffffu))
#define U_READS(nb0) do { \
        _Pragma("unroll") for (int nb = 0; nb < 4; ++nb) { _Pragma("unroll") for (int ks = 0; ks < 2; ++ks) \
            bw[nb][ks] = *(const LAS u32x4*)((LAS unsigned char*)(size_t)(rb0 ^ (64u * ks)) + 2048 * ((nb0) + nb)); } \
        __builtin_amdgcn_sched_barrier(0); \
    } while (0)
#define U_MFMAS() do { \
        _Pragma("unroll") for (int nb = 0; nb < 4; ++nb) U_MFMA4_FIRST(dA[nb], aop[0], bw[nb][0]); \
        _Pragma("unroll") for (int nb = 0; nb < 4; ++nb) U_MFMA4(dA[nb], aop[1], bw[nb][1]); \
        __builtin_amdgcn_sched_barrier(0); \
    } while (0)
#define U_OUTS(nb0) do { \
        asm volatile("s_nop 15\n\ts_nop 3" : "+v"(dA[0]), "+v"(dA[1]), "+v"(dA[2]), "+v"(dA[3]) :: "memory");     \
        _Pragma("unroll") for (int nb = 0; nb < 4; ++nb) { ov[(nb0) + nb] = dA[nb][0] + dA[nb][1]; asm volatile("" : "+v"(ov[(nb0) + nb])); } \
    } while (0)
#define U_EID4(id4, r_) (((r_) & 1) ? (id4[(r_) >> 1] >> 16) : (id4[(r_) >> 1] & 0xffffu))
#define U_NH 10
#define U_BODY(j, HB, CUR, N1, N2, N3) do { \
        unsigned id1[(16 - U_NH) / 2], id2[U_NH / 2]; \
        _Pragma("unroll") for (int k = 0; k < (16 - U_NH) / 2; ++k) id1[k] = (unsigned)__builtin_amdgcn_ds_bpermute((8 * rsub + U_NH / 2 + k) * 4, (int)ci##N1);     \
        _Pragma("unroll") for (int k = 0; k < U_NH / 2; ++k) id2[k] = (unsigned)__builtin_amdgcn_ds_bpermute((8 * rsub + k) * 4, (int)ci##N2);                         \
          \
        _Pragma("unroll") for (int i_ = 0; i_ < U_NH; ++i_) { \
            *(LAS u32x4*)((LAS unsigned char*)(size_t)(wx0 ^ (unsigned)(((i_) >> 1) << 4)) + i_ * 128) = HB[i_]; \
            if (UVAR == 0) HB[i_] = *(const u32x4*)(U4s + (unsigned)(U_EID4(id2, i_) * 128 + 16 * c8)); \
        } \
        _Pragma("unroll") for (int i_ = U_NH; i_ < 16; ++i_) { \
            *(LAS u32x4*)((LAS unsigned char*)(size_t)(wx0 ^ (unsigned)(((i_) >> 1) << 4)) + i_ * 128) = S[i_ - U_NH]; \
            if (UVAR == 0) S[i_ - U_NH] = *(const u32x4*)(U4s + (unsigned)(U_EID4(id1, i_ - U_NH) * 128 + 16 * c8)); \
        } \
          \
        u32x4 aop[2]; \
        _Pragma("unroll") for (int ks = 0; ks < 2; ++ks) { _Pragma("unroll") for (int k = 0; k < 4; ++k) { \
            const unsigned w_ = (unsigned)__builtin_amdgcn_ds_bpermute(abase + (16 * ks + k) * 4, (int)cx##CUR); \
            aop[ks][k] = (n16 < 2) ? w_ : 0u; } } \
        asm volatile("s_waitcnt lgkmcnt(0)" ::: "memory");               \
        f32x4 dA[4]; u32x4 bw[4][2]; float ov[8]; \
        U_READS(0); \
        U_MFMAS(); \
          \
        ci##CUR = U_LDI((j) + 4); cx##N3 = U_LDXQ((j) + 3); \
        __builtin_amdgcn_sched_barrier(0); \
        U_READS(4);                                                      \
        U_OUTS(0); \
        U_MFMAS(); \
        U_OUTS(4); \
          \
        _Pragma("unroll") for (int nb = 0; nb < 8; ++nb) *(LAS float*)(stg + nb * 64) = ov[nb]; \
        asm volatile("s_waitcnt lgkmcnt(0)" ::: "memory"); \
        const f32x2 sum = *(const LAS f32x2*)(tile + 8 * lane); \
        asm volatile("s_waitcnt lgkmcnt(0)" ::: "memory"); \
        if ((j) < ntok) PART[U_TOK(j) * 64 + lane] = cvtpk(sum.x * osc, sum.y * osc); \
    } while (0)
    u32x4 H0[U_NH], H1[U_NH], S[16 - U_NH];
    unsigned cxA, cxB, cxC, cxD, ciA, ciB, ciC, ciD;
    ciA = U_LDI(0); ciB = U_LDI(1);
    cxA = U_LDXQ(0); cxB = U_LDXQ(1); cxC = U_LDXQ(2);
    { unsigned idp0[8], idp1[8]; U_IDP(idp0, ciA); U_IDP(idp1, ciB);
#pragma unroll
      for (int i_ = 0; i_ < U_NH; ++i_) H0[i_] = *(const u32x4*)(U4s + (unsigned)(U_EIDP(idp0, i_) * 128 + 16 * c8));
#pragma unroll
      for (int i_ = U_NH; i_ < 16; ++i_) S[i_ - U_NH] = *(const u32x4*)(U4s + (unsigned)(U_EIDP(idp0, i_) * 128 + 16 * c8));
#pragma unroll
      for (int i_ = 0; i_ < U_NH; ++i_) H1[i_] = *(const u32x4*)(U4s + (unsigned)(U_EIDP(idp1, i_) * 128 + 16 * c8)); }
    ciC = U_LDI(2); ciD = U_LDI(3);
    cxD = 0u;
    asm volatile("" :: "v"(ciD));
    for (int i = 0; i < ntok; i += 4) {
        U_BODY(i, H0, A, B, C, D);
        U_BODY(i + 1, H1, B, C, D, A);
        U_BODY(i + 2, H0, C, D, A, B);
        U_BODY(i + 3, H1, D, A, B, C);
    }
#undef U_EID4
#undef U_NH
#undef U_BODY
#undef U_READS
#undef U_MFMAS
#undef U_OUTS
#undef U_LDXQ
#undef U_LDI
#undef U_IDP
#undef U_EIDP
#undef U_TOK
}
#undef U_MFMA4_FIRST
#undef U_MFMA4
__device__ __forceinline__ void peer_w_phase(const Ctx& F0, const Args& a) {
    const Ctx F = fresh(F0);
    const unsigned* PART = (const unsigned*)(a.ws + WS_PART);
    const float* GATE = (const float*)(a.ws + WS_GATE);
    unsigned char* WQ = a.ws + WS_WT;
    float* WSC = (float*)(a.ws + WS_WSC);
    const int gwv = F.vcu * NWAVES + F.wave, NGW = F.G * NWAVES;
    unsigned pn[4]; f32x2 gn;
#define W_LD(t_) do { const int tt_ = (t_) < ML ? (t_) : ML - 1; _Pragma("unroll") for (int s = 0; s < 4; ++s) pn[s] = PART[((size_t)s * ML + tt_) * 64 + F.lane]; gn = *(const f32x2*)(GATE + (size_t)tt_ * 128 + 2 * F.lane); } while (0)
    W_LD(gwv);
    for (int t = gwv; t < ML; t += NGW) {
        f32x2 z = (f32x2){0.f, 0.f};
#pragma unroll
        for (int s = 0; s < 4; ++s) z += (f32x2){bflo(pn[s]), bfhi(pn[s])};
        const f32x2 g = gn;
        W_LD(t + NGW);
        f32x2 w; w.x = g.x * gelu_erf(z.x); w.y = g.y * gelu_erf(z.y);
        float wm = fmaxf(__builtin_fabsf(w.x), __builtin_fabsf(w.y));
#pragma unroll
        for (int o = 1; o < 64; o <<= 1) wm = fmaxf(wm, __shfl_xor(wm, o));
        wm = fmaxf(wm, 1e-20f);
        const float qs = 6.0f / wm, ax = fminf(fmaxf(w.x * qs, -6.f), 6.f), ay = fminf(fmaxf(w.y * qs, -6.f), 6.f);
        const unsigned ph = __builtin_amdgcn_cvt_scalef32_pk_fp4_f32(0u, ax, ay, 1.0f, 0) & 0xffu;
        const f32x2 dh = FP4_DEC(ph, 0);
        const unsigned pl = __builtin_amdgcn_cvt_scalef32_pk_fp4_f32(0u, fminf(fmaxf(4.f * (ax - dh.x), -6.f), 6.f), fminf(fmaxf(4.f * (ay - dh.y), -6.f), 6.f), 1.0f, 0) & 0xffu;
        ((unsigned short*)WQ)[(size_t)t * 128 + F.lane] = (unsigned short)((ph & 0xfu) | ((ph & 0xf0u) << 4));
        ((unsigned short*)WQ)[(size_t)t * 128 + 64 + F.lane] = (unsigned short)((pl & 0xfu) | ((pl & 0xf0u) << 4));
        if (F.lane == 0) WSC[t] = wm * (1.0f / 6.0f);
    }
#undef W_LD
}
#define V_MFMA4_FIRST(acc, av, bv, sa) asm volatile("v_mfma_scale_f32_16x16x128_f8f6f4 %0, %1, %2, 0, %3, %4 op_sel_hi:[0,0,0] cbsz:4 blgp:4" : "=&v"(acc) : "v"(av), "v"(bv), "v"(sa), "v"(sc_one))
#define V_MFMA4(acc, av, bv, sa) asm volatile("v_mfma_scale_f32_16x16x128_f8f6f4 %0, %1, %2, %0, %3, %4 op_sel_hi:[0,0,0] cbsz:4 blgp:4" : "+v"(acc) : "v"(av), "v"(bv), "v"(sa), "v"(sc_one))
template <int VAR = 0>
__device__ __forceinline__ void peer_v_phase(const Ctx& F0, const Args& a, int layer, float oscale = 1.0f) {
    const Ctx F = fresh(F0);
    const int s = (int)(blockIdx.x & 3), half = (int)((blockIdx.x >> 2) & 1), j = (int)(blockIdx.x >> 3), nmem = F.G >> 3;
    const unsigned char* V4s = a.ws + WS_TAB + (size_t)layer * TAB_LAYER + TAB_VOFF + (size_t)s * NEXP * 128;
    const unsigned short* IDX = (const unsigned short*)(a.ws + WS_IDX);
    const unsigned char* WQ = a.ws + WS_WT;
    const float* WSC = (const float*)(a.ws + WS_WSC);
    const float* modb = (const float*)(a.ws + WS_MOD) + (size_t)layer * 9 * NMOD;
    bf16_t* X = (bf16_t*)(a.ws + WS_XB);
    const int lane = F.lane, rsub = lane >> 3, c8 = lane & 7, n16 = lane & 15, g4 = lane >> 4;
    LAS unsigned char* tile = F.lds + F.wave * 16384;
    const float osc = ((DBG_SKIP & (layer == 0 ? 2 : 8)) ? 0.f : oscale) * (1.0f / V_SCALE);
    constexpr int MLH = ML / 2;
    const int t0 = half * MLH + j * NWAVES + F.wave, stride = nmem * NWAVES, ntok = (half * MLH + MLH - t0 + stride - 1) / stride;
    unsigned sc_one = 0x7f7f7f7fu; asm volatile("" : "+v"(sc_one));
    typedef int v2i_t __attribute__((ext_vector_type(2)));
    LAS float* gl = (LAS float*)(F.lds + RING_BYTES + 4096);
    for (int u = F.tid; u < 4 * 256; u += NWAVES * 64) gl[u] = modb[(size_t)(4 * half + (u >> 8)) * NMOD + 5 * DM + 256 * s + (u & 255)] * osc;
    __syncthreads();
#define V_TOK(i) ((size_t)(t0 + ((i) < ntok ? (i) : ntok - 1) * stride))
    LAS unsigned char* wx[4]; LAS unsigned char* rb[4];
#pragma unroll
    for (int k = 0; k < 4; ++k) wx[k] = tile + rsub * 2048 + ((c8 ^ k ^ ((rsub & 1) << 2)) << 4);
#pragma unroll
    for (int nb = 0; nb < 4; ++nb) rb[nb] = tile + g4 * 2048 + (n16 >> 1) * 128 + 8 * (n16 & 1) + ((nb ^ ((n16 >> 2) & 3) ^ ((g4 & 1) << 2)) << 4);
    LAS unsigned char* stg = tile + g4 * 1024 + n16 * 8;
#define V_LDW(i) (((const unsigned*)WQ)[V_TOK(i) * 64 + lane])
#define V_LDI(i) (((const unsigned*)IDX)[V_TOK(i) * 64 + lane])
#define V_LDX(i) (*(const u32x2*)(X + V_TOK(i) * DM + 256 * s + 4 * lane))
#define V_LDS(i) (WSC[V_TOK(i)])
#define V_IDP(dst, ci) do { _Pragma("unroll") for (int k = 0; k < 8; ++k) dst[k] = (unsigned)__builtin_amdgcn_ds_bpermute((8 * rsub + k) * 4, (int)(ci)); } while (0)
#define V_EIDP(idp, i_) (((i_) & 1) ? (idp[(i_) >> 1] >> 16) : (idp[(i_) >> 1] & 0xffffu))
#define V_READS(nb0) do { \
        unsigned x64 = (nb0) ? 64u : 0u; asm volatile("" : "+v"(x64));                   \
        _Pragma("unroll") for (int nb = 0; nb < 4; ++nb) { LAS unsigned char* rbn = (LAS unsigned char*)((unsigned)(size_t)rb[nb] ^ x64); \
          _Pragma("unroll") for (int h = 0; h < 2; ++h) { _Pragma("unroll") for (int q = 0; q < 2; ++q) { \
            const v2i_t tr = __builtin_amdgcn_ds_read_tr8_b64_v2i32((LAS v2i_t*)(rbn + 8192 * h + 1024 * q)); \
            bw[nb][h][2 * q] = (unsigned)tr[0]; bw[nb][h][2 * q + 1] = (unsigned)tr[1]; } } } \
        __builtin_amdgcn_sched_barrier(0); \
    } while (0)
#define V_MFMAS() do { \
        _Pragma("unroll") for (int nb = 0; nb < 4; ++nb) V_MFMA4_FIRST(dA[nb], aop[0], bw[nb][0], sc_a); \
        _Pragma("unroll") for (int nb = 0; nb < 4; ++nb) V_MFMA4(dA[nb], aop[1], bw[nb][1], sc_a); \
        __builtin_amdgcn_sched_barrier(0); \
    } while (0)
#define V_OUTS(nb0) do { \
        asm volatile("s_nop 15\n\ts_nop 3" : "+v"(dA[0]), "+v"(dA[1]), "+v"(dA[2]), "+v"(dA[3]) :: "memory");     \
        _Pragma("unroll") for (int nb = 0; nb < 4; ++nb) { ov[(nb0) + nb] = (f32x2){dA[nb][0] + dA[nb][2], dA[nb][1] + dA[nb][3]}; asm volatile("" : "+v"(ov[(nb0) + nb])); } \
    } while (0)
#define V_NH 8
#define V_EID4(id4, r_) (((r_) & 1) ? (id4[(r_) >> 1] >> 16) : (id4[(r_) >> 1] & 0xffffu))
#define V_BODY(j, HB, CUR, N1, N2, N3) do { \
        const size_t t_ = V_TOK(j); \
        unsigned id1[(16 - V_NH) / 2], id2[V_NH / 2]; \
        _Pragma("unroll") for (int k = 0; k < (16 - V_NH) / 2; ++k) id1[k] = (unsigned)__builtin_amdgcn_ds_bpermute((8 * rsub + V_NH / 2 + k) * 4, (int)ci##N1);     \
        _Pragma("unroll") for (int k = 0; k < V_NH / 2; ++k) id2[k] = (unsigned)__builtin_amdgcn_ds_bpermute((8 * rsub + k) * 4, (int)ci##N2);                         \
          \
        _Pragma("unroll") for (int i_ = 0; i_ < V_NH; ++i_) { \
            *(LAS u32x4*)(wx[(i_ >> 1) & 3] + i_ * 128) = HB[i_]; \
            if (VAR == 0) HB[i_] = *(const u32x4*)(V4s + (unsigned)(V_EID4(id2, i_) * 128 + 16 * c8)); \
        } \
        _Pragma("unroll") for (int i_ = V_NH; i_ < 16; ++i_) { \
            *(LAS u32x4*)(wx[(i_ >> 1) & 3] + i_ * 128) = S[i_ - V_NH]; \
            if (VAR == 0) S[i_ - V_NH] = *(const u32x4*)(V4s + (unsigned)(V_EID4(id1, i_ - V_NH) * 128 + 16 * c8)); \
        } \
          \
        u32x4 aop[2]; \
        _Pragma("unroll") for (int h = 0; h < 2; ++h) { _Pragma("unroll") for (int k = 0; k < 4; ++k) { \
            const unsigned w_ = (unsigned)__builtin_amdgcn_ds_bpermute(abase + (16 * h + k) * 4, (int)cw##CUR); \
            aop[h][k] = (n16 < 4) ? (w_ << ash) : 0u; } } \
        asm volatile("s_waitcnt lgkmcnt(0)" ::: "memory");               \
        f32x4 dA[4]; u32x4 bw[4][2]; f32x2 ov[8]; \
        V_READS(0); \
        V_MFMAS(); \
          \
        ci##CUR = V_LDI((j) + 4); cw##N2 = V_LDW((j) + 2); xo##N2 = V_LDX((j) + 2); ws##N2 = V_LDS((j) + 2); (void)sizeof(ci##N3); \
        __builtin_amdgcn_sched_barrier(0); \
        V_READS(4);                                                      \
        V_OUTS(0); \
        V_MFMAS(); \
        V_OUTS(4); \
          \
        _Pragma("unroll") for (int nb = 0; nb < 8; ++nb) *(LAS f32x2*)(stg + nb * 128) = ov[nb]; \
        asm volatile("s_waitcnt lgkmcnt(0)" ::: "memory"); \
        const f32x4 sum = *(const LAS f32x4*)(tile + 16 * lane); \
        const f32x4 gt_ = *(const LAS f32x4*)(gl + ((t_ >> 12) & 3) * 256 + 4 * lane); \
        asm volatile("s_waitcnt lgkmcnt(0)" ::: "memory"); \
        if ((j) < ntok) { const f32x4 r_ = bf4_f32(xo##CUR) + gt_ * ws##CUR * sum; *(u32x2*)(X + t_ * DM + 256 * s + 4 * lane) = (u32x2){cvtpk(r_.x, r_.y), cvtpk(r_.z, r_.w)}; } \
    } while (0)
    u32x4 H0[V_NH], H1[V_NH], S[16 - V_NH];
    unsigned cwA, cwB, cwC, cwD, ciA, ciB, ciC, ciD;
    u32x2 xoA, xoB, xoC, xoD;
    float wsA, wsB, wsC, wsD;
    const int abase = (32 * ((n16 >> 1) & 1) + 4 * g4) * 4, ash = 4 * (n16 & 1);
    unsigned sc_a = (n16 & 2) ? 0x7d7d7d7du : 0x7f7f7f7fu; asm volatile("" : "+v"(sc_a));
    ciA = V_LDI(0); ciB = V_LDI(1);
    cwA = V_LDW(0); cwB = V_LDW(1); xoA = V_LDX(0); xoB = V_LDX(1); wsA = V_LDS(0); wsB = V_LDS(1);
    { unsigned idp0[8], idp1[8]; V_IDP(idp0, ciA); V_IDP(idp1, ciB);
#pragma unroll
      for (int i_ = 0; i_ < V_NH; ++i_) H0[i_] = *(const u32x4*)(V4s + (unsigned)(V_EIDP(idp0, i_) * 128 + 16 * c8));
#pragma unroll
      for (int i_ = V_NH; i_ < 16; ++i_) S[i_ - V_NH] = *(const u32x4*)(V4s + (unsigned)(V_EIDP(idp0, i_) * 128 + 16 * c8));
#pragma unroll
      for (int i_ = 0; i_ < V_NH; ++i_) H1[i_] = *(const u32x4*)(V4s + (unsigned)(V_EIDP(idp1, i_) * 128 + 16 * c8)); }
    ciC = V_LDI(2); ciD = V_LDI(3);
    cwC = 0u; xoC = (u32x2){0u, 0u}; wsC = 0.f; cwD = 0u; xoD = (u32x2){0u, 0u}; wsD = 0.f;
    asm volatile("" :: "v"(ciD));
    for (int i = 0; i < ntok; i += 4) {
        V_BODY(i, H0, A, B, C, D);
        V_BODY(i + 1, H1, B, C, D, A);
        V_BODY(i + 2, H0, C, D, A, B);
        V_BODY(i + 3, H1, D, A, B, C);
    }
#undef V_EID4
#undef V_NH
#undef V_BODY
#undef V_READS
#undef V_MFMAS
#undef V_OUTS
#undef V_LDW
#undef V_LDI
#undef V_LDX
#undef V_LDS
#undef V_IDP
#undef V_EIDP
#undef V_TOK
}
#undef V_MFMA4_FIRST
#undef V_MFMA4

__device__ __forceinline__ void dft_nyquist_rows(const Ctx& F0, const Args& a) {
    const Ctx F = fresh(F0);
    const unsigned char* Yt = a.ws + WS_QK;
    const float* YN = (const float*)(a.ws + WS_YN);
    unsigned char* Fo = a.ws + WS_VT;
    const int gwv = F.vcu * NWAVES + F.wave, NGW = F.G * NWAVES;
    for (int o = gwv; o < NB * DM; o += NGW) {
        const unsigned char* src = Yt + (size_t)o * 4096;
        float s = 0.f;
#pragma unroll
        for (int it = 0; it < 2; ++it) { const u32x4 v = *(const u32x4*)(src + it * 1024 + F.lane * 16);
#pragma unroll
            for (int d = 0; d < 4; ++d) { const f32x2 lo = __builtin_amdgcn_cvt_pk_f32_fp8((int)v[d], false), hi = __builtin_amdgcn_cvt_pk_f32_fp8((int)v[d], true); s += (lo[0] - lo[1]) + (hi[0] - hi[1]); } }
        s = wave_sum(s) * (pg8::ACT8_SCALE / (64.0f * pg8::YT_SCALE)) + YN[o] * (pg8::ACT8_SCALE / 64.0f);
        if (F.lane == 0) Fo[((size_t)(o >> 10) * SEQ + 2048) * DM + (o & 1023)] = (unsigned char)(fp8_pack4(s, 0.f, 0.f, 0.f) & 0xffu);
    }
}
__device__ __forceinline__ void dft_yn_rows(const Ctx& F0, const Args& a) {
    const Ctx F = fresh(F0);
    const float* yi = (const float*)(a.ws + WS_YNI);
    const bf16_t* wc = (const bf16_t*)(a.ws + WS_WC);
    float* YN = (float*)(a.ws + WS_YN);
    const int gwv = F.vcu * NWAVES + F.wave, NGW = F.G * NWAVES;
    for (int o = gwv; o < NB * DM; o += NGW) {
        const int cp = o & 255;
        const f32x4 x = *(const f32x4*)(yi + (size_t)(o & ~255) + 4 * F.lane);
        const u32x2 w = *(const u32x2*)(wc + (size_t)cp * 256 + 4 * F.lane);
        const f32x4 wf = bf4_f32(w);
        const float s = wave_sum(x.x * wf.x + x.y * wf.y + x.z * wf.z + x.w * wf.w);
        if (F.lane == 0) YN[o] = s;
    }
}

__global__ void __launch_bounds__(NWAVES * 64, 2) fwd_kernel(Args args) {
    extern __shared__ __attribute__((aligned(16))) unsigned char lds_raw[];
    Ctx F;
    F.lds = (LAS unsigned char*)lds_raw;
    F.tid = threadIdx.x; F.lane = F.tid & 63; F.wave = __builtin_amdgcn_readfirstlane(F.tid >> 6);
    F.G = gridDim.x; { const int bx = blockIdx.x; F.vcu = (F.G % 8 == 0) ? (bx % 8) * (F.G / 8) + bx / 8 : bx; }
    volatile LAS unsigned* MISC = (volatile LAS unsigned*)(F.lds + MISC_OFF);
    for (int u = F.tid; u < (LDS_BYTES - LDSCTL_OFF) / 4; u += NWAVES * 64) ((LAS unsigned*)(F.lds + LDSCTL_OFF))[u] = 0u;
    __syncthreads();
    unsigned char* ws = args.ws;
    XcdBarrier bar = xcd_barrier_post((unsigned*)(ws + WS_CTL) + CW_BAR, MISC + 8);
#define GRID_BAR() xcd_barrier(bar)
#define GRID_BAR_WT() xcd_barrier<false>(bar)
#ifndef DBG_REP
#define DBG_REP 0
#endif
#ifndef DBG_VVAR
#define DBG_VVAR 0
#endif
#define REP(k, ...) do { __VA_ARGS__; if (DBG_REP == (k)) { GRID_BAR(); __VA_ARGS__; } } while (0)
#define PEER_BLOCK(layer) do { \
        norm_phase(F, args, 1, layer, 3 * DM, args.in[5] + (layer) * DM); \
        GRID_BAR(); \
        { using SHq = pg8::Shape<ML, 2048, DM / 2, DM / 2, DM / 2, 1, 0, 0>;       \
          REP(7, pg8::gemm_phase<SHq, pg8::EpiStoreBf16, true>(F.lds, pg8::Gemm{HX, (const bf16_t*)(ws + WS_WPQ) + (size_t)(layer) * 2048 * DM / 2}, F.G, bx, pg8::EpiStoreBf16{QKb, 2048, 0, 0, 1.0f, 1.0f / (pg8::ACT8_SCALE * pg8::W8_SCALE)})); } \
        if (DBG_REP == 7) GRID_BAR(); else GRID_BAR_WT(); \
        REP(8, peer_topk_phase(F, args, layer)); \
        GRID_BAR(); \
        REP(9, peer_u_phase(F, args, layer)); \
        GRID_BAR(); \
        REP(10, peer_w_phase(F, args)); \
        GRID_BAR(); \
        peer_v_phase(F, args, layer); if (DBG_REP == 11) { GRID_BAR(); peer_v_phase<DBG_VVAR>(F, args, layer, 0.f); } \
        GRID_BAR(); \
    } while (0)
    const float* modb = (const float*)(ws + WS_MOD);
    bf16_t* HX = (bf16_t*)(ws + WS_HX);
    bf16_t* QKb = (bf16_t*)(ws + WS_QK);
    bf16_t* VTb = (bf16_t*)(ws + WS_VT);
    const bf16_t* Wqkv = (const bf16_t*)(ws + WS_WQKV);
    const int bx = (int)blockIdx.x;

    REP(1, p0_prologue(F, args));
    GRID_BAR();
    REP(2, norm_phase(F, args, 0, 0, 0, args.in[4]));
    GRID_BAR();
    {
        constexpr float o8 = 1.0f / (pg8::ACT8_SCALE * pg8::W8_SCALE);
        using SH1 = pg8::Shape<MT, 2048, DM / 2, DM / 2, DM / 2, 1, 0, 0>;
        pg8::gemm_phase<SH1, pg8::EpiStoreBf16, true>(F.lds, pg8::Gemm{HX, Wqkv}, F.G, bx, pg8::EpiStoreBf16{QKb, 2048, 0, 1024, 0.125f * LOG2E, o8});
        using SH2 = pg8::Shape<DM, MT, DM / 2, DM / 2, DM / 2, 1, 0, 0>;
        const int bxv = F.G - 1 - bx;
        pg8::gemm_phase<SH2, pg8::EpiStoreBf16, true>(F.lds, pg8::Gemm{Wqkv + (size_t)2048 * DM / 2, HX}, F.G, bxv, pg8::EpiStoreBf16{VTb, MT, 0, 0, 1.0f, o8});
        {
            const int nq = (MT / 256) * 8, nv = 4 * (MT / 256), rq = nq % F.G, rv = nv % F.G;
            const int sh_q = (rq == 0 || bx >= rq) ? 1 : 0, sh_v = (rv == 0 || bxv >= rv) ? 1 : 0;
            const int nq_sh = (rq == 0 ? F.G : F.G - rq);
            const int before_q = (rq == 0 ? bx : max(0, bx - rq)), before_v = nq_sh + ((rv == 0) ? bx : min(bx, F.G - rv));
            const int total = (rq == 0 ? F.G : F.G - rq) + (rv == 0 ? F.G : F.G - rv);
            if (sh_q) table_convert(F, args, before_q, 1, total);
            if (sh_v) table_convert(F, args, before_v, 1, total);
        }
    }
    GRID_BAR();
    REP(4, attn_phase(F, args));
    GRID_BAR();
    {
        using SH = pg8::Shape<ML, DM, DM / 2, DM / 2, DM / 2, 1, 0, 0>;
        pg8::gemm_phase<SH, pg8::EpiResid<false>, true>(F.lds, pg8::Gemm{(const bf16_t*)(ws + WS_HX + 36 * MiB), (const bf16_t*)(ws + WS_WO)}, F.G, bx, pg8::EpiResid<false>{args.in[0], (bf16_t*)(ws + WS_XB), modb + 2 * DM, NMOD, ((DBG_SKIP & 1) ? 0.f : 1.f) / (pg8::ACT8_SCALE * pg8::W8_SCALE)});
    }
    GRID_BAR_WT();
    PEER_BLOCK(0);
    norm_fold_phase(F, args, 1, args.in[4] + DM);
    GRID_BAR();
    {
        using SH = pg8::Shape<256, ML / 2, 256, 256, DM, 4, 0, 256>;
        pg8::gemm_phase<SH>(F.lds, pg8::Gemm{(const bf16_t*)(ws + WS_WC), HX}, F.G, bx, pg8::EpiYt{(unsigned char*)QKb, 0});
        pg8::gemm_phase<SH>(F.lds, pg8::Gemm{(const bf16_t*)(ws + WS_WC) + 256 * 256, (const bf16_t*)(ws + WS_HX + 32 * MiB)}, F.G, bx, pg8::EpiYt{(unsigned char*)QKb, 1});
        dft_yn_rows(F, args);
    }
    GRID_BAR();
    {
        using SH = pg8::Shape<SEQ / 2, DM, 2048, 2048, 2048, NB, 0, (long)DM * 2048>;
        REP(14, pg8::gemm_phase<SH, pg8::EpiDft2, true>(F.lds, pg8::Gemm{(const bf16_t*)(ws + WS_CS), QKb}, F.G, bx, pg8::EpiDft2{(unsigned char*)VTb, (const float*)(ws + WS_YN)}));
        dft_nyquist_rows(F, args);
    }
    GRID_BAR();
    {
        using SH = pg8::Shape<ML, DM, DM / 2, DM / 2, DM / 2, 1, 0, 0>;
        pg8::gemm_phase<SH, pg8::EpiResid<true>, true>(F.lds, pg8::Gemm{VTb, (const bf16_t*)(ws + WS_WF)}, F.G, bx, pg8::EpiResid<true>{ws + WS_XB, (bf16_t*)(ws + WS_XB), modb + (size_t)9 * NMOD + 2 * DM, NMOD, ((DBG_SKIP & 4) ? 0.f : 1.f) / (pg8::ACT8_SCALE * pg8::W8_SCALE)});
    }
    GRID_BAR_WT();
    PEER_BLOCK(1);
    if (DBG_REP == 20) { for (int r = 0; r < 16; ++r) GRID_BAR(); }
    final_norm_phase(F, args);
#undef PEER_BLOCK
}

extern "C" void kernel_launch(void* const* d_in, const int* in_sizes, int n_in, void* d_out, int out_size, void* d_ws, size_t ws_size, hipStream_t stream) {
    static int grid = 0;
    if (grid == 0) {
        if (n_in != 17 || in_sizes[0] != ML * DM || out_size != ML * DM || ws_size < WS_END) { fprintf(stderr, "kernel_launch: unexpected shapes (n_in %d, in0 %d, out %d, ws %zu)\n", n_in, n_in > 0 ? in_sizes[0] : -1, out_size, ws_size); grid = -1; return; }
        int dev = 0, cus = 0, per_cu = 0;
        if (hipGetDevice(&dev) != hipSuccess || hipDeviceGetAttribute(&cus, hipDeviceAttributeMultiprocessorCount, dev) != hipSuccess) { grid = -1; return; }
        if (hipFuncSetAttribute((const void*)fwd_kernel, hipFuncAttributeMaxDynamicSharedMemorySize, LDS_BYTES) != hipSuccess) { fprintf(stderr, "kernel_launch: hipFuncSetAttribute failed\n"); grid = -1; return; }
        if (hipOccupancyMaxActiveBlocksPerMultiprocessor(&per_cu, (const void*)fwd_kernel, NWAVES * 64, LDS_BYTES) != hipSuccess || per_cu < 1)
            fprintf(stderr, "kernel_launch: note: occupancy query reports %d workgroups per CU\n", per_cu);
        (void)hipGetLastError();
        grid = cus;
        if (grid % 8 != 0) { fprintf(stderr, "kernel_launch: CU count %d is not a multiple of 8\n", cus); grid = -1; return; }
    }
    if (grid < 0) return;
    if (hipMemsetAsync((char*)d_ws + WS_CTL, 0, CTL_ZERO_BYTES, stream) != hipSuccess) { fprintf(stderr, "kernel_launch: memset failed\n"); return; }
    Args a{};
    for (int i = 0; i < 17; ++i) a.in[i] = (const float*)d_in[i];
    a.out = (float*)d_out; a.ws = (unsigned char*)d_ws;
    hipLaunchKernelGGL(fwd_kernel, dim3(grid), dim3(NWAVES * 64), LDS_BYTES, stream, a);
    const hipError_t le = hipPeekAtLastError();
    if (le != hipSuccess) fprintf(stderr, "kernel_launch: launch failed: %s\n", hipGetErrorName(le));
}
```
